# Optimizing an MI355X kernel written in HIP

```python
import numpy as np
import jax, jax.numpy as jnp
from jax import lax

D_MODEL = 1024
BATCH = 2
SEQ = 8192
DEPTH = 2

HEAD_DIM = 64
ROPE_THETA = 10000.0
RMS_EPS = 1e-6
Q_BLOCK = 128
NEG_INF = -1e30
FORCE = 1e30

POOL_WINDOWS = (2, 4, 8, 16)
POOL_GROUPS = len(POOL_WINDOWS)
POOL_GROUP_DIM = D_MODEL // 16
POOL_DIM = POOL_GROUPS * POOL_GROUP_DIM
POOL_MAXW = max(POOL_WINDOWS)

NSA_HEADS = D_MODEL // 128
NSA_KV_GROUPS = 2
NSA_HPG = NSA_HEADS // NSA_KV_GROUPS
NSA_DIM = NSA_HEADS * HEAD_DIM
NSA_KV_DIM = NSA_KV_GROUPS * HEAD_DIM
CMP_BLOCK = 32
CMP_STRIDE = 16
CMP_HIDDEN = 256
SEL_BLOCK = 64
SEL_COUNT = 16
WINDOW = 512

MOBA_HEADS = 4
MOBA_DIM = MOBA_HEADS * HEAD_DIM
MOBA_BLOCK = 256
MOBA_TOPK = 3

D_FF = ((8 * D_MODEL + 3 * 256 - 1) // (3 * 256)) * 256

IN_SIZES = (POOL_DIM, NSA_DIM, 6 * NSA_KV_DIM, 3 * NSA_HEADS, 3 * MOBA_DIM, 3 * D_MODEL)
IN_COLS = sum(IN_SIZES)

kernel_name = "hybrid_pool_nsa_moba_block"


def rms_norm(x, g):
    xf = x.astype(jnp.float32)
    y = xf * lax.rsqrt(jnp.mean(xf * xf, axis=-1, keepdims=True) + RMS_EPS)
    return (y * g.astype(jnp.float32)).astype(x.dtype)


def rope_tables(seq):
    pos = jnp.arange(seq, dtype=jnp.float32)
    inv_freq = ROPE_THETA ** (-jnp.arange(0, HEAD_DIM, 2, dtype=jnp.float32) / HEAD_DIM)
    ang = pos[:, None] * inv_freq[None, :]
    return jnp.cos(ang), jnp.sin(ang)


def apply_rope(x, cos, sin):
    half = HEAD_DIM // 2
    x1, x2 = x[..., :half], x[..., half:]
    c = cos[:, None, :].astype(x.dtype)
    s = sin[:, None, :].astype(x.dtype)
    return jnp.concatenate([x1 * c - x2 * s, x2 * c + x1 * s], axis=-1)


def masked_softmax(scores, mask):
    s = jnp.where(mask, scores.astype(jnp.float32), NEG_INF)
    m = jnp.max(s, axis=-1, keepdims=True)
    p = jnp.exp(s - m) * mask
    return p / jnp.maximum(jnp.sum(p, axis=-1, keepdims=True), 1e-30)


def pool_mixer(u, pool_w, pool_scale):
    B, S, C = u.shape
    uf = u.astype(jnp.float32)
    csum = jnp.concatenate([jnp.zeros((B, POOL_MAXW, C), jnp.float32), jnp.cumsum(uf, axis=1)], axis=1)
    t = jnp.arange(S)
    pooled = []
    for gi, w in enumerate(POOL_WINDOWS):
        sl = slice(gi * POOL_GROUP_DIM, (gi + 1) * POOL_GROUP_DIM)
        total = csum[:, POOL_MAXW:POOL_MAXW + S, sl] - csum[:, POOL_MAXW - w:POOL_MAXW - w + S, sl]
        count = jnp.minimum(t + 1, w).astype(jnp.float32)
        pooled.append(total / count[None, :, None])
    d = jnp.concatenate(pooled, axis=-1) - uf
    d = d.reshape(B, S, POOL_GROUPS, POOL_GROUP_DIM)
    y = jnp.einsum("bsgc,gce->bsge", d, pool_w.astype(jnp.float32)).reshape(B, S, C)
    return (y * pool_scale.astype(jnp.float32)).astype(u.dtype)


def nsa_compress(kv, pos_emb, w1, b1, w2, b2):
    B, S, G, D = kv.shape
    n_cmp = (S - CMP_BLOCK) // CMP_STRIDE + 1
    idx = jnp.arange(n_cmp)[:, None] * CMP_STRIDE + jnp.arange(CMP_BLOCK)[None, :]
    blocks = kv[:, idx] + pos_emb[:, None, :]
    flat = blocks.transpose(0, 1, 3, 2, 4).reshape(B, n_cmp, G, CMP_BLOCK * D)
    hid = jax.nn.gelu(flat @ w1 + b1)
    return hid @ w2 + b2


def nsa_mixer(q, k_cmp, v_cmp, k_sel, v_sel, k_win, v_win, gate_logits, cmp_pos, cmp_w1, cmp_b1, cmp_w2, cmp_b2):
    B, S = q.shape[0], q.shape[1]
    G, Hg, D = NSA_KV_GROUPS, NSA_HPG, HEAD_DIM
    scale = HEAD_DIM ** -0.5
    qg = q.reshape(B, S, G, Hg, D)
    kc = nsa_compress(k_cmp, cmp_pos[0], cmp_w1[0], cmp_b1[0], cmp_w2[0], cmp_b2[0])
    vc = nsa_compress(v_cmp, cmp_pos[1], cmp_w1[1], cmp_b1[1], cmp_w2[1], cmp_b2[1])
    n_cmp = kc.shape[1]
    n_sel = S // SEL_BLOCK
    n_top = min(SEL_COUNT, n_sel)
    ratio = SEL_BLOCK // CMP_STRIDE
    overlap = CMP_BLOCK // CMP_STRIDE
    agg_w = np.convolve(np.ones(ratio), np.ones(overlap))
    pad_front = overlap - 1
    pad_back = ratio * n_sel + len(agg_w) - 1 - pad_front - n_cmp
    cmp_end = jnp.arange(n_cmp) * CMP_STRIDE + CMP_BLOCK - 1
    k_sel_blk = k_sel.transpose(0, 2, 1, 3).reshape(B, G, n_sel, SEL_BLOCK, D)
    v_sel_blk = v_sel.transpose(0, 2, 1, 3).reshape(B, G, n_sel, SEL_BLOCK, D)
    k_win_pad = jnp.pad(k_win, ((0, 0), (WINDOW, 0), (0, 0), (0, 0)))
    v_win_pad = jnp.pad(v_win, ((0, 0), (WINDOW, 0), (0, 0), (0, 0)))
    b_idx = jnp.arange(B)[:, None, None, None]
    g_idx = jnp.arange(G)[None, :, None, None]
    blk = jnp.arange(n_sel)

    def chunk(c):
        q0 = c * Q_BLOCK
        tq = q0 + jnp.arange(Q_BLOCK)
        qc = lax.dynamic_slice_in_dim(qg, q0, Q_BLOCK, axis=1)
        s_cmp = jnp.einsum("bqghd,bngd->bghqn", qc, kc) * scale
        p_cmp = masked_softmax(s_cmp, cmp_end[None, :] <= tq[:, None])
        o_cmp = jnp.einsum("bghqn,bngd->bqghd", p_cmp.astype(vc.dtype), vc)
        p_grp = jnp.sum(p_cmp, axis=2)
        p_pad = jnp.pad(p_grp, ((0, 0), (0, 0), (0, 0), (pad_front, pad_back)))
        p_slc = sum(float(agg_w[w]) * p_pad[..., w:w + ratio * n_sel:ratio] for w in range(len(agg_w)))
        cur = tq // SEL_BLOCK
        started = blk[None, :] <= cur[:, None]
        forced = (blk[None, :] == 0) | (blk[None, :] == cur[:, None]) | (blk[None, :] == cur[:, None] - 1)
        s_slc = jnp.where(forced, FORCE, jnp.where(started, p_slc, NEG_INF))
        _, sel = lax.top_k(s_slc, n_top)
        kb = k_sel_blk[b_idx, g_idx, sel].reshape(B, G, Q_BLOCK, n_top * SEL_BLOCK, D)
        vb = v_sel_blk[b_idx, g_idx, sel].reshape(B, G, Q_BLOCK, n_top * SEL_BLOCK, D)
        kpos = (sel[..., None] * SEL_BLOCK + jnp.arange(SEL_BLOCK)).reshape(B, G, Q_BLOCK, n_top * SEL_BLOCK)
        m_sel = (kpos <= tq[:, None])[:, :, None]
        s_sel = jnp.einsum("bqghd,bgqnd->bghqn", qc, kb) * scale
        p_sel = masked_softmax(s_sel, m_sel)
        o_sel = jnp.einsum("bghqn,bgqnd->bqghd", p_sel.astype(vb.dtype), vb)
        kw = lax.dynamic_slice_in_dim(k_win_pad, q0, Q_BLOCK + WINDOW, axis=1)
        vw = lax.dynamic_slice_in_dim(v_win_pad, q0, Q_BLOCK + WINDOW, axis=1)
        kpos_w = q0 - WINDOW + jnp.arange(Q_BLOCK + WINDOW)
        m_win = (kpos_w[None, :] <= tq[:, None]) & (kpos_w[None, :] > tq[:, None] - WINDOW) & (kpos_w[None, :] >= 0)
        s_win = jnp.einsum("bqghd,bkgd->bghqk", qc, kw) * scale
        p_win = masked_softmax(s_win, m_win)
        o_win = jnp.einsum("bghqk,bkgd->bqghd", p_win.astype(vw.dtype), vw)
        return o_cmp, o_sel, o_win

    o_cmp, o_sel, o_win = lax.map(chunk, jnp.arange(S // Q_BLOCK))

    def unchunk(y):
        return jnp.moveaxis(y, 0, 1).reshape(B, S, NSA_HEADS, D)

    g = jax.nn.sigmoid(gate_logits)
    out = g[..., 0:1] * unchunk(o_cmp) + g[..., 1:2] * unchunk(o_sel) + g[..., 2:3] * unchunk(o_win)
    return out.reshape(B, S, NSA_DIM)


def moba_mixer(q, k, v):
    B, S, H, D = q.shape
    scale = HEAD_DIM ** -0.5
    n_blk = -(-S // MOBA_BLOCK)
    s_pad = n_blk * MOBA_BLOCK - S
    k_pad = jnp.pad(k, ((0, 0), (0, s_pad), (0, 0), (0, 0)))
    v_pad = jnp.pad(v, ((0, 0), (0, s_pad), (0, 0), (0, 0)))
    k_blk = k_pad.reshape(B, n_blk, MOBA_BLOCK, H, D).transpose(0, 3, 1, 2, 4)
    v_blk = v_pad.reshape(B, n_blk, MOBA_BLOCK, H, D).transpose(0, 3, 1, 2, 4)
    k_mean = jnp.mean(k_blk.astype(jnp.float32), axis=3).astype(k.dtype)
    n_top = max(1, min(MOBA_TOPK, n_blk - 1))
    b_idx = jnp.arange(B)[:, None, None, None]
    h_idx = jnp.arange(H)[None, :, None, None]
    blk = jnp.arange(n_blk)

    def chunk(c):
        q0 = c * Q_BLOCK
        tq = q0 + jnp.arange(Q_BLOCK)
        own = q0 // MOBA_BLOCK
        qc = lax.dynamic_slice_in_dim(q, q0, Q_BLOCK, axis=1)
        s_gate = jnp.einsum("bqhd,bhnd->bhqn", qc, k_mean).astype(jnp.float32)
        s_gate = jnp.where(blk < own, s_gate, NEG_INF)
        _, sel = lax.top_k(s_gate, n_top)
        sel_ok = sel < own
        kb = k_blk[b_idx, h_idx, sel].reshape(B, H, Q_BLOCK, n_top * MOBA_BLOCK, D)
        vb = v_blk[b_idx, h_idx, sel].reshape(B, H, Q_BLOCK, n_top * MOBA_BLOCK, D)
        s_sel = jnp.einsum("bqhd,bhqnd->bhqn", qc, kb) * scale
        m_sel = jnp.repeat(sel_ok, MOBA_BLOCK, axis=-1)
        ko = lax.dynamic_slice_in_dim(k_pad, own * MOBA_BLOCK, MOBA_BLOCK, axis=1)
        vo = lax.dynamic_slice_in_dim(v_pad, own * MOBA_BLOCK, MOBA_BLOCK, axis=1)
        s_own = jnp.einsum("bqhd,bkhd->bhqk", qc, ko) * scale
        kpos = own * MOBA_BLOCK + jnp.arange(MOBA_BLOCK)
        m_own = jnp.broadcast_to(kpos[None, :] <= tq[:, None], (B, H, Q_BLOCK, MOBA_BLOCK))
        p = masked_softmax(jnp.concatenate([s_sel, s_own], axis=-1),
                           jnp.concatenate([m_sel, m_own], axis=-1)).astype(v.dtype)
        n_s = n_top * MOBA_BLOCK
        return (jnp.einsum("bhqn,bhqnd->bqhd", p[..., :n_s], vb)
                + jnp.einsum("bhqk,bkhd->bqhd", p[..., n_s:], vo))

    out = lax.map(chunk, jnp.arange(S // Q_BLOCK))
    return jnp.moveaxis(out, 0, 1).reshape(B, S, H * D)


def setup_inputs(seed: int = 0) -> dict:
    key = jax.random.key(seed)
    ks = jax.random.split(key, 20)
    f32 = jnp.float32

    def nrm(k, shape, s):
        return jax.random.normal(k, shape, f32) * s

    return {
        "x": nrm(ks[0], (BATCH, SEQ, D_MODEL), 1.0),
        "attn_norm": 1.0 + nrm(ks[1], (DEPTH, D_MODEL), 0.05),
        "w_in": nrm(ks[2], (DEPTH, D_MODEL, IN_COLS), D_MODEL ** -0.5),
        "b_in": nrm(ks[3], (DEPTH, IN_COLS), 0.02),
        "pool_w": nrm(ks[4], (DEPTH, POOL_GROUPS, POOL_GROUP_DIM, POOL_GROUP_DIM), POOL_GROUP_DIM ** -0.5),
        "pool_scale": 1.0 + nrm(ks[5], (DEPTH, POOL_DIM), 0.05),
        "cmp_pos": nrm(ks[6], (DEPTH, 2, CMP_BLOCK, HEAD_DIM), 0.1),
        "cmp_w1": nrm(ks[7], (DEPTH, 2, CMP_BLOCK * HEAD_DIM, CMP_HIDDEN), (CMP_BLOCK * HEAD_DIM) ** -0.5),
        "cmp_b1": nrm(ks[8], (DEPTH, 2, CMP_HIDDEN), 0.02),
        "cmp_w2": nrm(ks[9], (DEPTH, 2, CMP_HIDDEN, HEAD_DIM), CMP_HIDDEN ** -0.5),
        "cmp_b2": nrm(ks[10], (DEPTH, 2, HEAD_DIM), 0.02),
        "w_br_pool": nrm(ks[11], (DEPTH, POOL_DIM, D_MODEL), POOL_DIM ** -0.5),
        "w_br_nsa": nrm(ks[12], (DEPTH, NSA_DIM, D_MODEL), NSA_DIM ** -0.5),
        "w_br_moba": nrm(ks[13], (DEPTH, MOBA_DIM, D_MODEL), MOBA_DIM ** -0.5),
        "w_out": nrm(ks[14], (DEPTH, D_MODEL, D_MODEL), D_MODEL ** -0.5),
        "ffn_norm": 1.0 + nrm(ks[15], (DEPTH, D_MODEL), 0.05),
        "w_gate": nrm(ks[16], (DEPTH, D_MODEL, D_FF), D_MODEL ** -0.5),
        "w_up": nrm(ks[17], (DEPTH, D_MODEL, D_FF), D_MODEL ** -0.5),
        "w_down": nrm(ks[18], (DEPTH, D_FF, D_MODEL), D_FF ** -0.5),
        "final_norm": 1.0 + nrm(ks[19], (D_MODEL,), 0.05),
    }


def reference(x, attn_norm, w_in, b_in, pool_w, pool_scale, cmp_pos, cmp_w1, cmp_b1, cmp_w2, cmp_b2,
              w_br_pool, w_br_nsa, w_br_moba, w_out, ffn_norm, w_gate, w_up, w_down, final_norm):
    B, S, _ = x.shape
    cos, sin = rope_tables(S)
    split_at = np.cumsum(IN_SIZES)[:-1].tolist()
    for l in range(DEPTH):
        h = rms_norm(x, attn_norm[l])
        proj = h @ w_in[l] + b_in[l]
        u_pool, q_nsa, kv_nsa, g_nsa, qkv_moba, g_br = jnp.split(proj, split_at, axis=-1)

        a = pool_mixer(u_pool, pool_w[l], pool_scale[l])

        q_n = apply_rope(q_nsa.reshape(B, S, NSA_HEADS, HEAD_DIM), cos, sin)
        kv = kv_nsa.reshape(B, S, 6, NSA_KV_GROUPS, HEAD_DIM)
        k_c = apply_rope(kv[:, :, 0], cos, sin)
        k_s = apply_rope(kv[:, :, 2], cos, sin)
        k_w = apply_rope(kv[:, :, 4], cos, sin)
        b = nsa_mixer(q_n, k_c, kv[:, :, 1], k_s, kv[:, :, 3], k_w, kv[:, :, 5],
                      g_nsa.reshape(B, S, NSA_HEADS, 3),
                      cmp_pos[l], cmp_w1[l], cmp_b1[l], cmp_w2[l], cmp_b2[l])

        qkv = qkv_moba.reshape(B, S, 3, MOBA_HEADS, HEAD_DIM)
        c = moba_mixer(apply_rope(qkv[:, :, 0], cos, sin), apply_rope(qkv[:, :, 1], cos, sin),
                       qkv[:, :, 2])

        gate = jax.nn.sigmoid(g_br)
        g_a, g_b, g_c = jnp.split(gate, 3, axis=-1)
        merged = g_a * (a @ w_br_pool[l]) + g_b * (b @ w_br_nsa[l]) + g_c * (c @ w_br_moba[l])
        x = x + merged @ w_out[l]

        h2 = rms_norm(x, ffn_norm[l])
        x = x + (jax.nn.silu(h2 @ w_gate[l]) * (h2 @ w_up[l])) @ w_down[l]
    return rms_norm(x, final_norm)
```

```cpp
#include <hip/hip_runtime.h>
#include <hip/hip_cooperative_groups.h>
#include <cstdio>
#include <cstdint>
#include <cmath>
namespace cg = cooperative_groups;

#define LAS __attribute__((address_space(3)))
typedef unsigned short bf16_t;
typedef short bf16x8 __attribute__((ext_vector_type(8)));
typedef short s16x4 __attribute__((ext_vector_type(4)));
typedef float f32x2 __attribute__((ext_vector_type(2)));
typedef float f32x4 __attribute__((ext_vector_type(4)));
typedef float f32x16 __attribute__((ext_vector_type(16)));
typedef unsigned u32x4 __attribute__((ext_vector_type(4)));
typedef unsigned u32x2 __attribute__((ext_vector_type(2)));
typedef __bf16 bf16x2_t __attribute__((ext_vector_type(2)));

constexpr int SEQ = 8192, BATCH = 2, MTOK = BATCH * SEQ, DM = 1024, DEPTH = 2;
constexpr int IN_COLS = 5400, NIN = 5632, DFF = 2816, NGU = 5632;
constexpr float RMS_EPS = 1e-6f;
constexpr float QSCALE = 0.125f * 1.4426950408889634f;

__device__ __forceinline__ unsigned cvtpk(float lo, float hi) { f32x2 v = {lo, hi}; bf16x2_t b = __builtin_convertvector(v, bf16x2_t); return __builtin_bit_cast(unsigned, b); }
__device__ __forceinline__ float bflo(unsigned w) { return __uint_as_float(w << 16); }
__device__ __forceinline__ float bfhi(unsigned w) { return __uint_as_float(w & 0xffff0000u); }
__device__ __forceinline__ float sigmoidf_(float x) { return __builtin_amdgcn_rcpf(1.f + __expf(-x)); }

namespace pg8 {
constexpr int BM = 256, BK = 64, HALF = 128, HTB = HALF * BK * 2, STAGE_BYTES = 8 * HTB, NXCD = 8, WGM = 8;
__host__ __device__ __forceinline__ int lds_byte(int r, int c) { const int st = (r >> 4) * 2 + (c >> 5), rr = r & 15, cc = c & 31, ob = rr * 64 + cc * 2; return st * 1024 + (ob ^ (((ob >> 9) & 1) << 5)); }
__host__ __device__ __forceinline__ void stage_rc(int b, int& R, int& C) { const int st = b / 1024, sb = b % 1024, swz = sb ^ (((sb >> 9) & 1) << 5); R = (st >> 1) * 16 + swz / 64; C = (st & 1) * 32 + (swz % 64) / 2; }
__host__ __device__ __forceinline__ int perm32(int rho) { const int n = rho >> 4, i = rho & 15; return 8 * (i >> 2) + 4 * n + (i & 3); }
struct Unit { int pm, pn; };
struct Gemm { const bf16_t* A; const bf16_t* Bt; int M, N, K; };
struct StaticOrder {
    int nM, nN, nwg, G, c;
    __host__ __device__ void init(int M, int N, int G_, int c_) { nM = M / BM; nN = N / BM; nwg = nM * nN; G = G_; c = c_; }
    __host__ __device__ bool next(int i, Unit& u) const {
        const long L = (long)i * G + c; if (L >= nwg) return false;
        int wgid = (int)L; { const int q = nwg / NXCD, r = nwg % NXCD, xcd = wgid % NXCD, off = wgid / NXCD; wgid = (xcd < r ? xcd * (q + 1) : r * (q + 1) + (xcd - r) * q) + off; }
        const int nig = WGM * nN, gid = wgid / nig, fm = gid * WGM, gsz = (nM - fm) < WGM ? (nM - fm) : WGM;
        u.pm = fm + ((wgid % nig) % gsz); u.pn = (wgid % nig) / gsz; return true;
    }
};
template <class Epi, class Sched>
__device__ __forceinline__ void gemm_phase(LAS unsigned char* lds, const Gemm g, const Sched& S, const Epi& E) {
    int tid_ = threadIdx.x; asm volatile("" : "+v"(tid_));
    const int tid = tid_, wid = __builtin_amdgcn_readfirstlane(tid >> 6), lane = tid & 63, wr = wid >> 2, wc = wid & 3, fr = lane & 15, fq = lane >> 4;
    const int K = g.K, nt = K / BK;
    unsigned voffA[2], voffB[2];
#pragma unroll
    for (int i = 0; i < 2; ++i) { int R, C; stage_rc(tid * 16 + i * 8192, R, C); const int Rb = ((R & ~31) + perm32(R & 31));
        voffA[i] = (unsigned)(R * K + C) * 2u; voffB[i] = (unsigned)(Rb * K + C) * 2u; }
    const size_t kstep = (size_t)(BK * 2);
    const size_t hstep = (size_t)HALF * K * 2;
    const size_t tstep = 2 * hstep;
    const unsigned ldsw = (unsigned)wid * 1024u;
    const int aoff = lds_byte(wr * 64 + fr, fq * 8), boff = lds_byte(wc * 32 + fr, fq * 8);
#define PG8_SA(b, h) (((b) * 2 + (h)) * HTB)
#define PG8_SB(b, h) ((4 + (b) * 2 + (h)) * HTB)
#define PG8_STAGE(bufoff, gbase, voff) do { _Pragma("unroll") for (int _i = 0; _i < 2; ++_i) \
        __builtin_amdgcn_global_load_lds((const unsigned*)((const char*)(gbase) + (voff)[_i]), (LAS unsigned*)(lds + (bufoff) + ldsw + _i * 8192), 16, 0, 0); } while (0)
#define PG8_LDA(dst, b, h) do { _Pragma("unroll") for (int m = 0; m < 4; ++m) _Pragma("unroll") for (int k = 0; k < 2; ++k) dst[m][k] = *(const LAS bf16x8*)(lds + PG8_SA(b, h) + aoff + m * 2048 + k * 1024); } while (0)
#define PG8_LDB(dst, b, h) do { _Pragma("unroll") for (int n = 0; n < 2; ++n) _Pragma("unroll") for (int k = 0; k < 2; ++k) dst[n][k] = *(const LAS bf16x8*)(lds + PG8_SB(b, h) + boff + n * 2048 + k * 1024); } while (0)
#define PG8_MMA(ai, bj, At, Bt) do { __builtin_amdgcn_s_setprio(1); _Pragma("unroll") for (int m = 0; m < 4; ++m) _Pragma("unroll") for (int n = 0; n < 2; ++n) _Pragma("unroll") for (int k = 0; k < 2; ++k) \
        acc[ai][bj][m][n] = __builtin_amdgcn_mfma_f32_16x16x32_bf16(Bt[n][k], At[m][k], acc[ai][bj][m][n], 0, 0, 0); __builtin_amdgcn_s_setprio(0); } while (0)
#define PG8_WAIT_V(n) asm volatile("s_waitcnt vmcnt(" #n ")" ::: "memory")
#define PG8_WAIT_L(n) asm volatile("s_waitcnt lgkmcnt(" #n ")" ::: "memory")
#define PG8_BAR __builtin_amdgcn_s_barrier()
#define PG8_SCHED __builtin_amdgcn_sched_barrier(0)
    Unit cur, nxt; int ui = 0;
    if (!S.next(0, cur)) return;
    f32x4 acc[2][2][4][2];
#pragma unroll
    for (int a = 0; a < 2; ++a)
#pragma unroll
        for (int b = 0; b < 2; ++b)
#pragma unroll
            for (int m = 0; m < 4; ++m)
#pragma unroll
                for (int n = 0; n < 2; ++n) acc[a][b][m][n] = (f32x4){0.f, 0.f, 0.f, 0.f};
    bf16x8 At[4][2], B0[2][2], B1[2][2];
    const char* cA = (const char*)g.A + (size_t)cur.pm * tstep; const char* cB = (const char*)g.Bt + (size_t)cur.pn * tstep;
    PG8_STAGE(PG8_SB(0, 0), cB, voffB); PG8_STAGE(PG8_SB(0, 1), cB + hstep, voffB); PG8_STAGE(PG8_SA(0, 0), cA, voffA); PG8_STAGE(PG8_SA(0, 1), cA + hstep, voffA);
    if (wr == 1) PG8_BAR;
    PG8_WAIT_V(2); PG8_BAR;
    PG8_STAGE(PG8_SB(1, 0), cB + kstep, voffB); PG8_STAGE(PG8_SA(1, 0), cA + kstep, voffA); PG8_STAGE(PG8_SB(1, 1), cB + hstep + kstep, voffB);
    PG8_WAIT_V(6); PG8_BAR;
    for (;;) {
        const bool has_next = S.next(ui + 1, nxt);
        const char* nA = has_next ? (const char*)g.A + (size_t)nxt.pm * tstep : cA; const char* nB = has_next ? (const char*)g.Bt + (size_t)nxt.pn * tstep : cB;
        for (int t = 0; t < nt; t += 2) {
            const bool last = (t == nt - 2);
            const char* a1 = cA + (size_t)(t + 1) * kstep;
            const char* a2 = last ? nA : cA + (size_t)(t + 2) * kstep; const char* b2 = last ? nB : cB + (size_t)(t + 2) * kstep;
            const char* a3 = a2 + kstep; const char* b3 = b2 + kstep;
            if constexpr (Epi::KHOOK) { if (t == 4 || t == 12) { PG8_SCHED; E.khook(acc, cur, t, wr, wc, fr, fq); PG8_SCHED; } }
            PG8_LDB(B0, 0, 0); PG8_LDB(B1, 0, 1); PG8_SCHED; PG8_LDA(At, 0, 0); PG8_STAGE(PG8_SA(1, 1), a1 + hstep, voffA);
            PG8_WAIT_V(8); PG8_WAIT_L(0); PG8_BAR; PG8_MMA(0, 0, At, B0); PG8_MMA(0, 1, At, B1); PG8_BAR; PG8_SCHED;
            PG8_LDA(At, 0, 1); PG8_STAGE(PG8_SB(0, 0), b2, voffB); PG8_STAGE(PG8_SB(0, 1), b2 + hstep, voffB); PG8_STAGE(PG8_SA(0, 0), a2, voffA);
            PG8_WAIT_V(8); PG8_WAIT_L(0); PG8_BAR; PG8_MMA(1, 0, At, B0); PG8_MMA(1, 1, At, B1); PG8_BAR; PG8_SCHED;
            PG8_LDB(B0, 1, 0); PG8_LDB(B1, 1, 1); PG8_SCHED; PG8_LDA(At, 1, 0); PG8_STAGE(PG8_SA(0, 1), a2 + hstep, voffA);
            PG8_WAIT_V(8); PG8_WAIT_L(0); PG8_BAR; PG8_MMA(0, 0, At, B0); PG8_MMA(0, 1, At, B1); PG8_BAR; PG8_SCHED;
            PG8_LDA(At, 1, 1); PG8_STAGE(PG8_SB(1, 0), b3, voffB); PG8_STAGE(PG8_SB(1, 1), b3 + hstep, voffB); PG8_STAGE(PG8_SA(1, 0), a3, voffA);
            PG8_WAIT_V(8); PG8_WAIT_L(0); PG8_BAR; PG8_MMA(1, 0, At, B0); PG8_MMA(1, 1, At, B1); PG8_BAR; PG8_SCHED;
        }
        if (wr == 0) PG8_BAR;
        E(acc, cur, wr, wc, fr, fq);
        if (!has_next) break;
#pragma unroll
        for (int a = 0; a < 2; ++a)
#pragma unroll
            for (int b = 0; b < 2; ++b)
#pragma unroll
                for (int m = 0; m < 4; ++m)
#pragma unroll
                    for (int n = 0; n < 2; ++n) acc[a][b][m][n] = (f32x4){0.f, 0.f, 0.f, 0.f};
        cur = nxt; cA = nA; cB = nB; ++ui;
        if (wr == 1) PG8_BAR;
    }
    PG8_WAIT_V(0);
    PG8_BAR;
#undef PG8_SA
#undef PG8_SB
#undef PG8_STAGE
#undef PG8_LDA
#undef PG8_LDB
#undef PG8_MMA
#undef PG8_WAIT_V
#undef PG8_WAIT_L
#undef PG8_BAR
#undef PG8_SCHED
}
}
using pg8::Unit;
__device__ __forceinline__ float row_rstd(const float* ssp, int row) {
    const f32x4* p = (const f32x4*)(ssp + (size_t)row * 16);
    const f32x4 a = p[0], b = p[1], c = p[2], d = p[3];
    const float ss = ((a[0] + a[1]) + (a[2] + a[3])) + ((b[0] + b[1]) + (b[2] + b[3])) + ((c[0] + c[1]) + (c[2] + c[3])) + ((d[0] + d[1]) + (d[2] + d[3]));
    return 1.0f / sqrtf(ss * (1.0f / DM) + RMS_EPS);
}
__device__ __forceinline__ u32x4 pack8(const f32x4 a, const f32x4 b) { u32x4 w; w.x = cvtpk(a[0], a[1]); w.y = cvtpk(a[2], a[3]); w.z = cvtpk(b[0], b[1]); w.w = cvtpk(b[2], b[3]); return w; }
__device__ __forceinline__ void rope8(f32x4& v0, f32x4& v1, const float* tab, int t, int pos, float sc) {
    const f32x4* cs = (const f32x4*)(tab + ((size_t)t * 32 + (pos >> 1)) * 2);
    const f32x4 c0 = cs[0], c1 = cs[1];
    f32x4 o0, o1;
    o0[0] = (v0[0] * c0[0] - v0[1] * c0[1]) * sc; o0[1] = (v0[1] * c0[0] + v0[0] * c0[1]) * sc;
    o0[2] = (v0[2] * c0[2] - v0[3] * c0[3]) * sc; o0[3] = (v0[3] * c0[2] + v0[2] * c0[3]) * sc;
    o1[0] = (v1[0] * c1[0] - v1[1] * c1[1]) * sc; o1[1] = (v1[1] * c1[0] + v1[0] * c1[1]) * sc;
    o1[2] = (v1[2] * c1[2] - v1[3] * c1[3]) * sc; o1[3] = (v1[3] * c1[2] + v1[2] * c1[3]) * sc;
    v0 = o0; v1 = o1;
}
struct EpiInProj {
    static constexpr bool KHOOK = false;
    const float* ssp; const float* bias; const float* tab;
    bf16_t *U, *Qn, *KV, *Mo, *G, *Gn;
    __device__ __forceinline__ void operator()(const f32x4 (&acc)[2][2][4][2], const Unit& u, int wr, int wc, int fr, int fq) const {
        asm volatile("" : "+v"(fr), "+v"(fq));
        const int pn = u.pn;
#pragma unroll
        for (int ai = 0; ai < 2; ++ai)
#pragma unroll
            for (int m = 0; m < 4; ++m) {
                const int row = u.pm * 256 + ai * 128 + wr * 64 + m * 16 + fr;
                const float rstd = row_rstd(ssp, row);
                const int t = row & (SEQ - 1), b = row >> 13;
#pragma unroll
                for (int bj = 0; bj < 2; ++bj) {
                    const int cit = bj * 128 + wc * 32 + 8 * fq, gc = pn * 256 + cit;
                    f32x4 v0 = acc[ai][bj][m][0] * rstd + *(const f32x4*)(bias + gc), v1 = acc[ai][bj][m][1] * rstd + *(const f32x4*)(bias + gc + 4);
                    bf16_t* dst;
                    if (pn == 0) { dst = U + (size_t)row * 256 + cit; }
                    else if (pn <= 2) { const int c2 = (pn - 1) * 256 + cit, head = c2 >> 6, pos = c2 & 63; rope8(v0, v1, tab, t, pos, QSCALE); dst = Qn + ((size_t)(b * 8 + head) * SEQ + t) * 64 + pos; }
                    else if (pn <= 5) { const int c2 = cit & 127, g = c2 >> 6, pos = c2 & 63, kvi = 2 * (pn - 3) + bj; if (bj == 0) rope8(v0, v1, tab, t, pos, 1.f);
                        dst = KV + (size_t)kvi * ((size_t)MTOK * 128) + ((size_t)(b * 2 + g) * SEQ + t) * 64 + pos; }
                    else if (pn <= 8) { const int h = cit >> 6, pos = cit & 63; if (pn < 8) rope8(v0, v1, tab, t, pos, pn == 6 ? QSCALE : 1.f);
                        dst = Mo + (size_t)(pn - 6) * ((size_t)MTOK * 256) + ((size_t)(b * 4 + h) * SEQ + t) * 64 + pos; }
                    else if (pn <= 20) {
#pragma unroll
                        for (int e = 0; e < 4; ++e) { v0[e] = sigmoidf_(v0[e]); v1[e] = sigmoidf_(v1[e]); }
                        dst = G + (size_t)row * 3072 + (pn - 9) * 256 + cit; }
                    else {
#pragma unroll
                        for (int e = 0; e < 4; ++e) { v0[e] = sigmoidf_(v0[e]); v1[e] = sigmoidf_(v1[e]); }
                        dst = Gn + (size_t)row * 32 + (cit & 31); if (cit >= 32) dst = nullptr; }
                    if (dst) *(u32x4*)dst = pack8(v0, v1);
                }
                asm volatile("" ::: "memory");
            }
    }
};
struct EpiBranch {
    static constexpr bool KHOOK = true;
    const bf16_t* G; bf16_t* out;
    __device__ __forceinline__ void khook(f32x4 (&acc)[2][2][4][2], const Unit& u, int t, int wr, int wc, int fr, int fq) const {
        asm volatile("" : "+v"(fr), "+v"(fq));
        const int gsel = (t == 4) ? 0 : 1024;
#pragma unroll
        for (int ai = 0; ai < 2; ++ai)
#pragma unroll
            for (int m = 0; m < 4; ++m) {
                const int row = u.pm * 256 + ai * 128 + wr * 64 + m * 16 + fr;
#pragma unroll
                for (int bj = 0; bj < 2; ++bj) {
                    const int col = u.pn * 256 + bj * 128 + wc * 32 + 8 * fq;
                    const u32x4 gx = *(const u32x4*)(G + (size_t)row * 3072 + gsel + col), gy = *(const u32x4*)(G + (size_t)row * 3072 + gsel + 1024 + col);
#pragma unroll
                    for (int e = 0; e < 4; ++e) {
                        const float x0 = fmaxf(bflo(gx[e]), 1e-20f), x1 = fmaxf(bfhi(gx[e]), 1e-20f), y0 = fmaxf(bflo(gy[e]), 1e-20f), y1 = fmaxf(bfhi(gy[e]), 1e-20f);
                        const float r0 = x0 * __builtin_amdgcn_rcpf(y0), r1 = x1 * __builtin_amdgcn_rcpf(y1);
                        acc[ai][bj][m][e >> 1][(e & 1) * 2] *= r0; acc[ai][bj][m][e >> 1][(e & 1) * 2 + 1] *= r1;
                    }
                    asm volatile("" ::: "memory");
                }
            }
    }
    __device__ __forceinline__ void operator()(const f32x4 (&acc)[2][2][4][2], const Unit& u, int wr, int wc, int fr, int fq) const {
        asm volatile("" : "+v"(fr), "+v"(fq));
#pragma unroll
        for (int ai = 0; ai < 2; ++ai)
#pragma unroll
            for (int m = 0; m < 4; ++m) {
                const int row = u.pm * 256 + ai * 128 + wr * 64 + m * 16 + fr;
#pragma unroll
                for (int bj = 0; bj < 2; ++bj) {
                    const int col = u.pn * 256 + bj * 128 + wc * 32 + 8 * fq;
                    const u32x4 gz = *(const u32x4*)(G + (size_t)row * 3072 + 2048 + col);
                    f32x4 v0 = acc[ai][bj][m][0], v1 = acc[ai][bj][m][1];
                    v0[0] *= fmaxf(bflo(gz[0]), 1e-20f); v0[1] *= fmaxf(bfhi(gz[0]), 1e-20f); v0[2] *= fmaxf(bflo(gz[1]), 1e-20f); v0[3] *= fmaxf(bfhi(gz[1]), 1e-20f);
                    v1[0] *= fmaxf(bflo(gz[2]), 1e-20f); v1[1] *= fmaxf(bfhi(gz[2]), 1e-20f); v1[2] *= fmaxf(bflo(gz[3]), 1e-20f); v1[3] *= fmaxf(bfhi(gz[3]), 1e-20f);
                    *(u32x4*)(out + (size_t)row * DM + col) = pack8(v0, v1);
                }
                asm volatile("" ::: "memory");
            }
    }
};
struct EpiResid {
    static constexpr bool KHOOK = false;
    const float* base; float* out; bf16_t* xb; float* ssp;
    __device__ __forceinline__ void operator()(const f32x4 (&acc)[2][2][4][2], const Unit& u, int wr, int wc, int fr, int fq) const {
        asm volatile("" : "+v"(fr), "+v"(fq));
#pragma unroll
        for (int ai = 0; ai < 2; ++ai)
#pragma unroll
            for (int m = 0; m < 4; ++m) {
                const int row = u.pm * 256 + ai * 128 + wr * 64 + m * 16 + fr;
                float ss = 0.f;
#pragma unroll
                for (int bj = 0; bj < 2; ++bj) {
                    const size_t off = (size_t)row * DM + u.pn * 256 + bj * 128 + wc * 32 + 8 * fq;
                    const f32x4 v0 = acc[ai][bj][m][0] + *(const f32x4*)(base + off), v1 = acc[ai][bj][m][1] + *(const f32x4*)(base + off + 4);
                    *(f32x4*)(out + off) = v0; *(f32x4*)(out + off + 4) = v1;
                    *(u32x4*)(xb + off) = pack8(v0, v1);
                    ss += (v0[0] * v0[0] + v0[1] * v0[1]) + (v0[2] * v0[2] + v0[3] * v0[3]) + (v1[0] * v1[0] + v1[1] * v1[1]) + (v1[2] * v1[2] + v1[3] * v1[3]);
                }
                ss += __shfl_xor(ss, 16); ss += __shfl_xor(ss, 32);
                if (fq == 0) ssp[(size_t)row * 16 + u.pn * 4 + wc] = ss;
                asm volatile("" ::: "memory");
            }
    }
};
struct EpiSwiGLU {
    static constexpr bool KHOOK = false;
    const float* ssp; bf16_t* H;
    __device__ __forceinline__ void operator()(const f32x4 (&acc)[2][2][4][2], const Unit& u, int wr, int wc, int fr, int fq) const {
        asm volatile("" : "+v"(fr), "+v"(fq));
#pragma unroll
        for (int ai = 0; ai < 2; ++ai)
#pragma unroll
            for (int m = 0; m < 4; ++m) {
                const int row = u.pm * 256 + ai * 128 + wr * 64 + m * 16 + fr;
                const float rstd = row_rstd(ssp, row);
                f32x4 o[2];
#pragma unroll
                for (int n = 0; n < 2; ++n)
#pragma unroll
                    for (int e = 0; e < 4; ++e) { const float gt = acc[ai][0][m][n][e] * rstd, up = acc[ai][1][m][n][e] * rstd; o[n][e] = gt * sigmoidf_(gt) * up; }
                *(u32x4*)(H + (size_t)row * DFF + u.pn * 128 + wc * 32 + 8 * fq) = pack8(o[0], o[1]);
                asm volatile("" ::: "memory");
            }
    }
};
#ifndef ABL_NSA_SCALE
#define ABL_NSA_SCALE
#endif
#ifndef ABL_MOBA_SCALE
#define ABL_MOBA_SCALE
#endif
namespace att {
constexpr int KCS = 1040, KSLOT = 8 * KCS, VSLOT = 8192;
constexpr int L_K0 = 0, L_K1 = KSLOT, L_V0 = 2 * KSLOT, L_V1 = 2 * KSLOT + VSLOT, L_WSF = 2 * KSLOT + 2 * VSLOT, L_PS = L_WSF + 8 * 256, L_MSK = L_PS + 64 * 128 * 4,
              L_UNI = L_MSK + 1024, L_LIST = L_UNI + 64, L_END = L_LIST + 512, L_OT = L_END + 64, L_TOTAL = L_OT + 8 * 8192;
#define LBAR() asm volatile("s_waitcnt lgkmcnt(0)\n\ts_barrier" ::: "memory")
#define LWAIT() asm volatile("s_waitcnt lgkmcnt(0)" ::: "memory")
__device__ __forceinline__ int crow(int r, int hi) { return (r & 3) + 8 * (r >> 2) + 4 * hi; }
__device__ __forceinline__ float swap_other(float v, int hi) { auto rr = __builtin_amdgcn_permlane32_swap(__float_as_uint(v), __float_as_uint(v), false, false); return __uint_as_float(hi ? rr[0] : rr[1]); }
__device__ __forceinline__ void qkt(f32x16& p0, f32x16& p1, const LAS char* Ks, const bf16x8* qr, int r32, int hi) {
    const LAS char* kb = Ks + hi * KCS + r32 * 16;
    p0 = f32x16{}; p1 = f32x16{};
#pragma unroll
    for (int d0 = 0; d0 < 4; ++d0) {
        const bf16x8 b0 = *(const LAS bf16x8*)(kb + d0 * 2 * KCS), b1 = *(const LAS bf16x8*)(kb + d0 * 2 * KCS + 512);
        p0 = __builtin_amdgcn_mfma_f32_32x32x16_bf16(b0, qr[d0], p0, 0, 0, 0); p1 = __builtin_amdgcn_mfma_f32_32x32x16_bf16(b1, qr[d0], p1, 0, 0, 0); }
}
__device__ __forceinline__ void pv(f32x16* o, int vb, bf16x8 pa0, bf16x8 pa1, bf16x8 pa2, bf16x8 pa3) {
#pragma unroll
    for (int d0 = 0; d0 < 2; ++d0) { s16x4 lo[4], hi[4];
#pragma unroll
        for (int ks = 0; ks < 4; ++ks) {
            asm volatile("ds_read_b64_tr_b16 %0,%1 offset:%c2" : "=&v"(lo[ks]) : "v"(vb), "i"(d0 * 4096 + ks * 1024) : "memory");
            asm volatile("ds_read_b64_tr_b16 %0,%1 offset:%c2" : "=&v"(hi[ks]) : "v"(vb), "i"(d0 * 4096 + ks * 1024 + 512) : "memory"); }
        asm volatile("s_waitcnt lgkmcnt(0)" ::: "memory"); __builtin_amdgcn_sched_barrier(0);
#define PK(k) (bf16x8){lo[k][0], lo[k][1], lo[k][2], lo[k][3], hi[k][0], hi[k][1], hi[k][2], hi[k][3]}
        o[d0] = __builtin_amdgcn_mfma_f32_32x32x16_bf16(pa0, PK(0), o[d0], 0, 0, 0);
        o[d0] = __builtin_amdgcn_mfma_f32_32x32x16_bf16(pa1, PK(1), o[d0], 0, 0, 0);
        o[d0] = __builtin_amdgcn_mfma_f32_32x32x16_bf16(pa2, PK(2), o[d0], 0, 0, 0);
        o[d0] = __builtin_amdgcn_mfma_f32_32x32x16_bf16(pa3, PK(3), o[d0], 0, 0, 0);
#undef PK
    }
}
__device__ __forceinline__ float rowmax(const f32x16& p0, const f32x16& p1, int hi) {
    float a = __builtin_fmaxf(p0[0], p1[0]);
#pragma unroll
    for (int r = 1; r < 16; ++r) a = __builtin_fmaxf(__builtin_fmaxf(a, p0[r]), p1[r]);
    return __builtin_fmaxf(a, swap_other(a, hi));
}
struct KVRegs { u32x4 k, v; };
__device__ __forceinline__ void tile_load(KVRegs& R, const bf16_t* K, const bf16_t* V, int tid) { R.k = *(const u32x4*)(K + tid * 8); R.v = *(const u32x4*)(V + tid * 8); }
__device__ __forceinline__ void tile_store(const KVRegs& R, LAS char* Ks, LAS char* Vs, int tid) {
    const int row = tid >> 3, c = tid & 7;
    *(LAS u32x4*)(Ks + c * KCS + row * 16) = R.k;
    *(LAS u32x4*)(Vs + (c >> 2) * 4096 + (row >> 4) * 1024 + (row & 15) * 64 + (c & 3) * 16) = R.v;
}
__device__ __forceinline__ void ps_accum(const f32x16 p, int jb, LAS float* ps_row, bool writer) {
#pragma unroll
    for (int rg = 0; rg < 4; ++rg) {
        float a = 2.f * (p[4 * rg] + p[4 * rg + 1] + p[4 * rg + 2]) + p[4 * rg + 3], bq = p[4 * rg + 3];
        a += __shfl_xor(a, 1); a += __shfl_xor(a, 2); bq += __shfl_xor(bq, 1); bq += __shfl_xor(bq, 2);
        const int j = jb + 2 * rg;
        if (writer) { __hip_atomic_fetch_add(ps_row + j, a, __ATOMIC_RELAXED, __HIP_MEMORY_SCOPE_WORKGROUP); if (j + 1 < 128) __hip_atomic_fetch_add(ps_row + j + 1, bq, __ATOMIC_RELAXED, __HIP_MEMORY_SCOPE_WORKGROUP); }
    }
}
struct Ctx { LAS char* lds; LAS float* wsf; LAS float* otl; int tid, wid, lane, r32, hi, vbl; };
template <int MODE, class Src, class Msk>
__device__ __forceinline__ void run_branch(const Ctx& C, int nt, const Src& src, const Msk& msk, const bf16x8* qr, float& m, float& l, f32x16* o, float invl, LAS float* ps_row, bool ps_writer) {
    if (nt <= 0) return;
    KVRegs R; const bf16_t *kp, *vp;
    src(0, kp, vp); tile_load(R, kp, vp, C.tid);
    LBAR();
    for (int it = 0; it < nt; ++it) {
        LAS char* Ks = C.lds + ((it & 1) ? L_K1 : L_K0); LAS char* Vs = C.lds + ((it & 1) ? L_V1 : L_V0);
        tile_store(R, Ks, Vs, C.tid);
        if (it + 1 < nt) { src(it + 1, kp, vp); tile_load(R, kp, vp, C.tid); }
        LBAR();
        int klo, khi; const bool nm = msk(it, klo, khi);
        if (!__any(khi >= klo)) continue;
        f32x16 p0, p1; qkt(p0, p1, Ks, qr, C.r32, C.hi);
        if (__any(nm)) {
#pragma unroll
            for (int r = 0; r < 16; ++r) { const int kv = crow(r, C.hi); if (kv < klo || kv > khi) p0[r] = -INFINITY; if (kv + 32 < klo || kv + 32 > khi) p1[r] = -INFINITY; }
        }
        if constexpr (MODE == 2) {
#pragma unroll
            for (int r = 0; r < 16; ++r) { p0[r] = __builtin_amdgcn_exp2f(p0[r] - m) * invl; p1[r] = __builtin_amdgcn_exp2f(p1[r] - m) * invl; }
            ps_accum(p0, 16 * it + C.hi, ps_row, ps_writer); ps_accum(p1, 16 * it + 8 + C.hi, ps_row, ps_writer);
        } else {
            const float rm = rowmax(p0, p1, C.hi), mn = __builtin_fmaxf(m, rm), alpha = __builtin_amdgcn_exp2f(m - mn);
            float s = 0.f;
#pragma unroll
            for (int r = 0; r < 16; ++r) { p0[r] = __builtin_amdgcn_exp2f(p0[r] - mn); p1[r] = __builtin_amdgcn_exp2f(p1[r] - mn); s += p0[r] + p1[r]; }
            l = l * alpha + s;
            if constexpr (MODE == 1) {
                if (__any(mn > m)) {
                    if (C.hi == 0) C.wsf[C.r32] = alpha;
                    LWAIT();
#pragma unroll
                    for (int r = 0; r < 16; ++r) { const float f = C.wsf[crow(r, C.hi)]; o[0][r] *= f; o[1][r] *= f; }
                    LWAIT();
                }
            }
            m = mn;
        }
        if constexpr (MODE != 0) {
            u32x4 w0 = {cvtpk(p0[0], p0[1]), cvtpk(p0[2], p0[3]), cvtpk(p0[4], p0[5]), cvtpk(p0[6], p0[7])}, w1 = {cvtpk(p0[8], p0[9]), cvtpk(p0[10], p0[11]), cvtpk(p0[12], p0[13]), cvtpk(p0[14], p0[15])};
            u32x4 w2 = {cvtpk(p1[0], p1[1]), cvtpk(p1[2], p1[3]), cvtpk(p1[4], p1[5]), cvtpk(p1[6], p1[7])}, w3 = {cvtpk(p1[8], p1[9]), cvtpk(p1[10], p1[11]), cvtpk(p1[12], p1[13]), cvtpk(p1[14], p1[15])};
            pv(o, (int)(unsigned)(uintptr_t)Vs + C.vbl, __builtin_bit_cast(bf16x8, w0), __builtin_bit_cast(bf16x8, w1), __builtin_bit_cast(bf16x8, w2), __builtin_bit_cast(bf16x8, w3));
        }
    }
}
template <bool FIRST> __device__ __forceinline__ void merge_branch(const Ctx& C, const f32x16* o, float factor) {
    if (C.hi == 0) C.wsf[C.r32] = factor;
    LWAIT();
#pragma unroll
    for (int r = 0; r < 16; ++r) { const float f = C.wsf[crow(r, C.hi)];
        if (FIRST) { C.otl[r * 64] = o[0][r] * f; C.otl[(16 + r) * 64] = o[1][r] * f; }
        else { C.otl[r * 64] += o[0][r] * f; C.otl[(16 + r) * 64] += o[1][r] * f; } }
    LWAIT();
}
struct Bufs { const bf16_t *Qn, *KV, *Mo, *KC, *KM, *Gn; bf16_t* Abr; };
constexpr size_t KV_STRIDE = (size_t)MTOK * 128, MO_STRIDE = (size_t)MTOK * 256;

__device__ __forceinline__ void nsa_item(const Ctx& C, const Bufs& B, int b, int g, int i) {
    const int r32 = C.r32, hi = C.hi, wid = C.wid;
    const int qi = 8 * wid + (r32 >> 2), hh = r32 & 3, head = g * 4 + hh, t = 64 * i + qi, cur = i;
    const size_t bg = (size_t)(b * 2 + g) * SEQ;
    bf16x8 qr[4];
    { const bf16_t* qp = B.Qn + ((size_t)(b * 8 + head) * SEQ + t) * 64 + hi * 8;
#pragma unroll
      for (int d0 = 0; d0 < 4; ++d0) qr[d0] = *(const bf16x8*)(qp + d0 * 16); }
    const unsigned gw = *(const unsigned*)(B.Gn + ((size_t)b * SEQ + t) * 32 + head * 3 - (head & 1));
    const unsigned gw2 = *(const unsigned*)(B.Gn + ((size_t)b * SEQ + t) * 32 + head * 3 - (head & 1) + 2);
    float g0, g1, g2; if (head & 1) { g0 = bfhi(gw); g1 = bflo(gw2); g2 = bfhi(gw2); } else { g0 = bflo(gw); g1 = bfhi(gw); g2 = bflo(gw2); }
    f32x16 o[2];
    LAS float* Ps = (LAS float*)(C.lds + L_PS); LAS unsigned* Mk = (LAS unsigned*)(C.lds + L_MSK); LAS unsigned* Uni = (LAS unsigned*)(C.lds + L_UNI); LAS int* List = (LAS int*)(C.lds + L_LIST);
    const int nv = t >= 31 ? ((t - 31) >> 4) + 1 : 0;
    const int nvt = (4 * i + 3 < 511) ? 4 * i + 3 : 511, ntc = (nvt + 63) >> 6;
    const bf16_t* kc = B.KC + (size_t)(0 * 4 + b * 2 + g) * 512 * 64; const bf16_t* vc = B.KC + (size_t)(1 * 4 + b * 2 + g) * 512 * 64;
    auto srcC = [&](int it, const bf16_t*& kp, const bf16_t*& vp) { kp = kc + (size_t)it * 4096; vp = vc + (size_t)it * 4096; };
    auto mskC = [&](int it, int& klo, int& khi) { klo = 0; khi = nv - 1 - 64 * it; return true; };
    float m = -1e30f, l = 0.f;
    run_branch<0>(C, ntc, srcC, mskC, qr, m, l, o, 0.f, nullptr, false);
    l += swap_other(l, hi);
    const float invl = l > 0.f ? 1.0f / l : 0.f;
    for (int e = C.tid; e < 64 * 128; e += 512) Ps[e] = 0.f;
    if (C.tid < 8) Uni[C.tid] = 0u;
    o[0] = f32x16{}; o[1] = f32x16{};
    run_branch<2>(C, ntc, srcC, mskC, qr, m, l, o, invl, Ps + qi * 128, hh == 0);
    merge_branch<true>(C, o, g0);
    LBAR();
    {
        const int nf = cur == 0 ? 1 : (cur == 1 ? 2 : 3), kp_ = 16 - nf, lane = C.lane;
        for (int qq = 0; qq < 8; ++qq) {
            const int q = 8 * wid + qq; LAS float* ps = Ps + q * 128;
            const int j0 = lane, j1 = lane + 64;
            const bool f0 = (j0 == 0 || j0 == cur || j0 == cur - 1) && j0 <= cur, f1 = (j1 == cur || j1 == cur - 1) && j1 <= cur;
            const bool va0 = j0 <= cur && !f0, va1 = j1 <= cur && !f1;
            const float v0 = va0 ? ps[j0] : -1.f, v1 = va1 ? ps[j1] : -1.f;
            int r0 = 0, r1 = 0;
            for (int e = 1; e <= cur; ++e) {
                float ve = ps[e]; if (e == cur || e == cur - 1) ve = -2.f;
                r0 += (ve > v0 || (ve == v0 && e < j0)) ? 1 : 0; r1 += (ve > v1 || (ve == v1 && e < j1)) ? 1 : 0;
            }
            const bool s0 = f0 || (va0 && r0 < kp_), s1 = f1 || (va1 && r1 < kp_);
            const unsigned long long b0 = __ballot(s0), b1 = __ballot(s1);
            if (lane == 0) { Mk[q * 4 + 0] = (unsigned)b0; Mk[q * 4 + 1] = (unsigned)(b0 >> 32); Mk[q * 4 + 2] = (unsigned)b1; Mk[q * 4 + 3] = (unsigned)(b1 >> 32);
                __hip_atomic_fetch_or(&Uni[0], (unsigned)b0, __ATOMIC_RELAXED, __HIP_MEMORY_SCOPE_WORKGROUP); __hip_atomic_fetch_or(&Uni[1], (unsigned)(b0 >> 32), __ATOMIC_RELAXED, __HIP_MEMORY_SCOPE_WORKGROUP); __hip_atomic_fetch_or(&Uni[2], (unsigned)b1, __ATOMIC_RELAXED, __HIP_MEMORY_SCOPE_WORKGROUP); __hip_atomic_fetch_or(&Uni[3], (unsigned)(b1 >> 32), __ATOMIC_RELAXED, __HIP_MEMORY_SCOPE_WORKGROUP); }
        }
    }
    LBAR();
    if (C.tid == 0) { int n = 0; for (int w = 0; w < 4; ++w) { unsigned u = Uni[w]; while (u) { const int bpos = __builtin_ctz(u); u &= u - 1; List[n++] = w * 32 + bpos; } } Uni[4] = (unsigned)n; }
    LBAR();
    {
        const int nsel = (int)Uni[4];
        const bf16_t* ks = B.KV + 2 * KV_STRIDE + bg * 64; const bf16_t* vs = B.KV + 3 * KV_STRIDE + bg * 64;
        auto srcS = [&](int it, const bf16_t*& kp, const bf16_t*& vp) { const int j = List[it]; kp = ks + (size_t)j * 4096; vp = vs + (size_t)j * 4096; };
        auto mskS = [&](int it, int& klo, int& khi) { const int j = List[it]; const unsigned w = Mk[qi * 4 + (j >> 5)]; const bool bit = (w >> (j & 31)) & 1u;
            klo = 0; khi = bit ? (j == cur ? qi : 63) : -1; return (!bit) || j == cur; };
        m = -1e30f; l = 0.f; o[0] = f32x16{}; o[1] = f32x16{};
        run_branch<1>(C, nsel, srcS, mskS, qr, m, l, o, 0.f, nullptr, false);
        l += swap_other(l, hi);
        merge_branch<false>(C, o, l > 0.f ? g1 / l : 0.f);
    }
    {
        const int tw0 = i >= 8 ? i - 8 : 0, ntw = i - tw0 + 1;
        const bf16_t* kw = B.KV + 4 * KV_STRIDE + bg * 64; const bf16_t* vw = B.KV + 5 * KV_STRIDE + bg * 64;
        auto srcW = [&](int it, const bf16_t*& kp, const bf16_t*& vp) { kp = kw + (size_t)(tw0 + it) * 4096; vp = vw + (size_t)(tw0 + it) * 4096; };
        auto mskW = [&](int it, int& klo, int& khi) { const int tw = tw0 + it; klo = (t - 511) - 64 * tw; khi = (tw == i) ? qi : 63; return tw == i || klo > 0; };
        m = -1e30f; l = 0.f; o[0] = f32x16{}; o[1] = f32x16{};
        run_branch<1>(C, ntw, srcW, mskW, qr, m, l, o, 0.f, nullptr, false);
        l += swap_other(l, hi);
        merge_branch<false>(C, o, l > 0.f ? g2 / l : 0.f);
    }
#pragma unroll
    for (int r = 0; r < 16; ++r) { const int qrow = crow(r, hi); bf16_t* dst = B.Abr + ((size_t)b * SEQ + 64 * i + 8 * wid + (qrow >> 2)) * DM + 256 + (g * 4 + (qrow & 3)) * 64 + r32;
        dst[0] = (bf16_t)(cvtpk(ABL_NSA_SCALE C.otl[r * 64], 0.f) & 0xffffu); dst[32] = (bf16_t)(cvtpk(ABL_NSA_SCALE C.otl[(16 + r) * 64], 0.f) & 0xffffu); }
}
__device__ __forceinline__ void moba_item(const Ctx& C, const Bufs& B, int b, int h, int qb) {
    const int r32 = C.r32, hi = C.hi, wid = C.wid, own = qb, t = 256 * qb + 32 * wid + r32;
    const size_t bh = (size_t)(b * 4 + h) * SEQ;
    bf16x8 qr[4];
    { const bf16_t* qp = B.Mo + (bh + t) * 64 + hi * 8;
#pragma unroll
      for (int d0 = 0; d0 < 4; ++d0) qr[d0] = *(const bf16x8*)(qp + d0 * 16); }
    LAS unsigned* Uni = (LAS unsigned*)(C.lds + L_UNI); LAS int* List = (LAS int*)(C.lds + L_LIST);
    LBAR();
    if (C.tid < 256) { const u32x4 kmv = *(const u32x4*)(B.KM + (size_t)(b * 4 + h) * 2048 + C.tid * 8); *(LAS u32x4*)(C.lds + L_K0 + (C.tid & 7) * KCS + (C.tid >> 3) * 16) = kmv; }
    if (C.tid == 0) Uni[0] = 0u;
    LBAR();
    unsigned sel = 0u;
    {
        f32x16 gs = f32x16{};
        const LAS char* kb = C.lds + L_K0 + hi * KCS + r32 * 16;
#pragma unroll
        for (int d0 = 0; d0 < 4; ++d0) gs = __builtin_amdgcn_mfma_f32_32x32x16_bf16(*(const LAS bf16x8*)(kb + d0 * 2 * KCS), qr[d0], gs, 0, 0, 0);
        float lo[16], hv[16];
#pragma unroll
        for (int r = 0; r < 16; ++r) { const float ownv = gs[r], oth = swap_other(ownv, hi); lo[r] = hi ? oth : ownv; hv[r] = hi ? ownv : oth; }
        unsigned taken = ~((1u << own) - 1u);
#pragma unroll
        for (int round = 0; round < 3; ++round) {
            float best = -INFINITY; int bi = 32;
#pragma unroll
            for (int n = 0; n < 32; ++n) { const int rr = (n & 3) + 4 * (n >> 3); const float v = ((n >> 2) & 1) ? hv[rr] : lo[rr]; if (!((taken >> n) & 1u) && v > best) { best = v; bi = n; } }
            if (bi < 32) { sel |= 1u << bi; taken |= 1u << bi; }
        }
    }
    { unsigned u = sel;
#pragma unroll
      for (int o_ = 1; o_ < 64; o_ <<= 1) u |= (unsigned)__shfl_xor((int)u, o_);
      if (C.lane == 0) __hip_atomic_fetch_or(&Uni[0], u, __ATOMIC_RELAXED, __HIP_MEMORY_SCOPE_WORKGROUP); }
    LBAR();
    if (C.tid == 0) { int n = 0; unsigned u = Uni[0]; while (u) { const int bpos = __builtin_ctz(u); u &= u - 1; List[n++] = bpos; } Uni[4] = (unsigned)n; }
    LBAR();
    const int nl = (int)Uni[4], nt = 4 * nl + 4;
    const bf16_t* kk = B.Mo + MO_STRIDE + bh * 64; const bf16_t* vv = B.Mo + 2 * MO_STRIDE + bh * 64;
    auto src = [&](int it, const bf16_t*& kp, const bf16_t*& vp) { const int T = (it < 4 * nl) ? 4 * List[it >> 2] + (it & 3) : 4 * own + (it - 4 * nl); kp = kk + (size_t)T * 4096; vp = vv + (size_t)T * 4096; };
    auto msk = [&](int it, int& klo, int& khi) { klo = 0; if (it < 4 * nl) { const bool bit = (sel >> List[it >> 2]) & 1u; khi = bit ? 63 : -1; return !bit; } khi = 32 * wid + r32 - 64 * (it - 4 * nl); return true; };
    float m = -1e30f, l = 0.f; f32x16 o[2] = {f32x16{}, f32x16{}};
    run_branch<1>(C, nt, src, msk, qr, m, l, o, 0.f, nullptr, false);
    l += swap_other(l, hi);
    merge_branch<true>(C, o, l > 0.f ? 1.0f / l : 0.f);
#pragma unroll
    for (int r = 0; r < 16; ++r) { const int qrow = crow(r, hi); bf16_t* dst = B.Abr + ((size_t)b * SEQ + 256 * qb + 32 * wid + qrow) * DM + 768 + h * 64 + r32;
        dst[0] = (bf16_t)(cvtpk(ABL_MOBA_SCALE C.otl[r * 64], 0.f) & 0xffffu); dst[32] = (bf16_t)(cvtpk(ABL_MOBA_SCALE C.otl[(16 + r) * 64], 0.f) & 0xffffu); }
}
}
constexpr size_t MiB = 1u << 20;
constexpr size_t WS_CTL = 0, WS_ORDER = 4096;
constexpr size_t WS_W = 1 * MiB, OFF_WIN = 0, OFF_WGU = 11 * MiB, OFF_WD = 22 * MiB, OFF_WBR = 28 * MiB, OFF_WOUT = 30 * MiB, OFF_W1 = 32 * MiB, OFF_W2 = 34 * MiB,
                 OFF_BIN = 34 * MiB + 65536, OFF_CB1 = OFF_BIN + 32768, OFF_CB2 = OFF_CB1 + 4096;
constexpr size_t WS_TAB = 36 * MiB, WS_SSP = 38 * MiB, WS_KC = 39 * MiB, WS_KM = 39 * MiB + 512 * 1024, WS_GN = 40 * MiB, WS_XB = 42 * MiB, WS_BIG = 74 * MiB,
                 WS_U = 170 * MiB, WS_QN = 178 * MiB, WS_KV = 194 * MiB, WS_MO = 218 * MiB, WS_MRG = 178 * MiB, WS_END = 242 * MiB;
constexpr int LDS_BYTES = 147456;

__device__ __forceinline__ int dint(int pos) { return (pos >> 1) + 32 * (pos & 1); }
__device__ __forceinline__ int in_orig(int c) {
    if (c < 256) return c;
    if (c < 768) { const int c2 = c - 256; return 256 + (c2 >> 6) * 64 + dint(c2 & 63); }
    if (c < 1536) { const int c2 = c - 768, tt = c2 >> 8, bj = (c2 >> 7) & 1, g = (c2 >> 6) & 1, pos = c2 & 63; return 768 + (2 * tt + bj) * 128 + g * 64 + (bj == 0 ? dint(pos) : pos); }
    if (c < 2304) { const int c2 = c - 1536, part = c2 >> 8, h = (c2 >> 6) & 3, pos = c2 & 63; return 1560 + part * 256 + h * 64 + (part < 2 ? dint(pos) : pos); }
    if (c < 5376) return 2328 + (c - 2304);
    const int c2 = c - 5376; return c2 < 24 ? 1536 + c2 : -1;
}
template <class F> __device__ __forceinline__ void cvt_tile(LAS float* scr, int lane, int k0, int n0, bf16_t* dst, size_t pitch, F f) {
#pragma unroll 4
    for (int i = 0; i < 32; ++i) { const int kk = 2 * i + (lane >> 5); scr[kk * 33 + (lane & 31)] = f(k0 + kk, n0 + (lane & 31)); }
    asm volatile("s_waitcnt lgkmcnt(0)" ::: "memory");
    const int c = lane & 7;
#pragma unroll
    for (int j = 0; j < 4; ++j) { const int n = (lane >> 3) + 8 * j; const LAS float* s = scr + (8 * c) * 33 + n;
        u32x4 o; o.x = cvtpk(s[0 * 33], s[1 * 33]); o.y = cvtpk(s[2 * 33], s[3 * 33]); o.z = cvtpk(s[4 * 33], s[5 * 33]); o.w = cvtpk(s[6 * 33], s[7 * 33]);
        *(u32x4*)(dst + (size_t)(n0 + n) * pitch + k0 + 8 * c) = o; }
    asm volatile("s_waitcnt lgkmcnt(0)" ::: "memory");
}
struct Args { const float* in[20]; float* out; unsigned char* ws; };
typedef const __attribute__((address_space(4))) Args* ArgsP;

__device__ __forceinline__ void phase0(ArgsP a, int l, LAS unsigned char* lds, int tid, int lane, int wave, int gw, int NGW) {
    unsigned char* ws = a->ws;
    LAS float* scr = (LAS float*)(lds + wave * 8704);
    const float* attn_norm = a->in[1] + (size_t)l * DM; const float* w_in = a->in[2] + (size_t)l * DM * IN_COLS; const float* b_in = a->in[3] + (size_t)l * IN_COLS;
    const float* pool_w = a->in[4] + (size_t)l * 4 * 64 * 64; const float* pool_scale = a->in[5] + (size_t)l * 256; const float* cmp_pos = a->in[6] + (size_t)l * 2 * 32 * 64;
    const float* cmp_w1 = a->in[7] + (size_t)l * 2 * 2048 * 256; const float* cmp_b1 = a->in[8] + (size_t)l * 2 * 256; const float* cmp_w2 = a->in[9] + (size_t)l * 2 * 256 * 64; const float* cmp_b2 = a->in[10] + (size_t)l * 2 * 64;
    const float* w_br_pool = a->in[11] + (size_t)l * 256 * DM; const float* w_br_nsa = a->in[12] + (size_t)l * 512 * DM; const float* w_br_moba = a->in[13] + (size_t)l * 256 * DM;
    const float* w_out = a->in[14] + (size_t)l * DM * DM; const float* ffn_norm = a->in[15] + (size_t)l * DM; const float* w_gate = a->in[16] + (size_t)l * DM * DFF; const float* w_up = a->in[17] + (size_t)l * DM * DFF;
    const float* w_down = a->in[18] + (size_t)l * DFF * DM;
    bf16_t* Win = (bf16_t*)(ws + WS_W + OFF_WIN); bf16_t* Wgu = (bf16_t*)(ws + WS_W + OFF_WGU); bf16_t* Wd = (bf16_t*)(ws + WS_W + OFF_WD); bf16_t* Wbr = (bf16_t*)(ws + WS_W + OFF_WBR);
    bf16_t* Wout = (bf16_t*)(ws + WS_W + OFF_WOUT); bf16_t* W1t = (bf16_t*)(ws + WS_W + OFF_W1); bf16_t* W2t = (bf16_t*)(ws + WS_W + OFF_W2);
    float* bin = (float*)(ws + WS_W + OFF_BIN); float* cb1 = (float*)(ws + WS_W + OFF_CB1); float* cb2 = (float*)(ws + WS_W + OFF_CB2);
    constexpr int I_A = 16 * 176, I_B = 16 * 176, I_C = 44 * 32, I_D = 16 * 32, I_E = 16 * 32, I_F = 2 * 32 * 8, I_G = 2 * 4 * 2;
    constexpr int NITEMS = I_A + I_B + I_C + I_D + I_E + I_F + I_G;
    for (int it = gw; it < NITEMS; it += NGW) {
        int r = it;
        if (r < I_A) { const int kb = r / 176, nb = r % 176; cvt_tile(scr, lane, 64 * kb, 32 * nb, Win, DM, [&](int k, int n) { const int o = in_orig(n); return o >= 0 ? w_in[(size_t)k * IN_COLS + o] * attn_norm[k] : 0.f; }); continue; } r -= I_A;
        if (r < I_B) { const int kb = r / 176, nb = r % 176; cvt_tile(scr, lane, 64 * kb, 32 * nb, Wgu, DM, [&](int k, int n) { const int j = (n >> 8) * 128 + (n & 127); const float* s = ((n >> 7) & 1) ? w_up : w_gate; return s[(size_t)k * DFF + j] * ffn_norm[k]; }); continue; } r -= I_B;
        if (r < I_C) { const int kb = r / 32, nb = r % 32; cvt_tile(scr, lane, 64 * kb, 32 * nb, Wd, DFF, [&](int k, int n) { return w_down[(size_t)k * DM + n]; }); continue; } r -= I_C;
        if (r < I_D) { const int kb = r / 32, nb = r % 32; cvt_tile(scr, lane, 64 * kb, 32 * nb, Wout, DM, [&](int k, int n) { return w_out[(size_t)k * DM + n]; }); continue; } r -= I_D;
        if (r < I_E) { const int kb = r / 32, nb = r % 32;
            if (kb < 4) cvt_tile(scr, lane, 64 * kb, 32 * nb, Wbr, DM, [&](int k, int n) { const int g = k >> 6, c = k & 63; float s = 0.f;
#pragma unroll 8
                for (int j = 0; j < 64; ++j) s += pool_w[(g * 64 + c) * 64 + j] * pool_scale[g * 64 + j] * w_br_pool[(size_t)(g * 64 + j) * DM + n];
                return s; });
            else if (kb < 12) cvt_tile(scr, lane, 64 * kb, 32 * nb, Wbr, DM, [&](int k, int n) { return w_br_nsa[(size_t)(k - 256) * DM + n]; });
            else cvt_tile(scr, lane, 64 * kb, 32 * nb, Wbr, DM, [&](int k, int n) { return w_br_moba[(size_t)(k - 768) * DM + n]; });
            continue; } r -= I_E;
        if (r < I_F) { const int kv = r >> 8, kb = (r >> 3) & 31, nb = r & 7; const float* w1 = cmp_w1 + (size_t)kv * 2048 * 256;
            cvt_tile(scr, lane, 64 * kb, 32 * nb, W1t + (size_t)kv * 256 * 2048, 2048, [&](int k, int n) { const int pos = k & 63, d = kv == 0 ? dint(pos) : pos; return w1[(size_t)((k & ~63) + d) * 256 + n]; }); continue; } r -= I_F;
        { const int kv = r >> 3, kb = (r >> 1) & 3, nb = r & 1; const float* w2 = cmp_w2 + (size_t)kv * 256 * 64;
            cvt_tile(scr, lane, 64 * kb, 32 * nb, W2t + (size_t)kv * 64 * 256, 256, [&](int k, int n) { return w2[(size_t)k * 64 + (kv == 0 ? dint(n) : n)]; }); }
    }
    const int gt = gw * 64 + lane, NGT = NGW * 64;
    for (int c = gt; c < NIN; c += NGT) { const int o = in_orig(c); bin[c] = o >= 0 ? b_in[o] : 0.f; }
    for (int e = gt; e < 512; e += NGT) { const int kv = e >> 8, n = e & 255; const float* w1 = cmp_w1 + (size_t)kv * 2048 * 256; const float* pe = cmp_pos + (size_t)kv * 2048; float s = cmp_b1[kv * 256 + n];
        for (int k = 0; k < 2048; ++k) s += pe[k] * w1[(size_t)k * 256 + n];
        cb1[e] = s; }
    for (int e = gt; e < 128; e += NGT) { const int kv = e >> 6, n = e & 63; cb2[e] = cmp_b2[kv * 64 + (kv == 0 ? dint(n) : n)]; }
    if (l == 0) {
        float* tab = (float*)(ws + WS_TAB);
        for (int e = gt; e < SEQ * 32; e += NGT) { const int t = e >> 5, f = e & 31; const float inv = powf(10000.0f, -(float)(2 * f) / 64.0f); const float ang = (float)t * inv;
            const double ad = (double)ang, kq = rint(ad * 0.15915494309189535); double rr = fma(-kq, 6.283185307179586, ad); rr = fma(-kq, 2.4492935982947064e-16, rr);
            const float rf = (float)rr; tab[2 * e] = __cosf(rf); tab[2 * e + 1] = __sinf(rf); }
        const float* x = a->in[0]; bf16_t* xb = (bf16_t*)(ws + WS_XB); float* ssp = (float*)(ws + WS_SSP);
        for (int m = gw; m < MTOK; m += NGW) { const f32x4* xr = (const f32x4*)(x + (size_t)m * DM) + lane; f32x4 v[4]; float s = 0.f;
#pragma unroll
            for (int j = 0; j < 4; ++j) { v[j] = xr[64 * j]; s += (v[j][0] * v[j][0] + v[j][1] * v[j][1]) + (v[j][2] * v[j][2] + v[j][3] * v[j][3]); }
#pragma unroll
            for (int o = 1; o < 64; o <<= 1) s += __shfl_xor(s, o);
            u32x2* o8 = (u32x2*)(xb + (size_t)m * DM) + lane;
#pragma unroll
            for (int j = 0; j < 4; ++j) o8[64 * j] = (u32x2){cvtpk(v[j][0], v[j][1]), cvtpk(v[j][2], v[j][3])};
            if (lane < 16) ssp[(size_t)m * 16 + lane] = lane == 0 ? s : 0.f; }
        int* order = (int*)(ws + WS_ORDER);
        if (gt < 768) { auto cost = [](int id) { return id < 512 ? 9 * (id & 127) + 80 : 32 * ((id - 512) & 31) + 32; }; const int mc = cost(gt); int rk = 0;
            for (int j = 0; j < 768; ++j) { const int cj = cost(j); rk += (cj > mc || (cj == mc && j < gt)) ? 1 : 0; }
            order[rk] = gt; }
    }
}
__device__ __forceinline__ float gelu_tanh(float x) { const float u = 0.7978845608028654f * (x + 0.044715f * x * x * x); const float th = 1.f - 2.f * __builtin_amdgcn_rcpf(1.f + __expf(2.f * u)); return 0.5f * x * (1.f + th); }
__device__ __forceinline__ void phase2(ArgsP a, LAS unsigned char* lds, int tid, int lane, int wave, int G) {
    unsigned char* ws = a->ws;
    const bf16_t* KV = (const bf16_t*)(ws + WS_KV); const bf16_t* W1t = (const bf16_t*)(ws + WS_W + OFF_W1); const bf16_t* W2t = (const bf16_t*)(ws + WS_W + OFF_W2);
    const float* cb1 = (const float*)(ws + WS_W + OFF_CB1); const float* cb2 = (const float*)(ws + WS_W + OFF_CB2);
    bf16_t* KC = (bf16_t*)(ws + WS_KC);
    LAS bf16_t* hid = (LAS bf16_t*)lds;
    const int arow = lane & 15, kq = lane >> 4;
    for (int task = blockIdx.x; task < 256; task += G) {
        const int kv = task >> 7, bgi = (task >> 5) & 3, nt = task & 31;
        const bf16_t* src = KV + (size_t)kv * att::KV_STRIDE + (size_t)bgi * SEQ * 64;
        const int nrow = 16 * nt + arow, neff = nrow < 510 ? nrow : 510;
        const bf16_t* ap = src + (size_t)neff * 1024 + kq * 8;
        const bf16_t* bp0 = W1t + (size_t)kv * 256 * 2048 + (size_t)(32 * wave + arow) * 2048 + kq * 8; const bf16_t* bp1 = bp0 + 16 * 2048;
        f32x4 c0 = {0.f, 0.f, 0.f, 0.f}, c1 = {0.f, 0.f, 0.f, 0.f};
#pragma unroll 4
        for (int ks = 0; ks < 64; ++ks) { const bf16x8 av = *(const bf16x8*)(ap + ks * 32), b0 = *(const bf16x8*)(bp0 + ks * 32), b1 = *(const bf16x8*)(bp1 + ks * 32);
            c0 = __builtin_amdgcn_mfma_f32_16x16x32_bf16(av, b0, c0, 0, 0, 0); c1 = __builtin_amdgcn_mfma_f32_16x16x32_bf16(av, b1, c1, 0, 0, 0); }
        { const int col0 = 32 * wave + arow; const float bb0 = cb1[kv * 256 + col0], bb1 = cb1[kv * 256 + col0 + 16];
#pragma unroll
          for (int j = 0; j < 4; ++j) { const int row = kq * 4 + j; hid[row * 264 + col0] = (bf16_t)(cvtpk(gelu_tanh(c0[j] + bb0), 0.f) & 0xffffu); hid[row * 264 + col0 + 16] = (bf16_t)(cvtpk(gelu_tanh(c1[j] + bb1), 0.f) & 0xffffu); } }
        LBAR();
        if (wave < 4) {
            const bf16_t* bp = W2t + (size_t)kv * 64 * 256 + (size_t)(16 * wave + arow) * 256 + kq * 8; f32x4 c = {0.f, 0.f, 0.f, 0.f};
#pragma unroll
            for (int ks = 0; ks < 8; ++ks) { const bf16x8 av = *(const LAS bf16x8*)(hid + arow * 264 + kq * 8 + ks * 32), bv = *(const bf16x8*)(bp + ks * 32); c = __builtin_amdgcn_mfma_f32_16x16x32_bf16(av, bv, c, 0, 0, 0); }
            const int col = 16 * wave + arow; const float bb = cb2[kv * 64 + col];
#pragma unroll
            for (int j = 0; j < 4; ++j) { const int n = 16 * nt + kq * 4 + j; KC[((size_t)(kv * 4 + bgi) * 512 + n) * 64 + col] = n < 511 ? (bf16_t)(cvtpk(c[j] + bb, 0.f) & 0xffffu) : (bf16_t)0; }
        }
        LBAR();
    }
    const int gt = blockIdx.x * 512 + tid, NGT = G * 512;
    { const bf16_t* MoK = (const bf16_t*)(ws + WS_MO) + att::MO_STRIDE; bf16_t* KM = (bf16_t*)(ws + WS_KM);
      for (int e = gt; e < 8 * 32 * 64; e += NGT) { const int d = e & 63, blk = e >> 6; const bf16_t* p = MoK + (size_t)blk * 256 * 64 + d; float s = 0.f;
#pragma unroll 8
          for (int r = 0; r < 256; ++r) s += __uint_as_float((unsigned)p[(size_t)r * 64] << 16);
          KM[e] = (bf16_t)(cvtpk(s * (1.0f / 256.0f), 0.f) & 0xffffu); } }
    { const bf16_t* U = (const bf16_t*)(ws + WS_U); bf16_t* Abr = (bf16_t*)(ws + WS_XB);
      for (int e = gt; e < MTOK * 32; e += NGT) { const int row = e >> 5, c8 = e & 31, s = row & (SEQ - 1), w = 2 << (c8 >> 3), cnt = (s + 1 < w) ? s + 1 : w;
          float acc[8] = {0.f, 0.f, 0.f, 0.f, 0.f, 0.f, 0.f, 0.f}; u32x4 v0 = {0u, 0u, 0u, 0u};
          for (int i = 0; i < cnt; ++i) { const u32x4 v = *(const u32x4*)(U + (size_t)(row - i) * 256 + c8 * 8); if (i == 0) v0 = v;
#pragma unroll
              for (int q = 0; q < 4; ++q) { acc[2 * q] += bflo(v[q]); acc[2 * q + 1] += bfhi(v[q]); } }
          const float ic = 1.0f / (float)cnt; u32x4 o;
#pragma unroll
          for (int q = 0; q < 4; ++q) o[q] = cvtpk(acc[2 * q] * ic - bflo(v0[q]), acc[2 * q + 1] * ic - bfhi(v0[q]));
          *(u32x4*)(Abr + (size_t)row * DM + c8 * 8) = o; } }
}
__global__ void __launch_bounds__(512, 2) fwd_megakernel(Args a) {
    extern __shared__ __attribute__((aligned(16))) unsigned char lds_raw[];
    LAS unsigned char* lds = (LAS unsigned char*)lds_raw;
    cg::grid_group grid = cg::this_grid();
    const int G = gridDim.x;
    const ArgsP ap0 = (ArgsP)__builtin_amdgcn_kernarg_segment_ptr();
#define PHASE_ARGS ArgsP a_ = ap0; asm volatile("" : "+s"(a_)); unsigned char* ws = a_->ws; unsigned* ctl = (unsigned*)(ws + WS_CTL); float* ssp = (float*)(ws + WS_SSP); const float* tab = (const float*)(ws + WS_TAB); \
    bf16_t* XB = (bf16_t*)(ws + WS_XB); bf16_t* BIG = (bf16_t*)(ws + WS_BIG); bf16_t* MRG = (bf16_t*)(ws + WS_MRG); (void)ctl; (void)ssp; (void)tab; (void)XB; (void)BIG; (void)MRG;
    for (int l = 0; l < DEPTH; ++l) {
        int tid_ = threadIdx.x; asm volatile("" : "+v"(tid_));
        const int tid = tid_, lane = tid & 63, wave = __builtin_amdgcn_readfirstlane(tid >> 6), gw = blockIdx.x * 8 + wave, NGW = G * 8;
        { PHASE_ARGS phase0(a_, l, lds, tid, lane, wave, gw, NGW); }
        grid.sync();
        { PHASE_ARGS pg8::Gemm g{XB, (const bf16_t*)(ws + WS_W + OFF_WIN), MTOK, NIN, DM}; pg8::StaticOrder S; S.init(MTOK, NIN, G, (int)blockIdx.x);
          EpiInProj E{ssp, (const float*)(ws + WS_W + OFF_BIN), tab, (bf16_t*)(ws + WS_U), (bf16_t*)(ws + WS_QN), (bf16_t*)(ws + WS_KV), (bf16_t*)(ws + WS_MO), BIG, (bf16_t*)(ws + WS_GN)};
          pg8::gemm_phase(lds, g, S, E); }
        grid.sync();
        { PHASE_ARGS phase2(a_, lds, tid, lane, wave, G); }
        grid.sync();
        { PHASE_ARGS att::Ctx C; C.lds = (LAS char*)lds; C.wsf = (LAS float*)(lds + att::L_WSF) + wave * 64; C.otl = (LAS float*)(lds + att::L_OT) + wave * 2048 + lane; C.tid = tid; C.wid = wave; C.lane = lane; C.r32 = lane & 31; C.hi = lane >> 5;
          C.vbl = ((lane >> 4) & 1) * 32 + (lane & 3) * 8 + (4 * (lane >> 5) + ((lane & 15) >> 2)) * 64;
          att::Bufs B{(const bf16_t*)(ws + WS_QN), (const bf16_t*)(ws + WS_KV), (const bf16_t*)(ws + WS_MO), (const bf16_t*)(ws + WS_KC), (const bf16_t*)(ws + WS_KM), (const bf16_t*)(ws + WS_GN), XB};
          const int* order = (const int*)(ws + WS_ORDER); LAS int* slot = (LAS int*)(lds + att::L_END);
          for (;;) {
              LBAR();
              if (tid == 0) slot[0] = (int)atomicAdd(ctl + l, 1u);
              LBAR();
              const int item = slot[0];
              if (item >= 768) break;
              const int id = order[item];
              if (id < 512) att::nsa_item(C, B, id >> 8, (id >> 7) & 1, id & 127);
              else { const int x = id - 512; att::moba_item(C, B, x >> 7, (x >> 5) & 3, x & 31); }
          } }
        grid.sync();
        { PHASE_ARGS pg8::Gemm g{XB, (const bf16_t*)(ws + WS_W + OFF_WBR), MTOK, DM, DM}; pg8::StaticOrder S; S.init(MTOK, DM, G, (int)blockIdx.x);
          EpiBranch E{BIG, MRG}; pg8::gemm_phase(lds, g, S, E); }
        grid.sync();
        { PHASE_ARGS pg8::Gemm g{MRG, (const bf16_t*)(ws + WS_W + OFF_WOUT), MTOK, DM, DM}; pg8::StaticOrder S; S.init(MTOK, DM, G, (int)blockIdx.x);
          float* outp = a_->out; EpiResid E{l == 0 ? a_->in[0] : outp, outp, XB, ssp}; pg8::gemm_phase(lds, g, S, E); }
        grid.sync();
        { PHASE_ARGS pg8::Gemm g{XB, (const bf16_t*)(ws + WS_W + OFF_WGU), MTOK, NGU, DM}; pg8::StaticOrder S; S.init(MTOK, NGU, G, (int)blockIdx.x);
          EpiSwiGLU E{ssp, BIG}; pg8::gemm_phase(lds, g, S, E); }
        grid.sync();
        { PHASE_ARGS pg8::Gemm g{BIG, (const bf16_t*)(ws + WS_W + OFF_WD), MTOK, DM, DFF}; pg8::StaticOrder S; S.init(MTOK, DM, G, (int)blockIdx.x);
          float* outp = a_->out; EpiResid E{outp, outp, XB, ssp}; pg8::gemm_phase(lds, g, S, E); }
        grid.sync();
    }
    { PHASE_ARGS const float* fn = a_->in[19]; float* outp = a_->out; const int lane = threadIdx.x & 63, gw = blockIdx.x * 8 + (threadIdx.x >> 6), NGW = G * 8;
      for (int m = gw; m < MTOK; m += NGW) { const float rstd = row_rstd(ssp, m); f32x4* xr = (f32x4*)(outp + (size_t)m * DM) + lane; const f32x4* gr = (const f32x4*)fn + lane;
#pragma unroll
          for (int j = 0; j < 4; ++j) xr[64 * j] = xr[64 * j] * rstd * gr[64 * j]; } }
}

extern "C" void kernel_launch(void* const* d_in, const int* in_sizes, int n_in, void* d_out, int out_size, void* d_ws, size_t ws_size, hipStream_t stream) {
    static int grid = 0;
    if (grid == 0) {
        if (n_in != 20 || in_sizes[0] != MTOK * DM || out_size != MTOK * DM || ws_size < WS_END) { fprintf(stderr, "kernel_launch: unexpected shapes / workspace (n_in %d, ws %zu)\n", n_in, ws_size); grid = -1; return; }
        int dev = 0, cus = 0, per_cu = 0;
        if (hipGetDevice(&dev) != hipSuccess || hipDeviceGetAttribute(&cus, hipDeviceAttributeMultiprocessorCount, dev) != hipSuccess) { grid = -1; return; }
        if (hipFuncSetAttribute((const void*)fwd_megakernel, hipFuncAttributeMaxDynamicSharedMemorySize, LDS_BYTES) != hipSuccess) { fprintf(stderr, "kernel_launch: hipFuncSetAttribute failed\n"); grid = -1; return; }
        if (hipOccupancyMaxActiveBlocksPerMultiprocessor(&per_cu, (const void*)fwd_megakernel, 512, LDS_BYTES) != hipSuccess || per_cu < 1) { fprintf(stderr, "kernel_launch: occupancy query failed (%d)\n", per_cu); (void)hipGetLastError(); grid = -1; return; }
        grid = cus * per_cu;
    }
    if (grid < 0) return;
    if (hipMemsetAsync((char*)d_ws + WS_CTL, 0, 4096, stream) != hipSuccess) { fprintf(stderr, "kernel_launch: memset failed\n"); return; }
    Args a{};
    for (int i = 0; i < 20; ++i) a.in[i] = (const float*)d_in[i];
    a.out = (float*)d_out; a.ws = (unsigned char*)d_ws;
    void* args[] = {&a};
    const hipError_t e = hipLaunchCooperativeKernel((const void*)fwd_megakernel, dim3(grid), dim3(512), args, LDS_BYTES, stream);
    if (e != hipSuccess) fprintf(stderr, "kernel_launch: cooperative launch failed: %s (grid %d)\n", hipGetErrorString(e), grid);
}
```

```cpp
#include <hip/hip_runtime.h>
#include <hip/hip_cooperative_groups.h>
#include <cstdio>
#include <cstdint>
#include <cmath>
namespace cg = cooperative_groups;

#define LAS __attribute__((address_space(3)))
typedef unsigned short bf16_t;
typedef short bf16x8 __attribute__((ext_vector_type(8)));
typedef short s16x4 __attribute__((ext_vector_type(4)));
typedef float f32x2 __attribute__((ext_vector_type(2)));
typedef float f32x4 __attribute__((ext_vector_type(4)));
typedef float f32x16 __attribute__((ext_vector_type(16)));
typedef unsigned u32x4 __attribute__((ext_vector_type(4)));
typedef unsigned u32x2 __attribute__((ext_vector_type(2)));
typedef __bf16 bf16x2_t __attribute__((ext_vector_type(2)));

constexpr int SEQ = 8192, BATCH = 2, MTOK = BATCH * SEQ, DM = 1024, DEPTH = 2;
constexpr int IN_COLS = 5400, NIN = 5632, DFF = 2816, NGU = 5632;
constexpr float RMS_EPS = 1e-6f;
constexpr float QSCALE = 0.125f * 1.4426950408889634f;

__device__ __forceinline__ unsigned cvtpk(float lo, float hi) { f32x2 v = {lo, hi}; bf16x2_t b = __builtin_convertvector(v, bf16x2_t); return __builtin_bit_cast(unsigned, b); }
__device__ __forceinline__ float bflo(unsigned w) { return __uint_as_float(w << 16); }
__device__ __forceinline__ float bfhi(unsigned w) { return __uint_as_float(w & 0xffff0000u); }
__device__ __forceinline__ float sigmoidf_(float x) { return __builtin_amdgcn_rcpf(1.f + __expf(-x)); }

namespace pg8 {
constexpr int BM = 256, BK = 64, HALF = 128, HTB = HALF * BK * 2, STAGE_BYTES = 8 * HTB, NXCD = 8, WGM = 8;
__host__ __device__ __forceinline__ int lds_byte(int r, int c) { const int st = (r >> 4) * 2 + (c >> 5), rr = r & 15, cc = c & 31, ob = rr * 64 + cc * 2; return st * 1024 + (ob ^ (((ob >> 9) & 1) << 5)); }
__host__ __device__ __forceinline__ void stage_rc(int b, int& R, int& C) { const int st = b / 1024, sb = b % 1024, swz = sb ^ (((sb >> 9) & 1) << 5); R = (st >> 1) * 16 + swz / 64; C = (st & 1) * 32 + (swz % 64) / 2; }
__host__ __device__ __forceinline__ int perm32(int rho) { const int n = rho >> 4, i = rho & 15; return 8 * (i >> 2) + 4 * n + (i & 3); }
struct Unit { int pm, pn; };
struct Gemm { const bf16_t* A; const bf16_t* Bt; int M, N, K; };
struct StaticOrder {
    int nM, nN, nwg, G, c;
    __host__ __device__ void init(int M, int N, int G_, int c_) { nM = M / BM; nN = N / BM; nwg = nM * nN; G = G_; c = c_; }
    __host__ __device__ bool next(int i, Unit& u) const {
        const long L = (long)i * G + c; if (L >= nwg) return false;
        int wgid = (int)L; { const int q = nwg / NXCD, r = nwg % NXCD, xcd = wgid % NXCD, off = wgid / NXCD; wgid = (xcd < r ? xcd * (q + 1) : r * (q + 1) + (xcd - r) * q) + off; }
        const int nig = WGM * nN, gid = wgid / nig, fm = gid * WGM, gsz = (nM - fm) < WGM ? (nM - fm) : WGM;
        u.pm = fm + ((wgid % nig) % gsz); u.pn = (wgid % nig) / gsz; return true;
    }
};
template <class Epi, class Sched>
__device__ __forceinline__ void gemm_phase(LAS unsigned char* lds, const Gemm g, const Sched& S, const Epi& E) {
    int tid_ = threadIdx.x; asm volatile("" : "+v"(tid_));
    const int tid = tid_, wid = __builtin_amdgcn_readfirstlane(tid >> 6), lane = tid & 63, wr = wid >> 2, wc = wid & 3, fr = lane & 15, fq = lane >> 4;
    const int K = g.K, nt = K / BK;
    unsigned voffA[2], voffB[2];
#pragma unroll
    for (int i = 0; i < 2; ++i) { int R, C; stage_rc(tid * 16 + i * 8192, R, C); const int Rb = ((R & ~31) + perm32(R & 31));
        voffA[i] = (unsigned)(R * K + C) * 2u; voffB[i] = (unsigned)(Rb * K + C) * 2u; }
    const size_t kstep = (size_t)(BK * 2);
    const size_t hstep = (size_t)HALF * K * 2;
    const size_t tstep = 2 * hstep;
    const unsigned ldsw = (unsigned)wid * 1024u;
    const int aoff = lds_byte(wr * 64 + fr, fq * 8), boff = lds_byte(wc * 32 + fr, fq * 8);
#define PG8_SA(b, h) (((b) * 2 + (h)) * HTB)
#define PG8_SB(b, h) ((4 + (b) * 2 + (h)) * HTB)
#define PG8_STAGE(bufoff, gbase, voff) do { _Pragma("unroll") for (int _i = 0; _i < 2; ++_i) \
        __builtin_amdgcn_global_load_lds((const unsigned*)((const char*)(gbase) + (voff)[_i]), (LAS unsigned*)(lds + (bufoff) + ldsw + _i * 8192), 16, 0, 0); } while (0)
#define PG8_LDA(dst, b, h) do { _Pragma("unroll") for (int m = 0; m < 4; ++m) _Pragma("unroll") for (int k = 0; k < 2; ++k) dst[m][k] = *(const LAS bf16x8*)(lds + PG8_SA(b, h) + aoff + m * 2048 + k * 1024); } while (0)
#define PG8_LDB(dst, b, h) do { _Pragma("unroll") for (int n = 0; n < 2; ++n) _Pragma("unroll") for (int k = 0; k < 2; ++k) dst[n][k] = *(const LAS bf16x8*)(lds + PG8_SB(b, h) + boff + n * 2048 + k * 1024); } while (0)
#define PG8_MMA(ai, bj, At, Bt) do { __builtin_amdgcn_s_setprio(1); _Pragma("unroll") for (int m = 0; m < 4; ++m) _Pragma("unroll") for (int n = 0; n < 2; ++n) _Pragma("unroll") for (int k = 0; k < 2; ++k) \
        acc[ai][bj][m][n] = __builtin_amdgcn_mfma_f32_16x16x32_bf16(Bt[n][k], At[m][k], acc[ai][bj][m][n], 0, 0, 0); __builtin_amdgcn_s_setprio(0); } while (0)
#define PG8_WAIT_V(n) asm volatile("s_waitcnt vmcnt(" #n ")" ::: "memory")
#define PG8_WAIT_L(n) asm volatile("s_waitcnt lgkmcnt(" #n ")" ::: "memory")
#define PG8_BAR __builtin_amdgcn_s_barrier()
#define PG8_SCHED __builtin_amdgcn_sched_barrier(0)
    Unit cur, nxt; int ui = 0;
    if (!S.next(0, cur)) return;
    f32x4 acc[2][2][4][2];
#pragma unroll
    for (int a = 0; a < 2; ++a)
#pragma unroll
        for (int b = 0; b < 2; ++b)
#pragma unroll
            for (int m = 0; m < 4; ++m)
#pragma unroll
                for (int n = 0; n < 2; ++n) acc[a][b][m][n] = (f32x4){0.f, 0.f, 0.f, 0.f};
    bf16x8 At[4][2], B0[2][2], B1[2][2];
    const char* cA = (const char*)g.A + (size_t)cur.pm * tstep; const char* cB = (const char*)g.Bt + (size_t)cur.pn * tstep;
    PG8_STAGE(PG8_SB(0, 0), cB, voffB); PG8_STAGE(PG8_SB(0, 1), cB + hstep, voffB); PG8_STAGE(PG8_SA(0, 0), cA, voffA); PG8_STAGE(PG8_SA(0, 1), cA + hstep, voffA);
    if (wr == 1) PG8_BAR;
    PG8_WAIT_V(2); PG8_BAR;
    PG8_STAGE(PG8_SB(1, 0), cB + kstep, voffB); PG8_STAGE(PG8_SA(1, 0), cA + kstep, voffA); PG8_STAGE(PG8_SB(1, 1), cB + hstep + kstep, voffB);
    PG8_WAIT_V(6); PG8_BAR;
    for (;;) {
        const bool has_next = S.next(ui + 1, nxt);
        const char* nA = has_next ? (const char*)g.A + (size_t)nxt.pm * tstep : cA; const char* nB = has_next ? (const char*)g.Bt + (size_t)nxt.pn * tstep : cB;
        for (int t = 0; t < nt; t += 2) {
            const bool last = (t == nt - 2);
            const char* a1 = cA + (size_t)(t + 1) * kstep;
            const char* a2 = last ? nA : cA + (size_t)(t + 2) * kstep; const char* b2 = last ? nB : cB + (size_t)(t + 2) * kstep;
            const char* a3 = a2 + kstep; const char* b3 = b2 + kstep;
            if constexpr (Epi::KHOOK) { if (t == 4 || t == 12) { PG8_SCHED; E.khook(acc, cur, t, wr, wc, fr, fq); PG8_SCHED; } }
            PG8_LDB(B0, 0, 0); PG8_LDB(B1, 0, 1); PG8_SCHED; PG8_LDA(At, 0, 0); PG8_STAGE(PG8_SA(1, 1), a1 + hstep, voffA);
            PG8_WAIT_V(8); PG8_WAIT_L(0); PG8_BAR; PG8_MMA(0, 0, At, B0); PG8_MMA(0, 1, At, B1); PG8_BAR; PG8_SCHED;
            PG8_LDA(At, 0, 1); PG8_STAGE(PG8_SB(0, 0), b2, voffB); PG8_STAGE(PG8_SB(0, 1), b2 + hstep, voffB); PG8_STAGE(PG8_SA(0, 0), a2, voffA);
            PG8_WAIT_V(8); PG8_WAIT_L(0); PG8_BAR; PG8_MMA(1, 0, At, B0); PG8_MMA(1, 1, At, B1); PG8_BAR; PG8_SCHED;
            PG8_LDB(B0, 1, 0); PG8_LDB(B1, 1, 1); PG8_SCHED; PG8_LDA(At, 1, 0); PG8_STAGE(PG8_SA(0, 1), a2 + hstep, voffA);
            PG8_WAIT_V(8); PG8_WAIT_L(0); PG8_BAR; PG8_MMA(0, 0, At, B0); PG8_MMA(0, 1, At, B1); PG8_BAR; PG8_SCHED;
            PG8_LDA(At, 1, 1); PG8_STAGE(PG8_SB(1, 0), b3, voffB); PG8_STAGE(PG8_SB(1, 1), b3 + hstep, voffB); PG8_STAGE(PG8_SA(1, 0), a3, voffA);
            PG8_WAIT_V(8); PG8_WAIT_L(0); PG8_BAR; PG8_MMA(1, 0, At, B0); PG8_MMA(1, 1, At, B1); PG8_BAR; PG8_SCHED;
        }
        if (wr == 0) PG8_BAR;
        E(acc, cur, wr, wc, fr, fq);
        if (!has_next) break;
#pragma unroll
        for (int a = 0; a < 2; ++a)
#pragma unroll
            for (int b = 0; b < 2; ++b)
#pragma unroll
                for (int m = 0; m < 4; ++m)
#pragma unroll
                    for (int n = 0; n < 2; ++n) acc[a][b][m][n] = (f32x4){0.f, 0.f, 0.f, 0.f};
        cur = nxt; cA = nA; cB = nB; ++ui;
        if (wr == 1) PG8_BAR;
    }
    PG8_WAIT_V(0);
    PG8_BAR;
#undef PG8_SA
#undef PG8_SB
#undef PG8_STAGE
#undef PG8_LDA
#undef PG8_LDB
#undef PG8_MMA
#undef PG8_WAIT_V
#undef PG8_WAIT_L
#undef PG8_BAR
#undef PG8_SCHED
}
}
using pg8::Unit;
__device__ __forceinline__ float row_rstd(const float* ssp, int row) {
    const f32x4* p = (const f32x4*)(ssp + (size_t)row * 16);
    const f32x4 a = p[0], b = p[1], c = p[2], d = p[3];
    const float ss = ((a[0] + a[1]) + (a[2] + a[3])) + ((b[0] + b[1]) + (b[2] + b[3])) + ((c[0] + c[1]) + (c[2] + c[3])) + ((d[0] + d[1]) + (d[2] + d[3]));
    return 1.0f / sqrtf(ss * (1.0f / DM) + RMS_EPS);
}
__device__ __forceinline__ u32x4 pack8(const f32x4 a, const f32x4 b) { u32x4 w; w.x = cvtpk(a[0], a[1]); w.y = cvtpk(a[2], a[3]); w.z = cvtpk(b[0], b[1]); w.w = cvtpk(b[2], b[3]); return w; }
__device__ __forceinline__ void rope8(f32x4& v0, f32x4& v1, const float* tab, int t, int pos, float sc) {
    const f32x4* cs = (const f32x4*)(tab + ((size_t)t * 32 + (pos >> 1)) * 2);
    const f32x4 c0 = cs[0], c1 = cs[1];
    f32x4 o0, o1;
    o0[0] = (v0[0] * c0[0] - v0[1] * c0[1]) * sc; o0[1] = (v0[1] * c0[0] + v0[0] * c0[1]) * sc;
    o0[2] = (v0[2] * c0[2] - v0[3] * c0[3]) * sc; o0[3] = (v0[3] * c0[2] + v0[2] * c0[3]) * sc;
    o1[0] = (v1[0] * c1[0] - v1[1] * c1[1]) * sc; o1[1] = (v1[1] * c1[0] + v1[0] * c1[1]) * sc;
    o1[2] = (v1[2] * c1[2] - v1[3] * c1[3]) * sc; o1[3] = (v1[3] * c1[2] + v1[2] * c1[3]) * sc;
    v0 = o0; v1 = o1;
}
struct EpiInProj {
    static constexpr bool KHOOK = false;
    const float* ssp; const float* bias; const float* tab;
    bf16_t *U, *Qn, *KV, *Mo, *G, *Gn;
    __device__ __forceinline__ void operator()(const f32x4 (&acc)[2][2][4][2], const Unit& u, int wr, int wc, int fr, int fq) const {
        asm volatile("" : "+v"(fr), "+v"(fq));
        const int pn = u.pn;
#pragma unroll
        for (int ai = 0; ai < 2; ++ai)
#pragma unroll
            for (int m = 0; m < 4; ++m) {
                const int row = u.pm * 256 + ai * 128 + wr * 64 + m * 16 + fr;
                const float rstd = row_rstd(ssp, row);
                const int t = row & (SEQ - 1), b = row >> 13;
#pragma unroll
                for (int bj = 0; bj < 2; ++bj) {
                    const int cit = bj * 128 + wc * 32 + 8 * fq, gc = pn * 256 + cit;
                    f32x4 v0 = acc[ai][bj][m][0] * rstd + *(const f32x4*)(bias + gc), v1 = acc[ai][bj][m][1] * rstd + *(const f32x4*)(bias + gc + 4);
                    bf16_t* dst;
                    if (pn == 0) { dst = U + (size_t)row * 256 + cit; }
                    else if (pn <= 2) { const int c2 = (pn - 1) * 256 + cit, head = c2 >> 6, pos = c2 & 63; rope8(v0, v1, tab, t, pos, QSCALE); dst = Qn + ((size_t)(b * 8 + head) * SEQ + t) * 64 + pos; }
                    else if (pn <= 5) { const int c2 = cit & 127, g = c2 >> 6, pos = c2 & 63, kvi = 2 * (pn - 3) + bj; if (bj == 0) rope8(v0, v1, tab, t, pos, 1.f);
                        dst = KV + (size_t)kvi * ((size_t)MTOK * 128) + ((size_t)(b * 2 + g) * SEQ + t) * 64 + pos; }
                    else if (pn <= 8) { const int h = cit >> 6, pos = cit & 63; if (pn < 8) rope8(v0, v1, tab, t, pos, pn == 6 ? QSCALE : 1.f);
                        dst = Mo + (size_t)(pn - 6) * ((size_t)MTOK * 256) + ((size_t)(b * 4 + h) * SEQ + t) * 64 + pos; }
                    else if (pn <= 20) {
#pragma unroll
                        for (int e = 0; e < 4; ++e) { v0[e] = sigmoidf_(v0[e]); v1[e] = sigmoidf_(v1[e]); }
                        dst = G + (size_t)row * 3072 + (pn - 9) * 256 + cit; }
                    else {
#pragma unroll
                        for (int e = 0; e < 4; ++e) { v0[e] = sigmoidf_(v0[e]); v1[e] = sigmoidf_(v1[e]); }
                        dst = Gn + (size_t)row * 32 + (cit & 31); if (cit >= 32) dst = nullptr; }
                    if (dst) *(u32x4*)dst = pack8(v0, v1);
                }
                asm volatile("" ::: "memory");
            }
    }
};
struct EpiBranch {
    static constexpr bool KHOOK = true;
    const bf16_t* G; bf16_t* out;
    __device__ __forceinline__ void khook(f32x4 (&acc)[2][2][4][2], const Unit& u, int t, int wr, int wc, int fr, int fq) const {
        asm volatile("" : "+v"(fr), "+v"(fq));
        const int gsel = (t == 4) ? 0 : 1024;
#pragma unroll
        for (int ai = 0; ai < 2; ++ai)
#pragma unroll
            for (int m = 0; m < 4; ++m) {
                const int row = u.pm * 256 + ai * 128 + wr * 64 + m * 16 + fr;
#pragma unroll
                for (int bj = 0; bj < 2; ++bj) {
                    const int col = u.pn * 256 + bj * 128 + wc * 32 + 8 * fq;
                    const u32x4 gx = *(const u32x4*)(G + (size_t)row * 3072 + gsel + col), gy = *(const u32x4*)(G + (size_t)row * 3072 + gsel + 1024 + col);
#pragma unroll
                    for (int e = 0; e < 4; ++e) {
                        const float x0 = fmaxf(bflo(gx[e]), 1e-20f), x1 = fmaxf(bfhi(gx[e]), 1e-20f), y0 = fmaxf(bflo(gy[e]), 1e-20f), y1 = fmaxf(bfhi(gy[e]), 1e-20f);
                        const float r0 = x0 * __builtin_amdgcn_rcpf(y0), r1 = x1 * __builtin_amdgcn_rcpf(y1);
                        acc[ai][bj][m][e >> 1][(e & 1) * 2] *= r0; acc[ai][bj][m][e >> 1][(e & 1) * 2 + 1] *= r1;
                    }
                    asm volatile("" ::: "memory");
                }
            }
    }
    __device__ __forceinline__ void operator()(const f32x4 (&acc)[2][2][4][2], const Unit& u, int wr, int wc, int fr, int fq) const {
        asm volatile("" : "+v"(fr), "+v"(fq));
#pragma unroll
        for (int ai = 0; ai < 2; ++ai)
#pragma unroll
            for (int m = 0; m < 4; ++m) {
                const int row = u.pm * 256 + ai * 128 + wr * 64 + m * 16 + fr;
#pragma unroll
                for (int bj = 0; bj < 2; ++bj) {
                    const int col = u.pn * 256 + bj * 128 + wc * 32 + 8 * fq;
                    const u32x4 gz = *(const u32x4*)(G + (size_t)row * 3072 + 2048 + col);
                    f32x4 v0 = acc[ai][bj][m][0], v1 = acc[ai][bj][m][1];
                    v0[0] *= fmaxf(bflo(gz[0]), 1e-20f); v0[1] *= fmaxf(bfhi(gz[0]), 1e-20f); v0[2] *= fmaxf(bflo(gz[1]), 1e-20f); v0[3] *= fmaxf(bfhi(gz[1]), 1e-20f);
                    v1[0] *= fmaxf(bflo(gz[2]), 1e-20f); v1[1] *= fmaxf(bfhi(gz[2]), 1e-20f); v1[2] *= fmaxf(bflo(gz[3]), 1e-20f); v1[3] *= fmaxf(bfhi(gz[3]), 1e-20f);
                    *(u32x4*)(out + (size_t)row * DM + col) = pack8(v0, v1);
                }
                asm volatile("" ::: "memory");
            }
    }
};
struct EpiResid {
    static constexpr bool KHOOK = false;
    const float* base; float* out; bf16_t* xb; float* ssp;
    __device__ __forceinline__ void operator()(const f32x4 (&acc)[2][2][4][2], const Unit& u, int wr, int wc, int fr, int fq) const {
        asm volatile("" : "+v"(fr), "+v"(fq));
#pragma unroll
        for (int ai = 0; ai < 2; ++ai)
#pragma unroll
            for (int m = 0; m < 4; ++m) {
                const int row = u.pm * 256 + ai * 128 + wr * 64 + m * 16 + fr;
                float ss = 0.f;
#pragma unroll
                for (int bj = 0; bj < 2; ++bj) {
                    const size_t off = (size_t)row * DM + u.pn * 256 + bj * 128 + wc * 32 + 8 * fq;
                    const f32x4 v0 = acc[ai][bj][m][0] + *(const f32x4*)(base + off), v1 = acc[ai][bj][m][1] + *(const f32x4*)(base + off + 4);
                    *(f32x4*)(out + off) = v0; *(f32x4*)(out + off + 4) = v1;
                    *(u32x4*)(xb + off) = pack8(v0, v1);
                    ss += (v0[0] * v0[0] + v0[1] * v0[1]) + (v0[2] * v0[2] + v0[3] * v0[3]) + (v1[0] * v1[0] + v1[1] * v1[1]) + (v1[2] * v1[2] + v1[3] * v1[3]);
                }
                ss += __shfl_xor(ss, 16); ss += __shfl_xor(ss, 32);
                if (fq == 0) ssp[(size_t)row * 16 + u.pn * 4 + wc] = ss;
                asm volatile("" ::: "memory");
            }
    }
};
struct EpiSwiGLU {
    static constexpr bool KHOOK = false;
    const float* ssp; bf16_t* H;
    __device__ __forceinline__ void operator()(const f32x4 (&acc)[2][2][4][2], const Unit& u, int wr, int wc, int fr, int fq) const {
        asm volatile("" : "+v"(fr), "+v"(fq));
#pragma unroll
        for (int ai = 0; ai < 2; ++ai)
#pragma unroll
            for (int m = 0; m < 4; ++m) {
                const int row = u.pm * 256 + ai * 128 + wr * 64 + m * 16 + fr;
                const float rstd = row_rstd(ssp, row);
                f32x4 o[2];
#pragma unroll
                for (int n = 0; n < 2; ++n)
#pragma unroll
                    for (int e = 0; e < 4; ++e) { const float gt = acc[ai][0][m][n][e] * rstd, up = acc[ai][1][m][n][e] * rstd; o[n][e] = gt * sigmoidf_(gt) * up; }
                *(u32x4*)(H + (size_t)row * DFF + u.pn * 128 + wc * 32 + 8 * fq) = pack8(o[0], o[1]);
                asm volatile("" ::: "memory");
            }
    }
};
#ifndef ABL_NSA_SCALE
#define ABL_NSA_SCALE
#endif
#ifndef ABL_MOBA_SCALE
#define ABL_MOBA_SCALE
#endif
namespace att {
constexpr int KCS = 1040, KSLOT = 8 * KCS, VSLOT = 8192;
constexpr int L_K0 = 0, L_K1 = KSLOT, L_V0 = 2 * KSLOT, L_V1 = 2 * KSLOT + VSLOT, L_WSF = 2 * KSLOT + 2 * VSLOT, L_PS = L_WSF + 8 * 256, L_MSK = L_PS + 64 * 128 * 4,
              L_UNI = L_MSK + 1024, L_LIST = L_UNI + 64, L_END = L_LIST + 512, L_OT = L_END + 64, L_TOTAL = L_OT + 8 * 8192;
#define LBAR() asm volatile("s_waitcnt lgkmcnt(0)\n\ts_barrier" ::: "memory")
#define LWAIT() asm volatile("s_waitcnt lgkmcnt(0)" ::: "memory")
__device__ __forceinline__ int crow(int r, int hi) { return (r & 3) + 8 * (r >> 2) + 4 * hi; }
__device__ __forceinline__ float swap_other(float v, int hi) { auto rr = __builtin_amdgcn_permlane32_swap(__float_as_uint(v), __float_as_uint(v), false, false); return __uint_as_float(hi ? rr[0] : rr[1]); }
__device__ __forceinline__ void qkt(f32x16& p0, f32x16& p1, const LAS char* Ks, const bf16x8* qr, int r32, int hi) {
    const LAS char* kb = Ks + hi * KCS + r32 * 16;
    p0 = f32x16{}; p1 = f32x16{};
#pragma unroll
    for (int d0 = 0; d0 < 4; ++d0) {
        const bf16x8 b0 = *(const LAS bf16x8*)(kb + d0 * 2 * KCS), b1 = *(const LAS bf16x8*)(kb + d0 * 2 * KCS + 512);
        p0 = __builtin_amdgcn_mfma_f32_32x32x16_bf16(b0, qr[d0], p0, 0, 0, 0); p1 = __builtin_amdgcn_mfma_f32_32x32x16_bf16(b1, qr[d0], p1, 0, 0, 0); }
}
__device__ __forceinline__ void pv(f32x16* o, int vb, bf16x8 pa0, bf16x8 pa1, bf16x8 pa2, bf16x8 pa3) {
#pragma unroll
    for (int d0 = 0; d0 < 2; ++d0) { s16x4 lo[4], hi[4];
#pragma unroll
        for (int ks = 0; ks < 4; ++ks) {
            asm volatile("ds_read_b64_tr_b16 %0,%1 offset:%c2" : "=&v"(lo[ks]) : "v"(vb), "i"(d0 * 4096 + ks * 1024) : "memory");
            asm volatile("ds_read_b64_tr_b16 %0,%1 offset:%c2" : "=&v"(hi[ks]) : "v"(vb), "i"(d0 * 4096 + ks * 1024 + 512) : "memory"); }
        asm volatile("s_waitcnt lgkmcnt(0)" ::: "memory"); __builtin_amdgcn_sched_barrier(0);
#define PK(k) (bf16x8){lo[k][0], lo[k][1], lo[k][2], lo[k][3], hi[k][0], hi[k][1], hi[k][2], hi[k][3]}
        o[d0] = __builtin_amdgcn_mfma_f32_32x32x16_bf16(pa0, PK(0), o[d0], 0, 0, 0);
        o[d0] = __builtin_amdgcn_mfma_f32_32x32x16_bf16(pa1, PK(1), o[d0], 0, 0, 0);
        o[d0] = __builtin_amdgcn_mfma_f32_32x32x16_bf16(pa2, PK(2), o[d0], 0, 0, 0);
        o[d0] = __builtin_amdgcn_mfma_f32_32x32x16_bf16(pa3, PK(3), o[d0], 0, 0, 0);
#undef PK
    }
}
__device__ __forceinline__ float rowmax(const f32x16& p0, const f32x16& p1, int hi) {
    float a = __builtin_fmaxf(p0[0], p1[0]);
#pragma unroll
    for (int r = 1; r < 16; ++r) a = __builtin_fmaxf(__builtin_fmaxf(a, p0[r]), p1[r]);
    return __builtin_fmaxf(a, swap_other(a, hi));
}
struct KVRegs { u32x4 k, v; };
__device__ __forceinline__ void tile_load(KVRegs& R, const bf16_t* K, const bf16_t* V, int tid) { R.k = *(const u32x4*)(K + tid * 8); R.v = *(const u32x4*)(V + tid * 8); }
__device__ __forceinline__ void tile_store(const KVRegs& R, LAS char* Ks, LAS char* Vs, int tid) {
    const int row = tid >> 3, c = tid & 7;
    *(LAS u32x4*)(Ks + c * KCS + row * 16) = R.k;
    *(LAS u32x4*)(Vs + (c >> 2) * 4096 + (row >> 4) * 1024 + (row & 15) * 64 + (c & 3) * 16) = R.v;
}
__device__ __forceinline__ void ps_accum(const f32x16 p, int jb, LAS float* ps_row, bool writer) {
#pragma unroll
    for (int rg = 0; rg < 4; ++rg) {
        float a = 2.f * (p[4 * rg] + p[4 * rg + 1] + p[4 * rg + 2]) + p[4 * rg + 3], bq = p[4 * rg + 3];
        a += __shfl_xor(a, 1); a += __shfl_xor(a, 2); bq += __shfl_xor(bq, 1); bq += __shfl_xor(bq, 2);
        const int j = jb + 2 * rg;
        if (writer) { __hip_atomic_fetch_add(ps_row + j, a, __ATOMIC_RELAXED, __HIP_MEMORY_SCOPE_WORKGROUP); if (j + 1 < 128) __hip_atomic_fetch_add(ps_row + j + 1, bq, __ATOMIC_RELAXED, __HIP_MEMORY_SCOPE_WORKGROUP); }
    }
}
struct Ctx { LAS char* lds; LAS float* wsf; LAS float* otl; int tid, wid, lane, r32, hi, vbl; };
template <int MODE, class Src, class Msk>
__device__ __forceinline__ void run_branch(const Ctx& C, int nt, const Src& src, const Msk& msk, const bf16x8* qr, float& m, float& l, f32x16* o, float invl, LAS float* ps_row, bool ps_writer) {
    if (nt <= 0) return;
    KVRegs R; const bf16_t *kp, *vp;
    src(0, kp, vp); tile_load(R, kp, vp, C.tid);
    LBAR();
    for (int it = 0; it < nt; ++it) {
        LAS char* Ks = C.lds + ((it & 1) ? L_K1 : L_K0); LAS char* Vs = C.lds + ((it & 1) ? L_V1 : L_V0);
        tile_store(R, Ks, Vs, C.tid);
        if (it + 1 < nt) { src(it + 1, kp, vp); tile_load(R, kp, vp, C.tid); }
        LBAR();
        int klo, khi; const bool nm = msk(it, klo, khi);
        if (!__any(khi >= klo)) continue;
        f32x16 p0, p1; qkt(p0, p1, Ks, qr, C.r32, C.hi);
        if (__any(nm)) {
#pragma unroll
            for (int r = 0; r < 16; ++r) { const int kv = crow(r, C.hi); if (kv < klo || kv > khi) p0[r] = -INFINITY; if (kv + 32 < klo || kv + 32 > khi) p1[r] = -INFINITY; }
        }
        if constexpr (MODE == 2) {
#pragma unroll
            for (int r = 0; r < 16; ++r) { p0[r] = __builtin_amdgcn_exp2f(p0[r] - m) * invl; p1[r] = __builtin_amdgcn_exp2f(p1[r] - m) * invl; }
            ps_accum(p0, 16 * it + C.hi, ps_row, ps_writer); ps_accum(p1, 16 * it + 8 + C.hi, ps_row, ps_writer);
        } else {
            const float rm = rowmax(p0, p1, C.hi), mn = __builtin_fmaxf(m, rm), alpha = __builtin_amdgcn_exp2f(m - mn);
            float s = 0.f;
#pragma unroll
            for (int r = 0; r < 16; ++r) { p0[r] = __builtin_amdgcn_exp2f(p0[r] - mn); p1[r] = __builtin_amdgcn_exp2f(p1[r] - mn); s += p0[r] + p1[r]; }
            l = l * alpha + s;
            if constexpr (MODE == 1) {
                if (__any(mn > m)) {
                    if (C.hi == 0) C.wsf[C.r32] = alpha;
                    LWAIT();
#pragma unroll
                    for (int r = 0; r < 16; ++r) { const float f = C.wsf[crow(r, C.hi)]; o[0][r] *= f; o[1][r] *= f; }
                    LWAIT();
                }
            }
            m = mn;
        }
        if constexpr (MODE != 0) {
            u32x4 w0 = {cvtpk(p0[0], p0[1]), cvtpk(p0[2], p0[3]), cvtpk(p0[4], p0[5]), cvtpk(p0[6], p0[7])}, w1 = {cvtpk(p0[8], p0[9]), cvtpk(p0[10], p0[11]), cvtpk(p0[12], p0[13]), cvtpk(p0[14], p0[15])};
            u32x4 w2 = {cvtpk(p1[0], p1[1]), cvtpk(p1[2], p1[3]), cvtpk(p1[4], p1[5]), cvtpk(p1[6], p1[7])}, w3 = {cvtpk(p1[8], p1[9]), cvtpk(p1[10], p1[11]), cvtpk(p1[12], p1[13]), cvtpk(p1[14], p1[15])};
            pv(o, (int)(unsigned)(uintptr_t)Vs + C.vbl, __builtin_bit_cast(bf16x8, w0), __builtin_bit_cast(bf16x8, w1), __builtin_bit_cast(bf16x8, w2), __builtin_bit_cast(bf16x8, w3));
        }
    }
}
template <bool FIRST> __device__ __forceinline__ void merge_branch(const Ctx& C, const f32x16* o, float factor) {
    if (C.hi == 0) C.wsf[C.r32] = factor;
    LWAIT();
#pragma unroll
    for (int r = 0; r < 16; ++r) { const float f = C.wsf[crow(r, C.hi)];
        if (FIRST) { C.otl[r * 64] = o[0][r] * f; C.otl[(16 + r) * 64] = o[1][r] * f; }
        else { C.otl[r * 64] += o[0][r] * f; C.otl[(16 + r) * 64] += o[1][r] * f; } }
    LWAIT();
}
struct Bufs { const bf16_t *Qn, *KV, *Mo, *KC, *KM, *Gn; bf16_t* Abr; };
constexpr size_t KV_STRIDE = (size_t)MTOK * 128, MO_STRIDE = (size_t)MTOK * 256;

__device__ __forceinline__ void nsa_item(const Ctx& C, const Bufs& B, int b, int g, int i) {
    const int r32 = C.r32, hi = C.hi, wid = C.wid;
    const int qi = 8 * wid + (r32 >> 2), hh = r32 & 3, head = g * 4 + hh, t = 64 * i + qi, cur = i;
    const size_t bg = (size_t)(b * 2 + g) * SEQ;
    bf16x8 qr[4];
    { const bf16_t* qp = B.Qn + ((size_t)(b * 8 + head) * SEQ + t) * 64 + hi * 8;
#pragma unroll
      for (int d0 = 0; d0 < 4; ++d0) qr[d0] = *(const bf16x8*)(qp + d0 * 16); }
    const unsigned gw = *(const unsigned*)(B.Gn + ((size_t)b * SEQ + t) * 32 + head * 3 - (head & 1));
    const unsigned gw2 = *(const unsigned*)(B.Gn + ((size_t)b * SEQ + t) * 32 + head * 3 - (head & 1) + 2);
    float g0, g1, g2; if (head & 1) { g0 = bfhi(gw); g1 = bflo(gw2); g2 = bfhi(gw2); } else { g0 = bflo(gw); g1 = bfhi(gw); g2 = bflo(gw2); }
    f32x16 o[2];
    LAS float* Ps = (LAS float*)(C.lds + L_PS); LAS unsigned* Mk = (LAS unsigned*)(C.lds + L_MSK); LAS unsigned* Uni = (LAS unsigned*)(C.lds + L_UNI); LAS int* List = (LAS int*)(C.lds + L_LIST);
    const int nv = t >= 31 ? ((t - 31) >> 4) + 1 : 0;
    const int nvt = (4 * i + 3 < 511) ? 4 * i + 3 : 511, ntc = (nvt + 63) >> 6;
    const bf16_t* kc = B.KC + (size_t)(0 * 4 + b * 2 + g) * 512 * 64; const bf16_t* vc = B.KC + (size_t)(1 * 4 + b * 2 + g) * 512 * 64;
    auto srcC = [&](int it, const bf16_t*& kp, const bf16_t*& vp) { kp = kc + (size_t)it * 4096; vp = vc + (size_t)it * 4096; };
    auto mskC = [&](int it, int& klo, int& khi) { klo = 0; khi = nv - 1 - 64 * it; return true; };
    float m = -1e30f, l = 0.f;
    run_branch<0>(C, ntc, srcC, mskC, qr, m, l, o, 0.f, nullptr, false);
    l += swap_other(l, hi);
    const float invl = l > 0.f ? 1.0f / l : 0.f;
    for (int e = C.tid; e < 64 * 128; e += 512) Ps[e] = 0.f;
    if (C.tid < 8) Uni[C.tid] = 0u;
    o[0] = f32x16{}; o[1] = f32x16{};
    run_branch<2>(C, ntc, srcC, mskC, qr, m, l, o, invl, Ps + qi * 128, hh == 0);
    merge_branch<true>(C, o, g0);
    LBAR();
    {
        const int nf = cur == 0 ? 1 : (cur == 1 ? 2 : 3), kp_ = 16 - nf, lane = C.lane;
        for (int qq = 0; qq < 8; ++qq) {
            const int q = 8 * wid + qq; LAS float* ps = Ps + q * 128;
            const int j0 = lane, j1 = lane + 64;
            const bool f0 = (j0 == 0 || j0 == cur || j0 == cur - 1) && j0 <= cur, f1 = (j1 == cur || j1 == cur - 1) && j1 <= cur;
            const bool va0 = j0 <= cur && !f0, va1 = j1 <= cur && !f1;
            const float v0 = va0 ? ps[j0] : -1.f, v1 = va1 ? ps[j1] : -1.f;
            int r0 = 0, r1 = 0;
            for (int e = 1; e <= cur; ++e) {
                float ve = ps[e]; if (e == cur || e == cur - 1) ve = -2.f;
                r0 += (ve > v0 || (ve == v0 && e < j0)) ? 1 : 0; r1 += (ve > v1 || (ve == v1 && e < j1)) ? 1 : 0;
            }
            const bool s0 = f0 || (va0 && r0 < kp_), s1 = f1 || (va1 && r1 < kp_);
            const unsigned long long b0 = __ballot(s0), b1 = __ballot(s1);
            if (lane == 0) { Mk[q * 4 + 0] = (unsigned)b0; Mk[q * 4 + 1] = (unsigned)(b0 >> 32); Mk[q * 4 + 2] = (unsigned)b1; Mk[q * 4 + 3] = (unsigned)(b1 >> 32);
                __hip_atomic_fetch_or(&Uni[0], (unsigned)b0, __ATOMIC_RELAXED, __HIP_MEMORY_SCOPE_WORKGROUP); __hip_atomic_fetch_or(&Uni[1], (unsigned)(b0 >> 32), __ATOMIC_RELAXED, __HIP_MEMORY_SCOPE_WORKGROUP); __hip_atomic_fetch_or(&Uni[2], (unsigned)b1, __ATOMIC_RELAXED, __HIP_MEMORY_SCOPE_WORKGROUP); __hip_atomic_fetch_or(&Uni[3], (unsigned)(b1 >> 32), __ATOMIC_RELAXED, __HIP_MEMORY_SCOPE_WORKGROUP); }
        }
    }
    LBAR();
    if (C.tid == 0) { int n = 0; for (int w = 0; w < 4; ++w) { unsigned u = Uni[w]; while (u) { const int bpos = __builtin_ctz(u); u &= u - 1; List[n++] = w * 32 + bpos; } } Uni[4] = (unsigned)n; }
    LBAR();
    {
        const int nsel = (int)Uni[4];
        const bf16_t* ks = B.KV + 2 * KV_STRIDE + bg * 64; const bf16_t* vs = B.KV + 3 * KV_STRIDE + bg * 64;
        auto srcS = [&](int it, const bf16_t*& kp, const bf16_t*& vp) { const int j = List[it]; kp = ks + (size_t)j * 4096; vp = vs + (size_t)j * 4096; };
        auto mskS = [&](int it, int& klo, int& khi) { const int j = List[it]; const unsigned w = Mk[qi * 4 + (j >> 5)]; const bool bit = (w >> (j & 31)) & 1u;
            klo = 0; khi = bit ? (j == cur ? qi : 63) : -1; return (!bit) || j == cur; };
        m = -1e30f; l = 0.f; o[0] = f32x16{}; o[1] = f32x16{};
        run_branch<1>(C, nsel, srcS, mskS, qr, m, l, o, 0.f, nullptr, false);
        l += swap_other(l, hi);
        merge_branch<false>(C, o, l > 0.f ? g1 / l : 0.f);
    }
    {
        const int tw0 = i >= 8 ? i - 8 : 0, ntw = i - tw0 + 1;
        const bf16_t* kw = B.KV + 4 * KV_STRIDE + bg * 64; const bf16_t* vw = B.KV + 5 * KV_STRIDE + bg * 64;
        auto srcW = [&](int it, const bf16_t*& kp, const bf16_t*& vp) { kp = kw + (size_t)(tw0 + it) * 4096; vp = vw + (size_t)(tw0 + it) * 4096; };
        auto mskW = [&](int it, int& klo, int& khi) { const int tw = tw0 + it; klo = (t - 511) - 64 * tw; khi = (tw == i) ? qi : 63; return tw == i || klo > 0; };
        m = -1e30f; l = 0.f; o[0] = f32x16{}; o[1] = f32x16{};
        run_branch<1>(C, ntw, srcW, mskW, qr, m, l, o, 0.f, nullptr, false);
        l += swap_other(l, hi);
        merge_branch<false>(C, o, l > 0.f ? g2 / l : 0.f);
    }
#pragma unroll
    for (int r = 0; r < 16; ++r) { const int qrow = crow(r, hi); bf16_t* dst = B.Abr + ((size_t)b * SEQ + 64 * i + 8 * wid + (qrow >> 2)) * DM + 256 + (g * 4 + (qrow & 3)) * 64 + r32;
        dst[0] = (bf16_t)(cvtpk(ABL_NSA_SCALE C.otl[r * 64], 0.f) & 0xffffu); dst[32] = (bf16_t)(cvtpk(ABL_NSA_SCALE C.otl[(16 + r) * 64], 0.f) & 0xffffu); }
}
__device__ __forceinline__ void moba_item(const Ctx& C, const Bufs& B, int b, int h, int qb) {
    const int r32 = C.r32, hi = C.hi, wid = C.wid, own = qb, t = 256 * qb + 32 * wid + r32;
    const size_t bh = (size_t)(b * 4 + h) * SEQ;
    bf16x8 qr[4];
    { const bf16_t* qp = B.Mo + (bh + t) * 64 + hi * 8;
#pragma unroll
      for (int d0 = 0; d0 < 4; ++d0) qr[d0] = *(const bf16x8*)(qp + d0 * 16); }
    LAS unsigned* Uni = (LAS unsigned*)(C.lds + L_UNI); LAS int* List = (LAS int*)(C.lds + L_LIST);
    LBAR();
    if (C.tid < 256) { const u32x4 kmv = *(const u32x4*)(B.KM + (size_t)(b * 4 + h) * 2048 + C.tid * 8); *(LAS u32x4*)(C.lds + L_K0 + (C.tid & 7) * KCS + (C.tid >> 3) * 16) = kmv; }
    if (C.tid == 0) Uni[0] = 0u;
    LBAR();
    unsigned sel = 0u;
    {
        f32x16 gs = f32x16{};
        const LAS char* kb = C.lds + L_K0 + hi * KCS + r32 * 16;
#pragma unroll
        for (int d0 = 0; d0 < 4; ++d0) gs = __builtin_amdgcn_mfma_f32_32x32x16_bf16(*(const LAS bf16x8*)(kb + d0 * 2 * KCS), qr[d0], gs, 0, 0, 0);
        float lo[16], hv[16];
#pragma unroll
        for (int r = 0; r < 16; ++r) { const float ownv = gs[r], oth = swap_other(ownv, hi); lo[r] = hi ? oth : ownv; hv[r] = hi ? ownv : oth; }
        unsigned taken = ~((1u << own) - 1u);
#pragma unroll
        for (int round = 0; round < 3; ++round) {
            float best = -INFINITY; int bi = 32;
#pragma unroll
            for (int n = 0; n < 32; ++n) { const int rr = (n & 3) + 4 * (n >> 3); const float v = ((n >> 2) & 1) ? hv[rr] : lo[rr]; if (!((taken >> n) & 1u) && v > best) { best = v; bi = n; } }
            if (bi < 32) { sel |= 1u << bi; taken |= 1u << bi; }
        }
    }
    { unsigned u = sel;
#pragma unroll
      for (int o_ = 1; o_ < 64; o_ <<= 1) u |= (unsigned)__shfl_xor((int)u, o_);
      if (C.lane == 0) __hip_atomic_fetch_or(&Uni[0], u, __ATOMIC_RELAXED, __HIP_MEMORY_SCOPE_WORKGROUP); }
    LBAR();
    if (C.tid == 0) { int n = 0; unsigned u = Uni[0]; while (u) { const int bpos = __builtin_ctz(u); u &= u - 1; List[n++] = bpos; } Uni[4] = (unsigned)n; }
    LBAR();
    const int nl = (int)Uni[4], nt = 4 * nl + 4;
    const bf16_t* kk = B.Mo + MO_STRIDE + bh * 64; const bf16_t* vv = B.Mo + 2 * MO_STRIDE + bh * 64;
    auto src = [&](int it, const bf16_t*& kp, const bf16_t*& vp) { const int T = (it < 4 * nl) ? 4 * List[it >> 2] + (it & 3) : 4 * own + (it - 4 * nl); kp = kk + (size_t)T * 4096; vp = vv + (size_t)T * 4096; };
    auto msk = [&](int it, int& klo, int& khi) { klo = 0; if (it < 4 * nl) { const bool bit = (sel >> List[it >> 2]) & 1u; khi = bit ? 63 : -1; return !bit; } khi = 32 * wid + r32 - 64 * (it - 4 * nl); return true; };
    float m = -1e30f, l = 0.f; f32x16 o[2] = {f32x16{}, f32x16{}};
    run_branch<1>(C, nt, src, msk, qr, m, l, o, 0.f, nullptr, false);
    l += swap_other(l, hi);
    merge_branch<true>(C, o, l > 0.f ? 1.0f / l : 0.f);
#pragma unroll
    for (int r = 0; r < 16; ++r) { const int qrow = crow(r, hi); bf16_t* dst = B.Abr + ((size_t)b * SEQ + 256 * qb + 32 * wid + qrow) * DM + 768 + h * 64 + r32;
        dst[0] = (bf16_t)(cvtpk(ABL_MOBA_SCALE C.otl[r * 64], 0.f) & 0xffffu); dst[32] = (bf16_t)(cvtpk(ABL_MOBA_SCALE C.otl[(16 + r) * 64], 0.f) & 0xffffu); }
}
}
#define XB_TMO      128
#define XB_XCNT(j)  (256  + 64 * (j))
#define XB_XSUB(j)  (1280 + 64 * (j))
#define XB_XGEN(j)  (2304 + 64 * (j))
#define XB_TOP      3328
#define XB_TOPGEN   3392
#define XCD_BAR_WORDS 3456
#define XB_SPIN_CAP (1u << 18)

__device__ __forceinline__ unsigned xb_ld(unsigned* p)              { return __hip_atomic_load(p, __ATOMIC_RELAXED, __HIP_MEMORY_SCOPE_AGENT); }
__device__ __forceinline__ unsigned xb_add(unsigned* p, unsigned v) { return __hip_atomic_fetch_add(p, v, __ATOMIC_RELAXED, __HIP_MEMORY_SCOPE_AGENT); }
__device__ __forceinline__ unsigned xb_xcc_id() { return (unsigned)__builtin_amdgcn_s_getreg((3 << 11) | 20) & 0xFu; }
#define XB_SPIN(cond, bar) do { unsigned _sp = 0; while (cond) { __builtin_amdgcn_s_sleep(1); \
    if ((++_sp & 255u) == 0u) { if (xb_ld(&(bar)[XB_TMO])) break; if (_sp > XB_SPIN_CAP) { atomicAdd(&(bar)[XB_TMO], 1u); break; } } } } while (0)

struct XcdBarrier {
    unsigned* bar; unsigned x;
    volatile LAS unsigned* st;
};

__device__ __forceinline__ XcdBarrier xcd_barrier_post(unsigned* bar, volatile LAS unsigned* st) {
    XcdBarrier b; b.bar = bar; b.x = xb_xcc_id(); b.st = st;
    if (threadIdx.x == 0) (void)xb_add(&bar[XB_XCNT(b.x)], 1u);
    return b;
}
__device__ __forceinline__ void xcd_barrier_complete(unsigned* bar, unsigned x, unsigned& nloc, unsigned& nx) {
    const unsigned G = gridDim.x * gridDim.y * gridDim.z;
    unsigned sum, cnt, mine, sp = 0u;
    for (;;) {
        sum = 0u; cnt = 0u; mine = 0u;
#pragma unroll
        for (unsigned j = 0; j < 16; ++j) { const unsigned c = xb_ld(&bar[XB_XCNT(j)]); sum += c; cnt += (c > 0u) ? 1u : 0u; mine = (j == x) ? c : mine; }
        if (sum == G) break;
        __builtin_amdgcn_s_sleep(1);
        if ((++sp & 255u) == 0u) { if (xb_ld(&bar[XB_TMO])) break; if (sp > XB_SPIN_CAP) { atomicAdd(&bar[XB_TMO], 1u); break; } }
    }
    nloc = mine > 0u ? mine : 1u; nx = cnt > 0u ? cnt : 1u;
}

__device__ __forceinline__ void xcd_barrier(const XcdBarrier& b) {
    asm volatile("s_waitcnt vmcnt(0)" ::: "memory");
    __syncthreads();
    if (threadIdx.x == 0) {
        unsigned* bar = b.bar;
        __builtin_amdgcn_s_waitcnt(0);
        unsigned nloc = b.st[0], nx = b.st[1];
        if (nloc == 0u) { xcd_barrier_complete(bar, b.x, nloc, nx); b.st[0] = nloc; b.st[1] = nx; }
        const unsigned old = xb_add(&bar[XB_XSUB(b.x)], 1u);
        const unsigned gen = old / nloc;
        if (old + 1u == (gen + 1u) * nloc) {
            __builtin_amdgcn_fence(__ATOMIC_RELEASE, "agent");
            asm volatile("s_waitcnt vmcnt(0)" ::: "memory");
            const unsigned og = xb_add(&bar[XB_TOP], 1u);
            const unsigned tg = og / nx;
            if (og + 1u == (tg + 1u) * nx) xb_add(&bar[XB_TOPGEN], 1u);
            else XB_SPIN(xb_ld(&bar[XB_TOPGEN]) == tg, bar);
            __builtin_amdgcn_fence(__ATOMIC_ACQUIRE, "agent");
            xb_add(&bar[XB_XGEN(b.x)], 1u);
            asm volatile("s_waitcnt vmcnt(0)" ::: "memory");
        } else {
            XB_SPIN(xb_ld(&bar[XB_XGEN(b.x)]) == gen, bar);
            __builtin_amdgcn_fence(__ATOMIC_ACQUIRE, "agent");
            asm volatile("s_waitcnt vmcnt(0)" ::: "memory");
        }
    }
    __syncthreads();
}

constexpr size_t MiB = 1u << 20;
constexpr size_t WS_CTL = 0, WS_ORDER = 4096, WS_BAR = 8192;
constexpr size_t WS_W = 1 * MiB, OFF_WIN = 0, OFF_WGU = 11 * MiB, OFF_WD = 22 * MiB, OFF_WBR = 28 * MiB, OFF_WOUT = 30 * MiB, OFF_W1 = 32 * MiB, OFF_W2 = 34 * MiB,
                 OFF_BIN = 34 * MiB + 65536, OFF_CB1 = OFF_BIN + 32768  , OFF_CB2 = OFF_CB1 + 65536;
constexpr size_t WS_TAB = 36 * MiB, WS_SSP = 38 * MiB, WS_KC = 39 * MiB, WS_KM = 39 * MiB + 512 * 1024, WS_GN = 40 * MiB, WS_XB = 42 * MiB, WS_BIG = 74 * MiB,
                 WS_U = 170 * MiB, WS_QN = 178 * MiB, WS_KV = 194 * MiB, WS_MO = 218 * MiB, WS_MRG = 178 * MiB, WS_END = 242 * MiB;
constexpr int LDS_BYTES = 147456;

__device__ __forceinline__ int dint(int pos) { return (pos >> 1) + 32 * (pos & 1); }
__device__ __forceinline__ int in_orig(int c) {
    if (c < 256) return c;
    if (c < 768) { const int c2 = c - 256; return 256 + (c2 >> 6) * 64 + dint(c2 & 63); }
    if (c < 1536) { const int c2 = c - 768, tt = c2 >> 8, bj = (c2 >> 7) & 1, g = (c2 >> 6) & 1, pos = c2 & 63; return 768 + (2 * tt + bj) * 128 + g * 64 + (bj == 0 ? dint(pos) : pos); }
    if (c < 2304) { const int c2 = c - 1536, part = c2 >> 8, h = (c2 >> 6) & 3, pos = c2 & 63; return 1560 + part * 256 + h * 64 + (part < 2 ? dint(pos) : pos); }
    if (c < 5376) return 2328 + (c - 2304);
    const int c2 = c - 5376; return c2 < 24 ? 1536 + c2 : -1;
}
template <class F> __device__ __forceinline__ void cvt_tile(LAS float* scr, int lane, int k0, int n0, bf16_t* dst, size_t pitch, F f) {
#pragma unroll 4
    for (int i = 0; i < 32; ++i) { const int kk = 2 * i + (lane >> 5); scr[kk * 33 + (lane & 31)] = f(k0 + kk, n0 + (lane & 31)); }
    asm volatile("s_waitcnt lgkmcnt(0)" ::: "memory");
    const int c = lane & 7;
#pragma unroll
    for (int j = 0; j < 4; ++j) { const int n = (lane >> 3) + 8 * j; const LAS float* s = scr + (8 * c) * 33 + n;
        u32x4 o; o.x = cvtpk(s[0 * 33], s[1 * 33]); o.y = cvtpk(s[2 * 33], s[3 * 33]); o.z = cvtpk(s[4 * 33], s[5 * 33]); o.w = cvtpk(s[6 * 33], s[7 * 33]);
        *(u32x4*)(dst + (size_t)(n0 + n) * pitch + k0 + 8 * c) = o; }
    asm volatile("s_waitcnt lgkmcnt(0)" ::: "memory");
}
struct Args { const float* in[20]; float* out; unsigned char* ws; };
typedef const __attribute__((address_space(4))) Args* ArgsP;

__device__ __forceinline__ void phase0(ArgsP a, int l, LAS unsigned char* lds, int tid, int lane, int wave, int gw, int NGW) {
    unsigned char* ws = a->ws;
    LAS float* scr = (LAS float*)(lds + wave * 8704);
    const float* attn_norm = a->in[1] + (size_t)l * DM; const float* w_in = a->in[2] + (size_t)l * DM * IN_COLS; const float* b_in = a->in[3] + (size_t)l * IN_COLS;
    const float* pool_w = a->in[4] + (size_t)l * 4 * 64 * 64; const float* pool_scale = a->in[5] + (size_t)l * 256; const float* cmp_pos = a->in[6] + (size_t)l * 2 * 32 * 64;
    const float* cmp_w1 = a->in[7] + (size_t)l * 2 * 2048 * 256; const float* cmp_b1 = a->in[8] + (size_t)l * 2 * 256; const float* cmp_w2 = a->in[9] + (size_t)l * 2 * 256 * 64; const float* cmp_b2 = a->in[10] + (size_t)l * 2 * 64;
    const float* w_br_pool = a->in[11] + (size_t)l * 256 * DM; const float* w_br_nsa = a->in[12] + (size_t)l * 512 * DM; const float* w_br_moba = a->in[13] + (size_t)l * 256 * DM;
    const float* w_out = a->in[14] + (size_t)l * DM * DM; const float* ffn_norm = a->in[15] + (size_t)l * DM; const float* w_gate = a->in[16] + (size_t)l * DM * DFF; const float* w_up = a->in[17] + (size_t)l * DM * DFF;
    const float* w_down = a->in[18] + (size_t)l * DFF * DM;
    bf16_t* Win = (bf16_t*)(ws + WS_W + OFF_WIN); bf16_t* Wgu = (bf16_t*)(ws + WS_W + OFF_WGU); bf16_t* Wd = (bf16_t*)(ws + WS_W + OFF_WD); bf16_t* Wbr = (bf16_t*)(ws + WS_W + OFF_WBR);
    bf16_t* Wout = (bf16_t*)(ws + WS_W + OFF_WOUT); bf16_t* W1t = (bf16_t*)(ws + WS_W + OFF_W1); bf16_t* W2t = (bf16_t*)(ws + WS_W + OFF_W2);
    float* bin = (float*)(ws + WS_W + OFF_BIN); float* cb1 = (float*)(ws + WS_W + OFF_CB1); float* cb2 = (float*)(ws + WS_W + OFF_CB2);
    constexpr int I_A = 16 * 176, I_B = 16 * 176, I_C = 44 * 32, I_D = 16 * 32, I_E = 16 * 32, I_F = 2 * 32 * 8, I_G = 2 * 4 * 2;
    constexpr int NITEMS = I_A + I_B + I_C + I_D + I_E + I_F + I_G;
    for (int it = gw; it < NITEMS; it += NGW) {
        int r = it;
        if (r < I_A) { const int kb = r / 176, nb = r % 176; cvt_tile(scr, lane, 64 * kb, 32 * nb, Win, DM, [&](int k, int n) { const int o = in_orig(n); return o >= 0 ? w_in[(size_t)k * IN_COLS + o] * attn_norm[k] : 0.f; }); continue; } r -= I_A;
        if (r < I_B) { const int kb = r / 176, nb = r % 176; cvt_tile(scr, lane, 64 * kb, 32 * nb, Wgu, DM, [&](int k, int n) { const int j = (n >> 8) * 128 + (n & 127); const float* s = ((n >> 7) & 1) ? w_up : w_gate; return s[(size_t)k * DFF + j] * ffn_norm[k]; }); continue; } r -= I_B;
        if (r < I_C) { const int kb = r / 32, nb = r % 32; cvt_tile(scr, lane, 64 * kb, 32 * nb, Wd, DFF, [&](int k, int n) { return w_down[(size_t)k * DM + n]; }); continue; } r -= I_C;
        if (r < I_D) { const int kb = r / 32, nb = r % 32; cvt_tile(scr, lane, 64 * kb, 32 * nb, Wout, DM, [&](int k, int n) { return w_out[(size_t)k * DM + n]; }); continue; } r -= I_D;
        if (r < I_E) { const int kb = r / 32, nb = r % 32;
            if (kb < 4) { }
            else if (kb < 12) cvt_tile(scr, lane, 64 * kb, 32 * nb, Wbr, DM, [&](int k, int n) { return w_br_nsa[(size_t)(k - 256) * DM + n]; });
            else cvt_tile(scr, lane, 64 * kb, 32 * nb, Wbr, DM, [&](int k, int n) { return w_br_moba[(size_t)(k - 768) * DM + n]; });
            continue; } r -= I_E;
        if (r < I_F) { const int kv = r >> 8, kb = (r >> 3) & 31, nb = r & 7; const float* w1 = cmp_w1 + (size_t)kv * 2048 * 256;
            cvt_tile(scr, lane, 64 * kb, 32 * nb, W1t + (size_t)kv * 256 * 2048, 2048, [&](int k, int n) { const int pos = k & 63, d = kv == 0 ? dint(pos) : pos; return w1[(size_t)((k & ~63) + d) * 256 + n]; }); continue; } r -= I_F;
        { const int kv = r >> 3, kb = (r >> 1) & 3, nb = r & 1; const float* w2 = cmp_w2 + (size_t)kv * 256 * 64;
            cvt_tile(scr, lane, 64 * kb, 32 * nb, W2t + (size_t)kv * 64 * 256, 256, [&](int k, int n) { return w2[(size_t)k * 64 + (kv == 0 ? dint(n) : n)]; }); }
    }
    const int gt = gw * 64 + lane, NGT = NGW * 64;
    for (int c = gt; c < NIN; c += NGT) { const int o = in_orig(c); bin[c] = o >= 0 ? b_in[o] : 0.f; }
    for (int idx = gt; idx < 32 * 512; idx += NGT) { const int c = idx >> 9, e = idx & 511, kv = e >> 8, n = e & 255; const float* w1 = cmp_w1 + (size_t)kv * 2048 * 256 + (size_t)(64 * c) * 256 + n; const float* pe = cmp_pos + (size_t)kv * 2048 + 64 * c;
        float s = c == 0 ? cmp_b1[kv * 256 + n] : 0.f;
#pragma unroll 16
        for (int k = 0; k < 64; ++k) s += pe[k] * w1[(size_t)k * 256];
        cb1[idx] = s; }
    for (int idx = gt; idx < 256 * DM; idx += NGT) { const int k = idx >> 10, n = idx & 1023, g64 = k & ~63; float s = 0.f;
#pragma unroll 16
        for (int j = 0; j < 64; ++j) s += pool_w[k * 64 + j] * pool_scale[g64 + j] * w_br_pool[(size_t)(g64 + j) * DM + n];
        Wbr[(size_t)n * DM + k] = (bf16_t)(cvtpk(s, 0.f) & 0xffffu); }
    for (int e = gt; e < 128; e += NGT) { const int kv = e >> 6, n = e & 63; cb2[e] = cmp_b2[kv * 64 + (kv == 0 ? dint(n) : n)]; }
    if (l == 0) {
        float* tab = (float*)(ws + WS_TAB);
        for (int e = gt; e < SEQ * 32; e += NGT) { const int t = e >> 5, f = e & 31; const float inv = powf(10000.0f, -(float)(2 * f) / 64.0f); const float ang = (float)t * inv;
            const double ad = (double)ang, kq = rint(ad * 0.15915494309189535); double rr = fma(-kq, 6.283185307179586, ad); rr = fma(-kq, 2.4492935982947064e-16, rr);
            const float rf = (float)rr; tab[2 * e] = __cosf(rf); tab[2 * e + 1] = __sinf(rf); }
        const float* x = a->in[0]; bf16_t* xb = (bf16_t*)(ws + WS_XB); float* ssp = (float*)(ws + WS_SSP);
        for (int m = gw; m < MTOK; m += NGW) { const f32x4* xr = (const f32x4*)(x + (size_t)m * DM) + lane; f32x4 v[4]; float s = 0.f;
#pragma unroll
            for (int j = 0; j < 4; ++j) { v[j] = xr[64 * j]; s += (v[j][0] * v[j][0] + v[j][1] * v[j][1]) + (v[j][2] * v[j][2] + v[j][3] * v[j][3]); }
#pragma unroll
            for (int o = 1; o < 64; o <<= 1) s += __shfl_xor(s, o);
            u32x2* o8 = (u32x2*)(xb + (size_t)m * DM) + lane;
#pragma unroll
            for (int j = 0; j < 4; ++j) o8[64 * j] = (u32x2){cvtpk(v[j][0], v[j][1]), cvtpk(v[j][2], v[j][3])};
            if (lane < 16) ssp[(size_t)m * 16 + lane] = lane == 0 ? s : 0.f; }
        int* order = (int*)(ws + WS_ORDER);
        if (gt < 768) { auto cost = [](int id) { return id < 512 ? 9 * (id & 127) + 80 : 32 * ((id - 512) & 31) + 32; }; const int mc = cost(gt); int rk = 0;
            for (int j = 0; j < 768; ++j) { const int cj = cost(j); rk += (cj > mc || (cj == mc && j < gt)) ? 1 : 0; }
            order[rk] = gt; }
    }
}
__device__ __forceinline__ float gelu_tanh(float x) { const float u = 0.7978845608028654f * (x + 0.044715f * x * x * x); const float th = 1.f - 2.f * __builtin_amdgcn_rcpf(1.f + __expf(2.f * u)); return 0.5f * x * (1.f + th); }
__device__ __forceinline__ void phase2(ArgsP a, LAS unsigned char* lds, int tid, int lane, int wave, int G) {
    unsigned char* ws = a->ws;
    const bf16_t* KV = (const bf16_t*)(ws + WS_KV); const bf16_t* W1t = (const bf16_t*)(ws + WS_W + OFF_W1); const bf16_t* W2t = (const bf16_t*)(ws + WS_W + OFF_W2);
    const float* cb1 = (const float*)(ws + WS_W + OFF_CB1); const float* cb2 = (const float*)(ws + WS_W + OFF_CB2);
    bf16_t* KC = (bf16_t*)(ws + WS_KC);
    LAS bf16_t* hid = (LAS bf16_t*)lds;
    const int arow = lane & 15, kq = lane >> 4;
    for (int task = blockIdx.x; task < 256; task += G) {
        const int kv = task >> 7, bgi = (task >> 5) & 3, nt = task & 31;
        const bf16_t* src = KV + (size_t)kv * att::KV_STRIDE + (size_t)bgi * SEQ * 64;
        const int nrow = 16 * nt + arow, neff = nrow < 510 ? nrow : 510;
        const bf16_t* ap = src + (size_t)neff * 1024 + kq * 8;
        const bf16_t* bp0 = W1t + (size_t)kv * 256 * 2048 + (size_t)(32 * wave + arow) * 2048 + kq * 8; const bf16_t* bp1 = bp0 + 16 * 2048;
        f32x4 c0 = {0.f, 0.f, 0.f, 0.f}, c1 = {0.f, 0.f, 0.f, 0.f};
#pragma unroll 4
        for (int ks = 0; ks < 64; ++ks) { const bf16x8 av = *(const bf16x8*)(ap + ks * 32), b0 = *(const bf16x8*)(bp0 + ks * 32), b1 = *(const bf16x8*)(bp1 + ks * 32);
            c0 = __builtin_amdgcn_mfma_f32_16x16x32_bf16(av, b0, c0, 0, 0, 0); c1 = __builtin_amdgcn_mfma_f32_16x16x32_bf16(av, b1, c1, 0, 0, 0); }
        { const int col0 = 32 * wave + arow; float bb0 = 0.f, bb1 = 0.f;
#pragma unroll 8
          for (int c = 0; c < 32; ++c) { bb0 += cb1[c * 512 + kv * 256 + col0]; bb1 += cb1[c * 512 + kv * 256 + col0 + 16]; }
#pragma unroll
          for (int j = 0; j < 4; ++j) { const int row = kq * 4 + j; hid[row * 264 + col0] = (bf16_t)(cvtpk(gelu_tanh(c0[j] + bb0), 0.f) & 0xffffu); hid[row * 264 + col0 + 16] = (bf16_t)(cvtpk(gelu_tanh(c1[j] + bb1), 0.f) & 0xffffu); } }
        LBAR();
        if (wave < 4) {
            const bf16_t* bp = W2t + (size_t)kv * 64 * 256 + (size_t)(16 * wave + arow) * 256 + kq * 8; f32x4 c = {0.f, 0.f, 0.f, 0.f};
#pragma unroll
            for (int ks = 0; ks < 8; ++ks) { const bf16x8 av = *(const LAS bf16x8*)(hid + arow * 264 + kq * 8 + ks * 32), bv = *(const bf16x8*)(bp + ks * 32); c = __builtin_amdgcn_mfma_f32_16x16x32_bf16(av, bv, c, 0, 0, 0); }
            const int col = 16 * wave + arow; const float bb = cb2[kv * 64 + col];
#pragma unroll
            for (int j = 0; j < 4; ++j) { const int n = 16 * nt + kq * 4 + j; KC[((size_t)(kv * 4 + bgi) * 512 + n) * 64 + col] = n < 511 ? (bf16_t)(cvtpk(c[j] + bb, 0.f) & 0xffffu) : (bf16_t)0; }
        }
        LBAR();
    }
    const int gt = blockIdx.x * 512 + tid, NGT = G * 512;
    { const bf16_t* MoK = (const bf16_t*)(ws + WS_MO) + att::MO_STRIDE; bf16_t* KM = (bf16_t*)(ws + WS_KM);
      for (int e = gt; e < 8 * 32 * 64; e += NGT) { const int d = e & 63, blk = e >> 6; const bf16_t* p = MoK + (size_t)blk * 256 * 64 + d; float s = 0.f;
#pragma unroll 8
          for (int r = 0; r < 256; ++r) s += __uint_as_float((unsigned)p[(size_t)r * 64] << 16);
          KM[e] = (bf16_t)(cvtpk(s * (1.0f / 256.0f), 0.f) & 0xffffu); } }
    { const bf16_t* U = (const bf16_t*)(ws + WS_U); bf16_t* Abr = (bf16_t*)(ws + WS_XB);
      for (int e = gt; e < MTOK * 32; e += NGT) { const int row = e >> 5, c8 = e & 31, s = row & (SEQ - 1), w = 2 << (c8 >> 3), cnt = (s + 1 < w) ? s + 1 : w;
          float acc[8] = {0.f, 0.f, 0.f, 0.f, 0.f, 0.f, 0.f, 0.f}; u32x4 v0 = {0u, 0u, 0u, 0u};
          for (int i = 0; i < cnt; ++i) { const u32x4 v = *(const u32x4*)(U + (size_t)(row - i) * 256 + c8 * 8); if (i == 0) v0 = v;
#pragma unroll
              for (int q = 0; q < 4; ++q) { acc[2 * q] += bflo(v[q]); acc[2 * q + 1] += bfhi(v[q]); } }
          const float ic = 1.0f / (float)cnt; u32x4 o;
#pragma unroll
          for (int q = 0; q < 4; ++q) o[q] = cvtpk(acc[2 * q] * ic - bflo(v0[q]), acc[2 * q + 1] * ic - bfhi(v0[q]));
          *(u32x4*)(Abr + (size_t)row * DM + c8 * 8) = o; } }
}
#ifndef DUP
#define DUP 0
#endif
__global__ void __launch_bounds__(512, 2) fwd_megakernel(Args a) {
    extern __shared__ __attribute__((aligned(16))) unsigned char lds_raw[];
    LAS unsigned char* lds = (LAS unsigned char*)lds_raw;
    cg::grid_group grid = cg::this_grid();
    const int G = gridDim.x;
    volatile LAS unsigned* bst = (volatile LAS unsigned*)(lds + LDS_BYTES - 64);
    if (threadIdx.x < 16) bst[threadIdx.x] = 0u;
    __syncthreads();
    const ArgsP ap0 = (ArgsP)__builtin_amdgcn_kernarg_segment_ptr();
#define PHASE_ARGS ArgsP a_ = ap0; asm volatile("" : "+s"(a_)); unsigned char* ws = a_->ws; unsigned* ctl = (unsigned*)(ws + WS_CTL); float* ssp = (float*)(ws + WS_SSP); const float* tab = (const float*)(ws + WS_TAB); \
    bf16_t* XB = (bf16_t*)(ws + WS_XB); bf16_t* BIG = (bf16_t*)(ws + WS_BIG); bf16_t* MRG = (bf16_t*)(ws + WS_MRG); (void)ctl; (void)ssp; (void)tab; (void)XB; (void)BIG; (void)MRG;
    XcdBarrier xbar = xcd_barrier_post((unsigned*)(ap0->ws + WS_BAR), bst);
    bool first_sync = true;
#define GRID_SYNC() do { if (first_sync) { grid.sync(); first_sync = false; } else xcd_barrier(xbar); } while (0)
    for (int l = 0; l < DEPTH; ++l) {
        int tid_ = threadIdx.x; asm volatile("" : "+v"(tid_));
        const int tid = tid_, lane = tid & 63, wave = __builtin_amdgcn_readfirstlane(tid >> 6), gw = blockIdx.x * 8 + wave, NGW = G * 8;
        for (int rep = 0; rep < ((DUP & 1) ? 2 : 1); ++rep) { PHASE_ARGS phase0(a_, l, lds, tid, lane, wave, gw, NGW); }
        GRID_SYNC();
        for (int rep = 0; rep < ((DUP & 2) ? 2 : 1); ++rep) { PHASE_ARGS pg8::Gemm g{XB, (const bf16_t*)(ws + WS_W + OFF_WIN), MTOK, NIN, DM}; pg8::StaticOrder S; S.init(MTOK, NIN, G, (int)blockIdx.x);
          EpiInProj E{ssp, (const float*)(ws + WS_W + OFF_BIN), tab, (bf16_t*)(ws + WS_U), (bf16_t*)(ws + WS_QN), (bf16_t*)(ws + WS_KV), (bf16_t*)(ws + WS_MO), BIG, (bf16_t*)(ws + WS_GN)};
          pg8::gemm_phase(lds, g, S, E); }
        GRID_SYNC();
        for (int rep = 0; rep < ((DUP & 4) ? 2 : 1); ++rep) { PHASE_ARGS phase2(a_, lds, tid, lane, wave, G); }
        GRID_SYNC();
        for (int rep = 0; rep < ((DUP & 8) ? 2 : 1); ++rep) { PHASE_ARGS att::Ctx C; C.lds = (LAS char*)lds; C.wsf = (LAS float*)(lds + att::L_WSF) + wave * 64; C.otl = (LAS float*)(lds + att::L_OT) + wave * 2048 + lane; C.tid = tid; C.wid = wave; C.lane = lane; C.r32 = lane & 31; C.hi = lane >> 5;
          C.vbl = ((lane >> 4) & 1) * 32 + (lane & 3) * 8 + (4 * (lane >> 5) + ((lane & 15) >> 2)) * 64;
          att::Bufs B{(const bf16_t*)(ws + WS_QN), (const bf16_t*)(ws + WS_KV), (const bf16_t*)(ws + WS_MO), (const bf16_t*)(ws + WS_KC), (const bf16_t*)(ws + WS_KM), (const bf16_t*)(ws + WS_GN), XB};
          const int* order = (const int*)(ws + WS_ORDER); LAS int* slot = (LAS int*)(lds + att::L_END);
          for (;;) {
              LBAR();
              if (tid == 0) slot[0] = (int)atomicAdd(ctl + l + 2 * rep, 1u);
              LBAR();
              const int item = slot[0];
              if (item >= 768) break;
              const int id = order[item];
              if (id < 512) att::nsa_item(C, B, id >> 8, (id >> 7) & 1, id & 127);
              else { const int x = id - 512; att::moba_item(C, B, x >> 7, (x >> 5) & 3, x & 31); }
          } }
        GRID_SYNC();
        for (int rep = 0; rep < ((DUP & 16) ? 2 : 1); ++rep) { PHASE_ARGS pg8::Gemm g{XB, (const bf16_t*)(ws + WS_W + OFF_WBR), MTOK, DM, DM}; pg8::StaticOrder S; S.init(MTOK, DM, G, (int)blockIdx.x);
          EpiBranch E{BIG, MRG}; pg8::gemm_phase(lds, g, S, E); }
        GRID_SYNC();
        { PHASE_ARGS pg8::Gemm g{MRG, (const bf16_t*)(ws + WS_W + OFF_WOUT), MTOK, DM, DM}; pg8::StaticOrder S; S.init(MTOK, DM, G, (int)blockIdx.x);
          float* outp = a_->out; EpiResid E{l == 0 ? a_->in[0] : outp, outp, XB, ssp}; pg8::gemm_phase(lds, g, S, E); }
        GRID_SYNC();
        for (int rep = 0; rep < ((DUP & 64) ? 2 : 1); ++rep) { PHASE_ARGS pg8::Gemm g{XB, (const bf16_t*)(ws + WS_W + OFF_WGU), MTOK, NGU, DM}; pg8::StaticOrder S; S.init(MTOK, NGU, G, (int)blockIdx.x);
          EpiSwiGLU E{ssp, BIG}; pg8::gemm_phase(lds, g, S, E); }
        GRID_SYNC();
        { PHASE_ARGS pg8::Gemm g{BIG, (const bf16_t*)(ws + WS_W + OFF_WD), MTOK, DM, DFF}; pg8::StaticOrder S; S.init(MTOK, DM, G, (int)blockIdx.x);
          float* outp = a_->out; EpiResid E{outp, outp, XB, ssp}; pg8::gemm_phase(lds, g, S, E); }
        GRID_SYNC();
    }
    { PHASE_ARGS const float* fn = a_->in[19]; float* outp = a_->out; const int lane = threadIdx.x & 63, gw = blockIdx.x * 8 + (threadIdx.x >> 6), NGW = G * 8;
      for (int m = gw; m < MTOK; m += NGW) { const float rstd = row_rstd(ssp, m); f32x4* xr = (f32x4*)(outp + (size_t)m * DM) + lane; const f32x4* gr = (const f32x4*)fn + lane;
#pragma unroll
          for (int j = 0; j < 4; ++j) xr[64 * j] = xr[64 * j] * rstd * gr[64 * j]; } }
}

extern "C" void kernel_launch(void* const* d_in, const int* in_sizes, int n_in, void* d_out, int out_size, void* d_ws, size_t ws_size, hipStream_t stream) {
    static int grid = 0;
    if (grid == 0) {
        if (n_in != 20 || in_sizes[0] != MTOK * DM || out_size != MTOK * DM || ws_size < WS_END) { fprintf(stderr, "kernel_launch: unexpected shapes / workspace (n_in %d, ws %zu)\n", n_in, ws_size); grid = -1; return; }
        int dev = 0, cus = 0, per_cu = 0;
        if (hipGetDevice(&dev) != hipSuccess || hipDeviceGetAttribute(&cus, hipDeviceAttributeMultiprocessorCount, dev) != hipSuccess) { grid = -1; return; }
        if (hipFuncSetAttribute((const void*)fwd_megakernel, hipFuncAttributeMaxDynamicSharedMemorySize, LDS_BYTES) != hipSuccess) { fprintf(stderr, "kernel_launch: hipFuncSetAttribute failed\n"); grid = -1; return; }
        if (hipOccupancyMaxActiveBlocksPerMultiprocessor(&per_cu, (const void*)fwd_megakernel, 512, LDS_BYTES) != hipSuccess || per_cu < 1) { fprintf(stderr, "kernel_launch: occupancy query failed (%d)\n", per_cu); (void)hipGetLastError(); grid = -1; return; }
        grid = cus * per_cu;
    }
    if (grid < 0) return;
    if (hipMemsetAsync((char*)d_ws + WS_CTL, 0, 32768, stream) != hipSuccess) { fprintf(stderr, "kernel_launch: memset failed\n"); return; }
    Args a{};
    for (int i = 0; i < 20; ++i) a.in[i] = (const float*)d_in[i];
    a.out = (float*)d_out; a.ws = (unsigned char*)d_ws;
    void* args[] = {&a};
    const hipError_t e = hipLaunchCooperativeKernel((const void*)fwd_megakernel, dim3(grid), dim3(512), args, LDS_BYTES, stream);
    if (e != hipSuccess) fprintf(stderr, "kernel_launch: cooperative launch failed: %s (grid %d)\n", hipGetErrorString(e), grid);
}
```

```cpp
#include <hip/hip_runtime.h>
#include <hip/hip_cooperative_groups.h>
#include <cstdio>
#include <cstdint>
#include <cmath>
namespace cg = cooperative_groups;

#define LAS __attribute__((address_space(3)))
typedef unsigned short bf16_t;
typedef short bf16x8 __attribute__((ext_vector_type(8)));
typedef short s16x4 __attribute__((ext_vector_type(4)));
typedef float f32x2 __attribute__((ext_vector_type(2)));
typedef float f32x4 __attribute__((ext_vector_type(4)));
typedef float f32x16 __attribute__((ext_vector_type(16)));
typedef unsigned u32x4 __attribute__((ext_vector_type(4)));
typedef unsigned u32x2 __attribute__((ext_vector_type(2)));
typedef __bf16 bf16x2_t __attribute__((ext_vector_type(2)));

constexpr int SEQ = 8192, BATCH = 2, MTOK = BATCH * SEQ, DM = 1024, DEPTH = 2;
constexpr int IN_COLS = 5400, NIN = 5632, DFF = 2816, NGU = 5632;
constexpr float RMS_EPS = 1e-6f;
constexpr float QSCALE = 0.125f * 1.4426950408889634f;

__device__ __forceinline__ unsigned cvtpk(float lo, float hi) { f32x2 v = {lo, hi}; bf16x2_t b = __builtin_convertvector(v, bf16x2_t); return __builtin_bit_cast(unsigned, b); }
__device__ __forceinline__ float bflo(unsigned w) { return __uint_as_float(w << 16); }
__device__ __forceinline__ float bfhi(unsigned w) { return __uint_as_float(w & 0xffff0000u); }
__device__ __forceinline__ float sigmoidf_(float x) { return __builtin_amdgcn_rcpf(1.f + __expf(-x)); }

namespace pg8 {
constexpr int BM = 256, BK = 64, HALF = 128, HTB = HALF * BK * 2, STAGE_BYTES = 8 * HTB, NXCD = 8, WGM = 8;
__host__ __device__ __forceinline__ int lds_byte(int r, int c) { const int st = (r >> 4) * 2 + (c >> 5), rr = r & 15, cc = c & 31, ob = rr * 64 + cc * 2; return st * 1024 + (ob ^ (((ob >> 9) & 1) << 5)); }
__host__ __device__ __forceinline__ void stage_rc(int b, int& R, int& C) { const int st = b / 1024, sb = b % 1024, swz = sb ^ (((sb >> 9) & 1) << 5); R = (st >> 1) * 16 + swz / 64; C = (st & 1) * 32 + (swz % 64) / 2; }
__host__ __device__ __forceinline__ int perm32(int rho) { const int n = rho >> 4, i = rho & 15; return 8 * (i >> 2) + 4 * n + (i & 3); }
struct Unit { int pm, pn; };
struct Gemm { const bf16_t* A; const bf16_t* Bt; int M, N, K; };
struct StaticOrder {
    int nM, nN, nwg, G, c;
    __host__ __device__ void init(int M, int N, int G_, int c_) { nM = M / BM; nN = N / BM; nwg = nM * nN; G = G_; c = c_; }
    __host__ __device__ bool next(int i, Unit& u) const {
        const long L = (long)i * G + c; if (L >= nwg) return false;
        int wgid = (int)L; { const int q = nwg / NXCD, r = nwg % NXCD, xcd = wgid % NXCD, off = wgid / NXCD; wgid = (xcd < r ? xcd * (q + 1) : r * (q + 1) + (xcd - r) * q) + off; }
        const int nig = WGM * nN, gid = wgid / nig, fm = gid * WGM, gsz = (nM - fm) < WGM ? (nM - fm) : WGM;
        u.pm = fm + ((wgid % nig) % gsz); u.pn = (wgid % nig) / gsz; return true;
    }
};
template <class Epi, class Sched>
__device__ __forceinline__ void gemm_phase(LAS unsigned char* lds, const Gemm g, const Sched& S, const Epi& E) {
    int tid_ = threadIdx.x; asm volatile("" : "+v"(tid_));
    const int tid = tid_, wid = __builtin_amdgcn_readfirstlane(tid >> 6), lane = tid & 63, wr = wid >> 2, wc = wid & 3, fr = lane & 15, fq = lane >> 4;
    const int K = g.K, nt = K / BK;
    unsigned voffA[2], voffB[2];
#pragma unroll
    for (int i = 0; i < 2; ++i) { int R, C; stage_rc(tid * 16 + i * 8192, R, C); const int Rb = ((R & ~31) + perm32(R & 31));
        voffA[i] = (unsigned)(R * K + C) * 2u; voffB[i] = (unsigned)(Rb * K + C) * 2u; }
    const size_t kstep = (size_t)(BK * 2);
    const size_t hstep = (size_t)HALF * K * 2;
    const size_t tstep = 2 * hstep;
    const unsigned ldsw = (unsigned)wid * 1024u;
    const int aoff = lds_byte(wr * 64 + fr, fq * 8), boff = lds_byte(wc * 32 + fr, fq * 8);
#define PG8_SA(b, h) (((b) * 2 + (h)) * HTB)
#define PG8_SB(b, h) ((4 + (b) * 2 + (h)) * HTB)
#define PG8_STAGE(bufoff, gbase, voff) do { _Pragma("unroll") for (int _i = 0; _i < 2; ++_i) \
        __builtin_amdgcn_global_load_lds((const unsigned*)((const char*)(gbase) + (voff)[_i]), (LAS unsigned*)(lds + (bufoff) + ldsw + _i * 8192), 16, 0, 0); } while (0)
#define PG8_LDA(dst, b, h) do { _Pragma("unroll") for (int m = 0; m < 4; ++m) _Pragma("unroll") for (int k = 0; k < 2; ++k) dst[m][k] = *(const LAS bf16x8*)(lds + PG8_SA(b, h) + aoff + m * 2048 + k * 1024); } while (0)
#define PG8_LDB(dst, b, h) do { _Pragma("unroll") for (int n = 0; n < 2; ++n) _Pragma("unroll") for (int k = 0; k < 2; ++k) dst[n][k] = *(const LAS bf16x8*)(lds + PG8_SB(b, h) + boff + n * 2048 + k * 1024); } while (0)
#define PG8_MMA(ai, bj, At, Bt) do { __builtin_amdgcn_s_setprio(1); _Pragma("unroll") for (int m = 0; m < 4; ++m) _Pragma("unroll") for (int n = 0; n < 2; ++n) _Pragma("unroll") for (int k = 0; k < 2; ++k) \
        acc[ai][bj][m][n] = __builtin_amdgcn_mfma_f32_16x16x32_bf16(Bt[n][k], At[m][k], acc[ai][bj][m][n], 0, 0, 0); __builtin_amdgcn_s_setprio(0); } while (0)
#define PG8_WAIT_V(n) asm volatile("s_waitcnt vmcnt(" #n ")" ::: "memory")
#define PG8_WAIT_L(n) asm volatile("s_waitcnt lgkmcnt(" #n ")" ::: "memory")
#define PG8_BAR __builtin_amdgcn_s_barrier()
#define PG8_SCHED __builtin_amdgcn_sched_barrier(0)
    Unit cur, nxt; int ui = 0;
    if (!S.next(0, cur)) return;
    f32x4 acc[2][2][4][2];
#pragma unroll
    for (int a = 0; a < 2; ++a)
#pragma unroll
        for (int b = 0; b < 2; ++b)
#pragma unroll
            for (int m = 0; m < 4; ++m)
#pragma unroll
                for (int n = 0; n < 2; ++n) acc[a][b][m][n] = (f32x4){0.f, 0.f, 0.f, 0.f};
    bf16x8 At[4][2], B0[2][2], B1[2][2];
    const char* cA = (const char*)g.A + (size_t)cur.pm * tstep; const char* cB = (const char*)g.Bt + (size_t)cur.pn * tstep;
    PG8_STAGE(PG8_SB(0, 0), cB, voffB); PG8_STAGE(PG8_SB(0, 1), cB + hstep, voffB); PG8_STAGE(PG8_SA(0, 0), cA, voffA); PG8_STAGE(PG8_SA(0, 1), cA + hstep, voffA);
    if (wr == 1) PG8_BAR;
    PG8_WAIT_V(2); PG8_BAR;
    PG8_STAGE(PG8_SB(1, 0), cB + kstep, voffB); PG8_STAGE(PG8_SA(1, 0), cA + kstep, voffA); PG8_STAGE(PG8_SB(1, 1), cB + hstep + kstep, voffB);
    PG8_WAIT_V(6); PG8_BAR;
    for (;;) {
        const bool has_next = S.next(ui + 1, nxt);
        const char* nA = has_next ? (const char*)g.A + (size_t)nxt.pm * tstep : cA; const char* nB = has_next ? (const char*)g.Bt + (size_t)nxt.pn * tstep : cB;
        for (int t = 0; t < nt; t += 2) {
            const bool last = (t == nt - 2);
            const char* a1 = cA + (size_t)(t + 1) * kstep;
            const char* a2 = last ? nA : cA + (size_t)(t + 2) * kstep; const char* b2 = last ? nB : cB + (size_t)(t + 2) * kstep;
            const char* a3 = a2 + kstep; const char* b3 = b2 + kstep;
            if constexpr (Epi::KHOOK) { if (t == 4 || t == 12) { PG8_SCHED; E.khook(acc, cur, t, wr, wc, fr, fq); PG8_SCHED; } }
            PG8_LDB(B0, 0, 0); PG8_LDB(B1, 0, 1); PG8_SCHED; PG8_LDA(At, 0, 0); PG8_STAGE(PG8_SA(1, 1), a1 + hstep, voffA);
            PG8_WAIT_V(8); PG8_WAIT_L(0); PG8_BAR; PG8_MMA(0, 0, At, B0); PG8_MMA(0, 1, At, B1); PG8_BAR; PG8_SCHED;
            PG8_LDA(At, 0, 1); PG8_STAGE(PG8_SB(0, 0), b2, voffB); PG8_STAGE(PG8_SB(0, 1), b2 + hstep, voffB); PG8_STAGE(PG8_SA(0, 0), a2, voffA);
            PG8_WAIT_V(8); PG8_WAIT_L(0); PG8_BAR; PG8_MMA(1, 0, At, B0); PG8_MMA(1, 1, At, B1); PG8_BAR; PG8_SCHED;
            PG8_LDB(B0, 1, 0); PG8_LDB(B1, 1, 1); PG8_SCHED; PG8_LDA(At, 1, 0); PG8_STAGE(PG8_SA(0, 1), a2 + hstep, voffA);
            PG8_WAIT_V(8); PG8_WAIT_L(0); PG8_BAR; PG8_MMA(0, 0, At, B0); PG8_MMA(0, 1, At, B1); PG8_BAR; PG8_SCHED;
            PG8_LDA(At, 1, 1); PG8_STAGE(PG8_SB(1, 0), b3, voffB); PG8_STAGE(PG8_SB(1, 1), b3 + hstep, voffB); PG8_STAGE(PG8_SA(1, 0), a3, voffA);
            PG8_WAIT_V(8); PG8_WAIT_L(0); PG8_BAR; PG8_MMA(1, 0, At, B0); PG8_MMA(1, 1, At, B1); PG8_BAR; PG8_SCHED;
        }
        if (wr == 0) PG8_BAR;
        E(acc, cur, wr, wc, fr, fq);
        if (!has_next) break;
#pragma unroll
        for (int a = 0; a < 2; ++a)
#pragma unroll
            for (int b = 0; b < 2; ++b)
#pragma unroll
                for (int m = 0; m < 4; ++m)
#pragma unroll
                    for (int n = 0; n < 2; ++n) acc[a][b][m][n] = (f32x4){0.f, 0.f, 0.f, 0.f};
        cur = nxt; cA = nA; cB = nB; ++ui;
        if (wr == 1) PG8_BAR;
    }
    PG8_WAIT_V(0);
    PG8_BAR;
#undef PG8_SA
#undef PG8_SB
#undef PG8_STAGE
#undef PG8_LDA
#undef PG8_LDB
#undef PG8_MMA
#undef PG8_WAIT_V
#undef PG8_WAIT_L
#undef PG8_BAR
#undef PG8_SCHED
}
}
using pg8::Unit;
__device__ __forceinline__ float row_rstd(const float* ssp, int row) {
    const f32x4* p = (const f32x4*)(ssp + (size_t)row * 16);
    const f32x4 a = p[0], b = p[1], c = p[2], d = p[3];
    const float ss = ((a[0] + a[1]) + (a[2] + a[3])) + ((b[0] + b[1]) + (b[2] + b[3])) + ((c[0] + c[1]) + (c[2] + c[3])) + ((d[0] + d[1]) + (d[2] + d[3]));
    return 1.0f / sqrtf(ss * (1.0f / DM) + RMS_EPS);
}
__device__ __forceinline__ u32x4 pack8(const f32x4 a, const f32x4 b) { u32x4 w; w.x = cvtpk(a[0], a[1]); w.y = cvtpk(a[2], a[3]); w.z = cvtpk(b[0], b[1]); w.w = cvtpk(b[2], b[3]); return w; }
__device__ __forceinline__ void rope8(f32x4& v0, f32x4& v1, const float* tab, int t, int pos, float sc) {
    const f32x4* cs = (const f32x4*)(tab + ((size_t)t * 32 + (pos >> 1)) * 2);
    const f32x4 c0 = cs[0], c1 = cs[1];
    f32x4 o0, o1;
    o0[0] = (v0[0] * c0[0] - v0[1] * c0[1]) * sc; o0[1] = (v0[1] * c0[0] + v0[0] * c0[1]) * sc;
    o0[2] = (v0[2] * c0[2] - v0[3] * c0[3]) * sc; o0[3] = (v0[3] * c0[2] + v0[2] * c0[3]) * sc;
    o1[0] = (v1[0] * c1[0] - v1[1] * c1[1]) * sc; o1[1] = (v1[1] * c1[0] + v1[0] * c1[1]) * sc;
    o1[2] = (v1[2] * c1[2] - v1[3] * c1[3]) * sc; o1[3] = (v1[3] * c1[2] + v1[2] * c1[3]) * sc;
    v0 = o0; v1 = o1;
}
struct EpiInProj {
    static constexpr bool KHOOK = false;
    const float* ssp; const float* bias; const float* tab;
    bf16_t *U, *Qn, *KV, *Mo, *G, *Gn;
    __device__ __forceinline__ void operator()(const f32x4 (&acc)[2][2][4][2], const Unit& u, int wr, int wc, int fr, int fq) const {
        asm volatile("" : "+v"(fr), "+v"(fq));
        const int pn = u.pn;
#pragma unroll
        for (int ai = 0; ai < 2; ++ai)
#pragma unroll
            for (int m = 0; m < 4; ++m) {
                const int row = u.pm * 256 + ai * 128 + wr * 64 + m * 16 + fr;
                const float rstd = row_rstd(ssp, row);
                const int t = row & (SEQ - 1), b = row >> 13;
#pragma unroll
                for (int bj = 0; bj < 2; ++bj) {
                    const int cit = bj * 128 + wc * 32 + 8 * fq, gc = pn * 256 + cit;
                    f32x4 v0 = acc[ai][bj][m][0] * rstd + *(const f32x4*)(bias + gc), v1 = acc[ai][bj][m][1] * rstd + *(const f32x4*)(bias + gc + 4);
                    bf16_t* dst;
                    if (pn == 0) { dst = U + (size_t)row * 256 + cit; }
                    else if (pn <= 2) { const int c2 = (pn - 1) * 256 + cit, head = c2 >> 6, pos = c2 & 63; rope8(v0, v1, tab, t, pos, QSCALE); dst = Qn + ((size_t)(b * 8 + head) * SEQ + t) * 64 + pos; }
                    else if (pn <= 5) { const int c2 = cit & 127, g = c2 >> 6, pos = c2 & 63, kvi = 2 * (pn - 3) + bj; if (bj == 0) rope8(v0, v1, tab, t, pos, 1.f);
                        dst = KV + (size_t)kvi * ((size_t)MTOK * 128) + ((size_t)(b * 2 + g) * SEQ + t) * 64 + pos; }
                    else if (pn <= 8) { const int h = cit >> 6, pos = cit & 63; if (pn < 8) rope8(v0, v1, tab, t, pos, pn == 6 ? QSCALE : 1.f);
                        dst = Mo + (size_t)(pn - 6) * ((size_t)MTOK * 256) + ((size_t)(b * 4 + h) * SEQ + t) * 64 + pos; }
                    else if (pn <= 20) {
#pragma unroll
                        for (int e = 0; e < 4; ++e) { v0[e] = sigmoidf_(v0[e]); v1[e] = sigmoidf_(v1[e]); }
                        dst = G + (size_t)row * 3072 + (pn - 9) * 256 + cit; }
                    else {
#pragma unroll
                        for (int e = 0; e < 4; ++e) { v0[e] = sigmoidf_(v0[e]); v1[e] = sigmoidf_(v1[e]); }
                        dst = Gn + (size_t)row * 32 + (cit & 31); if (cit >= 32) dst = nullptr; }
                    if (dst) *(u32x4*)dst = pack8(v0, v1);
                }
                asm volatile("" ::: "memory");
            }
    }
};
struct EpiBranch {
    static constexpr bool KHOOK = true;
    const bf16_t* G; bf16_t* out;
    __device__ __forceinline__ void khook(f32x4 (&acc)[2][2][4][2], const Unit& u, int t, int wr, int wc, int fr, int fq) const {
        asm volatile("" : "+v"(fr), "+v"(fq));
        const int gsel = (t == 4) ? 0 : 1024;
#pragma unroll
        for (int ai = 0; ai < 2; ++ai)
#pragma unroll
            for (int m = 0; m < 4; ++m) {
                const int row = u.pm * 256 + ai * 128 + wr * 64 + m * 16 + fr;
#pragma unroll
                for (int bj = 0; bj < 2; ++bj) {
                    const int col = u.pn * 256 + bj * 128 + wc * 32 + 8 * fq;
                    const u32x4 gx = *(const u32x4*)(G + (size_t)row * 3072 + gsel + col), gy = *(const u32x4*)(G + (size_t)row * 3072 + gsel + 1024 + col);
#pragma unroll
                    for (int e = 0; e < 4; ++e) {
                        const float x0 = fmaxf(bflo(gx[e]), 1e-20f), x1 = fmaxf(bfhi(gx[e]), 1e-20f), y0 = fmaxf(bflo(gy[e]), 1e-20f), y1 = fmaxf(bfhi(gy[e]), 1e-20f);
                        const float r0 = x0 * __builtin_amdgcn_rcpf(y0), r1 = x1 * __builtin_amdgcn_rcpf(y1);
                        acc[ai][bj][m][e >> 1][(e & 1) * 2] *= r0; acc[ai][bj][m][e >> 1][(e & 1) * 2 + 1] *= r1;
                    }
                    asm volatile("" ::: "memory");
                }
            }
    }
    __device__ __forceinline__ void operator()(const f32x4 (&acc)[2][2][4][2], const Unit& u, int wr, int wc, int fr, int fq) const {
        asm volatile("" : "+v"(fr), "+v"(fq));
#pragma unroll
        for (int ai = 0; ai < 2; ++ai)
#pragma unroll
            for (int m = 0; m < 4; ++m) {
                const int row = u.pm * 256 + ai * 128 + wr * 64 + m * 16 + fr;
#pragma unroll
                for (int bj = 0; bj < 2; ++bj) {
                    const int col = u.pn * 256 + bj * 128 + wc * 32 + 8 * fq;
                    const u32x4 gz = *(const u32x4*)(G + (size_t)row * 3072 + 2048 + col);
                    f32x4 v0 = acc[ai][bj][m][0], v1 = acc[ai][bj][m][1];
                    v0[0] *= fmaxf(bflo(gz[0]), 1e-20f); v0[1] *= fmaxf(bfhi(gz[0]), 1e-20f); v0[2] *= fmaxf(bflo(gz[1]), 1e-20f); v0[3] *= fmaxf(bfhi(gz[1]), 1e-20f);
                    v1[0] *= fmaxf(bflo(gz[2]), 1e-20f); v1[1] *= fmaxf(bfhi(gz[2]), 1e-20f); v1[2] *= fmaxf(bflo(gz[3]), 1e-20f); v1[3] *= fmaxf(bfhi(gz[3]), 1e-20f);
                    *(u32x4*)(out + (size_t)row * DM + col) = pack8(v0, v1);
                }
                asm volatile("" ::: "memory");
            }
    }
};
struct EpiResid {
    static constexpr bool KHOOK = false;
    const float* base; float* out; bf16_t* xb; float* ssp;
    __device__ __forceinline__ void operator()(const f32x4 (&acc)[2][2][4][2], const Unit& u, int wr, int wc, int fr, int fq) const {
        asm volatile("" : "+v"(fr), "+v"(fq));
#pragma unroll
        for (int ai = 0; ai < 2; ++ai)
#pragma unroll
            for (int m = 0; m < 4; ++m) {
                const int row = u.pm * 256 + ai * 128 + wr * 64 + m * 16 + fr;
                float ss = 0.f;
#pragma unroll
                for (int bj = 0; bj < 2; ++bj) {
                    const size_t off = (size_t)row * DM + u.pn * 256 + bj * 128 + wc * 32 + 8 * fq;
                    const f32x4 v0 = acc[ai][bj][m][0] + *(const f32x4*)(base + off), v1 = acc[ai][bj][m][1] + *(const f32x4*)(base + off + 4);
                    *(f32x4*)(out + off) = v0; *(f32x4*)(out + off + 4) = v1;
                    *(u32x4*)(xb + off) = pack8(v0, v1);
                    ss += (v0[0] * v0[0] + v0[1] * v0[1]) + (v0[2] * v0[2] + v0[3] * v0[3]) + (v1[0] * v1[0] + v1[1] * v1[1]) + (v1[2] * v1[2] + v1[3] * v1[3]);
                }
                ss += __shfl_xor(ss, 16); ss += __shfl_xor(ss, 32);
                if (fq == 0) ssp[(size_t)row * 16 + u.pn * 4 + wc] = ss;
                asm volatile("" ::: "memory");
            }
    }
};
struct EpiSwiGLU {
    static constexpr bool KHOOK = false;
    const float* ssp; bf16_t* H;
    __device__ __forceinline__ void operator()(const f32x4 (&acc)[2][2][4][2], const Unit& u, int wr, int wc, int fr, int fq) const {
        asm volatile("" : "+v"(fr), "+v"(fq));
#pragma unroll
        for (int ai = 0; ai < 2; ++ai)
#pragma unroll
            for (int m = 0; m < 4; ++m) {
                const int row = u.pm * 256 + ai * 128 + wr * 64 + m * 16 + fr;
                const float rstd = row_rstd(ssp, row);
                f32x4 o[2];
#pragma unroll
                for (int n = 0; n < 2; ++n)
#pragma unroll
                    for (int e = 0; e < 4; ++e) { const float gt = acc[ai][0][m][n][e] * rstd, up = acc[ai][1][m][n][e] * rstd; o[n][e] = gt * sigmoidf_(gt) * up; }
                *(u32x4*)(H + (size_t)row * DFF + u.pn * 128 + wc * 32 + 8 * fq) = pack8(o[0], o[1]);
                asm volatile("" ::: "memory");
            }
    }
};
#ifndef ABL_NSA_SCALE
#define ABL_NSA_SCALE
#endif
#ifndef ABL_MOBA_SCALE
#define ABL_MOBA_SCALE
#endif
namespace att {
constexpr int KCS = 1040, KSLOT = 8 * KCS, VSLOT = 8192;
constexpr int L_K0 = 0, L_K1 = KSLOT, L_V0 = 2 * KSLOT, L_V1 = 2 * KSLOT + VSLOT, L_WSF = 2 * KSLOT + 2 * VSLOT, L_PS = L_WSF + 8 * 256, L_MSK = L_PS + 64 * 128 * 4,
              L_UNI = L_MSK + 1024, L_LIST = L_UNI + 64, L_END = L_LIST + 512, L_OT = L_END + 64, L_TOTAL = L_OT + 8 * 8192;
#define LBAR() asm volatile("s_waitcnt lgkmcnt(0)\n\ts_barrier" ::: "memory")
#define LWAIT() asm volatile("s_waitcnt lgkmcnt(0)" ::: "memory")
__device__ __forceinline__ int crow(int r, int hi) { return (r & 3) + 8 * (r >> 2) + 4 * hi; }
__device__ __forceinline__ float swap_other(float v, int hi) { auto rr = __builtin_amdgcn_permlane32_swap(__float_as_uint(v), __float_as_uint(v), false, false); return __uint_as_float(hi ? rr[0] : rr[1]); }
__device__ __forceinline__ void qkt(f32x16& p0, f32x16& p1, const LAS char* Ks, const bf16x8* qr, int r32, int hi) {
    const LAS char* kb = Ks + hi * KCS + r32 * 16;
    p0 = f32x16{}; p1 = f32x16{};
#pragma unroll
    for (int d0 = 0; d0 < 4; ++d0) {
        const bf16x8 b0 = *(const LAS bf16x8*)(kb + d0 * 2 * KCS), b1 = *(const LAS bf16x8*)(kb + d0 * 2 * KCS + 512);
        p0 = __builtin_amdgcn_mfma_f32_32x32x16_bf16(b0, qr[d0], p0, 0, 0, 0); p1 = __builtin_amdgcn_mfma_f32_32x32x16_bf16(b1, qr[d0], p1, 0, 0, 0); }
}
__device__ __forceinline__ void pv(f32x16* o, int vb, bf16x8 pa0, bf16x8 pa1, bf16x8 pa2, bf16x8 pa3) {
#pragma unroll
    for (int d0 = 0; d0 < 2; ++d0) { s16x4 lo[4], hi[4];
#pragma unroll
        for (int ks = 0; ks < 4; ++ks) {
            asm volatile("ds_read_b64_tr_b16 %0,%1 offset:%c2" : "=&v"(lo[ks]) : "v"(vb), "i"(d0 * 4096 + ks * 1024) : "memory");
            asm volatile("ds_read_b64_tr_b16 %0,%1 offset:%c2" : "=&v"(hi[ks]) : "v"(vb), "i"(d0 * 4096 + ks * 1024 + 512) : "memory"); }
        asm volatile("s_waitcnt lgkmcnt(0)" ::: "memory"); __builtin_amdgcn_sched_barrier(0);
#define PK(k) (bf16x8){lo[k][0], lo[k][1], lo[k][2], lo[k][3], hi[k][0], hi[k][1], hi[k][2], hi[k][3]}
        o[d0] = __builtin_amdgcn_mfma_f32_32x32x16_bf16(pa0, PK(0), o[d0], 0, 0, 0);
        o[d0] = __builtin_amdgcn_mfma_f32_32x32x16_bf16(pa1, PK(1), o[d0], 0, 0, 0);
        o[d0] = __builtin_amdgcn_mfma_f32_32x32x16_bf16(pa2, PK(2), o[d0], 0, 0, 0);
        o[d0] = __builtin_amdgcn_mfma_f32_32x32x16_bf16(pa3, PK(3), o[d0], 0, 0, 0);
#undef PK
    }
}
__device__ __forceinline__ float rowmax(const f32x16& p0, const f32x16& p1, int hi) {
    float a = __builtin_fmaxf(p0[0], p1[0]);
#pragma unroll
    for (int r = 1; r < 16; ++r) a = __builtin_fmaxf(__builtin_fmaxf(a, p0[r]), p1[r]);
    return __builtin_fmaxf(a, swap_other(a, hi));
}
struct KVRegs { u32x4 k, v; };
__device__ __forceinline__ void tile_load(KVRegs& R, const bf16_t* K, const bf16_t* V, int tid) { R.k = *(const u32x4*)(K + tid * 8); R.v = *(const u32x4*)(V + tid * 8); }
__device__ __forceinline__ void tile_store(const KVRegs& R, LAS char* Ks, LAS char* Vs, int tid) {
    const int row = tid >> 3, c = tid & 7;
    *(LAS u32x4*)(Ks + c * KCS + row * 16) = R.k;
    *(LAS u32x4*)(Vs + (c >> 2) * 4096 + (row >> 4) * 1024 + (row & 15) * 64 + (c & 3) * 16) = R.v;
}
__device__ __forceinline__ void ps_accum(const f32x16 p, int jb, LAS float* ps_row, bool writer) {
#pragma unroll
    for (int rg = 0; rg < 4; ++rg) {
        float a = 2.f * (p[4 * rg] + p[4 * rg + 1] + p[4 * rg + 2]) + p[4 * rg + 3], bq = p[4 * rg + 3];
        a += __shfl_xor(a, 1); a += __shfl_xor(a, 2); bq += __shfl_xor(bq, 1); bq += __shfl_xor(bq, 2);
        const int j = jb + 2 * rg;
        if (writer) { __hip_atomic_fetch_add(ps_row + j, a, __ATOMIC_RELAXED, __HIP_MEMORY_SCOPE_WORKGROUP); if (j + 1 < 128) __hip_atomic_fetch_add(ps_row + j + 1, bq, __ATOMIC_RELAXED, __HIP_MEMORY_SCOPE_WORKGROUP); }
    }
}
struct Ctx { LAS char* lds; LAS float* wsf; LAS float* otl; int tid, wid, lane, r32, hi, vbl; };
template <int MODE, class Src, class Msk>
__device__ __forceinline__ void run_branch(const Ctx& C, int nt, const Src& src, const Msk& msk, const bf16x8* qr, float& m, float& l, f32x16* o, float invl, LAS float* ps_row, bool ps_writer) {
    if (nt <= 0) return;
    KVRegs R; const bf16_t *kp, *vp;
    src(0, kp, vp); tile_load(R, kp, vp, C.tid);
    LBAR();
    for (int it = 0; it < nt; ++it) {
        LAS char* Ks = C.lds + ((it & 1) ? L_K1 : L_K0); LAS char* Vs = C.lds + ((it & 1) ? L_V1 : L_V0);
        tile_store(R, Ks, Vs, C.tid);
        if (it + 1 < nt) { src(it + 1, kp, vp); tile_load(R, kp, vp, C.tid); }
        LBAR();
        int klo, khi; const bool nm = msk(it, klo, khi);
        const bool kill = khi < klo;
        if (!__any(!kill)) continue;
        f32x16 p0, p1; qkt(p0, p1, Ks, qr, C.r32, C.hi);
        if (__any(nm && !kill)) {
#pragma unroll
            for (int r = 0; r < 16; ++r) { const int kv = crow(r, C.hi); if (kv < klo || kv > khi) p0[r] = -INFINITY; if (kv + 32 < klo || kv + 32 > khi) p1[r] = -INFINITY; }
        }
        if constexpr (MODE == 2) {
            const float sub = kill ? INFINITY : m;
#pragma unroll
            for (int r = 0; r < 16; ++r) { p0[r] = __builtin_amdgcn_exp2f(p0[r] - sub) * invl; p1[r] = __builtin_amdgcn_exp2f(p1[r] - sub) * invl; }
            ps_accum(p0, 16 * it + C.hi, ps_row, ps_writer); ps_accum(p1, 16 * it + 8 + C.hi, ps_row, ps_writer);
        } else {
            float rm = rowmax(p0, p1, C.hi); if (kill) rm = -INFINITY;
            const bool grow = rm > m + 8.0f;
            if (__any(grow)) {
                const float mn = grow ? rm : m, alpha = __builtin_amdgcn_exp2f(m - mn);
                l *= alpha; m = mn;
                if constexpr (MODE == 1) {
                    if (C.hi == 0) C.wsf[C.r32] = alpha;
                    LWAIT();
#pragma unroll
                    for (int r = 0; r < 16; ++r) { const float f = C.wsf[crow(r, C.hi)]; o[0][r] *= f; o[1][r] *= f; }
                    LWAIT();
                }
            }
            const float sub = kill ? INFINITY : m;
            float s = 0.f;
#pragma unroll
            for (int r = 0; r < 16; ++r) { p0[r] = __builtin_amdgcn_exp2f(p0[r] - sub); p1[r] = __builtin_amdgcn_exp2f(p1[r] - sub); s += p0[r] + p1[r]; }
            l += s;
        }
        if constexpr (MODE != 0) {
            u32x4 w0 = {cvtpk(p0[0], p0[1]), cvtpk(p0[2], p0[3]), cvtpk(p0[4], p0[5]), cvtpk(p0[6], p0[7])}, w1 = {cvtpk(p0[8], p0[9]), cvtpk(p0[10], p0[11]), cvtpk(p0[12], p0[13]), cvtpk(p0[14], p0[15])};
            u32x4 w2 = {cvtpk(p1[0], p1[1]), cvtpk(p1[2], p1[3]), cvtpk(p1[4], p1[5]), cvtpk(p1[6], p1[7])}, w3 = {cvtpk(p1[8], p1[9]), cvtpk(p1[10], p1[11]), cvtpk(p1[12], p1[13]), cvtpk(p1[14], p1[15])};
            pv(o, (int)(unsigned)(uintptr_t)Vs + C.vbl, __builtin_bit_cast(bf16x8, w0), __builtin_bit_cast(bf16x8, w1), __builtin_bit_cast(bf16x8, w2), __builtin_bit_cast(bf16x8, w3));
        }
    }
}
template <bool FIRST> __device__ __forceinline__ void merge_branch(const Ctx& C, const f32x16* o, float factor) {
    if (C.hi == 0) C.wsf[C.r32] = factor;
    LWAIT();
#pragma unroll
    for (int r = 0; r < 16; ++r) { const float f = C.wsf[crow(r, C.hi)];
        if (FIRST) { C.otl[r * 64] = o[0][r] * f; C.otl[(16 + r) * 64] = o[1][r] * f; }
        else { C.otl[r * 64] += o[0][r] * f; C.otl[(16 + r) * 64] += o[1][r] * f; } }
    LWAIT();
}
struct Bufs { const bf16_t *Qn, *KV, *Mo, *KC, *KM, *Gn; bf16_t* Abr; };
constexpr size_t KV_STRIDE = (size_t)MTOK * 128, MO_STRIDE = (size_t)MTOK * 256;

__device__ __forceinline__ void nsa_item(const Ctx& C, const Bufs& B, int b, int g, int i) {
    const int r32 = C.r32, hi = C.hi, wid = C.wid;
    const int qi = 8 * wid + (r32 >> 2), hh = r32 & 3, head = g * 4 + hh, t = 64 * i + qi, cur = i;
    const size_t bg = (size_t)(b * 2 + g) * SEQ;
    bf16x8 qr[4];
    { const bf16_t* qp = B.Qn + ((size_t)(b * 8 + head) * SEQ + t) * 64 + hi * 8;
#pragma unroll
      for (int d0 = 0; d0 < 4; ++d0) qr[d0] = *(const bf16x8*)(qp + d0 * 16); }
    const unsigned gw = *(const unsigned*)(B.Gn + ((size_t)b * SEQ + t) * 32 + head * 3 - (head & 1));
    const unsigned gw2 = *(const unsigned*)(B.Gn + ((size_t)b * SEQ + t) * 32 + head * 3 - (head & 1) + 2);
    float g0, g1, g2; if (head & 1) { g0 = bfhi(gw); g1 = bflo(gw2); g2 = bfhi(gw2); } else { g0 = bflo(gw); g1 = bfhi(gw); g2 = bflo(gw2); }
    f32x16 o[2];
    LAS float* Ps = (LAS float*)(C.lds + L_PS); LAS unsigned* Mk = (LAS unsigned*)(C.lds + L_MSK); LAS unsigned* Uni = (LAS unsigned*)(C.lds + L_UNI); LAS int* List = (LAS int*)(C.lds + L_LIST);
    const int nv = t >= 31 ? ((t - 31) >> 4) + 1 : 0;
    const int nvt = (4 * i + 3 < 511) ? 4 * i + 3 : 511, ntc = (nvt + 63) >> 6;
    const bf16_t* kc = B.KC + (size_t)(0 * 4 + b * 2 + g) * 512 * 64; const bf16_t* vc = B.KC + (size_t)(1 * 4 + b * 2 + g) * 512 * 64;
    auto srcC = [&](int it, const bf16_t*& kp, const bf16_t*& vp) { kp = kc + (size_t)it * 4096; vp = vc + (size_t)it * 4096; };
    auto mskC = [&](int it, int& klo, int& khi) { klo = 0; khi = nv - 1 - 64 * it; return khi < 63; };
    float m = -1e30f, l = 0.f;
    run_branch<0>(C, ntc, srcC, mskC, qr, m, l, o, 0.f, nullptr, false);
    l += swap_other(l, hi);
    const float invl = l > 0.f ? 1.0f / l : 0.f;
    for (int e = C.tid; e < 64 * 128; e += 512) Ps[e] = 0.f;
    if (C.tid < 8) Uni[C.tid] = 0u;
    o[0] = f32x16{}; o[1] = f32x16{};
    run_branch<2>(C, ntc, srcC, mskC, qr, m, l, o, invl, Ps + qi * 128, hh == 0);
    merge_branch<true>(C, o, g0);
    LBAR();
    {
        const int nf = cur == 0 ? 1 : (cur == 1 ? 2 : 3), kp_ = 16 - nf, lane = C.lane;
        for (int qq = 0; qq < 8; ++qq) {
            const int q = 8 * wid + qq; LAS float* ps = Ps + q * 128;
            const int j0 = lane, j1 = lane + 64;
            const bool f0 = (j0 == 0 || j0 == cur || j0 == cur - 1) && j0 <= cur, f1 = (j1 == cur || j1 == cur - 1) && j1 <= cur;
            const bool va0 = j0 <= cur && !f0, va1 = j1 <= cur && !f1;
            const float v0 = va0 ? ps[j0] : -1.f, v1 = va1 ? ps[j1] : -1.f;
            int r0 = 0, r1 = 0;
            for (int e = 1; e <= cur; ++e) {
                float ve = ps[e]; if (e == cur || e == cur - 1) ve = -2.f;
                r0 += (ve > v0 || (ve == v0 && e < j0)) ? 1 : 0; r1 += (ve > v1 || (ve == v1 && e < j1)) ? 1 : 0;
            }
            const bool s0 = f0 || (va0 && r0 < kp_), s1 = f1 || (va1 && r1 < kp_);
            const unsigned long long b0 = __ballot(s0), b1 = __ballot(s1);
            if (lane == 0) { Mk[q * 4 + 0] = (unsigned)b0; Mk[q * 4 + 1] = (unsigned)(b0 >> 32); Mk[q * 4 + 2] = (unsigned)b1; Mk[q * 4 + 3] = (unsigned)(b1 >> 32);
                __hip_atomic_fetch_or(&Uni[0], (unsigned)b0, __ATOMIC_RELAXED, __HIP_MEMORY_SCOPE_WORKGROUP); __hip_atomic_fetch_or(&Uni[1], (unsigned)(b0 >> 32), __ATOMIC_RELAXED, __HIP_MEMORY_SCOPE_WORKGROUP); __hip_atomic_fetch_or(&Uni[2], (unsigned)b1, __ATOMIC_RELAXED, __HIP_MEMORY_SCOPE_WORKGROUP); __hip_atomic_fetch_or(&Uni[3], (unsigned)(b1 >> 32), __ATOMIC_RELAXED, __HIP_MEMORY_SCOPE_WORKGROUP); }
        }
    }
    LBAR();
    if (C.tid == 0) { int n = 0; for (int w = 0; w < 4; ++w) { unsigned u = Uni[w]; while (u) { const int bpos = __builtin_ctz(u); u &= u - 1; List[n++] = w * 32 + bpos; } } Uni[4] = (unsigned)n; }
    LBAR();
    {
        const int nsel = (int)Uni[4];
        const bf16_t* ks = B.KV + 2 * KV_STRIDE + bg * 64; const bf16_t* vs = B.KV + 3 * KV_STRIDE + bg * 64;
        auto srcS = [&](int it, const bf16_t*& kp, const bf16_t*& vp) { const int j = List[it]; kp = ks + (size_t)j * 4096; vp = vs + (size_t)j * 4096; };
        auto mskS = [&](int it, int& klo, int& khi) { const int j = List[it]; const unsigned w = Mk[qi * 4 + (j >> 5)]; const bool bit = (w >> (j & 31)) & 1u;
            klo = 0; khi = bit ? (j == cur ? qi : 63) : -1; return j == cur; };
        m = -1e30f; l = 0.f; o[0] = f32x16{}; o[1] = f32x16{};
        run_branch<1>(C, nsel, srcS, mskS, qr, m, l, o, 0.f, nullptr, false);
        l += swap_other(l, hi);
        merge_branch<false>(C, o, l > 0.f ? g1 / l : 0.f);
    }
    {
        const int tw0 = i >= 8 ? i - 8 : 0, ntw = i - tw0 + 1;
        const bf16_t* kw = B.KV + 4 * KV_STRIDE + bg * 64; const bf16_t* vw = B.KV + 5 * KV_STRIDE + bg * 64;
        auto srcW = [&](int it, const bf16_t*& kp, const bf16_t*& vp) { kp = kw + (size_t)(tw0 + it) * 4096; vp = vw + (size_t)(tw0 + it) * 4096; };
        auto mskW = [&](int it, int& klo, int& khi) { const int tw = tw0 + it; klo = (t - 511) - 64 * tw; khi = (tw == i) ? qi : 63; return tw == i || klo > 0; };
        m = -1e30f; l = 0.f; o[0] = f32x16{}; o[1] = f32x16{};
        run_branch<1>(C, ntw, srcW, mskW, qr, m, l, o, 0.f, nullptr, false);
        l += swap_other(l, hi);
        merge_branch<false>(C, o, l > 0.f ? g2 / l : 0.f);
    }
#pragma unroll
    for (int r = 0; r < 16; ++r) { const int qrow = crow(r, hi); bf16_t* dst = B.Abr + ((size_t)b * SEQ + 64 * i + 8 * wid + (qrow >> 2)) * DM + 256 + (g * 4 + (qrow & 3)) * 64 + r32;
        dst[0] = (bf16_t)(cvtpk(ABL_NSA_SCALE C.otl[r * 64], 0.f) & 0xffffu); dst[32] = (bf16_t)(cvtpk(ABL_NSA_SCALE C.otl[(16 + r) * 64], 0.f) & 0xffffu); }
}
__device__ __forceinline__ void moba_item(const Ctx& C, const Bufs& B, int b, int h, int qb) {
    const int r32 = C.r32, hi = C.hi, wid = C.wid, own = qb, t = 256 * qb + 32 * wid + r32;
    const size_t bh = (size_t)(b * 4 + h) * SEQ;
    bf16x8 qr[4];
    { const bf16_t* qp = B.Mo + (bh + t) * 64 + hi * 8;
#pragma unroll
      for (int d0 = 0; d0 < 4; ++d0) qr[d0] = *(const bf16x8*)(qp + d0 * 16); }
    LAS unsigned* Uni = (LAS unsigned*)(C.lds + L_UNI); LAS int* List = (LAS int*)(C.lds + L_LIST);
    LBAR();
    if (C.tid < 256) { const u32x4 kmv = *(const u32x4*)(B.KM + (size_t)(b * 4 + h) * 2048 + C.tid * 8); *(LAS u32x4*)(C.lds + L_K0 + (C.tid & 7) * KCS + (C.tid >> 3) * 16) = kmv; }
    if (C.tid == 0) Uni[0] = 0u;
    LBAR();
    unsigned sel = 0u;
    {
        f32x16 gs = f32x16{};
        const LAS char* kb = C.lds + L_K0 + hi * KCS + r32 * 16;
#pragma unroll
        for (int d0 = 0; d0 < 4; ++d0) gs = __builtin_amdgcn_mfma_f32_32x32x16_bf16(*(const LAS bf16x8*)(kb + d0 * 2 * KCS), qr[d0], gs, 0, 0, 0);
        float lo[16], hv[16];
#pragma unroll
        for (int r = 0; r < 16; ++r) { const float ownv = gs[r], oth = swap_other(ownv, hi); lo[r] = hi ? oth : ownv; hv[r] = hi ? ownv : oth; }
        unsigned taken = ~((1u << own) - 1u);
#pragma unroll
        for (int round = 0; round < 3; ++round) {
            float best = -INFINITY; int bi = 32;
#pragma unroll
            for (int n = 0; n < 32; ++n) { const int rr = (n & 3) + 4 * (n >> 3); const float v = ((n >> 2) & 1) ? hv[rr] : lo[rr]; if (!((taken >> n) & 1u) && v > best) { best = v; bi = n; } }
            if (bi < 32) { sel |= 1u << bi; taken |= 1u << bi; }
        }
    }
    { unsigned u = sel;
#pragma unroll
      for (int o_ = 1; o_ < 64; o_ <<= 1) u |= (unsigned)__shfl_xor((int)u, o_);
      if (C.lane == 0) __hip_atomic_fetch_or(&Uni[0], u, __ATOMIC_RELAXED, __HIP_MEMORY_SCOPE_WORKGROUP); }
    LBAR();
    if (C.tid == 0) { int n = 0; unsigned u = Uni[0]; while (u) { const int bpos = __builtin_ctz(u); u &= u - 1; List[n++] = bpos; } Uni[4] = (unsigned)n; }
    LBAR();
    const int nl = (int)Uni[4], nt = 4 * nl + 4;
    const bf16_t* kk = B.Mo + MO_STRIDE + bh * 64; const bf16_t* vv = B.Mo + 2 * MO_STRIDE + bh * 64;
    auto src = [&](int it, const bf16_t*& kp, const bf16_t*& vp) { const int T = (it < 4 * nl) ? 4 * List[it >> 2] + (it & 3) : 4 * own + (it - 4 * nl); kp = kk + (size_t)T * 4096; vp = vv + (size_t)T * 4096; };
    auto msk = [&](int it, int& klo, int& khi) { klo = 0; if (it < 4 * nl) { const bool bit = (sel >> List[it >> 2]) & 1u; khi = bit ? 63 : -1; return false; } khi = 32 * wid + r32 - 64 * (it - 4 * nl); return true; };
    float m = -1e30f, l = 0.f; f32x16 o[2] = {f32x16{}, f32x16{}};
    run_branch<1>(C, nt, src, msk, qr, m, l, o, 0.f, nullptr, false);
    l += swap_other(l, hi);
    merge_branch<true>(C, o, l > 0.f ? 1.0f / l : 0.f);
#pragma unroll
    for (int r = 0; r < 16; ++r) { const int qrow = crow(r, hi); bf16_t* dst = B.Abr + ((size_t)b * SEQ + 256 * qb + 32 * wid + qrow) * DM + 768 + h * 64 + r32;
        dst[0] = (bf16_t)(cvtpk(ABL_MOBA_SCALE C.otl[r * 64], 0.f) & 0xffffu); dst[32] = (bf16_t)(cvtpk(ABL_MOBA_SCALE C.otl[(16 + r) * 64], 0.f) & 0xffffu); }
}
}
#define XB_TMO      128
#define XB_XCNT(j)  (256  + 64 * (j))
#define XB_XSUB(j)  (1280 + 64 * (j))
#define XB_XGEN(j)  (2304 + 64 * (j))
#define XB_TOP      3328
#define XB_TOPGEN   3392
#define XCD_BAR_WORDS 3456
#define XB_SPIN_CAP (1u << 18)

__device__ __forceinline__ unsigned xb_ld(unsigned* p)              { return __hip_atomic_load(p, __ATOMIC_RELAXED, __HIP_MEMORY_SCOPE_AGENT); }
__device__ __forceinline__ unsigned xb_add(unsigned* p, unsigned v) { return __hip_atomic_fetch_add(p, v, __ATOMIC_RELAXED, __HIP_MEMORY_SCOPE_AGENT); }
__device__ __forceinline__ unsigned xb_xcc_id() { return (unsigned)__builtin_amdgcn_s_getreg((3 << 11) | 20) & 0xFu; }
#define XB_SPIN(cond, bar) do { unsigned _sp = 0; while (cond) { __builtin_amdgcn_s_sleep(1); \
    if ((++_sp & 255u) == 0u) { if (xb_ld(&(bar)[XB_TMO])) break; if (_sp > XB_SPIN_CAP) { atomicAdd(&(bar)[XB_TMO], 1u); break; } } } } while (0)

struct XcdBarrier {
    unsigned* bar; unsigned x;
    volatile LAS unsigned* st;
};

__device__ __forceinline__ XcdBarrier xcd_barrier_post(unsigned* bar, volatile LAS unsigned* st) {
    XcdBarrier b; b.bar = bar; b.x = xb_xcc_id(); b.st = st;
    if (threadIdx.x == 0) (void)xb_add(&bar[XB_XCNT(b.x)], 1u);
    return b;
}
__device__ __forceinline__ void xcd_barrier_complete(unsigned* bar, unsigned x, unsigned& nloc, unsigned& nx) {
    const unsigned G = gridDim.x * gridDim.y * gridDim.z;
    unsigned sum, cnt, mine, sp = 0u;
    for (;;) {
        sum = 0u; cnt = 0u; mine = 0u;
#pragma unroll
        for (unsigned j = 0; j < 16; ++j) { const unsigned c = xb_ld(&bar[XB_XCNT(j)]); sum += c; cnt += (c > 0u) ? 1u : 0u; mine = (j == x) ? c : mine; }
        if (sum == G) break;
        __builtin_amdgcn_s_sleep(1);
        if ((++sp & 255u) == 0u) { if (xb_ld(&bar[XB_TMO])) break; if (sp > XB_SPIN_CAP) { atomicAdd(&bar[XB_TMO], 1u); break; } }
    }
    nloc = mine > 0u ? mine : 1u; nx = cnt > 0u ? cnt : 1u;
}

__device__ __forceinline__ void xcd_barrier(const XcdBarrier& b) {
    asm volatile("s_waitcnt vmcnt(0)" ::: "memory");
    __syncthreads();
    if (threadIdx.x == 0) {
        unsigned* bar = b.bar;
        __builtin_amdgcn_s_waitcnt(0);
        unsigned nloc = b.st[0], nx = b.st[1];
        if (nloc == 0u) { xcd_barrier_complete(bar, b.x, nloc, nx); b.st[0] = nloc; b.st[1] = nx; }
        const unsigned old = xb_add(&bar[XB_XSUB(b.x)], 1u);
        const unsigned gen = old / nloc;
        if (old + 1u == (gen + 1u) * nloc) {
            __builtin_amdgcn_fence(__ATOMIC_RELEASE, "agent");
            asm volatile("s_waitcnt vmcnt(0)" ::: "memory");
            const unsigned og = xb_add(&bar[XB_TOP], 1u);
            const unsigned tg = og / nx;
            if (og + 1u == (tg + 1u) * nx) xb_add(&bar[XB_TOPGEN], 1u);
            else XB_SPIN(xb_ld(&bar[XB_TOPGEN]) == tg, bar);
            __builtin_amdgcn_fence(__ATOMIC_ACQUIRE, "agent");
            xb_add(&bar[XB_XGEN(b.x)], 1u);
            asm volatile("s_waitcnt vmcnt(0)" ::: "memory");
        } else {
            XB_SPIN(xb_ld(&bar[XB_XGEN(b.x)]) == gen, bar);
            __builtin_amdgcn_fence(__ATOMIC_ACQUIRE, "agent");
            asm volatile("s_waitcnt vmcnt(0)" ::: "memory");
        }
    }
    __syncthreads();
}

constexpr size_t MiB = 1u << 20;
constexpr size_t WS_CTL = 0, WS_ORDER = 4096, WS_BAR = 8192;
constexpr size_t WS_W = 1 * MiB, OFF_WIN = 0, OFF_WGU = 11 * MiB, OFF_WD = 22 * MiB, OFF_WBR = 28 * MiB, OFF_WOUT = 30 * MiB, OFF_W1 = 32 * MiB, OFF_W2 = 34 * MiB,
                 OFF_BIN = 34 * MiB + 65536, OFF_CB1 = OFF_BIN + 32768  , OFF_CB2 = OFF_CB1 + 65536;
constexpr size_t WS_TAB = 36 * MiB, WS_SSP = 38 * MiB, WS_KC = 39 * MiB, WS_KM = 39 * MiB + 512 * 1024, WS_GN = 40 * MiB, WS_XB = 42 * MiB, WS_BIG = 74 * MiB,
                 WS_U = 170 * MiB, WS_QN = 178 * MiB, WS_KV = 194 * MiB, WS_MO = 218 * MiB, WS_MRG = 178 * MiB, WS_END = 242 * MiB;
constexpr int LDS_BYTES = 147456;

__device__ __forceinline__ int dint(int pos) { return (pos >> 1) + 32 * (pos & 1); }
__device__ __forceinline__ int in_orig(int c) {
    if (c < 256) return c;
    if (c < 768) { const int c2 = c - 256; return 256 + (c2 >> 6) * 64 + dint(c2 & 63); }
    if (c < 1536) { const int c2 = c - 768, tt = c2 >> 8, bj = (c2 >> 7) & 1, g = (c2 >> 6) & 1, pos = c2 & 63; return 768 + (2 * tt + bj) * 128 + g * 64 + (bj == 0 ? dint(pos) : pos); }
    if (c < 2304) { const int c2 = c - 1536, part = c2 >> 8, h = (c2 >> 6) & 3, pos = c2 & 63; return 1560 + part * 256 + h * 64 + (part < 2 ? dint(pos) : pos); }
    if (c < 5376) return 2328 + (c - 2304);
    const int c2 = c - 5376; return c2 < 24 ? 1536 + c2 : -1;
}
template <class F> __device__ __forceinline__ void cvt_tile(LAS float* scr, int lane, int k0, int n0, bf16_t* dst, size_t pitch, F f) {
    float vals[32];
#pragma unroll
    for (int i = 0; i < 32; ++i) vals[i] = f(k0 + 2 * i + (lane >> 5), n0 + (lane & 31));
#pragma unroll
    for (int i = 0; i < 32; ++i) scr[(2 * i + (lane >> 5)) * 33 + (lane & 31)] = vals[i];
    asm volatile("s_waitcnt lgkmcnt(0)" ::: "memory");
    const int c = lane & 7;
#pragma unroll
    for (int j = 0; j < 4; ++j) { const int n = (lane >> 3) + 8 * j; const LAS float* s = scr + (8 * c) * 33 + n;
        u32x4 o; o.x = cvtpk(s[0 * 33], s[1 * 33]); o.y = cvtpk(s[2 * 33], s[3 * 33]); o.z = cvtpk(s[4 * 33], s[5 * 33]); o.w = cvtpk(s[6 * 33], s[7 * 33]);
        *(u32x4*)(dst + (size_t)(n0 + n) * pitch + k0 + 8 * c) = o; }
    asm volatile("s_waitcnt lgkmcnt(0)" ::: "memory");
}
struct Args { const float* in[20]; float* out; unsigned char* ws; };
typedef const __attribute__((address_space(4))) Args* ArgsP;

__device__ __forceinline__ void phase0(ArgsP a, int l, LAS unsigned char* lds, int tid, int lane, int wave, int gw, int NGW) {
    unsigned char* ws = a->ws;
    LAS float* scr = (LAS float*)(lds + wave * 8704);
    const float* attn_norm = a->in[1] + (size_t)l * DM; const float* w_in = a->in[2] + (size_t)l * DM * IN_COLS; const float* b_in = a->in[3] + (size_t)l * IN_COLS;
    const float* pool_w = a->in[4] + (size_t)l * 4 * 64 * 64; const float* pool_scale = a->in[5] + (size_t)l * 256; const float* cmp_pos = a->in[6] + (size_t)l * 2 * 32 * 64;
    const float* cmp_w1 = a->in[7] + (size_t)l * 2 * 2048 * 256; const float* cmp_b1 = a->in[8] + (size_t)l * 2 * 256; const float* cmp_w2 = a->in[9] + (size_t)l * 2 * 256 * 64; const float* cmp_b2 = a->in[10] + (size_t)l * 2 * 64;
    const float* w_br_pool = a->in[11] + (size_t)l * 256 * DM; const float* w_br_nsa = a->in[12] + (size_t)l * 512 * DM; const float* w_br_moba = a->in[13] + (size_t)l * 256 * DM;
    const float* w_out = a->in[14] + (size_t)l * DM * DM; const float* ffn_norm = a->in[15] + (size_t)l * DM; const float* w_gate = a->in[16] + (size_t)l * DM * DFF; const float* w_up = a->in[17] + (size_t)l * DM * DFF;
    const float* w_down = a->in[18] + (size_t)l * DFF * DM;
    bf16_t* Win = (bf16_t*)(ws + WS_W + OFF_WIN); bf16_t* Wgu = (bf16_t*)(ws + WS_W + OFF_WGU); bf16_t* Wd = (bf16_t*)(ws + WS_W + OFF_WD); bf16_t* Wbr = (bf16_t*)(ws + WS_W + OFF_WBR);
    bf16_t* Wout = (bf16_t*)(ws + WS_W + OFF_WOUT); bf16_t* W1t = (bf16_t*)(ws + WS_W + OFF_W1); bf16_t* W2t = (bf16_t*)(ws + WS_W + OFF_W2);
    float* bin = (float*)(ws + WS_W + OFF_BIN); float* cb1 = (float*)(ws + WS_W + OFF_CB1); float* cb2 = (float*)(ws + WS_W + OFF_CB2);
    constexpr int I_A = 16 * 176, I_B = 16 * 176, I_C = 44 * 32, I_D = 16 * 32, I_E = 16 * 32, I_F = 2 * 32 * 8, I_G = 2 * 4 * 2;
    constexpr int NITEMS = I_A + I_B + I_C + I_D + I_E + I_F + I_G;
    for (int it = gw; it < NITEMS; it += NGW) {
        int r = it;
        if (r < I_A) { const int kb = r / 176, nb = r % 176; cvt_tile(scr, lane, 64 * kb, 32 * nb, Win, DM, [&](int k, int n) { const int o = in_orig(n); return o >= 0 ? w_in[(size_t)k * IN_COLS + o] * attn_norm[k] : 0.f; }); continue; } r -= I_A;
        if (r < I_B) { const int kb = r / 176, nb = r % 176; cvt_tile(scr, lane, 64 * kb, 32 * nb, Wgu, DM, [&](int k, int n) { const int j = (n >> 8) * 128 + (n & 127); const float* s = ((n >> 7) & 1) ? w_up : w_gate; return s[(size_t)k * DFF + j] * ffn_norm[k]; }); continue; } r -= I_B;
        if (r < I_C) { const int kb = r / 32, nb = r % 32; cvt_tile(scr, lane, 64 * kb, 32 * nb, Wd, DFF, [&](int k, int n) { return w_down[(size_t)k * DM + n]; }); continue; } r -= I_C;
        if (r < I_D) { const int kb = r / 32, nb = r % 32; cvt_tile(scr, lane, 64 * kb, 32 * nb, Wout, DM, [&](int k, int n) { return w_out[(size_t)k * DM + n]; }); continue; } r -= I_D;
        if (r < I_E) { const int kb = r / 32, nb = r % 32;
            if (kb < 4) { }
            else if (kb < 12) cvt_tile(scr, lane, 64 * kb, 32 * nb, Wbr, DM, [&](int k, int n) { return w_br_nsa[(size_t)(k - 256) * DM + n]; });
            else cvt_tile(scr, lane, 64 * kb, 32 * nb, Wbr, DM, [&](int k, int n) { return w_br_moba[(size_t)(k - 768) * DM + n]; });
            continue; } r -= I_E;
        if (r < I_F) { const int kv = r >> 8, kb = (r >> 3) & 31, nb = r & 7; const float* w1 = cmp_w1 + (size_t)kv * 2048 * 256;
            cvt_tile(scr, lane, 64 * kb, 32 * nb, W1t + (size_t)kv * 256 * 2048, 2048, [&](int k, int n) { const int pos = k & 63, d = kv == 0 ? dint(pos) : pos; return w1[(size_t)((k & ~63) + d) * 256 + n]; }); continue; } r -= I_F;
        { const int kv = r >> 3, kb = (r >> 1) & 3, nb = r & 1; const float* w2 = cmp_w2 + (size_t)kv * 256 * 64;
            cvt_tile(scr, lane, 64 * kb, 32 * nb, W2t + (size_t)kv * 64 * 256, 256, [&](int k, int n) { return w2[(size_t)k * 64 + (kv == 0 ? dint(n) : n)]; }); }
    }
    const int gt = gw * 64 + lane, NGT = NGW * 64;
    for (int c = gt; c < NIN; c += NGT) { const int o = in_orig(c); bin[c] = o >= 0 ? b_in[o] : 0.f; }
    for (int idx = gt; idx < 32 * 512; idx += NGT) { const int c = idx >> 9, e = idx & 511, kv = e >> 8, n = e & 255; const float* w1 = cmp_w1 + (size_t)kv * 2048 * 256 + (size_t)(64 * c) * 256 + n; const float* pe = cmp_pos + (size_t)kv * 2048 + 64 * c;
        float s = c == 0 ? cmp_b1[kv * 256 + n] : 0.f;
#pragma unroll 16
        for (int k = 0; k < 64; ++k) s += pe[k] * w1[(size_t)k * 256];
        cb1[idx] = s; }
    for (int idx = gt; idx < 256 * DM; idx += NGT) { const int k = idx >> 10, n = idx & 1023, g64 = k & ~63; float s = 0.f;
#pragma unroll 16
        for (int j = 0; j < 64; ++j) s += pool_w[k * 64 + j] * pool_scale[g64 + j] * w_br_pool[(size_t)(g64 + j) * DM + n];
        Wbr[(size_t)n * DM + k] = (bf16_t)(cvtpk(s, 0.f) & 0xffffu); }
    for (int e = gt; e < 128; e += NGT) { const int kv = e >> 6, n = e & 63; cb2[e] = cmp_b2[kv * 64 + (kv == 0 ? dint(n) : n)]; }
    if (l == 0) {
        float* tab = (float*)(ws + WS_TAB);
        for (int e = gt; e < SEQ * 32; e += NGT) { const int t = e >> 5, f = e & 31; const float inv = powf(10000.0f, -(float)(2 * f) / 64.0f); const float ang = (float)t * inv;
            const double ad = (double)ang, kq = rint(ad * 0.15915494309189535); double rr = fma(-kq, 6.283185307179586, ad); rr = fma(-kq, 2.4492935982947064e-16, rr);
            const float rf = (float)rr; tab[2 * e] = __cosf(rf); tab[2 * e + 1] = __sinf(rf); }
        const float* x = a->in[0]; bf16_t* xb = (bf16_t*)(ws + WS_XB); float* ssp = (float*)(ws + WS_SSP);
        for (int m = gw; m < MTOK; m += NGW) { const f32x4* xr = (const f32x4*)(x + (size_t)m * DM) + lane; f32x4 v[4]; float s = 0.f;
#pragma unroll
            for (int j = 0; j < 4; ++j) { v[j] = xr[64 * j]; s += (v[j][0] * v[j][0] + v[j][1] * v[j][1]) + (v[j][2] * v[j][2] + v[j][3] * v[j][3]); }
#pragma unroll
            for (int o = 1; o < 64; o <<= 1) s += __shfl_xor(s, o);
            u32x2* o8 = (u32x2*)(xb + (size_t)m * DM) + lane;
#pragma unroll
            for (int j = 0; j < 4; ++j) o8[64 * j] = (u32x2){cvtpk(v[j][0], v[j][1]), cvtpk(v[j][2], v[j][3])};
            if (lane < 16) ssp[(size_t)m * 16 + lane] = lane == 0 ? s : 0.f; }
        int* order = (int*)(ws + WS_ORDER);
        if (gt < 768) { auto cost = [](int id) { return id < 512 ? 9 * (id & 127) + 80 : 32 * ((id - 512) & 31) + 32; }; const int mc = cost(gt); int rk = 0;
            for (int j = 0; j < 768; ++j) { const int cj = cost(j); rk += (cj > mc || (cj == mc && j < gt)) ? 1 : 0; }
            order[rk] = gt; }
    }
}
__device__ __forceinline__ float gelu_tanh(float x) { const float u = 0.7978845608028654f * (x + 0.044715f * x * x * x); const float th = 1.f - 2.f * __builtin_amdgcn_rcpf(1.f + __expf(2.f * u)); return 0.5f * x * (1.f + th); }
__device__ __forceinline__ void phase2(ArgsP a, LAS unsigned char* lds, int tid, int lane, int wave, int G) {
    unsigned char* ws = a->ws;
    const bf16_t* KV = (const bf16_t*)(ws + WS_KV); const bf16_t* W1t = (const bf16_t*)(ws + WS_W + OFF_W1); const bf16_t* W2t = (const bf16_t*)(ws + WS_W + OFF_W2);
    const float* cb1 = (const float*)(ws + WS_W + OFF_CB1); const float* cb2 = (const float*)(ws + WS_W + OFF_CB2);
    bf16_t* KC = (bf16_t*)(ws + WS_KC);
    LAS bf16_t* hid = (LAS bf16_t*)lds;
    const int arow = lane & 15, kq = lane >> 4;
    for (int task = blockIdx.x; task < 256; task += G) {
        const int kv = task >> 7, bgi = (task >> 5) & 3, nt = task & 31;
        const bf16_t* src = KV + (size_t)kv * att::KV_STRIDE + (size_t)bgi * SEQ * 64;
        const int nrow = 16 * nt + arow, neff = nrow < 510 ? nrow : 510;
        const bf16_t* ap = src + (size_t)neff * 1024 + kq * 8;
        const bf16_t* bp0 = W1t + (size_t)kv * 256 * 2048 + (size_t)(32 * wave + arow) * 2048 + kq * 8; const bf16_t* bp1 = bp0 + 16 * 2048;
        f32x4 c0 = {0.f, 0.f, 0.f, 0.f}, c1 = {0.f, 0.f, 0.f, 0.f};
#pragma unroll 4
        for (int ks = 0; ks < 64; ++ks) { const bf16x8 av = *(const bf16x8*)(ap + ks * 32), b0 = *(const bf16x8*)(bp0 + ks * 32), b1 = *(const bf16x8*)(bp1 + ks * 32);
            c0 = __builtin_amdgcn_mfma_f32_16x16x32_bf16(av, b0, c0, 0, 0, 0); c1 = __builtin_amdgcn_mfma_f32_16x16x32_bf16(av, b1, c1, 0, 0, 0); }
        { const int col0 = 32 * wave + arow; float bb0 = 0.f, bb1 = 0.f;
#pragma unroll 8
          for (int c = 0; c < 32; ++c) { bb0 += cb1[c * 512 + kv * 256 + col0]; bb1 += cb1[c * 512 + kv * 256 + col0 + 16]; }
#pragma unroll
          for (int j = 0; j < 4; ++j) { const int row = kq * 4 + j; hid[row * 264 + col0] = (bf16_t)(cvtpk(gelu_tanh(c0[j] + bb0), 0.f) & 0xffffu); hid[row * 264 + col0 + 16] = (bf16_t)(cvtpk(gelu_tanh(c1[j] + bb1), 0.f) & 0xffffu); } }
        LBAR();
        if (wave < 4) {
            const bf16_t* bp = W2t + (size_t)kv * 64 * 256 + (size_t)(16 * wave + arow) * 256 + kq * 8; f32x4 c = {0.f, 0.f, 0.f, 0.f};
#pragma unroll
            for (int ks = 0; ks < 8; ++ks) { const bf16x8 av = *(const LAS bf16x8*)(hid + arow * 264 + kq * 8 + ks * 32), bv = *(const bf16x8*)(bp + ks * 32); c = __builtin_amdgcn_mfma_f32_16x16x32_bf16(av, bv, c, 0, 0, 0); }
            const int col = 16 * wave + arow; const float bb = cb2[kv * 64 + col];
#pragma unroll
            for (int j = 0; j < 4; ++j) { const int n = 16 * nt + kq * 4 + j; KC[((size_t)(kv * 4 + bgi) * 512 + n) * 64 + col] = n < 511 ? (bf16_t)(cvtpk(c[j] + bb, 0.f) & 0xffffu) : (bf16_t)0; }
        }
        LBAR();
    }
    const int gt = blockIdx.x * 512 + tid, NGT = G * 512;
    { const bf16_t* MoK = (const bf16_t*)(ws + WS_MO) + att::MO_STRIDE; bf16_t* KM = (bf16_t*)(ws + WS_KM); LAS float* part = (LAS float*)(lds + 16384);
      for (int blk = blockIdx.x; blk < 256; blk += G) { const bf16_t* p = MoK + ((size_t)blk * 256 + 32 * wave) * 64 + lane; float s = 0.f;
#pragma unroll
          for (int r = 0; r < 32; ++r) s += __uint_as_float((unsigned)p[(size_t)r * 64] << 16);
          part[wave * 64 + lane] = s;
          LBAR();
          if (wave == 0) { float t = 0.f;
#pragma unroll
              for (int w = 0; w < 8; ++w) t += part[w * 64 + lane];
              KM[(size_t)blk * 64 + lane] = (bf16_t)(cvtpk(t * (1.0f / 256.0f), 0.f) & 0xffffu); }
          LBAR(); } }
    { const bf16_t* U = (const bf16_t*)(ws + WS_U); bf16_t* Abr = (bf16_t*)(ws + WS_XB);
      for (int e = gt; e < MTOK * 32; e += NGT) { const int row = e >> 5, c8 = e & 31, s = row & (SEQ - 1), w = 2 << (c8 >> 3), cnt = (s + 1 < w) ? s + 1 : w;
          float acc[8] = {0.f, 0.f, 0.f, 0.f, 0.f, 0.f, 0.f, 0.f}; u32x4 v0 = {0u, 0u, 0u, 0u};
#pragma unroll
          for (int i0 = 0; i0 < 16; i0 += 8) { if (i0 >= cnt) break; u32x4 v[8];
#pragma unroll
              for (int i = 0; i < 8; ++i) v[i] = (i0 + i < cnt) ? *(const u32x4*)(U + (size_t)(row - i0 - i) * 256 + c8 * 8) : (u32x4){0u, 0u, 0u, 0u};
              if (i0 == 0) v0 = v[0];
#pragma unroll
              for (int i = 0; i < 8; ++i)
#pragma unroll
                  for (int q = 0; q < 4; ++q) { acc[2 * q] += bflo(v[i][q]); acc[2 * q + 1] += bfhi(v[i][q]); } }
          const float ic = 1.0f / (float)cnt; u32x4 o;
#pragma unroll
          for (int q = 0; q < 4; ++q) o[q] = cvtpk(acc[2 * q] * ic - bflo(v0[q]), acc[2 * q + 1] * ic - bfhi(v0[q]));
          *(u32x4*)(Abr + (size_t)row * DM + c8 * 8) = o; } }
}
#ifndef DUP
#define DUP 0
#endif
__global__ void __launch_bounds__(512, 2) fwd_megakernel(Args a) {
    extern __shared__ __attribute__((aligned(16))) unsigned char lds_raw[];
    LAS unsigned char* lds = (LAS unsigned char*)lds_raw;
    cg::grid_group grid = cg::this_grid();
    const int G = gridDim.x;
    volatile LAS unsigned* bst = (volatile LAS unsigned*)(lds + LDS_BYTES - 64);
    if (threadIdx.x < 16) bst[threadIdx.x] = 0u;
    __syncthreads();
    const ArgsP ap0 = (ArgsP)__builtin_amdgcn_kernarg_segment_ptr();
#define PHASE_ARGS ArgsP a_ = ap0; asm volatile("" : "+s"(a_)); unsigned char* ws = a_->ws; unsigned* ctl = (unsigned*)(ws + WS_CTL); float* ssp = (float*)(ws + WS_SSP); const float* tab = (const float*)(ws + WS_TAB); \
    bf16_t* XB = (bf16_t*)(ws + WS_XB); bf16_t* BIG = (bf16_t*)(ws + WS_BIG); bf16_t* MRG = (bf16_t*)(ws + WS_MRG); (void)ctl; (void)ssp; (void)tab; (void)XB; (void)BIG; (void)MRG;
    XcdBarrier xbar = xcd_barrier_post((unsigned*)(ap0->ws + WS_BAR), bst);
    bool first_sync = true;
#define GRID_SYNC() do { if (first_sync) { grid.sync(); first_sync = false; } else xcd_barrier(xbar); } while (0)
    for (int l = 0; l < DEPTH; ++l) {
        int tid_ = threadIdx.x; asm volatile("" : "+v"(tid_));
        const int tid = tid_, lane = tid & 63, wave = __builtin_amdgcn_readfirstlane(tid >> 6), gw = blockIdx.x * 8 + wave, NGW = G * 8;
        for (int rep = 0; rep < ((DUP & 1) ? 2 : 1); ++rep) { PHASE_ARGS phase0(a_, l, lds, tid, lane, wave, gw, NGW); }
        GRID_SYNC();
        for (int rep = 0; rep < ((DUP & 2) ? 2 : 1); ++rep) { PHASE_ARGS pg8::Gemm g{XB, (const bf16_t*)(ws + WS_W + OFF_WIN), MTOK, NIN, DM}; pg8::StaticOrder S; S.init(MTOK, NIN, G, (int)blockIdx.x);
          EpiInProj E{ssp, (const float*)(ws + WS_W + OFF_BIN), tab, (bf16_t*)(ws + WS_U), (bf16_t*)(ws + WS_QN), (bf16_t*)(ws + WS_KV), (bf16_t*)(ws + WS_MO), BIG, (bf16_t*)(ws + WS_GN)};
          pg8::gemm_phase(lds, g, S, E); }
        GRID_SYNC();
        for (int rep = 0; rep < ((DUP & 4) ? 2 : 1); ++rep) { PHASE_ARGS phase2(a_, lds, tid, lane, wave, G); }
        GRID_SYNC();
        for (int rep = 0; rep < ((DUP & 8) ? 2 : 1); ++rep) { PHASE_ARGS att::Ctx C; C.lds = (LAS char*)lds; C.wsf = (LAS float*)(lds + att::L_WSF) + wave * 64; C.otl = (LAS float*)(lds + att::L_OT) + wave * 2048 + lane; C.tid = tid; C.wid = wave; C.lane = lane; C.r32 = lane & 31; C.hi = lane >> 5;
          C.vbl = ((lane >> 4) & 1) * 32 + (lane & 3) * 8 + (4 * (lane >> 5) + ((lane & 15) >> 2)) * 64;
          att::Bufs B{(const bf16_t*)(ws + WS_QN), (const bf16_t*)(ws + WS_KV), (const bf16_t*)(ws + WS_MO), (const bf16_t*)(ws + WS_KC), (const bf16_t*)(ws + WS_KM), (const bf16_t*)(ws + WS_GN), XB};
          const int* order = (const int*)(ws + WS_ORDER); LAS int* slot = (LAS int*)(lds + att::L_END);
          for (;;) {
              LBAR();
              if (tid == 0) slot[0] = (int)atomicAdd(ctl + l + 2 * rep, 1u);
              LBAR();
              const int item = slot[0];
              if (item >= 768) break;
              const int id = order[item];
              if (id < 512) att::nsa_item(C, B, id >> 8, (id >> 7) & 1, id & 127);
              else { const int x = id - 512; att::moba_item(C, B, x >> 7, (x >> 5) & 3, x & 31); }
          } }
        GRID_SYNC();
        for (int rep = 0; rep < ((DUP & 16) ? 2 : 1); ++rep) { PHASE_ARGS pg8::Gemm g{XB, (const bf16_t*)(ws + WS_W + OFF_WBR), MTOK, DM, DM}; pg8::StaticOrder S; S.init(MTOK, DM, G, (int)blockIdx.x);
          EpiBranch E{BIG, MRG}; pg8::gemm_phase(lds, g, S, E); }
        GRID_SYNC();
        { PHASE_ARGS pg8::Gemm g{MRG, (const bf16_t*)(ws + WS_W + OFF_WOUT), MTOK, DM, DM}; pg8::StaticOrder S; S.init(MTOK, DM, G, (int)blockIdx.x);
          float* outp = a_->out; EpiResid E{l == 0 ? a_->in[0] : outp, outp, XB, ssp}; pg8::gemm_phase(lds, g, S, E); }
        GRID_SYNC();
        for (int rep = 0; rep < ((DUP & 64) ? 2 : 1); ++rep) { PHASE_ARGS pg8::Gemm g{XB, (const bf16_t*)(ws + WS_W + OFF_WGU), MTOK, NGU, DM}; pg8::StaticOrder S; S.init(MTOK, NGU, G, (int)blockIdx.x);
          EpiSwiGLU E{ssp, BIG}; pg8::gemm_phase(lds, g, S, E); }
        GRID_SYNC();
        { PHASE_ARGS pg8::Gemm g{BIG, (const bf16_t*)(ws + WS_W + OFF_WD), MTOK, DM, DFF}; pg8::StaticOrder S; S.init(MTOK, DM, G, (int)blockIdx.x);
          float* outp = a_->out; EpiResid E{outp, outp, XB, ssp}; pg8::gemm_phase(lds, g, S, E); }
        GRID_SYNC();
    }
    { PHASE_ARGS const float* fn = a_->in[19]; float* outp = a_->out; const int lane = threadIdx.x & 63, gw = blockIdx.x * 8 + (threadIdx.x >> 6), NGW = G * 8;
      for (int m = gw; m < MTOK; m += NGW) { const float rstd = row_rstd(ssp, m); f32x4* xr = (f32x4*)(outp + (size_t)m * DM) + lane; const f32x4* gr = (const f32x4*)fn + lane;
#pragma unroll
          for (int j = 0; j < 4; ++j) xr[64 * j] = xr[64 * j] * rstd * gr[64 * j]; } }
}

extern "C" void kernel_launch(void* const* d_in, const int* in_sizes, int n_in, void* d_out, int out_size, void* d_ws, size_t ws_size, hipStream_t stream) {
    static int grid = 0;
    if (grid == 0) {
        if (n_in != 20 || in_sizes[0] != MTOK * DM || out_size != MTOK * DM || ws_size < WS_END) { fprintf(stderr, "kernel_launch: unexpected shapes / workspace (n_in %d, ws %zu)\n", n_in, ws_size); grid = -1; return; }
        int dev = 0, cus = 0, per_cu = 0;
        if (hipGetDevice(&dev) != hipSuccess || hipDeviceGetAttribute(&cus, hipDeviceAttributeMultiprocessorCount, dev) != hipSuccess) { grid = -1; return; }
        if (hipFuncSetAttribute((const void*)fwd_megakernel, hipFuncAttributeMaxDynamicSharedMemorySize, LDS_BYTES) != hipSuccess) { fprintf(stderr, "kernel_launch: hipFuncSetAttribute failed\n"); grid = -1; return; }
        if (hipOccupancyMaxActiveBlocksPerMultiprocessor(&per_cu, (const void*)fwd_megakernel, 512, LDS_BYTES) != hipSuccess || per_cu < 1) { fprintf(stderr, "kernel_launch: occupancy query failed (%d)\n", per_cu); (void)hipGetLastError(); grid = -1; return; }
        grid = cus * per_cu;
    }
    if (grid < 0) return;
    if (hipMemsetAsync((char*)d_ws + WS_CTL, 0, 32768, stream) != hipSuccess) { fprintf(stderr, "kernel_launch: memset failed\n"); return; }
    Args a{};
    for (int i = 0; i < 20; ++i) a.in[i] = (const float*)d_in[i];
    a.out = (float*)d_out; a.ws = (unsigned char*)d_ws;
    void* args[] = {&a};
    const hipError_t e = hipLaunchCooperativeKernel((const void*)fwd_megakernel, dim3(grid), dim3(512), args, LDS_BYTES, stream);
    if (e != hipSuccess) fprintf(stderr, "kernel_launch: cooperative launch failed: %s (grid %d)\n", hipGetErrorString(e), grid);
}
```

```cpp
#include <hip/hip_runtime.h>
#include <hip/hip_cooperative_groups.h>
#include <cstdio>
#include <cstdint>
#include <cmath>
namespace cg = cooperative_groups;

#define LAS __attribute__((address_space(3)))
typedef unsigned short bf16_t;
typedef short bf16x8 __attribute__((ext_vector_type(8)));
typedef short s16x4 __attribute__((ext_vector_type(4)));
typedef float f32x2 __attribute__((ext_vector_type(2)));
typedef float f32x4 __attribute__((ext_vector_type(4)));
typedef float f32x16 __attribute__((ext_vector_type(16)));
typedef unsigned u32x4 __attribute__((ext_vector_type(4)));
typedef unsigned u32x2 __attribute__((ext_vector_type(2)));
typedef __bf16 bf16x2_t __attribute__((ext_vector_type(2)));

constexpr int SEQ = 8192, BATCH = 2, MTOK = BATCH * SEQ, DM = 1024, DEPTH = 2;
constexpr int IN_COLS = 5400, NIN = 5632, DFF = 2816, NGU = 5632;
constexpr float RMS_EPS = 1e-6f;
constexpr float QSCALE = 0.125f * 1.4426950408889634f;

__device__ __forceinline__ unsigned cvtpk(float lo, float hi) { f32x2 v = {lo, hi}; bf16x2_t b = __builtin_convertvector(v, bf16x2_t); return __builtin_bit_cast(unsigned, b); }
__device__ __forceinline__ float bflo(unsigned w) { return __uint_as_float(w << 16); }
__device__ __forceinline__ float bfhi(unsigned w) { return __uint_as_float(w & 0xffff0000u); }
__device__ __forceinline__ float sigmoidf_(float x) { return __builtin_amdgcn_rcpf(1.f + __expf(-x)); }

namespace pg8 {
constexpr int BM = 256, BK = 64, HALF = 128, HTB = HALF * BK * 2, STAGE_BYTES = 8 * HTB, NXCD = 8, WGM = 8;
__host__ __device__ __forceinline__ int lds_byte(int r, int c) { const int st = (r >> 4) * 2 + (c >> 5), rr = r & 15, cc = c & 31, ob = rr * 64 + cc * 2; return st * 1024 + (ob ^ (((ob >> 9) & 1) << 5)); }
__host__ __device__ __forceinline__ void stage_rc(int b, int& R, int& C) { const int st = b / 1024, sb = b % 1024, swz = sb ^ (((sb >> 9) & 1) << 5); R = (st >> 1) * 16 + swz / 64; C = (st & 1) * 32 + (swz % 64) / 2; }
__host__ __device__ __forceinline__ int perm32(int rho) { const int n = rho >> 4, i = rho & 15; return 8 * (i >> 2) + 4 * n + (i & 3); }
struct Unit { int pm, pn; };
struct Gemm { const bf16_t* A; const bf16_t* Bt; int M, N, K; };
struct StaticOrder {
    int nM, nN, nwg, G, c;
    __host__ __device__ void init(int M, int N, int G_, int c_) { nM = M / BM; nN = N / BM; nwg = nM * nN; G = G_; c = c_; }
    __host__ __device__ bool next(int i, Unit& u) const {
        const long L = (long)i * G + c; if (L >= nwg) return false;
        int wgid = (int)L; { const int q = nwg / NXCD, r = nwg % NXCD, xcd = wgid % NXCD, off = wgid / NXCD; wgid = (xcd < r ? xcd * (q + 1) : r * (q + 1) + (xcd - r) * q) + off; }
        const int nig = WGM * nN, gid = wgid / nig, fm = gid * WGM, gsz = (nM - fm) < WGM ? (nM - fm) : WGM;
        u.pm = fm + ((wgid % nig) % gsz); u.pn = (wgid % nig) / gsz; return true;
    }
};
template <class Epi, class Sched>
__device__ __forceinline__ void gemm_phase(LAS unsigned char* lds, const Gemm g, const Sched& S, const Epi& E) {
    int tid_ = threadIdx.x; asm volatile("" : "+v"(tid_));
    const int tid = tid_, wid = __builtin_amdgcn_readfirstlane(tid >> 6), lane = tid & 63, wr = wid >> 2, wc = wid & 3, fr = lane & 15, fq = lane >> 4;
    const int K = g.K, nt = K / BK;
    unsigned voffA[2], voffB[2];
#pragma unroll
    for (int i = 0; i < 2; ++i) { int R, C; stage_rc(tid * 16 + i * 8192, R, C); const int Rb = ((R & ~31) + perm32(R & 31));
        voffA[i] = (unsigned)(R * K + C) * 2u; voffB[i] = (unsigned)(Rb * K + C) * 2u; }
    const size_t kstep = (size_t)(BK * 2);
    const size_t hstep = (size_t)HALF * K * 2;
    const size_t tstep = 2 * hstep;
    const unsigned ldsw = (unsigned)wid * 1024u;
    const int aoff = lds_byte(wr * 64 + fr, fq * 8), boff = lds_byte(wc * 32 + fr, fq * 8);
#define PG8_SA(b, h) (((b) * 2 + (h)) * HTB)
#define PG8_SB(b, h) ((4 + (b) * 2 + (h)) * HTB)
#define PG8_STAGE(bufoff, gbase, voff) do { _Pragma("unroll") for (int _i = 0; _i < 2; ++_i) \
        __builtin_amdgcn_global_load_lds((const unsigned*)((const char*)(gbase) + (voff)[_i]), (LAS unsigned*)(lds + (bufoff) + ldsw + _i * 8192), 16, 0, 0); } while (0)
#define PG8_LDA(dst, b, h) do { _Pragma("unroll") for (int m = 0; m < 4; ++m) _Pragma("unroll") for (int k = 0; k < 2; ++k) dst[m][k] = *(const LAS bf16x8*)(lds + PG8_SA(b, h) + aoff + m * 2048 + k * 1024); } while (0)
#define PG8_LDB(dst, b, h) do { _Pragma("unroll") for (int n = 0; n < 2; ++n) _Pragma("unroll") for (int k = 0; k < 2; ++k) dst[n][k] = *(const LAS bf16x8*)(lds + PG8_SB(b, h) + boff + n * 2048 + k * 1024); } while (0)
#define PG8_MMA(ai, bj, At, Bt) do { __builtin_amdgcn_s_setprio(1); _Pragma("unroll") for (int m = 0; m < 4; ++m) _Pragma("unroll") for (int n = 0; n < 2; ++n) _Pragma("unroll") for (int k = 0; k < 2; ++k) \
        acc[ai][bj][m][n] = __builtin_amdgcn_mfma_f32_16x16x32_bf16(Bt[n][k], At[m][k], acc[ai][bj][m][n], 0, 0, 0); __builtin_amdgcn_s_setprio(0); } while (0)
#define PG8_WAIT_V(n) asm volatile("s_waitcnt vmcnt(" #n ")" ::: "memory")
#define PG8_WAIT_L(n) asm volatile("s_waitcnt lgkmcnt(" #n ")" ::: "memory")
#define PG8_BAR __builtin_amdgcn_s_barrier()
#define PG8_SCHED __builtin_amdgcn_sched_barrier(0)
    Unit cur, nxt; int ui = 0;
    if (!S.next(0, cur)) return;
    f32x4 acc[2][2][4][2];
#pragma unroll
    for (int a = 0; a < 2; ++a)
#pragma unroll
        for (int b = 0; b < 2; ++b)
#pragma unroll
            for (int m = 0; m < 4; ++m)
#pragma unroll
                for (int n = 0; n < 2; ++n) acc[a][b][m][n] = (f32x4){0.f, 0.f, 0.f, 0.f};
    bf16x8 At[4][2], B0[2][2], B1[2][2];
    const char* cA = (const char*)g.A + (size_t)cur.pm * tstep; const char* cB = (const char*)g.Bt + (size_t)cur.pn * tstep;
    PG8_STAGE(PG8_SB(0, 0), cB, voffB); PG8_STAGE(PG8_SB(0, 1), cB + hstep, voffB); PG8_STAGE(PG8_SA(0, 0), cA, voffA); PG8_STAGE(PG8_SA(0, 1), cA + hstep, voffA);
    if (wr == 1) PG8_BAR;
    PG8_WAIT_V(2); PG8_BAR;
    PG8_STAGE(PG8_SB(1, 0), cB + kstep, voffB); PG8_STAGE(PG8_SA(1, 0), cA + kstep, voffA); PG8_STAGE(PG8_SB(1, 1), cB + hstep + kstep, voffB);
    PG8_WAIT_V(6); PG8_BAR;
    for (;;) {
        const bool has_next = S.next(ui + 1, nxt);
        const char* nA = has_next ? (const char*)g.A + (size_t)nxt.pm * tstep : cA; const char* nB = has_next ? (const char*)g.Bt + (size_t)nxt.pn * tstep : cB;
        for (int t = 0; t < nt; t += 2) {
            const bool last = (t == nt - 2);
            const char* a1 = cA + (size_t)(t + 1) * kstep;
            const char* a2 = last ? nA : cA + (size_t)(t + 2) * kstep; const char* b2 = last ? nB : cB + (size_t)(t + 2) * kstep;
            const char* a3 = a2 + kstep; const char* b3 = b2 + kstep;
            if constexpr (Epi::KHOOK) { if (t == 4 || t == 12) { PG8_SCHED; E.khook(acc, cur, t, wr, wc, fr, fq); PG8_SCHED; } }
            PG8_LDB(B0, 0, 0); PG8_LDB(B1, 0, 1); PG8_SCHED; PG8_LDA(At, 0, 0); PG8_STAGE(PG8_SA(1, 1), a1 + hstep, voffA);
            PG8_WAIT_V(8); PG8_WAIT_L(0); PG8_BAR; PG8_MMA(0, 0, At, B0); PG8_MMA(0, 1, At, B1); PG8_BAR; PG8_SCHED;
            PG8_LDA(At, 0, 1); PG8_STAGE(PG8_SB(0, 0), b2, voffB); PG8_STAGE(PG8_SB(0, 1), b2 + hstep, voffB); PG8_STAGE(PG8_SA(0, 0), a2, voffA);
            PG8_WAIT_V(8); PG8_WAIT_L(0); PG8_BAR; PG8_MMA(1, 0, At, B0); PG8_MMA(1, 1, At, B1); PG8_BAR; PG8_SCHED;
            PG8_LDB(B0, 1, 0); PG8_LDB(B1, 1, 1); PG8_SCHED; PG8_LDA(At, 1, 0); PG8_STAGE(PG8_SA(0, 1), a2 + hstep, voffA);
            PG8_WAIT_V(8); PG8_WAIT_L(0); PG8_BAR; PG8_MMA(0, 0, At, B0); PG8_MMA(0, 1, At, B1); PG8_BAR; PG8_SCHED;
            PG8_LDA(At, 1, 1); PG8_STAGE(PG8_SB(1, 0), b3, voffB); PG8_STAGE(PG8_SB(1, 1), b3 + hstep, voffB); PG8_STAGE(PG8_SA(1, 0), a3, voffA);
            PG8_WAIT_V(8); PG8_WAIT_L(0); PG8_BAR; PG8_MMA(1, 0, At, B0); PG8_MMA(1, 1, At, B1); PG8_BAR; PG8_SCHED;
        }
        if (wr == 0) PG8_BAR;
        E(acc, cur, wr, wc, fr, fq);
        if (!has_next) break;
#pragma unroll
        for (int a = 0; a < 2; ++a)
#pragma unroll
            for (int b = 0; b < 2; ++b)
#pragma unroll
                for (int m = 0; m < 4; ++m)
#pragma unroll
                    for (int n = 0; n < 2; ++n) acc[a][b][m][n] = (f32x4){0.f, 0.f, 0.f, 0.f};
        cur = nxt; cA = nA; cB = nB; ++ui;
        if (wr == 1) PG8_BAR;
    }
    PG8_WAIT_V(0);
    PG8_BAR;
#undef PG8_SA
#undef PG8_SB
#undef PG8_STAGE
#undef PG8_LDA
#undef PG8_LDB
#undef PG8_MMA
#undef PG8_WAIT_V
#undef PG8_WAIT_L
#undef PG8_BAR
#undef PG8_SCHED
}
}
using pg8::Unit;
__device__ __forceinline__ float row_rstd(const float* ssp, int row) {
    const f32x4* p = (const f32x4*)(ssp + (size_t)row * 16);
    const f32x4 a = p[0], b = p[1], c = p[2], d = p[3];
    const float ss = ((a[0] + a[1]) + (a[2] + a[3])) + ((b[0] + b[1]) + (b[2] + b[3])) + ((c[0] + c[1]) + (c[2] + c[3])) + ((d[0] + d[1]) + (d[2] + d[3]));
    return 1.0f / sqrtf(ss * (1.0f / DM) + RMS_EPS);
}
__device__ __forceinline__ u32x4 pack8(const f32x4 a, const f32x4 b) { u32x4 w; w.x = cvtpk(a[0], a[1]); w.y = cvtpk(a[2], a[3]); w.z = cvtpk(b[0], b[1]); w.w = cvtpk(b[2], b[3]); return w; }
__device__ __forceinline__ void rope8(f32x4& v0, f32x4& v1, const float* tab, int t, int pos, float sc) {
    const f32x4* cs = (const f32x4*)(tab + ((size_t)t * 32 + (pos >> 1)) * 2);
    const f32x4 c0 = cs[0], c1 = cs[1];
    f32x4 o0, o1;
    o0[0] = (v0[0] * c0[0] - v0[1] * c0[1]) * sc; o0[1] = (v0[1] * c0[0] + v0[0] * c0[1]) * sc;
    o0[2] = (v0[2] * c0[2] - v0[3] * c0[3]) * sc; o0[3] = (v0[3] * c0[2] + v0[2] * c0[3]) * sc;
    o1[0] = (v1[0] * c1[0] - v1[1] * c1[1]) * sc; o1[1] = (v1[1] * c1[0] + v1[0] * c1[1]) * sc;
    o1[2] = (v1[2] * c1[2] - v1[3] * c1[3]) * sc; o1[3] = (v1[3] * c1[2] + v1[2] * c1[3]) * sc;
    v0 = o0; v1 = o1;
}
struct EpiInProj {
    static constexpr bool KHOOK = false;
    const float* ssp; const float* bias; const float* tab;
    bf16_t *U, *Qn, *KV, *Mo, *G, *Gn;
    __device__ __forceinline__ void operator()(const f32x4 (&acc)[2][2][4][2], const Unit& u, int wr, int wc, int fr, int fq) const {
        asm volatile("" : "+v"(fr), "+v"(fq));
        const int pn = u.pn;
#pragma unroll
        for (int ai = 0; ai < 2; ++ai)
#pragma unroll
            for (int m = 0; m < 4; ++m) {
                const int row = u.pm * 256 + ai * 128 + wr * 64 + m * 16 + fr;
                const float rstd = row_rstd(ssp, row);
                const int t = row & (SEQ - 1), b = row >> 13;
#pragma unroll
                for (int bj = 0; bj < 2; ++bj) {
                    const int cit = bj * 128 + wc * 32 + 8 * fq, gc = pn * 256 + cit;
                    f32x4 v0 = acc[ai][bj][m][0] * rstd + *(const f32x4*)(bias + gc), v1 = acc[ai][bj][m][1] * rstd + *(const f32x4*)(bias + gc + 4);
                    bf16_t* dst;
                    if (pn == 0) { dst = U + (size_t)row * 256 + cit; }
                    else if (pn <= 2) { const int c2 = (pn - 1) * 256 + cit, head = c2 >> 6, pos = c2 & 63; rope8(v0, v1, tab, t, pos, QSCALE); dst = Qn + ((size_t)(b * 8 + head) * SEQ + t) * 64 + pos; }
                    else if (pn <= 5) { const int c2 = cit & 127, g = c2 >> 6, pos = c2 & 63, kvi = 2 * (pn - 3) + bj; if (bj == 0) rope8(v0, v1, tab, t, pos, 1.f);
                        dst = KV + (size_t)kvi * ((size_t)MTOK * 128) + ((size_t)(b * 2 + g) * SEQ + t) * 64 + pos; }
                    else if (pn <= 8) { const int h = cit >> 6, pos = cit & 63; if (pn < 8) rope8(v0, v1, tab, t, pos, pn == 6 ? QSCALE : 1.f);
                        dst = Mo + (size_t)(pn - 6) * ((size_t)MTOK * 256) + ((size_t)(b * 4 + h) * SEQ + t) * 64 + pos; }
                    else if (pn <= 20) {
#pragma unroll
                        for (int e = 0; e < 4; ++e) { v0[e] = sigmoidf_(v0[e]); v1[e] = sigmoidf_(v1[e]); }
                        dst = G + (size_t)row * 3072 + (pn - 9) * 256 + cit; }
                    else {
#pragma unroll
                        for (int e = 0; e < 4; ++e) { v0[e] = sigmoidf_(v0[e]); v1[e] = sigmoidf_(v1[e]); }
                        dst = Gn + (size_t)row * 32 + (cit & 31); if (cit >= 32) dst = nullptr; }
                    if (dst) *(u32x4*)dst = pack8(v0, v1);
                }
                asm volatile("" ::: "memory");
            }
    }
};
struct EpiBranch {
    static constexpr bool KHOOK = true;
    const bf16_t* G; bf16_t* out;
    __device__ __forceinline__ void khook(f32x4 (&acc)[2][2][4][2], const Unit& u, int t, int wr, int wc, int fr, int fq) const {
        asm volatile("" : "+v"(fr), "+v"(fq));
        const int gsel = (t == 4) ? 0 : 1024;
#pragma unroll
        for (int ai = 0; ai < 2; ++ai)
#pragma unroll
            for (int m = 0; m < 4; ++m) {
                const int row = u.pm * 256 + ai * 128 + wr * 64 + m * 16 + fr;
#pragma unroll
                for (int bj = 0; bj < 2; ++bj) {
                    const int col = u.pn * 256 + bj * 128 + wc * 32 + 8 * fq;
                    const u32x4 gx = *(const u32x4*)(G + (size_t)row * 3072 + gsel + col), gy = *(const u32x4*)(G + (size_t)row * 3072 + gsel + 1024 + col);
#pragma unroll
                    for (int e = 0; e < 4; ++e) {
                        const float x0 = fmaxf(bflo(gx[e]), 1e-20f), x1 = fmaxf(bfhi(gx[e]), 1e-20f), y0 = fmaxf(bflo(gy[e]), 1e-20f), y1 = fmaxf(bfhi(gy[e]), 1e-20f);
                        const float r0 = x0 * __builtin_amdgcn_rcpf(y0), r1 = x1 * __builtin_amdgcn_rcpf(y1);
                        acc[ai][bj][m][e >> 1][(e & 1) * 2] *= r0; acc[ai][bj][m][e >> 1][(e & 1) * 2 + 1] *= r1;
                    }
                    asm volatile("" ::: "memory");
                }
            }
    }
    __device__ __forceinline__ void operator()(const f32x4 (&acc)[2][2][4][2], const Unit& u, int wr, int wc, int fr, int fq) const {
        asm volatile("" : "+v"(fr), "+v"(fq));
#pragma unroll
        for (int ai = 0; ai < 2; ++ai)
#pragma unroll
            for (int m = 0; m < 4; ++m) {
                const int row = u.pm * 256 + ai * 128 + wr * 64 + m * 16 + fr;
#pragma unroll
                for (int bj = 0; bj < 2; ++bj) {
                    const int col = u.pn * 256 + bj * 128 + wc * 32 + 8 * fq;
                    const u32x4 gz = *(const u32x4*)(G + (size_t)row * 3072 + 2048 + col);
                    f32x4 v0 = acc[ai][bj][m][0], v1 = acc[ai][bj][m][1];
                    v0[0] *= fmaxf(bflo(gz[0]), 1e-20f); v0[1] *= fmaxf(bfhi(gz[0]), 1e-20f); v0[2] *= fmaxf(bflo(gz[1]), 1e-20f); v0[3] *= fmaxf(bfhi(gz[1]), 1e-20f);
                    v1[0] *= fmaxf(bflo(gz[2]), 1e-20f); v1[1] *= fmaxf(bfhi(gz[2]), 1e-20f); v1[2] *= fmaxf(bflo(gz[3]), 1e-20f); v1[3] *= fmaxf(bfhi(gz[3]), 1e-20f);
                    *(u32x4*)(out + (size_t)row * DM + col) = pack8(v0, v1);
                }
                asm volatile("" ::: "memory");
            }
    }
};
struct EpiResid {
    static constexpr bool KHOOK = false;
    const float* base; float* out; bf16_t* xb; float* ssp;
    __device__ __forceinline__ void operator()(const f32x4 (&acc)[2][2][4][2], const Unit& u, int wr, int wc, int fr, int fq) const {
        asm volatile("" : "+v"(fr), "+v"(fq));
#pragma unroll
        for (int ai = 0; ai < 2; ++ai)
#pragma unroll
            for (int m = 0; m < 4; ++m) {
                const int row = u.pm * 256 + ai * 128 + wr * 64 + m * 16 + fr;
                float ss = 0.f;
#pragma unroll
                for (int bj = 0; bj < 2; ++bj) {
                    const size_t off = (size_t)row * DM + u.pn * 256 + bj * 128 + wc * 32 + 8 * fq;
                    const f32x4 v0 = acc[ai][bj][m][0] + *(const f32x4*)(base + off), v1 = acc[ai][bj][m][1] + *(const f32x4*)(base + off + 4);
                    *(f32x4*)(out + off) = v0; *(f32x4*)(out + off + 4) = v1;
                    *(u32x4*)(xb + off) = pack8(v0, v1);
                    ss += (v0[0] * v0[0] + v0[1] * v0[1]) + (v0[2] * v0[2] + v0[3] * v0[3]) + (v1[0] * v1[0] + v1[1] * v1[1]) + (v1[2] * v1[2] + v1[3] * v1[3]);
                }
                ss += __shfl_xor(ss, 16); ss += __shfl_xor(ss, 32);
                if (fq == 0) ssp[(size_t)row * 16 + u.pn * 4 + wc] = ss;
                asm volatile("" ::: "memory");
            }
    }
};
struct EpiSwiGLU {
    static constexpr bool KHOOK = false;
    const float* ssp; bf16_t* H;
    __device__ __forceinline__ void operator()(const f32x4 (&acc)[2][2][4][2], const Unit& u, int wr, int wc, int fr, int fq) const {
        asm volatile("" : "+v"(fr), "+v"(fq));
#pragma unroll
        for (int ai = 0; ai < 2; ++ai)
#pragma unroll
            for (int m = 0; m < 4; ++m) {
                const int row = u.pm * 256 + ai * 128 + wr * 64 + m * 16 + fr;
                const float rstd = row_rstd(ssp, row);
                f32x4 o[2];
#pragma unroll
                for (int n = 0; n < 2; ++n)
#pragma unroll
                    for (int e = 0; e < 4; ++e) { const float gt = acc[ai][0][m][n][e] * rstd, up = acc[ai][1][m][n][e] * rstd; o[n][e] = gt * sigmoidf_(gt) * up; }
                *(u32x4*)(H + (size_t)row * DFF + u.pn * 128 + wc * 32 + 8 * fq) = pack8(o[0], o[1]);
                asm volatile("" ::: "memory");
            }
    }
};
#ifndef ABL_NSA_SCALE
#define ABL_NSA_SCALE
#endif
#ifndef ABL_MOBA_SCALE
#define ABL_MOBA_SCALE
#endif
namespace att {
constexpr int KCS = 1040, KSLOT = 8 * KCS, VSLOT = 8192;
constexpr int L_K0 = 0, L_K1 = KSLOT, L_V0 = 2 * KSLOT, L_V1 = 2 * KSLOT + VSLOT, L_WSF = 2 * KSLOT + 2 * VSLOT, L_PS = L_WSF + 8 * 256, L_MSK = L_PS + 64 * 128 * 4,
              L_UNI = L_MSK + 1024, L_LIST = L_UNI + 64, L_END = L_LIST + 512, L_OT = L_END + 64, L_TOTAL = L_OT + 8 * 8192;
#define LBAR() asm volatile("s_waitcnt lgkmcnt(0)\n\ts_barrier" ::: "memory")
#define LWAIT() asm volatile("s_waitcnt lgkmcnt(0)" ::: "memory")
__device__ __forceinline__ int crow(int r, int hi) { return (r & 3) + 8 * (r >> 2) + 4 * hi; }
__device__ __forceinline__ float swap_other(float v, int hi) { auto rr = __builtin_amdgcn_permlane32_swap(__float_as_uint(v), __float_as_uint(v), false, false); return __uint_as_float(hi ? rr[0] : rr[1]); }
__device__ __forceinline__ void qkt(f32x16& p0, f32x16& p1, const LAS char* Ks, const bf16x8* qr, int r32, int hi) {
    const LAS char* kb = Ks + hi * KCS + r32 * 16;
    p0 = f32x16{}; p1 = f32x16{};
#pragma unroll
    for (int d0 = 0; d0 < 4; ++d0) {
        const bf16x8 b0 = *(const LAS bf16x8*)(kb + d0 * 2 * KCS), b1 = *(const LAS bf16x8*)(kb + d0 * 2 * KCS + 512);
        p0 = __builtin_amdgcn_mfma_f32_32x32x16_bf16(b0, qr[d0], p0, 0, 0, 0); p1 = __builtin_amdgcn_mfma_f32_32x32x16_bf16(b1, qr[d0], p1, 0, 0, 0); }
}
struct VFrag { s16x4 lo[8], hi[8]; };
typedef short v4i16_t __attribute__((ext_vector_type(4)));
__device__ __forceinline__ s16x4 vtr(const LAS char* p) { return __builtin_bit_cast(s16x4, __builtin_amdgcn_ds_read_tr16_b64_v4i16((LAS v4i16_t*)p)); }
__device__ __forceinline__ void v_issue(VFrag& F, const LAS char* vp) {
#pragma unroll
    for (int d0 = 0; d0 < 2; ++d0)
#pragma unroll
        for (int ks = 0; ks < 4; ++ks) { F.lo[d0 * 4 + ks] = vtr(vp + d0 * 4096 + ks * 1024); F.hi[d0 * 4 + ks] = vtr(vp + d0 * 4096 + ks * 1024 + 512); }
}
__device__ __forceinline__ void pv(f32x16* o, VFrag& F, bf16x8 pa0, bf16x8 pa1, bf16x8 pa2, bf16x8 pa3) {
#define PK(k) (bf16x8){F.lo[k][0], F.lo[k][1], F.lo[k][2], F.lo[k][3], F.hi[k][0], F.hi[k][1], F.hi[k][2], F.hi[k][3]}
    __builtin_amdgcn_s_setprio(1);
    o[0] = __builtin_amdgcn_mfma_f32_32x32x16_bf16(pa0, PK(0), o[0], 0, 0, 0);
    o[1] = __builtin_amdgcn_mfma_f32_32x32x16_bf16(pa0, PK(4), o[1], 0, 0, 0);
    o[0] = __builtin_amdgcn_mfma_f32_32x32x16_bf16(pa1, PK(1), o[0], 0, 0, 0);
    o[1] = __builtin_amdgcn_mfma_f32_32x32x16_bf16(pa1, PK(5), o[1], 0, 0, 0);
    o[0] = __builtin_amdgcn_mfma_f32_32x32x16_bf16(pa2, PK(2), o[0], 0, 0, 0);
    o[1] = __builtin_amdgcn_mfma_f32_32x32x16_bf16(pa2, PK(6), o[1], 0, 0, 0);
    o[0] = __builtin_amdgcn_mfma_f32_32x32x16_bf16(pa3, PK(3), o[0], 0, 0, 0);
    o[1] = __builtin_amdgcn_mfma_f32_32x32x16_bf16(pa3, PK(7), o[1], 0, 0, 0);
    __builtin_amdgcn_s_setprio(0);
#undef PK
}
__device__ __forceinline__ float rowmax(const f32x16& p0, const f32x16& p1, int hi) {
    float a = __builtin_fmaxf(p0[0], p1[0]);
#pragma unroll
    for (int r = 1; r < 16; ++r) a = __builtin_fmaxf(__builtin_fmaxf(a, p0[r]), p1[r]);
    return __builtin_fmaxf(a, swap_other(a, hi));
}
struct KVRegs { u32x4 k, v; };
__device__ __forceinline__ void tile_load(KVRegs& R, const bf16_t* K, const bf16_t* V, int tid) { R.k = *(const u32x4*)(K + tid * 8); R.v = *(const u32x4*)(V + tid * 8); }
__device__ __forceinline__ void tile_store(const KVRegs& R, LAS char* Ks, LAS char* Vs, int tid) {
    const int row = tid >> 3, c = tid & 7;
    *(LAS u32x4*)(Ks + c * KCS + row * 16) = R.k;
    *(LAS u32x4*)(Vs + (c >> 2) * 4096 + (row >> 4) * 1024 + (row & 15) * 64 + (c & 3) * 16) = R.v;
}
__device__ __forceinline__ void ps_accum(const f32x16 p, int jb, LAS float* ps_row, bool writer) {
#pragma unroll
    for (int rg = 0; rg < 4; ++rg) {
        float a = 2.f * (p[4 * rg] + p[4 * rg + 1] + p[4 * rg + 2]) + p[4 * rg + 3], bq = p[4 * rg + 3];
        a += __shfl_xor(a, 1); a += __shfl_xor(a, 2); bq += __shfl_xor(bq, 1); bq += __shfl_xor(bq, 2);
        const int j = jb + 2 * rg;
        if (writer) { __hip_atomic_fetch_add(ps_row + j, a, __ATOMIC_RELAXED, __HIP_MEMORY_SCOPE_WORKGROUP); if (j + 1 < 128) __hip_atomic_fetch_add(ps_row + j + 1, bq, __ATOMIC_RELAXED, __HIP_MEMORY_SCOPE_WORKGROUP); }
    }
}
struct Ctx { LAS char* lds; LAS float* wsf; LAS float* otl; int tid, wid, lane, r32, hi, vbl; };
template <int MODE, class Src, class Msk>
__device__ __forceinline__ void run_branch(const Ctx& C, int nt, const Src& src, const Msk& msk, const bf16x8* qr, float& m, float& l, f32x16* o, float invl, LAS float* ps_row, bool ps_writer) {
    if (nt <= 0) return;
    KVRegs R; const bf16_t *kp, *vp;
    src(0, kp, vp); tile_load(R, kp, vp, C.tid);
    LBAR();
    for (int it = 0; it < nt; ++it) {
        LAS char* Ks = C.lds + ((it & 1) ? L_K1 : L_K0); LAS char* Vs = C.lds + ((it & 1) ? L_V1 : L_V0);
        tile_store(R, Ks, Vs, C.tid);
        if (it + 1 < nt) { src(it + 1, kp, vp); tile_load(R, kp, vp, C.tid); }
        int klo, khi; const bool nm = msk(it, klo, khi);
        LBAR();
        const bool kill = khi < klo;
        if (!__any(!kill)) continue;
        f32x16 p0, p1; qkt(p0, p1, Ks, qr, C.r32, C.hi);
        VFrag VF; if constexpr (MODE != 0) v_issue(VF, Vs + C.vbl);
        if (__any(nm && !kill)) {
#pragma unroll
            for (int r = 0; r < 16; ++r) { const int kv = crow(r, C.hi); if (kv < klo || kv > khi) p0[r] = -INFINITY; if (kv + 32 < klo || kv + 32 > khi) p1[r] = -INFINITY; }
        }
        if constexpr (MODE == 2) {
            const float sub = kill ? INFINITY : m;
#pragma unroll
            for (int r = 0; r < 16; ++r) { p0[r] = __builtin_amdgcn_exp2f(p0[r] - sub) * invl; p1[r] = __builtin_amdgcn_exp2f(p1[r] - sub) * invl; }
            ps_accum(p0, 16 * it + C.hi, ps_row, ps_writer); ps_accum(p1, 16 * it + 8 + C.hi, ps_row, ps_writer);
        } else {
            float rm = rowmax(p0, p1, C.hi); if (kill) rm = -INFINITY;
            const bool grow = rm > m + 8.0f;
            if (__any(grow)) {
                const float mn = grow ? rm : m, alpha = __builtin_amdgcn_exp2f(m - mn);
                l *= alpha; m = mn;
                if constexpr (MODE == 1) {
                    if (C.hi == 0) C.wsf[C.r32] = alpha;
                    LWAIT();
#pragma unroll
                    for (int r = 0; r < 16; ++r) { const float f = C.wsf[crow(r, C.hi)]; o[0][r] *= f; o[1][r] *= f; }
                    LWAIT();
                }
            }
            const float sub = kill ? INFINITY : m;
            float s = 0.f;
#pragma unroll
            for (int r = 0; r < 16; ++r) { p0[r] = __builtin_amdgcn_exp2f(p0[r] - sub); p1[r] = __builtin_amdgcn_exp2f(p1[r] - sub); s += p0[r] + p1[r]; }
            l += s;
        }
        if constexpr (MODE != 0) {
            u32x4 w0 = {cvtpk(p0[0], p0[1]), cvtpk(p0[2], p0[3]), cvtpk(p0[4], p0[5]), cvtpk(p0[6], p0[7])}, w1 = {cvtpk(p0[8], p0[9]), cvtpk(p0[10], p0[11]), cvtpk(p0[12], p0[13]), cvtpk(p0[14], p0[15])};
            u32x4 w2 = {cvtpk(p1[0], p1[1]), cvtpk(p1[2], p1[3]), cvtpk(p1[4], p1[5]), cvtpk(p1[6], p1[7])}, w3 = {cvtpk(p1[8], p1[9]), cvtpk(p1[10], p1[11]), cvtpk(p1[12], p1[13]), cvtpk(p1[14], p1[15])};
            pv(o, VF, __builtin_bit_cast(bf16x8, w0), __builtin_bit_cast(bf16x8, w1), __builtin_bit_cast(bf16x8, w2), __builtin_bit_cast(bf16x8, w3));
        }
    }
}
template <bool FIRST> __device__ __forceinline__ void merge_branch(const Ctx& C, const f32x16* o, float factor) {
    if (C.hi == 0) C.wsf[C.r32] = factor;
    LWAIT();
#pragma unroll
    for (int r = 0; r < 16; ++r) { const float f = C.wsf[crow(r, C.hi)];
        if (FIRST) { C.otl[r * 64] = o[0][r] * f; C.otl[(16 + r) * 64] = o[1][r] * f; }
        else { C.otl[r * 64] += o[0][r] * f; C.otl[(16 + r) * 64] += o[1][r] * f; } }
    LWAIT();
}
struct Bufs { const bf16_t *Qn, *KV, *Mo, *KC, *KM, *Gn; bf16_t* Abr; };
constexpr size_t KV_STRIDE = (size_t)MTOK * 128, MO_STRIDE = (size_t)MTOK * 256;

__device__ __forceinline__ void nsa_item(const Ctx& C, const Bufs& B, int b, int g, int i) {
    const int r32 = C.r32, hi = C.hi, wid = C.wid;
    const int qi = 8 * wid + (r32 >> 2), hh = r32 & 3, head = g * 4 + hh, t = 64 * i + qi, cur = i;
    const size_t bg = (size_t)(b * 2 + g) * SEQ;
    bf16x8 qr[4];
    { const bf16_t* qp = B.Qn + ((size_t)(b * 8 + head) * SEQ + t) * 64 + hi * 8;
#pragma unroll
      for (int d0 = 0; d0 < 4; ++d0) qr[d0] = *(const bf16x8*)(qp + d0 * 16); }
    const unsigned gw = *(const unsigned*)(B.Gn + ((size_t)b * SEQ + t) * 32 + head * 3 - (head & 1));
    const unsigned gw2 = *(const unsigned*)(B.Gn + ((size_t)b * SEQ + t) * 32 + head * 3 - (head & 1) + 2);
    float g0, g1, g2; if (head & 1) { g0 = bfhi(gw); g1 = bflo(gw2); g2 = bfhi(gw2); } else { g0 = bflo(gw); g1 = bfhi(gw); g2 = bflo(gw2); }
    f32x16 o[2];
    LAS float* Ps = (LAS float*)(C.lds + L_PS); LAS unsigned* Mk = (LAS unsigned*)(C.lds + L_MSK); LAS unsigned* Uni = (LAS unsigned*)(C.lds + L_UNI); LAS int* List = (LAS int*)(C.lds + L_LIST);
    const int nv = t >= 31 ? ((t - 31) >> 4) + 1 : 0;
    const int nvt = (4 * i + 3 < 511) ? 4 * i + 3 : 511, ntc = (nvt + 63) >> 6;
    const bf16_t* kc = B.KC + (size_t)(0 * 4 + b * 2 + g) * 512 * 64; const bf16_t* vc = B.KC + (size_t)(1 * 4 + b * 2 + g) * 512 * 64;
    auto srcC = [&](int it, const bf16_t*& kp, const bf16_t*& vp) { kp = kc + (size_t)it * 4096; vp = vc + (size_t)it * 4096; };
    auto mskC = [&](int it, int& klo, int& khi) { klo = 0; khi = nv - 1 - 64 * it; return khi < 63; };
    float m = -1e30f, l = 0.f;
    run_branch<0>(C, ntc, srcC, mskC, qr, m, l, o, 0.f, nullptr, false);
    l += swap_other(l, hi);
    const float invl = l > 0.f ? 1.0f / l : 0.f;
    for (int e = C.tid; e < 64 * 128; e += 512) Ps[e] = 0.f;
    if (C.tid < 8) Uni[C.tid] = 0u;
    o[0] = f32x16{}; o[1] = f32x16{};
    run_branch<2>(C, ntc, srcC, mskC, qr, m, l, o, invl, Ps + qi * 128, hh == 0);
    merge_branch<true>(C, o, g0);
    LBAR();
    {
        const int nf = cur == 0 ? 1 : (cur == 1 ? 2 : 3), kp_ = 16 - nf, lane = C.lane;
#pragma unroll 1
        for (int qq = 0; qq < 8; ++qq) {
            int q = 8 * wid + qq; asm volatile("" : "+s"(q)); LAS float* ps = Ps + q * 128;
            const int j0 = lane, j1 = lane + 64;
            const bool f0 = (j0 == 0 || j0 == cur || j0 == cur - 1) && j0 <= cur, f1 = (j1 == cur || j1 == cur - 1) && j1 <= cur;
            const bool va0 = j0 <= cur && !f0, va1 = j1 <= cur && !f1;
            const float v0 = va0 ? ps[j0] : -1.f, v1 = va1 ? ps[j1] : -1.f;
            int r0 = 0, r1 = 0;
            for (int e = 1; e <= cur; ++e) {
                float ve = ps[e]; if (e == cur || e == cur - 1) ve = -2.f;
                r0 += (ve > v0 || (ve == v0 && e < j0)) ? 1 : 0; r1 += (ve > v1 || (ve == v1 && e < j1)) ? 1 : 0;
            }
            const bool s0 = f0 || (va0 && r0 < kp_), s1 = f1 || (va1 && r1 < kp_);
            const unsigned long long b0 = __ballot(s0), b1 = __ballot(s1);
            if (lane == 0) { Mk[q * 4 + 0] = (unsigned)b0; Mk[q * 4 + 1] = (unsigned)(b0 >> 32); Mk[q * 4 + 2] = (unsigned)b1; Mk[q * 4 + 3] = (unsigned)(b1 >> 32);
                __hip_atomic_fetch_or(&Uni[0], (unsigned)b0, __ATOMIC_RELAXED, __HIP_MEMORY_SCOPE_WORKGROUP); __hip_atomic_fetch_or(&Uni[1], (unsigned)(b0 >> 32), __ATOMIC_RELAXED, __HIP_MEMORY_SCOPE_WORKGROUP); __hip_atomic_fetch_or(&Uni[2], (unsigned)b1, __ATOMIC_RELAXED, __HIP_MEMORY_SCOPE_WORKGROUP); __hip_atomic_fetch_or(&Uni[3], (unsigned)(b1 >> 32), __ATOMIC_RELAXED, __HIP_MEMORY_SCOPE_WORKGROUP); }
        }
    }
    LBAR();
    if (C.tid == 0) { int n = 0; for (int w = 0; w < 4; ++w) { unsigned u = Uni[w]; while (u) { const int bpos = __builtin_ctz(u); u &= u - 1; List[n++] = w * 32 + bpos; } } Uni[4] = (unsigned)n; }
    LBAR();
    {
        const int nsel = (int)Uni[4];
        const bf16_t* ks = B.KV + 2 * KV_STRIDE + bg * 64; const bf16_t* vs = B.KV + 3 * KV_STRIDE + bg * 64;
        auto srcS = [&](int it, const bf16_t*& kp, const bf16_t*& vp) { const int j = List[it]; kp = ks + (size_t)j * 4096; vp = vs + (size_t)j * 4096; };
        auto mskS = [&](int it, int& klo, int& khi) { const int j = List[it]; const unsigned w = Mk[qi * 4 + (j >> 5)]; const bool bit = (w >> (j & 31)) & 1u;
            klo = 0; khi = bit ? (j == cur ? qi : 63) : -1; return j == cur; };
        m = -1e30f; l = 0.f; o[0] = f32x16{}; o[1] = f32x16{};
        run_branch<1>(C, nsel, srcS, mskS, qr, m, l, o, 0.f, nullptr, false);
        l += swap_other(l, hi);
        merge_branch<false>(C, o, l > 0.f ? g1 / l : 0.f);
    }
    {
        const int tw0 = i >= 8 ? i - 8 : 0, ntw = i - tw0 + 1;
        const bf16_t* kw = B.KV + 4 * KV_STRIDE + bg * 64; const bf16_t* vw = B.KV + 5 * KV_STRIDE + bg * 64;
        auto srcW = [&](int it, const bf16_t*& kp, const bf16_t*& vp) { kp = kw + (size_t)(tw0 + it) * 4096; vp = vw + (size_t)(tw0 + it) * 4096; };
        auto mskW = [&](int it, int& klo, int& khi) { const int tw = tw0 + it; klo = (t - 511) - 64 * tw; khi = (tw == i) ? qi : 63; return tw == i || klo > 0; };
        m = -1e30f; l = 0.f; o[0] = f32x16{}; o[1] = f32x16{};
        run_branch<1>(C, ntw, srcW, mskW, qr, m, l, o, 0.f, nullptr, false);
        l += swap_other(l, hi);
        merge_branch<false>(C, o, l > 0.f ? g2 / l : 0.f);
    }
#pragma unroll
    for (int r = 0; r < 16; ++r) { const int qrow = crow(r, hi); bf16_t* dst = B.Abr + ((size_t)b * SEQ + 64 * i + 8 * wid + (qrow >> 2)) * DM + 256 + (g * 4 + (qrow & 3)) * 64 + r32;
        dst[0] = (bf16_t)(cvtpk(ABL_NSA_SCALE C.otl[r * 64], 0.f) & 0xffffu); dst[32] = (bf16_t)(cvtpk(ABL_NSA_SCALE C.otl[(16 + r) * 64], 0.f) & 0xffffu); }
}
__device__ __forceinline__ void moba_item(const Ctx& C, const Bufs& B, int b, int h, int qb) {
    const int r32 = C.r32, hi = C.hi, wid = C.wid, own = qb, t = 256 * qb + 32 * wid + r32;
    const size_t bh = (size_t)(b * 4 + h) * SEQ;
    bf16x8 qr[4];
    { const bf16_t* qp = B.Mo + (bh + t) * 64 + hi * 8;
#pragma unroll
      for (int d0 = 0; d0 < 4; ++d0) qr[d0] = *(const bf16x8*)(qp + d0 * 16); }
    LAS unsigned* Uni = (LAS unsigned*)(C.lds + L_UNI); LAS int* List = (LAS int*)(C.lds + L_LIST);
    LBAR();
    if (C.tid < 256) { const u32x4 kmv = *(const u32x4*)(B.KM + (size_t)(b * 4 + h) * 2048 + C.tid * 8); *(LAS u32x4*)(C.lds + L_K0 + (C.tid & 7) * KCS + (C.tid >> 3) * 16) = kmv; }
    if (C.tid == 0) Uni[0] = 0u;
    LBAR();
    unsigned sel = 0u;
    {
        f32x16 gs = f32x16{};
        const LAS char* kb = C.lds + L_K0 + hi * KCS + r32 * 16;
#pragma unroll
        for (int d0 = 0; d0 < 4; ++d0) gs = __builtin_amdgcn_mfma_f32_32x32x16_bf16(*(const LAS bf16x8*)(kb + d0 * 2 * KCS), qr[d0], gs, 0, 0, 0);
        float lo[16], hv[16];
#pragma unroll
        for (int r = 0; r < 16; ++r) { const float ownv = gs[r], oth = swap_other(ownv, hi); lo[r] = hi ? oth : ownv; hv[r] = hi ? ownv : oth; }
        unsigned taken = ~((1u << own) - 1u);
#pragma unroll
        for (int round = 0; round < 3; ++round) {
            float best = -INFINITY; int bi = 32;
#pragma unroll
            for (int n = 0; n < 32; ++n) { const int rr = (n & 3) + 4 * (n >> 3); const float v = ((n >> 2) & 1) ? hv[rr] : lo[rr]; if (!((taken >> n) & 1u) && v > best) { best = v; bi = n; } }
            if (bi < 32) { sel |= 1u << bi; taken |= 1u << bi; }
        }
    }
    { unsigned u = sel;
#pragma unroll
      for (int o_ = 1; o_ < 64; o_ <<= 1) u |= (unsigned)__shfl_xor((int)u, o_);
      if (C.lane == 0) __hip_atomic_fetch_or(&Uni[0], u, __ATOMIC_RELAXED, __HIP_MEMORY_SCOPE_WORKGROUP); }
    LBAR();
    if (C.tid == 0) { int n = 0; unsigned u = Uni[0]; while (u) { const int bpos = __builtin_ctz(u); u &= u - 1; List[n++] = bpos; } Uni[4] = (unsigned)n; }
    LBAR();
    const int nl = (int)Uni[4], nt = 4 * nl + 4;
    const bf16_t* kk = B.Mo + MO_STRIDE + bh * 64; const bf16_t* vv = B.Mo + 2 * MO_STRIDE + bh * 64;
    auto src = [&](int it, const bf16_t*& kp, const bf16_t*& vp) { const int T = (it < 4 * nl) ? 4 * List[it >> 2] + (it & 3) : 4 * own + (it - 4 * nl); kp = kk + (size_t)T * 4096; vp = vv + (size_t)T * 4096; };
    auto msk = [&](int it, int& klo, int& khi) { klo = 0; if (it < 4 * nl) { const bool bit = (sel >> List[it >> 2]) & 1u; khi = bit ? 63 : -1; return false; } khi = 32 * wid + r32 - 64 * (it - 4 * nl); return true; };
    float m = -1e30f, l = 0.f; f32x16 o[2] = {f32x16{}, f32x16{}};
    run_branch<1>(C, nt, src, msk, qr, m, l, o, 0.f, nullptr, false);
    l += swap_other(l, hi);
    merge_branch<true>(C, o, l > 0.f ? 1.0f / l : 0.f);
#pragma unroll
    for (int r = 0; r < 16; ++r) { const int qrow = crow(r, hi); bf16_t* dst = B.Abr + ((size_t)b * SEQ + 256 * qb + 32 * wid + qrow) * DM + 768 + h * 64 + r32;
        dst[0] = (bf16_t)(cvtpk(ABL_MOBA_SCALE C.otl[r * 64], 0.f) & 0xffffu); dst[32] = (bf16_t)(cvtpk(ABL_MOBA_SCALE C.otl[(16 + r) * 64], 0.f) & 0xffffu); }
}
}
#define XB_TMO      128
#define XB_XCNT(j)  (256  + 64 * (j))
#define XB_XSUB(j)  (1280 + 64 * (j))
#define XB_XGEN(j)  (2304 + 64 * (j))
#define XB_TOP      3328
#define XB_TOPGEN   3392
#define XCD_BAR_WORDS 3456
#define XB_SPIN_CAP (1u << 18)

__device__ __forceinline__ unsigned xb_ld(unsigned* p)              { return __hip_atomic_load(p, __ATOMIC_RELAXED, __HIP_MEMORY_SCOPE_AGENT); }
__device__ __forceinline__ unsigned xb_add(unsigned* p, unsigned v) { return __hip_atomic_fetch_add(p, v, __ATOMIC_RELAXED, __HIP_MEMORY_SCOPE_AGENT); }
__device__ __forceinline__ unsigned xb_xcc_id() { return (unsigned)__builtin_amdgcn_s_getreg((3 << 11) | 20) & 0xFu; }
#define XB_SPIN(cond, bar) do { unsigned _sp = 0; while (cond) { __builtin_amdgcn_s_sleep(1); \
    if ((++_sp & 255u) == 0u) { if (xb_ld(&(bar)[XB_TMO])) break; if (_sp > XB_SPIN_CAP) { atomicAdd(&(bar)[XB_TMO], 1u); break; } } } } while (0)

struct XcdBarrier {
    unsigned* bar; unsigned x;
    volatile LAS unsigned* st;
};

__device__ __forceinline__ XcdBarrier xcd_barrier_post(unsigned* bar, volatile LAS unsigned* st) {
    XcdBarrier b; b.bar = bar; b.x = xb_xcc_id(); b.st = st;
    if (threadIdx.x == 0) (void)xb_add(&bar[XB_XCNT(b.x)], 1u);
    return b;
}
__device__ __forceinline__ void xcd_barrier_complete(unsigned* bar, unsigned x, unsigned& nloc, unsigned& nx) {
    const unsigned G = gridDim.x * gridDim.y * gridDim.z;
    unsigned sum, cnt, mine, sp = 0u;
    for (;;) {
        sum = 0u; cnt = 0u; mine = 0u;
#pragma unroll
        for (unsigned j = 0; j < 16; ++j) { const unsigned c = xb_ld(&bar[XB_XCNT(j)]); sum += c; cnt += (c > 0u) ? 1u : 0u; mine = (j == x) ? c : mine; }
        if (sum == G) break;
        __builtin_amdgcn_s_sleep(1);
        if ((++sp & 255u) == 0u) { if (xb_ld(&bar[XB_TMO])) break; if (sp > XB_SPIN_CAP) { atomicAdd(&bar[XB_TMO], 1u); break; } }
    }
    nloc = mine > 0u ? mine : 1u; nx = cnt > 0u ? cnt : 1u;
}

__device__ __forceinline__ void xcd_barrier(const XcdBarrier& b) {
    asm volatile("s_waitcnt vmcnt(0)" ::: "memory");
    __syncthreads();
    if (threadIdx.x == 0) {
        unsigned* bar = b.bar;
        __builtin_amdgcn_s_waitcnt(0);
        unsigned nloc = b.st[0], nx = b.st[1];
        if (nloc == 0u) { xcd_barrier_complete(bar, b.x, nloc, nx); b.st[0] = nloc; b.st[1] = nx; }
        const unsigned old = xb_add(&bar[XB_XSUB(b.x)], 1u);
        const unsigned gen = old / nloc;
        if (old + 1u == (gen + 1u) * nloc) {
            __builtin_amdgcn_fence(__ATOMIC_RELEASE, "agent");
            asm volatile("s_waitcnt vmcnt(0)" ::: "memory");
            const unsigned og = xb_add(&bar[XB_TOP], 1u);
            const unsigned tg = og / nx;
            if (og + 1u == (tg + 1u) * nx) xb_add(&bar[XB_TOPGEN], 1u);
            else XB_SPIN(xb_ld(&bar[XB_TOPGEN]) == tg, bar);
            __builtin_amdgcn_fence(__ATOMIC_ACQUIRE, "agent");
            xb_add(&bar[XB_XGEN(b.x)], 1u);
            asm volatile("s_waitcnt vmcnt(0)" ::: "memory");
        } else {
            XB_SPIN(xb_ld(&bar[XB_XGEN(b.x)]) == gen, bar);
            __builtin_amdgcn_fence(__ATOMIC_ACQUIRE, "agent");
            asm volatile("s_waitcnt vmcnt(0)" ::: "memory");
        }
    }
    __syncthreads();
}

#ifndef DUP
#define DUP 0
#endif
constexpr size_t MiB = 1u << 20;
constexpr size_t WS_CTL = 0, WS_ORDER = 4096, WS_BAR = 8192;
constexpr size_t WS_W = 1 * MiB, OFF_WIN = 0, OFF_WGU = 11 * MiB, OFF_WD = 22 * MiB, OFF_WBR = 28 * MiB, OFF_WOUT = 30 * MiB, OFF_W1 = 32 * MiB, OFF_W2 = 34 * MiB,
                 OFF_BIN = 34 * MiB + 65536, OFF_CB1 = OFF_BIN + 32768  , OFF_CB2 = OFF_CB1 + 65536;
constexpr size_t WS_TAB = 36 * MiB, WS_SSP = 38 * MiB, WS_KC = 39 * MiB, WS_KM = 39 * MiB + 512 * 1024, WS_GN = 40 * MiB, WS_XB = 42 * MiB, WS_BIG = 74 * MiB,
                 WS_U = 170 * MiB, WS_QN = 178 * MiB, WS_KV = 194 * MiB, WS_MO = 218 * MiB, WS_MRG = 178 * MiB, WS_END = 242 * MiB;
constexpr int LDS_BYTES = 147456;

__device__ __forceinline__ int dint(int pos) { return (pos >> 1) + 32 * (pos & 1); }
__device__ __forceinline__ int in_orig(int c) {
    if (c < 256) return c;
    if (c < 768) { const int c2 = c - 256; return 256 + (c2 >> 6) * 64 + dint(c2 & 63); }
    if (c < 1536) { const int c2 = c - 768, tt = c2 >> 8, bj = (c2 >> 7) & 1, g = (c2 >> 6) & 1, pos = c2 & 63; return 768 + (2 * tt + bj) * 128 + g * 64 + (bj == 0 ? dint(pos) : pos); }
    if (c < 2304) { const int c2 = c - 1536, part = c2 >> 8, h = (c2 >> 6) & 3, pos = c2 & 63; return 1560 + part * 256 + h * 64 + (part < 2 ? dint(pos) : pos); }
    if (c < 5376) return 2328 + (c - 2304);
    const int c2 = c - 5376; return c2 < 24 ? 1536 + c2 : -1;
}
template <class F> __device__ __forceinline__ void cvt_tile(LAS float* scr, int lane, int k0, int n0, bf16_t* dst, size_t pitch, F f) {
    float vals[32];
#pragma unroll
    for (int i = 0; i < 32; ++i) vals[i] = f(k0 + 2 * i + (lane >> 5), n0 + (lane & 31));
#pragma unroll
    for (int i = 0; i < 32; ++i) scr[(2 * i + (lane >> 5)) * 33 + (lane & 31)] = vals[i];
    asm volatile("s_waitcnt lgkmcnt(0)" ::: "memory");
    const int c = lane & 7;
#pragma unroll
    for (int j = 0; j < 4; ++j) { const int n = (lane >> 3) + 8 * j; const LAS float* s = scr + (8 * c) * 33 + n;
        u32x4 o; o.x = cvtpk(s[0 * 33], s[1 * 33]); o.y = cvtpk(s[2 * 33], s[3 * 33]); o.z = cvtpk(s[4 * 33], s[5 * 33]); o.w = cvtpk(s[6 * 33], s[7 * 33]);
        *(u32x4*)(dst + (size_t)(n0 + n) * pitch + k0 + 8 * c) = o; }
    asm volatile("s_waitcnt lgkmcnt(0)" ::: "memory");
}
struct Args { const float* in[20]; float* out; unsigned char* ws; };
typedef const __attribute__((address_space(4))) Args* ArgsP;

__device__ __forceinline__ void phase0(ArgsP a, int l, LAS unsigned char* lds, int tid, int lane, int wave, int gw, int NGW) {
    unsigned char* ws = a->ws;
    LAS float* scr = (LAS float*)(lds + wave * 8704);
    const float* attn_norm = a->in[1] + (size_t)l * DM; const float* w_in = a->in[2] + (size_t)l * DM * IN_COLS; const float* b_in = a->in[3] + (size_t)l * IN_COLS;
    const float* pool_w = a->in[4] + (size_t)l * 4 * 64 * 64; const float* pool_scale = a->in[5] + (size_t)l * 256; const float* cmp_pos = a->in[6] + (size_t)l * 2 * 32 * 64;
    const float* cmp_w1 = a->in[7] + (size_t)l * 2 * 2048 * 256; const float* cmp_b1 = a->in[8] + (size_t)l * 2 * 256; const float* cmp_w2 = a->in[9] + (size_t)l * 2 * 256 * 64; const float* cmp_b2 = a->in[10] + (size_t)l * 2 * 64;
    const float* w_br_pool = a->in[11] + (size_t)l * 256 * DM; const float* w_br_nsa = a->in[12] + (size_t)l * 512 * DM; const float* w_br_moba = a->in[13] + (size_t)l * 256 * DM;
    const float* w_out = a->in[14] + (size_t)l * DM * DM; const float* ffn_norm = a->in[15] + (size_t)l * DM; const float* w_gate = a->in[16] + (size_t)l * DM * DFF; const float* w_up = a->in[17] + (size_t)l * DM * DFF;
    const float* w_down = a->in[18] + (size_t)l * DFF * DM;
    bf16_t* Win = (bf16_t*)(ws + WS_W + OFF_WIN); bf16_t* Wgu = (bf16_t*)(ws + WS_W + OFF_WGU); bf16_t* Wd = (bf16_t*)(ws + WS_W + OFF_WD); bf16_t* Wbr = (bf16_t*)(ws + WS_W + OFF_WBR);
    bf16_t* Wout = (bf16_t*)(ws + WS_W + OFF_WOUT); bf16_t* W1t = (bf16_t*)(ws + WS_W + OFF_W1); bf16_t* W2t = (bf16_t*)(ws + WS_W + OFF_W2);
    float* bin = (float*)(ws + WS_W + OFF_BIN); float* cb1 = (float*)(ws + WS_W + OFF_CB1); float* cb2 = (float*)(ws + WS_W + OFF_CB2);
    constexpr int I_A = 16 * 176, I_B = 16 * 176, I_C = 44 * 32, I_D = 16 * 32, I_E = 16 * 32, I_F = 2 * 32 * 8, I_G = 2 * 4 * 2;
    constexpr int NITEMS = I_A + I_B + I_C + I_D + I_E + I_F + I_G;
    for (int rep_ = 0; rep_ < ((DUP & 256) ? 2 : 1); ++rep_)
    for (int it = gw; it < NITEMS; it += NGW) {
        int r = it;
        if (r < I_A) { const int kb = r / 176, nb = r % 176; cvt_tile(scr, lane, 64 * kb, 32 * nb, Win, DM, [&](int k, int n) { const int o = in_orig(n); const float v = w_in[(size_t)k * IN_COLS + (o >= 0 ? o : 0)] * attn_norm[k]; return o >= 0 ? v : 0.f; }); continue; } r -= I_A;
        if (r < I_B) { const int kb = r / 176, nb = r % 176; cvt_tile(scr, lane, 64 * kb, 32 * nb, Wgu, DM, [&](int k, int n) { const int j = (n >> 8) * 128 + (n & 127); const float* s = ((n >> 7) & 1) ? w_up : w_gate; return s[(size_t)k * DFF + j] * ffn_norm[k]; }); continue; } r -= I_B;
        if (r < I_C) { const int kb = r / 32, nb = r % 32; cvt_tile(scr, lane, 64 * kb, 32 * nb, Wd, DFF, [&](int k, int n) { return w_down[(size_t)k * DM + n]; }); continue; } r -= I_C;
        if (r < I_D) { const int kb = r / 32, nb = r % 32; cvt_tile(scr, lane, 64 * kb, 32 * nb, Wout, DM, [&](int k, int n) { return w_out[(size_t)k * DM + n]; }); continue; } r -= I_D;
        if (r < I_E) { const int kb = r / 32, nb = r % 32;
            if (kb < 4) { }
            else if (kb < 12) cvt_tile(scr, lane, 64 * kb, 32 * nb, Wbr, DM, [&](int k, int n) { return w_br_nsa[(size_t)(k - 256) * DM + n]; });
            else cvt_tile(scr, lane, 64 * kb, 32 * nb, Wbr, DM, [&](int k, int n) { return w_br_moba[(size_t)(k - 768) * DM + n]; });
            continue; } r -= I_E;
        if (r < I_F) { const int kv = r >> 8, kb = (r >> 3) & 31, nb = r & 7; const float* w1 = cmp_w1 + (size_t)kv * 2048 * 256;
            cvt_tile(scr, lane, 64 * kb, 32 * nb, W1t + (size_t)kv * 256 * 2048, 2048, [&](int k, int n) { const int pos = k & 63, d = kv == 0 ? dint(pos) : pos; return w1[(size_t)((k & ~63) + d) * 256 + n]; }); continue; } r -= I_F;
        { const int kv = r >> 3, kb = (r >> 1) & 3, nb = r & 1; const float* w2 = cmp_w2 + (size_t)kv * 256 * 64;
            cvt_tile(scr, lane, 64 * kb, 32 * nb, W2t + (size_t)kv * 64 * 256, 256, [&](int k, int n) { return w2[(size_t)k * 64 + (kv == 0 ? dint(n) : n)]; }); }
    }
    const int gt = gw * 64 + lane, NGT = NGW * 64;
    for (int c = gt; c < NIN; c += NGT) { const int o = in_orig(c); bin[c] = o >= 0 ? b_in[o] : 0.f; }
    for (int idx = gt; idx < 32 * 512; idx += NGT) { const int c = idx >> 9, e = idx & 511, kv = e >> 8, n = e & 255; const float* w1 = cmp_w1 + (size_t)kv * 2048 * 256 + (size_t)(64 * c) * 256 + n; const float* pe = cmp_pos + (size_t)kv * 2048 + 64 * c;
        float s = c == 0 ? cmp_b1[kv * 256 + n] : 0.f;
#pragma unroll 16
        for (int k = 0; k < 64; ++k) s += pe[k] * w1[(size_t)k * 256];
        cb1[idx] = s; }
    for (int idx = gt; idx < 256 * DM; idx += NGT) { const int k = idx >> 10, n = idx & 1023, g64 = k & ~63; float s = 0.f;
#pragma unroll 16
        for (int j = 0; j < 64; ++j) s += pool_w[k * 64 + j] * pool_scale[g64 + j] * w_br_pool[(size_t)(g64 + j) * DM + n];
        Wbr[(size_t)n * DM + k] = (bf16_t)(cvtpk(s, 0.f) & 0xffffu); }
    for (int e = gt; e < 128; e += NGT) { const int kv = e >> 6, n = e & 63; cb2[e] = cmp_b2[kv * 64 + (kv == 0 ? dint(n) : n)]; }
    if (l == 0) {
        float* tab = (float*)(ws + WS_TAB);
        for (int e = gt; e < SEQ * 32; e += NGT) { const int t = e >> 5, f = e & 31; const float inv = powf(10000.0f, -(float)(2 * f) / 64.0f); const float ang = (float)t * inv;
            const double ad = (double)ang, kq = rint(ad * 0.15915494309189535); double rr = fma(-kq, 6.283185307179586, ad); rr = fma(-kq, 2.4492935982947064e-16, rr);
            const float rf = (float)rr; tab[2 * e] = __cosf(rf); tab[2 * e + 1] = __sinf(rf); }
        const float* x = a->in[0]; bf16_t* xb = (bf16_t*)(ws + WS_XB); float* ssp = (float*)(ws + WS_SSP);
        for (int m0 = 2 * gw; m0 < MTOK; m0 += 2 * NGW) { f32x4 v[2][4]; float s[2] = {0.f, 0.f};
#pragma unroll
            for (int q = 0; q < 2; ++q) { const f32x4* xr = (const f32x4*)(x + (size_t)(m0 + q) * DM) + lane;
#pragma unroll
                for (int j = 0; j < 4; ++j) v[q][j] = xr[64 * j]; }
#pragma unroll
            for (int q = 0; q < 2; ++q) {
#pragma unroll
                for (int j = 0; j < 4; ++j) s[q] += (v[q][j][0] * v[q][j][0] + v[q][j][1] * v[q][j][1]) + (v[q][j][2] * v[q][j][2] + v[q][j][3] * v[q][j][3]);
#pragma unroll
                for (int o = 1; o < 64; o <<= 1) s[q] += __shfl_xor(s[q], o);
                u32x2* o8 = (u32x2*)(xb + (size_t)(m0 + q) * DM) + lane;
#pragma unroll
                for (int j = 0; j < 4; ++j) o8[64 * j] = (u32x2){cvtpk(v[q][j][0], v[q][j][1]), cvtpk(v[q][j][2], v[q][j][3])};
                if (lane < 16) ssp[(size_t)(m0 + q) * 16 + lane] = lane == 0 ? s[q] : 0.f; } }
        int* order = (int*)(ws + WS_ORDER);
        if (gt < 768) { auto cost = [](int id) { return id < 512 ? 9 * (id & 127) + 80 : 32 * ((id - 512) & 31) + 32; }; const int mc = cost(gt); int rk = 0;
            for (int j = 0; j < 768; ++j) { const int cj = cost(j); rk += (cj > mc || (cj == mc && j < gt)) ? 1 : 0; }
            order[rk] = gt; }
    }
}
__device__ __forceinline__ float gelu_tanh(float x) { const float u = 0.7978845608028654f * (x + 0.044715f * x * x * x); const float th = 1.f - 2.f * __builtin_amdgcn_rcpf(1.f + __expf(2.f * u)); return 0.5f * x * (1.f + th); }
__device__ __forceinline__ void phase2(ArgsP a, LAS unsigned char* lds, int tid, int lane, int wave, int G) {
    unsigned char* ws = a->ws;
    const bf16_t* KV = (const bf16_t*)(ws + WS_KV); const bf16_t* W1t = (const bf16_t*)(ws + WS_W + OFF_W1); const bf16_t* W2t = (const bf16_t*)(ws + WS_W + OFF_W2);
    const float* cb1 = (const float*)(ws + WS_W + OFF_CB1); const float* cb2 = (const float*)(ws + WS_W + OFF_CB2);
    bf16_t* KC = (bf16_t*)(ws + WS_KC);
    LAS bf16_t* hid = (LAS bf16_t*)lds;
    const int arow = lane & 15, kq = lane >> 4;
    for (int task = blockIdx.x; task < 256; task += G) {
        const int kv = task >> 7, bgi = (task >> 5) & 3, nt = task & 31;
        const bf16_t* src = KV + (size_t)kv * att::KV_STRIDE + (size_t)bgi * SEQ * 64;
        const int nrow = 16 * nt + arow, neff = nrow < 510 ? nrow : 510;
        const bf16_t* ap = src + (size_t)neff * 1024 + kq * 8;
        const bf16_t* bp0 = W1t + (size_t)kv * 256 * 2048 + (size_t)(32 * wave + arow) * 2048 + kq * 8; const bf16_t* bp1 = bp0 + 16 * 2048;
        f32x4 c0 = {0.f, 0.f, 0.f, 0.f}, c1 = {0.f, 0.f, 0.f, 0.f};
#pragma unroll 8
        for (int ks = 0; ks < 64; ++ks) { const bf16x8 av = *(const bf16x8*)(ap + ks * 32), b0 = *(const bf16x8*)(bp0 + ks * 32), b1 = *(const bf16x8*)(bp1 + ks * 32);
            c0 = __builtin_amdgcn_mfma_f32_16x16x32_bf16(av, b0, c0, 0, 0, 0); c1 = __builtin_amdgcn_mfma_f32_16x16x32_bf16(av, b1, c1, 0, 0, 0); }
        { const int col0 = 32 * wave + arow; float bb0 = 0.f, bb1 = 0.f;
#pragma unroll 8
          for (int c = 0; c < 32; ++c) { bb0 += cb1[c * 512 + kv * 256 + col0]; bb1 += cb1[c * 512 + kv * 256 + col0 + 16]; }
#pragma unroll
          for (int j = 0; j < 4; ++j) { const int row = kq * 4 + j; hid[row * 264 + col0] = (bf16_t)(cvtpk(gelu_tanh(c0[j] + bb0), 0.f) & 0xffffu); hid[row * 264 + col0 + 16] = (bf16_t)(cvtpk(gelu_tanh(c1[j] + bb1), 0.f) & 0xffffu); } }
        LBAR();
        if (wave < 4) {
            const bf16_t* bp = W2t + (size_t)kv * 64 * 256 + (size_t)(16 * wave + arow) * 256 + kq * 8; f32x4 c = {0.f, 0.f, 0.f, 0.f};
#pragma unroll
            for (int ks = 0; ks < 8; ++ks) { const bf16x8 av = *(const LAS bf16x8*)(hid + arow * 264 + kq * 8 + ks * 32), bv = *(const bf16x8*)(bp + ks * 32); c = __builtin_amdgcn_mfma_f32_16x16x32_bf16(av, bv, c, 0, 0, 0); }
            const int col = 16 * wave + arow; const float bb = cb2[kv * 64 + col];
#pragma unroll
            for (int j = 0; j < 4; ++j) { const int n = 16 * nt + kq * 4 + j; KC[((size_t)(kv * 4 + bgi) * 512 + n) * 64 + col] = n < 511 ? (bf16_t)(cvtpk(c[j] + bb, 0.f) & 0xffffu) : (bf16_t)0; }
        }
        LBAR();
    }
    const int gt = blockIdx.x * 512 + tid, NGT = G * 512;
    { const bf16_t* MoK = (const bf16_t*)(ws + WS_MO) + att::MO_STRIDE; bf16_t* KM = (bf16_t*)(ws + WS_KM); LAS float* part = (LAS float*)(lds + 16384);
      for (int blk = blockIdx.x; blk < 256; blk += G) { const bf16_t* p = MoK + ((size_t)blk * 256 + 32 * wave) * 64 + lane; float s = 0.f;
#pragma unroll
          for (int r = 0; r < 32; ++r) s += __uint_as_float((unsigned)p[(size_t)r * 64] << 16);
          part[wave * 64 + lane] = s;
          LBAR();
          if (wave == 0) { float t = 0.f;
#pragma unroll
              for (int w = 0; w < 8; ++w) t += part[w * 64 + lane];
              KM[(size_t)blk * 64 + lane] = (bf16_t)(cvtpk(t * (1.0f / 256.0f), 0.f) & 0xffffu); }
          LBAR(); } }
    { const bf16_t* U = (const bf16_t*)(ws + WS_U); bf16_t* Abr = (bf16_t*)(ws + WS_XB);
      for (int e = gt; e < MTOK * 32; e += NGT) { const int row = e >> 5, c8 = e & 31, s = row & (SEQ - 1), w = 2 << (c8 >> 3), cnt = (s + 1 < w) ? s + 1 : w;
          float acc[8] = {0.f, 0.f, 0.f, 0.f, 0.f, 0.f, 0.f, 0.f}; u32x4 v0 = {0u, 0u, 0u, 0u};
#pragma unroll
          for (int i0 = 0; i0 < 16; i0 += 8) { if (i0 >= cnt) break; u32x4 v[8];
#pragma unroll
              for (int i = 0; i < 8; ++i) v[i] = (i0 + i < cnt) ? *(const u32x4*)(U + (size_t)(row - i0 - i) * 256 + c8 * 8) : (u32x4){0u, 0u, 0u, 0u};
              if (i0 == 0) v0 = v[0];
#pragma unroll
              for (int i = 0; i < 8; ++i)
#pragma unroll
                  for (int q = 0; q < 4; ++q) { acc[2 * q] += bflo(v[i][q]); acc[2 * q + 1] += bfhi(v[i][q]); } }
          const float ic = 1.0f / (float)cnt; u32x4 o;
#pragma unroll
          for (int q = 0; q < 4; ++q) o[q] = cvtpk(acc[2 * q] * ic - bflo(v0[q]), acc[2 * q + 1] * ic - bfhi(v0[q]));
          *(u32x4*)(Abr + (size_t)row * DM + c8 * 8) = o; } }
}
#ifndef DUP
#define DUP 0
#endif
__global__ void __launch_bounds__(512, 2) fwd_megakernel(Args a) {
    extern __shared__ __attribute__((aligned(16))) unsigned char lds_raw[];
    LAS unsigned char* lds = (LAS unsigned char*)lds_raw;
    cg::grid_group grid = cg::this_grid();
    const int G = gridDim.x;
    volatile LAS unsigned* bst = (volatile LAS unsigned*)(lds + LDS_BYTES - 64);
    if (threadIdx.x < 16) bst[threadIdx.x] = 0u;
    __syncthreads();
    const ArgsP ap0 = (ArgsP)__builtin_amdgcn_kernarg_segment_ptr();
#define PHASE_ARGS ArgsP a_ = ap0; asm volatile("" : "+s"(a_)); unsigned char* ws = a_->ws; unsigned* ctl = (unsigned*)(ws + WS_CTL); float* ssp = (float*)(ws + WS_SSP); const float* tab = (const float*)(ws + WS_TAB); \
    bf16_t* XB = (bf16_t*)(ws + WS_XB); bf16_t* BIG = (bf16_t*)(ws + WS_BIG); bf16_t* MRG = (bf16_t*)(ws + WS_MRG); (void)ctl; (void)ssp; (void)tab; (void)XB; (void)BIG; (void)MRG;
    XcdBarrier xbar = xcd_barrier_post((unsigned*)(ap0->ws + WS_BAR), bst);
    bool first_sync = true;
#define GRID_SYNC() do { if (first_sync) { grid.sync(); first_sync = false; } else xcd_barrier(xbar); } while (0)
    for (int l = 0; l < DEPTH; ++l) {
        int tid_ = threadIdx.x; asm volatile("" : "+v"(tid_));
        const int tid = tid_, lane = tid & 63, wave = __builtin_amdgcn_readfirstlane(tid >> 6), gw = blockIdx.x * 8 + wave, NGW = G * 8;
        for (int rep = 0; rep < ((DUP & 1) ? 2 : 1); ++rep) { PHASE_ARGS phase0(a_, l, lds, tid, lane, wave, gw, NGW); }
        GRID_SYNC();
        for (int rep = 0; rep < ((DUP & 2) ? 2 : 1); ++rep) { PHASE_ARGS pg8::Gemm g{XB, (const bf16_t*)(ws + WS_W + OFF_WIN), MTOK, NIN, DM}; pg8::StaticOrder S; S.init(MTOK, NIN, G, (int)blockIdx.x);
          EpiInProj E{ssp, (const float*)(ws + WS_W + OFF_BIN), tab, (bf16_t*)(ws + WS_U), (bf16_t*)(ws + WS_QN), (bf16_t*)(ws + WS_KV), (bf16_t*)(ws + WS_MO), BIG, (bf16_t*)(ws + WS_GN)};
          pg8::gemm_phase(lds, g, S, E); }
        GRID_SYNC();
        for (int rep = 0; rep < ((DUP & 4) ? 2 : 1); ++rep) { PHASE_ARGS phase2(a_, lds, tid, lane, wave, G); }
        GRID_SYNC();
        for (int rep = 0; rep < ((DUP & 8) ? 2 : 1); ++rep) { PHASE_ARGS
          att::Bufs B{(const bf16_t*)(ws + WS_QN), (const bf16_t*)(ws + WS_KV), (const bf16_t*)(ws + WS_MO), (const bf16_t*)(ws + WS_KC), (const bf16_t*)(ws + WS_KM), (const bf16_t*)(ws + WS_GN), XB};
          const int* order = (const int*)(ws + WS_ORDER); LAS int* slot = (LAS int*)(lds + att::L_END);
          if (wave >= 4) __builtin_amdgcn_s_setprio(1);
          for (;;) {
              LBAR();
              if (tid == 0) slot[0] = (int)atomicAdd(ctl + l + 2 * rep, 1u);
              LBAR();
              const int item = slot[0];
              if (item >= 768) break;
              const int id = order[item];
              int tl = threadIdx.x; asm volatile("" : "+v"(tl));
              const int tid = tl, lane = tid & 63, wave = __builtin_amdgcn_readfirstlane(tid >> 6);
              att::Ctx C; C.lds = (LAS char*)lds; C.wsf = (LAS float*)(lds + att::L_WSF) + wave * 64; C.otl = (LAS float*)(lds + att::L_OT) + wave * 2048 + lane; C.tid = tid; C.wid = wave; C.lane = lane; C.r32 = lane & 31; C.hi = lane >> 5;
              C.vbl = ((lane >> 4) & 1) * 32 + (lane & 3) * 8 + (4 * (lane >> 5) + ((lane & 15) >> 2)) * 64;
              if (id < 512) att::nsa_item(C, B, id >> 8, (id >> 7) & 1, id & 127);
              else { const int x = id - 512; att::moba_item(C, B, x >> 7, (x >> 5) & 3, x & 31); }
          }
          __builtin_amdgcn_s_setprio(0); }
        GRID_SYNC();
        for (int rep = 0; rep < ((DUP & 16) ? 2 : 1); ++rep) { PHASE_ARGS pg8::Gemm g{XB, (const bf16_t*)(ws + WS_W + OFF_WBR), MTOK, DM, DM}; pg8::StaticOrder S; S.init(MTOK, DM, G, (int)blockIdx.x);
          EpiBranch E{BIG, MRG}; pg8::gemm_phase(lds, g, S, E); }
        GRID_SYNC();
        { PHASE_ARGS pg8::Gemm g{MRG, (const bf16_t*)(ws + WS_W + OFF_WOUT), MTOK, DM, DM}; pg8::StaticOrder S; S.init(MTOK, DM, G, (int)blockIdx.x);
          float* outp = a_->out; EpiResid E{l == 0 ? a_->in[0] : outp, outp, XB, ssp}; pg8::gemm_phase(lds, g, S, E); }
        GRID_SYNC();
        for (int rep = 0; rep < ((DUP & 64) ? 2 : 1); ++rep) { PHASE_ARGS pg8::Gemm g{XB, (const bf16_t*)(ws + WS_W + OFF_WGU), MTOK, NGU, DM}; pg8::StaticOrder S; S.init(MTOK, NGU, G, (int)blockIdx.x);
          EpiSwiGLU E{ssp, BIG}; pg8::gemm_phase(lds, g, S, E); }
        GRID_SYNC();
        { PHASE_ARGS pg8::Gemm g{BIG, (const bf16_t*)(ws + WS_W + OFF_WD), MTOK, DM, DFF}; pg8::StaticOrder S; S.init(MTOK, DM, G, (int)blockIdx.x);
          float* outp = a_->out; EpiResid E{outp, outp, XB, ssp}; pg8::gemm_phase(lds, g, S, E); }
        GRID_SYNC();
    }
    { PHASE_ARGS const float* fn = a_->in[19]; float* outp = a_->out; const int lane = threadIdx.x & 63, gw = blockIdx.x * 8 + (threadIdx.x >> 6), NGW = G * 8;
      for (int m = gw; m < MTOK; m += NGW) { const float rstd = row_rstd(ssp, m); f32x4* xr = (f32x4*)(outp + (size_t)m * DM) + lane; const f32x4* gr = (const f32x4*)fn + lane;
#pragma unroll
          for (int j = 0; j < 4; ++j) xr[64 * j] = xr[64 * j] * rstd * gr[64 * j]; } }
}

extern "C" void kernel_launch(void* const* d_in, const int* in_sizes, int n_in, void* d_out, int out_size, void* d_ws, size_t ws_size, hipStream_t stream) {
    static int grid = 0;
    if (grid == 0) {
        if (n_in != 20 || in_sizes[0] != MTOK * DM || out_size != MTOK * DM || ws_size < WS_END) { fprintf(stderr, "kernel_launch: unexpected shapes / workspace (n_in %d, ws %zu)\n", n_in, ws_size); grid = -1; return; }
        int dev = 0, cus = 0, per_cu = 0;
        if (hipGetDevice(&dev) != hipSuccess || hipDeviceGetAttribute(&cus, hipDeviceAttributeMultiprocessorCount, dev) != hipSuccess) { grid = -1; return; }
        if (hipFuncSetAttribute((const void*)fwd_megakernel, hipFuncAttributeMaxDynamicSharedMemorySize, LDS_BYTES) != hipSuccess) { fprintf(stderr, "kernel_launch: hipFuncSetAttribute failed\n"); grid = -1; return; }
        if (hipOccupancyMaxActiveBlocksPerMultiprocessor(&per_cu, (const void*)fwd_megakernel, 512, LDS_BYTES) != hipSuccess || per_cu < 1) { fprintf(stderr, "kernel_launch: occupancy query failed (%d)\n", per_cu); (void)hipGetLastError(); grid = -1; return; }
        grid = cus * per_cu;
    }
    if (grid < 0) return;
    if (hipMemsetAsync((char*)d_ws + WS_CTL, 0, 32768, stream) != hipSuccess) { fprintf(stderr, "kernel_launch: memset failed\n"); return; }
    Args a{};
    for (int i = 0; i < 20; ++i) a.in[i] = (const float*)d_in[i];
    a.out = (float*)d_out; a.ws = (unsigned char*)d_ws;
    void* args[] = {&a};
    const hipError_t e = hipLaunchCooperativeKernel((const void*)fwd_megakernel, dim3(grid), dim3(512), args, LDS_BYTES, stream);
    if (e != hipSuccess) fprintf(stderr, "kernel_launch: cooperative launch failed: %s (grid %d)\n", hipGetErrorString(e), grid);
}
```

```cpp
#include <hip/hip_runtime.h>
#include <hip/hip_cooperative_groups.h>
#include <cstdio>
#include <cstdint>
#include <cmath>
namespace cg = cooperative_groups;

#define LAS __attribute__((address_space(3)))
typedef unsigned short bf16_t;
typedef short bf16x8 __attribute__((ext_vector_type(8)));
typedef short s16x4 __attribute__((ext_vector_type(4)));
typedef float f32x2 __attribute__((ext_vector_type(2)));
typedef float f32x4 __attribute__((ext_vector_type(4)));
typedef float f32x16 __attribute__((ext_vector_type(16)));
typedef unsigned u32x4 __attribute__((ext_vector_type(4)));
typedef unsigned u32x2 __attribute__((ext_vector_type(2)));
typedef __bf16 bf16x2_t __attribute__((ext_vector_type(2)));

constexpr int SEQ = 8192, BATCH = 2, MTOK = BATCH * SEQ, DM = 1024, DEPTH = 2;
constexpr int IN_COLS = 5400, NIN = 5632, DFF = 2816, NGU = 5632;
constexpr float RMS_EPS = 1e-6f;
constexpr float QSCALE = 0.125f * 1.4426950408889634f;

__device__ __forceinline__ unsigned cvtpk(float lo, float hi) { f32x2 v = {lo, hi}; bf16x2_t b = __builtin_convertvector(v, bf16x2_t); return __builtin_bit_cast(unsigned, b); }
__device__ __forceinline__ float bflo(unsigned w) { return __uint_as_float(w << 16); }
__device__ __forceinline__ float bfhi(unsigned w) { return __uint_as_float(w & 0xffff0000u); }
__device__ __forceinline__ float sigmoidf_(float x) { return __builtin_amdgcn_rcpf(1.f + __expf(-x)); }

namespace pg8 {
constexpr int BM = 256, BK = 64, HALF = 128, HTB = HALF * BK * 2, STAGE_BYTES = 8 * HTB, NXCD = 8, WGM = 8;
__host__ __device__ __forceinline__ int lds_byte(int r, int c) { const int st = (r >> 4) * 2 + (c >> 5), rr = r & 15, cc = c & 31, ob = rr * 64 + cc * 2; return st * 1024 + (ob ^ (((ob >> 9) & 1) << 5)); }
__host__ __device__ __forceinline__ void stage_rc(int b, int& R, int& C) { const int st = b / 1024, sb = b % 1024, swz = sb ^ (((sb >> 9) & 1) << 5); R = (st >> 1) * 16 + swz / 64; C = (st & 1) * 32 + (swz % 64) / 2; }
__host__ __device__ __forceinline__ int perm32(int rho) { const int n = rho >> 4, i = rho & 15; return 8 * (i >> 2) + 4 * n + (i & 3); }
struct Unit { int pm, pn; };
struct Gemm { const bf16_t* A; const bf16_t* Bt; int M, N, K; };
struct StaticOrder {
    int nM, nN, nwg, G, c;
    __host__ __device__ void init(int M, int N, int G_, int c_) { nM = M / BM; nN = N / BM; nwg = nM * nN; G = G_; c = c_; }
    __host__ __device__ bool next(int i, Unit& u) const {
        const long L = (long)i * G + c; if (L >= nwg) return false;
        int wgid = (int)L; { const int q = nwg / NXCD, r = nwg % NXCD, xcd = wgid % NXCD, off = wgid / NXCD; wgid = (xcd < r ? xcd * (q + 1) : r * (q + 1) + (xcd - r) * q) + off; }
        const int nig = WGM * nN, gid = wgid / nig, fm = gid * WGM, gsz = (nM - fm) < WGM ? (nM - fm) : WGM;
        u.pm = fm + ((wgid % nig) % gsz); u.pn = (wgid % nig) / gsz; return true;
    }
};
template <class Epi, class Sched>
__device__ __forceinline__ void gemm_phase(LAS unsigned char* lds, const Gemm g, const Sched& S, const Epi& E) {
    int tid_ = threadIdx.x; asm volatile("" : "+v"(tid_));
    const int tid = tid_, wid = __builtin_amdgcn_readfirstlane(tid >> 6), lane = tid & 63, wr = wid >> 2, wc = wid & 3, fr = lane & 15, fq = lane >> 4;
    const int K = g.K, nt = K / BK;
    unsigned voffA[2], voffB[2];
#pragma unroll
    for (int i = 0; i < 2; ++i) { int R, C; stage_rc(tid * 16 + i * 8192, R, C); const int Rb = ((R & ~31) + perm32(R & 31));
        voffA[i] = (unsigned)(R * K + C) * 2u; voffB[i] = (unsigned)(Rb * K + C) * 2u; }
    const size_t kstep = (size_t)(BK * 2);
    const size_t hstep = (size_t)HALF * K * 2;
    const size_t tstep = 2 * hstep;
    const unsigned ldsw = (unsigned)wid * 1024u;
    const int aoff = lds_byte(wr * 64 + fr, fq * 8), boff = lds_byte(wc * 32 + fr, fq * 8);
#define PG8_SA(b, h) (((b) * 2 + (h)) * HTB)
#define PG8_SB(b, h) ((4 + (b) * 2 + (h)) * HTB)
#define PG8_STAGE(bufoff, gbase, voff) do { _Pragma("unroll") for (int _i = 0; _i < 2; ++_i) \
        __builtin_amdgcn_global_load_lds((const unsigned*)((const char*)(gbase) + (voff)[_i]), (LAS unsigned*)(lds + (bufoff) + ldsw + _i * 8192), 16, 0, 0); } while (0)
#define PG8_LDA(dst, b, h) do { _Pragma("unroll") for (int m = 0; m < 4; ++m) _Pragma("unroll") for (int k = 0; k < 2; ++k) dst[m][k] = *(const LAS bf16x8*)(lds + PG8_SA(b, h) + aoff + m * 2048 + k * 1024); } while (0)
#define PG8_LDB(dst, b, h) do { _Pragma("unroll") for (int n = 0; n < 2; ++n) _Pragma("unroll") for (int k = 0; k < 2; ++k) dst[n][k] = *(const LAS bf16x8*)(lds + PG8_SB(b, h) + boff + n * 2048 + k * 1024); } while (0)
#define PG8_MMA(ai, bj, At, Bt) do { __builtin_amdgcn_s_setprio(1); _Pragma("unroll") for (int m = 0; m < 4; ++m) _Pragma("unroll") for (int n = 0; n < 2; ++n) _Pragma("unroll") for (int k = 0; k < 2; ++k) \
        acc[ai][bj][m][n] = __builtin_amdgcn_mfma_f32_16x16x32_bf16(Bt[n][k], At[m][k], acc[ai][bj][m][n], 0, 0, 0); __builtin_amdgcn_s_setprio(0); } while (0)
#define PG8_WAIT_V(n) asm volatile("s_waitcnt vmcnt(" #n ")" ::: "memory")
#define PG8_WAIT_L(n) asm volatile("s_waitcnt lgkmcnt(" #n ")" ::: "memory")
#define PG8_BAR __builtin_amdgcn_s_barrier()
#define PG8_SCHED __builtin_amdgcn_sched_barrier(0)
    Unit cur, nxt; int ui = 0;
    if (!S.next(0, cur)) return;
    f32x4 acc[2][2][4][2];
#pragma unroll
    for (int a = 0; a < 2; ++a)
#pragma unroll
        for (int b = 0; b < 2; ++b)
#pragma unroll
            for (int m = 0; m < 4; ++m)
#pragma unroll
                for (int n = 0; n < 2; ++n) acc[a][b][m][n] = (f32x4){0.f, 0.f, 0.f, 0.f};
    bf16x8 At[4][2], B0[2][2], B1[2][2];
    const char* cA = (const char*)g.A + (size_t)cur.pm * tstep; const char* cB = (const char*)g.Bt + (size_t)cur.pn * tstep;
    PG8_STAGE(PG8_SB(0, 0), cB, voffB); PG8_STAGE(PG8_SB(0, 1), cB + hstep, voffB); PG8_STAGE(PG8_SA(0, 0), cA, voffA); PG8_STAGE(PG8_SA(0, 1), cA + hstep, voffA);
    if (wr == 1) PG8_BAR;
    PG8_WAIT_V(2); PG8_BAR;
    PG8_STAGE(PG8_SB(1, 0), cB + kstep, voffB); PG8_STAGE(PG8_SA(1, 0), cA + kstep, voffA); PG8_STAGE(PG8_SB(1, 1), cB + hstep + kstep, voffB);
    PG8_WAIT_V(6); PG8_BAR;
    for (;;) {
        const bool has_next = S.next(ui + 1, nxt);
        const char* nA = has_next ? (const char*)g.A + (size_t)nxt.pm * tstep : cA; const char* nB = has_next ? (const char*)g.Bt + (size_t)nxt.pn * tstep : cB;
        for (int t = 0; t < nt; t += 2) {
            const bool last = (t == nt - 2);
            const char* a1 = cA + (size_t)(t + 1) * kstep;
            const char* a2 = last ? nA : cA + (size_t)(t + 2) * kstep; const char* b2 = last ? nB : cB + (size_t)(t + 2) * kstep;
            const char* a3 = a2 + kstep; const char* b3 = b2 + kstep;
            if constexpr (Epi::KHOOK) { if (t == 4 || t == 12) { PG8_SCHED; E.khook(acc, cur, t, wr, wc, fr, fq); PG8_SCHED; } }
            PG8_LDB(B0, 0, 0); PG8_LDB(B1, 0, 1); PG8_SCHED; PG8_LDA(At, 0, 0); PG8_STAGE(PG8_SA(1, 1), a1 + hstep, voffA);
            PG8_WAIT_V(8); PG8_WAIT_L(0); PG8_BAR; PG8_MMA(0, 0, At, B0); PG8_MMA(0, 1, At, B1); PG8_BAR; PG8_SCHED;
            PG8_LDA(At, 0, 1); PG8_STAGE(PG8_SB(0, 0), b2, voffB); PG8_STAGE(PG8_SB(0, 1), b2 + hstep, voffB); PG8_STAGE(PG8_SA(0, 0), a2, voffA);
            PG8_WAIT_V(8); PG8_WAIT_L(0); PG8_BAR; PG8_MMA(1, 0, At, B0); PG8_MMA(1, 1, At, B1); PG8_BAR; PG8_SCHED;
            PG8_LDB(B0, 1, 0); PG8_LDB(B1, 1, 1); PG8_SCHED; PG8_LDA(At, 1, 0); PG8_STAGE(PG8_SA(0, 1), a2 + hstep, voffA);
            PG8_WAIT_V(8); PG8_WAIT_L(0); PG8_BAR; PG8_MMA(0, 0, At, B0); PG8_MMA(0, 1, At, B1); PG8_BAR; PG8_SCHED;
            PG8_LDA(At, 1, 1); PG8_STAGE(PG8_SB(1, 0), b3, voffB); PG8_STAGE(PG8_SB(1, 1), b3 + hstep, voffB); PG8_STAGE(PG8_SA(1, 0), a3, voffA);
            PG8_WAIT_V(8); PG8_WAIT_L(0); PG8_BAR; PG8_MMA(1, 0, At, B0); PG8_MMA(1, 1, At, B1); PG8_BAR; PG8_SCHED;
        }
        if (wr == 0) PG8_BAR;
        E(acc, cur, wr, wc, fr, fq);
        if (!has_next) break;
#pragma unroll
        for (int a = 0; a < 2; ++a)
#pragma unroll
            for (int b = 0; b < 2; ++b)
#pragma unroll
                for (int m = 0; m < 4; ++m)
#pragma unroll
                    for (int n = 0; n < 2; ++n) acc[a][b][m][n] = (f32x4){0.f, 0.f, 0.f, 0.f};
        cur = nxt; cA = nA; cB = nB; ++ui;
        if (wr == 1) PG8_BAR;
    }
    PG8_WAIT_V(0);
    PG8_BAR;
#undef PG8_SA
#undef PG8_SB
#undef PG8_STAGE
#undef PG8_LDA
#undef PG8_LDB
#undef PG8_MMA
#undef PG8_WAIT_V
#undef PG8_WAIT_L
#undef PG8_BAR
#undef PG8_SCHED
}
}
using pg8::Unit;
__device__ __forceinline__ float row_rstd(const float* ssp, int row) {
    const f32x4* p = (const f32x4*)(ssp + (size_t)row * 16);
    const f32x4 a = p[0], b = p[1], c = p[2], d = p[3];
    const float ss = ((a[0] + a[1]) + (a[2] + a[3])) + ((b[0] + b[1]) + (b[2] + b[3])) + ((c[0] + c[1]) + (c[2] + c[3])) + ((d[0] + d[1]) + (d[2] + d[3]));
    return 1.0f / sqrtf(ss * (1.0f / DM) + RMS_EPS);
}
__device__ __forceinline__ u32x4 pack8(const f32x4 a, const f32x4 b) { u32x4 w; w.x = cvtpk(a[0], a[1]); w.y = cvtpk(a[2], a[3]); w.z = cvtpk(b[0], b[1]); w.w = cvtpk(b[2], b[3]); return w; }
__device__ __forceinline__ void rope8(f32x4& v0, f32x4& v1, const float* tab, int t, int pos, float sc) {
    const f32x4* cs = (const f32x4*)(tab + ((size_t)t * 32 + (pos >> 1)) * 2);
    const f32x4 c0 = cs[0], c1 = cs[1];
    f32x4 o0, o1;
    o0[0] = (v0[0] * c0[0] - v0[1] * c0[1]) * sc; o0[1] = (v0[1] * c0[0] + v0[0] * c0[1]) * sc;
    o0[2] = (v0[2] * c0[2] - v0[3] * c0[3]) * sc; o0[3] = (v0[3] * c0[2] + v0[2] * c0[3]) * sc;
    o1[0] = (v1[0] * c1[0] - v1[1] * c1[1]) * sc; o1[1] = (v1[1] * c1[0] + v1[0] * c1[1]) * sc;
    o1[2] = (v1[2] * c1[2] - v1[3] * c1[3]) * sc; o1[3] = (v1[3] * c1[2] + v1[2] * c1[3]) * sc;
    v0 = o0; v1 = o1;
}
struct EpiInProj {
    static constexpr bool KHOOK = false;
    const float* ssp; const float* bias; const float* tab;
    bf16_t *U, *Qn, *KV, *Mo, *G, *Gn;
    __device__ __forceinline__ void operator()(const f32x4 (&acc)[2][2][4][2], const Unit& u, int wr, int wc, int fr, int fq) const {
        asm volatile("" : "+v"(fr), "+v"(fq));
        const int pn = u.pn;
#pragma unroll
        for (int ai = 0; ai < 2; ++ai)
#pragma unroll
            for (int m = 0; m < 4; ++m) {
                const int row = u.pm * 256 + ai * 128 + wr * 64 + m * 16 + fr;
                const float rstd = row_rstd(ssp, row);
                const int t = row & (SEQ - 1), b = row >> 13;
#pragma unroll
                for (int bj = 0; bj < 2; ++bj) {
                    const int cit = bj * 128 + wc * 32 + 8 * fq, gc = pn * 256 + cit;
                    f32x4 v0 = acc[ai][bj][m][0] * rstd + *(const f32x4*)(bias + gc), v1 = acc[ai][bj][m][1] * rstd + *(const f32x4*)(bias + gc + 4);
                    bf16_t* dst;
                    if (pn == 0) { dst = U + (size_t)row * 256 + cit; }
                    else if (pn <= 2) { const int c2 = (pn - 1) * 256 + cit, head = c2 >> 6, pos = c2 & 63; rope8(v0, v1, tab, t, pos, QSCALE); dst = Qn + ((size_t)(b * 8 + head) * SEQ + t) * 64 + pos; }
                    else if (pn <= 5) { const int c2 = cit & 127, g = c2 >> 6, pos = c2 & 63, kvi = 2 * (pn - 3) + bj; if (bj == 0) rope8(v0, v1, tab, t, pos, 1.f);
                        dst = KV + (size_t)kvi * ((size_t)MTOK * 128) + ((size_t)(b * 2 + g) * SEQ + t) * 64 + pos; }
                    else if (pn <= 8) { const int h = cit >> 6, pos = cit & 63; if (pn < 8) rope8(v0, v1, tab, t, pos, pn == 6 ? QSCALE : 1.f);
                        dst = Mo + (size_t)(pn - 6) * ((size_t)MTOK * 256) + ((size_t)(b * 4 + h) * SEQ + t) * 64 + pos; }
                    else if (pn <= 20) {
#pragma unroll
                        for (int e = 0; e < 4; ++e) { v0[e] = sigmoidf_(v0[e]); v1[e] = sigmoidf_(v1[e]); }
                        dst = G + (size_t)row * 3072 + (pn - 9) * 256 + cit; }
                    else {
#pragma unroll
                        for (int e = 0; e < 4; ++e) { v0[e] = sigmoidf_(v0[e]); v1[e] = sigmoidf_(v1[e]); }
                        dst = Gn + (size_t)row * 32 + (cit & 31); if (cit >= 32) dst = nullptr; }
                    if (dst) *(u32x4*)dst = pack8(v0, v1);
                }
                asm volatile("" ::: "memory");
            }
    }
};
struct EpiBranch {
    static constexpr bool KHOOK = true;
    const bf16_t* G; bf16_t* out;
    __device__ __forceinline__ void khook(f32x4 (&acc)[2][2][4][2], const Unit& u, int t, int wr, int wc, int fr, int fq) const {
        asm volatile("" : "+v"(fr), "+v"(fq));
        const int gsel = (t == 4) ? 0 : 1024;
#pragma unroll
        for (int ai = 0; ai < 2; ++ai)
#pragma unroll
            for (int m = 0; m < 4; ++m) {
                const int row = u.pm * 256 + ai * 128 + wr * 64 + m * 16 + fr;
#pragma unroll
                for (int bj = 0; bj < 2; ++bj) {
                    const int col = u.pn * 256 + bj * 128 + wc * 32 + 8 * fq;
                    const u32x4 gx = *(const u32x4*)(G + (size_t)row * 3072 + gsel + col), gy = *(const u32x4*)(G + (size_t)row * 3072 + gsel + 1024 + col);
#pragma unroll
                    for (int e = 0; e < 4; ++e) {
                        const float x0 = fmaxf(bflo(gx[e]), 1e-20f), x1 = fmaxf(bfhi(gx[e]), 1e-20f), y0 = fmaxf(bflo(gy[e]), 1e-20f), y1 = fmaxf(bfhi(gy[e]), 1e-20f);
                        const float r0 = x0 * __builtin_amdgcn_rcpf(y0), r1 = x1 * __builtin_amdgcn_rcpf(y1);
                        acc[ai][bj][m][e >> 1][(e & 1) * 2] *= r0; acc[ai][bj][m][e >> 1][(e & 1) * 2 + 1] *= r1;
                    }
                    asm volatile("" ::: "memory");
                }
            }
    }
    __device__ __forceinline__ void operator()(const f32x4 (&acc)[2][2][4][2], const Unit& u, int wr, int wc, int fr, int fq) const {
        asm volatile("" : "+v"(fr), "+v"(fq));
#pragma unroll
        for (int ai = 0; ai < 2; ++ai)
#pragma unroll
            for (int m = 0; m < 4; ++m) {
                const int row = u.pm * 256 + ai * 128 + wr * 64 + m * 16 + fr;
#pragma unroll
                for (int bj = 0; bj < 2; ++bj) {
                    const int col = u.pn * 256 + bj * 128 + wc * 32 + 8 * fq;
                    const u32x4 gz = *(const u32x4*)(G + (size_t)row * 3072 + 2048 + col);
                    f32x4 v0 = acc[ai][bj][m][0], v1 = acc[ai][bj][m][1];
                    v0[0] *= fmaxf(bflo(gz[0]), 1e-20f); v0[1] *= fmaxf(bfhi(gz[0]), 1e-20f); v0[2] *= fmaxf(bflo(gz[1]), 1e-20f); v0[3] *= fmaxf(bfhi(gz[1]), 1e-20f);
                    v1[0] *= fmaxf(bflo(gz[2]), 1e-20f); v1[1] *= fmaxf(bfhi(gz[2]), 1e-20f); v1[2] *= fmaxf(bflo(gz[3]), 1e-20f); v1[3] *= fmaxf(bfhi(gz[3]), 1e-20f);
                    *(u32x4*)(out + (size_t)row * DM + col) = pack8(v0, v1);
                }
                asm volatile("" ::: "memory");
            }
    }
};
struct EpiResid {
    static constexpr bool KHOOK = false;
    const float* base; float* out; bf16_t* xb; float* ssp;
    __device__ __forceinline__ void operator()(const f32x4 (&acc)[2][2][4][2], const Unit& u, int wr, int wc, int fr, int fq) const {
        asm volatile("" : "+v"(fr), "+v"(fq));
#pragma unroll
        for (int ai = 0; ai < 2; ++ai)
#pragma unroll
            for (int m = 0; m < 4; ++m) {
                const int row = u.pm * 256 + ai * 128 + wr * 64 + m * 16 + fr;
                float ss = 0.f;
#pragma unroll
                for (int bj = 0; bj < 2; ++bj) {
                    const size_t off = (size_t)row * DM + u.pn * 256 + bj * 128 + wc * 32 + 8 * fq;
                    const f32x4 v0 = acc[ai][bj][m][0] + *(const f32x4*)(base + off), v1 = acc[ai][bj][m][1] + *(const f32x4*)(base + off + 4);
                    *(f32x4*)(out + off) = v0; *(f32x4*)(out + off + 4) = v1;
                    *(u32x4*)(xb + off) = pack8(v0, v1);
                    ss += (v0[0] * v0[0] + v0[1] * v0[1]) + (v0[2] * v0[2] + v0[3] * v0[3]) + (v1[0] * v1[0] + v1[1] * v1[1]) + (v1[2] * v1[2] + v1[3] * v1[3]);
                }
                ss += __shfl_xor(ss, 16); ss += __shfl_xor(ss, 32);
                if (fq == 0) ssp[(size_t)row * 16 + u.pn * 4 + wc] = ss;
                asm volatile("" ::: "memory");
            }
    }
};
struct EpiSwiGLU {
    static constexpr bool KHOOK = false;
    const float* ssp; bf16_t* H;
    __device__ __forceinline__ void operator()(const f32x4 (&acc)[2][2][4][2], const Unit& u, int wr, int wc, int fr, int fq) const {
        asm volatile("" : "+v"(fr), "+v"(fq));
#pragma unroll
        for (int ai = 0; ai < 2; ++ai)
#pragma unroll
            for (int m = 0; m < 4; ++m) {
                const int row = u.pm * 256 + ai * 128 + wr * 64 + m * 16 + fr;
                const float rstd = row_rstd(ssp, row);
                f32x4 o[2];
#pragma unroll
                for (int n = 0; n < 2; ++n)
#pragma unroll
                    for (int e = 0; e < 4; ++e) { const float gt = acc[ai][0][m][n][e] * rstd, up = acc[ai][1][m][n][e] * rstd; o[n][e] = gt * sigmoidf_(gt) * up; }
                *(u32x4*)(H + (size_t)row * DFF + u.pn * 128 + wc * 32 + 8 * fq) = pack8(o[0], o[1]);
                asm volatile("" ::: "memory");
            }
    }
};
#ifndef ABL_NSA_SCALE
#define ABL_NSA_SCALE
#endif
#ifndef ABL_MOBA_SCALE
#define ABL_MOBA_SCALE
#endif
namespace att {
constexpr int KCS = 1040, KSLOT = 8 * KCS, VSLOT = 8192;
constexpr int L_K0 = 0, L_K1 = KSLOT, L_V0 = 2 * KSLOT, L_V1 = 2 * KSLOT + VSLOT, L_WSF = 2 * KSLOT + 2 * VSLOT, L_PS = L_WSF + 8 * 256, L_MSK = L_PS + 64 * 128 * 4,
              L_UNI = L_MSK + 1024, L_LIST = L_UNI + 64, L_END = L_LIST + 512, L_OT = L_END + 64, L_TOTAL = L_OT + 8 * 8192;
#define LBAR() asm volatile("s_waitcnt lgkmcnt(0)\n\ts_barrier" ::: "memory")
#define LWAIT() asm volatile("s_waitcnt lgkmcnt(0)" ::: "memory")
__device__ __forceinline__ int crow(int r, int hi) { return (r & 3) + 8 * (r >> 2) + 4 * hi; }
__device__ __forceinline__ float swap_other(float v, int hi) { auto rr = __builtin_amdgcn_permlane32_swap(__float_as_uint(v), __float_as_uint(v), false, false); return __uint_as_float(hi ? rr[0] : rr[1]); }
__device__ __forceinline__ void qkt(f32x16& p0, f32x16& p1, const LAS char* Ks, const bf16x8* qr, const f32x16& cinit, int r32, int hi) {
    const LAS char* kb = Ks + hi * KCS + r32 * 16;
#pragma unroll
    for (int d0 = 0; d0 < 4; ++d0) {
        const bf16x8 b0 = *(const LAS bf16x8*)(kb + d0 * 2 * KCS), b1 = *(const LAS bf16x8*)(kb + d0 * 2 * KCS + 512);
        if (d0 == 0) { p0 = __builtin_amdgcn_mfma_f32_32x32x16_bf16(b0, qr[0], cinit, 0, 0, 0); p1 = __builtin_amdgcn_mfma_f32_32x32x16_bf16(b1, qr[0], cinit, 0, 0, 0); }
        else { p0 = __builtin_amdgcn_mfma_f32_32x32x16_bf16(b0, qr[d0], p0, 0, 0, 0); p1 = __builtin_amdgcn_mfma_f32_32x32x16_bf16(b1, qr[d0], p1, 0, 0, 0); } }
}
struct VFrag { s16x4 lo[8], hi[8]; };
typedef short v4i16_t __attribute__((ext_vector_type(4)));
__device__ __forceinline__ s16x4 vtr(const LAS char* p) { return __builtin_bit_cast(s16x4, __builtin_amdgcn_ds_read_tr16_b64_v4i16((LAS v4i16_t*)p)); }
__device__ __forceinline__ void v_issue(VFrag& F, const LAS char* vp) {
#pragma unroll
    for (int d0 = 0; d0 < 2; ++d0)
#pragma unroll
        for (int ks = 0; ks < 4; ++ks) { F.lo[d0 * 4 + ks] = vtr(vp + d0 * 4096 + ks * 1024); F.hi[d0 * 4 + ks] = vtr(vp + d0 * 4096 + ks * 1024 + 512); }
}
template <bool SUM> __device__ __forceinline__ void pv(f32x16* o, f32x16& osum, VFrag& F, bf16x8 pa0, bf16x8 pa1, bf16x8 pa2, bf16x8 pa3) {
#define PK(k) (bf16x8){F.lo[k][0], F.lo[k][1], F.lo[k][2], F.lo[k][3], F.hi[k][0], F.hi[k][1], F.hi[k][2], F.hi[k][3]}
    const bf16x8 ones = {0x3F80, 0x3F80, 0x3F80, 0x3F80, 0x3F80, 0x3F80, 0x3F80, 0x3F80};
    __builtin_amdgcn_s_setprio(1);
    o[0] = __builtin_amdgcn_mfma_f32_32x32x16_bf16(pa0, PK(0), o[0], 0, 0, 0);
    o[1] = __builtin_amdgcn_mfma_f32_32x32x16_bf16(pa0, PK(4), o[1], 0, 0, 0);
    if (SUM) osum = __builtin_amdgcn_mfma_f32_32x32x16_bf16(pa0, ones, osum, 0, 0, 0);
    o[0] = __builtin_amdgcn_mfma_f32_32x32x16_bf16(pa1, PK(1), o[0], 0, 0, 0);
    o[1] = __builtin_amdgcn_mfma_f32_32x32x16_bf16(pa1, PK(5), o[1], 0, 0, 0);
    if (SUM) osum = __builtin_amdgcn_mfma_f32_32x32x16_bf16(pa1, ones, osum, 0, 0, 0);
    o[0] = __builtin_amdgcn_mfma_f32_32x32x16_bf16(pa2, PK(2), o[0], 0, 0, 0);
    o[1] = __builtin_amdgcn_mfma_f32_32x32x16_bf16(pa2, PK(6), o[1], 0, 0, 0);
    if (SUM) osum = __builtin_amdgcn_mfma_f32_32x32x16_bf16(pa2, ones, osum, 0, 0, 0);
    o[0] = __builtin_amdgcn_mfma_f32_32x32x16_bf16(pa3, PK(3), o[0], 0, 0, 0);
    o[1] = __builtin_amdgcn_mfma_f32_32x32x16_bf16(pa3, PK(7), o[1], 0, 0, 0);
    if (SUM) osum = __builtin_amdgcn_mfma_f32_32x32x16_bf16(pa3, ones, osum, 0, 0, 0);
    __builtin_amdgcn_s_setprio(0);
#undef PK
}
__device__ __forceinline__ float rowmax(const f32x16& p0, const f32x16& p1, int hi) {
    float a = __builtin_fmaxf(p0[0], p1[0]);
#pragma unroll
    for (int r = 1; r < 16; ++r) a = __builtin_fmaxf(__builtin_fmaxf(a, p0[r]), p1[r]);
    return __builtin_fmaxf(a, swap_other(a, hi));
}
struct KVRegs { u32x4 k, v; };
__device__ __forceinline__ void tile_load(KVRegs& R, const bf16_t* K, const bf16_t* V, int tid) { R.k = *(const u32x4*)(K + tid * 8); R.v = *(const u32x4*)(V + tid * 8); }
__device__ __forceinline__ void tile_store(const KVRegs& R, LAS char* Ks, LAS char* Vs, int tid) {
    const int row = tid >> 3, c = tid & 7;
    *(LAS u32x4*)(Ks + c * KCS + row * 16) = R.k;
    *(LAS u32x4*)(Vs + (c >> 2) * 4096 + (row >> 4) * 1024 + (row & 15) * 64 + (c & 3) * 16) = R.v;
}
__device__ __forceinline__ void ps_accum(const f32x16 p, int jb, LAS float* ps_row, bool writer) {
#pragma unroll
    for (int rg = 0; rg < 4; ++rg) {
        float a = 2.f * (p[4 * rg] + p[4 * rg + 1] + p[4 * rg + 2]) + p[4 * rg + 3], bq = p[4 * rg + 3];
        a += __shfl_xor(a, 1); a += __shfl_xor(a, 2); bq += __shfl_xor(bq, 1); bq += __shfl_xor(bq, 2);
        const int j = jb + 2 * rg;
        if (writer) { __hip_atomic_fetch_add(ps_row + j, a, __ATOMIC_RELAXED, __HIP_MEMORY_SCOPE_WORKGROUP); if (j + 1 < 128) __hip_atomic_fetch_add(ps_row + j + 1, bq, __ATOMIC_RELAXED, __HIP_MEMORY_SCOPE_WORKGROUP); }
    }
}
struct Ctx { LAS char* lds; LAS float* wsf; LAS float* otl; int tid, wid, lane, r32, hi, vbl; };
struct RowSt { float m, l; bool started; f32x16 negm, osum; };
__device__ __forceinline__ void rowst_init(RowSt& S) { S.m = 0.f; S.l = 0.f; S.started = false; S.negm = f32x16{}; S.osum = f32x16{}; asm volatile("" : "+v"(S.negm)); }
__device__ __forceinline__ void rowst_fixed(RowSt& S, float ref) { S.m = ref; S.l = 0.f; S.started = true; S.osum = f32x16{};
#pragma unroll
    for (int r = 0; r < 16; ++r) S.negm[r] = -ref;
    asm volatile("" : "+v"(S.negm)); }
template <int MODE, class Src, class Msk>
__device__ __forceinline__ void run_branch(const Ctx& C, int nt, const Src& src, const Msk& msk, const bf16x8* qr, RowSt& S, f32x16* o, LAS float* ps_row, bool ps_writer, KVRegs& R, bool pre, const bf16_t* nk, const bf16_t* nv) {
    const bf16_t *kp, *vp;
    if (!pre) { src(0, kp, vp); tile_load(R, kp, vp, C.tid); }
    LBAR();
    for (int it = 0; it < nt; ++it) {
        LAS char* Ks = C.lds + ((it & 1) ? L_K1 : L_K0); LAS char* Vs = C.lds + ((it & 1) ? L_V1 : L_V0);
        tile_store(R, Ks, Vs, C.tid);
        if (it + 1 < nt) { src(it + 1, kp, vp); tile_load(R, kp, vp, C.tid); } else if (nk) tile_load(R, nk, nv, C.tid);
        int klo, khi; const bool nm = msk(it, klo, khi);
        LBAR();
        const bool kill = khi < klo;
        if (!__any(!kill)) continue;
        f32x16 p0, p1; qkt(p0, p1, Ks, qr, S.negm, C.r32, C.hi);
        VFrag VF; if constexpr (MODE != 0) v_issue(VF, Vs + C.vbl);
        if (__any(nm && !kill)) {
#pragma unroll
            for (int r = 0; r < 16; ++r) { const int kv = crow(r, C.hi); if (kv < klo || kv > khi) p0[r] = -INFINITY; if (kv + 32 < klo || kv + 32 > khi) p1[r] = -INFINITY; }
        }
        if constexpr (MODE != 2) {
            float rm = rowmax(p0, p1, C.hi); if (kill) rm = -INFINITY;
            const bool first = !S.started && rm > -INFINITY, grow = first || rm > 8.0f;
            if (__any(grow)) {
                const float d = grow ? rm : 0.f, alpha = first ? 1.0f : __builtin_amdgcn_exp2f(-d);
                S.m += d; S.started = S.started || first;
#pragma unroll
                for (int r = 0; r < 16; ++r) { S.negm[r] = -S.m; p0[r] -= d; p1[r] -= d; }
                if constexpr (MODE == 0) S.l *= alpha;
                if constexpr (MODE == 1) {
                    if (C.hi == 0) C.wsf[C.r32] = alpha;
                    LWAIT();
#pragma unroll
                    for (int r = 0; r < 16; ++r) { const float f = C.wsf[crow(r, C.hi)]; o[0][r] *= f; o[1][r] *= f; S.osum[r] *= f; }
                    LWAIT();
                }
            }
        }
#pragma unroll
        for (int r = 0; r < 16; ++r) { p0[r] = __builtin_amdgcn_exp2f(p0[r]); p1[r] = __builtin_amdgcn_exp2f(p1[r]); }
        if constexpr (MODE == 0) {
            float s = 0.f;
#pragma unroll
            for (int r = 0; r < 16; ++r) s += p0[r] + p1[r];
            S.l += kill ? 0.f : s;
        }
        if constexpr (MODE == 2) {
            if (__any(kill)) {
#pragma unroll
                for (int r = 0; r < 16; ++r) { p0[r] = kill ? 0.f : p0[r]; p1[r] = kill ? 0.f : p1[r]; }
            }
            ps_accum(p0, 16 * it + C.hi, ps_row, ps_writer); ps_accum(p1, 16 * it + 8 + C.hi, ps_row, ps_writer);
        }
        if constexpr (MODE != 0) {
            u32x4 w0 = {cvtpk(p0[0], p0[1]), cvtpk(p0[2], p0[3]), cvtpk(p0[4], p0[5]), cvtpk(p0[6], p0[7])}, w1 = {cvtpk(p0[8], p0[9]), cvtpk(p0[10], p0[11]), cvtpk(p0[12], p0[13]), cvtpk(p0[14], p0[15])};
            u32x4 w2 = {cvtpk(p1[0], p1[1]), cvtpk(p1[2], p1[3]), cvtpk(p1[4], p1[5]), cvtpk(p1[6], p1[7])}, w3 = {cvtpk(p1[8], p1[9]), cvtpk(p1[10], p1[11]), cvtpk(p1[12], p1[13]), cvtpk(p1[14], p1[15])};
            if constexpr (MODE == 1) {
                if (__any(kill)) {
#pragma unroll
                    for (int e = 0; e < 4; ++e) { w0[e] = kill ? 0u : w0[e]; w1[e] = kill ? 0u : w1[e]; w2[e] = kill ? 0u : w2[e]; w3[e] = kill ? 0u : w3[e]; }
                }
            }
            pv<MODE == 1>(o, S.osum, VF, __builtin_bit_cast(bf16x8, w0), __builtin_bit_cast(bf16x8, w1), __builtin_bit_cast(bf16x8, w2), __builtin_bit_cast(bf16x8, w3));
        }
    }
}
template <bool FIRST> __device__ __forceinline__ void merge_branch_n(const Ctx& C, const f32x16* o, const f32x16& osum, float gate) {
    if (C.hi == 0) C.wsf[C.r32] = gate;
    LWAIT();
#pragma unroll
    for (int r = 0; r < 16; ++r) { const float den = osum[r], f = den > 0.f ? C.wsf[crow(r, C.hi)] * __builtin_amdgcn_rcpf(den) : 0.f;
        if (FIRST) { C.otl[r * 64] = o[0][r] * f; C.otl[(16 + r) * 64] = o[1][r] * f; }
        else { C.otl[r * 64] += o[0][r] * f; C.otl[(16 + r) * 64] += o[1][r] * f; } }
    LWAIT();
}
template <bool FIRST> __device__ __forceinline__ void merge_branch(const Ctx& C, const f32x16* o, float factor) {
    if (C.hi == 0) C.wsf[C.r32] = factor;
    LWAIT();
#pragma unroll
    for (int r = 0; r < 16; ++r) { const float f = C.wsf[crow(r, C.hi)];
        if (FIRST) { C.otl[r * 64] = o[0][r] * f; C.otl[(16 + r) * 64] = o[1][r] * f; }
        else { C.otl[r * 64] += o[0][r] * f; C.otl[(16 + r) * 64] += o[1][r] * f; } }
    LWAIT();
}
struct Bufs { const bf16_t *Qn, *KV, *Mo, *KC, *KM, *Gn; bf16_t* Abr; };
constexpr size_t KV_STRIDE = (size_t)MTOK * 128, MO_STRIDE = (size_t)MTOK * 256;

__device__ __forceinline__ void nsa_item(const Ctx& C, const Bufs& B, int b, int g, int i) {
    const int r32 = C.r32, hi = C.hi, wid = C.wid;
    const int qi = 8 * wid + (r32 >> 2), hh = r32 & 3, head = g * 4 + hh, t = 64 * i + qi, cur = i;
    const size_t bg = (size_t)(b * 2 + g) * SEQ;
    bf16x8 qr[4];
    { const bf16_t* qp = B.Qn + ((size_t)(b * 8 + head) * SEQ + t) * 64 + hi * 8;
#pragma unroll
      for (int d0 = 0; d0 < 4; ++d0) qr[d0] = *(const bf16x8*)(qp + d0 * 16); }
    const unsigned gw = *(const unsigned*)(B.Gn + ((size_t)b * SEQ + t) * 32 + head * 3 - (head & 1));
    const unsigned gw2 = *(const unsigned*)(B.Gn + ((size_t)b * SEQ + t) * 32 + head * 3 - (head & 1) + 2);
    float g0, g1, g2; if (head & 1) { g0 = bfhi(gw); g1 = bflo(gw2); g2 = bfhi(gw2); } else { g0 = bflo(gw); g1 = bfhi(gw); g2 = bflo(gw2); }
    f32x16 o[2];
    LAS float* Ps = (LAS float*)(C.lds + L_PS); LAS unsigned* Mk = (LAS unsigned*)(C.lds + L_MSK); LAS unsigned* Uni = (LAS unsigned*)(C.lds + L_UNI); LAS int* List = (LAS int*)(C.lds + L_LIST);
    const int nv = t >= 31 ? ((t - 31) >> 4) + 1 : 0;
    const int nvt = (4 * i + 3 < 511) ? 4 * i + 3 : 511, ntc = (nvt + 63) >> 6;
    const bf16_t* kc = B.KC + (size_t)(0 * 4 + b * 2 + g) * 512 * 64; const bf16_t* vc = B.KC + (size_t)(1 * 4 + b * 2 + g) * 512 * 64;
    auto srcC = [&](int it, const bf16_t*& kp, const bf16_t*& vp) { kp = kc + (size_t)it * 4096; vp = vc + (size_t)it * 4096; };
    auto mskC = [&](int it, int& klo, int& khi) { klo = 0; khi = nv - 1 - 64 * it; return khi < 63; };
    RowSt S; rowst_init(S);
    KVRegs R;
    run_branch<0>(C, ntc, srcC, mskC, qr, S, o, nullptr, false, R, false, kc, vc);
    const float lt = S.l + swap_other(S.l, hi);
    rowst_fixed(S, lt > 0.f ? S.m + __builtin_amdgcn_logf(lt) : 0.f);
    for (int e = C.tid; e < 64 * 128; e += 512) Ps[e] = 0.f;
    if (C.tid < 8) Uni[C.tid] = 0u;
    o[0] = f32x16{}; o[1] = f32x16{};
    run_branch<2>(C, ntc, srcC, mskC, qr, S, o, Ps + qi * 128, hh == 0, R, true, B.KV + 2 * KV_STRIDE + bg * 64, B.KV + 3 * KV_STRIDE + bg * 64);
    merge_branch<true>(C, o, g0);
    LBAR();
    {
        const int nf = cur == 0 ? 1 : (cur == 1 ? 2 : 3), kp_ = 16 - nf, lane = C.lane;
#pragma unroll 1
        for (int qq = 0; qq < 8; ++qq) {
            int q = 8 * wid + qq; asm volatile("" : "+s"(q)); LAS float* ps = Ps + q * 128;
            const int j0 = lane, j1 = lane + 64;
            const bool f0 = (j0 == 0 || j0 == cur || j0 == cur - 1) && j0 <= cur, f1 = (j1 == cur || j1 == cur - 1) && j1 <= cur;
            const bool va0 = j0 <= cur && !f0, va1 = j1 <= cur && !f1;
            const unsigned k0 = va0 ? __float_as_uint(ps[j0]) + 1u : 0u, k1 = va1 ? __float_as_uint(ps[j1]) + 1u : 0u;
            unsigned T = 0u;
            for (int bit = 30; bit >= 0; --bit) { const unsigned cand = T | (1u << bit); const int cnt = __popcll(__ballot(k0 >= cand)) + __popcll(__ballot(k1 >= cand)); if (cnt >= kp_) T = cand; }
            const int need = kp_ - (__popcll(__ballot(k0 > T)) + __popcll(__ballot(k1 > T)));
            const unsigned long long t0 = __ballot(k0 == T), t1 = __ballot(k1 == T), below = (1ull << lane) - 1ull;
            const int pre0 = __popcll(t0 & below), pre1 = __popcll(t0) + __popcll(t1 & below);
            const bool s0 = f0 || (k0 > 0u && (k0 > T || (k0 == T && pre0 < need))), s1 = f1 || (k1 > 0u && (k1 > T || (k1 == T && pre1 < need)));
            const unsigned long long b0 = __ballot(s0), b1 = __ballot(s1);
            if (lane == 0) { Mk[q * 4 + 0] = (unsigned)b0; Mk[q * 4 + 1] = (unsigned)(b0 >> 32); Mk[q * 4 + 2] = (unsigned)b1; Mk[q * 4 + 3] = (unsigned)(b1 >> 32);
                __hip_atomic_fetch_or(&Uni[0], (unsigned)b0, __ATOMIC_RELAXED, __HIP_MEMORY_SCOPE_WORKGROUP); __hip_atomic_fetch_or(&Uni[1], (unsigned)(b0 >> 32), __ATOMIC_RELAXED, __HIP_MEMORY_SCOPE_WORKGROUP); __hip_atomic_fetch_or(&Uni[2], (unsigned)b1, __ATOMIC_RELAXED, __HIP_MEMORY_SCOPE_WORKGROUP); __hip_atomic_fetch_or(&Uni[3], (unsigned)(b1 >> 32), __ATOMIC_RELAXED, __HIP_MEMORY_SCOPE_WORKGROUP); }
        }
    }
    LBAR();
    if (C.tid == 0) { int n = 0; for (int w = 0; w < 4; ++w) { unsigned u = Uni[w]; while (u) { const int bpos = __builtin_ctz(u); u &= u - 1; List[n++] = w * 32 + bpos; } } Uni[4] = (unsigned)n; }
    LBAR();
    {
        const int nsel = (int)Uni[4];
        const bf16_t* ks = B.KV + 2 * KV_STRIDE + bg * 64; const bf16_t* vs = B.KV + 3 * KV_STRIDE + bg * 64;
        auto srcS = [&](int it, const bf16_t*& kp, const bf16_t*& vp) { const int j = List[it]; kp = ks + (size_t)j * 4096; vp = vs + (size_t)j * 4096; };
        auto mskS = [&](int it, int& klo, int& khi) { const int j = List[it]; const unsigned w = Mk[qi * 4 + (j >> 5)]; const bool bit = (w >> (j & 31)) & 1u;
            klo = 0; khi = bit ? (j == cur ? qi : 63) : -1; return j == cur; };
        rowst_init(S); o[0] = f32x16{}; o[1] = f32x16{};
        const int tw0n = i >= 8 ? i - 8 : 0;
        run_branch<1>(C, nsel, srcS, mskS, qr, S, o, nullptr, false, R, true, B.KV + 4 * KV_STRIDE + bg * 64 + (size_t)tw0n * 4096, B.KV + 5 * KV_STRIDE + bg * 64 + (size_t)tw0n * 4096);
        merge_branch_n<false>(C, o, S.osum, g1);
    }
    {
        const int tw0 = i >= 8 ? i - 8 : 0, ntw = i - tw0 + 1;
        const bf16_t* kw = B.KV + 4 * KV_STRIDE + bg * 64; const bf16_t* vw = B.KV + 5 * KV_STRIDE + bg * 64;
        auto srcW = [&](int it, const bf16_t*& kp, const bf16_t*& vp) { kp = kw + (size_t)(tw0 + it) * 4096; vp = vw + (size_t)(tw0 + it) * 4096; };
        auto mskW = [&](int it, int& klo, int& khi) { const int tw = tw0 + it; klo = (t - 511) - 64 * tw; khi = (tw == i) ? qi : 63; return tw == i || klo > 0; };
        rowst_init(S); o[0] = f32x16{}; o[1] = f32x16{};
        run_branch<1>(C, ntw, srcW, mskW, qr, S, o, nullptr, false, R, true, nullptr, nullptr);
        merge_branch_n<false>(C, o, S.osum, g2);
    }
#pragma unroll
    for (int r = 0; r < 16; ++r) { const int qrow = crow(r, hi); bf16_t* dst = B.Abr + ((size_t)b * SEQ + 64 * i + 8 * wid + (qrow >> 2)) * DM + 256 + (g * 4 + (qrow & 3)) * 64 + r32;
        dst[0] = (bf16_t)(cvtpk(ABL_NSA_SCALE C.otl[r * 64], 0.f) & 0xffffu); dst[32] = (bf16_t)(cvtpk(ABL_NSA_SCALE C.otl[(16 + r) * 64], 0.f) & 0xffffu); }
}
__device__ __forceinline__ void moba_item(const Ctx& C, const Bufs& B, int b, int h, int qb) {
    const int r32 = C.r32, hi = C.hi, wid = C.wid, own = qb, t = 256 * qb + 32 * wid + r32;
    const size_t bh = (size_t)(b * 4 + h) * SEQ;
    bf16x8 qr[4];
    { const bf16_t* qp = B.Mo + (bh + t) * 64 + hi * 8;
#pragma unroll
      for (int d0 = 0; d0 < 4; ++d0) qr[d0] = *(const bf16x8*)(qp + d0 * 16); }
    LAS unsigned* Uni = (LAS unsigned*)(C.lds + L_UNI); LAS int* List = (LAS int*)(C.lds + L_LIST);
    LBAR();
    if (C.tid < 256) { const u32x4 kmv = *(const u32x4*)(B.KM + (size_t)(b * 4 + h) * 2048 + C.tid * 8); *(LAS u32x4*)(C.lds + L_K0 + (C.tid & 7) * KCS + (C.tid >> 3) * 16) = kmv; }
    if (C.tid == 0) Uni[0] = 0u;
    LBAR();
    unsigned sel = 0u;
    {
        f32x16 gs = f32x16{};
        const LAS char* kb = C.lds + L_K0 + hi * KCS + r32 * 16;
#pragma unroll
        for (int d0 = 0; d0 < 4; ++d0) gs = __builtin_amdgcn_mfma_f32_32x32x16_bf16(*(const LAS bf16x8*)(kb + d0 * 2 * KCS), qr[d0], gs, 0, 0, 0);
        float lo[16], hv[16];
#pragma unroll
        for (int r = 0; r < 16; ++r) { const float ownv = gs[r], oth = swap_other(ownv, hi); lo[r] = hi ? oth : ownv; hv[r] = hi ? ownv : oth; }
        unsigned taken = ~((1u << own) - 1u);
#pragma unroll
        for (int round = 0; round < 3; ++round) {
            float best = -INFINITY; int bi = 32;
#pragma unroll
            for (int n = 0; n < 32; ++n) { const int rr = (n & 3) + 4 * (n >> 3); const float v = ((n >> 2) & 1) ? hv[rr] : lo[rr]; if (!((taken >> n) & 1u) && v > best) { best = v; bi = n; } }
            if (bi < 32) { sel |= 1u << bi; taken |= 1u << bi; }
        }
    }
    { unsigned u = sel;
#pragma unroll
      for (int o_ = 1; o_ < 64; o_ <<= 1) u |= (unsigned)__shfl_xor((int)u, o_);
      if (C.lane == 0) __hip_atomic_fetch_or(&Uni[0], u, __ATOMIC_RELAXED, __HIP_MEMORY_SCOPE_WORKGROUP); }
    LBAR();
    if (C.tid == 0) { int n = 0; unsigned u = Uni[0]; while (u) { const int bpos = __builtin_ctz(u); u &= u - 1; List[n++] = bpos; } Uni[4] = (unsigned)n; }
    LBAR();
    const int nl = (int)Uni[4], nt = 4 * nl + 4;
    const bf16_t* kk = B.Mo + MO_STRIDE + bh * 64; const bf16_t* vv = B.Mo + 2 * MO_STRIDE + bh * 64;
    auto src = [&](int it, const bf16_t*& kp, const bf16_t*& vp) { const int T = (it < 4 * nl) ? 4 * List[it >> 2] + (it & 3) : 4 * own + (it - 4 * nl); kp = kk + (size_t)T * 4096; vp = vv + (size_t)T * 4096; };
    auto msk = [&](int it, int& klo, int& khi) { klo = 0; if (it < 4 * nl) { const bool bit = (sel >> List[it >> 2]) & 1u; khi = bit ? 63 : -1; return false; } khi = 32 * wid + r32 - 64 * (it - 4 * nl); return true; };
    RowSt S; rowst_init(S); f32x16 o[2] = {f32x16{}, f32x16{}};
    KVRegs R;
    run_branch<1>(C, nt, src, msk, qr, S, o, nullptr, false, R, false, nullptr, nullptr);
    merge_branch_n<true>(C, o, S.osum, 1.0f);
#pragma unroll
    for (int r = 0; r < 16; ++r) { const int qrow = crow(r, hi); bf16_t* dst = B.Abr + ((size_t)b * SEQ + 256 * qb + 32 * wid + qrow) * DM + 768 + h * 64 + r32;
        dst[0] = (bf16_t)(cvtpk(ABL_MOBA_SCALE C.otl[r * 64], 0.f) & 0xffffu); dst[32] = (bf16_t)(cvtpk(ABL_MOBA_SCALE C.otl[(16 + r) * 64], 0.f) & 0xffffu); }
}
}
#define XB_TMO      128
#define XB_XCNT(j)  (256  + 64 * (j))
#define XB_XSUB(j)  (1280 + 64 * (j))
#define XB_XGEN(j)  (2304 + 64 * (j))
#define XB_TOP      3328
#define XB_TOPGEN   3392
#define XCD_BAR_WORDS 3456
#define XB_SPIN_CAP (1u << 18)

__device__ __forceinline__ unsigned xb_ld(unsigned* p)              { return __hip_atomic_load(p, __ATOMIC_RELAXED, __HIP_MEMORY_SCOPE_AGENT); }
__device__ __forceinline__ unsigned xb_add(unsigned* p, unsigned v) { return __hip_atomic_fetch_add(p, v, __ATOMIC_RELAXED, __HIP_MEMORY_SCOPE_AGENT); }
__device__ __forceinline__ unsigned xb_xcc_id() { return (unsigned)__builtin_amdgcn_s_getreg((3 << 11) | 20) & 0xFu; }
#define XB_SPIN(cond, bar) do { unsigned _sp = 0; while (cond) { __builtin_amdgcn_s_sleep(1); \
    if ((++_sp & 255u) == 0u) { if (xb_ld(&(bar)[XB_TMO])) break; if (_sp > XB_SPIN_CAP) { atomicAdd(&(bar)[XB_TMO], 1u); break; } } } } while (0)

struct XcdBarrier {
    unsigned* bar; unsigned x;
    volatile LAS unsigned* st;
};

__device__ __forceinline__ XcdBarrier xcd_barrier_post(unsigned* bar, volatile LAS unsigned* st) {
    XcdBarrier b; b.bar = bar; b.x = xb_xcc_id(); b.st = st;
    if (threadIdx.x == 0) (void)xb_add(&bar[XB_XCNT(b.x)], 1u);
    return b;
}
__device__ __forceinline__ void xcd_barrier_complete(unsigned* bar, unsigned x, unsigned& nloc, unsigned& nx) {
    const unsigned G = gridDim.x * gridDim.y * gridDim.z;
    unsigned sum, cnt, mine, sp = 0u;
    for (;;) {
        sum = 0u; cnt = 0u; mine = 0u;
#pragma unroll
        for (unsigned j = 0; j < 16; ++j) { const unsigned c = xb_ld(&bar[XB_XCNT(j)]); sum += c; cnt += (c > 0u) ? 1u : 0u; mine = (j == x) ? c : mine; }
        if (sum == G) break;
        __builtin_amdgcn_s_sleep(1);
        if ((++sp & 255u) == 0u) { if (xb_ld(&bar[XB_TMO])) break; if (sp > XB_SPIN_CAP) { atomicAdd(&bar[XB_TMO], 1u); break; } }
    }
    nloc = mine > 0u ? mine : 1u; nx = cnt > 0u ? cnt : 1u;
}

__device__ __forceinline__ void xcd_barrier(const XcdBarrier& b) {
    asm volatile("s_waitcnt vmcnt(0)" ::: "memory");
    __syncthreads();
    if (threadIdx.x == 0) {
        unsigned* bar = b.bar;
        __builtin_amdgcn_s_waitcnt(0);
        unsigned nloc = b.st[0], nx = b.st[1];
        if (nloc == 0u) { xcd_barrier_complete(bar, b.x, nloc, nx); b.st[0] = nloc; b.st[1] = nx; }
        const unsigned old = xb_add(&bar[XB_XSUB(b.x)], 1u);
        const unsigned gen = old / nloc;
        if (old + 1u == (gen + 1u) * nloc) {
            __builtin_amdgcn_fence(__ATOMIC_RELEASE, "agent");
            asm volatile("s_waitcnt vmcnt(0)" ::: "memory");
            const unsigned og = xb_add(&bar[XB_TOP], 1u);
            const unsigned tg = og / nx;
            if (og + 1u == (tg + 1u) * nx) xb_add(&bar[XB_TOPGEN], 1u);
            else XB_SPIN(xb_ld(&bar[XB_TOPGEN]) == tg, bar);
            __builtin_amdgcn_fence(__ATOMIC_ACQUIRE, "agent");
            xb_add(&bar[XB_XGEN(b.x)], 1u);
            asm volatile("s_waitcnt vmcnt(0)" ::: "memory");
        } else {
            XB_SPIN(xb_ld(&bar[XB_XGEN(b.x)]) == gen, bar);
            __builtin_amdgcn_fence(__ATOMIC_ACQUIRE, "agent");
            asm volatile("s_waitcnt vmcnt(0)" ::: "memory");
        }
    }
    __syncthreads();
}

#ifndef DUP
#define DUP 0
#endif
constexpr size_t MiB = 1u << 20;
constexpr size_t WS_CTL = 0, WS_ORDER = 4096, WS_BAR = 8192;
constexpr size_t WS_W = 1 * MiB, OFF_WIN = 0, OFF_WGU = 11 * MiB, OFF_WD = 22 * MiB, OFF_WBR = 28 * MiB, OFF_WOUT = 30 * MiB, OFF_W1 = 32 * MiB, OFF_W2 = 34 * MiB,
                 OFF_BIN = 34 * MiB + 65536, OFF_CB1 = OFF_BIN + 32768  , OFF_CB2 = OFF_CB1 + 65536;
constexpr size_t WS_TAB = 36 * MiB, WS_SSP = 38 * MiB, WS_KC = 39 * MiB, WS_KM = 39 * MiB + 512 * 1024, WS_GN = 40 * MiB, WS_XB = 42 * MiB, WS_BIG = 74 * MiB,
                 WS_U = 170 * MiB, WS_QN = 178 * MiB, WS_KV = 194 * MiB, WS_MO = 218 * MiB, WS_MRG = 178 * MiB, WS_END = 242 * MiB;
constexpr int LDS_BYTES = 147456;

__device__ __forceinline__ int dint(int pos) { return (pos >> 1) + 32 * (pos & 1); }
__device__ __forceinline__ int in_orig(int c) {
    if (c < 256) return c;
    if (c < 768) { const int c2 = c - 256; return 256 + (c2 >> 6) * 64 + dint(c2 & 63); }
    if (c < 1536) { const int c2 = c - 768, tt = c2 >> 8, bj = (c2 >> 7) & 1, g = (c2 >> 6) & 1, pos = c2 & 63; return 768 + (2 * tt + bj) * 128 + g * 64 + (bj == 0 ? dint(pos) : pos); }
    if (c < 2304) { const int c2 = c - 1536, part = c2 >> 8, h = (c2 >> 6) & 3, pos = c2 & 63; return 1560 + part * 256 + h * 64 + (part < 2 ? dint(pos) : pos); }
    if (c < 5376) return 2328 + (c - 2304);
    const int c2 = c - 5376; return c2 < 24 ? 1536 + c2 : -1;
}
template <class F> __device__ __forceinline__ void cvt_tile(LAS float* scr, int lane, int k0, int n0, bf16_t* dst, size_t pitch, F f) {
    float vals[32];
#pragma unroll
    for (int i = 0; i < 32; ++i) vals[i] = f(k0 + 2 * i + (lane >> 5), n0 + (lane & 31));
#pragma unroll
    for (int i = 0; i < 32; ++i) scr[(2 * i + (lane >> 5)) * 33 + (lane & 31)] = vals[i];
    asm volatile("s_waitcnt lgkmcnt(0)" ::: "memory");
    const int c = lane & 7;
#pragma unroll
    for (int j = 0; j < 4; ++j) { const int n = (lane >> 3) + 8 * j; const LAS float* s = scr + (8 * c) * 33 + n;
        u32x4 o; o.x = cvtpk(s[0 * 33], s[1 * 33]); o.y = cvtpk(s[2 * 33], s[3 * 33]); o.z = cvtpk(s[4 * 33], s[5 * 33]); o.w = cvtpk(s[6 * 33], s[7 * 33]);
        *(u32x4*)(dst + (size_t)(n0 + n) * pitch + k0 + 8 * c) = o; }
    asm volatile("s_waitcnt lgkmcnt(0)" ::: "memory");
}
struct Args { const float* in[20]; float* out; unsigned char* ws; };
typedef const __attribute__((address_space(4))) Args* ArgsP;

__device__ __forceinline__ void phase0(ArgsP a, int l, LAS unsigned char* lds, int tid, int lane, int wave, int gw, int NGW) {
    unsigned char* ws = a->ws;
    LAS float* scr = (LAS float*)(lds + wave * 8704);
    const float* attn_norm = a->in[1] + (size_t)l * DM; const float* w_in = a->in[2] + (size_t)l * DM * IN_COLS; const float* b_in = a->in[3] + (size_t)l * IN_COLS;
    const float* pool_w = a->in[4] + (size_t)l * 4 * 64 * 64; const float* pool_scale = a->in[5] + (size_t)l * 256; const float* cmp_pos = a->in[6] + (size_t)l * 2 * 32 * 64;
    const float* cmp_w1 = a->in[7] + (size_t)l * 2 * 2048 * 256; const float* cmp_b1 = a->in[8] + (size_t)l * 2 * 256; const float* cmp_w2 = a->in[9] + (size_t)l * 2 * 256 * 64; const float* cmp_b2 = a->in[10] + (size_t)l * 2 * 64;
    const float* w_br_pool = a->in[11] + (size_t)l * 256 * DM; const float* w_br_nsa = a->in[12] + (size_t)l * 512 * DM; const float* w_br_moba = a->in[13] + (size_t)l * 256 * DM;
    const float* w_out = a->in[14] + (size_t)l * DM * DM; const float* ffn_norm = a->in[15] + (size_t)l * DM; const float* w_gate = a->in[16] + (size_t)l * DM * DFF; const float* w_up = a->in[17] + (size_t)l * DM * DFF;
    const float* w_down = a->in[18] + (size_t)l * DFF * DM;
    bf16_t* Win = (bf16_t*)(ws + WS_W + OFF_WIN); bf16_t* Wgu = (bf16_t*)(ws + WS_W + OFF_WGU); bf16_t* Wd = (bf16_t*)(ws + WS_W + OFF_WD); bf16_t* Wbr = (bf16_t*)(ws + WS_W + OFF_WBR);
    bf16_t* Wout = (bf16_t*)(ws + WS_W + OFF_WOUT); bf16_t* W1t = (bf16_t*)(ws + WS_W + OFF_W1); bf16_t* W2t = (bf16_t*)(ws + WS_W + OFF_W2);
    float* bin = (float*)(ws + WS_W + OFF_BIN); float* cb1 = (float*)(ws + WS_W + OFF_CB1); float* cb2 = (float*)(ws + WS_W + OFF_CB2);
    constexpr int I_A = 16 * 176, I_B = 16 * 176, I_C = 44 * 32, I_D = 16 * 32, I_E = 16 * 32, I_F = 2 * 32 * 8, I_G = 2 * 4 * 2;
    constexpr int NITEMS = I_A + I_B + I_C + I_D + I_E + I_F + I_G;
    for (int rep_ = 0; rep_ < ((DUP & 256) ? 2 : 1); ++rep_)
    for (int it = gw; it < NITEMS; it += NGW) {
        int r = it;
        if (r < I_A) { const int kb = r / 176, nb = r % 176; cvt_tile(scr, lane, 64 * kb, 32 * nb, Win, DM, [&](int k, int n) { const int o = in_orig(n); const float v = w_in[(size_t)k * IN_COLS + (o >= 0 ? o : 0)] * attn_norm[k]; return o >= 0 ? v : 0.f; }); continue; } r -= I_A;
        if (r < I_B) { const int kb = r / 176, nb = r % 176; cvt_tile(scr, lane, 64 * kb, 32 * nb, Wgu, DM, [&](int k, int n) { const int j = (n >> 8) * 128 + (n & 127); const float* s = ((n >> 7) & 1) ? w_up : w_gate; return s[(size_t)k * DFF + j] * ffn_norm[k]; }); continue; } r -= I_B;
        if (r < I_C) { const int kb = r / 32, nb = r % 32; cvt_tile(scr, lane, 64 * kb, 32 * nb, Wd, DFF, [&](int k, int n) { return w_down[(size_t)k * DM + n]; }); continue; } r -= I_C;
        if (r < I_D) { const int kb = r / 32, nb = r % 32; cvt_tile(scr, lane, 64 * kb, 32 * nb, Wout, DM, [&](int k, int n) { return w_out[(size_t)k * DM + n]; }); continue; } r -= I_D;
        if (r < I_E) { const int kb = r / 32, nb = r % 32;
            if (kb < 4) { }
            else if (kb < 12) cvt_tile(scr, lane, 64 * kb, 32 * nb, Wbr, DM, [&](int k, int n) { return w_br_nsa[(size_t)(k - 256) * DM + n]; });
            else cvt_tile(scr, lane, 64 * kb, 32 * nb, Wbr, DM, [&](int k, int n) { return w_br_moba[(size_t)(k - 768) * DM + n]; });
            continue; } r -= I_E;
        if (r < I_F) { const int kv = r >> 8, kb = (r >> 3) & 31, nb = r & 7; const float* w1 = cmp_w1 + (size_t)kv * 2048 * 256;
            cvt_tile(scr, lane, 64 * kb, 32 * nb, W1t + (size_t)kv * 256 * 2048, 2048, [&](int k, int n) { const int pos = k & 63, d = kv == 0 ? dint(pos) : pos; return w1[(size_t)((k & ~63) + d) * 256 + n]; }); continue; } r -= I_F;
        { const int kv = r >> 3, kb = (r >> 1) & 3, nb = r & 1; const float* w2 = cmp_w2 + (size_t)kv * 256 * 64;
            cvt_tile(scr, lane, 64 * kb, 32 * nb, W2t + (size_t)kv * 64 * 256, 256, [&](int k, int n) { return w2[(size_t)k * 64 + (kv == 0 ? dint(n) : n)]; }); }
    }
    const int gt = gw * 64 + lane, NGT = NGW * 64;
    for (int c = gt; c < NIN; c += NGT) { const int o = in_orig(c); bin[c] = o >= 0 ? b_in[o] : 0.f; }
    for (int idx = gt; idx < 32 * 512; idx += NGT) { const int c = idx >> 9, e = idx & 511, kv = e >> 8, n = e & 255; const float* w1 = cmp_w1 + (size_t)kv * 2048 * 256 + (size_t)(64 * c) * 256 + n; const float* pe = cmp_pos + (size_t)kv * 2048 + 64 * c;
        float s = c == 0 ? cmp_b1[kv * 256 + n] : 0.f;
#pragma unroll 16
        for (int k = 0; k < 64; ++k) s += pe[k] * w1[(size_t)k * 256];
        cb1[idx] = s; }
    for (int idx = gt; idx < 256 * DM; idx += NGT) { const int k = idx >> 10, n = idx & 1023, g64 = k & ~63; float s = 0.f;
#pragma unroll 16
        for (int j = 0; j < 64; ++j) s += pool_w[k * 64 + j] * pool_scale[g64 + j] * w_br_pool[(size_t)(g64 + j) * DM + n];
        Wbr[(size_t)n * DM + k] = (bf16_t)(cvtpk(s, 0.f) & 0xffffu); }
    for (int e = gt; e < 128; e += NGT) { const int kv = e >> 6, n = e & 63; cb2[e] = cmp_b2[kv * 64 + (kv == 0 ? dint(n) : n)]; }
    if (l == 0) {
        float* tab = (float*)(ws + WS_TAB);
        for (int e = gt; e < SEQ * 32; e += NGT) { const int t = e >> 5, f = e & 31; const float inv = powf(10000.0f, -(float)(2 * f) / 64.0f); const float ang = (float)t * inv;
            const double ad = (double)ang, kq = rint(ad * 0.15915494309189535); double rr = fma(-kq, 6.283185307179586, ad); rr = fma(-kq, 2.4492935982947064e-16, rr);
            const float rf = (float)rr; tab[2 * e] = __cosf(rf); tab[2 * e + 1] = __sinf(rf); }
        const float* x = a->in[0]; bf16_t* xb = (bf16_t*)(ws + WS_XB); float* ssp = (float*)(ws + WS_SSP);
        for (int m0 = 2 * gw; m0 < MTOK; m0 += 2 * NGW) { f32x4 v[2][4]; float s[2] = {0.f, 0.f};
#pragma unroll
            for (int q = 0; q < 2; ++q) { const f32x4* xr = (const f32x4*)(x + (size_t)(m0 + q) * DM) + lane;
#pragma unroll
                for (int j = 0; j < 4; ++j) v[q][j] = xr[64 * j]; }
#pragma unroll
            for (int q = 0; q < 2; ++q) {
#pragma unroll
                for (int j = 0; j < 4; ++j) s[q] += (v[q][j][0] * v[q][j][0] + v[q][j][1] * v[q][j][1]) + (v[q][j][2] * v[q][j][2] + v[q][j][3] * v[q][j][3]);
#pragma unroll
                for (int o = 1; o < 64; o <<= 1) s[q] += __shfl_xor(s[q], o);
                u32x2* o8 = (u32x2*)(xb + (size_t)(m0 + q) * DM) + lane;
#pragma unroll
                for (int j = 0; j < 4; ++j) o8[64 * j] = (u32x2){cvtpk(v[q][j][0], v[q][j][1]), cvtpk(v[q][j][2], v[q][j][3])};
                if (lane < 16) ssp[(size_t)(m0 + q) * 16 + lane] = lane == 0 ? s[q] : 0.f; } }
        int* order = (int*)(ws + WS_ORDER);
        if (gt < 768) { auto cost = [](int id) { return id < 512 ? 9 * (id & 127) + 80 : 32 * ((id - 512) & 31) + 32; }; const int mc = cost(gt); int rk = 0;
            for (int j = 0; j < 768; ++j) { const int cj = cost(j); rk += (cj > mc || (cj == mc && j < gt)) ? 1 : 0; }
            order[rk] = gt; }
    }
}
__device__ __forceinline__ float gelu_tanh(float x) { const float u = 0.7978845608028654f * (x + 0.044715f * x * x * x); const float th = 1.f - 2.f * __builtin_amdgcn_rcpf(1.f + __expf(2.f * u)); return 0.5f * x * (1.f + th); }
__device__ __forceinline__ void phase2(ArgsP a, LAS unsigned char* lds, int tid, int lane, int wave, int G) {
    unsigned char* ws = a->ws;
    const bf16_t* KV = (const bf16_t*)(ws + WS_KV); const bf16_t* W1t = (const bf16_t*)(ws + WS_W + OFF_W1); const bf16_t* W2t = (const bf16_t*)(ws + WS_W + OFF_W2);
    const float* cb1 = (const float*)(ws + WS_W + OFF_CB1); const float* cb2 = (const float*)(ws + WS_W + OFF_CB2);
    bf16_t* KC = (bf16_t*)(ws + WS_KC);
    LAS bf16_t* hid = (LAS bf16_t*)lds;
    const int arow = lane & 15, kq = lane >> 4;
    for (int task = blockIdx.x; task < 256; task += G) {
        const int kv = task >> 7, bgi = (task >> 5) & 3, nt = task & 31;
        const bf16_t* src = KV + (size_t)kv * att::KV_STRIDE + (size_t)bgi * SEQ * 64;
        const int nrow = 16 * nt + arow, neff = nrow < 510 ? nrow : 510;
        const bf16_t* ap = src + (size_t)neff * 1024 + kq * 8;
        const bf16_t* bp0 = W1t + (size_t)kv * 256 * 2048 + (size_t)(32 * wave + arow) * 2048 + kq * 8; const bf16_t* bp1 = bp0 + 16 * 2048;
        f32x4 c0 = {0.f, 0.f, 0.f, 0.f}, c1 = {0.f, 0.f, 0.f, 0.f};
#pragma unroll 8
        for (int ks = 0; ks < 64; ++ks) { const bf16x8 av = *(const bf16x8*)(ap + ks * 32), b0 = *(const bf16x8*)(bp0 + ks * 32), b1 = *(const bf16x8*)(bp1 + ks * 32);
            c0 = __builtin_amdgcn_mfma_f32_16x16x32_bf16(av, b0, c0, 0, 0, 0); c1 = __builtin_amdgcn_mfma_f32_16x16x32_bf16(av, b1, c1, 0, 0, 0); }
        { const int col0 = 32 * wave + arow; float bb0 = 0.f, bb1 = 0.f;
#pragma unroll 8
          for (int c = 0; c < 32; ++c) { bb0 += cb1[c * 512 + kv * 256 + col0]; bb1 += cb1[c * 512 + kv * 256 + col0 + 16]; }
#pragma unroll
          for (int j = 0; j < 4; ++j) { const int row = kq * 4 + j; hid[row * 264 + col0] = (bf16_t)(cvtpk(gelu_tanh(c0[j] + bb0), 0.f) & 0xffffu); hid[row * 264 + col0 + 16] = (bf16_t)(cvtpk(gelu_tanh(c1[j] + bb1), 0.f) & 0xffffu); } }
        LBAR();
        if (wave < 4) {
            const bf16_t* bp = W2t + (size_t)kv * 64 * 256 + (size_t)(16 * wave + arow) * 256 + kq * 8; f32x4 c = {0.f, 0.f, 0.f, 0.f};
#pragma unroll
            for (int ks = 0; ks < 8; ++ks) { const bf16x8 av = *(const LAS bf16x8*)(hid + arow * 264 + kq * 8 + ks * 32), bv = *(const bf16x8*)(bp + ks * 32); c = __builtin_amdgcn_mfma_f32_16x16x32_bf16(av, bv, c, 0, 0, 0); }
            const int col = 16 * wave + arow; const float bb = cb2[kv * 64 + col];
#pragma unroll
            for (int j = 0; j < 4; ++j) { const int n = 16 * nt + kq * 4 + j; KC[((size_t)(kv * 4 + bgi) * 512 + n) * 64 + col] = n < 511 ? (bf16_t)(cvtpk(c[j] + bb, 0.f) & 0xffffu) : (bf16_t)0; }
        }
        LBAR();
    }
    const int gt = blockIdx.x * 512 + tid, NGT = G * 512;
    { const bf16_t* MoK = (const bf16_t*)(ws + WS_MO) + att::MO_STRIDE; bf16_t* KM = (bf16_t*)(ws + WS_KM); LAS float* part = (LAS float*)(lds + 16384);
      for (int blk = blockIdx.x; blk < 256; blk += G) { const bf16_t* p = MoK + ((size_t)blk * 256 + 32 * wave) * 64 + lane; float s = 0.f;
#pragma unroll
          for (int r = 0; r < 32; ++r) s += __uint_as_float((unsigned)p[(size_t)r * 64] << 16);
          part[wave * 64 + lane] = s;
          LBAR();
          if (wave == 0) { float t = 0.f;
#pragma unroll
              for (int w = 0; w < 8; ++w) t += part[w * 64 + lane];
              KM[(size_t)blk * 64 + lane] = (bf16_t)(cvtpk(t * (1.0f / 256.0f), 0.f) & 0xffffu); }
          LBAR(); } }
    { const bf16_t* U = (const bf16_t*)(ws + WS_U); bf16_t* Abr = (bf16_t*)(ws + WS_XB);
      for (int e = gt; e < MTOK * 32; e += NGT) { const int row = e >> 5, c8 = e & 31, s = row & (SEQ - 1), w = 2 << (c8 >> 3), cnt = (s + 1 < w) ? s + 1 : w;
          float acc[8] = {0.f, 0.f, 0.f, 0.f, 0.f, 0.f, 0.f, 0.f}; u32x4 v0 = {0u, 0u, 0u, 0u};
#pragma unroll
          for (int i0 = 0; i0 < 16; i0 += 8) { if (i0 >= cnt) break; u32x4 v[8];
#pragma unroll
              for (int i = 0; i < 8; ++i) v[i] = (i0 + i < cnt) ? *(const u32x4*)(U + (size_t)(row - i0 - i) * 256 + c8 * 8) : (u32x4){0u, 0u, 0u, 0u};
              if (i0 == 0) v0 = v[0];
#pragma unroll
              for (int i = 0; i < 8; ++i)
#pragma unroll
                  for (int q = 0; q < 4; ++q) { acc[2 * q] += bflo(v[i][q]); acc[2 * q + 1] += bfhi(v[i][q]); } }
          const float ic = 1.0f / (float)cnt; u32x4 o;
#pragma unroll
          for (int q = 0; q < 4; ++q) o[q] = cvtpk(acc[2 * q] * ic - bflo(v0[q]), acc[2 * q + 1] * ic - bfhi(v0[q]));
          *(u32x4*)(Abr + (size_t)row * DM + c8 * 8) = o; } }
}
#ifndef DUP
#define DUP 0
#endif
__global__ void __launch_bounds__(512, 2) fwd_megakernel(Args a) {
    extern __shared__ __attribute__((aligned(16))) unsigned char lds_raw[];
    LAS unsigned char* lds = (LAS unsigned char*)lds_raw;
    cg::grid_group grid = cg::this_grid();
    const int G = gridDim.x;
    volatile LAS unsigned* bst = (volatile LAS unsigned*)(lds + LDS_BYTES - 64);
    if (threadIdx.x < 16) bst[threadIdx.x] = 0u;
    __syncthreads();
    const ArgsP ap0 = (ArgsP)__builtin_amdgcn_kernarg_segment_ptr();
#define PHASE_ARGS ArgsP a_ = ap0; asm volatile("" : "+s"(a_)); unsigned char* ws = a_->ws; unsigned* ctl = (unsigned*)(ws + WS_CTL); float* ssp = (float*)(ws + WS_SSP); const float* tab = (const float*)(ws + WS_TAB); \
    bf16_t* XB = (bf16_t*)(ws + WS_XB); bf16_t* BIG = (bf16_t*)(ws + WS_BIG); bf16_t* MRG = (bf16_t*)(ws + WS_MRG); (void)ctl; (void)ssp; (void)tab; (void)XB; (void)BIG; (void)MRG;
    XcdBarrier xbar = xcd_barrier_post((unsigned*)(ap0->ws + WS_BAR), bst);
    bool first_sync = true;
#define GRID_SYNC() do { if (first_sync) { grid.sync(); first_sync = false; } else xcd_barrier(xbar); } while (0)
    for (int l = 0; l < DEPTH; ++l) {
        int tid_ = threadIdx.x; asm volatile("" : "+v"(tid_));
        const int tid = tid_, lane = tid & 63, wave = __builtin_amdgcn_readfirstlane(tid >> 6), gw = blockIdx.x * 8 + wave, NGW = G * 8;
        for (int rep = 0; rep < ((DUP & 1) ? 2 : 1); ++rep) { PHASE_ARGS phase0(a_, l, lds, tid, lane, wave, gw, NGW); }
        GRID_SYNC();
        for (int rep = 0; rep < ((DUP & 2) ? 2 : 1); ++rep) { PHASE_ARGS pg8::Gemm g{XB, (const bf16_t*)(ws + WS_W + OFF_WIN), MTOK, NIN, DM}; pg8::StaticOrder S; S.init(MTOK, NIN, G, (int)blockIdx.x);
          EpiInProj E{ssp, (const float*)(ws + WS_W + OFF_BIN), tab, (bf16_t*)(ws + WS_U), (bf16_t*)(ws + WS_QN), (bf16_t*)(ws + WS_KV), (bf16_t*)(ws + WS_MO), BIG, (bf16_t*)(ws + WS_GN)};
          pg8::gemm_phase(lds, g, S, E); }
        GRID_SYNC();
        for (int rep = 0; rep < ((DUP & 4) ? 2 : 1); ++rep) { PHASE_ARGS phase2(a_, lds, tid, lane, wave, G); }
        GRID_SYNC();
        for (int rep = 0; rep < ((DUP & 8) ? 2 : 1); ++rep) { PHASE_ARGS
          att::Bufs B{(const bf16_t*)(ws + WS_QN), (const bf16_t*)(ws + WS_KV), (const bf16_t*)(ws + WS_MO), (const bf16_t*)(ws + WS_KC), (const bf16_t*)(ws + WS_KM), (const bf16_t*)(ws + WS_GN), XB};
          const int* order = (const int*)(ws + WS_ORDER); LAS int* slot = (LAS int*)(lds + att::L_END);
          if (wave >= 4) __builtin_amdgcn_s_setprio(1);
          for (;;) {
              LBAR();
              if (tid == 0) slot[0] = (int)atomicAdd(ctl + l + 2 * rep, 1u);
              LBAR();
              const int item = slot[0];
              if (item >= 768) break;
              const int id = order[item];
              int tl = threadIdx.x; asm volatile("" : "+v"(tl));
              const int tid = tl, lane = tid & 63, wave = __builtin_amdgcn_readfirstlane(tid >> 6);
              att::Ctx C; C.lds = (LAS char*)lds; C.wsf = (LAS float*)(lds + att::L_WSF) + wave * 64; C.otl = (LAS float*)(lds + att::L_OT) + wave * 2048 + lane; C.tid = tid; C.wid = wave; C.lane = lane; C.r32 = lane & 31; C.hi = lane >> 5;
              C.vbl = ((lane >> 4) & 1) * 32 + (lane & 3) * 8 + (4 * (lane >> 5) + ((lane & 15) >> 2)) * 64;
              if (id < 512) att::nsa_item(C, B, id >> 8, (id >> 7) & 1, id & 127);
              else { const int x = id - 512; att::moba_item(C, B, x >> 7, (x >> 5) & 3, x & 31); }
          }
          __builtin_amdgcn_s_setprio(0); }
        GRID_SYNC();
        for (int rep = 0; rep < ((DUP & 16) ? 2 : 1); ++rep) { PHASE_ARGS pg8::Gemm g{XB, (const bf16_t*)(ws + WS_W + OFF_WBR), MTOK, DM, DM}; pg8::StaticOrder S; S.init(MTOK, DM, G, (int)blockIdx.x);
          EpiBranch E{BIG, MRG}; pg8::gemm_phase(lds, g, S, E); }
        GRID_SYNC();
        { PHASE_ARGS pg8::Gemm g{MRG, (const bf16_t*)(ws + WS_W + OFF_WOUT), MTOK, DM, DM}; pg8::StaticOrder S; S.init(MTOK, DM, G, (int)blockIdx.x);
          float* outp = a_->out; EpiResid E{l == 0 ? a_->in[0] : outp, outp, XB, ssp}; pg8::gemm_phase(lds, g, S, E); }
        GRID_SYNC();
        for (int rep = 0; rep < ((DUP & 64) ? 2 : 1); ++rep) { PHASE_ARGS pg8::Gemm g{XB, (const bf16_t*)(ws + WS_W + OFF_WGU), MTOK, NGU, DM}; pg8::StaticOrder S; S.init(MTOK, NGU, G, (int)blockIdx.x);
          EpiSwiGLU E{ssp, BIG}; pg8::gemm_phase(lds, g, S, E); }
        GRID_SYNC();
        { PHASE_ARGS pg8::Gemm g{BIG, (const bf16_t*)(ws + WS_W + OFF_WD), MTOK, DM, DFF}; pg8::StaticOrder S; S.init(MTOK, DM, G, (int)blockIdx.x);
          float* outp = a_->out; EpiResid E{outp, outp, XB, ssp}; pg8::gemm_phase(lds, g, S, E); }
        GRID_SYNC();
    }
    { PHASE_ARGS const float* fn = a_->in[19]; float* outp = a_->out; const int lane = threadIdx.x & 63, gw = blockIdx.x * 8 + (threadIdx.x >> 6), NGW = G * 8;
      for (int m = gw; m < MTOK; m += NGW) { const float rstd = row_rstd(ssp, m); f32x4* xr = (f32x4*)(outp + (size_t)m * DM) + lane; const f32x4* gr = (const f32x4*)fn + lane;
#pragma unroll
          for (int j = 0; j < 4; ++j) xr[64 * j] = xr[64 * j] * rstd * gr[64 * j]; } }
}

extern "C" void kernel_launch(void* const* d_in, const int* in_sizes, int n_in, void* d_out, int out_size, void* d_ws, size_t ws_size, hipStream_t stream) {
    static int grid = 0;
    if (grid == 0) {
        if (n_in != 20 || in_sizes[0] != MTOK * DM || out_size != MTOK * DM || ws_size < WS_END) { fprintf(stderr, "kernel_launch: unexpected shapes / workspace (n_in %d, ws %zu)\n", n_in, ws_size); grid = -1; return; }
        int dev = 0, cus = 0, per_cu = 0;
        if (hipGetDevice(&dev) != hipSuccess || hipDeviceGetAttribute(&cus, hipDeviceAttributeMultiprocessorCount, dev) != hipSuccess) { grid = -1; return; }
        if (hipFuncSetAttribute((const void*)fwd_megakernel, hipFuncAttributeMaxDynamicSharedMemorySize, LDS_BYTES) != hipSuccess) { fprintf(stderr, "kernel_launch: hipFuncSetAttribute failed\n"); grid = -1; return; }
        if (hipOccupancyMaxActiveBlocksPerMultiprocessor(&per_cu, (const void*)fwd_megakernel, 512, LDS_BYTES) != hipSuccess || per_cu < 1) { fprintf(stderr, "kernel_launch: occupancy query failed (%d)\n", per_cu); (void)hipGetLastError(); grid = -1; return; }
        grid = cus * per_cu;
    }
    if (grid < 0) return;
    if (hipMemsetAsync((char*)d_ws + WS_CTL, 0, 32768, stream) != hipSuccess) { fprintf(stderr, "kernel_launch: memset failed\n"); return; }
    Args a{};
    for (int i = 0; i < 20; ++i) a.in[i] = (const float*)d_in[i];
    a.out = (float*)d_out; a.ws = (unsigned char*)d_ws;
    void* args[] = {&a};
    const hipError_t e = hipLaunchCooperativeKernel((const void*)fwd_megakernel, dim3(grid), dim3(512), args, LDS_BYTES, stream);
    if (e != hipSuccess) fprintf(stderr, "kernel_launch: cooperative launch failed: %s (grid %d)\n", hipGetErrorString(e), grid);
}
```

```cpp
#include <hip/hip_runtime.h>
#include <hip/hip_cooperative_groups.h>
#include <cstdio>
#include <cstdint>
#include <cmath>
namespace cg = cooperative_groups;

#define LAS __attribute__((address_space(3)))
typedef unsigned short bf16_t;
typedef short bf16x8 __attribute__((ext_vector_type(8)));
typedef short s16x4 __attribute__((ext_vector_type(4)));
typedef float f32x2 __attribute__((ext_vector_type(2)));
typedef float f32x4 __attribute__((ext_vector_type(4)));
typedef float f32x16 __attribute__((ext_vector_type(16)));
typedef unsigned u32x4 __attribute__((ext_vector_type(4)));
typedef unsigned u32x2 __attribute__((ext_vector_type(2)));
typedef __bf16 bf16x2_t __attribute__((ext_vector_type(2)));

constexpr int SEQ = 8192, BATCH = 2, MTOK = BATCH * SEQ, DM = 1024, DEPTH = 2;
constexpr int IN_COLS = 5400, NIN = 5632, DFF = 2816, NGU = 5632;
constexpr float RMS_EPS = 1e-6f;
constexpr float QSCALE = 0.125f * 1.4426950408889634f;

__device__ __forceinline__ unsigned cvtpk(float lo, float hi) { f32x2 v = {lo, hi}; bf16x2_t b = __builtin_convertvector(v, bf16x2_t); return __builtin_bit_cast(unsigned, b); }
__device__ __forceinline__ float bflo(unsigned w) { return __uint_as_float(w << 16); }
__device__ __forceinline__ float bfhi(unsigned w) { return __uint_as_float(w & 0xffff0000u); }
__device__ __forceinline__ float sigmoidf_(float x) { return __builtin_amdgcn_rcpf(1.f + __expf(-x)); }

namespace pg8 {
constexpr int BM = 256, BK = 64, HALF = 128, HTB = HALF * BK * 2, STAGE_BYTES = 8 * HTB, NXCD = 8, WGM = 8;
__host__ __device__ __forceinline__ int lds_byte(int r, int c) { const int st = (r >> 4) * 2 + (c >> 5), rr = r & 15, cc = c & 31, ob = rr * 64 + cc * 2; return st * 1024 + (ob ^ (((ob >> 9) & 1) << 5)); }
__host__ __device__ __forceinline__ void stage_rc(int b, int& R, int& C) { const int st = b / 1024, sb = b % 1024, swz = sb ^ (((sb >> 9) & 1) << 5); R = (st >> 1) * 16 + swz / 64; C = (st & 1) * 32 + (swz % 64) / 2; }
__host__ __device__ __forceinline__ int perm32(int rho) { const int n = rho >> 4, i = rho & 15; return 8 * (i >> 2) + 4 * n + (i & 3); }
struct Unit { int pm, pn; };
struct Gemm { const bf16_t* A; const bf16_t* Bt; int M, N, K; };
struct StaticOrder {
    int nM, nN, nwg, G, c;
    __host__ __device__ void init(int M, int N, int G_, int c_) { nM = M / BM; nN = N / BM; nwg = nM * nN; G = G_; c = c_; }
    __host__ __device__ bool next(int i, Unit& u) const {
        const long L = (long)i * G + c; if (L >= nwg) return false;
        int wgid = (int)L; { const int q = nwg / NXCD, r = nwg % NXCD, xcd = wgid % NXCD, off = wgid / NXCD; wgid = (xcd < r ? xcd * (q + 1) : r * (q + 1) + (xcd - r) * q) + off; }
        const int nig = WGM * nN, gid = wgid / nig, fm = gid * WGM, gsz = (nM - fm) < WGM ? (nM - fm) : WGM;
        u.pm = fm + ((wgid % nig) % gsz); u.pn = (wgid % nig) / gsz; return true;
    }
};
template <class Epi, class Sched>
__device__ __forceinline__ void gemm_phase(LAS unsigned char* lds, const Gemm g, const Sched& S, const Epi& E) {
    int tid_ = threadIdx.x; asm volatile("" : "+v"(tid_));
    const int tid = tid_, wid = __builtin_amdgcn_readfirstlane(tid >> 6), lane = tid & 63, wr = wid >> 2, wc = wid & 3, fr = lane & 15, fq = lane >> 4;
    const int K = g.K, nt = K / BK;
    unsigned voffA[2], voffB[2];
#pragma unroll
    for (int i = 0; i < 2; ++i) { int R, C; stage_rc(tid * 16 + i * 8192, R, C); const int Rb = ((R & ~31) + perm32(R & 31));
        voffA[i] = (unsigned)(R * K + C) * 2u; voffB[i] = (unsigned)(Rb * K + C) * 2u; }
    const size_t kstep = (size_t)(BK * 2);
    const size_t hstep = (size_t)HALF * K * 2;
    const size_t tstep = 2 * hstep;
    const unsigned ldsw = (unsigned)wid * 1024u;
    const int aoff = lds_byte(wr * 64 + fr, fq * 8), boff = lds_byte(wc * 32 + fr, fq * 8);
#define PG8_SA(b, h) (((b) * 2 + (h)) * HTB)
#define PG8_SB(b, h) ((4 + (b) * 2 + (h)) * HTB)
#define PG8_STAGE(bufoff, gbase, voff) do { _Pragma("unroll") for (int _i = 0; _i < 2; ++_i) \
        __builtin_amdgcn_global_load_lds((const unsigned*)((const char*)(gbase) + (voff)[_i]), (LAS unsigned*)(lds + (bufoff) + ldsw + _i * 8192), 16, 0, 0); } while (0)
#define PG8_LDA(dst, b, h) do { _Pragma("unroll") for (int m = 0; m < 4; ++m) _Pragma("unroll") for (int k = 0; k < 2; ++k) dst[m][k] = *(const LAS bf16x8*)(lds + PG8_SA(b, h) + aoff + m * 2048 + k * 1024); } while (0)
#define PG8_LDB(dst, b, h) do { _Pragma("unroll") for (int n = 0; n < 2; ++n) _Pragma("unroll") for (int k = 0; k < 2; ++k) dst[n][k] = *(const LAS bf16x8*)(lds + PG8_SB(b, h) + boff + n * 2048 + k * 1024); } while (0)
#define PG8_MMA(ai, bj, At, Bt) do { __builtin_amdgcn_s_setprio(1); _Pragma("unroll") for (int m = 0; m < 4; ++m) _Pragma("unroll") for (int n = 0; n < 2; ++n) _Pragma("unroll") for (int k = 0; k < 2; ++k) \
        acc[ai][bj][m][n] = __builtin_amdgcn_mfma_f32_16x16x32_bf16(Bt[n][k], At[m][k], acc[ai][bj][m][n], 0, 0, 0); __builtin_amdgcn_s_setprio(0); } while (0)
#define PG8_WAIT_V(n) asm volatile("s_waitcnt vmcnt(" #n ")" ::: "memory")
#define PG8_WAIT_L(n) asm volatile("s_waitcnt lgkmcnt(" #n ")" ::: "memory")
#define PG8_BAR __builtin_amdgcn_s_barrier()
#define PG8_SCHED __builtin_amdgcn_sched_barrier(0)
    Unit cur, nxt; int ui = 0;
    if (!S.next(0, cur)) return;
    f32x4 acc[2][2][4][2];
#pragma unroll
    for (int a = 0; a < 2; ++a)
#pragma unroll
        for (int b = 0; b < 2; ++b)
#pragma unroll
            for (int m = 0; m < 4; ++m)
#pragma unroll
                for (int n = 0; n < 2; ++n) acc[a][b][m][n] = (f32x4){0.f, 0.f, 0.f, 0.f};
    bf16x8 At[4][2], B0[2][2], B1[2][2];
    const char* cA = (const char*)g.A + (size_t)cur.pm * tstep; const char* cB = (const char*)g.Bt + (size_t)cur.pn * tstep;
    PG8_STAGE(PG8_SB(0, 0), cB, voffB); PG8_STAGE(PG8_SB(0, 1), cB + hstep, voffB); PG8_STAGE(PG8_SA(0, 0), cA, voffA); PG8_STAGE(PG8_SA(0, 1), cA + hstep, voffA);
    if (wr == 1) PG8_BAR;
    PG8_WAIT_V(2); PG8_BAR;
    PG8_STAGE(PG8_SB(1, 0), cB + kstep, voffB); PG8_STAGE(PG8_SA(1, 0), cA + kstep, voffA); PG8_STAGE(PG8_SB(1, 1), cB + hstep + kstep, voffB);
    PG8_WAIT_V(6); PG8_BAR;
    for (;;) {
        const bool has_next = S.next(ui + 1, nxt);
        const char* nA = has_next ? (const char*)g.A + (size_t)nxt.pm * tstep : cA; const char* nB = has_next ? (const char*)g.Bt + (size_t)nxt.pn * tstep : cB;
        for (int t = 0; t < nt; t += 2) {
            const bool last = (t == nt - 2);
            const char* a1 = cA + (size_t)(t + 1) * kstep;
            const char* a2 = last ? nA : cA + (size_t)(t + 2) * kstep; const char* b2 = last ? nB : cB + (size_t)(t + 2) * kstep;
            const char* a3 = a2 + kstep; const char* b3 = b2 + kstep;
            if constexpr (Epi::KHOOK) { if (t == 4 || t == 12) { PG8_SCHED; E.khook(acc, cur, t, wr, wc, fr, fq); PG8_SCHED; } }
            PG8_LDB(B0, 0, 0); PG8_LDB(B1, 0, 1); PG8_SCHED; PG8_LDA(At, 0, 0); PG8_STAGE(PG8_SA(1, 1), a1 + hstep, voffA);
            PG8_WAIT_V(8); PG8_WAIT_L(0); PG8_BAR; PG8_MMA(0, 0, At, B0); PG8_MMA(0, 1, At, B1); PG8_BAR; PG8_SCHED;
            PG8_LDA(At, 0, 1); PG8_STAGE(PG8_SB(0, 0), b2, voffB); PG8_STAGE(PG8_SB(0, 1), b2 + hstep, voffB); PG8_STAGE(PG8_SA(0, 0), a2, voffA);
            PG8_WAIT_V(8); PG8_WAIT_L(0); PG8_BAR; PG8_MMA(1, 0, At, B0); PG8_MMA(1, 1, At, B1); PG8_BAR; PG8_SCHED;
            PG8_LDB(B0, 1, 0); PG8_LDB(B1, 1, 1); PG8_SCHED; PG8_LDA(At, 1, 0); PG8_STAGE(PG8_SA(0, 1), a2 + hstep, voffA);
            PG8_WAIT_V(8); PG8_WAIT_L(0); PG8_BAR; PG8_MMA(0, 0, At, B0); PG8_MMA(0, 1, At, B1); PG8_BAR; PG8_SCHED;
            PG8_LDA(At, 1, 1); PG8_STAGE(PG8_SB(1, 0), b3, voffB); PG8_STAGE(PG8_SB(1, 1), b3 + hstep, voffB); PG8_STAGE(PG8_SA(1, 0), a3, voffA);
            PG8_WAIT_V(8); PG8_WAIT_L(0); PG8_BAR; PG8_MMA(1, 0, At, B0); PG8_MMA(1, 1, At, B1); PG8_BAR; PG8_SCHED;
        }
        if (wr == 0) PG8_BAR;
        E(acc, cur, wr, wc, fr, fq);
        if (!has_next) break;
#pragma unroll
        for (int a = 0; a < 2; ++a)
#pragma unroll
            for (int b = 0; b < 2; ++b)
#pragma unroll
                for (int m = 0; m < 4; ++m)
#pragma unroll
                    for (int n = 0; n < 2; ++n) acc[a][b][m][n] = (f32x4){0.f, 0.f, 0.f, 0.f};
        cur = nxt; cA = nA; cB = nB; ++ui;
        if (wr == 1) PG8_BAR;
    }
    PG8_WAIT_V(0);
    PG8_BAR;
#undef PG8_SA
#undef PG8_SB
#undef PG8_STAGE
#undef PG8_LDA
#undef PG8_LDB
#undef PG8_MMA
#undef PG8_WAIT_V
#undef PG8_WAIT_L
#undef PG8_BAR
#undef PG8_SCHED
}
}
using pg8::Unit;
__device__ __forceinline__ float row_rstd(const float* ssp, int row) {
    const f32x4* p = (const f32x4*)(ssp + (size_t)row * 16);
    const f32x4 a = p[0], b = p[1], c = p[2], d = p[3];
    const float ss = ((a[0] + a[1]) + (a[2] + a[3])) + ((b[0] + b[1]) + (b[2] + b[3])) + ((c[0] + c[1]) + (c[2] + c[3])) + ((d[0] + d[1]) + (d[2] + d[3]));
    return 1.0f / sqrtf(ss * (1.0f / DM) + RMS_EPS);
}
__device__ __forceinline__ u32x4 pack8(const f32x4 a, const f32x4 b) { u32x4 w; w.x = cvtpk(a[0], a[1]); w.y = cvtpk(a[2], a[3]); w.z = cvtpk(b[0], b[1]); w.w = cvtpk(b[2], b[3]); return w; }
__device__ __forceinline__ void rope8(f32x4& v0, f32x4& v1, const float* tab, int t, int pos, float sc) {
    const f32x4* cs = (const f32x4*)(tab + ((size_t)t * 32 + (pos >> 1)) * 2);
    const f32x4 c0 = cs[0], c1 = cs[1];
    f32x4 o0, o1;
    o0[0] = (v0[0] * c0[0] - v0[1] * c0[1]) * sc; o0[1] = (v0[1] * c0[0] + v0[0] * c0[1]) * sc;
    o0[2] = (v0[2] * c0[2] - v0[3] * c0[3]) * sc; o0[3] = (v0[3] * c0[2] + v0[2] * c0[3]) * sc;
    o1[0] = (v1[0] * c1[0] - v1[1] * c1[1]) * sc; o1[1] = (v1[1] * c1[0] + v1[0] * c1[1]) * sc;
    o1[2] = (v1[2] * c1[2] - v1[3] * c1[3]) * sc; o1[3] = (v1[3] * c1[2] + v1[2] * c1[3]) * sc;
    v0 = o0; v1 = o1;
}
struct EpiInProj {
    static constexpr bool KHOOK = false;
    const float* ssp; const float* bias; const float* tab;
    bf16_t *U, *Qn, *KV, *Mo, *G, *Gn;
    __device__ __forceinline__ void operator()(const f32x4 (&acc)[2][2][4][2], const Unit& u, int wr, int wc, int fr, int fq) const {
        asm volatile("" : "+v"(fr), "+v"(fq));
        const int pn = u.pn;
#pragma unroll
        for (int ai = 0; ai < 2; ++ai)
#pragma unroll
            for (int m = 0; m < 4; ++m) {
                const int row = u.pm * 256 + ai * 128 + wr * 64 + m * 16 + fr;
                const float rstd = row_rstd(ssp, row);
                const int t = row & (SEQ - 1), b = row >> 13;
#pragma unroll
                for (int bj = 0; bj < 2; ++bj) {
                    const int cit = bj * 128 + wc * 32 + 8 * fq, gc = pn * 256 + cit;
                    f32x4 v0 = acc[ai][bj][m][0] * rstd + *(const f32x4*)(bias + gc), v1 = acc[ai][bj][m][1] * rstd + *(const f32x4*)(bias + gc + 4);
                    bf16_t* dst;
                    if (pn == 0) { dst = U + (size_t)row * 256 + cit; }
                    else if (pn <= 2) { const int c2 = (pn - 1) * 256 + cit, head = c2 >> 6, pos = c2 & 63; rope8(v0, v1, tab, t, pos, QSCALE); dst = Qn + ((size_t)(b * 8 + head) * SEQ + t) * 64 + pos; }
                    else if (pn <= 5) { const int c2 = cit & 127, g = c2 >> 6, pos = c2 & 63, kvi = 2 * (pn - 3) + bj; if (bj == 0) rope8(v0, v1, tab, t, pos, 1.f);
                        dst = KV + (size_t)kvi * ((size_t)MTOK * 128) + ((size_t)(b * 2 + g) * SEQ + t) * 64 + pos; }
                    else if (pn <= 8) { const int h = cit >> 6, pos = cit & 63; if (pn < 8) rope8(v0, v1, tab, t, pos, pn == 6 ? QSCALE : 1.f);
                        dst = Mo + (size_t)(pn - 6) * ((size_t)MTOK * 256) + ((size_t)(b * 4 + h) * SEQ + t) * 64 + pos; }
                    else if (pn <= 20) {
#pragma unroll
                        for (int e = 0; e < 4; ++e) { v0[e] = sigmoidf_(v0[e]); v1[e] = sigmoidf_(v1[e]); }
                        dst = G + (size_t)row * 3072 + (pn - 9) * 256 + cit; }
                    else {
#pragma unroll
                        for (int e = 0; e < 4; ++e) { v0[e] = sigmoidf_(v0[e]); v1[e] = sigmoidf_(v1[e]); }
                        dst = Gn + (size_t)row * 32 + (cit & 31); if (cit >= 32) dst = nullptr; }
                    if (dst) *(u32x4*)dst = pack8(v0, v1);
                }
                asm volatile("" ::: "memory");
            }
    }
};
struct EpiBranch {
    static constexpr bool KHOOK = true;
    const bf16_t* G; bf16_t* out;
    __device__ __forceinline__ void khook(f32x4 (&acc)[2][2][4][2], const Unit& u, int t, int wr, int wc, int fr, int fq) const {
        asm volatile("" : "+v"(fr), "+v"(fq));
        const int gsel = (t == 4) ? 0 : 1024;
#pragma unroll
        for (int ai = 0; ai < 2; ++ai)
#pragma unroll
            for (int m = 0; m < 4; ++m) {
                const int row = u.pm * 256 + ai * 128 + wr * 64 + m * 16 + fr;
#pragma unroll
                for (int bj = 0; bj < 2; ++bj) {
                    const int col = u.pn * 256 + bj * 128 + wc * 32 + 8 * fq;
                    const u32x4 gx = *(const u32x4*)(G + (size_t)row * 3072 + gsel + col), gy = *(const u32x4*)(G + (size_t)row * 3072 + gsel + 1024 + col);
#pragma unroll
                    for (int e = 0; e < 4; ++e) {
                        const float x0 = fmaxf(bflo(gx[e]), 1e-20f), x1 = fmaxf(bfhi(gx[e]), 1e-20f), y0 = fmaxf(bflo(gy[e]), 1e-20f), y1 = fmaxf(bfhi(gy[e]), 1e-20f);
                        const float r0 = x0 * __builtin_amdgcn_rcpf(y0), r1 = x1 * __builtin_amdgcn_rcpf(y1);
                        acc[ai][bj][m][e >> 1][(e & 1) * 2] *= r0; acc[ai][bj][m][e >> 1][(e & 1) * 2 + 1] *= r1;
                    }
                    asm volatile("" ::: "memory");
                }
            }
    }
    __device__ __forceinline__ void operator()(const f32x4 (&acc)[2][2][4][2], const Unit& u, int wr, int wc, int fr, int fq) const {
        asm volatile("" : "+v"(fr), "+v"(fq));
#pragma unroll
        for (int ai = 0; ai < 2; ++ai)
#pragma unroll
            for (int m = 0; m < 4; ++m) {
                const int row = u.pm * 256 + ai * 128 + wr * 64 + m * 16 + fr;
#pragma unroll
                for (int bj = 0; bj < 2; ++bj) {
                    const int col = u.pn * 256 + bj * 128 + wc * 32 + 8 * fq;
                    const u32x4 gz = *(const u32x4*)(G + (size_t)row * 3072 + 2048 + col);
                    f32x4 v0 = acc[ai][bj][m][0], v1 = acc[ai][bj][m][1];
                    v0[0] *= fmaxf(bflo(gz[0]), 1e-20f); v0[1] *= fmaxf(bfhi(gz[0]), 1e-20f); v0[2] *= fmaxf(bflo(gz[1]), 1e-20f); v0[3] *= fmaxf(bfhi(gz[1]), 1e-20f);
                    v1[0] *= fmaxf(bflo(gz[2]), 1e-20f); v1[1] *= fmaxf(bfhi(gz[2]), 1e-20f); v1[2] *= fmaxf(bflo(gz[3]), 1e-20f); v1[3] *= fmaxf(bfhi(gz[3]), 1e-20f);
                    *(u32x4*)(out + (size_t)row * DM + col) = pack8(v0, v1);
                }
                asm volatile("" ::: "memory");
            }
    }
};
struct EpiResid {
    static constexpr bool KHOOK = false;
    const float* base; float* out; bf16_t* xb; float* ssp;
    __device__ __forceinline__ void operator()(const f32x4 (&acc)[2][2][4][2], const Unit& u, int wr, int wc, int fr, int fq) const {
        asm volatile("" : "+v"(fr), "+v"(fq));
#pragma unroll
        for (int ai = 0; ai < 2; ++ai)
#pragma unroll
            for (int m = 0; m < 4; ++m) {
                const int row = u.pm * 256 + ai * 128 + wr * 64 + m * 16 + fr;
                float ss = 0.f;
#pragma unroll
                for (int bj = 0; bj < 2; ++bj) {
                    const size_t off = (size_t)row * DM + u.pn * 256 + bj * 128 + wc * 32 + 8 * fq;
                    const f32x4 v0 = acc[ai][bj][m][0] + *(const f32x4*)(base + off), v1 = acc[ai][bj][m][1] + *(const f32x4*)(base + off + 4);
                    *(f32x4*)(out + off) = v0; *(f32x4*)(out + off + 4) = v1;
                    *(u32x4*)(xb + off) = pack8(v0, v1);
                    ss += (v0[0] * v0[0] + v0[1] * v0[1]) + (v0[2] * v0[2] + v0[3] * v0[3]) + (v1[0] * v1[0] + v1[1] * v1[1]) + (v1[2] * v1[2] + v1[3] * v1[3]);
                }
                ss += __shfl_xor(ss, 16); ss += __shfl_xor(ss, 32);
                if (fq == 0) ssp[(size_t)row * 16 + u.pn * 4 + wc] = ss;
                asm volatile("" ::: "memory");
            }
    }
};
struct EpiSwiGLU {
    static constexpr bool KHOOK = false;
    const float* ssp; bf16_t* H;
    __device__ __forceinline__ void operator()(const f32x4 (&acc)[2][2][4][2], const Unit& u, int wr, int wc, int fr, int fq) const {
        asm volatile("" : "+v"(fr), "+v"(fq));
#pragma unroll
        for (int ai = 0; ai < 2; ++ai)
#pragma unroll
            for (int m = 0; m < 4; ++m) {
                const int row = u.pm * 256 + ai * 128 + wr * 64 + m * 16 + fr;
                const float rstd = row_rstd(ssp, row);
                f32x4 o[2];
#pragma unroll
                for (int n = 0; n < 2; ++n)
#pragma unroll
                    for (int e = 0; e < 4; ++e) { const float gt = acc[ai][0][m][n][e] * rstd, up = acc[ai][1][m][n][e] * rstd; o[n][e] = gt * sigmoidf_(gt) * up; }
                *(u32x4*)(H + (size_t)row * DFF + u.pn * 128 + wc * 32 + 8 * fq) = pack8(o[0], o[1]);
                asm volatile("" ::: "memory");
            }
    }
};
#ifndef ABL_NSA_SCALE
#define ABL_NSA_SCALE
#endif
#ifndef ABL_MOBA_SCALE
#define ABL_MOBA_SCALE
#endif
namespace att {
constexpr int KCS = 1040, KSLOT = 8 * KCS, VSLOT = 8192;
constexpr int L_K0 = 0, L_V0 = 4 * KSLOT, L_WSF = 4 * KSLOT + 4 * VSLOT, L_MSK = L_WSF + 8 * 256, L_UNI = L_MSK + 1024, L_LIST = L_UNI + 64, L_END = L_LIST + 512,
              L_PS = L_END + 64, L_OT = L_PS, L_TOTAL = L_OT + 8 * 8192;
static_assert(L_TOTAL <= 147456 - 64, "attention LDS map");
#define LBAR() asm volatile("s_waitcnt lgkmcnt(0)\n\ts_barrier" ::: "memory")
#define LWAIT() asm volatile("s_waitcnt lgkmcnt(0)" ::: "memory")
__device__ __forceinline__ int crow(int r, int hi) { return (r & 3) + 8 * (r >> 2) + 4 * hi; }
__device__ __forceinline__ float swap_other(float v, int hi) { auto rr = __builtin_amdgcn_permlane32_swap(__float_as_uint(v), __float_as_uint(v), false, false); return __uint_as_float(hi ? rr[0] : rr[1]); }
__device__ __forceinline__ void qkt(f32x16& p0, f32x16& p1, const LAS char* Ks, const bf16x8* qr, const f32x16& cinit, int r32, int hi) {
    const LAS char* kb = Ks + hi * KCS + r32 * 16;
#pragma unroll
    for (int d0 = 0; d0 < 4; ++d0) {
        const bf16x8 b0 = *(const LAS bf16x8*)(kb + d0 * 2 * KCS), b1 = *(const LAS bf16x8*)(kb + d0 * 2 * KCS + 512);
        if (d0 == 0) { p0 = __builtin_amdgcn_mfma_f32_32x32x16_bf16(b0, qr[0], cinit, 0, 0, 0); p1 = __builtin_amdgcn_mfma_f32_32x32x16_bf16(b1, qr[0], cinit, 0, 0, 0); }
        else { p0 = __builtin_amdgcn_mfma_f32_32x32x16_bf16(b0, qr[d0], p0, 0, 0, 0); p1 = __builtin_amdgcn_mfma_f32_32x32x16_bf16(b1, qr[d0], p1, 0, 0, 0); } }
}
struct VFrag { s16x4 lo[8], hi[8]; };
typedef short v4i16_t __attribute__((ext_vector_type(4)));
__device__ __forceinline__ s16x4 vtr(const LAS char* p) { return __builtin_bit_cast(s16x4, __builtin_amdgcn_ds_read_tr16_b64_v4i16((LAS v4i16_t*)p)); }
__device__ __forceinline__ void v_issue(VFrag& F, const LAS char* vp) {
#pragma unroll
    for (int d0 = 0; d0 < 2; ++d0)
#pragma unroll
        for (int ks = 0; ks < 4; ++ks) { F.lo[d0 * 4 + ks] = vtr(vp + d0 * 4096 + ks * 1024); F.hi[d0 * 4 + ks] = vtr(vp + d0 * 4096 + ks * 1024 + 512); }
}
template <bool SUM> __device__ __forceinline__ void pv(f32x16* o, f32x16& osum, VFrag& F, bf16x8 pa0, bf16x8 pa1, bf16x8 pa2, bf16x8 pa3) {
#define PK(k) (bf16x8){F.lo[k][0], F.lo[k][1], F.lo[k][2], F.lo[k][3], F.hi[k][0], F.hi[k][1], F.hi[k][2], F.hi[k][3]}
    const bf16x8 ones = {0x3F80, 0x3F80, 0x3F80, 0x3F80, 0x3F80, 0x3F80, 0x3F80, 0x3F80};
    __builtin_amdgcn_s_setprio(1);
    o[0] = __builtin_amdgcn_mfma_f32_32x32x16_bf16(pa0, PK(0), o[0], 0, 0, 0);
    o[1] = __builtin_amdgcn_mfma_f32_32x32x16_bf16(pa0, PK(4), o[1], 0, 0, 0);
    if (SUM) osum = __builtin_amdgcn_mfma_f32_32x32x16_bf16(pa0, ones, osum, 0, 0, 0);
    o[0] = __builtin_amdgcn_mfma_f32_32x32x16_bf16(pa1, PK(1), o[0], 0, 0, 0);
    o[1] = __builtin_amdgcn_mfma_f32_32x32x16_bf16(pa1, PK(5), o[1], 0, 0, 0);
    if (SUM) osum = __builtin_amdgcn_mfma_f32_32x32x16_bf16(pa1, ones, osum, 0, 0, 0);
    o[0] = __builtin_amdgcn_mfma_f32_32x32x16_bf16(pa2, PK(2), o[0], 0, 0, 0);
    o[1] = __builtin_amdgcn_mfma_f32_32x32x16_bf16(pa2, PK(6), o[1], 0, 0, 0);
    if (SUM) osum = __builtin_amdgcn_mfma_f32_32x32x16_bf16(pa2, ones, osum, 0, 0, 0);
    o[0] = __builtin_amdgcn_mfma_f32_32x32x16_bf16(pa3, PK(3), o[0], 0, 0, 0);
    o[1] = __builtin_amdgcn_mfma_f32_32x32x16_bf16(pa3, PK(7), o[1], 0, 0, 0);
    if (SUM) osum = __builtin_amdgcn_mfma_f32_32x32x16_bf16(pa3, ones, osum, 0, 0, 0);
    __builtin_amdgcn_s_setprio(0);
#undef PK
}
__device__ __forceinline__ float rowmax(const f32x16& p0, const f32x16& p1, int hi) {
    float a = __builtin_fmaxf(p0[0], p1[0]);
#pragma unroll
    for (int r = 1; r < 16; ++r) a = __builtin_fmaxf(__builtin_fmaxf(a, p0[r]), p1[r]);
    return __builtin_fmaxf(a, swap_other(a, hi));
}
struct KVRegs { u32x4 k, v; };
__device__ __forceinline__ void tile_load(KVRegs& R, const bf16_t* K, const bf16_t* V, int tid) { R.k = *(const u32x4*)(K + tid * 8); R.v = *(const u32x4*)(V + tid * 8); }
__device__ __forceinline__ void tile_store(const KVRegs& R, LAS char* Ks, LAS char* Vs, int tid) {
    const int row = tid >> 3, c = tid & 7;
    *(LAS u32x4*)(Ks + c * KCS + row * 16) = R.k;
    *(LAS u32x4*)(Vs + (c >> 2) * 4096 + (row >> 4) * 1024 + (row & 15) * 64 + (c & 3) * 16) = R.v;
}
__device__ __forceinline__ void ps_accum(const f32x16 p, int jb, LAS float* ps_row, bool writer) {
#pragma unroll
    for (int rg = 0; rg < 4; ++rg) {
        float a = 2.f * (p[4 * rg] + p[4 * rg + 1] + p[4 * rg + 2]) + p[4 * rg + 3], bq = p[4 * rg + 3];
        a += __shfl_xor(a, 1); a += __shfl_xor(a, 2); bq += __shfl_xor(bq, 1); bq += __shfl_xor(bq, 2);
        const int j = jb + 2 * rg;
        if (writer) { __hip_atomic_fetch_add(ps_row + j, a, __ATOMIC_RELAXED, __HIP_MEMORY_SCOPE_WORKGROUP); if (j + 1 < 128) __hip_atomic_fetch_add(ps_row + j + 1, bq, __ATOMIC_RELAXED, __HIP_MEMORY_SCOPE_WORKGROUP); }
    }
}
struct Ctx { LAS char* lds; LAS float* wsf; LAS float* otl; int tid, wid, lane, r32, hi, vbl; };
struct RowSt { float m, l; bool started; f32x16 negm, osum; };
__device__ __forceinline__ void rowst_init(RowSt& S) { S.m = 0.f; S.l = 0.f; S.started = false; S.negm = f32x16{}; S.osum = f32x16{}; asm volatile("" : "+v"(S.negm)); }
__device__ __forceinline__ void rowst_fixed(RowSt& S, float ref) { S.m = ref; S.l = 0.f; S.started = true; S.osum = f32x16{};
#pragma unroll
    for (int r = 0; r < 16; ++r) S.negm[r] = -ref;
    asm volatile("" : "+v"(S.negm)); }
template <int MODE, class Src, class Msk>
__device__ __forceinline__ void run_branch(const Ctx& C, int nt, const Src& src, const Msk& msk, const bf16x8* qr, RowSt& S, f32x16* o, LAS float* ps_row, bool ps_writer, KVRegs& R0, bool pre, const bf16_t* nk, const bf16_t* nv) {
    KVRegs R1; const bf16_t *kp, *vp;
    if (!pre) { src(0, kp, vp); tile_load(R0, kp, vp, C.tid); }
    if (nt > 1) { src(1, kp, vp); tile_load(R1, kp, vp, C.tid); }
    auto compute = [&](int it, const LAS char* Ks, const LAS char* Vs, int klo, int khi, bool nm) {
        const bool kill = khi < klo;
        if (!__any(!kill)) return;
        f32x16 p0, p1; qkt(p0, p1, Ks, qr, S.negm, C.r32, C.hi);
        VFrag VF; if constexpr (MODE != 0) v_issue(VF, Vs + C.vbl);
        if (__any(nm && !kill)) {
#pragma unroll
            for (int r = 0; r < 16; ++r) { const int kv = crow(r, C.hi); if (kv < klo || kv > khi) p0[r] = -INFINITY; if (kv + 32 < klo || kv + 32 > khi) p1[r] = -INFINITY; }
        }
        if constexpr (MODE != 2) {
            float rm = rowmax(p0, p1, C.hi); if (kill) rm = -INFINITY;
            const bool first = !S.started && rm > -INFINITY, grow = first || rm > 8.0f;
            if (__any(grow)) {
                const float d = grow ? rm : 0.f, alpha = first ? 1.0f : __builtin_amdgcn_exp2f(-d);
                S.m += d; S.started = S.started || first;
#pragma unroll
                for (int r = 0; r < 16; ++r) { S.negm[r] = -S.m; p0[r] -= d; p1[r] -= d; }
                if constexpr (MODE == 0) S.l *= alpha;
                if constexpr (MODE == 1) {
                    if (C.hi == 0) C.wsf[C.r32] = alpha;
                    LWAIT();
#pragma unroll
                    for (int r = 0; r < 16; ++r) { const float f = C.wsf[crow(r, C.hi)]; o[0][r] *= f; o[1][r] *= f; S.osum[r] *= f; }
                    LWAIT();
                }
            }
        }
#pragma unroll
        for (int r = 0; r < 16; ++r) { p0[r] = __builtin_amdgcn_exp2f(p0[r]); p1[r] = __builtin_amdgcn_exp2f(p1[r]); }
        if constexpr (MODE == 0) {
            float s = 0.f;
#pragma unroll
            for (int r = 0; r < 16; ++r) s += p0[r] + p1[r];
            S.l += kill ? 0.f : s;
        }
        if constexpr (MODE == 2) {
            if (__any(kill)) {
#pragma unroll
                for (int r = 0; r < 16; ++r) { p0[r] = kill ? 0.f : p0[r]; p1[r] = kill ? 0.f : p1[r]; }
            }
            ps_accum(p0, 16 * it + C.hi, ps_row, ps_writer); ps_accum(p1, 16 * it + 8 + C.hi, ps_row, ps_writer);
        }
        if constexpr (MODE != 0) {
            u32x4 w0 = {cvtpk(p0[0], p0[1]), cvtpk(p0[2], p0[3]), cvtpk(p0[4], p0[5]), cvtpk(p0[6], p0[7])}, w1 = {cvtpk(p0[8], p0[9]), cvtpk(p0[10], p0[11]), cvtpk(p0[12], p0[13]), cvtpk(p0[14], p0[15])};
            u32x4 w2 = {cvtpk(p1[0], p1[1]), cvtpk(p1[2], p1[3]), cvtpk(p1[4], p1[5]), cvtpk(p1[6], p1[7])}, w3 = {cvtpk(p1[8], p1[9]), cvtpk(p1[10], p1[11]), cvtpk(p1[12], p1[13]), cvtpk(p1[14], p1[15])};
            if constexpr (MODE == 1) {
                if (__any(kill)) {
#pragma unroll
                    for (int e = 0; e < 4; ++e) { w0[e] = kill ? 0u : w0[e]; w1[e] = kill ? 0u : w1[e]; w2[e] = kill ? 0u : w2[e]; w3[e] = kill ? 0u : w3[e]; }
                }
            }
            pv<MODE == 1>(o, S.osum, VF, __builtin_bit_cast(bf16x8, w0), __builtin_bit_cast(bf16x8, w1), __builtin_bit_cast(bf16x8, w2), __builtin_bit_cast(bf16x8, w3));
        }
    };
    LBAR();
    for (int it = 0; it < nt; it += 2) {
        const int p = (it >> 1) & 1; const bool two = it + 1 < nt;
        LAS char* KsA = C.lds + L_K0 + (2 * p) * KSLOT; LAS char* VsA = C.lds + L_V0 + (2 * p) * VSLOT;
        LAS char* KsB = KsA + KSLOT; LAS char* VsB = VsA + VSLOT;
        tile_store(R0, KsA, VsA, C.tid); if (two) tile_store(R1, KsB, VsB, C.tid);
        if (it + 2 < nt) { src(it + 2, kp, vp); tile_load(R0, kp, vp, C.tid); } else if (nk) tile_load(R0, nk, nv, C.tid);
        if (it + 3 < nt) { src(it + 3, kp, vp); tile_load(R1, kp, vp, C.tid); }
        int kloA, khiA, kloB = 0, khiB = -1; const bool nmA = msk(it, kloA, khiA); bool nmB = false; if (two) nmB = msk(it + 1, kloB, khiB);
        LBAR();
        compute(it, KsA, VsA, kloA, khiA, nmA);
        if (two) compute(it + 1, KsB, VsB, kloB, khiB, nmB);
    }
}
template <bool FIRST> __device__ __forceinline__ void merge_branch_n(const Ctx& C, const f32x16* o, const f32x16& osum, float gate) {
    if (C.hi == 0) C.wsf[C.r32] = gate;
    LWAIT();
#pragma unroll
    for (int r = 0; r < 16; ++r) { const float den = osum[r], f = den > 0.f ? C.wsf[crow(r, C.hi)] * __builtin_amdgcn_rcpf(den) : 0.f;
        if (FIRST) { C.otl[r * 64] = o[0][r] * f; C.otl[(16 + r) * 64] = o[1][r] * f; }
        else { C.otl[r * 64] += o[0][r] * f; C.otl[(16 + r) * 64] += o[1][r] * f; } }
    LWAIT();
}
template <bool FIRST> __device__ __forceinline__ void merge_branch(const Ctx& C, const f32x16* o, float factor) {
    if (C.hi == 0) C.wsf[C.r32] = factor;
    LWAIT();
#pragma unroll
    for (int r = 0; r < 16; ++r) { const float f = C.wsf[crow(r, C.hi)];
        if (FIRST) { C.otl[r * 64] = o[0][r] * f; C.otl[(16 + r) * 64] = o[1][r] * f; }
        else { C.otl[r * 64] += o[0][r] * f; C.otl[(16 + r) * 64] += o[1][r] * f; } }
    LWAIT();
}
struct Bufs { const bf16_t *Qn, *KV, *Mo, *KC, *KM, *Gn; bf16_t* Abr; };
constexpr size_t KV_STRIDE = (size_t)MTOK * 128, MO_STRIDE = (size_t)MTOK * 256;

__device__ __forceinline__ void nsa_item(const Ctx& C, const Bufs& B, int b, int g, int i) {
    const int r32 = C.r32, hi = C.hi, wid = C.wid;
    const int qi = 8 * wid + (r32 >> 2), hh = r32 & 3, head = g * 4 + hh, t = 64 * i + qi, cur = i;
    const size_t bg = (size_t)(b * 2 + g) * SEQ;
    bf16x8 qr[4];
    { const bf16_t* qp = B.Qn + ((size_t)(b * 8 + head) * SEQ + t) * 64 + hi * 8;
#pragma unroll
      for (int d0 = 0; d0 < 4; ++d0) qr[d0] = *(const bf16x8*)(qp + d0 * 16); }
    const unsigned gw = *(const unsigned*)(B.Gn + ((size_t)b * SEQ + t) * 32 + head * 3 - (head & 1));
    const unsigned gw2 = *(const unsigned*)(B.Gn + ((size_t)b * SEQ + t) * 32 + head * 3 - (head & 1) + 2);
    float g0, g1, g2; if (head & 1) { g0 = bfhi(gw); g1 = bflo(gw2); g2 = bfhi(gw2); } else { g0 = bflo(gw); g1 = bfhi(gw); g2 = bflo(gw2); }
    f32x16 o[2];
    LAS float* Ps = (LAS float*)(C.lds + L_PS); LAS unsigned* Mk = (LAS unsigned*)(C.lds + L_MSK); LAS unsigned* Uni = (LAS unsigned*)(C.lds + L_UNI); LAS int* List = (LAS int*)(C.lds + L_LIST);
    const int nv = t >= 31 ? ((t - 31) >> 4) + 1 : 0;
    const int nvt = (4 * i + 3 < 511) ? 4 * i + 3 : 511, ntc = (nvt + 63) >> 6;
    const bf16_t* kc = B.KC + (size_t)(0 * 4 + b * 2 + g) * 512 * 64; const bf16_t* vc = B.KC + (size_t)(1 * 4 + b * 2 + g) * 512 * 64;
    auto srcC = [&](int it, const bf16_t*& kp, const bf16_t*& vp) { kp = kc + (size_t)it * 4096; vp = vc + (size_t)it * 4096; };
    auto mskC = [&](int it, int& klo, int& khi) { klo = 0; khi = nv - 1 - 64 * it; return khi < 63; };
    RowSt S; rowst_init(S);
    KVRegs R;
    run_branch<0>(C, ntc, srcC, mskC, qr, S, o, nullptr, false, R, false, kc, vc);
    const float lt = S.l + swap_other(S.l, hi);
    rowst_fixed(S, lt > 0.f ? S.m + __builtin_amdgcn_logf(lt) : 0.f);
    for (int e = C.tid; e < 64 * 128; e += 512) Ps[e] = 0.f;
    if (C.tid < 8) Uni[C.tid] = 0u;
    o[0] = f32x16{}; o[1] = f32x16{};
    run_branch<2>(C, ntc, srcC, mskC, qr, S, o, Ps + qi * 128, hh == 0, R, true, B.KV + 2 * KV_STRIDE + bg * 64, B.KV + 3 * KV_STRIDE + bg * 64);
    LBAR();
    {
        const int nf = cur == 0 ? 1 : (cur == 1 ? 2 : 3), kp_ = 16 - nf, lane = C.lane;
#pragma unroll 1
        for (int qq = 0; qq < 8; ++qq) {
            int q = 8 * wid + qq; asm volatile("" : "+s"(q)); LAS float* ps = Ps + q * 128;
            const int j0 = lane, j1 = lane + 64;
            const bool f0 = (j0 == 0 || j0 == cur || j0 == cur - 1) && j0 <= cur, f1 = (j1 == cur || j1 == cur - 1) && j1 <= cur;
            const bool va0 = j0 <= cur && !f0, va1 = j1 <= cur && !f1;
            const unsigned k0 = va0 ? __float_as_uint(ps[j0]) + 1u : 0u, k1 = va1 ? __float_as_uint(ps[j1]) + 1u : 0u;
            unsigned T = 0u;
            for (int bit = 30; bit >= 0; --bit) { const unsigned cand = T | (1u << bit); const int cnt = __popcll(__ballot(k0 >= cand)) + __popcll(__ballot(k1 >= cand)); if (cnt >= kp_) T = cand; }
            const int need = kp_ - (__popcll(__ballot(k0 > T)) + __popcll(__ballot(k1 > T)));
            const unsigned long long t0 = __ballot(k0 == T), t1 = __ballot(k1 == T), below = (1ull << lane) - 1ull;
            const int pre0 = __popcll(t0 & below), pre1 = __popcll(t0) + __popcll(t1 & below);
            const bool s0 = f0 || (k0 > 0u && (k0 > T || (k0 == T && pre0 < need))), s1 = f1 || (k1 > 0u && (k1 > T || (k1 == T && pre1 < need)));
            const unsigned long long b0 = __ballot(s0), b1 = __ballot(s1);
            if (lane == 0) { Mk[q * 4 + 0] = (unsigned)b0; Mk[q * 4 + 1] = (unsigned)(b0 >> 32); Mk[q * 4 + 2] = (unsigned)b1; Mk[q * 4 + 3] = (unsigned)(b1 >> 32);
                __hip_atomic_fetch_or(&Uni[0], (unsigned)b0, __ATOMIC_RELAXED, __HIP_MEMORY_SCOPE_WORKGROUP); __hip_atomic_fetch_or(&Uni[1], (unsigned)(b0 >> 32), __ATOMIC_RELAXED, __HIP_MEMORY_SCOPE_WORKGROUP); __hip_atomic_fetch_or(&Uni[2], (unsigned)b1, __ATOMIC_RELAXED, __HIP_MEMORY_SCOPE_WORKGROUP); __hip_atomic_fetch_or(&Uni[3], (unsigned)(b1 >> 32), __ATOMIC_RELAXED, __HIP_MEMORY_SCOPE_WORKGROUP); }
        }
    }
    LBAR();
    if (C.tid == 0) { int n = 0; for (int w = 0; w < 4; ++w) { unsigned u = Uni[w]; while (u) { const int bpos = __builtin_ctz(u); u &= u - 1; List[n++] = w * 32 + bpos; } } Uni[4] = (unsigned)n; }
    LBAR();
    merge_branch<true>(C, o, g0);
    {
        const int nsel = (int)Uni[4];
        const bf16_t* ks = B.KV + 2 * KV_STRIDE + bg * 64; const bf16_t* vs = B.KV + 3 * KV_STRIDE + bg * 64;
        auto srcS = [&](int it, const bf16_t*& kp, const bf16_t*& vp) { const int j = List[it]; kp = ks + (size_t)j * 4096; vp = vs + (size_t)j * 4096; };
        auto mskS = [&](int it, int& klo, int& khi) { const int j = List[it]; const unsigned w = Mk[qi * 4 + (j >> 5)]; const bool bit = (w >> (j & 31)) & 1u;
            klo = 0; khi = bit ? (j == cur ? qi : 63) : -1; return j == cur; };
        rowst_init(S); o[0] = f32x16{}; o[1] = f32x16{};
        const int tw0n = i >= 8 ? i - 8 : 0;
        run_branch<1>(C, nsel, srcS, mskS, qr, S, o, nullptr, false, R, true, B.KV + 4 * KV_STRIDE + bg * 64 + (size_t)tw0n * 4096, B.KV + 5 * KV_STRIDE + bg * 64 + (size_t)tw0n * 4096);
        merge_branch_n<false>(C, o, S.osum, g1);
    }
    {
        const int tw0 = i >= 8 ? i - 8 : 0, ntw = i - tw0 + 1;
        const bf16_t* kw = B.KV + 4 * KV_STRIDE + bg * 64; const bf16_t* vw = B.KV + 5 * KV_STRIDE + bg * 64;
        auto srcW = [&](int it, const bf16_t*& kp, const bf16_t*& vp) { kp = kw + (size_t)(tw0 + it) * 4096; vp = vw + (size_t)(tw0 + it) * 4096; };
        auto mskW = [&](int it, int& klo, int& khi) { const int tw = tw0 + it; klo = (t - 511) - 64 * tw; khi = (tw == i) ? qi : 63; return tw == i || klo > 0; };
        rowst_init(S); o[0] = f32x16{}; o[1] = f32x16{};
        run_branch<1>(C, ntw, srcW, mskW, qr, S, o, nullptr, false, R, true, nullptr, nullptr);
        merge_branch_n<false>(C, o, S.osum, g2);
    }
#pragma unroll
    for (int r = 0; r < 16; ++r) { const int qrow = crow(r, hi); bf16_t* dst = B.Abr + ((size_t)b * SEQ + 64 * i + 8 * wid + (qrow >> 2)) * DM + 256 + (g * 4 + (qrow & 3)) * 64 + r32;
        dst[0] = (bf16_t)(cvtpk(ABL_NSA_SCALE C.otl[r * 64], 0.f) & 0xffffu); dst[32] = (bf16_t)(cvtpk(ABL_NSA_SCALE C.otl[(16 + r) * 64], 0.f) & 0xffffu); }
}
__device__ __forceinline__ void moba_item(const Ctx& C, const Bufs& B, int b, int h, int qb) {
    const int r32 = C.r32, hi = C.hi, wid = C.wid, own = qb, t = 256 * qb + 32 * wid + r32;
    const size_t bh = (size_t)(b * 4 + h) * SEQ;
    bf16x8 qr[4];
    { const bf16_t* qp = B.Mo + (bh + t) * 64 + hi * 8;
#pragma unroll
      for (int d0 = 0; d0 < 4; ++d0) qr[d0] = *(const bf16x8*)(qp + d0 * 16); }
    LAS unsigned* Uni = (LAS unsigned*)(C.lds + L_UNI); LAS int* List = (LAS int*)(C.lds + L_LIST);
    LBAR();
    if (C.tid < 256) { const u32x4 kmv = *(const u32x4*)(B.KM + (size_t)(b * 4 + h) * 2048 + C.tid * 8); *(LAS u32x4*)(C.lds + L_K0 + (C.tid & 7) * KCS + (C.tid >> 3) * 16) = kmv; }
    if (C.tid == 0) Uni[0] = 0u;
    LBAR();
    unsigned sel = 0u;
    {
        f32x16 gs = f32x16{};
        const LAS char* kb = C.lds + L_K0 + hi * KCS + r32 * 16;
#pragma unroll
        for (int d0 = 0; d0 < 4; ++d0) gs = __builtin_amdgcn_mfma_f32_32x32x16_bf16(*(const LAS bf16x8*)(kb + d0 * 2 * KCS), qr[d0], gs, 0, 0, 0);
        float lo[16], hv[16];
#pragma unroll
        for (int r = 0; r < 16; ++r) { const float ownv = gs[r], oth = swap_other(ownv, hi); lo[r] = hi ? oth : ownv; hv[r] = hi ? ownv : oth; }
        unsigned taken = ~((1u << own) - 1u);
#pragma unroll
        for (int round = 0; round < 3; ++round) {
            float best = -INFINITY; int bi = 32;
#pragma unroll
            for (int n = 0; n < 32; ++n) { const int rr = (n & 3) + 4 * (n >> 3); const float v = ((n >> 2) & 1) ? hv[rr] : lo[rr]; if (!((taken >> n) & 1u) && v > best) { best = v; bi = n; } }
            if (bi < 32) { sel |= 1u << bi; taken |= 1u << bi; }
        }
    }
    { unsigned u = sel;
#pragma unroll
      for (int o_ = 1; o_ < 64; o_ <<= 1) u |= (unsigned)__shfl_xor((int)u, o_);
      if (C.lane == 0) __hip_atomic_fetch_or(&Uni[0], u, __ATOMIC_RELAXED, __HIP_MEMORY_SCOPE_WORKGROUP); }
    LBAR();
    if (C.tid == 0) { int n = 0; unsigned u = Uni[0]; while (u) { const int bpos = __builtin_ctz(u); u &= u - 1; List[n++] = bpos; } Uni[4] = (unsigned)n; }
    LBAR();
    const int nl = (int)Uni[4], nt = 4 * nl + 4;
    const bf16_t* kk = B.Mo + MO_STRIDE + bh * 64; const bf16_t* vv = B.Mo + 2 * MO_STRIDE + bh * 64;
    auto src = [&](int it, const bf16_t*& kp, const bf16_t*& vp) { const int T = (it < 4 * nl) ? 4 * List[it >> 2] + (it & 3) : 4 * own + (it - 4 * nl); kp = kk + (size_t)T * 4096; vp = vv + (size_t)T * 4096; };
    auto msk = [&](int it, int& klo, int& khi) { klo = 0; if (it < 4 * nl) { const bool bit = (sel >> List[it >> 2]) & 1u; khi = bit ? 63 : -1; return false; } khi = 32 * wid + r32 - 64 * (it - 4 * nl); return true; };
    RowSt S; rowst_init(S); f32x16 o[2] = {f32x16{}, f32x16{}};
    KVRegs R;
    run_branch<1>(C, nt, src, msk, qr, S, o, nullptr, false, R, false, nullptr, nullptr);
    merge_branch_n<true>(C, o, S.osum, 1.0f);
#pragma unroll
    for (int r = 0; r < 16; ++r) { const int qrow = crow(r, hi); bf16_t* dst = B.Abr + ((size_t)b * SEQ + 256 * qb + 32 * wid + qrow) * DM + 768 + h * 64 + r32;
        dst[0] = (bf16_t)(cvtpk(ABL_MOBA_SCALE C.otl[r * 64], 0.f) & 0xffffu); dst[32] = (bf16_t)(cvtpk(ABL_MOBA_SCALE C.otl[(16 + r) * 64], 0.f) & 0xffffu); }
}
}
#define XB_TMO      128
#define XB_XCNT(j)  (256  + 64 * (j))
#define XB_XSUB(j)  (1280 + 64 * (j))
#define XB_XGEN(j)  (2304 + 64 * (j))
#define XB_TOP      3328
#define XB_TOPGEN   3392
#define XCD_BAR_WORDS 3456
#define XB_SPIN_CAP (1u << 18)

__device__ __forceinline__ unsigned xb_ld(unsigned* p)              { return __hip_atomic_load(p, __ATOMIC_RELAXED, __HIP_MEMORY_SCOPE_AGENT); }
__device__ __forceinline__ unsigned xb_add(unsigned* p, unsigned v) { return __hip_atomic_fetch_add(p, v, __ATOMIC_RELAXED, __HIP_MEMORY_SCOPE_AGENT); }
__device__ __forceinline__ unsigned xb_xcc_id() { return (unsigned)__builtin_amdgcn_s_getreg((3 << 11) | 20) & 0xFu; }
#define XB_SPIN(cond, bar) do { unsigned _sp = 0; while (cond) { __builtin_amdgcn_s_sleep(1); \
    if ((++_sp & 255u) == 0u) { if (xb_ld(&(bar)[XB_TMO])) break; if (_sp > XB_SPIN_CAP) { atomicAdd(&(bar)[XB_TMO], 1u); break; } } } } while (0)

struct XcdBarrier {
    unsigned* bar; unsigned x;
    volatile LAS unsigned* st;
};

__device__ __forceinline__ XcdBarrier xcd_barrier_post(unsigned* bar, volatile LAS unsigned* st) {
    XcdBarrier b; b.bar = bar; b.x = xb_xcc_id(); b.st = st;
    if (threadIdx.x == 0) (void)xb_add(&bar[XB_XCNT(b.x)], 1u);
    return b;
}
__device__ __forceinline__ void xcd_barrier_complete(unsigned* bar, unsigned x, unsigned& nloc, unsigned& nx) {
    const unsigned G = gridDim.x * gridDim.y * gridDim.z;
    unsigned sum, cnt, mine, sp = 0u;
    for (;;) {
        sum = 0u; cnt = 0u; mine = 0u;
#pragma unroll
        for (unsigned j = 0; j < 16; ++j) { const unsigned c = xb_ld(&bar[XB_XCNT(j)]); sum += c; cnt += (c > 0u) ? 1u : 0u; mine = (j == x) ? c : mine; }
        if (sum == G) break;
        __builtin_amdgcn_s_sleep(1);
        if ((++sp & 255u) == 0u) { if (xb_ld(&bar[XB_TMO])) break; if (sp > XB_SPIN_CAP) { atomicAdd(&bar[XB_TMO], 1u); break; } }
    }
    nloc = mine > 0u ? mine : 1u; nx = cnt > 0u ? cnt : 1u;
}

__device__ __forceinline__ void xcd_barrier(const XcdBarrier& b) {
    asm volatile("s_waitcnt vmcnt(0)" ::: "memory");
    __syncthreads();
    if (threadIdx.x == 0) {
        unsigned* bar = b.bar;
        __builtin_amdgcn_s_waitcnt(0);
        unsigned nloc = b.st[0], nx = b.st[1];
        if (nloc == 0u) { xcd_barrier_complete(bar, b.x, nloc, nx); b.st[0] = nloc; b.st[1] = nx; }
        const unsigned old = xb_add(&bar[XB_XSUB(b.x)], 1u);
        const unsigned gen = old / nloc;
        if (old + 1u == (gen + 1u) * nloc) {
            __builtin_amdgcn_fence(__ATOMIC_RELEASE, "agent");
            asm volatile("s_waitcnt vmcnt(0)" ::: "memory");
            const unsigned og = xb_add(&bar[XB_TOP], 1u);
            const unsigned tg = og / nx;
            if (og + 1u == (tg + 1u) * nx) xb_add(&bar[XB_TOPGEN], 1u);
            else XB_SPIN(xb_ld(&bar[XB_TOPGEN]) == tg, bar);
            __builtin_amdgcn_fence(__ATOMIC_ACQUIRE, "agent");
            xb_add(&bar[XB_XGEN(b.x)], 1u);
            asm volatile("s_waitcnt vmcnt(0)" ::: "memory");
        } else {
            XB_SPIN(xb_ld(&bar[XB_XGEN(b.x)]) == gen, bar);
            __builtin_amdgcn_fence(__ATOMIC_ACQUIRE, "agent");
            asm volatile("s_waitcnt vmcnt(0)" ::: "memory");
        }
    }
    __syncthreads();
}

#ifndef DUP
#define DUP 0
#endif
constexpr size_t MiB = 1u << 20;
constexpr size_t WS_CTL = 0, WS_ORDER = 4096, WS_BAR = 8192;
constexpr size_t WS_W = 1 * MiB, OFF_WIN = 0, OFF_WGU = 11 * MiB, OFF_WD = 22 * MiB, OFF_WBR = 28 * MiB, OFF_WOUT = 30 * MiB, OFF_W1 = 32 * MiB, OFF_W2 = 34 * MiB,
                 OFF_BIN = 34 * MiB + 65536, OFF_CB1 = OFF_BIN + 32768  , OFF_CB2 = OFF_CB1 + 65536;
constexpr size_t WS_TAB = 36 * MiB, WS_SSP = 38 * MiB, WS_KC = 39 * MiB, WS_KM = 39 * MiB + 512 * 1024, WS_GN = 40 * MiB, WS_XB = 42 * MiB, WS_BIG = 74 * MiB,
                 WS_U = 170 * MiB, WS_QN = 178 * MiB, WS_KV = 194 * MiB, WS_MO = 218 * MiB, WS_MRG = 178 * MiB, WS_END = 242 * MiB;
constexpr int LDS_BYTES = 147456;

__device__ __forceinline__ int dint(int pos) { return (pos >> 1) + 32 * (pos & 1); }
__device__ __forceinline__ int in_orig(int c) {
    if (c < 256) return c;
    if (c < 768) { const int c2 = c - 256; return 256 + (c2 >> 6) * 64 + dint(c2 & 63); }
    if (c < 1536) { const int c2 = c - 768, tt = c2 >> 8, bj = (c2 >> 7) & 1, g = (c2 >> 6) & 1, pos = c2 & 63; return 768 + (2 * tt + bj) * 128 + g * 64 + (bj == 0 ? dint(pos) : pos); }
    if (c < 2304) { const int c2 = c - 1536, part = c2 >> 8, h = (c2 >> 6) & 3, pos = c2 & 63; return 1560 + part * 256 + h * 64 + (part < 2 ? dint(pos) : pos); }
    if (c < 5376) return 2328 + (c - 2304);
    const int c2 = c - 5376; return c2 < 24 ? 1536 + c2 : -1;
}
template <class F> __device__ __forceinline__ void cvt_tile(LAS float* scr, int lane, int k0, int n0, bf16_t* dst, size_t pitch, F f) {
    float vals[32];
#pragma unroll
    for (int i = 0; i < 32; ++i) vals[i] = f(k0 + 2 * i + (lane >> 5), n0 + (lane & 31));
#pragma unroll
    for (int i = 0; i < 32; ++i) scr[(2 * i + (lane >> 5)) * 33 + (lane & 31)] = vals[i];
    asm volatile("s_waitcnt lgkmcnt(0)" ::: "memory");
    const int c = lane & 7;
#pragma unroll
    for (int j = 0; j < 4; ++j) { const int n = (lane >> 3) + 8 * j; const LAS float* s = scr + (8 * c) * 33 + n;
        u32x4 o; o.x = cvtpk(s[0 * 33], s[1 * 33]); o.y = cvtpk(s[2 * 33], s[3 * 33]); o.z = cvtpk(s[4 * 33], s[5 * 33]); o.w = cvtpk(s[6 * 33], s[7 * 33]);
        *(u32x4*)(dst + (size_t)(n0 + n) * pitch + k0 + 8 * c) = o; }
    asm volatile("s_waitcnt lgkmcnt(0)" ::: "memory");
}
struct Args { const float* in[20]; float* out; unsigned char* ws; };
typedef const __attribute__((address_space(4))) Args* ArgsP;

__device__ __forceinline__ void phase0(ArgsP a, int l, LAS unsigned char* lds, int tid, int lane, int wave, int gw, int NGW) {
    unsigned char* ws = a->ws;
    LAS float* scr = (LAS float*)(lds + wave * 8704);
    const float* attn_norm = a->in[1] + (size_t)l * DM; const float* w_in = a->in[2] + (size_t)l * DM * IN_COLS; const float* b_in = a->in[3] + (size_t)l * IN_COLS;
    const float* pool_w = a->in[4] + (size_t)l * 4 * 64 * 64; const float* pool_scale = a->in[5] + (size_t)l * 256; const float* cmp_pos = a->in[6] + (size_t)l * 2 * 32 * 64;
    const float* cmp_w1 = a->in[7] + (size_t)l * 2 * 2048 * 256; const float* cmp_b1 = a->in[8] + (size_t)l * 2 * 256; const float* cmp_w2 = a->in[9] + (size_t)l * 2 * 256 * 64; const float* cmp_b2 = a->in[10] + (size_t)l * 2 * 64;
    const float* w_br_pool = a->in[11] + (size_t)l * 256 * DM; const float* w_br_nsa = a->in[12] + (size_t)l * 512 * DM; const float* w_br_moba = a->in[13] + (size_t)l * 256 * DM;
    const float* w_out = a->in[14] + (size_t)l * DM * DM; const float* ffn_norm = a->in[15] + (size_t)l * DM; const float* w_gate = a->in[16] + (size_t)l * DM * DFF; const float* w_up = a->in[17] + (size_t)l * DM * DFF;
    const float* w_down = a->in[18] + (size_t)l * DFF * DM;
    bf16_t* Win = (bf16_t*)(ws + WS_W + OFF_WIN); bf16_t* Wgu = (bf16_t*)(ws + WS_W + OFF_WGU); bf16_t* Wd = (bf16_t*)(ws + WS_W + OFF_WD); bf16_t* Wbr = (bf16_t*)(ws + WS_W + OFF_WBR);
    bf16_t* Wout = (bf16_t*)(ws + WS_W + OFF_WOUT); bf16_t* W1t = (bf16_t*)(ws + WS_W + OFF_W1); bf16_t* W2t = (bf16_t*)(ws + WS_W + OFF_W2);
    float* bin = (float*)(ws + WS_W + OFF_BIN); float* cb1 = (float*)(ws + WS_W + OFF_CB1); float* cb2 = (float*)(ws + WS_W + OFF_CB2);
    constexpr int I_A = 16 * 176, I_B = 16 * 176, I_C = 44 * 32, I_D = 16 * 32, I_E = 16 * 32, I_F = 2 * 32 * 8, I_G = 2 * 4 * 2;
    constexpr int NITEMS = I_A + I_B + I_C + I_D + I_E + I_F + I_G;
    for (int rep_ = 0; rep_ < ((DUP & 256) ? 2 : 1); ++rep_)
    for (int it = gw; it < NITEMS; it += NGW) {
        int r = it;
        if (r < I_A) { const int kb = r / 176, nb = r % 176; cvt_tile(scr, lane, 64 * kb, 32 * nb, Win, DM, [&](int k, int n) { const int o = in_orig(n); const float v = w_in[(size_t)k * IN_COLS + (o >= 0 ? o : 0)] * attn_norm[k]; return o >= 0 ? v : 0.f; }); continue; } r -= I_A;
        if (r < I_B) { const int kb = r / 176, nb = r % 176; cvt_tile(scr, lane, 64 * kb, 32 * nb, Wgu, DM, [&](int k, int n) { const int j = (n >> 8) * 128 + (n & 127); const float* s = ((n >> 7) & 1) ? w_up : w_gate; return s[(size_t)k * DFF + j] * ffn_norm[k]; }); continue; } r -= I_B;
        if (r < I_C) { const int kb = r / 32, nb = r % 32; cvt_tile(scr, lane, 64 * kb, 32 * nb, Wd, DFF, [&](int k, int n) { return w_down[(size_t)k * DM + n]; }); continue; } r -= I_C;
        if (r < I_D) { const int kb = r / 32, nb = r % 32; cvt_tile(scr, lane, 64 * kb, 32 * nb, Wout, DM, [&](int k, int n) { return w_out[(size_t)k * DM + n]; }); continue; } r -= I_D;
        if (r < I_E) { const int kb = r / 32, nb = r % 32;
            if (kb < 4) { }
            else if (kb < 12) cvt_tile(scr, lane, 64 * kb, 32 * nb, Wbr, DM, [&](int k, int n) { return w_br_nsa[(size_t)(k - 256) * DM + n]; });
            else cvt_tile(scr, lane, 64 * kb, 32 * nb, Wbr, DM, [&](int k, int n) { return w_br_moba[(size_t)(k - 768) * DM + n]; });
            continue; } r -= I_E;
        if (r < I_F) { const int kv = r >> 8, kb = (r >> 3) & 31, nb = r & 7; const float* w1 = cmp_w1 + (size_t)kv * 2048 * 256;
            cvt_tile(scr, lane, 64 * kb, 32 * nb, W1t + (size_t)kv * 256 * 2048, 2048, [&](int k, int n) { const int pos = k & 63, d = kv == 0 ? dint(pos) : pos; return w1[(size_t)((k & ~63) + d) * 256 + n]; }); continue; } r -= I_F;
        { const int kv = r >> 3, kb = (r >> 1) & 3, nb = r & 1; const float* w2 = cmp_w2 + (size_t)kv * 256 * 64;
            cvt_tile(scr, lane, 64 * kb, 32 * nb, W2t + (size_t)kv * 64 * 256, 256, [&](int k, int n) { return w2[(size_t)k * 64 + (kv == 0 ? dint(n) : n)]; }); }
    }
    const int gt = gw * 64 + lane, NGT = NGW * 64;
    for (int c = gt; c < NIN; c += NGT) { const int o = in_orig(c); bin[c] = o >= 0 ? b_in[o] : 0.f; }
    for (int idx = gt; idx < 32 * 512; idx += NGT) { const int c = idx >> 9, e = idx & 511, kv = e >> 8, n = e & 255; const float* w1 = cmp_w1 + (size_t)kv * 2048 * 256 + (size_t)(64 * c) * 256 + n; const float* pe = cmp_pos + (size_t)kv * 2048 + 64 * c;
        float s = c == 0 ? cmp_b1[kv * 256 + n] : 0.f;
#pragma unroll 16
        for (int k = 0; k < 64; ++k) s += pe[k] * w1[(size_t)k * 256];
        cb1[idx] = s; }
    for (int idx = gt; idx < 256 * DM; idx += NGT) { const int k = idx >> 10, n = idx & 1023, g64 = k & ~63; float s = 0.f;
#pragma unroll 16
        for (int j = 0; j < 64; ++j) s += pool_w[k * 64 + j] * pool_scale[g64 + j] * w_br_pool[(size_t)(g64 + j) * DM + n];
        Wbr[(size_t)n * DM + k] = (bf16_t)(cvtpk(s, 0.f) & 0xffffu); }
    for (int e = gt; e < 128; e += NGT) { const int kv = e >> 6, n = e & 63; cb2[e] = cmp_b2[kv * 64 + (kv == 0 ? dint(n) : n)]; }
    if (l == 0) {
        float* tab = (float*)(ws + WS_TAB);
        for (int e = gt; e < SEQ * 32; e += NGT) { const int t = e >> 5, f = e & 31; const float inv = powf(10000.0f, -(float)(2 * f) / 64.0f); const float ang = (float)t * inv;
            const double ad = (double)ang, kq = rint(ad * 0.15915494309189535); double rr = fma(-kq, 6.283185307179586, ad); rr = fma(-kq, 2.4492935982947064e-16, rr);
            const float rf = (float)rr; tab[2 * e] = __cosf(rf); tab[2 * e + 1] = __sinf(rf); }
        const float* x = a->in[0]; bf16_t* xb = (bf16_t*)(ws + WS_XB); float* ssp = (float*)(ws + WS_SSP);
        for (int m0 = 2 * gw; m0 < MTOK; m0 += 2 * NGW) { f32x4 v[2][4]; float s[2] = {0.f, 0.f};
#pragma unroll
            for (int q = 0; q < 2; ++q) { const f32x4* xr = (const f32x4*)(x + (size_t)(m0 + q) * DM) + lane;
#pragma unroll
                for (int j = 0; j < 4; ++j) v[q][j] = xr[64 * j]; }
#pragma unroll
            for (int q = 0; q < 2; ++q) {
#pragma unroll
                for (int j = 0; j < 4; ++j) s[q] += (v[q][j][0] * v[q][j][0] + v[q][j][1] * v[q][j][1]) + (v[q][j][2] * v[q][j][2] + v[q][j][3] * v[q][j][3]);
#pragma unroll
                for (int o = 1; o < 64; o <<= 1) s[q] += __shfl_xor(s[q], o);
                u32x2* o8 = (u32x2*)(xb + (size_t)(m0 + q) * DM) + lane;
#pragma unroll
                for (int j = 0; j < 4; ++j) o8[64 * j] = (u32x2){cvtpk(v[q][j][0], v[q][j][1]), cvtpk(v[q][j][2], v[q][j][3])};
                if (lane < 16) ssp[(size_t)(m0 + q) * 16 + lane] = lane == 0 ? s[q] : 0.f; } }
        int* order = (int*)(ws + WS_ORDER);
        auto cost = [](int id) { if (id < 512) { const int i = id & 127; return 10 * ((i + 1) + ((i < 8 ? i : 8) + 1) + 10) + 16 * ((4 * i + 3 + 63) >> 6); } const int qb = (id - 512) & 31; return 7 * (4 * qb + 3) + 50; };
        for (int id = gw; id < 768; id += NGW) { const int mc = cost(id); int rk = 0;
            for (int j = lane; j < 768; j += 64) { const int cj = cost(j); rk += (cj > mc || (cj == mc && j < id)) ? 1 : 0; }
#pragma unroll
            for (int o = 1; o < 64; o <<= 1) rk += __shfl_xor(rk, o);
            if (lane == 0) order[rk] = id; }
    }
}
__device__ __forceinline__ float gelu_tanh(float x) { const float u = 0.7978845608028654f * (x + 0.044715f * x * x * x); const float th = 1.f - 2.f * __builtin_amdgcn_rcpf(1.f + __expf(2.f * u)); return 0.5f * x * (1.f + th); }
__device__ __forceinline__ void phase2(ArgsP a, LAS unsigned char* lds, int tid, int lane, int wave, int G) {
    unsigned char* ws = a->ws;
    const bf16_t* KV = (const bf16_t*)(ws + WS_KV); const bf16_t* W1t = (const bf16_t*)(ws + WS_W + OFF_W1); const bf16_t* W2t = (const bf16_t*)(ws + WS_W + OFF_W2);
    const float* cb1 = (const float*)(ws + WS_W + OFF_CB1); const float* cb2 = (const float*)(ws + WS_W + OFF_CB2);
    bf16_t* KC = (bf16_t*)(ws + WS_KC);
    LAS bf16_t* hid = (LAS bf16_t*)lds;
    const int arow = lane & 15, kq = lane >> 4;
    for (int task = blockIdx.x; task < 256; task += G) {
        const int kv = task >> 7, bgi = (task >> 5) & 3, nt = task & 31;
        const bf16_t* src = KV + (size_t)kv * att::KV_STRIDE + (size_t)bgi * SEQ * 64;
        const int nrow = 16 * nt + arow, neff = nrow < 510 ? nrow : 510;
        const bf16_t* ap = src + (size_t)neff * 1024 + kq * 8;
        const bf16_t* bp0 = W1t + (size_t)kv * 256 * 2048 + (size_t)(32 * wave + arow) * 2048 + kq * 8; const bf16_t* bp1 = bp0 + 16 * 2048;
        f32x4 c0 = {0.f, 0.f, 0.f, 0.f}, c1 = {0.f, 0.f, 0.f, 0.f};
#pragma unroll 8
        for (int ks = 0; ks < 64; ++ks) { const bf16x8 av = *(const bf16x8*)(ap + ks * 32), b0 = *(const bf16x8*)(bp0 + ks * 32), b1 = *(const bf16x8*)(bp1 + ks * 32);
            c0 = __builtin_amdgcn_mfma_f32_16x16x32_bf16(av, b0, c0, 0, 0, 0); c1 = __builtin_amdgcn_mfma_f32_16x16x32_bf16(av, b1, c1, 0, 0, 0); }
        { const int col0 = 32 * wave + arow; float bb0 = 0.f, bb1 = 0.f;
#pragma unroll 8
          for (int c = 0; c < 32; ++c) { bb0 += cb1[c * 512 + kv * 256 + col0]; bb1 += cb1[c * 512 + kv * 256 + col0 + 16]; }
#pragma unroll
          for (int j = 0; j < 4; ++j) { const int row = kq * 4 + j; hid[row * 264 + col0] = (bf16_t)(cvtpk(gelu_tanh(c0[j] + bb0), 0.f) & 0xffffu); hid[row * 264 + col0 + 16] = (bf16_t)(cvtpk(gelu_tanh(c1[j] + bb1), 0.f) & 0xffffu); } }
        LBAR();
        if (wave < 4) {
            const bf16_t* bp = W2t + (size_t)kv * 64 * 256 + (size_t)(16 * wave + arow) * 256 + kq * 8; f32x4 c = {0.f, 0.f, 0.f, 0.f};
#pragma unroll
            for (int ks = 0; ks < 8; ++ks) { const bf16x8 av = *(const LAS bf16x8*)(hid + arow * 264 + kq * 8 + ks * 32), bv = *(const bf16x8*)(bp + ks * 32); c = __builtin_amdgcn_mfma_f32_16x16x32_bf16(av, bv, c, 0, 0, 0); }
            const int col = 16 * wave + arow; const float bb = cb2[kv * 64 + col];
#pragma unroll
            for (int j = 0; j < 4; ++j) { const int n = 16 * nt + kq * 4 + j; KC[((size_t)(kv * 4 + bgi) * 512 + n) * 64 + col] = n < 511 ? (bf16_t)(cvtpk(c[j] + bb, 0.f) & 0xffffu) : (bf16_t)0; }
        }
        LBAR();
    }
    const int gt = blockIdx.x * 512 + tid, NGT = G * 512;
    { const bf16_t* MoK = (const bf16_t*)(ws + WS_MO) + att::MO_STRIDE; bf16_t* KM = (bf16_t*)(ws + WS_KM); LAS float* part = (LAS float*)(lds + 16384);
      for (int blk = blockIdx.x; blk < 256; blk += G) { const bf16_t* p = MoK + ((size_t)blk * 256 + 32 * wave) * 64 + lane; float s = 0.f;
#pragma unroll
          for (int r = 0; r < 32; ++r) s += __uint_as_float((unsigned)p[(size_t)r * 64] << 16);
          part[wave * 64 + lane] = s;
          LBAR();
          if (wave == 0) { float t = 0.f;
#pragma unroll
              for (int w = 0; w < 8; ++w) t += part[w * 64 + lane];
              KM[(size_t)blk * 64 + lane] = (bf16_t)(cvtpk(t * (1.0f / 256.0f), 0.f) & 0xffffu); }
          LBAR(); } }
    { const bf16_t* U = (const bf16_t*)(ws + WS_U); bf16_t* Abr = (bf16_t*)(ws + WS_XB);
      for (int e = gt; e < MTOK * 32; e += NGT) { const int row = e >> 5, c8 = e & 31, s = row & (SEQ - 1), w = 2 << (c8 >> 3), cnt = (s + 1 < w) ? s + 1 : w;
          float acc[8] = {0.f, 0.f, 0.f, 0.f, 0.f, 0.f, 0.f, 0.f}; u32x4 v0 = {0u, 0u, 0u, 0u};
#pragma unroll
          for (int i0 = 0; i0 < 16; i0 += 8) { if (i0 >= cnt) break; u32x4 v[8];
#pragma unroll
              for (int i = 0; i < 8; ++i) v[i] = (i0 + i < cnt) ? *(const u32x4*)(U + (size_t)(row - i0 - i) * 256 + c8 * 8) : (u32x4){0u, 0u, 0u, 0u};
              if (i0 == 0) v0 = v[0];
#pragma unroll
              for (int i = 0; i < 8; ++i)
#pragma unroll
                  for (int q = 0; q < 4; ++q) { acc[2 * q] += bflo(v[i][q]); acc[2 * q + 1] += bfhi(v[i][q]); } }
          const float ic = 1.0f / (float)cnt; u32x4 o;
#pragma unroll
          for (int q = 0; q < 4; ++q) o[q] = cvtpk(acc[2 * q] * ic - bflo(v0[q]), acc[2 * q + 1] * ic - bfhi(v0[q]));
          *(u32x4*)(Abr + (size_t)row * DM + c8 * 8) = o; } }
}
#ifndef DUP
#define DUP 0
#endif
__global__ void __launch_bounds__(512, 2) fwd_megakernel(Args a) {
    extern __shared__ __attribute__((aligned(16))) unsigned char lds_raw[];
    LAS unsigned char* lds = (LAS unsigned char*)lds_raw;
    cg::grid_group grid = cg::this_grid();
    const int G = gridDim.x;
    volatile LAS unsigned* bst = (volatile LAS unsigned*)(lds + LDS_BYTES - 64);
    if (threadIdx.x < 16) bst[threadIdx.x] = 0u;
    __syncthreads();
    const ArgsP ap0 = (ArgsP)__builtin_amdgcn_kernarg_segment_ptr();
#define PHASE_ARGS ArgsP a_ = ap0; asm volatile("" : "+s"(a_)); unsigned char* ws = a_->ws; unsigned* ctl = (unsigned*)(ws + WS_CTL); float* ssp = (float*)(ws + WS_SSP); const float* tab = (const float*)(ws + WS_TAB); \
    bf16_t* XB = (bf16_t*)(ws + WS_XB); bf16_t* BIG = (bf16_t*)(ws + WS_BIG); bf16_t* MRG = (bf16_t*)(ws + WS_MRG); (void)ctl; (void)ssp; (void)tab; (void)XB; (void)BIG; (void)MRG;
    XcdBarrier xbar = xcd_barrier_post((unsigned*)(ap0->ws + WS_BAR), bst);
    bool first_sync = true;
#define GRID_SYNC() do { if (first_sync) { grid.sync(); first_sync = false; } else xcd_barrier(xbar); } while (0)
    for (int l = 0; l < DEPTH; ++l) {
        int tid_ = threadIdx.x; asm volatile("" : "+v"(tid_));
        const int tid = tid_, lane = tid & 63, wave = __builtin_amdgcn_readfirstlane(tid >> 6), gw = blockIdx.x * 8 + wave, NGW = G * 8;
        for (int rep = 0; rep < ((DUP & 1) ? 2 : 1); ++rep) { PHASE_ARGS phase0(a_, l, lds, tid, lane, wave, gw, NGW); }
        GRID_SYNC();
        for (int rep = 0; rep < ((DUP & 2) ? 2 : 1); ++rep) { PHASE_ARGS pg8::Gemm g{XB, (const bf16_t*)(ws + WS_W + OFF_WIN), MTOK, NIN, DM}; pg8::StaticOrder S; S.init(MTOK, NIN, G, (int)blockIdx.x);
          EpiInProj E{ssp, (const float*)(ws + WS_W + OFF_BIN), tab, (bf16_t*)(ws + WS_U), (bf16_t*)(ws + WS_QN), (bf16_t*)(ws + WS_KV), (bf16_t*)(ws + WS_MO), BIG, (bf16_t*)(ws + WS_GN)};
          pg8::gemm_phase(lds, g, S, E); }
        GRID_SYNC();
        for (int rep = 0; rep < ((DUP & 4) ? 2 : 1); ++rep) { PHASE_ARGS phase2(a_, lds, tid, lane, wave, G); }
        GRID_SYNC();
        for (int rep = 0; rep < ((DUP & 8) ? 2 : 1); ++rep) { PHASE_ARGS
          att::Bufs B{(const bf16_t*)(ws + WS_QN), (const bf16_t*)(ws + WS_KV), (const bf16_t*)(ws + WS_MO), (const bf16_t*)(ws + WS_KC), (const bf16_t*)(ws + WS_KM), (const bf16_t*)(ws + WS_GN), XB};
          const int* order = (const int*)(ws + WS_ORDER); LAS int* slot = (LAS int*)(lds + att::L_END);
          if (wave >= 4) __builtin_amdgcn_s_setprio(1);
          for (;;) {
              LBAR();
              if (tid == 0) slot[0] = (int)atomicAdd(ctl + l + 2 * rep, 1u);
              LBAR();
              const int item = slot[0];
              if (item >= 768) break;
              const int id = order[item];
              int tl = threadIdx.x; asm volatile("" : "+v"(tl));
              const int tid = tl, lane = tid & 63, wave = __builtin_amdgcn_readfirstlane(tid >> 6);
              att::Ctx C; C.lds = (LAS char*)lds; C.wsf = (LAS float*)(lds + att::L_WSF) + wave * 64; C.otl = (LAS float*)(lds + att::L_OT) + wave * 2048 + lane; C.tid = tid; C.wid = wave; C.lane = lane; C.r32 = lane & 31; C.hi = lane >> 5;
              C.vbl = ((lane >> 4) & 1) * 32 + (lane & 3) * 8 + (4 * (lane >> 5) + ((lane & 15) >> 2)) * 64;
              if (id < 512) att::nsa_item(C, B, id >> 8, (id >> 7) & 1, id & 127);
              else { const int x = id - 512; att::moba_item(C, B, x >> 7, (x >> 5) & 3, x & 31); }
          }
          __builtin_amdgcn_s_setprio(0); }
        GRID_SYNC();
        for (int rep = 0; rep < ((DUP & 16) ? 2 : 1); ++rep) { PHASE_ARGS pg8::Gemm g{XB, (const bf16_t*)(ws + WS_W + OFF_WBR), MTOK, DM, DM}; pg8::StaticOrder S; S.init(MTOK, DM, G, (int)blockIdx.x);
          EpiBranch E{BIG, MRG}; pg8::gemm_phase(lds, g, S, E); }
        GRID_SYNC();
        { PHASE_ARGS pg8::Gemm g{MRG, (const bf16_t*)(ws + WS_W + OFF_WOUT), MTOK, DM, DM}; pg8::StaticOrder S; S.init(MTOK, DM, G, (int)blockIdx.x);
          float* outp = a_->out; EpiResid E{l == 0 ? a_->in[0] : outp, outp, XB, ssp}; pg8::gemm_phase(lds, g, S, E); }
        GRID_SYNC();
        for (int rep = 0; rep < ((DUP & 64) ? 2 : 1); ++rep) { PHASE_ARGS pg8::Gemm g{XB, (const bf16_t*)(ws + WS_W + OFF_WGU), MTOK, NGU, DM}; pg8::StaticOrder S; S.init(MTOK, NGU, G, (int)blockIdx.x);
          EpiSwiGLU E{ssp, BIG}; pg8::gemm_phase(lds, g, S, E); }
        GRID_SYNC();
        { PHASE_ARGS pg8::Gemm g{BIG, (const bf16_t*)(ws + WS_W + OFF_WD), MTOK, DM, DFF}; pg8::StaticOrder S; S.init(MTOK, DM, G, (int)blockIdx.x);
          float* outp = a_->out; EpiResid E{outp, outp, XB, ssp}; pg8::gemm_phase(lds, g, S, E); }
        GRID_SYNC();
    }
    { PHASE_ARGS const float* fn = a_->in[19]; float* outp = a_->out; const int lane = threadIdx.x & 63, gw = blockIdx.x * 8 + (threadIdx.x >> 6), NGW = G * 8;
      for (int m = gw; m < MTOK; m += NGW) { const float rstd = row_rstd(ssp, m); f32x4* xr = (f32x4*)(outp + (size_t)m * DM) + lane; const f32x4* gr = (const f32x4*)fn + lane;
#pragma unroll
          for (int j = 0; j < 4; ++j) xr[64 * j] = xr[64 * j] * rstd * gr[64 * j]; } }
}

extern "C" void kernel_launch(void* const* d_in, const int* in_sizes, int n_in, void* d_out, int out_size, void* d_ws, size_t ws_size, hipStream_t stream) {
    static int grid = 0;
    if (grid == 0) {
        if (n_in != 20 || in_sizes[0] != MTOK * DM || out_size != MTOK * DM || ws_size < WS_END) { fprintf(stderr, "kernel_launch: unexpected shapes / workspace (n_in %d, ws %zu)\n", n_in, ws_size); grid = -1; return; }
        int dev = 0, cus = 0, per_cu = 0;
        if (hipGetDevice(&dev) != hipSuccess || hipDeviceGetAttribute(&cus, hipDeviceAttributeMultiprocessorCount, dev) != hipSuccess) { grid = -1; return; }
        if (hipFuncSetAttribute((const void*)fwd_megakernel, hipFuncAttributeMaxDynamicSharedMemorySize, LDS_BYTES) != hipSuccess) { fprintf(stderr, "kernel_launch: hipFuncSetAttribute failed\n"); grid = -1; return; }
        if (hipOccupancyMaxActiveBlocksPerMultiprocessor(&per_cu, (const void*)fwd_megakernel, 512, LDS_BYTES) != hipSuccess || per_cu < 1) { fprintf(stderr, "kernel_launch: occupancy query failed (%d)\n", per_cu); (void)hipGetLastError(); grid = -1; return; }
        grid = cus * per_cu;
    }
    if (grid < 0) return;
    if (hipMemsetAsync((char*)d_ws + WS_CTL, 0, 32768, stream) != hipSuccess) { fprintf(stderr, "kernel_launch: memset failed\n"); return; }
    Args a{};
    for (int i = 0; i < 20; ++i) a.in[i] = (const float*)d_in[i];
    a.out = (float*)d_out; a.ws = (unsigned char*)d_ws;
    void* args[] = {&a};
    const hipError_t e = hipLaunchCooperativeKernel((const void*)fwd_megakernel, dim3(grid), dim3(512), args, LDS_BYTES, stream);
    if (e != hipSuccess) fprintf(stderr, "kernel_launch: cooperative launch failed: %s (grid %d)\n", hipGetErrorString(e), grid);
}
```

```cpp
#include <hip/hip_runtime.h>
#include <hip/hip_cooperative_groups.h>
#include <cstdio>
#include <cstdint>
#include <cmath>
namespace cg = cooperative_groups;

#define LAS __attribute__((address_space(3)))
typedef unsigned short bf16_t;
typedef short bf16x8 __attribute__((ext_vector_type(8)));
typedef short s16x4 __attribute__((ext_vector_type(4)));
typedef float f32x2 __attribute__((ext_vector_type(2)));
typedef float f32x4 __attribute__((ext_vector_type(4)));
typedef float f32x16 __attribute__((ext_vector_type(16)));
typedef unsigned u32x4 __attribute__((ext_vector_type(4)));
typedef unsigned u32x2 __attribute__((ext_vector_type(2)));
typedef __bf16 bf16x2_t __attribute__((ext_vector_type(2)));

constexpr int SEQ = 8192, BATCH = 2, MTOK = BATCH * SEQ, DM = 1024, DEPTH = 2;
constexpr int IN_COLS = 5400, NIN = 5632, DFF = 2816, NGU = 5632;
constexpr float RMS_EPS = 1e-6f;
constexpr float QSCALE = 0.125f * 1.4426950408889634f;

__device__ __forceinline__ unsigned cvtpk(float lo, float hi) { f32x2 v = {lo, hi}; bf16x2_t b = __builtin_convertvector(v, bf16x2_t); return __builtin_bit_cast(unsigned, b); }
__device__ __forceinline__ float bflo(unsigned w) { return __uint_as_float(w << 16); }
__device__ __forceinline__ float bfhi(unsigned w) { return __uint_as_float(w & 0xffff0000u); }
__device__ __forceinline__ float sigmoidf_(float x) { return __builtin_amdgcn_rcpf(1.f + __expf(-x)); }

namespace pg8 {
constexpr int BM = 256, BK = 64, HALF = 128, HTB = HALF * BK * 2, STAGE_BYTES = 8 * HTB, NXCD = 8, WGM = 8;
__host__ __device__ __forceinline__ int lds_byte(int r, int c) { const int st = (r >> 4) * 2 + (c >> 5), rr = r & 15, cc = c & 31, ob = rr * 64 + cc * 2; return st * 1024 + (ob ^ (((ob >> 9) & 1) << 5)); }
__host__ __device__ __forceinline__ void stage_rc(int b, int& R, int& C) { const int st = b / 1024, sb = b % 1024, swz = sb ^ (((sb >> 9) & 1) << 5); R = (st >> 1) * 16 + swz / 64; C = (st & 1) * 32 + (swz % 64) / 2; }
__host__ __device__ __forceinline__ int perm32(int rho) { const int n = rho >> 4, i = rho & 15; return 8 * (i >> 2) + 4 * n + (i & 3); }
struct Unit { int pm, pn; };
struct Gemm { const bf16_t* A; const bf16_t* Bt; int M, N, K; };
struct StaticOrder {
    int nM, nN, nwg, G, c;
    __host__ __device__ void init(int M, int N, int G_, int c_) { nM = M / BM; nN = N / BM; nwg = nM * nN; G = G_; c = c_; }
    __host__ __device__ bool next(int i, Unit& u) const {
        const long L = (long)i * G + c; if (L >= nwg) return false;
        int wgid = (int)L; { const int q = nwg / NXCD, r = nwg % NXCD, xcd = wgid % NXCD, off = wgid / NXCD; wgid = (xcd < r ? xcd * (q + 1) : r * (q + 1) + (xcd - r) * q) + off; }
        const int nig = WGM * nN, gid = wgid / nig, fm = gid * WGM, gsz = (nM - fm) < WGM ? (nM - fm) : WGM;
        u.pm = fm + ((wgid % nig) % gsz); u.pn = (wgid % nig) / gsz; return true;
    }
};
template <class Epi, class Sched>
__device__ __forceinline__ void gemm_phase(LAS unsigned char* lds, const Gemm g, const Sched& S, const Epi& E) {
    int tid_ = threadIdx.x; asm volatile("" : "+v"(tid_));
    const int tid = tid_, wid = __builtin_amdgcn_readfirstlane(tid >> 6), lane = tid & 63, wr = wid >> 2, wc = wid & 3, fr = lane & 15, fq = lane >> 4;
    const int K = g.K, nt = K / BK;
    unsigned voffA[2], voffB[2];
#pragma unroll
    for (int i = 0; i < 2; ++i) { int R, C; stage_rc(tid * 16 + i * 8192, R, C); const int Rb = ((R & ~31) + perm32(R & 31));
        voffA[i] = (unsigned)(R * K + C) * 2u; voffB[i] = (unsigned)(Rb * K + C) * 2u; }
    const size_t kstep = (size_t)(BK * 2);
    const size_t hstep = (size_t)HALF * K * 2;
    const size_t tstep = 2 * hstep;
    const unsigned ldsw = (unsigned)wid * 1024u;
    const int aoff = lds_byte(wr * 64 + fr, fq * 8), boff = lds_byte(wc * 32 + fr, fq * 8);
#define PG8_SA(b, h) (((b) * 2 + (h)) * HTB)
#define PG8_SB(b, h) ((4 + (b) * 2 + (h)) * HTB)
#define PG8_STAGE(bufoff, gbase, voff) do { _Pragma("unroll") for (int _i = 0; _i < 2; ++_i) \
        __builtin_amdgcn_global_load_lds((const unsigned*)((const char*)(gbase) + (voff)[_i]), (LAS unsigned*)(lds + (bufoff) + ldsw + _i * 8192), 16, 0, 0); } while (0)
#define PG8_LDA(dst, b, h) do { _Pragma("unroll") for (int m = 0; m < 4; ++m) _Pragma("unroll") for (int k = 0; k < 2; ++k) dst[m][k] = *(const LAS bf16x8*)(lds + PG8_SA(b, h) + aoff + m * 2048 + k * 1024); } while (0)
#define PG8_LDB(dst, b, h) do { _Pragma("unroll") for (int n = 0; n < 2; ++n) _Pragma("unroll") for (int k = 0; k < 2; ++k) dst[n][k] = *(const LAS bf16x8*)(lds + PG8_SB(b, h) + boff + n * 2048 + k * 1024); } while (0)
#define PG8_MMA(ai, bj, At, Bt) do { __builtin_amdgcn_s_setprio(1); _Pragma("unroll") for (int m = 0; m < 4; ++m) _Pragma("unroll") for (int n = 0; n < 2; ++n) _Pragma("unroll") for (int k = 0; k < 2; ++k) \
        acc[ai][bj][m][n] = __builtin_amdgcn_mfma_f32_16x16x32_bf16(Bt[n][k], At[m][k], acc[ai][bj][m][n], 0, 0, 0); __builtin_amdgcn_s_setprio(0); } while (0)
#define PG8_WAIT_V(n) asm volatile("s_waitcnt vmcnt(" #n ")" ::: "memory")
#define PG8_WAIT_L(n) asm volatile("s_waitcnt lgkmcnt(" #n ")" ::: "memory")
#define PG8_BAR __builtin_amdgcn_s_barrier()
#define PG8_SCHED __builtin_amdgcn_sched_barrier(0)
    Unit cur, nxt; int ui = 0;
    if (!S.next(0, cur)) return;
    f32x4 acc[2][2][4][2];
#pragma unroll
    for (int a = 0; a < 2; ++a)
#pragma unroll
        for (int b = 0; b < 2; ++b)
#pragma unroll
            for (int m = 0; m < 4; ++m)
#pragma unroll
                for (int n = 0; n < 2; ++n) acc[a][b][m][n] = (f32x4){0.f, 0.f, 0.f, 0.f};
    bf16x8 At[4][2], B0[2][2], B1[2][2];
    const char* cA = (const char*)g.A + (size_t)cur.pm * tstep; const char* cB = (const char*)g.Bt + (size_t)cur.pn * tstep;
    PG8_STAGE(PG8_SB(0, 0), cB, voffB); PG8_STAGE(PG8_SB(0, 1), cB + hstep, voffB); PG8_STAGE(PG8_SA(0, 0), cA, voffA); PG8_STAGE(PG8_SA(0, 1), cA + hstep, voffA);
    if (wr == 1) PG8_BAR;
    PG8_WAIT_V(2); PG8_BAR;
    PG8_STAGE(PG8_SB(1, 0), cB + kstep, voffB); PG8_STAGE(PG8_SA(1, 0), cA + kstep, voffA); PG8_STAGE(PG8_SB(1, 1), cB + hstep + kstep, voffB);
    PG8_WAIT_V(6); PG8_BAR;
    for (;;) {
        const bool has_next = S.next(ui + 1, nxt);
        const char* nA = has_next ? (const char*)g.A + (size_t)nxt.pm * tstep : cA; const char* nB = has_next ? (const char*)g.Bt + (size_t)nxt.pn * tstep : cB;
        for (int t = 0; t < nt; t += 2) {
            const bool last = (t == nt - 2);
            const char* a1 = cA + (size_t)(t + 1) * kstep;
            const char* a2 = last ? nA : cA + (size_t)(t + 2) * kstep; const char* b2 = last ? nB : cB + (size_t)(t + 2) * kstep;
            const char* a3 = a2 + kstep; const char* b3 = b2 + kstep;
            if constexpr (Epi::KHOOK) { if (t == 4 || t == 12) { PG8_SCHED; E.khook(acc, cur, t, wr, wc, fr, fq); PG8_SCHED; } }
            PG8_LDB(B0, 0, 0); PG8_LDB(B1, 0, 1); PG8_SCHED; PG8_LDA(At, 0, 0); PG8_STAGE(PG8_SA(1, 1), a1 + hstep, voffA);
            PG8_WAIT_V(8); PG8_WAIT_L(0); PG8_BAR; PG8_MMA(0, 0, At, B0); PG8_MMA(0, 1, At, B1); PG8_BAR; PG8_SCHED;
            PG8_LDA(At, 0, 1); PG8_STAGE(PG8_SB(0, 0), b2, voffB); PG8_STAGE(PG8_SB(0, 1), b2 + hstep, voffB); PG8_STAGE(PG8_SA(0, 0), a2, voffA);
            PG8_WAIT_V(8); PG8_WAIT_L(0); PG8_BAR; PG8_MMA(1, 0, At, B0); PG8_MMA(1, 1, At, B1); PG8_BAR; PG8_SCHED;
            PG8_LDB(B0, 1, 0); PG8_LDB(B1, 1, 1); PG8_SCHED; PG8_LDA(At, 1, 0); PG8_STAGE(PG8_SA(0, 1), a2 + hstep, voffA);
            PG8_WAIT_V(8); PG8_WAIT_L(0); PG8_BAR; PG8_MMA(0, 0, At, B0); PG8_MMA(0, 1, At, B1); PG8_BAR; PG8_SCHED;
            PG8_LDA(At, 1, 1); PG8_STAGE(PG8_SB(1, 0), b3, voffB); PG8_STAGE(PG8_SB(1, 1), b3 + hstep, voffB); PG8_STAGE(PG8_SA(1, 0), a3, voffA);
            PG8_WAIT_V(8); PG8_WAIT_L(0); PG8_BAR; PG8_MMA(1, 0, At, B0); PG8_MMA(1, 1, At, B1); PG8_BAR; PG8_SCHED;
        }
        if (wr == 0) PG8_BAR;
        E(acc, cur, wr, wc, fr, fq);
        if (!has_next) break;
#pragma unroll
        for (int a = 0; a < 2; ++a)
#pragma unroll
            for (int b = 0; b < 2; ++b)
#pragma unroll
                for (int m = 0; m < 4; ++m)
#pragma unroll
                    for (int n = 0; n < 2; ++n) acc[a][b][m][n] = (f32x4){0.f, 0.f, 0.f, 0.f};
        cur = nxt; cA = nA; cB = nB; ++ui;
        if (wr == 1) PG8_BAR;
    }
    PG8_WAIT_V(0);
    PG8_BAR;
#undef PG8_SA
#undef PG8_SB
#undef PG8_STAGE
#undef PG8_LDA
#undef PG8_LDB
#undef PG8_MMA
#undef PG8_WAIT_V
#undef PG8_WAIT_L
#undef PG8_BAR
#undef PG8_SCHED
}
}
using pg8::Unit;
__device__ __forceinline__ float row_rstd(const float* ssp, int row) {
    const f32x4* p = (const f32x4*)(ssp + (size_t)row * 16);
    const f32x4 a = p[0], b = p[1], c = p[2], d = p[3];
    const float ss = ((a[0] + a[1]) + (a[2] + a[3])) + ((b[0] + b[1]) + (b[2] + b[3])) + ((c[0] + c[1]) + (c[2] + c[3])) + ((d[0] + d[1]) + (d[2] + d[3]));
    return 1.0f / sqrtf(ss * (1.0f / DM) + RMS_EPS);
}
__device__ __forceinline__ u32x4 pack8(const f32x4 a, const f32x4 b) { u32x4 w; w.x = cvtpk(a[0], a[1]); w.y = cvtpk(a[2], a[3]); w.z = cvtpk(b[0], b[1]); w.w = cvtpk(b[2], b[3]); return w; }
__device__ __forceinline__ void rope8(f32x4& v0, f32x4& v1, const float* tab, int t, int pos, float sc) {
    const f32x4* cs = (const f32x4*)(tab + ((size_t)t * 32 + (pos >> 1)) * 2);
    const f32x4 c0 = cs[0], c1 = cs[1];
    f32x4 o0, o1;
    o0[0] = (v0[0] * c0[0] - v0[1] * c0[1]) * sc; o0[1] = (v0[1] * c0[0] + v0[0] * c0[1]) * sc;
    o0[2] = (v0[2] * c0[2] - v0[3] * c0[3]) * sc; o0[3] = (v0[3] * c0[2] + v0[2] * c0[3]) * sc;
    o1[0] = (v1[0] * c1[0] - v1[1] * c1[1]) * sc; o1[1] = (v1[1] * c1[0] + v1[0] * c1[1]) * sc;
    o1[2] = (v1[2] * c1[2] - v1[3] * c1[3]) * sc; o1[3] = (v1[3] * c1[2] + v1[2] * c1[3]) * sc;
    v0 = o0; v1 = o1;
}
struct EpiInProj {
    static constexpr bool KHOOK = false;
    const float* ssp; const float* bias; const float* tab;
    bf16_t *U, *Qn, *KV, *Mo, *G, *Gn;
    __device__ __forceinline__ void operator()(const f32x4 (&acc)[2][2][4][2], const Unit& u, int wr, int wc, int fr, int fq) const {
        asm volatile("" : "+v"(fr), "+v"(fq));
        const int pn = u.pn;
#pragma unroll
        for (int ai = 0; ai < 2; ++ai)
#pragma unroll
            for (int m = 0; m < 4; ++m) {
                const int row = u.pm * 256 + ai * 128 + wr * 64 + m * 16 + fr;
                const float rstd = row_rstd(ssp, row);
                const int t = row & (SEQ - 1), b = row >> 13;
#pragma unroll
                for (int bj = 0; bj < 2; ++bj) {
                    const int cit = bj * 128 + wc * 32 + 8 * fq, gc = pn * 256 + cit;
                    f32x4 v0 = acc[ai][bj][m][0] * rstd + *(const f32x4*)(bias + gc), v1 = acc[ai][bj][m][1] * rstd + *(const f32x4*)(bias + gc + 4);
                    bf16_t* dst;
                    if (pn == 0) { dst = U + (size_t)row * 256 + cit; }
                    else if (pn <= 2) { const int c2 = (pn - 1) * 256 + cit, head = c2 >> 6, pos = c2 & 63; rope8(v0, v1, tab, t, pos, QSCALE); dst = Qn + ((size_t)(b * 8 + head) * SEQ + t) * 64 + pos; }
                    else if (pn <= 5) { const int c2 = cit & 127, g = c2 >> 6, pos = c2 & 63, kvi = 2 * (pn - 3) + bj; if (bj == 0) rope8(v0, v1, tab, t, pos, 1.f);
                        dst = KV + (size_t)kvi * ((size_t)MTOK * 128) + ((size_t)(b * 2 + g) * SEQ + t) * 64 + pos; }
                    else if (pn <= 8) { const int h = cit >> 6, pos = cit & 63; if (pn < 8) rope8(v0, v1, tab, t, pos, pn == 6 ? QSCALE : 1.f);
                        dst = Mo + (size_t)(pn - 6) * ((size_t)MTOK * 256) + ((size_t)(b * 4 + h) * SEQ + t) * 64 + pos; }
                    else if (pn <= 20) {
#pragma unroll
                        for (int e = 0; e < 4; ++e) { v0[e] = sigmoidf_(v0[e]); v1[e] = sigmoidf_(v1[e]); }
                        dst = G + (size_t)row * 3072 + (pn - 9) * 256 + cit; }
                    else {
#pragma unroll
                        for (int e = 0; e < 4; ++e) { v0[e] = sigmoidf_(v0[e]); v1[e] = sigmoidf_(v1[e]); }
                        dst = Gn + (size_t)row * 32 + (cit & 31); if (cit >= 32) dst = nullptr; }
                    if (dst) *(u32x4*)dst = pack8(v0, v1);
                }
                asm volatile("" ::: "memory");
            }
    }
};
struct EpiBranch {
    static constexpr bool KHOOK = true;
    const bf16_t* G; bf16_t* out;
    __device__ __forceinline__ void khook(f32x4 (&acc)[2][2][4][2], const Unit& u, int t, int wr, int wc, int fr, int fq) const {
        asm volatile("" : "+v"(fr), "+v"(fq));
        const int gsel = (t == 4) ? 0 : 1024;
#pragma unroll
        for (int ai = 0; ai < 2; ++ai)
#pragma unroll
            for (int m = 0; m < 4; ++m) {
                const int row = u.pm * 256 + ai * 128 + wr * 64 + m * 16 + fr;
#pragma unroll
                for (int bj = 0; bj < 2; ++bj) {
                    const int col = u.pn * 256 + bj * 128 + wc * 32 + 8 * fq;
                    const u32x4 gx = *(const u32x4*)(G + (size_t)row * 3072 + gsel + col), gy = *(const u32x4*)(G + (size_t)row * 3072 + gsel + 1024 + col);
#pragma unroll
                    for (int e = 0; e < 4; ++e) {
                        const float x0 = fmaxf(bflo(gx[e]), 1e-20f), x1 = fmaxf(bfhi(gx[e]), 1e-20f), y0 = fmaxf(bflo(gy[e]), 1e-20f), y1 = fmaxf(bfhi(gy[e]), 1e-20f);
                        const float r0 = x0 * __builtin_amdgcn_rcpf(y0), r1 = x1 * __builtin_amdgcn_rcpf(y1);
                        acc[ai][bj][m][e >> 1][(e & 1) * 2] *= r0; acc[ai][bj][m][e >> 1][(e & 1) * 2 + 1] *= r1;
                    }
                    asm volatile("" ::: "memory");
                }
            }
    }
    __device__ __forceinline__ void operator()(const f32x4 (&acc)[2][2][4][2], const Unit& u, int wr, int wc, int fr, int fq) const {
        asm volatile("" : "+v"(fr), "+v"(fq));
#pragma unroll
        for (int ai = 0; ai < 2; ++ai)
#pragma unroll
            for (int m = 0; m < 4; ++m) {
                const int row = u.pm * 256 + ai * 128 + wr * 64 + m * 16 + fr;
#pragma unroll
                for (int bj = 0; bj < 2; ++bj) {
                    const int col = u.pn * 256 + bj * 128 + wc * 32 + 8 * fq;
                    const u32x4 gz = *(const u32x4*)(G + (size_t)row * 3072 + 2048 + col);
                    f32x4 v0 = acc[ai][bj][m][0], v1 = acc[ai][bj][m][1];
                    v0[0] *= fmaxf(bflo(gz[0]), 1e-20f); v0[1] *= fmaxf(bfhi(gz[0]), 1e-20f); v0[2] *= fmaxf(bflo(gz[1]), 1e-20f); v0[3] *= fmaxf(bfhi(gz[1]), 1e-20f);
                    v1[0] *= fmaxf(bflo(gz[2]), 1e-20f); v1[1] *= fmaxf(bfhi(gz[2]), 1e-20f); v1[2] *= fmaxf(bflo(gz[3]), 1e-20f); v1[3] *= fmaxf(bfhi(gz[3]), 1e-20f);
                    *(u32x4*)(out + (size_t)row * DM + col) = pack8(v0, v1);
                }
                asm volatile("" ::: "memory");
            }
    }
};
struct EpiResid {
    static constexpr bool KHOOK = false;
    const float* base_f; const bf16_t* base_b; bf16_t* xb; bf16_t* res; float* ssp;
    __device__ __forceinline__ void operator()(const f32x4 (&acc)[2][2][4][2], const Unit& u, int wr, int wc, int fr, int fq) const {
        asm volatile("" : "+v"(fr), "+v"(fq));
#pragma unroll
        for (int ai = 0; ai < 2; ++ai)
#pragma unroll
            for (int m = 0; m < 4; ++m) {
                const int row = u.pm * 256 + ai * 128 + wr * 64 + m * 16 + fr;
                float ss = 0.f;
#pragma unroll
                for (int bj = 0; bj < 2; ++bj) {
                    const size_t off = (size_t)row * DM + u.pn * 256 + bj * 128 + wc * 32 + 8 * fq;
                    f32x4 b0, b1;
                    if (base_f) { b0 = *(const f32x4*)(base_f + off); b1 = *(const f32x4*)(base_f + off + 4); }
                    else { const u32x4 w = *(const u32x4*)(base_b + off); b0 = (f32x4){bflo(w[0]), bfhi(w[0]), bflo(w[1]), bfhi(w[1])}; b1 = (f32x4){bflo(w[2]), bfhi(w[2]), bflo(w[3]), bfhi(w[3])}; }
                    const f32x4 v0 = acc[ai][bj][m][0] + b0, v1 = acc[ai][bj][m][1] + b1;
                    const u32x4 pk = pack8(v0, v1);
                    *(u32x4*)(xb + off) = pk;
                    if (res) *(u32x4*)(res + off) = pk;
                    ss += (v0[0] * v0[0] + v0[1] * v0[1]) + (v0[2] * v0[2] + v0[3] * v0[3]) + (v1[0] * v1[0] + v1[1] * v1[1]) + (v1[2] * v1[2] + v1[3] * v1[3]);
                }
                ss += __shfl_xor(ss, 16); ss += __shfl_xor(ss, 32);
                if (fq == 0) ssp[(size_t)row * 16 + u.pn * 4 + wc] = ss;
                asm volatile("" ::: "memory");
            }
    }
};
struct EpiSwiGLU {
    static constexpr bool KHOOK = false;
    const float* ssp; bf16_t* H;
    __device__ __forceinline__ void operator()(const f32x4 (&acc)[2][2][4][2], const Unit& u, int wr, int wc, int fr, int fq) const {
        asm volatile("" : "+v"(fr), "+v"(fq));
#pragma unroll
        for (int ai = 0; ai < 2; ++ai)
#pragma unroll
            for (int m = 0; m < 4; ++m) {
                const int row = u.pm * 256 + ai * 128 + wr * 64 + m * 16 + fr;
                const float rstd = row_rstd(ssp, row);
                f32x4 o[2];
#pragma unroll
                for (int n = 0; n < 2; ++n)
#pragma unroll
                    for (int e = 0; e < 4; ++e) { const float gt = acc[ai][0][m][n][e] * rstd, up = acc[ai][1][m][n][e] * rstd; o[n][e] = gt * sigmoidf_(gt) * up; }
                *(u32x4*)(H + (size_t)row * DFF + u.pn * 128 + wc * 32 + 8 * fq) = pack8(o[0], o[1]);
                asm volatile("" ::: "memory");
            }
    }
};
#ifndef ABL_NSA_SCALE
#define ABL_NSA_SCALE
#endif
#ifndef ABL_MOBA_SCALE
#define ABL_MOBA_SCALE
#endif
namespace att {
constexpr int KCS = 1040, KSLOT = 8 * KCS, VSLOT = 8192;
constexpr int L_K0 = 0, L_V0 = 4 * KSLOT, L_WSF = 4 * KSLOT + 4 * VSLOT, L_MSK = L_WSF + 8 * 256, L_UNI = L_MSK + 1024, L_LIST = L_UNI + 64, L_END = L_LIST + 512,
              L_PS = L_END + 64, L_OT = L_PS, L_TOTAL = L_OT + 8 * 8192;
static_assert(L_TOTAL <= 147456 - 64, "attention LDS map");
#define LBAR() asm volatile("s_waitcnt lgkmcnt(0)\n\ts_barrier" ::: "memory")
#define LWAIT() asm volatile("s_waitcnt lgkmcnt(0)" ::: "memory")
__device__ __forceinline__ int crow(int r, int hi) { return (r & 3) + 8 * (r >> 2) + 4 * hi; }
__device__ __forceinline__ float swap_other(float v, int hi) { auto rr = __builtin_amdgcn_permlane32_swap(__float_as_uint(v), __float_as_uint(v), false, false); return __uint_as_float(hi ? rr[0] : rr[1]); }
__device__ __forceinline__ void qkt(f32x16& p0, f32x16& p1, const LAS char* Ks, const bf16x8* qr, const f32x16& cinit, int r32, int hi) {
    const LAS char* kb = Ks + hi * KCS + r32 * 16;
#pragma unroll
    for (int d0 = 0; d0 < 4; ++d0) {
        const bf16x8 b0 = *(const LAS bf16x8*)(kb + d0 * 2 * KCS), b1 = *(const LAS bf16x8*)(kb + d0 * 2 * KCS + 512);
        if (d0 == 0) { p0 = __builtin_amdgcn_mfma_f32_32x32x16_bf16(b0, qr[0], cinit, 0, 0, 0); p1 = __builtin_amdgcn_mfma_f32_32x32x16_bf16(b1, qr[0], cinit, 0, 0, 0); }
        else { p0 = __builtin_amdgcn_mfma_f32_32x32x16_bf16(b0, qr[d0], p0, 0, 0, 0); p1 = __builtin_amdgcn_mfma_f32_32x32x16_bf16(b1, qr[d0], p1, 0, 0, 0); } }
}
struct VFrag { s16x4 lo[8], hi[8]; };
typedef short v4i16_t __attribute__((ext_vector_type(4)));
__device__ __forceinline__ s16x4 vtr(const LAS char* p) { return __builtin_bit_cast(s16x4, __builtin_amdgcn_ds_read_tr16_b64_v4i16((LAS v4i16_t*)p)); }
__device__ __forceinline__ void v_issue(VFrag& F, const LAS char* vp) {
#pragma unroll
    for (int d0 = 0; d0 < 2; ++d0)
#pragma unroll
        for (int ks = 0; ks < 4; ++ks) { F.lo[d0 * 4 + ks] = vtr(vp + d0 * 4096 + ks * 1024); F.hi[d0 * 4 + ks] = vtr(vp + d0 * 4096 + ks * 1024 + 512); }
}
template <bool SUM> __device__ __forceinline__ void pv(f32x16* o, f32x16& osum, VFrag& F, bf16x8 pa0, bf16x8 pa1, bf16x8 pa2, bf16x8 pa3) {
#define PK(k) (bf16x8){F.lo[k][0], F.lo[k][1], F.lo[k][2], F.lo[k][3], F.hi[k][0], F.hi[k][1], F.hi[k][2], F.hi[k][3]}
    const bf16x8 ones = {0x3F80, 0x3F80, 0x3F80, 0x3F80, 0x3F80, 0x3F80, 0x3F80, 0x3F80};
    __builtin_amdgcn_s_setprio(1);
    o[0] = __builtin_amdgcn_mfma_f32_32x32x16_bf16(pa0, PK(0), o[0], 0, 0, 0);
    o[1] = __builtin_amdgcn_mfma_f32_32x32x16_bf16(pa0, PK(4), o[1], 0, 0, 0);
    if (SUM) osum = __builtin_amdgcn_mfma_f32_32x32x16_bf16(pa0, ones, osum, 0, 0, 0);
    o[0] = __builtin_amdgcn_mfma_f32_32x32x16_bf16(pa1, PK(1), o[0], 0, 0, 0);
    o[1] = __builtin_amdgcn_mfma_f32_32x32x16_bf16(pa1, PK(5), o[1], 0, 0, 0);
    if (SUM) osum = __builtin_amdgcn_mfma_f32_32x32x16_bf16(pa1, ones, osum, 0, 0, 0);
    o[0] = __builtin_amdgcn_mfma_f32_32x32x16_bf16(pa2, PK(2), o[0], 0, 0, 0);
    o[1] = __builtin_amdgcn_mfma_f32_32x32x16_bf16(pa2, PK(6), o[1], 0, 0, 0);
    if (SUM) osum = __builtin_amdgcn_mfma_f32_32x32x16_bf16(pa2, ones, osum, 0, 0, 0);
    o[0] = __builtin_amdgcn_mfma_f32_32x32x16_bf16(pa3, PK(3), o[0], 0, 0, 0);
    o[1] = __builtin_amdgcn_mfma_f32_32x32x16_bf16(pa3, PK(7), o[1], 0, 0, 0);
    if (SUM) osum = __builtin_amdgcn_mfma_f32_32x32x16_bf16(pa3, ones, osum, 0, 0, 0);
    __builtin_amdgcn_s_setprio(0);
#undef PK
}
__device__ __forceinline__ float rowmax(const f32x16& p0, const f32x16& p1, int hi) {
    float a = __builtin_fmaxf(p0[0], p1[0]);
#pragma unroll
    for (int r = 1; r < 16; ++r) a = __builtin_fmaxf(__builtin_fmaxf(a, p0[r]), p1[r]);
    return __builtin_fmaxf(a, swap_other(a, hi));
}
struct KVRegs { u32x4 k, v; };
__device__ __forceinline__ void tile_load(KVRegs& R, const bf16_t* K, const bf16_t* V, int tid) { R.k = *(const u32x4*)(K + tid * 8); R.v = *(const u32x4*)(V + tid * 8); }
__device__ __forceinline__ void tile_store(const KVRegs& R, LAS char* Ks, LAS char* Vs, int tid) {
    const int row = tid >> 3, c = tid & 7;
    *(LAS u32x4*)(Ks + c * KCS + row * 16) = R.k;
    *(LAS u32x4*)(Vs + (c >> 2) * 4096 + (row >> 4) * 1024 + (row & 15) * 64 + (c & 3) * 16) = R.v;
}
__device__ __forceinline__ void ps_accum(const f32x16 p, int jb, LAS float* ps_row, bool writer) {
#pragma unroll
    for (int rg = 0; rg < 4; ++rg) {
        float a = 2.f * (p[4 * rg] + p[4 * rg + 1] + p[4 * rg + 2]) + p[4 * rg + 3], bq = p[4 * rg + 3];
        a += __shfl_xor(a, 1); a += __shfl_xor(a, 2); bq += __shfl_xor(bq, 1); bq += __shfl_xor(bq, 2);
        const int j = jb + 2 * rg;
        if (writer) { __hip_atomic_fetch_add(ps_row + j, a, __ATOMIC_RELAXED, __HIP_MEMORY_SCOPE_WORKGROUP); if (j + 1 < 128) __hip_atomic_fetch_add(ps_row + j + 1, bq, __ATOMIC_RELAXED, __HIP_MEMORY_SCOPE_WORKGROUP); }
    }
}
struct Ctx { LAS char* lds; LAS float* wsf; LAS float* otl; int tid, wid, lane, r32, hi, vbl; };
struct RowSt { float m, l; bool started; f32x16 negm, osum; };
__device__ __forceinline__ void rowst_init(RowSt& S) { S.m = 0.f; S.l = 0.f; S.started = false; S.negm = f32x16{}; S.osum = f32x16{}; asm volatile("" : "+v"(S.negm)); }
__device__ __forceinline__ void rowst_fixed(RowSt& S, float ref) { S.m = ref; S.l = 0.f; S.started = true; S.osum = f32x16{};
#pragma unroll
    for (int r = 0; r < 16; ++r) S.negm[r] = -ref;
    asm volatile("" : "+v"(S.negm)); }
template <int MODE, class Src, class Msk>
__device__ __forceinline__ void run_branch(const Ctx& C, int nt, const Src& src, const Msk& msk, const bf16x8* qr, RowSt& S, f32x16* o, LAS float* ps_row, bool ps_writer, KVRegs& R0, bool pre, const bf16_t* nk, const bf16_t* nv) {
    KVRegs R1; const bf16_t *kp, *vp;
    if (!pre) { src(0, kp, vp); tile_load(R0, kp, vp, C.tid); }
    if (nt > 1) { src(1, kp, vp); tile_load(R1, kp, vp, C.tid); }
    auto compute = [&](int it, const LAS char* Ks, const LAS char* Vs, int klo, int khi, bool nm) {
        const bool kill = khi < klo;
        if (!__any(!kill)) return;
        f32x16 p0, p1; qkt(p0, p1, Ks, qr, S.negm, C.r32, C.hi);
        VFrag VF; if constexpr (MODE != 0) v_issue(VF, Vs + C.vbl);
        if (__any(nm && !kill)) {
#pragma unroll
            for (int r = 0; r < 16; ++r) { const int kv = crow(r, C.hi); if (kv < klo || kv > khi) p0[r] = -INFINITY; if (kv + 32 < klo || kv + 32 > khi) p1[r] = -INFINITY; }
        }
        if constexpr (MODE != 2) {
            float rm = rowmax(p0, p1, C.hi); if (kill) rm = -INFINITY;
            const bool first = !S.started && rm > -INFINITY, grow = first || rm > 8.0f;
            if (__any(grow)) {
                const float d = grow ? rm : 0.f, alpha = first ? 1.0f : __builtin_amdgcn_exp2f(-d);
                S.m += d; S.started = S.started || first;
#pragma unroll
                for (int r = 0; r < 16; ++r) { S.negm[r] = -S.m; p0[r] -= d; p1[r] -= d; }
                if constexpr (MODE == 0) S.l *= alpha;
                if constexpr (MODE == 1) {
                    if (C.hi == 0) C.wsf[C.r32] = alpha;
                    LWAIT();
#pragma unroll
                    for (int r = 0; r < 16; ++r) { const float f = C.wsf[crow(r, C.hi)]; o[0][r] *= f; o[1][r] *= f; S.osum[r] *= f; }
                    LWAIT();
                }
            }
        }
#pragma unroll
        for (int r = 0; r < 16; ++r) { p0[r] = __builtin_amdgcn_exp2f(p0[r]); p1[r] = __builtin_amdgcn_exp2f(p1[r]); }
        if constexpr (MODE == 0) {
            float s = 0.f;
#pragma unroll
            for (int r = 0; r < 16; ++r) s += p0[r] + p1[r];
            S.l += kill ? 0.f : s;
        }
        if constexpr (MODE == 2) {
            if (__any(kill)) {
#pragma unroll
                for (int r = 0; r < 16; ++r) { p0[r] = kill ? 0.f : p0[r]; p1[r] = kill ? 0.f : p1[r]; }
            }
            ps_accum(p0, 16 * it + C.hi, ps_row, ps_writer); ps_accum(p1, 16 * it + 8 + C.hi, ps_row, ps_writer);
        }
        if constexpr (MODE != 0) {
            u32x4 w0 = {cvtpk(p0[0], p0[1]), cvtpk(p0[2], p0[3]), cvtpk(p0[4], p0[5]), cvtpk(p0[6], p0[7])}, w1 = {cvtpk(p0[8], p0[9]), cvtpk(p0[10], p0[11]), cvtpk(p0[12], p0[13]), cvtpk(p0[14], p0[15])};
            u32x4 w2 = {cvtpk(p1[0], p1[1]), cvtpk(p1[2], p1[3]), cvtpk(p1[4], p1[5]), cvtpk(p1[6], p1[7])}, w3 = {cvtpk(p1[8], p1[9]), cvtpk(p1[10], p1[11]), cvtpk(p1[12], p1[13]), cvtpk(p1[14], p1[15])};
            if constexpr (MODE == 1) {
                if (__any(kill)) {
#pragma unroll
                    for (int e = 0; e < 4; ++e) { w0[e] = kill ? 0u : w0[e]; w1[e] = kill ? 0u : w1[e]; w2[e] = kill ? 0u : w2[e]; w3[e] = kill ? 0u : w3[e]; }
                }
            }
            pv<MODE == 1>(o, S.osum, VF, __builtin_bit_cast(bf16x8, w0), __builtin_bit_cast(bf16x8, w1), __builtin_bit_cast(bf16x8, w2), __builtin_bit_cast(bf16x8, w3));
        }
    };
    LBAR();
    for (int it = 0; it < nt; it += 2) {
        const int p = (it >> 1) & 1; const bool two = it + 1 < nt;
        LAS char* KsA = C.lds + L_K0 + (2 * p) * KSLOT; LAS char* VsA = C.lds + L_V0 + (2 * p) * VSLOT;
        LAS char* KsB = KsA + KSLOT; LAS char* VsB = VsA + VSLOT;
        tile_store(R0, KsA, VsA, C.tid); if (two) tile_store(R1, KsB, VsB, C.tid);
        if (it + 2 < nt) { src(it + 2, kp, vp); tile_load(R0, kp, vp, C.tid); } else if (nk) tile_load(R0, nk, nv, C.tid);
        if (it + 3 < nt) { src(it + 3, kp, vp); tile_load(R1, kp, vp, C.tid); }
        int kloA, khiA, kloB = 0, khiB = -1; const bool nmA = msk(it, kloA, khiA); bool nmB = false; if (two) nmB = msk(it + 1, kloB, khiB);
        LBAR();
        compute(it, KsA, VsA, kloA, khiA, nmA);
        if (two) compute(it + 1, KsB, VsB, kloB, khiB, nmB);
    }
}
template <bool FIRST> __device__ __forceinline__ void merge_branch_n(const Ctx& C, const f32x16* o, const f32x16& osum, float gate) {
    if (C.hi == 0) C.wsf[C.r32] = gate;
    LWAIT();
#pragma unroll
    for (int r = 0; r < 16; ++r) { const float den = osum[r], f = den > 0.f ? C.wsf[crow(r, C.hi)] * __builtin_amdgcn_rcpf(den) : 0.f;
        if (FIRST) { C.otl[r * 64] = o[0][r] * f; C.otl[(16 + r) * 64] = o[1][r] * f; }
        else { C.otl[r * 64] += o[0][r] * f; C.otl[(16 + r) * 64] += o[1][r] * f; } }
    LWAIT();
}
template <bool FIRST> __device__ __forceinline__ void merge_branch(const Ctx& C, const f32x16* o, float factor) {
    if (C.hi == 0) C.wsf[C.r32] = factor;
    LWAIT();
#pragma unroll
    for (int r = 0; r < 16; ++r) { const float f = C.wsf[crow(r, C.hi)];
        if (FIRST) { C.otl[r * 64] = o[0][r] * f; C.otl[(16 + r) * 64] = o[1][r] * f; }
        else { C.otl[r * 64] += o[0][r] * f; C.otl[(16 + r) * 64] += o[1][r] * f; } }
    LWAIT();
}
struct Bufs { const bf16_t *Qn, *KV, *Mo, *KC, *KM, *Gn; bf16_t* Abr; };
constexpr size_t KV_STRIDE = (size_t)MTOK * 128, MO_STRIDE = (size_t)MTOK * 256;

__device__ __forceinline__ void nsa_item(const Ctx& C, const Bufs& B, int b, int g, int i) {
    const int r32 = C.r32, hi = C.hi, wid = C.wid;
    const int qi = 8 * wid + (r32 >> 2), hh = r32 & 3, head = g * 4 + hh, t = 64 * i + qi, cur = i;
    const size_t bg = (size_t)(b * 2 + g) * SEQ;
    bf16x8 qr[4];
    { const bf16_t* qp = B.Qn + ((size_t)(b * 8 + head) * SEQ + t) * 64 + hi * 8;
#pragma unroll
      for (int d0 = 0; d0 < 4; ++d0) qr[d0] = *(const bf16x8*)(qp + d0 * 16); }
    const unsigned gw = *(const unsigned*)(B.Gn + ((size_t)b * SEQ + t) * 32 + head * 3 - (head & 1));
    const unsigned gw2 = *(const unsigned*)(B.Gn + ((size_t)b * SEQ + t) * 32 + head * 3 - (head & 1) + 2);
    float g0, g1, g2; if (head & 1) { g0 = bfhi(gw); g1 = bflo(gw2); g2 = bfhi(gw2); } else { g0 = bflo(gw); g1 = bfhi(gw); g2 = bflo(gw2); }
    f32x16 o[2];
    LAS float* Ps = (LAS float*)(C.lds + L_PS); LAS unsigned* Mk = (LAS unsigned*)(C.lds + L_MSK); LAS unsigned* Uni = (LAS unsigned*)(C.lds + L_UNI); LAS int* List = (LAS int*)(C.lds + L_LIST);
    const int nv = t >= 31 ? ((t - 31) >> 4) + 1 : 0;
    const int nvt = (4 * i + 3 < 511) ? 4 * i + 3 : 511, ntc = (nvt + 63) >> 6;
    const bf16_t* kc = B.KC + (size_t)(0 * 4 + b * 2 + g) * 512 * 64; const bf16_t* vc = B.KC + (size_t)(1 * 4 + b * 2 + g) * 512 * 64;
    auto srcC = [&](int it, const bf16_t*& kp, const bf16_t*& vp) { kp = kc + (size_t)it * 4096; vp = vc + (size_t)it * 4096; };
    auto mskC = [&](int it, int& klo, int& khi) { klo = 0; khi = nv - 1 - 64 * it; return khi < 63; };
    RowSt S; rowst_init(S);
    KVRegs R;
    run_branch<0>(C, ntc, srcC, mskC, qr, S, o, nullptr, false, R, false, kc, vc);
    const float lt = S.l + swap_other(S.l, hi);
    rowst_fixed(S, lt > 0.f ? S.m + __builtin_amdgcn_logf(lt) : 0.f);
    for (int e = C.tid; e < 64 * 128; e += 512) Ps[e] = 0.f;
    if (C.tid < 8) Uni[C.tid] = 0u;
    o[0] = f32x16{}; o[1] = f32x16{};
    run_branch<2>(C, ntc, srcC, mskC, qr, S, o, Ps + qi * 128, hh == 0, R, true, B.KV + 2 * KV_STRIDE + bg * 64, B.KV + 3 * KV_STRIDE + bg * 64);
    LBAR();
    {
        const int nf = cur == 0 ? 1 : (cur == 1 ? 2 : 3), kp_ = 16 - nf, lane = C.lane;
#pragma unroll 1
        for (int qq = 0; qq < 8; ++qq) {
            int q = 8 * wid + qq; asm volatile("" : "+s"(q)); LAS float* ps = Ps + q * 128;
            const int j0 = lane, j1 = lane + 64;
            const bool f0 = (j0 == 0 || j0 == cur || j0 == cur - 1) && j0 <= cur, f1 = (j1 == cur || j1 == cur - 1) && j1 <= cur;
            const bool va0 = j0 <= cur && !f0, va1 = j1 <= cur && !f1;
            const unsigned k0 = va0 ? __float_as_uint(ps[j0]) + 1u : 0u, k1 = va1 ? __float_as_uint(ps[j1]) + 1u : 0u;
            unsigned T = 0u;
            for (int bit = 30; bit >= 0; --bit) { const unsigned cand = T | (1u << bit); const int cnt = __popcll(__ballot(k0 >= cand)) + __popcll(__ballot(k1 >= cand)); if (cnt >= kp_) T = cand; }
            const int need = kp_ - (__popcll(__ballot(k0 > T)) + __popcll(__ballot(k1 > T)));
            const unsigned long long t0 = __ballot(k0 == T), t1 = __ballot(k1 == T), below = (1ull << lane) - 1ull;
            const int pre0 = __popcll(t0 & below), pre1 = __popcll(t0) + __popcll(t1 & below);
            const bool s0 = f0 || (k0 > 0u && (k0 > T || (k0 == T && pre0 < need))), s1 = f1 || (k1 > 0u && (k1 > T || (k1 == T && pre1 < need)));
            const unsigned long long b0 = __ballot(s0), b1 = __ballot(s1);
            if (lane == 0) { Mk[q * 4 + 0] = (unsigned)b0; Mk[q * 4 + 1] = (unsigned)(b0 >> 32); Mk[q * 4 + 2] = (unsigned)b1; Mk[q * 4 + 3] = (unsigned)(b1 >> 32);
                __hip_atomic_fetch_or(&Uni[0], (unsigned)b0, __ATOMIC_RELAXED, __HIP_MEMORY_SCOPE_WORKGROUP); __hip_atomic_fetch_or(&Uni[1], (unsigned)(b0 >> 32), __ATOMIC_RELAXED, __HIP_MEMORY_SCOPE_WORKGROUP); __hip_atomic_fetch_or(&Uni[2], (unsigned)b1, __ATOMIC_RELAXED, __HIP_MEMORY_SCOPE_WORKGROUP); __hip_atomic_fetch_or(&Uni[3], (unsigned)(b1 >> 32), __ATOMIC_RELAXED, __HIP_MEMORY_SCOPE_WORKGROUP); }
        }
    }
    LBAR();
    if (C.tid == 0) { int n = 0; for (int w = 0; w < 4; ++w) { unsigned u = Uni[w]; while (u) { const int bpos = __builtin_ctz(u); u &= u - 1; List[n++] = w * 32 + bpos; } } Uni[4] = (unsigned)n; }
    LBAR();
    merge_branch<true>(C, o, g0);
    {
        const int nsel = (int)Uni[4];
        const bf16_t* ks = B.KV + 2 * KV_STRIDE + bg * 64; const bf16_t* vs = B.KV + 3 * KV_STRIDE + bg * 64;
        auto srcS = [&](int it, const bf16_t*& kp, const bf16_t*& vp) { const int j = List[it]; kp = ks + (size_t)j * 4096; vp = vs + (size_t)j * 4096; };
        auto mskS = [&](int it, int& klo, int& khi) { const int j = List[it]; const unsigned w = Mk[qi * 4 + (j >> 5)]; const bool bit = (w >> (j & 31)) & 1u;
            klo = 0; khi = bit ? (j == cur ? qi : 63) : -1; return j == cur; };
        rowst_init(S); o[0] = f32x16{}; o[1] = f32x16{};
        const int tw0n = i >= 8 ? i - 8 : 0;
        run_branch<1>(C, nsel, srcS, mskS, qr, S, o, nullptr, false, R, true, B.KV + 4 * KV_STRIDE + bg * 64 + (size_t)tw0n * 4096, B.KV + 5 * KV_STRIDE + bg * 64 + (size_t)tw0n * 4096);
        merge_branch_n<false>(C, o, S.osum, g1);
    }
    {
        const int tw0 = i >= 8 ? i - 8 : 0, ntw = i - tw0 + 1;
        const bf16_t* kw = B.KV + 4 * KV_STRIDE + bg * 64; const bf16_t* vw = B.KV + 5 * KV_STRIDE + bg * 64;
        auto srcW = [&](int it, const bf16_t*& kp, const bf16_t*& vp) { kp = kw + (size_t)(tw0 + it) * 4096; vp = vw + (size_t)(tw0 + it) * 4096; };
        auto mskW = [&](int it, int& klo, int& khi) { const int tw = tw0 + it; klo = (t - 511) - 64 * tw; khi = (tw == i) ? qi : 63; return tw == i || klo > 0; };
        rowst_init(S); o[0] = f32x16{}; o[1] = f32x16{};
        run_branch<1>(C, ntw, srcW, mskW, qr, S, o, nullptr, false, R, true, nullptr, nullptr);
        merge_branch_n<false>(C, o, S.osum, g2);
    }
#pragma unroll
    for (int r = 0; r < 16; ++r) { const int qrow = crow(r, hi); bf16_t* dst = B.Abr + ((size_t)b * SEQ + 64 * i + 8 * wid + (qrow >> 2)) * DM + 256 + (g * 4 + (qrow & 3)) * 64 + r32;
        dst[0] = (bf16_t)(cvtpk(ABL_NSA_SCALE C.otl[r * 64], 0.f) & 0xffffu); dst[32] = (bf16_t)(cvtpk(ABL_NSA_SCALE C.otl[(16 + r) * 64], 0.f) & 0xffffu); }
}
__device__ __forceinline__ void moba_item(const Ctx& C, const Bufs& B, int b, int h, int qb) {
    const int r32 = C.r32, hi = C.hi, wid = C.wid, own = qb, t = 256 * qb + 32 * wid + r32;
    const size_t bh = (size_t)(b * 4 + h) * SEQ;
    bf16x8 qr[4];
    { const bf16_t* qp = B.Mo + (bh + t) * 64 + hi * 8;
#pragma unroll
      for (int d0 = 0; d0 < 4; ++d0) qr[d0] = *(const bf16x8*)(qp + d0 * 16); }
    LAS unsigned* Uni = (LAS unsigned*)(C.lds + L_UNI); LAS int* List = (LAS int*)(C.lds + L_LIST);
    LBAR();
    if (C.tid < 256) { const u32x4 kmv = *(const u32x4*)(B.KM + (size_t)(b * 4 + h) * 2048 + C.tid * 8); *(LAS u32x4*)(C.lds + L_K0 + (C.tid & 7) * KCS + (C.tid >> 3) * 16) = kmv; }
    if (C.tid == 0) Uni[0] = 0u;
    LBAR();
    unsigned sel = 0u;
    {
        f32x16 gs = f32x16{};
        const LAS char* kb = C.lds + L_K0 + hi * KCS + r32 * 16;
#pragma unroll
        for (int d0 = 0; d0 < 4; ++d0) gs = __builtin_amdgcn_mfma_f32_32x32x16_bf16(*(const LAS bf16x8*)(kb + d0 * 2 * KCS), qr[d0], gs, 0, 0, 0);
        float lo[16], hv[16];
#pragma unroll
        for (int r = 0; r < 16; ++r) { const float ownv = gs[r], oth = swap_other(ownv, hi); lo[r] = hi ? oth : ownv; hv[r] = hi ? ownv : oth; }
        unsigned taken = ~((1u << own) - 1u);
#pragma unroll
        for (int round = 0; round < 3; ++round) {
            float best = -INFINITY; int bi = 32;
#pragma unroll
            for (int n = 0; n < 32; ++n) { const int rr = (n & 3) + 4 * (n >> 3); const float v = ((n >> 2) & 1) ? hv[rr] : lo[rr]; if (!((taken >> n) & 1u) && v > best) { best = v; bi = n; } }
            if (bi < 32) { sel |= 1u << bi; taken |= 1u << bi; }
        }
    }
    { unsigned u = sel;
#pragma unroll
      for (int o_ = 1; o_ < 64; o_ <<= 1) u |= (unsigned)__shfl_xor((int)u, o_);
      if (C.lane == 0) __hip_atomic_fetch_or(&Uni[0], u, __ATOMIC_RELAXED, __HIP_MEMORY_SCOPE_WORKGROUP); }
    LBAR();
    if (C.tid == 0) { int n = 0; unsigned u = Uni[0]; while (u) { const int bpos = __builtin_ctz(u); u &= u - 1; List[n++] = bpos; } Uni[4] = (unsigned)n; }
    LBAR();
    const int nl = (int)Uni[4], nt = 4 * nl + 4;
    const bf16_t* kk = B.Mo + MO_STRIDE + bh * 64; const bf16_t* vv = B.Mo + 2 * MO_STRIDE + bh * 64;
    auto src = [&](int it, const bf16_t*& kp, const bf16_t*& vp) { const int T = (it < 4 * nl) ? 4 * List[it >> 2] + (it & 3) : 4 * own + (it - 4 * nl); kp = kk + (size_t)T * 4096; vp = vv + (size_t)T * 4096; };
    auto msk = [&](int it, int& klo, int& khi) { klo = 0; if (it < 4 * nl) { const bool bit = (sel >> List[it >> 2]) & 1u; khi = bit ? 63 : -1; return false; } khi = 32 * wid + r32 - 64 * (it - 4 * nl); return true; };
    RowSt S; rowst_init(S); f32x16 o[2] = {f32x16{}, f32x16{}};
    KVRegs R;
    run_branch<1>(C, nt, src, msk, qr, S, o, nullptr, false, R, false, nullptr, nullptr);
    merge_branch_n<true>(C, o, S.osum, 1.0f);
#pragma unroll
    for (int r = 0; r < 16; ++r) { const int qrow = crow(r, hi); bf16_t* dst = B.Abr + ((size_t)b * SEQ + 256 * qb + 32 * wid + qrow) * DM + 768 + h * 64 + r32;
        dst[0] = (bf16_t)(cvtpk(ABL_MOBA_SCALE C.otl[r * 64], 0.f) & 0xffffu); dst[32] = (bf16_t)(cvtpk(ABL_MOBA_SCALE C.otl[(16 + r) * 64], 0.f) & 0xffffu); }
}
}
#define XB_TMO      128
#define XB_XCNT(j)  (256  + 64 * (j))
#define XB_XSUB(j)  (1280 + 64 * (j))
#define XB_XGEN(j)  (2304 + 64 * (j))
#define XB_TOP      3328
#define XB_TOPGEN   3392
#define XCD_BAR_WORDS 3456
#define XB_SPIN_CAP (1u << 18)

__device__ __forceinline__ unsigned xb_ld(unsigned* p)              { return __hip_atomic_load(p, __ATOMIC_RELAXED, __HIP_MEMORY_SCOPE_AGENT); }
__device__ __forceinline__ unsigned xb_add(unsigned* p, unsigned v) { return __hip_atomic_fetch_add(p, v, __ATOMIC_RELAXED, __HIP_MEMORY_SCOPE_AGENT); }
__device__ __forceinline__ unsigned xb_xcc_id() { return (unsigned)__builtin_amdgcn_s_getreg((3 << 11) | 20) & 0xFu; }
#define XB_SPIN(cond, bar) do { unsigned _sp = 0; while (cond) { __builtin_amdgcn_s_sleep(1); \
    if ((++_sp & 255u) == 0u) { if (xb_ld(&(bar)[XB_TMO])) break; if (_sp > XB_SPIN_CAP) { atomicAdd(&(bar)[XB_TMO], 1u); break; } } } } while (0)

struct XcdBarrier {
    unsigned* bar; unsigned x;
    volatile LAS unsigned* st;
};

__device__ __forceinline__ XcdBarrier xcd_barrier_post(unsigned* bar, volatile LAS unsigned* st) {
    XcdBarrier b; b.bar = bar; b.x = xb_xcc_id(); b.st = st;
    if (threadIdx.x == 0) (void)xb_add(&bar[XB_XCNT(b.x)], 1u);
    return b;
}
__device__ __forceinline__ void xcd_barrier_complete(unsigned* bar, unsigned x, unsigned& nloc, unsigned& nx) {
    const unsigned G = gridDim.x * gridDim.y * gridDim.z;
    unsigned sum, cnt, mine, sp = 0u;
    for (;;) {
        sum = 0u; cnt = 0u; mine = 0u;
#pragma unroll
        for (unsigned j = 0; j < 16; ++j) { const unsigned c = xb_ld(&bar[XB_XCNT(j)]); sum += c; cnt += (c > 0u) ? 1u : 0u; mine = (j == x) ? c : mine; }
        if (sum == G) break;
        __builtin_amdgcn_s_sleep(1);
        if ((++sp & 255u) == 0u) { if (xb_ld(&bar[XB_TMO])) break; if (sp > XB_SPIN_CAP) { atomicAdd(&bar[XB_TMO], 1u); break; } }
    }
    nloc = mine > 0u ? mine : 1u; nx = cnt > 0u ? cnt : 1u;
}

__device__ __forceinline__ void xcd_barrier(const XcdBarrier& b) {
    asm volatile("s_waitcnt vmcnt(0)" ::: "memory");
    __syncthreads();
    if (threadIdx.x == 0) {
        unsigned* bar = b.bar;
        __builtin_amdgcn_s_waitcnt(0);
        unsigned nloc = b.st[0], nx = b.st[1];
        if (nloc == 0u) { xcd_barrier_complete(bar, b.x, nloc, nx); b.st[0] = nloc; b.st[1] = nx; }
        const unsigned old = xb_add(&bar[XB_XSUB(b.x)], 1u);
        const unsigned gen = old / nloc;
        if (old + 1u == (gen + 1u) * nloc) {
            __builtin_amdgcn_fence(__ATOMIC_RELEASE, "agent");
            asm volatile("s_waitcnt vmcnt(0)" ::: "memory");
            const unsigned og = xb_add(&bar[XB_TOP], 1u);
            const unsigned tg = og / nx;
            if (og + 1u == (tg + 1u) * nx) xb_add(&bar[XB_TOPGEN], 1u);
            else XB_SPIN(xb_ld(&bar[XB_TOPGEN]) == tg, bar);
            __builtin_amdgcn_fence(__ATOMIC_ACQUIRE, "agent");
            xb_add(&bar[XB_XGEN(b.x)], 1u);
            asm volatile("s_waitcnt vmcnt(0)" ::: "memory");
        } else {
            XB_SPIN(xb_ld(&bar[XB_XGEN(b.x)]) == gen, bar);
            __builtin_amdgcn_fence(__ATOMIC_ACQUIRE, "agent");
            asm volatile("s_waitcnt vmcnt(0)" ::: "memory");
        }
    }
    __syncthreads();
}

#ifndef DUP
#define DUP 0
#endif
constexpr size_t MiB = 1u << 20;
constexpr size_t WS_CTL = 0, WS_ORDER = 4096, WS_BAR = 8192;
constexpr size_t WS_W = 1 * MiB, OFF_WIN = 0, OFF_WGU = 11 * MiB, OFF_WD = 22 * MiB, OFF_WBR = 28 * MiB, OFF_WOUT = 30 * MiB, OFF_W1 = 32 * MiB, OFF_W2 = 34 * MiB,
                 OFF_BIN = 34 * MiB + 65536, OFF_CB1 = OFF_BIN + 32768  , OFF_CB2 = OFF_CB1 + 65536;
constexpr size_t WS_TAB = 36 * MiB, WS_SSP = 38 * MiB, WS_KC = 39 * MiB, WS_KM = 39 * MiB + 512 * 1024, WS_GN = 40 * MiB, WS_XB = 42 * MiB, WS_BIG = 74 * MiB,
                 WS_U = 170 * MiB, WS_QN = 178 * MiB, WS_KV = 194 * MiB, WS_MO = 218 * MiB, WS_MRG = 178 * MiB, WS_END = 242 * MiB;
constexpr int LDS_BYTES = 147456;

__device__ __forceinline__ int dint(int pos) { return (pos >> 1) + 32 * (pos & 1); }
__device__ __forceinline__ int in_orig(int c) {
    if (c < 256) return c;
    if (c < 768) { const int c2 = c - 256; return 256 + (c2 >> 6) * 64 + dint(c2 & 63); }
    if (c < 1536) { const int c2 = c - 768, tt = c2 >> 8, bj = (c2 >> 7) & 1, g = (c2 >> 6) & 1, pos = c2 & 63; return 768 + (2 * tt + bj) * 128 + g * 64 + (bj == 0 ? dint(pos) : pos); }
    if (c < 2304) { const int c2 = c - 1536, part = c2 >> 8, h = (c2 >> 6) & 3, pos = c2 & 63; return 1560 + part * 256 + h * 64 + (part < 2 ? dint(pos) : pos); }
    if (c < 5376) return 2328 + (c - 2304);
    const int c2 = c - 5376; return c2 < 24 ? 1536 + c2 : -1;
}
template <class F> __device__ __forceinline__ void cvt_tile(LAS float* scr, int lane, int k0, int n0, bf16_t* dst, size_t pitch, F f) {
    float vals[32];
#pragma unroll
    for (int i = 0; i < 32; ++i) vals[i] = f(k0 + 2 * i + (lane >> 5), n0 + (lane & 31));
#pragma unroll
    for (int i = 0; i < 32; ++i) scr[(2 * i + (lane >> 5)) * 33 + (lane & 31)] = vals[i];
    asm volatile("s_waitcnt lgkmcnt(0)" ::: "memory");
    const int c = lane & 7;
#pragma unroll
    for (int j = 0; j < 4; ++j) { const int n = (lane >> 3) + 8 * j; const LAS float* s = scr + (8 * c) * 33 + n;
        u32x4 o; o.x = cvtpk(s[0 * 33], s[1 * 33]); o.y = cvtpk(s[2 * 33], s[3 * 33]); o.z = cvtpk(s[4 * 33], s[5 * 33]); o.w = cvtpk(s[6 * 33], s[7 * 33]);
        *(u32x4*)(dst + (size_t)(n0 + n) * pitch + k0 + 8 * c) = o; }
    asm volatile("s_waitcnt lgkmcnt(0)" ::: "memory");
}
struct Args { const float* in[20]; float* out; unsigned char* ws; };
typedef const __attribute__((address_space(4))) Args* ArgsP;

__device__ __forceinline__ void phase0(ArgsP a, int l, LAS unsigned char* lds, int tid, int lane, int wave, int gw, int NGW) {
    unsigned char* ws = a->ws;
    LAS float* scr = (LAS float*)(lds + wave * 8704);
    const float* attn_norm = a->in[1] + (size_t)l * DM; const float* w_in = a->in[2] + (size_t)l * DM * IN_COLS; const float* b_in = a->in[3] + (size_t)l * IN_COLS;
    const float* pool_w = a->in[4] + (size_t)l * 4 * 64 * 64; const float* pool_scale = a->in[5] + (size_t)l * 256; const float* cmp_pos = a->in[6] + (size_t)l * 2 * 32 * 64;
    const float* cmp_w1 = a->in[7] + (size_t)l * 2 * 2048 * 256; const float* cmp_b1 = a->in[8] + (size_t)l * 2 * 256; const float* cmp_w2 = a->in[9] + (size_t)l * 2 * 256 * 64; const float* cmp_b2 = a->in[10] + (size_t)l * 2 * 64;
    const float* w_br_pool = a->in[11] + (size_t)l * 256 * DM; const float* w_br_nsa = a->in[12] + (size_t)l * 512 * DM; const float* w_br_moba = a->in[13] + (size_t)l * 256 * DM;
    const float* w_out = a->in[14] + (size_t)l * DM * DM; const float* ffn_norm = a->in[15] + (size_t)l * DM; const float* w_gate = a->in[16] + (size_t)l * DM * DFF; const float* w_up = a->in[17] + (size_t)l * DM * DFF;
    const float* w_down = a->in[18] + (size_t)l * DFF * DM;
    bf16_t* Win = (bf16_t*)(ws + WS_W + OFF_WIN); bf16_t* Wgu = (bf16_t*)(ws + WS_W + OFF_WGU); bf16_t* Wd = (bf16_t*)(ws + WS_W + OFF_WD); bf16_t* Wbr = (bf16_t*)(ws + WS_W + OFF_WBR);
    bf16_t* Wout = (bf16_t*)(ws + WS_W + OFF_WOUT); bf16_t* W1t = (bf16_t*)(ws + WS_W + OFF_W1); bf16_t* W2t = (bf16_t*)(ws + WS_W + OFF_W2);
    float* bin = (float*)(ws + WS_W + OFF_BIN); float* cb1 = (float*)(ws + WS_W + OFF_CB1); float* cb2 = (float*)(ws + WS_W + OFF_CB2);
    constexpr int I_A = 16 * 176, I_B = 16 * 176, I_C = 44 * 32, I_D = 16 * 32, I_E = 16 * 32, I_F = 2 * 32 * 8, I_G = 2 * 4 * 2;
    constexpr int NITEMS = I_A + I_B + I_C + I_D + I_E + I_F + I_G;
    for (int rep_ = 0; rep_ < ((DUP & 256) ? 2 : 1); ++rep_)
    for (int it = gw; it < NITEMS; it += NGW) {
        int r = it;
        if (r < I_A) { const int kb = r / 176, nb = r % 176; cvt_tile(scr, lane, 64 * kb, 32 * nb, Win, DM, [&](int k, int n) { const int o = in_orig(n); const float v = w_in[(size_t)k * IN_COLS + (o >= 0 ? o : 0)] * attn_norm[k]; return o >= 0 ? v : 0.f; }); continue; } r -= I_A;
        if (r < I_B) { const int kb = r / 176, nb = r % 176; cvt_tile(scr, lane, 64 * kb, 32 * nb, Wgu, DM, [&](int k, int n) { const int j = (n >> 8) * 128 + (n & 127); const float* s = ((n >> 7) & 1) ? w_up : w_gate; return s[(size_t)k * DFF + j] * ffn_norm[k]; }); continue; } r -= I_B;
        if (r < I_C) { const int kb = r / 32, nb = r % 32; cvt_tile(scr, lane, 64 * kb, 32 * nb, Wd, DFF, [&](int k, int n) { return w_down[(size_t)k * DM + n]; }); continue; } r -= I_C;
        if (r < I_D) { const int kb = r / 32, nb = r % 32; cvt_tile(scr, lane, 64 * kb, 32 * nb, Wout, DM, [&](int k, int n) { return w_out[(size_t)k * DM + n]; }); continue; } r -= I_D;
        if (r < I_E) { const int kb = r / 32, nb = r % 32;
            if (kb < 4) { }
            else if (kb < 12) cvt_tile(scr, lane, 64 * kb, 32 * nb, Wbr, DM, [&](int k, int n) { return w_br_nsa[(size_t)(k - 256) * DM + n]; });
            else cvt_tile(scr, lane, 64 * kb, 32 * nb, Wbr, DM, [&](int k, int n) { return w_br_moba[(size_t)(k - 768) * DM + n]; });
            continue; } r -= I_E;
        if (r < I_F) { const int kv = r >> 8, kb = (r >> 3) & 31, nb = r & 7; const float* w1 = cmp_w1 + (size_t)kv * 2048 * 256;
            cvt_tile(scr, lane, 64 * kb, 32 * nb, W1t + (size_t)kv * 256 * 2048, 2048, [&](int k, int n) { const int pos = k & 63, d = kv == 0 ? dint(pos) : pos; return w1[(size_t)((k & ~63) + d) * 256 + n]; }); continue; } r -= I_F;
        { const int kv = r >> 3, kb = (r >> 1) & 3, nb = r & 1; const float* w2 = cmp_w2 + (size_t)kv * 256 * 64;
            cvt_tile(scr, lane, 64 * kb, 32 * nb, W2t + (size_t)kv * 64 * 256, 256, [&](int k, int n) { return w2[(size_t)k * 64 + (kv == 0 ? dint(n) : n)]; }); }
    }
    const int gt = gw * 64 + lane, NGT = NGW * 64;
    for (int c = gt; c < NIN; c += NGT) { const int o = in_orig(c); bin[c] = o >= 0 ? b_in[o] : 0.f; }
    for (int idx = gt; idx < 32 * 512; idx += NGT) { const int c = idx >> 9, e = idx & 511, kv = e >> 8, n = e & 255; const float* w1 = cmp_w1 + (size_t)kv * 2048 * 256 + (size_t)(64 * c) * 256 + n; const float* pe = cmp_pos + (size_t)kv * 2048 + 64 * c;
        float s = c == 0 ? cmp_b1[kv * 256 + n] : 0.f;
#pragma unroll 16
        for (int k = 0; k < 64; ++k) s += pe[k] * w1[(size_t)k * 256];
        cb1[idx] = s; }
    for (int idx = gt; idx < 256 * DM; idx += NGT) { const int k = idx >> 10, n = idx & 1023, g64 = k & ~63; float s = 0.f;
#pragma unroll 16
        for (int j = 0; j < 64; ++j) s += pool_w[k * 64 + j] * pool_scale[g64 + j] * w_br_pool[(size_t)(g64 + j) * DM + n];
        Wbr[(size_t)n * DM + k] = (bf16_t)(cvtpk(s, 0.f) & 0xffffu); }
    for (int e = gt; e < 128; e += NGT) { const int kv = e >> 6, n = e & 63; cb2[e] = cmp_b2[kv * 64 + (kv == 0 ? dint(n) : n)]; }
    if (l == 0) {
        float* tab = (float*)(ws + WS_TAB);
        for (int e = gt; e < SEQ * 32; e += NGT) { const int t = e >> 5, f = e & 31; const float inv = powf(10000.0f, -(float)(2 * f) / 64.0f); const float ang = (float)t * inv;
            const double ad = (double)ang, kq = rint(ad * 0.15915494309189535); double rr = fma(-kq, 6.283185307179586, ad); rr = fma(-kq, 2.4492935982947064e-16, rr);
            const float rf = (float)rr; tab[2 * e] = __cosf(rf); tab[2 * e + 1] = __sinf(rf); }
        const float* x = a->in[0]; bf16_t* xb = (bf16_t*)(ws + WS_XB); float* ssp = (float*)(ws + WS_SSP);
        for (int m0 = 2 * gw; m0 < MTOK; m0 += 2 * NGW) { f32x4 v[2][4]; float s[2] = {0.f, 0.f};
#pragma unroll
            for (int q = 0; q < 2; ++q) { const f32x4* xr = (const f32x4*)(x + (size_t)(m0 + q) * DM) + lane;
#pragma unroll
                for (int j = 0; j < 4; ++j) v[q][j] = xr[64 * j]; }
#pragma unroll
            for (int q = 0; q < 2; ++q) {
#pragma unroll
                for (int j = 0; j < 4; ++j) s[q] += (v[q][j][0] * v[q][j][0] + v[q][j][1] * v[q][j][1]) + (v[q][j][2] * v[q][j][2] + v[q][j][3] * v[q][j][3]);
#pragma unroll
                for (int o = 1; o < 64; o <<= 1) s[q] += __shfl_xor(s[q], o);
                u32x2* o8 = (u32x2*)(xb + (size_t)(m0 + q) * DM) + lane;
#pragma unroll
                for (int j = 0; j < 4; ++j) o8[64 * j] = (u32x2){cvtpk(v[q][j][0], v[q][j][1]), cvtpk(v[q][j][2], v[q][j][3])};
                if (lane < 16) ssp[(size_t)(m0 + q) * 16 + lane] = lane == 0 ? s[q] : 0.f; } }
        int* order = (int*)(ws + WS_ORDER);
        auto cost = [](int id) { if (id < 512) { const int i = id & 127; return 10 * ((i + 1) + ((i < 8 ? i : 8) + 1) + 10) + 16 * ((4 * i + 3 + 63) >> 6); } const int qb = (id - 512) & 31; return 7 * (4 * qb + 3) + 50; };
        for (int id = gw; id < 768; id += NGW) { const int mc = cost(id); int rk = 0;
            for (int j = lane; j < 768; j += 64) { const int cj = cost(j); rk += (cj > mc || (cj == mc && j < id)) ? 1 : 0; }
#pragma unroll
            for (int o = 1; o < 64; o <<= 1) rk += __shfl_xor(rk, o);
            if (lane == 0) order[rk] = id; }
    }
}
__device__ __forceinline__ float gelu_tanh(float x) { const float u = 0.7978845608028654f * (x + 0.044715f * x * x * x); const float th = 1.f - 2.f * __builtin_amdgcn_rcpf(1.f + __expf(2.f * u)); return 0.5f * x * (1.f + th); }
__device__ __forceinline__ void phase2(ArgsP a, LAS unsigned char* lds, int tid, int lane, int wave, int G) {
    unsigned char* ws = a->ws;
    const bf16_t* KV = (const bf16_t*)(ws + WS_KV); const bf16_t* W1t = (const bf16_t*)(ws + WS_W + OFF_W1); const bf16_t* W2t = (const bf16_t*)(ws + WS_W + OFF_W2);
    const float* cb1 = (const float*)(ws + WS_W + OFF_CB1); const float* cb2 = (const float*)(ws + WS_W + OFF_CB2);
    bf16_t* KC = (bf16_t*)(ws + WS_KC);
    LAS bf16_t* hid = (LAS bf16_t*)lds;
    const int arow = lane & 15, kq = lane >> 4;
    for (int task = blockIdx.x; task < 256; task += G) {
        const int kv = task >> 7, bgi = (task >> 5) & 3, nt = task & 31;
        const bf16_t* src = KV + (size_t)kv * att::KV_STRIDE + (size_t)bgi * SEQ * 64;
        const int nrow = 16 * nt + arow, neff = nrow < 510 ? nrow : 510;
        const bf16_t* ap = src + (size_t)neff * 1024 + kq * 8;
        const bf16_t* bp0 = W1t + (size_t)kv * 256 * 2048 + (size_t)(32 * wave + arow) * 2048 + kq * 8; const bf16_t* bp1 = bp0 + 16 * 2048;
        f32x4 c0 = {0.f, 0.f, 0.f, 0.f}, c1 = {0.f, 0.f, 0.f, 0.f};
#pragma unroll 8
        for (int ks = 0; ks < 64; ++ks) { const bf16x8 av = *(const bf16x8*)(ap + ks * 32), b0 = *(const bf16x8*)(bp0 + ks * 32), b1 = *(const bf16x8*)(bp1 + ks * 32);
            c0 = __builtin_amdgcn_mfma_f32_16x16x32_bf16(av, b0, c0, 0, 0, 0); c1 = __builtin_amdgcn_mfma_f32_16x16x32_bf16(av, b1, c1, 0, 0, 0); }
        { const int col0 = 32 * wave + arow; float bb0 = 0.f, bb1 = 0.f;
#pragma unroll 8
          for (int c = 0; c < 32; ++c) { bb0 += cb1[c * 512 + kv * 256 + col0]; bb1 += cb1[c * 512 + kv * 256 + col0 + 16]; }
#pragma unroll
          for (int j = 0; j < 4; ++j) { const int row = kq * 4 + j; hid[row * 264 + col0] = (bf16_t)(cvtpk(gelu_tanh(c0[j] + bb0), 0.f) & 0xffffu); hid[row * 264 + col0 + 16] = (bf16_t)(cvtpk(gelu_tanh(c1[j] + bb1), 0.f) & 0xffffu); } }
        LBAR();
        if (wave < 4) {
            const bf16_t* bp = W2t + (size_t)kv * 64 * 256 + (size_t)(16 * wave + arow) * 256 + kq * 8; f32x4 c = {0.f, 0.f, 0.f, 0.f};
#pragma unroll
            for (int ks = 0; ks < 8; ++ks) { const bf16x8 av = *(const LAS bf16x8*)(hid + arow * 264 + kq * 8 + ks * 32), bv = *(const bf16x8*)(bp + ks * 32); c = __builtin_amdgcn_mfma_f32_16x16x32_bf16(av, bv, c, 0, 0, 0); }
            const int col = 16 * wave + arow; const float bb = cb2[kv * 64 + col];
#pragma unroll
            for (int j = 0; j < 4; ++j) { const int n = 16 * nt + kq * 4 + j; KC[((size_t)(kv * 4 + bgi) * 512 + n) * 64 + col] = n < 511 ? (bf16_t)(cvtpk(c[j] + bb, 0.f) & 0xffffu) : (bf16_t)0; }
        }
        LBAR();
    }
    const int gt = blockIdx.x * 512 + tid, NGT = G * 512;
    { const bf16_t* MoK = (const bf16_t*)(ws + WS_MO) + att::MO_STRIDE; bf16_t* KM = (bf16_t*)(ws + WS_KM); LAS float* part = (LAS float*)(lds + 16384);
      for (int blk = blockIdx.x; blk < 256; blk += G) { const bf16_t* p = MoK + ((size_t)blk * 256 + 32 * wave) * 64 + lane; float s = 0.f;
#pragma unroll
          for (int r = 0; r < 32; ++r) s += __uint_as_float((unsigned)p[(size_t)r * 64] << 16);
          part[wave * 64 + lane] = s;
          LBAR();
          if (wave == 0) { float t = 0.f;
#pragma unroll
              for (int w = 0; w < 8; ++w) t += part[w * 64 + lane];
              KM[(size_t)blk * 64 + lane] = (bf16_t)(cvtpk(t * (1.0f / 256.0f), 0.f) & 0xffffu); }
          LBAR(); } }
    { const bf16_t* U = (const bf16_t*)(ws + WS_U); bf16_t* Abr = (bf16_t*)(ws + WS_XB);
      for (int e = gt; e < MTOK * 32; e += NGT) { const int row = e >> 5, c8 = e & 31, s = row & (SEQ - 1), w = 2 << (c8 >> 3), cnt = (s + 1 < w) ? s + 1 : w;
          float acc[8] = {0.f, 0.f, 0.f, 0.f, 0.f, 0.f, 0.f, 0.f}; u32x4 v0 = {0u, 0u, 0u, 0u};
#pragma unroll
          for (int i0 = 0; i0 < 16; i0 += 8) { if (i0 >= cnt) break; u32x4 v[8];
#pragma unroll
              for (int i = 0; i < 8; ++i) v[i] = (i0 + i < cnt) ? *(const u32x4*)(U + (size_t)(row - i0 - i) * 256 + c8 * 8) : (u32x4){0u, 0u, 0u, 0u};
              if (i0 == 0) v0 = v[0];
#pragma unroll
              for (int i = 0; i < 8; ++i)
#pragma unroll
                  for (int q = 0; q < 4; ++q) { acc[2 * q] += bflo(v[i][q]); acc[2 * q + 1] += bfhi(v[i][q]); } }
          const float ic = 1.0f / (float)cnt; u32x4 o;
#pragma unroll
          for (int q = 0; q < 4; ++q) o[q] = cvtpk(acc[2 * q] * ic - bflo(v0[q]), acc[2 * q + 1] * ic - bfhi(v0[q]));
          *(u32x4*)(Abr + (size_t)row * DM + c8 * 8) = o; } }
}
#ifndef DUP
#define DUP 0
#endif
__global__ void __launch_bounds__(512, 2) fwd_megakernel(Args a) {
    extern __shared__ __attribute__((aligned(16))) unsigned char lds_raw[];
    LAS unsigned char* lds = (LAS unsigned char*)lds_raw;
    cg::grid_group grid = cg::this_grid();
    const int G = gridDim.x;
    volatile LAS unsigned* bst = (volatile LAS unsigned*)(lds + LDS_BYTES - 64);
    if (threadIdx.x < 16) bst[threadIdx.x] = 0u;
    __syncthreads();
    const ArgsP ap0 = (ArgsP)__builtin_amdgcn_kernarg_segment_ptr();
#define PHASE_ARGS ArgsP a_ = ap0; asm volatile("" : "+s"(a_)); unsigned char* ws = a_->ws; unsigned* ctl = (unsigned*)(ws + WS_CTL); float* ssp = (float*)(ws + WS_SSP); const float* tab = (const float*)(ws + WS_TAB); \
    bf16_t* XB = (bf16_t*)(ws + WS_XB); bf16_t* BIG = (bf16_t*)(ws + WS_BIG); bf16_t* MRG = (bf16_t*)(ws + WS_MRG); (void)ctl; (void)ssp; (void)tab; (void)XB; (void)BIG; (void)MRG;
    XcdBarrier xbar = xcd_barrier_post((unsigned*)(ap0->ws + WS_BAR), bst);
    bool first_sync = true;
#define GRID_SYNC() do { if (first_sync) { grid.sync(); first_sync = false; } else xcd_barrier(xbar); } while (0)
    for (int l = 0; l < DEPTH; ++l) {
        int tid_ = threadIdx.x; asm volatile("" : "+v"(tid_));
        const int tid = tid_, lane = tid & 63, wave = __builtin_amdgcn_readfirstlane(tid >> 6), gw = blockIdx.x * 8 + wave, NGW = G * 8;
        for (int rep = 0; rep < ((DUP & 1) ? 2 : 1); ++rep) { PHASE_ARGS phase0(a_, l, lds, tid, lane, wave, gw, NGW); }
        GRID_SYNC();
        for (int rep = 0; rep < ((DUP & 2) ? 2 : 1); ++rep) { PHASE_ARGS pg8::Gemm g{XB, (const bf16_t*)(ws + WS_W + OFF_WIN), MTOK, NIN, DM}; pg8::StaticOrder S; S.init(MTOK, NIN, G, (int)blockIdx.x);
          EpiInProj E{ssp, (const float*)(ws + WS_W + OFF_BIN), tab, (bf16_t*)(ws + WS_U), (bf16_t*)(ws + WS_QN), (bf16_t*)(ws + WS_KV), (bf16_t*)(ws + WS_MO), BIG, (bf16_t*)(ws + WS_GN)};
          pg8::gemm_phase(lds, g, S, E); }
        GRID_SYNC();
        for (int rep = 0; rep < ((DUP & 4) ? 2 : 1); ++rep) { PHASE_ARGS phase2(a_, lds, tid, lane, wave, G); }
        GRID_SYNC();
        for (int rep = 0; rep < ((DUP & 8) ? 2 : 1); ++rep) { PHASE_ARGS
          att::Bufs B{(const bf16_t*)(ws + WS_QN), (const bf16_t*)(ws + WS_KV), (const bf16_t*)(ws + WS_MO), (const bf16_t*)(ws + WS_KC), (const bf16_t*)(ws + WS_KM), (const bf16_t*)(ws + WS_GN), XB};
          const int* order = (const int*)(ws + WS_ORDER); LAS int* slot = (LAS int*)(lds + att::L_END);
          if (wave >= 4) __builtin_amdgcn_s_setprio(1);
          for (;;) {
              LBAR();
              if (tid == 0) slot[0] = (int)atomicAdd(ctl + l + 2 * rep, 1u);
              LBAR();
              const int item = slot[0];
              if (item >= 768) break;
              const int id = order[item];
              int tl = threadIdx.x; asm volatile("" : "+v"(tl));
              const int tid = tl, lane = tid & 63, wave = __builtin_amdgcn_readfirstlane(tid >> 6);
              att::Ctx C; C.lds = (LAS char*)lds; C.wsf = (LAS float*)(lds + att::L_WSF) + wave * 64; C.otl = (LAS float*)(lds + att::L_OT) + wave * 2048 + lane; C.tid = tid; C.wid = wave; C.lane = lane; C.r32 = lane & 31; C.hi = lane >> 5;
              C.vbl = ((lane >> 4) & 1) * 32 + (lane & 3) * 8 + (4 * (lane >> 5) + ((lane & 15) >> 2)) * 64;
#ifdef DUPSEL
              if (rep == 1 && ((id < 512) != (DUPSEL == 1))) continue;
#endif
              if (id < 512) att::nsa_item(C, B, id >> 8, (id >> 7) & 1, id & 127);
              else { const int x = id - 512; att::moba_item(C, B, x >> 7, (x >> 5) & 3, x & 31); }
          }
          __builtin_amdgcn_s_setprio(0); }
        GRID_SYNC();
        for (int rep = 0; rep < ((DUP & 16) ? 2 : 1); ++rep) { PHASE_ARGS pg8::Gemm g{XB, (const bf16_t*)(ws + WS_W + OFF_WBR), MTOK, DM, DM}; pg8::StaticOrder S; S.init(MTOK, DM, G, (int)blockIdx.x);
          EpiBranch E{BIG, MRG}; pg8::gemm_phase(lds, g, S, E); }
        GRID_SYNC();
        { PHASE_ARGS pg8::Gemm g{MRG, (const bf16_t*)(ws + WS_W + OFF_WOUT), MTOK, DM, DM}; pg8::StaticOrder S; S.init(MTOK, DM, G, (int)blockIdx.x);
          bf16_t* RES = (bf16_t*)a_->out; EpiResid E{l == 0 ? a_->in[0] : nullptr, RES, XB, nullptr, ssp};   pg8::gemm_phase(lds, g, S, E); }
        GRID_SYNC();
        for (int rep = 0; rep < ((DUP & 64) ? 2 : 1); ++rep) { PHASE_ARGS pg8::Gemm g{XB, (const bf16_t*)(ws + WS_W + OFF_WGU), MTOK, NGU, DM}; pg8::StaticOrder S; S.init(MTOK, NGU, G, (int)blockIdx.x);
          EpiSwiGLU E{ssp, BIG}; pg8::gemm_phase(lds, g, S, E); }
        GRID_SYNC();
        { PHASE_ARGS pg8::Gemm g{BIG, (const bf16_t*)(ws + WS_W + OFF_WD), MTOK, DM, DFF}; pg8::StaticOrder S; S.init(MTOK, DM, G, (int)blockIdx.x);
          bf16_t* RES = (bf16_t*)a_->out; EpiResid E{nullptr, XB, XB, l + 1 < DEPTH ? RES : nullptr, ssp};   pg8::gemm_phase(lds, g, S, E); }
        GRID_SYNC();
    }
    { PHASE_ARGS const float* fn = a_->in[19]; float* outp = a_->out; const int lane = threadIdx.x & 63, gw = blockIdx.x * 8 + (threadIdx.x >> 6), NGW = G * 8;
      for (int m = gw; m < MTOK; m += NGW) { const float rstd = row_rstd(ssp, m); const u32x2* xr = (const u32x2*)(XB + (size_t)m * DM) + lane; f32x4* orow = (f32x4*)(outp + (size_t)m * DM) + lane; const f32x4* gr = (const f32x4*)fn + lane;
#pragma unroll
          for (int j = 0; j < 4; ++j) { const u32x2 w = xr[64 * j]; const f32x4 v = {bflo(w[0]), bfhi(w[0]), bflo(w[1]), bfhi(w[1])}; orow[64 * j] = v * rstd * gr[64 * j]; } } }
}

extern "C" void kernel_launch(void* const* d_in, const int* in_sizes, int n_in, void* d_out, int out_size, void* d_ws, size_t ws_size, hipStream_t stream) {
    static int grid = 0;
    if (grid == 0) {
        if (n_in != 20 || in_sizes[0] != MTOK * DM || out_size != MTOK * DM || ws_size < WS_END) { fprintf(stderr, "kernel_launch: unexpected shapes / workspace (n_in %d, ws %zu)\n", n_in, ws_size); grid = -1; return; }
        int dev = 0, cus = 0, per_cu = 0;
        if (hipGetDevice(&dev) != hipSuccess || hipDeviceGetAttribute(&cus, hipDeviceAttributeMultiprocessorCount, dev) != hipSuccess) { grid = -1; return; }
        if (hipFuncSetAttribute((const void*)fwd_megakernel, hipFuncAttributeMaxDynamicSharedMemorySize, LDS_BYTES) != hipSuccess) { fprintf(stderr, "kernel_launch: hipFuncSetAttribute failed\n"); grid = -1; return; }
        if (hipOccupancyMaxActiveBlocksPerMultiprocessor(&per_cu, (const void*)fwd_megakernel, 512, LDS_BYTES) != hipSuccess || per_cu < 1) { fprintf(stderr, "kernel_launch: occupancy query failed (%d)\n", per_cu); (void)hipGetLastError(); grid = -1; return; }
        grid = cus * per_cu;
    }
    if (grid < 0) return;
    if (hipMemsetAsync((char*)d_ws + WS_CTL, 0, 32768, stream) != hipSuccess) { fprintf(stderr, "kernel_launch: memset failed\n"); return; }
    Args a{};
    for (int i = 0; i < 20; ++i) a.in[i] = (const float*)d_in[i];
    a.out = (float*)d_out; a.ws = (unsigned char*)d_ws;
    void* args[] = {&a};
    const hipError_t e = hipLaunchCooperativeKernel((const void*)fwd_megakernel, dim3(grid), dim3(512), args, LDS_BYTES, stream);
    if (e != hipSuccess) fprintf(stderr, "kernel_launch: cooperative launch failed: %s (grid %d)\n", hipGetErrorString(e), grid);
}
```

```cpp
#include <hip/hip_runtime.h>
#include <hip/hip_cooperative_groups.h>
#include <cstdio>
#include <cstdint>
#include <cmath>
namespace cg = cooperative_groups;

#define LAS __attribute__((address_space(3)))
typedef unsigned short bf16_t;
typedef short bf16x8 __attribute__((ext_vector_type(8)));
typedef short s16x4 __attribute__((ext_vector_type(4)));
typedef float f32x2 __attribute__((ext_vector_type(2)));
typedef float f32x4 __attribute__((ext_vector_type(4)));
typedef float f32x16 __attribute__((ext_vector_type(16)));
typedef unsigned u32x4 __attribute__((ext_vector_type(4)));
typedef unsigned u32x2 __attribute__((ext_vector_type(2)));
typedef __bf16 bf16x2_t __attribute__((ext_vector_type(2)));

constexpr int SEQ = 8192, BATCH = 2, MTOK = BATCH * SEQ, DM = 1024, DEPTH = 2;
constexpr int IN_COLS = 5400, NIN = 5632, DFF = 2816, NGU = 5632;
constexpr float RMS_EPS = 1e-6f;
constexpr float QSCALE = 0.125f * 1.4426950408889634f;

__device__ __forceinline__ unsigned cvtpk(float lo, float hi) { f32x2 v = {lo, hi}; bf16x2_t b = __builtin_convertvector(v, bf16x2_t); return __builtin_bit_cast(unsigned, b); }
__device__ __forceinline__ float bflo(unsigned w) { return __uint_as_float(w << 16); }
__device__ __forceinline__ float bfhi(unsigned w) { return __uint_as_float(w & 0xffff0000u); }
__device__ __forceinline__ float sigmoidf_(float x) { return __builtin_amdgcn_rcpf(1.f + __expf(-x)); }

namespace pg8 {
constexpr int BM = 256, BK = 64, HALF = 128, HTB = HALF * BK * 2, STAGE_BYTES = 8 * HTB, NXCD = 8, WGM = 8;
__host__ __device__ __forceinline__ int lds_byte(int r, int c) { const int st = (r >> 4) * 2 + (c >> 5), rr = r & 15, cc = c & 31, ob = rr * 64 + cc * 2; return st * 1024 + (ob ^ (((ob >> 9) & 1) << 5)); }
__host__ __device__ __forceinline__ void stage_rc(int b, int& R, int& C) { const int st = b / 1024, sb = b % 1024, swz = sb ^ (((sb >> 9) & 1) << 5); R = (st >> 1) * 16 + swz / 64; C = (st & 1) * 32 + (swz % 64) / 2; }
__host__ __device__ __forceinline__ int perm32(int rho) { const int n = rho >> 4, i = rho & 15; return 8 * (i >> 2) + 4 * n + (i & 3); }
struct Unit { int pm, pn; };
struct Gemm { const bf16_t* A; const bf16_t* Bt; int M, N, K; };
struct StaticOrder {
    int nM, nN, nwg, G, c;
    __host__ __device__ void init(int M, int N, int G_, int c_) { nM = M / BM; nN = N / BM; nwg = nM * nN; G = G_; c = c_; }
    __host__ __device__ bool next(int i, Unit& u) const {
        const long L = (long)i * G + c; if (L >= nwg) return false;
        int wgid = (int)L; { const int q = nwg / NXCD, r = nwg % NXCD, xcd = wgid % NXCD, off = wgid / NXCD; wgid = (xcd < r ? xcd * (q + 1) : r * (q + 1) + (xcd - r) * q) + off; }
        const int nig = WGM * nN, gid = wgid / nig, fm = gid * WGM, gsz = (nM - fm) < WGM ? (nM - fm) : WGM;
        u.pm = fm + ((wgid % nig) % gsz); u.pn = (wgid % nig) / gsz; return true;
    }
};
template <class Epi, class Sched>
__device__ __forceinline__ void gemm_phase(LAS unsigned char* lds, const Gemm g, const Sched& S, const Epi& E) {
    int tid_ = threadIdx.x; asm volatile("" : "+v"(tid_));
    const int tid = tid_, wid = __builtin_amdgcn_readfirstlane(tid >> 6), lane = tid & 63, wr = wid >> 2, wc = wid & 3, fr = lane & 15, fq = lane >> 4;
    const int K = g.K, nt = K / BK;
    unsigned voffA[2], voffB[2];
#pragma unroll
    for (int i = 0; i < 2; ++i) { int R, C; stage_rc(tid * 16 + i * 8192, R, C); const int Rb = ((R & ~31) + perm32(R & 31));
        voffA[i] = (unsigned)(R * K + C) * 2u; voffB[i] = (unsigned)(Rb * K + C) * 2u; }
    const size_t kstep = (size_t)(BK * 2);
    const size_t hstep = (size_t)HALF * K * 2;
    const size_t tstep = 2 * hstep;
    const unsigned ldsw = (unsigned)wid * 1024u;
    const int aoff = lds_byte(wr * 64 + fr, fq * 8), boff = lds_byte(wc * 32 + fr, fq * 8);
#define PG8_SA(b, h) (((b) * 2 + (h)) * HTB)
#define PG8_SB(b, h) ((4 + (b) * 2 + (h)) * HTB)
#define PG8_STAGE(bufoff, gbase, voff) do { _Pragma("unroll") for (int _i = 0; _i < 2; ++_i) \
        __builtin_amdgcn_global_load_lds((const unsigned*)((const char*)(gbase) + (voff)[_i]), (LAS unsigned*)(lds + (bufoff) + ldsw + _i * 8192), 16, 0, 0); } while (0)
#define PG8_LDA(dst, b, h) do { _Pragma("unroll") for (int m = 0; m < 4; ++m) _Pragma("unroll") for (int k = 0; k < 2; ++k) dst[m][k] = *(const LAS bf16x8*)(lds + PG8_SA(b, h) + aoff + m * 2048 + k * 1024); } while (0)
#define PG8_LDB(dst, b, h) do { _Pragma("unroll") for (int n = 0; n < 2; ++n) _Pragma("unroll") for (int k = 0; k < 2; ++k) dst[n][k] = *(const LAS bf16x8*)(lds + PG8_SB(b, h) + boff + n * 2048 + k * 1024); } while (0)
#define PG8_MMA(ai, bj, At, Bt) do { __builtin_amdgcn_s_setprio(1); _Pragma("unroll") for (int m = 0; m < 4; ++m) _Pragma("unroll") for (int n = 0; n < 2; ++n) _Pragma("unroll") for (int k = 0; k < 2; ++k) \
        acc[ai][bj][m][n] = __builtin_amdgcn_mfma_f32_16x16x32_bf16(Bt[n][k], At[m][k], acc[ai][bj][m][n], 0, 0, 0); __builtin_amdgcn_s_setprio(0); } while (0)
#define PG8_WAIT_V(n) asm volatile("s_waitcnt vmcnt(" #n ")" ::: "memory")
#define PG8_WAIT_L(n) asm volatile("s_waitcnt lgkmcnt(" #n ")" ::: "memory")
#define PG8_BAR __builtin_amdgcn_s_barrier()
#define PG8_SCHED __builtin_amdgcn_sched_barrier(0)
    Unit cur, nxt; int ui = 0;
    if (!S.next(0, cur)) return;
    f32x4 acc[2][2][4][2];
#pragma unroll
    for (int a = 0; a < 2; ++a)
#pragma unroll
        for (int b = 0; b < 2; ++b)
#pragma unroll
            for (int m = 0; m < 4; ++m)
#pragma unroll
                for (int n = 0; n < 2; ++n) acc[a][b][m][n] = (f32x4){0.f, 0.f, 0.f, 0.f};
    bf16x8 At[4][2], B0[2][2], B1[2][2];
    const char* cA = (const char*)g.A + (size_t)cur.pm * tstep; const char* cB = (const char*)g.Bt + (size_t)cur.pn * tstep;
    PG8_STAGE(PG8_SB(0, 0), cB, voffB); PG8_STAGE(PG8_SB(0, 1), cB + hstep, voffB); PG8_STAGE(PG8_SA(0, 0), cA, voffA); PG8_STAGE(PG8_SA(0, 1), cA + hstep, voffA);
    if (wr == 1) PG8_BAR;
    PG8_WAIT_V(2); PG8_BAR;
    PG8_STAGE(PG8_SB(1, 0), cB + kstep, voffB); PG8_STAGE(PG8_SA(1, 0), cA + kstep, voffA); PG8_STAGE(PG8_SB(1, 1), cB + hstep + kstep, voffB);
    PG8_WAIT_V(6); PG8_BAR;
    for (;;) {
        const bool has_next = S.next(ui + 1, nxt);
        const char* nA = has_next ? (const char*)g.A + (size_t)nxt.pm * tstep : cA; const char* nB = has_next ? (const char*)g.Bt + (size_t)nxt.pn * tstep : cB;
        for (int t = 0; t < nt; t += 2) {
            const bool last = (t == nt - 2);
            const char* a1 = cA + (size_t)(t + 1) * kstep;
            const char* a2 = last ? nA : cA + (size_t)(t + 2) * kstep; const char* b2 = last ? nB : cB + (size_t)(t + 2) * kstep;
            const char* a3 = a2 + kstep; const char* b3 = b2 + kstep;
            if constexpr (Epi::KHOOK) { if (t == 4 || t == 12) { PG8_SCHED; E.khook(acc, cur, t, wr, wc, fr, fq); PG8_SCHED; } }
            PG8_LDB(B0, 0, 0); PG8_LDB(B1, 0, 1); PG8_SCHED; PG8_LDA(At, 0, 0); PG8_STAGE(PG8_SA(1, 1), a1 + hstep, voffA);
            PG8_WAIT_V(8); PG8_WAIT_L(0); PG8_BAR; PG8_MMA(0, 0, At, B0); PG8_MMA(0, 1, At, B1); PG8_BAR; PG8_SCHED;
            PG8_LDA(At, 0, 1); PG8_STAGE(PG8_SB(0, 0), b2, voffB); PG8_STAGE(PG8_SB(0, 1), b2 + hstep, voffB); PG8_STAGE(PG8_SA(0, 0), a2, voffA);
            PG8_WAIT_V(8); PG8_WAIT_L(0); PG8_BAR; PG8_MMA(1, 0, At, B0); PG8_MMA(1, 1, At, B1); PG8_BAR; PG8_SCHED;
            PG8_LDB(B0, 1, 0); PG8_LDB(B1, 1, 1); PG8_SCHED; PG8_LDA(At, 1, 0); PG8_STAGE(PG8_SA(0, 1), a2 + hstep, voffA);
            PG8_WAIT_V(8); PG8_WAIT_L(0); PG8_BAR; PG8_MMA(0, 0, At, B0); PG8_MMA(0, 1, At, B1); PG8_BAR; PG8_SCHED;
            PG8_LDA(At, 1, 1); PG8_STAGE(PG8_SB(1, 0), b3, voffB); PG8_STAGE(PG8_SB(1, 1), b3 + hstep, voffB); PG8_STAGE(PG8_SA(1, 0), a3, voffA);
            PG8_WAIT_V(8); PG8_WAIT_L(0); PG8_BAR; PG8_MMA(1, 0, At, B0); PG8_MMA(1, 1, At, B1); PG8_BAR; PG8_SCHED;
        }
        if (wr == 0) PG8_BAR;
        E(acc, cur, wr, wc, fr, fq);
        if (!has_next) break;
#pragma unroll
        for (int a = 0; a < 2; ++a)
#pragma unroll
            for (int b = 0; b < 2; ++b)
#pragma unroll
                for (int m = 0; m < 4; ++m)
#pragma unroll
                    for (int n = 0; n < 2; ++n) acc[a][b][m][n] = (f32x4){0.f, 0.f, 0.f, 0.f};
        cur = nxt; cA = nA; cB = nB; ++ui;
        if (wr == 1) PG8_BAR;
    }
    PG8_WAIT_V(0);
    PG8_BAR;
#undef PG8_SA
#undef PG8_SB
#undef PG8_STAGE
#undef PG8_LDA
#undef PG8_LDB
#undef PG8_MMA
#undef PG8_WAIT_V
#undef PG8_WAIT_L
#undef PG8_BAR
#undef PG8_SCHED
}
}
using pg8::Unit;
__device__ __forceinline__ float row_rstd(const float* ssp, int row) {
    const f32x4* p = (const f32x4*)(ssp + (size_t)row * 16);
    const f32x4 a = p[0], b = p[1], c = p[2], d = p[3];
    const float ss = ((a[0] + a[1]) + (a[2] + a[3])) + ((b[0] + b[1]) + (b[2] + b[3])) + ((c[0] + c[1]) + (c[2] + c[3])) + ((d[0] + d[1]) + (d[2] + d[3]));
    return 1.0f / sqrtf(ss * (1.0f / DM) + RMS_EPS);
}
__device__ __forceinline__ float row_rstd4(const float* ssp, int row, int fq) {
    const f32x4 a = *((const f32x4*)(ssp + (size_t)row * 16) + fq);
    float ss = (a[0] + a[1]) + (a[2] + a[3]);
    ss += __shfl_xor(ss, 16); ss += __shfl_xor(ss, 32);
    return 1.0f / sqrtf(ss * (1.0f / DM) + RMS_EPS);
}
__device__ __forceinline__ u32x4 pack8(const f32x4 a, const f32x4 b) { u32x4 w; w.x = cvtpk(a[0], a[1]); w.y = cvtpk(a[2], a[3]); w.z = cvtpk(b[0], b[1]); w.w = cvtpk(b[2], b[3]); return w; }
__device__ __forceinline__ void rope8(f32x4& v0, f32x4& v1, const float* tab, int t, int pos, float sc) {
    const f32x4* cs = (const f32x4*)(tab + ((size_t)t * 32 + (pos >> 1)) * 2);
    const f32x4 c0 = cs[0], c1 = cs[1];
    f32x4 o0, o1;
    o0[0] = (v0[0] * c0[0] - v0[1] * c0[1]) * sc; o0[1] = (v0[1] * c0[0] + v0[0] * c0[1]) * sc;
    o0[2] = (v0[2] * c0[2] - v0[3] * c0[3]) * sc; o0[3] = (v0[3] * c0[2] + v0[2] * c0[3]) * sc;
    o1[0] = (v1[0] * c1[0] - v1[1] * c1[1]) * sc; o1[1] = (v1[1] * c1[0] + v1[0] * c1[1]) * sc;
    o1[2] = (v1[2] * c1[2] - v1[3] * c1[3]) * sc; o1[3] = (v1[3] * c1[2] + v1[2] * c1[3]) * sc;
    v0 = o0; v1 = o1;
}
struct EpiInProj {
    static constexpr bool KHOOK = false;
    const float* ssp; const float* bias; const float* tab;
    bf16_t *U, *Qn, *KV, *Mo, *G, *Gn;
    __device__ __forceinline__ void operator()(const f32x4 (&acc)[2][2][4][2], const Unit& u, int wr, int wc, int fr, int fq) const {
        asm volatile("" : "+v"(fr), "+v"(fq));
        const int pn = u.pn;
        f32x4 bia[2][2];
#pragma unroll
        for (int bj = 0; bj < 2; ++bj) { const int gc = pn * 256 + bj * 128 + wc * 32 + 8 * fq; bia[bj][0] = *(const f32x4*)(bias + gc); bia[bj][1] = *(const f32x4*)(bias + gc + 4); }
        float rs[2][4];
#pragma unroll
        for (int ai = 0; ai < 2; ++ai)
#pragma unroll
            for (int m = 0; m < 4; ++m) rs[ai][m] = row_rstd4(ssp, u.pm * 256 + ai * 128 + wr * 64 + m * 16 + fr, fq);
#pragma unroll
        for (int ai = 0; ai < 2; ++ai)
#pragma unroll
            for (int m = 0; m < 4; ++m) {
                const int row = u.pm * 256 + ai * 128 + wr * 64 + m * 16 + fr;
                const float rstd = rs[ai][m];
                const int t = row & (SEQ - 1), b = row >> 13;
#pragma unroll
                for (int bj = 0; bj < 2; ++bj) {
                    const int cit = bj * 128 + wc * 32 + 8 * fq;
                    f32x4 v0 = acc[ai][bj][m][0] * rstd + bia[bj][0], v1 = acc[ai][bj][m][1] * rstd + bia[bj][1];
                    bf16_t* dst;
                    if (pn == 0) { dst = U + (size_t)row * 256 + cit; }
                    else if (pn <= 2) { const int c2 = (pn - 1) * 256 + cit, head = c2 >> 6, pos = c2 & 63; rope8(v0, v1, tab, t, pos, QSCALE); dst = Qn + ((size_t)(b * 8 + head) * SEQ + t) * 64 + pos; }
                    else if (pn <= 5) { const int c2 = cit & 127, g = c2 >> 6, pos = c2 & 63, kvi = 2 * (pn - 3) + bj; if (bj == 0) rope8(v0, v1, tab, t, pos, 1.f);
                        dst = KV + (size_t)kvi * ((size_t)MTOK * 128) + ((size_t)(b * 2 + g) * SEQ + t) * 64 + pos; }
                    else if (pn <= 8) { const int h = cit >> 6, pos = cit & 63; if (pn < 8) rope8(v0, v1, tab, t, pos, pn == 6 ? QSCALE : 1.f);
                        dst = Mo + (size_t)(pn - 6) * ((size_t)MTOK * 256) + ((size_t)(b * 4 + h) * SEQ + t) * 64 + pos; }
                    else if (pn <= 20) {
#pragma unroll
                        for (int e = 0; e < 4; ++e) { v0[e] = sigmoidf_(v0[e]); v1[e] = sigmoidf_(v1[e]); }
                        dst = G + (size_t)row * 3072 + (pn - 9) * 256 + cit; }
                    else {
#pragma unroll
                        for (int e = 0; e < 4; ++e) { v0[e] = sigmoidf_(v0[e]); v1[e] = sigmoidf_(v1[e]); }
                        dst = Gn + (size_t)row * 32 + (cit & 31); if (cit >= 32) dst = nullptr; }
                    if (dst) *(u32x4*)dst = pack8(v0, v1);
                }
                asm volatile("" ::: "memory");
            }
    }
};
struct EpiBranch {
    static constexpr bool KHOOK = true;
    const bf16_t* G; bf16_t* out;
    __device__ __forceinline__ void khook(f32x4 (&acc)[2][2][4][2], const Unit& u, int t, int wr, int wc, int fr, int fq) const {
        asm volatile("" : "+v"(fr), "+v"(fq));
        const int gsel = (t == 4) ? 0 : 1024;
#pragma unroll
        for (int ai = 0; ai < 2; ++ai)
#pragma unroll
            for (int m = 0; m < 4; ++m) {
                const int row = u.pm * 256 + ai * 128 + wr * 64 + m * 16 + fr;
#pragma unroll
                for (int bj = 0; bj < 2; ++bj) {
                    const int col = u.pn * 256 + bj * 128 + wc * 32 + 8 * fq;
                    const u32x4 gx = *(const u32x4*)(G + (size_t)row * 3072 + gsel + col), gy = *(const u32x4*)(G + (size_t)row * 3072 + gsel + 1024 + col);
#pragma unroll
                    for (int e = 0; e < 4; ++e) {
                        const float x0 = fmaxf(bflo(gx[e]), 1e-20f), x1 = fmaxf(bfhi(gx[e]), 1e-20f), y0 = fmaxf(bflo(gy[e]), 1e-20f), y1 = fmaxf(bfhi(gy[e]), 1e-20f);
                        const float r0 = x0 * __builtin_amdgcn_rcpf(y0), r1 = x1 * __builtin_amdgcn_rcpf(y1);
                        acc[ai][bj][m][e >> 1][(e & 1) * 2] *= r0; acc[ai][bj][m][e >> 1][(e & 1) * 2 + 1] *= r1;
                    }
                }
                asm volatile("" ::: "memory");
            }
    }
    __device__ __forceinline__ void operator()(const f32x4 (&acc)[2][2][4][2], const Unit& u, int wr, int wc, int fr, int fq) const {
        asm volatile("" : "+v"(fr), "+v"(fq));
#pragma unroll
        for (int ai = 0; ai < 2; ++ai)
#pragma unroll
            for (int m = 0; m < 4; ++m) {
                const int row = u.pm * 256 + ai * 128 + wr * 64 + m * 16 + fr;
#pragma unroll
                for (int bj = 0; bj < 2; ++bj) {
                    const int col = u.pn * 256 + bj * 128 + wc * 32 + 8 * fq;
                    const u32x4 gz = *(const u32x4*)(G + (size_t)row * 3072 + 2048 + col);
                    f32x4 v0 = acc[ai][bj][m][0], v1 = acc[ai][bj][m][1];
                    v0[0] *= fmaxf(bflo(gz[0]), 1e-20f); v0[1] *= fmaxf(bfhi(gz[0]), 1e-20f); v0[2] *= fmaxf(bflo(gz[1]), 1e-20f); v0[3] *= fmaxf(bfhi(gz[1]), 1e-20f);
                    v1[0] *= fmaxf(bflo(gz[2]), 1e-20f); v1[1] *= fmaxf(bfhi(gz[2]), 1e-20f); v1[2] *= fmaxf(bflo(gz[3]), 1e-20f); v1[3] *= fmaxf(bfhi(gz[3]), 1e-20f);
                    *(u32x4*)(out + (size_t)row * DM + col) = pack8(v0, v1);
                }
                asm volatile("" ::: "memory");
            }
    }
};
struct EpiResid {
    static constexpr bool KHOOK = false;
    const float* base_f; const bf16_t* base_b; bf16_t* xb; bf16_t* res; float* ssp;
    __device__ __forceinline__ void operator()(const f32x4 (&acc)[2][2][4][2], const Unit& u, int wr, int wc, int fr, int fq) const {
        asm volatile("" : "+v"(fr), "+v"(fq));
#pragma unroll
        for (int ai = 0; ai < 2; ++ai)
#pragma unroll
            for (int m = 0; m < 4; ++m) {
                const int row = u.pm * 256 + ai * 128 + wr * 64 + m * 16 + fr;
                float ss = 0.f;
#pragma unroll
                for (int bj = 0; bj < 2; ++bj) {
                    const size_t off = (size_t)row * DM + u.pn * 256 + bj * 128 + wc * 32 + 8 * fq;
                    f32x4 b0, b1;
                    if (base_f) { b0 = *(const f32x4*)(base_f + off); b1 = *(const f32x4*)(base_f + off + 4); }
                    else { const u32x4 w = *(const u32x4*)(base_b + off); b0 = (f32x4){bflo(w[0]), bfhi(w[0]), bflo(w[1]), bfhi(w[1])}; b1 = (f32x4){bflo(w[2]), bfhi(w[2]), bflo(w[3]), bfhi(w[3])}; }
                    const f32x4 v0 = acc[ai][bj][m][0] + b0, v1 = acc[ai][bj][m][1] + b1;
                    const u32x4 pk = pack8(v0, v1);
                    *(u32x4*)(xb + off) = pk;
                    if (res) *(u32x4*)(res + off) = pk;
                    ss += (v0[0] * v0[0] + v0[1] * v0[1]) + (v0[2] * v0[2] + v0[3] * v0[3]) + (v1[0] * v1[0] + v1[1] * v1[1]) + (v1[2] * v1[2] + v1[3] * v1[3]);
                }
                ss += __shfl_xor(ss, 16); ss += __shfl_xor(ss, 32);
                if (fq == 0) ssp[(size_t)row * 16 + u.pn * 4 + wc] = ss;
                if (m & 1) asm volatile("" ::: "memory");
            }
    }
};
struct EpiSwiGLU {
    static constexpr bool KHOOK = false;
    const float* ssp; bf16_t* H;
    __device__ __forceinline__ void operator()(const f32x4 (&acc)[2][2][4][2], const Unit& u, int wr, int wc, int fr, int fq) const {
        asm volatile("" : "+v"(fr), "+v"(fq));
        float rs[2][4];
#pragma unroll
        for (int ai = 0; ai < 2; ++ai)
#pragma unroll
            for (int m = 0; m < 4; ++m) rs[ai][m] = row_rstd4(ssp, u.pm * 256 + ai * 128 + wr * 64 + m * 16 + fr, fq);
#pragma unroll
        for (int ai = 0; ai < 2; ++ai)
#pragma unroll
            for (int m = 0; m < 4; ++m) {
                const int row = u.pm * 256 + ai * 128 + wr * 64 + m * 16 + fr;
                const float rstd = rs[ai][m];
                f32x4 o[2];
#pragma unroll
                for (int n = 0; n < 2; ++n)
#pragma unroll
                    for (int e = 0; e < 4; ++e) { const float gt = acc[ai][0][m][n][e] * rstd, up = acc[ai][1][m][n][e] * rstd; o[n][e] = gt * sigmoidf_(gt) * up; }
                *(u32x4*)(H + (size_t)row * DFF + u.pn * 128 + wc * 32 + 8 * fq) = pack8(o[0], o[1]);
                asm volatile("" ::: "memory");
            }
    }
};
namespace att {
constexpr int KCS = 1040, KSLOT = 8 * KCS, VSLOT = 8192;
constexpr int L_K0 = 0, L_V0 = 4 * KSLOT, L_WSF = 4 * KSLOT + 4 * VSLOT, L_MSK = L_WSF + 8 * 256, L_UNI = L_MSK + 1024, L_LIST = L_UNI + 64, L_END = L_LIST + 512,
              L_PS = L_END + 64, L_OT = L_PS, L_TOTAL = L_OT + 8 * 8192;
static_assert(L_TOTAL <= 147456 - 64, "attention LDS map");
#define LBAR() asm volatile("s_waitcnt lgkmcnt(0)\n\ts_barrier" ::: "memory")
#define LWAIT() asm volatile("s_waitcnt lgkmcnt(0)" ::: "memory")
__device__ __forceinline__ int crow(int r, int hi) { return (r & 3) + 8 * (r >> 2) + 4 * hi; }
__device__ __forceinline__ float swap_other(float v, int hi) { auto rr = __builtin_amdgcn_permlane32_swap(__float_as_uint(v), __float_as_uint(v), false, false); return __uint_as_float(hi ? rr[0] : rr[1]); }
__device__ __forceinline__ void qkt(f32x16& p0, f32x16& p1, const LAS char* Ks, const bf16x8* qr, const f32x16& cinit, int r32, int hi) {
    const LAS char* kb = Ks + hi * KCS + r32 * 16;
#pragma unroll
    for (int d0 = 0; d0 < 4; ++d0) {
        const bf16x8 b0 = *(const LAS bf16x8*)(kb + d0 * 2 * KCS), b1 = *(const LAS bf16x8*)(kb + d0 * 2 * KCS + 512);
        if (d0 == 0) { p0 = __builtin_amdgcn_mfma_f32_32x32x16_bf16(b0, qr[0], cinit, 0, 0, 0); p1 = __builtin_amdgcn_mfma_f32_32x32x16_bf16(b1, qr[0], cinit, 0, 0, 0); }
        else { p0 = __builtin_amdgcn_mfma_f32_32x32x16_bf16(b0, qr[d0], p0, 0, 0, 0); p1 = __builtin_amdgcn_mfma_f32_32x32x16_bf16(b1, qr[d0], p1, 0, 0, 0); } }
}
struct VFrag { s16x4 lo[8], hi[8]; };
typedef short v4i16_t __attribute__((ext_vector_type(4)));
__device__ __forceinline__ s16x4 vtr(const LAS char* p) { return __builtin_bit_cast(s16x4, __builtin_amdgcn_ds_read_tr16_b64_v4i16((LAS v4i16_t*)p)); }
__device__ __forceinline__ void v_issue(VFrag& F, const LAS char* vp) {
#pragma unroll
    for (int d0 = 0; d0 < 2; ++d0)
#pragma unroll
        for (int ks = 0; ks < 4; ++ks) { F.lo[d0 * 4 + ks] = vtr(vp + d0 * 4096 + ks * 1024); F.hi[d0 * 4 + ks] = vtr(vp + d0 * 4096 + ks * 1024 + 512); }
}
template <bool SUM> __device__ __forceinline__ void pv(f32x16* o, f32x16& osum, VFrag& F, bf16x8 pa0, bf16x8 pa1, bf16x8 pa2, bf16x8 pa3) {
#define PK(k) (bf16x8){F.lo[k][0], F.lo[k][1], F.lo[k][2], F.lo[k][3], F.hi[k][0], F.hi[k][1], F.hi[k][2], F.hi[k][3]}
    const bf16x8 ones = {0x3F80, 0x3F80, 0x3F80, 0x3F80, 0x3F80, 0x3F80, 0x3F80, 0x3F80};
    __builtin_amdgcn_s_setprio(1);
    o[0] = __builtin_amdgcn_mfma_f32_32x32x16_bf16(pa0, PK(0), o[0], 0, 0, 0);
    o[1] = __builtin_amdgcn_mfma_f32_32x32x16_bf16(pa0, PK(4), o[1], 0, 0, 0);
    if (SUM) osum = __builtin_amdgcn_mfma_f32_32x32x16_bf16(pa0, ones, osum, 0, 0, 0);
    o[0] = __builtin_amdgcn_mfma_f32_32x32x16_bf16(pa1, PK(1), o[0], 0, 0, 0);
    o[1] = __builtin_amdgcn_mfma_f32_32x32x16_bf16(pa1, PK(5), o[1], 0, 0, 0);
    if (SUM) osum = __builtin_amdgcn_mfma_f32_32x32x16_bf16(pa1, ones, osum, 0, 0, 0);
    o[0] = __builtin_amdgcn_mfma_f32_32x32x16_bf16(pa2, PK(2), o[0], 0, 0, 0);
    o[1] = __builtin_amdgcn_mfma_f32_32x32x16_bf16(pa2, PK(6), o[1], 0, 0, 0);
    if (SUM) osum = __builtin_amdgcn_mfma_f32_32x32x16_bf16(pa2, ones, osum, 0, 0, 0);
    o[0] = __builtin_amdgcn_mfma_f32_32x32x16_bf16(pa3, PK(3), o[0], 0, 0, 0);
    o[1] = __builtin_amdgcn_mfma_f32_32x32x16_bf16(pa3, PK(7), o[1], 0, 0, 0);
    if (SUM) osum = __builtin_amdgcn_mfma_f32_32x32x16_bf16(pa3, ones, osum, 0, 0, 0);
    __builtin_amdgcn_s_setprio(0);
#undef PK
}
__device__ __forceinline__ float rowmax(const f32x16& p0, const f32x16& p1, int hi) {
    float a = __builtin_fmaxf(p0[0], p1[0]);
#pragma unroll
    for (int r = 1; r < 16; ++r) a = __builtin_fmaxf(__builtin_fmaxf(a, p0[r]), p1[r]);
    return __builtin_fmaxf(a, swap_other(a, hi));
}
struct KVRegs { u32x4 k, v; };
__device__ __forceinline__ void tile_load(KVRegs& R, const bf16_t* K, const bf16_t* V, int tid) { R.k = *(const u32x4*)(K + tid * 8); R.v = *(const u32x4*)(V + tid * 8); }
__device__ __forceinline__ void tile_store(const KVRegs& R, LAS char* Ks, LAS char* Vs, int tid) {
    const int row = tid >> 3, c = tid & 7;
    *(LAS u32x4*)(Ks + c * KCS + row * 16) = R.k;
    *(LAS u32x4*)(Vs + (c >> 2) * 4096 + (row >> 4) * 1024 + (row & 15) * 64 + (c & 3) * 16) = R.v;
}
__device__ __forceinline__ void ps_accum(const f32x16 p, int jb, LAS float* ps_row, bool writer) {
#pragma unroll
    for (int rg = 0; rg < 4; ++rg) {
        float a = 2.f * (p[4 * rg] + p[4 * rg + 1] + p[4 * rg + 2]) + p[4 * rg + 3], bq = p[4 * rg + 3];
        a += __shfl_xor(a, 1); a += __shfl_xor(a, 2); bq += __shfl_xor(bq, 1); bq += __shfl_xor(bq, 2);
        const int j = jb + 2 * rg;
        if (writer) { __hip_atomic_fetch_add(ps_row + j, a, __ATOMIC_RELAXED, __HIP_MEMORY_SCOPE_WORKGROUP); if (j + 1 < 128) __hip_atomic_fetch_add(ps_row + j + 1, bq, __ATOMIC_RELAXED, __HIP_MEMORY_SCOPE_WORKGROUP); }
    }
}
struct Ctx { LAS char* lds; LAS float* wsf; LAS float* otl; int tid, wid, lane, r32, hi, vbl; };
struct RowSt { float m, l; bool started; f32x16 negm, osum; };
__device__ __forceinline__ void rowst_init(RowSt& S) { S.m = 0.f; S.l = 0.f; S.started = false; S.negm = f32x16{}; S.osum = f32x16{}; asm volatile("" : "+v"(S.negm)); }
__device__ __forceinline__ void rowst_fixed(RowSt& S, float ref) { S.m = ref; S.l = 0.f; S.started = true; S.osum = f32x16{};
#pragma unroll
    for (int r = 0; r < 16; ++r) S.negm[r] = -ref;
    asm volatile("" : "+v"(S.negm)); }
template <int MODE, class Src, class Msk>
__device__ __forceinline__ void run_branch(const Ctx& C, int nt, const Src& src, const Msk& msk, const bf16x8* qr, RowSt& S, f32x16* o, LAS float* ps_row, bool ps_writer, KVRegs& R0, bool pre, const bf16_t* nk, const bf16_t* nv) {
    KVRegs R1; const bf16_t *kp, *vp;
    if (!pre) { src(0, kp, vp); tile_load(R0, kp, vp, C.tid); }
    if (nt > 1) { src(1, kp, vp); tile_load(R1, kp, vp, C.tid); }
    auto compute = [&](int it, const LAS char* Ks, const LAS char* Vs, int klo, int khi, bool nm) {
        const bool kill = khi < klo;
        if (!__any(!kill)) return;
        f32x16 p0, p1; qkt(p0, p1, Ks, qr, S.negm, C.r32, C.hi);
        VFrag VF; if constexpr (MODE != 0) v_issue(VF, Vs + C.vbl);
        if (__any(nm && !kill)) {
#pragma unroll
            for (int r = 0; r < 16; ++r) { const int kv = crow(r, C.hi); if (kv < klo || kv > khi) p0[r] = -INFINITY; if (kv + 32 < klo || kv + 32 > khi) p1[r] = -INFINITY; }
        }
        if constexpr (MODE != 2) {
            float rm = rowmax(p0, p1, C.hi); if (kill) rm = -INFINITY;
            const bool first = !S.started && rm > -INFINITY, grow = first || rm > 8.0f;
            if (__any(grow)) {
                const float d = grow ? rm : 0.f, alpha = first ? 1.0f : __builtin_amdgcn_exp2f(-d);
                S.m += d; S.started = S.started || first;
#pragma unroll
                for (int r = 0; r < 16; ++r) { S.negm[r] = -S.m; p0[r] -= d; p1[r] -= d; }
                if constexpr (MODE == 0) S.l *= alpha;
                if constexpr (MODE == 1) {
                    if (C.hi == 0) C.wsf[C.r32] = alpha;
                    LWAIT();
#pragma unroll
                    for (int r = 0; r < 16; ++r) { const float f = C.wsf[crow(r, C.hi)]; o[0][r] *= f; o[1][r] *= f; S.osum[r] *= f; }
                    LWAIT();
                }
            }
        }
#pragma unroll
        for (int r = 0; r < 16; ++r) { p0[r] = __builtin_amdgcn_exp2f(p0[r]); p1[r] = __builtin_amdgcn_exp2f(p1[r]); }
        if constexpr (MODE == 0) {
            float s = 0.f;
#pragma unroll
            for (int r = 0; r < 16; ++r) s += p0[r] + p1[r];
            S.l += kill ? 0.f : s;
        }
        if constexpr (MODE == 2) {
            if (__any(kill)) {
#pragma unroll
                for (int r = 0; r < 16; ++r) { p0[r] = kill ? 0.f : p0[r]; p1[r] = kill ? 0.f : p1[r]; }
            }
            ps_accum(p0, 16 * it + C.hi, ps_row, ps_writer); ps_accum(p1, 16 * it + 8 + C.hi, ps_row, ps_writer);
        }
        if constexpr (MODE != 0) {
            u32x4 w0 = {cvtpk(p0[0], p0[1]), cvtpk(p0[2], p0[3]), cvtpk(p0[4], p0[5]), cvtpk(p0[6], p0[7])}, w1 = {cvtpk(p0[8], p0[9]), cvtpk(p0[10], p0[11]), cvtpk(p0[12], p0[13]), cvtpk(p0[14], p0[15])};
            u32x4 w2 = {cvtpk(p1[0], p1[1]), cvtpk(p1[2], p1[3]), cvtpk(p1[4], p1[5]), cvtpk(p1[6], p1[7])}, w3 = {cvtpk(p1[8], p1[9]), cvtpk(p1[10], p1[11]), cvtpk(p1[12], p1[13]), cvtpk(p1[14], p1[15])};
            if constexpr (MODE == 1) {
                if (__any(kill)) {
#pragma unroll
                    for (int e = 0; e < 4; ++e) { w0[e] = kill ? 0u : w0[e]; w1[e] = kill ? 0u : w1[e]; w2[e] = kill ? 0u : w2[e]; w3[e] = kill ? 0u : w3[e]; }
                }
            }
            pv<MODE == 1>(o, S.osum, VF, __builtin_bit_cast(bf16x8, w0), __builtin_bit_cast(bf16x8, w1), __builtin_bit_cast(bf16x8, w2), __builtin_bit_cast(bf16x8, w3));
        }
    };
    LBAR();
    for (int it = 0; it < nt; it += 2) {
        const int p = (it >> 1) & 1; const bool two = it + 1 < nt;
        LAS char* KsA = C.lds + L_K0 + (2 * p) * KSLOT; LAS char* VsA = C.lds + L_V0 + (2 * p) * VSLOT;
        LAS char* KsB = KsA + KSLOT; LAS char* VsB = VsA + VSLOT;
        tile_store(R0, KsA, VsA, C.tid); if (two) tile_store(R1, KsB, VsB, C.tid);
        if (it + 2 < nt) { src(it + 2, kp, vp); tile_load(R0, kp, vp, C.tid); } else if (nk) tile_load(R0, nk, nv, C.tid);
        if (it + 3 < nt) { src(it + 3, kp, vp); tile_load(R1, kp, vp, C.tid); }
        int kloA, khiA, kloB = 0, khiB = -1; const bool nmA = msk(it, kloA, khiA); bool nmB = false; if (two) nmB = msk(it + 1, kloB, khiB);
        LBAR();
        compute(it, KsA, VsA, kloA, khiA, nmA);
        if (two) compute(it + 1, KsB, VsB, kloB, khiB, nmB);
    }
}
template <bool FIRST> __device__ __forceinline__ void merge_branch_n(const Ctx& C, const f32x16* o, const f32x16& osum, float gate) {
    if (C.hi == 0) C.wsf[C.r32] = gate;
    LWAIT();
#pragma unroll
    for (int r = 0; r < 16; ++r) { const float den = osum[r], f = den > 0.f ? C.wsf[crow(r, C.hi)] * __builtin_amdgcn_rcpf(den) : 0.f;
        if (FIRST) { C.otl[r * 64] = o[0][r] * f; C.otl[(16 + r) * 64] = o[1][r] * f; }
        else { C.otl[r * 64] += o[0][r] * f; C.otl[(16 + r) * 64] += o[1][r] * f; } }
    LWAIT();
}
template <bool FIRST> __device__ __forceinline__ void merge_branch(const Ctx& C, const f32x16* o, float factor) {
    if (C.hi == 0) C.wsf[C.r32] = factor;
    LWAIT();
#pragma unroll
    for (int r = 0; r < 16; ++r) { const float f = C.wsf[crow(r, C.hi)];
        if (FIRST) { C.otl[r * 64] = o[0][r] * f; C.otl[(16 + r) * 64] = o[1][r] * f; }
        else { C.otl[r * 64] += o[0][r] * f; C.otl[(16 + r) * 64] += o[1][r] * f; } }
    LWAIT();
}
struct Bufs { const bf16_t *Qn, *KV, *Mo, *KC, *KM, *Gn; bf16_t* Abr; };
constexpr size_t KV_STRIDE = (size_t)MTOK * 128, MO_STRIDE = (size_t)MTOK * 256;

__device__ __forceinline__ void nsa_item(const Ctx& C, const Bufs& B, int b, int g, int i) {
    const int r32 = C.r32, hi = C.hi, wid = C.wid;
    const int qi = 8 * wid + (r32 >> 2), hh = r32 & 3, head = g * 4 + hh, t = 64 * i + qi, cur = i;
    const size_t bg = (size_t)(b * 2 + g) * SEQ;
    bf16x8 qr[4];
    { const bf16_t* qp = B.Qn + ((size_t)(b * 8 + head) * SEQ + t) * 64 + hi * 8;
#pragma unroll
      for (int d0 = 0; d0 < 4; ++d0) qr[d0] = *(const bf16x8*)(qp + d0 * 16); }
    const unsigned gw = *(const unsigned*)(B.Gn + ((size_t)b * SEQ + t) * 32 + head * 3 - (head & 1));
    const unsigned gw2 = *(const unsigned*)(B.Gn + ((size_t)b * SEQ + t) * 32 + head * 3 - (head & 1) + 2);
    float g0, g1, g2; if (head & 1) { g0 = bfhi(gw); g1 = bflo(gw2); g2 = bfhi(gw2); } else { g0 = bflo(gw); g1 = bfhi(gw); g2 = bflo(gw2); }
    f32x16 o[2];
    LAS float* Ps = (LAS float*)(C.lds + L_PS); LAS unsigned* Mk = (LAS unsigned*)(C.lds + L_MSK); LAS unsigned* Uni = (LAS unsigned*)(C.lds + L_UNI); LAS int* List = (LAS int*)(C.lds + L_LIST);
    const int nv = t >= 31 ? ((t - 31) >> 4) + 1 : 0;
    const int nvt = (4 * i + 3 < 511) ? 4 * i + 3 : 511, ntc = (nvt + 63) >> 6;
    const bf16_t* kc = B.KC + (size_t)(0 * 4 + b * 2 + g) * 512 * 64; const bf16_t* vc = B.KC + (size_t)(1 * 4 + b * 2 + g) * 512 * 64;
    auto srcC = [&](int it, const bf16_t*& kp, const bf16_t*& vp) { kp = kc + (size_t)it * 4096; vp = vc + (size_t)it * 4096; };
    auto mskC = [&](int it, int& klo, int& khi) { klo = 0; khi = nv - 1 - 64 * it; return khi < 63; };
    RowSt S; rowst_init(S);
    KVRegs R;
    run_branch<0>(C, ntc, srcC, mskC, qr, S, o, nullptr, false, R, false, kc, vc);
    const float lt = S.l + swap_other(S.l, hi);
    rowst_fixed(S, lt > 0.f ? S.m + __builtin_amdgcn_logf(lt) : 0.f);
    for (int e = C.tid; e < 64 * 128; e += 512) Ps[e] = 0.f;
    if (C.tid < 8) Uni[C.tid] = 0u;
    o[0] = f32x16{}; o[1] = f32x16{};
    run_branch<2>(C, ntc, srcC, mskC, qr, S, o, Ps + qi * 128, hh == 0, R, true, B.KV + 2 * KV_STRIDE + bg * 64, B.KV + 3 * KV_STRIDE + bg * 64);
    LBAR();
    {
        const int nf = cur == 0 ? 1 : (cur == 1 ? 2 : 3), kp_ = 16 - nf, lane = C.lane;
#pragma unroll 1
        for (int qq = 0; qq < 8; ++qq) {
            int q = 8 * wid + qq; asm volatile("" : "+s"(q)); LAS float* ps = Ps + q * 128;
            const int j0 = lane, j1 = lane + 64;
            const bool f0 = (j0 == 0 || j0 == cur || j0 == cur - 1) && j0 <= cur, f1 = (j1 == cur || j1 == cur - 1) && j1 <= cur;
            const bool va0 = j0 <= cur && !f0, va1 = j1 <= cur && !f1;
            const unsigned k0 = va0 ? __float_as_uint(ps[j0]) + 1u : 0u, k1 = va1 ? __float_as_uint(ps[j1]) + 1u : 0u;
            unsigned T = 0u;
            for (int bit = 30; bit >= 0; --bit) { const unsigned cand = T | (1u << bit); const int cnt = __popcll(__ballot(k0 >= cand)) + __popcll(__ballot(k1 >= cand)); if (cnt >= kp_) T = cand; }
            const int need = kp_ - (__popcll(__ballot(k0 > T)) + __popcll(__ballot(k1 > T)));
            const unsigned long long t0 = __ballot(k0 == T), t1 = __ballot(k1 == T), below = (1ull << lane) - 1ull;
            const int pre0 = __popcll(t0 & below), pre1 = __popcll(t0) + __popcll(t1 & below);
            const bool s0 = f0 || (k0 > 0u && (k0 > T || (k0 == T && pre0 < need))), s1 = f1 || (k1 > 0u && (k1 > T || (k1 == T && pre1 < need)));
            const unsigned long long b0 = __ballot(s0), b1 = __ballot(s1);
            if (lane == 0) { Mk[q * 4 + 0] = (unsigned)b0; Mk[q * 4 + 1] = (unsigned)(b0 >> 32); Mk[q * 4 + 2] = (unsigned)b1; Mk[q * 4 + 3] = (unsigned)(b1 >> 32);
                __hip_atomic_fetch_or(&Uni[0], (unsigned)b0, __ATOMIC_RELAXED, __HIP_MEMORY_SCOPE_WORKGROUP); __hip_atomic_fetch_or(&Uni[1], (unsigned)(b0 >> 32), __ATOMIC_RELAXED, __HIP_MEMORY_SCOPE_WORKGROUP); __hip_atomic_fetch_or(&Uni[2], (unsigned)b1, __ATOMIC_RELAXED, __HIP_MEMORY_SCOPE_WORKGROUP); __hip_atomic_fetch_or(&Uni[3], (unsigned)(b1 >> 32), __ATOMIC_RELAXED, __HIP_MEMORY_SCOPE_WORKGROUP); }
        }
    }
    LBAR();
    if (C.tid == 0) { int n = 0; for (int w = 0; w < 4; ++w) { unsigned u = Uni[w]; while (u) { const int bpos = __builtin_ctz(u); u &= u - 1; List[n++] = w * 32 + bpos; } } Uni[4] = (unsigned)n; }
    LBAR();
    merge_branch<true>(C, o, g0);
    {
        const int nsel = (int)Uni[4];
        const bf16_t* ks = B.KV + 2 * KV_STRIDE + bg * 64; const bf16_t* vs = B.KV + 3 * KV_STRIDE + bg * 64;
        auto srcS = [&](int it, const bf16_t*& kp, const bf16_t*& vp) { const int j = List[it]; kp = ks + (size_t)j * 4096; vp = vs + (size_t)j * 4096; };
        auto mskS = [&](int it, int& klo, int& khi) { const int j = List[it]; const unsigned w = Mk[qi * 4 + (j >> 5)]; const bool bit = (w >> (j & 31)) & 1u;
            klo = 0; khi = bit ? (j == cur ? qi : 63) : -1; return j == cur; };
        rowst_init(S); o[0] = f32x16{}; o[1] = f32x16{};
        const int tw0n = i >= 8 ? i - 8 : 0;
        run_branch<1>(C, nsel, srcS, mskS, qr, S, o, nullptr, false, R, true, B.KV + 4 * KV_STRIDE + bg * 64 + (size_t)tw0n * 4096, B.KV + 5 * KV_STRIDE + bg * 64 + (size_t)tw0n * 4096);
        merge_branch_n<false>(C, o, S.osum, g1);
    }
    {
        const int tw0 = i >= 8 ? i - 8 : 0, ntw = i - tw0 + 1;
        const bf16_t* kw = B.KV + 4 * KV_STRIDE + bg * 64; const bf16_t* vw = B.KV + 5 * KV_STRIDE + bg * 64;
        auto srcW = [&](int it, const bf16_t*& kp, const bf16_t*& vp) { kp = kw + (size_t)(tw0 + it) * 4096; vp = vw + (size_t)(tw0 + it) * 4096; };
        auto mskW = [&](int it, int& klo, int& khi) { const int tw = tw0 + it; klo = (t - 511) - 64 * tw; khi = (tw == i) ? qi : 63; return tw == i || klo > 0; };
        rowst_init(S); o[0] = f32x16{}; o[1] = f32x16{};
        run_branch<1>(C, ntw, srcW, mskW, qr, S, o, nullptr, false, R, true, nullptr, nullptr);
        merge_branch_n<false>(C, o, S.osum, g2);
    }
#pragma unroll
    for (int r = 0; r < 16; ++r) { const int qrow = crow(r, hi); bf16_t* dst = B.Abr + ((size_t)b * SEQ + 64 * i + 8 * wid + (qrow >> 2)) * DM + 256 + (g * 4 + (qrow & 3)) * 64 + r32;
        dst[0] = (bf16_t)(cvtpk(C.otl[r * 64], 0.f) & 0xffffu); dst[32] = (bf16_t)(cvtpk(C.otl[(16 + r) * 64], 0.f) & 0xffffu); }
}
__device__ __forceinline__ void moba_item(const Ctx& C, const Bufs& B, int b, int h, int qb) {
    const int r32 = C.r32, hi = C.hi, wid = C.wid, own = qb, t = 256 * qb + 32 * wid + r32;
    const size_t bh = (size_t)(b * 4 + h) * SEQ;
    bf16x8 qr[4];
    { const bf16_t* qp = B.Mo + (bh + t) * 64 + hi * 8;
#pragma unroll
      for (int d0 = 0; d0 < 4; ++d0) qr[d0] = *(const bf16x8*)(qp + d0 * 16); }
    LAS unsigned* Uni = (LAS unsigned*)(C.lds + L_UNI); LAS int* List = (LAS int*)(C.lds + L_LIST);
    LBAR();
    if (C.tid < 256) { const u32x4 kmv = *(const u32x4*)(B.KM + (size_t)(b * 4 + h) * 2048 + C.tid * 8); *(LAS u32x4*)(C.lds + L_K0 + (C.tid & 7) * KCS + (C.tid >> 3) * 16) = kmv; }
    if (C.tid == 0) Uni[0] = 0u;
    LBAR();
    unsigned sel = 0u;
    {
        f32x16 gs = f32x16{};
        const LAS char* kb = C.lds + L_K0 + hi * KCS + r32 * 16;
#pragma unroll
        for (int d0 = 0; d0 < 4; ++d0) gs = __builtin_amdgcn_mfma_f32_32x32x16_bf16(*(const LAS bf16x8*)(kb + d0 * 2 * KCS), qr[d0], gs, 0, 0, 0);
        float lo[16], hv[16];
#pragma unroll
        for (int r = 0; r < 16; ++r) { const float ownv = gs[r], oth = swap_other(ownv, hi); lo[r] = hi ? oth : ownv; hv[r] = hi ? ownv : oth; }
        unsigned taken = ~((1u << own) - 1u);
#pragma unroll
        for (int round = 0; round < 3; ++round) {
            float best = -INFINITY; int bi = 32;
#pragma unroll
            for (int n = 0; n < 32; ++n) { const int rr = (n & 3) + 4 * (n >> 3); const float v = ((n >> 2) & 1) ? hv[rr] : lo[rr]; if (!((taken >> n) & 1u) && v > best) { best = v; bi = n; } }
            if (bi < 32) { sel |= 1u << bi; taken |= 1u << bi; }
        }
    }
    { unsigned u = sel;
#pragma unroll
      for (int o_ = 1; o_ < 64; o_ <<= 1) u |= (unsigned)__shfl_xor((int)u, o_);
      if (C.lane == 0) __hip_atomic_fetch_or(&Uni[0], u, __ATOMIC_RELAXED, __HIP_MEMORY_SCOPE_WORKGROUP); }
    LBAR();
    if (C.tid == 0) { int n = 0; unsigned u = Uni[0]; while (u) { const int bpos = __builtin_ctz(u); u &= u - 1; List[n++] = bpos; } Uni[4] = (unsigned)n; }
    LBAR();
    const int nl = (int)Uni[4], nt = 4 * nl + 4;
    const bf16_t* kk = B.Mo + MO_STRIDE + bh * 64; const bf16_t* vv = B.Mo + 2 * MO_STRIDE + bh * 64;
    auto src = [&](int it, const bf16_t*& kp, const bf16_t*& vp) { const int T = (it < 4 * nl) ? 4 * List[it >> 2] + (it & 3) : 4 * own + (it - 4 * nl); kp = kk + (size_t)T * 4096; vp = vv + (size_t)T * 4096; };
    auto msk = [&](int it, int& klo, int& khi) { klo = 0; if (it < 4 * nl) { const bool bit = (sel >> List[it >> 2]) & 1u; khi = bit ? 63 : -1; return false; } khi = 32 * wid + r32 - 64 * (it - 4 * nl); return true; };
    RowSt S; rowst_init(S); f32x16 o[2] = {f32x16{}, f32x16{}};
    KVRegs R;
    run_branch<1>(C, nt, src, msk, qr, S, o, nullptr, false, R, false, nullptr, nullptr);
    merge_branch_n<true>(C, o, S.osum, 1.0f);
#pragma unroll
    for (int r = 0; r < 16; ++r) { const int qrow = crow(r, hi); bf16_t* dst = B.Abr + ((size_t)b * SEQ + 256 * qb + 32 * wid + qrow) * DM + 768 + h * 64 + r32;
        dst[0] = (bf16_t)(cvtpk(C.otl[r * 64], 0.f) & 0xffffu); dst[32] = (bf16_t)(cvtpk(C.otl[(16 + r) * 64], 0.f) & 0xffffu); }
}
}
#define XB_TMO      128
#define XB_XCNT(j)  (256  + 64 * (j))
#define XB_XSUB(j)  (1280 + 64 * (j))
#define XB_XGEN(j)  (2304 + 64 * (j))
#define XB_TOP      3328
#define XB_TOPGEN   3392
#define XCD_BAR_WORDS 3456
#define XB_SPIN_CAP (1u << 18)

__device__ __forceinline__ unsigned xb_ld(unsigned* p)              { return __hip_atomic_load(p, __ATOMIC_RELAXED, __HIP_MEMORY_SCOPE_AGENT); }
__device__ __forceinline__ unsigned xb_add(unsigned* p, unsigned v) { return __hip_atomic_fetch_add(p, v, __ATOMIC_RELAXED, __HIP_MEMORY_SCOPE_AGENT); }
__device__ __forceinline__ unsigned xb_xcc_id() { return (unsigned)__builtin_amdgcn_s_getreg((3 << 11) | 20) & 0xFu; }
#define XB_SPIN(cond, bar) do { unsigned _sp = 0; while (cond) { __builtin_amdgcn_s_sleep(1); \
    if ((++_sp & 255u) == 0u) { if (xb_ld(&(bar)[XB_TMO])) break; if (_sp > XB_SPIN_CAP) { atomicAdd(&(bar)[XB_TMO], 1u); break; } } } } while (0)

struct XcdBarrier {
    unsigned* bar; unsigned x;
    volatile LAS unsigned* st;
};

__device__ __forceinline__ XcdBarrier xcd_barrier_post(unsigned* bar, volatile LAS unsigned* st) {
    XcdBarrier b; b.bar = bar; b.x = xb_xcc_id(); b.st = st;
    if (threadIdx.x == 0) (void)xb_add(&bar[XB_XCNT(b.x)], 1u);
    return b;
}
__device__ __forceinline__ void xcd_barrier_complete(unsigned* bar, unsigned x, unsigned& nloc, unsigned& nx) {
    const unsigned G = gridDim.x * gridDim.y * gridDim.z;
    unsigned sum, cnt, mine, sp = 0u;
    for (;;) {
        sum = 0u; cnt = 0u; mine = 0u;
#pragma unroll
        for (unsigned j = 0; j < 16; ++j) { const unsigned c = xb_ld(&bar[XB_XCNT(j)]); sum += c; cnt += (c > 0u) ? 1u : 0u; mine = (j == x) ? c : mine; }
        if (sum == G) break;
        __builtin_amdgcn_s_sleep(1);
        if ((++sp & 255u) == 0u) { if (xb_ld(&bar[XB_TMO])) break; if (sp > XB_SPIN_CAP) { atomicAdd(&bar[XB_TMO], 1u); break; } }
    }
    nloc = mine > 0u ? mine : 1u; nx = cnt > 0u ? cnt : 1u;
}

__device__ __forceinline__ void xcd_barrier(const XcdBarrier& b) {
    asm volatile("s_waitcnt vmcnt(0)" ::: "memory");
    __syncthreads();
    if (threadIdx.x == 0) {
        unsigned* bar = b.bar;
        __builtin_amdgcn_s_waitcnt(0);
        unsigned nloc = b.st[0], nx = b.st[1];
        if (nloc == 0u) { xcd_barrier_complete(bar, b.x, nloc, nx); b.st[0] = nloc; b.st[1] = nx; }
        const unsigned old = xb_add(&bar[XB_XSUB(b.x)], 1u);
        const unsigned gen = old / nloc;
        if (old + 1u == (gen + 1u) * nloc) {
            __builtin_amdgcn_fence(__ATOMIC_RELEASE, "agent");
            asm volatile("s_waitcnt vmcnt(0)" ::: "memory");
            const unsigned og = xb_add(&bar[XB_TOP], 1u);
            const unsigned tg = og / nx;
            if (og + 1u == (tg + 1u) * nx) xb_add(&bar[XB_TOPGEN], 1u);
            else XB_SPIN(xb_ld(&bar[XB_TOPGEN]) == tg, bar);
            __builtin_amdgcn_fence(__ATOMIC_ACQUIRE, "agent");
            xb_add(&bar[XB_XGEN(b.x)], 1u);
            asm volatile("s_waitcnt vmcnt(0)" ::: "memory");
        } else {
            XB_SPIN(xb_ld(&bar[XB_XGEN(b.x)]) == gen, bar);
            __builtin_amdgcn_fence(__ATOMIC_ACQUIRE, "agent");
            asm volatile("s_waitcnt vmcnt(0)" ::: "memory");
        }
    }
    __syncthreads();
}

constexpr size_t MiB = 1u << 20;
constexpr size_t WS_CTL = 0, WS_ORDER = 4096, WS_BAR = 8192;
constexpr size_t WS_W = 1 * MiB, OFF_WIN = 0, OFF_WGU = 11 * MiB, OFF_WD = 22 * MiB, OFF_WBR = 28 * MiB, OFF_WOUT = 30 * MiB, OFF_W1 = 32 * MiB, OFF_W2 = 34 * MiB,
                 OFF_BIN = 34 * MiB + 65536, OFF_CB1 = OFF_BIN + 32768  , OFF_CB2 = OFF_CB1 + 65536;
constexpr size_t WS_TAB = 36 * MiB, WS_SSP = 38 * MiB, WS_KC = 39 * MiB, WS_KM = 39 * MiB + 512 * 1024, WS_GN = 40 * MiB, WS_XB = 42 * MiB, WS_BIG = 74 * MiB,
                 WS_U = 170 * MiB, WS_QN = 178 * MiB, WS_KV = 194 * MiB, WS_MO = 218 * MiB, WS_MRG = 178 * MiB, WS_END = 242 * MiB;
constexpr int LDS_BYTES = 147456;

__device__ __forceinline__ int dint(int pos) { return (pos >> 1) + 32 * (pos & 1); }
__device__ __forceinline__ int in_orig(int c) {
    if (c < 256) return c;
    if (c < 768) { const int c2 = c - 256; return 256 + (c2 >> 6) * 64 + dint(c2 & 63); }
    if (c < 1536) { const int c2 = c - 768, tt = c2 >> 8, bj = (c2 >> 7) & 1, g = (c2 >> 6) & 1, pos = c2 & 63; return 768 + (2 * tt + bj) * 128 + g * 64 + (bj == 0 ? dint(pos) : pos); }
    if (c < 2304) { const int c2 = c - 1536, part = c2 >> 8, h = (c2 >> 6) & 3, pos = c2 & 63; return 1560 + part * 256 + h * 64 + (part < 2 ? dint(pos) : pos); }
    if (c < 5376) return 2328 + (c - 2304);
    const int c2 = c - 5376; return c2 < 24 ? 1536 + c2 : -1;
}
template <class F> __device__ __forceinline__ void cvt_tile(LAS float* scr, int lane, int k0, int n0, bf16_t* dst, size_t pitch, F f) {
    float vals[32];
#pragma unroll
    for (int i = 0; i < 32; ++i) vals[i] = f(k0 + 2 * i + (lane >> 5), n0 + (lane & 31));
#pragma unroll
    for (int i = 0; i < 32; ++i) scr[(2 * i + (lane >> 5)) * 33 + (lane & 31)] = vals[i];
    asm volatile("s_waitcnt lgkmcnt(0)" ::: "memory");
    const int c = lane & 7;
#pragma unroll
    for (int j = 0; j < 4; ++j) { const int n = (lane >> 3) + 8 * j; const LAS float* s = scr + (8 * c) * 33 + n;
        u32x4 o; o.x = cvtpk(s[0 * 33], s[1 * 33]); o.y = cvtpk(s[2 * 33], s[3 * 33]); o.z = cvtpk(s[4 * 33], s[5 * 33]); o.w = cvtpk(s[6 * 33], s[7 * 33]);
        *(u32x4*)(dst + (size_t)(n0 + n) * pitch + k0 + 8 * c) = o; }
    asm volatile("s_waitcnt lgkmcnt(0)" ::: "memory");
}
struct Args { const float* in[20]; float* out; unsigned char* ws; };
typedef const __attribute__((address_space(4))) Args* ArgsP;

__device__ __forceinline__ void phase0(ArgsP a, int l, LAS unsigned char* lds, int tid, int lane, int wave, int gw, int NGW) {
    unsigned char* ws = a->ws;
    LAS float* scr = (LAS float*)(lds + wave * 8704);
    const float* attn_norm = a->in[1] + (size_t)l * DM; const float* w_in = a->in[2] + (size_t)l * DM * IN_COLS; const float* b_in = a->in[3] + (size_t)l * IN_COLS;
    const float* pool_w = a->in[4] + (size_t)l * 4 * 64 * 64; const float* pool_scale = a->in[5] + (size_t)l * 256; const float* cmp_pos = a->in[6] + (size_t)l * 2 * 32 * 64;
    const float* cmp_w1 = a->in[7] + (size_t)l * 2 * 2048 * 256; const float* cmp_b1 = a->in[8] + (size_t)l * 2 * 256; const float* cmp_w2 = a->in[9] + (size_t)l * 2 * 256 * 64; const float* cmp_b2 = a->in[10] + (size_t)l * 2 * 64;
    const float* w_br_pool = a->in[11] + (size_t)l * 256 * DM; const float* w_br_nsa = a->in[12] + (size_t)l * 512 * DM; const float* w_br_moba = a->in[13] + (size_t)l * 256 * DM;
    const float* w_out = a->in[14] + (size_t)l * DM * DM; const float* ffn_norm = a->in[15] + (size_t)l * DM; const float* w_gate = a->in[16] + (size_t)l * DM * DFF; const float* w_up = a->in[17] + (size_t)l * DM * DFF;
    const float* w_down = a->in[18] + (size_t)l * DFF * DM;
    bf16_t* Win = (bf16_t*)(ws + WS_W + OFF_WIN); bf16_t* Wgu = (bf16_t*)(ws + WS_W + OFF_WGU); bf16_t* Wd = (bf16_t*)(ws + WS_W + OFF_WD); bf16_t* Wbr = (bf16_t*)(ws + WS_W + OFF_WBR);
    bf16_t* Wout = (bf16_t*)(ws + WS_W + OFF_WOUT); bf16_t* W1t = (bf16_t*)(ws + WS_W + OFF_W1); bf16_t* W2t = (bf16_t*)(ws + WS_W + OFF_W2);
    float* bin = (float*)(ws + WS_W + OFF_BIN); float* cb1 = (float*)(ws + WS_W + OFF_CB1); float* cb2 = (float*)(ws + WS_W + OFF_CB2);
    constexpr int I_A = 16 * 176, I_B = 16 * 176, I_C = 44 * 32, I_D = 16 * 32, I_E = 16 * 32, I_F = 2 * 32 * 8, I_G = 2 * 4 * 2;
    constexpr int NITEMS = I_A + I_B + I_C + I_D + I_E + I_F + I_G;
    for (int it = gw; it < NITEMS; it += NGW) {
        int r = it;
        if (r < I_A) { const int kb = r / 176, nb = r % 176; cvt_tile(scr, lane, 64 * kb, 32 * nb, Win, DM, [&](int k, int n) { const int o = in_orig(n); const float v = w_in[(size_t)k * IN_COLS + (o >= 0 ? o : 0)] * attn_norm[k]; return o >= 0 ? v : 0.f; }); continue; } r -= I_A;
        if (r < I_B) { const int kb = r / 176, nb = r % 176; cvt_tile(scr, lane, 64 * kb, 32 * nb, Wgu, DM, [&](int k, int n) { const int j = (n >> 8) * 128 + (n & 127); const float* s = ((n >> 7) & 1) ? w_up : w_gate; return s[(size_t)k * DFF + j] * ffn_norm[k]; }); continue; } r -= I_B;
        if (r < I_C) { const int kb = r / 32, nb = r % 32; cvt_tile(scr, lane, 64 * kb, 32 * nb, Wd, DFF, [&](int k, int n) { return w_down[(size_t)k * DM + n]; }); continue; } r -= I_C;
        if (r < I_D) { const int kb = r / 32, nb = r % 32; cvt_tile(scr, lane, 64 * kb, 32 * nb, Wout, DM, [&](int k, int n) { return w_out[(size_t)k * DM + n]; }); continue; } r -= I_D;
        if (r < I_E) { const int kb = r / 32, nb = r % 32;
            if (kb < 4) { }
            else if (kb < 12) cvt_tile(scr, lane, 64 * kb, 32 * nb, Wbr, DM, [&](int k, int n) { return w_br_nsa[(size_t)(k - 256) * DM + n]; });
            else cvt_tile(scr, lane, 64 * kb, 32 * nb, Wbr, DM, [&](int k, int n) { return w_br_moba[(size_t)(k - 768) * DM + n]; });
            continue; } r -= I_E;
        if (r < I_F) { const int kv = r >> 8, kb = (r >> 3) & 31, nb = r & 7; const float* w1 = cmp_w1 + (size_t)kv * 2048 * 256;
            cvt_tile(scr, lane, 64 * kb, 32 * nb, W1t + (size_t)kv * 256 * 2048, 2048, [&](int k, int n) { const int pos = k & 63, d = kv == 0 ? dint(pos) : pos; return w1[(size_t)((k & ~63) + d) * 256 + n]; }); continue; } r -= I_F;
        { const int kv = r >> 3, kb = (r >> 1) & 3, nb = r & 1; const float* w2 = cmp_w2 + (size_t)kv * 256 * 64;
            cvt_tile(scr, lane, 64 * kb, 32 * nb, W2t + (size_t)kv * 64 * 256, 256, [&](int k, int n) { return w2[(size_t)k * 64 + (kv == 0 ? dint(n) : n)]; }); }
    }
    const int gt = gw * 64 + lane, NGT = NGW * 64;
    for (int c = gt; c < NIN; c += NGT) { const int o = in_orig(c); bin[c] = o >= 0 ? b_in[o] : 0.f; }
    for (int idx = gt; idx < 32 * 512; idx += NGT) { const int c = idx >> 9, e = idx & 511, kv = e >> 8, n = e & 255; const float* w1 = cmp_w1 + (size_t)kv * 2048 * 256 + (size_t)(64 * c) * 256 + n; const float* pe = cmp_pos + (size_t)kv * 2048 + 64 * c;
        float s = c == 0 ? cmp_b1[kv * 256 + n] : 0.f;
#pragma unroll 16
        for (int k = 0; k < 64; ++k) s += pe[k] * w1[(size_t)k * 256];
        cb1[idx] = s; }
    for (int idx = gt; idx < 256 * DM; idx += NGT) { const int k = idx >> 10, n = idx & 1023, g64 = k & ~63; float s = 0.f;
#pragma unroll 16
        for (int j = 0; j < 64; ++j) s += pool_w[k * 64 + j] * pool_scale[g64 + j] * w_br_pool[(size_t)(g64 + j) * DM + n];
        Wbr[(size_t)n * DM + k] = (bf16_t)(cvtpk(s, 0.f) & 0xffffu); }
    for (int e = gt; e < 128; e += NGT) { const int kv = e >> 6, n = e & 63; cb2[e] = cmp_b2[kv * 64 + (kv == 0 ? dint(n) : n)]; }
    if (l == 0) {
        float* tab = (float*)(ws + WS_TAB);
        for (int e = gt; e < SEQ * 32; e += NGT) { const int t = e >> 5, f = e & 31; const float inv = powf(10000.0f, -(float)(2 * f) / 64.0f); const float ang = (float)t * inv;
            const double ad = (double)ang, kq = rint(ad * 0.15915494309189535); double rr = fma(-kq, 6.283185307179586, ad); rr = fma(-kq, 2.4492935982947064e-16, rr);
            const float rf = (float)rr; tab[2 * e] = __cosf(rf); tab[2 * e + 1] = __sinf(rf); }
        const float* x = a->in[0]; bf16_t* xb = (bf16_t*)(ws + WS_XB); float* ssp = (float*)(ws + WS_SSP);
        for (int m0 = 2 * gw; m0 < MTOK; m0 += 2 * NGW) { f32x4 v[2][4]; float s[2] = {0.f, 0.f};
#pragma unroll
            for (int q = 0; q < 2; ++q) { const f32x4* xr = (const f32x4*)(x + (size_t)(m0 + q) * DM) + lane;
#pragma unroll
                for (int j = 0; j < 4; ++j) v[q][j] = xr[64 * j]; }
#pragma unroll
            for (int q = 0; q < 2; ++q) {
#pragma unroll
                for (int j = 0; j < 4; ++j) s[q] += (v[q][j][0] * v[q][j][0] + v[q][j][1] * v[q][j][1]) + (v[q][j][2] * v[q][j][2] + v[q][j][3] * v[q][j][3]);
#pragma unroll
                for (int o = 1; o < 64; o <<= 1) s[q] += __shfl_xor(s[q], o);
                u32x2* o8 = (u32x2*)(xb + (size_t)(m0 + q) * DM) + lane;
#pragma unroll
                for (int j = 0; j < 4; ++j) o8[64 * j] = (u32x2){cvtpk(v[q][j][0], v[q][j][1]), cvtpk(v[q][j][2], v[q][j][3])};
                if (lane < 16) ssp[(size_t)(m0 + q) * 16 + lane] = lane == 0 ? s[q] : 0.f; } }
        int* order = (int*)(ws + WS_ORDER);
        auto cost = [](int id) { if (id < 512) { const int i = id & 127; return 10 * ((i + 1) + ((i < 8 ? i : 8) + 1) + 10) + 16 * ((4 * i + 3 + 63) >> 6); } const int qb = (id - 512) & 31; return 7 * (4 * qb + 3) + 50; };
        for (int id = gw; id < 768; id += NGW) { const int mc = cost(id); int rk = 0;
            for (int j = lane; j < 768; j += 64) { const int cj = cost(j); rk += (cj > mc || (cj == mc && j < id)) ? 1 : 0; }
#pragma unroll
            for (int o = 1; o < 64; o <<= 1) rk += __shfl_xor(rk, o);
            if (lane == 0) order[rk] = id; }
    }
}
__device__ __forceinline__ float gelu_tanh(float x) { const float u = 0.7978845608028654f * (x + 0.044715f * x * x * x); const float th = 1.f - 2.f * __builtin_amdgcn_rcpf(1.f + __expf(2.f * u)); return 0.5f * x * (1.f + th); }
__device__ __forceinline__ void phase2(ArgsP a, LAS unsigned char* lds, int tid, int lane, int wave, int G) {
    unsigned char* ws = a->ws;
    const bf16_t* KV = (const bf16_t*)(ws + WS_KV); const bf16_t* W1t = (const bf16_t*)(ws + WS_W + OFF_W1); const bf16_t* W2t = (const bf16_t*)(ws + WS_W + OFF_W2);
    const float* cb1 = (const float*)(ws + WS_W + OFF_CB1); const float* cb2 = (const float*)(ws + WS_W + OFF_CB2);
    bf16_t* KC = (bf16_t*)(ws + WS_KC);
    LAS bf16_t* hid = (LAS bf16_t*)lds;
    const int arow = lane & 15, kq = lane >> 4;
    for (int task = blockIdx.x; task < 256; task += G) {
        const int kv = task >> 7, bgi = (task >> 5) & 3, nt = task & 31;
        const bf16_t* src = KV + (size_t)kv * att::KV_STRIDE + (size_t)bgi * SEQ * 64;
        const int nrow = 16 * nt + arow, neff = nrow < 510 ? nrow : 510;
        const bf16_t* ap = src + (size_t)neff * 1024 + kq * 8;
        const bf16_t* bp0 = W1t + (size_t)kv * 256 * 2048 + (size_t)(32 * wave + arow) * 2048 + kq * 8; const bf16_t* bp1 = bp0 + 16 * 2048;
        f32x4 c0 = {0.f, 0.f, 0.f, 0.f}, c1 = {0.f, 0.f, 0.f, 0.f};
#pragma unroll 8
        for (int ks = 0; ks < 64; ++ks) { const bf16x8 av = *(const bf16x8*)(ap + ks * 32), b0 = *(const bf16x8*)(bp0 + ks * 32), b1 = *(const bf16x8*)(bp1 + ks * 32);
            c0 = __builtin_amdgcn_mfma_f32_16x16x32_bf16(av, b0, c0, 0, 0, 0); c1 = __builtin_amdgcn_mfma_f32_16x16x32_bf16(av, b1, c1, 0, 0, 0); }
        { const int col0 = 32 * wave + arow; float bb0 = 0.f, bb1 = 0.f;
#pragma unroll 8
          for (int c = 0; c < 32; ++c) { bb0 += cb1[c * 512 + kv * 256 + col0]; bb1 += cb1[c * 512 + kv * 256 + col0 + 16]; }
#pragma unroll
          for (int j = 0; j < 4; ++j) { const int row = kq * 4 + j; hid[row * 264 + col0] = (bf16_t)(cvtpk(gelu_tanh(c0[j] + bb0), 0.f) & 0xffffu); hid[row * 264 + col0 + 16] = (bf16_t)(cvtpk(gelu_tanh(c1[j] + bb1), 0.f) & 0xffffu); } }
        LBAR();
        if (wave < 4) {
            const bf16_t* bp = W2t + (size_t)kv * 64 * 256 + (size_t)(16 * wave + arow) * 256 + kq * 8; f32x4 c = {0.f, 0.f, 0.f, 0.f};
#pragma unroll
            for (int ks = 0; ks < 8; ++ks) { const bf16x8 av = *(const LAS bf16x8*)(hid + arow * 264 + kq * 8 + ks * 32), bv = *(const bf16x8*)(bp + ks * 32); c = __builtin_amdgcn_mfma_f32_16x16x32_bf16(av, bv, c, 0, 0, 0); }
            const int col = 16 * wave + arow; const float bb = cb2[kv * 64 + col];
#pragma unroll
            for (int j = 0; j < 4; ++j) { const int n = 16 * nt + kq * 4 + j; KC[((size_t)(kv * 4 + bgi) * 512 + n) * 64 + col] = n < 511 ? (bf16_t)(cvtpk(c[j] + bb, 0.f) & 0xffffu) : (bf16_t)0; }
        }
        LBAR();
    }
    const int gt = blockIdx.x * 512 + tid, NGT = G * 512;
    { const bf16_t* MoK = (const bf16_t*)(ws + WS_MO) + att::MO_STRIDE; bf16_t* KM = (bf16_t*)(ws + WS_KM); LAS float* part = (LAS float*)(lds + 16384);
      for (int blk = blockIdx.x; blk < 256; blk += G) { const bf16_t* p = MoK + ((size_t)blk * 256 + 32 * wave) * 64 + lane; float s = 0.f;
#pragma unroll
          for (int r = 0; r < 32; ++r) s += __uint_as_float((unsigned)p[(size_t)r * 64] << 16);
          part[wave * 64 + lane] = s;
          LBAR();
          if (wave == 0) { float t = 0.f;
#pragma unroll
              for (int w = 0; w < 8; ++w) t += part[w * 64 + lane];
              KM[(size_t)blk * 64 + lane] = (bf16_t)(cvtpk(t * (1.0f / 256.0f), 0.f) & 0xffffu); }
          LBAR(); } }
    { const bf16_t* U = (const bf16_t*)(ws + WS_U); bf16_t* Abr = (bf16_t*)(ws + WS_XB);
      for (int e = gt; e < MTOK * 32; e += NGT) { const int row = e >> 5, c8 = e & 31, s = row & (SEQ - 1), w = 2 << (c8 >> 3), cnt = (s + 1 < w) ? s + 1 : w;
          float acc[8] = {0.f, 0.f, 0.f, 0.f, 0.f, 0.f, 0.f, 0.f}; u32x4 v0 = {0u, 0u, 0u, 0u};
#pragma unroll
          for (int i0 = 0; i0 < 16; i0 += 8) { if (i0 >= cnt) break; u32x4 v[8];
#pragma unroll
              for (int i = 0; i < 8; ++i) v[i] = (i0 + i < cnt) ? *(const u32x4*)(U + (size_t)(row - i0 - i) * 256 + c8 * 8) : (u32x4){0u, 0u, 0u, 0u};
              if (i0 == 0) v0 = v[0];
#pragma unroll
              for (int i = 0; i < 8; ++i)
#pragma unroll
                  for (int q = 0; q < 4; ++q) { acc[2 * q] += bflo(v[i][q]); acc[2 * q + 1] += bfhi(v[i][q]); } }
          const float ic = 1.0f / (float)cnt; u32x4 o;
#pragma unroll
          for (int q = 0; q < 4; ++q) o[q] = cvtpk(acc[2 * q] * ic - bflo(v0[q]), acc[2 * q + 1] * ic - bfhi(v0[q]));
          *(u32x4*)(Abr + (size_t)row * DM + c8 * 8) = o; } }
}
__global__ void __launch_bounds__(512, 2) fwd_megakernel(Args a) {
    extern __shared__ __attribute__((aligned(16))) unsigned char lds_raw[];
    LAS unsigned char* lds = (LAS unsigned char*)lds_raw;
    cg::grid_group grid = cg::this_grid();
    const int G = gridDim.x;
    volatile LAS unsigned* bst = (volatile LAS unsigned*)(lds + LDS_BYTES - 64);
    if (threadIdx.x < 16) bst[threadIdx.x] = 0u;
    __syncthreads();
    const ArgsP ap0 = (ArgsP)__builtin_amdgcn_kernarg_segment_ptr();
#define PHASE_ARGS ArgsP a_ = ap0; asm volatile("" : "+s"(a_)); unsigned char* ws = a_->ws; unsigned* ctl = (unsigned*)(ws + WS_CTL); float* ssp = (float*)(ws + WS_SSP); const float* tab = (const float*)(ws + WS_TAB); \
    bf16_t* XB = (bf16_t*)(ws + WS_XB); bf16_t* BIG = (bf16_t*)(ws + WS_BIG); bf16_t* MRG = (bf16_t*)(ws + WS_MRG); (void)ctl; (void)ssp; (void)tab; (void)XB; (void)BIG; (void)MRG;
    XcdBarrier xbar = xcd_barrier_post((unsigned*)(ap0->ws + WS_BAR), bst);
    bool first_sync = true;
#define GRID_SYNC() do { if (first_sync) { grid.sync(); first_sync = false; } else xcd_barrier(xbar); } while (0)
    for (int l = 0; l < DEPTH; ++l) {
        int tid_ = threadIdx.x; asm volatile("" : "+v"(tid_));
        const int tid = tid_, lane = tid & 63, wave = __builtin_amdgcn_readfirstlane(tid >> 6), gw = blockIdx.x * 8 + wave, NGW = G * 8;
        { PHASE_ARGS phase0(a_, l, lds, tid, lane, wave, gw, NGW); }
        GRID_SYNC();
        { PHASE_ARGS pg8::Gemm g{XB, (const bf16_t*)(ws + WS_W + OFF_WIN), MTOK, NIN, DM}; pg8::StaticOrder S; S.init(MTOK, NIN, G, (int)blockIdx.x);
          EpiInProj E{ssp, (const float*)(ws + WS_W + OFF_BIN), tab, (bf16_t*)(ws + WS_U), (bf16_t*)(ws + WS_QN), (bf16_t*)(ws + WS_KV), (bf16_t*)(ws + WS_MO), BIG, (bf16_t*)(ws + WS_GN)};
          pg8::gemm_phase(lds, g, S, E); }
        GRID_SYNC();
        { PHASE_ARGS phase2(a_, lds, tid, lane, wave, G); }
        GRID_SYNC();
        { PHASE_ARGS
          att::Bufs B{(const bf16_t*)(ws + WS_QN), (const bf16_t*)(ws + WS_KV), (const bf16_t*)(ws + WS_MO), (const bf16_t*)(ws + WS_KC), (const bf16_t*)(ws + WS_KM), (const bf16_t*)(ws + WS_GN), XB};
          const int* order = (const int*)(ws + WS_ORDER); LAS int* slot = (LAS int*)(lds + att::L_END);
          if (wave >= 4) __builtin_amdgcn_s_setprio(1);
          for (;;) {
              LBAR();
              if (tid == 0) slot[0] = (int)atomicAdd(ctl + l, 1u);
              LBAR();
              const int item = slot[0];
              if (item >= 768) break;
              const int id = order[item];
              int tl = threadIdx.x; asm volatile("" : "+v"(tl));
              const int tid = tl, lane = tid & 63, wave = __builtin_amdgcn_readfirstlane(tid >> 6);
              att::Ctx C; C.lds = (LAS char*)lds; C.wsf = (LAS float*)(lds + att::L_WSF) + wave * 64; C.otl = (LAS float*)(lds + att::L_OT) + wave * 2048 + lane; C.tid = tid; C.wid = wave; C.lane = lane; C.r32 = lane & 31; C.hi = lane >> 5;
              C.vbl = ((lane >> 4) & 1) * 32 + (lane & 3) * 8 + (4 * (lane >> 5) + ((lane & 15) >> 2)) * 64;
              if (id < 512) att::nsa_item(C, B, id >> 8, (id >> 7) & 1, id & 127);
              else { const int x = id - 512; att::moba_item(C, B, x >> 7, (x >> 5) & 3, x & 31); }
          }
          __builtin_amdgcn_s_setprio(0); }
        GRID_SYNC();
        { PHASE_ARGS pg8::Gemm g{XB, (const bf16_t*)(ws + WS_W + OFF_WBR), MTOK, DM, DM}; pg8::StaticOrder S; S.init(MTOK, DM, G, (int)blockIdx.x);
          EpiBranch E{BIG, MRG}; pg8::gemm_phase(lds, g, S, E); }
        GRID_SYNC();
        { PHASE_ARGS pg8::Gemm g{MRG, (const bf16_t*)(ws + WS_W + OFF_WOUT), MTOK, DM, DM}; pg8::StaticOrder S; S.init(MTOK, DM, G, (int)blockIdx.x);
          bf16_t* RES = (bf16_t*)a_->out; EpiResid E{l == 0 ? a_->in[0] : nullptr, RES, XB, nullptr, ssp};   pg8::gemm_phase(lds, g, S, E); }
        GRID_SYNC();
        { PHASE_ARGS pg8::Gemm g{XB, (const bf16_t*)(ws + WS_W + OFF_WGU), MTOK, NGU, DM}; pg8::StaticOrder S; S.init(MTOK, NGU, G, (int)blockIdx.x);
          EpiSwiGLU E{ssp, BIG}; pg8::gemm_phase(lds, g, S, E); }
        GRID_SYNC();
        { PHASE_ARGS pg8::Gemm g{BIG, (const bf16_t*)(ws + WS_W + OFF_WD), MTOK, DM, DFF}; pg8::StaticOrder S; S.init(MTOK, DM, G, (int)blockIdx.x);
          bf16_t* RES = (bf16_t*)a_->out; EpiResid E{nullptr, XB, XB, l + 1 < DEPTH ? RES : nullptr, ssp};   pg8::gemm_phase(lds, g, S, E); }
        GRID_SYNC();
    }
    { PHASE_ARGS const float* fn = a_->in[19]; float* outp = a_->out; const int lane = threadIdx.x & 63, gw = blockIdx.x * 8 + (threadIdx.x >> 6), NGW = G * 8;
      for (int m = gw; m < MTOK; m += NGW) { const float rstd = row_rstd(ssp, m); const u32x2* xr = (const u32x2*)(XB + (size_t)m * DM) + lane; f32x4* orow = (f32x4*)(outp + (size_t)m * DM) + lane; const f32x4* gr = (const f32x4*)fn + lane;
#pragma unroll
          for (int j = 0; j < 4; ++j) { const u32x2 w = xr[64 * j]; const f32x4 v = {bflo(w[0]), bfhi(w[0]), bflo(w[1]), bfhi(w[1])}; orow[64 * j] = v * rstd * gr[64 * j]; } } }
}

extern "C" void kernel_launch(void* const* d_in, const int* in_sizes, int n_in, void* d_out, int out_size, void* d_ws, size_t ws_size, hipStream_t stream) {
    static int grid = 0;
    if (grid == 0) {
        if (n_in != 20 || in_sizes[0] != MTOK * DM || out_size != MTOK * DM || ws_size < WS_END) { fprintf(stderr, "kernel_launch: unexpected shapes / workspace (n_in %d, ws %zu)\n", n_in, ws_size); grid = -1; return; }
        int dev = 0, cus = 0, per_cu = 0;
        if (hipGetDevice(&dev) != hipSuccess || hipDeviceGetAttribute(&cus, hipDeviceAttributeMultiprocessorCount, dev) != hipSuccess) { grid = -1; return; }
        if (hipFuncSetAttribute((const void*)fwd_megakernel, hipFuncAttributeMaxDynamicSharedMemorySize, LDS_BYTES) != hipSuccess) { fprintf(stderr, "kernel_launch: hipFuncSetAttribute failed\n"); grid = -1; return; }
        if (hipOccupancyMaxActiveBlocksPerMultiprocessor(&per_cu, (const void*)fwd_megakernel, 512, LDS_BYTES) != hipSuccess || per_cu < 1) { fprintf(stderr, "kernel_launch: occupancy query failed (%d)\n", per_cu); (void)hipGetLastError(); grid = -1; return; }
        grid = cus * per_cu;
    }
    if (grid < 0) return;
    if (hipMemsetAsync((char*)d_ws + WS_CTL, 0, 32768, stream) != hipSuccess) { fprintf(stderr, "kernel_launch: memset failed\n"); return; }
    Args a{};
    for (int i = 0; i < 20; ++i) a.in[i] = (const float*)d_in[i];
    a.out = (float*)d_out; a.ws = (unsigned char*)d_ws;
    void* args[] = {&a};
    const hipError_t e = hipLaunchCooperativeKernel((const void*)fwd_megakernel, dim3(grid), dim3(512), args, LDS_BYTES, stream);
    if (e != hipSuccess) fprintf(stderr, "kernel_launch: cooperative launch failed: %s (grid %d)\n", hipGetErrorString(e), grid);
}
```

```cpp
#include <hip/hip_runtime.h>
#include <hip/hip_cooperative_groups.h>
#include <cstdio>
#include <cstdint>
#include <cmath>
namespace cg = cooperative_groups;

#define LAS __attribute__((address_space(3)))
typedef unsigned short bf16_t;
typedef short bf16x8 __attribute__((ext_vector_type(8)));
typedef short s16x4 __attribute__((ext_vector_type(4)));
typedef float f32x2 __attribute__((ext_vector_type(2)));
typedef float f32x4 __attribute__((ext_vector_type(4)));
typedef float f32x16 __attribute__((ext_vector_type(16)));
typedef unsigned u32x4 __attribute__((ext_vector_type(4)));
typedef unsigned u32x2 __attribute__((ext_vector_type(2)));
typedef __bf16 bf16x2_t __attribute__((ext_vector_type(2)));

constexpr int SEQ = 8192, BATCH = 2, MTOK = BATCH * SEQ, DM = 1024, DEPTH = 2;
constexpr int IN_COLS = 5400, NIN = 5632, DFF = 2816, NGU = 5632;
constexpr float RMS_EPS = 1e-6f;
constexpr float QSCALE = 0.125f * 1.4426950408889634f;

__device__ __forceinline__ unsigned cvtpk(float lo, float hi) { f32x2 v = {lo, hi}; bf16x2_t b = __builtin_convertvector(v, bf16x2_t); return __builtin_bit_cast(unsigned, b); }
__device__ __forceinline__ float bflo(unsigned w) { return __uint_as_float(w << 16); }
__device__ __forceinline__ float bfhi(unsigned w) { return __uint_as_float(w & 0xffff0000u); }
__device__ __forceinline__ float sigmoidf_(float x) { return __builtin_amdgcn_rcpf(1.f + __expf(-x)); }

namespace pg8 {
constexpr int BM = 256, BK = 64, HALF = 128, HTB = HALF * BK * 2, STAGE_BYTES = 8 * HTB, NXCD = 8, WGM = 8;
__host__ __device__ __forceinline__ int lds_byte(int r, int c) { const int st = (r >> 4) * 2 + (c >> 5), rr = r & 15, cc = c & 31, ob = rr * 64 + cc * 2; return st * 1024 + (ob ^ (((ob >> 9) & 1) << 5)); }
__host__ __device__ __forceinline__ void stage_rc(int b, int& R, int& C) { const int st = b / 1024, sb = b % 1024, swz = sb ^ (((sb >> 9) & 1) << 5); R = (st >> 1) * 16 + swz / 64; C = (st & 1) * 32 + (swz % 64) / 2; }
__host__ __device__ __forceinline__ int perm32(int rho) { const int n = rho >> 4, i = rho & 15; return 8 * (i >> 2) + 4 * n + (i & 3); }
struct Unit { int pm, pn; };
struct Gemm { const bf16_t* A; const bf16_t* Bt; int M, N, K; };
struct StaticOrder {
    int nM, nN, nwg, G, c;
    __host__ __device__ void init(int M, int N, int G_, int c_) { nM = M / BM; nN = N / BM; nwg = nM * nN; G = G_; c = c_; }
    __host__ __device__ bool next(int i, Unit& u) const {
        const long L = (long)i * G + c; if (L >= nwg) return false;
        int wgid = (int)L; { const int q = nwg / NXCD, r = nwg % NXCD, xcd = wgid % NXCD, off = wgid / NXCD; wgid = (xcd < r ? xcd * (q + 1) : r * (q + 1) + (xcd - r) * q) + off; }
        const int nig = WGM * nN, gid = wgid / nig, fm = gid * WGM, gsz = (nM - fm) < WGM ? (nM - fm) : WGM;
        u.pm = fm + ((wgid % nig) % gsz); u.pn = (wgid % nig) / gsz; return true;
    }
};
template <class Epi, class Sched>
__device__ __forceinline__ void gemm_phase(LAS unsigned char* lds, const Gemm g, const Sched& S, const Epi& E) {
    int tid_ = threadIdx.x; asm volatile("" : "+v"(tid_));
    const int tid = tid_, wid = __builtin_amdgcn_readfirstlane(tid >> 6), lane = tid & 63, wr = wid >> 2, wc = wid & 3, fr = lane & 15, fq = lane >> 4;
    const int K = g.K, nt = K / BK;
    unsigned voffA[2], voffB[2];
#pragma unroll
    for (int i = 0; i < 2; ++i) { int R, C; stage_rc(tid * 16 + i * 8192, R, C); const int Rb = ((R & ~31) + perm32(R & 31));
        voffA[i] = (unsigned)(R * K + C) * 2u; voffB[i] = (unsigned)(Rb * K + C) * 2u; }
    const size_t kstep = (size_t)(BK * 2);
    const size_t hstep = (size_t)HALF * K * 2;
    const size_t tstep = 2 * hstep;
    const unsigned ldsw = (unsigned)wid * 1024u;
    const int aoff = lds_byte(wr * 64 + fr, fq * 8), boff = lds_byte(wc * 32 + fr, fq * 8);
#define PG8_SA(b, h) (((b) * 2 + (h)) * HTB)
#define PG8_SB(b, h) ((4 + (b) * 2 + (h)) * HTB)
#define PG8_STAGE(bufoff, gbase, voff) do { _Pragma("unroll") for (int _i = 0; _i < 2; ++_i) \
        __builtin_amdgcn_global_load_lds((const unsigned*)((const char*)(gbase) + (voff)[_i]), (LAS unsigned*)(lds + (bufoff) + ldsw + _i * 8192), 16, 0, 0); } while (0)
#define PG8_LDA(dst, b, h) do { _Pragma("unroll") for (int m = 0; m < 4; ++m) _Pragma("unroll") for (int k = 0; k < 2; ++k) dst[m][k] = *(const LAS bf16x8*)(lds + PG8_SA(b, h) + aoff + m * 2048 + k * 1024); } while (0)
#define PG8_LDB(dst, b, h) do { _Pragma("unroll") for (int n = 0; n < 2; ++n) _Pragma("unroll") for (int k = 0; k < 2; ++k) dst[n][k] = *(const LAS bf16x8*)(lds + PG8_SB(b, h) + boff + n * 2048 + k * 1024); } while (0)
#define PG8_MMA(ai, bj, At, Bt) do { __builtin_amdgcn_s_setprio(1); _Pragma("unroll") for (int m = 0; m < 4; ++m) _Pragma("unroll") for (int n = 0; n < 2; ++n) _Pragma("unroll") for (int k = 0; k < 2; ++k) \
        acc[ai][bj][m][n] = __builtin_amdgcn_mfma_f32_16x16x32_bf16(Bt[n][k], At[m][k], acc[ai][bj][m][n], 0, 0, 0); __builtin_amdgcn_s_setprio(0); } while (0)
#define PG8_WAIT_V(n) asm volatile("s_waitcnt vmcnt(" #n ")" ::: "memory")
#define PG8_WAIT_L(n) asm volatile("s_waitcnt lgkmcnt(" #n ")" ::: "memory")
#define PG8_BAR __builtin_amdgcn_s_barrier()
#define PG8_SCHED __builtin_amdgcn_sched_barrier(0)
    Unit cur, nxt; int ui = 0;
    if (!S.next(0, cur)) return;
    f32x4 acc[2][2][4][2];
#pragma unroll
    for (int a = 0; a < 2; ++a)
#pragma unroll
        for (int b = 0; b < 2; ++b)
#pragma unroll
            for (int m = 0; m < 4; ++m)
#pragma unroll
                for (int n = 0; n < 2; ++n) acc[a][b][m][n] = (f32x4){0.f, 0.f, 0.f, 0.f};
    bf16x8 At[4][2], B0[2][2], B1[2][2];
    const char* cA = (const char*)g.A + (size_t)cur.pm * tstep; const char* cB = (const char*)g.Bt + (size_t)cur.pn * tstep;
    PG8_STAGE(PG8_SB(0, 0), cB, voffB); PG8_STAGE(PG8_SB(0, 1), cB + hstep, voffB); PG8_STAGE(PG8_SA(0, 0), cA, voffA); PG8_STAGE(PG8_SA(0, 1), cA + hstep, voffA);
    if (wr == 1) PG8_BAR;
    PG8_WAIT_V(2); PG8_BAR;
    PG8_STAGE(PG8_SB(1, 0), cB + kstep, voffB); PG8_STAGE(PG8_SA(1, 0), cA + kstep, voffA); PG8_STAGE(PG8_SB(1, 1), cB + hstep + kstep, voffB);
    PG8_WAIT_V(6); PG8_BAR;
    for (;;) {
        const bool has_next = S.next(ui + 1, nxt);
        const char* nA = has_next ? (const char*)g.A + (size_t)nxt.pm * tstep : cA; const char* nB = has_next ? (const char*)g.Bt + (size_t)nxt.pn * tstep : cB;
        for (int t = 0; t < nt; t += 2) {
            const bool last = (t == nt - 2);
            const char* a1 = cA + (size_t)(t + 1) * kstep;
            const char* a2 = last ? nA : cA + (size_t)(t + 2) * kstep; const char* b2 = last ? nB : cB + (size_t)(t + 2) * kstep;
            const char* a3 = a2 + kstep; const char* b3 = b2 + kstep;
            if constexpr (Epi::KHOOK) { if (t == 4 || t == 12) { PG8_SCHED; E.khook(acc, cur, t, wr, wc, fr, fq); PG8_SCHED; } }
            PG8_LDB(B0, 0, 0); PG8_LDB(B1, 0, 1); PG8_SCHED; PG8_LDA(At, 0, 0); PG8_STAGE(PG8_SA(1, 1), a1 + hstep, voffA);
            PG8_WAIT_V(8); PG8_WAIT_L(0); PG8_BAR; PG8_MMA(0, 0, At, B0); PG8_MMA(0, 1, At, B1); PG8_BAR; PG8_SCHED;
            PG8_LDA(At, 0, 1); PG8_STAGE(PG8_SB(0, 0), b2, voffB); PG8_STAGE(PG8_SB(0, 1), b2 + hstep, voffB); PG8_STAGE(PG8_SA(0, 0), a2, voffA);
            PG8_WAIT_V(8); PG8_WAIT_L(0); PG8_BAR; PG8_MMA(1, 0, At, B0); PG8_MMA(1, 1, At, B1); PG8_BAR; PG8_SCHED;
            PG8_LDB(B0, 1, 0); PG8_LDB(B1, 1, 1); PG8_SCHED; PG8_LDA(At, 1, 0); PG8_STAGE(PG8_SA(0, 1), a2 + hstep, voffA);
            PG8_WAIT_V(8); PG8_WAIT_L(0); PG8_BAR; PG8_MMA(0, 0, At, B0); PG8_MMA(0, 1, At, B1); PG8_BAR; PG8_SCHED;
            PG8_LDA(At, 1, 1); PG8_STAGE(PG8_SB(1, 0), b3, voffB); PG8_STAGE(PG8_SB(1, 1), b3 + hstep, voffB); PG8_STAGE(PG8_SA(1, 0), a3, voffA);
            PG8_WAIT_V(8); PG8_WAIT_L(0); PG8_BAR; PG8_MMA(1, 0, At, B0); PG8_MMA(1, 1, At, B1); PG8_BAR; PG8_SCHED;
        }
        if (wr == 0) PG8_BAR;
        E(acc, cur, wr, wc, fr, fq);
        if (!has_next) break;
#pragma unroll
        for (int a = 0; a < 2; ++a)
#pragma unroll
            for (int b = 0; b < 2; ++b)
#pragma unroll
                for (int m = 0; m < 4; ++m)
#pragma unroll
                    for (int n = 0; n < 2; ++n) acc[a][b][m][n] = (f32x4){0.f, 0.f, 0.f, 0.f};
        cur = nxt; cA = nA; cB = nB; ++ui;
        if (wr == 1) PG8_BAR;
    }
    PG8_WAIT_V(0);
    PG8_BAR;
#undef PG8_SA
#undef PG8_SB
#undef PG8_STAGE
#undef PG8_LDA
#undef PG8_LDB
#undef PG8_MMA
#undef PG8_WAIT_V
#undef PG8_WAIT_L
#undef PG8_BAR
#undef PG8_SCHED
}
}
using pg8::Unit;
__device__ __forceinline__ float row_rstd(const float* ssp, int row) {
    const f32x4* p = (const f32x4*)(ssp + (size_t)row * 16);
    const f32x4 a = p[0], b = p[1], c = p[2], d = p[3];
    const float ss = ((a[0] + a[1]) + (a[2] + a[3])) + ((b[0] + b[1]) + (b[2] + b[3])) + ((c[0] + c[1]) + (c[2] + c[3])) + ((d[0] + d[1]) + (d[2] + d[3]));
    return 1.0f / sqrtf(ss * (1.0f / DM) + RMS_EPS);
}
__device__ __forceinline__ float row_rstd4(const float* ssp, int row, int fq) {
    const f32x4 a = *((const f32x4*)(ssp + (size_t)row * 16) + fq);
    float ss = (a[0] + a[1]) + (a[2] + a[3]);
    ss += __shfl_xor(ss, 16); ss += __shfl_xor(ss, 32);
    return 1.0f / sqrtf(ss * (1.0f / DM) + RMS_EPS);
}
__device__ __forceinline__ u32x4 pack8(const f32x4 a, const f32x4 b) { u32x4 w; w.x = cvtpk(a[0], a[1]); w.y = cvtpk(a[2], a[3]); w.z = cvtpk(b[0], b[1]); w.w = cvtpk(b[2], b[3]); return w; }
__device__ __forceinline__ void rope8(f32x4& v0, f32x4& v1, const float* tab, int t, int pos, float sc) {
    const f32x4* cs = (const f32x4*)(tab + ((size_t)t * 32 + (pos >> 1)) * 2);
    const f32x4 c0 = cs[0], c1 = cs[1];
    f32x4 o0, o1;
    o0[0] = (v0[0] * c0[0] - v0[1] * c0[1]) * sc; o0[1] = (v0[1] * c0[0] + v0[0] * c0[1]) * sc;
    o0[2] = (v0[2] * c0[2] - v0[3] * c0[3]) * sc; o0[3] = (v0[3] * c0[2] + v0[2] * c0[3]) * sc;
    o1[0] = (v1[0] * c1[0] - v1[1] * c1[1]) * sc; o1[1] = (v1[1] * c1[0] + v1[0] * c1[1]) * sc;
    o1[2] = (v1[2] * c1[2] - v1[3] * c1[3]) * sc; o1[3] = (v1[3] * c1[2] + v1[2] * c1[3]) * sc;
    v0 = o0; v1 = o1;
}
struct EpiInProj {
    static constexpr bool KHOOK = false;
    const float* ssp; const float* bias; const float* tab;
    bf16_t *U, *Qn, *KV, *Mo, *G, *Gn;
    __device__ __forceinline__ void operator()(const f32x4 (&acc)[2][2][4][2], const Unit& u, int wr, int wc, int fr, int fq) const {
        asm volatile("" : "+v"(fr), "+v"(fq));
        const int pn = u.pn;
        f32x4 bia[2][2];
#pragma unroll
        for (int bj = 0; bj < 2; ++bj) { const int gc = pn * 256 + bj * 128 + wc * 32 + 8 * fq; bia[bj][0] = *(const f32x4*)(bias + gc); bia[bj][1] = *(const f32x4*)(bias + gc + 4); }
        float rs[2][4];
#pragma unroll
        for (int ai = 0; ai < 2; ++ai)
#pragma unroll
            for (int m = 0; m < 4; ++m) rs[ai][m] = row_rstd4(ssp, u.pm * 256 + ai * 128 + wr * 64 + m * 16 + fr, fq);
#pragma unroll
        for (int ai = 0; ai < 2; ++ai)
#pragma unroll
            for (int m = 0; m < 4; ++m) {
                const int row = u.pm * 256 + ai * 128 + wr * 64 + m * 16 + fr;
                const float rstd = rs[ai][m];
                const int t = row & (SEQ - 1), b = row >> 13;
#pragma unroll
                for (int bj = 0; bj < 2; ++bj) {
                    const int cit = bj * 128 + wc * 32 + 8 * fq;
                    f32x4 v0 = acc[ai][bj][m][0] * rstd + bia[bj][0], v1 = acc[ai][bj][m][1] * rstd + bia[bj][1];
                    bf16_t* dst;
                    if (pn == 0) { dst = U + (size_t)row * 256 + cit; }
                    else if (pn <= 2) { const int c2 = (pn - 1) * 256 + cit, head = c2 >> 6, pos = c2 & 63; rope8(v0, v1, tab, t, pos, QSCALE); dst = Qn + ((size_t)(b * 8 + head) * SEQ + t) * 64 + pos; }
                    else if (pn <= 5) { const int c2 = cit & 127, g = c2 >> 6, pos = c2 & 63, kvi = 2 * (pn - 3) + bj; if (bj == 0) rope8(v0, v1, tab, t, pos, 1.f);
                        dst = KV + (size_t)kvi * ((size_t)MTOK * 128) + ((size_t)(b * 2 + g) * SEQ + t) * 64 + pos; }
                    else if (pn <= 8) { const int h = cit >> 6, pos = cit & 63; if (pn < 8) rope8(v0, v1, tab, t, pos, pn == 6 ? QSCALE : 1.f);
                        dst = Mo + (size_t)(pn - 6) * ((size_t)MTOK * 256) + ((size_t)(b * 4 + h) * SEQ + t) * 64 + pos; }
                    else if (pn <= 20) {
#pragma unroll
                        for (int e = 0; e < 4; ++e) { v0[e] = sigmoidf_(v0[e]); v1[e] = sigmoidf_(v1[e]); }
                        dst = G + (size_t)row * 3072 + (pn - 9) * 256 + cit; }
                    else {
#pragma unroll
                        for (int e = 0; e < 4; ++e) { v0[e] = sigmoidf_(v0[e]); v1[e] = sigmoidf_(v1[e]); }
                        dst = Gn + (size_t)row * 32 + (cit & 31); if (cit >= 32) dst = nullptr; }
                    if (dst) *(u32x4*)dst = pack8(v0, v1);
                }
                asm volatile("" ::: "memory");
            }
    }
};
struct EpiBranch {
    static constexpr bool KHOOK = true;
    const bf16_t* G; bf16_t* out;
    __device__ __forceinline__ void khook(f32x4 (&acc)[2][2][4][2], const Unit& u, int t, int wr, int wc, int fr, int fq) const {
        asm volatile("" : "+v"(fr), "+v"(fq));
        const int gsel = (t == 4) ? 0 : 1024;
#pragma unroll
        for (int ai = 0; ai < 2; ++ai)
#pragma unroll
            for (int m = 0; m < 4; ++m) {
                const int row = u.pm * 256 + ai * 128 + wr * 64 + m * 16 + fr;
#pragma unroll
                for (int bj = 0; bj < 2; ++bj) {
                    const int col = u.pn * 256 + bj * 128 + wc * 32 + 8 * fq;
                    const u32x4 gx = *(const u32x4*)(G + (size_t)row * 3072 + gsel + col), gy = *(const u32x4*)(G + (size_t)row * 3072 + gsel + 1024 + col);
#pragma unroll
                    for (int e = 0; e < 4; ++e) {
                        const float x0 = fmaxf(bflo(gx[e]), 1e-20f), x1 = fmaxf(bfhi(gx[e]), 1e-20f), y0 = fmaxf(bflo(gy[e]), 1e-20f), y1 = fmaxf(bfhi(gy[e]), 1e-20f);
                        const float r0 = x0 * __builtin_amdgcn_rcpf(y0), r1 = x1 * __builtin_amdgcn_rcpf(y1);
                        acc[ai][bj][m][e >> 1][(e & 1) * 2] *= r0; acc[ai][bj][m][e >> 1][(e & 1) * 2 + 1] *= r1;
                    }
                }
                asm volatile("" ::: "memory");
            }
    }
    __device__ __forceinline__ void operator()(const f32x4 (&acc)[2][2][4][2], const Unit& u, int wr, int wc, int fr, int fq) const {
        asm volatile("" : "+v"(fr), "+v"(fq));
#pragma unroll
        for (int ai = 0; ai < 2; ++ai)
#pragma unroll
            for (int m = 0; m < 4; ++m) {
                const int row = u.pm * 256 + ai * 128 + wr * 64 + m * 16 + fr;
#pragma unroll
                for (int bj = 0; bj < 2; ++bj) {
                    const int col = u.pn * 256 + bj * 128 + wc * 32 + 8 * fq;
                    const u32x4 gz = *(const u32x4*)(G + (size_t)row * 3072 + 2048 + col);
                    f32x4 v0 = acc[ai][bj][m][0], v1 = acc[ai][bj][m][1];
                    v0[0] *= fmaxf(bflo(gz[0]), 1e-20f); v0[1] *= fmaxf(bfhi(gz[0]), 1e-20f); v0[2] *= fmaxf(bflo(gz[1]), 1e-20f); v0[3] *= fmaxf(bfhi(gz[1]), 1e-20f);
                    v1[0] *= fmaxf(bflo(gz[2]), 1e-20f); v1[1] *= fmaxf(bfhi(gz[2]), 1e-20f); v1[2] *= fmaxf(bflo(gz[3]), 1e-20f); v1[3] *= fmaxf(bfhi(gz[3]), 1e-20f);
                    *(u32x4*)(out + (size_t)row * DM + col) = pack8(v0, v1);
                }
                asm volatile("" ::: "memory");
            }
    }
};
struct EpiResid {
    static constexpr bool KHOOK = false;
    const float* base_f; const bf16_t* base_b; bf16_t* xb; bf16_t* res; float* ssp;
    __device__ __forceinline__ void operator()(const f32x4 (&acc)[2][2][4][2], const Unit& u, int wr, int wc, int fr, int fq) const {
        asm volatile("" : "+v"(fr), "+v"(fq));
#pragma unroll
        for (int ai = 0; ai < 2; ++ai)
#pragma unroll
            for (int m = 0; m < 4; ++m) {
                const int row = u.pm * 256 + ai * 128 + wr * 64 + m * 16 + fr;
                float ss = 0.f;
#pragma unroll
                for (int bj = 0; bj < 2; ++bj) {
                    const size_t off = (size_t)row * DM + u.pn * 256 + bj * 128 + wc * 32 + 8 * fq;
                    f32x4 b0, b1;
                    if (base_f) { b0 = *(const f32x4*)(base_f + off); b1 = *(const f32x4*)(base_f + off + 4); }
                    else { const u32x4 w = *(const u32x4*)(base_b + off); b0 = (f32x4){bflo(w[0]), bfhi(w[0]), bflo(w[1]), bfhi(w[1])}; b1 = (f32x4){bflo(w[2]), bfhi(w[2]), bflo(w[3]), bfhi(w[3])}; }
                    const f32x4 v0 = acc[ai][bj][m][0] + b0, v1 = acc[ai][bj][m][1] + b1;
                    const u32x4 pk = pack8(v0, v1);
                    *(u32x4*)(xb + off) = pk;
                    if (res) *(u32x4*)(res + off) = pk;
                    ss += (v0[0] * v0[0] + v0[1] * v0[1]) + (v0[2] * v0[2] + v0[3] * v0[3]) + (v1[0] * v1[0] + v1[1] * v1[1]) + (v1[2] * v1[2] + v1[3] * v1[3]);
                }
                ss += __shfl_xor(ss, 16); ss += __shfl_xor(ss, 32);
                if (fq == 0) ssp[(size_t)row * 16 + u.pn * 4 + wc] = ss;
                if (m & 1) asm volatile("" ::: "memory");
            }
    }
};
struct EpiSwiGLU {
    static constexpr bool KHOOK = false;
    const float* ssp; bf16_t* H;
    __device__ __forceinline__ void operator()(const f32x4 (&acc)[2][2][4][2], const Unit& u, int wr, int wc, int fr, int fq) const {
        asm volatile("" : "+v"(fr), "+v"(fq));
        float rs[2][4];
#pragma unroll
        for (int ai = 0; ai < 2; ++ai)
#pragma unroll
            for (int m = 0; m < 4; ++m) rs[ai][m] = row_rstd4(ssp, u.pm * 256 + ai * 128 + wr * 64 + m * 16 + fr, fq);
#pragma unroll
        for (int ai = 0; ai < 2; ++ai)
#pragma unroll
            for (int m = 0; m < 4; ++m) {
                const int row = u.pm * 256 + ai * 128 + wr * 64 + m * 16 + fr;
                const float rstd = rs[ai][m];
                f32x4 o[2];
#pragma unroll
                for (int n = 0; n < 2; ++n)
#pragma unroll
                    for (int e = 0; e < 4; ++e) { const float gt = acc[ai][0][m][n][e] * rstd, up = acc[ai][1][m][n][e] * rstd; o[n][e] = gt * sigmoidf_(gt) * up; }
                *(u32x4*)(H + (size_t)row * DFF + u.pn * 128 + wc * 32 + 8 * fq) = pack8(o[0], o[1]);
                asm volatile("" ::: "memory");
            }
    }
};
namespace att {
constexpr int KCS = 1040, KSLOT = 8 * KCS, VSLOT = 8192;
constexpr int L_K0 = 0, L_V0 = 4 * KSLOT, L_WSF = 4 * KSLOT + 4 * VSLOT, L_MSK = L_WSF + 8 * 256, L_UNI = L_MSK + 1024, L_LIST = L_UNI + 64, L_END = L_LIST + 512,
              L_PS = L_END + 64, L_OT = L_PS, L_TOTAL = L_OT + 8 * 8192;
static_assert(L_TOTAL <= 147456 - 64, "attention LDS map");
#define LBAR() asm volatile("s_waitcnt lgkmcnt(0)\n\ts_barrier" ::: "memory")
#define LWAIT() asm volatile("s_waitcnt lgkmcnt(0)" ::: "memory")
__device__ __forceinline__ int crow(int r, int hi) { return (r & 3) + 8 * (r >> 2) + 4 * hi; }
__device__ __forceinline__ float swap_other(float v, int hi) { auto rr = __builtin_amdgcn_permlane32_swap(__float_as_uint(v), __float_as_uint(v), false, false); return __uint_as_float(hi ? rr[0] : rr[1]); }
__device__ __forceinline__ void qkt(f32x16& p0, f32x16& p1, const LAS char* Ks, const bf16x8* qr, const f32x16& cinit, int r32, int hi) {
    const LAS char* kb = Ks + hi * KCS + r32 * 16;
#pragma unroll
    for (int d0 = 0; d0 < 4; ++d0) {
        const bf16x8 b0 = *(const LAS bf16x8*)(kb + d0 * 2 * KCS), b1 = *(const LAS bf16x8*)(kb + d0 * 2 * KCS + 512);
        if (d0 == 0) { p0 = __builtin_amdgcn_mfma_f32_32x32x16_bf16(b0, qr[0], cinit, 0, 0, 0); p1 = __builtin_amdgcn_mfma_f32_32x32x16_bf16(b1, qr[0], cinit, 0, 0, 0); }
        else { p0 = __builtin_amdgcn_mfma_f32_32x32x16_bf16(b0, qr[d0], p0, 0, 0, 0); p1 = __builtin_amdgcn_mfma_f32_32x32x16_bf16(b1, qr[d0], p1, 0, 0, 0); } }
}
struct VFrag { s16x4 lo[8], hi[8]; };
typedef short v4i16_t __attribute__((ext_vector_type(4)));
__device__ __forceinline__ s16x4 vtr(const LAS char* p) { return __builtin_bit_cast(s16x4, __builtin_amdgcn_ds_read_tr16_b64_v4i16((LAS v4i16_t*)p)); }
__device__ __forceinline__ void v_issue(VFrag& F, const LAS char* vp) {
#pragma unroll
    for (int d0 = 0; d0 < 2; ++d0)
#pragma unroll
        for (int ks = 0; ks < 4; ++ks) { F.lo[d0 * 4 + ks] = vtr(vp + d0 * 4096 + ks * 1024); F.hi[d0 * 4 + ks] = vtr(vp + d0 * 4096 + ks * 1024 + 512); }
}
template <bool SUM> __device__ __forceinline__ void pv(f32x16* o, f32x16& osum, VFrag& F, bf16x8 pa0, bf16x8 pa1, bf16x8 pa2, bf16x8 pa3) {
#define PK(k) (bf16x8){F.lo[k][0], F.lo[k][1], F.lo[k][2], F.lo[k][3], F.hi[k][0], F.hi[k][1], F.hi[k][2], F.hi[k][3]}
    const bf16x8 ones = {0x3F80, 0x3F80, 0x3F80, 0x3F80, 0x3F80, 0x3F80, 0x3F80, 0x3F80};
    __builtin_amdgcn_s_setprio(1);
    o[0] = __builtin_amdgcn_mfma_f32_32x32x16_bf16(pa0, PK(0), o[0], 0, 0, 0);
    o[1] = __builtin_amdgcn_mfma_f32_32x32x16_bf16(pa0, PK(4), o[1], 0, 0, 0);
    if (SUM) osum = __builtin_amdgcn_mfma_f32_32x32x16_bf16(pa0, ones, osum, 0, 0, 0);
    o[0] = __builtin_amdgcn_mfma_f32_32x32x16_bf16(pa1, PK(1), o[0], 0, 0, 0);
    o[1] = __builtin_amdgcn_mfma_f32_32x32x16_bf16(pa1, PK(5), o[1], 0, 0, 0);
    if (SUM) osum = __builtin_amdgcn_mfma_f32_32x32x16_bf16(pa1, ones, osum, 0, 0, 0);
    o[0] = __builtin_amdgcn_mfma_f32_32x32x16_bf16(pa2, PK(2), o[0], 0, 0, 0);
    o[1] = __builtin_amdgcn_mfma_f32_32x32x16_bf16(pa2, PK(6), o[1], 0, 0, 0);
    if (SUM) osum = __builtin_amdgcn_mfma_f32_32x32x16_bf16(pa2, ones, osum, 0, 0, 0);
    o[0] = __builtin_amdgcn_mfma_f32_32x32x16_bf16(pa3, PK(3), o[0], 0, 0, 0);
    o[1] = __builtin_amdgcn_mfma_f32_32x32x16_bf16(pa3, PK(7), o[1], 0, 0, 0);
    if (SUM) osum = __builtin_amdgcn_mfma_f32_32x32x16_bf16(pa3, ones, osum, 0, 0, 0);
    __builtin_amdgcn_s_setprio(0);
#undef PK
}
__device__ __forceinline__ float rowmax(const f32x16& p0, const f32x16& p1, int hi) {
    float a = __builtin_fmaxf(p0[0], p1[0]);
#pragma unroll
    for (int r = 1; r < 16; ++r) a = __builtin_fmaxf(__builtin_fmaxf(a, p0[r]), p1[r]);
    return __builtin_fmaxf(a, swap_other(a, hi));
}
struct KVRegs { u32x4 k, v; };
__device__ __forceinline__ void tile_load(KVRegs& R, const bf16_t* K, const bf16_t* V, int tid) { R.k = *(const u32x4*)(K + tid * 8); R.v = *(const u32x4*)(V + tid * 8); }
__device__ __forceinline__ void tile_store(const KVRegs& R, LAS char* Ks, LAS char* Vs, int tid) {
    const int row = tid >> 3, c = tid & 7;
    *(LAS u32x4*)(Ks + c * KCS + row * 16) = R.k;
    *(LAS u32x4*)(Vs + (c >> 2) * 4096 + (row >> 4) * 1024 + (row & 15) * 64 + (c & 3) * 16) = R.v;
}
__device__ __forceinline__ void ps_accum(const f32x16 p, int jb, LAS float* ps_row, bool writer) {
#pragma unroll
    for (int rg = 0; rg < 4; ++rg) {
        float a = 2.f * (p[4 * rg] + p[4 * rg + 1] + p[4 * rg + 2]) + p[4 * rg + 3], bq = p[4 * rg + 3];
        a += __shfl_xor(a, 1); a += __shfl_xor(a, 2); bq += __shfl_xor(bq, 1); bq += __shfl_xor(bq, 2);
        const int j = jb + 2 * rg;
        if (writer) { __hip_atomic_fetch_add(ps_row + j, a, __ATOMIC_RELAXED, __HIP_MEMORY_SCOPE_WORKGROUP); if (j + 1 < 128) __hip_atomic_fetch_add(ps_row + j + 1, bq, __ATOMIC_RELAXED, __HIP_MEMORY_SCOPE_WORKGROUP); }
    }
}
struct Ctx { LAS char* lds; LAS float* wsf; LAS float* otl; int tid, wid, lane, r32, hi, vbl; };
struct RowSt { float m, l; bool started; f32x16 negm, osum; };
__device__ __forceinline__ void rowst_init(RowSt& S) { S.m = 0.f; S.l = 0.f; S.started = false; S.negm = f32x16{}; S.osum = f32x16{}; asm volatile("" : "+v"(S.negm)); }
__device__ __forceinline__ void rowst_fixed(RowSt& S, float ref) { S.m = ref; S.l = 0.f; S.started = true; S.osum = f32x16{};
#pragma unroll
    for (int r = 0; r < 16; ++r) S.negm[r] = -ref;
    asm volatile("" : "+v"(S.negm)); }
template <int MODE, class Src, class Msk>
__device__ __forceinline__ void run_branch(const Ctx& C, int nt, const Src& src, const Msk& msk, const bf16x8* qr, RowSt& S, f32x16* o, LAS float* ps_row, bool ps_writer, KVRegs& R0, bool pre, const bf16_t* nk, const bf16_t* nv) {
    KVRegs R1; const bf16_t *kp, *vp;
    if (!pre) { src(0, kp, vp); tile_load(R0, kp, vp, C.tid); }
    if (nt > 1) { src(1, kp, vp); tile_load(R1, kp, vp, C.tid); }
    auto compute = [&](int it, const LAS char* Ks, const LAS char* Vs, int klo, int khi, bool nm) {
        const bool kill = khi < klo;
        if (!__any(!kill)) return;
        f32x16 p0, p1; qkt(p0, p1, Ks, qr, S.negm, C.r32, C.hi);
        VFrag VF; if constexpr (MODE != 0) v_issue(VF, Vs + C.vbl);
        if (__any(nm && !kill)) {
#pragma unroll
            for (int r = 0; r < 16; ++r) { const int kv = crow(r, C.hi); if (kv < klo || kv > khi) p0[r] = -INFINITY; if (kv + 32 < klo || kv + 32 > khi) p1[r] = -INFINITY; }
        }
        if constexpr (MODE != 2) {
            float rm = rowmax(p0, p1, C.hi); if (kill) rm = -INFINITY;
            const bool first = !S.started && rm > -INFINITY, grow = first || rm > 8.0f;
            if (__any(grow)) {
                const float d = grow ? rm : 0.f, alpha = first ? 1.0f : __builtin_amdgcn_exp2f(-d);
                S.m += d; S.started = S.started || first;
#pragma unroll
                for (int r = 0; r < 16; ++r) { S.negm[r] = -S.m; p0[r] -= d; p1[r] -= d; }
                if constexpr (MODE == 0) S.l *= alpha;
                if constexpr (MODE == 1) {
                    if (C.hi == 0) C.wsf[C.r32] = alpha;
                    LWAIT();
#pragma unroll
                    for (int r = 0; r < 16; ++r) { const float f = C.wsf[crow(r, C.hi)]; o[0][r] *= f; o[1][r] *= f; S.osum[r] *= f; }
                    LWAIT();
                }
            }
        }
#pragma unroll
        for (int r = 0; r < 16; ++r) { p0[r] = __builtin_amdgcn_exp2f(p0[r]); p1[r] = __builtin_amdgcn_exp2f(p1[r]); }
        if constexpr (MODE == 0) {
            float s = 0.f;
#pragma unroll
            for (int r = 0; r < 16; ++r) s += p0[r] + p1[r];
            S.l += kill ? 0.f : s;
        }
        if constexpr (MODE == 2) {
            if (__any(kill)) {
#pragma unroll
                for (int r = 0; r < 16; ++r) { p0[r] = kill ? 0.f : p0[r]; p1[r] = kill ? 0.f : p1[r]; }
            }
            ps_accum(p0, 16 * it + C.hi, ps_row, ps_writer); ps_accum(p1, 16 * it + 8 + C.hi, ps_row, ps_writer);
        }
        if constexpr (MODE != 0) {
            u32x4 w0 = {cvtpk(p0[0], p0[1]), cvtpk(p0[2], p0[3]), cvtpk(p0[4], p0[5]), cvtpk(p0[6], p0[7])}, w1 = {cvtpk(p0[8], p0[9]), cvtpk(p0[10], p0[11]), cvtpk(p0[12], p0[13]), cvtpk(p0[14], p0[15])};
            u32x4 w2 = {cvtpk(p1[0], p1[1]), cvtpk(p1[2], p1[3]), cvtpk(p1[4], p1[5]), cvtpk(p1[6], p1[7])}, w3 = {cvtpk(p1[8], p1[9]), cvtpk(p1[10], p1[11]), cvtpk(p1[12], p1[13]), cvtpk(p1[14], p1[15])};
            if constexpr (MODE == 1) {
                if (__any(kill)) {
#pragma unroll
                    for (int e = 0; e < 4; ++e) { w0[e] = kill ? 0u : w0[e]; w1[e] = kill ? 0u : w1[e]; w2[e] = kill ? 0u : w2[e]; w3[e] = kill ? 0u : w3[e]; }
                }
            }
            pv<MODE == 1>(o, S.osum, VF, __builtin_bit_cast(bf16x8, w0), __builtin_bit_cast(bf16x8, w1), __builtin_bit_cast(bf16x8, w2), __builtin_bit_cast(bf16x8, w3));
        }
    };
    LBAR();
    for (int it = 0; it < nt; it += 2) {
        const int p = (it >> 1) & 1; const bool two = it + 1 < nt;
        LAS char* KsA = C.lds + L_K0 + (2 * p) * KSLOT; LAS char* VsA = C.lds + L_V0 + (2 * p) * VSLOT;
        LAS char* KsB = KsA + KSLOT; LAS char* VsB = VsA + VSLOT;
        tile_store(R0, KsA, VsA, C.tid); if (two) tile_store(R1, KsB, VsB, C.tid);
        if (it + 2 < nt) { src(it + 2, kp, vp); tile_load(R0, kp, vp, C.tid); } else if (nk) tile_load(R0, nk, nv, C.tid);
        if (it + 3 < nt) { src(it + 3, kp, vp); tile_load(R1, kp, vp, C.tid); }
        int kloA, khiA, kloB = 0, khiB = -1; const bool nmA = msk(it, kloA, khiA); bool nmB = false; if (two) nmB = msk(it + 1, kloB, khiB);
        LBAR();
        compute(it, KsA, VsA, kloA, khiA, nmA);
        if (two) compute(it + 1, KsB, VsB, kloB, khiB, nmB);
    }
}
template <bool FIRST> __device__ __forceinline__ void merge_branch_n(const Ctx& C, const f32x16* o, const f32x16& osum, float gate) {
    if (C.hi == 0) C.wsf[C.r32] = gate;
    LWAIT();
#pragma unroll
    for (int r = 0; r < 16; ++r) { const float den = osum[r], f = den > 0.f ? C.wsf[crow(r, C.hi)] * __builtin_amdgcn_rcpf(den) : 0.f;
        if (FIRST) { C.otl[r * 64] = o[0][r] * f; C.otl[(16 + r) * 64] = o[1][r] * f; }
        else { C.otl[r * 64] += o[0][r] * f; C.otl[(16 + r) * 64] += o[1][r] * f; } }
    LWAIT();
}
template <bool FIRST> __device__ __forceinline__ void merge_branch(const Ctx& C, const f32x16* o, float factor) {
    if (C.hi == 0) C.wsf[C.r32] = factor;
    LWAIT();
#pragma unroll
    for (int r = 0; r < 16; ++r) { const float f = C.wsf[crow(r, C.hi)];
        if (FIRST) { C.otl[r * 64] = o[0][r] * f; C.otl[(16 + r) * 64] = o[1][r] * f; }
        else { C.otl[r * 64] += o[0][r] * f; C.otl[(16 + r) * 64] += o[1][r] * f; } }
    LWAIT();
}
struct Bufs { const bf16_t *Qn, *KV, *Mo, *KC, *KM, *Gn; bf16_t* Abr; };
constexpr size_t KV_STRIDE = (size_t)MTOK * 128, MO_STRIDE = (size_t)MTOK * 256;

__device__ __forceinline__ void nsa_item(const Ctx& C, const Bufs& B, int b, int g, int i) {
    const int r32 = C.r32, hi = C.hi, wid = C.wid;
    const int qi = 8 * wid + (r32 >> 2), hh = r32 & 3, head = g * 4 + hh, t = 64 * i + qi, cur = i;
    const size_t bg = (size_t)(b * 2 + g) * SEQ;
    bf16x8 qr[4];
    { const bf16_t* qp = B.Qn + ((size_t)(b * 8 + head) * SEQ + t) * 64 + hi * 8;
#pragma unroll
      for (int d0 = 0; d0 < 4; ++d0) qr[d0] = *(const bf16x8*)(qp + d0 * 16); }
    const unsigned gw = *(const unsigned*)(B.Gn + ((size_t)b * SEQ + t) * 32 + head * 3 - (head & 1));
    const unsigned gw2 = *(const unsigned*)(B.Gn + ((size_t)b * SEQ + t) * 32 + head * 3 - (head & 1) + 2);
    float g0, g1, g2; if (head & 1) { g0 = bfhi(gw); g1 = bflo(gw2); g2 = bfhi(gw2); } else { g0 = bflo(gw); g1 = bfhi(gw); g2 = bflo(gw2); }
    f32x16 o[2];
    LAS float* Ps = (LAS float*)(C.lds + L_PS); LAS unsigned* Mk = (LAS unsigned*)(C.lds + L_MSK); LAS unsigned* Uni = (LAS unsigned*)(C.lds + L_UNI); LAS int* List = (LAS int*)(C.lds + L_LIST);
    const int nv = t >= 31 ? ((t - 31) >> 4) + 1 : 0;
    const int nvt = (4 * i + 3 < 511) ? 4 * i + 3 : 511, ntc = (nvt + 63) >> 6;
    const bf16_t* kc = B.KC + (size_t)(0 * 4 + b * 2 + g) * 512 * 64; const bf16_t* vc = B.KC + (size_t)(1 * 4 + b * 2 + g) * 512 * 64;
    auto srcC = [&](int it, const bf16_t*& kp, const bf16_t*& vp) { kp = kc + (size_t)it * 4096; vp = vc + (size_t)it * 4096; };
    auto mskC = [&](int it, int& klo, int& khi) { klo = 0; khi = nv - 1 - 64 * it; return khi < 63; };
    RowSt S; rowst_init(S);
    KVRegs R;
    run_branch<0>(C, ntc, srcC, mskC, qr, S, o, nullptr, false, R, false, kc, vc);
    const float lt = S.l + swap_other(S.l, hi);
    rowst_fixed(S, lt > 0.f ? S.m + __builtin_amdgcn_logf(lt) : 0.f);
    for (int e = C.tid; e < 64 * 128; e += 512) Ps[e] = 0.f;
    if (C.tid < 8) Uni[C.tid] = 0u;
    o[0] = f32x16{}; o[1] = f32x16{};
    run_branch<2>(C, ntc, srcC, mskC, qr, S, o, Ps + qi * 128, hh == 0, R, true, B.KV + 2 * KV_STRIDE + bg * 64, B.KV + 3 * KV_STRIDE + bg * 64);
    LBAR();
    {
        const int nf = cur == 0 ? 1 : (cur == 1 ? 2 : 3), kp_ = 16 - nf, lane = C.lane;
#pragma unroll 1
        for (int qq = 0; qq < 8; ++qq) {
            int q = 8 * wid + qq; asm volatile("" : "+s"(q)); LAS float* ps = Ps + q * 128;
            const int j0 = lane, j1 = lane + 64;
            const bool f0 = (j0 == 0 || j0 == cur || j0 == cur - 1) && j0 <= cur, f1 = (j1 == cur || j1 == cur - 1) && j1 <= cur;
            const bool va0 = j0 <= cur && !f0, va1 = j1 <= cur && !f1;
            const unsigned k0 = va0 ? __float_as_uint(ps[j0]) + 1u : 0u, k1 = va1 ? __float_as_uint(ps[j1]) + 1u : 0u;
            unsigned T = 0u;
            for (int bit = 30; bit >= 0; --bit) { const unsigned cand = T | (1u << bit); const int cnt = __popcll(__ballot(k0 >= cand)) + __popcll(__ballot(k1 >= cand)); if (cnt >= kp_) T = cand; }
            const int need = kp_ - (__popcll(__ballot(k0 > T)) + __popcll(__ballot(k1 > T)));
            const unsigned long long t0 = __ballot(k0 == T), t1 = __ballot(k1 == T), below = (1ull << lane) - 1ull;
            const int pre0 = __popcll(t0 & below), pre1 = __popcll(t0) + __popcll(t1 & below);
            const bool s0 = f0 || (k0 > 0u && (k0 > T || (k0 == T && pre0 < need))), s1 = f1 || (k1 > 0u && (k1 > T || (k1 == T && pre1 < need)));
            const unsigned long long b0 = __ballot(s0), b1 = __ballot(s1);
            if (lane == 0) { Mk[q * 4 + 0] = (unsigned)b0; Mk[q * 4 + 1] = (unsigned)(b0 >> 32); Mk[q * 4 + 2] = (unsigned)b1; Mk[q * 4 + 3] = (unsigned)(b1 >> 32);
                __hip_atomic_fetch_or(&Uni[0], (unsigned)b0, __ATOMIC_RELAXED, __HIP_MEMORY_SCOPE_WORKGROUP); __hip_atomic_fetch_or(&Uni[1], (unsigned)(b0 >> 32), __ATOMIC_RELAXED, __HIP_MEMORY_SCOPE_WORKGROUP); __hip_atomic_fetch_or(&Uni[2], (unsigned)b1, __ATOMIC_RELAXED, __HIP_MEMORY_SCOPE_WORKGROUP); __hip_atomic_fetch_or(&Uni[3], (unsigned)(b1 >> 32), __ATOMIC_RELAXED, __HIP_MEMORY_SCOPE_WORKGROUP); }
        }
    }
    LBAR();
    if (C.tid < 128) {
        const int wi = C.tid >> 5, bi = C.tid & 31; const unsigned u0 = Uni[0], u1 = Uni[1], u2 = Uni[2], u3 = Uni[3];
        const unsigned mine = wi == 0 ? u0 : wi == 1 ? u1 : wi == 2 ? u2 : u3;
        const int before = (wi > 0 ? __popc(u0) : 0) + (wi > 1 ? __popc(u1) : 0) + (wi > 2 ? __popc(u2) : 0) + __popc(mine & ((1u << bi) - 1u));
        if ((mine >> bi) & 1u) List[before] = C.tid;
        if (C.tid == 0) Uni[4] = (unsigned)(__popc(u0) + __popc(u1) + __popc(u2) + __popc(u3));
    }
    LBAR();
    merge_branch<true>(C, o, g0);
    {
        const int nsel = (int)Uni[4];
        const bf16_t* ks = B.KV + 2 * KV_STRIDE + bg * 64; const bf16_t* vs = B.KV + 3 * KV_STRIDE + bg * 64;
        auto srcS = [&](int it, const bf16_t*& kp, const bf16_t*& vp) { const int j = List[it]; kp = ks + (size_t)j * 4096; vp = vs + (size_t)j * 4096; };
        auto mskS = [&](int it, int& klo, int& khi) { const int j = List[it]; const unsigned w = Mk[qi * 4 + (j >> 5)]; const bool bit = (w >> (j & 31)) & 1u;
            klo = 0; khi = bit ? (j == cur ? qi : 63) : -1; return j == cur; };
        rowst_init(S); o[0] = f32x16{}; o[1] = f32x16{};
        const int tw0n = i >= 8 ? i - 8 : 0;
        run_branch<1>(C, nsel, srcS, mskS, qr, S, o, nullptr, false, R, true, B.KV + 4 * KV_STRIDE + bg * 64 + (size_t)tw0n * 4096, B.KV + 5 * KV_STRIDE + bg * 64 + (size_t)tw0n * 4096);
        merge_branch_n<false>(C, o, S.osum, g1);
    }
    {
        const int tw0 = i >= 8 ? i - 8 : 0, ntw = i - tw0 + 1;
        const bf16_t* kw = B.KV + 4 * KV_STRIDE + bg * 64; const bf16_t* vw = B.KV + 5 * KV_STRIDE + bg * 64;
        auto srcW = [&](int it, const bf16_t*& kp, const bf16_t*& vp) { kp = kw + (size_t)(tw0 + it) * 4096; vp = vw + (size_t)(tw0 + it) * 4096; };
        auto mskW = [&](int it, int& klo, int& khi) { const int tw = tw0 + it; klo = (t - 511) - 64 * tw; khi = (tw == i) ? qi : 63; return tw == i || klo > 0; };
        rowst_init(S); o[0] = f32x16{}; o[1] = f32x16{};
        run_branch<1>(C, ntw, srcW, mskW, qr, S, o, nullptr, false, R, true, nullptr, nullptr);
        merge_branch_n<false>(C, o, S.osum, g2);
    }
#pragma unroll
    for (int r = 0; r < 16; ++r) { const int qrow = crow(r, hi); bf16_t* dst = B.Abr + ((size_t)b * SEQ + 64 * i + 8 * wid + (qrow >> 2)) * DM + 256 + (g * 4 + (qrow & 3)) * 64 + r32;
        dst[0] = (bf16_t)(cvtpk(C.otl[r * 64], 0.f) & 0xffffu); dst[32] = (bf16_t)(cvtpk(C.otl[(16 + r) * 64], 0.f) & 0xffffu); }
}
__device__ __forceinline__ void moba_item(const Ctx& C, const Bufs& B, int b, int h, int qb) {
    const int r32 = C.r32, hi = C.hi, wid = C.wid, own = qb, t = 256 * qb + 32 * wid + r32;
    const size_t bh = (size_t)(b * 4 + h) * SEQ;
    bf16x8 qr[4];
    { const bf16_t* qp = B.Mo + (bh + t) * 64 + hi * 8;
#pragma unroll
      for (int d0 = 0; d0 < 4; ++d0) qr[d0] = *(const bf16x8*)(qp + d0 * 16); }
    LAS unsigned* Uni = (LAS unsigned*)(C.lds + L_UNI); LAS int* List = (LAS int*)(C.lds + L_LIST);
    LBAR();
    if (C.tid < 256) { const u32x4 kmv = *(const u32x4*)(B.KM + (size_t)(b * 4 + h) * 2048 + C.tid * 8); *(LAS u32x4*)(C.lds + L_K0 + (C.tid & 7) * KCS + (C.tid >> 3) * 16) = kmv; }
    if (C.tid == 0) Uni[0] = 0u;
    LBAR();
    unsigned sel = 0u;
    {
        f32x16 gs = f32x16{};
        const LAS char* kb = C.lds + L_K0 + hi * KCS + r32 * 16;
#pragma unroll
        for (int d0 = 0; d0 < 4; ++d0) gs = __builtin_amdgcn_mfma_f32_32x32x16_bf16(*(const LAS bf16x8*)(kb + d0 * 2 * KCS), qr[d0], gs, 0, 0, 0);
        float lo[16], hv[16];
#pragma unroll
        for (int r = 0; r < 16; ++r) { const float ownv = gs[r], oth = swap_other(ownv, hi); lo[r] = hi ? oth : ownv; hv[r] = hi ? ownv : oth; }
        unsigned taken = ~((1u << own) - 1u);
#pragma unroll
        for (int round = 0; round < 3; ++round) {
            float best = -INFINITY; int bi = 32;
#pragma unroll
            for (int n = 0; n < 32; ++n) { const int rr = (n & 3) + 4 * (n >> 3); const float v = ((n >> 2) & 1) ? hv[rr] : lo[rr]; if (!((taken >> n) & 1u) && v > best) { best = v; bi = n; } }
            if (bi < 32) { sel |= 1u << bi; taken |= 1u << bi; }
        }
    }
    { unsigned u = sel;
#pragma unroll
      for (int o_ = 1; o_ < 64; o_ <<= 1) u |= (unsigned)__shfl_xor((int)u, o_);
      if (C.lane == 0) __hip_atomic_fetch_or(&Uni[0], u, __ATOMIC_RELAXED, __HIP_MEMORY_SCOPE_WORKGROUP); }
    LBAR();
    if (C.tid == 0) { int n = 0; unsigned u = Uni[0]; while (u) { const int bpos = __builtin_ctz(u); u &= u - 1; List[n++] = bpos; } Uni[4] = (unsigned)n; }
    LBAR();
    const int nl = (int)Uni[4], nt = 4 * nl + 4;
    const bf16_t* kk = B.Mo + MO_STRIDE + bh * 64; const bf16_t* vv = B.Mo + 2 * MO_STRIDE + bh * 64;
    auto src = [&](int it, const bf16_t*& kp, const bf16_t*& vp) { const int T = (it < 4 * nl) ? 4 * List[it >> 2] + (it & 3) : 4 * own + (it - 4 * nl); kp = kk + (size_t)T * 4096; vp = vv + (size_t)T * 4096; };
    auto msk = [&](int it, int& klo, int& khi) { klo = 0; if (it < 4 * nl) { const bool bit = (sel >> List[it >> 2]) & 1u; khi = bit ? 63 : -1; return false; } khi = 32 * wid + r32 - 64 * (it - 4 * nl); return true; };
    RowSt S; rowst_init(S); f32x16 o[2] = {f32x16{}, f32x16{}};
    KVRegs R;
    run_branch<1>(C, nt, src, msk, qr, S, o, nullptr, false, R, false, nullptr, nullptr);
    merge_branch_n<true>(C, o, S.osum, 1.0f);
#pragma unroll
    for (int r = 0; r < 16; ++r) { const int qrow = crow(r, hi); bf16_t* dst = B.Abr + ((size_t)b * SEQ + 256 * qb + 32 * wid + qrow) * DM + 768 + h * 64 + r32;
        dst[0] = (bf16_t)(cvtpk(C.otl[r * 64], 0.f) & 0xffffu); dst[32] = (bf16_t)(cvtpk(C.otl[(16 + r) * 64], 0.f) & 0xffffu); }
}
}
#define XB_TMO      128
#define XB_XCNT(j)  (256  + 64 * (j))
#define XB_XSUB(j)  (1280 + 64 * (j))
#define XB_XGEN(j)  (2304 + 64 * (j))
#define XB_TOP      3328
#define XB_TOPGEN   3392
#define XCD_BAR_WORDS 3456
#define XB_SPIN_CAP (1u << 18)

__device__ __forceinline__ unsigned xb_ld(unsigned* p)              { return __hip_atomic_load(p, __ATOMIC_RELAXED, __HIP_MEMORY_SCOPE_AGENT); }
__device__ __forceinline__ unsigned xb_add(unsigned* p, unsigned v) { return __hip_atomic_fetch_add(p, v, __ATOMIC_RELAXED, __HIP_MEMORY_SCOPE_AGENT); }
__device__ __forceinline__ unsigned xb_xcc_id() { return (unsigned)__builtin_amdgcn_s_getreg((3 << 11) | 20) & 0xFu; }
#define XB_SPIN(cond, bar) do { unsigned _sp = 0; while (cond) { __builtin_amdgcn_s_sleep(1); \
    if ((++_sp & 255u) == 0u) { if (xb_ld(&(bar)[XB_TMO])) break; if (_sp > XB_SPIN_CAP) { atomicAdd(&(bar)[XB_TMO], 1u); break; } } } } while (0)

struct XcdBarrier {
    unsigned* bar; unsigned x;
    volatile LAS unsigned* st;
};

__device__ __forceinline__ XcdBarrier xcd_barrier_post(unsigned* bar, volatile LAS unsigned* st) {
    XcdBarrier b; b.bar = bar; b.x = xb_xcc_id(); b.st = st;
    if (threadIdx.x == 0) (void)xb_add(&bar[XB_XCNT(b.x)], 1u);
    return b;
}
__device__ __forceinline__ void xcd_barrier_complete(unsigned* bar, unsigned x, unsigned& nloc, unsigned& nx) {
    const unsigned G = gridDim.x * gridDim.y * gridDim.z;
    unsigned sum, cnt, mine, sp = 0u;
    for (;;) {
        sum = 0u; cnt = 0u; mine = 0u;
#pragma unroll
        for (unsigned j = 0; j < 16; ++j) { const unsigned c = xb_ld(&bar[XB_XCNT(j)]); sum += c; cnt += (c > 0u) ? 1u : 0u; mine = (j == x) ? c : mine; }
        if (sum == G) break;
        __builtin_amdgcn_s_sleep(1);
        if ((++sp & 255u) == 0u) { if (xb_ld(&bar[XB_TMO])) break; if (sp > XB_SPIN_CAP) { atomicAdd(&bar[XB_TMO], 1u); break; } }
    }
    nloc = mine > 0u ? mine : 1u; nx = cnt > 0u ? cnt : 1u;
}

__device__ __forceinline__ void xcd_barrier(const XcdBarrier& b) {
    asm volatile("s_waitcnt vmcnt(0)" ::: "memory");
    __syncthreads();
    if (threadIdx.x == 0) {
        unsigned* bar = b.bar;
        __builtin_amdgcn_s_waitcnt(0);
        unsigned nloc = b.st[0], nx = b.st[1];
        if (nloc == 0u) { xcd_barrier_complete(bar, b.x, nloc, nx); b.st[0] = nloc; b.st[1] = nx; }
        const unsigned old = xb_add(&bar[XB_XSUB(b.x)], 1u);
        const unsigned gen = old / nloc;
        if (old + 1u == (gen + 1u) * nloc) {
            __builtin_amdgcn_fence(__ATOMIC_RELEASE, "agent");
            asm volatile("s_waitcnt vmcnt(0)" ::: "memory");
            const unsigned og = xb_add(&bar[XB_TOP], 1u);
            const unsigned tg = og / nx;
            if (og + 1u == (tg + 1u) * nx) xb_add(&bar[XB_TOPGEN], 1u);
            else XB_SPIN(xb_ld(&bar[XB_TOPGEN]) == tg, bar);
            __builtin_amdgcn_fence(__ATOMIC_ACQUIRE, "agent");
            xb_add(&bar[XB_XGEN(b.x)], 1u);
            asm volatile("s_waitcnt vmcnt(0)" ::: "memory");
        } else {
            XB_SPIN(xb_ld(&bar[XB_XGEN(b.x)]) == gen, bar);
            __builtin_amdgcn_fence(__ATOMIC_ACQUIRE, "agent");
            asm volatile("s_waitcnt vmcnt(0)" ::: "memory");
        }
    }
    __syncthreads();
}

constexpr size_t MiB = 1u << 20;
constexpr size_t WS_CTL = 0, WS_ORDER = 4096, WS_BAR = 8192;
constexpr size_t WS_W = 1 * MiB, OFF_WIN = 0, OFF_WGU = 11 * MiB, OFF_WD = 22 * MiB, OFF_WBR = 28 * MiB, OFF_WOUT = 30 * MiB, OFF_W1 = 32 * MiB, OFF_W2 = 34 * MiB,
                 OFF_BIN = 34 * MiB + 65536, OFF_CB1 = OFF_BIN + 32768  , OFF_CB2 = OFF_CB1 + 65536;
constexpr size_t WS_TAB = 36 * MiB, WS_SSP = 38 * MiB, WS_KC = 39 * MiB, WS_KM = 39 * MiB + 512 * 1024, WS_GN = 40 * MiB, WS_XB = 42 * MiB, WS_BIG = 74 * MiB,
                 WS_U = 170 * MiB, WS_QN = 178 * MiB, WS_KV = 194 * MiB, WS_MO = 218 * MiB, WS_MRG = 178 * MiB, WS_END = 242 * MiB;
constexpr int LDS_BYTES = 147456;

__device__ __forceinline__ int dint(int pos) { return (pos >> 1) + 32 * (pos & 1); }
__device__ __forceinline__ int in_orig(int c) {
    if (c < 256) return c;
    if (c < 768) { const int c2 = c - 256; return 256 + (c2 >> 6) * 64 + dint(c2 & 63); }
    if (c < 1536) { const int c2 = c - 768, tt = c2 >> 8, bj = (c2 >> 7) & 1, g = (c2 >> 6) & 1, pos = c2 & 63; return 768 + (2 * tt + bj) * 128 + g * 64 + (bj == 0 ? dint(pos) : pos); }
    if (c < 2304) { const int c2 = c - 1536, part = c2 >> 8, h = (c2 >> 6) & 3, pos = c2 & 63; return 1560 + part * 256 + h * 64 + (part < 2 ? dint(pos) : pos); }
    if (c < 5376) return 2328 + (c - 2304);
    const int c2 = c - 5376; return c2 < 24 ? 1536 + c2 : -1;
}
template <class F> __device__ __forceinline__ void cvt_tile(LAS float* scr, int lane, int k0, int n0, bf16_t* dst, size_t pitch, F f) {
    float vals[32];
#pragma unroll
    for (int i = 0; i < 32; ++i) vals[i] = f(k0 + 2 * i + (lane >> 5), n0 + (lane & 31));
#pragma unroll
    for (int i = 0; i < 32; ++i) scr[(2 * i + (lane >> 5)) * 33 + (lane & 31)] = vals[i];
    asm volatile("s_waitcnt lgkmcnt(0)" ::: "memory");
    const int c = lane & 7;
#pragma unroll
    for (int j = 0; j < 4; ++j) { const int n = (lane >> 3) + 8 * j; const LAS float* s = scr + (8 * c) * 33 + n;
        u32x4 o; o.x = cvtpk(s[0 * 33], s[1 * 33]); o.y = cvtpk(s[2 * 33], s[3 * 33]); o.z = cvtpk(s[4 * 33], s[5 * 33]); o.w = cvtpk(s[6 * 33], s[7 * 33]);
        *(u32x4*)(dst + (size_t)(n0 + n) * pitch + k0 + 8 * c) = o; }
    asm volatile("s_waitcnt lgkmcnt(0)" ::: "memory");
}
struct Args { const float* in[20]; float* out; unsigned char* ws; };
typedef const __attribute__((address_space(4))) Args* ArgsP;

__device__ __forceinline__ void phase0(ArgsP a, int l, LAS unsigned char* lds, int tid, int lane, int wave, int gw, int NGW) {
    unsigned char* ws = a->ws;
    LAS float* scr = (LAS float*)(lds + wave * 8704);
    const float* attn_norm = a->in[1] + (size_t)l * DM; const float* w_in = a->in[2] + (size_t)l * DM * IN_COLS; const float* b_in = a->in[3] + (size_t)l * IN_COLS;
    const float* pool_w = a->in[4] + (size_t)l * 4 * 64 * 64; const float* pool_scale = a->in[5] + (size_t)l * 256; const float* cmp_pos = a->in[6] + (size_t)l * 2 * 32 * 64;
    const float* cmp_w1 = a->in[7] + (size_t)l * 2 * 2048 * 256; const float* cmp_b1 = a->in[8] + (size_t)l * 2 * 256; const float* cmp_w2 = a->in[9] + (size_t)l * 2 * 256 * 64; const float* cmp_b2 = a->in[10] + (size_t)l * 2 * 64;
    const float* w_br_pool = a->in[11] + (size_t)l * 256 * DM; const float* w_br_nsa = a->in[12] + (size_t)l * 512 * DM; const float* w_br_moba = a->in[13] + (size_t)l * 256 * DM;
    const float* w_out = a->in[14] + (size_t)l * DM * DM; const float* ffn_norm = a->in[15] + (size_t)l * DM; const float* w_gate = a->in[16] + (size_t)l * DM * DFF; const float* w_up = a->in[17] + (size_t)l * DM * DFF;
    const float* w_down = a->in[18] + (size_t)l * DFF * DM;
    bf16_t* Win = (bf16_t*)(ws + WS_W + OFF_WIN); bf16_t* Wgu = (bf16_t*)(ws + WS_W + OFF_WGU); bf16_t* Wd = (bf16_t*)(ws + WS_W + OFF_WD); bf16_t* Wbr = (bf16_t*)(ws + WS_W + OFF_WBR);
    bf16_t* Wout = (bf16_t*)(ws + WS_W + OFF_WOUT); bf16_t* W1t = (bf16_t*)(ws + WS_W + OFF_W1); bf16_t* W2t = (bf16_t*)(ws + WS_W + OFF_W2);
    float* bin = (float*)(ws + WS_W + OFF_BIN); float* cb1 = (float*)(ws + WS_W + OFF_CB1); float* cb2 = (float*)(ws + WS_W + OFF_CB2);
    constexpr int I_A = 16 * 176, I_B = 16 * 176, I_C = 44 * 32, I_D = 16 * 32, I_E = 16 * 32, I_F = 2 * 32 * 8, I_G = 2 * 4 * 2;
    constexpr int NITEMS = I_A + I_B + I_C + I_D + I_E + I_F + I_G;
    for (int it = gw; it < NITEMS; it += NGW) {
        int r = it;
        if (r < I_A) { const int kb = r / 176, nb = r % 176; cvt_tile(scr, lane, 64 * kb, 32 * nb, Win, DM, [&](int k, int n) { const int o = in_orig(n); const float v = w_in[(size_t)k * IN_COLS + (o >= 0 ? o : 0)] * attn_norm[k]; return o >= 0 ? v : 0.f; }); continue; } r -= I_A;
        if (r < I_B) { const int kb = r / 176, nb = r % 176; cvt_tile(scr, lane, 64 * kb, 32 * nb, Wgu, DM, [&](int k, int n) { const int j = (n >> 8) * 128 + (n & 127); const float* s = ((n >> 7) & 1) ? w_up : w_gate; return s[(size_t)k * DFF + j] * ffn_norm[k]; }); continue; } r -= I_B;
        if (r < I_C) { const int kb = r / 32, nb = r % 32; cvt_tile(scr, lane, 64 * kb, 32 * nb, Wd, DFF, [&](int k, int n) { return w_down[(size_t)k * DM + n]; }); continue; } r -= I_C;
        if (r < I_D) { const int kb = r / 32, nb = r % 32; cvt_tile(scr, lane, 64 * kb, 32 * nb, Wout, DM, [&](int k, int n) { return w_out[(size_t)k * DM + n]; }); continue; } r -= I_D;
        if (r < I_E) { const int kb = r / 32, nb = r % 32;
            if (kb < 4) { }
            else if (kb < 12) cvt_tile(scr, lane, 64 * kb, 32 * nb, Wbr, DM, [&](int k, int n) { return w_br_nsa[(size_t)(k - 256) * DM + n]; });
            else cvt_tile(scr, lane, 64 * kb, 32 * nb, Wbr, DM, [&](int k, int n) { return w_br_moba[(size_t)(k - 768) * DM + n]; });
            continue; } r -= I_E;
        if (r < I_F) { const int kv = r >> 8, kb = (r >> 3) & 31, nb = r & 7; const float* w1 = cmp_w1 + (size_t)kv * 2048 * 256;
            cvt_tile(scr, lane, 64 * kb, 32 * nb, W1t + (size_t)kv * 256 * 2048, 2048, [&](int k, int n) { const int pos = k & 63, d = kv == 0 ? dint(pos) : pos; return w1[(size_t)((k & ~63) + d) * 256 + n]; }); continue; } r -= I_F;
        { const int kv = r >> 3, kb = (r >> 1) & 3, nb = r & 1; const float* w2 = cmp_w2 + (size_t)kv * 256 * 64;
            cvt_tile(scr, lane, 64 * kb, 32 * nb, W2t + (size_t)kv * 64 * 256, 256, [&](int k, int n) { return w2[(size_t)k * 64 + (kv == 0 ? dint(n) : n)]; }); }
    }
    const int gt = gw * 64 + lane, NGT = NGW * 64;
    for (int c = gt; c < NIN; c += NGT) { const int o = in_orig(c); bin[c] = o >= 0 ? b_in[o] : 0.f; }
    for (int idx = gt; idx < 32 * 512; idx += NGT) { const int c = idx >> 9, e = idx & 511, kv = e >> 8, n = e & 255; const float* w1 = cmp_w1 + (size_t)kv * 2048 * 256 + (size_t)(64 * c) * 256 + n; const float* pe = cmp_pos + (size_t)kv * 2048 + 64 * c;
        float s = c == 0 ? cmp_b1[kv * 256 + n] : 0.f;
#pragma unroll 16
        for (int k = 0; k < 64; ++k) s += pe[k] * w1[(size_t)k * 256];
        cb1[idx] = s; }
    for (int idx = gt; idx < 256 * DM; idx += NGT) { const int k = idx >> 10, n = idx & 1023, g64 = k & ~63; float s = 0.f;
#pragma unroll 16
        for (int j = 0; j < 64; ++j) s += pool_w[k * 64 + j] * pool_scale[g64 + j] * w_br_pool[(size_t)(g64 + j) * DM + n];
        Wbr[(size_t)n * DM + k] = (bf16_t)(cvtpk(s, 0.f) & 0xffffu); }
    for (int e = gt; e < 128; e += NGT) { const int kv = e >> 6, n = e & 63; cb2[e] = cmp_b2[kv * 64 + (kv == 0 ? dint(n) : n)]; }
    if (l == 0) {
        float* tab = (float*)(ws + WS_TAB);
        for (int e = gt; e < SEQ * 32; e += NGT) { const int t = e >> 5, f = e & 31; const float inv = powf(10000.0f, -(float)(2 * f) / 64.0f); const float ang = (float)t * inv;
            const double ad = (double)ang, kq = rint(ad * 0.15915494309189535); double rr = fma(-kq, 6.283185307179586, ad); rr = fma(-kq, 2.4492935982947064e-16, rr);
            const float rf = (float)rr; tab[2 * e] = __cosf(rf); tab[2 * e + 1] = __sinf(rf); }
        const float* x = a->in[0]; bf16_t* xb = (bf16_t*)(ws + WS_XB); float* ssp = (float*)(ws + WS_SSP);
        for (int m0 = 2 * gw; m0 < MTOK; m0 += 2 * NGW) { f32x4 v[2][4]; float s[2] = {0.f, 0.f};
#pragma unroll
            for (int q = 0; q < 2; ++q) { const f32x4* xr = (const f32x4*)(x + (size_t)(m0 + q) * DM) + lane;
#pragma unroll
                for (int j = 0; j < 4; ++j) v[q][j] = xr[64 * j]; }
#pragma unroll
            for (int q = 0; q < 2; ++q) {
#pragma unroll
                for (int j = 0; j < 4; ++j) s[q] += (v[q][j][0] * v[q][j][0] + v[q][j][1] * v[q][j][1]) + (v[q][j][2] * v[q][j][2] + v[q][j][3] * v[q][j][3]);
#pragma unroll
                for (int o = 1; o < 64; o <<= 1) s[q] += __shfl_xor(s[q], o);
                u32x2* o8 = (u32x2*)(xb + (size_t)(m0 + q) * DM) + lane;
#pragma unroll
                for (int j = 0; j < 4; ++j) o8[64 * j] = (u32x2){cvtpk(v[q][j][0], v[q][j][1]), cvtpk(v[q][j][2], v[q][j][3])};
                if (lane < 16) ssp[(size_t)(m0 + q) * 16 + lane] = lane == 0 ? s[q] : 0.f; } }
        int* order = (int*)(ws + WS_ORDER);
        auto cost = [](int id) { if (id < 512) { const int i = id & 127; return 10 * ((i + 1) + ((i < 8 ? i : 8) + 1) + 10) + 16 * ((4 * i + 3 + 63) >> 6); } const int qb = (id - 512) & 31; return 7 * (4 * qb + 3) + 50; };
        for (int id = gw; id < 768; id += NGW) { const int mc = cost(id); int rk = 0;
            for (int j = lane; j < 768; j += 64) { const int cj = cost(j); rk += (cj > mc || (cj == mc && j < id)) ? 1 : 0; }
#pragma unroll
            for (int o = 1; o < 64; o <<= 1) rk += __shfl_xor(rk, o);
            if (lane == 0) order[rk] = id; }
    }
}
__device__ __forceinline__ float gelu_tanh(float x) { const float u = 0.7978845608028654f * (x + 0.044715f * x * x * x); const float th = 1.f - 2.f * __builtin_amdgcn_rcpf(1.f + __expf(2.f * u)); return 0.5f * x * (1.f + th); }
__device__ __forceinline__ void phase2(ArgsP a, LAS unsigned char* lds, int tid, int lane, int wave, int G) {
    unsigned char* ws = a->ws;
    const bf16_t* KV = (const bf16_t*)(ws + WS_KV); const bf16_t* W1t = (const bf16_t*)(ws + WS_W + OFF_W1); const bf16_t* W2t = (const bf16_t*)(ws + WS_W + OFF_W2);
    const float* cb1 = (const float*)(ws + WS_W + OFF_CB1); const float* cb2 = (const float*)(ws + WS_W + OFF_CB2);
    bf16_t* KC = (bf16_t*)(ws + WS_KC);
    LAS bf16_t* hid = (LAS bf16_t*)lds;
    const int arow = lane & 15, kq = lane >> 4;
    for (int task = blockIdx.x; task < 256; task += G) {
        const int kv = task >> 7, bgi = (task >> 5) & 3, nt = task & 31;
        const bf16_t* src = KV + (size_t)kv * att::KV_STRIDE + (size_t)bgi * SEQ * 64;
        const int nrow = 16 * nt + arow, neff = nrow < 510 ? nrow : 510;
        const bf16_t* ap = src + (size_t)neff * 1024 + kq * 8;
        const bf16_t* bp0 = W1t + (size_t)kv * 256 * 2048 + (size_t)(32 * wave + arow) * 2048 + kq * 8; const bf16_t* bp1 = bp0 + 16 * 2048;
        f32x4 c0 = {0.f, 0.f, 0.f, 0.f}, c1 = {0.f, 0.f, 0.f, 0.f};
#pragma unroll 8
        for (int ks = 0; ks < 64; ++ks) { const bf16x8 av = *(const bf16x8*)(ap + ks * 32), b0 = *(const bf16x8*)(bp0 + ks * 32), b1 = *(const bf16x8*)(bp1 + ks * 32);
            c0 = __builtin_amdgcn_mfma_f32_16x16x32_bf16(av, b0, c0, 0, 0, 0); c1 = __builtin_amdgcn_mfma_f32_16x16x32_bf16(av, b1, c1, 0, 0, 0); }
        { const int col0 = 32 * wave + arow; float bb0 = 0.f, bb1 = 0.f;
#pragma unroll 8
          for (int c = 0; c < 32; ++c) { bb0 += cb1[c * 512 + kv * 256 + col0]; bb1 += cb1[c * 512 + kv * 256 + col0 + 16]; }
#pragma unroll
          for (int j = 0; j < 4; ++j) { const int row = kq * 4 + j; hid[row * 264 + col0] = (bf16_t)(cvtpk(gelu_tanh(c0[j] + bb0), 0.f) & 0xffffu); hid[row * 264 + col0 + 16] = (bf16_t)(cvtpk(gelu_tanh(c1[j] + bb1), 0.f) & 0xffffu); } }
        LBAR();
        if (wave < 4) {
            const bf16_t* bp = W2t + (size_t)kv * 64 * 256 + (size_t)(16 * wave + arow) * 256 + kq * 8; f32x4 c = {0.f, 0.f, 0.f, 0.f};
#pragma unroll
            for (int ks = 0; ks < 8; ++ks) { const bf16x8 av = *(const LAS bf16x8*)(hid + arow * 264 + kq * 8 + ks * 32), bv = *(const bf16x8*)(bp + ks * 32); c = __builtin_amdgcn_mfma_f32_16x16x32_bf16(av, bv, c, 0, 0, 0); }
            const int col = 16 * wave + arow; const float bb = cb2[kv * 64 + col];
#pragma unroll
            for (int j = 0; j < 4; ++j) { const int n = 16 * nt + kq * 4 + j; KC[((size_t)(kv * 4 + bgi) * 512 + n) * 64 + col] = n < 511 ? (bf16_t)(cvtpk(c[j] + bb, 0.f) & 0xffffu) : (bf16_t)0; }
        }
        LBAR();
    }
    const int gt = blockIdx.x * 512 + tid, NGT = G * 512;
    { const bf16_t* MoK = (const bf16_t*)(ws + WS_MO) + att::MO_STRIDE; bf16_t* KM = (bf16_t*)(ws + WS_KM); LAS float* part = (LAS float*)(lds + 16384);
      for (int blk = blockIdx.x; blk < 256; blk += G) { const bf16_t* p = MoK + ((size_t)blk * 256 + 32 * wave) * 64 + lane; float s = 0.f;
#pragma unroll
          for (int r = 0; r < 32; ++r) s += __uint_as_float((unsigned)p[(size_t)r * 64] << 16);
          part[wave * 64 + lane] = s;
          LBAR();
          if (wave == 0) { float t = 0.f;
#pragma unroll
              for (int w = 0; w < 8; ++w) t += part[w * 64 + lane];
              KM[(size_t)blk * 64 + lane] = (bf16_t)(cvtpk(t * (1.0f / 256.0f), 0.f) & 0xffffu); }
          LBAR(); } }
    { const bf16_t* U = (const bf16_t*)(ws + WS_U); bf16_t* Abr = (bf16_t*)(ws + WS_XB);
      for (int e = gt; e < MTOK * 32; e += NGT) { const int row = e >> 5, c8 = e & 31, s = row & (SEQ - 1), w = 2 << (c8 >> 3), cnt = (s + 1 < w) ? s + 1 : w;
          float acc[8] = {0.f, 0.f, 0.f, 0.f, 0.f, 0.f, 0.f, 0.f}; u32x4 v0 = {0u, 0u, 0u, 0u};
#pragma unroll
          for (int i0 = 0; i0 < 16; i0 += 8) { if (i0 >= cnt) break; u32x4 v[8];
#pragma unroll
              for (int i = 0; i < 8; ++i) v[i] = (i0 + i < cnt) ? *(const u32x4*)(U + (size_t)(row - i0 - i) * 256 + c8 * 8) : (u32x4){0u, 0u, 0u, 0u};
              if (i0 == 0) v0 = v[0];
#pragma unroll
              for (int i = 0; i < 8; ++i)
#pragma unroll
                  for (int q = 0; q < 4; ++q) { acc[2 * q] += bflo(v[i][q]); acc[2 * q + 1] += bfhi(v[i][q]); } }
          const float ic = 1.0f / (float)cnt; u32x4 o;
#pragma unroll
          for (int q = 0; q < 4; ++q) o[q] = cvtpk(acc[2 * q] * ic - bflo(v0[q]), acc[2 * q + 1] * ic - bfhi(v0[q]));
          *(u32x4*)(Abr + (size_t)row * DM + c8 * 8) = o; } }
}
__global__ void __launch_bounds__(512, 2) fwd_megakernel(Args a) {
    extern __shared__ __attribute__((aligned(16))) unsigned char lds_raw[];
    LAS unsigned char* lds = (LAS unsigned char*)lds_raw;
    cg::grid_group grid = cg::this_grid();
    const int G = gridDim.x;
    volatile LAS unsigned* bst = (volatile LAS unsigned*)(lds + LDS_BYTES - 64);
    if (threadIdx.x < 16) bst[threadIdx.x] = 0u;
    __syncthreads();
    const ArgsP ap0 = (ArgsP)__builtin_amdgcn_kernarg_segment_ptr();
#define PHASE_ARGS ArgsP a_ = ap0; asm volatile("" : "+s"(a_)); unsigned char* ws = a_->ws; unsigned* ctl = (unsigned*)(ws + WS_CTL); float* ssp = (float*)(ws + WS_SSP); const float* tab = (const float*)(ws + WS_TAB); \
    bf16_t* XB = (bf16_t*)(ws + WS_XB); bf16_t* BIG = (bf16_t*)(ws + WS_BIG); bf16_t* MRG = (bf16_t*)(ws + WS_MRG); (void)ctl; (void)ssp; (void)tab; (void)XB; (void)BIG; (void)MRG;
    XcdBarrier xbar = xcd_barrier_post((unsigned*)(ap0->ws + WS_BAR), bst);
    bool first_sync = true;
#define GRID_SYNC() do { if (first_sync) { grid.sync(); first_sync = false; } else xcd_barrier(xbar); } while (0)
    for (int l = 0; l < DEPTH; ++l) {
        int tid_ = threadIdx.x; asm volatile("" : "+v"(tid_));
        const int tid = tid_, lane = tid & 63, wave = __builtin_amdgcn_readfirstlane(tid >> 6), gw = blockIdx.x * 8 + wave, NGW = G * 8;
        { PHASE_ARGS phase0(a_, l, lds, tid, lane, wave, gw, NGW); }
        GRID_SYNC();
        { PHASE_ARGS pg8::Gemm g{XB, (const bf16_t*)(ws + WS_W + OFF_WIN), MTOK, NIN, DM}; pg8::StaticOrder S; S.init(MTOK, NIN, G, (int)blockIdx.x);
          EpiInProj E{ssp, (const float*)(ws + WS_W + OFF_BIN), tab, (bf16_t*)(ws + WS_U), (bf16_t*)(ws + WS_QN), (bf16_t*)(ws + WS_KV), (bf16_t*)(ws + WS_MO), BIG, (bf16_t*)(ws + WS_GN)};
          pg8::gemm_phase(lds, g, S, E); }
        GRID_SYNC();
        { PHASE_ARGS phase2(a_, lds, tid, lane, wave, G); }
        GRID_SYNC();
        { PHASE_ARGS
          att::Bufs B{(const bf16_t*)(ws + WS_QN), (const bf16_t*)(ws + WS_KV), (const bf16_t*)(ws + WS_MO), (const bf16_t*)(ws + WS_KC), (const bf16_t*)(ws + WS_KM), (const bf16_t*)(ws + WS_GN), XB};
          const int* order = (const int*)(ws + WS_ORDER); LAS int* slot = (LAS int*)(lds + att::L_END);
          if (wave >= 4) __builtin_amdgcn_s_setprio(1);
          for (;;) {
              LBAR();
              if (tid == 0) slot[0] = (int)atomicAdd(ctl + l, 1u);
              LBAR();
              const int item = slot[0];
              if (item >= 768) break;
              const int id = order[item];
              int tl = threadIdx.x; asm volatile("" : "+v"(tl));
              const int tid = tl, lane = tid & 63, wave = __builtin_amdgcn_readfirstlane(tid >> 6);
              att::Ctx C; C.lds = (LAS char*)lds; C.wsf = (LAS float*)(lds + att::L_WSF) + wave * 64; C.otl = (LAS float*)(lds + att::L_OT) + wave * 2048 + lane; C.tid = tid; C.wid = wave; C.lane = lane; C.r32 = lane & 31; C.hi = lane >> 5;
              C.vbl = ((lane >> 4) & 1) * 32 + (lane & 3) * 8 + (4 * (lane >> 5) + ((lane & 15) >> 2)) * 64;
              if (id < 512) att::nsa_item(C, B, id >> 8, (id >> 7) & 1, id & 127);
              else { const int x = id - 512; att::moba_item(C, B, x >> 7, (x >> 5) & 3, x & 31); }
          }
          __builtin_amdgcn_s_setprio(0); }
        GRID_SYNC();
        { PHASE_ARGS pg8::Gemm g{XB, (const bf16_t*)(ws + WS_W + OFF_WBR), MTOK, DM, DM}; pg8::StaticOrder S; S.init(MTOK, DM, G, (int)blockIdx.x);
          EpiBranch E{BIG, MRG}; pg8::gemm_phase(lds, g, S, E); }
        GRID_SYNC();
        { PHASE_ARGS pg8::Gemm g{MRG, (const bf16_t*)(ws + WS_W + OFF_WOUT), MTOK, DM, DM}; pg8::StaticOrder S; S.init(MTOK, DM, G, (int)blockIdx.x);
          bf16_t* RES = (bf16_t*)a_->out; EpiResid E{l == 0 ? a_->in[0] : nullptr, RES, XB, nullptr, ssp};   pg8::gemm_phase(lds, g, S, E); }
        GRID_SYNC();
        { PHASE_ARGS pg8::Gemm g{XB, (const bf16_t*)(ws + WS_W + OFF_WGU), MTOK, NGU, DM}; pg8::StaticOrder S; S.init(MTOK, NGU, G, (int)blockIdx.x);
          EpiSwiGLU E{ssp, BIG}; pg8::gemm_phase(lds, g, S, E); }
        GRID_SYNC();
        { PHASE_ARGS pg8::Gemm g{BIG, (const bf16_t*)(ws + WS_W + OFF_WD), MTOK, DM, DFF}; pg8::StaticOrder S; S.init(MTOK, DM, G, (int)blockIdx.x);
          bf16_t* RES = (bf16_t*)a_->out; EpiResid E{nullptr, XB, XB, l + 1 < DEPTH ? RES : nullptr, ssp};   pg8::gemm_phase(lds, g, S, E); }
        GRID_SYNC();
    }
    { PHASE_ARGS const float* fn = a_->in[19]; float* outp = a_->out; const int lane = threadIdx.x & 63, gw = blockIdx.x * 8 + (threadIdx.x >> 6), NGW = G * 8;
      const f32x4* gr = (const f32x4*)fn + lane; f32x4 gv[4];
#pragma unroll
      for (int j = 0; j < 4; ++j) gv[j] = gr[64 * j];
      for (int m0 = 2 * gw; m0 < MTOK; m0 += 2 * NGW) { u32x2 w[2][4]; float rstd[2];
#pragma unroll
          for (int q = 0; q < 2; ++q) { const u32x2* xr = (const u32x2*)(XB + (size_t)(m0 + q) * DM) + lane; rstd[q] = row_rstd(ssp, m0 + q);
#pragma unroll
              for (int j = 0; j < 4; ++j) w[q][j] = xr[64 * j]; }
#pragma unroll
          for (int q = 0; q < 2; ++q) { f32x4* orow = (f32x4*)(outp + (size_t)(m0 + q) * DM) + lane;
#pragma unroll
              for (int j = 0; j < 4; ++j) { const f32x4 v = {bflo(w[q][j][0]), bfhi(w[q][j][0]), bflo(w[q][j][1]), bfhi(w[q][j][1])}; orow[64 * j] = v * rstd[q] * gv[j]; } } } }
}

extern "C" void kernel_launch(void* const* d_in, const int* in_sizes, int n_in, void* d_out, int out_size, void* d_ws, size_t ws_size, hipStream_t stream) {
    static int grid = 0;
    if (grid == 0) {
        if (n_in != 20 || in_sizes[0] != MTOK * DM || out_size != MTOK * DM || ws_size < WS_END) { fprintf(stderr, "kernel_launch: unexpected shapes / workspace (n_in %d, ws %zu)\n", n_in, ws_size); grid = -1; return; }
        int dev = 0, cus = 0, per_cu = 0;
        if (hipGetDevice(&dev) != hipSuccess || hipDeviceGetAttribute(&cus, hipDeviceAttributeMultiprocessorCount, dev) != hipSuccess) { grid = -1; return; }
        if (hipFuncSetAttribute((const void*)fwd_megakernel, hipFuncAttributeMaxDynamicSharedMemorySize, LDS_BYTES) != hipSuccess) { fprintf(stderr, "kernel_launch: hipFuncSetAttribute failed\n"); grid = -1; return; }
        if (hipOccupancyMaxActiveBlocksPerMultiprocessor(&per_cu, (const void*)fwd_megakernel, 512, LDS_BYTES) != hipSuccess || per_cu < 1) { fprintf(stderr, "kernel_launch: occupancy query failed (%d)\n", per_cu); (void)hipGetLastError(); grid = -1; return; }
        grid = cus * per_cu;
    }
    if (grid < 0) return;
    if (hipMemsetAsync((char*)d_ws + WS_CTL, 0, 32768, stream) != hipSuccess) { fprintf(stderr, "kernel_launch: memset failed\n"); return; }
    Args a{};
    for (int i = 0; i < 20; ++i) a.in[i] = (const float*)d_in[i];
    a.out = (float*)d_out; a.ws = (unsigned char*)d_ws;
    void* args[] = {&a};
    const hipError_t e = hipLaunchCooperativeKernel((const void*)fwd_megakernel, dim3(grid), dim3(512), args, LDS_BYTES, stream);
    if (e != hipSuccess) fprintf(stderr, "kernel_launch: cooperative launch failed: %s (grid %d)\n", hipGetErrorString(e), grid);
}
```

```cpp
#include <hip/hip_runtime.h>
#include <hip/hip_cooperative_groups.h>
#include <cstdio>
#include <cstdint>
#include <cmath>
namespace cg = cooperative_groups;

#define LAS __attribute__((address_space(3)))
typedef unsigned short bf16_t;
typedef short bf16x8 __attribute__((ext_vector_type(8)));
typedef short s16x4 __attribute__((ext_vector_type(4)));
typedef float f32x2 __attribute__((ext_vector_type(2)));
typedef float f32x4 __attribute__((ext_vector_type(4)));
typedef float f32x16 __attribute__((ext_vector_type(16)));
typedef unsigned u32x4 __attribute__((ext_vector_type(4)));
typedef unsigned u32x2 __attribute__((ext_vector_type(2)));
typedef __bf16 bf16x2_t __attribute__((ext_vector_type(2)));

constexpr int SEQ = 8192, BATCH = 2, MTOK = BATCH * SEQ, DM = 1024, DEPTH = 2;
constexpr int IN_COLS = 5400, NIN = 5632, DFF = 2816, NGU = 5632;
constexpr float RMS_EPS = 1e-6f;
constexpr float QSCALE = 0.125f * 1.4426950408889634f;

__device__ __forceinline__ unsigned cvtpk(float lo, float hi) { f32x2 v = {lo, hi}; bf16x2_t b = __builtin_convertvector(v, bf16x2_t); return __builtin_bit_cast(unsigned, b); }
__device__ __forceinline__ float bflo(unsigned w) { return __uint_as_float(w << 16); }
__device__ __forceinline__ float bfhi(unsigned w) { return __uint_as_float(w & 0xffff0000u); }
__device__ __forceinline__ float sigmoidf_(float x) { return __builtin_amdgcn_rcpf(1.f + __expf(-x)); }

namespace pg8 {
constexpr int BM = 256, BK = 64, HALF = 128, HTB = HALF * BK * 2, STAGE_BYTES = 8 * HTB, NXCD = 8, WGM = 8;
__host__ __device__ __forceinline__ int lds_byte(int r, int c) { const int st = (r >> 4) * 2 + (c >> 5), rr = r & 15, cc = c & 31, ob = rr * 64 + cc * 2; return st * 1024 + (ob ^ (((ob >> 9) & 1) << 5)); }
__host__ __device__ __forceinline__ void stage_rc(int b, int& R, int& C) { const int st = b / 1024, sb = b % 1024, swz = sb ^ (((sb >> 9) & 1) << 5); R = (st >> 1) * 16 + swz / 64; C = (st & 1) * 32 + (swz % 64) / 2; }
__host__ __device__ __forceinline__ int perm32(int rho) { const int n = rho >> 4, i = rho & 15; return 8 * (i >> 2) + 4 * n + (i & 3); }
struct Unit { int pm, pn; };
struct Gemm { const bf16_t* A; const bf16_t* Bt; int M, N, K; };
struct StaticOrder {
    int nM, nN, nwg, G, c;
    __host__ __device__ void init(int M, int N, int G_, int c_) { nM = M / BM; nN = N / BM; nwg = nM * nN; G = G_; c = c_; }
    __host__ __device__ bool next(int i, Unit& u) const {
        const long L = (long)i * G + c; if (L >= nwg) return false;
        int wgid = (int)L; { const int q = nwg / NXCD, r = nwg % NXCD, xcd = wgid % NXCD, off = wgid / NXCD; wgid = (xcd < r ? xcd * (q + 1) : r * (q + 1) + (xcd - r) * q) + off; }
        const int nig = WGM * nN, gid = wgid / nig, fm = gid * WGM, gsz = (nM - fm) < WGM ? (nM - fm) : WGM;
        u.pm = fm + ((wgid % nig) % gsz); u.pn = (wgid % nig) / gsz; return true;
    }
};
template <class Epi, class Sched>
__device__ __forceinline__ void gemm_phase(LAS unsigned char* lds, const Gemm g, const Sched& S, const Epi& E) {
    int tid_ = threadIdx.x; asm volatile("" : "+v"(tid_));
    const int tid = tid_, wid = __builtin_amdgcn_readfirstlane(tid >> 6), lane = tid & 63, wr = wid >> 2, wc = wid & 3, fr = lane & 15, fq = lane >> 4;
    const int K = g.K, nt = K / BK;
    unsigned voffA[2], voffB[2];
#pragma unroll
    for (int i = 0; i < 2; ++i) { int R, C; stage_rc(tid * 16 + i * 8192, R, C); const int Rb = ((R & ~31) + perm32(R & 31));
        voffA[i] = (unsigned)(R * K + C) * 2u; voffB[i] = (unsigned)(Rb * K + C) * 2u; }
    const size_t kstep = (size_t)(BK * 2);
    const size_t hstep = (size_t)HALF * K * 2;
    const size_t tstep = 2 * hstep;
    const unsigned ldsw = (unsigned)wid * 1024u;
    const int aoff = lds_byte(wr * 64 + fr, fq * 8), boff = lds_byte(wc * 32 + fr, fq * 8);
#define PG8_SA(b, h) (((b) * 2 + (h)) * HTB)
#define PG8_SB(b, h) ((4 + (b) * 2 + (h)) * HTB)
#define PG8_STAGE(bufoff, gbase, voff) do { _Pragma("unroll") for (int _i = 0; _i < 2; ++_i) \
        __builtin_amdgcn_global_load_lds((const unsigned*)((const char*)(gbase) + (voff)[_i]), (LAS unsigned*)(lds + (bufoff) + ldsw + _i * 8192), 16, 0, 0); } while (0)
#define PG8_LDA(dst, b, h) do { _Pragma("unroll") for (int m = 0; m < 4; ++m) _Pragma("unroll") for (int k = 0; k < 2; ++k) dst[m][k] = *(const LAS bf16x8*)(lds + PG8_SA(b, h) + aoff + m * 2048 + k * 1024); } while (0)
#define PG8_LDB(dst, b, h) do { _Pragma("unroll") for (int n = 0; n < 2; ++n) _Pragma("unroll") for (int k = 0; k < 2; ++k) dst[n][k] = *(const LAS bf16x8*)(lds + PG8_SB(b, h) + boff + n * 2048 + k * 1024); } while (0)
#define PG8_MMA(ai, bj, At, Bt) do { __builtin_amdgcn_s_setprio(1); _Pragma("unroll") for (int m = 0; m < 4; ++m) _Pragma("unroll") for (int n = 0; n < 2; ++n) _Pragma("unroll") for (int k = 0; k < 2; ++k) \
        acc[ai][bj][m][n] = __builtin_amdgcn_mfma_f32_16x16x32_bf16(Bt[n][k], At[m][k], acc[ai][bj][m][n], 0, 0, 0); __builtin_amdgcn_s_setprio(0); } while (0)
#define PG8_WAIT_V(n) asm volatile("s_waitcnt vmcnt(" #n ")" ::: "memory")
#define PG8_WAIT_L(n) asm volatile("s_waitcnt lgkmcnt(" #n ")" ::: "memory")
#define PG8_BAR __builtin_amdgcn_s_barrier()
#define PG8_SCHED __builtin_amdgcn_sched_barrier(0)
    Unit cur, nxt; int ui = 0;
    if (!S.next(0, cur)) return;
    f32x4 acc[2][2][4][2];
#pragma unroll
    for (int a = 0; a < 2; ++a)
#pragma unroll
        for (int b = 0; b < 2; ++b)
#pragma unroll
            for (int m = 0; m < 4; ++m)
#pragma unroll
                for (int n = 0; n < 2; ++n) acc[a][b][m][n] = (f32x4){0.f, 0.f, 0.f, 0.f};
    bf16x8 At[4][2], B0[2][2], B1[2][2];
    const char* cA = (const char*)g.A + (size_t)cur.pm * tstep; const char* cB = (const char*)g.Bt + (size_t)cur.pn * tstep;
    PG8_STAGE(PG8_SB(0, 0), cB, voffB); PG8_STAGE(PG8_SB(0, 1), cB + hstep, voffB); PG8_STAGE(PG8_SA(0, 0), cA, voffA); PG8_STAGE(PG8_SA(0, 1), cA + hstep, voffA);
    if (wr == 1) PG8_BAR;
    PG8_WAIT_V(2); PG8_BAR;
    PG8_STAGE(PG8_SB(1, 0), cB + kstep, voffB); PG8_STAGE(PG8_SA(1, 0), cA + kstep, voffA); PG8_STAGE(PG8_SB(1, 1), cB + hstep + kstep, voffB);
    PG8_WAIT_V(6); PG8_BAR;
    for (;;) {
        const bool has_next = S.next(ui + 1, nxt);
        const char* nA = has_next ? (const char*)g.A + (size_t)nxt.pm * tstep : cA; const char* nB = has_next ? (const char*)g.Bt + (size_t)nxt.pn * tstep : cB;
        for (int t = 0; t < nt; t += 2) {
            const bool last = (t == nt - 2);
            const char* a1 = cA + (size_t)(t + 1) * kstep;
            const char* a2 = last ? nA : cA + (size_t)(t + 2) * kstep; const char* b2 = last ? nB : cB + (size_t)(t + 2) * kstep;
            const char* a3 = a2 + kstep; const char* b3 = b2 + kstep;
            if constexpr (Epi::KHOOK) { if (t == 4 || t == 12) { PG8_SCHED; E.khook(acc, cur, t, wr, wc, fr, fq); PG8_SCHED; } }
            PG8_LDB(B0, 0, 0); PG8_LDB(B1, 0, 1); PG8_SCHED; PG8_LDA(At, 0, 0); PG8_STAGE(PG8_SA(1, 1), a1 + hstep, voffA);
            PG8_WAIT_V(8); PG8_WAIT_L(0); PG8_BAR; PG8_MMA(0, 0, At, B0); PG8_MMA(0, 1, At, B1); PG8_BAR; PG8_SCHED;
            PG8_LDA(At, 0, 1); PG8_STAGE(PG8_SB(0, 0), b2, voffB); PG8_STAGE(PG8_SB(0, 1), b2 + hstep, voffB); PG8_STAGE(PG8_SA(0, 0), a2, voffA);
            PG8_WAIT_V(8); PG8_WAIT_L(0); PG8_BAR; PG8_MMA(1, 0, At, B0); PG8_MMA(1, 1, At, B1); PG8_BAR; PG8_SCHED;
            PG8_LDB(B0, 1, 0); PG8_LDB(B1, 1, 1); PG8_SCHED; PG8_LDA(At, 1, 0); PG8_STAGE(PG8_SA(0, 1), a2 + hstep, voffA);
            PG8_WAIT_V(8); PG8_WAIT_L(0); PG8_BAR; PG8_MMA(0, 0, At, B0); PG8_MMA(0, 1, At, B1); PG8_BAR; PG8_SCHED;
            PG8_LDA(At, 1, 1); PG8_STAGE(PG8_SB(1, 0), b3, voffB); PG8_STAGE(PG8_SB(1, 1), b3 + hstep, voffB); PG8_STAGE(PG8_SA(1, 0), a3, voffA);
            PG8_WAIT_V(8); PG8_WAIT_L(0); PG8_BAR; PG8_MMA(1, 0, At, B0); PG8_MMA(1, 1, At, B1); PG8_BAR; PG8_SCHED;
        }
        if (wr == 0) PG8_BAR;
        E(acc, cur, wr, wc, fr, fq);
        if (!has_next) break;
#pragma unroll
        for (int a = 0; a < 2; ++a)
#pragma unroll
            for (int b = 0; b < 2; ++b)
#pragma unroll
                for (int m = 0; m < 4; ++m)
#pragma unroll
                    for (int n = 0; n < 2; ++n) acc[a][b][m][n] = (f32x4){0.f, 0.f, 0.f, 0.f};
        cur = nxt; cA = nA; cB = nB; ++ui;
        if (wr == 1) PG8_BAR;
    }
    PG8_WAIT_V(0);
    PG8_BAR;
#undef PG8_SA
#undef PG8_SB
#undef PG8_STAGE
#undef PG8_LDA
#undef PG8_LDB
#undef PG8_MMA
#undef PG8_WAIT_V
#undef PG8_WAIT_L
#undef PG8_BAR
#undef PG8_SCHED
}
}
using pg8::Unit;
__device__ __forceinline__ float row_rstd(const float* ssp, int row) {
    const f32x4* p = (const f32x4*)(ssp + (size_t)row * 16);
    const f32x4 a = p[0], b = p[1], c = p[2], d = p[3];
    const float ss = ((a[0] + a[1]) + (a[2] + a[3])) + ((b[0] + b[1]) + (b[2] + b[3])) + ((c[0] + c[1]) + (c[2] + c[3])) + ((d[0] + d[1]) + (d[2] + d[3]));
    return 1.0f / sqrtf(ss * (1.0f / DM) + RMS_EPS);
}
__device__ __forceinline__ float row_rstd4(const float* ssp, int row, int fq) {
    const f32x4 a = *((const f32x4*)(ssp + (size_t)row * 16) + fq);
    float ss = (a[0] + a[1]) + (a[2] + a[3]);
    ss += __shfl_xor(ss, 16); ss += __shfl_xor(ss, 32);
    return 1.0f / sqrtf(ss * (1.0f / DM) + RMS_EPS);
}
__device__ __forceinline__ u32x4 pack8(const f32x4 a, const f32x4 b) { u32x4 w; w.x = cvtpk(a[0], a[1]); w.y = cvtpk(a[2], a[3]); w.z = cvtpk(b[0], b[1]); w.w = cvtpk(b[2], b[3]); return w; }
__device__ __forceinline__ void rope8(f32x4& v0, f32x4& v1, const float* tab, int t, int pos, float sc) {
    const f32x4* cs = (const f32x4*)(tab + ((size_t)t * 32 + (pos >> 1)) * 2);
    const f32x4 c0 = cs[0], c1 = cs[1];
    f32x4 o0, o1;
    o0[0] = (v0[0] * c0[0] - v0[1] * c0[1]) * sc; o0[1] = (v0[1] * c0[0] + v0[0] * c0[1]) * sc;
    o0[2] = (v0[2] * c0[2] - v0[3] * c0[3]) * sc; o0[3] = (v0[3] * c0[2] + v0[2] * c0[3]) * sc;
    o1[0] = (v1[0] * c1[0] - v1[1] * c1[1]) * sc; o1[1] = (v1[1] * c1[0] + v1[0] * c1[1]) * sc;
    o1[2] = (v1[2] * c1[2] - v1[3] * c1[3]) * sc; o1[3] = (v1[3] * c1[2] + v1[2] * c1[3]) * sc;
    v0 = o0; v1 = o1;
}
struct EpiInProj {
    static constexpr bool KHOOK = false;
    const float* ssp; const float* bias; const float* tab;
    bf16_t *U, *Qn, *KV, *Mo, *G, *Gn;
    __device__ __forceinline__ void operator()(const f32x4 (&acc)[2][2][4][2], const Unit& u, int wr, int wc, int fr, int fq) const {
        asm volatile("" : "+v"(fr), "+v"(fq));
        const int pn = u.pn;
        f32x4 bia[2][2];
#pragma unroll
        for (int bj = 0; bj < 2; ++bj) { const int gc = pn * 256 + bj * 128 + wc * 32 + 8 * fq; bia[bj][0] = *(const f32x4*)(bias + gc); bia[bj][1] = *(const f32x4*)(bias + gc + 4); }
        float rs[2][4];
#pragma unroll
        for (int ai = 0; ai < 2; ++ai) { f32x4 ra[4];
#pragma unroll
            for (int m = 0; m < 4; ++m) ra[m] = *((const f32x4*)(ssp + (size_t)(u.pm * 256 + ai * 128 + wr * 64 + m * 16 + fr) * 16) + fq);
            __builtin_amdgcn_sched_barrier(0);
#pragma unroll
            for (int m = 0; m < 4; ++m) { float ss = (ra[m][0] + ra[m][1]) + (ra[m][2] + ra[m][3]); ss += __shfl_xor(ss, 16); ss += __shfl_xor(ss, 32); rs[ai][m] = 1.0f / sqrtf(ss * (1.0f / DM) + RMS_EPS); } }
#pragma unroll
        for (int ai = 0; ai < 2; ++ai)
#pragma unroll
            for (int m = 0; m < 4; ++m) {
                const int row = u.pm * 256 + ai * 128 + wr * 64 + m * 16 + fr;
                const float rstd = rs[ai][m];
                const int t = row & (SEQ - 1), b = row >> 13;
#pragma unroll
                for (int bj = 0; bj < 2; ++bj) {
                    const int cit = bj * 128 + wc * 32 + 8 * fq;
                    f32x4 v0 = acc[ai][bj][m][0] * rstd + bia[bj][0], v1 = acc[ai][bj][m][1] * rstd + bia[bj][1];
                    bf16_t* dst;
                    if (pn == 0) { dst = U + (size_t)row * 256 + cit; }
                    else if (pn <= 2) { const int c2 = (pn - 1) * 256 + cit, head = c2 >> 6, pos = c2 & 63; rope8(v0, v1, tab, t, pos, QSCALE); dst = Qn + ((size_t)(b * 8 + head) * SEQ + t) * 64 + pos; }
                    else if (pn <= 5) { const int c2 = cit & 127, g = c2 >> 6, pos = c2 & 63, kvi = 2 * (pn - 3) + bj; if (bj == 0) rope8(v0, v1, tab, t, pos, 1.f);
                        dst = KV + (size_t)kvi * ((size_t)MTOK * 128) + ((size_t)(b * 2 + g) * SEQ + t) * 64 + pos; }
                    else if (pn <= 8) { const int h = cit >> 6, pos = cit & 63; if (pn < 8) rope8(v0, v1, tab, t, pos, pn == 6 ? QSCALE : 1.f);
                        dst = Mo + (size_t)(pn - 6) * ((size_t)MTOK * 256) + ((size_t)(b * 4 + h) * SEQ + t) * 64 + pos; }
                    else if (pn <= 20) {
#pragma unroll
                        for (int e = 0; e < 4; ++e) { v0[e] = sigmoidf_(v0[e]); v1[e] = sigmoidf_(v1[e]); }
                        dst = G + (size_t)row * 3072 + (pn - 9) * 256 + cit; }
                    else {
#pragma unroll
                        for (int e = 0; e < 4; ++e) { v0[e] = sigmoidf_(v0[e]); v1[e] = sigmoidf_(v1[e]); }
                        dst = Gn + (size_t)row * 32 + (cit & 31); if (cit >= 32) dst = nullptr; }
                    if (dst) *(u32x4*)dst = pack8(v0, v1);
                }
                asm volatile("" ::: "memory");
            }
    }
};
struct EpiBranch {
    static constexpr bool KHOOK = true;
    const bf16_t* G; bf16_t* out;
    __device__ __forceinline__ void khook(f32x4 (&acc)[2][2][4][2], const Unit& u, int t, int wr, int wc, int fr, int fq) const {
        asm volatile("" : "+v"(fr), "+v"(fq));
        const int gsel = (t == 4) ? 0 : 1024;
#pragma unroll
        for (int ai = 0; ai < 2; ++ai)
#pragma unroll
            for (int m = 0; m < 4; ++m) {
                u32x4 gx[2], gy[2];
#pragma unroll
                for (int bj = 0; bj < 2; ++bj) { const int row = u.pm * 256 + ai * 128 + wr * 64 + m * 16 + fr, col = u.pn * 256 + bj * 128 + wc * 32 + 8 * fq;
                    gx[bj] = *(const u32x4*)(G + (size_t)row * 3072 + gsel + col); gy[bj] = *(const u32x4*)(G + (size_t)row * 3072 + gsel + 1024 + col); }
                __builtin_amdgcn_sched_barrier(0);
#pragma unroll
                for (int bj = 0; bj < 2; ++bj)
#pragma unroll
                    for (int e = 0; e < 4; ++e) {
                        const float x0 = fmaxf(bflo(gx[bj][e]), 1e-20f), x1 = fmaxf(bfhi(gx[bj][e]), 1e-20f), y0 = fmaxf(bflo(gy[bj][e]), 1e-20f), y1 = fmaxf(bfhi(gy[bj][e]), 1e-20f);
                        const float r0 = x0 * __builtin_amdgcn_rcpf(y0), r1 = x1 * __builtin_amdgcn_rcpf(y1);
                        acc[ai][bj][m][e >> 1][(e & 1) * 2] *= r0; acc[ai][bj][m][e >> 1][(e & 1) * 2 + 1] *= r1; }
                asm volatile("" ::: "memory");
            }
    }
    __device__ __forceinline__ void operator()(const f32x4 (&acc)[2][2][4][2], const Unit& u, int wr, int wc, int fr, int fq) const {
        asm volatile("" : "+v"(fr), "+v"(fq));
#pragma unroll
        for (int ai = 0; ai < 2; ++ai) {
            u32x4 gz[4][2];
#pragma unroll
            for (int m = 0; m < 4; ++m)
#pragma unroll
                for (int bj = 0; bj < 2; ++bj) gz[m][bj] = *(const u32x4*)(G + (size_t)(u.pm * 256 + ai * 128 + wr * 64 + m * 16 + fr) * 3072 + 2048 + u.pn * 256 + bj * 128 + wc * 32 + 8 * fq);
            __builtin_amdgcn_sched_barrier(0);
#pragma unroll
            for (int m = 0; m < 4; ++m) {
                const int row = u.pm * 256 + ai * 128 + wr * 64 + m * 16 + fr;
#pragma unroll
                for (int bj = 0; bj < 2; ++bj) {
                    const int col = u.pn * 256 + bj * 128 + wc * 32 + 8 * fq; const u32x4 g = gz[m][bj];
                    f32x4 v0 = acc[ai][bj][m][0], v1 = acc[ai][bj][m][1];
                    v0[0] *= fmaxf(bflo(g[0]), 1e-20f); v0[1] *= fmaxf(bfhi(g[0]), 1e-20f); v0[2] *= fmaxf(bflo(g[1]), 1e-20f); v0[3] *= fmaxf(bfhi(g[1]), 1e-20f);
                    v1[0] *= fmaxf(bflo(g[2]), 1e-20f); v1[1] *= fmaxf(bfhi(g[2]), 1e-20f); v1[2] *= fmaxf(bflo(g[3]), 1e-20f); v1[3] *= fmaxf(bfhi(g[3]), 1e-20f);
                    *(u32x4*)(out + (size_t)row * DM + col) = pack8(v0, v1);
                }
            }
            asm volatile("" ::: "memory");
        }
    }
};
struct EpiResid {
    static constexpr bool KHOOK = false;
    const float* base_f; const bf16_t* base_b; bf16_t* xb; bf16_t* res; float* ssp;
    __device__ __forceinline__ void operator()(const f32x4 (&acc)[2][2][4][2], const Unit& u, int wr, int wc, int fr, int fq) const {
        asm volatile("" : "+v"(fr), "+v"(fq));
#pragma unroll
        for (int ai = 0; ai < 2; ++ai)
#pragma unroll
            for (int mp = 0; mp < 2; ++mp) {
                f32x4 b0[2][2], b1[2][2];
                if (base_f) {
#pragma unroll
                    for (int mm = 0; mm < 2; ++mm)
#pragma unroll
                        for (int bj = 0; bj < 2; ++bj) { const size_t off = (size_t)(u.pm * 256 + ai * 128 + wr * 64 + (2 * mp + mm) * 16 + fr) * DM + u.pn * 256 + bj * 128 + wc * 32 + 8 * fq;
                            b0[mm][bj] = *(const f32x4*)(base_f + off); b1[mm][bj] = *(const f32x4*)(base_f + off + 4); }
                    __builtin_amdgcn_sched_barrier(0);
                } else {
                    u32x4 w[2][2];
#pragma unroll
                    for (int mm = 0; mm < 2; ++mm)
#pragma unroll
                        for (int bj = 0; bj < 2; ++bj) w[mm][bj] = *(const u32x4*)(base_b + (size_t)(u.pm * 256 + ai * 128 + wr * 64 + (2 * mp + mm) * 16 + fr) * DM + u.pn * 256 + bj * 128 + wc * 32 + 8 * fq);
                    __builtin_amdgcn_sched_barrier(0);
#pragma unroll
                    for (int mm = 0; mm < 2; ++mm)
#pragma unroll
                        for (int bj = 0; bj < 2; ++bj) { const u32x4 x = w[mm][bj]; b0[mm][bj] = (f32x4){bflo(x[0]), bfhi(x[0]), bflo(x[1]), bfhi(x[1])}; b1[mm][bj] = (f32x4){bflo(x[2]), bfhi(x[2]), bflo(x[3]), bfhi(x[3])}; }
                }
#pragma unroll
                for (int mm = 0; mm < 2; ++mm) {
                    const int m = 2 * mp + mm, row = u.pm * 256 + ai * 128 + wr * 64 + m * 16 + fr;
                    float ss = 0.f;
#pragma unroll
                    for (int bj = 0; bj < 2; ++bj) {
                        const size_t off = (size_t)row * DM + u.pn * 256 + bj * 128 + wc * 32 + 8 * fq;
                        const f32x4 v0 = acc[ai][bj][m][0] + b0[mm][bj], v1 = acc[ai][bj][m][1] + b1[mm][bj];
                        const u32x4 pk = pack8(v0, v1);
                        *(u32x4*)(xb + off) = pk;
                        if (res) *(u32x4*)(res + off) = pk;
                        ss += (v0[0] * v0[0] + v0[1] * v0[1]) + (v0[2] * v0[2] + v0[3] * v0[3]) + (v1[0] * v1[0] + v1[1] * v1[1]) + (v1[2] * v1[2] + v1[3] * v1[3]);
                    }
                    ss += __shfl_xor(ss, 16); ss += __shfl_xor(ss, 32);
                    if (fq == 0) ssp[(size_t)row * 16 + u.pn * 4 + wc] = ss;
                }
                asm volatile("" ::: "memory");
            }
    }
};
struct EpiSwiGLU {
    static constexpr bool KHOOK = false;
    const float* ssp; bf16_t* H;
    __device__ __forceinline__ void operator()(const f32x4 (&acc)[2][2][4][2], const Unit& u, int wr, int wc, int fr, int fq) const {
        asm volatile("" : "+v"(fr), "+v"(fq));
        float rs[2][4];
#pragma unroll
        for (int ai = 0; ai < 2; ++ai) { f32x4 ra[4];
#pragma unroll
            for (int m = 0; m < 4; ++m) ra[m] = *((const f32x4*)(ssp + (size_t)(u.pm * 256 + ai * 128 + wr * 64 + m * 16 + fr) * 16) + fq);
            __builtin_amdgcn_sched_barrier(0);
#pragma unroll
            for (int m = 0; m < 4; ++m) { float ss = (ra[m][0] + ra[m][1]) + (ra[m][2] + ra[m][3]); ss += __shfl_xor(ss, 16); ss += __shfl_xor(ss, 32); rs[ai][m] = 1.0f / sqrtf(ss * (1.0f / DM) + RMS_EPS); } }
#pragma unroll
        for (int ai = 0; ai < 2; ++ai)
#pragma unroll
            for (int m = 0; m < 4; ++m) {
                const int row = u.pm * 256 + ai * 128 + wr * 64 + m * 16 + fr;
                const float rstd = rs[ai][m];
                f32x4 o[2];
#pragma unroll
                for (int n = 0; n < 2; ++n)
#pragma unroll
                    for (int e = 0; e < 4; ++e) { const float gt = acc[ai][0][m][n][e] * rstd, up = acc[ai][1][m][n][e] * rstd; o[n][e] = gt * sigmoidf_(gt) * up; }
                *(u32x4*)(H + (size_t)row * DFF + u.pn * 128 + wc * 32 + 8 * fq) = pack8(o[0], o[1]);
                asm volatile("" ::: "memory");
            }
    }
};
namespace att {
constexpr int KCS = 1040, KSLOT = 8 * KCS, VSLOT = 8192;
constexpr int L_K0 = 0, L_V0 = 4 * KSLOT, L_WSF = 4 * KSLOT + 4 * VSLOT, L_MSK = L_WSF + 8 * 256, L_UNI = L_MSK + 1024, L_LIST = L_UNI + 64, L_END = L_LIST + 512,
              L_PS = L_END + 64, L_OT = L_PS, L_TOTAL = L_OT + 8 * 8192;
static_assert(L_TOTAL <= 147456 - 64, "attention LDS map");
#define LBAR() asm volatile("s_waitcnt lgkmcnt(0)\n\ts_barrier" ::: "memory")
#define LWAIT() asm volatile("s_waitcnt lgkmcnt(0)" ::: "memory")
__device__ __forceinline__ int crow(int r, int hi) { return (r & 3) + 8 * (r >> 2) + 4 * hi; }
__device__ __forceinline__ float swap_other(float v, int hi) { auto rr = __builtin_amdgcn_permlane32_swap(__float_as_uint(v), __float_as_uint(v), false, false); return __uint_as_float(hi ? rr[0] : rr[1]); }
__device__ __forceinline__ void qkt(f32x16& p0, f32x16& p1, const LAS char* Ks, const bf16x8* qr, const f32x16& cinit, int r32, int hi) {
    const LAS char* kb = Ks + hi * KCS + r32 * 16;
#pragma unroll
    for (int d0 = 0; d0 < 4; ++d0) {
        const bf16x8 b0 = *(const LAS bf16x8*)(kb + d0 * 2 * KCS), b1 = *(const LAS bf16x8*)(kb + d0 * 2 * KCS + 512);
        if (d0 == 0) { p0 = __builtin_amdgcn_mfma_f32_32x32x16_bf16(b0, qr[0], cinit, 0, 0, 0); p1 = __builtin_amdgcn_mfma_f32_32x32x16_bf16(b1, qr[0], cinit, 0, 0, 0); }
        else { p0 = __builtin_amdgcn_mfma_f32_32x32x16_bf16(b0, qr[d0], p0, 0, 0, 0); p1 = __builtin_amdgcn_mfma_f32_32x32x16_bf16(b1, qr[d0], p1, 0, 0, 0); } }
}
struct VFrag { s16x4 lo[8], hi[8]; };
typedef short v4i16_t __attribute__((ext_vector_type(4)));
__device__ __forceinline__ s16x4 vtr(const LAS char* p) { return __builtin_bit_cast(s16x4, __builtin_amdgcn_ds_read_tr16_b64_v4i16((LAS v4i16_t*)p)); }
__device__ __forceinline__ void v_issue(VFrag& F, const LAS char* vp) {
#pragma unroll
    for (int d0 = 0; d0 < 2; ++d0)
#pragma unroll
        for (int ks = 0; ks < 4; ++ks) { F.lo[d0 * 4 + ks] = vtr(vp + d0 * 4096 + ks * 1024); F.hi[d0 * 4 + ks] = vtr(vp + d0 * 4096 + ks * 1024 + 512); }
}
template <bool SUM> __device__ __forceinline__ void pv(f32x16* o, f32x16& osum, VFrag& F, bf16x8 pa0, bf16x8 pa1, bf16x8 pa2, bf16x8 pa3) {
#define PK(k) (bf16x8){F.lo[k][0], F.lo[k][1], F.lo[k][2], F.lo[k][3], F.hi[k][0], F.hi[k][1], F.hi[k][2], F.hi[k][3]}
    const bf16x8 ones = {0x3F80, 0x3F80, 0x3F80, 0x3F80, 0x3F80, 0x3F80, 0x3F80, 0x3F80};
    __builtin_amdgcn_s_setprio(1);
    o[0] = __builtin_amdgcn_mfma_f32_32x32x16_bf16(pa0, PK(0), o[0], 0, 0, 0);
    o[1] = __builtin_amdgcn_mfma_f32_32x32x16_bf16(pa0, PK(4), o[1], 0, 0, 0);
    if (SUM) osum = __builtin_amdgcn_mfma_f32_32x32x16_bf16(pa0, ones, osum, 0, 0, 0);
    o[0] = __builtin_amdgcn_mfma_f32_32x32x16_bf16(pa1, PK(1), o[0], 0, 0, 0);
    o[1] = __builtin_amdgcn_mfma_f32_32x32x16_bf16(pa1, PK(5), o[1], 0, 0, 0);
    if (SUM) osum = __builtin_amdgcn_mfma_f32_32x32x16_bf16(pa1, ones, osum, 0, 0, 0);
    o[0] = __builtin_amdgcn_mfma_f32_32x32x16_bf16(pa2, PK(2), o[0], 0, 0, 0);
    o[1] = __builtin_amdgcn_mfma_f32_32x32x16_bf16(pa2, PK(6), o[1], 0, 0, 0);
    if (SUM) osum = __builtin_amdgcn_mfma_f32_32x32x16_bf16(pa2, ones, osum, 0, 0, 0);
    o[0] = __builtin_amdgcn_mfma_f32_32x32x16_bf16(pa3, PK(3), o[0], 0, 0, 0);
    o[1] = __builtin_amdgcn_mfma_f32_32x32x16_bf16(pa3, PK(7), o[1], 0, 0, 0);
    if (SUM) osum = __builtin_amdgcn_mfma_f32_32x32x16_bf16(pa3, ones, osum, 0, 0, 0);
    __builtin_amdgcn_s_setprio(0);
#undef PK
}
__device__ __forceinline__ float rowmax(const f32x16& p0, const f32x16& p1, int hi) {
    float a = __builtin_fmaxf(p0[0], p1[0]);
#pragma unroll
    for (int r = 1; r < 16; ++r) a = __builtin_fmaxf(__builtin_fmaxf(a, p0[r]), p1[r]);
    return __builtin_fmaxf(a, swap_other(a, hi));
}
struct KVRegs { u32x4 k, v; };
__device__ __forceinline__ void tile_load(KVRegs& R, const bf16_t* K, const bf16_t* V, int tid) { R.k = *(const u32x4*)(K + tid * 8); R.v = *(const u32x4*)(V + tid * 8); }
__device__ __forceinline__ void tile_store(const KVRegs& R, LAS char* Ks, LAS char* Vs, int tid) {
    const int row = tid >> 3, c = tid & 7;
    *(LAS u32x4*)(Ks + c * KCS + row * 16) = R.k;
    *(LAS u32x4*)(Vs + (c >> 2) * 4096 + (row >> 4) * 1024 + (row & 15) * 64 + (c & 3) * 16) = R.v;
}
__device__ __forceinline__ void ps_accum(const f32x16 p, int jb, LAS float* ps_row, bool writer) {
#pragma unroll
    for (int rg = 0; rg < 4; ++rg) {
        float a = 2.f * (p[4 * rg] + p[4 * rg + 1] + p[4 * rg + 2]) + p[4 * rg + 3], bq = p[4 * rg + 3];
        a += __shfl_xor(a, 1); a += __shfl_xor(a, 2); bq += __shfl_xor(bq, 1); bq += __shfl_xor(bq, 2);
        const int j = jb + 2 * rg;
        if (writer) { __hip_atomic_fetch_add(ps_row + j, a, __ATOMIC_RELAXED, __HIP_MEMORY_SCOPE_WORKGROUP); if (j + 1 < 128) __hip_atomic_fetch_add(ps_row + j + 1, bq, __ATOMIC_RELAXED, __HIP_MEMORY_SCOPE_WORKGROUP); }
    }
}
struct Ctx { LAS char* lds; LAS float* wsf; LAS float* otl; int tid, wid, lane, r32, hi, vbl; };
struct RowSt { float m, l; bool started; f32x16 negm, osum; };
__device__ __forceinline__ void rowst_init(RowSt& S) { S.m = 0.f; S.l = 0.f; S.started = false; S.negm = f32x16{}; S.osum = f32x16{}; asm volatile("" : "+v"(S.negm)); }
__device__ __forceinline__ void rowst_fixed(RowSt& S, float ref) { S.m = ref; S.l = 0.f; S.started = true; S.osum = f32x16{};
#pragma unroll
    for (int r = 0; r < 16; ++r) S.negm[r] = -ref;
    asm volatile("" : "+v"(S.negm)); }
template <int MODE, class Src, class Msk>
__device__ __forceinline__ void run_branch(const Ctx& C, int nt, const Src& src, const Msk& msk, const bf16x8* qr, RowSt& S, f32x16* o, LAS float* ps_row, bool ps_writer, KVRegs& R0, bool pre, const bf16_t* nk, const bf16_t* nv) {
    KVRegs R1; const bf16_t *kp, *vp;
    if (!pre) { src(0, kp, vp); tile_load(R0, kp, vp, C.tid); }
    if (nt > 1) { src(1, kp, vp); tile_load(R1, kp, vp, C.tid); }
    auto compute = [&](int it, const LAS char* Ks, const LAS char* Vs, int klo, int khi, bool nm) {
        const bool kill = khi < klo;
        if (!__any(!kill)) return;
        f32x16 p0, p1; qkt(p0, p1, Ks, qr, S.negm, C.r32, C.hi);
        VFrag VF; if constexpr (MODE != 0) v_issue(VF, Vs + C.vbl);
        if (__any(nm && !kill)) {
#pragma unroll
            for (int r = 0; r < 16; ++r) { const int kv = crow(r, C.hi); if (kv < klo || kv > khi) p0[r] = -INFINITY; if (kv + 32 < klo || kv + 32 > khi) p1[r] = -INFINITY; }
        }
        if constexpr (MODE != 2) {
            float rm = rowmax(p0, p1, C.hi); if (kill) rm = -INFINITY;
            const bool first = !S.started && rm > -INFINITY, grow = first || rm > 8.0f;
            if (__any(grow)) {
                const float d = grow ? rm : 0.f, alpha = first ? 1.0f : __builtin_amdgcn_exp2f(-d);
                S.m += d; S.started = S.started || first;
#pragma unroll
                for (int r = 0; r < 16; ++r) { S.negm[r] = -S.m; p0[r] -= d; p1[r] -= d; }
                if constexpr (MODE == 0) S.l *= alpha;
                if constexpr (MODE == 1) {
                    if (C.hi == 0) C.wsf[C.r32] = alpha;
                    LWAIT();
#pragma unroll
                    for (int r = 0; r < 16; ++r) { const float f = C.wsf[crow(r, C.hi)]; o[0][r] *= f; o[1][r] *= f; S.osum[r] *= f; }
                    LWAIT();
                }
            }
        }
#pragma unroll
        for (int r = 0; r < 16; ++r) { p0[r] = __builtin_amdgcn_exp2f(p0[r]); p1[r] = __builtin_amdgcn_exp2f(p1[r]); }
        if constexpr (MODE == 0) {
            float s = 0.f;
#pragma unroll
            for (int r = 0; r < 16; ++r) s += p0[r] + p1[r];
            S.l += kill ? 0.f : s;
        }
        if constexpr (MODE == 2) {
            if (__any(kill)) {
#pragma unroll
                for (int r = 0; r < 16; ++r) { p0[r] = kill ? 0.f : p0[r]; p1[r] = kill ? 0.f : p1[r]; }
            }
            ps_accum(p0, 16 * it + C.hi, ps_row, ps_writer); ps_accum(p1, 16 * it + 8 + C.hi, ps_row, ps_writer);
        }
        if constexpr (MODE != 0) {
            u32x4 w0 = {cvtpk(p0[0], p0[1]), cvtpk(p0[2], p0[3]), cvtpk(p0[4], p0[5]), cvtpk(p0[6], p0[7])}, w1 = {cvtpk(p0[8], p0[9]), cvtpk(p0[10], p0[11]), cvtpk(p0[12], p0[13]), cvtpk(p0[14], p0[15])};
            u32x4 w2 = {cvtpk(p1[0], p1[1]), cvtpk(p1[2], p1[3]), cvtpk(p1[4], p1[5]), cvtpk(p1[6], p1[7])}, w3 = {cvtpk(p1[8], p1[9]), cvtpk(p1[10], p1[11]), cvtpk(p1[12], p1[13]), cvtpk(p1[14], p1[15])};
            if constexpr (MODE == 1) {
                if (__any(kill)) {
#pragma unroll
                    for (int e = 0; e < 4; ++e) { w0[e] = kill ? 0u : w0[e]; w1[e] = kill ? 0u : w1[e]; w2[e] = kill ? 0u : w2[e]; w3[e] = kill ? 0u : w3[e]; }
                }
            }
            pv<MODE == 1>(o, S.osum, VF, __builtin_bit_cast(bf16x8, w0), __builtin_bit_cast(bf16x8, w1), __builtin_bit_cast(bf16x8, w2), __builtin_bit_cast(bf16x8, w3));
        }
    };
    LBAR();
    for (int it = 0; it < nt; it += 2) {
        const int p = (it >> 1) & 1; const bool two = it + 1 < nt;
        LAS char* KsA = C.lds + L_K0 + (2 * p) * KSLOT; LAS char* VsA = C.lds + L_V0 + (2 * p) * VSLOT;
        LAS char* KsB = KsA + KSLOT; LAS char* VsB = VsA + VSLOT;
        tile_store(R0, KsA, VsA, C.tid); if (two) tile_store(R1, KsB, VsB, C.tid);
        if (it + 2 < nt) { src(it + 2, kp, vp); tile_load(R0, kp, vp, C.tid); } else if (nk) tile_load(R0, nk, nv, C.tid);
        if (it + 3 < nt) { src(it + 3, kp, vp); tile_load(R1, kp, vp, C.tid); }
        int kloA, khiA, kloB = 0, khiB = -1; const bool nmA = msk(it, kloA, khiA); bool nmB = false; if (two) nmB = msk(it + 1, kloB, khiB);
        LBAR();
        compute(it, KsA, VsA, kloA, khiA, nmA);
        if (two) compute(it + 1, KsB, VsB, kloB, khiB, nmB);
    }
}
template <bool FIRST> __device__ __forceinline__ void merge_branch_n(const Ctx& C, const f32x16* o, const f32x16& osum, float gate) {
    if (C.hi == 0) C.wsf[C.r32] = gate;
    LWAIT();
#pragma unroll
    for (int r = 0; r < 16; ++r) { const float den = osum[r], f = den > 0.f ? C.wsf[crow(r, C.hi)] * __builtin_amdgcn_rcpf(den) : 0.f;
        if (FIRST) { C.otl[r * 64] = o[0][r] * f; C.otl[(16 + r) * 64] = o[1][r] * f; }
        else { C.otl[r * 64] += o[0][r] * f; C.otl[(16 + r) * 64] += o[1][r] * f; } }
    LWAIT();
}
template <bool FIRST> __device__ __forceinline__ void merge_branch(const Ctx& C, const f32x16* o, float factor) {
    if (C.hi == 0) C.wsf[C.r32] = factor;
    LWAIT();
#pragma unroll
    for (int r = 0; r < 16; ++r) { const float f = C.wsf[crow(r, C.hi)];
        if (FIRST) { C.otl[r * 64] = o[0][r] * f; C.otl[(16 + r) * 64] = o[1][r] * f; }
        else { C.otl[r * 64] += o[0][r] * f; C.otl[(16 + r) * 64] += o[1][r] * f; } }
    LWAIT();
}
struct Bufs { const bf16_t *Qn, *KV, *Mo, *KC, *KM, *Gn; bf16_t* Abr; };
constexpr size_t KV_STRIDE = (size_t)MTOK * 128, MO_STRIDE = (size_t)MTOK * 256;

__device__ __forceinline__ void nsa_item(const Ctx& C, const Bufs& B, int b, int g, int i) {
    const int r32 = C.r32, hi = C.hi, wid = C.wid;
    const int qi = 8 * wid + (r32 >> 2), hh = r32 & 3, head = g * 4 + hh, t = 64 * i + qi, cur = i;
    const size_t bg = (size_t)(b * 2 + g) * SEQ;
    bf16x8 qr[4];
    { const bf16_t* qp = B.Qn + ((size_t)(b * 8 + head) * SEQ + t) * 64 + hi * 8;
#pragma unroll
      for (int d0 = 0; d0 < 4; ++d0) qr[d0] = *(const bf16x8*)(qp + d0 * 16); }
    const unsigned gw = *(const unsigned*)(B.Gn + ((size_t)b * SEQ + t) * 32 + head * 3 - (head & 1));
    const unsigned gw2 = *(const unsigned*)(B.Gn + ((size_t)b * SEQ + t) * 32 + head * 3 - (head & 1) + 2);
    float g0, g1, g2; if (head & 1) { g0 = bfhi(gw); g1 = bflo(gw2); g2 = bfhi(gw2); } else { g0 = bflo(gw); g1 = bfhi(gw); g2 = bflo(gw2); }
    f32x16 o[2];
    LAS float* Ps = (LAS float*)(C.lds + L_PS); LAS unsigned* Mk = (LAS unsigned*)(C.lds + L_MSK); LAS unsigned* Uni = (LAS unsigned*)(C.lds + L_UNI); LAS int* List = (LAS int*)(C.lds + L_LIST);
    const int nv = t >= 31 ? ((t - 31) >> 4) + 1 : 0;
    const int nvt = (4 * i + 3 < 511) ? 4 * i + 3 : 511, ntc = (nvt + 63) >> 6;
    const bf16_t* kc = B.KC + (size_t)(0 * 4 + b * 2 + g) * 512 * 64; const bf16_t* vc = B.KC + (size_t)(1 * 4 + b * 2 + g) * 512 * 64;
    auto srcC = [&](int it, const bf16_t*& kp, const bf16_t*& vp) { kp = kc + (size_t)it * 4096; vp = vc + (size_t)it * 4096; };
    auto mskC = [&](int it, int& klo, int& khi) { klo = 0; khi = nv - 1 - 64 * it; return khi < 63; };
    RowSt S; rowst_init(S);
    KVRegs R;
    run_branch<0>(C, ntc, srcC, mskC, qr, S, o, nullptr, false, R, false, kc, vc);
    const float lt = S.l + swap_other(S.l, hi);
    rowst_fixed(S, lt > 0.f ? S.m + __builtin_amdgcn_logf(lt) : 0.f);
    for (int e = C.tid; e < 64 * 128; e += 512) Ps[e] = 0.f;
    if (C.tid < 8) Uni[C.tid] = 0u;
    o[0] = f32x16{}; o[1] = f32x16{};
    run_branch<2>(C, ntc, srcC, mskC, qr, S, o, Ps + qi * 128, hh == 0, R, true, B.KV + 2 * KV_STRIDE + bg * 64, B.KV + 3 * KV_STRIDE + bg * 64);
    LBAR();
    {
        const int nf = cur == 0 ? 1 : (cur == 1 ? 2 : 3), kp_ = 16 - nf, lane = C.lane;
#pragma unroll 1
        for (int qq = 0; qq < 8; ++qq) {
            int q = 8 * wid + qq; asm volatile("" : "+s"(q)); LAS float* ps = Ps + q * 128;
            const int j0 = lane, j1 = lane + 64;
            const bool f0 = (j0 == 0 || j0 == cur || j0 == cur - 1) && j0 <= cur, f1 = (j1 == cur || j1 == cur - 1) && j1 <= cur;
            const bool va0 = j0 <= cur && !f0, va1 = j1 <= cur && !f1;
            const unsigned k0 = va0 ? __float_as_uint(ps[j0]) + 1u : 0u, k1 = va1 ? __float_as_uint(ps[j1]) + 1u : 0u;
            unsigned T = 0u;
            for (int bit = 30; bit >= 0; --bit) { const unsigned cand = T | (1u << bit); const int cnt = __popcll(__ballot(k0 >= cand)) + __popcll(__ballot(k1 >= cand)); if (cnt >= kp_) T = cand; }
            const int need = kp_ - (__popcll(__ballot(k0 > T)) + __popcll(__ballot(k1 > T)));
            const unsigned long long t0 = __ballot(k0 == T), t1 = __ballot(k1 == T), below = (1ull << lane) - 1ull;
            const int pre0 = __popcll(t0 & below), pre1 = __popcll(t0) + __popcll(t1 & below);
            const bool s0 = f0 || (k0 > 0u && (k0 > T || (k0 == T && pre0 < need))), s1 = f1 || (k1 > 0u && (k1 > T || (k1 == T && pre1 < need)));
            const unsigned long long b0 = __ballot(s0), b1 = __ballot(s1);
            if (lane == 0) { Mk[q * 4 + 0] = (unsigned)b0; Mk[q * 4 + 1] = (unsigned)(b0 >> 32); Mk[q * 4 + 2] = (unsigned)b1; Mk[q * 4 + 3] = (unsigned)(b1 >> 32);
                __hip_atomic_fetch_or(&Uni[0], (unsigned)b0, __ATOMIC_RELAXED, __HIP_MEMORY_SCOPE_WORKGROUP); __hip_atomic_fetch_or(&Uni[1], (unsigned)(b0 >> 32), __ATOMIC_RELAXED, __HIP_MEMORY_SCOPE_WORKGROUP); __hip_atomic_fetch_or(&Uni[2], (unsigned)b1, __ATOMIC_RELAXED, __HIP_MEMORY_SCOPE_WORKGROUP); __hip_atomic_fetch_or(&Uni[3], (unsigned)(b1 >> 32), __ATOMIC_RELAXED, __HIP_MEMORY_SCOPE_WORKGROUP); }
        }
    }
    LBAR();
    if (C.tid < 128) {
        const int wi = C.tid >> 5, bi = C.tid & 31; const unsigned u0 = Uni[0], u1 = Uni[1], u2 = Uni[2], u3 = Uni[3];
        const unsigned mine = wi == 0 ? u0 : wi == 1 ? u1 : wi == 2 ? u2 : u3;
        const int before = (wi > 0 ? __popc(u0) : 0) + (wi > 1 ? __popc(u1) : 0) + (wi > 2 ? __popc(u2) : 0) + __popc(mine & ((1u << bi) - 1u));
        if ((mine >> bi) & 1u) List[before] = C.tid;
        if (C.tid == 0) Uni[4] = (unsigned)(__popc(u0) + __popc(u1) + __popc(u2) + __popc(u3));
    }
    LBAR();
    merge_branch<true>(C, o, g0);
    {
        const int nsel = (int)Uni[4];
        const bf16_t* ks = B.KV + 2 * KV_STRIDE + bg * 64; const bf16_t* vs = B.KV + 3 * KV_STRIDE + bg * 64;
        auto srcS = [&](int it, const bf16_t*& kp, const bf16_t*& vp) { const int j = List[it]; kp = ks + (size_t)j * 4096; vp = vs + (size_t)j * 4096; };
        auto mskS = [&](int it, int& klo, int& khi) { const int j = List[it]; const unsigned w = Mk[qi * 4 + (j >> 5)]; const bool bit = (w >> (j & 31)) & 1u;
            klo = 0; khi = bit ? (j == cur ? qi : 63) : -1; return j == cur; };
        rowst_init(S); o[0] = f32x16{}; o[1] = f32x16{};
        const int tw0n = i >= 8 ? i - 8 : 0;
        run_branch<1>(C, nsel, srcS, mskS, qr, S, o, nullptr, false, R, true, B.KV + 4 * KV_STRIDE + bg * 64 + (size_t)tw0n * 4096, B.KV + 5 * KV_STRIDE + bg * 64 + (size_t)tw0n * 4096);
        merge_branch_n<false>(C, o, S.osum, g1);
    }
    {
        const int tw0 = i >= 8 ? i - 8 : 0, ntw = i - tw0 + 1;
        const bf16_t* kw = B.KV + 4 * KV_STRIDE + bg * 64; const bf16_t* vw = B.KV + 5 * KV_STRIDE + bg * 64;
        auto srcW = [&](int it, const bf16_t*& kp, const bf16_t*& vp) { kp = kw + (size_t)(tw0 + it) * 4096; vp = vw + (size_t)(tw0 + it) * 4096; };
        auto mskW = [&](int it, int& klo, int& khi) { const int tw = tw0 + it; klo = (t - 511) - 64 * tw; khi = (tw == i) ? qi : 63; return tw == i || klo > 0; };
        rowst_init(S); o[0] = f32x16{}; o[1] = f32x16{};
        run_branch<1>(C, ntw, srcW, mskW, qr, S, o, nullptr, false, R, true, nullptr, nullptr);
        merge_branch_n<false>(C, o, S.osum, g2);
    }
#pragma unroll
    for (int r = 0; r < 16; ++r) { const int qrow = crow(r, hi); bf16_t* dst = B.Abr + ((size_t)b * SEQ + 64 * i + 8 * wid + (qrow >> 2)) * DM + 256 + (g * 4 + (qrow & 3)) * 64 + r32;
        dst[0] = (bf16_t)(cvtpk(C.otl[r * 64], 0.f) & 0xffffu); dst[32] = (bf16_t)(cvtpk(C.otl[(16 + r) * 64], 0.f) & 0xffffu); }
}
__device__ __forceinline__ void moba_item(const Ctx& C, const Bufs& B, int b, int h, int qb) {
    const int r32 = C.r32, hi = C.hi, wid = C.wid, own = qb, t = 256 * qb + 32 * wid + r32;
    const size_t bh = (size_t)(b * 4 + h) * SEQ;
    bf16x8 qr[4];
    { const bf16_t* qp = B.Mo + (bh + t) * 64 + hi * 8;
#pragma unroll
      for (int d0 = 0; d0 < 4; ++d0) qr[d0] = *(const bf16x8*)(qp + d0 * 16); }
    LAS unsigned* Uni = (LAS unsigned*)(C.lds + L_UNI); LAS int* List = (LAS int*)(C.lds + L_LIST);
    LBAR();
    if (C.tid < 256) { const u32x4 kmv = *(const u32x4*)(B.KM + (size_t)(b * 4 + h) * 2048 + C.tid * 8); *(LAS u32x4*)(C.lds + L_K0 + (C.tid & 7) * KCS + (C.tid >> 3) * 16) = kmv; }
    if (C.tid == 0) Uni[0] = 0u;
    LBAR();
    unsigned sel = 0u;
    {
        f32x16 gs = f32x16{};
        const LAS char* kb = C.lds + L_K0 + hi * KCS + r32 * 16;
#pragma unroll
        for (int d0 = 0; d0 < 4; ++d0) gs = __builtin_amdgcn_mfma_f32_32x32x16_bf16(*(const LAS bf16x8*)(kb + d0 * 2 * KCS), qr[d0], gs, 0, 0, 0);
        float lo[16], hv[16];
#pragma unroll
        for (int r = 0; r < 16; ++r) { const float ownv = gs[r], oth = swap_other(ownv, hi); lo[r] = hi ? oth : ownv; hv[r] = hi ? ownv : oth; }
        unsigned taken = ~((1u << own) - 1u);
#pragma unroll
        for (int round = 0; round < 3; ++round) {
            float best = -INFINITY; int bi = 32;
#pragma unroll
            for (int n = 0; n < 32; ++n) { const int rr = (n & 3) + 4 * (n >> 3); const float v = ((n >> 2) & 1) ? hv[rr] : lo[rr]; if (!((taken >> n) & 1u) && v > best) { best = v; bi = n; } }
            if (bi < 32) { sel |= 1u << bi; taken |= 1u << bi; }
        }
    }
    { unsigned u = sel;
#pragma unroll
      for (int o_ = 1; o_ < 64; o_ <<= 1) u |= (unsigned)__shfl_xor((int)u, o_);
      if (C.lane == 0) __hip_atomic_fetch_or(&Uni[0], u, __ATOMIC_RELAXED, __HIP_MEMORY_SCOPE_WORKGROUP); }
    LBAR();
    if (C.tid == 0) { int n = 0; unsigned u = Uni[0]; while (u) { const int bpos = __builtin_ctz(u); u &= u - 1; List[n++] = bpos; } Uni[4] = (unsigned)n; }
    LBAR();
    const int nl = (int)Uni[4], nt = 4 * nl + 4;
    const bf16_t* kk = B.Mo + MO_STRIDE + bh * 64; const bf16_t* vv = B.Mo + 2 * MO_STRIDE + bh * 64;
    auto src = [&](int it, const bf16_t*& kp, const bf16_t*& vp) { const int T = (it < 4 * nl) ? 4 * List[it >> 2] + (it & 3) : 4 * own + (it - 4 * nl); kp = kk + (size_t)T * 4096; vp = vv + (size_t)T * 4096; };
    auto msk = [&](int it, int& klo, int& khi) { klo = 0; if (it < 4 * nl) { const bool bit = (sel >> List[it >> 2]) & 1u; khi = bit ? 63 : -1; return false; } khi = 32 * wid + r32 - 64 * (it - 4 * nl); return true; };
    RowSt S; rowst_init(S); f32x16 o[2] = {f32x16{}, f32x16{}};
    KVRegs R;
    run_branch<1>(C, nt, src, msk, qr, S, o, nullptr, false, R, false, nullptr, nullptr);
    merge_branch_n<true>(C, o, S.osum, 1.0f);
#pragma unroll
    for (int r = 0; r < 16; ++r) { const int qrow = crow(r, hi); bf16_t* dst = B.Abr + ((size_t)b * SEQ + 256 * qb + 32 * wid + qrow) * DM + 768 + h * 64 + r32;
        dst[0] = (bf16_t)(cvtpk(C.otl[r * 64], 0.f) & 0xffffu); dst[32] = (bf16_t)(cvtpk(C.otl[(16 + r) * 64], 0.f) & 0xffffu); }
}
}
#define XB_TMO      128
#define XB_XCNT(j)  (256  + 64 * (j))
#define XB_XSUB(j)  (1280 + 64 * (j))
#define XB_XGEN(j)  (2304 + 64 * (j))
#define XB_TOP      3328
#define XB_TOPGEN   3392
#define XCD_BAR_WORDS 3456
#define XB_SPIN_CAP (1u << 18)

__device__ __forceinline__ unsigned xb_ld(unsigned* p)              { return __hip_atomic_load(p, __ATOMIC_RELAXED, __HIP_MEMORY_SCOPE_AGENT); }
__device__ __forceinline__ unsigned xb_add(unsigned* p, unsigned v) { return __hip_atomic_fetch_add(p, v, __ATOMIC_RELAXED, __HIP_MEMORY_SCOPE_AGENT); }
__device__ __forceinline__ unsigned xb_xcc_id() { return (unsigned)__builtin_amdgcn_s_getreg((3 << 11) | 20) & 0xFu; }
#define XB_SPIN(cond, bar) do { unsigned _sp = 0; while (cond) { __builtin_amdgcn_s_sleep(1); \
    if ((++_sp & 255u) == 0u) { if (xb_ld(&(bar)[XB_TMO])) break; if (_sp > XB_SPIN_CAP) { atomicAdd(&(bar)[XB_TMO], 1u); break; } } } } while (0)

struct XcdBarrier {
    unsigned* bar; unsigned x;
    volatile LAS unsigned* st;
};

__device__ __forceinline__ XcdBarrier xcd_barrier_post(unsigned* bar, volatile LAS unsigned* st) {
    XcdBarrier b; b.bar = bar; b.x = xb_xcc_id(); b.st = st;
    if (threadIdx.x == 0) (void)xb_add(&bar[XB_XCNT(b.x)], 1u);
    return b;
}
__device__ __forceinline__ void xcd_barrier_complete(unsigned* bar, unsigned x, unsigned& nloc, unsigned& nx) {
    const unsigned G = gridDim.x * gridDim.y * gridDim.z;
    unsigned sum, cnt, mine, sp = 0u;
    for (;;) {
        sum = 0u; cnt = 0u; mine = 0u;
#pragma unroll
        for (unsigned j = 0; j < 16; ++j) { const unsigned c = xb_ld(&bar[XB_XCNT(j)]); sum += c; cnt += (c > 0u) ? 1u : 0u; mine = (j == x) ? c : mine; }
        if (sum == G) break;
        __builtin_amdgcn_s_sleep(1);
        if ((++sp & 255u) == 0u) { if (xb_ld(&bar[XB_TMO])) break; if (sp > XB_SPIN_CAP) { atomicAdd(&bar[XB_TMO], 1u); break; } }
    }
    nloc = mine > 0u ? mine : 1u; nx = cnt > 0u ? cnt : 1u;
}

__device__ __forceinline__ void xcd_barrier(const XcdBarrier& b) {
    asm volatile("s_waitcnt vmcnt(0)" ::: "memory");
    __syncthreads();
    if (threadIdx.x == 0) {
        unsigned* bar = b.bar;
        __builtin_amdgcn_s_waitcnt(0);
        unsigned nloc = b.st[0], nx = b.st[1];
        if (nloc == 0u) { xcd_barrier_complete(bar, b.x, nloc, nx); b.st[0] = nloc; b.st[1] = nx; }
        const unsigned old = xb_add(&bar[XB_XSUB(b.x)], 1u);
        const unsigned gen = old / nloc;
        if (old + 1u == (gen + 1u) * nloc) {
            __builtin_amdgcn_fence(__ATOMIC_RELEASE, "agent");
            asm volatile("s_waitcnt vmcnt(0)" ::: "memory");
            const unsigned og = xb_add(&bar[XB_TOP], 1u);
            const unsigned tg = og / nx;
            if (og + 1u == (tg + 1u) * nx) xb_add(&bar[XB_TOPGEN], 1u);
            else XB_SPIN(xb_ld(&bar[XB_TOPGEN]) == tg, bar);
            __builtin_amdgcn_fence(__ATOMIC_ACQUIRE, "agent");
            xb_add(&bar[XB_XGEN(b.x)], 1u);
            asm volatile("s_waitcnt vmcnt(0)" ::: "memory");
        } else {
            XB_SPIN(xb_ld(&bar[XB_XGEN(b.x)]) == gen, bar);
            __builtin_amdgcn_fence(__ATOMIC_ACQUIRE, "agent");
            asm volatile("s_waitcnt vmcnt(0)" ::: "memory");
        }
    }
    __syncthreads();
}

constexpr size_t MiB = 1u << 20;
constexpr size_t WS_CTL = 0, WS_ORDER = 4096, WS_BAR = 8192;
constexpr size_t WS_W = 1 * MiB, OFF_WIN = 0, OFF_WGU = 11 * MiB, OFF_WD = 22 * MiB, OFF_WBR = 28 * MiB, OFF_WOUT = 30 * MiB, OFF_W1 = 32 * MiB, OFF_W2 = 34 * MiB,
                 OFF_BIN = 34 * MiB + 65536, OFF_CB1 = OFF_BIN + 32768  , OFF_CB2 = OFF_CB1 + 65536;
constexpr size_t WS_TAB = 36 * MiB, WS_SSP = 38 * MiB, WS_KC = 39 * MiB, WS_KM = 39 * MiB + 512 * 1024, WS_GN = 40 * MiB, WS_XB = 42 * MiB, WS_BIG = 74 * MiB,
                 WS_U = 170 * MiB, WS_QN = 178 * MiB, WS_KV = 194 * MiB, WS_MO = 218 * MiB, WS_MRG = 178 * MiB, WS_END = 242 * MiB;
constexpr int LDS_BYTES = 147456;

__device__ __forceinline__ int dint(int pos) { return (pos >> 1) + 32 * (pos & 1); }
__device__ __forceinline__ int in_orig(int c) {
    if (c < 256) return c;
    if (c < 768) { const int c2 = c - 256; return 256 + (c2 >> 6) * 64 + dint(c2 & 63); }
    if (c < 1536) { const int c2 = c - 768, tt = c2 >> 8, bj = (c2 >> 7) & 1, g = (c2 >> 6) & 1, pos = c2 & 63; return 768 + (2 * tt + bj) * 128 + g * 64 + (bj == 0 ? dint(pos) : pos); }
    if (c < 2304) { const int c2 = c - 1536, part = c2 >> 8, h = (c2 >> 6) & 3, pos = c2 & 63; return 1560 + part * 256 + h * 64 + (part < 2 ? dint(pos) : pos); }
    if (c < 5376) return 2328 + (c - 2304);
    const int c2 = c - 5376; return c2 < 24 ? 1536 + c2 : -1;
}
template <class F> __device__ __forceinline__ void cvt_tile(LAS float* scr, int lane, int k0, int n0, bf16_t* dst, size_t pitch, F f) {
    float vals[32];
#pragma unroll
    for (int i = 0; i < 32; ++i) vals[i] = f(k0 + 2 * i + (lane >> 5), n0 + (lane & 31));
#pragma unroll
    for (int i = 0; i < 32; ++i) scr[(2 * i + (lane >> 5)) * 33 + (lane & 31)] = vals[i];
    asm volatile("s_waitcnt lgkmcnt(0)" ::: "memory");
    const int c = lane & 7;
#pragma unroll
    for (int j = 0; j < 4; ++j) { const int n = (lane >> 3) + 8 * j; const LAS float* s = scr + (8 * c) * 33 + n;
        u32x4 o; o.x = cvtpk(s[0 * 33], s[1 * 33]); o.y = cvtpk(s[2 * 33], s[3 * 33]); o.z = cvtpk(s[4 * 33], s[5 * 33]); o.w = cvtpk(s[6 * 33], s[7 * 33]);
        *(u32x4*)(dst + (size_t)(n0 + n) * pitch + k0 + 8 * c) = o; }
    asm volatile("s_waitcnt lgkmcnt(0)" ::: "memory");
}
template <class F> __device__ __forceinline__ void cvt_tile_scaled(LAS float* scr, int lane, int k0, int n0, bf16_t* dst, size_t pitch, F f, const float* scale, float keep) {
    float vals[32], sc[32];
#pragma unroll
    for (int i = 0; i < 32; ++i) { vals[i] = f(k0 + 2 * i + (lane >> 5), n0 + (lane & 31)); sc[i] = scale[k0 + 2 * i + (lane >> 5)]; }
    __builtin_amdgcn_sched_barrier(0);
#pragma unroll
    for (int i = 0; i < 32; ++i) scr[(2 * i + (lane >> 5)) * 33 + (lane & 31)] = vals[i] * (sc[i] * keep);
    asm volatile("s_waitcnt lgkmcnt(0)" ::: "memory");
    const int c = lane & 7;
#pragma unroll
    for (int j = 0; j < 4; ++j) { const int n = (lane >> 3) + 8 * j; const LAS float* s = scr + (8 * c) * 33 + n;
        u32x4 o; o.x = cvtpk(s[0 * 33], s[1 * 33]); o.y = cvtpk(s[2 * 33], s[3 * 33]); o.z = cvtpk(s[4 * 33], s[5 * 33]); o.w = cvtpk(s[6 * 33], s[7 * 33]);
        *(u32x4*)(dst + (size_t)(n0 + n) * pitch + k0 + 8 * c) = o; }
    asm volatile("s_waitcnt lgkmcnt(0)" ::: "memory");
}
struct Args { const float* in[20]; float* out; unsigned char* ws; };
typedef const __attribute__((address_space(4))) Args* ArgsP;

__device__ __forceinline__ void phase0(ArgsP a, int l, LAS unsigned char* lds, int tid, int lane, int wave, int gw, int NGW) {
    unsigned char* ws = a->ws;
    LAS float* scr = (LAS float*)(lds + wave * 8704);
    const float* attn_norm = a->in[1] + (size_t)l * DM; const float* w_in = a->in[2] + (size_t)l * DM * IN_COLS; const float* b_in = a->in[3] + (size_t)l * IN_COLS;
    const float* pool_w = a->in[4] + (size_t)l * 4 * 64 * 64; const float* pool_scale = a->in[5] + (size_t)l * 256; const float* cmp_pos = a->in[6] + (size_t)l * 2 * 32 * 64;
    const float* cmp_w1 = a->in[7] + (size_t)l * 2 * 2048 * 256; const float* cmp_b1 = a->in[8] + (size_t)l * 2 * 256; const float* cmp_w2 = a->in[9] + (size_t)l * 2 * 256 * 64; const float* cmp_b2 = a->in[10] + (size_t)l * 2 * 64;
    const float* w_br_pool = a->in[11] + (size_t)l * 256 * DM; const float* w_br_nsa = a->in[12] + (size_t)l * 512 * DM; const float* w_br_moba = a->in[13] + (size_t)l * 256 * DM;
    const float* w_out = a->in[14] + (size_t)l * DM * DM; const float* ffn_norm = a->in[15] + (size_t)l * DM; const float* w_gate = a->in[16] + (size_t)l * DM * DFF; const float* w_up = a->in[17] + (size_t)l * DM * DFF;
    const float* w_down = a->in[18] + (size_t)l * DFF * DM;
    bf16_t* Win = (bf16_t*)(ws + WS_W + OFF_WIN); bf16_t* Wgu = (bf16_t*)(ws + WS_W + OFF_WGU); bf16_t* Wd = (bf16_t*)(ws + WS_W + OFF_WD); bf16_t* Wbr = (bf16_t*)(ws + WS_W + OFF_WBR);
    bf16_t* Wout = (bf16_t*)(ws + WS_W + OFF_WOUT); bf16_t* W1t = (bf16_t*)(ws + WS_W + OFF_W1); bf16_t* W2t = (bf16_t*)(ws + WS_W + OFF_W2);
    float* bin = (float*)(ws + WS_W + OFF_BIN); float* cb1 = (float*)(ws + WS_W + OFF_CB1); float* cb2 = (float*)(ws + WS_W + OFF_CB2);
    constexpr int I_A = 16 * 176, I_B = 16 * 176, I_C = 44 * 32, I_D = 16 * 32, I_E = 16 * 32, I_F = 2 * 32 * 8, I_G = 2 * 4 * 2;
    constexpr int NITEMS = I_A + I_B + I_C + I_D + I_E + I_F + I_G;
    for (int it = gw; it < NITEMS; it += NGW) {
        int r = it;
        if (r < I_A) { const int kb = r / 176, nb = r % 176; { const int o = in_orig(32 * nb + (lane & 31)); const float* wc = w_in + (o >= 0 ? o : 0); const float keep = o >= 0 ? 1.f : 0.f;
            cvt_tile_scaled(scr, lane, 64 * kb, 32 * nb, Win, DM, [&](int k, int) { return wc[(size_t)k * IN_COLS]; }, attn_norm, keep); } continue; } r -= I_A;
        if (r < I_B) { const int kb = r / 176, nb = r % 176; { const int n = 32 * nb + (lane & 31), j = (n >> 8) * 128 + (n & 127); const float* wc = (((n >> 7) & 1) ? w_up : w_gate) + j;
            cvt_tile_scaled(scr, lane, 64 * kb, 32 * nb, Wgu, DM, [&](int k, int) { return wc[(size_t)k * DFF]; }, ffn_norm, 1.f); } continue; } r -= I_B;
        if (r < I_C) { const int kb = r / 32, nb = r % 32; cvt_tile(scr, lane, 64 * kb, 32 * nb, Wd, DFF, [&](int k, int n) { return w_down[(size_t)k * DM + n]; }); continue; } r -= I_C;
        if (r < I_D) { const int kb = r / 32, nb = r % 32; cvt_tile(scr, lane, 64 * kb, 32 * nb, Wout, DM, [&](int k, int n) { return w_out[(size_t)k * DM + n]; }); continue; } r -= I_D;
        if (r < I_E) { const int kb = r / 32, nb = r % 32;
            if (kb < 4) { }
            else if (kb < 12) cvt_tile(scr, lane, 64 * kb, 32 * nb, Wbr, DM, [&](int k, int n) { return w_br_nsa[(size_t)(k - 256) * DM + n]; });
            else cvt_tile(scr, lane, 64 * kb, 32 * nb, Wbr, DM, [&](int k, int n) { return w_br_moba[(size_t)(k - 768) * DM + n]; });
            continue; } r -= I_E;
        if (r < I_F) { const int kv = r >> 8, kb = (r >> 3) & 31, nb = r & 7; const float* w1 = cmp_w1 + (size_t)kv * 2048 * 256;
            cvt_tile(scr, lane, 64 * kb, 32 * nb, W1t + (size_t)kv * 256 * 2048, 2048, [&](int k, int n) { const int pos = k & 63, d = kv == 0 ? dint(pos) : pos; return w1[(size_t)((k & ~63) + d) * 256 + n]; }); continue; } r -= I_F;
        { const int kv = r >> 3, kb = (r >> 1) & 3, nb = r & 1; const float* w2 = cmp_w2 + (size_t)kv * 256 * 64;
            cvt_tile(scr, lane, 64 * kb, 32 * nb, W2t + (size_t)kv * 64 * 256, 256, [&](int k, int n) { return w2[(size_t)k * 64 + (kv == 0 ? dint(n) : n)]; }); }
    }
    const int gt = gw * 64 + lane, NGT = NGW * 64;
    for (int c = gt; c < NIN; c += NGT) { const int o = in_orig(c); bin[c] = o >= 0 ? b_in[o] : 0.f; }
    for (int idx = gt; idx < 32 * 512; idx += NGT) { const int c = idx >> 9, e = idx & 511, kv = e >> 8, n = e & 255; const float* w1 = cmp_w1 + (size_t)kv * 2048 * 256 + (size_t)(64 * c) * 256 + n; const float* pe = cmp_pos + (size_t)kv * 2048 + 64 * c;
        float s = c == 0 ? cmp_b1[kv * 256 + n] : 0.f;
#pragma unroll
        for (int k0 = 0; k0 < 64; k0 += 32) { float av[32], bv[32];
#pragma unroll
            for (int k = 0; k < 32; ++k) { av[k] = pe[k0 + k]; bv[k] = w1[(size_t)(k0 + k) * 256]; }
            __builtin_amdgcn_sched_barrier(0);
#pragma unroll
            for (int k = 0; k < 32; ++k) s += av[k] * bv[k]; }
        cb1[idx] = s; }
    for (int idx = gt; idx < 256 * DM; idx += NGT) { const int k = idx >> 10, n = idx & 1023, g64 = k & ~63; float s = 0.f;
        const f32x4* pw4 = (const f32x4*)(pool_w + (size_t)k * 64); const f32x4* ps4 = (const f32x4*)(pool_scale + g64);
#pragma unroll
        for (int j0 = 0; j0 < 64; j0 += 32) { f32x4 pw[8], psc[8]; float wb[32];
#pragma unroll
            for (int q = 0; q < 8; ++q) { pw[q] = pw4[j0 / 4 + q]; psc[q] = ps4[j0 / 4 + q]; }
#pragma unroll
            for (int j = 0; j < 32; ++j) wb[j] = w_br_pool[(size_t)(g64 + j0 + j) * DM + n];
            __builtin_amdgcn_sched_barrier(0);
#pragma unroll
            for (int j = 0; j < 32; ++j) s += pw[j >> 2][j & 3] * psc[j >> 2][j & 3] * wb[j]; }
        Wbr[(size_t)n * DM + k] = (bf16_t)(cvtpk(s, 0.f) & 0xffffu); }
    for (int e = gt; e < 128; e += NGT) { const int kv = e >> 6, n = e & 63; cb2[e] = cmp_b2[kv * 64 + (kv == 0 ? dint(n) : n)]; }
    if (l == 0) {
        float* tab = (float*)(ws + WS_TAB);
        for (int e = gt; e < SEQ * 32; e += NGT) { const int t = e >> 5, f = e & 31; const float inv = powf(10000.0f, -(float)(2 * f) / 64.0f); const float ang = (float)t * inv;
            const double ad = (double)ang, kq = rint(ad * 0.15915494309189535); double rr = fma(-kq, 6.283185307179586, ad); rr = fma(-kq, 2.4492935982947064e-16, rr);
            const float rf = (float)rr; tab[2 * e] = __cosf(rf); tab[2 * e + 1] = __sinf(rf); }
        const float* x = a->in[0]; bf16_t* xb = (bf16_t*)(ws + WS_XB); float* ssp = (float*)(ws + WS_SSP);
        for (int m0 = 2 * gw; m0 < MTOK; m0 += 2 * NGW) { f32x4 v[2][4]; float s[2] = {0.f, 0.f};
#pragma unroll
            for (int q = 0; q < 2; ++q) { const f32x4* xr = (const f32x4*)(x + (size_t)(m0 + q) * DM) + lane;
#pragma unroll
                for (int j = 0; j < 4; ++j) v[q][j] = xr[64 * j]; }
#pragma unroll
            for (int q = 0; q < 2; ++q) {
#pragma unroll
                for (int j = 0; j < 4; ++j) s[q] += (v[q][j][0] * v[q][j][0] + v[q][j][1] * v[q][j][1]) + (v[q][j][2] * v[q][j][2] + v[q][j][3] * v[q][j][3]);
#pragma unroll
                for (int o = 1; o < 64; o <<= 1) s[q] += __shfl_xor(s[q], o);
                u32x2* o8 = (u32x2*)(xb + (size_t)(m0 + q) * DM) + lane;
#pragma unroll
                for (int j = 0; j < 4; ++j) o8[64 * j] = (u32x2){cvtpk(v[q][j][0], v[q][j][1]), cvtpk(v[q][j][2], v[q][j][3])};
                if (lane < 16) ssp[(size_t)(m0 + q) * 16 + lane] = lane == 0 ? s[q] : 0.f; } }
        int* order = (int*)(ws + WS_ORDER);
        auto cost = [](int id) { if (id < 512) { const int i = id & 127; return 10 * ((i + 1) + ((i < 8 ? i : 8) + 1) + 10) + 16 * ((4 * i + 3 + 63) >> 6); } const int qb = (id - 512) & 31; return 7 * (4 * qb + 3) + 50; };
        for (int id = gw; id < 768; id += NGW) { const int mc = cost(id); int rk = 0;
            for (int j = lane; j < 768; j += 64) { const int cj = cost(j); rk += (cj > mc || (cj == mc && j < id)) ? 1 : 0; }
#pragma unroll
            for (int o = 1; o < 64; o <<= 1) rk += __shfl_xor(rk, o);
            if (lane == 0) order[rk] = id; }
    }
}
__device__ __forceinline__ float gelu_tanh(float x) { const float u = 0.7978845608028654f * (x + 0.044715f * x * x * x); const float th = 1.f - 2.f * __builtin_amdgcn_rcpf(1.f + __expf(2.f * u)); return 0.5f * x * (1.f + th); }
__device__ __forceinline__ void phase2(ArgsP a, LAS unsigned char* lds, int tid, int lane, int wave, int G) {
    unsigned char* ws = a->ws;
    const bf16_t* KV = (const bf16_t*)(ws + WS_KV); const bf16_t* W1t = (const bf16_t*)(ws + WS_W + OFF_W1); const bf16_t* W2t = (const bf16_t*)(ws + WS_W + OFF_W2);
    const float* cb1 = (const float*)(ws + WS_W + OFF_CB1); const float* cb2 = (const float*)(ws + WS_W + OFF_CB2);
    bf16_t* KC = (bf16_t*)(ws + WS_KC);
    LAS bf16_t* hid = (LAS bf16_t*)lds;
    const int arow = lane & 15, kq = lane >> 4;
    for (int task = blockIdx.x; task < 256; task += G) {
        const int kv = task >> 7, bgi = (task >> 5) & 3, nt = task & 31;
        const bf16_t* src = KV + (size_t)kv * att::KV_STRIDE + (size_t)bgi * SEQ * 64;
        const int nrow = 16 * nt + arow, neff = nrow < 510 ? nrow : 510;
        const bf16_t* ap = src + (size_t)neff * 1024 + kq * 8;
        const bf16_t* bp0 = W1t + (size_t)kv * 256 * 2048 + (size_t)(32 * wave + arow) * 2048 + kq * 8; const bf16_t* bp1 = bp0 + 16 * 2048;
        f32x4 c0 = {0.f, 0.f, 0.f, 0.f}, c1 = {0.f, 0.f, 0.f, 0.f};
        float bb0 = 0.f, bb1 = 0.f;
        { const int col0 = 32 * wave + arow; float t0[32], t1[32];
#pragma unroll
          for (int c = 0; c < 32; ++c) { t0[c] = cb1[c * 512 + kv * 256 + col0]; t1[c] = cb1[c * 512 + kv * 256 + col0 + 16]; }
          __builtin_amdgcn_sched_barrier(0);
#pragma unroll
          for (int c = 0; c < 32; ++c) { bb0 += t0[c]; bb1 += t1[c]; } }
#pragma unroll 1
        for (int ks0 = 0; ks0 < 64; ks0 += 8) { bf16x8 av[8], b0[8], b1[8];
#pragma unroll
            for (int q = 0; q < 8; ++q) { av[q] = *(const bf16x8*)(ap + (ks0 + q) * 32); b0[q] = *(const bf16x8*)(bp0 + (ks0 + q) * 32); b1[q] = *(const bf16x8*)(bp1 + (ks0 + q) * 32); }
            __builtin_amdgcn_sched_barrier(0);
#pragma unroll
            for (int q = 0; q < 8; ++q) { c0 = __builtin_amdgcn_mfma_f32_16x16x32_bf16(av[q], b0[q], c0, 0, 0, 0); c1 = __builtin_amdgcn_mfma_f32_16x16x32_bf16(av[q], b1[q], c1, 0, 0, 0); } }
        { const int col0 = 32 * wave + arow;
#pragma unroll
          for (int j = 0; j < 4; ++j) { const int row = kq * 4 + j; hid[row * 264 + col0] = (bf16_t)(cvtpk(gelu_tanh(c0[j] + bb0), 0.f) & 0xffffu); hid[row * 264 + col0 + 16] = (bf16_t)(cvtpk(gelu_tanh(c1[j] + bb1), 0.f) & 0xffffu); } }
        LBAR();
        if (wave < 4) {
            const bf16_t* bp = W2t + (size_t)kv * 64 * 256 + (size_t)(16 * wave + arow) * 256 + kq * 8; f32x4 c = {0.f, 0.f, 0.f, 0.f};
            bf16x8 bv[8];
#pragma unroll
            for (int ks = 0; ks < 8; ++ks) bv[ks] = *(const bf16x8*)(bp + ks * 32);
            __builtin_amdgcn_sched_barrier(0);
#pragma unroll
            for (int ks = 0; ks < 8; ++ks) { const bf16x8 av = *(const LAS bf16x8*)(hid + arow * 264 + kq * 8 + ks * 32); c = __builtin_amdgcn_mfma_f32_16x16x32_bf16(av, bv[ks], c, 0, 0, 0); }
            const int col = 16 * wave + arow; const float bb = cb2[kv * 64 + col];
#pragma unroll
            for (int j = 0; j < 4; ++j) { const int n = 16 * nt + kq * 4 + j; KC[((size_t)(kv * 4 + bgi) * 512 + n) * 64 + col] = n < 511 ? (bf16_t)(cvtpk(c[j] + bb, 0.f) & 0xffffu) : (bf16_t)0; }
        }
        LBAR();
    }
    const int gt = blockIdx.x * 512 + tid, NGT = G * 512;
    { const bf16_t* MoK = (const bf16_t*)(ws + WS_MO) + att::MO_STRIDE; bf16_t* KM = (bf16_t*)(ws + WS_KM); LAS float* part = (LAS float*)(lds + 16384);
      for (int blk = blockIdx.x; blk < 256; blk += G) { const bf16_t* p = MoK + ((size_t)blk * 256 + 32 * wave) * 64 + lane; float s = 0.f;
#pragma unroll
          for (int r0 = 0; r0 < 32; r0 += 16) { unsigned short tv[16];
#pragma unroll
              for (int r = 0; r < 16; ++r) tv[r] = p[(size_t)(r0 + r) * 64];
              __builtin_amdgcn_sched_barrier(0);
#pragma unroll
              for (int r = 0; r < 16; ++r) s += __uint_as_float((unsigned)tv[r] << 16); }
          part[wave * 64 + lane] = s;
          LBAR();
          if (wave == 0) { float t = 0.f;
#pragma unroll
              for (int w = 0; w < 8; ++w) t += part[w * 64 + lane];
              KM[(size_t)blk * 64 + lane] = (bf16_t)(cvtpk(t * (1.0f / 256.0f), 0.f) & 0xffffu); }
          LBAR(); } }
    { const bf16_t* U = (const bf16_t*)(ws + WS_U); bf16_t* Abr = (bf16_t*)(ws + WS_XB);
      for (int e = gt; e < MTOK * 32; e += NGT) { const int row = e >> 5, c8 = e & 31, s = row & (SEQ - 1), w = 2 << (c8 >> 3), cnt = (s + 1 < w) ? s + 1 : w;
          float acc[8] = {0.f, 0.f, 0.f, 0.f, 0.f, 0.f, 0.f, 0.f}; u32x4 v0 = {0u, 0u, 0u, 0u};
#pragma unroll
          for (int i0 = 0; i0 < 16; i0 += 8) { if (i0 >= cnt) break; u32x4 v[8];
#pragma unroll
              for (int i = 0; i < 8; ++i) v[i] = (i0 + i < cnt) ? *(const u32x4*)(U + (size_t)(row - i0 - i) * 256 + c8 * 8) : (u32x4){0u, 0u, 0u, 0u};
              __builtin_amdgcn_sched_barrier(0);
              if (i0 == 0) v0 = v[0];
#pragma unroll
              for (int i = 0; i < 8; ++i)
#pragma unroll
                  for (int q = 0; q < 4; ++q) { acc[2 * q] += bflo(v[i][q]); acc[2 * q + 1] += bfhi(v[i][q]); } }
          const float ic = 1.0f / (float)cnt; u32x4 o;
#pragma unroll
          for (int q = 0; q < 4; ++q) o[q] = cvtpk(acc[2 * q] * ic - bflo(v0[q]), acc[2 * q + 1] * ic - bfhi(v0[q]));
          *(u32x4*)(Abr + (size_t)row * DM + c8 * 8) = o; } }
}
__global__ void __launch_bounds__(512, 2) fwd_megakernel(Args a) {
    extern __shared__ __attribute__((aligned(16))) unsigned char lds_raw[];
    LAS unsigned char* lds = (LAS unsigned char*)lds_raw;
    cg::grid_group grid = cg::this_grid();
    const int G = gridDim.x;
    volatile LAS unsigned* bst = (volatile LAS unsigned*)(lds + LDS_BYTES - 64);
    if (threadIdx.x < 16) bst[threadIdx.x] = 0u;
    __syncthreads();
    const ArgsP ap0 = (ArgsP)__builtin_amdgcn_kernarg_segment_ptr();
#define PHASE_ARGS ArgsP a_ = ap0; asm volatile("" : "+s"(a_)); unsigned char* ws = a_->ws; unsigned* ctl = (unsigned*)(ws + WS_CTL); float* ssp = (float*)(ws + WS_SSP); const float* tab = (const float*)(ws + WS_TAB); \
    bf16_t* XB = (bf16_t*)(ws + WS_XB); bf16_t* BIG = (bf16_t*)(ws + WS_BIG); bf16_t* MRG = (bf16_t*)(ws + WS_MRG); (void)ctl; (void)ssp; (void)tab; (void)XB; (void)BIG; (void)MRG;
    XcdBarrier xbar = xcd_barrier_post((unsigned*)(ap0->ws + WS_BAR), bst);
    bool first_sync = true;
#define GRID_SYNC() do { if (first_sync) { grid.sync(); first_sync = false; } else xcd_barrier(xbar); } while (0)
    for (int l = 0; l < DEPTH; ++l) {
        int tid_ = threadIdx.x; asm volatile("" : "+v"(tid_));
        const int tid = tid_, lane = tid & 63, wave = __builtin_amdgcn_readfirstlane(tid >> 6), gw = blockIdx.x * 8 + wave, NGW = G * 8;
        { PHASE_ARGS phase0(a_, l, lds, tid, lane, wave, gw, NGW); }
        GRID_SYNC();
        { PHASE_ARGS pg8::Gemm g{XB, (const bf16_t*)(ws + WS_W + OFF_WIN), MTOK, NIN, DM}; pg8::StaticOrder S; S.init(MTOK, NIN, G, (int)blockIdx.x);
          EpiInProj E{ssp, (const float*)(ws + WS_W + OFF_BIN), tab, (bf16_t*)(ws + WS_U), (bf16_t*)(ws + WS_QN), (bf16_t*)(ws + WS_KV), (bf16_t*)(ws + WS_MO), BIG, (bf16_t*)(ws + WS_GN)};
          pg8::gemm_phase(lds, g, S, E); }
        GRID_SYNC();
        { PHASE_ARGS phase2(a_, lds, tid, lane, wave, G); }
        GRID_SYNC();
        { PHASE_ARGS
          att::Bufs B{(const bf16_t*)(ws + WS_QN), (const bf16_t*)(ws + WS_KV), (const bf16_t*)(ws + WS_MO), (const bf16_t*)(ws + WS_KC), (const bf16_t*)(ws + WS_KM), (const bf16_t*)(ws + WS_GN), XB};
          const int* order = (const int*)(ws + WS_ORDER); LAS int* slot = (LAS int*)(lds + att::L_END);
          if (wave >= 4) __builtin_amdgcn_s_setprio(1);
          for (;;) {
              LBAR();
              if (tid == 0) slot[0] = (int)atomicAdd(ctl + l, 1u);
              LBAR();
              const int item = slot[0];
              if (item >= 768) break;
              const int id = order[item];
              int tl = threadIdx.x; asm volatile("" : "+v"(tl));
              const int tid = tl, lane = tid & 63, wave = __builtin_amdgcn_readfirstlane(tid >> 6);
              att::Ctx C; C.lds = (LAS char*)lds; C.wsf = (LAS float*)(lds + att::L_WSF) + wave * 64; C.otl = (LAS float*)(lds + att::L_OT) + wave * 2048 + lane; C.tid = tid; C.wid = wave; C.lane = lane; C.r32 = lane & 31; C.hi = lane >> 5;
              C.vbl = ((lane >> 4) & 1) * 32 + (lane & 3) * 8 + (4 * (lane >> 5) + ((lane & 15) >> 2)) * 64;
              if (id < 512) att::nsa_item(C, B, id >> 8, (id >> 7) & 1, id & 127);
              else { const int x = id - 512; att::moba_item(C, B, x >> 7, (x >> 5) & 3, x & 31); }
          }
          __builtin_amdgcn_s_setprio(0); }
        GRID_SYNC();
        { PHASE_ARGS pg8::Gemm g{XB, (const bf16_t*)(ws + WS_W + OFF_WBR), MTOK, DM, DM}; pg8::StaticOrder S; S.init(MTOK, DM, G, (int)blockIdx.x);
          EpiBranch E{BIG, MRG}; pg8::gemm_phase(lds, g, S, E); }
        GRID_SYNC();
        { PHASE_ARGS pg8::Gemm g{MRG, (const bf16_t*)(ws + WS_W + OFF_WOUT), MTOK, DM, DM}; pg8::StaticOrder S; S.init(MTOK, DM, G, (int)blockIdx.x);
          bf16_t* RES = (bf16_t*)a_->out; EpiResid E{l == 0 ? a_->in[0] : nullptr, RES, XB, nullptr, ssp};   pg8::gemm_phase(lds, g, S, E); }
        GRID_SYNC();
        { PHASE_ARGS pg8::Gemm g{XB, (const bf16_t*)(ws + WS_W + OFF_WGU), MTOK, NGU, DM}; pg8::StaticOrder S; S.init(MTOK, NGU, G, (int)blockIdx.x);
          EpiSwiGLU E{ssp, BIG}; pg8::gemm_phase(lds, g, S, E); }
        GRID_SYNC();
        { PHASE_ARGS pg8::Gemm g{BIG, (const bf16_t*)(ws + WS_W + OFF_WD), MTOK, DM, DFF}; pg8::StaticOrder S; S.init(MTOK, DM, G, (int)blockIdx.x);
          bf16_t* RES = (bf16_t*)a_->out; EpiResid E{nullptr, XB, XB, l + 1 < DEPTH ? RES : nullptr, ssp};   pg8::gemm_phase(lds, g, S, E); }
        GRID_SYNC();
    }
    { PHASE_ARGS const float* fn = a_->in[19]; float* outp = a_->out; const int lane = threadIdx.x & 63, gw = blockIdx.x * 8 + (threadIdx.x >> 6), NGW = G * 8;
      const f32x4* gr = (const f32x4*)fn + lane; f32x4 gv[4];
#pragma unroll
      for (int j = 0; j < 4; ++j) gv[j] = gr[64 * j];
      for (int m0 = 2 * gw; m0 < MTOK; m0 += 2 * NGW) { u32x2 w[2][4]; float rstd[2];
#pragma unroll
          for (int q = 0; q < 2; ++q) { const u32x2* xr = (const u32x2*)(XB + (size_t)(m0 + q) * DM) + lane; rstd[q] = row_rstd(ssp, m0 + q);
#pragma unroll
              for (int j = 0; j < 4; ++j) w[q][j] = xr[64 * j]; }
#pragma unroll
          for (int q = 0; q < 2; ++q) { f32x4* orow = (f32x4*)(outp + (size_t)(m0 + q) * DM) + lane;
#pragma unroll
              for (int j = 0; j < 4; ++j) { const f32x4 v = {bflo(w[q][j][0]), bfhi(w[q][j][0]), bflo(w[q][j][1]), bfhi(w[q][j][1])}; orow[64 * j] = v * rstd[q] * gv[j]; } } } }
}

extern "C" void kernel_launch(void* const* d_in, const int* in_sizes, int n_in, void* d_out, int out_size, void* d_ws, size_t ws_size, hipStream_t stream) {
    static int grid = 0;
    if (grid == 0) {
        if (n_in != 20 || in_sizes[0] != MTOK * DM || out_size != MTOK * DM || ws_size < WS_END) { fprintf(stderr, "kernel_launch: unexpected shapes / workspace (n_in %d, ws %zu)\n", n_in, ws_size); grid = -1; return; }
        int dev = 0, cus = 0, per_cu = 0;
        if (hipGetDevice(&dev) != hipSuccess || hipDeviceGetAttribute(&cus, hipDeviceAttributeMultiprocessorCount, dev) != hipSuccess) { grid = -1; return; }
        if (hipFuncSetAttribute((const void*)fwd_megakernel, hipFuncAttributeMaxDynamicSharedMemorySize, LDS_BYTES) != hipSuccess) { fprintf(stderr, "kernel_launch: hipFuncSetAttribute failed\n"); grid = -1; return; }
        if (hipOccupancyMaxActiveBlocksPerMultiprocessor(&per_cu, (const void*)fwd_megakernel, 512, LDS_BYTES) != hipSuccess || per_cu < 1) { fprintf(stderr, "kernel_launch: occupancy query failed (%d)\n", per_cu); (void)hipGetLastError(); grid = -1; return; }
        grid = cus * per_cu;
    }
    if (grid < 0) return;
    if (hipMemsetAsync((char*)d_ws + WS_CTL, 0, 32768, stream) != hipSuccess) { fprintf(stderr, "kernel_launch: memset failed\n"); return; }
    Args a{};
    for (int i = 0; i < 20; ++i) a.in[i] = (const float*)d_in[i];
    a.out = (float*)d_out; a.ws = (unsigned char*)d_ws;
    void* args[] = {&a};
    const hipError_t e = hipLaunchCooperativeKernel((const void*)fwd_megakernel, dim3(grid), dim3(512), args, LDS_BYTES, stream);
    if (e != hipSuccess) fprintf(stderr, "kernel_launch: cooperative launch failed: %s (grid %d)\n", hipGetErrorString(e), grid);
}
```

```cpp
#include <hip/hip_runtime.h>
#include <hip/hip_cooperative_groups.h>
#include <cstdio>
#include <cstdint>
#include <cmath>
namespace cg = cooperative_groups;

#define LAS __attribute__((address_space(3)))
typedef unsigned short bf16_t;
typedef short bf16x8 __attribute__((ext_vector_type(8)));
typedef short s16x4 __attribute__((ext_vector_type(4)));
typedef float f32x2 __attribute__((ext_vector_type(2)));
typedef float f32x4 __attribute__((ext_vector_type(4)));
typedef float f32x16 __attribute__((ext_vector_type(16)));
typedef unsigned u32x4 __attribute__((ext_vector_type(4)));
typedef unsigned u32x2 __attribute__((ext_vector_type(2)));
typedef __bf16 bf16x2_t __attribute__((ext_vector_type(2)));

constexpr int SEQ = 8192, BATCH = 2, MTOK = BATCH * SEQ, DM = 1024, DEPTH = 2;
constexpr int IN_COLS = 5400, NIN = 5632, DFF = 2816, NGU = 5632;
constexpr float RMS_EPS = 1e-6f;
constexpr float QSCALE = 0.125f * 1.4426950408889634f;

__device__ __forceinline__ unsigned cvtpk(float lo, float hi) { f32x2 v = {lo, hi}; bf16x2_t b = __builtin_convertvector(v, bf16x2_t); return __builtin_bit_cast(unsigned, b); }
__device__ __forceinline__ float bflo(unsigned w) { return __uint_as_float(w << 16); }
__device__ __forceinline__ float bfhi(unsigned w) { return __uint_as_float(w & 0xffff0000u); }
__device__ __forceinline__ float sigmoidf_(float x) { return __builtin_amdgcn_rcpf(1.f + __expf(-x)); }

namespace pg8 {
constexpr int BM = 256, BK = 64, HALF = 128, HTB = HALF * BK * 2, STAGE_BYTES = 8 * HTB, NXCD = 8, WGM = 8;
__host__ __device__ __forceinline__ int lds_byte(int r, int c) { const int st = (r >> 4) * 2 + (c >> 5), rr = r & 15, cc = c & 31, ob = rr * 64 + cc * 2; return st * 1024 + (ob ^ (((ob >> 9) & 1) << 5)); }
__host__ __device__ __forceinline__ void stage_rc(int b, int& R, int& C) { const int st = b / 1024, sb = b % 1024, swz = sb ^ (((sb >> 9) & 1) << 5); R = (st >> 1) * 16 + swz / 64; C = (st & 1) * 32 + (swz % 64) / 2; }
__host__ __device__ __forceinline__ int perm32(int rho) { const int n = rho >> 4, i = rho & 15; return 8 * (i >> 2) + 4 * n + (i & 3); }
struct Unit { int pm, pn; };
struct Gemm { const bf16_t* A; const bf16_t* Bt; int M, N, K; };
struct StaticOrder {
    int nM, nN, nwg, G, c;
    __host__ __device__ void init(int M, int N, int G_, int c_) { nM = M / BM; nN = N / BM; nwg = nM * nN; G = G_; c = c_; }
    __host__ __device__ bool next(int i, Unit& u) const {
        const long L = (long)i * G + c; if (L >= nwg) return false;
        int wgid = (int)L; { const int q = nwg / NXCD, r = nwg % NXCD, xcd = wgid % NXCD, off = wgid / NXCD; wgid = (xcd < r ? xcd * (q + 1) : r * (q + 1) + (xcd - r) * q) + off; }
        const int nig = WGM * nN, gid = wgid / nig, fm = gid * WGM, gsz = (nM - fm) < WGM ? (nM - fm) : WGM;
        u.pm = fm + ((wgid % nig) % gsz); u.pn = (wgid % nig) / gsz; return true;
    }
};
template <class Epi, class Sched>
__device__ __forceinline__ void gemm_phase(LAS unsigned char* lds, const Gemm g, const Sched& S, const Epi& E) {
    int tid_ = threadIdx.x; asm volatile("" : "+v"(tid_));
    const int tid = tid_, wid = __builtin_amdgcn_readfirstlane(tid >> 6), lane = tid & 63, wr = wid >> 2, wc = wid & 3, fr = lane & 15, fq = lane >> 4;
    const int K = g.K, nt = K / BK;
    unsigned voffA[2], voffB[2];
#pragma unroll
    for (int i = 0; i < 2; ++i) { int R, C; stage_rc(tid * 16 + i * 8192, R, C); const int Rb = ((R & ~31) + perm32(R & 31));
        voffA[i] = (unsigned)(R * K + C) * 2u; voffB[i] = (unsigned)(Rb * K + C) * 2u; }
    const size_t kstep = (size_t)(BK * 2);
    const size_t hstep = (size_t)HALF * K * 2;
    const size_t tstep = 2 * hstep;
    const unsigned ldsw = (unsigned)wid * 1024u;
    const int aoff = lds_byte(wr * 64 + fr, fq * 8), boff = lds_byte(wc * 32 + fr, fq * 8);
#define PG8_SA(b, h) (((b) * 2 + (h)) * HTB)
#define PG8_SB(b, h) ((4 + (b) * 2 + (h)) * HTB)
#define PG8_STAGE(bufoff, gbase, voff) do { _Pragma("unroll") for (int _i = 0; _i < 2; ++_i) \
        __builtin_amdgcn_global_load_lds((const unsigned*)((const char*)(gbase) + (voff)[_i]), (LAS unsigned*)(lds + (bufoff) + ldsw + _i * 8192), 16, 0, 0); } while (0)
#define PG8_LDA(dst, b, h) do { _Pragma("unroll") for (int m = 0; m < 4; ++m) _Pragma("unroll") for (int k = 0; k < 2; ++k) dst[m][k] = *(const LAS bf16x8*)(lds + PG8_SA(b, h) + aoff + m * 2048 + k * 1024); } while (0)
#define PG8_LDB(dst, b, h) do { _Pragma("unroll") for (int n = 0; n < 2; ++n) _Pragma("unroll") for (int k = 0; k < 2; ++k) dst[n][k] = *(const LAS bf16x8*)(lds + PG8_SB(b, h) + boff + n * 2048 + k * 1024); } while (0)
#define PG8_MMA(ai, bj, At, Bt) do { __builtin_amdgcn_s_setprio(1); _Pragma("unroll") for (int m = 0; m < 4; ++m) _Pragma("unroll") for (int n = 0; n < 2; ++n) _Pragma("unroll") for (int k = 0; k < 2; ++k) \
        acc[ai][bj][m][n] = __builtin_amdgcn_mfma_f32_16x16x32_bf16(Bt[n][k], At[m][k], acc[ai][bj][m][n], 0, 0, 0); __builtin_amdgcn_s_setprio(0); } while (0)
#define PG8_WAIT_V(n) asm volatile("s_waitcnt vmcnt(" #n ")" ::: "memory")
#define PG8_WAIT_L(n) asm volatile("s_waitcnt lgkmcnt(" #n ")" ::: "memory")
#define PG8_BAR __builtin_amdgcn_s_barrier()
#define PG8_SCHED __builtin_amdgcn_sched_barrier(0)
    Unit cur, nxt; int ui = 0;
    if (!S.next(0, cur)) return;
    f32x4 acc[2][2][4][2];
#pragma unroll
    for (int a = 0; a < 2; ++a)
#pragma unroll
        for (int b = 0; b < 2; ++b)
#pragma unroll
            for (int m = 0; m < 4; ++m)
#pragma unroll
                for (int n = 0; n < 2; ++n) acc[a][b][m][n] = (f32x4){0.f, 0.f, 0.f, 0.f};
    bf16x8 At[4][2], B0[2][2], B1[2][2];
    const char* cA = (const char*)g.A + (size_t)cur.pm * tstep; const char* cB = (const char*)g.Bt + (size_t)cur.pn * tstep;
    PG8_STAGE(PG8_SB(0, 0), cB, voffB); PG8_STAGE(PG8_SB(0, 1), cB + hstep, voffB); PG8_STAGE(PG8_SA(0, 0), cA, voffA); PG8_STAGE(PG8_SA(0, 1), cA + hstep, voffA);
    if (wr == 1) PG8_BAR;
    PG8_WAIT_V(2); PG8_BAR;
    PG8_STAGE(PG8_SB(1, 0), cB + kstep, voffB); PG8_STAGE(PG8_SA(1, 0), cA + kstep, voffA); PG8_STAGE(PG8_SB(1, 1), cB + hstep + kstep, voffB);
    PG8_WAIT_V(6); PG8_BAR;
    for (;;) {
        const bool has_next = S.next(ui + 1, nxt);
        const char* nA = has_next ? (const char*)g.A + (size_t)nxt.pm * tstep : cA; const char* nB = has_next ? (const char*)g.Bt + (size_t)nxt.pn * tstep : cB;
        for (int t = 0; t < nt; t += 2) {
            const bool last = (t == nt - 2);
            const char* a1 = cA + (size_t)(t + 1) * kstep;
            const char* a2 = last ? nA : cA + (size_t)(t + 2) * kstep; const char* b2 = last ? nB : cB + (size_t)(t + 2) * kstep;
            const char* a3 = a2 + kstep; const char* b3 = b2 + kstep;
            if constexpr (Epi::KHOOK) { if (t == 4 || t == 12) { PG8_SCHED; E.khook(acc, cur, t, wr, wc, fr, fq); PG8_SCHED; } }
            PG8_LDB(B0, 0, 0); PG8_LDB(B1, 0, 1); PG8_SCHED; PG8_LDA(At, 0, 0); PG8_STAGE(PG8_SA(1, 1), a1 + hstep, voffA);
            PG8_WAIT_V(8); PG8_WAIT_L(0); PG8_BAR; PG8_MMA(0, 0, At, B0); PG8_MMA(0, 1, At, B1); PG8_BAR; PG8_SCHED;
            PG8_LDA(At, 0, 1); PG8_STAGE(PG8_SB(0, 0), b2, voffB); PG8_STAGE(PG8_SB(0, 1), b2 + hstep, voffB); PG8_STAGE(PG8_SA(0, 0), a2, voffA);
            PG8_WAIT_V(8); PG8_WAIT_L(0); PG8_BAR; PG8_MMA(1, 0, At, B0); PG8_MMA(1, 1, At, B1); PG8_BAR; PG8_SCHED;
            PG8_LDB(B0, 1, 0); PG8_LDB(B1, 1, 1); PG8_SCHED; PG8_LDA(At, 1, 0); PG8_STAGE(PG8_SA(0, 1), a2 + hstep, voffA);
            PG8_WAIT_V(8); PG8_WAIT_L(0); PG8_BAR; PG8_MMA(0, 0, At, B0); PG8_MMA(0, 1, At, B1); PG8_BAR; PG8_SCHED;
            PG8_LDA(At, 1, 1); PG8_STAGE(PG8_SB(1, 0), b3, voffB); PG8_STAGE(PG8_SB(1, 1), b3 + hstep, voffB); PG8_STAGE(PG8_SA(1, 0), a3, voffA);
            PG8_WAIT_V(8); PG8_WAIT_L(0); PG8_BAR; PG8_MMA(1, 0, At, B0); PG8_MMA(1, 1, At, B1); PG8_BAR; PG8_SCHED;
        }
        if (wr == 0) PG8_BAR;
        E(acc, cur, wr, wc, fr, fq);
        if (!has_next) break;
#pragma unroll
        for (int a = 0; a < 2; ++a)
#pragma unroll
            for (int b = 0; b < 2; ++b)
#pragma unroll
                for (int m = 0; m < 4; ++m)
#pragma unroll
                    for (int n = 0; n < 2; ++n) acc[a][b][m][n] = (f32x4){0.f, 0.f, 0.f, 0.f};
        cur = nxt; cA = nA; cB = nB; ++ui;
        if (wr == 1) PG8_BAR;
    }
    PG8_WAIT_V(0);
    PG8_BAR;
#undef PG8_SA
#undef PG8_SB
#undef PG8_STAGE
#undef PG8_LDA
#undef PG8_LDB
#undef PG8_MMA
#undef PG8_WAIT_V
#undef PG8_WAIT_L
#undef PG8_BAR
#undef PG8_SCHED
}
}
using pg8::Unit;
__device__ __forceinline__ float row_rstd(const float* ssp, int row) {
    const f32x4* p = (const f32x4*)(ssp + (size_t)row * 16);
    const f32x4 a = p[0], b = p[1], c = p[2], d = p[3];
    const float ss = ((a[0] + a[1]) + (a[2] + a[3])) + ((b[0] + b[1]) + (b[2] + b[3])) + ((c[0] + c[1]) + (c[2] + c[3])) + ((d[0] + d[1]) + (d[2] + d[3]));
    return 1.0f / sqrtf(ss * (1.0f / DM) + RMS_EPS);
}
__device__ __forceinline__ float row_rstd4(const float* ssp, int row, int fq) {
    const f32x4 a = *((const f32x4*)(ssp + (size_t)row * 16) + fq);
    float ss = (a[0] + a[1]) + (a[2] + a[3]);
    ss += __shfl_xor(ss, 16); ss += __shfl_xor(ss, 32);
    return 1.0f / sqrtf(ss * (1.0f / DM) + RMS_EPS);
}
__device__ __forceinline__ u32x4 pack8(const f32x4 a, const f32x4 b) { u32x4 w; w.x = cvtpk(a[0], a[1]); w.y = cvtpk(a[2], a[3]); w.z = cvtpk(b[0], b[1]); w.w = cvtpk(b[2], b[3]); return w; }
__device__ __forceinline__ void rope8(f32x4& v0, f32x4& v1, const float* tab, int t, int pos, float sc) {
    const f32x4* cs = (const f32x4*)(tab + ((size_t)t * 32 + (pos >> 1)) * 2);
    const f32x4 c0 = cs[0], c1 = cs[1];
    f32x4 o0, o1;
    o0[0] = (v0[0] * c0[0] - v0[1] * c0[1]) * sc; o0[1] = (v0[1] * c0[0] + v0[0] * c0[1]) * sc;
    o0[2] = (v0[2] * c0[2] - v0[3] * c0[3]) * sc; o0[3] = (v0[3] * c0[2] + v0[2] * c0[3]) * sc;
    o1[0] = (v1[0] * c1[0] - v1[1] * c1[1]) * sc; o1[1] = (v1[1] * c1[0] + v1[0] * c1[1]) * sc;
    o1[2] = (v1[2] * c1[2] - v1[3] * c1[3]) * sc; o1[3] = (v1[3] * c1[2] + v1[2] * c1[3]) * sc;
    v0 = o0; v1 = o1;
}
struct EpiInProj {
    static constexpr bool KHOOK = false;
    const float* ssp; const float* bias; const float* tab;
    bf16_t *U, *Qn, *KV, *Mo, *G, *Gn;
    __device__ __forceinline__ void operator()(const f32x4 (&acc)[2][2][4][2], const Unit& u, int wr, int wc, int fr, int fq) const {
        asm volatile("" : "+v"(fr), "+v"(fq));
        const int pn = u.pn;
        f32x4 bia[2][2];
#pragma unroll
        for (int bj = 0; bj < 2; ++bj) { const int gc = pn * 256 + bj * 128 + wc * 32 + 8 * fq; bia[bj][0] = *(const f32x4*)(bias + gc); bia[bj][1] = *(const f32x4*)(bias + gc + 4); }
        float rs[2][4];
#pragma unroll
        for (int ai = 0; ai < 2; ++ai) { f32x4 ra[4];
#pragma unroll
            for (int m = 0; m < 4; ++m) ra[m] = *((const f32x4*)(ssp + (size_t)(u.pm * 256 + ai * 128 + wr * 64 + m * 16 + fr) * 16) + fq);
            __builtin_amdgcn_sched_barrier(0);
#pragma unroll
            for (int m = 0; m < 4; ++m) { float ss = (ra[m][0] + ra[m][1]) + (ra[m][2] + ra[m][3]); ss += __shfl_xor(ss, 16); ss += __shfl_xor(ss, 32); rs[ai][m] = 1.0f / sqrtf(ss * (1.0f / DM) + RMS_EPS); } }
#pragma unroll
        for (int ai = 0; ai < 2; ++ai)
#pragma unroll
            for (int m = 0; m < 4; ++m) {
                const int row = u.pm * 256 + ai * 128 + wr * 64 + m * 16 + fr;
                const float rstd = rs[ai][m];
                const int t = row & (SEQ - 1), b = row >> 13;
#pragma unroll
                for (int bj = 0; bj < 2; ++bj) {
                    const int cit = bj * 128 + wc * 32 + 8 * fq;
                    f32x4 v0 = acc[ai][bj][m][0] * rstd + bia[bj][0], v1 = acc[ai][bj][m][1] * rstd + bia[bj][1];
                    bf16_t* dst;
                    if (pn == 0) { dst = U + (size_t)row * 256 + cit; }
                    else if (pn <= 2) { const int c2 = (pn - 1) * 256 + cit, head = c2 >> 6, pos = c2 & 63; rope8(v0, v1, tab, t, pos, QSCALE); dst = Qn + ((size_t)(b * 8 + head) * SEQ + t) * 64 + pos; }
                    else if (pn <= 5) { const int c2 = cit & 127, g = c2 >> 6, pos = c2 & 63, kvi = 2 * (pn - 3) + bj; if (bj == 0) rope8(v0, v1, tab, t, pos, 1.f);
                        dst = KV + (size_t)kvi * ((size_t)MTOK * 128) + ((size_t)(b * 2 + g) * SEQ + t) * 64 + pos; }
                    else if (pn <= 8) { const int h = cit >> 6, pos = cit & 63; if (pn < 8) rope8(v0, v1, tab, t, pos, pn == 6 ? QSCALE : 1.f);
                        dst = Mo + (size_t)(pn - 6) * ((size_t)MTOK * 256) + ((size_t)(b * 4 + h) * SEQ + t) * 64 + pos; }
                    else if (pn <= 20) {
#pragma unroll
                        for (int e = 0; e < 4; ++e) { v0[e] = sigmoidf_(v0[e]); v1[e] = sigmoidf_(v1[e]); }
                        dst = G + (size_t)row * 3072 + (pn - 9) * 256 + cit; }
                    else {
#pragma unroll
                        for (int e = 0; e < 4; ++e) { v0[e] = sigmoidf_(v0[e]); v1[e] = sigmoidf_(v1[e]); }
                        dst = Gn + (size_t)row * 32 + (cit & 31); if (cit >= 32) dst = nullptr; }
                    if (dst) *(u32x4*)dst = pack8(v0, v1);
                }
                asm volatile("" ::: "memory");
            }
    }
};
struct EpiBranch {
    static constexpr bool KHOOK = true;
    const bf16_t* G; bf16_t* out;
    __device__ __forceinline__ void khook(f32x4 (&acc)[2][2][4][2], const Unit& u, int t, int wr, int wc, int fr, int fq) const {
        asm volatile("" : "+v"(fr), "+v"(fq));
        const int gsel = (t == 4) ? 0 : 1024;
#pragma unroll
        for (int ai = 0; ai < 2; ++ai)
#pragma unroll
            for (int m = 0; m < 4; ++m) {
                u32x4 gx[2], gy[2];
#pragma unroll
                for (int bj = 0; bj < 2; ++bj) { const int row = u.pm * 256 + ai * 128 + wr * 64 + m * 16 + fr, col = u.pn * 256 + bj * 128 + wc * 32 + 8 * fq;
                    gx[bj] = *(const u32x4*)(G + (size_t)row * 3072 + gsel + col); gy[bj] = *(const u32x4*)(G + (size_t)row * 3072 + gsel + 1024 + col); }
                __builtin_amdgcn_sched_barrier(0);
#pragma unroll
                for (int bj = 0; bj < 2; ++bj)
#pragma unroll
                    for (int e = 0; e < 4; ++e) {
                        const float x0 = fmaxf(bflo(gx[bj][e]), 1e-20f), x1 = fmaxf(bfhi(gx[bj][e]), 1e-20f), y0 = fmaxf(bflo(gy[bj][e]), 1e-20f), y1 = fmaxf(bfhi(gy[bj][e]), 1e-20f);
                        const float r0 = x0 * __builtin_amdgcn_rcpf(y0), r1 = x1 * __builtin_amdgcn_rcpf(y1);
                        acc[ai][bj][m][e >> 1][(e & 1) * 2] *= r0; acc[ai][bj][m][e >> 1][(e & 1) * 2 + 1] *= r1; }
                asm volatile("" ::: "memory");
            }
    }
    __device__ __forceinline__ void operator()(const f32x4 (&acc)[2][2][4][2], const Unit& u, int wr, int wc, int fr, int fq) const {
        asm volatile("" : "+v"(fr), "+v"(fq));
#pragma unroll
        for (int ai = 0; ai < 2; ++ai) {
            u32x4 gz[4][2];
#pragma unroll
            for (int m = 0; m < 4; ++m)
#pragma unroll
                for (int bj = 0; bj < 2; ++bj) gz[m][bj] = *(const u32x4*)(G + (size_t)(u.pm * 256 + ai * 128 + wr * 64 + m * 16 + fr) * 3072 + 2048 + u.pn * 256 + bj * 128 + wc * 32 + 8 * fq);
            __builtin_amdgcn_sched_barrier(0);
#pragma unroll
            for (int m = 0; m < 4; ++m) {
                const int row = u.pm * 256 + ai * 128 + wr * 64 + m * 16 + fr;
#pragma unroll
                for (int bj = 0; bj < 2; ++bj) {
                    const int col = u.pn * 256 + bj * 128 + wc * 32 + 8 * fq; const u32x4 g = gz[m][bj];
                    f32x4 v0 = acc[ai][bj][m][0], v1 = acc[ai][bj][m][1];
                    v0[0] *= fmaxf(bflo(g[0]), 1e-20f); v0[1] *= fmaxf(bfhi(g[0]), 1e-20f); v0[2] *= fmaxf(bflo(g[1]), 1e-20f); v0[3] *= fmaxf(bfhi(g[1]), 1e-20f);
                    v1[0] *= fmaxf(bflo(g[2]), 1e-20f); v1[1] *= fmaxf(bfhi(g[2]), 1e-20f); v1[2] *= fmaxf(bflo(g[3]), 1e-20f); v1[3] *= fmaxf(bfhi(g[3]), 1e-20f);
                    *(u32x4*)(out + (size_t)row * DM + col) = pack8(v0, v1);
                }
            }
            asm volatile("" ::: "memory");
        }
    }
};
struct EpiResid {
    static constexpr bool KHOOK = false;
    const float* base_f; const bf16_t* base_b; bf16_t* xb; bf16_t* res; float* ssp;
    __device__ __forceinline__ void operator()(const f32x4 (&acc)[2][2][4][2], const Unit& u, int wr, int wc, int fr, int fq) const {
        asm volatile("" : "+v"(fr), "+v"(fq));
#pragma unroll
        for (int ai = 0; ai < 2; ++ai)
#pragma unroll
            for (int mp = 0; mp < 2; ++mp) {
                f32x4 b0[2][2], b1[2][2];
                if (base_f) {
#pragma unroll
                    for (int mm = 0; mm < 2; ++mm)
#pragma unroll
                        for (int bj = 0; bj < 2; ++bj) { const size_t off = (size_t)(u.pm * 256 + ai * 128 + wr * 64 + (2 * mp + mm) * 16 + fr) * DM + u.pn * 256 + bj * 128 + wc * 32 + 8 * fq;
                            b0[mm][bj] = *(const f32x4*)(base_f + off); b1[mm][bj] = *(const f32x4*)(base_f + off + 4); }
                    __builtin_amdgcn_sched_barrier(0);
                } else {
                    u32x4 w[2][2];
#pragma unroll
                    for (int mm = 0; mm < 2; ++mm)
#pragma unroll
                        for (int bj = 0; bj < 2; ++bj) w[mm][bj] = *(const u32x4*)(base_b + (size_t)(u.pm * 256 + ai * 128 + wr * 64 + (2 * mp + mm) * 16 + fr) * DM + u.pn * 256 + bj * 128 + wc * 32 + 8 * fq);
                    __builtin_amdgcn_sched_barrier(0);
#pragma unroll
                    for (int mm = 0; mm < 2; ++mm)
#pragma unroll
                        for (int bj = 0; bj < 2; ++bj) { const u32x4 x = w[mm][bj]; b0[mm][bj] = (f32x4){bflo(x[0]), bfhi(x[0]), bflo(x[1]), bfhi(x[1])}; b1[mm][bj] = (f32x4){bflo(x[2]), bfhi(x[2]), bflo(x[3]), bfhi(x[3])}; }
                }
#pragma unroll
                for (int mm = 0; mm < 2; ++mm) {
                    const int m = 2 * mp + mm, row = u.pm * 256 + ai * 128 + wr * 64 + m * 16 + fr;
                    float ss = 0.f;
#pragma unroll
                    for (int bj = 0; bj < 2; ++bj) {
                        const size_t off = (size_t)row * DM + u.pn * 256 + bj * 128 + wc * 32 + 8 * fq;
                        const f32x4 v0 = acc[ai][bj][m][0] + b0[mm][bj], v1 = acc[ai][bj][m][1] + b1[mm][bj];
                        const u32x4 pk = pack8(v0, v1);
                        *(u32x4*)(xb + off) = pk;
                        if (res) *(u32x4*)(res + off) = pk;
                        ss += (v0[0] * v0[0] + v0[1] * v0[1]) + (v0[2] * v0[2] + v0[3] * v0[3]) + (v1[0] * v1[0] + v1[1] * v1[1]) + (v1[2] * v1[2] + v1[3] * v1[3]);
                    }
                    ss += __shfl_xor(ss, 16); ss += __shfl_xor(ss, 32);
                    if (fq == 0) ssp[(size_t)row * 16 + u.pn * 4 + wc] = ss;
                }
                asm volatile("" ::: "memory");
            }
    }
};
struct EpiSwiGLU {
    static constexpr bool KHOOK = false;
    const float* ssp; bf16_t* H;
    __device__ __forceinline__ void operator()(const f32x4 (&acc)[2][2][4][2], const Unit& u, int wr, int wc, int fr, int fq) const {
        asm volatile("" : "+v"(fr), "+v"(fq));
        float rs[2][4];
#pragma unroll
        for (int ai = 0; ai < 2; ++ai) { f32x4 ra[4];
#pragma unroll
            for (int m = 0; m < 4; ++m) ra[m] = *((const f32x4*)(ssp + (size_t)(u.pm * 256 + ai * 128 + wr * 64 + m * 16 + fr) * 16) + fq);
            __builtin_amdgcn_sched_barrier(0);
#pragma unroll
            for (int m = 0; m < 4; ++m) { float ss = (ra[m][0] + ra[m][1]) + (ra[m][2] + ra[m][3]); ss += __shfl_xor(ss, 16); ss += __shfl_xor(ss, 32); rs[ai][m] = 1.0f / sqrtf(ss * (1.0f / DM) + RMS_EPS); } }
#pragma unroll
        for (int ai = 0; ai < 2; ++ai)
#pragma unroll
            for (int m = 0; m < 4; ++m) {
                const int row = u.pm * 256 + ai * 128 + wr * 64 + m * 16 + fr;
                const float rstd = rs[ai][m];
                f32x4 o[2];
#pragma unroll
                for (int n = 0; n < 2; ++n)
#pragma unroll
                    for (int e = 0; e < 4; ++e) { const float gt = acc[ai][0][m][n][e] * rstd, up = acc[ai][1][m][n][e] * rstd; o[n][e] = gt * sigmoidf_(gt) * up; }
                *(u32x4*)(H + (size_t)row * DFF + u.pn * 128 + wc * 32 + 8 * fq) = pack8(o[0], o[1]);
                asm volatile("" ::: "memory");
            }
    }
};
namespace att {
constexpr int KCS = 1040, KSLOT = 8 * KCS, VSLOT = 8192;
constexpr int L_K0 = 0, L_V0 = 4 * KSLOT, L_WSF = 4 * KSLOT + 4 * VSLOT, L_MSK = L_WSF + 8 * 256, L_UNI = L_MSK + 1024, L_LIST = L_UNI + 64, L_END = L_LIST + 512,
              L_PS = L_END + 64, L_OT = L_PS, L_TOTAL = L_OT + 8 * 8192;
static_assert(L_TOTAL <= 147456 - 64, "attention LDS map");
#define LBAR() asm volatile("s_waitcnt lgkmcnt(0)\n\ts_barrier" ::: "memory")
#define LWAIT() asm volatile("s_waitcnt lgkmcnt(0)" ::: "memory")
__device__ __forceinline__ int crow(int r, int hi) { return (r & 3) + 8 * (r >> 2) + 4 * hi; }
__device__ __forceinline__ float swap_other(float v, int hi) { auto rr = __builtin_amdgcn_permlane32_swap(__float_as_uint(v), __float_as_uint(v), false, false); return __uint_as_float(hi ? rr[0] : rr[1]); }
__device__ __forceinline__ void qkt(f32x16& p0, f32x16& p1, const LAS char* Ks, const bf16x8* qr, const f32x16& cinit, int r32, int hi) {
    const LAS char* kb = Ks + hi * KCS + r32 * 16;
    bf16x8 kf[8];
#pragma unroll
    for (int d0 = 0; d0 < 4; ++d0) { kf[2 * d0] = *(const LAS bf16x8*)(kb + d0 * 2 * KCS); kf[2 * d0 + 1] = *(const LAS bf16x8*)(kb + d0 * 2 * KCS + 512); }
    __builtin_amdgcn_sched_barrier(0);
    p0 = __builtin_amdgcn_mfma_f32_32x32x16_bf16(kf[0], qr[0], cinit, 0, 0, 0); p1 = __builtin_amdgcn_mfma_f32_32x32x16_bf16(kf[1], qr[0], cinit, 0, 0, 0);
#pragma unroll
    for (int d0 = 1; d0 < 4; ++d0) { p0 = __builtin_amdgcn_mfma_f32_32x32x16_bf16(kf[2 * d0], qr[d0], p0, 0, 0, 0); p1 = __builtin_amdgcn_mfma_f32_32x32x16_bf16(kf[2 * d0 + 1], qr[d0], p1, 0, 0, 0); }
}
struct VFrag { s16x4 lo[8], hi[8]; };
typedef short v4i16_t __attribute__((ext_vector_type(4)));
__device__ __forceinline__ s16x4 vtr(const LAS char* p) { return __builtin_bit_cast(s16x4, __builtin_amdgcn_ds_read_tr16_b64_v4i16((LAS v4i16_t*)p)); }
__device__ __forceinline__ void v_issue(VFrag& F, const LAS char* vp) {
#pragma unroll
    for (int d0 = 0; d0 < 2; ++d0)
#pragma unroll
        for (int ks = 0; ks < 4; ++ks) { F.lo[d0 * 4 + ks] = vtr(vp + d0 * 4096 + ks * 1024); F.hi[d0 * 4 + ks] = vtr(vp + d0 * 4096 + ks * 1024 + 512); }
}
template <bool SUM> __device__ __forceinline__ void pv(f32x16* o, f32x16& osum, VFrag& F, bf16x8 pa0, bf16x8 pa1, bf16x8 pa2, bf16x8 pa3) {
#define PK(k) (bf16x8){F.lo[k][0], F.lo[k][1], F.lo[k][2], F.lo[k][3], F.hi[k][0], F.hi[k][1], F.hi[k][2], F.hi[k][3]}
    const bf16x8 ones = {0x3F80, 0x3F80, 0x3F80, 0x3F80, 0x3F80, 0x3F80, 0x3F80, 0x3F80};
    __builtin_amdgcn_s_setprio(1);
    o[0] = __builtin_amdgcn_mfma_f32_32x32x16_bf16(pa0, PK(0), o[0], 0, 0, 0);
    o[1] = __builtin_amdgcn_mfma_f32_32x32x16_bf16(pa0, PK(4), o[1], 0, 0, 0);
    if (SUM) osum = __builtin_amdgcn_mfma_f32_32x32x16_bf16(pa0, ones, osum, 0, 0, 0);
    o[0] = __builtin_amdgcn_mfma_f32_32x32x16_bf16(pa1, PK(1), o[0], 0, 0, 0);
    o[1] = __builtin_amdgcn_mfma_f32_32x32x16_bf16(pa1, PK(5), o[1], 0, 0, 0);
    if (SUM) osum = __builtin_amdgcn_mfma_f32_32x32x16_bf16(pa1, ones, osum, 0, 0, 0);
    o[0] = __builtin_amdgcn_mfma_f32_32x32x16_bf16(pa2, PK(2), o[0], 0, 0, 0);
    o[1] = __builtin_amdgcn_mfma_f32_32x32x16_bf16(pa2, PK(6), o[1], 0, 0, 0);
    if (SUM) osum = __builtin_amdgcn_mfma_f32_32x32x16_bf16(pa2, ones, osum, 0, 0, 0);
    o[0] = __builtin_amdgcn_mfma_f32_32x32x16_bf16(pa3, PK(3), o[0], 0, 0, 0);
    o[1] = __builtin_amdgcn_mfma_f32_32x32x16_bf16(pa3, PK(7), o[1], 0, 0, 0);
    if (SUM) osum = __builtin_amdgcn_mfma_f32_32x32x16_bf16(pa3, ones, osum, 0, 0, 0);
    __builtin_amdgcn_s_setprio(0);
#undef PK
}
__device__ __forceinline__ float rowmax(const f32x16& p0, const f32x16& p1, int hi) {
    float a = __builtin_fmaxf(p0[0], p1[0]);
#pragma unroll
    for (int r = 1; r < 16; ++r) a = __builtin_fmaxf(__builtin_fmaxf(a, p0[r]), p1[r]);
    return __builtin_fmaxf(a, swap_other(a, hi));
}
struct KVRegs { u32x4 k, v; };
__device__ __forceinline__ void tile_load(KVRegs& R, const bf16_t* K, const bf16_t* V, int tid) { R.k = *(const u32x4*)(K + tid * 8); R.v = *(const u32x4*)(V + tid * 8); }
__device__ __forceinline__ void tile_store(const KVRegs& R, LAS char* Ks, LAS char* Vs, int tid) {
    const int row = tid >> 3, c = tid & 7;
    *(LAS u32x4*)(Ks + c * KCS + row * 16) = R.k;
    *(LAS u32x4*)(Vs + (c >> 2) * 4096 + (row >> 4) * 1024 + (row & 15) * 64 + (c & 3) * 16) = R.v;
}
__device__ __forceinline__ void ps_accum(const f32x16 p, int jb, LAS float* ps_row, bool writer) {
#pragma unroll
    for (int rg = 0; rg < 4; ++rg) {
        float a = 2.f * (p[4 * rg] + p[4 * rg + 1] + p[4 * rg + 2]) + p[4 * rg + 3], bq = p[4 * rg + 3];
        a += __shfl_xor(a, 1); a += __shfl_xor(a, 2); bq += __shfl_xor(bq, 1); bq += __shfl_xor(bq, 2);
        const int j = jb + 2 * rg;
        if (writer) { __hip_atomic_fetch_add(ps_row + j, a, __ATOMIC_RELAXED, __HIP_MEMORY_SCOPE_WORKGROUP); if (j + 1 < 128) __hip_atomic_fetch_add(ps_row + j + 1, bq, __ATOMIC_RELAXED, __HIP_MEMORY_SCOPE_WORKGROUP); }
    }
}
struct Ctx { LAS char* lds; LAS float* wsf; LAS float* otl; int tid, wid, lane, r32, hi, vbl; };
struct RowSt { float m, l; bool started; f32x16 negm, osum; };
__device__ __forceinline__ void rowst_init(RowSt& S) { S.m = 0.f; S.l = 0.f; S.started = false; S.negm = f32x16{}; S.osum = f32x16{}; asm volatile("" : "+v"(S.negm)); }
__device__ __forceinline__ void rowst_fixed(RowSt& S, float ref) { S.m = ref; S.l = 0.f; S.started = true; S.osum = f32x16{};
#pragma unroll
    for (int r = 0; r < 16; ++r) S.negm[r] = -ref;
    asm volatile("" : "+v"(S.negm)); }
template <int MODE, class Idx, class Src, class Msk>
__device__ __forceinline__ void run_branch(const Ctx& C, int nt, const Idx& idx, const Src& src, const Msk& msk, const bf16x8* qr, RowSt& S, f32x16* o, LAS float* ps_row, bool ps_writer, KVRegs& R0, bool pre, const bf16_t* nk, const bf16_t* nv) {
    KVRegs R1; const bf16_t *kp, *vp;
    int dA = idx(0), dB = nt > 1 ? idx(1) : 0, dC = 0, dD = 0;
    if (!pre) { src(0, dA, kp, vp); tile_load(R0, kp, vp, C.tid); }
    if (nt > 1) { src(1, dB, kp, vp); tile_load(R1, kp, vp, C.tid); }
    auto compute = [&](int it, const LAS char* Ks, const LAS char* Vs, int klo, int khi, bool nm) {
        const bool kill = khi < klo;
        if (!__any(!kill)) return;
        f32x16 p0, p1; qkt(p0, p1, Ks, qr, S.negm, C.r32, C.hi);
        VFrag VF; if constexpr (MODE != 0) { v_issue(VF, Vs + C.vbl); __builtin_amdgcn_sched_barrier(0); }
        if (__any(nm && !kill)) {
#pragma unroll
            for (int r = 0; r < 16; ++r) { const int kv = crow(r, C.hi); if (kv < klo || kv > khi) p0[r] = -INFINITY; if (kv + 32 < klo || kv + 32 > khi) p1[r] = -INFINITY; }
        }
        if constexpr (MODE != 2) {
            float rm = rowmax(p0, p1, C.hi); if (kill) rm = -INFINITY;
            const bool first = !S.started && rm > -INFINITY, grow = first || rm > 8.0f;
            if (__any(grow)) {
                const float d = grow ? rm : 0.f, alpha = first ? 1.0f : __builtin_amdgcn_exp2f(-d);
                S.m += d; S.started = S.started || first;
#pragma unroll
                for (int r = 0; r < 16; ++r) { S.negm[r] = -S.m; p0[r] -= d; p1[r] -= d; }
                if constexpr (MODE == 0) S.l *= alpha;
                if constexpr (MODE == 1) {
                    if (C.hi == 0) C.wsf[C.r32] = alpha;
                    LWAIT();
#pragma unroll
                    for (int r = 0; r < 16; ++r) { const float f = C.wsf[crow(r, C.hi)]; o[0][r] *= f; o[1][r] *= f; S.osum[r] *= f; }
                    LWAIT();
                }
            }
        }
#pragma unroll
        for (int r = 0; r < 16; ++r) { p0[r] = __builtin_amdgcn_exp2f(p0[r]); p1[r] = __builtin_amdgcn_exp2f(p1[r]); }
        if constexpr (MODE == 0) {
            float s = 0.f;
#pragma unroll
            for (int r = 0; r < 16; ++r) s += p0[r] + p1[r];
            S.l += kill ? 0.f : s;
        }
        if constexpr (MODE == 2) {
            if (__any(kill)) {
#pragma unroll
                for (int r = 0; r < 16; ++r) { p0[r] = kill ? 0.f : p0[r]; p1[r] = kill ? 0.f : p1[r]; }
            }
            ps_accum(p0, 16 * it + C.hi, ps_row, ps_writer); ps_accum(p1, 16 * it + 8 + C.hi, ps_row, ps_writer);
        }
        if constexpr (MODE != 0) {
            u32x4 w0 = {cvtpk(p0[0], p0[1]), cvtpk(p0[2], p0[3]), cvtpk(p0[4], p0[5]), cvtpk(p0[6], p0[7])}, w1 = {cvtpk(p0[8], p0[9]), cvtpk(p0[10], p0[11]), cvtpk(p0[12], p0[13]), cvtpk(p0[14], p0[15])};
            u32x4 w2 = {cvtpk(p1[0], p1[1]), cvtpk(p1[2], p1[3]), cvtpk(p1[4], p1[5]), cvtpk(p1[6], p1[7])}, w3 = {cvtpk(p1[8], p1[9]), cvtpk(p1[10], p1[11]), cvtpk(p1[12], p1[13]), cvtpk(p1[14], p1[15])};
            if constexpr (MODE == 1) {
                if (__any(kill)) {
#pragma unroll
                    for (int e = 0; e < 4; ++e) { w0[e] = kill ? 0u : w0[e]; w1[e] = kill ? 0u : w1[e]; w2[e] = kill ? 0u : w2[e]; w3[e] = kill ? 0u : w3[e]; }
                }
            }
            pv<MODE == 1>(o, S.osum, VF, __builtin_bit_cast(bf16x8, w0), __builtin_bit_cast(bf16x8, w1), __builtin_bit_cast(bf16x8, w2), __builtin_bit_cast(bf16x8, w3));
        }
    };
    LBAR();
    for (int it = 0; it < nt; it += 2) {
        const int p = (it >> 1) & 1; const bool two = it + 1 < nt;
        LAS char* KsA = C.lds + L_K0 + (2 * p) * KSLOT; LAS char* VsA = C.lds + L_V0 + (2 * p) * VSLOT;
        LAS char* KsB = KsA + KSLOT; LAS char* VsB = VsA + VSLOT;
        tile_store(R0, KsA, VsA, C.tid); if (two) tile_store(R1, KsB, VsB, C.tid);
        if (it + 2 < nt) dC = idx(it + 2);
        if (it + 3 < nt) dD = idx(it + 3);
        int kloA, khiA, kloB = 0, khiB = -1; const bool nmA = msk(it, dA, kloA, khiA); bool nmB = false; if (two) nmB = msk(it + 1, dB, kloB, khiB);
        if (it + 2 < nt) { src(it + 2, dC, kp, vp); tile_load(R0, kp, vp, C.tid); } else if (nk) tile_load(R0, nk, nv, C.tid);
        if (it + 3 < nt) { src(it + 3, dD, kp, vp); tile_load(R1, kp, vp, C.tid); }
        LBAR();
        compute(it, KsA, VsA, kloA, khiA, nmA);
        if (two) compute(it + 1, KsB, VsB, kloB, khiB, nmB);
        dA = dC; dB = dD;
    }
}
template <bool FIRST> __device__ __forceinline__ void merge_branch_n(const Ctx& C, const f32x16* o, const f32x16& osum, float gate) {
    if (C.hi == 0) C.wsf[C.r32] = gate;
    LWAIT();
#pragma unroll
    for (int r = 0; r < 16; ++r) { const float den = osum[r], f = den > 0.f ? C.wsf[crow(r, C.hi)] * __builtin_amdgcn_rcpf(den) : 0.f;
        if (FIRST) { C.otl[r * 64] = o[0][r] * f; C.otl[(16 + r) * 64] = o[1][r] * f; }
        else { C.otl[r * 64] += o[0][r] * f; C.otl[(16 + r) * 64] += o[1][r] * f; } }
    LWAIT();
}
template <bool FIRST> __device__ __forceinline__ void merge_branch(const Ctx& C, const f32x16* o, float factor) {
    if (C.hi == 0) C.wsf[C.r32] = factor;
    LWAIT();
#pragma unroll
    for (int r = 0; r < 16; ++r) { const float f = C.wsf[crow(r, C.hi)];
        if (FIRST) { C.otl[r * 64] = o[0][r] * f; C.otl[(16 + r) * 64] = o[1][r] * f; }
        else { C.otl[r * 64] += o[0][r] * f; C.otl[(16 + r) * 64] += o[1][r] * f; } }
    LWAIT();
}
struct Bufs { const bf16_t *Qn, *KV, *Mo, *KC, *KM, *Gn; bf16_t* Abr; };
constexpr size_t KV_STRIDE = (size_t)MTOK * 128, MO_STRIDE = (size_t)MTOK * 256;

__device__ __forceinline__ void nsa_item(const Ctx& C, const Bufs& B, int b, int g, int i) {
    const int r32 = C.r32, hi = C.hi, wid = C.wid;
    const int qi = 8 * wid + (r32 >> 2), hh = r32 & 3, head = g * 4 + hh, t = 64 * i + qi, cur = i;
    const size_t bg = (size_t)(b * 2 + g) * SEQ;
    bf16x8 qr[4];
    { const bf16_t* qp = B.Qn + ((size_t)(b * 8 + head) * SEQ + t) * 64 + hi * 8;
#pragma unroll
      for (int d0 = 0; d0 < 4; ++d0) qr[d0] = *(const bf16x8*)(qp + d0 * 16); }
    const unsigned gw = *(const unsigned*)(B.Gn + ((size_t)b * SEQ + t) * 32 + head * 3 - (head & 1));
    const unsigned gw2 = *(const unsigned*)(B.Gn + ((size_t)b * SEQ + t) * 32 + head * 3 - (head & 1) + 2);
    float g0, g1, g2; if (head & 1) { g0 = bfhi(gw); g1 = bflo(gw2); g2 = bfhi(gw2); } else { g0 = bflo(gw); g1 = bfhi(gw); g2 = bflo(gw2); }
    f32x16 o[2];
    LAS float* Ps = (LAS float*)(C.lds + L_PS); LAS unsigned* Mk = (LAS unsigned*)(C.lds + L_MSK); LAS unsigned* Uni = (LAS unsigned*)(C.lds + L_UNI); LAS int* List = (LAS int*)(C.lds + L_LIST);
    const int nv = t >= 31 ? ((t - 31) >> 4) + 1 : 0;
    const int nvt = (4 * i + 3 < 511) ? 4 * i + 3 : 511, ntc = (nvt + 63) >> 6;
    const bf16_t* kc = B.KC + (size_t)(0 * 4 + b * 2 + g) * 512 * 64; const bf16_t* vc = B.KC + (size_t)(1 * 4 + b * 2 + g) * 512 * 64;
    auto idxI = [&](int it) { return it; };
    auto srcC = [&](int it, int, const bf16_t*& kp, const bf16_t*& vp) { kp = kc + (size_t)it * 4096; vp = vc + (size_t)it * 4096; };
    auto mskC = [&](int it, int, int& klo, int& khi) { klo = 0; khi = nv - 1 - 64 * it; return khi < 63; };
    RowSt S; rowst_init(S);
    KVRegs R;
    run_branch<0>(C, ntc, idxI, srcC, mskC, qr, S, o, nullptr, false, R, false, kc, vc);
    const float lt = S.l + swap_other(S.l, hi);
    rowst_fixed(S, lt > 0.f ? S.m + __builtin_amdgcn_logf(lt) : 0.f);
    for (int e = C.tid; e < 64 * 128; e += 512) Ps[e] = 0.f;
    if (C.tid < 8) Uni[C.tid] = 0u;
    o[0] = f32x16{}; o[1] = f32x16{};
    run_branch<2>(C, ntc, idxI, srcC, mskC, qr, S, o, Ps + qi * 128, hh == 0, R, true, B.KV + 2 * KV_STRIDE + bg * 64, B.KV + 3 * KV_STRIDE + bg * 64);
    LBAR();
    {
        const int nf = cur == 0 ? 1 : (cur == 1 ? 2 : 3), kp_ = 16 - nf, lane = C.lane;
#pragma unroll 1
        for (int qq = 0; qq < 8; ++qq) {
            int q = 8 * wid + qq; asm volatile("" : "+s"(q)); LAS float* ps = Ps + q * 128;
            const int j0 = lane, j1 = lane + 64;
            const bool f0 = (j0 == 0 || j0 == cur || j0 == cur - 1) && j0 <= cur, f1 = (j1 == cur || j1 == cur - 1) && j1 <= cur;
            const bool va0 = j0 <= cur && !f0, va1 = j1 <= cur && !f1;
            const unsigned k0 = va0 ? __float_as_uint(ps[j0]) + 1u : 0u, k1 = va1 ? __float_as_uint(ps[j1]) + 1u : 0u;
            unsigned T = 0u;
            for (int bit = 30; bit >= 0; --bit) { const unsigned cand = T | (1u << bit); const int cnt = __popcll(__ballot(k0 >= cand)) + __popcll(__ballot(k1 >= cand)); if (cnt >= kp_) T = cand; }
            const int need = kp_ - (__popcll(__ballot(k0 > T)) + __popcll(__ballot(k1 > T)));
            const unsigned long long t0 = __ballot(k0 == T), t1 = __ballot(k1 == T), below = (1ull << lane) - 1ull;
            const int pre0 = __popcll(t0 & below), pre1 = __popcll(t0) + __popcll(t1 & below);
            const bool s0 = f0 || (k0 > 0u && (k0 > T || (k0 == T && pre0 < need))), s1 = f1 || (k1 > 0u && (k1 > T || (k1 == T && pre1 < need)));
            const unsigned long long b0 = __ballot(s0), b1 = __ballot(s1);
            if (lane == 0) { Mk[q * 4 + 0] = (unsigned)b0; Mk[q * 4 + 1] = (unsigned)(b0 >> 32); Mk[q * 4 + 2] = (unsigned)b1; Mk[q * 4 + 3] = (unsigned)(b1 >> 32);
                __hip_atomic_fetch_or(&Uni[0], (unsigned)b0, __ATOMIC_RELAXED, __HIP_MEMORY_SCOPE_WORKGROUP); __hip_atomic_fetch_or(&Uni[1], (unsigned)(b0 >> 32), __ATOMIC_RELAXED, __HIP_MEMORY_SCOPE_WORKGROUP); __hip_atomic_fetch_or(&Uni[2], (unsigned)b1, __ATOMIC_RELAXED, __HIP_MEMORY_SCOPE_WORKGROUP); __hip_atomic_fetch_or(&Uni[3], (unsigned)(b1 >> 32), __ATOMIC_RELAXED, __HIP_MEMORY_SCOPE_WORKGROUP); }
        }
    }
    LBAR();
    if (C.tid < 128) {
        const int wi = C.tid >> 5, bi = C.tid & 31; const unsigned u0 = Uni[0], u1 = Uni[1], u2 = Uni[2], u3 = Uni[3];
        const unsigned mine = wi == 0 ? u0 : wi == 1 ? u1 : wi == 2 ? u2 : u3;
        const int before = (wi > 0 ? __popc(u0) : 0) + (wi > 1 ? __popc(u1) : 0) + (wi > 2 ? __popc(u2) : 0) + __popc(mine & ((1u << bi) - 1u));
        if ((mine >> bi) & 1u) List[before] = C.tid;
        if (C.tid == 0) Uni[4] = (unsigned)(__popc(u0) + __popc(u1) + __popc(u2) + __popc(u3));
    }
    LBAR();
    merge_branch<true>(C, o, g0);
    {
        const int nsel = (int)Uni[4];
        const bf16_t* ks = B.KV + 2 * KV_STRIDE + bg * 64; const bf16_t* vs = B.KV + 3 * KV_STRIDE + bg * 64;
        auto idxS = [&](int it) { return List[it]; };
        auto srcS = [&](int, int j, const bf16_t*& kp, const bf16_t*& vp) { kp = ks + (size_t)j * 4096; vp = vs + (size_t)j * 4096; };
        auto mskS = [&](int, int j, int& klo, int& khi) { const unsigned w = Mk[qi * 4 + (j >> 5)]; const bool bit = (w >> (j & 31)) & 1u;
            klo = 0; khi = bit ? (j == cur ? qi : 63) : -1; return j == cur; };
        rowst_init(S); o[0] = f32x16{}; o[1] = f32x16{};
        const int tw0n = i >= 8 ? i - 8 : 0;
        run_branch<1>(C, nsel, idxS, srcS, mskS, qr, S, o, nullptr, false, R, true, B.KV + 4 * KV_STRIDE + bg * 64 + (size_t)tw0n * 4096, B.KV + 5 * KV_STRIDE + bg * 64 + (size_t)tw0n * 4096);
        merge_branch_n<false>(C, o, S.osum, g1);
    }
    {
        const int tw0 = i >= 8 ? i - 8 : 0, ntw = i - tw0 + 1;
        const bf16_t* kw = B.KV + 4 * KV_STRIDE + bg * 64; const bf16_t* vw = B.KV + 5 * KV_STRIDE + bg * 64;
        auto srcW = [&](int it, int, const bf16_t*& kp, const bf16_t*& vp) { kp = kw + (size_t)(tw0 + it) * 4096; vp = vw + (size_t)(tw0 + it) * 4096; };
        auto mskW = [&](int it, int, int& klo, int& khi) { const int tw = tw0 + it; klo = (t - 511) - 64 * tw; khi = (tw == i) ? qi : 63; return tw == i || klo > 0; };
        rowst_init(S); o[0] = f32x16{}; o[1] = f32x16{};
        run_branch<1>(C, ntw, idxI, srcW, mskW, qr, S, o, nullptr, false, R, true, nullptr, nullptr);
        merge_branch_n<false>(C, o, S.osum, g2);
    }
#pragma unroll
    for (int r = 0; r < 16; ++r) { const int qrow = crow(r, hi); bf16_t* dst = B.Abr + ((size_t)b * SEQ + 64 * i + 8 * wid + (qrow >> 2)) * DM + 256 + (g * 4 + (qrow & 3)) * 64 + r32;
        dst[0] = (bf16_t)(cvtpk(C.otl[r * 64], 0.f) & 0xffffu); dst[32] = (bf16_t)(cvtpk(C.otl[(16 + r) * 64], 0.f) & 0xffffu); }
}
__device__ __forceinline__ void moba_item(const Ctx& C, const Bufs& B, int b, int h, int qb) {
    const int r32 = C.r32, hi = C.hi, wid = C.wid, own = qb, t = 256 * qb + 32 * wid + r32;
    const size_t bh = (size_t)(b * 4 + h) * SEQ;
    bf16x8 qr[4];
    { const bf16_t* qp = B.Mo + (bh + t) * 64 + hi * 8;
#pragma unroll
      for (int d0 = 0; d0 < 4; ++d0) qr[d0] = *(const bf16x8*)(qp + d0 * 16); }
    LAS unsigned* Uni = (LAS unsigned*)(C.lds + L_UNI); LAS int* List = (LAS int*)(C.lds + L_LIST);
    LBAR();
    if (C.tid < 256) { const u32x4 kmv = *(const u32x4*)(B.KM + (size_t)(b * 4 + h) * 2048 + C.tid * 8); *(LAS u32x4*)(C.lds + L_K0 + (C.tid & 7) * KCS + (C.tid >> 3) * 16) = kmv; }
    if (C.tid == 0) Uni[0] = 0u;
    LBAR();
    unsigned sel = 0u;
    {
        f32x16 gs = f32x16{};
        const LAS char* kb = C.lds + L_K0 + hi * KCS + r32 * 16;
#pragma unroll
        for (int d0 = 0; d0 < 4; ++d0) gs = __builtin_amdgcn_mfma_f32_32x32x16_bf16(*(const LAS bf16x8*)(kb + d0 * 2 * KCS), qr[d0], gs, 0, 0, 0);
        float lo[16], hv[16];
#pragma unroll
        for (int r = 0; r < 16; ++r) { const float ownv = gs[r], oth = swap_other(ownv, hi); lo[r] = hi ? oth : ownv; hv[r] = hi ? ownv : oth; }
        unsigned taken = ~((1u << own) - 1u);
#pragma unroll
        for (int round = 0; round < 3; ++round) {
            float best = -INFINITY; int bi = 32;
#pragma unroll
            for (int n = 0; n < 32; ++n) { const int rr = (n & 3) + 4 * (n >> 3); const float v = ((n >> 2) & 1) ? hv[rr] : lo[rr]; if (!((taken >> n) & 1u) && v > best) { best = v; bi = n; } }
            if (bi < 32) { sel |= 1u << bi; taken |= 1u << bi; }
        }
    }
    { unsigned u = sel;
#pragma unroll
      for (int o_ = 1; o_ < 64; o_ <<= 1) u |= (unsigned)__shfl_xor((int)u, o_);
      if (C.lane == 0) __hip_atomic_fetch_or(&Uni[0], u, __ATOMIC_RELAXED, __HIP_MEMORY_SCOPE_WORKGROUP); }
    LBAR();
    if (C.tid == 0) { int n = 0; unsigned u = Uni[0]; while (u) { const int bpos = __builtin_ctz(u); u &= u - 1; List[n++] = bpos; } Uni[4] = (unsigned)n; }
    LBAR();
    const int nl = (int)Uni[4], nt = 4 * nl + 4;
    const bf16_t* kk = B.Mo + MO_STRIDE + bh * 64; const bf16_t* vv = B.Mo + 2 * MO_STRIDE + bh * 64;
    auto idxM = [&](int it) { return (it < 4 * nl) ? List[it >> 2] : own; };
    auto src = [&](int it, int blk, const bf16_t*& kp, const bf16_t*& vp) { const int T = 4 * blk + ((it < 4 * nl) ? (it & 3) : (it - 4 * nl)); kp = kk + (size_t)T * 4096; vp = vv + (size_t)T * 4096; };
    auto msk = [&](int it, int blk, int& klo, int& khi) { klo = 0; if (it < 4 * nl) { const bool bit = (sel >> blk) & 1u; khi = bit ? 63 : -1; return false; } khi = 32 * wid + r32 - 64 * (it - 4 * nl); return true; };
    RowSt S; rowst_init(S); f32x16 o[2] = {f32x16{}, f32x16{}};
    KVRegs R;
    run_branch<1>(C, nt, idxM, src, msk, qr, S, o, nullptr, false, R, false, nullptr, nullptr);
    merge_branch_n<true>(C, o, S.osum, 1.0f);
#pragma unroll
    for (int r = 0; r < 16; ++r) { const int qrow = crow(r, hi); bf16_t* dst = B.Abr + ((size_t)b * SEQ + 256 * qb + 32 * wid + qrow) * DM + 768 + h * 64 + r32;
        dst[0] = (bf16_t)(cvtpk(C.otl[r * 64], 0.f) & 0xffffu); dst[32] = (bf16_t)(cvtpk(C.otl[(16 + r) * 64], 0.f) & 0xffffu); }
}
}
#define XB_TMO      128
#define XB_XCNT(j)  (256  + 64 * (j))
#define XB_XSUB(j)  (1280 + 64 * (j))
#define XB_XGEN(j)  (2304 + 64 * (j))
#define XB_TOP      3328
#define XB_TOPGEN   3392
#define XCD_BAR_WORDS 3456
#define XB_SPIN_CAP (1u << 18)

__device__ __forceinline__ unsigned xb_ld(unsigned* p)              { return __hip_atomic_load(p, __ATOMIC_RELAXED, __HIP_MEMORY_SCOPE_AGENT); }
__device__ __forceinline__ unsigned xb_add(unsigned* p, unsigned v) { return __hip_atomic_fetch_add(p, v, __ATOMIC_RELAXED, __HIP_MEMORY_SCOPE_AGENT); }
__device__ __forceinline__ unsigned xb_xcc_id() { return (unsigned)__builtin_amdgcn_s_getreg((3 << 11) | 20) & 0xFu; }
#define XB_SPIN(cond, bar) do { unsigned _sp = 0; while (cond) { __builtin_amdgcn_s_sleep(1); \
    if ((++_sp & 255u) == 0u) { if (xb_ld(&(bar)[XB_TMO])) break; if (_sp > XB_SPIN_CAP) { atomicAdd(&(bar)[XB_TMO], 1u); break; } } } } while (0)

struct XcdBarrier {
    unsigned* bar; unsigned x;
    volatile LAS unsigned* st;
};

__device__ __forceinline__ XcdBarrier xcd_barrier_post(unsigned* bar, volatile LAS unsigned* st) {
    XcdBarrier b; b.bar = bar; b.x = xb_xcc_id(); b.st = st;
    if (threadIdx.x == 0) (void)xb_add(&bar[XB_XCNT(b.x)], 1u);
    return b;
}
__device__ __forceinline__ void xcd_barrier_complete(unsigned* bar, unsigned x, unsigned& nloc, unsigned& nx) {
    const unsigned G = gridDim.x * gridDim.y * gridDim.z;
    unsigned sum, cnt, mine, sp = 0u;
    for (;;) {
        sum = 0u; cnt = 0u; mine = 0u;
#pragma unroll
        for (unsigned j = 0; j < 16; ++j) { const unsigned c = xb_ld(&bar[XB_XCNT(j)]); sum += c; cnt += (c > 0u) ? 1u : 0u; mine = (j == x) ? c : mine; }
        if (sum == G) break;
        __builtin_amdgcn_s_sleep(1);
        if ((++sp & 255u) == 0u) { if (xb_ld(&bar[XB_TMO])) break; if (sp > XB_SPIN_CAP) { atomicAdd(&bar[XB_TMO], 1u); break; } }
    }
    nloc = mine > 0u ? mine : 1u; nx = cnt > 0u ? cnt : 1u;
}

__device__ __forceinline__ void xcd_barrier(const XcdBarrier& b) {
    asm volatile("s_waitcnt vmcnt(0)" ::: "memory");
    __syncthreads();
    if (threadIdx.x == 0) {
        unsigned* bar = b.bar;
        __builtin_amdgcn_s_waitcnt(0);
        unsigned nloc = b.st[0], nx = b.st[1];
        if (nloc == 0u) { xcd_barrier_complete(bar, b.x, nloc, nx); b.st[0] = nloc; b.st[1] = nx; }
        const unsigned old = xb_add(&bar[XB_XSUB(b.x)], 1u);
        const unsigned gen = old / nloc;
        if (old + 1u == (gen + 1u) * nloc) {
            __builtin_amdgcn_fence(__ATOMIC_RELEASE, "agent");
            asm volatile("s_waitcnt vmcnt(0)" ::: "memory");
            const unsigned og = xb_add(&bar[XB_TOP], 1u);
            const unsigned tg = og / nx;
            if (og + 1u == (tg + 1u) * nx) xb_add(&bar[XB_TOPGEN], 1u);
            else XB_SPIN(xb_ld(&bar[XB_TOPGEN]) == tg, bar);
            __builtin_amdgcn_fence(__ATOMIC_ACQUIRE, "agent");
            xb_add(&bar[XB_XGEN(b.x)], 1u);
            asm volatile("s_waitcnt vmcnt(0)" ::: "memory");
        } else {
            XB_SPIN(xb_ld(&bar[XB_XGEN(b.x)]) == gen, bar);
            __builtin_amdgcn_fence(__ATOMIC_ACQUIRE, "agent");
            asm volatile("s_waitcnt vmcnt(0)" ::: "memory");
        }
    }
    __syncthreads();
}

constexpr size_t MiB = 1u << 20;
constexpr size_t WS_CTL = 0, WS_ORDER = 4096, WS_BAR = 8192;
constexpr size_t WS_W = 1 * MiB, OFF_WIN = 0, OFF_WGU = 11 * MiB, OFF_WD = 22 * MiB, OFF_WBR = 28 * MiB, OFF_WOUT = 30 * MiB, OFF_W1 = 32 * MiB, OFF_W2 = 34 * MiB,
                 OFF_BIN = 34 * MiB + 65536, OFF_CB1 = OFF_BIN + 32768  , OFF_CB2 = OFF_CB1 + 65536;
constexpr size_t WS_TAB = 36 * MiB, WS_SSP = 38 * MiB, WS_KC = 39 * MiB, WS_KM = 39 * MiB + 512 * 1024, WS_GN = 40 * MiB, WS_XB = 42 * MiB, WS_BIG = 74 * MiB,
                 WS_U = 170 * MiB, WS_QN = 178 * MiB, WS_KV = 194 * MiB, WS_MO = 218 * MiB, WS_MRG = 178 * MiB, WS_END = 242 * MiB;
constexpr int LDS_BYTES = 147456;

__device__ __forceinline__ int dint(int pos) { return (pos >> 1) + 32 * (pos & 1); }
__device__ __forceinline__ int in_orig(int c) {
    if (c < 256) return c;
    if (c < 768) { const int c2 = c - 256; return 256 + (c2 >> 6) * 64 + dint(c2 & 63); }
    if (c < 1536) { const int c2 = c - 768, tt = c2 >> 8, bj = (c2 >> 7) & 1, g = (c2 >> 6) & 1, pos = c2 & 63; return 768 + (2 * tt + bj) * 128 + g * 64 + (bj == 0 ? dint(pos) : pos); }
    if (c < 2304) { const int c2 = c - 1536, part = c2 >> 8, h = (c2 >> 6) & 3, pos = c2 & 63; return 1560 + part * 256 + h * 64 + (part < 2 ? dint(pos) : pos); }
    if (c < 5376) return 2328 + (c - 2304);
    const int c2 = c - 5376; return c2 < 24 ? 1536 + c2 : -1;
}
template <class F> __device__ __forceinline__ void cvt_tile(LAS float* scr, int lane, int k0, int n0, bf16_t* dst, size_t pitch, F f) {
    float vals[32];
#pragma unroll
    for (int i = 0; i < 32; ++i) vals[i] = f(k0 + 2 * i + (lane >> 5), n0 + (lane & 31));
#pragma unroll
    for (int i = 0; i < 32; ++i) scr[(2 * i + (lane >> 5)) * 33 + (lane & 31)] = vals[i];
    asm volatile("s_waitcnt lgkmcnt(0)" ::: "memory");
    const int c = lane & 7;
#pragma unroll
    for (int j = 0; j < 4; ++j) { const int n = (lane >> 3) + 8 * j; const LAS float* s = scr + (8 * c) * 33 + n;
        u32x4 o; o.x = cvtpk(s[0 * 33], s[1 * 33]); o.y = cvtpk(s[2 * 33], s[3 * 33]); o.z = cvtpk(s[4 * 33], s[5 * 33]); o.w = cvtpk(s[6 * 33], s[7 * 33]);
        *(u32x4*)(dst + (size_t)(n0 + n) * pitch + k0 + 8 * c) = o; }
    asm volatile("s_waitcnt lgkmcnt(0)" ::: "memory");
}
template <class F> __device__ __forceinline__ void cvt_tile_scaled(LAS float* scr, int lane, int k0, int n0, bf16_t* dst, size_t pitch, F f, const float* scale, float keep) {
    float vals[32], sc[32];
#pragma unroll
    for (int i = 0; i < 32; ++i) { vals[i] = f(k0 + 2 * i + (lane >> 5), n0 + (lane & 31)); sc[i] = scale[k0 + 2 * i + (lane >> 5)]; }
    __builtin_amdgcn_sched_barrier(0);
#pragma unroll
    for (int i = 0; i < 32; ++i) scr[(2 * i + (lane >> 5)) * 33 + (lane & 31)] = vals[i] * (sc[i] * keep);
    asm volatile("s_waitcnt lgkmcnt(0)" ::: "memory");
    const int c = lane & 7;
#pragma unroll
    for (int j = 0; j < 4; ++j) { const int n = (lane >> 3) + 8 * j; const LAS float* s = scr + (8 * c) * 33 + n;
        u32x4 o; o.x = cvtpk(s[0 * 33], s[1 * 33]); o.y = cvtpk(s[2 * 33], s[3 * 33]); o.z = cvtpk(s[4 * 33], s[5 * 33]); o.w = cvtpk(s[6 * 33], s[7 * 33]);
        *(u32x4*)(dst + (size_t)(n0 + n) * pitch + k0 + 8 * c) = o; }
    asm volatile("s_waitcnt lgkmcnt(0)" ::: "memory");
}
struct Args { const float* in[20]; float* out; unsigned char* ws; };
typedef const __attribute__((address_space(4))) Args* ArgsP;

__device__ __forceinline__ void phase0(ArgsP a, int l, LAS unsigned char* lds, int tid, int lane, int wave, int gw, int NGW) {
    unsigned char* ws = a->ws;
    LAS float* scr = (LAS float*)(lds + wave * 8704);
    const float* attn_norm = a->in[1] + (size_t)l * DM; const float* w_in = a->in[2] + (size_t)l * DM * IN_COLS; const float* b_in = a->in[3] + (size_t)l * IN_COLS;
    const float* pool_w = a->in[4] + (size_t)l * 4 * 64 * 64; const float* pool_scale = a->in[5] + (size_t)l * 256; const float* cmp_pos = a->in[6] + (size_t)l * 2 * 32 * 64;
    const float* cmp_w1 = a->in[7] + (size_t)l * 2 * 2048 * 256; const float* cmp_b1 = a->in[8] + (size_t)l * 2 * 256; const float* cmp_w2 = a->in[9] + (size_t)l * 2 * 256 * 64; const float* cmp_b2 = a->in[10] + (size_t)l * 2 * 64;
    const float* w_br_pool = a->in[11] + (size_t)l * 256 * DM; const float* w_br_nsa = a->in[12] + (size_t)l * 512 * DM; const float* w_br_moba = a->in[13] + (size_t)l * 256 * DM;
    const float* w_out = a->in[14] + (size_t)l * DM * DM; const float* ffn_norm = a->in[15] + (size_t)l * DM; const float* w_gate = a->in[16] + (size_t)l * DM * DFF; const float* w_up = a->in[17] + (size_t)l * DM * DFF;
    const float* w_down = a->in[18] + (size_t)l * DFF * DM;
    bf16_t* Win = (bf16_t*)(ws + WS_W + OFF_WIN); bf16_t* Wgu = (bf16_t*)(ws + WS_W + OFF_WGU); bf16_t* Wd = (bf16_t*)(ws + WS_W + OFF_WD); bf16_t* Wbr = (bf16_t*)(ws + WS_W + OFF_WBR);
    bf16_t* Wout = (bf16_t*)(ws + WS_W + OFF_WOUT); bf16_t* W1t = (bf16_t*)(ws + WS_W + OFF_W1); bf16_t* W2t = (bf16_t*)(ws + WS_W + OFF_W2);
    float* bin = (float*)(ws + WS_W + OFF_BIN); float* cb1 = (float*)(ws + WS_W + OFF_CB1); float* cb2 = (float*)(ws + WS_W + OFF_CB2);
    constexpr int I_A = 16 * 176, I_B = 16 * 176, I_C = 44 * 32, I_D = 16 * 32, I_E = 16 * 32, I_F = 2 * 32 * 8, I_G = 2 * 4 * 2;
    constexpr int NITEMS = I_A + I_B + I_C + I_D + I_E + I_F + I_G;
    for (int it = gw; it < NITEMS; it += NGW) {
        int r = it;
        if (r < I_A) { const int kb = r / 176, nb = r % 176; { const int o = in_orig(32 * nb + (lane & 31)); const float* wc = w_in + (o >= 0 ? o : 0); const float keep = o >= 0 ? 1.f : 0.f;
            cvt_tile_scaled(scr, lane, 64 * kb, 32 * nb, Win, DM, [&](int k, int) { return wc[(size_t)k * IN_COLS]; }, attn_norm, keep); } continue; } r -= I_A;
        if (r < I_B) { const int kb = r / 176, nb = r % 176; { const int n = 32 * nb + (lane & 31), j = (n >> 8) * 128 + (n & 127); const float* wc = (((n >> 7) & 1) ? w_up : w_gate) + j;
            cvt_tile_scaled(scr, lane, 64 * kb, 32 * nb, Wgu, DM, [&](int k, int) { return wc[(size_t)k * DFF]; }, ffn_norm, 1.f); } continue; } r -= I_B;
        if (r < I_C) { const int kb = r / 32, nb = r % 32; cvt_tile(scr, lane, 64 * kb, 32 * nb, Wd, DFF, [&](int k, int n) { return w_down[(size_t)k * DM + n]; }); continue; } r -= I_C;
        if (r < I_D) { const int kb = r / 32, nb = r % 32; cvt_tile(scr, lane, 64 * kb, 32 * nb, Wout, DM, [&](int k, int n) { return w_out[(size_t)k * DM + n]; }); continue; } r -= I_D;
        if (r < I_E) { const int kb = r / 32, nb = r % 32;
            if (kb < 4) { }
            else if (kb < 12) cvt_tile(scr, lane, 64 * kb, 32 * nb, Wbr, DM, [&](int k, int n) { return w_br_nsa[(size_t)(k - 256) * DM + n]; });
            else cvt_tile(scr, lane, 64 * kb, 32 * nb, Wbr, DM, [&](int k, int n) { return w_br_moba[(size_t)(k - 768) * DM + n]; });
            continue; } r -= I_E;
        if (r < I_F) { const int kv = r >> 8, kb = (r >> 3) & 31, nb = r & 7; const float* w1 = cmp_w1 + (size_t)kv * 2048 * 256;
            cvt_tile(scr, lane, 64 * kb, 32 * nb, W1t + (size_t)kv * 256 * 2048, 2048, [&](int k, int n) { const int pos = k & 63, d = kv == 0 ? dint(pos) : pos; return w1[(size_t)((k & ~63) + d) * 256 + n]; }); continue; } r -= I_F;
        { const int kv = r >> 3, kb = (r >> 1) & 3, nb = r & 1; const float* w2 = cmp_w2 + (size_t)kv * 256 * 64;
            cvt_tile(scr, lane, 64 * kb, 32 * nb, W2t + (size_t)kv * 64 * 256, 256, [&](int k, int n) { return w2[(size_t)k * 64 + (kv == 0 ? dint(n) : n)]; }); }
    }
    const int gt = gw * 64 + lane, NGT = NGW * 64;
    for (int c = gt; c < NIN; c += NGT) { const int o = in_orig(c); bin[c] = o >= 0 ? b_in[o] : 0.f; }
    for (int idx = gt; idx < 32 * 512; idx += NGT) { const int c = idx >> 9, e = idx & 511, kv = e >> 8, n = e & 255; const float* w1 = cmp_w1 + (size_t)kv * 2048 * 256 + (size_t)(64 * c) * 256 + n; const float* pe = cmp_pos + (size_t)kv * 2048 + 64 * c;
        float s = c == 0 ? cmp_b1[kv * 256 + n] : 0.f;
#pragma unroll
        for (int k0 = 0; k0 < 64; k0 += 32) { float av[32], bv[32];
#pragma unroll
            for (int k = 0; k < 32; ++k) { av[k] = pe[k0 + k]; bv[k] = w1[(size_t)(k0 + k) * 256]; }
            __builtin_amdgcn_sched_barrier(0);
#pragma unroll
            for (int k = 0; k < 32; ++k) s += av[k] * bv[k]; }
        cb1[idx] = s; }
    for (int idx = gt; idx < 256 * DM; idx += NGT) { const int k = idx >> 10, n = idx & 1023, g64 = k & ~63; float s = 0.f;
        const f32x4* pw4 = (const f32x4*)(pool_w + (size_t)k * 64); const f32x4* ps4 = (const f32x4*)(pool_scale + g64);
#pragma unroll
        for (int j0 = 0; j0 < 64; j0 += 32) { f32x4 pw[8], psc[8]; float wb[32];
#pragma unroll
            for (int q = 0; q < 8; ++q) { pw[q] = pw4[j0 / 4 + q]; psc[q] = ps4[j0 / 4 + q]; }
#pragma unroll
            for (int j = 0; j < 32; ++j) wb[j] = w_br_pool[(size_t)(g64 + j0 + j) * DM + n];
            __builtin_amdgcn_sched_barrier(0);
#pragma unroll
            for (int j = 0; j < 32; ++j) s += pw[j >> 2][j & 3] * psc[j >> 2][j & 3] * wb[j]; }
        Wbr[(size_t)n * DM + k] = (bf16_t)(cvtpk(s, 0.f) & 0xffffu); }
    for (int e = gt; e < 128; e += NGT) { const int kv = e >> 6, n = e & 63; cb2[e] = cmp_b2[kv * 64 + (kv == 0 ? dint(n) : n)]; }
    if (l == 0) {
        float* tab = (float*)(ws + WS_TAB);
        for (int e = gt; e < SEQ * 32; e += NGT) { const int t = e >> 5, f = e & 31; const float inv = powf(10000.0f, -(float)(2 * f) / 64.0f); const float ang = (float)t * inv;
            const double ad = (double)ang, kq = rint(ad * 0.15915494309189535); double rr = fma(-kq, 6.283185307179586, ad); rr = fma(-kq, 2.4492935982947064e-16, rr);
            const float rf = (float)rr; tab[2 * e] = __cosf(rf); tab[2 * e + 1] = __sinf(rf); }
        const float* x = a->in[0]; bf16_t* xb = (bf16_t*)(ws + WS_XB); float* ssp = (float*)(ws + WS_SSP);
        for (int m0 = 2 * gw; m0 < MTOK; m0 += 2 * NGW) { f32x4 v[2][4]; float s[2] = {0.f, 0.f};
#pragma unroll
            for (int q = 0; q < 2; ++q) { const f32x4* xr = (const f32x4*)(x + (size_t)(m0 + q) * DM) + lane;
#pragma unroll
                for (int j = 0; j < 4; ++j) v[q][j] = xr[64 * j]; }
#pragma unroll
            for (int q = 0; q < 2; ++q) {
#pragma unroll
                for (int j = 0; j < 4; ++j) s[q] += (v[q][j][0] * v[q][j][0] + v[q][j][1] * v[q][j][1]) + (v[q][j][2] * v[q][j][2] + v[q][j][3] * v[q][j][3]);
#pragma unroll
                for (int o = 1; o < 64; o <<= 1) s[q] += __shfl_xor(s[q], o);
                u32x2* o8 = (u32x2*)(xb + (size_t)(m0 + q) * DM) + lane;
#pragma unroll
                for (int j = 0; j < 4; ++j) o8[64 * j] = (u32x2){cvtpk(v[q][j][0], v[q][j][1]), cvtpk(v[q][j][2], v[q][j][3])};
                if (lane < 16) ssp[(size_t)(m0 + q) * 16 + lane] = lane == 0 ? s[q] : 0.f; } }
        int* order = (int*)(ws + WS_ORDER);
        auto cost = [](int id) { if (id < 512) { const int i = id & 127; return 10 * ((i + 1) + ((i < 8 ? i : 8) + 1) + 10) + 16 * ((4 * i + 3 + 63) >> 6); } const int qb = (id - 512) & 31; return 7 * (4 * qb + 3) + 50; };
        for (int id = gw; id < 768; id += NGW) { const int mc = cost(id); int rk = 0;
            for (int j = lane; j < 768; j += 64) { const int cj = cost(j); rk += (cj > mc || (cj == mc && j < id)) ? 1 : 0; }
#pragma unroll
            for (int o = 1; o < 64; o <<= 1) rk += __shfl_xor(rk, o);
            if (lane == 0) order[rk] = id; }
    }
}
__device__ __forceinline__ float gelu_tanh(float x) { const float u = 0.7978845608028654f * (x + 0.044715f * x * x * x); const float th = 1.f - 2.f * __builtin_amdgcn_rcpf(1.f + __expf(2.f * u)); return 0.5f * x * (1.f + th); }
__device__ __forceinline__ void phase2(ArgsP a, LAS unsigned char* lds, int tid, int lane, int wave, int G) {
    unsigned char* ws = a->ws;
    const bf16_t* KV = (const bf16_t*)(ws + WS_KV); const bf16_t* W1t = (const bf16_t*)(ws + WS_W + OFF_W1); const bf16_t* W2t = (const bf16_t*)(ws + WS_W + OFF_W2);
    const float* cb1 = (const float*)(ws + WS_W + OFF_CB1); const float* cb2 = (const float*)(ws + WS_W + OFF_CB2);
    bf16_t* KC = (bf16_t*)(ws + WS_KC);
    LAS bf16_t* hid = (LAS bf16_t*)lds;
    const int arow = lane & 15, kq = lane >> 4;
    for (int task = blockIdx.x; task < 256; task += G) {
        const int kv = task >> 7, bgi = (task >> 5) & 3, nt = task & 31;
        const bf16_t* src = KV + (size_t)kv * att::KV_STRIDE + (size_t)bgi * SEQ * 64;
        const int nrow = 16 * nt + arow, neff = nrow < 510 ? nrow : 510;
        const bf16_t* ap = src + (size_t)neff * 1024 + kq * 8;
        const bf16_t* bp0 = W1t + (size_t)kv * 256 * 2048 + (size_t)(32 * wave + arow) * 2048 + kq * 8; const bf16_t* bp1 = bp0 + 16 * 2048;
        f32x4 c0 = {0.f, 0.f, 0.f, 0.f}, c1 = {0.f, 0.f, 0.f, 0.f};
        float bb0 = 0.f, bb1 = 0.f;
        { const int col0 = 32 * wave + arow; float t0[32], t1[32];
#pragma unroll
          for (int c = 0; c < 32; ++c) { t0[c] = cb1[c * 512 + kv * 256 + col0]; t1[c] = cb1[c * 512 + kv * 256 + col0 + 16]; }
          __builtin_amdgcn_sched_barrier(0);
#pragma unroll
          for (int c = 0; c < 32; ++c) { bb0 += t0[c]; bb1 += t1[c]; } }
#pragma unroll 1
        for (int ks0 = 0; ks0 < 64; ks0 += 8) { bf16x8 av[8], b0[8], b1[8];
#pragma unroll
            for (int q = 0; q < 8; ++q) { av[q] = *(const bf16x8*)(ap + (ks0 + q) * 32); b0[q] = *(const bf16x8*)(bp0 + (ks0 + q) * 32); b1[q] = *(const bf16x8*)(bp1 + (ks0 + q) * 32); }
            __builtin_amdgcn_sched_barrier(0);
#pragma unroll
            for (int q = 0; q < 8; ++q) { c0 = __builtin_amdgcn_mfma_f32_16x16x32_bf16(av[q], b0[q], c0, 0, 0, 0); c1 = __builtin_amdgcn_mfma_f32_16x16x32_bf16(av[q], b1[q], c1, 0, 0, 0); } }
        { const int col0 = 32 * wave + arow;
#pragma unroll
          for (int j = 0; j < 4; ++j) { const int row = kq * 4 + j; hid[row * 264 + col0] = (bf16_t)(cvtpk(gelu_tanh(c0[j] + bb0), 0.f) & 0xffffu); hid[row * 264 + col0 + 16] = (bf16_t)(cvtpk(gelu_tanh(c1[j] + bb1), 0.f) & 0xffffu); } }
        LBAR();
        if (wave < 4) {
            const bf16_t* bp = W2t + (size_t)kv * 64 * 256 + (size_t)(16 * wave + arow) * 256 + kq * 8; f32x4 c = {0.f, 0.f, 0.f, 0.f};
            bf16x8 bv[8];
#pragma unroll
            for (int ks = 0; ks < 8; ++ks) bv[ks] = *(const bf16x8*)(bp + ks * 32);
            __builtin_amdgcn_sched_barrier(0);
#pragma unroll
            for (int ks = 0; ks < 8; ++ks) { const bf16x8 av = *(const LAS bf16x8*)(hid + arow * 264 + kq * 8 + ks * 32); c = __builtin_amdgcn_mfma_f32_16x16x32_bf16(av, bv[ks], c, 0, 0, 0); }
            const int col = 16 * wave + arow; const float bb = cb2[kv * 64 + col];
#pragma unroll
            for (int j = 0; j < 4; ++j) { const int n = 16 * nt + kq * 4 + j; KC[((size_t)(kv * 4 + bgi) * 512 + n) * 64 + col] = n < 511 ? (bf16_t)(cvtpk(c[j] + bb, 0.f) & 0xffffu) : (bf16_t)0; }
        }
        LBAR();
    }
    const int gt = blockIdx.x * 512 + tid, NGT = G * 512;
    { const bf16_t* MoK = (const bf16_t*)(ws + WS_MO) + att::MO_STRIDE; bf16_t* KM = (bf16_t*)(ws + WS_KM); LAS float* part = (LAS float*)(lds + 16384);
      for (int blk = blockIdx.x; blk < 256; blk += G) { const bf16_t* p = MoK + ((size_t)blk * 256 + 32 * wave) * 64 + lane; float s = 0.f;
#pragma unroll
          for (int r0 = 0; r0 < 32; r0 += 16) { unsigned short tv[16];
#pragma unroll
              for (int r = 0; r < 16; ++r) tv[r] = p[(size_t)(r0 + r) * 64];
              __builtin_amdgcn_sched_barrier(0);
#pragma unroll
              for (int r = 0; r < 16; ++r) s += __uint_as_float((unsigned)tv[r] << 16); }
          part[wave * 64 + lane] = s;
          LBAR();
          if (wave == 0) { float t = 0.f;
#pragma unroll
              for (int w = 0; w < 8; ++w) t += part[w * 64 + lane];
              KM[(size_t)blk * 64 + lane] = (bf16_t)(cvtpk(t * (1.0f / 256.0f), 0.f) & 0xffffu); }
          LBAR(); } }
    { const bf16_t* U = (const bf16_t*)(ws + WS_U); bf16_t* Abr = (bf16_t*)(ws + WS_XB);
      for (int e = gt; e < MTOK * 32; e += NGT) { const int row = e >> 5, c8 = e & 31, s = row & (SEQ - 1), w = 2 << (c8 >> 3), cnt = (s + 1 < w) ? s + 1 : w;
          float acc[8] = {0.f, 0.f, 0.f, 0.f, 0.f, 0.f, 0.f, 0.f}; u32x4 v0 = {0u, 0u, 0u, 0u};
#pragma unroll
          for (int i0 = 0; i0 < 16; i0 += 8) { if (i0 >= cnt) break; u32x4 v[8];
#pragma unroll
              for (int i = 0; i < 8; ++i) v[i] = (i0 + i < cnt) ? *(const u32x4*)(U + (size_t)(row - i0 - i) * 256 + c8 * 8) : (u32x4){0u, 0u, 0u, 0u};
              __builtin_amdgcn_sched_barrier(0);
              if (i0 == 0) v0 = v[0];
#pragma unroll
              for (int i = 0; i < 8; ++i)
#pragma unroll
                  for (int q = 0; q < 4; ++q) { acc[2 * q] += bflo(v[i][q]); acc[2 * q + 1] += bfhi(v[i][q]); } }
          const float ic = 1.0f / (float)cnt; u32x4 o;
#pragma unroll
          for (int q = 0; q < 4; ++q) o[q] = cvtpk(acc[2 * q] * ic - bflo(v0[q]), acc[2 * q + 1] * ic - bfhi(v0[q]));
          *(u32x4*)(Abr + (size_t)row * DM + c8 * 8) = o; } }
}
__global__ void __launch_bounds__(512, 2) fwd_megakernel(Args a) {
    extern __shared__ __attribute__((aligned(16))) unsigned char lds_raw[];
    LAS unsigned char* lds = (LAS unsigned char*)lds_raw;
    cg::grid_group grid = cg::this_grid();
    const int G = gridDim.x;
    volatile LAS unsigned* bst = (volatile LAS unsigned*)(lds + LDS_BYTES - 64);
    if (threadIdx.x < 16) bst[threadIdx.x] = 0u;
    __syncthreads();
    const ArgsP ap0 = (ArgsP)__builtin_amdgcn_kernarg_segment_ptr();
#define PHASE_ARGS ArgsP a_ = ap0; asm volatile("" : "+s"(a_)); unsigned char* ws = a_->ws; unsigned* ctl = (unsigned*)(ws + WS_CTL); float* ssp = (float*)(ws + WS_SSP); const float* tab = (const float*)(ws + WS_TAB); \
    bf16_t* XB = (bf16_t*)(ws + WS_XB); bf16_t* BIG = (bf16_t*)(ws + WS_BIG); bf16_t* MRG = (bf16_t*)(ws + WS_MRG); (void)ctl; (void)ssp; (void)tab; (void)XB; (void)BIG; (void)MRG;
    XcdBarrier xbar = xcd_barrier_post((unsigned*)(ap0->ws + WS_BAR), bst);
    bool first_sync = true;
#define GRID_SYNC() do { if (first_sync) { grid.sync(); first_sync = false; } else xcd_barrier(xbar); } while (0)
    for (int l = 0; l < DEPTH; ++l) {
        int tid_ = threadIdx.x; asm volatile("" : "+v"(tid_));
        const int tid = tid_, lane = tid & 63, wave = __builtin_amdgcn_readfirstlane(tid >> 6), gw = blockIdx.x * 8 + wave, NGW = G * 8;
        { PHASE_ARGS phase0(a_, l, lds, tid, lane, wave, gw, NGW); }
        GRID_SYNC();
        { PHASE_ARGS pg8::Gemm g{XB, (const bf16_t*)(ws + WS_W + OFF_WIN), MTOK, NIN, DM}; pg8::StaticOrder S; S.init(MTOK, NIN, G, (int)blockIdx.x);
          EpiInProj E{ssp, (const float*)(ws + WS_W + OFF_BIN), tab, (bf16_t*)(ws + WS_U), (bf16_t*)(ws + WS_QN), (bf16_t*)(ws + WS_KV), (bf16_t*)(ws + WS_MO), BIG, (bf16_t*)(ws + WS_GN)};
          pg8::gemm_phase(lds, g, S, E); }
        GRID_SYNC();
        { PHASE_ARGS phase2(a_, lds, tid, lane, wave, G); }
        GRID_SYNC();
        { PHASE_ARGS
          att::Bufs B{(const bf16_t*)(ws + WS_QN), (const bf16_t*)(ws + WS_KV), (const bf16_t*)(ws + WS_MO), (const bf16_t*)(ws + WS_KC), (const bf16_t*)(ws + WS_KM), (const bf16_t*)(ws + WS_GN), XB};
          const int* order = (const int*)(ws + WS_ORDER); LAS int* slot = (LAS int*)(lds + att::L_END);
          if (wave >= 4) __builtin_amdgcn_s_setprio(1);
          for (;;) {
              LBAR();
              if (tid == 0) slot[0] = (int)atomicAdd(ctl + l, 1u);
              LBAR();
              const int item = slot[0];
              if (item >= 768) break;
              const int id = order[item];
              int tl = threadIdx.x; asm volatile("" : "+v"(tl));
              const int tid = tl, lane = tid & 63, wave = __builtin_amdgcn_readfirstlane(tid >> 6);
              att::Ctx C; C.lds = (LAS char*)lds; C.wsf = (LAS float*)(lds + att::L_WSF) + wave * 64; C.otl = (LAS float*)(lds + att::L_OT) + wave * 2048 + lane; C.tid = tid; C.wid = wave; C.lane = lane; C.r32 = lane & 31; C.hi = lane >> 5;
              C.vbl = ((lane >> 4) & 1) * 32 + (lane & 3) * 8 + (4 * (lane >> 5) + ((lane & 15) >> 2)) * 64;
              if (id < 512) att::nsa_item(C, B, id >> 8, (id >> 7) & 1, id & 127);
              else { const int x = id - 512; att::moba_item(C, B, x >> 7, (x >> 5) & 3, x & 31); }
          }
          __builtin_amdgcn_s_setprio(0); }
        GRID_SYNC();
        { PHASE_ARGS pg8::Gemm g{XB, (const bf16_t*)(ws + WS_W + OFF_WBR), MTOK, DM, DM}; pg8::StaticOrder S; S.init(MTOK, DM, G, (int)blockIdx.x);
          EpiBranch E{BIG, MRG}; pg8::gemm_phase(lds, g, S, E); }
        GRID_SYNC();
        { PHASE_ARGS pg8::Gemm g{MRG, (const bf16_t*)(ws + WS_W + OFF_WOUT), MTOK, DM, DM}; pg8::StaticOrder S; S.init(MTOK, DM, G, (int)blockIdx.x);
          bf16_t* RES = (bf16_t*)a_->out; EpiResid E{l == 0 ? a_->in[0] : nullptr, RES, XB, nullptr, ssp};   pg8::gemm_phase(lds, g, S, E); }
        GRID_SYNC();
        { PHASE_ARGS pg8::Gemm g{XB, (const bf16_t*)(ws + WS_W + OFF_WGU), MTOK, NGU, DM}; pg8::StaticOrder S; S.init(MTOK, NGU, G, (int)blockIdx.x);
          EpiSwiGLU E{ssp, BIG}; pg8::gemm_phase(lds, g, S, E); }
        GRID_SYNC();
        { PHASE_ARGS pg8::Gemm g{BIG, (const bf16_t*)(ws + WS_W + OFF_WD), MTOK, DM, DFF}; pg8::StaticOrder S; S.init(MTOK, DM, G, (int)blockIdx.x);
          bf16_t* RES = (bf16_t*)a_->out; EpiResid E{nullptr, XB, XB, l + 1 < DEPTH ? RES : nullptr, ssp};   pg8::gemm_phase(lds, g, S, E); }
        GRID_SYNC();
    }
    { PHASE_ARGS const float* fn = a_->in[19]; float* outp = a_->out; const int lane = threadIdx.x & 63, gw = blockIdx.x * 8 + (threadIdx.x >> 6), NGW = G * 8;
      const f32x4* gr = (const f32x4*)fn + lane; f32x4 gv[4];
#pragma unroll
      for (int j = 0; j < 4; ++j) gv[j] = gr[64 * j];
      for (int m0 = 2 * gw; m0 < MTOK; m0 += 2 * NGW) { u32x2 w[2][4]; float rstd[2];
#pragma unroll
          for (int q = 0; q < 2; ++q) { const u32x2* xr = (const u32x2*)(XB + (size_t)(m0 + q) * DM) + lane; rstd[q] = row_rstd(ssp, m0 + q);
#pragma unroll
              for (int j = 0; j < 4; ++j) w[q][j] = xr[64 * j]; }
#pragma unroll
          for (int q = 0; q < 2; ++q) { f32x4* orow = (f32x4*)(outp + (size_t)(m0 + q) * DM) + lane;
#pragma unroll
              for (int j = 0; j < 4; ++j) { const f32x4 v = {bflo(w[q][j][0]), bfhi(w[q][j][0]), bflo(w[q][j][1]), bfhi(w[q][j][1])}; orow[64 * j] = v * rstd[q] * gv[j]; } } } }
}

extern "C" void kernel_launch(void* const* d_in, const int* in_sizes, int n_in, void* d_out, int out_size, void* d_ws, size_t ws_size, hipStream_t stream) {
    static int grid = 0;
    if (grid == 0) {
        if (n_in != 20 || in_sizes[0] != MTOK * DM || out_size != MTOK * DM || ws_size < WS_END) { fprintf(stderr, "kernel_launch: unexpected shapes / workspace (n_in %d, ws %zu)\n", n_in, ws_size); grid = -1; return; }
        int dev = 0, cus = 0, per_cu = 0;
        if (hipGetDevice(&dev) != hipSuccess || hipDeviceGetAttribute(&cus, hipDeviceAttributeMultiprocessorCount, dev) != hipSuccess) { grid = -1; return; }
        if (hipFuncSetAttribute((const void*)fwd_megakernel, hipFuncAttributeMaxDynamicSharedMemorySize, LDS_BYTES) != hipSuccess) { fprintf(stderr, "kernel_launch: hipFuncSetAttribute failed\n"); grid = -1; return; }
        if (hipOccupancyMaxActiveBlocksPerMultiprocessor(&per_cu, (const void*)fwd_megakernel, 512, LDS_BYTES) != hipSuccess || per_cu < 1) { fprintf(stderr, "kernel_launch: occupancy query failed (%d)\n", per_cu); (void)hipGetLastError(); grid = -1; return; }
        grid = cus * per_cu;
    }
    if (grid < 0) return;
    if (hipMemsetAsync((char*)d_ws + WS_CTL, 0, 32768, stream) != hipSuccess) { fprintf(stderr, "kernel_launch: memset failed\n"); return; }
    Args a{};
    for (int i = 0; i < 20; ++i) a.in[i] = (const float*)d_in[i];
    a.out = (float*)d_out; a.ws = (unsigned char*)d_ws;
    void* args[] = {&a};
    const hipError_t e = hipLaunchCooperativeKernel((const void*)fwd_megakernel, dim3(grid), dim3(512), args, LDS_BYTES, stream);
    if (e != hipSuccess) fprintf(stderr, "kernel_launch: cooperative launch failed: %s (grid %d)\n", hipGetErrorString(e), grid);
}
```

```cpp
#include <hip/hip_runtime.h>
#include <hip/hip_cooperative_groups.h>
#include <cstdio>
#include <cstdint>
#include <cmath>
namespace cg = cooperative_groups;

#define LAS __attribute__((address_space(3)))
typedef unsigned short bf16_t;
typedef short bf16x8 __attribute__((ext_vector_type(8)));
typedef short s16x4 __attribute__((ext_vector_type(4)));
typedef float f32x2 __attribute__((ext_vector_type(2)));
typedef float f32x4 __attribute__((ext_vector_type(4)));
typedef float f32x16 __attribute__((ext_vector_type(16)));
typedef unsigned u32x4 __attribute__((ext_vector_type(4)));
typedef unsigned u32x2 __attribute__((ext_vector_type(2)));
typedef __bf16 bf16x2_t __attribute__((ext_vector_type(2)));

constexpr int SEQ = 8192, BATCH = 2, MTOK = BATCH * SEQ, DM = 1024, DEPTH = 2;
constexpr int IN_COLS = 5400, NIN = 5632, DFF = 2816, NGU = 5632;
constexpr float RMS_EPS = 1e-6f;
constexpr float QSCALE = 0.125f * 1.4426950408889634f;

__device__ __forceinline__ unsigned cvtpk(float lo, float hi) { f32x2 v = {lo, hi}; bf16x2_t b = __builtin_convertvector(v, bf16x2_t); return __builtin_bit_cast(unsigned, b); }
__device__ __forceinline__ float bflo(unsigned w) { return __uint_as_float(w << 16); }
__device__ __forceinline__ float bfhi(unsigned w) { return __uint_as_float(w & 0xffff0000u); }
__device__ __forceinline__ float sigmoidf_(float x) { return __builtin_amdgcn_rcpf(1.f + __expf(-x)); }

namespace pg8 {
constexpr int BM = 256, BK = 64, HALF = 128, HTB = HALF * BK * 2, STAGE_BYTES = 8 * HTB, NXCD = 8, WGM = 8;
__host__ __device__ __forceinline__ int lds_byte(int r, int c) { const int st = (r >> 4) * 2 + (c >> 5), rr = r & 15, cc = c & 31, ob = rr * 64 + cc * 2; return st * 1024 + (ob ^ (((ob >> 9) & 1) << 5)); }
__host__ __device__ __forceinline__ void stage_rc(int b, int& R, int& C) { const int st = b / 1024, sb = b % 1024, swz = sb ^ (((sb >> 9) & 1) << 5); R = (st >> 1) * 16 + swz / 64; C = (st & 1) * 32 + (swz % 64) / 2; }
__host__ __device__ __forceinline__ int perm32(int rho) { const int n = rho >> 4, i = rho & 15; return 8 * (i >> 2) + 4 * n + (i & 3); }
struct Unit { int pm, pn; };
struct Gemm { const bf16_t* A; const bf16_t* Bt; int M, N, K; };
struct StaticOrder {
    int nM, nN, nwg, G, c;
    __host__ __device__ void init(int M, int N, int G_, int c_) { nM = M / BM; nN = N / BM; nwg = nM * nN; G = G_; c = c_; }
    __host__ __device__ bool next(int i, Unit& u) const {
        const long L = (long)i * G + c; if (L >= nwg) return false;
        int wgid = (int)L; { const int q = nwg / NXCD, r = nwg % NXCD, xcd = wgid % NXCD, off = wgid / NXCD; wgid = (xcd < r ? xcd * (q + 1) : r * (q + 1) + (xcd - r) * q) + off; }
        const int nig = WGM * nN, gid = wgid / nig, fm = gid * WGM, gsz = (nM - fm) < WGM ? (nM - fm) : WGM;
        u.pm = fm + ((wgid % nig) % gsz); u.pn = (wgid % nig) / gsz; return true;
    }
};
template <class Epi, class Sched>
__device__ __forceinline__ void gemm_phase(LAS unsigned char* lds, const Gemm g, const Sched& S, const Epi& E) {
    int tid_ = threadIdx.x; asm volatile("" : "+v"(tid_));
    const int tid = tid_, wid = __builtin_amdgcn_readfirstlane(tid >> 6), lane = tid & 63, wr = wid >> 2, wc = wid & 3, fr = lane & 15, fq = lane >> 4;
    const int K = g.K, nt = K / BK;
    unsigned voffA[2], voffB[2];
#pragma unroll
    for (int i = 0; i < 2; ++i) { int R, C; stage_rc(tid * 16 + i * 8192, R, C); const int Rb = ((R & ~31) + perm32(R & 31));
        voffA[i] = (unsigned)(R * K + C) * 2u; voffB[i] = (unsigned)(Rb * K + C) * 2u; }
    const size_t kstep = (size_t)(BK * 2);
    const size_t hstep = (size_t)HALF * K * 2;
    const size_t tstep = 2 * hstep;
    const unsigned ldsw = (unsigned)wid * 1024u;
    const int aoff = lds_byte(wr * 64 + fr, fq * 8), boff = lds_byte(wc * 32 + fr, fq * 8);
#define PG8_SA(b, h) (((b) * 2 + (h)) * HTB)
#define PG8_SB(b, h) ((4 + (b) * 2 + (h)) * HTB)
#define PG8_STAGE(bufoff, gbase, voff) do { _Pragma("unroll") for (int _i = 0; _i < 2; ++_i) \
        __builtin_amdgcn_global_load_lds((const unsigned*)((const char*)(gbase) + (voff)[_i]), (LAS unsigned*)(lds + (bufoff) + ldsw + _i * 8192), 16, 0, 0); } while (0)
#define PG8_LDA(dst, b, h) do { _Pragma("unroll") for (int m = 0; m < 4; ++m) _Pragma("unroll") for (int k = 0; k < 2; ++k) dst[m][k] = *(const LAS bf16x8*)(lds + PG8_SA(b, h) + aoff + m * 2048 + k * 1024); } while (0)
#define PG8_LDB(dst, b, h) do { _Pragma("unroll") for (int n = 0; n < 2; ++n) _Pragma("unroll") for (int k = 0; k < 2; ++k) dst[n][k] = *(const LAS bf16x8*)(lds + PG8_SB(b, h) + boff + n * 2048 + k * 1024); } while (0)
#define PG8_MMA(ai, bj, At, Bt) do { __builtin_amdgcn_s_setprio(1); _Pragma("unroll") for (int m = 0; m < 4; ++m) _Pragma("unroll") for (int n = 0; n < 2; ++n) _Pragma("unroll") for (int k = 0; k < 2; ++k) \
        acc[ai][bj][m][n] = __builtin_amdgcn_mfma_f32_16x16x32_bf16(Bt[n][k], At[m][k], acc[ai][bj][m][n], 0, 0, 0); __builtin_amdgcn_s_setprio(0); } while (0)
#define PG8_WAIT_V(n) asm volatile("s_waitcnt vmcnt(" #n ")" ::: "memory")
#define PG8_WAIT_L(n) asm volatile("s_waitcnt lgkmcnt(" #n ")" ::: "memory")
#define PG8_BAR __builtin_amdgcn_s_barrier()
#define PG8_SCHED __builtin_amdgcn_sched_barrier(0)
    Unit cur, nxt; int ui = 0;
    if (!S.next(0, cur)) return;
    f32x4 acc[2][2][4][2];
#pragma unroll
    for (int a = 0; a < 2; ++a)
#pragma unroll
        for (int b = 0; b < 2; ++b)
#pragma unroll
            for (int m = 0; m < 4; ++m)
#pragma unroll
                for (int n = 0; n < 2; ++n) acc[a][b][m][n] = (f32x4){0.f, 0.f, 0.f, 0.f};
    bf16x8 At[4][2], B0[2][2], B1[2][2];
    const char* cA = (const char*)g.A + (size_t)cur.pm * tstep; const char* cB = (const char*)g.Bt + (size_t)cur.pn * tstep;
    PG8_STAGE(PG8_SB(0, 0), cB, voffB); PG8_STAGE(PG8_SB(0, 1), cB + hstep, voffB); PG8_STAGE(PG8_SA(0, 0), cA, voffA); PG8_STAGE(PG8_SA(0, 1), cA + hstep, voffA);
    if (wr == 1) PG8_BAR;
    PG8_WAIT_V(2); PG8_BAR;
    PG8_STAGE(PG8_SB(1, 0), cB + kstep, voffB); PG8_STAGE(PG8_SA(1, 0), cA + kstep, voffA); PG8_STAGE(PG8_SB(1, 1), cB + hstep + kstep, voffB);
    PG8_WAIT_V(6); PG8_BAR;
    for (;;) {
        const bool has_next = S.next(ui + 1, nxt);
        const char* nA = has_next ? (const char*)g.A + (size_t)nxt.pm * tstep : cA; const char* nB = has_next ? (const char*)g.Bt + (size_t)nxt.pn * tstep : cB;
        for (int t = 0; t < nt; t += 2) {
            const bool last = (t == nt - 2);
            const char* a1 = cA + (size_t)(t + 1) * kstep;
            const char* a2 = last ? nA : cA + (size_t)(t + 2) * kstep; const char* b2 = last ? nB : cB + (size_t)(t + 2) * kstep;
            const char* a3 = a2 + kstep; const char* b3 = b2 + kstep;
            if constexpr (Epi::KHOOK) { if (t == 4 || t == 12) { PG8_SCHED; E.khook(acc, cur, t, wr, wc, fr, fq); PG8_SCHED; } }
            PG8_LDB(B0, 0, 0); PG8_LDB(B1, 0, 1); PG8_SCHED; PG8_LDA(At, 0, 0); PG8_STAGE(PG8_SA(1, 1), a1 + hstep, voffA);
            PG8_WAIT_V(8); PG8_WAIT_L(0); PG8_BAR; PG8_MMA(0, 0, At, B0); PG8_MMA(0, 1, At, B1); PG8_BAR; PG8_SCHED;
            PG8_LDA(At, 0, 1); PG8_STAGE(PG8_SB(0, 0), b2, voffB); PG8_STAGE(PG8_SB(0, 1), b2 + hstep, voffB); PG8_STAGE(PG8_SA(0, 0), a2, voffA);
            PG8_WAIT_V(8); PG8_WAIT_L(0); PG8_BAR; PG8_MMA(1, 0, At, B0); PG8_MMA(1, 1, At, B1); PG8_BAR; PG8_SCHED;
            PG8_LDB(B0, 1, 0); PG8_LDB(B1, 1, 1); PG8_SCHED; PG8_LDA(At, 1, 0); PG8_STAGE(PG8_SA(0, 1), a2 + hstep, voffA);
            PG8_WAIT_V(8); PG8_WAIT_L(0); PG8_BAR; PG8_MMA(0, 0, At, B0); PG8_MMA(0, 1, At, B1); PG8_BAR; PG8_SCHED;
            PG8_LDA(At, 1, 1); PG8_STAGE(PG8_SB(1, 0), b3, voffB); PG8_STAGE(PG8_SB(1, 1), b3 + hstep, voffB); PG8_STAGE(PG8_SA(1, 0), a3, voffA);
            PG8_WAIT_V(8); PG8_WAIT_L(0); PG8_BAR; PG8_MMA(1, 0, At, B0); PG8_MMA(1, 1, At, B1); PG8_BAR; PG8_SCHED;
        }
        if (wr == 0) PG8_BAR;
        E(acc, cur, wr, wc, fr, fq);
        if (!has_next) break;
#pragma unroll
        for (int a = 0; a < 2; ++a)
#pragma unroll
            for (int b = 0; b < 2; ++b)
#pragma unroll
                for (int m = 0; m < 4; ++m)
#pragma unroll
                    for (int n = 0; n < 2; ++n) acc[a][b][m][n] = (f32x4){0.f, 0.f, 0.f, 0.f};
        cur = nxt; cA = nA; cB = nB; ++ui;
        if (wr == 1) PG8_BAR;
    }
    PG8_WAIT_V(0);
    PG8_BAR;
#undef PG8_SA
#undef PG8_SB
#undef PG8_STAGE
#undef PG8_LDA
#undef PG8_LDB
#undef PG8_MMA
#undef PG8_WAIT_V
#undef PG8_WAIT_L
#undef PG8_BAR
#undef PG8_SCHED
}
}
__device__ __forceinline__ void st16_wt(void* p, u32x4 v) { asm volatile("global_store_dwordx4 %0, %1, off sc1\n\ts_nop 1" :: "v"(p), "v"(v) : "memory"); }
using pg8::Unit;
__device__ __forceinline__ float row_rstd(const float* ssp, int row) {
    const f32x4* p = (const f32x4*)(ssp + (size_t)row * 16);
    const f32x4 a = p[0], b = p[1], c = p[2], d = p[3];
    const float ss = ((a[0] + a[1]) + (a[2] + a[3])) + ((b[0] + b[1]) + (b[2] + b[3])) + ((c[0] + c[1]) + (c[2] + c[3])) + ((d[0] + d[1]) + (d[2] + d[3]));
    return 1.0f / sqrtf(ss * (1.0f / DM) + RMS_EPS);
}
__device__ __forceinline__ float row_rstd4(const float* ssp, int row, int fq) {
    const f32x4 a = *((const f32x4*)(ssp + (size_t)row * 16) + fq);
    float ss = (a[0] + a[1]) + (a[2] + a[3]);
    ss += __shfl_xor(ss, 16); ss += __shfl_xor(ss, 32);
    return 1.0f / sqrtf(ss * (1.0f / DM) + RMS_EPS);
}
__device__ __forceinline__ u32x4 pack8(const f32x4 a, const f32x4 b) { u32x4 w; w.x = cvtpk(a[0], a[1]); w.y = cvtpk(a[2], a[3]); w.z = cvtpk(b[0], b[1]); w.w = cvtpk(b[2], b[3]); return w; }
__device__ __forceinline__ void rope8(f32x4& v0, f32x4& v1, const float* tab, int t, int pos, float sc) {
    const f32x4* cs = (const f32x4*)(tab + ((size_t)t * 32 + (pos >> 1)) * 2);
    const f32x4 c0 = cs[0], c1 = cs[1];
    f32x4 o0, o1;
    o0[0] = (v0[0] * c0[0] - v0[1] * c0[1]) * sc; o0[1] = (v0[1] * c0[0] + v0[0] * c0[1]) * sc;
    o0[2] = (v0[2] * c0[2] - v0[3] * c0[3]) * sc; o0[3] = (v0[3] * c0[2] + v0[2] * c0[3]) * sc;
    o1[0] = (v1[0] * c1[0] - v1[1] * c1[1]) * sc; o1[1] = (v1[1] * c1[0] + v1[0] * c1[1]) * sc;
    o1[2] = (v1[2] * c1[2] - v1[3] * c1[3]) * sc; o1[3] = (v1[3] * c1[2] + v1[2] * c1[3]) * sc;
    v0 = o0; v1 = o1;
}
struct EpiInProj {
    static constexpr bool KHOOK = false;
    const float* ssp; const float* bias; const float* tab;
    bf16_t *U, *Qn, *KV, *Mo, *G, *Gn;
    __device__ __forceinline__ void operator()(const f32x4 (&acc)[2][2][4][2], const Unit& u, int wr, int wc, int fr, int fq) const {
        asm volatile("" : "+v"(fr), "+v"(fq));
        const int pn = u.pn;
        f32x4 bia[2][2];
#pragma unroll
        for (int bj = 0; bj < 2; ++bj) { const int gc = pn * 256 + bj * 128 + wc * 32 + 8 * fq; bia[bj][0] = *(const f32x4*)(bias + gc); bia[bj][1] = *(const f32x4*)(bias + gc + 4); }
        float rs[2][4];
#pragma unroll
        for (int ai = 0; ai < 2; ++ai) { f32x4 ra[4];
#pragma unroll
            for (int m = 0; m < 4; ++m) ra[m] = *((const f32x4*)(ssp + (size_t)(u.pm * 256 + ai * 128 + wr * 64 + m * 16 + fr) * 16) + fq);
            __builtin_amdgcn_sched_barrier(0);
#pragma unroll
            for (int m = 0; m < 4; ++m) { float ss = (ra[m][0] + ra[m][1]) + (ra[m][2] + ra[m][3]); ss += __shfl_xor(ss, 16); ss += __shfl_xor(ss, 32); rs[ai][m] = 1.0f / sqrtf(ss * (1.0f / DM) + RMS_EPS); } }
#pragma unroll
        for (int ai = 0; ai < 2; ++ai)
#pragma unroll
            for (int m = 0; m < 4; ++m) {
                const int row = u.pm * 256 + ai * 128 + wr * 64 + m * 16 + fr;
                const float rstd = rs[ai][m];
                const int t = row & (SEQ - 1), b = row >> 13;
#pragma unroll
                for (int bj = 0; bj < 2; ++bj) {
                    const int cit = bj * 128 + wc * 32 + 8 * fq;
                    f32x4 v0 = acc[ai][bj][m][0] * rstd + bia[bj][0], v1 = acc[ai][bj][m][1] * rstd + bia[bj][1];
                    bf16_t* dst;
                    if (pn == 0) { dst = U + (size_t)row * 256 + cit; }
                    else if (pn <= 2) { const int c2 = (pn - 1) * 256 + cit, head = c2 >> 6, pos = c2 & 63; rope8(v0, v1, tab, t, pos, QSCALE); dst = Qn + ((size_t)(b * 8 + head) * SEQ + t) * 64 + pos; }
                    else if (pn <= 5) { const int c2 = cit & 127, g = c2 >> 6, pos = c2 & 63, kvi = 2 * (pn - 3) + bj; if (bj == 0) rope8(v0, v1, tab, t, pos, 1.f);
                        dst = KV + (size_t)kvi * ((size_t)MTOK * 128) + ((size_t)(b * 2 + g) * SEQ + t) * 64 + pos; }
                    else if (pn <= 8) { const int h = cit >> 6, pos = cit & 63; if (pn < 8) rope8(v0, v1, tab, t, pos, pn == 6 ? QSCALE : 1.f);
                        dst = Mo + (size_t)(pn - 6) * ((size_t)MTOK * 256) + ((size_t)(b * 4 + h) * SEQ + t) * 64 + pos; }
                    else if (pn <= 20) {
#pragma unroll
                        for (int e = 0; e < 4; ++e) { v0[e] = sigmoidf_(v0[e]); v1[e] = sigmoidf_(v1[e]); }
                        dst = G + (size_t)row * 3072 + (pn - 9) * 256 + cit; }
                    else {
#pragma unroll
                        for (int e = 0; e < 4; ++e) { v0[e] = sigmoidf_(v0[e]); v1[e] = sigmoidf_(v1[e]); }
                        dst = Gn + (size_t)row * 32 + (cit & 31); if (cit >= 32) dst = nullptr; }
                    if (dst) st16_wt(dst, pack8(v0, v1));
                }
                asm volatile("" ::: "memory");
            }
    }
};
struct EpiBranch {
    static constexpr bool KHOOK = true;
    const bf16_t* G; bf16_t* out;
    __device__ __forceinline__ void khook(f32x4 (&acc)[2][2][4][2], const Unit& u, int t, int wr, int wc, int fr, int fq) const {
        asm volatile("" : "+v"(fr), "+v"(fq));
        const int gsel = (t == 4) ? 0 : 1024;
#pragma unroll
        for (int ai = 0; ai < 2; ++ai)
#pragma unroll
            for (int m = 0; m < 4; ++m) {
                u32x4 gx[2], gy[2];
#pragma unroll
                for (int bj = 0; bj < 2; ++bj) { const int row = u.pm * 256 + ai * 128 + wr * 64 + m * 16 + fr, col = u.pn * 256 + bj * 128 + wc * 32 + 8 * fq;
                    gx[bj] = *(const u32x4*)(G + (size_t)row * 3072 + gsel + col); gy[bj] = *(const u32x4*)(G + (size_t)row * 3072 + gsel + 1024 + col); }
                __builtin_amdgcn_sched_barrier(0);
#pragma unroll
                for (int bj = 0; bj < 2; ++bj)
#pragma unroll
                    for (int e = 0; e < 4; ++e) {
                        const float x0 = fmaxf(bflo(gx[bj][e]), 1e-20f), x1 = fmaxf(bfhi(gx[bj][e]), 1e-20f), y0 = fmaxf(bflo(gy[bj][e]), 1e-20f), y1 = fmaxf(bfhi(gy[bj][e]), 1e-20f);
                        const float r0 = x0 * __builtin_amdgcn_rcpf(y0), r1 = x1 * __builtin_amdgcn_rcpf(y1);
                        acc[ai][bj][m][e >> 1][(e & 1) * 2] *= r0; acc[ai][bj][m][e >> 1][(e & 1) * 2 + 1] *= r1; }
                asm volatile("" ::: "memory");
            }
    }
    __device__ __forceinline__ void operator()(const f32x4 (&acc)[2][2][4][2], const Unit& u, int wr, int wc, int fr, int fq) const {
        asm volatile("" : "+v"(fr), "+v"(fq));
#pragma unroll
        for (int ai = 0; ai < 2; ++ai) {
            u32x4 gz[4][2];
#pragma unroll
            for (int m = 0; m < 4; ++m)
#pragma unroll
                for (int bj = 0; bj < 2; ++bj) gz[m][bj] = *(const u32x4*)(G + (size_t)(u.pm * 256 + ai * 128 + wr * 64 + m * 16 + fr) * 3072 + 2048 + u.pn * 256 + bj * 128 + wc * 32 + 8 * fq);
            __builtin_amdgcn_sched_barrier(0);
#pragma unroll
            for (int m = 0; m < 4; ++m) {
                const int row = u.pm * 256 + ai * 128 + wr * 64 + m * 16 + fr;
#pragma unroll
                for (int bj = 0; bj < 2; ++bj) {
                    const int col = u.pn * 256 + bj * 128 + wc * 32 + 8 * fq; const u32x4 g = gz[m][bj];
                    f32x4 v0 = acc[ai][bj][m][0], v1 = acc[ai][bj][m][1];
                    v0[0] *= fmaxf(bflo(g[0]), 1e-20f); v0[1] *= fmaxf(bfhi(g[0]), 1e-20f); v0[2] *= fmaxf(bflo(g[1]), 1e-20f); v0[3] *= fmaxf(bfhi(g[1]), 1e-20f);
                    v1[0] *= fmaxf(bflo(g[2]), 1e-20f); v1[1] *= fmaxf(bfhi(g[2]), 1e-20f); v1[2] *= fmaxf(bflo(g[3]), 1e-20f); v1[3] *= fmaxf(bfhi(g[3]), 1e-20f);
                    st16_wt(out + (size_t)row * DM + col, pack8(v0, v1));
                }
            }
            asm volatile("" ::: "memory");
        }
    }
};
struct EpiResid {
    static constexpr bool KHOOK = false;
    const float* base_f; const bf16_t* base_b; bf16_t* xb; bf16_t* res; float* ssp;
    __device__ __forceinline__ void operator()(const f32x4 (&acc)[2][2][4][2], const Unit& u, int wr, int wc, int fr, int fq) const {
        asm volatile("" : "+v"(fr), "+v"(fq));
#pragma unroll
        for (int ai = 0; ai < 2; ++ai)
#pragma unroll
            for (int mp = 0; mp < 2; ++mp) {
                f32x4 b0[2][2], b1[2][2];
                if (base_f) {
#pragma unroll
                    for (int mm = 0; mm < 2; ++mm)
#pragma unroll
                        for (int bj = 0; bj < 2; ++bj) { const size_t off = (size_t)(u.pm * 256 + ai * 128 + wr * 64 + (2 * mp + mm) * 16 + fr) * DM + u.pn * 256 + bj * 128 + wc * 32 + 8 * fq;
                            b0[mm][bj] = *(const f32x4*)(base_f + off); b1[mm][bj] = *(const f32x4*)(base_f + off + 4); }
                    __builtin_amdgcn_sched_barrier(0);
                } else {
                    u32x4 w[2][2];
#pragma unroll
                    for (int mm = 0; mm < 2; ++mm)
#pragma unroll
                        for (int bj = 0; bj < 2; ++bj) w[mm][bj] = *(const u32x4*)(base_b + (size_t)(u.pm * 256 + ai * 128 + wr * 64 + (2 * mp + mm) * 16 + fr) * DM + u.pn * 256 + bj * 128 + wc * 32 + 8 * fq);
                    __builtin_amdgcn_sched_barrier(0);
#pragma unroll
                    for (int mm = 0; mm < 2; ++mm)
#pragma unroll
                        for (int bj = 0; bj < 2; ++bj) { const u32x4 x = w[mm][bj]; b0[mm][bj] = (f32x4){bflo(x[0]), bfhi(x[0]), bflo(x[1]), bfhi(x[1])}; b1[mm][bj] = (f32x4){bflo(x[2]), bfhi(x[2]), bflo(x[3]), bfhi(x[3])}; }
                }
#pragma unroll
                for (int mm = 0; mm < 2; ++mm) {
                    const int m = 2 * mp + mm, row = u.pm * 256 + ai * 128 + wr * 64 + m * 16 + fr;
                    float ss = 0.f;
#pragma unroll
                    for (int bj = 0; bj < 2; ++bj) {
                        const size_t off = (size_t)row * DM + u.pn * 256 + bj * 128 + wc * 32 + 8 * fq;
                        const f32x4 v0 = acc[ai][bj][m][0] + b0[mm][bj], v1 = acc[ai][bj][m][1] + b1[mm][bj];
                        const u32x4 pk = pack8(v0, v1);
                        st16_wt(xb + off, pk);
                        if (res) st16_wt(res + off, pk);
                        ss += (v0[0] * v0[0] + v0[1] * v0[1]) + (v0[2] * v0[2] + v0[3] * v0[3]) + (v1[0] * v1[0] + v1[1] * v1[1]) + (v1[2] * v1[2] + v1[3] * v1[3]);
                    }
                    ss += __shfl_xor(ss, 16); ss += __shfl_xor(ss, 32);
                    if (fq == 0) ssp[(size_t)row * 16 + u.pn * 4 + wc] = ss;
                }
                asm volatile("" ::: "memory");
            }
    }
};
struct EpiSwiGLU {
    static constexpr bool KHOOK = false;
    const float* ssp; bf16_t* H;
    __device__ __forceinline__ void operator()(const f32x4 (&acc)[2][2][4][2], const Unit& u, int wr, int wc, int fr, int fq) const {
        asm volatile("" : "+v"(fr), "+v"(fq));
        float rs[2][4];
#pragma unroll
        for (int ai = 0; ai < 2; ++ai) { f32x4 ra[4];
#pragma unroll
            for (int m = 0; m < 4; ++m) ra[m] = *((const f32x4*)(ssp + (size_t)(u.pm * 256 + ai * 128 + wr * 64 + m * 16 + fr) * 16) + fq);
            __builtin_amdgcn_sched_barrier(0);
#pragma unroll
            for (int m = 0; m < 4; ++m) { float ss = (ra[m][0] + ra[m][1]) + (ra[m][2] + ra[m][3]); ss += __shfl_xor(ss, 16); ss += __shfl_xor(ss, 32); rs[ai][m] = 1.0f / sqrtf(ss * (1.0f / DM) + RMS_EPS); } }
#pragma unroll
        for (int ai = 0; ai < 2; ++ai)
#pragma unroll
            for (int m = 0; m < 4; ++m) {
                const int row = u.pm * 256 + ai * 128 + wr * 64 + m * 16 + fr;
                const float rstd = rs[ai][m];
                f32x4 o[2];
#pragma unroll
                for (int n = 0; n < 2; ++n)
#pragma unroll
                    for (int e = 0; e < 4; ++e) { const float gt = acc[ai][0][m][n][e] * rstd, up = acc[ai][1][m][n][e] * rstd; o[n][e] = gt * sigmoidf_(gt) * up; }
                st16_wt(H + (size_t)row * DFF + u.pn * 128 + wc * 32 + 8 * fq, pack8(o[0], o[1]));
                asm volatile("" ::: "memory");
            }
    }
};
namespace att {
constexpr int KCS = 1040, KSLOT = 8 * KCS, VSLOT = 8192;
constexpr int L_K0 = 0, L_V0 = 4 * KSLOT, L_WSF = 4 * KSLOT + 4 * VSLOT, L_MSK = L_WSF + 8 * 256, L_UNI = L_MSK + 1024, L_LIST = L_UNI + 64, L_END = L_LIST + 512,
              L_PS = L_END + 64, L_OT = L_PS, L_TOTAL = L_OT + 8 * 8192;
static_assert(L_TOTAL <= 147456 - 64, "attention LDS map");
#define LBAR() asm volatile("s_waitcnt lgkmcnt(0)\n\ts_barrier" ::: "memory")
#define LWAIT() asm volatile("s_waitcnt lgkmcnt(0)" ::: "memory")
__device__ __forceinline__ int crow(int r, int hi) { return (r & 3) + 8 * (r >> 2) + 4 * hi; }
__device__ __forceinline__ float swap_other(float v, int hi) { auto rr = __builtin_amdgcn_permlane32_swap(__float_as_uint(v), __float_as_uint(v), false, false); return __uint_as_float(hi ? rr[0] : rr[1]); }
__device__ __forceinline__ void qkt(f32x16& p0, f32x16& p1, const LAS char* Ks, const bf16x8* qr, const f32x16& cinit, int r32, int hi) {
    const LAS char* kb = Ks + hi * KCS + r32 * 16;
    bf16x8 kf[8];
#pragma unroll
    for (int d0 = 0; d0 < 4; ++d0) { kf[2 * d0] = *(const LAS bf16x8*)(kb + d0 * 2 * KCS); kf[2 * d0 + 1] = *(const LAS bf16x8*)(kb + d0 * 2 * KCS + 512); }
    __builtin_amdgcn_sched_barrier(0);
    p0 = __builtin_amdgcn_mfma_f32_32x32x16_bf16(kf[0], qr[0], cinit, 0, 0, 0); p1 = __builtin_amdgcn_mfma_f32_32x32x16_bf16(kf[1], qr[0], cinit, 0, 0, 0);
#pragma unroll
    for (int d0 = 1; d0 < 4; ++d0) { p0 = __builtin_amdgcn_mfma_f32_32x32x16_bf16(kf[2 * d0], qr[d0], p0, 0, 0, 0); p1 = __builtin_amdgcn_mfma_f32_32x32x16_bf16(kf[2 * d0 + 1], qr[d0], p1, 0, 0, 0); }
}
struct VFrag { s16x4 lo[8], hi[8]; };
typedef short v4i16_t __attribute__((ext_vector_type(4)));
__device__ __forceinline__ s16x4 vtr(const LAS char* p) { return __builtin_bit_cast(s16x4, __builtin_amdgcn_ds_read_tr16_b64_v4i16((LAS v4i16_t*)p)); }
__device__ __forceinline__ void v_issue(VFrag& F, const LAS char* vp) {
#pragma unroll
    for (int d0 = 0; d0 < 2; ++d0)
#pragma unroll
        for (int ks = 0; ks < 4; ++ks) { F.lo[d0 * 4 + ks] = vtr(vp + d0 * 4096 + ks * 1024); F.hi[d0 * 4 + ks] = vtr(vp + d0 * 4096 + ks * 1024 + 512); }
}
template <bool SUM> __device__ __forceinline__ void pv(f32x16* o, f32x16& osum, VFrag& F, bf16x8 pa0, bf16x8 pa1, bf16x8 pa2, bf16x8 pa3) {
#define PK(k) (bf16x8){F.lo[k][0], F.lo[k][1], F.lo[k][2], F.lo[k][3], F.hi[k][0], F.hi[k][1], F.hi[k][2], F.hi[k][3]}
    const bf16x8 ones = {0x3F80, 0x3F80, 0x3F80, 0x3F80, 0x3F80, 0x3F80, 0x3F80, 0x3F80};
    __builtin_amdgcn_s_setprio(1);
    o[0] = __builtin_amdgcn_mfma_f32_32x32x16_bf16(pa0, PK(0), o[0], 0, 0, 0);
    o[1] = __builtin_amdgcn_mfma_f32_32x32x16_bf16(pa0, PK(4), o[1], 0, 0, 0);
    if (SUM) osum = __builtin_amdgcn_mfma_f32_32x32x16_bf16(pa0, ones, osum, 0, 0, 0);
    o[0] = __builtin_amdgcn_mfma_f32_32x32x16_bf16(pa1, PK(1), o[0], 0, 0, 0);
    o[1] = __builtin_amdgcn_mfma_f32_32x32x16_bf16(pa1, PK(5), o[1], 0, 0, 0);
    if (SUM) osum = __builtin_amdgcn_mfma_f32_32x32x16_bf16(pa1, ones, osum, 0, 0, 0);
    o[0] = __builtin_amdgcn_mfma_f32_32x32x16_bf16(pa2, PK(2), o[0], 0, 0, 0);
    o[1] = __builtin_amdgcn_mfma_f32_32x32x16_bf16(pa2, PK(6), o[1], 0, 0, 0);
    if (SUM) osum = __builtin_amdgcn_mfma_f32_32x32x16_bf16(pa2, ones, osum, 0, 0, 0);
    o[0] = __builtin_amdgcn_mfma_f32_32x32x16_bf16(pa3, PK(3), o[0], 0, 0, 0);
    o[1] = __builtin_amdgcn_mfma_f32_32x32x16_bf16(pa3, PK(7), o[1], 0, 0, 0);
    if (SUM) osum = __builtin_amdgcn_mfma_f32_32x32x16_bf16(pa3, ones, osum, 0, 0, 0);
    __builtin_amdgcn_s_setprio(0);
#undef PK
}
__device__ __forceinline__ float rowmax(const f32x16& p0, const f32x16& p1, int hi) {
    float a = __builtin_fmaxf(p0[0], p1[0]);
#pragma unroll
    for (int r = 1; r < 16; ++r) a = __builtin_fmaxf(__builtin_fmaxf(a, p0[r]), p1[r]);
    return __builtin_fmaxf(a, swap_other(a, hi));
}
struct KVRegs { u32x4 k, v; };
__device__ __forceinline__ void tile_load(KVRegs& R, const bf16_t* K, const bf16_t* V, int tid) { R.k = *(const u32x4*)(K + tid * 8); R.v = *(const u32x4*)(V + tid * 8); }
__device__ __forceinline__ void tile_store(const KVRegs& R, LAS char* Ks, LAS char* Vs, int tid) {
    const int row = tid >> 3, c = tid & 7;
    *(LAS u32x4*)(Ks + c * KCS + row * 16) = R.k;
    *(LAS u32x4*)(Vs + (c >> 2) * 4096 + (row >> 4) * 1024 + (row & 15) * 64 + (c & 3) * 16) = R.v;
}
__device__ __forceinline__ void ps_accum(const f32x16 p, int jb, LAS float* ps_row, bool writer) {
#pragma unroll
    for (int rg = 0; rg < 4; ++rg) {
        float a = 2.f * (p[4 * rg] + p[4 * rg + 1] + p[4 * rg + 2]) + p[4 * rg + 3], bq = p[4 * rg + 3];
        a += __shfl_xor(a, 1); a += __shfl_xor(a, 2); bq += __shfl_xor(bq, 1); bq += __shfl_xor(bq, 2);
        const int j = jb + 2 * rg;
        if (writer) { __hip_atomic_fetch_add(ps_row + j, a, __ATOMIC_RELAXED, __HIP_MEMORY_SCOPE_WORKGROUP); if (j + 1 < 128) __hip_atomic_fetch_add(ps_row + j + 1, bq, __ATOMIC_RELAXED, __HIP_MEMORY_SCOPE_WORKGROUP); }
    }
}
struct Ctx { LAS char* lds; LAS float* wsf; LAS float* otl; int tid, wid, lane, r32, hi, vbl; };
struct RowSt { float m, l; bool started; f32x16 negm, osum; };
__device__ __forceinline__ void rowst_init(RowSt& S) { S.m = 0.f; S.l = 0.f; S.started = false; S.negm = f32x16{}; S.osum = f32x16{}; asm volatile("" : "+v"(S.negm)); }
__device__ __forceinline__ void rowst_fixed(RowSt& S, float ref) { S.m = ref; S.l = 0.f; S.started = true; S.osum = f32x16{};
#pragma unroll
    for (int r = 0; r < 16; ++r) S.negm[r] = -ref;
    asm volatile("" : "+v"(S.negm)); }
template <int MODE, class Idx, class Src, class Msk>
__device__ __forceinline__ void run_branch(const Ctx& C, int nt, const Idx& idx, const Src& src, const Msk& msk, const bf16x8* qr, RowSt& S, f32x16* o, LAS float* ps_row, bool ps_writer, KVRegs& R0, bool pre, const bf16_t* nk, const bf16_t* nv) {
    KVRegs R1; const bf16_t *kp, *vp;
    int dA = idx(0), dB = nt > 1 ? idx(1) : 0, dC = 0, dD = 0;
    if (!pre) { src(0, dA, kp, vp); tile_load(R0, kp, vp, C.tid); }
    if (nt > 1) { src(1, dB, kp, vp); tile_load(R1, kp, vp, C.tid); }
    auto compute = [&](int it, const LAS char* Ks, const LAS char* Vs, int klo, int khi, bool nm) {
        const bool kill = khi < klo;
        if (!__any(!kill)) return;
        f32x16 p0, p1; qkt(p0, p1, Ks, qr, S.negm, C.r32, C.hi);
        VFrag VF; if constexpr (MODE != 0) { v_issue(VF, Vs + C.vbl); __builtin_amdgcn_sched_barrier(0); }
        if (__any(nm && !kill)) {
#pragma unroll
            for (int r = 0; r < 16; ++r) { const int kv = crow(r, C.hi); if (kv < klo || kv > khi) p0[r] = -INFINITY; if (kv + 32 < klo || kv + 32 > khi) p1[r] = -INFINITY; }
        }
        if constexpr (MODE != 2) {
            float rm = rowmax(p0, p1, C.hi); if (kill) rm = -INFINITY;
            const bool first = !S.started && rm > -INFINITY, grow = first || rm > 8.0f;
            if (__any(grow)) {
                const float d = grow ? rm : 0.f, alpha = first ? 1.0f : __builtin_amdgcn_exp2f(-d);
                S.m += d; S.started = S.started || first;
#pragma unroll
                for (int r = 0; r < 16; ++r) { S.negm[r] = -S.m; p0[r] -= d; p1[r] -= d; }
                if constexpr (MODE == 0) S.l *= alpha;
                if constexpr (MODE == 1) {
                    if (C.hi == 0) C.wsf[C.r32] = alpha;
                    LWAIT();
#pragma unroll
                    for (int r = 0; r < 16; ++r) { const float f = C.wsf[crow(r, C.hi)]; o[0][r] *= f; o[1][r] *= f; S.osum[r] *= f; }
                    LWAIT();
                }
            }
        }
#pragma unroll
        for (int r = 0; r < 16; ++r) { p0[r] = __builtin_amdgcn_exp2f(p0[r]); p1[r] = __builtin_amdgcn_exp2f(p1[r]); }
        if constexpr (MODE == 0) {
            float s = 0.f;
#pragma unroll
            for (int r = 0; r < 16; ++r) s += p0[r] + p1[r];
            S.l += kill ? 0.f : s;
        }
        if constexpr (MODE == 2) {
            if (__any(kill)) {
#pragma unroll
                for (int r = 0; r < 16; ++r) { p0[r] = kill ? 0.f : p0[r]; p1[r] = kill ? 0.f : p1[r]; }
            }
            ps_accum(p0, 16 * it + C.hi, ps_row, ps_writer); ps_accum(p1, 16 * it + 8 + C.hi, ps_row, ps_writer);
        }
        if constexpr (MODE != 0) {
            u32x4 w0 = {cvtpk(p0[0], p0[1]), cvtpk(p0[2], p0[3]), cvtpk(p0[4], p0[5]), cvtpk(p0[6], p0[7])}, w1 = {cvtpk(p0[8], p0[9]), cvtpk(p0[10], p0[11]), cvtpk(p0[12], p0[13]), cvtpk(p0[14], p0[15])};
            u32x4 w2 = {cvtpk(p1[0], p1[1]), cvtpk(p1[2], p1[3]), cvtpk(p1[4], p1[5]), cvtpk(p1[6], p1[7])}, w3 = {cvtpk(p1[8], p1[9]), cvtpk(p1[10], p1[11]), cvtpk(p1[12], p1[13]), cvtpk(p1[14], p1[15])};
            if constexpr (MODE == 1) {
                if (__any(kill)) {
#pragma unroll
                    for (int e = 0; e < 4; ++e) { w0[e] = kill ? 0u : w0[e]; w1[e] = kill ? 0u : w1[e]; w2[e] = kill ? 0u : w2[e]; w3[e] = kill ? 0u : w3[e]; }
                }
            }
            pv<MODE == 1>(o, S.osum, VF, __builtin_bit_cast(bf16x8, w0), __builtin_bit_cast(bf16x8, w1), __builtin_bit_cast(bf16x8, w2), __builtin_bit_cast(bf16x8, w3));
        }
    };
    LBAR();
    for (int it = 0; it < nt; it += 2) {
        const int p = (it >> 1) & 1; const bool two = it + 1 < nt;
        LAS char* KsA = C.lds + L_K0 + (2 * p) * KSLOT; LAS char* VsA = C.lds + L_V0 + (2 * p) * VSLOT;
        LAS char* KsB = KsA + KSLOT; LAS char* VsB = VsA + VSLOT;
        tile_store(R0, KsA, VsA, C.tid); if (two) tile_store(R1, KsB, VsB, C.tid);
        if (it + 2 < nt) dC = idx(it + 2);
        if (it + 3 < nt) dD = idx(it + 3);
        int kloA, khiA, kloB = 0, khiB = -1; const bool nmA = msk(it, dA, kloA, khiA); bool nmB = false; if (two) nmB = msk(it + 1, dB, kloB, khiB);
        if (it + 2 < nt) { src(it + 2, dC, kp, vp); tile_load(R0, kp, vp, C.tid); } else if (nk) tile_load(R0, nk, nv, C.tid);
        if (it + 3 < nt) { src(it + 3, dD, kp, vp); tile_load(R1, kp, vp, C.tid); }
        LBAR();
        compute(it, KsA, VsA, kloA, khiA, nmA);
        if (two) compute(it + 1, KsB, VsB, kloB, khiB, nmB);
        dA = dC; dB = dD;
    }
}
template <bool FIRST> __device__ __forceinline__ void merge_branch_n(const Ctx& C, const f32x16* o, const f32x16& osum, float gate) {
    if (C.hi == 0) C.wsf[C.r32] = gate;
    LWAIT();
#pragma unroll
    for (int r = 0; r < 16; ++r) { const float den = osum[r], f = den > 0.f ? C.wsf[crow(r, C.hi)] * __builtin_amdgcn_rcpf(den) : 0.f;
        if (FIRST) { C.otl[r * 64] = o[0][r] * f; C.otl[(16 + r) * 64] = o[1][r] * f; }
        else { C.otl[r * 64] += o[0][r] * f; C.otl[(16 + r) * 64] += o[1][r] * f; } }
    LWAIT();
}
template <bool FIRST> __device__ __forceinline__ void merge_branch(const Ctx& C, const f32x16* o, float factor) {
    if (C.hi == 0) C.wsf[C.r32] = factor;
    LWAIT();
#pragma unroll
    for (int r = 0; r < 16; ++r) { const float f = C.wsf[crow(r, C.hi)];
        if (FIRST) { C.otl[r * 64] = o[0][r] * f; C.otl[(16 + r) * 64] = o[1][r] * f; }
        else { C.otl[r * 64] += o[0][r] * f; C.otl[(16 + r) * 64] += o[1][r] * f; } }
    LWAIT();
}
struct Bufs { const bf16_t *Qn, *KV, *Mo, *KC, *KM, *Gn; bf16_t* Abr; };
constexpr size_t KV_STRIDE = (size_t)MTOK * 128, MO_STRIDE = (size_t)MTOK * 256;

__device__ __forceinline__ void nsa_item(const Ctx& C, const Bufs& B, int b, int g, int i) {
    const int r32 = C.r32, hi = C.hi, wid = C.wid;
    const int qi = 8 * wid + (r32 >> 2), hh = r32 & 3, head = g * 4 + hh, t = 64 * i + qi, cur = i;
    const size_t bg = (size_t)(b * 2 + g) * SEQ;
    bf16x8 qr[4];
    { const bf16_t* qp = B.Qn + ((size_t)(b * 8 + head) * SEQ + t) * 64 + hi * 8;
#pragma unroll
      for (int d0 = 0; d0 < 4; ++d0) qr[d0] = *(const bf16x8*)(qp + d0 * 16); }
    const unsigned gw = *(const unsigned*)(B.Gn + ((size_t)b * SEQ + t) * 32 + head * 3 - (head & 1));
    const unsigned gw2 = *(const unsigned*)(B.Gn + ((size_t)b * SEQ + t) * 32 + head * 3 - (head & 1) + 2);
    float g0, g1, g2; if (head & 1) { g0 = bfhi(gw); g1 = bflo(gw2); g2 = bfhi(gw2); } else { g0 = bflo(gw); g1 = bfhi(gw); g2 = bflo(gw2); }
    f32x16 o[2];
    LAS float* Ps = (LAS float*)(C.lds + L_PS); LAS unsigned* Mk = (LAS unsigned*)(C.lds + L_MSK); LAS unsigned* Uni = (LAS unsigned*)(C.lds + L_UNI); LAS int* List = (LAS int*)(C.lds + L_LIST);
    const int nv = t >= 31 ? ((t - 31) >> 4) + 1 : 0;
    const int nvt = (4 * i + 3 < 511) ? 4 * i + 3 : 511, ntc = (nvt + 63) >> 6;
    const bf16_t* kc = B.KC + (size_t)(0 * 4 + b * 2 + g) * 512 * 64; const bf16_t* vc = B.KC + (size_t)(1 * 4 + b * 2 + g) * 512 * 64;
    auto idxI = [&](int it) { return it; };
    auto srcC = [&](int it, int, const bf16_t*& kp, const bf16_t*& vp) { kp = kc + (size_t)it * 4096; vp = vc + (size_t)it * 4096; };
    auto mskC = [&](int it, int, int& klo, int& khi) { klo = 0; khi = nv - 1 - 64 * it; return khi < 63; };
    RowSt S; rowst_init(S);
    KVRegs R;
    run_branch<0>(C, ntc, idxI, srcC, mskC, qr, S, o, nullptr, false, R, false, kc, vc);
    const float lt = S.l + swap_other(S.l, hi);
    rowst_fixed(S, lt > 0.f ? S.m + __builtin_amdgcn_logf(lt) : 0.f);
    for (int e = C.tid; e < 64 * 128; e += 512) Ps[e] = 0.f;
    if (C.tid < 8) Uni[C.tid] = 0u;
    o[0] = f32x16{}; o[1] = f32x16{};
    run_branch<2>(C, ntc, idxI, srcC, mskC, qr, S, o, Ps + qi * 128, hh == 0, R, true, B.KV + 2 * KV_STRIDE + bg * 64, B.KV + 3 * KV_STRIDE + bg * 64);
    LBAR();
    {
        const int nf = cur == 0 ? 1 : (cur == 1 ? 2 : 3), kp_ = 16 - nf, lane = C.lane;
#pragma unroll 1
        for (int qq = 0; qq < 8; ++qq) {
            int q = 8 * wid + qq; asm volatile("" : "+s"(q)); LAS float* ps = Ps + q * 128;
            const int j0 = lane, j1 = lane + 64;
            const bool f0 = (j0 == 0 || j0 == cur || j0 == cur - 1) && j0 <= cur, f1 = (j1 == cur || j1 == cur - 1) && j1 <= cur;
            const bool va0 = j0 <= cur && !f0, va1 = j1 <= cur && !f1;
            const unsigned k0 = va0 ? __float_as_uint(ps[j0]) + 1u : 0u, k1 = va1 ? __float_as_uint(ps[j1]) + 1u : 0u;
            unsigned T = 0u;
            for (int bit = 30; bit >= 0; --bit) { const unsigned cand = T | (1u << bit); const int cnt = __popcll(__ballot(k0 >= cand)) + __popcll(__ballot(k1 >= cand)); if (cnt >= kp_) T = cand; }
            const int need = kp_ - (__popcll(__ballot(k0 > T)) + __popcll(__ballot(k1 > T)));
            const unsigned long long t0 = __ballot(k0 == T), t1 = __ballot(k1 == T), below = (1ull << lane) - 1ull;
            const int pre0 = __popcll(t0 & below), pre1 = __popcll(t0) + __popcll(t1 & below);
            const bool s0 = f0 || (k0 > 0u && (k0 > T || (k0 == T && pre0 < need))), s1 = f1 || (k1 > 0u && (k1 > T || (k1 == T && pre1 < need)));
            const unsigned long long b0 = __ballot(s0), b1 = __ballot(s1);
            if (lane == 0) { Mk[q * 4 + 0] = (unsigned)b0; Mk[q * 4 + 1] = (unsigned)(b0 >> 32); Mk[q * 4 + 2] = (unsigned)b1; Mk[q * 4 + 3] = (unsigned)(b1 >> 32);
                __hip_atomic_fetch_or(&Uni[0], (unsigned)b0, __ATOMIC_RELAXED, __HIP_MEMORY_SCOPE_WORKGROUP); __hip_atomic_fetch_or(&Uni[1], (unsigned)(b0 >> 32), __ATOMIC_RELAXED, __HIP_MEMORY_SCOPE_WORKGROUP); __hip_atomic_fetch_or(&Uni[2], (unsigned)b1, __ATOMIC_RELAXED, __HIP_MEMORY_SCOPE_WORKGROUP); __hip_atomic_fetch_or(&Uni[3], (unsigned)(b1 >> 32), __ATOMIC_RELAXED, __HIP_MEMORY_SCOPE_WORKGROUP); }
        }
    }
    LBAR();
    if (C.tid < 128) {
        const int wi = C.tid >> 5, bi = C.tid & 31; const unsigned u0 = Uni[0], u1 = Uni[1], u2 = Uni[2], u3 = Uni[3];
        const unsigned mine = wi == 0 ? u0 : wi == 1 ? u1 : wi == 2 ? u2 : u3;
        const int before = (wi > 0 ? __popc(u0) : 0) + (wi > 1 ? __popc(u1) : 0) + (wi > 2 ? __popc(u2) : 0) + __popc(mine & ((1u << bi) - 1u));
        if ((mine >> bi) & 1u) List[before] = C.tid;
        if (C.tid == 0) Uni[4] = (unsigned)(__popc(u0) + __popc(u1) + __popc(u2) + __popc(u3));
    }
    LBAR();
    merge_branch<true>(C, o, g0);
    {
        const int nsel = (int)Uni[4];
        const bf16_t* ks = B.KV + 2 * KV_STRIDE + bg * 64; const bf16_t* vs = B.KV + 3 * KV_STRIDE + bg * 64;
        auto idxS = [&](int it) { return List[it]; };
        auto srcS = [&](int, int j, const bf16_t*& kp, const bf16_t*& vp) { kp = ks + (size_t)j * 4096; vp = vs + (size_t)j * 4096; };
        auto mskS = [&](int, int j, int& klo, int& khi) { const unsigned w = Mk[qi * 4 + (j >> 5)]; const bool bit = (w >> (j & 31)) & 1u;
            klo = 0; khi = bit ? (j == cur ? qi : 63) : -1; return j == cur; };
        rowst_init(S); o[0] = f32x16{}; o[1] = f32x16{};
        const int tw0n = i >= 8 ? i - 8 : 0;
        run_branch<1>(C, nsel, idxS, srcS, mskS, qr, S, o, nullptr, false, R, true, B.KV + 4 * KV_STRIDE + bg * 64 + (size_t)tw0n * 4096, B.KV + 5 * KV_STRIDE + bg * 64 + (size_t)tw0n * 4096);
        merge_branch_n<false>(C, o, S.osum, g1);
    }
    {
        const int tw0 = i >= 8 ? i - 8 : 0, ntw = i - tw0 + 1;
        const bf16_t* kw = B.KV + 4 * KV_STRIDE + bg * 64; const bf16_t* vw = B.KV + 5 * KV_STRIDE + bg * 64;
        auto srcW = [&](int it, int, const bf16_t*& kp, const bf16_t*& vp) { kp = kw + (size_t)(tw0 + it) * 4096; vp = vw + (size_t)(tw0 + it) * 4096; };
        auto mskW = [&](int it, int, int& klo, int& khi) { const int tw = tw0 + it; klo = (t - 511) - 64 * tw; khi = (tw == i) ? qi : 63; return tw == i || klo > 0; };
        rowst_init(S); o[0] = f32x16{}; o[1] = f32x16{};
        run_branch<1>(C, ntw, idxI, srcW, mskW, qr, S, o, nullptr, false, R, true, nullptr, nullptr);
        merge_branch_n<false>(C, o, S.osum, g2);
    }
#pragma unroll
    for (int r = 0; r < 16; ++r) { const int qrow = crow(r, hi); bf16_t* dst = B.Abr + ((size_t)b * SEQ + 64 * i + 8 * wid + (qrow >> 2)) * DM + 256 + (g * 4 + (qrow & 3)) * 64 + r32;
        dst[0] = (bf16_t)(cvtpk(C.otl[r * 64], 0.f) & 0xffffu); dst[32] = (bf16_t)(cvtpk(C.otl[(16 + r) * 64], 0.f) & 0xffffu); }
}
__device__ __forceinline__ void moba_item(const Ctx& C, const Bufs& B, int b, int h, int qb) {
    const int r32 = C.r32, hi = C.hi, wid = C.wid, own = qb, t = 256 * qb + 32 * wid + r32;
    const size_t bh = (size_t)(b * 4 + h) * SEQ;
    bf16x8 qr[4];
    { const bf16_t* qp = B.Mo + (bh + t) * 64 + hi * 8;
#pragma unroll
      for (int d0 = 0; d0 < 4; ++d0) qr[d0] = *(const bf16x8*)(qp + d0 * 16); }
    LAS unsigned* Uni = (LAS unsigned*)(C.lds + L_UNI); LAS int* List = (LAS int*)(C.lds + L_LIST);
    LBAR();
    if (C.tid < 256) { const u32x4 kmv = *(const u32x4*)(B.KM + (size_t)(b * 4 + h) * 2048 + C.tid * 8); *(LAS u32x4*)(C.lds + L_K0 + (C.tid & 7) * KCS + (C.tid >> 3) * 16) = kmv; }
    if (C.tid == 0) Uni[0] = 0u;
    LBAR();
    unsigned sel = 0u;
    {
        f32x16 gs = f32x16{};
        const LAS char* kb = C.lds + L_K0 + hi * KCS + r32 * 16;
#pragma unroll
        for (int d0 = 0; d0 < 4; ++d0) gs = __builtin_amdgcn_mfma_f32_32x32x16_bf16(*(const LAS bf16x8*)(kb + d0 * 2 * KCS), qr[d0], gs, 0, 0, 0);
        float lo[16], hv[16];
#pragma unroll
        for (int r = 0; r < 16; ++r) { const float ownv = gs[r], oth = swap_other(ownv, hi); lo[r] = hi ? oth : ownv; hv[r] = hi ? ownv : oth; }
        unsigned taken = ~((1u << own) - 1u);
#pragma unroll
        for (int round = 0; round < 3; ++round) {
            float best = -INFINITY; int bi = 32;
#pragma unroll
            for (int n = 0; n < 32; ++n) { const int rr = (n & 3) + 4 * (n >> 3); const float v = ((n >> 2) & 1) ? hv[rr] : lo[rr]; if (!((taken >> n) & 1u) && v > best) { best = v; bi = n; } }
            if (bi < 32) { sel |= 1u << bi; taken |= 1u << bi; }
        }
    }
    { unsigned u = sel;
#pragma unroll
      for (int o_ = 1; o_ < 64; o_ <<= 1) u |= (unsigned)__shfl_xor((int)u, o_);
      if (C.lane == 0) __hip_atomic_fetch_or(&Uni[0], u, __ATOMIC_RELAXED, __HIP_MEMORY_SCOPE_WORKGROUP); }
    LBAR();
    if (C.tid == 0) { int n = 0; unsigned u = Uni[0]; while (u) { const int bpos = __builtin_ctz(u); u &= u - 1; List[n++] = bpos; } Uni[4] = (unsigned)n; }
    LBAR();
    const int nl = (int)Uni[4], nt = 4 * nl + 4;
    const bf16_t* kk = B.Mo + MO_STRIDE + bh * 64; const bf16_t* vv = B.Mo + 2 * MO_STRIDE + bh * 64;
    auto idxM = [&](int it) { return (it < 4 * nl) ? List[it >> 2] : own; };
    auto src = [&](int it, int blk, const bf16_t*& kp, const bf16_t*& vp) { const int T = 4 * blk + ((it < 4 * nl) ? (it & 3) : (it - 4 * nl)); kp = kk + (size_t)T * 4096; vp = vv + (size_t)T * 4096; };
    auto msk = [&](int it, int blk, int& klo, int& khi) { klo = 0; if (it < 4 * nl) { const bool bit = (sel >> blk) & 1u; khi = bit ? 63 : -1; return false; } khi = 32 * wid + r32 - 64 * (it - 4 * nl); return true; };
    RowSt S; rowst_init(S); f32x16 o[2] = {f32x16{}, f32x16{}};
    KVRegs R;
    run_branch<1>(C, nt, idxM, src, msk, qr, S, o, nullptr, false, R, false, nullptr, nullptr);
    merge_branch_n<true>(C, o, S.osum, 1.0f);
#pragma unroll
    for (int r = 0; r < 16; ++r) { const int qrow = crow(r, hi); bf16_t* dst = B.Abr + ((size_t)b * SEQ + 256 * qb + 32 * wid + qrow) * DM + 768 + h * 64 + r32;
        dst[0] = (bf16_t)(cvtpk(C.otl[r * 64], 0.f) & 0xffffu); dst[32] = (bf16_t)(cvtpk(C.otl[(16 + r) * 64], 0.f) & 0xffffu); }
}
}
#define XB_TMO      128
#define XB_XCNT(j)  (256  + 64 * (j))
#define XB_XSUB(j)  (1280 + 64 * (j))
#define XB_XGEN(j)  (2304 + 64 * (j))
#define XB_TOP      3328
#define XB_TOPGEN   3392
#define XCD_BAR_WORDS 3456
#define XB_SPIN_CAP (1u << 18)

__device__ __forceinline__ unsigned xb_ld(unsigned* p)              { return __hip_atomic_load(p, __ATOMIC_RELAXED, __HIP_MEMORY_SCOPE_AGENT); }
__device__ __forceinline__ unsigned xb_add(unsigned* p, unsigned v) { return __hip_atomic_fetch_add(p, v, __ATOMIC_RELAXED, __HIP_MEMORY_SCOPE_AGENT); }
__device__ __forceinline__ unsigned xb_xcc_id() { return (unsigned)__builtin_amdgcn_s_getreg((3 << 11) | 20) & 0xFu; }
#define XB_SPIN(cond, bar) do { unsigned _sp = 0; while (cond) { __builtin_amdgcn_s_sleep(1); \
    if ((++_sp & 255u) == 0u) { if (xb_ld(&(bar)[XB_TMO])) break; if (_sp > XB_SPIN_CAP) { atomicAdd(&(bar)[XB_TMO], 1u); break; } } } } while (0)

struct XcdBarrier {
    unsigned* bar; unsigned x;
    volatile LAS unsigned* st;
};

__device__ __forceinline__ XcdBarrier xcd_barrier_post(unsigned* bar, volatile LAS unsigned* st) {
    XcdBarrier b; b.bar = bar; b.x = xb_xcc_id(); b.st = st;
    if (threadIdx.x == 0) (void)xb_add(&bar[XB_XCNT(b.x)], 1u);
    return b;
}
__device__ __forceinline__ void xcd_barrier_complete(unsigned* bar, unsigned x, unsigned& nloc, unsigned& nx) {
    const unsigned G = gridDim.x * gridDim.y * gridDim.z;
    unsigned sum, cnt, mine, sp = 0u;
    for (;;) {
        sum = 0u; cnt = 0u; mine = 0u;
#pragma unroll
        for (unsigned j = 0; j < 16; ++j) { const unsigned c = xb_ld(&bar[XB_XCNT(j)]); sum += c; cnt += (c > 0u) ? 1u : 0u; mine = (j == x) ? c : mine; }
        if (sum == G) break;
        __builtin_amdgcn_s_sleep(1);
        if ((++sp & 255u) == 0u) { if (xb_ld(&bar[XB_TMO])) break; if (sp > XB_SPIN_CAP) { atomicAdd(&bar[XB_TMO], 1u); break; } }
    }
    nloc = mine > 0u ? mine : 1u; nx = cnt > 0u ? cnt : 1u;
}

__device__ __forceinline__ void xcd_barrier(const XcdBarrier& b) {
    asm volatile("s_waitcnt vmcnt(0)" ::: "memory");
    __syncthreads();
    if (threadIdx.x == 0) {
        unsigned* bar = b.bar;
        __builtin_amdgcn_s_waitcnt(0);
        unsigned nloc = b.st[0], nx = b.st[1];
        if (nloc == 0u) { xcd_barrier_complete(bar, b.x, nloc, nx); b.st[0] = nloc; b.st[1] = nx; }
        const unsigned old = xb_add(&bar[XB_XSUB(b.x)], 1u);
        const unsigned gen = old / nloc;
        if (old + 1u == (gen + 1u) * nloc) {
            __builtin_amdgcn_fence(__ATOMIC_RELEASE, "agent");
            asm volatile("s_waitcnt vmcnt(0)" ::: "memory");
            const unsigned og = xb_add(&bar[XB_TOP], 1u);
            const unsigned tg = og / nx;
            if (og + 1u == (tg + 1u) * nx) xb_add(&bar[XB_TOPGEN], 1u);
            else XB_SPIN(xb_ld(&bar[XB_TOPGEN]) == tg, bar);
            __builtin_amdgcn_fence(__ATOMIC_ACQUIRE, "agent");
            xb_add(&bar[XB_XGEN(b.x)], 1u);
            asm volatile("s_waitcnt vmcnt(0)" ::: "memory");
        } else {
            XB_SPIN(xb_ld(&bar[XB_XGEN(b.x)]) == gen, bar);
            __builtin_amdgcn_fence(__ATOMIC_ACQUIRE, "agent");
            asm volatile("s_waitcnt vmcnt(0)" ::: "memory");
        }
    }
    __syncthreads();
}

constexpr size_t MiB = 1u << 20;
constexpr size_t WS_CTL = 0, WS_ORDER = 4096, WS_BAR = 8192;
constexpr size_t WS_W = 1 * MiB, OFF_WIN = 0, OFF_WGU = 11 * MiB, OFF_WD = 22 * MiB, OFF_WBR = 28 * MiB, OFF_WOUT = 30 * MiB, OFF_W1 = 32 * MiB, OFF_W2 = 34 * MiB,
                 OFF_BIN = 34 * MiB + 65536, OFF_CB1 = OFF_BIN + 32768  , OFF_CB2 = OFF_CB1 + 65536;
constexpr size_t WS_TAB = 36 * MiB, WS_SSP = 38 * MiB, WS_KC = 39 * MiB, WS_KM = 39 * MiB + 512 * 1024, WS_GN = 40 * MiB, WS_XB = 42 * MiB, WS_BIG = 74 * MiB,
                 WS_U = 170 * MiB, WS_QN = 178 * MiB, WS_KV = 194 * MiB, WS_MO = 218 * MiB, WS_MRG = 178 * MiB, WS_END = 242 * MiB;
constexpr int LDS_BYTES = 147456;

__device__ __forceinline__ int dint(int pos) { return (pos >> 1) + 32 * (pos & 1); }
__device__ __forceinline__ int in_orig(int c) {
    if (c < 256) return c;
    if (c < 768) { const int c2 = c - 256; return 256 + (c2 >> 6) * 64 + dint(c2 & 63); }
    if (c < 1536) { const int c2 = c - 768, tt = c2 >> 8, bj = (c2 >> 7) & 1, g = (c2 >> 6) & 1, pos = c2 & 63; return 768 + (2 * tt + bj) * 128 + g * 64 + (bj == 0 ? dint(pos) : pos); }
    if (c < 2304) { const int c2 = c - 1536, part = c2 >> 8, h = (c2 >> 6) & 3, pos = c2 & 63; return 1560 + part * 256 + h * 64 + (part < 2 ? dint(pos) : pos); }
    if (c < 5376) return 2328 + (c - 2304);
    const int c2 = c - 5376; return c2 < 24 ? 1536 + c2 : -1;
}
template <class F> __device__ __forceinline__ void cvt_tile(LAS float* scr, int lane, int k0, int n0, bf16_t* dst, size_t pitch, F f) {
    float vals[32];
#pragma unroll
    for (int i = 0; i < 32; ++i) vals[i] = f(k0 + 2 * i + (lane >> 5), n0 + (lane & 31));
#pragma unroll
    for (int i = 0; i < 32; ++i) scr[(2 * i + (lane >> 5)) * 33 + (lane & 31)] = vals[i];
    asm volatile("s_waitcnt lgkmcnt(0)" ::: "memory");
    const int c = lane & 7;
#pragma unroll
    for (int j = 0; j < 4; ++j) { const int n = (lane >> 3) + 8 * j; const LAS float* s = scr + (8 * c) * 33 + n;
        u32x4 o; o.x = cvtpk(s[0 * 33], s[1 * 33]); o.y = cvtpk(s[2 * 33], s[3 * 33]); o.z = cvtpk(s[4 * 33], s[5 * 33]); o.w = cvtpk(s[6 * 33], s[7 * 33]);
        *(u32x4*)(dst + (size_t)(n0 + n) * pitch + k0 + 8 * c) = o; }
    asm volatile("s_waitcnt lgkmcnt(0)" ::: "memory");
}
template <class F> __device__ __forceinline__ void cvt_tile_scaled(LAS float* scr, int lane, int k0, int n0, bf16_t* dst, size_t pitch, F f, const float* scale, float keep) {
    float vals[32], sc[32];
#pragma unroll
    for (int i = 0; i < 32; ++i) { vals[i] = f(k0 + 2 * i + (lane >> 5), n0 + (lane & 31)); sc[i] = scale[k0 + 2 * i + (lane >> 5)]; }
    __builtin_amdgcn_sched_barrier(0);
#pragma unroll
    for (int i = 0; i < 32; ++i) scr[(2 * i + (lane >> 5)) * 33 + (lane & 31)] = vals[i] * (sc[i] * keep);
    asm volatile("s_waitcnt lgkmcnt(0)" ::: "memory");
    const int c = lane & 7;
#pragma unroll
    for (int j = 0; j < 4; ++j) { const int n = (lane >> 3) + 8 * j; const LAS float* s = scr + (8 * c) * 33 + n;
        u32x4 o; o.x = cvtpk(s[0 * 33], s[1 * 33]); o.y = cvtpk(s[2 * 33], s[3 * 33]); o.z = cvtpk(s[4 * 33], s[5 * 33]); o.w = cvtpk(s[6 * 33], s[7 * 33]);
        *(u32x4*)(dst + (size_t)(n0 + n) * pitch + k0 + 8 * c) = o; }
    asm volatile("s_waitcnt lgkmcnt(0)" ::: "memory");
}
struct Args { const float* in[20]; float* out; unsigned char* ws; };
typedef const __attribute__((address_space(4))) Args* ArgsP;

__device__ __forceinline__ void phase0(ArgsP a, int l, LAS unsigned char* lds, int tid, int lane, int wave, int gw, int NGW) {
    unsigned char* ws = a->ws;
    LAS float* scr = (LAS float*)(lds + wave * 8704);
    const float* attn_norm = a->in[1] + (size_t)l * DM; const float* w_in = a->in[2] + (size_t)l * DM * IN_COLS; const float* b_in = a->in[3] + (size_t)l * IN_COLS;
    const float* pool_w = a->in[4] + (size_t)l * 4 * 64 * 64; const float* pool_scale = a->in[5] + (size_t)l * 256; const float* cmp_pos = a->in[6] + (size_t)l * 2 * 32 * 64;
    const float* cmp_w1 = a->in[7] + (size_t)l * 2 * 2048 * 256; const float* cmp_b1 = a->in[8] + (size_t)l * 2 * 256; const float* cmp_w2 = a->in[9] + (size_t)l * 2 * 256 * 64; const float* cmp_b2 = a->in[10] + (size_t)l * 2 * 64;
    const float* w_br_pool = a->in[11] + (size_t)l * 256 * DM; const float* w_br_nsa = a->in[12] + (size_t)l * 512 * DM; const float* w_br_moba = a->in[13] + (size_t)l * 256 * DM;
    const float* w_out = a->in[14] + (size_t)l * DM * DM; const float* ffn_norm = a->in[15] + (size_t)l * DM; const float* w_gate = a->in[16] + (size_t)l * DM * DFF; const float* w_up = a->in[17] + (size_t)l * DM * DFF;
    const float* w_down = a->in[18] + (size_t)l * DFF * DM;
    bf16_t* Win = (bf16_t*)(ws + WS_W + OFF_WIN); bf16_t* Wgu = (bf16_t*)(ws + WS_W + OFF_WGU); bf16_t* Wd = (bf16_t*)(ws + WS_W + OFF_WD); bf16_t* Wbr = (bf16_t*)(ws + WS_W + OFF_WBR);
    bf16_t* Wout = (bf16_t*)(ws + WS_W + OFF_WOUT); bf16_t* W1t = (bf16_t*)(ws + WS_W + OFF_W1); bf16_t* W2t = (bf16_t*)(ws + WS_W + OFF_W2);
    float* bin = (float*)(ws + WS_W + OFF_BIN); float* cb1 = (float*)(ws + WS_W + OFF_CB1); float* cb2 = (float*)(ws + WS_W + OFF_CB2);
    constexpr int I_A = 16 * 176, I_B = 16 * 176, I_C = 44 * 32, I_D = 16 * 32, I_E = 16 * 32, I_F = 2 * 32 * 8, I_G = 2 * 4 * 2;
    constexpr int NITEMS = I_A + I_B + I_C + I_D + I_E + I_F + I_G;
    for (int it = gw; it < NITEMS; it += NGW) {
        int r = it;
        if (r < I_A) { const int kb = r / 176, nb = r % 176; { const int o = in_orig(32 * nb + (lane & 31)); const float* wc = w_in + (o >= 0 ? o : 0); const float keep = o >= 0 ? 1.f : 0.f;
            cvt_tile_scaled(scr, lane, 64 * kb, 32 * nb, Win, DM, [&](int k, int) { return wc[(size_t)k * IN_COLS]; }, attn_norm, keep); } continue; } r -= I_A;
        if (r < I_B) { const int kb = r / 176, nb = r % 176; { const int n = 32 * nb + (lane & 31), j = (n >> 8) * 128 + (n & 127); const float* wc = (((n >> 7) & 1) ? w_up : w_gate) + j;
            cvt_tile_scaled(scr, lane, 64 * kb, 32 * nb, Wgu, DM, [&](int k, int) { return wc[(size_t)k * DFF]; }, ffn_norm, 1.f); } continue; } r -= I_B;
        if (r < I_C) { const int kb = r / 32, nb = r % 32; cvt_tile(scr, lane, 64 * kb, 32 * nb, Wd, DFF, [&](int k, int n) { return w_down[(size_t)k * DM + n]; }); continue; } r -= I_C;
        if (r < I_D) { const int kb = r / 32, nb = r % 32; cvt_tile(scr, lane, 64 * kb, 32 * nb, Wout, DM, [&](int k, int n) { return w_out[(size_t)k * DM + n]; }); continue; } r -= I_D;
        if (r < I_E) { const int kb = r / 32, nb = r % 32;
            if (kb < 4) { }
            else if (kb < 12) cvt_tile(scr, lane, 64 * kb, 32 * nb, Wbr, DM, [&](int k, int n) { return w_br_nsa[(size_t)(k - 256) * DM + n]; });
            else cvt_tile(scr, lane, 64 * kb, 32 * nb, Wbr, DM, [&](int k, int n) { return w_br_moba[(size_t)(k - 768) * DM + n]; });
            continue; } r -= I_E;
        if (r < I_F) { const int kv = r >> 8, kb = (r >> 3) & 31, nb = r & 7; const float* w1 = cmp_w1 + (size_t)kv * 2048 * 256;
            cvt_tile(scr, lane, 64 * kb, 32 * nb, W1t + (size_t)kv * 256 * 2048, 2048, [&](int k, int n) { const int pos = k & 63, d = kv == 0 ? dint(pos) : pos; return w1[(size_t)((k & ~63) + d) * 256 + n]; }); continue; } r -= I_F;
        { const int kv = r >> 3, kb = (r >> 1) & 3, nb = r & 1; const float* w2 = cmp_w2 + (size_t)kv * 256 * 64;
            cvt_tile(scr, lane, 64 * kb, 32 * nb, W2t + (size_t)kv * 64 * 256, 256, [&](int k, int n) { return w2[(size_t)k * 64 + (kv == 0 ? dint(n) : n)]; }); }
    }
    const int gt = gw * 64 + lane, NGT = NGW * 64;
    for (int c = gt; c < NIN; c += NGT) { const int o = in_orig(c); bin[c] = o >= 0 ? b_in[o] : 0.f; }
    for (int idx = gt; idx < 32 * 512; idx += NGT) { const int c = idx >> 9, e = idx & 511, kv = e >> 8, n = e & 255; const float* w1 = cmp_w1 + (size_t)kv * 2048 * 256 + (size_t)(64 * c) * 256 + n; const float* pe = cmp_pos + (size_t)kv * 2048 + 64 * c;
        float s = c == 0 ? cmp_b1[kv * 256 + n] : 0.f;
#pragma unroll
        for (int k0 = 0; k0 < 64; k0 += 32) { float av[32], bv[32];
#pragma unroll
            for (int k = 0; k < 32; ++k) { av[k] = pe[k0 + k]; bv[k] = w1[(size_t)(k0 + k) * 256]; }
            __builtin_amdgcn_sched_barrier(0);
#pragma unroll
            for (int k = 0; k < 32; ++k) s += av[k] * bv[k]; }
        cb1[idx] = s; }
    for (int idx = gt; idx < 256 * DM; idx += NGT) { const int k = idx >> 10, n = idx & 1023, g64 = k & ~63; float s = 0.f;
        const f32x4* pw4 = (const f32x4*)(pool_w + (size_t)k * 64); const f32x4* ps4 = (const f32x4*)(pool_scale + g64);
#pragma unroll
        for (int j0 = 0; j0 < 64; j0 += 32) { f32x4 pw[8], psc[8]; float wb[32];
#pragma unroll
            for (int q = 0; q < 8; ++q) { pw[q] = pw4[j0 / 4 + q]; psc[q] = ps4[j0 / 4 + q]; }
#pragma unroll
            for (int j = 0; j < 32; ++j) wb[j] = w_br_pool[(size_t)(g64 + j0 + j) * DM + n];
            __builtin_amdgcn_sched_barrier(0);
#pragma unroll
            for (int j = 0; j < 32; ++j) s += pw[j >> 2][j & 3] * psc[j >> 2][j & 3] * wb[j]; }
        Wbr[(size_t)n * DM + k] = (bf16_t)(cvtpk(s, 0.f) & 0xffffu); }
    for (int e = gt; e < 128; e += NGT) { const int kv = e >> 6, n = e & 63; cb2[e] = cmp_b2[kv * 64 + (kv == 0 ? dint(n) : n)]; }
    if (l == 0) {
        float* tab = (float*)(ws + WS_TAB);
        for (int e = gt; e < SEQ * 32; e += NGT) { const int t = e >> 5, f = e & 31; const float inv = powf(10000.0f, -(float)(2 * f) / 64.0f); const float ang = (float)t * inv;
            const double ad = (double)ang, kq = rint(ad * 0.15915494309189535); double rr = fma(-kq, 6.283185307179586, ad); rr = fma(-kq, 2.4492935982947064e-16, rr);
            const float rf = (float)rr; tab[2 * e] = __cosf(rf); tab[2 * e + 1] = __sinf(rf); }
        const float* x = a->in[0]; bf16_t* xb = (bf16_t*)(ws + WS_XB); float* ssp = (float*)(ws + WS_SSP);
        for (int m0 = 2 * gw; m0 < MTOK; m0 += 2 * NGW) { f32x4 v[2][4]; float s[2] = {0.f, 0.f};
#pragma unroll
            for (int q = 0; q < 2; ++q) { const f32x4* xr = (const f32x4*)(x + (size_t)(m0 + q) * DM) + lane;
#pragma unroll
                for (int j = 0; j < 4; ++j) v[q][j] = xr[64 * j]; }
#pragma unroll
            for (int q = 0; q < 2; ++q) {
#pragma unroll
                for (int j = 0; j < 4; ++j) s[q] += (v[q][j][0] * v[q][j][0] + v[q][j][1] * v[q][j][1]) + (v[q][j][2] * v[q][j][2] + v[q][j][3] * v[q][j][3]);
#pragma unroll
                for (int o = 1; o < 64; o <<= 1) s[q] += __shfl_xor(s[q], o);
                u32x2* o8 = (u32x2*)(xb + (size_t)(m0 + q) * DM) + lane;
#pragma unroll
                for (int j = 0; j < 4; ++j) o8[64 * j] = (u32x2){cvtpk(v[q][j][0], v[q][j][1]), cvtpk(v[q][j][2], v[q][j][3])};
                if (lane < 16) ssp[(size_t)(m0 + q) * 16 + lane] = lane == 0 ? s[q] : 0.f; } }
        int* order = (int*)(ws + WS_ORDER);
        auto cost = [](int id) { if (id < 512) { const int i = id & 127; return 10 * ((i + 1) + ((i < 8 ? i : 8) + 1) + 10) + 16 * ((4 * i + 3 + 63) >> 6); } const int qb = (id - 512) & 31; return 7 * (4 * qb + 3) + 50; };
        for (int id = gw; id < 768; id += NGW) { const int mc = cost(id); int rk = 0;
            for (int j = lane; j < 768; j += 64) { const int cj = cost(j); rk += (cj > mc || (cj == mc && j < id)) ? 1 : 0; }
#pragma unroll
            for (int o = 1; o < 64; o <<= 1) rk += __shfl_xor(rk, o);
            if (lane == 0) order[rk] = id; }
    }
}
__device__ __forceinline__ float gelu_tanh(float x) { const float u = 0.7978845608028654f * (x + 0.044715f * x * x * x); const float th = 1.f - 2.f * __builtin_amdgcn_rcpf(1.f + __expf(2.f * u)); return 0.5f * x * (1.f + th); }
__device__ __forceinline__ void phase2(ArgsP a, LAS unsigned char* lds, int tid, int lane, int wave, int G) {
    unsigned char* ws = a->ws;
    const bf16_t* KV = (const bf16_t*)(ws + WS_KV); const bf16_t* W1t = (const bf16_t*)(ws + WS_W + OFF_W1); const bf16_t* W2t = (const bf16_t*)(ws + WS_W + OFF_W2);
    const float* cb1 = (const float*)(ws + WS_W + OFF_CB1); const float* cb2 = (const float*)(ws + WS_W + OFF_CB2);
    bf16_t* KC = (bf16_t*)(ws + WS_KC);
    LAS bf16_t* hid = (LAS bf16_t*)lds;
    const int arow = lane & 15, kq = lane >> 4;
    for (int task = blockIdx.x; task < 256; task += G) {
        const int kv = task >> 7, bgi = (task >> 5) & 3, nt = task & 31;
        const bf16_t* src = KV + (size_t)kv * att::KV_STRIDE + (size_t)bgi * SEQ * 64;
        const int nrow = 16 * nt + arow, neff = nrow < 510 ? nrow : 510;
        const bf16_t* ap = src + (size_t)neff * 1024 + kq * 8;
        const bf16_t* bp0 = W1t + (size_t)kv * 256 * 2048 + (size_t)(32 * wave + arow) * 2048 + kq * 8; const bf16_t* bp1 = bp0 + 16 * 2048;
        f32x4 c0 = {0.f, 0.f, 0.f, 0.f}, c1 = {0.f, 0.f, 0.f, 0.f};
        float bb0 = 0.f, bb1 = 0.f;
        { const int col0 = 32 * wave + arow; float t0[32], t1[32];
#pragma unroll
          for (int c = 0; c < 32; ++c) { t0[c] = cb1[c * 512 + kv * 256 + col0]; t1[c] = cb1[c * 512 + kv * 256 + col0 + 16]; }
          __builtin_amdgcn_sched_barrier(0);
#pragma unroll
          for (int c = 0; c < 32; ++c) { bb0 += t0[c]; bb1 += t1[c]; } }
#pragma unroll 1
        for (int ks0 = 0; ks0 < 64; ks0 += 8) { bf16x8 av[8], b0[8], b1[8];
#pragma unroll
            for (int q = 0; q < 8; ++q) { av[q] = *(const bf16x8*)(ap + (ks0 + q) * 32); b0[q] = *(const bf16x8*)(bp0 + (ks0 + q) * 32); b1[q] = *(const bf16x8*)(bp1 + (ks0 + q) * 32); }
            __builtin_amdgcn_sched_barrier(0);
#pragma unroll
            for (int q = 0; q < 8; ++q) { c0 = __builtin_amdgcn_mfma_f32_16x16x32_bf16(av[q], b0[q], c0, 0, 0, 0); c1 = __builtin_amdgcn_mfma_f32_16x16x32_bf16(av[q], b1[q], c1, 0, 0, 0); } }
        { const int col0 = 32 * wave + arow;
#pragma unroll
          for (int j = 0; j < 4; ++j) { const int row = kq * 4 + j; hid[row * 264 + col0] = (bf16_t)(cvtpk(gelu_tanh(c0[j] + bb0), 0.f) & 0xffffu); hid[row * 264 + col0 + 16] = (bf16_t)(cvtpk(gelu_tanh(c1[j] + bb1), 0.f) & 0xffffu); } }
        LBAR();
        if (wave < 4) {
            const bf16_t* bp = W2t + (size_t)kv * 64 * 256 + (size_t)(16 * wave + arow) * 256 + kq * 8; f32x4 c = {0.f, 0.f, 0.f, 0.f};
            bf16x8 bv[8];
#pragma unroll
            for (int ks = 0; ks < 8; ++ks) bv[ks] = *(const bf16x8*)(bp + ks * 32);
            __builtin_amdgcn_sched_barrier(0);
#pragma unroll
            for (int ks = 0; ks < 8; ++ks) { const bf16x8 av = *(const LAS bf16x8*)(hid + arow * 264 + kq * 8 + ks * 32); c = __builtin_amdgcn_mfma_f32_16x16x32_bf16(av, bv[ks], c, 0, 0, 0); }
            const int col = 16 * wave + arow; const float bb = cb2[kv * 64 + col];
#pragma unroll
            for (int j = 0; j < 4; ++j) { const int n = 16 * nt + kq * 4 + j; KC[((size_t)(kv * 4 + bgi) * 512 + n) * 64 + col] = n < 511 ? (bf16_t)(cvtpk(c[j] + bb, 0.f) & 0xffffu) : (bf16_t)0; }
        }
        LBAR();
    }
    const int gt = blockIdx.x * 512 + tid, NGT = G * 512;
    { const bf16_t* MoK = (const bf16_t*)(ws + WS_MO) + att::MO_STRIDE; bf16_t* KM = (bf16_t*)(ws + WS_KM); LAS float* part = (LAS float*)(lds + 16384);
      for (int blk = blockIdx.x; blk < 256; blk += G) { const bf16_t* p = MoK + ((size_t)blk * 256 + 32 * wave) * 64 + lane; float s = 0.f;
#pragma unroll
          for (int r0 = 0; r0 < 32; r0 += 16) { unsigned short tv[16];
#pragma unroll
              for (int r = 0; r < 16; ++r) tv[r] = p[(size_t)(r0 + r) * 64];
              __builtin_amdgcn_sched_barrier(0);
#pragma unroll
              for (int r = 0; r < 16; ++r) s += __uint_as_float((unsigned)tv[r] << 16); }
          part[wave * 64 + lane] = s;
          LBAR();
          if (wave == 0) { float t = 0.f;
#pragma unroll
              for (int w = 0; w < 8; ++w) t += part[w * 64 + lane];
              KM[(size_t)blk * 64 + lane] = (bf16_t)(cvtpk(t * (1.0f / 256.0f), 0.f) & 0xffffu); }
          LBAR(); } }
    { const bf16_t* U = (const bf16_t*)(ws + WS_U); bf16_t* Abr = (bf16_t*)(ws + WS_XB);
      for (int e = gt; e < MTOK * 32; e += NGT) { const int row = e >> 5, c8 = e & 31, s = row & (SEQ - 1), w = 2 << (c8 >> 3), cnt = (s + 1 < w) ? s + 1 : w;
          float acc[8] = {0.f, 0.f, 0.f, 0.f, 0.f, 0.f, 0.f, 0.f}; u32x4 v0 = {0u, 0u, 0u, 0u};
#pragma unroll
          for (int i0 = 0; i0 < 16; i0 += 8) { if (i0 >= cnt) break; u32x4 v[8];
#pragma unroll
              for (int i = 0; i < 8; ++i) v[i] = (i0 + i < cnt) ? *(const u32x4*)(U + (size_t)(row - i0 - i) * 256 + c8 * 8) : (u32x4){0u, 0u, 0u, 0u};
              __builtin_amdgcn_sched_barrier(0);
              if (i0 == 0) v0 = v[0];
#pragma unroll
              for (int i = 0; i < 8; ++i)
#pragma unroll
                  for (int q = 0; q < 4; ++q) { acc[2 * q] += bflo(v[i][q]); acc[2 * q + 1] += bfhi(v[i][q]); } }
          const float ic = 1.0f / (float)cnt; u32x4 o;
#pragma unroll
          for (int q = 0; q < 4; ++q) o[q] = cvtpk(acc[2 * q] * ic - bflo(v0[q]), acc[2 * q + 1] * ic - bfhi(v0[q]));
          *(u32x4*)(Abr + (size_t)row * DM + c8 * 8) = o; } }
}
__global__ void __launch_bounds__(512, 2) fwd_megakernel(Args a) {
    extern __shared__ __attribute__((aligned(16))) unsigned char lds_raw[];
    LAS unsigned char* lds = (LAS unsigned char*)lds_raw;
    cg::grid_group grid = cg::this_grid();
    const int G = gridDim.x;
    volatile LAS unsigned* bst = (volatile LAS unsigned*)(lds + LDS_BYTES - 64);
    if (threadIdx.x < 16) bst[threadIdx.x] = 0u;
    __syncthreads();
    const ArgsP ap0 = (ArgsP)__builtin_amdgcn_kernarg_segment_ptr();
#define PHASE_ARGS ArgsP a_ = ap0; asm volatile("" : "+s"(a_)); unsigned char* ws = a_->ws; unsigned* ctl = (unsigned*)(ws + WS_CTL); float* ssp = (float*)(ws + WS_SSP); const float* tab = (const float*)(ws + WS_TAB); \
    bf16_t* XB = (bf16_t*)(ws + WS_XB); bf16_t* BIG = (bf16_t*)(ws + WS_BIG); bf16_t* MRG = (bf16_t*)(ws + WS_MRG); (void)ctl; (void)ssp; (void)tab; (void)XB; (void)BIG; (void)MRG;
    XcdBarrier xbar = xcd_barrier_post((unsigned*)(ap0->ws + WS_BAR), bst);
    bool first_sync = true;
#define GRID_SYNC() do { if (first_sync) { grid.sync(); first_sync = false; } else xcd_barrier(xbar); } while (0)
    for (int l = 0; l < DEPTH; ++l) {
        int tid_ = threadIdx.x; asm volatile("" : "+v"(tid_));
        const int tid = tid_, lane = tid & 63, wave = __builtin_amdgcn_readfirstlane(tid >> 6), gw = blockIdx.x * 8 + wave, NGW = G * 8;
        { PHASE_ARGS phase0(a_, l, lds, tid, lane, wave, gw, NGW); }
        GRID_SYNC();
        { PHASE_ARGS pg8::Gemm g{XB, (const bf16_t*)(ws + WS_W + OFF_WIN), MTOK, NIN, DM}; pg8::StaticOrder S; S.init(MTOK, NIN, G, (int)blockIdx.x);
          EpiInProj E{ssp, (const float*)(ws + WS_W + OFF_BIN), tab, (bf16_t*)(ws + WS_U), (bf16_t*)(ws + WS_QN), (bf16_t*)(ws + WS_KV), (bf16_t*)(ws + WS_MO), BIG, (bf16_t*)(ws + WS_GN)};
          pg8::gemm_phase(lds, g, S, E); }
        GRID_SYNC();
        { PHASE_ARGS phase2(a_, lds, tid, lane, wave, G); }
        GRID_SYNC();
        { PHASE_ARGS
          att::Bufs B{(const bf16_t*)(ws + WS_QN), (const bf16_t*)(ws + WS_KV), (const bf16_t*)(ws + WS_MO), (const bf16_t*)(ws + WS_KC), (const bf16_t*)(ws + WS_KM), (const bf16_t*)(ws + WS_GN), XB};
          const int* order = (const int*)(ws + WS_ORDER); LAS int* slot = (LAS int*)(lds + att::L_END);
          if (wave >= 4) __builtin_amdgcn_s_setprio(1);
          for (;;) {
              LBAR();
              if (tid == 0) slot[0] = (int)atomicAdd(ctl + l, 1u);
              LBAR();
              const int item = slot[0];
              if (item >= 768) break;
              const int id = order[item];
              int tl = threadIdx.x; asm volatile("" : "+v"(tl));
              const int tid = tl, lane = tid & 63, wave = __builtin_amdgcn_readfirstlane(tid >> 6);
              att::Ctx C; C.lds = (LAS char*)lds; C.wsf = (LAS float*)(lds + att::L_WSF) + wave * 64; C.otl = (LAS float*)(lds + att::L_OT) + wave * 2048 + lane; C.tid = tid; C.wid = wave; C.lane = lane; C.r32 = lane & 31; C.hi = lane >> 5;
              C.vbl = ((lane >> 4) & 1) * 32 + (lane & 3) * 8 + (4 * (lane >> 5) + ((lane & 15) >> 2)) * 64;
              if (id < 512) att::nsa_item(C, B, id >> 8, (id >> 7) & 1, id & 127);
              else { const int x = id - 512; att::moba_item(C, B, x >> 7, (x >> 5) & 3, x & 31); }
          }
          __builtin_amdgcn_s_setprio(0); }
        GRID_SYNC();
        { PHASE_ARGS pg8::Gemm g{XB, (const bf16_t*)(ws + WS_W + OFF_WBR), MTOK, DM, DM}; pg8::StaticOrder S; S.init(MTOK, DM, G, (int)blockIdx.x);
          EpiBranch E{BIG, MRG}; pg8::gemm_phase(lds, g, S, E); }
        GRID_SYNC();
        { PHASE_ARGS pg8::Gemm g{MRG, (const bf16_t*)(ws + WS_W + OFF_WOUT), MTOK, DM, DM}; pg8::StaticOrder S; S.init(MTOK, DM, G, (int)blockIdx.x);
          bf16_t* RES = (bf16_t*)a_->out; EpiResid E{l == 0 ? a_->in[0] : nullptr, RES, XB, nullptr, ssp};   pg8::gemm_phase(lds, g, S, E); }
        GRID_SYNC();
        { PHASE_ARGS pg8::Gemm g{XB, (const bf16_t*)(ws + WS_W + OFF_WGU), MTOK, NGU, DM}; pg8::StaticOrder S; S.init(MTOK, NGU, G, (int)blockIdx.x);
          EpiSwiGLU E{ssp, BIG}; pg8::gemm_phase(lds, g, S, E); }
        GRID_SYNC();
        { PHASE_ARGS pg8::Gemm g{BIG, (const bf16_t*)(ws + WS_W + OFF_WD), MTOK, DM, DFF}; pg8::StaticOrder S; S.init(MTOK, DM, G, (int)blockIdx.x);
          bf16_t* RES = (bf16_t*)a_->out; EpiResid E{nullptr, XB, XB, l + 1 < DEPTH ? RES : nullptr, ssp};   pg8::gemm_phase(lds, g, S, E); }
        GRID_SYNC();
    }
    { PHASE_ARGS const float* fn = a_->in[19]; float* outp = a_->out; const int lane = threadIdx.x & 63, gw = blockIdx.x * 8 + (threadIdx.x >> 6), NGW = G * 8;
      const f32x4* gr = (const f32x4*)fn + lane; f32x4 gv[4];
#pragma unroll
      for (int j = 0; j < 4; ++j) gv[j] = gr[64 * j];
      for (int m0 = 2 * gw; m0 < MTOK; m0 += 2 * NGW) { u32x2 w[2][4]; float rstd[2];
#pragma unroll
          for (int q = 0; q < 2; ++q) { const u32x2* xr = (const u32x2*)(XB + (size_t)(m0 + q) * DM) + lane; rstd[q] = row_rstd(ssp, m0 + q);
#pragma unroll
              for (int j = 0; j < 4; ++j) w[q][j] = xr[64 * j]; }
#pragma unroll
          for (int q = 0; q < 2; ++q) { f32x4* orow = (f32x4*)(outp + (size_t)(m0 + q) * DM) + lane;
#pragma unroll
              for (int j = 0; j < 4; ++j) { const f32x4 v = {bflo(w[q][j][0]), bfhi(w[q][j][0]), bflo(w[q][j][1]), bfhi(w[q][j][1])}; orow[64 * j] = v * rstd[q] * gv[j]; } } } }
}

extern "C" void kernel_launch(void* const* d_in, const int* in_sizes, int n_in, void* d_out, int out_size, void* d_ws, size_t ws_size, hipStream_t stream) {
    static int grid = 0;
    if (grid == 0) {
        if (n_in != 20 || in_sizes[0] != MTOK * DM || out_size != MTOK * DM || ws_size < WS_END) { fprintf(stderr, "kernel_launch: unexpected shapes / workspace (n_in %d, ws %zu)\n", n_in, ws_size); grid = -1; return; }
        int dev = 0, cus = 0, per_cu = 0;
        if (hipGetDevice(&dev) != hipSuccess || hipDeviceGetAttribute(&cus, hipDeviceAttributeMultiprocessorCount, dev) != hipSuccess) { grid = -1; return; }
        if (hipFuncSetAttribute((const void*)fwd_megakernel, hipFuncAttributeMaxDynamicSharedMemorySize, LDS_BYTES) != hipSuccess) { fprintf(stderr, "kernel_launch: hipFuncSetAttribute failed\n"); grid = -1; return; }
        if (hipOccupancyMaxActiveBlocksPerMultiprocessor(&per_cu, (const void*)fwd_megakernel, 512, LDS_BYTES) != hipSuccess || per_cu < 1) { fprintf(stderr, "kernel_launch: occupancy query failed (%d)\n", per_cu); (void)hipGetLastError(); grid = -1; return; }
        grid = cus * per_cu;
    }
    if (grid < 0) return;
    if (hipMemsetAsync((char*)d_ws + WS_CTL, 0, 32768, stream) != hipSuccess) { fprintf(stderr, "kernel_launch: memset failed\n"); return; }
    Args a{};
    for (int i = 0; i < 20; ++i) a.in[i] = (const float*)d_in[i];
    a.out = (float*)d_out; a.ws = (unsigned char*)d_ws;
    void* args[] = {&a};
    const hipError_t e = hipLaunchCooperativeKernel((const void*)fwd_megakernel, dim3(grid), dim3(512), args, LDS_BYTES, stream);
    if (e != hipSuccess) fprintf(stderr, "kernel_launch: cooperative launch failed: %s (grid %d)\n", hipGetErrorString(e), grid);
}
```

```cpp
#include <hip/hip_runtime.h>
#include <hip/hip_cooperative_groups.h>
#include <cstdio>
#include <cstdint>
#include <cmath>
namespace cg = cooperative_groups;

#define LAS __attribute__((address_space(3)))
typedef unsigned short bf16_t;
typedef short bf16x8 __attribute__((ext_vector_type(8)));
typedef short s16x4 __attribute__((ext_vector_type(4)));
typedef float f32x2 __attribute__((ext_vector_type(2)));
typedef float f32x4 __attribute__((ext_vector_type(4)));
typedef float f32x16 __attribute__((ext_vector_type(16)));
typedef unsigned u32x4 __attribute__((ext_vector_type(4)));
typedef unsigned u32x2 __attribute__((ext_vector_type(2)));
typedef __bf16 bf16x2_t __attribute__((ext_vector_type(2)));

constexpr int SEQ = 8192, BATCH = 2, MTOK = BATCH * SEQ, DM = 1024, DEPTH = 2;
constexpr int IN_COLS = 5400, NIN = 5632, DFF = 2816, NGU = 5632;
constexpr float RMS_EPS = 1e-6f;
constexpr float QSCALE = 0.125f * 1.4426950408889634f;

__device__ __forceinline__ unsigned cvtpk(float lo, float hi) { f32x2 v = {lo, hi}; bf16x2_t b = __builtin_convertvector(v, bf16x2_t); return __builtin_bit_cast(unsigned, b); }
__device__ __forceinline__ float bflo(unsigned w) { return __uint_as_float(w << 16); }
__device__ __forceinline__ float bfhi(unsigned w) { return __uint_as_float(w & 0xffff0000u); }
__device__ __forceinline__ float sigmoidf_(float x) { return __builtin_amdgcn_rcpf(1.f + __expf(-x)); }

namespace pg8 {
constexpr int BM = 256, BK = 64, HALF = 128, HTB = HALF * BK * 2, STAGE_BYTES = 8 * HTB, NXCD = 8, WGM = 8;
__host__ __device__ __forceinline__ int lds_byte(int r, int c) { const int st = (r >> 4) * 2 + (c >> 5), rr = r & 15, cc = c & 31, ob = rr * 64 + cc * 2; return st * 1024 + (ob ^ (((ob >> 9) & 1) << 5)); }
__host__ __device__ __forceinline__ void stage_rc(int b, int& R, int& C) { const int st = b / 1024, sb = b % 1024, swz = sb ^ (((sb >> 9) & 1) << 5); R = (st >> 1) * 16 + swz / 64; C = (st & 1) * 32 + (swz % 64) / 2; }
__host__ __device__ __forceinline__ int perm32(int rho) { const int n = rho >> 4, i = rho & 15; return 8 * (i >> 2) + 4 * n + (i & 3); }
struct Unit { int pm, pn; };
struct Gemm { const bf16_t* A; const bf16_t* Bt; int M, N, K; };
struct StaticOrder {
    int nM, nN, nwg, G, c;
    __host__ __device__ void init(int M, int N, int G_, int c_) { nM = M / BM; nN = N / BM; nwg = nM * nN; G = G_; c = c_; }
    __host__ __device__ bool next(int i, Unit& u) const {
        const long L = (long)i * G + c; if (L >= nwg) return false;
        int wgid = (int)L; { const int q = nwg / NXCD, r = nwg % NXCD, xcd = wgid % NXCD, off = wgid / NXCD; wgid = (xcd < r ? xcd * (q + 1) : r * (q + 1) + (xcd - r) * q) + off; }
        const int nig = WGM * nN, gid = wgid / nig, fm = gid * WGM, gsz = (nM - fm) < WGM ? (nM - fm) : WGM;
        u.pm = fm + ((wgid % nig) % gsz); u.pn = (wgid % nig) / gsz; return true;
    }
};
template <class Epi, class Sched>
__device__ __forceinline__ void gemm_phase(LAS unsigned char* lds, const Gemm g, const Sched& S, const Epi& E) {
    int tid_ = threadIdx.x; asm volatile("" : "+v"(tid_));
    const int tid = tid_, wid = __builtin_amdgcn_readfirstlane(tid >> 6), lane = tid & 63, wr = wid >> 2, wc = wid & 3, fr = lane & 15, fq = lane >> 4;
    const int K = g.K, nt = K / BK;
    unsigned voffA[2], voffB[2];
#pragma unroll
    for (int i = 0; i < 2; ++i) { int R, C; stage_rc(tid * 16 + i * 8192, R, C); const int Rb = ((R & ~31) + perm32(R & 31));
        voffA[i] = (unsigned)(R * K + C) * 2u; voffB[i] = (unsigned)(Rb * K + C) * 2u; }
    const size_t kstep = (size_t)(BK * 2);
    const size_t hstep = (size_t)HALF * K * 2;
    const size_t tstep = 2 * hstep;
    const unsigned ldsw = (unsigned)wid * 1024u;
    const int aoff = lds_byte(wr * 64 + fr, fq * 8), boff = lds_byte(wc * 32 + fr, fq * 8);
#define PG8_SA(b, h) (((b) * 2 + (h)) * HTB)
#define PG8_SB(b, h) ((4 + (b) * 2 + (h)) * HTB)
#define PG8_STAGE(bufoff, gbase, voff) do { _Pragma("unroll") for (int _i = 0; _i < 2; ++_i) \
        __builtin_amdgcn_global_load_lds((const unsigned*)((const char*)(gbase) + (voff)[_i]), (LAS unsigned*)(lds + (bufoff) + ldsw + _i * 8192), 16, 0, 0); } while (0)
#define PG8_LDA(dst, b, h) do { _Pragma("unroll") for (int m = 0; m < 4; ++m) _Pragma("unroll") for (int k = 0; k < 2; ++k) dst[m][k] = *(const LAS bf16x8*)(lds + PG8_SA(b, h) + aoff + m * 2048 + k * 1024); } while (0)
#define PG8_LDB(dst, b, h) do { _Pragma("unroll") for (int n = 0; n < 2; ++n) _Pragma("unroll") for (int k = 0; k < 2; ++k) dst[n][k] = *(const LAS bf16x8*)(lds + PG8_SB(b, h) + boff + n * 2048 + k * 1024); } while (0)
#define PG8_MMA(ai, bj, At, Bt) do { __builtin_amdgcn_s_setprio(1); _Pragma("unroll") for (int m = 0; m < 4; ++m) _Pragma("unroll") for (int n = 0; n < 2; ++n) _Pragma("unroll") for (int k = 0; k < 2; ++k) \
        acc[ai][bj][m][n] = __builtin_amdgcn_mfma_f32_16x16x32_bf16(Bt[n][k], At[m][k], acc[ai][bj][m][n], 0, 0, 0); __builtin_amdgcn_s_setprio(0); } while (0)
#define PG8_WAIT_V(n) asm volatile("s_waitcnt vmcnt(" #n ")" ::: "memory")
#define PG8_WAIT_L(n) asm volatile("s_waitcnt lgkmcnt(" #n ")" ::: "memory")
#define PG8_BAR __builtin_amdgcn_s_barrier()
#define PG8_SCHED __builtin_amdgcn_sched_barrier(0)
    Unit cur, nxt; int ui = 0;
    if (!S.next(0, cur)) return;
    f32x4 acc[2][2][4][2];
#pragma unroll
    for (int a = 0; a < 2; ++a)
#pragma unroll
        for (int b = 0; b < 2; ++b)
#pragma unroll
            for (int m = 0; m < 4; ++m)
#pragma unroll
                for (int n = 0; n < 2; ++n) acc[a][b][m][n] = (f32x4){0.f, 0.f, 0.f, 0.f};
    bf16x8 At[4][2], B0[2][2], B1[2][2];
    const char* cA = (const char*)g.A + (size_t)cur.pm * tstep; const char* cB = (const char*)g.Bt + (size_t)cur.pn * tstep;
    PG8_STAGE(PG8_SB(0, 0), cB, voffB); PG8_STAGE(PG8_SB(0, 1), cB + hstep, voffB); PG8_STAGE(PG8_SA(0, 0), cA, voffA); PG8_STAGE(PG8_SA(0, 1), cA + hstep, voffA);
    if (wr == 1) PG8_BAR;
    PG8_WAIT_V(2); PG8_BAR;
    PG8_STAGE(PG8_SB(1, 0), cB + kstep, voffB); PG8_STAGE(PG8_SA(1, 0), cA + kstep, voffA); PG8_STAGE(PG8_SB(1, 1), cB + hstep + kstep, voffB);
    PG8_WAIT_V(6); PG8_BAR;
    for (;;) {
        const bool has_next = S.next(ui + 1, nxt);
        const char* nA = has_next ? (const char*)g.A + (size_t)nxt.pm * tstep : cA; const char* nB = has_next ? (const char*)g.Bt + (size_t)nxt.pn * tstep : cB;
        for (int t = 0; t < nt; t += 2) {
            const bool last = (t == nt - 2);
            const char* a1 = cA + (size_t)(t + 1) * kstep;
            const char* a2 = last ? nA : cA + (size_t)(t + 2) * kstep; const char* b2 = last ? nB : cB + (size_t)(t + 2) * kstep;
            const char* a3 = a2 + kstep; const char* b3 = b2 + kstep;
            if constexpr (Epi::KHOOK) { if (t == 4 || t == 12) { PG8_SCHED; E.khook(acc, cur, t, wr, wc, fr, fq); PG8_SCHED; } }
            PG8_LDB(B0, 0, 0); PG8_LDB(B1, 0, 1); PG8_SCHED; PG8_LDA(At, 0, 0); PG8_STAGE(PG8_SA(1, 1), a1 + hstep, voffA);
            PG8_WAIT_V(8); PG8_WAIT_L(0); PG8_BAR; PG8_MMA(0, 0, At, B0); PG8_MMA(0, 1, At, B1); PG8_BAR; PG8_SCHED;
            PG8_LDA(At, 0, 1); PG8_STAGE(PG8_SB(0, 0), b2, voffB); PG8_STAGE(PG8_SB(0, 1), b2 + hstep, voffB); PG8_STAGE(PG8_SA(0, 0), a2, voffA);
            PG8_WAIT_V(8); PG8_WAIT_L(0); PG8_BAR; PG8_MMA(1, 0, At, B0); PG8_MMA(1, 1, At, B1); PG8_BAR; PG8_SCHED;
            PG8_LDB(B0, 1, 0); PG8_LDB(B1, 1, 1); PG8_SCHED; PG8_LDA(At, 1, 0); PG8_STAGE(PG8_SA(0, 1), a2 + hstep, voffA);
            PG8_WAIT_V(8); PG8_WAIT_L(0); PG8_BAR; PG8_MMA(0, 0, At, B0); PG8_MMA(0, 1, At, B1); PG8_BAR; PG8_SCHED;
            PG8_LDA(At, 1, 1); PG8_STAGE(PG8_SB(1, 0), b3, voffB); PG8_STAGE(PG8_SB(1, 1), b3 + hstep, voffB); PG8_STAGE(PG8_SA(1, 0), a3, voffA);
            PG8_WAIT_V(8); PG8_WAIT_L(0); PG8_BAR; PG8_MMA(1, 0, At, B0); PG8_MMA(1, 1, At, B1); PG8_BAR; PG8_SCHED;
        }
        if (wr == 0) PG8_BAR;
        E(acc, cur, wr, wc, fr, fq);
        if (!has_next) break;
#pragma unroll
        for (int a = 0; a < 2; ++a)
#pragma unroll
            for (int b = 0; b < 2; ++b)
#pragma unroll
                for (int m = 0; m < 4; ++m)
#pragma unroll
                    for (int n = 0; n < 2; ++n) acc[a][b][m][n] = (f32x4){0.f, 0.f, 0.f, 0.f};
        cur = nxt; cA = nA; cB = nB; ++ui;
        if (wr == 1) PG8_BAR;
    }
    PG8_WAIT_V(0);
    PG8_BAR;
#undef PG8_SA
#undef PG8_SB
#undef PG8_STAGE
#undef PG8_LDA
#undef PG8_LDB
#undef PG8_MMA
#undef PG8_WAIT_V
#undef PG8_WAIT_L
#undef PG8_BAR
#undef PG8_SCHED
}
}
using pg8::Unit;
__device__ __forceinline__ float row_rstd(const float* ssp, int row) {
    const f32x4* p = (const f32x4*)(ssp + (size_t)row * 16);
    const f32x4 a = p[0], b = p[1], c = p[2], d = p[3];
    const float ss = ((a[0] + a[1]) + (a[2] + a[3])) + ((b[0] + b[1]) + (b[2] + b[3])) + ((c[0] + c[1]) + (c[2] + c[3])) + ((d[0] + d[1]) + (d[2] + d[3]));
    return 1.0f / sqrtf(ss * (1.0f / DM) + RMS_EPS);
}
__device__ __forceinline__ float row_rstd4(const float* ssp, int row, int fq) {
    const f32x4 a = *((const f32x4*)(ssp + (size_t)row * 16) + fq);
    float ss = (a[0] + a[1]) + (a[2] + a[3]);
    ss += __shfl_xor(ss, 16); ss += __shfl_xor(ss, 32);
    return 1.0f / sqrtf(ss * (1.0f / DM) + RMS_EPS);
}
__device__ __forceinline__ u32x4 pack8(const f32x4 a, const f32x4 b) { u32x4 w; w.x = cvtpk(a[0], a[1]); w.y = cvtpk(a[2], a[3]); w.z = cvtpk(b[0], b[1]); w.w = cvtpk(b[2], b[3]); return w; }
__device__ __forceinline__ void rope8(f32x4& v0, f32x4& v1, const float* tab, int t, int pos, float sc) {
    const f32x4* cs = (const f32x4*)(tab + ((size_t)t * 32 + (pos >> 1)) * 2);
    const f32x4 c0 = cs[0], c1 = cs[1];
    f32x4 o0, o1;
    o0[0] = (v0[0] * c0[0] - v0[1] * c0[1]) * sc; o0[1] = (v0[1] * c0[0] + v0[0] * c0[1]) * sc;
    o0[2] = (v0[2] * c0[2] - v0[3] * c0[3]) * sc; o0[3] = (v0[3] * c0[2] + v0[2] * c0[3]) * sc;
    o1[0] = (v1[0] * c1[0] - v1[1] * c1[1]) * sc; o1[1] = (v1[1] * c1[0] + v1[0] * c1[1]) * sc;
    o1[2] = (v1[2] * c1[2] - v1[3] * c1[3]) * sc; o1[3] = (v1[3] * c1[2] + v1[2] * c1[3]) * sc;
    v0 = o0; v1 = o1;
}
struct EpiInProj {
    static constexpr bool KHOOK = false;
    const float* ssp; const float* bias; const float* tab;
    bf16_t *U, *Qn, *KV, *Mo, *G, *Gn;
    __device__ __forceinline__ void operator()(const f32x4 (&acc)[2][2][4][2], const Unit& u, int wr, int wc, int fr, int fq) const {
        asm volatile("" : "+v"(fr), "+v"(fq));
        const int pn = u.pn;
        f32x4 bia[2][2];
#pragma unroll
        for (int bj = 0; bj < 2; ++bj) { const int gc = pn * 256 + bj * 128 + wc * 32 + 8 * fq; bia[bj][0] = *(const f32x4*)(bias + gc); bia[bj][1] = *(const f32x4*)(bias + gc + 4); }
        float rs[2][4];
#pragma unroll
        for (int ai = 0; ai < 2; ++ai) { f32x4 ra[4];
#pragma unroll
            for (int m = 0; m < 4; ++m) ra[m] = *((const f32x4*)(ssp + (size_t)(u.pm * 256 + ai * 128 + wr * 64 + m * 16 + fr) * 16) + fq);
            __builtin_amdgcn_sched_barrier(0);
#pragma unroll
            for (int m = 0; m < 4; ++m) { float ss = (ra[m][0] + ra[m][1]) + (ra[m][2] + ra[m][3]); ss += __shfl_xor(ss, 16); ss += __shfl_xor(ss, 32); rs[ai][m] = 1.0f / sqrtf(ss * (1.0f / DM) + RMS_EPS); } }
#pragma unroll
        for (int ai = 0; ai < 2; ++ai)
#pragma unroll
            for (int m = 0; m < 4; ++m) {
                const int row = u.pm * 256 + ai * 128 + wr * 64 + m * 16 + fr;
                const float rstd = rs[ai][m];
                const int t = row & (SEQ - 1), b = row >> 13;
#pragma unroll
                for (int bj = 0; bj < 2; ++bj) {
                    const int cit = bj * 128 + wc * 32 + 8 * fq;
                    f32x4 v0 = acc[ai][bj][m][0] * rstd + bia[bj][0], v1 = acc[ai][bj][m][1] * rstd + bia[bj][1];
                    bf16_t* dst;
                    if (pn == 0) { dst = U + (size_t)row * 256 + cit; }
                    else if (pn <= 2) { const int c2 = (pn - 1) * 256 + cit, head = c2 >> 6, pos = c2 & 63; rope8(v0, v1, tab, t, pos, QSCALE); dst = Qn + ((size_t)(b * 8 + head) * SEQ + t) * 64 + pos; }
                    else if (pn <= 5) { const int c2 = cit & 127, g = c2 >> 6, pos = c2 & 63, kvi = 2 * (pn - 3) + bj; if (bj == 0) rope8(v0, v1, tab, t, pos, 1.f);
                        dst = KV + (size_t)kvi * ((size_t)MTOK * 128) + ((size_t)(b * 2 + g) * SEQ + t) * 64 + pos; }
                    else if (pn <= 8) { const int h = cit >> 6, pos = cit & 63; if (pn < 8) rope8(v0, v1, tab, t, pos, pn == 6 ? QSCALE : 1.f);
                        dst = Mo + (size_t)(pn - 6) * ((size_t)MTOK * 256) + ((size_t)(b * 4 + h) * SEQ + t) * 64 + pos; }
                    else if (pn <= 20) {
#pragma unroll
                        for (int e = 0; e < 4; ++e) { v0[e] = sigmoidf_(v0[e]); v1[e] = sigmoidf_(v1[e]); }
                        dst = G + (size_t)row * 3072 + (pn - 9) * 256 + cit; }
                    else {
#pragma unroll
                        for (int e = 0; e < 4; ++e) { v0[e] = sigmoidf_(v0[e]); v1[e] = sigmoidf_(v1[e]); }
                        dst = Gn + (size_t)row * 32 + (cit & 31); if (cit >= 32) dst = nullptr; }
                    if (dst) *(u32x4*)dst = pack8(v0, v1);
                }
                asm volatile("" ::: "memory");
            }
    }
};
struct EpiBranch {
    static constexpr bool KHOOK = true;
    const bf16_t* G; bf16_t* out;
    __device__ __forceinline__ void khook(f32x4 (&acc)[2][2][4][2], const Unit& u, int t, int wr, int wc, int fr, int fq) const {
        asm volatile("" : "+v"(fr), "+v"(fq));
        const int gsel = (t == 4) ? 0 : 1024;
#pragma unroll
        for (int ai = 0; ai < 2; ++ai)
#pragma unroll
            for (int m = 0; m < 4; ++m) {
                u32x4 gx[2], gy[2];
#pragma unroll
                for (int bj = 0; bj < 2; ++bj) { const int row = u.pm * 256 + ai * 128 + wr * 64 + m * 16 + fr, col = u.pn * 256 + bj * 128 + wc * 32 + 8 * fq;
                    gx[bj] = *(const u32x4*)(G + (size_t)row * 3072 + gsel + col); gy[bj] = *(const u32x4*)(G + (size_t)row * 3072 + gsel + 1024 + col); }
                __builtin_amdgcn_sched_barrier(0);
#pragma unroll
                for (int bj = 0; bj < 2; ++bj)
#pragma unroll
                    for (int e = 0; e < 4; ++e) {
                        const float x0 = fmaxf(bflo(gx[bj][e]), 1e-20f), x1 = fmaxf(bfhi(gx[bj][e]), 1e-20f), y0 = fmaxf(bflo(gy[bj][e]), 1e-20f), y1 = fmaxf(bfhi(gy[bj][e]), 1e-20f);
                        const float r0 = x0 * __builtin_amdgcn_rcpf(y0), r1 = x1 * __builtin_amdgcn_rcpf(y1);
                        acc[ai][bj][m][e >> 1][(e & 1) * 2] *= r0; acc[ai][bj][m][e >> 1][(e & 1) * 2 + 1] *= r1; }
                asm volatile("" ::: "memory");
            }
    }
    __device__ __forceinline__ void operator()(const f32x4 (&acc)[2][2][4][2], const Unit& u, int wr, int wc, int fr, int fq) const {
        asm volatile("" : "+v"(fr), "+v"(fq));
#pragma unroll
        for (int ai = 0; ai < 2; ++ai) {
            u32x4 gz[4][2];
#pragma unroll
            for (int m = 0; m < 4; ++m)
#pragma unroll
                for (int bj = 0; bj < 2; ++bj) gz[m][bj] = *(const u32x4*)(G + (size_t)(u.pm * 256 + ai * 128 + wr * 64 + m * 16 + fr) * 3072 + 2048 + u.pn * 256 + bj * 128 + wc * 32 + 8 * fq);
            __builtin_amdgcn_sched_barrier(0);
#pragma unroll
            for (int m = 0; m < 4; ++m) {
                const int row = u.pm * 256 + ai * 128 + wr * 64 + m * 16 + fr;
#pragma unroll
                for (int bj = 0; bj < 2; ++bj) {
                    const int col = u.pn * 256 + bj * 128 + wc * 32 + 8 * fq; const u32x4 g = gz[m][bj];
                    f32x4 v0 = acc[ai][bj][m][0], v1 = acc[ai][bj][m][1];
                    v0[0] *= fmaxf(bflo(g[0]), 1e-20f); v0[1] *= fmaxf(bfhi(g[0]), 1e-20f); v0[2] *= fmaxf(bflo(g[1]), 1e-20f); v0[3] *= fmaxf(bfhi(g[1]), 1e-20f);
                    v1[0] *= fmaxf(bflo(g[2]), 1e-20f); v1[1] *= fmaxf(bfhi(g[2]), 1e-20f); v1[2] *= fmaxf(bflo(g[3]), 1e-20f); v1[3] *= fmaxf(bfhi(g[3]), 1e-20f);
                    *(u32x4*)(out + (size_t)row * DM + col) = pack8(v0, v1);
                }
            }
            asm volatile("" ::: "memory");
        }
    }
};
struct EpiResid {
    static constexpr bool KHOOK = false;
    const float* base_f; const bf16_t* base_b; bf16_t* xb; bf16_t* res; float* ssp;
    __device__ __forceinline__ void operator()(const f32x4 (&acc)[2][2][4][2], const Unit& u, int wr, int wc, int fr, int fq) const {
        asm volatile("" : "+v"(fr), "+v"(fq));
#pragma unroll
        for (int ai = 0; ai < 2; ++ai)
#pragma unroll
            for (int mp = 0; mp < 2; ++mp) {
                f32x4 b0[2][2], b1[2][2];
                if (base_f) {
#pragma unroll
                    for (int mm = 0; mm < 2; ++mm)
#pragma unroll
                        for (int bj = 0; bj < 2; ++bj) { const size_t off = (size_t)(u.pm * 256 + ai * 128 + wr * 64 + (2 * mp + mm) * 16 + fr) * DM + u.pn * 256 + bj * 128 + wc * 32 + 8 * fq;
                            b0[mm][bj] = *(const f32x4*)(base_f + off); b1[mm][bj] = *(const f32x4*)(base_f + off + 4); }
                    __builtin_amdgcn_sched_barrier(0);
                } else {
                    u32x4 w[2][2];
#pragma unroll
                    for (int mm = 0; mm < 2; ++mm)
#pragma unroll
                        for (int bj = 0; bj < 2; ++bj) w[mm][bj] = *(const u32x4*)(base_b + (size_t)(u.pm * 256 + ai * 128 + wr * 64 + (2 * mp + mm) * 16 + fr) * DM + u.pn * 256 + bj * 128 + wc * 32 + 8 * fq);
                    __builtin_amdgcn_sched_barrier(0);
#pragma unroll
                    for (int mm = 0; mm < 2; ++mm)
#pragma unroll
                        for (int bj = 0; bj < 2; ++bj) { const u32x4 x = w[mm][bj]; b0[mm][bj] = (f32x4){bflo(x[0]), bfhi(x[0]), bflo(x[1]), bfhi(x[1])}; b1[mm][bj] = (f32x4){bflo(x[2]), bfhi(x[2]), bflo(x[3]), bfhi(x[3])}; }
                }
#pragma unroll
                for (int mm = 0; mm < 2; ++mm) {
                    const int m = 2 * mp + mm, row = u.pm * 256 + ai * 128 + wr * 64 + m * 16 + fr;
                    float ss = 0.f;
#pragma unroll
                    for (int bj = 0; bj < 2; ++bj) {
                        const size_t off = (size_t)row * DM + u.pn * 256 + bj * 128 + wc * 32 + 8 * fq;
                        const f32x4 v0 = acc[ai][bj][m][0] + b0[mm][bj], v1 = acc[ai][bj][m][1] + b1[mm][bj];
                        const u32x4 pk = pack8(v0, v1);
                        *(u32x4*)(xb + off) = pk;
                        if (res) *(u32x4*)(res + off) = pk;
                        ss += (v0[0] * v0[0] + v0[1] * v0[1]) + (v0[2] * v0[2] + v0[3] * v0[3]) + (v1[0] * v1[0] + v1[1] * v1[1]) + (v1[2] * v1[2] + v1[3] * v1[3]);
                    }
                    ss += __shfl_xor(ss, 16); ss += __shfl_xor(ss, 32);
                    if (fq == 0) ssp[(size_t)row * 16 + u.pn * 4 + wc] = ss;
                }
                asm volatile("" ::: "memory");
            }
    }
};
struct EpiSwiGLU {
    static constexpr bool KHOOK = false;
    const float* ssp; bf16_t* H;
    __device__ __forceinline__ void operator()(const f32x4 (&acc)[2][2][4][2], const Unit& u, int wr, int wc, int fr, int fq) const {
        asm volatile("" : "+v"(fr), "+v"(fq));
        float rs[2][4];
#pragma unroll
        for (int ai = 0; ai < 2; ++ai) { f32x4 ra[4];
#pragma unroll
            for (int m = 0; m < 4; ++m) ra[m] = *((const f32x4*)(ssp + (size_t)(u.pm * 256 + ai * 128 + wr * 64 + m * 16 + fr) * 16) + fq);
            __builtin_amdgcn_sched_barrier(0);
#pragma unroll
            for (int m = 0; m < 4; ++m) { float ss = (ra[m][0] + ra[m][1]) + (ra[m][2] + ra[m][3]); ss += __shfl_xor(ss, 16); ss += __shfl_xor(ss, 32); rs[ai][m] = 1.0f / sqrtf(ss * (1.0f / DM) + RMS_EPS); } }
#pragma unroll
        for (int ai = 0; ai < 2; ++ai)
#pragma unroll
            for (int m = 0; m < 4; ++m) {
                const int row = u.pm * 256 + ai * 128 + wr * 64 + m * 16 + fr;
                const float rstd = rs[ai][m];
                f32x4 o[2];
#pragma unroll
                for (int n = 0; n < 2; ++n)
#pragma unroll
                    for (int e = 0; e < 4; ++e) { const float gt = acc[ai][0][m][n][e] * rstd, up = acc[ai][1][m][n][e] * rstd; o[n][e] = gt * sigmoidf_(gt) * up; }
                *(u32x4*)(H + (size_t)row * DFF + u.pn * 128 + wc * 32 + 8 * fq) = pack8(o[0], o[1]);
                asm volatile("" ::: "memory");
            }
    }
};
namespace att {
constexpr int KCS = 1040, KSLOT = 8 * KCS, VSLOT = 8192;
constexpr int L_K0 = 0, L_V0 = 4 * KSLOT, L_WSF = 4 * KSLOT + 4 * VSLOT, L_MSK = L_WSF + 8 * 256, L_UNI = L_MSK + 1024, L_LIST = L_UNI + 64, L_END = L_LIST + 512,
              L_PS = L_END + 64, L_OT = L_PS, L_TOTAL = L_OT + 8 * 8192;
static_assert(L_TOTAL <= 147456 - 64, "attention LDS map");
#define LBAR() asm volatile("s_waitcnt lgkmcnt(0)\n\ts_barrier" ::: "memory")
#define LWAIT() asm volatile("s_waitcnt lgkmcnt(0)" ::: "memory")
__device__ __forceinline__ int crow(int r, int hi) { return (r & 3) + 8 * (r >> 2) + 4 * hi; }
__device__ __forceinline__ float swap_other(float v, int hi) { auto rr = __builtin_amdgcn_permlane32_swap(__float_as_uint(v), __float_as_uint(v), false, false); return __uint_as_float(hi ? rr[0] : rr[1]); }
__device__ __forceinline__ void qkt(f32x16& p0, f32x16& p1, const LAS char* Ks, const bf16x8* qr, const f32x16& cinit, int r32, int hi) {
    const LAS char* kb = Ks + hi * KCS + r32 * 16;
    bf16x8 kf[8];
#pragma unroll
    for (int d0 = 0; d0 < 4; ++d0) { kf[2 * d0] = *(const LAS bf16x8*)(kb + d0 * 2 * KCS); kf[2 * d0 + 1] = *(const LAS bf16x8*)(kb + d0 * 2 * KCS + 512); }
    __builtin_amdgcn_sched_barrier(0);
    p0 = __builtin_amdgcn_mfma_f32_32x32x16_bf16(kf[0], qr[0], cinit, 0, 0, 0); p1 = __builtin_amdgcn_mfma_f32_32x32x16_bf16(kf[1], qr[0], cinit, 0, 0, 0);
#pragma unroll
    for (int d0 = 1; d0 < 4; ++d0) { p0 = __builtin_amdgcn_mfma_f32_32x32x16_bf16(kf[2 * d0], qr[d0], p0, 0, 0, 0); p1 = __builtin_amdgcn_mfma_f32_32x32x16_bf16(kf[2 * d0 + 1], qr[d0], p1, 0, 0, 0); }
}
struct VFrag { s16x4 lo[8], hi[8]; };
typedef short v4i16_t __attribute__((ext_vector_type(4)));
__device__ __forceinline__ s16x4 vtr(const LAS char* p) { return __builtin_bit_cast(s16x4, __builtin_amdgcn_ds_read_tr16_b64_v4i16((LAS v4i16_t*)p)); }
__device__ __forceinline__ void v_issue(VFrag& F, const LAS char* vp) {
#pragma unroll
    for (int d0 = 0; d0 < 2; ++d0)
#pragma unroll
        for (int ks = 0; ks < 4; ++ks) { F.lo[d0 * 4 + ks] = vtr(vp + d0 * 4096 + ks * 1024); F.hi[d0 * 4 + ks] = vtr(vp + d0 * 4096 + ks * 1024 + 512); }
}
template <bool SUM> __device__ __forceinline__ void pv(f32x16* o, f32x16& osum, VFrag& F, bf16x8 pa0, bf16x8 pa1, bf16x8 pa2, bf16x8 pa3) {
#define PK(k) (bf16x8){F.lo[k][0], F.lo[k][1], F.lo[k][2], F.lo[k][3], F.hi[k][0], F.hi[k][1], F.hi[k][2], F.hi[k][3]}
    const bf16x8 ones = {0x3F80, 0x3F80, 0x3F80, 0x3F80, 0x3F80, 0x3F80, 0x3F80, 0x3F80};
    __builtin_amdgcn_s_setprio(1);
    o[0] = __builtin_amdgcn_mfma_f32_32x32x16_bf16(pa0, PK(0), o[0], 0, 0, 0);
    o[1] = __builtin_amdgcn_mfma_f32_32x32x16_bf16(pa0, PK(4), o[1], 0, 0, 0);
    if (SUM) osum = __builtin_amdgcn_mfma_f32_32x32x16_bf16(pa0, ones, osum, 0, 0, 0);
    o[0] = __builtin_amdgcn_mfma_f32_32x32x16_bf16(pa1, PK(1), o[0], 0, 0, 0);
    o[1] = __builtin_amdgcn_mfma_f32_32x32x16_bf16(pa1, PK(5), o[1], 0, 0, 0);
    if (SUM) osum = __builtin_amdgcn_mfma_f32_32x32x16_bf16(pa1, ones, osum, 0, 0, 0);
    o[0] = __builtin_amdgcn_mfma_f32_32x32x16_bf16(pa2, PK(2), o[0], 0, 0, 0);
    o[1] = __builtin_amdgcn_mfma_f32_32x32x16_bf16(pa2, PK(6), o[1], 0, 0, 0);
    if (SUM) osum = __builtin_amdgcn_mfma_f32_32x32x16_bf16(pa2, ones, osum, 0, 0, 0);
    o[0] = __builtin_amdgcn_mfma_f32_32x32x16_bf16(pa3, PK(3), o[0], 0, 0, 0);
    o[1] = __builtin_amdgcn_mfma_f32_32x32x16_bf16(pa3, PK(7), o[1], 0, 0, 0);
    if (SUM) osum = __builtin_amdgcn_mfma_f32_32x32x16_bf16(pa3, ones, osum, 0, 0, 0);
    __builtin_amdgcn_s_setprio(0);
#undef PK
}
__device__ __forceinline__ float rowmax(const f32x16& p0, const f32x16& p1, int hi) {
    float a = __builtin_fmaxf(p0[0], p1[0]);
#pragma unroll
    for (int r = 1; r < 16; ++r) a = __builtin_fmaxf(__builtin_fmaxf(a, p0[r]), p1[r]);
    return __builtin_fmaxf(a, swap_other(a, hi));
}
struct KVRegs { u32x4 k, v; };
__device__ __forceinline__ void tile_load(KVRegs& R, const bf16_t* K, const bf16_t* V, int tid) { R.k = *(const u32x4*)(K + tid * 8); R.v = *(const u32x4*)(V + tid * 8); }
__device__ __forceinline__ void tile_store(const KVRegs& R, LAS char* Ks, LAS char* Vs, int tid) {
    const int row = tid >> 3, c = tid & 7;
    *(LAS u32x4*)(Ks + c * KCS + row * 16) = R.k;
    *(LAS u32x4*)(Vs + (c >> 2) * 4096 + (row >> 4) * 1024 + (row & 15) * 64 + (c & 3) * 16) = R.v;
}
__device__ __forceinline__ void ps_accum(const f32x16 p, int jb, LAS float* ps_row, bool writer) {
#pragma unroll
    for (int rg = 0; rg < 4; ++rg) {
        float a = 2.f * (p[4 * rg] + p[4 * rg + 1] + p[4 * rg + 2]) + p[4 * rg + 3], bq = p[4 * rg + 3];
        a += __shfl_xor(a, 1); a += __shfl_xor(a, 2); bq += __shfl_xor(bq, 1); bq += __shfl_xor(bq, 2);
        const int j = jb + 2 * rg;
        if (writer) { __hip_atomic_fetch_add(ps_row + j, a, __ATOMIC_RELAXED, __HIP_MEMORY_SCOPE_WORKGROUP); if (j + 1 < 128) __hip_atomic_fetch_add(ps_row + j + 1, bq, __ATOMIC_RELAXED, __HIP_MEMORY_SCOPE_WORKGROUP); }
    }
}
struct Ctx { LAS char* lds; LAS float* wsf; LAS float* otl; int tid, wid, lane, r32, hi, vbl; };
struct RowSt { float m, l; bool started; f32x16 negm, osum; };
__device__ __forceinline__ void rowst_init(RowSt& S) { S.m = 0.f; S.l = 0.f; S.started = false; S.negm = f32x16{}; S.osum = f32x16{}; asm volatile("" : "+v"(S.negm)); }
__device__ __forceinline__ void rowst_fixed(RowSt& S, float ref) { S.m = ref; S.l = 0.f; S.started = true; S.osum = f32x16{};
#pragma unroll
    for (int r = 0; r < 16; ++r) S.negm[r] = -ref;
    asm volatile("" : "+v"(S.negm)); }
template <int MODE, class Idx, class Src, class Msk>
__device__ __forceinline__ void run_branch(const Ctx& C, int nt, const Idx& idx, const Src& src, const Msk& msk, const bf16x8* qr, RowSt& S, f32x16* o, LAS float* ps_row, bool ps_writer, KVRegs& R0, bool pre, const bf16_t* nk, const bf16_t* nv) {
    KVRegs R1; const bf16_t *kp, *vp;
    int dA = idx(0), dB = nt > 1 ? idx(1) : 0, dC = 0, dD = 0;
    if (!pre) { src(0, dA, kp, vp); tile_load(R0, kp, vp, C.tid); }
    if (nt > 1) { src(1, dB, kp, vp); tile_load(R1, kp, vp, C.tid); }
    auto compute = [&](int it, const LAS char* Ks, const LAS char* Vs, int klo, int khi, bool nm) {
        const bool kill = khi < klo;
        if (!__any(!kill)) return;
        f32x16 p0, p1; qkt(p0, p1, Ks, qr, S.negm, C.r32, C.hi);
        VFrag VF; if constexpr (MODE != 0) { v_issue(VF, Vs + C.vbl); __builtin_amdgcn_sched_barrier(0); }
        if (__any(nm && !kill)) {
#pragma unroll
            for (int r = 0; r < 16; ++r) { const int kv = crow(r, C.hi); if (kv < klo || kv > khi) p0[r] = -INFINITY; if (kv + 32 < klo || kv + 32 > khi) p1[r] = -INFINITY; }
        }
        if constexpr (MODE != 2) {
            float rm = rowmax(p0, p1, C.hi); if (kill) rm = -INFINITY;
            const bool first = !S.started && rm > -INFINITY, grow = first || rm > 8.0f;
            if (__any(grow)) {
                const float d = grow ? rm : 0.f, alpha = first ? 1.0f : __builtin_amdgcn_exp2f(-d);
                S.m += d; S.started = S.started || first;
#pragma unroll
                for (int r = 0; r < 16; ++r) { S.negm[r] = -S.m; p0[r] -= d; p1[r] -= d; }
                if constexpr (MODE == 0) S.l *= alpha;
                if constexpr (MODE == 1) {
                    if (C.hi == 0) C.wsf[C.r32] = alpha;
                    LWAIT();
#pragma unroll
                    for (int r = 0; r < 16; ++r) { const float f = C.wsf[crow(r, C.hi)]; o[0][r] *= f; o[1][r] *= f; S.osum[r] *= f; }
                    LWAIT();
                }
            }
        }
#pragma unroll
        for (int r = 0; r < 16; ++r) { p0[r] = __builtin_amdgcn_exp2f(p0[r]); p1[r] = __builtin_amdgcn_exp2f(p1[r]); }
        if constexpr (MODE == 0) {
            float s = 0.f;
#pragma unroll
            for (int r = 0; r < 16; ++r) s += p0[r] + p1[r];
            S.l += kill ? 0.f : s;
        }
        if constexpr (MODE == 2) {
            if (__any(kill)) {
#pragma unroll
                for (int r = 0; r < 16; ++r) { p0[r] = kill ? 0.f : p0[r]; p1[r] = kill ? 0.f : p1[r]; }
            }
            ps_accum(p0, 16 * it + C.hi, ps_row, ps_writer); ps_accum(p1, 16 * it + 8 + C.hi, ps_row, ps_writer);
        }
        if constexpr (MODE != 0) {
            u32x4 w0 = {cvtpk(p0[0], p0[1]), cvtpk(p0[2], p0[3]), cvtpk(p0[4], p0[5]), cvtpk(p0[6], p0[7])}, w1 = {cvtpk(p0[8], p0[9]), cvtpk(p0[10], p0[11]), cvtpk(p0[12], p0[13]), cvtpk(p0[14], p0[15])};
            u32x4 w2 = {cvtpk(p1[0], p1[1]), cvtpk(p1[2], p1[3]), cvtpk(p1[4], p1[5]), cvtpk(p1[6], p1[7])}, w3 = {cvtpk(p1[8], p1[9]), cvtpk(p1[10], p1[11]), cvtpk(p1[12], p1[13]), cvtpk(p1[14], p1[15])};
            if constexpr (MODE == 1) {
                if (__any(kill)) {
#pragma unroll
                    for (int e = 0; e < 4; ++e) { w0[e] = kill ? 0u : w0[e]; w1[e] = kill ? 0u : w1[e]; w2[e] = kill ? 0u : w2[e]; w3[e] = kill ? 0u : w3[e]; }
                }
            }
            pv<MODE == 1>(o, S.osum, VF, __builtin_bit_cast(bf16x8, w0), __builtin_bit_cast(bf16x8, w1), __builtin_bit_cast(bf16x8, w2), __builtin_bit_cast(bf16x8, w3));
        }
    };
    LBAR();
    for (int it = 0; it < nt; it += 2) {
        const int p = (it >> 1) & 1; const bool two = it + 1 < nt;
        LAS char* KsA = C.lds + L_K0 + (2 * p) * KSLOT; LAS char* VsA = C.lds + L_V0 + (2 * p) * VSLOT;
        LAS char* KsB = KsA + KSLOT; LAS char* VsB = VsA + VSLOT;
        tile_store(R0, KsA, VsA, C.tid); if (two) tile_store(R1, KsB, VsB, C.tid);
        if (it + 2 < nt) dC = idx(it + 2);
        if (it + 3 < nt) dD = idx(it + 3);
        int kloA, khiA, kloB = 0, khiB = -1; const bool nmA = msk(it, dA, kloA, khiA); bool nmB = false; if (two) nmB = msk(it + 1, dB, kloB, khiB);
        if (it + 2 < nt) { src(it + 2, dC, kp, vp); tile_load(R0, kp, vp, C.tid); } else if (nk) tile_load(R0, nk, nv, C.tid);
        if (it + 3 < nt) { src(it + 3, dD, kp, vp); tile_load(R1, kp, vp, C.tid); }
        LBAR();
        compute(it, KsA, VsA, kloA, khiA, nmA);
        if (two) compute(it + 1, KsB, VsB, kloB, khiB, nmB);
        dA = dC; dB = dD;
    }
}
template <bool FIRST> __device__ __forceinline__ void merge_branch_n(const Ctx& C, const f32x16* o, const f32x16& osum, float gate) {
    if (C.hi == 0) C.wsf[C.r32] = gate;
    LWAIT();
#pragma unroll
    for (int r0 = 0; r0 < 16; r0 += 8) {
        float gf[8], t0[8], t1[8];
#pragma unroll
        for (int r = 0; r < 8; ++r) { gf[r] = C.wsf[crow(r0 + r, C.hi)]; t0[r] = FIRST ? 0.f : C.otl[(r0 + r) * 64]; t1[r] = FIRST ? 0.f : C.otl[(16 + r0 + r) * 64]; }
        __builtin_amdgcn_sched_barrier(0);
#pragma unroll
        for (int r = 0; r < 8; ++r) { const float den = osum[r0 + r], f = den > 0.f ? gf[r] * __builtin_amdgcn_rcpf(den) : 0.f;
            C.otl[(r0 + r) * 64] = t0[r] + o[0][r0 + r] * f; C.otl[(16 + r0 + r) * 64] = t1[r] + o[1][r0 + r] * f; } }
    LWAIT();
}
template <bool FIRST> __device__ __forceinline__ void merge_branch(const Ctx& C, const f32x16* o, float factor) {
    if (C.hi == 0) C.wsf[C.r32] = factor;
    LWAIT();
#pragma unroll
    for (int r = 0; r < 16; ++r) { const float f = C.wsf[crow(r, C.hi)];
        if (FIRST) { C.otl[r * 64] = o[0][r] * f; C.otl[(16 + r) * 64] = o[1][r] * f; }
        else { C.otl[r * 64] += o[0][r] * f; C.otl[(16 + r) * 64] += o[1][r] * f; } }
    LWAIT();
}
struct Bufs { const bf16_t *Qn, *KV, *Mo, *KC, *KM, *Gn; bf16_t* Abr; };
constexpr size_t KV_STRIDE = (size_t)MTOK * 128, MO_STRIDE = (size_t)MTOK * 256;

__device__ __forceinline__ void nsa_item(const Ctx& C, const Bufs& B, int b, int g, int i) {
    const int r32 = C.r32, hi = C.hi, wid = C.wid;
    const int qi = 8 * wid + (r32 >> 2), hh = r32 & 3, head = g * 4 + hh, t = 64 * i + qi, cur = i;
    const size_t bg = (size_t)(b * 2 + g) * SEQ;
    bf16x8 qr[4];
    { const bf16_t* qp = B.Qn + ((size_t)(b * 8 + head) * SEQ + t) * 64 + hi * 8;
#pragma unroll
      for (int d0 = 0; d0 < 4; ++d0) qr[d0] = *(const bf16x8*)(qp + d0 * 16); }
    const unsigned gw = *(const unsigned*)(B.Gn + ((size_t)b * SEQ + t) * 32 + head * 3 - (head & 1));
    const unsigned gw2 = *(const unsigned*)(B.Gn + ((size_t)b * SEQ + t) * 32 + head * 3 - (head & 1) + 2);
    float g0, g1, g2; if (head & 1) { g0 = bfhi(gw); g1 = bflo(gw2); g2 = bfhi(gw2); } else { g0 = bflo(gw); g1 = bfhi(gw); g2 = bflo(gw2); }
    f32x16 o[2];
    LAS float* Ps = (LAS float*)(C.lds + L_PS); LAS unsigned* Mk = (LAS unsigned*)(C.lds + L_MSK); LAS unsigned* Uni = (LAS unsigned*)(C.lds + L_UNI); LAS int* List = (LAS int*)(C.lds + L_LIST);
    const int nv = t >= 31 ? ((t - 31) >> 4) + 1 : 0;
    const int nvt = (4 * i + 3 < 511) ? 4 * i + 3 : 511, ntc = (nvt + 63) >> 6;
    const bf16_t* kc = B.KC + (size_t)(0 * 4 + b * 2 + g) * 512 * 64; const bf16_t* vc = B.KC + (size_t)(1 * 4 + b * 2 + g) * 512 * 64;
    auto idxI = [&](int it) { return it; };
    auto srcC = [&](int it, int, const bf16_t*& kp, const bf16_t*& vp) { kp = kc + (size_t)it * 4096; vp = vc + (size_t)it * 4096; };
    auto mskC = [&](int it, int, int& klo, int& khi) { klo = 0; khi = nv - 1 - 64 * it; return khi < 63; };
    RowSt S; rowst_init(S);
    KVRegs R;
    run_branch<0>(C, ntc, idxI, srcC, mskC, qr, S, o, nullptr, false, R, false, kc, vc);
    const float lt = S.l + swap_other(S.l, hi);
    rowst_fixed(S, lt > 0.f ? S.m + __builtin_amdgcn_logf(lt) : 0.f);
    for (int e = C.tid; e < 64 * 128; e += 512) Ps[e] = 0.f;
    if (C.tid < 8) Uni[C.tid] = 0u;
    o[0] = f32x16{}; o[1] = f32x16{};
    run_branch<2>(C, ntc, idxI, srcC, mskC, qr, S, o, Ps + qi * 128, hh == 0, R, true, B.KV + 2 * KV_STRIDE + bg * 64, B.KV + 3 * KV_STRIDE + bg * 64);
    LBAR();
    {
        const int nf = cur == 0 ? 1 : (cur == 1 ? 2 : 3), kp_ = 16 - nf, lane = C.lane;
#pragma unroll 1
        for (int qq = 0; qq < 8; ++qq) {
            int q = 8 * wid + qq; asm volatile("" : "+s"(q)); LAS float* ps = Ps + q * 128;
            const int j0 = lane, j1 = lane + 64;
            const bool f0 = (j0 == 0 || j0 == cur || j0 == cur - 1) && j0 <= cur, f1 = (j1 == cur || j1 == cur - 1) && j1 <= cur;
            const bool va0 = j0 <= cur && !f0, va1 = j1 <= cur && !f1;
            const unsigned k0 = va0 ? __float_as_uint(ps[j0]) + 1u : 0u, k1 = va1 ? __float_as_uint(ps[j1]) + 1u : 0u;
            unsigned T = 0u;
            for (int bit = 30; bit >= 0; --bit) { const unsigned cand = T | (1u << bit); const int cnt = __popcll(__ballot(k0 >= cand)) + __popcll(__ballot(k1 >= cand)); if (cnt >= kp_) T = cand; }
            const int need = kp_ - (__popcll(__ballot(k0 > T)) + __popcll(__ballot(k1 > T)));
            const unsigned long long t0 = __ballot(k0 == T), t1 = __ballot(k1 == T), below = (1ull << lane) - 1ull;
            const int pre0 = __popcll(t0 & below), pre1 = __popcll(t0) + __popcll(t1 & below);
            const bool s0 = f0 || (k0 > 0u && (k0 > T || (k0 == T && pre0 < need))), s1 = f1 || (k1 > 0u && (k1 > T || (k1 == T && pre1 < need)));
            const unsigned long long b0 = __ballot(s0), b1 = __ballot(s1);
            if (lane == 0) { Mk[q * 4 + 0] = (unsigned)b0; Mk[q * 4 + 1] = (unsigned)(b0 >> 32); Mk[q * 4 + 2] = (unsigned)b1; Mk[q * 4 + 3] = (unsigned)(b1 >> 32);
                __hip_atomic_fetch_or(&Uni[0], (unsigned)b0, __ATOMIC_RELAXED, __HIP_MEMORY_SCOPE_WORKGROUP); __hip_atomic_fetch_or(&Uni[1], (unsigned)(b0 >> 32), __ATOMIC_RELAXED, __HIP_MEMORY_SCOPE_WORKGROUP); __hip_atomic_fetch_or(&Uni[2], (unsigned)b1, __ATOMIC_RELAXED, __HIP_MEMORY_SCOPE_WORKGROUP); __hip_atomic_fetch_or(&Uni[3], (unsigned)(b1 >> 32), __ATOMIC_RELAXED, __HIP_MEMORY_SCOPE_WORKGROUP); }
        }
    }
    LBAR();
    if (C.tid < 128) {
        const int wi = C.tid >> 5, bi = C.tid & 31; const unsigned u0 = Uni[0], u1 = Uni[1], u2 = Uni[2], u3 = Uni[3];
        const unsigned mine = wi == 0 ? u0 : wi == 1 ? u1 : wi == 2 ? u2 : u3;
        const int before = (wi > 0 ? __popc(u0) : 0) + (wi > 1 ? __popc(u1) : 0) + (wi > 2 ? __popc(u2) : 0) + __popc(mine & ((1u << bi) - 1u));
        if ((mine >> bi) & 1u) List[before] = C.tid;
        if (C.tid == 0) Uni[4] = (unsigned)(__popc(u0) + __popc(u1) + __popc(u2) + __popc(u3));
    }
    LBAR();
    merge_branch<true>(C, o, g0);
    {
        const int nsel = (int)Uni[4];
        const bf16_t* ks = B.KV + 2 * KV_STRIDE + bg * 64; const bf16_t* vs = B.KV + 3 * KV_STRIDE + bg * 64;
        auto idxS = [&](int it) { return List[it]; };
        auto srcS = [&](int, int j, const bf16_t*& kp, const bf16_t*& vp) { kp = ks + (size_t)j * 4096; vp = vs + (size_t)j * 4096; };
        auto mskS = [&](int, int j, int& klo, int& khi) { const unsigned w = Mk[qi * 4 + (j >> 5)]; const bool bit = (w >> (j & 31)) & 1u;
            klo = 0; khi = bit ? (j == cur ? qi : 63) : -1; return j == cur; };
        rowst_init(S); o[0] = f32x16{}; o[1] = f32x16{};
        const int tw0n = i >= 8 ? i - 8 : 0;
        run_branch<1>(C, nsel, idxS, srcS, mskS, qr, S, o, nullptr, false, R, true, B.KV + 4 * KV_STRIDE + bg * 64 + (size_t)tw0n * 4096, B.KV + 5 * KV_STRIDE + bg * 64 + (size_t)tw0n * 4096);
        merge_branch_n<false>(C, o, S.osum, g1);
    }
    {
        const int tw0 = i >= 8 ? i - 8 : 0, ntw = i - tw0 + 1;
        const bf16_t* kw = B.KV + 4 * KV_STRIDE + bg * 64; const bf16_t* vw = B.KV + 5 * KV_STRIDE + bg * 64;
        auto srcW = [&](int it, int, const bf16_t*& kp, const bf16_t*& vp) { kp = kw + (size_t)(tw0 + it) * 4096; vp = vw + (size_t)(tw0 + it) * 4096; };
        auto mskW = [&](int it, int, int& klo, int& khi) { const int tw = tw0 + it; klo = (t - 511) - 64 * tw; khi = (tw == i) ? qi : 63; return tw == i || klo > 0; };
        rowst_init(S); o[0] = f32x16{}; o[1] = f32x16{};
        run_branch<1>(C, ntw, idxI, srcW, mskW, qr, S, o, nullptr, false, R, true, nullptr, nullptr);
        merge_branch_n<false>(C, o, S.osum, g2);
    }
#pragma unroll
    for (int r = 0; r < 16; ++r) { const int qrow = crow(r, hi); bf16_t* dst = B.Abr + ((size_t)b * SEQ + 64 * i + 8 * wid + (qrow >> 2)) * DM + 256 + (g * 4 + (qrow & 3)) * 64 + r32;
        dst[0] = (bf16_t)(cvtpk(C.otl[r * 64], 0.f) & 0xffffu); dst[32] = (bf16_t)(cvtpk(C.otl[(16 + r) * 64], 0.f) & 0xffffu); }
}
__device__ __forceinline__ void moba_item(const Ctx& C, const Bufs& B, int b, int h, int qb) {
    const int r32 = C.r32, hi = C.hi, wid = C.wid, own = qb, t = 256 * qb + 32 * wid + r32;
    const size_t bh = (size_t)(b * 4 + h) * SEQ;
    bf16x8 qr[4];
    { const bf16_t* qp = B.Mo + (bh + t) * 64 + hi * 8;
#pragma unroll
      for (int d0 = 0; d0 < 4; ++d0) qr[d0] = *(const bf16x8*)(qp + d0 * 16); }
    LAS unsigned* Uni = (LAS unsigned*)(C.lds + L_UNI); LAS int* List = (LAS int*)(C.lds + L_LIST);
    LBAR();
    if (C.tid < 256) { const u32x4 kmv = *(const u32x4*)(B.KM + (size_t)(b * 4 + h) * 2048 + C.tid * 8); *(LAS u32x4*)(C.lds + L_K0 + (C.tid & 7) * KCS + (C.tid >> 3) * 16) = kmv; }
    if (C.tid == 0) Uni[0] = 0u;
    LBAR();
    unsigned sel = 0u;
    {
        f32x16 gs = f32x16{};
        const LAS char* kb = C.lds + L_K0 + hi * KCS + r32 * 16;
#pragma unroll
        for (int d0 = 0; d0 < 4; ++d0) gs = __builtin_amdgcn_mfma_f32_32x32x16_bf16(*(const LAS bf16x8*)(kb + d0 * 2 * KCS), qr[d0], gs, 0, 0, 0);
        float lo[16], hv[16];
#pragma unroll
        for (int r = 0; r < 16; ++r) { const float ownv = gs[r], oth = swap_other(ownv, hi); lo[r] = hi ? oth : ownv; hv[r] = hi ? ownv : oth; }
        unsigned taken = ~((1u << own) - 1u);
#pragma unroll
        for (int round = 0; round < 3; ++round) {
            float best = -INFINITY; int bi = 32;
#pragma unroll
            for (int n = 0; n < 32; ++n) { const int rr = (n & 3) + 4 * (n >> 3); const float v = ((n >> 2) & 1) ? hv[rr] : lo[rr]; if (!((taken >> n) & 1u) && v > best) { best = v; bi = n; } }
            if (bi < 32) { sel |= 1u << bi; taken |= 1u << bi; }
        }
    }
    { unsigned u = sel;
#pragma unroll
      for (int o_ = 1; o_ < 64; o_ <<= 1) u |= (unsigned)__shfl_xor((int)u, o_);
      if (C.lane == 0) __hip_atomic_fetch_or(&Uni[0], u, __ATOMIC_RELAXED, __HIP_MEMORY_SCOPE_WORKGROUP); }
    LBAR();
    if (C.tid == 0) { int n = 0; unsigned u = Uni[0]; while (u) { const int bpos = __builtin_ctz(u); u &= u - 1; List[n++] = bpos; } Uni[4] = (unsigned)n; }
    LBAR();
    const int nl = (int)Uni[4], nt = 4 * nl + 4;
    const bf16_t* kk = B.Mo + MO_STRIDE + bh * 64; const bf16_t* vv = B.Mo + 2 * MO_STRIDE + bh * 64;
    auto idxM = [&](int it) { return (it < 4 * nl) ? List[it >> 2] : own; };
    auto src = [&](int it, int blk, const bf16_t*& kp, const bf16_t*& vp) { const int T = 4 * blk + ((it < 4 * nl) ? (it & 3) : (it - 4 * nl)); kp = kk + (size_t)T * 4096; vp = vv + (size_t)T * 4096; };
    auto msk = [&](int it, int blk, int& klo, int& khi) { klo = 0; if (it < 4 * nl) { const bool bit = (sel >> blk) & 1u; khi = bit ? 63 : -1; return false; } khi = 32 * wid + r32 - 64 * (it - 4 * nl); return true; };
    RowSt S; rowst_init(S); f32x16 o[2] = {f32x16{}, f32x16{}};
    KVRegs R;
    run_branch<1>(C, nt, idxM, src, msk, qr, S, o, nullptr, false, R, false, nullptr, nullptr);
    merge_branch_n<true>(C, o, S.osum, 1.0f);
#pragma unroll
    for (int r = 0; r < 16; ++r) { const int qrow = crow(r, hi); bf16_t* dst = B.Abr + ((size_t)b * SEQ + 256 * qb + 32 * wid + qrow) * DM + 768 + h * 64 + r32;
        dst[0] = (bf16_t)(cvtpk(C.otl[r * 64], 0.f) & 0xffffu); dst[32] = (bf16_t)(cvtpk(C.otl[(16 + r) * 64], 0.f) & 0xffffu); }
}
}
#define XB_TMO      128
#define XB_XCNT(j)  (256  + 64 * (j))
#define XB_XSUB(j)  (1280 + 64 * (j))
#define XB_XGEN(j)  (2304 + 64 * (j))
#define XB_TOP      3328
#define XB_TOPGEN   3392
#define XCD_BAR_WORDS 3456
#define XB_SPIN_CAP (1u << 18)

__device__ __forceinline__ unsigned xb_ld(unsigned* p)              { return __hip_atomic_load(p, __ATOMIC_RELAXED, __HIP_MEMORY_SCOPE_AGENT); }
__device__ __forceinline__ unsigned xb_add(unsigned* p, unsigned v) { return __hip_atomic_fetch_add(p, v, __ATOMIC_RELAXED, __HIP_MEMORY_SCOPE_AGENT); }
__device__ __forceinline__ unsigned xb_xcc_id() { return (unsigned)__builtin_amdgcn_s_getreg((3 << 11) | 20) & 0xFu; }
#define XB_SPIN(cond, bar) do { unsigned _sp = 0; while (cond) { __builtin_amdgcn_s_sleep(1); \
    if ((++_sp & 255u) == 0u) { if (xb_ld(&(bar)[XB_TMO])) break; if (_sp > XB_SPIN_CAP) { atomicAdd(&(bar)[XB_TMO], 1u); break; } } } } while (0)

struct XcdBarrier {
    unsigned* bar; unsigned x;
    volatile LAS unsigned* st;
};

__device__ __forceinline__ XcdBarrier xcd_barrier_post(unsigned* bar, volatile LAS unsigned* st) {
    XcdBarrier b; b.bar = bar; b.x = xb_xcc_id(); b.st = st;
    if (threadIdx.x == 0) (void)xb_add(&bar[XB_XCNT(b.x)], 1u);
    return b;
}
__device__ __forceinline__ void xcd_barrier_complete(unsigned* bar, unsigned x, unsigned& nloc, unsigned& nx) {
    const unsigned G = gridDim.x * gridDim.y * gridDim.z;
    unsigned sum, cnt, mine, sp = 0u;
    for (;;) {
        sum = 0u; cnt = 0u; mine = 0u;
#pragma unroll
        for (unsigned j = 0; j < 16; ++j) { const unsigned c = xb_ld(&bar[XB_XCNT(j)]); sum += c; cnt += (c > 0u) ? 1u : 0u; mine = (j == x) ? c : mine; }
        if (sum == G) break;
        __builtin_amdgcn_s_sleep(1);
        if ((++sp & 255u) == 0u) { if (xb_ld(&bar[XB_TMO])) break; if (sp > XB_SPIN_CAP) { atomicAdd(&bar[XB_TMO], 1u); break; } }
    }
    nloc = mine > 0u ? mine : 1u; nx = cnt > 0u ? cnt : 1u;
}

__device__ __forceinline__ void xcd_barrier(const XcdBarrier& b) {
    asm volatile("s_waitcnt vmcnt(0)" ::: "memory");
    __syncthreads();
    if (threadIdx.x == 0) {
        unsigned* bar = b.bar;
        __builtin_amdgcn_s_waitcnt(0);
        unsigned nloc = b.st[0], nx = b.st[1];
        if (nloc == 0u) { xcd_barrier_complete(bar, b.x, nloc, nx); b.st[0] = nloc; b.st[1] = nx; }
        const unsigned old = xb_add(&bar[XB_XSUB(b.x)], 1u);
        const unsigned gen = old / nloc;
        if (old + 1u == (gen + 1u) * nloc) {
            __builtin_amdgcn_fence(__ATOMIC_RELEASE, "agent");
            asm volatile("s_waitcnt vmcnt(0)" ::: "memory");
            const unsigned og = xb_add(&bar[XB_TOP], 1u);
            const unsigned tg = og / nx;
            if (og + 1u == (tg + 1u) * nx) xb_add(&bar[XB_TOPGEN], 1u);
            else XB_SPIN(xb_ld(&bar[XB_TOPGEN]) == tg, bar);
            __builtin_amdgcn_fence(__ATOMIC_ACQUIRE, "agent");
            xb_add(&bar[XB_XGEN(b.x)], 1u);
            asm volatile("s_waitcnt vmcnt(0)" ::: "memory");
        } else {
            XB_SPIN(xb_ld(&bar[XB_XGEN(b.x)]) == gen, bar);
            __builtin_amdgcn_fence(__ATOMIC_ACQUIRE, "agent");
            asm volatile("s_waitcnt vmcnt(0)" ::: "memory");
        }
    }
    __syncthreads();
}

constexpr size_t MiB = 1u << 20;
constexpr size_t WS_CTL = 0, WS_ORDER = 4096, WS_BAR = 8192;
constexpr size_t WS_W = 1 * MiB, OFF_WIN = 0, OFF_WGU = 11 * MiB, OFF_WD = 22 * MiB, OFF_WBR = 28 * MiB, OFF_WOUT = 30 * MiB, OFF_W1 = 32 * MiB, OFF_W2 = 34 * MiB,
                 OFF_BIN = 34 * MiB + 65536, OFF_CB1 = OFF_BIN + 32768  , OFF_CB2 = OFF_CB1 + 65536;
constexpr size_t WS_TAB = 36 * MiB, WS_SSP = 38 * MiB, WS_KC = 39 * MiB, WS_KM = 39 * MiB + 512 * 1024, WS_GN = 40 * MiB, WS_XB = 42 * MiB, WS_BIG = 74 * MiB,
                 WS_U = 170 * MiB, WS_QN = 178 * MiB, WS_KV = 194 * MiB, WS_MO = 218 * MiB, WS_MRG = 178 * MiB, WS_END = 242 * MiB;
constexpr int LDS_BYTES = 147456;

__device__ __forceinline__ int dint(int pos) { return (pos >> 1) + 32 * (pos & 1); }
__device__ __forceinline__ int in_orig(int c) {
    if (c < 256) return c;
    if (c < 768) { const int c2 = c - 256; return 256 + (c2 >> 6) * 64 + dint(c2 & 63); }
    if (c < 1536) { const int c2 = c - 768, tt = c2 >> 8, bj = (c2 >> 7) & 1, g = (c2 >> 6) & 1, pos = c2 & 63; return 768 + (2 * tt + bj) * 128 + g * 64 + (bj == 0 ? dint(pos) : pos); }
    if (c < 2304) { const int c2 = c - 1536, part = c2 >> 8, h = (c2 >> 6) & 3, pos = c2 & 63; return 1560 + part * 256 + h * 64 + (part < 2 ? dint(pos) : pos); }
    if (c < 5376) return 2328 + (c - 2304);
    const int c2 = c - 5376; return c2 < 24 ? 1536 + c2 : -1;
}
template <class F> __device__ __forceinline__ void cvt_tile(LAS float* scr, int lane, int k0, int n0, bf16_t* dst, size_t pitch, F f) {
    float vals[32];
#pragma unroll
    for (int i = 0; i < 32; ++i) vals[i] = f(k0 + 2 * i + (lane >> 5), n0 + (lane & 31));
#pragma unroll
    for (int i = 0; i < 32; ++i) scr[(2 * i + (lane >> 5)) * 33 + (lane & 31)] = vals[i];
    asm volatile("s_waitcnt lgkmcnt(0)" ::: "memory");
    const int c = lane & 7;
#pragma unroll
    for (int j = 0; j < 4; ++j) { const int n = (lane >> 3) + 8 * j; const LAS float* s = scr + (8 * c) * 33 + n;
        u32x4 o; o.x = cvtpk(s[0 * 33], s[1 * 33]); o.y = cvtpk(s[2 * 33], s[3 * 33]); o.z = cvtpk(s[4 * 33], s[5 * 33]); o.w = cvtpk(s[6 * 33], s[7 * 33]);
        *(u32x4*)(dst + (size_t)(n0 + n) * pitch + k0 + 8 * c) = o; }
    asm volatile("s_waitcnt lgkmcnt(0)" ::: "memory");
}
template <class F> __device__ __forceinline__ void cvt_tile_scaled(LAS float* scr, int lane, int k0, int n0, bf16_t* dst, size_t pitch, F f, const float* scale, float keep) {
    float vals[32], sc[32];
#pragma unroll
    for (int i = 0; i < 32; ++i) { vals[i] = f(k0 + 2 * i + (lane >> 5), n0 + (lane & 31)); sc[i] = scale[k0 + 2 * i + (lane >> 5)]; }
    __builtin_amdgcn_sched_barrier(0);
#pragma unroll
    for (int i = 0; i < 32; ++i) scr[(2 * i + (lane >> 5)) * 33 + (lane & 31)] = vals[i] * (sc[i] * keep);
    asm volatile("s_waitcnt lgkmcnt(0)" ::: "memory");
    const int c = lane & 7;
#pragma unroll
    for (int j = 0; j < 4; ++j) { const int n = (lane >> 3) + 8 * j; const LAS float* s = scr + (8 * c) * 33 + n;
        u32x4 o; o.x = cvtpk(s[0 * 33], s[1 * 33]); o.y = cvtpk(s[2 * 33], s[3 * 33]); o.z = cvtpk(s[4 * 33], s[5 * 33]); o.w = cvtpk(s[6 * 33], s[7 * 33]);
        *(u32x4*)(dst + (size_t)(n0 + n) * pitch + k0 + 8 * c) = o; }
    asm volatile("s_waitcnt lgkmcnt(0)" ::: "memory");
}
struct Args { const float* in[20]; float* out; unsigned char* ws; };
typedef const __attribute__((address_space(4))) Args* ArgsP;

__device__ __forceinline__ void phase0(ArgsP a, int l, LAS unsigned char* lds, int tid, int lane, int wave, int gw, int NGW) {
    unsigned char* ws = a->ws;
    LAS float* scr = (LAS float*)(lds + wave * 8704);
    const float* attn_norm = a->in[1] + (size_t)l * DM; const float* w_in = a->in[2] + (size_t)l * DM * IN_COLS; const float* b_in = a->in[3] + (size_t)l * IN_COLS;
    const float* pool_w = a->in[4] + (size_t)l * 4 * 64 * 64; const float* pool_scale = a->in[5] + (size_t)l * 256; const float* cmp_pos = a->in[6] + (size_t)l * 2 * 32 * 64;
    const float* cmp_w1 = a->in[7] + (size_t)l * 2 * 2048 * 256; const float* cmp_b1 = a->in[8] + (size_t)l * 2 * 256; const float* cmp_w2 = a->in[9] + (size_t)l * 2 * 256 * 64; const float* cmp_b2 = a->in[10] + (size_t)l * 2 * 64;
    const float* w_br_pool = a->in[11] + (size_t)l * 256 * DM; const float* w_br_nsa = a->in[12] + (size_t)l * 512 * DM; const float* w_br_moba = a->in[13] + (size_t)l * 256 * DM;
    const float* w_out = a->in[14] + (size_t)l * DM * DM; const float* ffn_norm = a->in[15] + (size_t)l * DM; const float* w_gate = a->in[16] + (size_t)l * DM * DFF; const float* w_up = a->in[17] + (size_t)l * DM * DFF;
    const float* w_down = a->in[18] + (size_t)l * DFF * DM;
    bf16_t* Win = (bf16_t*)(ws + WS_W + OFF_WIN); bf16_t* Wgu = (bf16_t*)(ws + WS_W + OFF_WGU); bf16_t* Wd = (bf16_t*)(ws + WS_W + OFF_WD); bf16_t* Wbr = (bf16_t*)(ws + WS_W + OFF_WBR);
    bf16_t* Wout = (bf16_t*)(ws + WS_W + OFF_WOUT); bf16_t* W1t = (bf16_t*)(ws + WS_W + OFF_W1); bf16_t* W2t = (bf16_t*)(ws + WS_W + OFF_W2);
    float* bin = (float*)(ws + WS_W + OFF_BIN); float* cb1 = (float*)(ws + WS_W + OFF_CB1); float* cb2 = (float*)(ws + WS_W + OFF_CB2);
    constexpr int I_A = 16 * 176, I_B = 16 * 176, I_C = 44 * 32, I_D = 16 * 32, I_E = 16 * 32, I_F = 2 * 32 * 8, I_G = 2 * 4 * 2;
    constexpr int NITEMS = I_A + I_B + I_C + I_D + I_E + I_F + I_G;
    for (int it = gw; it < NITEMS; it += NGW) {
        int r = it;
        if (r < I_A) { const int kb = r / 176, nb = r % 176; { const int o = in_orig(32 * nb + (lane & 31)); const float* wc = w_in + (o >= 0 ? o : 0); const float keep = o >= 0 ? 1.f : 0.f;
            cvt_tile_scaled(scr, lane, 64 * kb, 32 * nb, Win, DM, [&](int k, int) { return wc[(size_t)k * IN_COLS]; }, attn_norm, keep); } continue; } r -= I_A;
        if (r < I_B) { const int kb = r / 176, nb = r % 176; { const int n = 32 * nb + (lane & 31), j = (n >> 8) * 128 + (n & 127); const float* wc = (((n >> 7) & 1) ? w_up : w_gate) + j;
            cvt_tile_scaled(scr, lane, 64 * kb, 32 * nb, Wgu, DM, [&](int k, int) { return wc[(size_t)k * DFF]; }, ffn_norm, 1.f); } continue; } r -= I_B;
        if (r < I_C) { const int kb = r / 32, nb = r % 32; cvt_tile(scr, lane, 64 * kb, 32 * nb, Wd, DFF, [&](int k, int n) { return w_down[(size_t)k * DM + n]; }); continue; } r -= I_C;
        if (r < I_D) { const int kb = r / 32, nb = r % 32; cvt_tile(scr, lane, 64 * kb, 32 * nb, Wout, DM, [&](int k, int n) { return w_out[(size_t)k * DM + n]; }); continue; } r -= I_D;
        if (r < I_E) { const int kb = r / 32, nb = r % 32;
            if (kb < 4) { }
            else if (kb < 12) cvt_tile(scr, lane, 64 * kb, 32 * nb, Wbr, DM, [&](int k, int n) { return w_br_nsa[(size_t)(k - 256) * DM + n]; });
            else cvt_tile(scr, lane, 64 * kb, 32 * nb, Wbr, DM, [&](int k, int n) { return w_br_moba[(size_t)(k - 768) * DM + n]; });
            continue; } r -= I_E;
        if (r < I_F) { const int kv = r >> 8, kb = (r >> 3) & 31, nb = r & 7; const float* w1 = cmp_w1 + (size_t)kv * 2048 * 256;
            cvt_tile(scr, lane, 64 * kb, 32 * nb, W1t + (size_t)kv * 256 * 2048, 2048, [&](int k, int n) { const int pos = k & 63, d = kv == 0 ? dint(pos) : pos; return w1[(size_t)((k & ~63) + d) * 256 + n]; }); continue; } r -= I_F;
        { const int kv = r >> 3, kb = (r >> 1) & 3, nb = r & 1; const float* w2 = cmp_w2 + (size_t)kv * 256 * 64;
            cvt_tile(scr, lane, 64 * kb, 32 * nb, W2t + (size_t)kv * 64 * 256, 256, [&](int k, int n) { return w2[(size_t)k * 64 + (kv == 0 ? dint(n) : n)]; }); }
    }
    const int gt = gw * 64 + lane, NGT = NGW * 64;
    for (int c = gt; c < NIN; c += NGT) { const int o = in_orig(c); bin[c] = o >= 0 ? b_in[o] : 0.f; }
    for (int idx = gt; idx < 32 * 512; idx += NGT) { const int c = idx >> 9, e = idx & 511, kv = e >> 8, n = e & 255; const float* w1 = cmp_w1 + (size_t)kv * 2048 * 256 + (size_t)(64 * c) * 256 + n; const float* pe = cmp_pos + (size_t)kv * 2048 + 64 * c;
        float s = c == 0 ? cmp_b1[kv * 256 + n] : 0.f;
#pragma unroll
        for (int k0 = 0; k0 < 64; k0 += 32) { float av[32], bv[32];
#pragma unroll
            for (int k = 0; k < 32; ++k) { av[k] = pe[k0 + k]; bv[k] = w1[(size_t)(k0 + k) * 256]; }
            __builtin_amdgcn_sched_barrier(0);
#pragma unroll
            for (int k = 0; k < 32; ++k) s += av[k] * bv[k]; }
        cb1[idx] = s; }
    for (int idx = gt; idx < 256 * DM; idx += NGT) { const int k = idx >> 10, n = idx & 1023, g64 = k & ~63; float s = 0.f;
        const f32x4* pw4 = (const f32x4*)(pool_w + (size_t)k * 64); const f32x4* ps4 = (const f32x4*)(pool_scale + g64);
#pragma unroll
        for (int j0 = 0; j0 < 64; j0 += 32) { f32x4 pw[8], psc[8]; float wb[32];
#pragma unroll
            for (int q = 0; q < 8; ++q) { pw[q] = pw4[j0 / 4 + q]; psc[q] = ps4[j0 / 4 + q]; }
#pragma unroll
            for (int j = 0; j < 32; ++j) wb[j] = w_br_pool[(size_t)(g64 + j0 + j) * DM + n];
            __builtin_amdgcn_sched_barrier(0);
#pragma unroll
            for (int j = 0; j < 32; ++j) s += pw[j >> 2][j & 3] * psc[j >> 2][j & 3] * wb[j]; }
        Wbr[(size_t)n * DM + k] = (bf16_t)(cvtpk(s, 0.f) & 0xffffu); }
    for (int e = gt; e < 128; e += NGT) { const int kv = e >> 6, n = e & 63; cb2[e] = cmp_b2[kv * 64 + (kv == 0 ? dint(n) : n)]; }
    if (l == 0) {
        float* tab = (float*)(ws + WS_TAB);
        for (int e = gt; e < SEQ * 32; e += NGT) { const int t = e >> 5, f = e & 31; const float inv = powf(10000.0f, -(float)(2 * f) / 64.0f); const float ang = (float)t * inv;
            const double ad = (double)ang, kq = rint(ad * 0.15915494309189535); double rr = fma(-kq, 6.283185307179586, ad); rr = fma(-kq, 2.4492935982947064e-16, rr);
            const float rf = (float)rr; tab[2 * e] = __cosf(rf); tab[2 * e + 1] = __sinf(rf); }
        const float* x = a->in[0]; bf16_t* xb = (bf16_t*)(ws + WS_XB); float* ssp = (float*)(ws + WS_SSP);
        for (int m0 = 2 * gw; m0 < MTOK; m0 += 2 * NGW) { f32x4 v[2][4]; float s[2] = {0.f, 0.f};
#pragma unroll
            for (int q = 0; q < 2; ++q) { const f32x4* xr = (const f32x4*)(x + (size_t)(m0 + q) * DM) + lane;
#pragma unroll
                for (int j = 0; j < 4; ++j) v[q][j] = xr[64 * j]; }
#pragma unroll
            for (int q = 0; q < 2; ++q) {
#pragma unroll
                for (int j = 0; j < 4; ++j) s[q] += (v[q][j][0] * v[q][j][0] + v[q][j][1] * v[q][j][1]) + (v[q][j][2] * v[q][j][2] + v[q][j][3] * v[q][j][3]);
#pragma unroll
                for (int o = 1; o < 64; o <<= 1) s[q] += __shfl_xor(s[q], o);
                u32x2* o8 = (u32x2*)(xb + (size_t)(m0 + q) * DM) + lane;
#pragma unroll
                for (int j = 0; j < 4; ++j) o8[64 * j] = (u32x2){cvtpk(v[q][j][0], v[q][j][1]), cvtpk(v[q][j][2], v[q][j][3])};
                if (lane < 16) ssp[(size_t)(m0 + q) * 16 + lane] = lane == 0 ? s[q] : 0.f; } }
        int* order = (int*)(ws + WS_ORDER);
        auto cost = [](int id) { if (id < 512) { const int i = id & 127; return 10 * ((i + 1) + ((i < 8 ? i : 8) + 1) + 10) + 16 * ((4 * i + 3 + 63) >> 6); } const int qb = (id - 512) & 31; return 7 * (4 * qb + 3) + 50; };
        for (int id = gw; id < 768; id += NGW) { const int mc = cost(id); int rk = 0;
            for (int j = lane; j < 768; j += 64) { const int cj = cost(j); rk += (cj > mc || (cj == mc && j < id)) ? 1 : 0; }
#pragma unroll
            for (int o = 1; o < 64; o <<= 1) rk += __shfl_xor(rk, o);
            if (lane == 0) order[rk] = id; }
    }
}
__device__ __forceinline__ float gelu_tanh(float x) { const float u = 0.7978845608028654f * (x + 0.044715f * x * x * x); const float th = 1.f - 2.f * __builtin_amdgcn_rcpf(1.f + __expf(2.f * u)); return 0.5f * x * (1.f + th); }
__device__ __forceinline__ void phase2(ArgsP a, LAS unsigned char* lds, int tid, int lane, int wave, int G) {
    unsigned char* ws = a->ws;
    const bf16_t* KV = (const bf16_t*)(ws + WS_KV); const bf16_t* W1t = (const bf16_t*)(ws + WS_W + OFF_W1); const bf16_t* W2t = (const bf16_t*)(ws + WS_W + OFF_W2);
    const float* cb1 = (const float*)(ws + WS_W + OFF_CB1); const float* cb2 = (const float*)(ws + WS_W + OFF_CB2);
    bf16_t* KC = (bf16_t*)(ws + WS_KC);
    LAS bf16_t* hid = (LAS bf16_t*)lds;
    const int arow = lane & 15, kq = lane >> 4;
    for (int task = blockIdx.x; task < 256; task += G) {
        const int kv = task >> 7, bgi = (task >> 5) & 3, nt = task & 31;
        const bf16_t* src = KV + (size_t)kv * att::KV_STRIDE + (size_t)bgi * SEQ * 64;
        const int nrow = 16 * nt + arow, neff = nrow < 510 ? nrow : 510;
        const bf16_t* ap = src + (size_t)neff * 1024 + kq * 8;
        const bf16_t* bp0 = W1t + (size_t)kv * 256 * 2048 + (size_t)(32 * wave + arow) * 2048 + kq * 8; const bf16_t* bp1 = bp0 + 16 * 2048;
        f32x4 c0 = {0.f, 0.f, 0.f, 0.f}, c1 = {0.f, 0.f, 0.f, 0.f};
        float bb0 = 0.f, bb1 = 0.f;
        { const int col0 = 32 * wave + arow; float t0[32], t1[32];
#pragma unroll
          for (int c = 0; c < 32; ++c) { t0[c] = cb1[c * 512 + kv * 256 + col0]; t1[c] = cb1[c * 512 + kv * 256 + col0 + 16]; }
          __builtin_amdgcn_sched_barrier(0);
#pragma unroll
          for (int c = 0; c < 32; ++c) { bb0 += t0[c]; bb1 += t1[c]; } }
#pragma unroll 1
        for (int ks0 = 0; ks0 < 64; ks0 += 8) { bf16x8 av[8], b0[8], b1[8];
#pragma unroll
            for (int q = 0; q < 8; ++q) { av[q] = *(const bf16x8*)(ap + (ks0 + q) * 32); b0[q] = *(const bf16x8*)(bp0 + (ks0 + q) * 32); b1[q] = *(const bf16x8*)(bp1 + (ks0 + q) * 32); }
            __builtin_amdgcn_sched_barrier(0);
#pragma unroll
            for (int q = 0; q < 8; ++q) { c0 = __builtin_amdgcn_mfma_f32_16x16x32_bf16(av[q], b0[q], c0, 0, 0, 0); c1 = __builtin_amdgcn_mfma_f32_16x16x32_bf16(av[q], b1[q], c1, 0, 0, 0); } }
        { const int col0 = 32 * wave + arow;
#pragma unroll
          for (int j = 0; j < 4; ++j) { const int row = kq * 4 + j; hid[row * 264 + col0] = (bf16_t)(cvtpk(gelu_tanh(c0[j] + bb0), 0.f) & 0xffffu); hid[row * 264 + col0 + 16] = (bf16_t)(cvtpk(gelu_tanh(c1[j] + bb1), 0.f) & 0xffffu); } }
        LBAR();
        if (wave < 4) {
            const bf16_t* bp = W2t + (size_t)kv * 64 * 256 + (size_t)(16 * wave + arow) * 256 + kq * 8; f32x4 c = {0.f, 0.f, 0.f, 0.f};
            bf16x8 bv[8];
#pragma unroll
            for (int ks = 0; ks < 8; ++ks) bv[ks] = *(const bf16x8*)(bp + ks * 32);
            __builtin_amdgcn_sched_barrier(0);
#pragma unroll
            for (int ks = 0; ks < 8; ++ks) { const bf16x8 av = *(const LAS bf16x8*)(hid + arow * 264 + kq * 8 + ks * 32); c = __builtin_amdgcn_mfma_f32_16x16x32_bf16(av, bv[ks], c, 0, 0, 0); }
            const int col = 16 * wave + arow; const float bb = cb2[kv * 64 + col];
#pragma unroll
            for (int j = 0; j < 4; ++j) { const int n = 16 * nt + kq * 4 + j; KC[((size_t)(kv * 4 + bgi) * 512 + n) * 64 + col] = n < 511 ? (bf16_t)(cvtpk(c[j] + bb, 0.f) & 0xffffu) : (bf16_t)0; }
        }
        LBAR();
    }
    const int gt = blockIdx.x * 512 + tid, NGT = G * 512;
    { const bf16_t* MoK = (const bf16_t*)(ws + WS_MO) + att::MO_STRIDE; bf16_t* KM = (bf16_t*)(ws + WS_KM); LAS float* part = (LAS float*)(lds + 16384);
      for (int blk = blockIdx.x; blk < 256; blk += G) { const bf16_t* p = MoK + ((size_t)blk * 256 + 32 * wave) * 64 + lane; float s = 0.f;
#pragma unroll
          for (int r0 = 0; r0 < 32; r0 += 16) { unsigned short tv[16];
#pragma unroll
              for (int r = 0; r < 16; ++r) tv[r] = p[(size_t)(r0 + r) * 64];
              __builtin_amdgcn_sched_barrier(0);
#pragma unroll
              for (int r = 0; r < 16; ++r) s += __uint_as_float((unsigned)tv[r] << 16); }
          part[wave * 64 + lane] = s;
          LBAR();
          if (wave == 0) { float t = 0.f;
#pragma unroll
              for (int w = 0; w < 8; ++w) t += part[w * 64 + lane];
              KM[(size_t)blk * 64 + lane] = (bf16_t)(cvtpk(t * (1.0f / 256.0f), 0.f) & 0xffffu); }
          LBAR(); } }
    { const bf16_t* U = (const bf16_t*)(ws + WS_U); bf16_t* Abr = (bf16_t*)(ws + WS_XB);
      for (int e = gt; e < MTOK * 32; e += NGT) { const int row = e >> 5, c8 = e & 31, s = row & (SEQ - 1), w = 2 << (c8 >> 3), cnt = (s + 1 < w) ? s + 1 : w;
          float acc[8] = {0.f, 0.f, 0.f, 0.f, 0.f, 0.f, 0.f, 0.f}; u32x4 v0 = {0u, 0u, 0u, 0u};
#pragma unroll
          for (int i0 = 0; i0 < 16; i0 += 8) { if (i0 >= cnt) break; u32x4 v[8];
#pragma unroll
              for (int i = 0; i < 8; ++i) v[i] = (i0 + i < cnt) ? *(const u32x4*)(U + (size_t)(row - i0 - i) * 256 + c8 * 8) : (u32x4){0u, 0u, 0u, 0u};
              __builtin_amdgcn_sched_barrier(0);
              if (i0 == 0) v0 = v[0];
#pragma unroll
              for (int i = 0; i < 8; ++i)
#pragma unroll
                  for (int q = 0; q < 4; ++q) { acc[2 * q] += bflo(v[i][q]); acc[2 * q + 1] += bfhi(v[i][q]); } }
          const float ic = 1.0f / (float)cnt; u32x4 o;
#pragma unroll
          for (int q = 0; q < 4; ++q) o[q] = cvtpk(acc[2 * q] * ic - bflo(v0[q]), acc[2 * q + 1] * ic - bfhi(v0[q]));
          *(u32x4*)(Abr + (size_t)row * DM + c8 * 8) = o; } }
}
__global__ void __launch_bounds__(512, 2) fwd_megakernel(Args a) {
    extern __shared__ __attribute__((aligned(16))) unsigned char lds_raw[];
    LAS unsigned char* lds = (LAS unsigned char*)lds_raw;
    cg::grid_group grid = cg::this_grid();
    const int G = gridDim.x;
    volatile LAS unsigned* bst = (volatile LAS unsigned*)(lds + LDS_BYTES - 64);
    if (threadIdx.x < 16) bst[threadIdx.x] = 0u;
    __syncthreads();
    const ArgsP ap0 = (ArgsP)__builtin_amdgcn_kernarg_segment_ptr();
#define PHASE_ARGS ArgsP a_ = ap0; asm volatile("" : "+s"(a_)); unsigned char* ws = a_->ws; unsigned* ctl = (unsigned*)(ws + WS_CTL); float* ssp = (float*)(ws + WS_SSP); const float* tab = (const float*)(ws + WS_TAB); \
    bf16_t* XB = (bf16_t*)(ws + WS_XB); bf16_t* BIG = (bf16_t*)(ws + WS_BIG); bf16_t* MRG = (bf16_t*)(ws + WS_MRG); (void)ctl; (void)ssp; (void)tab; (void)XB; (void)BIG; (void)MRG;
    XcdBarrier xbar = xcd_barrier_post((unsigned*)(ap0->ws + WS_BAR), bst);
    bool first_sync = true;
#define GRID_SYNC() do { if (first_sync) { grid.sync(); first_sync = false; } else xcd_barrier(xbar); } while (0)
    for (int l = 0; l < DEPTH; ++l) {
        int tid_ = threadIdx.x; asm volatile("" : "+v"(tid_));
        const int tid = tid_, lane = tid & 63, wave = __builtin_amdgcn_readfirstlane(tid >> 6), gw = blockIdx.x * 8 + wave, NGW = G * 8;
        { PHASE_ARGS phase0(a_, l, lds, tid, lane, wave, gw, NGW); }
        GRID_SYNC();
        { PHASE_ARGS pg8::Gemm g{XB, (const bf16_t*)(ws + WS_W + OFF_WIN), MTOK, NIN, DM}; pg8::StaticOrder S; S.init(MTOK, NIN, G, (int)blockIdx.x);
          EpiInProj E{ssp, (const float*)(ws + WS_W + OFF_BIN), tab, (bf16_t*)(ws + WS_U), (bf16_t*)(ws + WS_QN), (bf16_t*)(ws + WS_KV), (bf16_t*)(ws + WS_MO), BIG, (bf16_t*)(ws + WS_GN)};
          pg8::gemm_phase(lds, g, S, E); }
        GRID_SYNC();
        { PHASE_ARGS phase2(a_, lds, tid, lane, wave, G); }
        GRID_SYNC();
        { PHASE_ARGS
          att::Bufs B{(const bf16_t*)(ws + WS_QN), (const bf16_t*)(ws + WS_KV), (const bf16_t*)(ws + WS_MO), (const bf16_t*)(ws + WS_KC), (const bf16_t*)(ws + WS_KM), (const bf16_t*)(ws + WS_GN), XB};
          const int* order = (const int*)(ws + WS_ORDER); LAS int* slot = (LAS int*)(lds + att::L_END);
          if (wave >= 4) __builtin_amdgcn_s_setprio(1);
          for (;;) {
              LBAR();
              if (tid == 0) slot[0] = (int)atomicAdd(ctl + l, 1u);
              LBAR();
              const int item = slot[0];
              if (item >= 768) break;
              const int id = order[item];
              int tl = threadIdx.x; asm volatile("" : "+v"(tl));
              const int tid = tl, lane = tid & 63, wave = __builtin_amdgcn_readfirstlane(tid >> 6);
              att::Ctx C; C.lds = (LAS char*)lds; C.wsf = (LAS float*)(lds + att::L_WSF) + wave * 64; C.otl = (LAS float*)(lds + att::L_OT) + wave * 2048 + lane; C.tid = tid; C.wid = wave; C.lane = lane; C.r32 = lane & 31; C.hi = lane >> 5;
              C.vbl = ((lane >> 4) & 1) * 32 + (lane & 3) * 8 + (4 * (lane >> 5) + ((lane & 15) >> 2)) * 64;
              if (id < 512) att::nsa_item(C, B, id >> 8, (id >> 7) & 1, id & 127);
              else { const int x = id - 512; att::moba_item(C, B, x >> 7, (x >> 5) & 3, x & 31); }
          }
          __builtin_amdgcn_s_setprio(0); }
        GRID_SYNC();
        { PHASE_ARGS pg8::Gemm g{XB, (const bf16_t*)(ws + WS_W + OFF_WBR), MTOK, DM, DM}; pg8::StaticOrder S; S.init(MTOK, DM, G, (int)blockIdx.x);
          EpiBranch E{BIG, MRG}; pg8::gemm_phase(lds, g, S, E); }
        GRID_SYNC();
        { PHASE_ARGS pg8::Gemm g{MRG, (const bf16_t*)(ws + WS_W + OFF_WOUT), MTOK, DM, DM}; pg8::StaticOrder S; S.init(MTOK, DM, G, (int)blockIdx.x);
          bf16_t* RES = (bf16_t*)a_->out; EpiResid E{l == 0 ? a_->in[0] : nullptr, RES, XB, nullptr, ssp};   pg8::gemm_phase(lds, g, S, E); }
        GRID_SYNC();
        { PHASE_ARGS pg8::Gemm g{XB, (const bf16_t*)(ws + WS_W + OFF_WGU), MTOK, NGU, DM}; pg8::StaticOrder S; S.init(MTOK, NGU, G, (int)blockIdx.x);
          EpiSwiGLU E{ssp, BIG}; pg8::gemm_phase(lds, g, S, E); }
        GRID_SYNC();
        { PHASE_ARGS pg8::Gemm g{BIG, (const bf16_t*)(ws + WS_W + OFF_WD), MTOK, DM, DFF}; pg8::StaticOrder S; S.init(MTOK, DM, G, (int)blockIdx.x);
          bf16_t* RES = (bf16_t*)a_->out; EpiResid E{nullptr, XB, XB, l + 1 < DEPTH ? RES : nullptr, ssp};   pg8::gemm_phase(lds, g, S, E); }
        GRID_SYNC();
    }
    { PHASE_ARGS const float* fn = a_->in[19]; float* outp = a_->out; const int lane = threadIdx.x & 63, gw = blockIdx.x * 8 + (threadIdx.x >> 6), NGW = G * 8;
      const f32x4* gr = (const f32x4*)fn + lane; f32x4 gv[4];
#pragma unroll
      for (int j = 0; j < 4; ++j) gv[j] = gr[64 * j];
      for (int m0 = 2 * gw; m0 < MTOK; m0 += 2 * NGW) { u32x2 w[2][4]; float rstd[2];
#pragma unroll
          for (int q = 0; q < 2; ++q) { const u32x2* xr = (const u32x2*)(XB + (size_t)(m0 + q) * DM) + lane; rstd[q] = row_rstd(ssp, m0 + q);
#pragma unroll
              for (int j = 0; j < 4; ++j) w[q][j] = xr[64 * j]; }
#pragma unroll
          for (int q = 0; q < 2; ++q) { f32x4* orow = (f32x4*)(outp + (size_t)(m0 + q) * DM) + lane;
#pragma unroll
              for (int j = 0; j < 4; ++j) { const f32x4 v = {bflo(w[q][j][0]), bfhi(w[q][j][0]), bflo(w[q][j][1]), bfhi(w[q][j][1])}; orow[64 * j] = v * rstd[q] * gv[j]; } } } }
}

extern "C" void kernel_launch(void* const* d_in, const int* in_sizes, int n_in, void* d_out, int out_size, void* d_ws, size_t ws_size, hipStream_t stream) {
    static int grid = 0;
    if (grid == 0) {
        if (n_in != 20 || in_sizes[0] != MTOK * DM || out_size != MTOK * DM || ws_size < WS_END) { fprintf(stderr, "kernel_launch: unexpected shapes / workspace (n_in %d, ws %zu)\n", n_in, ws_size); grid = -1; return; }
        int dev = 0, cus = 0, per_cu = 0;
        if (hipGetDevice(&dev) != hipSuccess || hipDeviceGetAttribute(&cus, hipDeviceAttributeMultiprocessorCount, dev) != hipSuccess) { grid = -1; return; }
        if (hipFuncSetAttribute((const void*)fwd_megakernel, hipFuncAttributeMaxDynamicSharedMemorySize, LDS_BYTES) != hipSuccess) { fprintf(stderr, "kernel_launch: hipFuncSetAttribute failed\n"); grid = -1; return; }
        if (hipOccupancyMaxActiveBlocksPerMultiprocessor(&per_cu, (const void*)fwd_megakernel, 512, LDS_BYTES) != hipSuccess || per_cu < 1) { fprintf(stderr, "kernel_launch: occupancy query failed (%d)\n", per_cu); (void)hipGetLastError(); grid = -1; return; }
        grid = cus * per_cu;
    }
    if (grid < 0) return;
    if (hipMemsetAsync((char*)d_ws + WS_CTL, 0, 32768, stream) != hipSuccess) { fprintf(stderr, "kernel_launch: memset failed\n"); return; }
    Args a{};
    for (int i = 0; i < 20; ++i) a.in[i] = (const float*)d_in[i];
    a.out = (float*)d_out; a.ws = (unsigned char*)d_ws;
    void* args[] = {&a};
    const hipError_t e = hipLaunchCooperativeKernel((const void*)fwd_megakernel, dim3(grid), dim3(512), args, LDS_BYTES, stream);
    if (e != hipSuccess) fprintf(stderr, "kernel_launch: cooperative launch failed: %s (grid %d)\n", hipGetErrorString(e), grid);
}
```

```cpp
#include <hip/hip_runtime.h>
#include <hip/hip_cooperative_groups.h>
#include <cstdio>
#include <cstdint>
#include <cmath>
namespace cg = cooperative_groups;

#define LAS __attribute__((address_space(3)))
typedef unsigned short bf16_t;
typedef short bf16x8 __attribute__((ext_vector_type(8)));
typedef short s16x4 __attribute__((ext_vector_type(4)));
typedef float f32x2 __attribute__((ext_vector_type(2)));
typedef float f32x4 __attribute__((ext_vector_type(4)));
typedef float f32x16 __attribute__((ext_vector_type(16)));
typedef unsigned u32x4 __attribute__((ext_vector_type(4)));
typedef unsigned u32x2 __attribute__((ext_vector_type(2)));
typedef __bf16 bf16x2_t __attribute__((ext_vector_type(2)));

constexpr int SEQ = 8192, BATCH = 2, MTOK = BATCH * SEQ, DM = 1024, DEPTH = 2;
constexpr int IN_COLS = 5400, NIN = 5632, DFF = 2816, NGU = 5632;
constexpr float RMS_EPS = 1e-6f;
constexpr float QSCALE = 0.125f * 1.4426950408889634f;

__device__ __forceinline__ unsigned cvtpk(float lo, float hi) { f32x2 v = {lo, hi}; bf16x2_t b = __builtin_convertvector(v, bf16x2_t); return __builtin_bit_cast(unsigned, b); }
__device__ __forceinline__ float bflo(unsigned w) { return __uint_as_float(w << 16); }
__device__ __forceinline__ float bfhi(unsigned w) { return __uint_as_float(w & 0xffff0000u); }
__device__ __forceinline__ float sigmoidf_(float x) { return __builtin_amdgcn_rcpf(1.f + __expf(-x)); }

namespace pg8 {
constexpr int BM = 256, BK = 64, HALF = 128, HTB = HALF * BK * 2, STAGE_BYTES = 8 * HTB, NXCD = 8, WGM = 8;
__host__ __device__ __forceinline__ int lds_byte(int r, int c) { const int st = (r >> 4) * 2 + (c >> 5), rr = r & 15, cc = c & 31, ob = rr * 64 + cc * 2; return st * 1024 + (ob ^ (((ob >> 9) & 1) << 5)); }
__host__ __device__ __forceinline__ void stage_rc(int b, int& R, int& C) { const int st = b / 1024, sb = b % 1024, swz = sb ^ (((sb >> 9) & 1) << 5); R = (st >> 1) * 16 + swz / 64; C = (st & 1) * 32 + (swz % 64) / 2; }
__host__ __device__ __forceinline__ int perm32(int rho) { const int n = rho >> 4, i = rho & 15; return 8 * (i >> 2) + 4 * n + (i & 3); }
struct Unit { int pm, pn; };
struct Gemm { const bf16_t* A; const bf16_t* Bt; int M, N, K; };
struct StaticOrder {
    int nM, nN, nwg, G, c;
    __host__ __device__ void init(int M, int N, int G_, int c_) { nM = M / BM; nN = N / BM; nwg = nM * nN; G = G_; c = c_; }
    __host__ __device__ bool next(int i, Unit& u) const {
        const long L = (long)i * G + c; if (L >= nwg) return false;
        int wgid = (int)L; { const int q = nwg / NXCD, r = nwg % NXCD, xcd = wgid % NXCD, off = wgid / NXCD; wgid = (xcd < r ? xcd * (q + 1) : r * (q + 1) + (xcd - r) * q) + off; }
        const int nig = WGM * nN, gid = wgid / nig, fm = gid * WGM, gsz = (nM - fm) < WGM ? (nM - fm) : WGM;
        u.pm = fm + ((wgid % nig) % gsz); u.pn = (wgid % nig) / gsz; return true;
    }
};
template <class Epi, class Sched>
__device__ __forceinline__ void gemm_phase(LAS unsigned char* lds, const Gemm g, const Sched& S, const Epi& E) {
    int tid_ = threadIdx.x; asm volatile("" : "+v"(tid_));
    const int tid = tid_, wid = __builtin_amdgcn_readfirstlane(tid >> 6), lane = tid & 63, wr = wid >> 2, wc = wid & 3, fr = lane & 15, fq = lane >> 4;
    const int K = g.K, nt = K / BK;
    unsigned voffA[2], voffB[2];
#pragma unroll
    for (int i = 0; i < 2; ++i) { int R, C; stage_rc(tid * 16 + i * 8192, R, C); const int Rb = ((R & ~31) + perm32(R & 31));
        voffA[i] = (unsigned)(R * K + C) * 2u; voffB[i] = (unsigned)(Rb * K + C) * 2u; }
    const size_t kstep = (size_t)(BK * 2);
    const size_t hstep = (size_t)HALF * K * 2;
    const size_t tstep = 2 * hstep;
    const unsigned ldsw = (unsigned)wid * 1024u;
    const int aoff = lds_byte(wr * 64 + fr, fq * 8), boff = lds_byte(wc * 32 + fr, fq * 8);
#define PG8_SA(b, h) (((b) * 2 + (h)) * HTB)
#define PG8_SB(b, h) ((4 + (b) * 2 + (h)) * HTB)
#define PG8_STAGE(bufoff, gbase, voff) do { _Pragma("unroll") for (int _i = 0; _i < 2; ++_i) \
        __builtin_amdgcn_global_load_lds((const unsigned*)((const char*)(gbase) + (voff)[_i]), (LAS unsigned*)(lds + (bufoff) + ldsw + _i * 8192), 16, 0, 0); } while (0)
#define PG8_LDA(dst, b, h) do { _Pragma("unroll") for (int m = 0; m < 4; ++m) _Pragma("unroll") for (int k = 0; k < 2; ++k) dst[m][k] = *(const LAS bf16x8*)(lds + PG8_SA(b, h) + aoff + m * 2048 + k * 1024); } while (0)
#define PG8_LDB(dst, b, h) do { _Pragma("unroll") for (int n = 0; n < 2; ++n) _Pragma("unroll") for (int k = 0; k < 2; ++k) dst[n][k] = *(const LAS bf16x8*)(lds + PG8_SB(b, h) + boff + n * 2048 + k * 1024); } while (0)
#define PG8_MMA(ai, bj, At, Bt) do { __builtin_amdgcn_s_setprio(1); _Pragma("unroll") for (int m = 0; m < 4; ++m) _Pragma("unroll") for (int n = 0; n < 2; ++n) _Pragma("unroll") for (int k = 0; k < 2; ++k) \
        acc[ai][bj][m][n] = __builtin_amdgcn_mfma_f32_16x16x32_bf16(Bt[n][k], At[m][k], acc[ai][bj][m][n], 0, 0, 0); __builtin_amdgcn_s_setprio(0); } while (0)
#define PG8_WAIT_V(n) asm volatile("s_waitcnt vmcnt(" #n ")" ::: "memory")
#define PG8_WAIT_L(n) asm volatile("s_waitcnt lgkmcnt(" #n ")" ::: "memory")
#define PG8_BAR __builtin_amdgcn_s_barrier()
#define PG8_SCHED __builtin_amdgcn_sched_barrier(0)
    Unit cur, nxt; int ui = 0;
    if (!S.next(0, cur)) return;
    f32x4 acc[2][2][4][2];
#pragma unroll
    for (int a = 0; a < 2; ++a)
#pragma unroll
        for (int b = 0; b < 2; ++b)
#pragma unroll
            for (int m = 0; m < 4; ++m)
#pragma unroll
                for (int n = 0; n < 2; ++n) acc[a][b][m][n] = (f32x4){0.f, 0.f, 0.f, 0.f};
    bf16x8 At[4][2], B0[2][2], B1[2][2];
    const char* cA = (const char*)g.A + (size_t)cur.pm * tstep; const char* cB = (const char*)g.Bt + (size_t)cur.pn * tstep;
    PG8_STAGE(PG8_SB(0, 0), cB, voffB); PG8_STAGE(PG8_SB(0, 1), cB + hstep, voffB); PG8_STAGE(PG8_SA(0, 0), cA, voffA); PG8_STAGE(PG8_SA(0, 1), cA + hstep, voffA);
    if (wr == 1) PG8_BAR;
    PG8_WAIT_V(2); PG8_BAR;
    PG8_STAGE(PG8_SB(1, 0), cB + kstep, voffB); PG8_STAGE(PG8_SA(1, 0), cA + kstep, voffA); PG8_STAGE(PG8_SB(1, 1), cB + hstep + kstep, voffB);
    PG8_WAIT_V(6); PG8_BAR;
    for (;;) {
        const bool has_next = S.next(ui + 1, nxt);
        const char* nA = has_next ? (const char*)g.A + (size_t)nxt.pm * tstep : cA; const char* nB = has_next ? (const char*)g.Bt + (size_t)nxt.pn * tstep : cB;
        for (int t = 0; t < nt; t += 2) {
            const bool last = (t == nt - 2);
            const char* a1 = cA + (size_t)(t + 1) * kstep;
            const char* a2 = last ? nA : cA + (size_t)(t + 2) * kstep; const char* b2 = last ? nB : cB + (size_t)(t + 2) * kstep;
            const char* a3 = a2 + kstep; const char* b3 = b2 + kstep;
            if constexpr (Epi::KHOOK) { if (t == 4 || t == 12) { PG8_SCHED; E.khook(acc, cur, t, wr, wc, fr, fq); PG8_SCHED; } }
            PG8_LDB(B0, 0, 0); PG8_LDB(B1, 0, 1); PG8_SCHED; PG8_LDA(At, 0, 0); PG8_STAGE(PG8_SA(1, 1), a1 + hstep, voffA);
            PG8_WAIT_V(8); PG8_WAIT_L(0); PG8_BAR; PG8_MMA(0, 0, At, B0); PG8_MMA(0, 1, At, B1); PG8_BAR; PG8_SCHED;
            PG8_LDA(At, 0, 1); PG8_STAGE(PG8_SB(0, 0), b2, voffB); PG8_STAGE(PG8_SB(0, 1), b2 + hstep, voffB); PG8_STAGE(PG8_SA(0, 0), a2, voffA);
            PG8_WAIT_V(8); PG8_WAIT_L(0); PG8_BAR; PG8_MMA(1, 0, At, B0); PG8_MMA(1, 1, At, B1); PG8_BAR; PG8_SCHED;
            PG8_LDB(B0, 1, 0); PG8_LDB(B1, 1, 1); PG8_SCHED; PG8_LDA(At, 1, 0); PG8_STAGE(PG8_SA(0, 1), a2 + hstep, voffA);
            PG8_WAIT_V(8); PG8_WAIT_L(0); PG8_BAR; PG8_MMA(0, 0, At, B0); PG8_MMA(0, 1, At, B1); PG8_BAR; PG8_SCHED;
            PG8_LDA(At, 1, 1); PG8_STAGE(PG8_SB(1, 0), b3, voffB); PG8_STAGE(PG8_SB(1, 1), b3 + hstep, voffB); PG8_STAGE(PG8_SA(1, 0), a3, voffA);
            PG8_WAIT_V(8); PG8_WAIT_L(0); PG8_BAR; PG8_MMA(1, 0, At, B0); PG8_MMA(1, 1, At, B1); PG8_BAR; PG8_SCHED;
        }
        if (wr == 0) PG8_BAR;
        E(acc, cur, wr, wc, fr, fq);
        if (!has_next) break;
#pragma unroll
        for (int a = 0; a < 2; ++a)
#pragma unroll
            for (int b = 0; b < 2; ++b)
#pragma unroll
                for (int m = 0; m < 4; ++m)
#pragma unroll
                    for (int n = 0; n < 2; ++n) acc[a][b][m][n] = (f32x4){0.f, 0.f, 0.f, 0.f};
        cur = nxt; cA = nA; cB = nB; ++ui;
        if (wr == 1) PG8_BAR;
    }
    PG8_WAIT_V(0);
    PG8_BAR;
#undef PG8_SA
#undef PG8_SB
#undef PG8_STAGE
#undef PG8_LDA
#undef PG8_LDB
#undef PG8_MMA
#undef PG8_WAIT_V
#undef PG8_WAIT_L
#undef PG8_BAR
#undef PG8_SCHED
}
}
using pg8::Unit;
__device__ __forceinline__ float sum_fq(float v) {
    auto a = __builtin_amdgcn_permlane16_swap(__float_as_uint(v), __float_as_uint(v), false, false); v = __uint_as_float(a[0]) + __uint_as_float(a[1]);
    auto b = __builtin_amdgcn_permlane32_swap(__float_as_uint(v), __float_as_uint(v), false, false); return __uint_as_float(b[0]) + __uint_as_float(b[1]);
}
__device__ __forceinline__ float row_rstd(const float* ssp, int row) {
    const f32x4* p = (const f32x4*)(ssp + (size_t)row * 16);
    const f32x4 a = p[0], b = p[1], c = p[2], d = p[3];
    const float ss = ((a[0] + a[1]) + (a[2] + a[3])) + ((b[0] + b[1]) + (b[2] + b[3])) + ((c[0] + c[1]) + (c[2] + c[3])) + ((d[0] + d[1]) + (d[2] + d[3]));
    return 1.0f / sqrtf(ss * (1.0f / DM) + RMS_EPS);
}
__device__ __forceinline__ float row_rstd4(const float* ssp, int row, int fq) {
    const f32x4 a = *((const f32x4*)(ssp + (size_t)row * 16) + fq);
    float ss = (a[0] + a[1]) + (a[2] + a[3]);
    ss = sum_fq(ss);
    return 1.0f / sqrtf(ss * (1.0f / DM) + RMS_EPS);
}
__device__ __forceinline__ u32x4 pack8(const f32x4 a, const f32x4 b) { u32x4 w; w.x = cvtpk(a[0], a[1]); w.y = cvtpk(a[2], a[3]); w.z = cvtpk(b[0], b[1]); w.w = cvtpk(b[2], b[3]); return w; }
__device__ __forceinline__ void rope8(f32x4& v0, f32x4& v1, const float* tab, int t, int pos, float sc) {
    const f32x4* cs = (const f32x4*)(tab + ((size_t)t * 32 + (pos >> 1)) * 2);
    const f32x4 c0 = cs[0], c1 = cs[1];
    f32x4 o0, o1;
    o0[0] = (v0[0] * c0[0] - v0[1] * c0[1]) * sc; o0[1] = (v0[1] * c0[0] + v0[0] * c0[1]) * sc;
    o0[2] = (v0[2] * c0[2] - v0[3] * c0[3]) * sc; o0[3] = (v0[3] * c0[2] + v0[2] * c0[3]) * sc;
    o1[0] = (v1[0] * c1[0] - v1[1] * c1[1]) * sc; o1[1] = (v1[1] * c1[0] + v1[0] * c1[1]) * sc;
    o1[2] = (v1[2] * c1[2] - v1[3] * c1[3]) * sc; o1[3] = (v1[3] * c1[2] + v1[2] * c1[3]) * sc;
    v0 = o0; v1 = o1;
}
struct EpiInProj {
    static constexpr bool KHOOK = false;
    const float* ssp; const float* bias; const float* tab;
    bf16_t *U, *Qn, *KV, *Mo, *G, *Gn;
    __device__ __forceinline__ void operator()(const f32x4 (&acc)[2][2][4][2], const Unit& u, int wr, int wc, int fr, int fq) const {
        asm volatile("" : "+v"(fr), "+v"(fq));
        const int pn = u.pn;
        f32x4 bia[2][2];
#pragma unroll
        for (int bj = 0; bj < 2; ++bj) { const int gc = pn * 256 + bj * 128 + wc * 32 + 8 * fq; bia[bj][0] = *(const f32x4*)(bias + gc); bia[bj][1] = *(const f32x4*)(bias + gc + 4); }
        float rs[2][4];
#pragma unroll
        for (int ai = 0; ai < 2; ++ai) { f32x4 ra[4];
#pragma unroll
            for (int m = 0; m < 4; ++m) ra[m] = *((const f32x4*)(ssp + (size_t)(u.pm * 256 + ai * 128 + wr * 64 + m * 16 + fr) * 16) + fq);
            __builtin_amdgcn_sched_barrier(0);
#pragma unroll
            for (int m = 0; m < 4; ++m) { float ss = (ra[m][0] + ra[m][1]) + (ra[m][2] + ra[m][3]); ss = sum_fq(ss); rs[ai][m] = 1.0f / sqrtf(ss * (1.0f / DM) + RMS_EPS); } }
#pragma unroll
        for (int ai = 0; ai < 2; ++ai)
#pragma unroll
            for (int m = 0; m < 4; ++m) {
                const int row = u.pm * 256 + ai * 128 + wr * 64 + m * 16 + fr;
                const float rstd = rs[ai][m];
                const int t = row & (SEQ - 1), b = row >> 13;
#pragma unroll
                for (int bj = 0; bj < 2; ++bj) {
                    const int cit = bj * 128 + wc * 32 + 8 * fq;
                    f32x4 v0 = acc[ai][bj][m][0] * rstd + bia[bj][0], v1 = acc[ai][bj][m][1] * rstd + bia[bj][1];
                    bf16_t* dst;
                    if (pn == 0) { dst = U + (size_t)row * 256 + cit; }
                    else if (pn <= 2) { const int c2 = (pn - 1) * 256 + cit, head = c2 >> 6, pos = c2 & 63; rope8(v0, v1, tab, t, pos, QSCALE); dst = Qn + ((size_t)(b * 8 + head) * SEQ + t) * 64 + pos; }
                    else if (pn <= 5) { const int c2 = cit & 127, g = c2 >> 6, pos = c2 & 63, kvi = 2 * (pn - 3) + bj; if (bj == 0) rope8(v0, v1, tab, t, pos, 1.f);
                        dst = KV + (size_t)kvi * ((size_t)MTOK * 128) + ((size_t)(b * 2 + g) * SEQ + t) * 64 + pos; }
                    else if (pn <= 8) { const int h = cit >> 6, pos = cit & 63; if (pn < 8) rope8(v0, v1, tab, t, pos, pn == 6 ? QSCALE : 1.f);
                        dst = Mo + (size_t)(pn - 6) * ((size_t)MTOK * 256) + ((size_t)(b * 4 + h) * SEQ + t) * 64 + pos; }
                    else if (pn <= 20) {
#pragma unroll
                        for (int e = 0; e < 4; ++e) { v0[e] = sigmoidf_(v0[e]); v1[e] = sigmoidf_(v1[e]); }
                        dst = G + (size_t)row * 3072 + (pn - 9) * 256 + cit; }
                    else {
#pragma unroll
                        for (int e = 0; e < 4; ++e) { v0[e] = sigmoidf_(v0[e]); v1[e] = sigmoidf_(v1[e]); }
                        dst = Gn + (size_t)row * 32 + (cit & 31); if (cit >= 32) dst = nullptr; }
                    if (dst) *(u32x4*)dst = pack8(v0, v1);
                }
                asm volatile("" ::: "memory");
            }
    }
};
struct EpiBranch {
    static constexpr bool KHOOK = true;
    const bf16_t* G; bf16_t* out;
    __device__ __forceinline__ void khook(f32x4 (&acc)[2][2][4][2], const Unit& u, int t, int wr, int wc, int fr, int fq) const {
        asm volatile("" : "+v"(fr), "+v"(fq));
        const int gsel = (t == 4) ? 0 : 1024;
#pragma unroll
        for (int ai = 0; ai < 2; ++ai)
#pragma unroll
            for (int m = 0; m < 4; ++m) {
                u32x4 gx[2], gy[2];
#pragma unroll
                for (int bj = 0; bj < 2; ++bj) { const int row = u.pm * 256 + ai * 128 + wr * 64 + m * 16 + fr, col = u.pn * 256 + bj * 128 + wc * 32 + 8 * fq;
                    gx[bj] = *(const u32x4*)(G + (size_t)row * 3072 + gsel + col); gy[bj] = *(const u32x4*)(G + (size_t)row * 3072 + gsel + 1024 + col); }
                __builtin_amdgcn_sched_barrier(0);
#pragma unroll
                for (int bj = 0; bj < 2; ++bj)
#pragma unroll
                    for (int e = 0; e < 4; ++e) {
                        const float x0 = fmaxf(bflo(gx[bj][e]), 1e-20f), x1 = fmaxf(bfhi(gx[bj][e]), 1e-20f), y0 = fmaxf(bflo(gy[bj][e]), 1e-20f), y1 = fmaxf(bfhi(gy[bj][e]), 1e-20f);
                        const float r0 = x0 * __builtin_amdgcn_rcpf(y0), r1 = x1 * __builtin_amdgcn_rcpf(y1);
                        acc[ai][bj][m][e >> 1][(e & 1) * 2] *= r0; acc[ai][bj][m][e >> 1][(e & 1) * 2 + 1] *= r1; }
                asm volatile("" ::: "memory");
            }
    }
    __device__ __forceinline__ void operator()(const f32x4 (&acc)[2][2][4][2], const Unit& u, int wr, int wc, int fr, int fq) const {
        asm volatile("" : "+v"(fr), "+v"(fq));
#pragma unroll
        for (int ai = 0; ai < 2; ++ai) {
            u32x4 gz[4][2];
#pragma unroll
            for (int m = 0; m < 4; ++m)
#pragma unroll
                for (int bj = 0; bj < 2; ++bj) gz[m][bj] = *(const u32x4*)(G + (size_t)(u.pm * 256 + ai * 128 + wr * 64 + m * 16 + fr) * 3072 + 2048 + u.pn * 256 + bj * 128 + wc * 32 + 8 * fq);
            __builtin_amdgcn_sched_barrier(0);
#pragma unroll
            for (int m = 0; m < 4; ++m) {
                const int row = u.pm * 256 + ai * 128 + wr * 64 + m * 16 + fr;
#pragma unroll
                for (int bj = 0; bj < 2; ++bj) {
                    const int col = u.pn * 256 + bj * 128 + wc * 32 + 8 * fq; const u32x4 g = gz[m][bj];
                    f32x4 v0 = acc[ai][bj][m][0], v1 = acc[ai][bj][m][1];
                    v0[0] *= fmaxf(bflo(g[0]), 1e-20f); v0[1] *= fmaxf(bfhi(g[0]), 1e-20f); v0[2] *= fmaxf(bflo(g[1]), 1e-20f); v0[3] *= fmaxf(bfhi(g[1]), 1e-20f);
                    v1[0] *= fmaxf(bflo(g[2]), 1e-20f); v1[1] *= fmaxf(bfhi(g[2]), 1e-20f); v1[2] *= fmaxf(bflo(g[3]), 1e-20f); v1[3] *= fmaxf(bfhi(g[3]), 1e-20f);
                    *(u32x4*)(out + (size_t)row * DM + col) = pack8(v0, v1);
                }
            }
            asm volatile("" ::: "memory");
        }
    }
};
struct EpiResid {
    static constexpr bool KHOOK = false;
    const float* base_f; const bf16_t* base_b; bf16_t* xb; bf16_t* res; float* ssp;
    __device__ __forceinline__ void operator()(const f32x4 (&acc)[2][2][4][2], const Unit& u, int wr, int wc, int fr, int fq) const {
        asm volatile("" : "+v"(fr), "+v"(fq));
#pragma unroll
        for (int ai = 0; ai < 2; ++ai)
#pragma unroll
            for (int mp = 0; mp < 2; ++mp) {
                f32x4 b0[2][2], b1[2][2];
                if (base_f) {
#pragma unroll
                    for (int mm = 0; mm < 2; ++mm)
#pragma unroll
                        for (int bj = 0; bj < 2; ++bj) { const size_t off = (size_t)(u.pm * 256 + ai * 128 + wr * 64 + (2 * mp + mm) * 16 + fr) * DM + u.pn * 256 + bj * 128 + wc * 32 + 8 * fq;
                            b0[mm][bj] = *(const f32x4*)(base_f + off); b1[mm][bj] = *(const f32x4*)(base_f + off + 4); }
                    __builtin_amdgcn_sched_barrier(0);
                } else {
                    u32x4 w[2][2];
#pragma unroll
                    for (int mm = 0; mm < 2; ++mm)
#pragma unroll
                        for (int bj = 0; bj < 2; ++bj) w[mm][bj] = *(const u32x4*)(base_b + (size_t)(u.pm * 256 + ai * 128 + wr * 64 + (2 * mp + mm) * 16 + fr) * DM + u.pn * 256 + bj * 128 + wc * 32 + 8 * fq);
                    __builtin_amdgcn_sched_barrier(0);
#pragma unroll
                    for (int mm = 0; mm < 2; ++mm)
#pragma unroll
                        for (int bj = 0; bj < 2; ++bj) { const u32x4 x = w[mm][bj]; b0[mm][bj] = (f32x4){bflo(x[0]), bfhi(x[0]), bflo(x[1]), bfhi(x[1])}; b1[mm][bj] = (f32x4){bflo(x[2]), bfhi(x[2]), bflo(x[3]), bfhi(x[3])}; }
                }
#pragma unroll
                for (int mm = 0; mm < 2; ++mm) {
                    const int m = 2 * mp + mm, row = u.pm * 256 + ai * 128 + wr * 64 + m * 16 + fr;
                    float ss = 0.f;
#pragma unroll
                    for (int bj = 0; bj < 2; ++bj) {
                        const size_t off = (size_t)row * DM + u.pn * 256 + bj * 128 + wc * 32 + 8 * fq;
                        const f32x4 v0 = acc[ai][bj][m][0] + b0[mm][bj], v1 = acc[ai][bj][m][1] + b1[mm][bj];
                        const u32x4 pk = pack8(v0, v1);
                        *(u32x4*)(xb + off) = pk;
                        if (res) *(u32x4*)(res + off) = pk;
                        ss += (v0[0] * v0[0] + v0[1] * v0[1]) + (v0[2] * v0[2] + v0[3] * v0[3]) + (v1[0] * v1[0] + v1[1] * v1[1]) + (v1[2] * v1[2] + v1[3] * v1[3]);
                    }
                    ss = sum_fq(ss);
                    if (fq == 0) ssp[(size_t)row * 16 + u.pn * 4 + wc] = ss;
                }
                asm volatile("" ::: "memory");
            }
    }
};
struct EpiSwiGLU {
    static constexpr bool KHOOK = false;
    const float* ssp; bf16_t* H;
    __device__ __forceinline__ void operator()(const f32x4 (&acc)[2][2][4][2], const Unit& u, int wr, int wc, int fr, int fq) const {
        asm volatile("" : "+v"(fr), "+v"(fq));
        float rs[2][4];
#pragma unroll
        for (int ai = 0; ai < 2; ++ai) { f32x4 ra[4];
#pragma unroll
            for (int m = 0; m < 4; ++m) ra[m] = *((const f32x4*)(ssp + (size_t)(u.pm * 256 + ai * 128 + wr * 64 + m * 16 + fr) * 16) + fq);
            __builtin_amdgcn_sched_barrier(0);
#pragma unroll
            for (int m = 0; m < 4; ++m) { float ss = (ra[m][0] + ra[m][1]) + (ra[m][2] + ra[m][3]); ss = sum_fq(ss); rs[ai][m] = 1.0f / sqrtf(ss * (1.0f / DM) + RMS_EPS); } }
#pragma unroll
        for (int ai = 0; ai < 2; ++ai)
#pragma unroll
            for (int m = 0; m < 4; ++m) {
                const int row = u.pm * 256 + ai * 128 + wr * 64 + m * 16 + fr;
                const float rstd = rs[ai][m];
                f32x4 o[2];
#pragma unroll
                for (int n = 0; n < 2; ++n)
#pragma unroll
                    for (int e = 0; e < 4; ++e) { const float gt = acc[ai][0][m][n][e] * rstd, up = acc[ai][1][m][n][e] * rstd; o[n][e] = gt * sigmoidf_(gt) * up; }
                *(u32x4*)(H + (size_t)row * DFF + u.pn * 128 + wc * 32 + 8 * fq) = pack8(o[0], o[1]);
                asm volatile("" ::: "memory");
            }
    }
};
namespace att {
constexpr int KCS = 1040, KSLOT = 8 * KCS, VSLOT = 8192;
constexpr int L_K0 = 0, L_V0 = 4 * KSLOT, L_WSF = 4 * KSLOT + 4 * VSLOT, L_MSK = L_WSF + 8 * 256, L_UNI = L_MSK + 1024, L_LIST = L_UNI + 64, L_END = L_LIST + 512,
              L_PS = L_END + 64, L_OT = L_PS, L_TOTAL = L_OT + 8 * 8192;
static_assert(L_TOTAL <= 147456 - 64, "attention LDS map");
#define LBAR() asm volatile("s_waitcnt lgkmcnt(0)\n\ts_barrier" ::: "memory")
#define LWAIT() asm volatile("s_waitcnt lgkmcnt(0)" ::: "memory")
__device__ __forceinline__ int crow(int r, int hi) { return (r & 3) + 8 * (r >> 2) + 4 * hi; }
__device__ __forceinline__ float swap_other(float v, int hi) { auto rr = __builtin_amdgcn_permlane32_swap(__float_as_uint(v), __float_as_uint(v), false, false); return __uint_as_float(hi ? rr[0] : rr[1]); }
__device__ __forceinline__ void qkt(f32x16& p0, f32x16& p1, const LAS char* Ks, const bf16x8* qr, const f32x16& cinit, int r32, int hi) {
    const LAS char* kb = Ks + hi * KCS + r32 * 16;
    bf16x8 kf[8];
#pragma unroll
    for (int d0 = 0; d0 < 4; ++d0) { kf[2 * d0] = *(const LAS bf16x8*)(kb + d0 * 2 * KCS); kf[2 * d0 + 1] = *(const LAS bf16x8*)(kb + d0 * 2 * KCS + 512); }
    __builtin_amdgcn_sched_barrier(0);
    p0 = __builtin_amdgcn_mfma_f32_32x32x16_bf16(kf[0], qr[0], cinit, 0, 0, 0); p1 = __builtin_amdgcn_mfma_f32_32x32x16_bf16(kf[1], qr[0], cinit, 0, 0, 0);
#pragma unroll
    for (int d0 = 1; d0 < 4; ++d0) { p0 = __builtin_amdgcn_mfma_f32_32x32x16_bf16(kf[2 * d0], qr[d0], p0, 0, 0, 0); p1 = __builtin_amdgcn_mfma_f32_32x32x16_bf16(kf[2 * d0 + 1], qr[d0], p1, 0, 0, 0); }
}
struct VFrag { s16x4 lo[8], hi[8]; };
typedef short v4i16_t __attribute__((ext_vector_type(4)));
__device__ __forceinline__ s16x4 vtr(const LAS char* p) { return __builtin_bit_cast(s16x4, __builtin_amdgcn_ds_read_tr16_b64_v4i16((LAS v4i16_t*)p)); }
__device__ __forceinline__ void v_issue(VFrag& F, const LAS char* vp) {
#pragma unroll
    for (int d0 = 0; d0 < 2; ++d0)
#pragma unroll
        for (int ks = 0; ks < 4; ++ks) { F.lo[d0 * 4 + ks] = vtr(vp + d0 * 4096 + ks * 1024); F.hi[d0 * 4 + ks] = vtr(vp + d0 * 4096 + ks * 1024 + 512); }
}
template <bool SUM> __device__ __forceinline__ void pv(f32x16* o, f32x16& osum, VFrag& F, bf16x8 pa0, bf16x8 pa1, bf16x8 pa2, bf16x8 pa3) {
#define PK(k) (bf16x8){F.lo[k][0], F.lo[k][1], F.lo[k][2], F.lo[k][3], F.hi[k][0], F.hi[k][1], F.hi[k][2], F.hi[k][3]}
    const bf16x8 ones = {0x3F80, 0x3F80, 0x3F80, 0x3F80, 0x3F80, 0x3F80, 0x3F80, 0x3F80};
    __builtin_amdgcn_s_setprio(1);
    o[0] = __builtin_amdgcn_mfma_f32_32x32x16_bf16(pa0, PK(0), o[0], 0, 0, 0);
    o[1] = __builtin_amdgcn_mfma_f32_32x32x16_bf16(pa0, PK(4), o[1], 0, 0, 0);
    if (SUM) osum = __builtin_amdgcn_mfma_f32_32x32x16_bf16(pa0, ones, osum, 0, 0, 0);
    o[0] = __builtin_amdgcn_mfma_f32_32x32x16_bf16(pa1, PK(1), o[0], 0, 0, 0);
    o[1] = __builtin_amdgcn_mfma_f32_32x32x16_bf16(pa1, PK(5), o[1], 0, 0, 0);
    if (SUM) osum = __builtin_amdgcn_mfma_f32_32x32x16_bf16(pa1, ones, osum, 0, 0, 0);
    o[0] = __builtin_amdgcn_mfma_f32_32x32x16_bf16(pa2, PK(2), o[0], 0, 0, 0);
    o[1] = __builtin_amdgcn_mfma_f32_32x32x16_bf16(pa2, PK(6), o[1], 0, 0, 0);
    if (SUM) osum = __builtin_amdgcn_mfma_f32_32x32x16_bf16(pa2, ones, osum, 0, 0, 0);
    o[0] = __builtin_amdgcn_mfma_f32_32x32x16_bf16(pa3, PK(3), o[0], 0, 0, 0);
    o[1] = __builtin_amdgcn_mfma_f32_32x32x16_bf16(pa3, PK(7), o[1], 0, 0, 0);
    if (SUM) osum = __builtin_amdgcn_mfma_f32_32x32x16_bf16(pa3, ones, osum, 0, 0, 0);
    __builtin_amdgcn_s_setprio(0);
#undef PK
}
__device__ __forceinline__ float rowmax(const f32x16& p0, const f32x16& p1, int hi) {
    float a = __builtin_fmaxf(p0[0], p1[0]);
#pragma unroll
    for (int r = 1; r < 16; ++r) a = __builtin_fmaxf(__builtin_fmaxf(a, p0[r]), p1[r]);
    return __builtin_fmaxf(a, swap_other(a, hi));
}
struct KVRegs { u32x4 k, v; };
__device__ __forceinline__ void tile_load(KVRegs& R, const bf16_t* K, const bf16_t* V, int tid) { R.k = *(const u32x4*)(K + tid * 8); R.v = *(const u32x4*)(V + tid * 8); }
__device__ __forceinline__ void tile_store(const KVRegs& R, LAS char* Ks, LAS char* Vs, int tid) {
    const int row = tid >> 3, c = tid & 7;
    *(LAS u32x4*)(Ks + c * KCS + row * 16) = R.k;
    *(LAS u32x4*)(Vs + (c >> 2) * 4096 + (row >> 4) * 1024 + (row & 15) * 64 + (c & 3) * 16) = R.v;
}
__device__ __forceinline__ void ps_accum(const f32x16 p, int jb, LAS float* ps_row, bool writer) {
#pragma unroll
    for (int rg = 0; rg < 4; ++rg) {
        float a = 2.f * (p[4 * rg] + p[4 * rg + 1] + p[4 * rg + 2]) + p[4 * rg + 3], bq = p[4 * rg + 3];
        a += __shfl_xor(a, 1); a += __shfl_xor(a, 2); bq += __shfl_xor(bq, 1); bq += __shfl_xor(bq, 2);
        const int j = jb + 2 * rg;
        if (writer) { __hip_atomic_fetch_add(ps_row + j, a, __ATOMIC_RELAXED, __HIP_MEMORY_SCOPE_WORKGROUP); if (j + 1 < 128) __hip_atomic_fetch_add(ps_row + j + 1, bq, __ATOMIC_RELAXED, __HIP_MEMORY_SCOPE_WORKGROUP); }
    }
}
struct Ctx { LAS char* lds; LAS float* wsf; LAS float* otl; int tid, wid, lane, r32, hi, vbl; };
struct RowSt { float m, l; bool started; f32x16 negm, osum; };
__device__ __forceinline__ void rowst_init(RowSt& S) { S.m = 0.f; S.l = 0.f; S.started = false; S.negm = f32x16{}; S.osum = f32x16{}; asm volatile("" : "+v"(S.negm)); }
__device__ __forceinline__ void rowst_fixed(RowSt& S, float ref) { S.m = ref; S.l = 0.f; S.started = true; S.osum = f32x16{};
#pragma unroll
    for (int r = 0; r < 16; ++r) S.negm[r] = -ref;
    asm volatile("" : "+v"(S.negm)); }
template <int MODE, class Idx, class Src, class Msk>
__device__ __forceinline__ void run_branch(const Ctx& C, int nt, const Idx& idx, const Src& src, const Msk& msk, const bf16x8* qr, RowSt& S, f32x16* o, LAS float* ps_row, bool ps_writer, KVRegs& R0, bool pre, const bf16_t* nk, const bf16_t* nv) {
    KVRegs R1; const bf16_t *kp, *vp;
    int dA = idx(0), dB = nt > 1 ? idx(1) : 0, dC = 0, dD = 0;
    if (!pre) { src(0, dA, kp, vp); tile_load(R0, kp, vp, C.tid); }
    if (nt > 1) { src(1, dB, kp, vp); tile_load(R1, kp, vp, C.tid); }
    auto compute = [&](int it, const LAS char* Ks, const LAS char* Vs, int klo, int khi, bool nm) {
        const bool kill = khi < klo;
        if (!__any(!kill)) return;
        f32x16 p0, p1; qkt(p0, p1, Ks, qr, S.negm, C.r32, C.hi);
        VFrag VF; if constexpr (MODE != 0) { v_issue(VF, Vs + C.vbl); __builtin_amdgcn_sched_barrier(0); }
        if (__any(nm && !kill)) {
#pragma unroll
            for (int r = 0; r < 16; ++r) { const int kv = crow(r, C.hi); if (kv < klo || kv > khi) p0[r] = -INFINITY; if (kv + 32 < klo || kv + 32 > khi) p1[r] = -INFINITY; }
        }
        if constexpr (MODE != 2) {
            float rm = rowmax(p0, p1, C.hi); if (kill) rm = -INFINITY;
            const bool first = !S.started && rm > -INFINITY, grow = first || rm > 8.0f;
            if (__any(grow)) {
                const float d = grow ? rm : 0.f, alpha = first ? 1.0f : __builtin_amdgcn_exp2f(-d);
                S.m += d; S.started = S.started || first;
#pragma unroll
                for (int r = 0; r < 16; ++r) { S.negm[r] = -S.m; p0[r] -= d; p1[r] -= d; }
                if constexpr (MODE == 0) S.l *= alpha;
                if constexpr (MODE == 1) {
                    if (C.hi == 0) C.wsf[C.r32] = alpha;
                    LWAIT();
#pragma unroll
                    for (int r = 0; r < 16; ++r) { const float f = C.wsf[crow(r, C.hi)]; o[0][r] *= f; o[1][r] *= f; S.osum[r] *= f; }
                    LWAIT();
                }
            }
        }
#pragma unroll
        for (int r = 0; r < 16; ++r) { p0[r] = __builtin_amdgcn_exp2f(p0[r]); p1[r] = __builtin_amdgcn_exp2f(p1[r]); }
        if constexpr (MODE == 0) {
            float s = 0.f;
#pragma unroll
            for (int r = 0; r < 16; ++r) s += p0[r] + p1[r];
            S.l += kill ? 0.f : s;
        }
        if constexpr (MODE == 2) {
            if (__any(kill)) {
#pragma unroll
                for (int r = 0; r < 16; ++r) { p0[r] = kill ? 0.f : p0[r]; p1[r] = kill ? 0.f : p1[r]; }
            }
            ps_accum(p0, 16 * it + C.hi, ps_row, ps_writer); ps_accum(p1, 16 * it + 8 + C.hi, ps_row, ps_writer);
        }
        if constexpr (MODE != 0) {
            u32x4 w0 = {cvtpk(p0[0], p0[1]), cvtpk(p0[2], p0[3]), cvtpk(p0[4], p0[5]), cvtpk(p0[6], p0[7])}, w1 = {cvtpk(p0[8], p0[9]), cvtpk(p0[10], p0[11]), cvtpk(p0[12], p0[13]), cvtpk(p0[14], p0[15])};
            u32x4 w2 = {cvtpk(p1[0], p1[1]), cvtpk(p1[2], p1[3]), cvtpk(p1[4], p1[5]), cvtpk(p1[6], p1[7])}, w3 = {cvtpk(p1[8], p1[9]), cvtpk(p1[10], p1[11]), cvtpk(p1[12], p1[13]), cvtpk(p1[14], p1[15])};
            if constexpr (MODE == 1) {
                if (__any(kill)) {
#pragma unroll
                    for (int e = 0; e < 4; ++e) { w0[e] = kill ? 0u : w0[e]; w1[e] = kill ? 0u : w1[e]; w2[e] = kill ? 0u : w2[e]; w3[e] = kill ? 0u : w3[e]; }
                }
            }
            pv<MODE == 1>(o, S.osum, VF, __builtin_bit_cast(bf16x8, w0), __builtin_bit_cast(bf16x8, w1), __builtin_bit_cast(bf16x8, w2), __builtin_bit_cast(bf16x8, w3));
        }
    };
    LBAR();
    for (int it = 0; it < nt; it += 2) {
        const int p = (it >> 1) & 1; const bool two = it + 1 < nt;
        LAS char* KsA = C.lds + L_K0 + (2 * p) * KSLOT; LAS char* VsA = C.lds + L_V0 + (2 * p) * VSLOT;
        LAS char* KsB = KsA + KSLOT; LAS char* VsB = VsA + VSLOT;
        tile_store(R0, KsA, VsA, C.tid); if (two) tile_store(R1, KsB, VsB, C.tid);
        if (it + 2 < nt) dC = idx(it + 2);
        if (it + 3 < nt) dD = idx(it + 3);
        int kloA, khiA, kloB = 0, khiB = -1; const bool nmA = msk(it, dA, kloA, khiA); bool nmB = false; if (two) nmB = msk(it + 1, dB, kloB, khiB);
        if (it + 2 < nt) { src(it + 2, dC, kp, vp); tile_load(R0, kp, vp, C.tid); } else if (nk) tile_load(R0, nk, nv, C.tid);
        if (it + 3 < nt) { src(it + 3, dD, kp, vp); tile_load(R1, kp, vp, C.tid); }
        LBAR();
        compute(it, KsA, VsA, kloA, khiA, nmA);
        if (two) compute(it + 1, KsB, VsB, kloB, khiB, nmB);
        dA = dC; dB = dD;
    }
}
template <bool FIRST> __device__ __forceinline__ void merge_branch_n(const Ctx& C, const f32x16* o, const f32x16& osum, float gate) {
    if (C.hi == 0) C.wsf[C.r32] = gate;
    LWAIT();
#pragma unroll
    for (int r0 = 0; r0 < 16; r0 += 8) {
        float gf[8], t0[8], t1[8];
#pragma unroll
        for (int r = 0; r < 8; ++r) { gf[r] = C.wsf[crow(r0 + r, C.hi)]; t0[r] = FIRST ? 0.f : C.otl[(r0 + r) * 64]; t1[r] = FIRST ? 0.f : C.otl[(16 + r0 + r) * 64]; }
        __builtin_amdgcn_sched_barrier(0);
#pragma unroll
        for (int r = 0; r < 8; ++r) { const float den = osum[r0 + r], f = den > 0.f ? gf[r] * __builtin_amdgcn_rcpf(den) : 0.f;
            C.otl[(r0 + r) * 64] = t0[r] + o[0][r0 + r] * f; C.otl[(16 + r0 + r) * 64] = t1[r] + o[1][r0 + r] * f; } }
    LWAIT();
}
template <bool FIRST> __device__ __forceinline__ void merge_branch(const Ctx& C, const f32x16* o, float factor) {
    if (C.hi == 0) C.wsf[C.r32] = factor;
    LWAIT();
#pragma unroll
    for (int r0 = 0; r0 < 16; r0 += 8) {
        float gf[8], t0[8], t1[8];
#pragma unroll
        for (int r = 0; r < 8; ++r) { gf[r] = C.wsf[crow(r0 + r, C.hi)]; t0[r] = FIRST ? 0.f : C.otl[(r0 + r) * 64]; t1[r] = FIRST ? 0.f : C.otl[(16 + r0 + r) * 64]; }
        __builtin_amdgcn_sched_barrier(0);
#pragma unroll
        for (int r = 0; r < 8; ++r) { C.otl[(r0 + r) * 64] = t0[r] + o[0][r0 + r] * gf[r]; C.otl[(16 + r0 + r) * 64] = t1[r] + o[1][r0 + r] * gf[r]; } }
    LWAIT();
}
struct Bufs { const bf16_t *Qn, *KV, *Mo, *KC, *KM, *Gn; bf16_t* Abr; };
constexpr size_t KV_STRIDE = (size_t)MTOK * 128, MO_STRIDE = (size_t)MTOK * 256;

__device__ __forceinline__ void nsa_item(const Ctx& C, const Bufs& B, int b, int g, int i) {
    const int r32 = C.r32, hi = C.hi, wid = C.wid;
    const int qi = 8 * wid + (r32 >> 2), hh = r32 & 3, head = g * 4 + hh, t = 64 * i + qi, cur = i;
    const size_t bg = (size_t)(b * 2 + g) * SEQ;
    bf16x8 qr[4];
    { const bf16_t* qp = B.Qn + ((size_t)(b * 8 + head) * SEQ + t) * 64 + hi * 8;
#pragma unroll
      for (int d0 = 0; d0 < 4; ++d0) qr[d0] = *(const bf16x8*)(qp + d0 * 16); }
    const unsigned gw = *(const unsigned*)(B.Gn + ((size_t)b * SEQ + t) * 32 + head * 3 - (head & 1));
    const unsigned gw2 = *(const unsigned*)(B.Gn + ((size_t)b * SEQ + t) * 32 + head * 3 - (head & 1) + 2);
    float g0, g1, g2; if (head & 1) { g0 = bfhi(gw); g1 = bflo(gw2); g2 = bfhi(gw2); } else { g0 = bflo(gw); g1 = bfhi(gw); g2 = bflo(gw2); }
    f32x16 o[2];
    LAS float* Ps = (LAS float*)(C.lds + L_PS); LAS unsigned* Mk = (LAS unsigned*)(C.lds + L_MSK); LAS unsigned* Uni = (LAS unsigned*)(C.lds + L_UNI); LAS int* List = (LAS int*)(C.lds + L_LIST);
    const int nv = t >= 31 ? ((t - 31) >> 4) + 1 : 0;
    const int nvt = (4 * i + 3 < 511) ? 4 * i + 3 : 511, ntc = (nvt + 63) >> 6;
    const bf16_t* kc = B.KC + (size_t)(0 * 4 + b * 2 + g) * 512 * 64; const bf16_t* vc = B.KC + (size_t)(1 * 4 + b * 2 + g) * 512 * 64;
    auto idxI = [&](int it) { return it; };
    auto srcC = [&](int it, int, const bf16_t*& kp, const bf16_t*& vp) { kp = kc + (size_t)it * 4096; vp = vc + (size_t)it * 4096; };
    auto mskC = [&](int it, int, int& klo, int& khi) { klo = 0; khi = nv - 1 - 64 * it; return khi < 63; };
    RowSt S; rowst_init(S);
    KVRegs R;
    run_branch<0>(C, ntc, idxI, srcC, mskC, qr, S, o, nullptr, false, R, false, kc, vc);
    const float lt = S.l + swap_other(S.l, hi);
    rowst_fixed(S, lt > 0.f ? S.m + __builtin_amdgcn_logf(lt) : 0.f);
    for (int e = C.tid; e < 64 * 128; e += 512) Ps[e] = 0.f;
    if (C.tid < 8) Uni[C.tid] = 0u;
    o[0] = f32x16{}; o[1] = f32x16{};
    run_branch<2>(C, ntc, idxI, srcC, mskC, qr, S, o, Ps + qi * 128, hh == 0, R, true, B.KV + 2 * KV_STRIDE + bg * 64, B.KV + 3 * KV_STRIDE + bg * 64);
    LBAR();
    {
        const int nf = cur == 0 ? 1 : (cur == 1 ? 2 : 3), kp_ = 16 - nf, lane = C.lane;
#pragma unroll 1
        for (int qq = 0; qq < 8; ++qq) {
            int q = 8 * wid + qq; asm volatile("" : "+s"(q)); LAS float* ps = Ps + q * 128;
            const int j0 = lane, j1 = lane + 64;
            const bool f0 = (j0 == 0 || j0 == cur || j0 == cur - 1) && j0 <= cur, f1 = (j1 == cur || j1 == cur - 1) && j1 <= cur;
            const bool va0 = j0 <= cur && !f0, va1 = j1 <= cur && !f1;
            const unsigned k0 = va0 ? __float_as_uint(ps[j0]) + 1u : 0u, k1 = va1 ? __float_as_uint(ps[j1]) + 1u : 0u;
            unsigned T = 0u;
            for (int bit = 30; bit >= 0; --bit) { const unsigned cand = T | (1u << bit); const int cnt = __popcll(__ballot(k0 >= cand)) + __popcll(__ballot(k1 >= cand)); if (cnt >= kp_) T = cand; }
            const int need = kp_ - (__popcll(__ballot(k0 > T)) + __popcll(__ballot(k1 > T)));
            const unsigned long long t0 = __ballot(k0 == T), t1 = __ballot(k1 == T), below = (1ull << lane) - 1ull;
            const int pre0 = __popcll(t0 & below), pre1 = __popcll(t0) + __popcll(t1 & below);
            const bool s0 = f0 || (k0 > 0u && (k0 > T || (k0 == T && pre0 < need))), s1 = f1 || (k1 > 0u && (k1 > T || (k1 == T && pre1 < need)));
            const unsigned long long b0 = __ballot(s0), b1 = __ballot(s1);
            if (lane == 0) { Mk[q * 4 + 0] = (unsigned)b0; Mk[q * 4 + 1] = (unsigned)(b0 >> 32); Mk[q * 4 + 2] = (unsigned)b1; Mk[q * 4 + 3] = (unsigned)(b1 >> 32);
                __hip_atomic_fetch_or(&Uni[0], (unsigned)b0, __ATOMIC_RELAXED, __HIP_MEMORY_SCOPE_WORKGROUP); __hip_atomic_fetch_or(&Uni[1], (unsigned)(b0 >> 32), __ATOMIC_RELAXED, __HIP_MEMORY_SCOPE_WORKGROUP); __hip_atomic_fetch_or(&Uni[2], (unsigned)b1, __ATOMIC_RELAXED, __HIP_MEMORY_SCOPE_WORKGROUP); __hip_atomic_fetch_or(&Uni[3], (unsigned)(b1 >> 32), __ATOMIC_RELAXED, __HIP_MEMORY_SCOPE_WORKGROUP); }
        }
    }
    LBAR();
    if (C.tid < 128) {
        const int wi = C.tid >> 5, bi = C.tid & 31; const unsigned u0 = Uni[0], u1 = Uni[1], u2 = Uni[2], u3 = Uni[3];
        const unsigned mine = wi == 0 ? u0 : wi == 1 ? u1 : wi == 2 ? u2 : u3;
        const int before = (wi > 0 ? __popc(u0) : 0) + (wi > 1 ? __popc(u1) : 0) + (wi > 2 ? __popc(u2) : 0) + __popc(mine & ((1u << bi) - 1u));
        if ((mine >> bi) & 1u) List[before] = C.tid;
        if (C.tid == 0) Uni[4] = (unsigned)(__popc(u0) + __popc(u1) + __popc(u2) + __popc(u3));
    }
    LBAR();
    merge_branch<true>(C, o, g0);
    {
        const int nsel = (int)Uni[4];
        const bf16_t* ks = B.KV + 2 * KV_STRIDE + bg * 64; const bf16_t* vs = B.KV + 3 * KV_STRIDE + bg * 64;
        auto idxS = [&](int it) { return List[it]; };
        auto srcS = [&](int, int j, const bf16_t*& kp, const bf16_t*& vp) { kp = ks + (size_t)j * 4096; vp = vs + (size_t)j * 4096; };
        auto mskS = [&](int, int j, int& klo, int& khi) { const unsigned w = Mk[qi * 4 + (j >> 5)]; const bool bit = (w >> (j & 31)) & 1u;
            klo = 0; khi = bit ? (j == cur ? qi : 63) : -1; return j == cur; };
        rowst_init(S); o[0] = f32x16{}; o[1] = f32x16{};
        const int tw0n = i >= 8 ? i - 8 : 0;
        run_branch<1>(C, nsel, idxS, srcS, mskS, qr, S, o, nullptr, false, R, true, B.KV + 4 * KV_STRIDE + bg * 64 + (size_t)tw0n * 4096, B.KV + 5 * KV_STRIDE + bg * 64 + (size_t)tw0n * 4096);
        merge_branch_n<false>(C, o, S.osum, g1);
    }
    {
        const int tw0 = i >= 8 ? i - 8 : 0, ntw = i - tw0 + 1;
        const bf16_t* kw = B.KV + 4 * KV_STRIDE + bg * 64; const bf16_t* vw = B.KV + 5 * KV_STRIDE + bg * 64;
        auto srcW = [&](int it, int, const bf16_t*& kp, const bf16_t*& vp) { kp = kw + (size_t)(tw0 + it) * 4096; vp = vw + (size_t)(tw0 + it) * 4096; };
        auto mskW = [&](int it, int, int& klo, int& khi) { const int tw = tw0 + it; klo = (t - 511) - 64 * tw; khi = (tw == i) ? qi : 63; return tw == i || klo > 0; };
        rowst_init(S); o[0] = f32x16{}; o[1] = f32x16{};
        run_branch<1>(C, ntw, idxI, srcW, mskW, qr, S, o, nullptr, false, R, true, nullptr, nullptr);
        merge_branch_n<false>(C, o, S.osum, g2);
    }
#pragma unroll
    for (int r0 = 0; r0 < 16; r0 += 8) { float t0[8], t1[8];
#pragma unroll
        for (int r = 0; r < 8; ++r) { t0[r] = C.otl[(r0 + r) * 64]; t1[r] = C.otl[(16 + r0 + r) * 64]; }
        __builtin_amdgcn_sched_barrier(0);
#pragma unroll
        for (int r = 0; r < 8; ++r) { const int qrow = crow(r0 + r, hi); bf16_t* dst = B.Abr + ((size_t)b * SEQ + 64 * i + 8 * wid + (qrow >> 2)) * DM + 256 + (g * 4 + (qrow & 3)) * 64 + r32;
            dst[0] = (bf16_t)(cvtpk(t0[r], 0.f) & 0xffffu); dst[32] = (bf16_t)(cvtpk(t1[r], 0.f) & 0xffffu); } }
}
__device__ __forceinline__ void moba_item(const Ctx& C, const Bufs& B, int b, int h, int qb) {
    const int r32 = C.r32, hi = C.hi, wid = C.wid, own = qb, t = 256 * qb + 32 * wid + r32;
    const size_t bh = (size_t)(b * 4 + h) * SEQ;
    bf16x8 qr[4];
    { const bf16_t* qp = B.Mo + (bh + t) * 64 + hi * 8;
#pragma unroll
      for (int d0 = 0; d0 < 4; ++d0) qr[d0] = *(const bf16x8*)(qp + d0 * 16); }
    LAS unsigned* Uni = (LAS unsigned*)(C.lds + L_UNI); LAS int* List = (LAS int*)(C.lds + L_LIST);
    LBAR();
    if (C.tid < 256) { const u32x4 kmv = *(const u32x4*)(B.KM + (size_t)(b * 4 + h) * 2048 + C.tid * 8); *(LAS u32x4*)(C.lds + L_K0 + (C.tid & 7) * KCS + (C.tid >> 3) * 16) = kmv; }
    if (C.tid == 0) Uni[0] = 0u;
    LBAR();
    unsigned sel = 0u;
    {
        f32x16 gs = f32x16{};
        const LAS char* kb = C.lds + L_K0 + hi * KCS + r32 * 16;
#pragma unroll
        for (int d0 = 0; d0 < 4; ++d0) gs = __builtin_amdgcn_mfma_f32_32x32x16_bf16(*(const LAS bf16x8*)(kb + d0 * 2 * KCS), qr[d0], gs, 0, 0, 0);
        float lo[16], hv[16];
#pragma unroll
        for (int r = 0; r < 16; ++r) { const float ownv = gs[r], oth = swap_other(ownv, hi); lo[r] = hi ? oth : ownv; hv[r] = hi ? ownv : oth; }
        unsigned taken = ~((1u << own) - 1u);
#pragma unroll
        for (int round = 0; round < 3; ++round) {
            float best = -INFINITY; int bi = 32;
#pragma unroll
            for (int n = 0; n < 32; ++n) { const int rr = (n & 3) + 4 * (n >> 3); const float v = ((n >> 2) & 1) ? hv[rr] : lo[rr]; if (!((taken >> n) & 1u) && v > best) { best = v; bi = n; } }
            if (bi < 32) { sel |= 1u << bi; taken |= 1u << bi; }
        }
    }
    { unsigned u = sel;
#pragma unroll
      for (int o_ = 1; o_ < 64; o_ <<= 1) u |= (unsigned)__shfl_xor((int)u, o_);
      if (C.lane == 0) __hip_atomic_fetch_or(&Uni[0], u, __ATOMIC_RELAXED, __HIP_MEMORY_SCOPE_WORKGROUP); }
    LBAR();
    if (C.tid == 0) { int n = 0; unsigned u = Uni[0]; while (u) { const int bpos = __builtin_ctz(u); u &= u - 1; List[n++] = bpos; } Uni[4] = (unsigned)n; }
    LBAR();
    const int nl = (int)Uni[4], nt = 4 * nl + 4;
    const bf16_t* kk = B.Mo + MO_STRIDE + bh * 64; const bf16_t* vv = B.Mo + 2 * MO_STRIDE + bh * 64;
    auto idxM = [&](int it) { return (it < 4 * nl) ? List[it >> 2] : own; };
    auto src = [&](int it, int blk, const bf16_t*& kp, const bf16_t*& vp) { const int T = 4 * blk + ((it < 4 * nl) ? (it & 3) : (it - 4 * nl)); kp = kk + (size_t)T * 4096; vp = vv + (size_t)T * 4096; };
    auto msk = [&](int it, int blk, int& klo, int& khi) { klo = 0; if (it < 4 * nl) { const bool bit = (sel >> blk) & 1u; khi = bit ? 63 : -1; return false; } khi = 32 * wid + r32 - 64 * (it - 4 * nl); return true; };
    RowSt S; rowst_init(S); f32x16 o[2] = {f32x16{}, f32x16{}};
    KVRegs R;
    run_branch<1>(C, nt, idxM, src, msk, qr, S, o, nullptr, false, R, false, nullptr, nullptr);
    merge_branch_n<true>(C, o, S.osum, 1.0f);
#pragma unroll
    for (int r0 = 0; r0 < 16; r0 += 8) { float t0[8], t1[8];
#pragma unroll
        for (int r = 0; r < 8; ++r) { t0[r] = C.otl[(r0 + r) * 64]; t1[r] = C.otl[(16 + r0 + r) * 64]; }
        __builtin_amdgcn_sched_barrier(0);
#pragma unroll
        for (int r = 0; r < 8; ++r) { const int qrow = crow(r0 + r, hi); bf16_t* dst = B.Abr + ((size_t)b * SEQ + 256 * qb + 32 * wid + qrow) * DM + 768 + h * 64 + r32;
            dst[0] = (bf16_t)(cvtpk(t0[r], 0.f) & 0xffffu); dst[32] = (bf16_t)(cvtpk(t1[r], 0.f) & 0xffffu); } }
}
}
#define XB_TMO      128
#define XB_XCNT(j)  (256  + 64 * (j))
#define XB_XSUB(j)  (1280 + 64 * (j))
#define XB_XGEN(j)  (2304 + 64 * (j))
#define XB_TOP      3328
#define XB_TOPGEN   3392
#define XCD_BAR_WORDS 3456
#define XB_SPIN_CAP (1u << 18)

__device__ __forceinline__ unsigned xb_ld(unsigned* p)              { return __hip_atomic_load(p, __ATOMIC_RELAXED, __HIP_MEMORY_SCOPE_AGENT); }
__device__ __forceinline__ unsigned xb_add(unsigned* p, unsigned v) { return __hip_atomic_fetch_add(p, v, __ATOMIC_RELAXED, __HIP_MEMORY_SCOPE_AGENT); }
__device__ __forceinline__ unsigned xb_xcc_id() { return (unsigned)__builtin_amdgcn_s_getreg((3 << 11) | 20) & 0xFu; }
#define XB_SPIN(cond, bar) do { unsigned _sp = 0; while (cond) { __builtin_amdgcn_s_sleep(1); \
    if ((++_sp & 255u) == 0u) { if (xb_ld(&(bar)[XB_TMO])) break; if (_sp > XB_SPIN_CAP) { atomicAdd(&(bar)[XB_TMO], 1u); break; } } } } while (0)

struct XcdBarrier {
    unsigned* bar; unsigned x;
    volatile LAS unsigned* st;
};

__device__ __forceinline__ XcdBarrier xcd_barrier_post(unsigned* bar, volatile LAS unsigned* st) {
    XcdBarrier b; b.bar = bar; b.x = xb_xcc_id(); b.st = st;
    if (threadIdx.x == 0) (void)xb_add(&bar[XB_XCNT(b.x)], 1u);
    return b;
}
__device__ __forceinline__ void xcd_barrier_complete(unsigned* bar, unsigned x, unsigned& nloc, unsigned& nx) {
    const unsigned G = gridDim.x * gridDim.y * gridDim.z;
    unsigned sum, cnt, mine, sp = 0u;
    for (;;) {
        sum = 0u; cnt = 0u; mine = 0u;
#pragma unroll
        for (unsigned j = 0; j < 16; ++j) { const unsigned c = xb_ld(&bar[XB_XCNT(j)]); sum += c; cnt += (c > 0u) ? 1u : 0u; mine = (j == x) ? c : mine; }
        if (sum == G) break;
        __builtin_amdgcn_s_sleep(1);
        if ((++sp & 255u) == 0u) { if (xb_ld(&bar[XB_TMO])) break; if (sp > XB_SPIN_CAP) { atomicAdd(&bar[XB_TMO], 1u); break; } }
    }
    nloc = mine > 0u ? mine : 1u; nx = cnt > 0u ? cnt : 1u;
}

__device__ __forceinline__ void xcd_barrier(const XcdBarrier& b) {
    asm volatile("s_waitcnt vmcnt(0)" ::: "memory");
    __syncthreads();
    if (threadIdx.x == 0) {
        unsigned* bar = b.bar;
        __builtin_amdgcn_s_waitcnt(0);
        unsigned nloc = b.st[0], nx = b.st[1];
        if (nloc == 0u) { xcd_barrier_complete(bar, b.x, nloc, nx); b.st[0] = nloc; b.st[1] = nx; }
        const unsigned old = xb_add(&bar[XB_XSUB(b.x)], 1u);
        const unsigned gen = old / nloc;
        if (old + 1u == (gen + 1u) * nloc) {
            __builtin_amdgcn_fence(__ATOMIC_RELEASE, "agent");
            asm volatile("s_waitcnt vmcnt(0)" ::: "memory");
            const unsigned og = xb_add(&bar[XB_TOP], 1u);
            const unsigned tg = og / nx;
            if (og + 1u == (tg + 1u) * nx) xb_add(&bar[XB_TOPGEN], 1u);
            else XB_SPIN(xb_ld(&bar[XB_TOPGEN]) == tg, bar);
            __builtin_amdgcn_fence(__ATOMIC_ACQUIRE, "agent");
            xb_add(&bar[XB_XGEN(b.x)], 1u);
            asm volatile("s_waitcnt vmcnt(0)" ::: "memory");
        } else {
            XB_SPIN(xb_ld(&bar[XB_XGEN(b.x)]) == gen, bar);
            __builtin_amdgcn_fence(__ATOMIC_ACQUIRE, "agent");
            asm volatile("s_waitcnt vmcnt(0)" ::: "memory");
        }
    }
    __syncthreads();
}

constexpr size_t MiB = 1u << 20;
constexpr size_t WS_CTL = 0, WS_ORDER = 4096, WS_BAR = 8192;
constexpr size_t WS_W = 1 * MiB, OFF_WIN = 0, OFF_WGU = 11 * MiB, OFF_WD = 22 * MiB, OFF_WBR = 28 * MiB, OFF_WOUT = 30 * MiB, OFF_W1 = 32 * MiB, OFF_W2 = 34 * MiB,
                 OFF_BIN = 34 * MiB + 65536, OFF_CB1 = OFF_BIN + 32768  , OFF_CB2 = OFF_CB1 + 65536;
constexpr size_t WS_TAB = 36 * MiB, WS_SSP = 38 * MiB, WS_KC = 39 * MiB, WS_KM = 39 * MiB + 512 * 1024, WS_GN = 40 * MiB, WS_XB = 42 * MiB, WS_BIG = 74 * MiB,
                 WS_U = 170 * MiB, WS_QN = 178 * MiB, WS_KV = 194 * MiB, WS_MO = 218 * MiB, WS_MRG = 178 * MiB, WS_END = 242 * MiB;
constexpr int LDS_BYTES = 147456;

__device__ __forceinline__ int dint(int pos) { return (pos >> 1) + 32 * (pos & 1); }
__device__ __forceinline__ int in_orig(int c) {
    if (c < 256) return c;
    if (c < 768) { const int c2 = c - 256; return 256 + (c2 >> 6) * 64 + dint(c2 & 63); }
    if (c < 1536) { const int c2 = c - 768, tt = c2 >> 8, bj = (c2 >> 7) & 1, g = (c2 >> 6) & 1, pos = c2 & 63; return 768 + (2 * tt + bj) * 128 + g * 64 + (bj == 0 ? dint(pos) : pos); }
    if (c < 2304) { const int c2 = c - 1536, part = c2 >> 8, h = (c2 >> 6) & 3, pos = c2 & 63; return 1560 + part * 256 + h * 64 + (part < 2 ? dint(pos) : pos); }
    if (c < 5376) return 2328 + (c - 2304);
    const int c2 = c - 5376; return c2 < 24 ? 1536 + c2 : -1;
}
template <class F> __device__ __forceinline__ void cvt_tile(LAS float* scr, int lane, int k0, int n0, bf16_t* dst, size_t pitch, F f) {
    float vals[32];
#pragma unroll
    for (int i = 0; i < 32; ++i) vals[i] = f(k0 + 2 * i + (lane >> 5), n0 + (lane & 31));
#pragma unroll
    for (int i = 0; i < 32; ++i) scr[(2 * i + (lane >> 5)) * 33 + (lane & 31)] = vals[i];
    asm volatile("s_waitcnt lgkmcnt(0)" ::: "memory");
    const int c = lane & 7;
#pragma unroll
    for (int j = 0; j < 4; ++j) { const int n = (lane >> 3) + 8 * j; const LAS float* s = scr + (8 * c) * 33 + n;
        u32x4 o; o.x = cvtpk(s[0 * 33], s[1 * 33]); o.y = cvtpk(s[2 * 33], s[3 * 33]); o.z = cvtpk(s[4 * 33], s[5 * 33]); o.w = cvtpk(s[6 * 33], s[7 * 33]);
        *(u32x4*)(dst + (size_t)(n0 + n) * pitch + k0 + 8 * c) = o; }
    asm volatile("s_waitcnt lgkmcnt(0)" ::: "memory");
}
template <class F> __device__ __forceinline__ void cvt_tile_scaled(LAS float* scr, int lane, int k0, int n0, bf16_t* dst, size_t pitch, F f, const float* scale, float keep) {
    float vals[32], sc[32];
#pragma unroll
    for (int i = 0; i < 32; ++i) { vals[i] = f(k0 + 2 * i + (lane >> 5), n0 + (lane & 31)); sc[i] = scale[k0 + 2 * i + (lane >> 5)]; }
    __builtin_amdgcn_sched_barrier(0);
#pragma unroll
    for (int i = 0; i < 32; ++i) scr[(2 * i + (lane >> 5)) * 33 + (lane & 31)] = vals[i] * (sc[i] * keep);
    asm volatile("s_waitcnt lgkmcnt(0)" ::: "memory");
    const int c = lane & 7;
#pragma unroll
    for (int j = 0; j < 4; ++j) { const int n = (lane >> 3) + 8 * j; const LAS float* s = scr + (8 * c) * 33 + n;
        u32x4 o; o.x = cvtpk(s[0 * 33], s[1 * 33]); o.y = cvtpk(s[2 * 33], s[3 * 33]); o.z = cvtpk(s[4 * 33], s[5 * 33]); o.w = cvtpk(s[6 * 33], s[7 * 33]);
        *(u32x4*)(dst + (size_t)(n0 + n) * pitch + k0 + 8 * c) = o; }
    asm volatile("s_waitcnt lgkmcnt(0)" ::: "memory");
}
struct Args { const float* in[20]; float* out; unsigned char* ws; };
typedef const __attribute__((address_space(4))) Args* ArgsP;

__device__ __forceinline__ void phase0(ArgsP a, int l, LAS unsigned char* lds, int tid, int lane, int wave, int gw, int NGW) {
    unsigned char* ws = a->ws;
    LAS float* scr = (LAS float*)(lds + wave * 8704);
    const float* attn_norm = a->in[1] + (size_t)l * DM; const float* w_in = a->in[2] + (size_t)l * DM * IN_COLS; const float* b_in = a->in[3] + (size_t)l * IN_COLS;
    const float* pool_w = a->in[4] + (size_t)l * 4 * 64 * 64; const float* pool_scale = a->in[5] + (size_t)l * 256; const float* cmp_pos = a->in[6] + (size_t)l * 2 * 32 * 64;
    const float* cmp_w1 = a->in[7] + (size_t)l * 2 * 2048 * 256; const float* cmp_b1 = a->in[8] + (size_t)l * 2 * 256; const float* cmp_w2 = a->in[9] + (size_t)l * 2 * 256 * 64; const float* cmp_b2 = a->in[10] + (size_t)l * 2 * 64;
    const float* w_br_pool = a->in[11] + (size_t)l * 256 * DM; const float* w_br_nsa = a->in[12] + (size_t)l * 512 * DM; const float* w_br_moba = a->in[13] + (size_t)l * 256 * DM;
    const float* w_out = a->in[14] + (size_t)l * DM * DM; const float* ffn_norm = a->in[15] + (size_t)l * DM; const float* w_gate = a->in[16] + (size_t)l * DM * DFF; const float* w_up = a->in[17] + (size_t)l * DM * DFF;
    const float* w_down = a->in[18] + (size_t)l * DFF * DM;
    bf16_t* Win = (bf16_t*)(ws + WS_W + OFF_WIN); bf16_t* Wgu = (bf16_t*)(ws + WS_W + OFF_WGU); bf16_t* Wd = (bf16_t*)(ws + WS_W + OFF_WD); bf16_t* Wbr = (bf16_t*)(ws + WS_W + OFF_WBR);
    bf16_t* Wout = (bf16_t*)(ws + WS_W + OFF_WOUT); bf16_t* W1t = (bf16_t*)(ws + WS_W + OFF_W1); bf16_t* W2t = (bf16_t*)(ws + WS_W + OFF_W2);
    float* bin = (float*)(ws + WS_W + OFF_BIN); float* cb1 = (float*)(ws + WS_W + OFF_CB1); float* cb2 = (float*)(ws + WS_W + OFF_CB2);
    constexpr int I_A = 16 * 176, I_B = 16 * 176, I_C = 44 * 32, I_D = 16 * 32, I_E = 16 * 32, I_F = 2 * 32 * 8, I_G = 2 * 4 * 2;
    constexpr int NITEMS = I_A + I_B + I_C + I_D + I_E + I_F + I_G;
    for (int it = gw; it < NITEMS; it += NGW) {
        int r = it;
        if (r < I_A) { const int kb = r / 176, nb = r % 176; { const int o = in_orig(32 * nb + (lane & 31)); const float* wc = w_in + (o >= 0 ? o : 0); const float keep = o >= 0 ? 1.f : 0.f;
            cvt_tile_scaled(scr, lane, 64 * kb, 32 * nb, Win, DM, [&](int k, int) { return wc[(size_t)k * IN_COLS]; }, attn_norm, keep); } continue; } r -= I_A;
        if (r < I_B) { const int kb = r / 176, nb = r % 176; { const int n = 32 * nb + (lane & 31), j = (n >> 8) * 128 + (n & 127); const float* wc = (((n >> 7) & 1) ? w_up : w_gate) + j;
            cvt_tile_scaled(scr, lane, 64 * kb, 32 * nb, Wgu, DM, [&](int k, int) { return wc[(size_t)k * DFF]; }, ffn_norm, 1.f); } continue; } r -= I_B;
        if (r < I_C) { const int kb = r / 32, nb = r % 32; cvt_tile(scr, lane, 64 * kb, 32 * nb, Wd, DFF, [&](int k, int n) { return w_down[(size_t)k * DM + n]; }); continue; } r -= I_C;
        if (r < I_D) { const int kb = r / 32, nb = r % 32; cvt_tile(scr, lane, 64 * kb, 32 * nb, Wout, DM, [&](int k, int n) { return w_out[(size_t)k * DM + n]; }); continue; } r -= I_D;
        if (r < I_E) { const int kb = r / 32, nb = r % 32;
            if (kb < 4) { }
            else if (kb < 12) cvt_tile(scr, lane, 64 * kb, 32 * nb, Wbr, DM, [&](int k, int n) { return w_br_nsa[(size_t)(k - 256) * DM + n]; });
            else cvt_tile(scr, lane, 64 * kb, 32 * nb, Wbr, DM, [&](int k, int n) { return w_br_moba[(size_t)(k - 768) * DM + n]; });
            continue; } r -= I_E;
        if (r < I_F) { const int kv = r >> 8, kb = (r >> 3) & 31, nb = r & 7; const float* w1 = cmp_w1 + (size_t)kv * 2048 * 256;
            cvt_tile(scr, lane, 64 * kb, 32 * nb, W1t + (size_t)kv * 256 * 2048, 2048, [&](int k, int n) { const int pos = k & 63, d = kv == 0 ? dint(pos) : pos; return w1[(size_t)((k & ~63) + d) * 256 + n]; }); continue; } r -= I_F;
        { const int kv = r >> 3, kb = (r >> 1) & 3, nb = r & 1; const float* w2 = cmp_w2 + (size_t)kv * 256 * 64;
            cvt_tile(scr, lane, 64 * kb, 32 * nb, W2t + (size_t)kv * 64 * 256, 256, [&](int k, int n) { return w2[(size_t)k * 64 + (kv == 0 ? dint(n) : n)]; }); }
    }
    const int gt = gw * 64 + lane, NGT = NGW * 64;
    for (int c = gt; c < NIN; c += NGT) { const int o = in_orig(c); bin[c] = o >= 0 ? b_in[o] : 0.f; }
    for (int idx = gt; idx < 32 * 512; idx += NGT) { const int c = idx >> 9, e = idx & 511, kv = e >> 8, n = e & 255; const float* w1 = cmp_w1 + (size_t)kv * 2048 * 256 + (size_t)(64 * c) * 256 + n; const float* pe = cmp_pos + (size_t)kv * 2048 + 64 * c;
        float s = c == 0 ? cmp_b1[kv * 256 + n] : 0.f;
#pragma unroll
        for (int k0 = 0; k0 < 64; k0 += 32) { float av[32], bv[32];
#pragma unroll
            for (int k = 0; k < 32; ++k) { av[k] = pe[k0 + k]; bv[k] = w1[(size_t)(k0 + k) * 256]; }
            __builtin_amdgcn_sched_barrier(0);
#pragma unroll
            for (int k = 0; k < 32; ++k) s += av[k] * bv[k]; }
        cb1[idx] = s; }
    for (int idx = gt; idx < 256 * DM; idx += NGT) { const int k = idx >> 10, n = idx & 1023, g64 = k & ~63; float s = 0.f;
        const f32x4* pw4 = (const f32x4*)(pool_w + (size_t)k * 64); const f32x4* ps4 = (const f32x4*)(pool_scale + g64);
#pragma unroll
        for (int j0 = 0; j0 < 64; j0 += 32) { f32x4 pw[8], psc[8]; float wb[32];
#pragma unroll
            for (int q = 0; q < 8; ++q) { pw[q] = pw4[j0 / 4 + q]; psc[q] = ps4[j0 / 4 + q]; }
#pragma unroll
            for (int j = 0; j < 32; ++j) wb[j] = w_br_pool[(size_t)(g64 + j0 + j) * DM + n];
            __builtin_amdgcn_sched_barrier(0);
#pragma unroll
            for (int j = 0; j < 32; ++j) s += pw[j >> 2][j & 3] * psc[j >> 2][j & 3] * wb[j]; }
        Wbr[(size_t)n * DM + k] = (bf16_t)(cvtpk(s, 0.f) & 0xffffu); }
    for (int e = gt; e < 128; e += NGT) { const int kv = e >> 6, n = e & 63; cb2[e] = cmp_b2[kv * 64 + (kv == 0 ? dint(n) : n)]; }
    if (l == 0) {
        float* tab = (float*)(ws + WS_TAB);
        for (int e = gt; e < SEQ * 32; e += NGT) { const int t = e >> 5, f = e & 31; const float inv = powf(10000.0f, -(float)(2 * f) / 64.0f); const float ang = (float)t * inv;
            const double ad = (double)ang, kq = rint(ad * 0.15915494309189535); double rr = fma(-kq, 6.283185307179586, ad); rr = fma(-kq, 2.4492935982947064e-16, rr);
            const float rf = (float)rr; tab[2 * e] = __cosf(rf); tab[2 * e + 1] = __sinf(rf); }
        const float* x = a->in[0]; bf16_t* xb = (bf16_t*)(ws + WS_XB); float* ssp = (float*)(ws + WS_SSP);
        for (int m0 = 2 * gw; m0 < MTOK; m0 += 2 * NGW) { f32x4 v[2][4]; float s[2] = {0.f, 0.f};
#pragma unroll
            for (int q = 0; q < 2; ++q) { const f32x4* xr = (const f32x4*)(x + (size_t)(m0 + q) * DM) + lane;
#pragma unroll
                for (int j = 0; j < 4; ++j) v[q][j] = xr[64 * j]; }
#pragma unroll
            for (int q = 0; q < 2; ++q) {
#pragma unroll
                for (int j = 0; j < 4; ++j) s[q] += (v[q][j][0] * v[q][j][0] + v[q][j][1] * v[q][j][1]) + (v[q][j][2] * v[q][j][2] + v[q][j][3] * v[q][j][3]);
#pragma unroll
                for (int o = 1; o < 64; o <<= 1) s[q] += __shfl_xor(s[q], o);
                u32x2* o8 = (u32x2*)(xb + (size_t)(m0 + q) * DM) + lane;
#pragma unroll
                for (int j = 0; j < 4; ++j) o8[64 * j] = (u32x2){cvtpk(v[q][j][0], v[q][j][1]), cvtpk(v[q][j][2], v[q][j][3])};
                if (lane < 16) ssp[(size_t)(m0 + q) * 16 + lane] = lane == 0 ? s[q] : 0.f; } }
        int* order = (int*)(ws + WS_ORDER);
        auto cost = [](int id) { if (id < 512) { const int i = id & 127; return 10 * ((i + 1) + ((i < 8 ? i : 8) + 1) + 10) + 16 * ((4 * i + 3 + 63) >> 6); } const int qb = (id - 512) & 31; return 7 * (4 * qb + 3) + 50; };
        for (int id = gw; id < 768; id += NGW) { const int mc = cost(id); int rk = 0;
            for (int j = lane; j < 768; j += 64) { const int cj = cost(j); rk += (cj > mc || (cj == mc && j < id)) ? 1 : 0; }
#pragma unroll
            for (int o = 1; o < 64; o <<= 1) rk += __shfl_xor(rk, o);
            if (lane == 0) order[rk] = id; }
    }
}
__device__ __forceinline__ float gelu_tanh(float x) { const float u = 0.7978845608028654f * (x + 0.044715f * x * x * x); const float th = 1.f - 2.f * __builtin_amdgcn_rcpf(1.f + __expf(2.f * u)); return 0.5f * x * (1.f + th); }
__device__ __forceinline__ void phase2(ArgsP a, LAS unsigned char* lds, int tid, int lane, int wave, int G) {
    unsigned char* ws = a->ws;
    const bf16_t* KV = (const bf16_t*)(ws + WS_KV); const bf16_t* W1t = (const bf16_t*)(ws + WS_W + OFF_W1); const bf16_t* W2t = (const bf16_t*)(ws + WS_W + OFF_W2);
    const float* cb1 = (const float*)(ws + WS_W + OFF_CB1); const float* cb2 = (const float*)(ws + WS_W + OFF_CB2);
    bf16_t* KC = (bf16_t*)(ws + WS_KC);
    LAS bf16_t* hid = (LAS bf16_t*)lds;
    const int arow = lane & 15, kq = lane >> 4;
    for (int task = blockIdx.x; task < 256; task += G) {
        const int kv = task >> 7, bgi = (task >> 5) & 3, nt = task & 31;
        const bf16_t* src = KV + (size_t)kv * att::KV_STRIDE + (size_t)bgi * SEQ * 64;
        const int nrow = 16 * nt + arow, neff = nrow < 510 ? nrow : 510;
        const bf16_t* ap = src + (size_t)neff * 1024 + kq * 8;
        const bf16_t* bp0 = W1t + (size_t)kv * 256 * 2048 + (size_t)(32 * wave + arow) * 2048 + kq * 8; const bf16_t* bp1 = bp0 + 16 * 2048;
        f32x4 c0 = {0.f, 0.f, 0.f, 0.f}, c1 = {0.f, 0.f, 0.f, 0.f};
        float bb0 = 0.f, bb1 = 0.f;
        { const int col0 = 32 * wave + arow; float t0[32], t1[32];
#pragma unroll
          for (int c = 0; c < 32; ++c) { t0[c] = cb1[c * 512 + kv * 256 + col0]; t1[c] = cb1[c * 512 + kv * 256 + col0 + 16]; }
          __builtin_amdgcn_sched_barrier(0);
#pragma unroll
          for (int c = 0; c < 32; ++c) { bb0 += t0[c]; bb1 += t1[c]; } }
#pragma unroll 1
        for (int ks0 = 0; ks0 < 64; ks0 += 8) { bf16x8 av[8], b0[8], b1[8];
#pragma unroll
            for (int q = 0; q < 8; ++q) { av[q] = *(const bf16x8*)(ap + (ks0 + q) * 32); b0[q] = *(const bf16x8*)(bp0 + (ks0 + q) * 32); b1[q] = *(const bf16x8*)(bp1 + (ks0 + q) * 32); }
            __builtin_amdgcn_sched_barrier(0);
#pragma unroll
            for (int q = 0; q < 8; ++q) { c0 = __builtin_amdgcn_mfma_f32_16x16x32_bf16(av[q], b0[q], c0, 0, 0, 0); c1 = __builtin_amdgcn_mfma_f32_16x16x32_bf16(av[q], b1[q], c1, 0, 0, 0); } }
        { const int col0 = 32 * wave + arow;
#pragma unroll
          for (int j = 0; j < 4; ++j) { const int row = kq * 4 + j; hid[row * 264 + col0] = (bf16_t)(cvtpk(gelu_tanh(c0[j] + bb0), 0.f) & 0xffffu); hid[row * 264 + col0 + 16] = (bf16_t)(cvtpk(gelu_tanh(c1[j] + bb1), 0.f) & 0xffffu); } }
        LBAR();
        if (wave < 4) {
            const bf16_t* bp = W2t + (size_t)kv * 64 * 256 + (size_t)(16 * wave + arow) * 256 + kq * 8; f32x4 c = {0.f, 0.f, 0.f, 0.f};
            bf16x8 bv[8];
#pragma unroll
            for (int ks = 0; ks < 8; ++ks) bv[ks] = *(const bf16x8*)(bp + ks * 32);
            __builtin_amdgcn_sched_barrier(0);
#pragma unroll
            for (int ks = 0; ks < 8; ++ks) { const bf16x8 av = *(const LAS bf16x8*)(hid + arow * 264 + kq * 8 + ks * 32); c = __builtin_amdgcn_mfma_f32_16x16x32_bf16(av, bv[ks], c, 0, 0, 0); }
            const int col = 16 * wave + arow; const float bb = cb2[kv * 64 + col];
#pragma unroll
            for (int j = 0; j < 4; ++j) { const int n = 16 * nt + kq * 4 + j; KC[((size_t)(kv * 4 + bgi) * 512 + n) * 64 + col] = n < 511 ? (bf16_t)(cvtpk(c[j] + bb, 0.f) & 0xffffu) : (bf16_t)0; }
        }
        LBAR();
    }
    const int gt = blockIdx.x * 512 + tid, NGT = G * 512;
    { const bf16_t* MoK = (const bf16_t*)(ws + WS_MO) + att::MO_STRIDE; bf16_t* KM = (bf16_t*)(ws + WS_KM); LAS float* part = (LAS float*)(lds + 16384);
      for (int blk = blockIdx.x; blk < 256; blk += G) { const bf16_t* p = MoK + ((size_t)blk * 256 + 32 * wave) * 64 + lane; float s = 0.f;
#pragma unroll
          for (int r0 = 0; r0 < 32; r0 += 16) { unsigned short tv[16];
#pragma unroll
              for (int r = 0; r < 16; ++r) tv[r] = p[(size_t)(r0 + r) * 64];
              __builtin_amdgcn_sched_barrier(0);
#pragma unroll
              for (int r = 0; r < 16; ++r) s += __uint_as_float((unsigned)tv[r] << 16); }
          part[wave * 64 + lane] = s;
          LBAR();
          if (wave == 0) { float t = 0.f;
#pragma unroll
              for (int w = 0; w < 8; ++w) t += part[w * 64 + lane];
              KM[(size_t)blk * 64 + lane] = (bf16_t)(cvtpk(t * (1.0f / 256.0f), 0.f) & 0xffffu); }
          LBAR(); } }
    { const bf16_t* U = (const bf16_t*)(ws + WS_U); bf16_t* Abr = (bf16_t*)(ws + WS_XB);
      for (int e = gt; e < MTOK * 32; e += NGT) { const int row = e >> 5, c8 = e & 31, s = row & (SEQ - 1), w = 2 << (c8 >> 3), cnt = (s + 1 < w) ? s + 1 : w;
          float acc[8] = {0.f, 0.f, 0.f, 0.f, 0.f, 0.f, 0.f, 0.f}; u32x4 v0 = {0u, 0u, 0u, 0u};
#pragma unroll
          for (int i0 = 0; i0 < 16; i0 += 8) { if (i0 >= cnt) break; u32x4 v[8];
#pragma unroll
              for (int i = 0; i < 8; ++i) v[i] = (i0 + i < cnt) ? *(const u32x4*)(U + (size_t)(row - i0 - i) * 256 + c8 * 8) : (u32x4){0u, 0u, 0u, 0u};
              __builtin_amdgcn_sched_barrier(0);
              if (i0 == 0) v0 = v[0];
#pragma unroll
              for (int i = 0; i < 8; ++i)
#pragma unroll
                  for (int q = 0; q < 4; ++q) { acc[2 * q] += bflo(v[i][q]); acc[2 * q + 1] += bfhi(v[i][q]); } }
          const float ic = 1.0f / (float)cnt; u32x4 o;
#pragma unroll
          for (int q = 0; q < 4; ++q) o[q] = cvtpk(acc[2 * q] * ic - bflo(v0[q]), acc[2 * q + 1] * ic - bfhi(v0[q]));
          *(u32x4*)(Abr + (size_t)row * DM + c8 * 8) = o; } }
}
__global__ void __launch_bounds__(512, 2) fwd_megakernel(Args a) {
    extern __shared__ __attribute__((aligned(16))) unsigned char lds_raw[];
    LAS unsigned char* lds = (LAS unsigned char*)lds_raw;
    cg::grid_group grid = cg::this_grid();
    const int G = gridDim.x;
    volatile LAS unsigned* bst = (volatile LAS unsigned*)(lds + LDS_BYTES - 64);
    if (threadIdx.x < 16) bst[threadIdx.x] = 0u;
    __syncthreads();
    const ArgsP ap0 = (ArgsP)__builtin_amdgcn_kernarg_segment_ptr();
#define PHASE_ARGS ArgsP a_ = ap0; asm volatile("" : "+s"(a_)); unsigned char* ws = a_->ws; unsigned* ctl = (unsigned*)(ws + WS_CTL); float* ssp = (float*)(ws + WS_SSP); const float* tab = (const float*)(ws + WS_TAB); \
    bf16_t* XB = (bf16_t*)(ws + WS_XB); bf16_t* BIG = (bf16_t*)(ws + WS_BIG); bf16_t* MRG = (bf16_t*)(ws + WS_MRG); (void)ctl; (void)ssp; (void)tab; (void)XB; (void)BIG; (void)MRG;
    XcdBarrier xbar = xcd_barrier_post((unsigned*)(ap0->ws + WS_BAR), bst);
    bool first_sync = true;
#define GRID_SYNC() do { if (first_sync) { grid.sync(); first_sync = false; } else xcd_barrier(xbar); } while (0)
    for (int l = 0; l < DEPTH; ++l) {
        int tid_ = threadIdx.x; asm volatile("" : "+v"(tid_));
        const int tid = tid_, lane = tid & 63, wave = __builtin_amdgcn_readfirstlane(tid >> 6), gw = blockIdx.x * 8 + wave, NGW = G * 8;
        { PHASE_ARGS phase0(a_, l, lds, tid, lane, wave, gw, NGW); }
        GRID_SYNC();
        { PHASE_ARGS pg8::Gemm g{XB, (const bf16_t*)(ws + WS_W + OFF_WIN), MTOK, NIN, DM}; pg8::StaticOrder S; S.init(MTOK, NIN, G, (int)blockIdx.x);
          EpiInProj E{ssp, (const float*)(ws + WS_W + OFF_BIN), tab, (bf16_t*)(ws + WS_U), (bf16_t*)(ws + WS_QN), (bf16_t*)(ws + WS_KV), (bf16_t*)(ws + WS_MO), BIG, (bf16_t*)(ws + WS_GN)};
          pg8::gemm_phase(lds, g, S, E); }
        GRID_SYNC();
        { PHASE_ARGS phase2(a_, lds, tid, lane, wave, G); }
        GRID_SYNC();
        { PHASE_ARGS
          att::Bufs B{(const bf16_t*)(ws + WS_QN), (const bf16_t*)(ws + WS_KV), (const bf16_t*)(ws + WS_MO), (const bf16_t*)(ws + WS_KC), (const bf16_t*)(ws + WS_KM), (const bf16_t*)(ws + WS_GN), XB};
          const int* order = (const int*)(ws + WS_ORDER); LAS int* slot = (LAS int*)(lds + att::L_END);
          if (wave >= 4) __builtin_amdgcn_s_setprio(1);
          for (;;) {
              LBAR();
              if (tid == 0) slot[0] = (int)atomicAdd(ctl + l, 1u);
              LBAR();
              const int item = slot[0];
              if (item >= 768) break;
              const int id = order[item];
              int tl = threadIdx.x; asm volatile("" : "+v"(tl));
              const int tid = tl, lane = tid & 63, wave = __builtin_amdgcn_readfirstlane(tid >> 6);
              att::Ctx C; C.lds = (LAS char*)lds; C.wsf = (LAS float*)(lds + att::L_WSF) + wave * 64; C.otl = (LAS float*)(lds + att::L_OT) + wave * 2048 + lane; C.tid = tid; C.wid = wave; C.lane = lane; C.r32 = lane & 31; C.hi = lane >> 5;
              C.vbl = ((lane >> 4) & 1) * 32 + (lane & 3) * 8 + (4 * (lane >> 5) + ((lane & 15) >> 2)) * 64;
              if (id < 512) att::nsa_item(C, B, id >> 8, (id >> 7) & 1, id & 127);
              else { const int x = id - 512; att::moba_item(C, B, x >> 7, (x >> 5) & 3, x & 31); }
          }
          __builtin_amdgcn_s_setprio(0); }
        GRID_SYNC();
        { PHASE_ARGS pg8::Gemm g{XB, (const bf16_t*)(ws + WS_W + OFF_WBR), MTOK, DM, DM}; pg8::StaticOrder S; S.init(MTOK, DM, G, (int)blockIdx.x);
          EpiBranch E{BIG, MRG}; pg8::gemm_phase(lds, g, S, E); }
        GRID_SYNC();
        { PHASE_ARGS pg8::Gemm g{MRG, (const bf16_t*)(ws + WS_W + OFF_WOUT), MTOK, DM, DM}; pg8::StaticOrder S; S.init(MTOK, DM, G, (int)blockIdx.x);
          bf16_t* RES = (bf16_t*)a_->out; EpiResid E{l == 0 ? a_->in[0] : nullptr, RES, XB, nullptr, ssp};   pg8::gemm_phase(lds, g, S, E); }
        GRID_SYNC();
        { PHASE_ARGS pg8::Gemm g{XB, (const bf16_t*)(ws + WS_W + OFF_WGU), MTOK, NGU, DM}; pg8::StaticOrder S; S.init(MTOK, NGU, G, (int)blockIdx.x);
          EpiSwiGLU E{ssp, BIG}; pg8::gemm_phase(lds, g, S, E); }
        GRID_SYNC();
        { PHASE_ARGS pg8::Gemm g{BIG, (const bf16_t*)(ws + WS_W + OFF_WD), MTOK, DM, DFF}; pg8::StaticOrder S; S.init(MTOK, DM, G, (int)blockIdx.x);
          bf16_t* RES = (bf16_t*)a_->out; EpiResid E{nullptr, XB, XB, l + 1 < DEPTH ? RES : nullptr, ssp};   pg8::gemm_phase(lds, g, S, E); }
        GRID_SYNC();
    }
    { PHASE_ARGS const float* fn = a_->in[19]; float* outp = a_->out; const int lane = threadIdx.x & 63, gw = blockIdx.x * 8 + (threadIdx.x >> 6), NGW = G * 8;
      const f32x4* gr = (const f32x4*)fn + lane; f32x4 gv[4];
#pragma unroll
      for (int j = 0; j < 4; ++j) gv[j] = gr[64 * j];
      for (int m0 = 2 * gw; m0 < MTOK; m0 += 2 * NGW) { u32x2 w[2][4]; float rstd[2];
#pragma unroll
          for (int q = 0; q < 2; ++q) { const u32x2* xr = (const u32x2*)(XB + (size_t)(m0 + q) * DM) + lane; rstd[q] = row_rstd(ssp, m0 + q);
#pragma unroll
              for (int j = 0; j < 4; ++j) w[q][j] = xr[64 * j]; }
#pragma unroll
          for (int q = 0; q < 2; ++q) { f32x4* orow = (f32x4*)(outp + (size_t)(m0 + q) * DM) + lane;
#pragma unroll
              for (int j = 0; j < 4; ++j) { const f32x4 v = {bflo(w[q][j][0]), bfhi(w[q][j][0]), bflo(w[q][j][1]), bfhi(w[q][j][1])}; orow[64 * j] = v * rstd[q] * gv[j]; } } } }
}

extern "C" void kernel_launch(void* const* d_in, const int* in_sizes, int n_in, void* d_out, int out_size, void* d_ws, size_t ws_size, hipStream_t stream) {
    static int grid = 0;
    if (grid == 0) {
        if (n_in != 20 || in_sizes[0] != MTOK * DM || out_size != MTOK * DM || ws_size < WS_END) { fprintf(stderr, "kernel_launch: unexpected shapes / workspace (n_in %d, ws %zu)\n", n_in, ws_size); grid = -1; return; }
        int dev = 0, cus = 0, per_cu = 0;
        if (hipGetDevice(&dev) != hipSuccess || hipDeviceGetAttribute(&cus, hipDeviceAttributeMultiprocessorCount, dev) != hipSuccess) { grid = -1; return; }
        if (hipFuncSetAttribute((const void*)fwd_megakernel, hipFuncAttributeMaxDynamicSharedMemorySize, LDS_BYTES) != hipSuccess) { fprintf(stderr, "kernel_launch: hipFuncSetAttribute failed\n"); grid = -1; return; }
        if (hipOccupancyMaxActiveBlocksPerMultiprocessor(&per_cu, (const void*)fwd_megakernel, 512, LDS_BYTES) != hipSuccess || per_cu < 1) { fprintf(stderr, "kernel_launch: occupancy query failed (%d)\n", per_cu); (void)hipGetLastError(); grid = -1; return; }
        grid = cus * per_cu;
    }
    if (grid < 0) return;
    if (hipMemsetAsync((char*)d_ws + WS_CTL, 0, 32768, stream) != hipSuccess) { fprintf(stderr, "kernel_launch: memset failed\n"); return; }
    Args a{};
    for (int i = 0; i < 20; ++i) a.in[i] = (const float*)d_in[i];
    a.out = (float*)d_out; a.ws = (unsigned char*)d_ws;
    void* args[] = {&a};
    const hipError_t e = hipLaunchCooperativeKernel((const void*)fwd_megakernel, dim3(grid), dim3(512), args, LDS_BYTES, stream);
    if (e != hipSuccess) fprintf(stderr, "kernel_launch: cooperative launch failed: %s (grid %d)\n", hipGetErrorString(e), grid);
}
```

```cpp
#include <hip/hip_runtime.h>
#include <hip/hip_cooperative_groups.h>
#include <cstdio>
#include <cstdint>
#include <cmath>
namespace cg = cooperative_groups;

#define LAS __attribute__((address_space(3)))
typedef unsigned short bf16_t;
typedef short bf16x8 __attribute__((ext_vector_type(8)));
typedef short s16x4 __attribute__((ext_vector_type(4)));
typedef float f32x2 __attribute__((ext_vector_type(2)));
typedef float f32x4 __attribute__((ext_vector_type(4)));
typedef float f32x16 __attribute__((ext_vector_type(16)));
typedef unsigned u32x4 __attribute__((ext_vector_type(4)));
typedef unsigned u32x2 __attribute__((ext_vector_type(2)));
typedef __bf16 bf16x2_t __attribute__((ext_vector_type(2)));

constexpr int SEQ = 8192, BATCH = 2, MTOK = BATCH * SEQ, DM = 1024, DEPTH = 2;
constexpr int IN_COLS = 5400, NIN = 5632, DFF = 2816, NGU = 5632;
constexpr float RMS_EPS = 1e-6f;
constexpr float QSCALE = 0.125f * 1.4426950408889634f;

__device__ __forceinline__ unsigned cvtpk(float lo, float hi) { f32x2 v = {lo, hi}; bf16x2_t b = __builtin_convertvector(v, bf16x2_t); return __builtin_bit_cast(unsigned, b); }
__device__ __forceinline__ float bflo(unsigned w) { return __uint_as_float(w << 16); }
__device__ __forceinline__ float bfhi(unsigned w) { return __uint_as_float(w & 0xffff0000u); }
__device__ __forceinline__ float sigmoidf_(float x) { return __builtin_amdgcn_rcpf(1.f + __expf(-x)); }

namespace pg8 {
constexpr int BM = 256, BK = 64, HALF = 128, HTB = HALF * BK * 2, STAGE_BYTES = 8 * HTB, NXCD = 8, WGM = 8;
__host__ __device__ __forceinline__ int lds_byte(int r, int c) { const int st = (r >> 4) * 2 + (c >> 5), rr = r & 15, cc = c & 31, ob = rr * 64 + cc * 2; return st * 1024 + (ob ^ (((ob >> 9) & 1) << 5)); }
__host__ __device__ __forceinline__ void stage_rc(int b, int& R, int& C) { const int st = b / 1024, sb = b % 1024, swz = sb ^ (((sb >> 9) & 1) << 5); R = (st >> 1) * 16 + swz / 64; C = (st & 1) * 32 + (swz % 64) / 2; }
__host__ __device__ __forceinline__ int perm32(int rho) { const int n = rho >> 4, i = rho & 15; return 8 * (i >> 2) + 4 * n + (i & 3); }
struct Unit { int pm, pn; };
struct Gemm { const bf16_t* A; const bf16_t* Bt; int M, N, K; };
struct StaticOrder {
    int nM, nN, nwg, G, c;
    __host__ __device__ void init(int M, int N, int G_, int c_) { nM = M / BM; nN = N / BM; nwg = nM * nN; G = G_; c = c_; }
    __host__ __device__ bool next(int i, Unit& u) const {
        const long L = (long)i * G + c; if (L >= nwg) return false;
        int wgid = (int)L; { const int q = nwg / NXCD, r = nwg % NXCD, xcd = wgid % NXCD, off = wgid / NXCD; wgid = (xcd < r ? xcd * (q + 1) : r * (q + 1) + (xcd - r) * q) + off; }
        const int nig = WGM * nN, gid = wgid / nig, fm = gid * WGM, gsz = (nM - fm) < WGM ? (nM - fm) : WGM;
        u.pm = fm + ((wgid % nig) % gsz); u.pn = (wgid % nig) / gsz; return true;
    }
};
template <class Epi, class Sched>
__device__ __forceinline__ void gemm_phase(LAS unsigned char* lds, const Gemm g, const Sched& S, const Epi& E) {
    int tid_ = threadIdx.x; asm volatile("" : "+v"(tid_));
    const int tid = tid_, wid = __builtin_amdgcn_readfirstlane(tid >> 6), lane = tid & 63, wr = wid >> 2, wc = wid & 3, fr = lane & 15, fq = lane >> 4;
    const int K = g.K, nt = K / BK;
    unsigned voffA[2], voffB[2];
#pragma unroll
    for (int i = 0; i < 2; ++i) { int R, C; stage_rc(tid * 16 + i * 8192, R, C); const int Rb = ((R & ~31) + perm32(R & 31));
        voffA[i] = (unsigned)(R * K + C) * 2u; voffB[i] = (unsigned)(Rb * K + C) * 2u; }
    const size_t kstep = (size_t)(BK * 2);
    const size_t hstep = (size_t)HALF * K * 2;
    const size_t tstep = 2 * hstep;
    const unsigned ldsw = (unsigned)wid * 1024u;
    const int aoff = lds_byte(wr * 64 + fr, fq * 8), boff = lds_byte(wc * 32 + fr, fq * 8);
#define PG8_SA(b, h) (((b) * 2 + (h)) * HTB)
#define PG8_SB(b, h) ((4 + (b) * 2 + (h)) * HTB)
#define PG8_STAGE(bufoff, gbase, voff) do { _Pragma("unroll") for (int _i = 0; _i < 2; ++_i) \
        __builtin_amdgcn_global_load_lds((const unsigned*)((const char*)(gbase) + (voff)[_i]), (LAS unsigned*)(lds + (bufoff) + ldsw + _i * 8192), 16, 0, 0); } while (0)
#define PG8_LDA(dst, b, h) do { _Pragma("unroll") for (int m = 0; m < 4; ++m) _Pragma("unroll") for (int k = 0; k < 2; ++k) dst[m][k] = *(const LAS bf16x8*)(lds + PG8_SA(b, h) + aoff + m * 2048 + k * 1024); } while (0)
#define PG8_LDB(dst, b, h) do { _Pragma("unroll") for (int n = 0; n < 2; ++n) _Pragma("unroll") for (int k = 0; k < 2; ++k) dst[n][k] = *(const LAS bf16x8*)(lds + PG8_SB(b, h) + boff + n * 2048 + k * 1024); } while (0)
#define PG8_MMA(ai, bj, At, Bt) do { __builtin_amdgcn_s_setprio(1); _Pragma("unroll") for (int m = 0; m < 4; ++m) _Pragma("unroll") for (int n = 0; n < 2; ++n) _Pragma("unroll") for (int k = 0; k < 2; ++k) \
        acc[ai][bj][m][n] = __builtin_amdgcn_mfma_f32_16x16x32_bf16(Bt[n][k], At[m][k], acc[ai][bj][m][n], 0, 0, 0); __builtin_amdgcn_s_setprio(0); } while (0)
#define PG8_WAIT_V(n) asm volatile("s_waitcnt vmcnt(" #n ")" ::: "memory")
#define PG8_WAIT_L(n) asm volatile("s_waitcnt lgkmcnt(" #n ")" ::: "memory")
#define PG8_BAR __builtin_amdgcn_s_barrier()
#define PG8_SCHED __builtin_amdgcn_sched_barrier(0)
    Unit cur, nxt; int ui = 0;
    if (!S.next(0, cur)) return;
    f32x4 acc[2][2][4][2];
#pragma unroll
    for (int a = 0; a < 2; ++a)
#pragma unroll
        for (int b = 0; b < 2; ++b)
#pragma unroll
            for (int m = 0; m < 4; ++m)
#pragma unroll
                for (int n = 0; n < 2; ++n) acc[a][b][m][n] = (f32x4){0.f, 0.f, 0.f, 0.f};
    bf16x8 At[4][2], B0[2][2], B1[2][2];
    const char* cA = (const char*)g.A + (size_t)cur.pm * tstep; const char* cB = (const char*)g.Bt + (size_t)cur.pn * tstep;
    PG8_STAGE(PG8_SB(0, 0), cB, voffB); PG8_STAGE(PG8_SB(0, 1), cB + hstep, voffB); PG8_STAGE(PG8_SA(0, 0), cA, voffA); PG8_STAGE(PG8_SA(0, 1), cA + hstep, voffA);
    if (wr == 1) PG8_BAR;
    PG8_WAIT_V(2); PG8_BAR;
    PG8_STAGE(PG8_SB(1, 0), cB + kstep, voffB); PG8_STAGE(PG8_SA(1, 0), cA + kstep, voffA); PG8_STAGE(PG8_SB(1, 1), cB + hstep + kstep, voffB);
    PG8_WAIT_V(6); PG8_BAR;
    for (;;) {
        const bool has_next = S.next(ui + 1, nxt);
        const char* nA = has_next ? (const char*)g.A + (size_t)nxt.pm * tstep : cA; const char* nB = has_next ? (const char*)g.Bt + (size_t)nxt.pn * tstep : cB;
        for (int t = 0; t < nt; t += 2) {
            const bool last = (t == nt - 2);
            const char* a1 = cA + (size_t)(t + 1) * kstep;
            const char* a2 = last ? nA : cA + (size_t)(t + 2) * kstep; const char* b2 = last ? nB : cB + (size_t)(t + 2) * kstep;
            const char* a3 = a2 + kstep; const char* b3 = b2 + kstep;
            if constexpr (Epi::KHOOK) { if (t == 4 || t == 12) { PG8_SCHED; E.khook(acc, cur, t, wr, wc, fr, fq); PG8_SCHED; } }
            PG8_LDB(B0, 0, 0); PG8_LDB(B1, 0, 1); PG8_SCHED; PG8_LDA(At, 0, 0); PG8_STAGE(PG8_SA(1, 1), a1 + hstep, voffA);
            PG8_WAIT_V(8); PG8_WAIT_L(0); PG8_BAR; PG8_MMA(0, 0, At, B0); PG8_MMA(0, 1, At, B1); PG8_BAR; PG8_SCHED;
            PG8_LDA(At, 0, 1); PG8_STAGE(PG8_SB(0, 0), b2, voffB); PG8_STAGE(PG8_SB(0, 1), b2 + hstep, voffB); PG8_STAGE(PG8_SA(0, 0), a2, voffA);
            PG8_WAIT_V(8); PG8_WAIT_L(0); PG8_BAR; PG8_MMA(1, 0, At, B0); PG8_MMA(1, 1, At, B1); PG8_BAR; PG8_SCHED;
            PG8_LDB(B0, 1, 0); PG8_LDB(B1, 1, 1); PG8_SCHED; PG8_LDA(At, 1, 0); PG8_STAGE(PG8_SA(0, 1), a2 + hstep, voffA);
            PG8_WAIT_V(8); PG8_WAIT_L(0); PG8_BAR; PG8_MMA(0, 0, At, B0); PG8_MMA(0, 1, At, B1); PG8_BAR; PG8_SCHED;
            PG8_LDA(At, 1, 1); PG8_STAGE(PG8_SB(1, 0), b3, voffB); PG8_STAGE(PG8_SB(1, 1), b3 + hstep, voffB); PG8_STAGE(PG8_SA(1, 0), a3, voffA);
            PG8_WAIT_V(8); PG8_WAIT_L(0); PG8_BAR; PG8_MMA(1, 0, At, B0); PG8_MMA(1, 1, At, B1); PG8_BAR; PG8_SCHED;
        }
        if (wr == 0) PG8_BAR;
        E(acc, cur, wr, wc, fr, fq);
        if (!has_next) break;
#pragma unroll
        for (int a = 0; a < 2; ++a)
#pragma unroll
            for (int b = 0; b < 2; ++b)
#pragma unroll
                for (int m = 0; m < 4; ++m)
#pragma unroll
                    for (int n = 0; n < 2; ++n) acc[a][b][m][n] = (f32x4){0.f, 0.f, 0.f, 0.f};
        cur = nxt; cA = nA; cB = nB; ++ui;
        if (wr == 1) PG8_BAR;
    }
    PG8_WAIT_V(0);
    PG8_BAR;
#undef PG8_SA
#undef PG8_SB
#undef PG8_STAGE
#undef PG8_LDA
#undef PG8_LDB
#undef PG8_MMA
#undef PG8_WAIT_V
#undef PG8_WAIT_L
#undef PG8_BAR
#undef PG8_SCHED
}
}
using pg8::Unit;
__device__ __forceinline__ float sum_fq(float v) {
    auto a = __builtin_amdgcn_permlane16_swap(__float_as_uint(v), __float_as_uint(v), false, false); v = __uint_as_float(a[0]) + __uint_as_float(a[1]);
    auto b = __builtin_amdgcn_permlane32_swap(__float_as_uint(v), __float_as_uint(v), false, false); return __uint_as_float(b[0]) + __uint_as_float(b[1]);
}
__device__ __forceinline__ float row_rstd(const float* ssp, int row) {
    const f32x4* p = (const f32x4*)(ssp + (size_t)row * 16);
    const f32x4 a = p[0], b = p[1], c = p[2], d = p[3];
    const float ss = ((a[0] + a[1]) + (a[2] + a[3])) + ((b[0] + b[1]) + (b[2] + b[3])) + ((c[0] + c[1]) + (c[2] + c[3])) + ((d[0] + d[1]) + (d[2] + d[3]));
    return 1.0f / sqrtf(ss * (1.0f / DM) + RMS_EPS);
}
__device__ __forceinline__ float row_rstd4(const float* ssp, int row, int fq) {
    const f32x4 a = *((const f32x4*)(ssp + (size_t)row * 16) + fq);
    float ss = (a[0] + a[1]) + (a[2] + a[3]);
    ss = sum_fq(ss);
    return 1.0f / sqrtf(ss * (1.0f / DM) + RMS_EPS);
}
__device__ __forceinline__ u32x4 pack8(const f32x4 a, const f32x4 b) { u32x4 w; w.x = cvtpk(a[0], a[1]); w.y = cvtpk(a[2], a[3]); w.z = cvtpk(b[0], b[1]); w.w = cvtpk(b[2], b[3]); return w; }
__device__ __forceinline__ void rope8(f32x4& v0, f32x4& v1, const float* tab, int t, int pos, float sc) {
    const f32x4* cs = (const f32x4*)(tab + ((size_t)t * 32 + (pos >> 1)) * 2);
    const f32x4 c0 = cs[0], c1 = cs[1];
    f32x4 o0, o1;
    o0[0] = (v0[0] * c0[0] - v0[1] * c0[1]) * sc; o0[1] = (v0[1] * c0[0] + v0[0] * c0[1]) * sc;
    o0[2] = (v0[2] * c0[2] - v0[3] * c0[3]) * sc; o0[3] = (v0[3] * c0[2] + v0[2] * c0[3]) * sc;
    o1[0] = (v1[0] * c1[0] - v1[1] * c1[1]) * sc; o1[1] = (v1[1] * c1[0] + v1[0] * c1[1]) * sc;
    o1[2] = (v1[2] * c1[2] - v1[3] * c1[3]) * sc; o1[3] = (v1[3] * c1[2] + v1[2] * c1[3]) * sc;
    v0 = o0; v1 = o1;
}
struct EpiInProj {
    static constexpr bool KHOOK = false;
    const float* ssp; const float* bias; const float* tab;
    bf16_t *U, *Qn, *KV, *Mo, *G, *Gn;
    __device__ __forceinline__ void operator()(const f32x4 (&acc)[2][2][4][2], const Unit& u, int wr, int wc, int fr, int fq) const {
        asm volatile("" : "+v"(fr), "+v"(fq));
        const int pn = u.pn;
        f32x4 bia[2][2];
#pragma unroll
        for (int bj = 0; bj < 2; ++bj) { const int gc = pn * 256 + bj * 128 + wc * 32 + 8 * fq; bia[bj][0] = *(const f32x4*)(bias + gc); bia[bj][1] = *(const f32x4*)(bias + gc + 4); }
        float rs[2][4];
#pragma unroll
        for (int ai = 0; ai < 2; ++ai) { f32x4 ra[4];
#pragma unroll
            for (int m = 0; m < 4; ++m) ra[m] = *((const f32x4*)(ssp + (size_t)(u.pm * 256 + ai * 128 + wr * 64 + m * 16 + fr) * 16) + fq);
            __builtin_amdgcn_sched_barrier(0);
#pragma unroll
            for (int m = 0; m < 4; ++m) { float ss = (ra[m][0] + ra[m][1]) + (ra[m][2] + ra[m][3]); ss = sum_fq(ss); rs[ai][m] = 1.0f / sqrtf(ss * (1.0f / DM) + RMS_EPS); } }
#pragma unroll
        for (int ai = 0; ai < 2; ++ai)
#pragma unroll
            for (int m = 0; m < 4; ++m) {
                const int row = u.pm * 256 + ai * 128 + wr * 64 + m * 16 + fr;
                const float rstd = rs[ai][m];
                const int t = row & (SEQ - 1), b = row >> 13;
#pragma unroll
                for (int bj = 0; bj < 2; ++bj) {
                    const int cit = bj * 128 + wc * 32 + 8 * fq;
                    f32x4 v0 = acc[ai][bj][m][0] * rstd + bia[bj][0], v1 = acc[ai][bj][m][1] * rstd + bia[bj][1];
                    bf16_t* dst;
                    if (pn == 0) { dst = U + (size_t)row * 256 + cit; }
                    else if (pn <= 2) { const int c2 = (pn - 1) * 256 + cit, head = c2 >> 6, pos = c2 & 63; rope8(v0, v1, tab, t, pos, QSCALE); dst = Qn + ((size_t)(b * 8 + head) * SEQ + t) * 64 + pos; }
                    else if (pn <= 5) { const int c2 = cit & 127, g = c2 >> 6, pos = c2 & 63, kvi = 2 * (pn - 3) + bj; if (bj == 0) rope8(v0, v1, tab, t, pos, 1.f);
                        dst = KV + (size_t)kvi * ((size_t)MTOK * 128) + ((size_t)(b * 2 + g) * SEQ + t) * 64 + pos; }
                    else if (pn <= 8) { const int h = cit >> 6, pos = cit & 63; if (pn < 8) rope8(v0, v1, tab, t, pos, pn == 6 ? QSCALE : 1.f);
                        dst = Mo + (size_t)(pn - 6) * ((size_t)MTOK * 256) + ((size_t)(b * 4 + h) * SEQ + t) * 64 + pos; }
                    else if (pn <= 20) {
#pragma unroll
                        for (int e = 0; e < 4; ++e) { v0[e] = sigmoidf_(v0[e]); v1[e] = sigmoidf_(v1[e]); }
                        dst = G + (size_t)row * 3072 + (pn - 9) * 256 + cit; }
                    else {
#pragma unroll
                        for (int e = 0; e < 4; ++e) { v0[e] = sigmoidf_(v0[e]); v1[e] = sigmoidf_(v1[e]); }
                        dst = Gn + (size_t)row * 32 + (cit & 31); if (cit >= 32) dst = nullptr; }
                    if (dst) *(u32x4*)dst = pack8(v0, v1);
                }
                asm volatile("" ::: "memory");
            }
    }
};
struct EpiBranch {
    static constexpr bool KHOOK = true;
    const bf16_t* G; bf16_t* out;
    __device__ __forceinline__ void khook(f32x4 (&acc)[2][2][4][2], const Unit& u, int t, int wr, int wc, int fr, int fq) const {
        asm volatile("" : "+v"(fr), "+v"(fq));
        const int gsel = (t == 4) ? 0 : 1024;
#pragma unroll
        for (int ai = 0; ai < 2; ++ai)
#pragma unroll
            for (int m = 0; m < 4; ++m) {
                u32x4 gx[2], gy[2];
#pragma unroll
                for (int bj = 0; bj < 2; ++bj) { const int row = u.pm * 256 + ai * 128 + wr * 64 + m * 16 + fr, col = u.pn * 256 + bj * 128 + wc * 32 + 8 * fq;
                    gx[bj] = *(const u32x4*)(G + (size_t)row * 3072 + gsel + col); gy[bj] = *(const u32x4*)(G + (size_t)row * 3072 + gsel + 1024 + col); }
                __builtin_amdgcn_sched_barrier(0);
#pragma unroll
                for (int bj = 0; bj < 2; ++bj)
#pragma unroll
                    for (int e = 0; e < 4; ++e) {
                        const float x0 = fmaxf(bflo(gx[bj][e]), 1e-20f), x1 = fmaxf(bfhi(gx[bj][e]), 1e-20f), y0 = fmaxf(bflo(gy[bj][e]), 1e-20f), y1 = fmaxf(bfhi(gy[bj][e]), 1e-20f);
                        const float r0 = x0 * __builtin_amdgcn_rcpf(y0), r1 = x1 * __builtin_amdgcn_rcpf(y1);
                        acc[ai][bj][m][e >> 1][(e & 1) * 2] *= r0; acc[ai][bj][m][e >> 1][(e & 1) * 2 + 1] *= r1; }
                asm volatile("" ::: "memory");
            }
    }
    __device__ __forceinline__ void operator()(const f32x4 (&acc)[2][2][4][2], const Unit& u, int wr, int wc, int fr, int fq) const {
        asm volatile("" : "+v"(fr), "+v"(fq));
#pragma unroll
        for (int ai = 0; ai < 2; ++ai) {
            u32x4 gz[4][2];
#pragma unroll
            for (int m = 0; m < 4; ++m)
#pragma unroll
                for (int bj = 0; bj < 2; ++bj) gz[m][bj] = *(const u32x4*)(G + (size_t)(u.pm * 256 + ai * 128 + wr * 64 + m * 16 + fr) * 3072 + 2048 + u.pn * 256 + bj * 128 + wc * 32 + 8 * fq);
            __builtin_amdgcn_sched_barrier(0);
#pragma unroll
            for (int m = 0; m < 4; ++m) {
                const int row = u.pm * 256 + ai * 128 + wr * 64 + m * 16 + fr;
#pragma unroll
                for (int bj = 0; bj < 2; ++bj) {
                    const int col = u.pn * 256 + bj * 128 + wc * 32 + 8 * fq; const u32x4 g = gz[m][bj];
                    f32x4 v0 = acc[ai][bj][m][0], v1 = acc[ai][bj][m][1];
                    v0[0] *= fmaxf(bflo(g[0]), 1e-20f); v0[1] *= fmaxf(bfhi(g[0]), 1e-20f); v0[2] *= fmaxf(bflo(g[1]), 1e-20f); v0[3] *= fmaxf(bfhi(g[1]), 1e-20f);
                    v1[0] *= fmaxf(bflo(g[2]), 1e-20f); v1[1] *= fmaxf(bfhi(g[2]), 1e-20f); v1[2] *= fmaxf(bflo(g[3]), 1e-20f); v1[3] *= fmaxf(bfhi(g[3]), 1e-20f);
                    *(u32x4*)(out + (size_t)row * DM + col) = pack8(v0, v1);
                }
            }
            asm volatile("" ::: "memory");
        }
    }
};
struct EpiResid {
    static constexpr bool KHOOK = false;
    const float* base_f; const bf16_t* base_b; bf16_t* xb; bf16_t* res; float* ssp;
    __device__ __forceinline__ void operator()(const f32x4 (&acc)[2][2][4][2], const Unit& u, int wr, int wc, int fr, int fq) const {
        asm volatile("" : "+v"(fr), "+v"(fq));
#pragma unroll
        for (int ai = 0; ai < 2; ++ai)
#pragma unroll
            for (int mp = 0; mp < 2; ++mp) {
                f32x4 b0[2][2], b1[2][2];
                if (base_f) {
#pragma unroll
                    for (int mm = 0; mm < 2; ++mm)
#pragma unroll
                        for (int bj = 0; bj < 2; ++bj) { const size_t off = (size_t)(u.pm * 256 + ai * 128 + wr * 64 + (2 * mp + mm) * 16 + fr) * DM + u.pn * 256 + bj * 128 + wc * 32 + 8 * fq;
                            b0[mm][bj] = *(const f32x4*)(base_f + off); b1[mm][bj] = *(const f32x4*)(base_f + off + 4); }
                    __builtin_amdgcn_sched_barrier(0);
                } else {
                    u32x4 w[2][2];
#pragma unroll
                    for (int mm = 0; mm < 2; ++mm)
#pragma unroll
                        for (int bj = 0; bj < 2; ++bj) w[mm][bj] = *(const u32x4*)(base_b + (size_t)(u.pm * 256 + ai * 128 + wr * 64 + (2 * mp + mm) * 16 + fr) * DM + u.pn * 256 + bj * 128 + wc * 32 + 8 * fq);
                    __builtin_amdgcn_sched_barrier(0);
#pragma unroll
                    for (int mm = 0; mm < 2; ++mm)
#pragma unroll
                        for (int bj = 0; bj < 2; ++bj) { const u32x4 x = w[mm][bj]; b0[mm][bj] = (f32x4){bflo(x[0]), bfhi(x[0]), bflo(x[1]), bfhi(x[1])}; b1[mm][bj] = (f32x4){bflo(x[2]), bfhi(x[2]), bflo(x[3]), bfhi(x[3])}; }
                }
#pragma unroll
                for (int mm = 0; mm < 2; ++mm) {
                    const int m = 2 * mp + mm, row = u.pm * 256 + ai * 128 + wr * 64 + m * 16 + fr;
                    float ss = 0.f;
#pragma unroll
                    for (int bj = 0; bj < 2; ++bj) {
                        const size_t off = (size_t)row * DM + u.pn * 256 + bj * 128 + wc * 32 + 8 * fq;
                        const f32x4 v0 = acc[ai][bj][m][0] + b0[mm][bj], v1 = acc[ai][bj][m][1] + b1[mm][bj];
                        const u32x4 pk = pack8(v0, v1);
                        *(u32x4*)(xb + off) = pk;
                        if (res) *(u32x4*)(res + off) = pk;
                        ss += (v0[0] * v0[0] + v0[1] * v0[1]) + (v0[2] * v0[2] + v0[3] * v0[3]) + (v1[0] * v1[0] + v1[1] * v1[1]) + (v1[2] * v1[2] + v1[3] * v1[3]);
                    }
                    ss = sum_fq(ss);
                    if (fq == 0) ssp[(size_t)row * 16 + u.pn * 4 + wc] = ss;
                }
                asm volatile("" ::: "memory");
            }
    }
};
struct EpiSwiGLU {
    static constexpr bool KHOOK = false;
    const float* ssp; bf16_t* H;
    __device__ __forceinline__ void operator()(const f32x4 (&acc)[2][2][4][2], const Unit& u, int wr, int wc, int fr, int fq) const {
        asm volatile("" : "+v"(fr), "+v"(fq));
        float rs[2][4];
#pragma unroll
        for (int ai = 0; ai < 2; ++ai) { f32x4 ra[4];
#pragma unroll
            for (int m = 0; m < 4; ++m) ra[m] = *((const f32x4*)(ssp + (size_t)(u.pm * 256 + ai * 128 + wr * 64 + m * 16 + fr) * 16) + fq);
            __builtin_amdgcn_sched_barrier(0);
#pragma unroll
            for (int m = 0; m < 4; ++m) { float ss = (ra[m][0] + ra[m][1]) + (ra[m][2] + ra[m][3]); ss = sum_fq(ss); rs[ai][m] = 1.0f / sqrtf(ss * (1.0f / DM) + RMS_EPS); } }
#pragma unroll
        for (int ai = 0; ai < 2; ++ai)
#pragma unroll
            for (int m = 0; m < 4; ++m) {
                const int row = u.pm * 256 + ai * 128 + wr * 64 + m * 16 + fr;
                const float rstd = rs[ai][m];
                f32x4 o[2];
#pragma unroll
                for (int n = 0; n < 2; ++n)
#pragma unroll
                    for (int e = 0; e < 4; ++e) { const float gt = acc[ai][0][m][n][e] * rstd, up = acc[ai][1][m][n][e] * rstd; o[n][e] = gt * sigmoidf_(gt) * up; }
                *(u32x4*)(H + (size_t)row * DFF + u.pn * 128 + wc * 32 + 8 * fq) = pack8(o[0], o[1]);
                asm volatile("" ::: "memory");
            }
    }
};
namespace att {
constexpr int KCS = 1040, KSLOT = 8 * KCS, VSLOT = 8192;
constexpr int L_K0 = 0, L_V0 = 4 * KSLOT, L_WSF = 4 * KSLOT + 4 * VSLOT, L_MSK = L_WSF + 8 * 256, L_UNI = L_MSK + 1024, L_LIST = L_UNI + 64, L_END = L_LIST + 512,
              L_PS = L_END + 64, L_OT = L_PS, L_TOTAL = L_OT + 8 * 8192;
static_assert(L_TOTAL <= 147456 - 64, "attention LDS map");
#define LBAR() asm volatile("s_waitcnt lgkmcnt(0)\n\ts_barrier" ::: "memory")
#define LWAIT() asm volatile("s_waitcnt lgkmcnt(0)" ::: "memory")
__device__ __forceinline__ int crow(int r, int hi) { return (r & 3) + 8 * (r >> 2) + 4 * hi; }
__device__ __forceinline__ float swap_other(float v, int hi) { auto rr = __builtin_amdgcn_permlane32_swap(__float_as_uint(v), __float_as_uint(v), false, false); return __uint_as_float(hi ? rr[0] : rr[1]); }
__device__ __forceinline__ void qkt(f32x16& p0, f32x16& p1, const LAS char* Ks, const bf16x8* qr, const f32x16& cinit, int r32, int hi) {
    const LAS char* kb = Ks + hi * KCS + r32 * 16;
    bf16x8 kf[8];
#pragma unroll
    for (int d0 = 0; d0 < 4; ++d0) { kf[2 * d0] = *(const LAS bf16x8*)(kb + d0 * 2 * KCS); kf[2 * d0 + 1] = *(const LAS bf16x8*)(kb + d0 * 2 * KCS + 512); }
    __builtin_amdgcn_sched_barrier(0);
    p0 = __builtin_amdgcn_mfma_f32_32x32x16_bf16(kf[0], qr[0], cinit, 0, 0, 0); p1 = __builtin_amdgcn_mfma_f32_32x32x16_bf16(kf[1], qr[0], cinit, 0, 0, 0);
#pragma unroll
    for (int d0 = 1; d0 < 4; ++d0) { p0 = __builtin_amdgcn_mfma_f32_32x32x16_bf16(kf[2 * d0], qr[d0], p0, 0, 0, 0); p1 = __builtin_amdgcn_mfma_f32_32x32x16_bf16(kf[2 * d0 + 1], qr[d0], p1, 0, 0, 0); }
}
struct VFrag { s16x4 lo[8], hi[8]; };
typedef short v4i16_t __attribute__((ext_vector_type(4)));
__device__ __forceinline__ s16x4 vtr(const LAS char* p) { return __builtin_bit_cast(s16x4, __builtin_amdgcn_ds_read_tr16_b64_v4i16((LAS v4i16_t*)p)); }
__device__ __forceinline__ void v_issue(VFrag& F, const LAS char* vp) {
#pragma unroll
    for (int d0 = 0; d0 < 2; ++d0)
#pragma unroll
        for (int ks = 0; ks < 4; ++ks) { F.lo[d0 * 4 + ks] = vtr(vp + d0 * 4096 + ks * 1024); F.hi[d0 * 4 + ks] = vtr(vp + d0 * 4096 + ks * 1024 + 512); }
}
template <bool SUM> __device__ __forceinline__ void pv(f32x16* o, f32x16& osum, VFrag& F, bf16x8 pa0, bf16x8 pa1, bf16x8 pa2, bf16x8 pa3) {
#define PK(k) (bf16x8){F.lo[k][0], F.lo[k][1], F.lo[k][2], F.lo[k][3], F.hi[k][0], F.hi[k][1], F.hi[k][2], F.hi[k][3]}
    const bf16x8 ones = {0x3F80, 0x3F80, 0x3F80, 0x3F80, 0x3F80, 0x3F80, 0x3F80, 0x3F80};
    __builtin_amdgcn_s_setprio(1);
    o[0] = __builtin_amdgcn_mfma_f32_32x32x16_bf16(pa0, PK(0), o[0], 0, 0, 0);
    o[1] = __builtin_amdgcn_mfma_f32_32x32x16_bf16(pa0, PK(4), o[1], 0, 0, 0);
    if (SUM) osum = __builtin_amdgcn_mfma_f32_32x32x16_bf16(pa0, ones, osum, 0, 0, 0);
    o[0] = __builtin_amdgcn_mfma_f32_32x32x16_bf16(pa1, PK(1), o[0], 0, 0, 0);
    o[1] = __builtin_amdgcn_mfma_f32_32x32x16_bf16(pa1, PK(5), o[1], 0, 0, 0);
    if (SUM) osum = __builtin_amdgcn_mfma_f32_32x32x16_bf16(pa1, ones, osum, 0, 0, 0);
    o[0] = __builtin_amdgcn_mfma_f32_32x32x16_bf16(pa2, PK(2), o[0], 0, 0, 0);
    o[1] = __builtin_amdgcn_mfma_f32_32x32x16_bf16(pa2, PK(6), o[1], 0, 0, 0);
    if (SUM) osum = __builtin_amdgcn_mfma_f32_32x32x16_bf16(pa2, ones, osum, 0, 0, 0);
    o[0] = __builtin_amdgcn_mfma_f32_32x32x16_bf16(pa3, PK(3), o[0], 0, 0, 0);
    o[1] = __builtin_amdgcn_mfma_f32_32x32x16_bf16(pa3, PK(7), o[1], 0, 0, 0);
    if (SUM) osum = __builtin_amdgcn_mfma_f32_32x32x16_bf16(pa3, ones, osum, 0, 0, 0);
    __builtin_amdgcn_s_setprio(0);
#undef PK
}
__device__ __forceinline__ float rowmax(const f32x16& p0, const f32x16& p1, int hi) {
    float a = __builtin_fmaxf(p0[0], p1[0]);
#pragma unroll
    for (int r = 1; r < 16; ++r) a = __builtin_fmaxf(__builtin_fmaxf(a, p0[r]), p1[r]);
    return __builtin_fmaxf(a, swap_other(a, hi));
}
struct KVRegs { u32x4 k, v; };
__device__ __forceinline__ void tile_load(KVRegs& R, const bf16_t* K, const bf16_t* V, int tid) { R.k = *(const u32x4*)(K + tid * 8); R.v = *(const u32x4*)(V + tid * 8); }
__device__ __forceinline__ void tile_store(const KVRegs& R, LAS char* Ks, LAS char* Vs, int tid) {
    const int row = tid >> 3, c = tid & 7;
    *(LAS u32x4*)(Ks + c * KCS + row * 16) = R.k;
    *(LAS u32x4*)(Vs + (c >> 2) * 4096 + (row >> 4) * 1024 + (row & 15) * 64 + (c & 3) * 16) = R.v;
}
__device__ __forceinline__ void ps_accum(const f32x16 p, int jb, LAS float* ps_row, bool writer) {
#pragma unroll
    for (int rg = 0; rg < 4; ++rg) {
        float a = 2.f * (p[4 * rg] + p[4 * rg + 1] + p[4 * rg + 2]) + p[4 * rg + 3], bq = p[4 * rg + 3];
        a += __builtin_bit_cast(float, __builtin_amdgcn_update_dpp(0, __builtin_bit_cast(int, a), 0xB1, 0xF, 0xF, true)); a += __builtin_bit_cast(float, __builtin_amdgcn_update_dpp(0, __builtin_bit_cast(int, a), 0x4E, 0xF, 0xF, true));
        bq += __builtin_bit_cast(float, __builtin_amdgcn_update_dpp(0, __builtin_bit_cast(int, bq), 0xB1, 0xF, 0xF, true)); bq += __builtin_bit_cast(float, __builtin_amdgcn_update_dpp(0, __builtin_bit_cast(int, bq), 0x4E, 0xF, 0xF, true));
        const int j = jb + 2 * rg;
        if (writer) { __hip_atomic_fetch_add(ps_row + j, a, __ATOMIC_RELAXED, __HIP_MEMORY_SCOPE_WORKGROUP); if (j + 1 < 128) __hip_atomic_fetch_add(ps_row + j + 1, bq, __ATOMIC_RELAXED, __HIP_MEMORY_SCOPE_WORKGROUP); }
    }
}
struct Ctx { LAS char* lds; LAS float* wsf; LAS float* otl; int tid, wid, lane, r32, hi, vbl; };
struct RowSt { float m, l; bool started; f32x16 negm, osum; };
__device__ __forceinline__ void rowst_init(RowSt& S) { S.m = 0.f; S.l = 0.f; S.started = false; S.negm = f32x16{}; S.osum = f32x16{}; asm volatile("" : "+v"(S.negm)); }
__device__ __forceinline__ void rowst_fixed(RowSt& S, float ref) { S.m = ref; S.l = 0.f; S.started = true; S.osum = f32x16{};
#pragma unroll
    for (int r = 0; r < 16; ++r) S.negm[r] = -ref;
    asm volatile("" : "+v"(S.negm)); }
template <int MODE, class Idx, class Src, class Msk>
__device__ __forceinline__ void run_branch(const Ctx& C, int nt, const Idx& idx, const Src& src, const Msk& msk, const bf16x8* qr, RowSt& S, f32x16* o, LAS float* ps_row, bool ps_writer, KVRegs& R0, bool pre, const bf16_t* nk, const bf16_t* nv) {
    KVRegs R1; const bf16_t *kp, *vp;
    int dA = idx(0), dB = nt > 1 ? idx(1) : 0, dC = 0, dD = 0;
    if (!pre) { src(0, dA, kp, vp); tile_load(R0, kp, vp, C.tid); }
    if (nt > 1) { src(1, dB, kp, vp); tile_load(R1, kp, vp, C.tid); }
    auto compute = [&](int it, const LAS char* Ks, const LAS char* Vs, int klo, int khi, bool nm) {
        const bool kill = khi < klo;
        if (!__any(!kill)) return;
        f32x16 p0, p1; qkt(p0, p1, Ks, qr, S.negm, C.r32, C.hi);
        VFrag VF; if constexpr (MODE != 0) { v_issue(VF, Vs + C.vbl); __builtin_amdgcn_sched_barrier(0); }
        if (__any(nm && !kill)) {
#pragma unroll
            for (int r = 0; r < 16; ++r) { const int kv = crow(r, C.hi); if (kv < klo || kv > khi) p0[r] = -INFINITY; if (kv + 32 < klo || kv + 32 > khi) p1[r] = -INFINITY; }
        }
        if constexpr (MODE != 2) {
            float rm = rowmax(p0, p1, C.hi); if (kill) rm = -INFINITY;
            const bool first = !S.started && rm > -INFINITY, grow = first || rm > 8.0f;
            if (__any(grow)) {
                const float d = grow ? rm : 0.f, alpha = first ? 1.0f : __builtin_amdgcn_exp2f(-d);
                S.m += d; S.started = S.started || first;
#pragma unroll
                for (int r = 0; r < 16; ++r) { S.negm[r] = -S.m; p0[r] -= d; p1[r] -= d; }
                if constexpr (MODE == 0) S.l *= alpha;
                if constexpr (MODE == 1) {
                    if (C.hi == 0) C.wsf[C.r32] = alpha;
                    LWAIT();
#pragma unroll
                    for (int r = 0; r < 16; ++r) { const float f = C.wsf[crow(r, C.hi)]; o[0][r] *= f; o[1][r] *= f; S.osum[r] *= f; }
                    LWAIT();
                }
            }
        }
#pragma unroll
        for (int r = 0; r < 16; ++r) { p0[r] = __builtin_amdgcn_exp2f(p0[r]); p1[r] = __builtin_amdgcn_exp2f(p1[r]); }
        if constexpr (MODE == 0) {
            float s = 0.f;
#pragma unroll
            for (int r = 0; r < 16; ++r) s += p0[r] + p1[r];
            S.l += kill ? 0.f : s;
        }
        if constexpr (MODE == 2) {
            if (__any(kill)) {
#pragma unroll
                for (int r = 0; r < 16; ++r) { p0[r] = kill ? 0.f : p0[r]; p1[r] = kill ? 0.f : p1[r]; }
            }
            ps_accum(p0, 16 * it + C.hi, ps_row, ps_writer); ps_accum(p1, 16 * it + 8 + C.hi, ps_row, ps_writer);
        }
        if constexpr (MODE != 0) {
            u32x4 w0 = {cvtpk(p0[0], p0[1]), cvtpk(p0[2], p0[3]), cvtpk(p0[4], p0[5]), cvtpk(p0[6], p0[7])}, w1 = {cvtpk(p0[8], p0[9]), cvtpk(p0[10], p0[11]), cvtpk(p0[12], p0[13]), cvtpk(p0[14], p0[15])};
            u32x4 w2 = {cvtpk(p1[0], p1[1]), cvtpk(p1[2], p1[3]), cvtpk(p1[4], p1[5]), cvtpk(p1[6], p1[7])}, w3 = {cvtpk(p1[8], p1[9]), cvtpk(p1[10], p1[11]), cvtpk(p1[12], p1[13]), cvtpk(p1[14], p1[15])};
            if constexpr (MODE == 1) {
                if (__any(kill)) {
#pragma unroll
                    for (int e = 0; e < 4; ++e) { w0[e] = kill ? 0u : w0[e]; w1[e] = kill ? 0u : w1[e]; w2[e] = kill ? 0u : w2[e]; w3[e] = kill ? 0u : w3[e]; }
                }
            }
            pv<MODE == 1>(o, S.osum, VF, __builtin_bit_cast(bf16x8, w0), __builtin_bit_cast(bf16x8, w1), __builtin_bit_cast(bf16x8, w2), __builtin_bit_cast(bf16x8, w3));
        }
    };
    LBAR();
    for (int it = 0; it < nt; it += 2) {
        const int p = (it >> 1) & 1; const bool two = it + 1 < nt;
        LAS char* KsA = C.lds + L_K0 + (2 * p) * KSLOT; LAS char* VsA = C.lds + L_V0 + (2 * p) * VSLOT;
        LAS char* KsB = KsA + KSLOT; LAS char* VsB = VsA + VSLOT;
        tile_store(R0, KsA, VsA, C.tid); if (two) tile_store(R1, KsB, VsB, C.tid);
        if (it + 2 < nt) dC = idx(it + 2);
        if (it + 3 < nt) dD = idx(it + 3);
        int kloA, khiA, kloB = 0, khiB = -1; const bool nmA = msk(it, dA, kloA, khiA); bool nmB = false; if (two) nmB = msk(it + 1, dB, kloB, khiB);
        if (it + 2 < nt) { src(it + 2, dC, kp, vp); tile_load(R0, kp, vp, C.tid); } else if (nk) tile_load(R0, nk, nv, C.tid);
        if (it + 3 < nt) { src(it + 3, dD, kp, vp); tile_load(R1, kp, vp, C.tid); }
        LBAR();
        compute(it, KsA, VsA, kloA, khiA, nmA);
        if (two) compute(it + 1, KsB, VsB, kloB, khiB, nmB);
        dA = dC; dB = dD;
    }
}
template <bool FIRST> __device__ __forceinline__ void merge_branch_n(const Ctx& C, const f32x16* o, const f32x16& osum, float gate) {
    if (C.hi == 0) C.wsf[C.r32] = gate;
    LWAIT();
#pragma unroll
    for (int r0 = 0; r0 < 16; r0 += 8) {
        float gf[8], t0[8], t1[8];
#pragma unroll
        for (int r = 0; r < 8; ++r) { gf[r] = C.wsf[crow(r0 + r, C.hi)]; t0[r] = FIRST ? 0.f : C.otl[(r0 + r) * 64]; t1[r] = FIRST ? 0.f : C.otl[(16 + r0 + r) * 64]; }
        __builtin_amdgcn_sched_barrier(0);
#pragma unroll
        for (int r = 0; r < 8; ++r) { const float den = osum[r0 + r], f = den > 0.f ? gf[r] * __builtin_amdgcn_rcpf(den) : 0.f;
            C.otl[(r0 + r) * 64] = t0[r] + o[0][r0 + r] * f; C.otl[(16 + r0 + r) * 64] = t1[r] + o[1][r0 + r] * f; } }
    LWAIT();
}
template <bool FIRST> __device__ __forceinline__ void merge_branch(const Ctx& C, const f32x16* o, float factor) {
    if (C.hi == 0) C.wsf[C.r32] = factor;
    LWAIT();
#pragma unroll
    for (int r0 = 0; r0 < 16; r0 += 8) {
        float gf[8], t0[8], t1[8];
#pragma unroll
        for (int r = 0; r < 8; ++r) { gf[r] = C.wsf[crow(r0 + r, C.hi)]; t0[r] = FIRST ? 0.f : C.otl[(r0 + r) * 64]; t1[r] = FIRST ? 0.f : C.otl[(16 + r0 + r) * 64]; }
        __builtin_amdgcn_sched_barrier(0);
#pragma unroll
        for (int r = 0; r < 8; ++r) { C.otl[(r0 + r) * 64] = t0[r] + o[0][r0 + r] * gf[r]; C.otl[(16 + r0 + r) * 64] = t1[r] + o[1][r0 + r] * gf[r]; } }
    LWAIT();
}
struct Bufs { const bf16_t *Qn, *KV, *Mo, *KC, *KM, *Gn; bf16_t* Abr; };
constexpr size_t KV_STRIDE = (size_t)MTOK * 128, MO_STRIDE = (size_t)MTOK * 256;

__device__ __forceinline__ void nsa_item(const Ctx& C, const Bufs& B, int b, int g, int i) {
    const int r32 = C.r32, hi = C.hi, wid = C.wid;
    const int qi = 8 * wid + (r32 >> 2), hh = r32 & 3, head = g * 4 + hh, t = 64 * i + qi, cur = i;
    const size_t bg = (size_t)(b * 2 + g) * SEQ;
    bf16x8 qr[4];
    { const bf16_t* qp = B.Qn + ((size_t)(b * 8 + head) * SEQ + t) * 64 + hi * 8;
#pragma unroll
      for (int d0 = 0; d0 < 4; ++d0) qr[d0] = *(const bf16x8*)(qp + d0 * 16); }
    const unsigned gw = *(const unsigned*)(B.Gn + ((size_t)b * SEQ + t) * 32 + head * 3 - (head & 1));
    const unsigned gw2 = *(const unsigned*)(B.Gn + ((size_t)b * SEQ + t) * 32 + head * 3 - (head & 1) + 2);
    float g0, g1, g2; if (head & 1) { g0 = bfhi(gw); g1 = bflo(gw2); g2 = bfhi(gw2); } else { g0 = bflo(gw); g1 = bfhi(gw); g2 = bflo(gw2); }
    f32x16 o[2];
    LAS float* Ps = (LAS float*)(C.lds + L_PS); LAS unsigned* Mk = (LAS unsigned*)(C.lds + L_MSK); LAS unsigned* Uni = (LAS unsigned*)(C.lds + L_UNI); LAS int* List = (LAS int*)(C.lds + L_LIST);
    const int nv = t >= 31 ? ((t - 31) >> 4) + 1 : 0;
    const int nvt = (4 * i + 3 < 511) ? 4 * i + 3 : 511, ntc = (nvt + 63) >> 6;
    const bf16_t* kc = B.KC + (size_t)(0 * 4 + b * 2 + g) * 512 * 64; const bf16_t* vc = B.KC + (size_t)(1 * 4 + b * 2 + g) * 512 * 64;
    auto idxI = [&](int it) { return it; };
    auto srcC = [&](int it, int, const bf16_t*& kp, const bf16_t*& vp) { kp = kc + (size_t)it * 4096; vp = vc + (size_t)it * 4096; };
    auto mskC = [&](int it, int, int& klo, int& khi) { klo = 0; khi = nv - 1 - 64 * it; return khi < 63; };
    RowSt S; rowst_init(S);
    KVRegs R;
    run_branch<0>(C, ntc, idxI, srcC, mskC, qr, S, o, nullptr, false, R, false, kc, vc);
    const float lt = S.l + swap_other(S.l, hi);
    rowst_fixed(S, lt > 0.f ? S.m + __builtin_amdgcn_logf(lt) : 0.f);
    for (int e = C.tid; e < 64 * 128; e += 512) Ps[e] = 0.f;
    if (C.tid < 8) Uni[C.tid] = 0u;
    o[0] = f32x16{}; o[1] = f32x16{};
    run_branch<2>(C, ntc, idxI, srcC, mskC, qr, S, o, Ps + qi * 128, hh == 0, R, true, B.KV + 2 * KV_STRIDE + bg * 64, B.KV + 3 * KV_STRIDE + bg * 64);
    LBAR();
    {
        const int nf = cur == 0 ? 1 : (cur == 1 ? 2 : 3), kp_ = 16 - nf, lane = C.lane;
#pragma unroll 1
        for (int qq = 0; qq < 8; ++qq) {
            int q = 8 * wid + qq; asm volatile("" : "+s"(q)); LAS float* ps = Ps + q * 128;
            const int j0 = lane, j1 = lane + 64;
            const bool f0 = (j0 == 0 || j0 == cur || j0 == cur - 1) && j0 <= cur, f1 = (j1 == cur || j1 == cur - 1) && j1 <= cur;
            const bool va0 = j0 <= cur && !f0, va1 = j1 <= cur && !f1;
            const unsigned k0 = va0 ? __float_as_uint(ps[j0]) + 1u : 0u, k1 = va1 ? __float_as_uint(ps[j1]) + 1u : 0u;
            unsigned T = 0u;
            for (int bit = 30; bit >= 0; --bit) { const unsigned cand = T | (1u << bit); const int cnt = __popcll(__ballot(k0 >= cand)) + __popcll(__ballot(k1 >= cand)); if (cnt >= kp_) T = cand; }
            const int need = kp_ - (__popcll(__ballot(k0 > T)) + __popcll(__ballot(k1 > T)));
            const unsigned long long t0 = __ballot(k0 == T), t1 = __ballot(k1 == T), below = (1ull << lane) - 1ull;
            const int pre0 = __popcll(t0 & below), pre1 = __popcll(t0) + __popcll(t1 & below);
            const bool s0 = f0 || (k0 > 0u && (k0 > T || (k0 == T && pre0 < need))), s1 = f1 || (k1 > 0u && (k1 > T || (k1 == T && pre1 < need)));
            const unsigned long long b0 = __ballot(s0), b1 = __ballot(s1);
            if (lane == 0) { Mk[q * 4 + 0] = (unsigned)b0; Mk[q * 4 + 1] = (unsigned)(b0 >> 32); Mk[q * 4 + 2] = (unsigned)b1; Mk[q * 4 + 3] = (unsigned)(b1 >> 32);
                __hip_atomic_fetch_or(&Uni[0], (unsigned)b0, __ATOMIC_RELAXED, __HIP_MEMORY_SCOPE_WORKGROUP); __hip_atomic_fetch_or(&Uni[1], (unsigned)(b0 >> 32), __ATOMIC_RELAXED, __HIP_MEMORY_SCOPE_WORKGROUP); __hip_atomic_fetch_or(&Uni[2], (unsigned)b1, __ATOMIC_RELAXED, __HIP_MEMORY_SCOPE_WORKGROUP); __hip_atomic_fetch_or(&Uni[3], (unsigned)(b1 >> 32), __ATOMIC_RELAXED, __HIP_MEMORY_SCOPE_WORKGROUP); }
        }
    }
    LBAR();
    if (C.tid < 128) {
        const int wi = C.tid >> 5, bi = C.tid & 31; const unsigned u0 = Uni[0], u1 = Uni[1], u2 = Uni[2], u3 = Uni[3];
        const unsigned mine = wi == 0 ? u0 : wi == 1 ? u1 : wi == 2 ? u2 : u3;
        const int before = (wi > 0 ? __popc(u0) : 0) + (wi > 1 ? __popc(u1) : 0) + (wi > 2 ? __popc(u2) : 0) + __popc(mine & ((1u << bi) - 1u));
        if ((mine >> bi) & 1u) List[before] = C.tid;
        if (C.tid == 0) Uni[4] = (unsigned)(__popc(u0) + __popc(u1) + __popc(u2) + __popc(u3));
    }
    LBAR();
    merge_branch<true>(C, o, g0);
    {
        const int nsel = (int)Uni[4];
        const bf16_t* ks = B.KV + 2 * KV_STRIDE + bg * 64; const bf16_t* vs = B.KV + 3 * KV_STRIDE + bg * 64;
        auto idxS = [&](int it) { return List[it]; };
        auto srcS = [&](int, int j, const bf16_t*& kp, const bf16_t*& vp) { kp = ks + (size_t)j * 4096; vp = vs + (size_t)j * 4096; };
        auto mskS = [&](int, int j, int& klo, int& khi) { const unsigned w = Mk[qi * 4 + (j >> 5)]; const bool bit = (w >> (j & 31)) & 1u;
            klo = 0; khi = bit ? (j == cur ? qi : 63) : -1; return j == cur; };
        rowst_init(S); o[0] = f32x16{}; o[1] = f32x16{};
        const int tw0n = i >= 8 ? i - 8 : 0;
        run_branch<1>(C, nsel, idxS, srcS, mskS, qr, S, o, nullptr, false, R, true, B.KV + 4 * KV_STRIDE + bg * 64 + (size_t)tw0n * 4096, B.KV + 5 * KV_STRIDE + bg * 64 + (size_t)tw0n * 4096);
        merge_branch_n<false>(C, o, S.osum, g1);
    }
    {
        const int tw0 = i >= 8 ? i - 8 : 0, ntw = i - tw0 + 1;
        const bf16_t* kw = B.KV + 4 * KV_STRIDE + bg * 64; const bf16_t* vw = B.KV + 5 * KV_STRIDE + bg * 64;
        auto srcW = [&](int it, int, const bf16_t*& kp, const bf16_t*& vp) { kp = kw + (size_t)(tw0 + it) * 4096; vp = vw + (size_t)(tw0 + it) * 4096; };
        auto mskW = [&](int it, int, int& klo, int& khi) { const int tw = tw0 + it; klo = (t - 511) - 64 * tw; khi = (tw == i) ? qi : 63; return tw == i || klo > 0; };
        rowst_init(S); o[0] = f32x16{}; o[1] = f32x16{};
        run_branch<1>(C, ntw, idxI, srcW, mskW, qr, S, o, nullptr, false, R, true, nullptr, nullptr);
        merge_branch_n<false>(C, o, S.osum, g2);
    }
#pragma unroll
    for (int r0 = 0; r0 < 16; r0 += 8) { float t0[8], t1[8];
#pragma unroll
        for (int r = 0; r < 8; ++r) { t0[r] = C.otl[(r0 + r) * 64]; t1[r] = C.otl[(16 + r0 + r) * 64]; }
        __builtin_amdgcn_sched_barrier(0);
#pragma unroll
        for (int r = 0; r < 8; ++r) { const int qrow = crow(r0 + r, hi); bf16_t* dst = B.Abr + ((size_t)b * SEQ + 64 * i + 8 * wid + (qrow >> 2)) * DM + 256 + (g * 4 + (qrow & 3)) * 64 + r32;
            dst[0] = (bf16_t)(cvtpk(t0[r], 0.f) & 0xffffu); dst[32] = (bf16_t)(cvtpk(t1[r], 0.f) & 0xffffu); } }
}
__device__ __forceinline__ void moba_item(const Ctx& C, const Bufs& B, int b, int h, int qb) {
    const int r32 = C.r32, hi = C.hi, wid = C.wid, own = qb, t = 256 * qb + 32 * wid + r32;
    const size_t bh = (size_t)(b * 4 + h) * SEQ;
    bf16x8 qr[4];
    { const bf16_t* qp = B.Mo + (bh + t) * 64 + hi * 8;
#pragma unroll
      for (int d0 = 0; d0 < 4; ++d0) qr[d0] = *(const bf16x8*)(qp + d0 * 16); }
    LAS unsigned* Uni = (LAS unsigned*)(C.lds + L_UNI); LAS int* List = (LAS int*)(C.lds + L_LIST);
    LBAR();
    if (C.tid < 256) { const u32x4 kmv = *(const u32x4*)(B.KM + (size_t)(b * 4 + h) * 2048 + C.tid * 8); *(LAS u32x4*)(C.lds + L_K0 + (C.tid & 7) * KCS + (C.tid >> 3) * 16) = kmv; }
    if (C.tid == 0) Uni[0] = 0u;
    LBAR();
    unsigned sel = 0u;
    {
        f32x16 gs = f32x16{};
        const LAS char* kb = C.lds + L_K0 + hi * KCS + r32 * 16;
#pragma unroll
        for (int d0 = 0; d0 < 4; ++d0) gs = __builtin_amdgcn_mfma_f32_32x32x16_bf16(*(const LAS bf16x8*)(kb + d0 * 2 * KCS), qr[d0], gs, 0, 0, 0);
        float lo[16], hv[16];
#pragma unroll
        for (int r = 0; r < 16; ++r) { const float ownv = gs[r], oth = swap_other(ownv, hi); lo[r] = hi ? oth : ownv; hv[r] = hi ? ownv : oth; }
        unsigned taken = ~((1u << own) - 1u);
#pragma unroll
        for (int round = 0; round < 3; ++round) {
            float best = -INFINITY; int bi = 32;
#pragma unroll
            for (int n = 0; n < 32; ++n) { const int rr = (n & 3) + 4 * (n >> 3); const float v = ((n >> 2) & 1) ? hv[rr] : lo[rr]; if (!((taken >> n) & 1u) && v > best) { best = v; bi = n; } }
            if (bi < 32) { sel |= 1u << bi; taken |= 1u << bi; }
        }
    }
    { unsigned u = sel;
#pragma unroll
      for (int o_ = 1; o_ < 64; o_ <<= 1) u |= (unsigned)__shfl_xor((int)u, o_);
      if (C.lane == 0) __hip_atomic_fetch_or(&Uni[0], u, __ATOMIC_RELAXED, __HIP_MEMORY_SCOPE_WORKGROUP); }
    LBAR();
    if (C.tid == 0) { int n = 0; unsigned u = Uni[0]; while (u) { const int bpos = __builtin_ctz(u); u &= u - 1; List[n++] = bpos; } Uni[4] = (unsigned)n; }
    LBAR();
    const int nl = (int)Uni[4], nt = 4 * nl + 4;
    const bf16_t* kk = B.Mo + MO_STRIDE + bh * 64; const bf16_t* vv = B.Mo + 2 * MO_STRIDE + bh * 64;
    auto idxM = [&](int it) { return (it < 4 * nl) ? List[it >> 2] : own; };
    auto src = [&](int it, int blk, const bf16_t*& kp, const bf16_t*& vp) { const int T = 4 * blk + ((it < 4 * nl) ? (it & 3) : (it - 4 * nl)); kp = kk + (size_t)T * 4096; vp = vv + (size_t)T * 4096; };
    auto msk = [&](int it, int blk, int& klo, int& khi) { klo = 0; if (it < 4 * nl) { const bool bit = (sel >> blk) & 1u; khi = bit ? 63 : -1; return false; } khi = 32 * wid + r32 - 64 * (it - 4 * nl); return true; };
    RowSt S; rowst_init(S); f32x16 o[2] = {f32x16{}, f32x16{}};
    KVRegs R;
    run_branch<1>(C, nt, idxM, src, msk, qr, S, o, nullptr, false, R, false, nullptr, nullptr);
    merge_branch_n<true>(C, o, S.osum, 1.0f);
#pragma unroll
    for (int r0 = 0; r0 < 16; r0 += 8) { float t0[8], t1[8];
#pragma unroll
        for (int r = 0; r < 8; ++r) { t0[r] = C.otl[(r0 + r) * 64]; t1[r] = C.otl[(16 + r0 + r) * 64]; }
        __builtin_amdgcn_sched_barrier(0);
#pragma unroll
        for (int r = 0; r < 8; ++r) { const int qrow = crow(r0 + r, hi); bf16_t* dst = B.Abr + ((size_t)b * SEQ + 256 * qb + 32 * wid + qrow) * DM + 768 + h * 64 + r32;
            dst[0] = (bf16_t)(cvtpk(t0[r], 0.f) & 0xffffu); dst[32] = (bf16_t)(cvtpk(t1[r], 0.f) & 0xffffu); } }
}
}
#define XB_TMO      128
#define XB_XCNT(j)  (256  + 64 * (j))
#define XB_XSUB(j)  (1280 + 64 * (j))
#define XB_XGEN(j)  (2304 + 64 * (j))
#define XB_TOP      3328
#define XB_TOPGEN   3392
#define XCD_BAR_WORDS 3456
#define XB_SPIN_CAP (1u << 18)

__device__ __forceinline__ unsigned xb_ld(unsigned* p)              { return __hip_atomic_load(p, __ATOMIC_RELAXED, __HIP_MEMORY_SCOPE_AGENT); }
__device__ __forceinline__ unsigned xb_add(unsigned* p, unsigned v) { return __hip_atomic_fetch_add(p, v, __ATOMIC_RELAXED, __HIP_MEMORY_SCOPE_AGENT); }
__device__ __forceinline__ unsigned xb_xcc_id() { return (unsigned)__builtin_amdgcn_s_getreg((3 << 11) | 20) & 0xFu; }
#define XB_SPIN(cond, bar) do { unsigned _sp = 0; while (cond) { __builtin_amdgcn_s_sleep(1); \
    if ((++_sp & 255u) == 0u) { if (xb_ld(&(bar)[XB_TMO])) break; if (_sp > XB_SPIN_CAP) { atomicAdd(&(bar)[XB_TMO], 1u); break; } } } } while (0)

struct XcdBarrier {
    unsigned* bar; unsigned x;
    volatile LAS unsigned* st;
};

__device__ __forceinline__ XcdBarrier xcd_barrier_post(unsigned* bar, volatile LAS unsigned* st) {
    XcdBarrier b; b.bar = bar; b.x = xb_xcc_id(); b.st = st;
    if (threadIdx.x == 0) (void)xb_add(&bar[XB_XCNT(b.x)], 1u);
    return b;
}
__device__ __forceinline__ void xcd_barrier_complete(unsigned* bar, unsigned x, unsigned& nloc, unsigned& nx) {
    const unsigned G = gridDim.x * gridDim.y * gridDim.z;
    unsigned sum, cnt, mine, sp = 0u;
    for (;;) {
        sum = 0u; cnt = 0u; mine = 0u;
#pragma unroll
        for (unsigned j = 0; j < 16; ++j) { const unsigned c = xb_ld(&bar[XB_XCNT(j)]); sum += c; cnt += (c > 0u) ? 1u : 0u; mine = (j == x) ? c : mine; }
        if (sum == G) break;
        __builtin_amdgcn_s_sleep(1);
        if ((++sp & 255u) == 0u) { if (xb_ld(&bar[XB_TMO])) break; if (sp > XB_SPIN_CAP) { atomicAdd(&bar[XB_TMO], 1u); break; } }
    }
    nloc = mine > 0u ? mine : 1u; nx = cnt > 0u ? cnt : 1u;
}

__device__ __forceinline__ void xcd_barrier(const XcdBarrier& b) {
    asm volatile("s_waitcnt vmcnt(0)" ::: "memory");
    __syncthreads();
    if (threadIdx.x == 0) {
        unsigned* bar = b.bar;
        __builtin_amdgcn_s_waitcnt(0);
        unsigned nloc = b.st[0], nx = b.st[1];
        if (nloc == 0u) { xcd_barrier_complete(bar, b.x, nloc, nx); b.st[0] = nloc; b.st[1] = nx; }
        const unsigned old = xb_add(&bar[XB_XSUB(b.x)], 1u);
        const unsigned gen = old / nloc;
        if (old + 1u == (gen + 1u) * nloc) {
            __builtin_amdgcn_fence(__ATOMIC_RELEASE, "agent");
            asm volatile("s_waitcnt vmcnt(0)" ::: "memory");
            const unsigned og = xb_add(&bar[XB_TOP], 1u);
            const unsigned tg = og / nx;
            if (og + 1u == (tg + 1u) * nx) xb_add(&bar[XB_TOPGEN], 1u);
            else XB_SPIN(xb_ld(&bar[XB_TOPGEN]) == tg, bar);
            __builtin_amdgcn_fence(__ATOMIC_ACQUIRE, "agent");
            xb_add(&bar[XB_XGEN(b.x)], 1u);
            asm volatile("s_waitcnt vmcnt(0)" ::: "memory");
        } else {
            XB_SPIN(xb_ld(&bar[XB_XGEN(b.x)]) == gen, bar);
            __builtin_amdgcn_fence(__ATOMIC_ACQUIRE, "agent");
            asm volatile("s_waitcnt vmcnt(0)" ::: "memory");
        }
    }
    __syncthreads();
}

constexpr size_t MiB = 1u << 20;
constexpr size_t WS_CTL = 0, WS_ORDER = 4096, WS_BAR = 8192;
constexpr size_t WS_W = 1 * MiB, OFF_WIN = 0, OFF_WGU = 11 * MiB, OFF_WD = 22 * MiB, OFF_WBR = 28 * MiB, OFF_WOUT = 30 * MiB, OFF_W1 = 32 * MiB, OFF_W2 = 34 * MiB,
                 OFF_BIN = 34 * MiB + 65536, OFF_CB1 = OFF_BIN + 32768  , OFF_CB2 = OFF_CB1 + 65536;
constexpr size_t WS_TAB = 36 * MiB, WS_SSP = 38 * MiB, WS_KC = 39 * MiB, WS_KM = 39 * MiB + 512 * 1024, WS_GN = 40 * MiB, WS_XB = 42 * MiB, WS_BIG = 74 * MiB,
                 WS_U = 170 * MiB, WS_QN = 178 * MiB, WS_KV = 194 * MiB, WS_MO = 218 * MiB, WS_MRG = 178 * MiB, WS_END = 242 * MiB;
constexpr int LDS_BYTES = 147456;

__device__ __forceinline__ int dint(int pos) { return (pos >> 1) + 32 * (pos & 1); }
__device__ __forceinline__ int in_orig(int c) {
    if (c < 256) return c;
    if (c < 768) { const int c2 = c - 256; return 256 + (c2 >> 6) * 64 + dint(c2 & 63); }
    if (c < 1536) { const int c2 = c - 768, tt = c2 >> 8, bj = (c2 >> 7) & 1, g = (c2 >> 6) & 1, pos = c2 & 63; return 768 + (2 * tt + bj) * 128 + g * 64 + (bj == 0 ? dint(pos) : pos); }
    if (c < 2304) { const int c2 = c - 1536, part = c2 >> 8, h = (c2 >> 6) & 3, pos = c2 & 63; return 1560 + part * 256 + h * 64 + (part < 2 ? dint(pos) : pos); }
    if (c < 5376) return 2328 + (c - 2304);
    const int c2 = c - 5376; return c2 < 24 ? 1536 + c2 : -1;
}
template <class F> __device__ __forceinline__ void cvt_tile(LAS float* scr, int lane, int k0, int n0, bf16_t* dst, size_t pitch, F f) {
    float vals[32];
#pragma unroll
    for (int i = 0; i < 32; ++i) vals[i] = f(k0 + 2 * i + (lane >> 5), n0 + (lane & 31));
#pragma unroll
    for (int i = 0; i < 32; ++i) scr[(2 * i + (lane >> 5)) * 33 + (lane & 31)] = vals[i];
    asm volatile("s_waitcnt lgkmcnt(0)" ::: "memory");
    const int c = lane & 7;
#pragma unroll
    for (int j = 0; j < 4; ++j) { const int n = (lane >> 3) + 8 * j; const LAS float* s = scr + (8 * c) * 33 + n;
        u32x4 o; o.x = cvtpk(s[0 * 33], s[1 * 33]); o.y = cvtpk(s[2 * 33], s[3 * 33]); o.z = cvtpk(s[4 * 33], s[5 * 33]); o.w = cvtpk(s[6 * 33], s[7 * 33]);
        *(u32x4*)(dst + (size_t)(n0 + n) * pitch + k0 + 8 * c) = o; }
    asm volatile("s_waitcnt lgkmcnt(0)" ::: "memory");
}
template <class F> __device__ __forceinline__ void cvt_tile_scaled(LAS float* scr, int lane, int k0, int n0, bf16_t* dst, size_t pitch, F f, const float* scale, float keep) {
    float vals[32], sc[32];
#pragma unroll
    for (int i = 0; i < 32; ++i) { vals[i] = f(k0 + 2 * i + (lane >> 5), n0 + (lane & 31)); sc[i] = scale[k0 + 2 * i + (lane >> 5)]; }
    __builtin_amdgcn_sched_barrier(0);
#pragma unroll
    for (int i = 0; i < 32; ++i) scr[(2 * i + (lane >> 5)) * 33 + (lane & 31)] = vals[i] * (sc[i] * keep);
    asm volatile("s_waitcnt lgkmcnt(0)" ::: "memory");
    const int c = lane & 7;
#pragma unroll
    for (int j = 0; j < 4; ++j) { const int n = (lane >> 3) + 8 * j; const LAS float* s = scr + (8 * c) * 33 + n;
        u32x4 o; o.x = cvtpk(s[0 * 33], s[1 * 33]); o.y = cvtpk(s[2 * 33], s[3 * 33]); o.z = cvtpk(s[4 * 33], s[5 * 33]); o.w = cvtpk(s[6 * 33], s[7 * 33]);
        *(u32x4*)(dst + (size_t)(n0 + n) * pitch + k0 + 8 * c) = o; }
    asm volatile("s_waitcnt lgkmcnt(0)" ::: "memory");
}
struct Args { const float* in[20]; float* out; unsigned char* ws; };
typedef const __attribute__((address_space(4))) Args* ArgsP;

__device__ __forceinline__ void phase0(ArgsP a, int l, LAS unsigned char* lds, int tid, int lane, int wave, int gw, int NGW) {
    unsigned char* ws = a->ws;
    LAS float* scr = (LAS float*)(lds + wave * 8704);
    const float* attn_norm = a->in[1] + (size_t)l * DM; const float* w_in = a->in[2] + (size_t)l * DM * IN_COLS; const float* b_in = a->in[3] + (size_t)l * IN_COLS;
    const float* pool_w = a->in[4] + (size_t)l * 4 * 64 * 64; const float* pool_scale = a->in[5] + (size_t)l * 256; const float* cmp_pos = a->in[6] + (size_t)l * 2 * 32 * 64;
    const float* cmp_w1 = a->in[7] + (size_t)l * 2 * 2048 * 256; const float* cmp_b1 = a->in[8] + (size_t)l * 2 * 256; const float* cmp_w2 = a->in[9] + (size_t)l * 2 * 256 * 64; const float* cmp_b2 = a->in[10] + (size_t)l * 2 * 64;
    const float* w_br_pool = a->in[11] + (size_t)l * 256 * DM; const float* w_br_nsa = a->in[12] + (size_t)l * 512 * DM; const float* w_br_moba = a->in[13] + (size_t)l * 256 * DM;
    const float* w_out = a->in[14] + (size_t)l * DM * DM; const float* ffn_norm = a->in[15] + (size_t)l * DM; const float* w_gate = a->in[16] + (size_t)l * DM * DFF; const float* w_up = a->in[17] + (size_t)l * DM * DFF;
    const float* w_down = a->in[18] + (size_t)l * DFF * DM;
    bf16_t* Win = (bf16_t*)(ws + WS_W + OFF_WIN); bf16_t* Wgu = (bf16_t*)(ws + WS_W + OFF_WGU); bf16_t* Wd = (bf16_t*)(ws + WS_W + OFF_WD); bf16_t* Wbr = (bf16_t*)(ws + WS_W + OFF_WBR);
    bf16_t* Wout = (bf16_t*)(ws + WS_W + OFF_WOUT); bf16_t* W1t = (bf16_t*)(ws + WS_W + OFF_W1); bf16_t* W2t = (bf16_t*)(ws + WS_W + OFF_W2);
    float* bin = (float*)(ws + WS_W + OFF_BIN); float* cb1 = (float*)(ws + WS_W + OFF_CB1); float* cb2 = (float*)(ws + WS_W + OFF_CB2);
    constexpr int I_A = 16 * 176, I_B = 16 * 176, I_C = 44 * 32, I_D = 16 * 32, I_E = 16 * 32, I_F = 2 * 32 * 8, I_G = 2 * 4 * 2;
    constexpr int NITEMS = I_A + I_B + I_C + I_D + I_E + I_F + I_G;
    for (int it = gw; it < NITEMS; it += NGW) {
        int r = it;
        if (r < I_A) { const int kb = r / 176, nb = r % 176; { const int o = in_orig(32 * nb + (lane & 31)); const float* wc = w_in + (o >= 0 ? o : 0); const float keep = o >= 0 ? 1.f : 0.f;
            cvt_tile_scaled(scr, lane, 64 * kb, 32 * nb, Win, DM, [&](int k, int) { return wc[(size_t)k * IN_COLS]; }, attn_norm, keep); } continue; } r -= I_A;
        if (r < I_B) { const int kb = r / 176, nb = r % 176; { const int n = 32 * nb + (lane & 31), j = (n >> 8) * 128 + (n & 127); const float* wc = (((n >> 7) & 1) ? w_up : w_gate) + j;
            cvt_tile_scaled(scr, lane, 64 * kb, 32 * nb, Wgu, DM, [&](int k, int) { return wc[(size_t)k * DFF]; }, ffn_norm, 1.f); } continue; } r -= I_B;
        if (r < I_C) { const int kb = r / 32, nb = r % 32; cvt_tile(scr, lane, 64 * kb, 32 * nb, Wd, DFF, [&](int k, int n) { return w_down[(size_t)k * DM + n]; }); continue; } r -= I_C;
        if (r < I_D) { const int kb = r / 32, nb = r % 32; cvt_tile(scr, lane, 64 * kb, 32 * nb, Wout, DM, [&](int k, int n) { return w_out[(size_t)k * DM + n]; }); continue; } r -= I_D;
        if (r < I_E) { const int kb = r / 32, nb = r % 32;
            if (kb < 4) { }
            else if (kb < 12) cvt_tile(scr, lane, 64 * kb, 32 * nb, Wbr, DM, [&](int k, int n) { return w_br_nsa[(size_t)(k - 256) * DM + n]; });
            else cvt_tile(scr, lane, 64 * kb, 32 * nb, Wbr, DM, [&](int k, int n) { return w_br_moba[(size_t)(k - 768) * DM + n]; });
            continue; } r -= I_E;
        if (r < I_F) { const int kv = r >> 8, kb = (r >> 3) & 31, nb = r & 7; const float* w1 = cmp_w1 + (size_t)kv * 2048 * 256;
            cvt_tile(scr, lane, 64 * kb, 32 * nb, W1t + (size_t)kv * 256 * 2048, 2048, [&](int k, int n) { const int pos = k & 63, d = kv == 0 ? dint(pos) : pos; return w1[(size_t)((k & ~63) + d) * 256 + n]; }); continue; } r -= I_F;
        { const int kv = r >> 3, kb = (r >> 1) & 3, nb = r & 1; const float* w2 = cmp_w2 + (size_t)kv * 256 * 64;
            cvt_tile(scr, lane, 64 * kb, 32 * nb, W2t + (size_t)kv * 64 * 256, 256, [&](int k, int n) { return w2[(size_t)k * 64 + (kv == 0 ? dint(n) : n)]; }); }
    }
    const int gt = gw * 64 + lane, NGT = NGW * 64;
    for (int c = gt; c < NIN; c += NGT) { const int o = in_orig(c); bin[c] = o >= 0 ? b_in[o] : 0.f; }
    for (int idx = gt; idx < 32 * 512; idx += NGT) { const int c = idx >> 9, e = idx & 511, kv = e >> 8, n = e & 255; const float* w1 = cmp_w1 + (size_t)kv * 2048 * 256 + (size_t)(64 * c) * 256 + n; const float* pe = cmp_pos + (size_t)kv * 2048 + 64 * c;
        float s = c == 0 ? cmp_b1[kv * 256 + n] : 0.f;
#pragma unroll
        for (int k0 = 0; k0 < 64; k0 += 32) { float av[32], bv[32];
#pragma unroll
            for (int k = 0; k < 32; ++k) { av[k] = pe[k0 + k]; bv[k] = w1[(size_t)(k0 + k) * 256]; }
            __builtin_amdgcn_sched_barrier(0);
#pragma unroll
            for (int k = 0; k < 32; ++k) s += av[k] * bv[k]; }
        cb1[idx] = s; }
    for (int idx = gt; idx < 256 * DM; idx += NGT) { const int k = idx >> 10, n = idx & 1023, g64 = k & ~63; float s = 0.f;
        const f32x4* pw4 = (const f32x4*)(pool_w + (size_t)k * 64); const f32x4* ps4 = (const f32x4*)(pool_scale + g64);
#pragma unroll
        for (int j0 = 0; j0 < 64; j0 += 32) { f32x4 pw[8], psc[8]; float wb[32];
#pragma unroll
            for (int q = 0; q < 8; ++q) { pw[q] = pw4[j0 / 4 + q]; psc[q] = ps4[j0 / 4 + q]; }
#pragma unroll
            for (int j = 0; j < 32; ++j) wb[j] = w_br_pool[(size_t)(g64 + j0 + j) * DM + n];
            __builtin_amdgcn_sched_barrier(0);
#pragma unroll
            for (int j = 0; j < 32; ++j) s += pw[j >> 2][j & 3] * psc[j >> 2][j & 3] * wb[j]; }
        Wbr[(size_t)n * DM + k] = (bf16_t)(cvtpk(s, 0.f) & 0xffffu); }
    for (int e = gt; e < 128; e += NGT) { const int kv = e >> 6, n = e & 63; cb2[e] = cmp_b2[kv * 64 + (kv == 0 ? dint(n) : n)]; }
    if (l == 0) {
        float* tab = (float*)(ws + WS_TAB);
        for (int e = gt; e < SEQ * 32; e += NGT) { const int t = e >> 5, f = e & 31; const float inv = powf(10000.0f, -(float)(2 * f) / 64.0f); const float ang = (float)t * inv;
            const double ad = (double)ang, kq = rint(ad * 0.15915494309189535); double rr = fma(-kq, 6.283185307179586, ad); rr = fma(-kq, 2.4492935982947064e-16, rr);
            const float rf = (float)rr; tab[2 * e] = __cosf(rf); tab[2 * e + 1] = __sinf(rf); }
        const float* x = a->in[0]; bf16_t* xb = (bf16_t*)(ws + WS_XB); float* ssp = (float*)(ws + WS_SSP);
        for (int m0 = 2 * gw; m0 < MTOK; m0 += 2 * NGW) { f32x4 v[2][4]; float s[2] = {0.f, 0.f};
#pragma unroll
            for (int q = 0; q < 2; ++q) { const f32x4* xr = (const f32x4*)(x + (size_t)(m0 + q) * DM) + lane;
#pragma unroll
                for (int j = 0; j < 4; ++j) v[q][j] = xr[64 * j]; }
#pragma unroll
            for (int q = 0; q < 2; ++q) {
#pragma unroll
                for (int j = 0; j < 4; ++j) s[q] += (v[q][j][0] * v[q][j][0] + v[q][j][1] * v[q][j][1]) + (v[q][j][2] * v[q][j][2] + v[q][j][3] * v[q][j][3]);
#pragma unroll
                for (int o = 1; o < 64; o <<= 1) s[q] += __shfl_xor(s[q], o);
                u32x2* o8 = (u32x2*)(xb + (size_t)(m0 + q) * DM) + lane;
#pragma unroll
                for (int j = 0; j < 4; ++j) o8[64 * j] = (u32x2){cvtpk(v[q][j][0], v[q][j][1]), cvtpk(v[q][j][2], v[q][j][3])};
                if (lane < 16) ssp[(size_t)(m0 + q) * 16 + lane] = lane == 0 ? s[q] : 0.f; } }
        int* order = (int*)(ws + WS_ORDER);
        auto cost = [](int id) { if (id < 512) { const int i = id & 127; return 10 * ((i + 1) + ((i < 8 ? i : 8) + 1) + 10) + 16 * ((4 * i + 3 + 63) >> 6); } const int qb = (id - 512) & 31; return 7 * (4 * qb + 3) + 50; };
        for (int id = gw; id < 768; id += NGW) { const int mc = cost(id); int rk = 0;
            for (int j = lane; j < 768; j += 64) { const int cj = cost(j); rk += (cj > mc || (cj == mc && j < id)) ? 1 : 0; }
#pragma unroll
            for (int o = 1; o < 64; o <<= 1) rk += __shfl_xor(rk, o);
            if (lane == 0) order[rk] = id; }
    }
}
__device__ __forceinline__ float gelu_tanh(float x) { const float u = 0.7978845608028654f * (x + 0.044715f * x * x * x); const float th = 1.f - 2.f * __builtin_amdgcn_rcpf(1.f + __expf(2.f * u)); return 0.5f * x * (1.f + th); }
__device__ __forceinline__ void phase2(ArgsP a, LAS unsigned char* lds, int tid, int lane, int wave, int G) {
    unsigned char* ws = a->ws;
    const bf16_t* KV = (const bf16_t*)(ws + WS_KV); const bf16_t* W1t = (const bf16_t*)(ws + WS_W + OFF_W1); const bf16_t* W2t = (const bf16_t*)(ws + WS_W + OFF_W2);
    const float* cb1 = (const float*)(ws + WS_W + OFF_CB1); const float* cb2 = (const float*)(ws + WS_W + OFF_CB2);
    bf16_t* KC = (bf16_t*)(ws + WS_KC);
    LAS bf16_t* hid = (LAS bf16_t*)lds;
    const int arow = lane & 15, kq = lane >> 4;
    for (int task = blockIdx.x; task < 256; task += G) {
        const int kv = task >> 7, bgi = (task >> 5) & 3, nt = task & 31;
        const bf16_t* src = KV + (size_t)kv * att::KV_STRIDE + (size_t)bgi * SEQ * 64;
        const int nrow = 16 * nt + arow, neff = nrow < 510 ? nrow : 510;
        const bf16_t* ap = src + (size_t)neff * 1024 + kq * 8;
        const bf16_t* bp0 = W1t + (size_t)kv * 256 * 2048 + (size_t)(32 * wave + arow) * 2048 + kq * 8; const bf16_t* bp1 = bp0 + 16 * 2048;
        f32x4 c0 = {0.f, 0.f, 0.f, 0.f}, c1 = {0.f, 0.f, 0.f, 0.f};
        float bb0 = 0.f, bb1 = 0.f;
        { const int col0 = 32 * wave + arow; float t0[32], t1[32];
#pragma unroll
          for (int c = 0; c < 32; ++c) { t0[c] = cb1[c * 512 + kv * 256 + col0]; t1[c] = cb1[c * 512 + kv * 256 + col0 + 16]; }
          __builtin_amdgcn_sched_barrier(0);
#pragma unroll
          for (int c = 0; c < 32; ++c) { bb0 += t0[c]; bb1 += t1[c]; } }
#pragma unroll 1
        for (int ks0 = 0; ks0 < 64; ks0 += 8) { bf16x8 av[8], b0[8], b1[8];
#pragma unroll
            for (int q = 0; q < 8; ++q) { av[q] = *(const bf16x8*)(ap + (ks0 + q) * 32); b0[q] = *(const bf16x8*)(bp0 + (ks0 + q) * 32); b1[q] = *(const bf16x8*)(bp1 + (ks0 + q) * 32); }
            __builtin_amdgcn_sched_barrier(0);
#pragma unroll
            for (int q = 0; q < 8; ++q) { c0 = __builtin_amdgcn_mfma_f32_16x16x32_bf16(av[q], b0[q], c0, 0, 0, 0); c1 = __builtin_amdgcn_mfma_f32_16x16x32_bf16(av[q], b1[q], c1, 0, 0, 0); } }
        { const int col0 = 32 * wave + arow;
#pragma unroll
          for (int j = 0; j < 4; ++j) { const int row = kq * 4 + j; hid[row * 264 + col0] = (bf16_t)(cvtpk(gelu_tanh(c0[j] + bb0), 0.f) & 0xffffu); hid[row * 264 + col0 + 16] = (bf16_t)(cvtpk(gelu_tanh(c1[j] + bb1), 0.f) & 0xffffu); } }
        LBAR();
        if (wave < 4) {
            const bf16_t* bp = W2t + (size_t)kv * 64 * 256 + (size_t)(16 * wave + arow) * 256 + kq * 8; f32x4 c = {0.f, 0.f, 0.f, 0.f};
            bf16x8 bv[8];
#pragma unroll
            for (int ks = 0; ks < 8; ++ks) bv[ks] = *(const bf16x8*)(bp + ks * 32);
            __builtin_amdgcn_sched_barrier(0);
#pragma unroll
            for (int ks = 0; ks < 8; ++ks) { const bf16x8 av = *(const LAS bf16x8*)(hid + arow * 264 + kq * 8 + ks * 32); c = __builtin_amdgcn_mfma_f32_16x16x32_bf16(av, bv[ks], c, 0, 0, 0); }
            const int col = 16 * wave + arow; const float bb = cb2[kv * 64 + col];
#pragma unroll
            for (int j = 0; j < 4; ++j) { const int n = 16 * nt + kq * 4 + j; KC[((size_t)(kv * 4 + bgi) * 512 + n) * 64 + col] = n < 511 ? (bf16_t)(cvtpk(c[j] + bb, 0.f) & 0xffffu) : (bf16_t)0; }
        }
        LBAR();
    }
    const int gt = blockIdx.x * 512 + tid, NGT = G * 512;
    { const bf16_t* MoK = (const bf16_t*)(ws + WS_MO) + att::MO_STRIDE; bf16_t* KM = (bf16_t*)(ws + WS_KM); LAS float* part = (LAS float*)(lds + 16384);
      for (int blk = blockIdx.x; blk < 256; blk += G) { const bf16_t* p = MoK + ((size_t)blk * 256 + 32 * wave) * 64 + lane; float s = 0.f;
#pragma unroll
          for (int r0 = 0; r0 < 32; r0 += 16) { unsigned short tv[16];
#pragma unroll
              for (int r = 0; r < 16; ++r) tv[r] = p[(size_t)(r0 + r) * 64];
              __builtin_amdgcn_sched_barrier(0);
#pragma unroll
              for (int r = 0; r < 16; ++r) s += __uint_as_float((unsigned)tv[r] << 16); }
          part[wave * 64 + lane] = s;
          LBAR();
          if (wave == 0) { float t = 0.f;
#pragma unroll
              for (int w = 0; w < 8; ++w) t += part[w * 64 + lane];
              KM[(size_t)blk * 64 + lane] = (bf16_t)(cvtpk(t * (1.0f / 256.0f), 0.f) & 0xffffu); }
          LBAR(); } }
    { const bf16_t* U = (const bf16_t*)(ws + WS_U); bf16_t* Abr = (bf16_t*)(ws + WS_XB);
      for (int e = gt; e < MTOK * 32; e += NGT) { const int row = e >> 5, c8 = e & 31, s = row & (SEQ - 1), w = 2 << (c8 >> 3), cnt = (s + 1 < w) ? s + 1 : w;
          float acc[8] = {0.f, 0.f, 0.f, 0.f, 0.f, 0.f, 0.f, 0.f}; u32x4 v0 = {0u, 0u, 0u, 0u};
#pragma unroll
          for (int i0 = 0; i0 < 16; i0 += 8) { if (i0 >= cnt) break; u32x4 v[8];
#pragma unroll
              for (int i = 0; i < 8; ++i) v[i] = (i0 + i < cnt) ? *(const u32x4*)(U + (size_t)(row - i0 - i) * 256 + c8 * 8) : (u32x4){0u, 0u, 0u, 0u};
              __builtin_amdgcn_sched_barrier(0);
              if (i0 == 0) v0 = v[0];
#pragma unroll
              for (int i = 0; i < 8; ++i)
#pragma unroll
                  for (int q = 0; q < 4; ++q) { acc[2 * q] += bflo(v[i][q]); acc[2 * q + 1] += bfhi(v[i][q]); } }
          const float ic = 1.0f / (float)cnt; u32x4 o;
#pragma unroll
          for (int q = 0; q < 4; ++q) o[q] = cvtpk(acc[2 * q] * ic - bflo(v0[q]), acc[2 * q + 1] * ic - bfhi(v0[q]));
          *(u32x4*)(Abr + (size_t)row * DM + c8 * 8) = o; } }
}
__global__ void __launch_bounds__(512, 2) fwd_megakernel(Args a) {
    extern __shared__ __attribute__((aligned(16))) unsigned char lds_raw[];
    LAS unsigned char* lds = (LAS unsigned char*)lds_raw;
    cg::grid_group grid = cg::this_grid();
    const int G = gridDim.x;
    volatile LAS unsigned* bst = (volatile LAS unsigned*)(lds + LDS_BYTES - 64);
    if (threadIdx.x < 16) bst[threadIdx.x] = 0u;
    __syncthreads();
    const ArgsP ap0 = (ArgsP)__builtin_amdgcn_kernarg_segment_ptr();
#define PHASE_ARGS ArgsP a_ = ap0; asm volatile("" : "+s"(a_)); unsigned char* ws = a_->ws; unsigned* ctl = (unsigned*)(ws + WS_CTL); float* ssp = (float*)(ws + WS_SSP); const float* tab = (const float*)(ws + WS_TAB); \
    bf16_t* XB = (bf16_t*)(ws + WS_XB); bf16_t* BIG = (bf16_t*)(ws + WS_BIG); bf16_t* MRG = (bf16_t*)(ws + WS_MRG); (void)ctl; (void)ssp; (void)tab; (void)XB; (void)BIG; (void)MRG;
    XcdBarrier xbar = xcd_barrier_post((unsigned*)(ap0->ws + WS_BAR), bst);
    bool first_sync = true;
#define GRID_SYNC() do { if (first_sync) { grid.sync(); first_sync = false; } else xcd_barrier(xbar); } while (0)
    for (int l = 0; l < DEPTH; ++l) {
        int tid_ = threadIdx.x; asm volatile("" : "+v"(tid_));
        const int tid = tid_, lane = tid & 63, wave = __builtin_amdgcn_readfirstlane(tid >> 6), gw = blockIdx.x * 8 + wave, NGW = G * 8;
        { PHASE_ARGS phase0(a_, l, lds, tid, lane, wave, gw, NGW); }
        GRID_SYNC();
        { PHASE_ARGS pg8::Gemm g{XB, (const bf16_t*)(ws + WS_W + OFF_WIN), MTOK, NIN, DM}; pg8::StaticOrder S; S.init(MTOK, NIN, G, (int)blockIdx.x);
          EpiInProj E{ssp, (const float*)(ws + WS_W + OFF_BIN), tab, (bf16_t*)(ws + WS_U), (bf16_t*)(ws + WS_QN), (bf16_t*)(ws + WS_KV), (bf16_t*)(ws + WS_MO), BIG, (bf16_t*)(ws + WS_GN)};
          pg8::gemm_phase(lds, g, S, E); }
        GRID_SYNC();
        { PHASE_ARGS phase2(a_, lds, tid, lane, wave, G); }
        GRID_SYNC();
        { PHASE_ARGS
          att::Bufs B{(const bf16_t*)(ws + WS_QN), (const bf16_t*)(ws + WS_KV), (const bf16_t*)(ws + WS_MO), (const bf16_t*)(ws + WS_KC), (const bf16_t*)(ws + WS_KM), (const bf16_t*)(ws + WS_GN), XB};
          const int* order = (const int*)(ws + WS_ORDER); LAS int* slot = (LAS int*)(lds + att::L_END);
          if (wave >= 4) __builtin_amdgcn_s_setprio(1);
          for (;;) {
              LBAR();
              if (tid == 0) slot[0] = (int)atomicAdd(ctl + l, 1u);
              LBAR();
              const int item = slot[0];
              if (item >= 768) break;
              const int id = order[item];
              int tl = threadIdx.x; asm volatile("" : "+v"(tl));
              const int tid = tl, lane = tid & 63, wave = __builtin_amdgcn_readfirstlane(tid >> 6);
              att::Ctx C; C.lds = (LAS char*)lds; C.wsf = (LAS float*)(lds + att::L_WSF) + wave * 64; C.otl = (LAS float*)(lds + att::L_OT) + wave * 2048 + lane; C.tid = tid; C.wid = wave; C.lane = lane; C.r32 = lane & 31; C.hi = lane >> 5;
              C.vbl = ((lane >> 4) & 1) * 32 + (lane & 3) * 8 + (4 * (lane >> 5) + ((lane & 15) >> 2)) * 64;
              if (id < 512) att::nsa_item(C, B, id >> 8, (id >> 7) & 1, id & 127);
              else { const int x = id - 512; att::moba_item(C, B, x >> 7, (x >> 5) & 3, x & 31); }
          }
          __builtin_amdgcn_s_setprio(0); }
        GRID_SYNC();
        { PHASE_ARGS pg8::Gemm g{XB, (const bf16_t*)(ws + WS_W + OFF_WBR), MTOK, DM, DM}; pg8::StaticOrder S; S.init(MTOK, DM, G, (int)blockIdx.x);
          EpiBranch E{BIG, MRG}; pg8::gemm_phase(lds, g, S, E); }
        GRID_SYNC();
        { PHASE_ARGS pg8::Gemm g{MRG, (const bf16_t*)(ws + WS_W + OFF_WOUT), MTOK, DM, DM}; pg8::StaticOrder S; S.init(MTOK, DM, G, (int)blockIdx.x);
          bf16_t* RES = (bf16_t*)a_->out; EpiResid E{l == 0 ? a_->in[0] : nullptr, RES, XB, nullptr, ssp};   pg8::gemm_phase(lds, g, S, E); }
        GRID_SYNC();
        { PHASE_ARGS pg8::Gemm g{XB, (const bf16_t*)(ws + WS_W + OFF_WGU), MTOK, NGU, DM}; pg8::StaticOrder S; S.init(MTOK, NGU, G, (int)blockIdx.x);
          EpiSwiGLU E{ssp, BIG}; pg8::gemm_phase(lds, g, S, E); }
        GRID_SYNC();
        { PHASE_ARGS pg8::Gemm g{BIG, (const bf16_t*)(ws + WS_W + OFF_WD), MTOK, DM, DFF}; pg8::StaticOrder S; S.init(MTOK, DM, G, (int)blockIdx.x);
          bf16_t* RES = (bf16_t*)a_->out; EpiResid E{nullptr, XB, XB, l + 1 < DEPTH ? RES : nullptr, ssp};   pg8::gemm_phase(lds, g, S, E); }
        GRID_SYNC();
    }
    { PHASE_ARGS const float* fn = a_->in[19]; float* outp = a_->out; const int lane = threadIdx.x & 63, gw = blockIdx.x * 8 + (threadIdx.x >> 6), NGW = G * 8;
      const f32x4* gr = (const f32x4*)fn + lane; f32x4 gv[4];
#pragma unroll
      for (int j = 0; j < 4; ++j) gv[j] = gr[64 * j];
      for (int m0 = 2 * gw; m0 < MTOK; m0 += 2 * NGW) { u32x2 w[2][4]; float rstd[2];
#pragma unroll
          for (int q = 0; q < 2; ++q) { const u32x2* xr = (const u32x2*)(XB + (size_t)(m0 + q) * DM) + lane; rstd[q] = row_rstd(ssp, m0 + q);
#pragma unroll
              for (int j = 0; j < 4; ++j) w[q][j] = xr[64 * j]; }
#pragma unroll
          for (int q = 0; q < 2; ++q) { f32x4* orow = (f32x4*)(outp + (size_t)(m0 + q) * DM) + lane;
#pragma unroll
              for (int j = 0; j < 4; ++j) { const f32x4 v = {bflo(w[q][j][0]), bfhi(w[q][j][0]), bflo(w[q][j][1]), bfhi(w[q][j][1])}; orow[64 * j] = v * rstd[q] * gv[j]; } } } }
}

extern "C" void kernel_launch(void* const* d_in, const int* in_sizes, int n_in, void* d_out, int out_size, void* d_ws, size_t ws_size, hipStream_t stream) {
    static int grid = 0;
    if (grid == 0) {
        if (n_in != 20 || in_sizes[0] != MTOK * DM || out_size != MTOK * DM || ws_size < WS_END) { fprintf(stderr, "kernel_launch: unexpected shapes / workspace (n_in %d, ws %zu)\n", n_in, ws_size); grid = -1; return; }
        int dev = 0, cus = 0, per_cu = 0;
        if (hipGetDevice(&dev) != hipSuccess || hipDeviceGetAttribute(&cus, hipDeviceAttributeMultiprocessorCount, dev) != hipSuccess) { grid = -1; return; }
        if (hipFuncSetAttribute((const void*)fwd_megakernel, hipFuncAttributeMaxDynamicSharedMemorySize, LDS_BYTES) != hipSuccess) { fprintf(stderr, "kernel_launch: hipFuncSetAttribute failed\n"); grid = -1; return; }
        if (hipOccupancyMaxActiveBlocksPerMultiprocessor(&per_cu, (const void*)fwd_megakernel, 512, LDS_BYTES) != hipSuccess || per_cu < 1) { fprintf(stderr, "kernel_launch: occupancy query failed (%d)\n", per_cu); (void)hipGetLastError(); grid = -1; return; }
        grid = cus * per_cu;
    }
    if (grid < 0) return;
    if (hipMemsetAsync((char*)d_ws + WS_CTL, 0, 32768, stream) != hipSuccess) { fprintf(stderr, "kernel_launch: memset failed\n"); return; }
    Args a{};
    for (int i = 0; i < 20; ++i) a.in[i] = (const float*)d_in[i];
    a.out = (float*)d_out; a.ws = (unsigned char*)d_ws;
    void* args[] = {&a};
    const hipError_t e = hipLaunchCooperativeKernel((const void*)fwd_megakernel, dim3(grid), dim3(512), args, LDS_BYTES, stream);
    if (e != hipSuccess) fprintf(stderr, "kernel_launch: cooperative launch failed: %s (grid %d)\n", hipGetErrorString(e), grid);
}
```

```cpp
#include <hip/hip_runtime.h>
#include <hip/hip_cooperative_groups.h>
#include <cstdio>
#include <cstdint>
#include <cmath>
namespace cg = cooperative_groups;

#define LAS __attribute__((address_space(3)))
typedef unsigned short bf16_t;
typedef short bf16x8 __attribute__((ext_vector_type(8)));
typedef short s16x4 __attribute__((ext_vector_type(4)));
typedef float f32x2 __attribute__((ext_vector_type(2)));
typedef float f32x4 __attribute__((ext_vector_type(4)));
typedef float f32x16 __attribute__((ext_vector_type(16)));
typedef unsigned u32x4 __attribute__((ext_vector_type(4)));
typedef unsigned u32x2 __attribute__((ext_vector_type(2)));
typedef __bf16 bf16x2_t __attribute__((ext_vector_type(2)));

constexpr int SEQ = 8192, BATCH = 2, MTOK = BATCH * SEQ, DM = 1024, DEPTH = 2;
constexpr int IN_COLS = 5400, NIN = 5632, DFF = 2816, NGU = 5632;
constexpr float RMS_EPS = 1e-6f;
constexpr float QSCALE = 0.125f * 1.4426950408889634f;

__device__ __forceinline__ unsigned cvtpk(float lo, float hi) { f32x2 v = {lo, hi}; bf16x2_t b = __builtin_convertvector(v, bf16x2_t); return __builtin_bit_cast(unsigned, b); }
__device__ __forceinline__ float bflo(unsigned w) { return __uint_as_float(w << 16); }
__device__ __forceinline__ float bfhi(unsigned w) { return __uint_as_float(w & 0xffff0000u); }
__device__ __forceinline__ float sigmoidf_(float x) { return __builtin_amdgcn_rcpf(1.f + __expf(-x)); }

namespace pg8 {
constexpr int BM = 256, BK = 64, HALF = 128, HTB = HALF * BK * 2, STAGE_BYTES = 8 * HTB, NXCD = 8, WGM = 8;
__host__ __device__ __forceinline__ int lds_byte(int r, int c) { const int st = (r >> 4) * 2 + (c >> 5), rr = r & 15, cc = c & 31, ob = rr * 64 + cc * 2; return st * 1024 + (ob ^ (((ob >> 9) & 1) << 5)); }
__host__ __device__ __forceinline__ void stage_rc(int b, int& R, int& C) { const int st = b / 1024, sb = b % 1024, swz = sb ^ (((sb >> 9) & 1) << 5); R = (st >> 1) * 16 + swz / 64; C = (st & 1) * 32 + (swz % 64) / 2; }
__host__ __device__ __forceinline__ int perm32(int rho) { const int n = rho >> 4, i = rho & 15; return 8 * (i >> 2) + 4 * n + (i & 3); }
struct Unit { int pm, pn; };
struct Gemm { const bf16_t* A; const bf16_t* Bt; int M, N, K; };
struct StaticOrder {
    int nM, nN, nwg, G, c;
    __host__ __device__ void init(int M, int N, int G_, int c_) { nM = M / BM; nN = N / BM; nwg = nM * nN; G = G_; c = c_; }
    __host__ __device__ bool next(int i, Unit& u) const {
        const long L = (long)i * G + c; if (L >= nwg) return false;
        int wgid = (int)L; { const int q = nwg / NXCD, r = nwg % NXCD, xcd = wgid % NXCD, off = wgid / NXCD; wgid = (xcd < r ? xcd * (q + 1) : r * (q + 1) + (xcd - r) * q) + off; }
        const int nig = WGM * nN, gid = wgid / nig, fm = gid * WGM, gsz = (nM - fm) < WGM ? (nM - fm) : WGM;
        u.pm = fm + ((wgid % nig) % gsz); u.pn = (wgid % nig) / gsz; return true;
    }
};
template <class Epi, class Sched>
__device__ __forceinline__ void gemm_phase(LAS unsigned char* lds, const Gemm g, const Sched& S, const Epi& E) {
    int tid_ = threadIdx.x; asm volatile("" : "+v"(tid_));
    const int tid = tid_, wid = __builtin_amdgcn_readfirstlane(tid >> 6), lane = tid & 63, wr = wid >> 2, wc = wid & 3, fr = lane & 15, fq = lane >> 4;
    const int K = g.K, nt = K / BK;
    unsigned voffA[2], voffB[2];
#pragma unroll
    for (int i = 0; i < 2; ++i) { int R, C; stage_rc(tid * 16 + i * 8192, R, C); const int Rb = ((R & ~31) + perm32(R & 31));
        voffA[i] = (unsigned)(R * K + C) * 2u; voffB[i] = (unsigned)(Rb * K + C) * 2u; }
    const size_t kstep = (size_t)(BK * 2);
    const size_t hstep = (size_t)HALF * K * 2;
    const size_t tstep = 2 * hstep;
    const unsigned ldsw = (unsigned)wid * 1024u;
    const int aoff = lds_byte(wr * 64 + fr, fq * 8), boff = lds_byte(wc * 32 + fr, fq * 8);
#define PG8_SA(b, h) (((b) * 2 + (h)) * HTB)
#define PG8_SB(b, h) ((4 + (b) * 2 + (h)) * HTB)
#define PG8_STAGE(bufoff, gbase, voff) do { _Pragma("unroll") for (int _i = 0; _i < 2; ++_i) \
        __builtin_amdgcn_global_load_lds((const unsigned*)((const char*)(gbase) + (voff)[_i]), (LAS unsigned*)(lds + (bufoff) + ldsw + _i * 8192), 16, 0, 0); } while (0)
#define PG8_LDA(dst, b, h) do { _Pragma("unroll") for (int m = 0; m < 4; ++m) _Pragma("unroll") for (int k = 0; k < 2; ++k) dst[m][k] = *(const LAS bf16x8*)(lds + PG8_SA(b, h) + aoff + m * 2048 + k * 1024); } while (0)
#define PG8_LDB(dst, b, h) do { _Pragma("unroll") for (int n = 0; n < 2; ++n) _Pragma("unroll") for (int k = 0; k < 2; ++k) dst[n][k] = *(const LAS bf16x8*)(lds + PG8_SB(b, h) + boff + n * 2048 + k * 1024); } while (0)
#define PG8_MMA(ai, bj, At, Bt) do { __builtin_amdgcn_s_setprio(1); _Pragma("unroll") for (int m = 0; m < 4; ++m) _Pragma("unroll") for (int n = 0; n < 2; ++n) _Pragma("unroll") for (int k = 0; k < 2; ++k) \
        acc[ai][bj][m][n] = __builtin_amdgcn_mfma_f32_16x16x32_bf16(Bt[n][k], At[m][k], acc[ai][bj][m][n], 0, 0, 0); __builtin_amdgcn_s_setprio(0); } while (0)
#define PG8_WAIT_V(n) asm volatile("s_waitcnt vmcnt(" #n ")" ::: "memory")
#define PG8_WAIT_L(n) asm volatile("s_waitcnt lgkmcnt(" #n ")" ::: "memory")
#define PG8_BAR __builtin_amdgcn_s_barrier()
#define PG8_SCHED __builtin_amdgcn_sched_barrier(0)
    Unit cur, nxt; int ui = 0;
    if (!S.next(0, cur)) return;
    f32x4 acc[2][2][4][2];
#pragma unroll
    for (int a = 0; a < 2; ++a)
#pragma unroll
        for (int b = 0; b < 2; ++b)
#pragma unroll
            for (int m = 0; m < 4; ++m)
#pragma unroll
                for (int n = 0; n < 2; ++n) acc[a][b][m][n] = (f32x4){0.f, 0.f, 0.f, 0.f};
    bf16x8 At[4][2], B0[2][2], B1[2][2];
    const char* cA = (const char*)g.A + (size_t)cur.pm * tstep; const char* cB = (const char*)g.Bt + (size_t)cur.pn * tstep;
    PG8_STAGE(PG8_SB(0, 0), cB, voffB); PG8_STAGE(PG8_SB(0, 1), cB + hstep, voffB); PG8_STAGE(PG8_SA(0, 0), cA, voffA); PG8_STAGE(PG8_SA(0, 1), cA + hstep, voffA);
    if (wr == 1) PG8_BAR;
    PG8_WAIT_V(2); PG8_BAR;
    PG8_STAGE(PG8_SB(1, 0), cB + kstep, voffB); PG8_STAGE(PG8_SA(1, 0), cA + kstep, voffA); PG8_STAGE(PG8_SB(1, 1), cB + hstep + kstep, voffB);
    PG8_WAIT_V(6); PG8_BAR;
    for (;;) {
        const bool has_next = S.next(ui + 1, nxt);
        const char* nA = has_next ? (const char*)g.A + (size_t)nxt.pm * tstep : cA; const char* nB = has_next ? (const char*)g.Bt + (size_t)nxt.pn * tstep : cB;
        for (int t = 0; t < nt; t += 2) {
            const bool last = (t == nt - 2);
            const char* a1 = cA + (size_t)(t + 1) * kstep;
            const char* a2 = last ? nA : cA + (size_t)(t + 2) * kstep; const char* b2 = last ? nB : cB + (size_t)(t + 2) * kstep;
            const char* a3 = a2 + kstep; const char* b3 = b2 + kstep;
            if constexpr (Epi::KHOOK) { if (t == 4 || t == 12) { PG8_SCHED; E.khook(acc, cur, t, wr, wc, fr, fq); PG8_SCHED; } }
            PG8_LDB(B0, 0, 0); PG8_LDB(B1, 0, 1); PG8_SCHED; PG8_LDA(At, 0, 0); PG8_STAGE(PG8_SA(1, 1), a1 + hstep, voffA);
            PG8_WAIT_V(8); PG8_WAIT_L(0); PG8_BAR; PG8_MMA(0, 0, At, B0); PG8_MMA(0, 1, At, B1); PG8_BAR; PG8_SCHED;
            PG8_LDA(At, 0, 1); PG8_STAGE(PG8_SB(0, 0), b2, voffB); PG8_STAGE(PG8_SB(0, 1), b2 + hstep, voffB); PG8_STAGE(PG8_SA(0, 0), a2, voffA);
            PG8_WAIT_V(8); PG8_WAIT_L(0); PG8_BAR; PG8_MMA(1, 0, At, B0); PG8_MMA(1, 1, At, B1); PG8_BAR; PG8_SCHED;
            PG8_LDB(B0, 1, 0); PG8_LDB(B1, 1, 1); PG8_SCHED; PG8_LDA(At, 1, 0); PG8_STAGE(PG8_SA(0, 1), a2 + hstep, voffA);
            PG8_WAIT_V(8); PG8_WAIT_L(0); PG8_BAR; PG8_MMA(0, 0, At, B0); PG8_MMA(0, 1, At, B1); PG8_BAR; PG8_SCHED;
            PG8_LDA(At, 1, 1); PG8_STAGE(PG8_SB(1, 0), b3, voffB); PG8_STAGE(PG8_SB(1, 1), b3 + hstep, voffB); PG8_STAGE(PG8_SA(1, 0), a3, voffA);
            PG8_WAIT_V(8); PG8_WAIT_L(0); PG8_BAR; PG8_MMA(1, 0, At, B0); PG8_MMA(1, 1, At, B1); PG8_BAR; PG8_SCHED;
        }
        if (wr == 0) PG8_BAR;
        E(acc, cur, wr, wc, fr, fq);
        if (!has_next) break;
#pragma unroll
        for (int a = 0; a < 2; ++a)
#pragma unroll
            for (int b = 0; b < 2; ++b)
#pragma unroll
                for (int m = 0; m < 4; ++m)
#pragma unroll
                    for (int n = 0; n < 2; ++n) acc[a][b][m][n] = (f32x4){0.f, 0.f, 0.f, 0.f};
        cur = nxt; cA = nA; cB = nB; ++ui;
        if (wr == 1) PG8_BAR;
    }
    PG8_WAIT_V(0);
    PG8_BAR;
#undef PG8_SA
#undef PG8_SB
#undef PG8_STAGE
#undef PG8_LDA
#undef PG8_LDB
#undef PG8_MMA
#undef PG8_WAIT_V
#undef PG8_WAIT_L
#undef PG8_BAR
#undef PG8_SCHED
}
}
using pg8::Unit;
__device__ __forceinline__ float sum_fq(float v) {
    auto a = __builtin_amdgcn_permlane16_swap(__float_as_uint(v), __float_as_uint(v), false, false); v = __uint_as_float(a[0]) + __uint_as_float(a[1]);
    auto b = __builtin_amdgcn_permlane32_swap(__float_as_uint(v), __float_as_uint(v), false, false); return __uint_as_float(b[0]) + __uint_as_float(b[1]);
}
__device__ __forceinline__ float row_rstd(const float* ssp, int row) {
    const f32x4* p = (const f32x4*)(ssp + (size_t)row * 16);
    const f32x4 a = p[0], b = p[1], c = p[2], d = p[3];
    const float ss = ((a[0] + a[1]) + (a[2] + a[3])) + ((b[0] + b[1]) + (b[2] + b[3])) + ((c[0] + c[1]) + (c[2] + c[3])) + ((d[0] + d[1]) + (d[2] + d[3]));
    return 1.0f / sqrtf(ss * (1.0f / DM) + RMS_EPS);
}
__device__ __forceinline__ float row_rstd4(const float* ssp, int row, int fq) {
    const f32x4 a = *((const f32x4*)(ssp + (size_t)row * 16) + fq);
    float ss = (a[0] + a[1]) + (a[2] + a[3]);
    ss = sum_fq(ss);
    return 1.0f / sqrtf(ss * (1.0f / DM) + RMS_EPS);
}
__device__ __forceinline__ u32x4 pack8(const f32x4 a, const f32x4 b) { u32x4 w; w.x = cvtpk(a[0], a[1]); w.y = cvtpk(a[2], a[3]); w.z = cvtpk(b[0], b[1]); w.w = cvtpk(b[2], b[3]); return w; }
__device__ __forceinline__ void rope8(f32x4& v0, f32x4& v1, const float* tab, int t, int pos, float sc) {
    const f32x4* cs = (const f32x4*)(tab + ((size_t)t * 32 + (pos >> 1)) * 2);
    const f32x4 c0 = cs[0], c1 = cs[1];
    f32x4 o0, o1;
    o0[0] = (v0[0] * c0[0] - v0[1] * c0[1]) * sc; o0[1] = (v0[1] * c0[0] + v0[0] * c0[1]) * sc;
    o0[2] = (v0[2] * c0[2] - v0[3] * c0[3]) * sc; o0[3] = (v0[3] * c0[2] + v0[2] * c0[3]) * sc;
    o1[0] = (v1[0] * c1[0] - v1[1] * c1[1]) * sc; o1[1] = (v1[1] * c1[0] + v1[0] * c1[1]) * sc;
    o1[2] = (v1[2] * c1[2] - v1[3] * c1[3]) * sc; o1[3] = (v1[3] * c1[2] + v1[2] * c1[3]) * sc;
    v0 = o0; v1 = o1;
}
struct EpiInProj {
    static constexpr bool KHOOK = false;
    const float* ssp; const float* bias; const float* tab;
    bf16_t *U, *Qn, *KV, *Mo, *G, *Gn;
    __device__ __forceinline__ void operator()(const f32x4 (&acc)[2][2][4][2], const Unit& u, int wr, int wc, int fr, int fq) const {
        asm volatile("" : "+v"(fr), "+v"(fq));
        const int pn = u.pn;
        f32x4 bia[2][2];
#pragma unroll
        for (int bj = 0; bj < 2; ++bj) { const int gc = pn * 256 + bj * 128 + wc * 32 + 8 * fq; bia[bj][0] = *(const f32x4*)(bias + gc); bia[bj][1] = *(const f32x4*)(bias + gc + 4); }
        float rs[2][4];
#pragma unroll
        for (int ai = 0; ai < 2; ++ai) { f32x4 ra[4];
#pragma unroll
            for (int m = 0; m < 4; ++m) ra[m] = *((const f32x4*)(ssp + (size_t)(u.pm * 256 + ai * 128 + wr * 64 + m * 16 + fr) * 16) + fq);
            __builtin_amdgcn_sched_barrier(0);
#pragma unroll
            for (int m = 0; m < 4; ++m) { float ss = (ra[m][0] + ra[m][1]) + (ra[m][2] + ra[m][3]); ss = sum_fq(ss); rs[ai][m] = 1.0f / sqrtf(ss * (1.0f / DM) + RMS_EPS); } }
#pragma unroll
        for (int ai = 0; ai < 2; ++ai)
#pragma unroll
            for (int m = 0; m < 4; ++m) {
                const int row = u.pm * 256 + ai * 128 + wr * 64 + m * 16 + fr;
                const float rstd = rs[ai][m];
                const int t = row & (SEQ - 1), b = row >> 13;
#pragma unroll
                for (int bj = 0; bj < 2; ++bj) {
                    const int cit = bj * 128 + wc * 32 + 8 * fq;
                    f32x4 v0 = acc[ai][bj][m][0] * rstd + bia[bj][0], v1 = acc[ai][bj][m][1] * rstd + bia[bj][1];
                    bf16_t* dst;
                    if (pn == 0) { dst = U + (size_t)row * 256 + cit; }
                    else if (pn <= 2) { const int c2 = (pn - 1) * 256 + cit, head = c2 >> 6, pos = c2 & 63; rope8(v0, v1, tab, t, pos, QSCALE); dst = Qn + ((size_t)(b * 8 + head) * SEQ + t) * 64 + pos; }
                    else if (pn <= 5) { const int c2 = cit & 127, g = c2 >> 6, pos = c2 & 63, kvi = 2 * (pn - 3) + bj; if (bj == 0) rope8(v0, v1, tab, t, pos, 1.f);
                        dst = KV + (size_t)kvi * ((size_t)MTOK * 128) + ((size_t)(b * 2 + g) * SEQ + t) * 64 + pos; }
                    else if (pn <= 8) { const int h = cit >> 6, pos = cit & 63; if (pn < 8) rope8(v0, v1, tab, t, pos, pn == 6 ? QSCALE : 1.f);
                        dst = Mo + (size_t)(pn - 6) * ((size_t)MTOK * 256) + ((size_t)(b * 4 + h) * SEQ + t) * 64 + pos; }
                    else if (pn <= 20) {
#pragma unroll
                        for (int e = 0; e < 4; ++e) { v0[e] = sigmoidf_(v0[e]); v1[e] = sigmoidf_(v1[e]); }
                        dst = G + (size_t)row * 3072 + (pn - 9) * 256 + cit; }
                    else {
#pragma unroll
                        for (int e = 0; e < 4; ++e) { v0[e] = sigmoidf_(v0[e]); v1[e] = sigmoidf_(v1[e]); }
                        dst = Gn + (size_t)row * 32 + (cit & 31); if (cit >= 32) dst = nullptr; }
                    if (dst) *(u32x4*)dst = pack8(v0, v1);
                }
                asm volatile("" ::: "memory");
            }
    }
};
struct EpiBranch {
    static constexpr bool KHOOK = true;
    const bf16_t* G; bf16_t* out;
    __device__ __forceinline__ void khook(f32x4 (&acc)[2][2][4][2], const Unit& u, int t, int wr, int wc, int fr, int fq) const {
        asm volatile("" : "+v"(fr), "+v"(fq));
        const int gsel = (t == 4) ? 0 : 1024;
#pragma unroll
        for (int ai = 0; ai < 2; ++ai)
#pragma unroll
            for (int m = 0; m < 4; ++m) {
                u32x4 gx[2], gy[2];
#pragma unroll
                for (int bj = 0; bj < 2; ++bj) { const int row = u.pm * 256 + ai * 128 + wr * 64 + m * 16 + fr, col = u.pn * 256 + bj * 128 + wc * 32 + 8 * fq;
                    gx[bj] = *(const u32x4*)(G + (size_t)row * 3072 + gsel + col); gy[bj] = *(const u32x4*)(G + (size_t)row * 3072 + gsel + 1024 + col); }
                __builtin_amdgcn_sched_barrier(0);
#pragma unroll
                for (int bj = 0; bj < 2; ++bj)
#pragma unroll
                    for (int e = 0; e < 4; ++e) {
                        const float x0 = fmaxf(bflo(gx[bj][e]), 1e-20f), x1 = fmaxf(bfhi(gx[bj][e]), 1e-20f), y0 = fmaxf(bflo(gy[bj][e]), 1e-20f), y1 = fmaxf(bfhi(gy[bj][e]), 1e-20f);
                        const float r0 = x0 * __builtin_amdgcn_rcpf(y0), r1 = x1 * __builtin_amdgcn_rcpf(y1);
                        acc[ai][bj][m][e >> 1][(e & 1) * 2] *= r0; acc[ai][bj][m][e >> 1][(e & 1) * 2 + 1] *= r1; }
                asm volatile("" ::: "memory");
            }
    }
    __device__ __forceinline__ void operator()(const f32x4 (&acc)[2][2][4][2], const Unit& u, int wr, int wc, int fr, int fq) const {
        asm volatile("" : "+v"(fr), "+v"(fq));
#pragma unroll
        for (int ai = 0; ai < 2; ++ai) {
            u32x4 gz[4][2];
#pragma unroll
            for (int m = 0; m < 4; ++m)
#pragma unroll
                for (int bj = 0; bj < 2; ++bj) gz[m][bj] = *(const u32x4*)(G + (size_t)(u.pm * 256 + ai * 128 + wr * 64 + m * 16 + fr) * 3072 + 2048 + u.pn * 256 + bj * 128 + wc * 32 + 8 * fq);
            __builtin_amdgcn_sched_barrier(0);
#pragma unroll
            for (int m = 0; m < 4; ++m) {
                const int row = u.pm * 256 + ai * 128 + wr * 64 + m * 16 + fr;
#pragma unroll
                for (int bj = 0; bj < 2; ++bj) {
                    const int col = u.pn * 256 + bj * 128 + wc * 32 + 8 * fq; const u32x4 g = gz[m][bj];
                    f32x4 v0 = acc[ai][bj][m][0], v1 = acc[ai][bj][m][1];
                    v0[0] *= fmaxf(bflo(g[0]), 1e-20f); v0[1] *= fmaxf(bfhi(g[0]), 1e-20f); v0[2] *= fmaxf(bflo(g[1]), 1e-20f); v0[3] *= fmaxf(bfhi(g[1]), 1e-20f);
                    v1[0] *= fmaxf(bflo(g[2]), 1e-20f); v1[1] *= fmaxf(bfhi(g[2]), 1e-20f); v1[2] *= fmaxf(bflo(g[3]), 1e-20f); v1[3] *= fmaxf(bfhi(g[3]), 1e-20f);
                    *(u32x4*)(out + (size_t)row * DM + col) = pack8(v0, v1);
                }
            }
            asm volatile("" ::: "memory");
        }
    }
};
struct EpiResid {
    static constexpr bool KHOOK = false;
    const float* base_f; const bf16_t* base_b; bf16_t* xb; bf16_t* res; float* ssp;
    __device__ __forceinline__ void operator()(const f32x4 (&acc)[2][2][4][2], const Unit& u, int wr, int wc, int fr, int fq) const {
        asm volatile("" : "+v"(fr), "+v"(fq));
#pragma unroll
        for (int ai = 0; ai < 2; ++ai)
#pragma unroll
            for (int mp = 0; mp < 2; ++mp) {
                f32x4 b0[2][2], b1[2][2];
                if (base_f) {
#pragma unroll
                    for (int mm = 0; mm < 2; ++mm)
#pragma unroll
                        for (int bj = 0; bj < 2; ++bj) { const size_t off = (size_t)(u.pm * 256 + ai * 128 + wr * 64 + (2 * mp + mm) * 16 + fr) * DM + u.pn * 256 + bj * 128 + wc * 32 + 8 * fq;
                            b0[mm][bj] = *(const f32x4*)(base_f + off); b1[mm][bj] = *(const f32x4*)(base_f + off + 4); }
                    __builtin_amdgcn_sched_barrier(0);
                } else {
                    u32x4 w[2][2];
#pragma unroll
                    for (int mm = 0; mm < 2; ++mm)
#pragma unroll
                        for (int bj = 0; bj < 2; ++bj) w[mm][bj] = *(const u32x4*)(base_b + (size_t)(u.pm * 256 + ai * 128 + wr * 64 + (2 * mp + mm) * 16 + fr) * DM + u.pn * 256 + bj * 128 + wc * 32 + 8 * fq);
                    __builtin_amdgcn_sched_barrier(0);
#pragma unroll
                    for (int mm = 0; mm < 2; ++mm)
#pragma unroll
                        for (int bj = 0; bj < 2; ++bj) { const u32x4 x = w[mm][bj]; b0[mm][bj] = (f32x4){bflo(x[0]), bfhi(x[0]), bflo(x[1]), bfhi(x[1])}; b1[mm][bj] = (f32x4){bflo(x[2]), bfhi(x[2]), bflo(x[3]), bfhi(x[3])}; }
                }
#pragma unroll
                for (int mm = 0; mm < 2; ++mm) {
                    const int m = 2 * mp + mm, row = u.pm * 256 + ai * 128 + wr * 64 + m * 16 + fr;
                    float ss = 0.f;
#pragma unroll
                    for (int bj = 0; bj < 2; ++bj) {
                        const size_t off = (size_t)row * DM + u.pn * 256 + bj * 128 + wc * 32 + 8 * fq;
                        const f32x4 v0 = acc[ai][bj][m][0] + b0[mm][bj], v1 = acc[ai][bj][m][1] + b1[mm][bj];
                        const u32x4 pk = pack8(v0, v1);
                        *(u32x4*)(xb + off) = pk;
                        if (res) *(u32x4*)(res + off) = pk;
                        ss += (v0[0] * v0[0] + v0[1] * v0[1]) + (v0[2] * v0[2] + v0[3] * v0[3]) + (v1[0] * v1[0] + v1[1] * v1[1]) + (v1[2] * v1[2] + v1[3] * v1[3]);
                    }
                    ss = sum_fq(ss);
                    if (fq == 0) ssp[(size_t)row * 16 + u.pn * 4 + wc] = ss;
                }
                asm volatile("" ::: "memory");
            }
    }
};
struct EpiSwiGLU {
    static constexpr bool KHOOK = false;
    const float* ssp; bf16_t* H;
    __device__ __forceinline__ void operator()(const f32x4 (&acc)[2][2][4][2], const Unit& u, int wr, int wc, int fr, int fq) const {
        asm volatile("" : "+v"(fr), "+v"(fq));
        float rs[2][4];
#pragma unroll
        for (int ai = 0; ai < 2; ++ai) { f32x4 ra[4];
#pragma unroll
            for (int m = 0; m < 4; ++m) ra[m] = *((const f32x4*)(ssp + (size_t)(u.pm * 256 + ai * 128 + wr * 64 + m * 16 + fr) * 16) + fq);
            __builtin_amdgcn_sched_barrier(0);
#pragma unroll
            for (int m = 0; m < 4; ++m) { float ss = (ra[m][0] + ra[m][1]) + (ra[m][2] + ra[m][3]); ss = sum_fq(ss); rs[ai][m] = 1.0f / sqrtf(ss * (1.0f / DM) + RMS_EPS); } }
#pragma unroll
        for (int ai = 0; ai < 2; ++ai)
#pragma unroll
            for (int m = 0; m < 4; ++m) {
                const int row = u.pm * 256 + ai * 128 + wr * 64 + m * 16 + fr;
                const float rstd = rs[ai][m];
                f32x4 o[2];
#pragma unroll
                for (int n = 0; n < 2; ++n)
#pragma unroll
                    for (int e = 0; e < 4; ++e) { const float gt = acc[ai][0][m][n][e] * rstd, up = acc[ai][1][m][n][e] * rstd; o[n][e] = gt * sigmoidf_(gt) * up; }
                *(u32x4*)(H + (size_t)row * DFF + u.pn * 128 + wc * 32 + 8 * fq) = pack8(o[0], o[1]);
                asm volatile("" ::: "memory");
            }
    }
};
namespace att {
constexpr int KCS = 1040, KSLOT = 8 * KCS, VSLOT = 8192;
constexpr int L_K0 = 0, L_V0 = 4 * KSLOT, L_WSF = 4 * KSLOT + 4 * VSLOT, L_MSK = L_WSF + 8 * 256, L_UNI = L_MSK + 1024, L_LIST = L_UNI + 64, L_END = L_LIST + 512,
              L_PS = L_END + 64, L_OT = L_PS, L_TOTAL = L_OT + 8 * 8192;
static_assert(L_TOTAL <= 147456 - 64, "attention LDS map");
#define LBAR() asm volatile("s_waitcnt lgkmcnt(0)\n\ts_barrier" ::: "memory")
#define LWAIT() asm volatile("s_waitcnt lgkmcnt(0)" ::: "memory")
__device__ __forceinline__ int crow(int r, int hi) { return (r & 3) + 8 * (r >> 2) + 4 * hi; }
__device__ __forceinline__ float swap_other(float v, int hi) { auto rr = __builtin_amdgcn_permlane32_swap(__float_as_uint(v), __float_as_uint(v), false, false); return __uint_as_float(hi ? rr[0] : rr[1]); }
__device__ __forceinline__ void qkt(f32x16& p0, f32x16& p1, const LAS char* Ks, const bf16x8* qr, const f32x16& cinit, int r32, int hi) {
    const LAS char* kb = Ks + hi * KCS + r32 * 16;
    bf16x8 kf[8];
#pragma unroll
    for (int d0 = 0; d0 < 4; ++d0) { kf[2 * d0] = *(const LAS bf16x8*)(kb + d0 * 2 * KCS); kf[2 * d0 + 1] = *(const LAS bf16x8*)(kb + d0 * 2 * KCS + 512); }
    __builtin_amdgcn_sched_barrier(0);
    p0 = __builtin_amdgcn_mfma_f32_32x32x16_bf16(kf[0], qr[0], cinit, 0, 0, 0); p1 = __builtin_amdgcn_mfma_f32_32x32x16_bf16(kf[1], qr[0], cinit, 0, 0, 0);
#pragma unroll
    for (int d0 = 1; d0 < 4; ++d0) { p0 = __builtin_amdgcn_mfma_f32_32x32x16_bf16(kf[2 * d0], qr[d0], p0, 0, 0, 0); p1 = __builtin_amdgcn_mfma_f32_32x32x16_bf16(kf[2 * d0 + 1], qr[d0], p1, 0, 0, 0); }
}
struct VFrag { s16x4 lo[8], hi[8]; };
typedef short v4i16_t __attribute__((ext_vector_type(4)));
__device__ __forceinline__ s16x4 vtr(const LAS char* p) { return __builtin_bit_cast(s16x4, __builtin_amdgcn_ds_read_tr16_b64_v4i16((LAS v4i16_t*)p)); }
__device__ __forceinline__ void v_issue(VFrag& F, const LAS char* vp) {
#pragma unroll
    for (int d0 = 0; d0 < 2; ++d0)
#pragma unroll
        for (int ks = 0; ks < 4; ++ks) { F.lo[d0 * 4 + ks] = vtr(vp + d0 * 4096 + ks * 1024); F.hi[d0 * 4 + ks] = vtr(vp + d0 * 4096 + ks * 1024 + 512); }
}
template <bool SUM> __device__ __forceinline__ void pv(f32x16* o, f32x16& osum, VFrag& F, bf16x8 pa0, bf16x8 pa1, bf16x8 pa2, bf16x8 pa3) {
#define PK(k) (bf16x8){F.lo[k][0], F.lo[k][1], F.lo[k][2], F.lo[k][3], F.hi[k][0], F.hi[k][1], F.hi[k][2], F.hi[k][3]}
    const bf16x8 ones = {0x3F80, 0x3F80, 0x3F80, 0x3F80, 0x3F80, 0x3F80, 0x3F80, 0x3F80};
    __builtin_amdgcn_s_setprio(1);
    o[0] = __builtin_amdgcn_mfma_f32_32x32x16_bf16(pa0, PK(0), o[0], 0, 0, 0);
    o[1] = __builtin_amdgcn_mfma_f32_32x32x16_bf16(pa0, PK(4), o[1], 0, 0, 0);
    if (SUM) osum = __builtin_amdgcn_mfma_f32_32x32x16_bf16(pa0, ones, osum, 0, 0, 0);
    o[0] = __builtin_amdgcn_mfma_f32_32x32x16_bf16(pa1, PK(1), o[0], 0, 0, 0);
    o[1] = __builtin_amdgcn_mfma_f32_32x32x16_bf16(pa1, PK(5), o[1], 0, 0, 0);
    if (SUM) osum = __builtin_amdgcn_mfma_f32_32x32x16_bf16(pa1, ones, osum, 0, 0, 0);
    o[0] = __builtin_amdgcn_mfma_f32_32x32x16_bf16(pa2, PK(2), o[0], 0, 0, 0);
    o[1] = __builtin_amdgcn_mfma_f32_32x32x16_bf16(pa2, PK(6), o[1], 0, 0, 0);
    if (SUM) osum = __builtin_amdgcn_mfma_f32_32x32x16_bf16(pa2, ones, osum, 0, 0, 0);
    o[0] = __builtin_amdgcn_mfma_f32_32x32x16_bf16(pa3, PK(3), o[0], 0, 0, 0);
    o[1] = __builtin_amdgcn_mfma_f32_32x32x16_bf16(pa3, PK(7), o[1], 0, 0, 0);
    if (SUM) osum = __builtin_amdgcn_mfma_f32_32x32x16_bf16(pa3, ones, osum, 0, 0, 0);
    __builtin_amdgcn_s_setprio(0);
#undef PK
}
__device__ __forceinline__ float rowmax(const f32x16& p0, const f32x16& p1, int hi) {
    float a = __builtin_fmaxf(p0[0], p1[0]);
#pragma unroll
    for (int r = 1; r < 16; ++r) a = __builtin_fmaxf(__builtin_fmaxf(a, p0[r]), p1[r]);
    return __builtin_fmaxf(a, swap_other(a, hi));
}
struct KVRegs { u32x4 k, v; };
__device__ __forceinline__ void tile_load(KVRegs& R, const bf16_t* K, const bf16_t* V, int tid) { R.k = *(const u32x4*)(K + tid * 8); R.v = *(const u32x4*)(V + tid * 8); }
__device__ __forceinline__ void tile_store(const KVRegs& R, LAS char* Ks, LAS char* Vs, int tid) {
    const int row = tid >> 3, c = tid & 7;
    *(LAS u32x4*)(Ks + c * KCS + row * 16) = R.k;
    *(LAS u32x4*)(Vs + (c >> 2) * 4096 + (row >> 4) * 1024 + (row & 15) * 64 + (c & 3) * 16) = R.v;
}
__device__ __forceinline__ void ps_accum(const f32x16 p, int jb, LAS float* ps_row, bool writer) {
#pragma unroll
    for (int rg = 0; rg < 4; ++rg) {
        float a = 2.f * (p[4 * rg] + p[4 * rg + 1] + p[4 * rg + 2]) + p[4 * rg + 3], bq = p[4 * rg + 3];
        a += __builtin_bit_cast(float, __builtin_amdgcn_update_dpp(0, __builtin_bit_cast(int, a), 0xB1, 0xF, 0xF, true)); a += __builtin_bit_cast(float, __builtin_amdgcn_update_dpp(0, __builtin_bit_cast(int, a), 0x4E, 0xF, 0xF, true));
        bq += __builtin_bit_cast(float, __builtin_amdgcn_update_dpp(0, __builtin_bit_cast(int, bq), 0xB1, 0xF, 0xF, true)); bq += __builtin_bit_cast(float, __builtin_amdgcn_update_dpp(0, __builtin_bit_cast(int, bq), 0x4E, 0xF, 0xF, true));
        const int j = jb + 2 * rg;
        if (writer) { __hip_atomic_fetch_add(ps_row + j, a, __ATOMIC_RELAXED, __HIP_MEMORY_SCOPE_WORKGROUP); if (j + 1 < 128) __hip_atomic_fetch_add(ps_row + j + 1, bq, __ATOMIC_RELAXED, __HIP_MEMORY_SCOPE_WORKGROUP); }
    }
}
struct Ctx { LAS char* lds; LAS float* wsf; LAS float* otl; int tid, wid, lane, r32, hi, vbl; };
struct RowSt { float m, l; bool started; f32x16 negm, osum; };
__device__ __forceinline__ void rowst_init(RowSt& S) { S.m = 0.f; S.l = 0.f; S.started = false; S.negm = f32x16{}; S.osum = f32x16{}; asm volatile("" : "+v"(S.negm)); }
__device__ __forceinline__ void rowst_fixed(RowSt& S, float ref) { S.m = ref; S.l = 0.f; S.started = true; S.osum = f32x16{};
#pragma unroll
    for (int r = 0; r < 16; ++r) S.negm[r] = -ref;
    asm volatile("" : "+v"(S.negm)); }
template <int MODE, class Idx, class Src, class Msk>
__device__ __forceinline__ void run_branch(const Ctx& C, int nt, const Idx& idx, const Src& src, const Msk& msk, const bf16x8* qr, RowSt& S, f32x16* o, LAS float* ps_row, bool ps_writer, KVRegs& R0, bool pre, const bf16_t* nk, const bf16_t* nv) {
    KVRegs R1; const bf16_t *kp, *vp;
    int dA = idx(0), dB = nt > 1 ? idx(1) : 0, dC = 0, dD = 0;
    if (!pre) { src(0, dA, kp, vp); tile_load(R0, kp, vp, C.tid); }
    if (nt > 1) { src(1, dB, kp, vp); tile_load(R1, kp, vp, C.tid); }
    auto compute = [&](int it, const LAS char* Ks, const LAS char* Vs, int klo, int khi, bool nm) {
        const bool kill = khi < klo;
        if (!__any(!kill)) return;
        f32x16 p0, p1; qkt(p0, p1, Ks, qr, S.negm, C.r32, C.hi);
        VFrag VF; if constexpr (MODE != 0) { v_issue(VF, Vs + C.vbl); __builtin_amdgcn_sched_barrier(0); }
        if (__any(nm && !kill)) {
#pragma unroll
            for (int r = 0; r < 16; ++r) { const int kv = crow(r, C.hi); if (kv < klo || kv > khi) p0[r] = -INFINITY; if (kv + 32 < klo || kv + 32 > khi) p1[r] = -INFINITY; }
        }
        if constexpr (MODE != 2) {
            float rm = rowmax(p0, p1, C.hi); if (kill) rm = -INFINITY;
            const bool first = !S.started && rm > -INFINITY, grow = first || rm > 8.0f;
            if (__any(grow)) {
                const float d = grow ? rm : 0.f, alpha = first ? 1.0f : __builtin_amdgcn_exp2f(-d);
                S.m += d; S.started = S.started || first;
#pragma unroll
                for (int r = 0; r < 16; ++r) { S.negm[r] = -S.m; p0[r] -= d; p1[r] -= d; }
                if constexpr (MODE == 0) S.l *= alpha;
                if constexpr (MODE == 1) {
                    if (C.hi == 0) C.wsf[C.r32] = alpha;
                    LWAIT();
#pragma unroll
                    for (int r = 0; r < 16; ++r) { const float f = C.wsf[crow(r, C.hi)]; o[0][r] *= f; o[1][r] *= f; S.osum[r] *= f; }
                    LWAIT();
                }
            }
        }
#pragma unroll
        for (int r = 0; r < 16; ++r) { p0[r] = __builtin_amdgcn_exp2f(p0[r]); p1[r] = __builtin_amdgcn_exp2f(p1[r]); }
        if constexpr (MODE == 0) {
            float s = 0.f;
#pragma unroll
            for (int r = 0; r < 16; ++r) s += p0[r] + p1[r];
            S.l += kill ? 0.f : s;
        }
        if constexpr (MODE == 2) {
            if (__any(kill)) {
#pragma unroll
                for (int r = 0; r < 16; ++r) { p0[r] = kill ? 0.f : p0[r]; p1[r] = kill ? 0.f : p1[r]; }
            }
            ps_accum(p0, 16 * it + C.hi, ps_row, ps_writer); ps_accum(p1, 16 * it + 8 + C.hi, ps_row, ps_writer);
        }
        if constexpr (MODE != 0) {
            u32x4 w0 = {cvtpk(p0[0], p0[1]), cvtpk(p0[2], p0[3]), cvtpk(p0[4], p0[5]), cvtpk(p0[6], p0[7])}, w1 = {cvtpk(p0[8], p0[9]), cvtpk(p0[10], p0[11]), cvtpk(p0[12], p0[13]), cvtpk(p0[14], p0[15])};
            u32x4 w2 = {cvtpk(p1[0], p1[1]), cvtpk(p1[2], p1[3]), cvtpk(p1[4], p1[5]), cvtpk(p1[6], p1[7])}, w3 = {cvtpk(p1[8], p1[9]), cvtpk(p1[10], p1[11]), cvtpk(p1[12], p1[13]), cvtpk(p1[14], p1[15])};
            if constexpr (MODE == 1) {
                if (__any(kill)) {
#pragma unroll
                    for (int e = 0; e < 4; ++e) { w0[e] = kill ? 0u : w0[e]; w1[e] = kill ? 0u : w1[e]; w2[e] = kill ? 0u : w2[e]; w3[e] = kill ? 0u : w3[e]; }
                }
            }
            pv<MODE == 1>(o, S.osum, VF, __builtin_bit_cast(bf16x8, w0), __builtin_bit_cast(bf16x8, w1), __builtin_bit_cast(bf16x8, w2), __builtin_bit_cast(bf16x8, w3));
        }
    };
    LBAR();
    for (int it = 0; it < nt; it += 2) {
        const int p = (it >> 1) & 1; const bool two = it + 1 < nt;
        LAS char* KsA = C.lds + L_K0 + (2 * p) * KSLOT; LAS char* VsA = C.lds + L_V0 + (2 * p) * VSLOT;
        LAS char* KsB = KsA + KSLOT; LAS char* VsB = VsA + VSLOT;
        tile_store(R0, KsA, VsA, C.tid); if (two) tile_store(R1, KsB, VsB, C.tid);
        if (it + 2 < nt) dC = idx(it + 2);
        if (it + 3 < nt) dD = idx(it + 3);
        int kloA, khiA, kloB = 0, khiB = -1; const bool nmA = msk(it, dA, kloA, khiA); bool nmB = false; if (two) nmB = msk(it + 1, dB, kloB, khiB);
        if (it + 2 < nt) { src(it + 2, dC, kp, vp); tile_load(R0, kp, vp, C.tid); } else if (nk) tile_load(R0, nk, nv, C.tid);
        if (it + 3 < nt) { src(it + 3, dD, kp, vp); tile_load(R1, kp, vp, C.tid); }
        LBAR();
        compute(it, KsA, VsA, kloA, khiA, nmA);
        if (two) compute(it + 1, KsB, VsB, kloB, khiB, nmB);
        dA = dC; dB = dD;
    }
}
template <bool FIRST> __device__ __forceinline__ void merge_branch_n(const Ctx& C, const f32x16* o, const f32x16& osum, float gate) {
    if (C.hi == 0) C.wsf[C.r32] = gate;
    LWAIT();
#pragma unroll
    for (int r0 = 0; r0 < 16; r0 += 8) {
        float gf[8], t0[8], t1[8];
#pragma unroll
        for (int r = 0; r < 8; ++r) { gf[r] = C.wsf[crow(r0 + r, C.hi)]; t0[r] = FIRST ? 0.f : C.otl[(r0 + r) * 64]; t1[r] = FIRST ? 0.f : C.otl[(16 + r0 + r) * 64]; }
        __builtin_amdgcn_sched_barrier(0);
#pragma unroll
        for (int r = 0; r < 8; ++r) { const float den = osum[r0 + r], f = den > 0.f ? gf[r] * __builtin_amdgcn_rcpf(den) : 0.f;
            C.otl[(r0 + r) * 64] = t0[r] + o[0][r0 + r] * f; C.otl[(16 + r0 + r) * 64] = t1[r] + o[1][r0 + r] * f; } }
    LWAIT();
}
template <bool FIRST> __device__ __forceinline__ void merge_branch(const Ctx& C, const f32x16* o, float factor) {
    if (C.hi == 0) C.wsf[C.r32] = factor;
    LWAIT();
#pragma unroll
    for (int r0 = 0; r0 < 16; r0 += 8) {
        float gf[8], t0[8], t1[8];
#pragma unroll
        for (int r = 0; r < 8; ++r) { gf[r] = C.wsf[crow(r0 + r, C.hi)]; t0[r] = FIRST ? 0.f : C.otl[(r0 + r) * 64]; t1[r] = FIRST ? 0.f : C.otl[(16 + r0 + r) * 64]; }
        __builtin_amdgcn_sched_barrier(0);
#pragma unroll
        for (int r = 0; r < 8; ++r) { C.otl[(r0 + r) * 64] = t0[r] + o[0][r0 + r] * gf[r]; C.otl[(16 + r0 + r) * 64] = t1[r] + o[1][r0 + r] * gf[r]; } }
    LWAIT();
}
struct Bufs { const bf16_t *Qn, *KV, *Mo, *KC, *KM, *Gn; bf16_t* Abr; };
constexpr size_t KV_STRIDE = (size_t)MTOK * 128, MO_STRIDE = (size_t)MTOK * 256;

__device__ __forceinline__ void nsa_item(const Ctx& C, const Bufs& B, int b, int g, int i) {
    const int r32 = C.r32, hi = C.hi, wid = C.wid;
    const int qi = 8 * wid + (r32 >> 2), hh = r32 & 3, head = g * 4 + hh, t = 64 * i + qi, cur = i;
    const size_t bg = (size_t)(b * 2 + g) * SEQ;
    bf16x8 qr[4];
    { const bf16_t* qp = B.Qn + ((size_t)(b * 8 + head) * SEQ + t) * 64 + hi * 8;
#pragma unroll
      for (int d0 = 0; d0 < 4; ++d0) qr[d0] = *(const bf16x8*)(qp + d0 * 16); }
    const unsigned gw = *(const unsigned*)(B.Gn + ((size_t)b * SEQ + t) * 32 + head * 3 - (head & 1));
    const unsigned gw2 = *(const unsigned*)(B.Gn + ((size_t)b * SEQ + t) * 32 + head * 3 - (head & 1) + 2);
    float g0, g1, g2; if (head & 1) { g0 = bfhi(gw); g1 = bflo(gw2); g2 = bfhi(gw2); } else { g0 = bflo(gw); g1 = bfhi(gw); g2 = bflo(gw2); }
    f32x16 o[2];
    LAS float* Ps = (LAS float*)(C.lds + L_PS); LAS unsigned* Mk = (LAS unsigned*)(C.lds + L_MSK); LAS unsigned* Uni = (LAS unsigned*)(C.lds + L_UNI); LAS int* List = (LAS int*)(C.lds + L_LIST);
    const int nv = t >= 31 ? ((t - 31) >> 4) + 1 : 0;
    const int nvt = (4 * i + 3 < 511) ? 4 * i + 3 : 511, ntc = (nvt + 63) >> 6;
    const bf16_t* kc = B.KC + (size_t)(0 * 4 + b * 2 + g) * 512 * 64; const bf16_t* vc = B.KC + (size_t)(1 * 4 + b * 2 + g) * 512 * 64;
    auto idxI = [&](int it) { return it; };
    auto srcC = [&](int it, int, const bf16_t*& kp, const bf16_t*& vp) { kp = kc + (size_t)it * 4096; vp = vc + (size_t)it * 4096; };
    auto mskC = [&](int it, int, int& klo, int& khi) { klo = 0; khi = nv - 1 - 64 * it; return khi < 63; };
    RowSt S; rowst_init(S);
    KVRegs R;
    run_branch<0>(C, ntc, idxI, srcC, mskC, qr, S, o, nullptr, false, R, false, kc, vc);
    const float lt = S.l + swap_other(S.l, hi);
    rowst_fixed(S, lt > 0.f ? S.m + __builtin_amdgcn_logf(lt) : 0.f);
    for (int e = C.tid; e < 64 * 128; e += 512) Ps[e] = 0.f;
    if (C.tid < 8) Uni[C.tid] = 0u;
    o[0] = f32x16{}; o[1] = f32x16{};
    run_branch<2>(C, ntc, idxI, srcC, mskC, qr, S, o, Ps + qi * 128, hh == 0, R, true, B.KV + 2 * KV_STRIDE + bg * 64, B.KV + 3 * KV_STRIDE + bg * 64);
    LBAR();
    {
        const int nf = cur == 0 ? 1 : (cur == 1 ? 2 : 3), kp_ = 16 - nf, lane = C.lane;
#pragma unroll 1
        for (int qq = 0; qq < 8; ++qq) {
            int q = 8 * wid + qq; asm volatile("" : "+s"(q)); LAS float* ps = Ps + q * 128;
            const int j0 = lane, j1 = lane + 64;
            const bool f0 = (j0 == 0 || j0 == cur || j0 == cur - 1) && j0 <= cur, f1 = (j1 == cur || j1 == cur - 1) && j1 <= cur;
            const bool va0 = j0 <= cur && !f0, va1 = j1 <= cur && !f1;
            const unsigned k0 = va0 ? __float_as_uint(ps[j0]) + 1u : 0u, k1 = va1 ? __float_as_uint(ps[j1]) + 1u : 0u;
            unsigned T = 0u;
            for (int bit = 30; bit >= 0; --bit) { const unsigned cand = T | (1u << bit); const int cnt = __popcll(__ballot(k0 >= cand)) + __popcll(__ballot(k1 >= cand)); if (cnt >= kp_) T = cand; }
            const int need = kp_ - (__popcll(__ballot(k0 > T)) + __popcll(__ballot(k1 > T)));
            const unsigned long long t0 = __ballot(k0 == T), t1 = __ballot(k1 == T), below = (1ull << lane) - 1ull;
            const int pre0 = __popcll(t0 & below), pre1 = __popcll(t0) + __popcll(t1 & below);
            const bool s0 = f0 || (k0 > 0u && (k0 > T || (k0 == T && pre0 < need))), s1 = f1 || (k1 > 0u && (k1 > T || (k1 == T && pre1 < need)));
            const unsigned long long b0 = __ballot(s0), b1 = __ballot(s1);
            if (lane == 0) { Mk[q * 4 + 0] = (unsigned)b0; Mk[q * 4 + 1] = (unsigned)(b0 >> 32); Mk[q * 4 + 2] = (unsigned)b1; Mk[q * 4 + 3] = (unsigned)(b1 >> 32);
                __hip_atomic_fetch_or(&Uni[0], (unsigned)b0, __ATOMIC_RELAXED, __HIP_MEMORY_SCOPE_WORKGROUP); __hip_atomic_fetch_or(&Uni[1], (unsigned)(b0 >> 32), __ATOMIC_RELAXED, __HIP_MEMORY_SCOPE_WORKGROUP); __hip_atomic_fetch_or(&Uni[2], (unsigned)b1, __ATOMIC_RELAXED, __HIP_MEMORY_SCOPE_WORKGROUP); __hip_atomic_fetch_or(&Uni[3], (unsigned)(b1 >> 32), __ATOMIC_RELAXED, __HIP_MEMORY_SCOPE_WORKGROUP); }
        }
    }
    LBAR();
    if (C.tid < 128) {
        const int wi = C.tid >> 5, bi = C.tid & 31; const unsigned u0 = Uni[0], u1 = Uni[1], u2 = Uni[2], u3 = Uni[3];
        const unsigned mine = wi == 0 ? u0 : wi == 1 ? u1 : wi == 2 ? u2 : u3;
        const int before = (wi > 0 ? __popc(u0) : 0) + (wi > 1 ? __popc(u1) : 0) + (wi > 2 ? __popc(u2) : 0) + __popc(mine & ((1u << bi) - 1u));
        if ((mine >> bi) & 1u) List[before] = C.tid;
        if (C.tid == 0) Uni[4] = (unsigned)(__popc(u0) + __popc(u1) + __popc(u2) + __popc(u3));
    }
    LBAR();
    merge_branch<true>(C, o, g0);
    {
        const int nsel = (int)Uni[4];
        const bf16_t* ks = B.KV + 2 * KV_STRIDE + bg * 64; const bf16_t* vs = B.KV + 3 * KV_STRIDE + bg * 64;
        auto idxS = [&](int it) { return List[it]; };
        auto srcS = [&](int, int j, const bf16_t*& kp, const bf16_t*& vp) { kp = ks + (size_t)j * 4096; vp = vs + (size_t)j * 4096; };
        auto mskS = [&](int, int j, int& klo, int& khi) { const unsigned w = Mk[qi * 4 + (j >> 5)]; const bool bit = (w >> (j & 31)) & 1u;
            klo = 0; khi = bit ? (j == cur ? qi : 63) : -1; return j == cur; };
        rowst_init(S); o[0] = f32x16{}; o[1] = f32x16{};
        const int tw0n = i >= 8 ? i - 8 : 0;
        run_branch<1>(C, nsel, idxS, srcS, mskS, qr, S, o, nullptr, false, R, true, B.KV + 4 * KV_STRIDE + bg * 64 + (size_t)tw0n * 4096, B.KV + 5 * KV_STRIDE + bg * 64 + (size_t)tw0n * 4096);
        merge_branch_n<false>(C, o, S.osum, g1);
    }
    {
        const int tw0 = i >= 8 ? i - 8 : 0, ntw = i - tw0 + 1;
        const bf16_t* kw = B.KV + 4 * KV_STRIDE + bg * 64; const bf16_t* vw = B.KV + 5 * KV_STRIDE + bg * 64;
        auto srcW = [&](int it, int, const bf16_t*& kp, const bf16_t*& vp) { kp = kw + (size_t)(tw0 + it) * 4096; vp = vw + (size_t)(tw0 + it) * 4096; };
        auto mskW = [&](int it, int, int& klo, int& khi) { const int tw = tw0 + it; klo = (t - 511) - 64 * tw; khi = (tw == i) ? qi : 63; return tw == i || klo > 0; };
        rowst_init(S); o[0] = f32x16{}; o[1] = f32x16{};
        run_branch<1>(C, ntw, idxI, srcW, mskW, qr, S, o, nullptr, false, R, true, nullptr, nullptr);
        merge_branch_n<false>(C, o, S.osum, g2);
    }
#pragma unroll
    for (int r0 = 0; r0 < 16; r0 += 8) { float t0[8], t1[8];
#pragma unroll
        for (int r = 0; r < 8; ++r) { t0[r] = C.otl[(r0 + r) * 64]; t1[r] = C.otl[(16 + r0 + r) * 64]; }
        __builtin_amdgcn_sched_barrier(0);
#pragma unroll
        for (int r = 0; r < 8; ++r) { const int qrow = crow(r0 + r, hi); bf16_t* dst = B.Abr + ((size_t)b * SEQ + 64 * i + 8 * wid + (qrow >> 2)) * DM + 256 + (g * 4 + (qrow & 3)) * 64 + r32;
            dst[0] = (bf16_t)(cvtpk(t0[r], 0.f) & 0xffffu); dst[32] = (bf16_t)(cvtpk(t1[r], 0.f) & 0xffffu); } }
}
__device__ __forceinline__ void moba_item(const Ctx& C, const Bufs& B, int b, int h, int qb) {
    const int r32 = C.r32, hi = C.hi, wid = C.wid, own = qb, t = 256 * qb + 32 * wid + r32;
    const size_t bh = (size_t)(b * 4 + h) * SEQ;
    bf16x8 qr[4];
    { const bf16_t* qp = B.Mo + (bh + t) * 64 + hi * 8;
#pragma unroll
      for (int d0 = 0; d0 < 4; ++d0) qr[d0] = *(const bf16x8*)(qp + d0 * 16); }
    LAS unsigned* Uni = (LAS unsigned*)(C.lds + L_UNI); LAS int* List = (LAS int*)(C.lds + L_LIST);
    LBAR();
    if (C.tid < 256) { const u32x4 kmv = *(const u32x4*)(B.KM + (size_t)(b * 4 + h) * 2048 + C.tid * 8); *(LAS u32x4*)(C.lds + L_K0 + (C.tid & 7) * KCS + (C.tid >> 3) * 16) = kmv; }
    if (C.tid == 0) Uni[0] = 0u;
    LBAR();
    unsigned sel = 0u;
    {
        f32x16 gs = f32x16{};
        const LAS char* kb = C.lds + L_K0 + hi * KCS + r32 * 16;
#pragma unroll
        for (int d0 = 0; d0 < 4; ++d0) gs = __builtin_amdgcn_mfma_f32_32x32x16_bf16(*(const LAS bf16x8*)(kb + d0 * 2 * KCS), qr[d0], gs, 0, 0, 0);
        float lo[16], hv[16];
#pragma unroll
        for (int r = 0; r < 16; ++r) { const float ownv = gs[r], oth = swap_other(ownv, hi); lo[r] = hi ? oth : ownv; hv[r] = hi ? ownv : oth; }
        unsigned taken = ~((1u << own) - 1u);
#pragma unroll
        for (int round = 0; round < 3; ++round) {
            float best = -INFINITY; int bi = 32;
#pragma unroll
            for (int n = 0; n < 32; ++n) { const int rr = (n & 3) + 4 * (n >> 3); const float v = ((n >> 2) & 1) ? hv[rr] : lo[rr]; if (!((taken >> n) & 1u) && v > best) { best = v; bi = n; } }
            if (bi < 32) { sel |= 1u << bi; taken |= 1u << bi; }
        }
    }
    { unsigned u = sel;
#pragma unroll
      for (int o_ = 1; o_ < 64; o_ <<= 1) u |= (unsigned)__shfl_xor((int)u, o_);
      if (C.lane == 0) __hip_atomic_fetch_or(&Uni[0], u, __ATOMIC_RELAXED, __HIP_MEMORY_SCOPE_WORKGROUP); }
    LBAR();
    if (C.tid == 0) { int n = 0; unsigned u = Uni[0]; while (u) { const int bpos = __builtin_ctz(u); u &= u - 1; List[n++] = bpos; } Uni[4] = (unsigned)n; }
    LBAR();
    const int nl = (int)Uni[4], nt = 4 * nl + 4;
    const bf16_t* kk = B.Mo + MO_STRIDE + bh * 64; const bf16_t* vv = B.Mo + 2 * MO_STRIDE + bh * 64;
    auto idxM = [&](int it) { return (it < 4 * nl) ? List[it >> 2] : own; };
    auto src = [&](int it, int blk, const bf16_t*& kp, const bf16_t*& vp) { const int T = 4 * blk + ((it < 4 * nl) ? (it & 3) : (it - 4 * nl)); kp = kk + (size_t)T * 4096; vp = vv + (size_t)T * 4096; };
    auto msk = [&](int it, int blk, int& klo, int& khi) { klo = 0; if (it < 4 * nl) { const bool bit = (sel >> blk) & 1u; khi = bit ? 63 : -1; return false; } khi = 32 * wid + r32 - 64 * (it - 4 * nl); return true; };
    RowSt S; rowst_init(S); f32x16 o[2] = {f32x16{}, f32x16{}};
    KVRegs R;
    run_branch<1>(C, nt, idxM, src, msk, qr, S, o, nullptr, false, R, false, nullptr, nullptr);
    merge_branch_n<true>(C, o, S.osum, 1.0f);
#pragma unroll
    for (int r0 = 0; r0 < 16; r0 += 8) { float t0[8], t1[8];
#pragma unroll
        for (int r = 0; r < 8; ++r) { t0[r] = C.otl[(r0 + r) * 64]; t1[r] = C.otl[(16 + r0 + r) * 64]; }
        __builtin_amdgcn_sched_barrier(0);
#pragma unroll
        for (int r = 0; r < 8; ++r) { const int qrow = crow(r0 + r, hi); bf16_t* dst = B.Abr + ((size_t)b * SEQ + 256 * qb + 32 * wid + qrow) * DM + 768 + h * 64 + r32;
            dst[0] = (bf16_t)(cvtpk(t0[r], 0.f) & 0xffffu); dst[32] = (bf16_t)(cvtpk(t1[r], 0.f) & 0xffffu); } }
}
}
#define XB_TMO      128
#define XB_XCNT(j)  (256  + 64 * (j))
#define XB_XSUB(j)  (1280 + 64 * (j))
#define XB_XGEN(j)  (2304 + 64 * (j))
#define XB_TOP      3328
#define XB_TOPGEN   3392
#define XCD_BAR_WORDS 3456
#define XB_SPIN_CAP (1u << 18)

__device__ __forceinline__ unsigned xb_ld(unsigned* p)              { return __hip_atomic_load(p, __ATOMIC_RELAXED, __HIP_MEMORY_SCOPE_AGENT); }
__device__ __forceinline__ unsigned xb_add(unsigned* p, unsigned v) { return __hip_atomic_fetch_add(p, v, __ATOMIC_RELAXED, __HIP_MEMORY_SCOPE_AGENT); }
__device__ __forceinline__ unsigned xb_xcc_id() { return (unsigned)__builtin_amdgcn_s_getreg((3 << 11) | 20) & 0xFu; }
#define XB_SPIN(cond, bar) do { unsigned _sp = 0; while (cond) { __builtin_amdgcn_s_sleep(1); \
    if ((++_sp & 255u) == 0u) { if (xb_ld(&(bar)[XB_TMO])) break; if (_sp > XB_SPIN_CAP) { atomicAdd(&(bar)[XB_TMO], 1u); break; } } } } while (0)

struct XcdBarrier {
    unsigned* bar; unsigned x;
    volatile LAS unsigned* st;
};

__device__ __forceinline__ XcdBarrier xcd_barrier_post(unsigned* bar, volatile LAS unsigned* st) {
    XcdBarrier b; b.bar = bar; b.x = xb_xcc_id(); b.st = st;
    if (threadIdx.x == 0) (void)xb_add(&bar[XB_XCNT(b.x)], 1u);
    return b;
}
__device__ __forceinline__ void xcd_barrier_complete(unsigned* bar, unsigned x, unsigned& nloc, unsigned& nx) {
    const unsigned G = gridDim.x * gridDim.y * gridDim.z;
    unsigned sum, cnt, mine, sp = 0u;
    for (;;) {
        sum = 0u; cnt = 0u; mine = 0u;
#pragma unroll
        for (unsigned j = 0; j < 16; ++j) { const unsigned c = xb_ld(&bar[XB_XCNT(j)]); sum += c; cnt += (c > 0u) ? 1u : 0u; mine = (j == x) ? c : mine; }
        if (sum == G) break;
        __builtin_amdgcn_s_sleep(1);
        if ((++sp & 255u) == 0u) { if (xb_ld(&bar[XB_TMO])) break; if (sp > XB_SPIN_CAP) { atomicAdd(&bar[XB_TMO], 1u); break; } }
    }
    nloc = mine > 0u ? mine : 1u; nx = cnt > 0u ? cnt : 1u;
}

__device__ __forceinline__ void xcd_barrier(const XcdBarrier& b) {
    asm volatile("s_waitcnt vmcnt(0)" ::: "memory");
    __syncthreads();
    if (threadIdx.x == 0) {
        unsigned* bar = b.bar;
        __builtin_amdgcn_s_waitcnt(0);
        unsigned nloc = b.st[0], nx = b.st[1];
        if (nloc == 0u) { xcd_barrier_complete(bar, b.x, nloc, nx); b.st[0] = nloc; b.st[1] = nx; }
        const unsigned old = xb_add(&bar[XB_XSUB(b.x)], 1u);
        const unsigned gen = old / nloc;
        if (old + 1u == (gen + 1u) * nloc) {
            __builtin_amdgcn_fence(__ATOMIC_RELEASE, "agent");
            asm volatile("s_waitcnt vmcnt(0)" ::: "memory");
            const unsigned og = xb_add(&bar[XB_TOP], 1u);
            const unsigned tg = og / nx;
            if (og + 1u == (tg + 1u) * nx) xb_add(&bar[XB_TOPGEN], 1u);
            else XB_SPIN(xb_ld(&bar[XB_TOPGEN]) == tg, bar);
            __builtin_amdgcn_fence(__ATOMIC_ACQUIRE, "agent");
            xb_add(&bar[XB_XGEN(b.x)], 1u);
            asm volatile("s_waitcnt vmcnt(0)" ::: "memory");
        } else {
            XB_SPIN(xb_ld(&bar[XB_XGEN(b.x)]) == gen, bar);
            __builtin_amdgcn_fence(__ATOMIC_ACQUIRE, "agent");
            asm volatile("s_waitcnt vmcnt(0)" ::: "memory");
        }
    }
    __syncthreads();
}

constexpr size_t MiB = 1u << 20;
constexpr size_t WS_CTL = 0, WS_ORDER = 4096, WS_BAR = 8192;
constexpr size_t WS_W = 1 * MiB, OFF_WIN = 0, OFF_WGU = 11 * MiB, OFF_WD = 22 * MiB, OFF_WBR = 28 * MiB, OFF_WOUT = 30 * MiB, OFF_W1 = 32 * MiB, OFF_W2 = 34 * MiB,
                 OFF_BIN = 34 * MiB + 65536, OFF_CB1 = OFF_BIN + 32768  , OFF_CB2 = OFF_CB1 + 65536;
constexpr size_t WS_TAB = 36 * MiB, WS_SSP = 38 * MiB, WS_KC = 39 * MiB, WS_KM = 39 * MiB + 512 * 1024, WS_GN = 40 * MiB, WS_XB = 42 * MiB, WS_BIG = 74 * MiB,
                 WS_U = 170 * MiB, WS_QN = 178 * MiB, WS_KV = 194 * MiB, WS_MO = 218 * MiB, WS_MRG = 178 * MiB, WS_END = 242 * MiB;
constexpr int LDS_BYTES = 147456;

__device__ __forceinline__ int dint(int pos) { return (pos >> 1) + 32 * (pos & 1); }
__device__ __forceinline__ int in_orig(int c) {
    if (c < 256) return c;
    if (c < 768) { const int c2 = c - 256; return 256 + (c2 >> 6) * 64 + dint(c2 & 63); }
    if (c < 1536) { const int c2 = c - 768, tt = c2 >> 8, bj = (c2 >> 7) & 1, g = (c2 >> 6) & 1, pos = c2 & 63; return 768 + (2 * tt + bj) * 128 + g * 64 + (bj == 0 ? dint(pos) : pos); }
    if (c < 2304) { const int c2 = c - 1536, part = c2 >> 8, h = (c2 >> 6) & 3, pos = c2 & 63; return 1560 + part * 256 + h * 64 + (part < 2 ? dint(pos) : pos); }
    if (c < 5376) return 2328 + (c - 2304);
    const int c2 = c - 5376; return c2 < 24 ? 1536 + c2 : -1;
}
template <class F> __device__ __forceinline__ void cvt_tile(LAS float* scr, int lane, int k0, int n0, bf16_t* dst, size_t pitch, F f) {
    float vals[32];
#pragma unroll
    for (int i = 0; i < 32; ++i) vals[i] = f(k0 + 2 * i + (lane >> 5), n0 + (lane & 31));
#pragma unroll
    for (int i = 0; i < 32; ++i) scr[(2 * i + (lane >> 5)) * 33 + (lane & 31)] = vals[i];
    asm volatile("s_waitcnt lgkmcnt(0)" ::: "memory");
    const int c = lane & 7;
#pragma unroll
    for (int j = 0; j < 4; ++j) { const int n = (lane >> 3) + 8 * j; const LAS float* s = scr + (8 * c) * 33 + n;
        u32x4 o; o.x = cvtpk(s[0 * 33], s[1 * 33]); o.y = cvtpk(s[2 * 33], s[3 * 33]); o.z = cvtpk(s[4 * 33], s[5 * 33]); o.w = cvtpk(s[6 * 33], s[7 * 33]);
        *(u32x4*)(dst + (size_t)(n0 + n) * pitch + k0 + 8 * c) = o; }
    asm volatile("s_waitcnt lgkmcnt(0)" ::: "memory");
}
template <class F> __device__ __forceinline__ void cvt_tile_scaled(LAS float* scr, int lane, int k0, int n0, bf16_t* dst, size_t pitch, F f, const float* scale, float keep) {
    float vals[32], sc[32];
#pragma unroll
    for (int i = 0; i < 32; ++i) { vals[i] = f(k0 + 2 * i + (lane >> 5), n0 + (lane & 31)); sc[i] = scale[k0 + 2 * i + (lane >> 5)]; }
    __builtin_amdgcn_sched_barrier(0);
#pragma unroll
    for (int i = 0; i < 32; ++i) scr[(2 * i + (lane >> 5)) * 33 + (lane & 31)] = vals[i] * (sc[i] * keep);
    asm volatile("s_waitcnt lgkmcnt(0)" ::: "memory");
    const int c = lane & 7;
#pragma unroll
    for (int j = 0; j < 4; ++j) { const int n = (lane >> 3) + 8 * j; const LAS float* s = scr + (8 * c) * 33 + n;
        u32x4 o; o.x = cvtpk(s[0 * 33], s[1 * 33]); o.y = cvtpk(s[2 * 33], s[3 * 33]); o.z = cvtpk(s[4 * 33], s[5 * 33]); o.w = cvtpk(s[6 * 33], s[7 * 33]);
        *(u32x4*)(dst + (size_t)(n0 + n) * pitch + k0 + 8 * c) = o; }
    asm volatile("s_waitcnt lgkmcnt(0)" ::: "memory");
}
struct Args { const float* in[20]; float* out; unsigned char* ws; };
typedef const __attribute__((address_space(4))) Args* ArgsP;

__device__ __forceinline__ void phase0(ArgsP a, int l, LAS unsigned char* lds, int tid, int lane, int wave, int gw, int NGW) {
    unsigned char* ws = a->ws;
    LAS float* scr = (LAS float*)(lds + wave * 8704);
    const float* attn_norm = a->in[1] + (size_t)l * DM; const float* w_in = a->in[2] + (size_t)l * DM * IN_COLS; const float* b_in = a->in[3] + (size_t)l * IN_COLS;
    const float* pool_w = a->in[4] + (size_t)l * 4 * 64 * 64; const float* pool_scale = a->in[5] + (size_t)l * 256; const float* cmp_pos = a->in[6] + (size_t)l * 2 * 32 * 64;
    const float* cmp_w1 = a->in[7] + (size_t)l * 2 * 2048 * 256; const float* cmp_b1 = a->in[8] + (size_t)l * 2 * 256; const float* cmp_w2 = a->in[9] + (size_t)l * 2 * 256 * 64; const float* cmp_b2 = a->in[10] + (size_t)l * 2 * 64;
    const float* w_br_pool = a->in[11] + (size_t)l * 256 * DM; const float* w_br_nsa = a->in[12] + (size_t)l * 512 * DM; const float* w_br_moba = a->in[13] + (size_t)l * 256 * DM;
    const float* w_out = a->in[14] + (size_t)l * DM * DM; const float* ffn_norm = a->in[15] + (size_t)l * DM; const float* w_gate = a->in[16] + (size_t)l * DM * DFF; const float* w_up = a->in[17] + (size_t)l * DM * DFF;
    const float* w_down = a->in[18] + (size_t)l * DFF * DM;
    bf16_t* Win = (bf16_t*)(ws + WS_W + OFF_WIN); bf16_t* Wgu = (bf16_t*)(ws + WS_W + OFF_WGU); bf16_t* Wd = (bf16_t*)(ws + WS_W + OFF_WD); bf16_t* Wbr = (bf16_t*)(ws + WS_W + OFF_WBR);
    bf16_t* Wout = (bf16_t*)(ws + WS_W + OFF_WOUT); bf16_t* W1t = (bf16_t*)(ws + WS_W + OFF_W1); bf16_t* W2t = (bf16_t*)(ws + WS_W + OFF_W2);
    float* bin = (float*)(ws + WS_W + OFF_BIN); float* cb1 = (float*)(ws + WS_W + OFF_CB1); float* cb2 = (float*)(ws + WS_W + OFF_CB2);
    constexpr int I_A = 16 * 176, I_B = 16 * 176, I_C = 44 * 32, I_D = 16 * 32, I_E = 16 * 32, I_F = 2 * 32 * 8, I_G = 2 * 4 * 2;
    constexpr int NITEMS = I_A + I_B + I_C + I_D + I_E + I_F + I_G;
    for (int it = gw; it < NITEMS; it += NGW) {
        int r = it;
        if (r < I_A) { const int kb = r / 176, nb = r % 176; { const int o = in_orig(32 * nb + (lane & 31)); const float* wc = w_in + (o >= 0 ? o : 0); const float keep = o >= 0 ? 1.f : 0.f;
            cvt_tile_scaled(scr, lane, 64 * kb, 32 * nb, Win, DM, [&](int k, int) { return wc[(size_t)k * IN_COLS]; }, attn_norm, keep); } continue; } r -= I_A;
        if (r < I_B) { const int kb = r / 176, nb = r % 176; { const int n = 32 * nb + (lane & 31), j = (n >> 8) * 128 + (n & 127); const float* wc = (((n >> 7) & 1) ? w_up : w_gate) + j;
            cvt_tile_scaled(scr, lane, 64 * kb, 32 * nb, Wgu, DM, [&](int k, int) { return wc[(size_t)k * DFF]; }, ffn_norm, 1.f); } continue; } r -= I_B;
        if (r < I_C) { const int kb = r / 32, nb = r % 32; cvt_tile(scr, lane, 64 * kb, 32 * nb, Wd, DFF, [&](int k, int n) { return w_down[(size_t)k * DM + n]; }); continue; } r -= I_C;
        if (r < I_D) { const int kb = r / 32, nb = r % 32; cvt_tile(scr, lane, 64 * kb, 32 * nb, Wout, DM, [&](int k, int n) { return w_out[(size_t)k * DM + n]; }); continue; } r -= I_D;
        if (r < I_E) { const int kb = r / 32, nb = r % 32;
            if (kb < 4) { }
            else if (kb < 12) cvt_tile(scr, lane, 64 * kb, 32 * nb, Wbr, DM, [&](int k, int n) { return w_br_nsa[(size_t)(k - 256) * DM + n]; });
            else cvt_tile(scr, lane, 64 * kb, 32 * nb, Wbr, DM, [&](int k, int n) { return w_br_moba[(size_t)(k - 768) * DM + n]; });
            continue; } r -= I_E;
        if (r < I_F) { const int kv = r >> 8, kb = (r >> 3) & 31, nb = r & 7; const float* w1 = cmp_w1 + (size_t)kv * 2048 * 256;
            cvt_tile(scr, lane, 64 * kb, 32 * nb, W1t + (size_t)kv * 256 * 2048, 2048, [&](int k, int n) { const int pos = k & 63, d = kv == 0 ? dint(pos) : pos; return w1[(size_t)((k & ~63) + d) * 256 + n]; }); continue; } r -= I_F;
        { const int kv = r >> 3, kb = (r >> 1) & 3, nb = r & 1; const float* w2 = cmp_w2 + (size_t)kv * 256 * 64;
            cvt_tile(scr, lane, 64 * kb, 32 * nb, W2t + (size_t)kv * 64 * 256, 256, [&](int k, int n) { return w2[(size_t)k * 64 + (kv == 0 ? dint(n) : n)]; }); }
    }
    const int gt = gw * 64 + lane, NGT = NGW * 64;
    for (int c = gt; c < NIN; c += NGT) { const int o = in_orig(c); bin[c] = o >= 0 ? b_in[o] : 0.f; }
    for (int idx = gt; idx < 32 * 512; idx += NGT) { const int c = idx >> 9, e = idx & 511, kv = e >> 8, n = e & 255; const float* w1 = cmp_w1 + (size_t)kv * 2048 * 256 + (size_t)(64 * c) * 256 + n; const float* pe = cmp_pos + (size_t)kv * 2048 + 64 * c;
        float s = c == 0 ? cmp_b1[kv * 256 + n] : 0.f;
#pragma unroll
        for (int k0 = 0; k0 < 64; k0 += 32) { float av[32], bv[32];
#pragma unroll
            for (int k = 0; k < 32; ++k) { av[k] = pe[k0 + k]; bv[k] = w1[(size_t)(k0 + k) * 256]; }
            __builtin_amdgcn_sched_barrier(0);
#pragma unroll
            for (int k = 0; k < 32; ++k) s += av[k] * bv[k]; }
        cb1[idx] = s; }
    for (int idx = gt; idx < 256 * DM; idx += NGT) { const int k = idx >> 10, n = idx & 1023, g64 = k & ~63; float s = 0.f;
        const f32x4* pw4 = (const f32x4*)(pool_w + (size_t)k * 64); const f32x4* ps4 = (const f32x4*)(pool_scale + g64);
#pragma unroll
        for (int j0 = 0; j0 < 64; j0 += 32) { f32x4 pw[8], psc[8]; float wb[32];
#pragma unroll
            for (int q = 0; q < 8; ++q) { pw[q] = pw4[j0 / 4 + q]; psc[q] = ps4[j0 / 4 + q]; }
#pragma unroll
            for (int j = 0; j < 32; ++j) wb[j] = w_br_pool[(size_t)(g64 + j0 + j) * DM + n];
            __builtin_amdgcn_sched_barrier(0);
#pragma unroll
            for (int j = 0; j < 32; ++j) s += pw[j >> 2][j & 3] * psc[j >> 2][j & 3] * wb[j]; }
        Wbr[(size_t)n * DM + k] = (bf16_t)(cvtpk(s, 0.f) & 0xffffu); }
    for (int e = gt; e < 128; e += NGT) { const int kv = e >> 6, n = e & 63; cb2[e] = cmp_b2[kv * 64 + (kv == 0 ? dint(n) : n)]; }
    if (l == 0) {
        float* tab = (float*)(ws + WS_TAB);
        for (int e = gt; e < SEQ * 32; e += NGT) { const int t = e >> 5, f = e & 31; const float inv = powf(10000.0f, -(float)(2 * f) / 64.0f); const float ang = (float)t * inv;
            const double ad = (double)ang, kq = rint(ad * 0.15915494309189535); double rr = fma(-kq, 6.283185307179586, ad); rr = fma(-kq, 2.4492935982947064e-16, rr);
            const float rf = (float)rr; tab[2 * e] = __cosf(rf); tab[2 * e + 1] = __sinf(rf); }
        const float* x = a->in[0]; bf16_t* xb = (bf16_t*)(ws + WS_XB); float* ssp = (float*)(ws + WS_SSP);
        for (int m0 = 2 * gw; m0 < MTOK; m0 += 2 * NGW) { f32x4 v[2][4]; float s[2] = {0.f, 0.f};
#pragma unroll
            for (int q = 0; q < 2; ++q) { const f32x4* xr = (const f32x4*)(x + (size_t)(m0 + q) * DM) + lane;
#pragma unroll
                for (int j = 0; j < 4; ++j) v[q][j] = xr[64 * j]; }
#pragma unroll
            for (int q = 0; q < 2; ++q) {
#pragma unroll
                for (int j = 0; j < 4; ++j) s[q] += (v[q][j][0] * v[q][j][0] + v[q][j][1] * v[q][j][1]) + (v[q][j][2] * v[q][j][2] + v[q][j][3] * v[q][j][3]);
#pragma unroll
                for (int o = 1; o < 64; o <<= 1) s[q] += __shfl_xor(s[q], o);
                u32x2* o8 = (u32x2*)(xb + (size_t)(m0 + q) * DM) + lane;
#pragma unroll
                for (int j = 0; j < 4; ++j) o8[64 * j] = (u32x2){cvtpk(v[q][j][0], v[q][j][1]), cvtpk(v[q][j][2], v[q][j][3])};
                if (lane < 16) ssp[(size_t)(m0 + q) * 16 + lane] = lane == 0 ? s[q] : 0.f; } }
        int* order = (int*)(ws + WS_ORDER);
        auto cost = [](int id) { if (id < 512) { const int i = id & 127; return 10 * ((i + 1) + ((i < 8 ? i : 8) + 1) + 10) + 16 * ((4 * i + 3 + 63) >> 6); } const int qb = (id - 512) & 31; return 7 * (4 * qb + 3) + 50; };
        for (int id = gw; id < 768; id += NGW) { const int mc = cost(id); int rk = 0;
            for (int j = lane; j < 768; j += 64) { const int cj = cost(j); rk += (cj > mc || (cj == mc && j < id)) ? 1 : 0; }
#pragma unroll
            for (int o = 1; o < 64; o <<= 1) rk += __shfl_xor(rk, o);
            if (lane == 0) order[rk] = id; }
    }
}
__device__ __forceinline__ float gelu_tanh(float x) { const float u = 0.7978845608028654f * (x + 0.044715f * x * x * x); const float th = 1.f - 2.f * __builtin_amdgcn_rcpf(1.f + __expf(2.f * u)); return 0.5f * x * (1.f + th); }
__device__ __forceinline__ void phase2(ArgsP a, LAS unsigned char* lds, int tid, int lane, int wave, int G) {
    unsigned char* ws = a->ws;
    const bf16_t* KV = (const bf16_t*)(ws + WS_KV); const bf16_t* W1t = (const bf16_t*)(ws + WS_W + OFF_W1); const bf16_t* W2t = (const bf16_t*)(ws + WS_W + OFF_W2);
    const float* cb1 = (const float*)(ws + WS_W + OFF_CB1); const float* cb2 = (const float*)(ws + WS_W + OFF_CB2);
    bf16_t* KC = (bf16_t*)(ws + WS_KC);
    LAS bf16_t* hid = (LAS bf16_t*)lds;
    const int arow = lane & 15, kq = lane >> 4;
    for (int task = blockIdx.x; task < 256; task += G) {
        const int kv = task >> 7, bgi = (task >> 5) & 3, nt = task & 31;
        const bf16_t* src = KV + (size_t)kv * att::KV_STRIDE + (size_t)bgi * SEQ * 64;
        const int nrow = 16 * nt + arow, neff = nrow < 510 ? nrow : 510;
        const bf16_t* ap = src + (size_t)neff * 1024 + kq * 8;
        const bf16_t* bp0 = W1t + (size_t)kv * 256 * 2048 + (size_t)(32 * wave + arow) * 2048 + kq * 8; const bf16_t* bp1 = bp0 + 16 * 2048;
        f32x4 c0 = {0.f, 0.f, 0.f, 0.f}, c1 = {0.f, 0.f, 0.f, 0.f};
        float bb0 = 0.f, bb1 = 0.f;
        { const int col0 = 32 * wave + arow; float t0[32], t1[32];
#pragma unroll
          for (int c = 0; c < 32; ++c) { t0[c] = cb1[c * 512 + kv * 256 + col0]; t1[c] = cb1[c * 512 + kv * 256 + col0 + 16]; }
          __builtin_amdgcn_sched_barrier(0);
#pragma unroll
          for (int c = 0; c < 32; ++c) { bb0 += t0[c]; bb1 += t1[c]; } }
#pragma unroll 1
        for (int ks0 = 0; ks0 < 64; ks0 += 8) { bf16x8 av[8], b0[8], b1[8];
#pragma unroll
            for (int q = 0; q < 8; ++q) { av[q] = *(const bf16x8*)(ap + (ks0 + q) * 32); b0[q] = *(const bf16x8*)(bp0 + (ks0 + q) * 32); b1[q] = *(const bf16x8*)(bp1 + (ks0 + q) * 32); }
            __builtin_amdgcn_sched_barrier(0);
#pragma unroll
            for (int q = 0; q < 8; ++q) { c0 = __builtin_amdgcn_mfma_f32_16x16x32_bf16(av[q], b0[q], c0, 0, 0, 0); c1 = __builtin_amdgcn_mfma_f32_16x16x32_bf16(av[q], b1[q], c1, 0, 0, 0); } }
        { const int col0 = 32 * wave + arow;
#pragma unroll
          for (int j = 0; j < 4; ++j) { const int row = kq * 4 + j; hid[row * 264 + col0] = (bf16_t)(cvtpk(gelu_tanh(c0[j] + bb0), 0.f) & 0xffffu); hid[row * 264 + col0 + 16] = (bf16_t)(cvtpk(gelu_tanh(c1[j] + bb1), 0.f) & 0xffffu); } }
        LBAR();
        if (wave < 4) {
            const bf16_t* bp = W2t + (size_t)kv * 64 * 256 + (size_t)(16 * wave + arow) * 256 + kq * 8; f32x4 c = {0.f, 0.f, 0.f, 0.f};
            bf16x8 bv[8];
#pragma unroll
            for (int ks = 0; ks < 8; ++ks) bv[ks] = *(const bf16x8*)(bp + ks * 32);
            __builtin_amdgcn_sched_barrier(0);
#pragma unroll
            for (int ks = 0; ks < 8; ++ks) { const bf16x8 av = *(const LAS bf16x8*)(hid + arow * 264 + kq * 8 + ks * 32); c = __builtin_amdgcn_mfma_f32_16x16x32_bf16(av, bv[ks], c, 0, 0, 0); }
            const int col = 16 * wave + arow; const float bb = cb2[kv * 64 + col];
#pragma unroll
            for (int j = 0; j < 4; ++j) { const int n = 16 * nt + kq * 4 + j; KC[((size_t)(kv * 4 + bgi) * 512 + n) * 64 + col] = n < 511 ? (bf16_t)(cvtpk(c[j] + bb, 0.f) & 0xffffu) : (bf16_t)0; }
        }
        LBAR();
    }
    const int gt = blockIdx.x * 512 + tid, NGT = G * 512;
    { const bf16_t* MoK = (const bf16_t*)(ws + WS_MO) + att::MO_STRIDE; bf16_t* KM = (bf16_t*)(ws + WS_KM); LAS float* part = (LAS float*)(lds + 16384);
      for (int blk = blockIdx.x; blk < 256; blk += G) { const bf16_t* p = MoK + ((size_t)blk * 256 + 32 * wave) * 64 + lane; float s = 0.f;
#pragma unroll
          for (int r0 = 0; r0 < 32; r0 += 16) { unsigned short tv[16];
#pragma unroll
              for (int r = 0; r < 16; ++r) tv[r] = p[(size_t)(r0 + r) * 64];
              __builtin_amdgcn_sched_barrier(0);
#pragma unroll
              for (int r = 0; r < 16; ++r) s += __uint_as_float((unsigned)tv[r] << 16); }
          part[wave * 64 + lane] = s;
          LBAR();
          if (wave == 0) { float t = 0.f;
#pragma unroll
              for (int w = 0; w < 8; ++w) t += part[w * 64 + lane];
              KM[(size_t)blk * 64 + lane] = (bf16_t)(cvtpk(t * (1.0f / 256.0f), 0.f) & 0xffffu); }
          LBAR(); } }
    { const bf16_t* U = (const bf16_t*)(ws + WS_U); bf16_t* Abr = (bf16_t*)(ws + WS_XB);
      for (int e = gt; e < MTOK * 32; e += NGT) { const int row = e >> 5, c8 = e & 31, s = row & (SEQ - 1), w = 2 << (c8 >> 3), cnt = (s + 1 < w) ? s + 1 : w;
          float acc[8] = {0.f, 0.f, 0.f, 0.f, 0.f, 0.f, 0.f, 0.f}; u32x4 v0 = {0u, 0u, 0u, 0u};
#pragma unroll
          for (int i0 = 0; i0 < 16; i0 += 8) { if (i0 >= cnt) break; u32x4 v[8];
#pragma unroll
              for (int i = 0; i < 8; ++i) v[i] = (i0 + i < cnt) ? *(const u32x4*)(U + (size_t)(row - i0 - i) * 256 + c8 * 8) : (u32x4){0u, 0u, 0u, 0u};
              __builtin_amdgcn_sched_barrier(0);
              if (i0 == 0) v0 = v[0];
#pragma unroll
              for (int i = 0; i < 8; ++i)
#pragma unroll
                  for (int q = 0; q < 4; ++q) { acc[2 * q] += bflo(v[i][q]); acc[2 * q + 1] += bfhi(v[i][q]); } }
          const float ic = 1.0f / (float)cnt; u32x4 o;
#pragma unroll
          for (int q = 0; q < 4; ++q) o[q] = cvtpk(acc[2 * q] * ic - bflo(v0[q]), acc[2 * q + 1] * ic - bfhi(v0[q]));
          *(u32x4*)(Abr + (size_t)row * DM + c8 * 8) = o; } }
}
__global__ void __launch_bounds__(512, 2) fwd_megakernel(Args a) {
    extern __shared__ __attribute__((aligned(16))) unsigned char lds_raw[];
    LAS unsigned char* lds = (LAS unsigned char*)lds_raw;
    cg::grid_group grid = cg::this_grid();
    const int G = gridDim.x;
    volatile LAS unsigned* bst = (volatile LAS unsigned*)(lds + LDS_BYTES - 64);
    if (threadIdx.x < 16) bst[threadIdx.x] = 0u;
    __syncthreads();
    const ArgsP ap0 = (ArgsP)__builtin_amdgcn_kernarg_segment_ptr();
#define PHASE_ARGS ArgsP a_ = ap0; asm volatile("" : "+s"(a_)); unsigned char* ws = a_->ws; unsigned* ctl = (unsigned*)(ws + WS_CTL); float* ssp = (float*)(ws + WS_SSP); const float* tab = (const float*)(ws + WS_TAB); \
    bf16_t* XB = (bf16_t*)(ws + WS_XB); bf16_t* BIG = (bf16_t*)(ws + WS_BIG); bf16_t* MRG = (bf16_t*)(ws + WS_MRG); (void)ctl; (void)ssp; (void)tab; (void)XB; (void)BIG; (void)MRG;
    XcdBarrier xbar = xcd_barrier_post((unsigned*)(ap0->ws + WS_BAR), bst);
#define GRID_SYNC() xcd_barrier(xbar)
    for (int l = 0; l < DEPTH; ++l) {
        int tid_ = threadIdx.x; asm volatile("" : "+v"(tid_));
        const int tid = tid_, lane = tid & 63, wave = __builtin_amdgcn_readfirstlane(tid >> 6), gw = blockIdx.x * 8 + wave, NGW = G * 8;
        { PHASE_ARGS phase0(a_, l, lds, tid, lane, wave, gw, NGW); }
        if (l == 0) {
            grid.sync();
            if (threadIdx.x < 64) { unsigned ln_ = threadIdx.x; asm volatile("" : "+v"(ln_)); const unsigned c_ = ln_ < 16 ? xb_ld(&xbar.bar[XB_XCNT(ln_)]) : 0u;
                const unsigned nx_ = (unsigned)__popcll(__ballot(c_ > 0u)); const unsigned nl_ = (unsigned)__builtin_amdgcn_readlane((int)c_, (int)xbar.x);
                if (ln_ == 0 && nl_ > 0u) { bst[0] = nl_; bst[1] = nx_; } }
            __syncthreads();
        } else GRID_SYNC();
        { PHASE_ARGS pg8::Gemm g{XB, (const bf16_t*)(ws + WS_W + OFF_WIN), MTOK, NIN, DM}; pg8::StaticOrder S; S.init(MTOK, NIN, G, (int)blockIdx.x);
          EpiInProj E{ssp, (const float*)(ws + WS_W + OFF_BIN), tab, (bf16_t*)(ws + WS_U), (bf16_t*)(ws + WS_QN), (bf16_t*)(ws + WS_KV), (bf16_t*)(ws + WS_MO), BIG, (bf16_t*)(ws + WS_GN)};
          pg8::gemm_phase(lds, g, S, E); }
        GRID_SYNC();
        { PHASE_ARGS phase2(a_, lds, tid, lane, wave, G); }
        GRID_SYNC();
        { PHASE_ARGS
          att::Bufs B{(const bf16_t*)(ws + WS_QN), (const bf16_t*)(ws + WS_KV), (const bf16_t*)(ws + WS_MO), (const bf16_t*)(ws + WS_KC), (const bf16_t*)(ws + WS_KM), (const bf16_t*)(ws + WS_GN), XB};
          const int* order = (const int*)(ws + WS_ORDER); LAS int* slot = (LAS int*)(lds + att::L_END);
          if (wave >= 4) __builtin_amdgcn_s_setprio(1);
          for (;;) {
              LBAR();
              if (tid == 0) slot[0] = (int)atomicAdd(ctl + l, 1u);
              LBAR();
              const int item = slot[0];
              if (item >= 768) break;
              const int id = order[item];
              int tl = threadIdx.x; asm volatile("" : "+v"(tl));
              const int tid = tl, lane = tid & 63, wave = __builtin_amdgcn_readfirstlane(tid >> 6);
              att::Ctx C; C.lds = (LAS char*)lds; C.wsf = (LAS float*)(lds + att::L_WSF) + wave * 64; C.otl = (LAS float*)(lds + att::L_OT) + wave * 2048 + lane; C.tid = tid; C.wid = wave; C.lane = lane; C.r32 = lane & 31; C.hi = lane >> 5;
              C.vbl = ((lane >> 4) & 1) * 32 + (lane & 3) * 8 + (4 * (lane >> 5) + ((lane & 15) >> 2)) * 64;
              if (id < 512) att::nsa_item(C, B, id >> 8, (id >> 7) & 1, id & 127);
              else { const int x = id - 512; att::moba_item(C, B, x >> 7, (x >> 5) & 3, x & 31); }
          }
          __builtin_amdgcn_s_setprio(0); }
        GRID_SYNC();
        { PHASE_ARGS pg8::Gemm g{XB, (const bf16_t*)(ws + WS_W + OFF_WBR), MTOK, DM, DM}; pg8::StaticOrder S; S.init(MTOK, DM, G, (int)blockIdx.x);
          EpiBranch E{BIG, MRG}; pg8::gemm_phase(lds, g, S, E); }
        GRID_SYNC();
        { PHASE_ARGS pg8::Gemm g{MRG, (const bf16_t*)(ws + WS_W + OFF_WOUT), MTOK, DM, DM}; pg8::StaticOrder S; S.init(MTOK, DM, G, (int)blockIdx.x);
          bf16_t* RES = (bf16_t*)a_->out; EpiResid E{l == 0 ? a_->in[0] : nullptr, RES, XB, nullptr, ssp};   pg8::gemm_phase(lds, g, S, E); }
        GRID_SYNC();
        { PHASE_ARGS pg8::Gemm g{XB, (const bf16_t*)(ws + WS_W + OFF_WGU), MTOK, NGU, DM}; pg8::StaticOrder S; S.init(MTOK, NGU, G, (int)blockIdx.x);
          EpiSwiGLU E{ssp, BIG}; pg8::gemm_phase(lds, g, S, E); }
        GRID_SYNC();
        { PHASE_ARGS pg8::Gemm g{BIG, (const bf16_t*)(ws + WS_W + OFF_WD), MTOK, DM, DFF}; pg8::StaticOrder S; S.init(MTOK, DM, G, (int)blockIdx.x);
          bf16_t* RES = (bf16_t*)a_->out; EpiResid E{nullptr, XB, XB, l + 1 < DEPTH ? RES : nullptr, ssp};   pg8::gemm_phase(lds, g, S, E); }
        GRID_SYNC();
    }
    { PHASE_ARGS const float* fn = a_->in[19]; float* outp = a_->out; const int lane = threadIdx.x & 63, gw = blockIdx.x * 8 + (threadIdx.x >> 6), NGW = G * 8;
      const f32x4* gr = (const f32x4*)fn + lane; f32x4 gv[4];
#pragma unroll
      for (int j = 0; j < 4; ++j) gv[j] = gr[64 * j];
      for (int m0 = 2 * gw; m0 < MTOK; m0 += 2 * NGW) { u32x2 w[2][4]; float rstd[2];
#pragma unroll
          for (int q = 0; q < 2; ++q) { const u32x2* xr = (const u32x2*)(XB + (size_t)(m0 + q) * DM) + lane; rstd[q] = row_rstd(ssp, m0 + q);
#pragma unroll
              for (int j = 0; j < 4; ++j) w[q][j] = xr[64 * j]; }
#pragma unroll
          for (int q = 0; q < 2; ++q) { f32x4* orow = (f32x4*)(outp + (size_t)(m0 + q) * DM) + lane;
#pragma unroll
              for (int j = 0; j < 4; ++j) { const f32x4 v = {bflo(w[q][j][0]), bfhi(w[q][j][0]), bflo(w[q][j][1]), bfhi(w[q][j][1])}; orow[64 * j] = v * rstd[q] * gv[j]; } } } }
}

extern "C" void kernel_launch(void* const* d_in, const int* in_sizes, int n_in, void* d_out, int out_size, void* d_ws, size_t ws_size, hipStream_t stream) {
    static int grid = 0;
    if (grid == 0) {
        if (n_in != 20 || in_sizes[0] != MTOK * DM || out_size != MTOK * DM || ws_size < WS_END) { fprintf(stderr, "kernel_launch: unexpected shapes / workspace (n_in %d, ws %zu)\n", n_in, ws_size); grid = -1; return; }
        int dev = 0, cus = 0, per_cu = 0;
        if (hipGetDevice(&dev) != hipSuccess || hipDeviceGetAttribute(&cus, hipDeviceAttributeMultiprocessorCount, dev) != hipSuccess) { grid = -1; return; }
        if (hipFuncSetAttribute((const void*)fwd_megakernel, hipFuncAttributeMaxDynamicSharedMemorySize, LDS_BYTES) != hipSuccess) { fprintf(stderr, "kernel_launch: hipFuncSetAttribute failed\n"); grid = -1; return; }
        if (hipOccupancyMaxActiveBlocksPerMultiprocessor(&per_cu, (const void*)fwd_megakernel, 512, LDS_BYTES) != hipSuccess || per_cu < 1) { fprintf(stderr, "kernel_launch: occupancy query failed (%d)\n", per_cu); (void)hipGetLastError(); grid = -1; return; }
        grid = cus * per_cu;
    }
    if (grid < 0) return;
    if (hipMemsetAsync((char*)d_ws + WS_CTL, 0, 32768, stream) != hipSuccess) { fprintf(stderr, "kernel_launch: memset failed\n"); return; }
    Args a{};
    for (int i = 0; i < 20; ++i) a.in[i] = (const float*)d_in[i];
    a.out = (float*)d_out; a.ws = (unsigned char*)d_ws;
    void* args[] = {&a};
    const hipError_t e = hipLaunchCooperativeKernel((const void*)fwd_megakernel, dim3(grid), dim3(512), args, LDS_BYTES, stream);
    if (e != hipSuccess) fprintf(stderr, "kernel_launch: cooperative launch failed: %s (grid %d)\n", hipGetErrorString(e), grid);
}
```

```cpp
#include <hip/hip_runtime.h>
#include <hip/hip_cooperative_groups.h>
#include <cstdio>
#include <cstdint>
#include <cmath>
namespace cg = cooperative_groups;

#define LAS __attribute__((address_space(3)))
typedef unsigned short bf16_t;
typedef short bf16x8 __attribute__((ext_vector_type(8)));
typedef short s16x4 __attribute__((ext_vector_type(4)));
typedef float f32x2 __attribute__((ext_vector_type(2)));
typedef float f32x4 __attribute__((ext_vector_type(4)));
typedef float f32x16 __attribute__((ext_vector_type(16)));
typedef unsigned u32x4 __attribute__((ext_vector_type(4)));
typedef unsigned u32x2 __attribute__((ext_vector_type(2)));
typedef __bf16 bf16x2_t __attribute__((ext_vector_type(2)));

constexpr int SEQ = 8192, BATCH = 2, MTOK = BATCH * SEQ, DM = 1024, DEPTH = 2;
constexpr int IN_COLS = 5400, NIN = 5632, DFF = 2816, NGU = 5632;
constexpr float RMS_EPS = 1e-6f;
constexpr float QSCALE = 0.125f * 1.4426950408889634f;

__device__ __forceinline__ unsigned cvtpk(float lo, float hi) { f32x2 v = {lo, hi}; bf16x2_t b = __builtin_convertvector(v, bf16x2_t); return __builtin_bit_cast(unsigned, b); }
__device__ __forceinline__ float bflo(unsigned w) { return __uint_as_float(w << 16); }
__device__ __forceinline__ float bfhi(unsigned w) { return __uint_as_float(w & 0xffff0000u); }
__device__ __forceinline__ float sigmoidf_(float x) { return __builtin_amdgcn_rcpf(1.f + __expf(-x)); }

namespace pg8 {
constexpr int BM = 256, BK = 64, HALF = 128, HTB = HALF * BK * 2, STAGE_BYTES = 8 * HTB, NXCD = 8, WGM = 8;
__host__ __device__ __forceinline__ int lds_byte(int r, int c) { const int st = (r >> 4) * 2 + (c >> 5), rr = r & 15, cc = c & 31, ob = rr * 64 + cc * 2; return st * 1024 + (ob ^ (((ob >> 9) & 1) << 5)); }
__host__ __device__ __forceinline__ void stage_rc(int b, int& R, int& C) { const int st = b / 1024, sb = b % 1024, swz = sb ^ (((sb >> 9) & 1) << 5); R = (st >> 1) * 16 + swz / 64; C = (st & 1) * 32 + (swz % 64) / 2; }
__host__ __device__ __forceinline__ int perm32(int rho) { const int n = rho >> 4, i = rho & 15; return 8 * (i >> 2) + 4 * n + (i & 3); }
struct Unit { int pm, pn; };
struct Gemm { const bf16_t* A; const bf16_t* Bt; int M, N, K; };
struct StaticOrder {
    int nM, nN, nwg, G, c;
    __host__ __device__ void init(int M, int N, int G_, int c_) { nM = M / BM; nN = N / BM; nwg = nM * nN; G = G_; c = c_; }
    __host__ __device__ bool next(int i, Unit& u) const {
        const long L = (long)i * G + c; if (L >= nwg) return false;
        int wgid = (int)L; { const int q = nwg / NXCD, r = nwg % NXCD, xcd = wgid % NXCD, off = wgid / NXCD; wgid = (xcd < r ? xcd * (q + 1) : r * (q + 1) + (xcd - r) * q) + off; }
        const int nig = WGM * nN, gid = wgid / nig, fm = gid * WGM, gsz = (nM - fm) < WGM ? (nM - fm) : WGM;
        u.pm = fm + ((wgid % nig) % gsz); u.pn = (wgid % nig) / gsz; return true;
    }
};
template <class Epi, class Sched>
__device__ __forceinline__ void gemm_phase(LAS unsigned char* lds, const Gemm g, const Sched& S, const Epi& E) {
    int tid_ = threadIdx.x; asm volatile("" : "+v"(tid_));
    const int tid = tid_, wid = __builtin_amdgcn_readfirstlane(tid >> 6), lane = tid & 63, wr = wid >> 2, wc = wid & 3, fr = lane & 15, fq = lane >> 4;
    const int K = g.K, nt = K / BK;
    unsigned voffA[2], voffB[2];
#pragma unroll
    for (int i = 0; i < 2; ++i) { int R, C; stage_rc(tid * 16 + i * 8192, R, C); const int Rb = ((R & ~31) + perm32(R & 31));
        voffA[i] = (unsigned)(R * K + C) * 2u; voffB[i] = (unsigned)(Rb * K + C) * 2u; }
    const size_t kstep = (size_t)(BK * 2);
    const size_t hstep = (size_t)HALF * K * 2;
    const size_t tstep = 2 * hstep;
    const unsigned ldsw = (unsigned)wid * 1024u;
    const int aoff = lds_byte(wr * 64 + fr, fq * 8), boff = lds_byte(wc * 32 + fr, fq * 8);
#define PG8_SA(b, h) (((b) * 2 + (h)) * HTB)
#define PG8_SB(b, h) ((4 + (b) * 2 + (h)) * HTB)
#define PG8_STAGE(bufoff, gbase, voff) do { _Pragma("unroll") for (int _i = 0; _i < 2; ++_i) \
        __builtin_amdgcn_global_load_lds((const unsigned*)((const char*)(gbase) + (voff)[_i]), (LAS unsigned*)(lds + (bufoff) + ldsw + _i * 8192), 16, 0, 0); } while (0)
#define PG8_LDA(dst, b, h) do { _Pragma("unroll") for (int m = 0; m < 4; ++m) _Pragma("unroll") for (int k = 0; k < 2; ++k) dst[m][k] = *(const LAS bf16x8*)(lds + PG8_SA(b, h) + aoff + m * 2048 + k * 1024); } while (0)
#define PG8_LDB(dst, b, h) do { _Pragma("unroll") for (int n = 0; n < 2; ++n) _Pragma("unroll") for (int k = 0; k < 2; ++k) dst[n][k] = *(const LAS bf16x8*)(lds + PG8_SB(b, h) + boff + n * 2048 + k * 1024); } while (0)
#define PG8_MMA(ai, bj, At, Bt) do { __builtin_amdgcn_s_setprio(1); _Pragma("unroll") for (int m = 0; m < 4; ++m) _Pragma("unroll") for (int n = 0; n < 2; ++n) _Pragma("unroll") for (int k = 0; k < 2; ++k) \
        acc[ai][bj][m][n] = __builtin_amdgcn_mfma_f32_16x16x32_bf16(Bt[n][k], At[m][k], acc[ai][bj][m][n], 0, 0, 0); __builtin_amdgcn_s_setprio(0); } while (0)
#define PG8_WAIT_V(n) asm volatile("s_waitcnt vmcnt(" #n ")" ::: "memory")
#define PG8_WAIT_L(n) asm volatile("s_waitcnt lgkmcnt(" #n ")" ::: "memory")
#define PG8_BAR __builtin_amdgcn_s_barrier()
#define PG8_SCHED __builtin_amdgcn_sched_barrier(0)
    Unit cur, nxt; int ui = 0;
    if (!S.next(0, cur)) return;
    f32x4 acc[2][2][4][2];
#pragma unroll
    for (int a = 0; a < 2; ++a)
#pragma unroll
        for (int b = 0; b < 2; ++b)
#pragma unroll
            for (int m = 0; m < 4; ++m)
#pragma unroll
                for (int n = 0; n < 2; ++n) acc[a][b][m][n] = (f32x4){0.f, 0.f, 0.f, 0.f};
    bf16x8 At[4][2], B0[2][2], B1[2][2];
    const char* cA = (const char*)g.A + (size_t)cur.pm * tstep; const char* cB = (const char*)g.Bt + (size_t)cur.pn * tstep;
    PG8_STAGE(PG8_SB(0, 0), cB, voffB); PG8_STAGE(PG8_SB(0, 1), cB + hstep, voffB); PG8_STAGE(PG8_SA(0, 0), cA, voffA); PG8_STAGE(PG8_SA(0, 1), cA + hstep, voffA);
    if (wr == 1) PG8_BAR;
    PG8_WAIT_V(2); PG8_BAR;
    PG8_STAGE(PG8_SB(1, 0), cB + kstep, voffB); PG8_STAGE(PG8_SA(1, 0), cA + kstep, voffA); PG8_STAGE(PG8_SB(1, 1), cB + hstep + kstep, voffB);
    PG8_WAIT_V(6); PG8_BAR;
    for (;;) {
        const bool has_next = S.next(ui + 1, nxt);
        const char* nA = has_next ? (const char*)g.A + (size_t)nxt.pm * tstep : cA; const char* nB = has_next ? (const char*)g.Bt + (size_t)nxt.pn * tstep : cB;
        for (int t = 0; t < nt; t += 2) {
            const bool last = (t == nt - 2);
            const char* a1 = cA + (size_t)(t + 1) * kstep;
            const char* a2 = last ? nA : cA + (size_t)(t + 2) * kstep; const char* b2 = last ? nB : cB + (size_t)(t + 2) * kstep;
            const char* a3 = a2 + kstep; const char* b3 = b2 + kstep;
            if constexpr (Epi::KHOOK) { if (t == 4 || t == 12) { PG8_SCHED; E.khook(acc, cur, t, wr, wc, fr, fq); PG8_SCHED; } }
            PG8_LDB(B0, 0, 0); PG8_LDB(B1, 0, 1); PG8_SCHED; PG8_LDA(At, 0, 0); PG8_STAGE(PG8_SA(1, 1), a1 + hstep, voffA);
            PG8_WAIT_V(8); PG8_WAIT_L(0); PG8_BAR; PG8_MMA(0, 0, At, B0); PG8_MMA(0, 1, At, B1); PG8_BAR; PG8_SCHED;
            PG8_LDA(At, 0, 1); PG8_STAGE(PG8_SB(0, 0), b2, voffB); PG8_STAGE(PG8_SB(0, 1), b2 + hstep, voffB); PG8_STAGE(PG8_SA(0, 0), a2, voffA);
            PG8_WAIT_V(8); PG8_WAIT_L(0); PG8_BAR; PG8_MMA(1, 0, At, B0); PG8_MMA(1, 1, At, B1); PG8_BAR; PG8_SCHED;
            PG8_LDB(B0, 1, 0); PG8_LDB(B1, 1, 1); PG8_SCHED; PG8_LDA(At, 1, 0); PG8_STAGE(PG8_SA(0, 1), a2 + hstep, voffA);
            PG8_WAIT_V(8); PG8_WAIT_L(0); PG8_BAR; PG8_MMA(0, 0, At, B0); PG8_MMA(0, 1, At, B1); PG8_BAR; PG8_SCHED;
            PG8_LDA(At, 1, 1); PG8_STAGE(PG8_SB(1, 0), b3, voffB); PG8_STAGE(PG8_SB(1, 1), b3 + hstep, voffB); PG8_STAGE(PG8_SA(1, 0), a3, voffA);
            PG8_WAIT_V(8); PG8_WAIT_L(0); PG8_BAR; PG8_MMA(1, 0, At, B0); PG8_MMA(1, 1, At, B1); PG8_BAR; PG8_SCHED;
        }
        if (wr == 0) PG8_BAR;
        E(acc, cur, wr, wc, fr, fq);
        if (!has_next) break;
#pragma unroll
        for (int a = 0; a < 2; ++a)
#pragma unroll
            for (int b = 0; b < 2; ++b)
#pragma unroll
                for (int m = 0; m < 4; ++m)
#pragma unroll
                    for (int n = 0; n < 2; ++n) acc[a][b][m][n] = (f32x4){0.f, 0.f, 0.f, 0.f};
        cur = nxt; cA = nA; cB = nB; ++ui;
        if (wr == 1) PG8_BAR;
    }
    PG8_WAIT_V(0);
    PG8_BAR;
#undef PG8_SA
#undef PG8_SB
#undef PG8_STAGE
#undef PG8_LDA
#undef PG8_LDB
#undef PG8_MMA
#undef PG8_WAIT_V
#undef PG8_WAIT_L
#undef PG8_BAR
#undef PG8_SCHED
}
}
using pg8::Unit;
__device__ __forceinline__ float sum_fq(float v) {
    auto a = __builtin_amdgcn_permlane16_swap(__float_as_uint(v), __float_as_uint(v), false, false); v = __uint_as_float(a[0]) + __uint_as_float(a[1]);
    auto b = __builtin_amdgcn_permlane32_swap(__float_as_uint(v), __float_as_uint(v), false, false); return __uint_as_float(b[0]) + __uint_as_float(b[1]);
}
__device__ __forceinline__ float row_rstd(const float* ssp, int row) {
    const f32x4* p = (const f32x4*)(ssp + (size_t)row * 16);
    const f32x4 a = p[0], b = p[1], c = p[2], d = p[3];
    const float ss = ((a[0] + a[1]) + (a[2] + a[3])) + ((b[0] + b[1]) + (b[2] + b[3])) + ((c[0] + c[1]) + (c[2] + c[3])) + ((d[0] + d[1]) + (d[2] + d[3]));
    return 1.0f / sqrtf(ss * (1.0f / DM) + RMS_EPS);
}
__device__ __forceinline__ float row_rstd4(const float* ssp, int row, int fq) {
    const f32x4 a = *((const f32x4*)(ssp + (size_t)row * 16) + fq);
    float ss = (a[0] + a[1]) + (a[2] + a[3]);
    ss = sum_fq(ss);
    return 1.0f / sqrtf(ss * (1.0f / DM) + RMS_EPS);
}
__device__ __forceinline__ u32x4 pack8(const f32x4 a, const f32x4 b) { u32x4 w; w.x = cvtpk(a[0], a[1]); w.y = cvtpk(a[2], a[3]); w.z = cvtpk(b[0], b[1]); w.w = cvtpk(b[2], b[3]); return w; }
__device__ __forceinline__ void rope8(f32x4& v0, f32x4& v1, const float* tab, int t, int pos, float sc) {
    const f32x4* cs = (const f32x4*)(tab + ((size_t)t * 32 + (pos >> 1)) * 2);
    const f32x4 c0 = cs[0], c1 = cs[1];
    f32x4 o0, o1;
    o0[0] = (v0[0] * c0[0] - v0[1] * c0[1]) * sc; o0[1] = (v0[1] * c0[0] + v0[0] * c0[1]) * sc;
    o0[2] = (v0[2] * c0[2] - v0[3] * c0[3]) * sc; o0[3] = (v0[3] * c0[2] + v0[2] * c0[3]) * sc;
    o1[0] = (v1[0] * c1[0] - v1[1] * c1[1]) * sc; o1[1] = (v1[1] * c1[0] + v1[0] * c1[1]) * sc;
    o1[2] = (v1[2] * c1[2] - v1[3] * c1[3]) * sc; o1[3] = (v1[3] * c1[2] + v1[2] * c1[3]) * sc;
    v0 = o0; v1 = o1;
}
struct EpiInProj {
    static constexpr bool KHOOK = false;
    const float* ssp; const float* bias; const float* tab;
    bf16_t *U, *Qn, *KV, *Mo, *G, *Gn;
    __device__ __forceinline__ void operator()(const f32x4 (&acc)[2][2][4][2], const Unit& u, int wr, int wc, int fr, int fq) const {
        asm volatile("" : "+v"(fr), "+v"(fq));
        const int pn = u.pn;
        f32x4 bia[2][2];
#pragma unroll
        for (int bj = 0; bj < 2; ++bj) { const int gc = pn * 256 + bj * 128 + wc * 32 + 8 * fq; bia[bj][0] = *(const f32x4*)(bias + gc); bia[bj][1] = *(const f32x4*)(bias + gc + 4); }
        float rs[2][4];
#pragma unroll
        for (int ai = 0; ai < 2; ++ai) { f32x4 ra[4];
#pragma unroll
            for (int m = 0; m < 4; ++m) ra[m] = *((const f32x4*)(ssp + (size_t)(u.pm * 256 + ai * 128 + wr * 64 + m * 16 + fr) * 16) + fq);
            __builtin_amdgcn_sched_barrier(0);
#pragma unroll
            for (int m = 0; m < 4; ++m) { float ss = (ra[m][0] + ra[m][1]) + (ra[m][2] + ra[m][3]); ss = sum_fq(ss); rs[ai][m] = 1.0f / sqrtf(ss * (1.0f / DM) + RMS_EPS); } }
#pragma unroll
        for (int ai = 0; ai < 2; ++ai)
#pragma unroll
            for (int m = 0; m < 4; ++m) {
                const int row = u.pm * 256 + ai * 128 + wr * 64 + m * 16 + fr;
                const float rstd = rs[ai][m];
                const int t = row & (SEQ - 1), b = row >> 13;
#pragma unroll
                for (int bj = 0; bj < 2; ++bj) {
                    const int cit = bj * 128 + wc * 32 + 8 * fq;
                    f32x4 v0 = acc[ai][bj][m][0] * rstd + bia[bj][0], v1 = acc[ai][bj][m][1] * rstd + bia[bj][1];
                    bf16_t* dst;
                    if (pn == 0) { dst = U + (size_t)row * 256 + cit; }
                    else if (pn <= 2) { const int c2 = (pn - 1) * 256 + cit, head = c2 >> 6, pos = c2 & 63; rope8(v0, v1, tab, t, pos, QSCALE); dst = Qn + ((size_t)(b * 8 + head) * SEQ + t) * 64 + pos; }
                    else if (pn <= 5) { const int c2 = cit & 127, g = c2 >> 6, pos = c2 & 63, kvi = 2 * (pn - 3) + bj; if (bj == 0) rope8(v0, v1, tab, t, pos, 1.f);
                        dst = KV + (size_t)kvi * ((size_t)MTOK * 128) + ((size_t)(b * 2 + g) * SEQ + t) * 64 + pos; }
                    else if (pn <= 8) { const int h = cit >> 6, pos = cit & 63; if (pn < 8) rope8(v0, v1, tab, t, pos, pn == 6 ? QSCALE : 1.f);
                        dst = Mo + (size_t)(pn - 6) * ((size_t)MTOK * 256) + ((size_t)(b * 4 + h) * SEQ + t) * 64 + pos; }
                    else if (pn <= 20) {
#pragma unroll
                        for (int e = 0; e < 4; ++e) { v0[e] = sigmoidf_(v0[e]); v1[e] = sigmoidf_(v1[e]); }
                        dst = G + (size_t)row * 3072 + (pn - 9) * 256 + cit; }
                    else {
#pragma unroll
                        for (int e = 0; e < 4; ++e) { v0[e] = sigmoidf_(v0[e]); v1[e] = sigmoidf_(v1[e]); }
                        dst = Gn + (size_t)row * 32 + (cit & 31); if (cit >= 32) dst = nullptr; }
                    if (dst) *(u32x4*)dst = pack8(v0, v1);
                }
                asm volatile("" ::: "memory");
            }
    }
};
struct EpiBranch {
    static constexpr bool KHOOK = true;
    const bf16_t* G; bf16_t* out;
    __device__ __forceinline__ void khook(f32x4 (&acc)[2][2][4][2], const Unit& u, int t, int wr, int wc, int fr, int fq) const {
        asm volatile("" : "+v"(fr), "+v"(fq));
        const int gsel = (t == 4) ? 0 : 1024;
#pragma unroll
        for (int ai = 0; ai < 2; ++ai)
#pragma unroll
            for (int m = 0; m < 4; ++m) {
                u32x4 gx[2], gy[2];
#pragma unroll
                for (int bj = 0; bj < 2; ++bj) { const int row = u.pm * 256 + ai * 128 + wr * 64 + m * 16 + fr, col = u.pn * 256 + bj * 128 + wc * 32 + 8 * fq;
                    gx[bj] = *(const u32x4*)(G + (size_t)row * 3072 + gsel + col); gy[bj] = *(const u32x4*)(G + (size_t)row * 3072 + gsel + 1024 + col); }
                __builtin_amdgcn_sched_barrier(0);
#pragma unroll
                for (int bj = 0; bj < 2; ++bj)
#pragma unroll
                    for (int e = 0; e < 4; ++e) {
                        const float x0 = fmaxf(bflo(gx[bj][e]), 1e-20f), x1 = fmaxf(bfhi(gx[bj][e]), 1e-20f), y0 = fmaxf(bflo(gy[bj][e]), 1e-20f), y1 = fmaxf(bfhi(gy[bj][e]), 1e-20f);
                        const float r0 = x0 * __builtin_amdgcn_rcpf(y0), r1 = x1 * __builtin_amdgcn_rcpf(y1);
                        acc[ai][bj][m][e >> 1][(e & 1) * 2] *= r0; acc[ai][bj][m][e >> 1][(e & 1) * 2 + 1] *= r1; }
                asm volatile("" ::: "memory");
            }
    }
    __device__ __forceinline__ void operator()(const f32x4 (&acc)[2][2][4][2], const Unit& u, int wr, int wc, int fr, int fq) const {
        asm volatile("" : "+v"(fr), "+v"(fq));
#pragma unroll
        for (int ai = 0; ai < 2; ++ai) {
            u32x4 gz[4][2];
#pragma unroll
            for (int m = 0; m < 4; ++m)
#pragma unroll
                for (int bj = 0; bj < 2; ++bj) gz[m][bj] = *(const u32x4*)(G + (size_t)(u.pm * 256 + ai * 128 + wr * 64 + m * 16 + fr) * 3072 + 2048 + u.pn * 256 + bj * 128 + wc * 32 + 8 * fq);
            __builtin_amdgcn_sched_barrier(0);
#pragma unroll
            for (int m = 0; m < 4; ++m) {
                const int row = u.pm * 256 + ai * 128 + wr * 64 + m * 16 + fr;
#pragma unroll
                for (int bj = 0; bj < 2; ++bj) {
                    const int col = u.pn * 256 + bj * 128 + wc * 32 + 8 * fq; const u32x4 g = gz[m][bj];
                    f32x4 v0 = acc[ai][bj][m][0], v1 = acc[ai][bj][m][1];
                    v0[0] *= fmaxf(bflo(g[0]), 1e-20f); v0[1] *= fmaxf(bfhi(g[0]), 1e-20f); v0[2] *= fmaxf(bflo(g[1]), 1e-20f); v0[3] *= fmaxf(bfhi(g[1]), 1e-20f);
                    v1[0] *= fmaxf(bflo(g[2]), 1e-20f); v1[1] *= fmaxf(bfhi(g[2]), 1e-20f); v1[2] *= fmaxf(bflo(g[3]), 1e-20f); v1[3] *= fmaxf(bfhi(g[3]), 1e-20f);
                    *(u32x4*)(out + (size_t)row * DM + col) = pack8(v0, v1);
                }
            }
            asm volatile("" ::: "memory");
        }
    }
};
struct EpiResid {
    static constexpr bool KHOOK = false;
    const float* base_f; const bf16_t* base_b; bf16_t* xb; bf16_t* res; float* ssp;
    __device__ __forceinline__ void operator()(const f32x4 (&acc)[2][2][4][2], const Unit& u, int wr, int wc, int fr, int fq) const {
        asm volatile("" : "+v"(fr), "+v"(fq));
#pragma unroll
        for (int ai = 0; ai < 2; ++ai)
#pragma unroll
            for (int mp = 0; mp < 2; ++mp) {
                f32x4 b0[2][2], b1[2][2];
                if (base_f) {
#pragma unroll
                    for (int mm = 0; mm < 2; ++mm)
#pragma unroll
                        for (int bj = 0; bj < 2; ++bj) { const size_t off = (size_t)(u.pm * 256 + ai * 128 + wr * 64 + (2 * mp + mm) * 16 + fr) * DM + u.pn * 256 + bj * 128 + wc * 32 + 8 * fq;
                            b0[mm][bj] = *(const f32x4*)(base_f + off); b1[mm][bj] = *(const f32x4*)(base_f + off + 4); }
                    __builtin_amdgcn_sched_barrier(0);
                } else {
                    u32x4 w[2][2];
#pragma unroll
                    for (int mm = 0; mm < 2; ++mm)
#pragma unroll
                        for (int bj = 0; bj < 2; ++bj) w[mm][bj] = *(const u32x4*)(base_b + (size_t)(u.pm * 256 + ai * 128 + wr * 64 + (2 * mp + mm) * 16 + fr) * DM + u.pn * 256 + bj * 128 + wc * 32 + 8 * fq);
                    __builtin_amdgcn_sched_barrier(0);
#pragma unroll
                    for (int mm = 0; mm < 2; ++mm)
#pragma unroll
                        for (int bj = 0; bj < 2; ++bj) { const u32x4 x = w[mm][bj]; b0[mm][bj] = (f32x4){bflo(x[0]), bfhi(x[0]), bflo(x[1]), bfhi(x[1])}; b1[mm][bj] = (f32x4){bflo(x[2]), bfhi(x[2]), bflo(x[3]), bfhi(x[3])}; }
                }
#pragma unroll
                for (int mm = 0; mm < 2; ++mm) {
                    const int m = 2 * mp + mm, row = u.pm * 256 + ai * 128 + wr * 64 + m * 16 + fr;
                    float ss = 0.f;
#pragma unroll
                    for (int bj = 0; bj < 2; ++bj) {
                        const size_t off = (size_t)row * DM + u.pn * 256 + bj * 128 + wc * 32 + 8 * fq;
                        const f32x4 v0 = acc[ai][bj][m][0] + b0[mm][bj], v1 = acc[ai][bj][m][1] + b1[mm][bj];
                        const u32x4 pk = pack8(v0, v1);
                        *(u32x4*)(xb + off) = pk;
                        if (res) *(u32x4*)(res + off) = pk;
                        ss += (v0[0] * v0[0] + v0[1] * v0[1]) + (v0[2] * v0[2] + v0[3] * v0[3]) + (v1[0] * v1[0] + v1[1] * v1[1]) + (v1[2] * v1[2] + v1[3] * v1[3]);
                    }
                    ss = sum_fq(ss);
                    if (fq == 0) ssp[(size_t)row * 16 + u.pn * 4 + wc] = ss;
                }
                asm volatile("" ::: "memory");
            }
    }
};
struct EpiSwiGLU {
    static constexpr bool KHOOK = false;
    const float* ssp; bf16_t* H;
    __device__ __forceinline__ void operator()(const f32x4 (&acc)[2][2][4][2], const Unit& u, int wr, int wc, int fr, int fq) const {
        asm volatile("" : "+v"(fr), "+v"(fq));
        float rs[2][4];
#pragma unroll
        for (int ai = 0; ai < 2; ++ai) { f32x4 ra[4];
#pragma unroll
            for (int m = 0; m < 4; ++m) ra[m] = *((const f32x4*)(ssp + (size_t)(u.pm * 256 + ai * 128 + wr * 64 + m * 16 + fr) * 16) + fq);
            __builtin_amdgcn_sched_barrier(0);
#pragma unroll
            for (int m = 0; m < 4; ++m) { float ss = (ra[m][0] + ra[m][1]) + (ra[m][2] + ra[m][3]); ss = sum_fq(ss); rs[ai][m] = 1.0f / sqrtf(ss * (1.0f / DM) + RMS_EPS); } }
#pragma unroll
        for (int ai = 0; ai < 2; ++ai)
#pragma unroll
            for (int m = 0; m < 4; ++m) {
                const int row = u.pm * 256 + ai * 128 + wr * 64 + m * 16 + fr;
                const float rstd = rs[ai][m];
                f32x4 o[2];
#pragma unroll
                for (int n = 0; n < 2; ++n)
#pragma unroll
                    for (int e = 0; e < 4; ++e) { const float gt = acc[ai][0][m][n][e] * rstd, up = acc[ai][1][m][n][e] * rstd; o[n][e] = gt * sigmoidf_(gt) * up; }
                *(u32x4*)(H + (size_t)row * DFF + u.pn * 128 + wc * 32 + 8 * fq) = pack8(o[0], o[1]);
                asm volatile("" ::: "memory");
            }
    }
};
namespace att {
constexpr int KCS = 1040, KSLOT = 8 * KCS, VSLOT = 8192;
constexpr int L_K0 = 0, L_V0 = 4 * KSLOT, L_WSF = 4 * KSLOT + 4 * VSLOT, L_MSK = L_WSF + 8 * 256, L_UNI = L_MSK + 1024, L_LIST = L_UNI + 64, L_END = L_LIST + 512,
              L_PS = L_END + 64, L_OT = L_PS, L_TOTAL = L_OT + 8 * 8192;
static_assert(L_TOTAL <= 147456 - 64, "attention LDS map");
#define LBAR() asm volatile("s_waitcnt lgkmcnt(0)\n\ts_barrier" ::: "memory")
#define LWAIT() asm volatile("s_waitcnt lgkmcnt(0)" ::: "memory")
__device__ __forceinline__ int crow(int r, int hi) { return (r & 3) + 8 * (r >> 2) + 4 * hi; }
__device__ __forceinline__ float swap_other(float v, int hi) { auto rr = __builtin_amdgcn_permlane32_swap(__float_as_uint(v), __float_as_uint(v), false, false); return __uint_as_float(hi ? rr[0] : rr[1]); }
__device__ __forceinline__ void qkt(f32x16& p0, f32x16& p1, const LAS char* Ks, const bf16x8* qr, const f32x16& cinit, int r32, int hi) {
    const LAS char* kb = Ks + hi * KCS + r32 * 16;
    bf16x8 kf[8];
#pragma unroll
    for (int d0 = 0; d0 < 4; ++d0) { kf[2 * d0] = *(const LAS bf16x8*)(kb + d0 * 2 * KCS); kf[2 * d0 + 1] = *(const LAS bf16x8*)(kb + d0 * 2 * KCS + 512); }
    __builtin_amdgcn_sched_barrier(0);
    p0 = __builtin_amdgcn_mfma_f32_32x32x16_bf16(kf[0], qr[0], cinit, 0, 0, 0); p1 = __builtin_amdgcn_mfma_f32_32x32x16_bf16(kf[1], qr[0], cinit, 0, 0, 0);
#pragma unroll
    for (int d0 = 1; d0 < 4; ++d0) { p0 = __builtin_amdgcn_mfma_f32_32x32x16_bf16(kf[2 * d0], qr[d0], p0, 0, 0, 0); p1 = __builtin_amdgcn_mfma_f32_32x32x16_bf16(kf[2 * d0 + 1], qr[d0], p1, 0, 0, 0); }
}
struct VFrag { s16x4 lo[8], hi[8]; };
typedef short v4i16_t __attribute__((ext_vector_type(4)));
__device__ __forceinline__ s16x4 vtr(const LAS char* p) { return __builtin_bit_cast(s16x4, __builtin_amdgcn_ds_read_tr16_b64_v4i16((LAS v4i16_t*)p)); }
__device__ __forceinline__ void v_issue(VFrag& F, const LAS char* vp) {
#pragma unroll
    for (int d0 = 0; d0 < 2; ++d0)
#pragma unroll
        for (int ks = 0; ks < 4; ++ks) { F.lo[d0 * 4 + ks] = vtr(vp + d0 * 4096 + ks * 1024); F.hi[d0 * 4 + ks] = vtr(vp + d0 * 4096 + ks * 1024 + 512); }
}
template <bool SUM> __device__ __forceinline__ void pv(f32x16* o, f32x16& osum, VFrag& F, bf16x8 pa0, bf16x8 pa1, bf16x8 pa2, bf16x8 pa3) {
#define PK(k) (bf16x8){F.lo[k][0], F.lo[k][1], F.lo[k][2], F.lo[k][3], F.hi[k][0], F.hi[k][1], F.hi[k][2], F.hi[k][3]}
    const bf16x8 ones = {0x3F80, 0x3F80, 0x3F80, 0x3F80, 0x3F80, 0x3F80, 0x3F80, 0x3F80};
    __builtin_amdgcn_s_setprio(1);
    o[0] = __builtin_amdgcn_mfma_f32_32x32x16_bf16(pa0, PK(0), o[0], 0, 0, 0);
    o[1] = __builtin_amdgcn_mfma_f32_32x32x16_bf16(pa0, PK(4), o[1], 0, 0, 0);
    if (SUM) osum = __builtin_amdgcn_mfma_f32_32x32x16_bf16(pa0, ones, osum, 0, 0, 0);
    o[0] = __builtin_amdgcn_mfma_f32_32x32x16_bf16(pa1, PK(1), o[0], 0, 0, 0);
    o[1] = __builtin_amdgcn_mfma_f32_32x32x16_bf16(pa1, PK(5), o[1], 0, 0, 0);
    if (SUM) osum = __builtin_amdgcn_mfma_f32_32x32x16_bf16(pa1, ones, osum, 0, 0, 0);
    o[0] = __builtin_amdgcn_mfma_f32_32x32x16_bf16(pa2, PK(2), o[0], 0, 0, 0);
    o[1] = __builtin_amdgcn_mfma_f32_32x32x16_bf16(pa2, PK(6), o[1], 0, 0, 0);
    if (SUM) osum = __builtin_amdgcn_mfma_f32_32x32x16_bf16(pa2, ones, osum, 0, 0, 0);
    o[0] = __builtin_amdgcn_mfma_f32_32x32x16_bf16(pa3, PK(3), o[0], 0, 0, 0);
    o[1] = __builtin_amdgcn_mfma_f32_32x32x16_bf16(pa3, PK(7), o[1], 0, 0, 0);
    if (SUM) osum = __builtin_amdgcn_mfma_f32_32x32x16_bf16(pa3, ones, osum, 0, 0, 0);
    __builtin_amdgcn_s_setprio(0);
#undef PK
}
__device__ __forceinline__ float rowmax(const f32x16& p0, const f32x16& p1, int hi) {
    float a = __builtin_fmaxf(p0[0], p1[0]);
#pragma unroll
    for (int r = 1; r < 16; ++r) a = __builtin_fmaxf(__builtin_fmaxf(a, p0[r]), p1[r]);
    return __builtin_fmaxf(a, swap_other(a, hi));
}
struct KVRegs { u32x4 k, v; };
__device__ __forceinline__ void tile_load(KVRegs& R, const bf16_t* K, const bf16_t* V, int tid) { R.k = *(const u32x4*)(K + tid * 8); R.v = *(const u32x4*)(V + tid * 8); }
__device__ __forceinline__ void tile_store(const KVRegs& R, LAS char* Ks, LAS char* Vs, int tid) {
    const int row = tid >> 3, c = tid & 7;
    *(LAS u32x4*)(Ks + c * KCS + row * 16) = R.k;
    *(LAS u32x4*)(Vs + (c >> 2) * 4096 + (row >> 4) * 1024 + (row & 15) * 64 + (c & 3) * 16) = R.v;
}
__device__ __forceinline__ void ps_accum(const f32x16 p, int jb, LAS float* ps_row, bool writer) {
#pragma unroll
    for (int rg = 0; rg < 4; ++rg) {
        float a = 2.f * (p[4 * rg] + p[4 * rg + 1] + p[4 * rg + 2]) + p[4 * rg + 3], bq = p[4 * rg + 3];
        a += __builtin_bit_cast(float, __builtin_amdgcn_update_dpp(0, __builtin_bit_cast(int, a), 0xB1, 0xF, 0xF, true)); a += __builtin_bit_cast(float, __builtin_amdgcn_update_dpp(0, __builtin_bit_cast(int, a), 0x4E, 0xF, 0xF, true));
        bq += __builtin_bit_cast(float, __builtin_amdgcn_update_dpp(0, __builtin_bit_cast(int, bq), 0xB1, 0xF, 0xF, true)); bq += __builtin_bit_cast(float, __builtin_amdgcn_update_dpp(0, __builtin_bit_cast(int, bq), 0x4E, 0xF, 0xF, true));
        const int j = jb + 2 * rg;
        if (writer) { __hip_atomic_fetch_add(ps_row + j, a, __ATOMIC_RELAXED, __HIP_MEMORY_SCOPE_WORKGROUP); if (j + 1 < 128) __hip_atomic_fetch_add(ps_row + j + 1, bq, __ATOMIC_RELAXED, __HIP_MEMORY_SCOPE_WORKGROUP); }
    }
}
struct Ctx { LAS char* lds; LAS float* wsf; LAS float* otl; int tid, wid, lane, r32, hi, vbl; };
struct RowSt { float m, l; bool started; f32x16 negm, osum; };
__device__ __forceinline__ void rowst_init(RowSt& S) { S.m = 0.f; S.l = 0.f; S.started = false; S.negm = f32x16{}; S.osum = f32x16{}; asm volatile("" : "+v"(S.negm)); }
__device__ __forceinline__ void rowst_fixed(RowSt& S, float ref) { S.m = ref; S.l = 0.f; S.started = true; S.osum = f32x16{};
#pragma unroll
    for (int r = 0; r < 16; ++r) S.negm[r] = -ref;
    asm volatile("" : "+v"(S.negm)); }
template <int MODE, class Idx, class Src, class Msk>
__device__ __forceinline__ void run_branch(const Ctx& C, int nt, const Idx& idx, const Src& src, const Msk& msk, const bf16x8* qr, RowSt& S, f32x16* o, LAS float* ps_row, bool ps_writer, KVRegs& R0, bool pre, const bf16_t* nk, const bf16_t* nv) {
    KVRegs R1; const bf16_t *kp, *vp;
    int dA = idx(0), dB = nt > 1 ? idx(1) : 0, dC = 0, dD = 0;
    if (!pre) { src(0, dA, kp, vp); tile_load(R0, kp, vp, C.tid); }
    if (nt > 1) { src(1, dB, kp, vp); tile_load(R1, kp, vp, C.tid); }
    auto compute = [&](int it, const LAS char* Ks, const LAS char* Vs, int klo, int khi, bool nm) {
        const bool kill = khi < klo;
        if (!__any(!kill)) return;
        f32x16 p0, p1; qkt(p0, p1, Ks, qr, S.negm, C.r32, C.hi);
        VFrag VF; if constexpr (MODE != 0) { v_issue(VF, Vs + C.vbl); __builtin_amdgcn_sched_barrier(0); }
        if (__any(nm && !kill)) {
#pragma unroll
            for (int r = 0; r < 16; ++r) { const int kv = crow(r, C.hi); if (kv < klo || kv > khi) p0[r] = -INFINITY; if (kv + 32 < klo || kv + 32 > khi) p1[r] = -INFINITY; }
        }
        if constexpr (MODE != 2) {
            float rm = rowmax(p0, p1, C.hi); if (kill) rm = -INFINITY;
            const bool first = !S.started && rm > -INFINITY, grow = first || rm > 8.0f;
            if (__any(grow)) {
                const float d = grow ? rm : 0.f, alpha = first ? 1.0f : __builtin_amdgcn_exp2f(-d);
                S.m += d; S.started = S.started || first;
#pragma unroll
                for (int r = 0; r < 16; ++r) { S.negm[r] = -S.m; p0[r] -= d; p1[r] -= d; }
                if constexpr (MODE == 0) S.l *= alpha;
                if constexpr (MODE == 1) {
                    if (C.hi == 0) C.wsf[C.r32] = alpha;
                    LWAIT();
#pragma unroll
                    for (int r = 0; r < 16; ++r) { const float f = C.wsf[crow(r, C.hi)]; o[0][r] *= f; o[1][r] *= f; S.osum[r] *= f; }
                    LWAIT();
                }
            }
        }
#pragma unroll
        for (int r = 0; r < 16; ++r) { p0[r] = __builtin_amdgcn_exp2f(p0[r]); p1[r] = __builtin_amdgcn_exp2f(p1[r]); }
        if constexpr (MODE == 0) {
            float s = 0.f;
#pragma unroll
            for (int r = 0; r < 16; ++r) s += p0[r] + p1[r];
            S.l += kill ? 0.f : s;
        }
        if constexpr (MODE == 2) {
            if (__any(kill)) {
#pragma unroll
                for (int r = 0; r < 16; ++r) { p0[r] = kill ? 0.f : p0[r]; p1[r] = kill ? 0.f : p1[r]; }
            }
            ps_accum(p0, 16 * it + C.hi, ps_row, ps_writer); ps_accum(p1, 16 * it + 8 + C.hi, ps_row, ps_writer);
        }
        if constexpr (MODE != 0) {
            u32x4 w0 = {cvtpk(p0[0], p0[1]), cvtpk(p0[2], p0[3]), cvtpk(p0[4], p0[5]), cvtpk(p0[6], p0[7])}, w1 = {cvtpk(p0[8], p0[9]), cvtpk(p0[10], p0[11]), cvtpk(p0[12], p0[13]), cvtpk(p0[14], p0[15])};
            u32x4 w2 = {cvtpk(p1[0], p1[1]), cvtpk(p1[2], p1[3]), cvtpk(p1[4], p1[5]), cvtpk(p1[6], p1[7])}, w3 = {cvtpk(p1[8], p1[9]), cvtpk(p1[10], p1[11]), cvtpk(p1[12], p1[13]), cvtpk(p1[14], p1[15])};
            if constexpr (MODE == 1) {
                if (__any(kill)) {
#pragma unroll
                    for (int e = 0; e < 4; ++e) { w0[e] = kill ? 0u : w0[e]; w1[e] = kill ? 0u : w1[e]; w2[e] = kill ? 0u : w2[e]; w3[e] = kill ? 0u : w3[e]; }
                }
            }
            pv<MODE == 1>(o, S.osum, VF, __builtin_bit_cast(bf16x8, w0), __builtin_bit_cast(bf16x8, w1), __builtin_bit_cast(bf16x8, w2), __builtin_bit_cast(bf16x8, w3));
        }
    };
    LBAR();
    for (int it = 0; it < nt; it += 2) {
        const int p = (it >> 1) & 1; const bool two = it + 1 < nt;
        LAS char* KsA = C.lds + L_K0 + (2 * p) * KSLOT; LAS char* VsA = C.lds + L_V0 + (2 * p) * VSLOT;
        LAS char* KsB = KsA + KSLOT; LAS char* VsB = VsA + VSLOT;
        tile_store(R0, KsA, VsA, C.tid); if (two) tile_store(R1, KsB, VsB, C.tid);
        if (it + 2 < nt) dC = idx(it + 2);
        if (it + 3 < nt) dD = idx(it + 3);
        int kloA, khiA, kloB = 0, khiB = -1; const bool nmA = msk(it, dA, kloA, khiA); bool nmB = false; if (two) nmB = msk(it + 1, dB, kloB, khiB);
        if (it + 2 < nt) { src(it + 2, dC, kp, vp); tile_load(R0, kp, vp, C.tid); } else if (nk) tile_load(R0, nk, nv, C.tid);
        if (it + 3 < nt) { src(it + 3, dD, kp, vp); tile_load(R1, kp, vp, C.tid); }
        LBAR();
        compute(it, KsA, VsA, kloA, khiA, nmA);
        if (two) compute(it + 1, KsB, VsB, kloB, khiB, nmB);
        dA = dC; dB = dD;
    }
}
template <bool FIRST> __device__ __forceinline__ void merge_branch_n(const Ctx& C, const f32x16* o, const f32x16& osum, float gate) {
    if (C.hi == 0) C.wsf[C.r32] = gate;
    LWAIT();
#pragma unroll
    for (int r0 = 0; r0 < 16; r0 += 8) {
        float gf[8], t0[8], t1[8];
#pragma unroll
        for (int r = 0; r < 8; ++r) { gf[r] = C.wsf[crow(r0 + r, C.hi)]; t0[r] = FIRST ? 0.f : C.otl[(r0 + r) * 64]; t1[r] = FIRST ? 0.f : C.otl[(16 + r0 + r) * 64]; }
        __builtin_amdgcn_sched_barrier(0);
#pragma unroll
        for (int r = 0; r < 8; ++r) { const float den = osum[r0 + r], f = den > 0.f ? gf[r] * __builtin_amdgcn_rcpf(den) : 0.f;
            C.otl[(r0 + r) * 64] = t0[r] + o[0][r0 + r] * f; C.otl[(16 + r0 + r) * 64] = t1[r] + o[1][r0 + r] * f; } }
    LWAIT();
}
template <bool FIRST> __device__ __forceinline__ void merge_branch(const Ctx& C, const f32x16* o, float factor) {
    if (C.hi == 0) C.wsf[C.r32] = factor;
    LWAIT();
#pragma unroll
    for (int r0 = 0; r0 < 16; r0 += 8) {
        float gf[8], t0[8], t1[8];
#pragma unroll
        for (int r = 0; r < 8; ++r) { gf[r] = C.wsf[crow(r0 + r, C.hi)]; t0[r] = FIRST ? 0.f : C.otl[(r0 + r) * 64]; t1[r] = FIRST ? 0.f : C.otl[(16 + r0 + r) * 64]; }
        __builtin_amdgcn_sched_barrier(0);
#pragma unroll
        for (int r = 0; r < 8; ++r) { C.otl[(r0 + r) * 64] = t0[r] + o[0][r0 + r] * gf[r]; C.otl[(16 + r0 + r) * 64] = t1[r] + o[1][r0 + r] * gf[r]; } }
    LWAIT();
}
struct Bufs { const bf16_t *Qn, *KV, *Mo, *KC, *KM, *Gn; bf16_t* Abr; };
constexpr size_t KV_STRIDE = (size_t)MTOK * 128, MO_STRIDE = (size_t)MTOK * 256;

__device__ __forceinline__ void nsa_item(const Ctx& C, const Bufs& B, int b, int g, int i) {
    const int r32 = C.r32, hi = C.hi, wid = C.wid;
    const int qi = 8 * wid + (r32 >> 2), hh = r32 & 3, head = g * 4 + hh, t = 64 * i + qi, cur = i;
    const size_t bg = (size_t)(b * 2 + g) * SEQ;
    bf16x8 qr[4];
    { const bf16_t* qp = B.Qn + ((size_t)(b * 8 + head) * SEQ + t) * 64 + hi * 8;
#pragma unroll
      for (int d0 = 0; d0 < 4; ++d0) qr[d0] = *(const bf16x8*)(qp + d0 * 16); }
    const unsigned gw = *(const unsigned*)(B.Gn + ((size_t)b * SEQ + t) * 32 + head * 3 - (head & 1));
    const unsigned gw2 = *(const unsigned*)(B.Gn + ((size_t)b * SEQ + t) * 32 + head * 3 - (head & 1) + 2);
    float g0, g1, g2; if (head & 1) { g0 = bfhi(gw); g1 = bflo(gw2); g2 = bfhi(gw2); } else { g0 = bflo(gw); g1 = bfhi(gw); g2 = bflo(gw2); }
    f32x16 o[2];
    LAS float* Ps = (LAS float*)(C.lds + L_PS); LAS unsigned* Mk = (LAS unsigned*)(C.lds + L_MSK); LAS unsigned* Uni = (LAS unsigned*)(C.lds + L_UNI); LAS int* List = (LAS int*)(C.lds + L_LIST);
    const int nv = t >= 31 ? ((t - 31) >> 4) + 1 : 0;
    const int nvt = (4 * i + 3 < 511) ? 4 * i + 3 : 511, ntc = (nvt + 63) >> 6;
    const bf16_t* kc = B.KC + (size_t)(0 * 4 + b * 2 + g) * 512 * 64; const bf16_t* vc = B.KC + (size_t)(1 * 4 + b * 2 + g) * 512 * 64;
    auto idxI = [&](int it) { return it; };
    auto srcC = [&](int it, int, const bf16_t*& kp, const bf16_t*& vp) { kp = kc + (size_t)it * 4096; vp = vc + (size_t)it * 4096; };
    auto mskC = [&](int it, int, int& klo, int& khi) { klo = 0; khi = nv - 1 - 64 * it; return khi < 63; };
    RowSt S; rowst_init(S);
    KVRegs R;
    run_branch<0>(C, ntc, idxI, srcC, mskC, qr, S, o, nullptr, false, R, false, kc, vc);
    const float lt = S.l + swap_other(S.l, hi);
    rowst_fixed(S, lt > 0.f ? S.m + __builtin_amdgcn_logf(lt) : 0.f);
    for (int e = C.tid; e < 64 * 128; e += 512) Ps[e] = 0.f;
    if (C.tid < 8) Uni[C.tid] = 0u;
    o[0] = f32x16{}; o[1] = f32x16{};
    run_branch<2>(C, ntc, idxI, srcC, mskC, qr, S, o, Ps + qi * 128, hh == 0, R, true, B.KV + 2 * KV_STRIDE + bg * 64, B.KV + 3 * KV_STRIDE + bg * 64);
    LBAR();
    {
        const int nf = cur == 0 ? 1 : (cur == 1 ? 2 : 3), kp_ = 16 - nf, lane = C.lane;
#pragma unroll 1
        for (int qq = 0; qq < 8; ++qq) {
            int q = 8 * wid + qq; asm volatile("" : "+s"(q)); LAS float* ps = Ps + q * 128;
            const int j0 = lane, j1 = lane + 64;
            const bool f0 = (j0 == 0 || j0 == cur || j0 == cur - 1) && j0 <= cur, f1 = (j1 == cur || j1 == cur - 1) && j1 <= cur;
            const bool va0 = j0 <= cur && !f0, va1 = j1 <= cur && !f1;
            const unsigned k0 = va0 ? __float_as_uint(ps[j0]) + 1u : 0u, k1 = va1 ? __float_as_uint(ps[j1]) + 1u : 0u;
            unsigned T = 0u;
            for (int bit = 30; bit >= 0; --bit) { const unsigned cand = T | (1u << bit); const int cnt = __popcll(__ballot(k0 >= cand)) + __popcll(__ballot(k1 >= cand)); if (cnt >= kp_) T = cand; }
            const int need = kp_ - (__popcll(__ballot(k0 > T)) + __popcll(__ballot(k1 > T)));
            const unsigned long long t0 = __ballot(k0 == T), t1 = __ballot(k1 == T), below = (1ull << lane) - 1ull;
            const int pre0 = __popcll(t0 & below), pre1 = __popcll(t0) + __popcll(t1 & below);
            const bool s0 = f0 || (k0 > 0u && (k0 > T || (k0 == T && pre0 < need))), s1 = f1 || (k1 > 0u && (k1 > T || (k1 == T && pre1 < need)));
            const unsigned long long b0 = __ballot(s0), b1 = __ballot(s1);
            if (lane == 0) { Mk[q * 4 + 0] = (unsigned)b0; Mk[q * 4 + 1] = (unsigned)(b0 >> 32); Mk[q * 4 + 2] = (unsigned)b1; Mk[q * 4 + 3] = (unsigned)(b1 >> 32);
                __hip_atomic_fetch_or(&Uni[0], (unsigned)b0, __ATOMIC_RELAXED, __HIP_MEMORY_SCOPE_WORKGROUP); __hip_atomic_fetch_or(&Uni[1], (unsigned)(b0 >> 32), __ATOMIC_RELAXED, __HIP_MEMORY_SCOPE_WORKGROUP); __hip_atomic_fetch_or(&Uni[2], (unsigned)b1, __ATOMIC_RELAXED, __HIP_MEMORY_SCOPE_WORKGROUP); __hip_atomic_fetch_or(&Uni[3], (unsigned)(b1 >> 32), __ATOMIC_RELAXED, __HIP_MEMORY_SCOPE_WORKGROUP); }
        }
    }
    LBAR();
    if (C.tid < 128) {
        const int wi = C.tid >> 5, bi = C.tid & 31; const unsigned u0 = Uni[0], u1 = Uni[1], u2 = Uni[2], u3 = Uni[3];
        const unsigned mine = wi == 0 ? u0 : wi == 1 ? u1 : wi == 2 ? u2 : u3;
        const int before = (wi > 0 ? __popc(u0) : 0) + (wi > 1 ? __popc(u1) : 0) + (wi > 2 ? __popc(u2) : 0) + __popc(mine & ((1u << bi) - 1u));
        if ((mine >> bi) & 1u) List[before] = C.tid;
        if (C.tid == 0) Uni[4] = (unsigned)(__popc(u0) + __popc(u1) + __popc(u2) + __popc(u3));
    }
    LBAR();
    merge_branch<true>(C, o, g0);
    {
        const int nsel = (int)Uni[4];
        const bf16_t* ks = B.KV + 2 * KV_STRIDE + bg * 64; const bf16_t* vs = B.KV + 3 * KV_STRIDE + bg * 64;
        auto idxS = [&](int it) { return List[it]; };
        auto srcS = [&](int, int j, const bf16_t*& kp, const bf16_t*& vp) { kp = ks + (size_t)j * 4096; vp = vs + (size_t)j * 4096; };
        auto mskS = [&](int, int j, int& klo, int& khi) { const unsigned w = Mk[qi * 4 + (j >> 5)]; const bool bit = (w >> (j & 31)) & 1u;
            klo = 0; khi = bit ? (j == cur ? qi : 63) : -1; return j == cur; };
        rowst_init(S); o[0] = f32x16{}; o[1] = f32x16{};
        const int tw0n = i >= 8 ? i - 8 : 0;
        run_branch<1>(C, nsel, idxS, srcS, mskS, qr, S, o, nullptr, false, R, true, B.KV + 4 * KV_STRIDE + bg * 64 + (size_t)tw0n * 4096, B.KV + 5 * KV_STRIDE + bg * 64 + (size_t)tw0n * 4096);
        merge_branch_n<false>(C, o, S.osum, g1);
    }
    {
        const int tw0 = i >= 8 ? i - 8 : 0, ntw = i - tw0 + 1;
        const bf16_t* kw = B.KV + 4 * KV_STRIDE + bg * 64; const bf16_t* vw = B.KV + 5 * KV_STRIDE + bg * 64;
        auto srcW = [&](int it, int, const bf16_t*& kp, const bf16_t*& vp) { kp = kw + (size_t)(tw0 + it) * 4096; vp = vw + (size_t)(tw0 + it) * 4096; };
        auto mskW = [&](int it, int, int& klo, int& khi) { const int tw = tw0 + it; klo = (t - 511) - 64 * tw; khi = (tw == i) ? qi : 63; return tw == i || klo > 0; };
        rowst_init(S); o[0] = f32x16{}; o[1] = f32x16{};
        run_branch<1>(C, ntw, idxI, srcW, mskW, qr, S, o, nullptr, false, R, true, nullptr, nullptr);
        merge_branch_n<false>(C, o, S.osum, g2);
    }
#pragma unroll
    for (int r0 = 0; r0 < 16; r0 += 8) { float t0[8], t1[8];
#pragma unroll
        for (int r = 0; r < 8; ++r) { t0[r] = C.otl[(r0 + r) * 64]; t1[r] = C.otl[(16 + r0 + r) * 64]; }
        __builtin_amdgcn_sched_barrier(0);
#pragma unroll
        for (int r = 0; r < 8; ++r) { const int qrow = crow(r0 + r, hi); bf16_t* dst = B.Abr + ((size_t)b * SEQ + 64 * i + 8 * wid + (qrow >> 2)) * DM + 256 + (g * 4 + (qrow & 3)) * 64 + r32;
            dst[0] = (bf16_t)(cvtpk(t0[r], 0.f) & 0xffffu); dst[32] = (bf16_t)(cvtpk(t1[r], 0.f) & 0xffffu); } }
}
__device__ __forceinline__ void moba_item(const Ctx& C, const Bufs& B, int b, int h, int qb) {
    const int r32 = C.r32, hi = C.hi, wid = C.wid, own = qb, t = 256 * qb + 32 * wid + r32;
    const size_t bh = (size_t)(b * 4 + h) * SEQ;
    bf16x8 qr[4];
    { const bf16_t* qp = B.Mo + (bh + t) * 64 + hi * 8;
#pragma unroll
      for (int d0 = 0; d0 < 4; ++d0) qr[d0] = *(const bf16x8*)(qp + d0 * 16); }
    LAS unsigned* Uni = (LAS unsigned*)(C.lds + L_UNI); LAS int* List = (LAS int*)(C.lds + L_LIST);
    LBAR();
    if (C.tid < 256) { const u32x4 kmv = *(const u32x4*)(B.KM + (size_t)(b * 4 + h) * 2048 + C.tid * 8); *(LAS u32x4*)(C.lds + L_K0 + (C.tid & 7) * KCS + (C.tid >> 3) * 16) = kmv; }
    if (C.tid == 0) Uni[0] = 0u;
    LBAR();
    unsigned sel = 0u;
    {
        f32x16 gs = f32x16{};
        const LAS char* kb = C.lds + L_K0 + hi * KCS + r32 * 16;
#pragma unroll
        for (int d0 = 0; d0 < 4; ++d0) gs = __builtin_amdgcn_mfma_f32_32x32x16_bf16(*(const LAS bf16x8*)(kb + d0 * 2 * KCS), qr[d0], gs, 0, 0, 0);
        float lo[16], hv[16];
#pragma unroll
        for (int r = 0; r < 16; ++r) { const float ownv = gs[r], oth = swap_other(ownv, hi); lo[r] = hi ? oth : ownv; hv[r] = hi ? ownv : oth; }
        unsigned taken = ~((1u << own) - 1u);
#pragma unroll
        for (int round = 0; round < 3; ++round) {
            float best = -INFINITY; int bi = 32;
#pragma unroll
            for (int n = 0; n < 32; ++n) { const int rr = (n & 3) + 4 * (n >> 3); const float v = ((n >> 2) & 1) ? hv[rr] : lo[rr]; if (!((taken >> n) & 1u) && v > best) { best = v; bi = n; } }
            if (bi < 32) { sel |= 1u << bi; taken |= 1u << bi; }
        }
    }
    { unsigned u = sel;
#pragma unroll
      for (int o_ = 1; o_ < 64; o_ <<= 1) u |= (unsigned)__shfl_xor((int)u, o_);
      if (C.lane == 0) __hip_atomic_fetch_or(&Uni[0], u, __ATOMIC_RELAXED, __HIP_MEMORY_SCOPE_WORKGROUP); }
    LBAR();
    if (C.tid == 0) { int n = 0; unsigned u = Uni[0]; while (u) { const int bpos = __builtin_ctz(u); u &= u - 1; List[n++] = bpos; } Uni[4] = (unsigned)n; }
    LBAR();
    const int nl = (int)Uni[4], nt = 4 * nl + 4;
    const bf16_t* kk = B.Mo + MO_STRIDE + bh * 64; const bf16_t* vv = B.Mo + 2 * MO_STRIDE + bh * 64;
    auto idxM = [&](int it) { return (it < 4 * nl) ? List[it >> 2] : own; };
    auto src = [&](int it, int blk, const bf16_t*& kp, const bf16_t*& vp) { const int T = 4 * blk + ((it < 4 * nl) ? (it & 3) : (it - 4 * nl)); kp = kk + (size_t)T * 4096; vp = vv + (size_t)T * 4096; };
    auto msk = [&](int it, int blk, int& klo, int& khi) { klo = 0; if (it < 4 * nl) { const bool bit = (sel >> blk) & 1u; khi = bit ? 63 : -1; return false; } khi = 32 * wid + r32 - 64 * (it - 4 * nl); return true; };
    RowSt S; rowst_init(S); f32x16 o[2] = {f32x16{}, f32x16{}};
    KVRegs R;
    run_branch<1>(C, nt, idxM, src, msk, qr, S, o, nullptr, false, R, false, nullptr, nullptr);
    merge_branch_n<true>(C, o, S.osum, 1.0f);
#pragma unroll
    for (int r0 = 0; r0 < 16; r0 += 8) { float t0[8], t1[8];
#pragma unroll
        for (int r = 0; r < 8; ++r) { t0[r] = C.otl[(r0 + r) * 64]; t1[r] = C.otl[(16 + r0 + r) * 64]; }
        __builtin_amdgcn_sched_barrier(0);
#pragma unroll
        for (int r = 0; r < 8; ++r) { const int qrow = crow(r0 + r, hi); bf16_t* dst = B.Abr + ((size_t)b * SEQ + 256 * qb + 32 * wid + qrow) * DM + 768 + h * 64 + r32;
            dst[0] = (bf16_t)(cvtpk(t0[r], 0.f) & 0xffffu); dst[32] = (bf16_t)(cvtpk(t1[r], 0.f) & 0xffffu); } }
}
}
#define XB_TMO      128
#define XB_XCNT(j)  (256  + 64 * (j))
#define XB_XSUB(j)  (1280 + 64 * (j))
#define XB_XGEN(j)  (2304 + 64 * (j))
#define XB_TOP      3328
#define XB_TOPGEN   3392
#define XCD_BAR_WORDS 3456
#define XB_SPIN_CAP (1u << 18)

__device__ __forceinline__ unsigned xb_ld(unsigned* p)              { return __hip_atomic_load(p, __ATOMIC_RELAXED, __HIP_MEMORY_SCOPE_AGENT); }
__device__ __forceinline__ unsigned xb_add(unsigned* p, unsigned v) { return __hip_atomic_fetch_add(p, v, __ATOMIC_RELAXED, __HIP_MEMORY_SCOPE_AGENT); }
__device__ __forceinline__ unsigned xb_xcc_id() { return (unsigned)__builtin_amdgcn_s_getreg((3 << 11) | 20) & 0xFu; }
#define XB_SPIN(cond, bar) do { unsigned _sp = 0; while (cond) { __builtin_amdgcn_s_sleep(1); \
    if ((++_sp & 255u) == 0u) { if (xb_ld(&(bar)[XB_TMO])) break; if (_sp > XB_SPIN_CAP) { atomicAdd(&(bar)[XB_TMO], 1u); break; } } } } while (0)

struct XcdBarrier {
    unsigned* bar; unsigned x;
    volatile LAS unsigned* st;
};

__device__ __forceinline__ XcdBarrier xcd_barrier_post(unsigned* bar, volatile LAS unsigned* st) {
    XcdBarrier b; b.bar = bar; b.x = xb_xcc_id(); b.st = st;
    if (threadIdx.x == 0) (void)xb_add(&bar[XB_XCNT(b.x)], 1u);
    return b;
}
__device__ __forceinline__ void xcd_barrier_complete(unsigned* bar, unsigned x, unsigned& nloc, unsigned& nx) {
    const unsigned G = gridDim.x * gridDim.y * gridDim.z;
    unsigned sum, cnt, mine, sp = 0u;
    for (;;) {
        sum = 0u; cnt = 0u; mine = 0u;
#pragma unroll
        for (unsigned j = 0; j < 16; ++j) { const unsigned c = xb_ld(&bar[XB_XCNT(j)]); sum += c; cnt += (c > 0u) ? 1u : 0u; mine = (j == x) ? c : mine; }
        if (sum == G) break;
        __builtin_amdgcn_s_sleep(1);
        if ((++sp & 255u) == 0u) { if (xb_ld(&bar[XB_TMO])) break; if (sp > XB_SPIN_CAP) { atomicAdd(&bar[XB_TMO], 1u); break; } }
    }
    nloc = mine > 0u ? mine : 1u; nx = cnt > 0u ? cnt : 1u;
}

__device__ __forceinline__ void xcd_barrier(const XcdBarrier& b) {
    asm volatile("s_waitcnt vmcnt(0)" ::: "memory");
    __syncthreads();
    if (threadIdx.x == 0) {
        unsigned* bar = b.bar;
        __builtin_amdgcn_s_waitcnt(0);
        unsigned nloc = b.st[0], nx = b.st[1];
        if (nloc == 0u) { xcd_barrier_complete(bar, b.x, nloc, nx); b.st[0] = nloc; b.st[1] = nx; }
        const unsigned old = xb_add(&bar[XB_XSUB(b.x)], 1u);
        const unsigned gen = old / nloc;
        if (old + 1u == (gen + 1u) * nloc) {
            __builtin_amdgcn_fence(__ATOMIC_RELEASE, "agent");
            asm volatile("s_waitcnt vmcnt(0)" ::: "memory");
            const unsigned og = xb_add(&bar[XB_TOP], 1u);
            const unsigned tg = og / nx;
            if (og + 1u == (tg + 1u) * nx) xb_add(&bar[XB_TOPGEN], 1u);
            else XB_SPIN(xb_ld(&bar[XB_TOPGEN]) == tg, bar);
            __builtin_amdgcn_fence(__ATOMIC_ACQUIRE, "agent");
            xb_add(&bar[XB_XGEN(b.x)], 1u);
            asm volatile("s_waitcnt vmcnt(0)" ::: "memory");
        } else {
            XB_SPIN(xb_ld(&bar[XB_XGEN(b.x)]) == gen, bar);
            __builtin_amdgcn_fence(__ATOMIC_ACQUIRE, "agent");
            asm volatile("s_waitcnt vmcnt(0)" ::: "memory");
        }
    }
    __syncthreads();
}

constexpr size_t MiB = 1u << 20;
constexpr size_t WS_CTL = 0, WS_ORDER = 4096, WS_BAR = 8192;
constexpr size_t WS_W = 1 * MiB, OFF_WIN = 0, OFF_WGU = 11 * MiB, OFF_WD = 22 * MiB, OFF_WBR = 28 * MiB, OFF_WOUT = 30 * MiB, OFF_W1 = 32 * MiB, OFF_W2 = 34 * MiB,
                 OFF_BIN = 34 * MiB + 65536, OFF_CB1 = OFF_BIN + 32768  , OFF_CB2 = OFF_CB1 + 65536;
constexpr size_t WS_TAB = 36 * MiB, WS_SSP = 38 * MiB, WS_KC = 39 * MiB, WS_KM = 39 * MiB + 512 * 1024, WS_GN = 40 * MiB, WS_XB = 42 * MiB, WS_BIG = 74 * MiB,
                 WS_U = 170 * MiB, WS_QN = 178 * MiB, WS_KV = 194 * MiB, WS_MO = 218 * MiB, WS_MRG = 178 * MiB, WS_END = 242 * MiB;
constexpr int LDS_BYTES = 147456;

__device__ __forceinline__ int dint(int pos) { return (pos >> 1) + 32 * (pos & 1); }
__device__ __forceinline__ int in_orig(int c) {
    if (c < 256) return c;
    if (c < 768) { const int c2 = c - 256; return 256 + (c2 >> 6) * 64 + dint(c2 & 63); }
    if (c < 1536) { const int c2 = c - 768, tt = c2 >> 8, bj = (c2 >> 7) & 1, g = (c2 >> 6) & 1, pos = c2 & 63; return 768 + (2 * tt + bj) * 128 + g * 64 + (bj == 0 ? dint(pos) : pos); }
    if (c < 2304) { const int c2 = c - 1536, part = c2 >> 8, h = (c2 >> 6) & 3, pos = c2 & 63; return 1560 + part * 256 + h * 64 + (part < 2 ? dint(pos) : pos); }
    if (c < 5376) return 2328 + (c - 2304);
    const int c2 = c - 5376; return c2 < 24 ? 1536 + c2 : -1;
}
template <class F> __device__ __forceinline__ void cvt_tile(LAS float* scr, int lane, int k0, int n0, bf16_t* dst, size_t pitch, F f) {
    float vals[32];
#pragma unroll
    for (int i = 0; i < 32; ++i) vals[i] = f(k0 + 2 * i + (lane >> 5), n0 + (lane & 31));
#pragma unroll
    for (int i = 0; i < 32; ++i) scr[(2 * i + (lane >> 5)) * 33 + (lane & 31)] = vals[i];
    asm volatile("s_waitcnt lgkmcnt(0)" ::: "memory");
    const int c = lane & 7;
#pragma unroll
    for (int j = 0; j < 4; ++j) { const int n = (lane >> 3) + 8 * j; const LAS float* s = scr + (8 * c) * 33 + n;
        u32x4 o; o.x = cvtpk(s[0 * 33], s[1 * 33]); o.y = cvtpk(s[2 * 33], s[3 * 33]); o.z = cvtpk(s[4 * 33], s[5 * 33]); o.w = cvtpk(s[6 * 33], s[7 * 33]);
        *(u32x4*)(dst + (size_t)(n0 + n) * pitch + k0 + 8 * c) = o; }
    asm volatile("s_waitcnt lgkmcnt(0)" ::: "memory");
}
template <class F> __device__ __forceinline__ void cvt_tile_scaled(LAS float* scr, int lane, int k0, int n0, bf16_t* dst, size_t pitch, F f, const float* scale, float keep) {
    float vals[32], sc[32];
#pragma unroll
    for (int i = 0; i < 32; ++i) { vals[i] = f(k0 + 2 * i + (lane >> 5), n0 + (lane & 31)); sc[i] = scale[k0 + 2 * i + (lane >> 5)]; }
    __builtin_amdgcn_sched_barrier(0);
#pragma unroll
    for (int i = 0; i < 32; ++i) scr[(2 * i + (lane >> 5)) * 33 + (lane & 31)] = vals[i] * (sc[i] * keep);
    asm volatile("s_waitcnt lgkmcnt(0)" ::: "memory");
    const int c = lane & 7;
#pragma unroll
    for (int j = 0; j < 4; ++j) { const int n = (lane >> 3) + 8 * j; const LAS float* s = scr + (8 * c) * 33 + n;
        u32x4 o; o.x = cvtpk(s[0 * 33], s[1 * 33]); o.y = cvtpk(s[2 * 33], s[3 * 33]); o.z = cvtpk(s[4 * 33], s[5 * 33]); o.w = cvtpk(s[6 * 33], s[7 * 33]);
        *(u32x4*)(dst + (size_t)(n0 + n) * pitch + k0 + 8 * c) = o; }
    asm volatile("s_waitcnt lgkmcnt(0)" ::: "memory");
}
struct Args { const float* in[20]; float* out; unsigned char* ws; };
typedef const __attribute__((address_space(4))) Args* ArgsP;

__device__ __forceinline__ void phase0(ArgsP a, int l, LAS unsigned char* lds, int tid, int lane, int wave, int gw, int NGW) {
    unsigned char* ws = a->ws;
    LAS float* scr = (LAS float*)(lds + wave * 8704);
    const float* attn_norm = a->in[1] + (size_t)l * DM; const float* w_in = a->in[2] + (size_t)l * DM * IN_COLS; const float* b_in = a->in[3] + (size_t)l * IN_COLS;
    const float* pool_w = a->in[4] + (size_t)l * 4 * 64 * 64; const float* pool_scale = a->in[5] + (size_t)l * 256; const float* cmp_pos = a->in[6] + (size_t)l * 2 * 32 * 64;
    const float* cmp_w1 = a->in[7] + (size_t)l * 2 * 2048 * 256; const float* cmp_b1 = a->in[8] + (size_t)l * 2 * 256; const float* cmp_w2 = a->in[9] + (size_t)l * 2 * 256 * 64; const float* cmp_b2 = a->in[10] + (size_t)l * 2 * 64;
    const float* w_br_pool = a->in[11] + (size_t)l * 256 * DM; const float* w_br_nsa = a->in[12] + (size_t)l * 512 * DM; const float* w_br_moba = a->in[13] + (size_t)l * 256 * DM;
    const float* w_out = a->in[14] + (size_t)l * DM * DM; const float* ffn_norm = a->in[15] + (size_t)l * DM; const float* w_gate = a->in[16] + (size_t)l * DM * DFF; const float* w_up = a->in[17] + (size_t)l * DM * DFF;
    const float* w_down = a->in[18] + (size_t)l * DFF * DM;
    bf16_t* Win = (bf16_t*)(ws + WS_W + OFF_WIN); bf16_t* Wgu = (bf16_t*)(ws + WS_W + OFF_WGU); bf16_t* Wd = (bf16_t*)(ws + WS_W + OFF_WD); bf16_t* Wbr = (bf16_t*)(ws + WS_W + OFF_WBR);
    bf16_t* Wout = (bf16_t*)(ws + WS_W + OFF_WOUT); bf16_t* W1t = (bf16_t*)(ws + WS_W + OFF_W1); bf16_t* W2t = (bf16_t*)(ws + WS_W + OFF_W2);
    float* bin = (float*)(ws + WS_W + OFF_BIN); float* cb1 = (float*)(ws + WS_W + OFF_CB1); float* cb2 = (float*)(ws + WS_W + OFF_CB2);
    constexpr int I_A = 16 * 176, I_B = 16 * 176, I_C = 44 * 32, I_D = 16 * 32, I_E = 16 * 32, I_F = 2 * 32 * 8, I_G = 2 * 4 * 2;
    constexpr int NITEMS = I_A + I_B + I_C + I_D + I_E + I_F + I_G;
    for (int it = gw; it < NITEMS; it += NGW) {
        int r = it;
        if (r < I_A) { const int kb = r / 176, nb = r % 176; { const int o = in_orig(32 * nb + (lane & 31)); const float* wc = w_in + (o >= 0 ? o : 0); const float keep = o >= 0 ? 1.f : 0.f;
            cvt_tile_scaled(scr, lane, 64 * kb, 32 * nb, Win, DM, [&](int k, int) { return wc[(size_t)k * IN_COLS]; }, attn_norm, keep); } continue; } r -= I_A;
        if (r < I_B) { const int kb = r / 176, nb = r % 176; { const int n = 32 * nb + (lane & 31), j = (n >> 8) * 128 + (n & 127); const float* wc = (((n >> 7) & 1) ? w_up : w_gate) + j;
            cvt_tile_scaled(scr, lane, 64 * kb, 32 * nb, Wgu, DM, [&](int k, int) { return wc[(size_t)k * DFF]; }, ffn_norm, 1.f); } continue; } r -= I_B;
        if (r < I_C) { const int kb = r / 32, nb = r % 32; cvt_tile(scr, lane, 64 * kb, 32 * nb, Wd, DFF, [&](int k, int n) { return w_down[(size_t)k * DM + n]; }); continue; } r -= I_C;
        if (r < I_D) { const int kb = r / 32, nb = r % 32; cvt_tile(scr, lane, 64 * kb, 32 * nb, Wout, DM, [&](int k, int n) { return w_out[(size_t)k * DM + n]; }); continue; } r -= I_D;
        if (r < I_E) { const int kb = r / 32, nb = r % 32;
            if (kb < 4) { }
            else if (kb < 12) cvt_tile(scr, lane, 64 * kb, 32 * nb, Wbr, DM, [&](int k, int n) { return w_br_nsa[(size_t)(k - 256) * DM + n]; });
            else cvt_tile(scr, lane, 64 * kb, 32 * nb, Wbr, DM, [&](int k, int n) { return w_br_moba[(size_t)(k - 768) * DM + n]; });
            continue; } r -= I_E;
        if (r < I_F) { const int kv = r >> 8, kb = (r >> 3) & 31, nb = r & 7; const float* w1 = cmp_w1 + (size_t)kv * 2048 * 256;
            cvt_tile(scr, lane, 64 * kb, 32 * nb, W1t + (size_t)kv * 256 * 2048, 2048, [&](int k, int n) { const int pos = k & 63, d = kv == 0 ? dint(pos) : pos; return w1[(size_t)((k & ~63) + d) * 256 + n]; }); continue; } r -= I_F;
        { const int kv = r >> 3, kb = (r >> 1) & 3, nb = r & 1; const float* w2 = cmp_w2 + (size_t)kv * 256 * 64;
            cvt_tile(scr, lane, 64 * kb, 32 * nb, W2t + (size_t)kv * 64 * 256, 256, [&](int k, int n) { return w2[(size_t)k * 64 + (kv == 0 ? dint(n) : n)]; }); }
    }
    const int gt = gw * 64 + lane, NGT = NGW * 64;
    for (int c = gt; c < NIN; c += NGT) { const int o = in_orig(c); bin[c] = o >= 0 ? b_in[o] : 0.f; }
    for (int idx = gt; idx < 32 * 512; idx += NGT) { const int c = idx >> 9, e = idx & 511, kv = e >> 8, n = e & 255; const float* w1 = cmp_w1 + (size_t)kv * 2048 * 256 + (size_t)(64 * c) * 256 + n; const float* pe = cmp_pos + (size_t)kv * 2048 + 64 * c;
        float s = c == 0 ? cmp_b1[kv * 256 + n] : 0.f;
#pragma unroll
        for (int k0 = 0; k0 < 64; k0 += 32) { float av[32], bv[32];
#pragma unroll
            for (int k = 0; k < 32; ++k) { av[k] = pe[k0 + k]; bv[k] = w1[(size_t)(k0 + k) * 256]; }
            __builtin_amdgcn_sched_barrier(0);
#pragma unroll
            for (int k = 0; k < 32; ++k) s += av[k] * bv[k]; }
        cb1[idx] = s; }
    for (int idx = gt; idx < 256 * DM; idx += NGT) { const int k = idx >> 10, n = idx & 1023, g64 = k & ~63; float s = 0.f;
        const f32x4* pw4 = (const f32x4*)(pool_w + (size_t)k * 64); const f32x4* ps4 = (const f32x4*)(pool_scale + g64);
#pragma unroll
        for (int j0 = 0; j0 < 64; j0 += 32) { f32x4 pw[8], psc[8]; float wb[32];
#pragma unroll
            for (int q = 0; q < 8; ++q) { pw[q] = pw4[j0 / 4 + q]; psc[q] = ps4[j0 / 4 + q]; }
#pragma unroll
            for (int j = 0; j < 32; ++j) wb[j] = w_br_pool[(size_t)(g64 + j0 + j) * DM + n];
            __builtin_amdgcn_sched_barrier(0);
#pragma unroll
            for (int j = 0; j < 32; ++j) s += pw[j >> 2][j & 3] * psc[j >> 2][j & 3] * wb[j]; }
        Wbr[(size_t)n * DM + k] = (bf16_t)(cvtpk(s, 0.f) & 0xffffu); }
    for (int e = gt; e < 128; e += NGT) { const int kv = e >> 6, n = e & 63; cb2[e] = cmp_b2[kv * 64 + (kv == 0 ? dint(n) : n)]; }
    if (l == 0) {
        float* tab = (float*)(ws + WS_TAB);
        for (int e = gt; e < SEQ * 32; e += NGT) { const int t = e >> 5, f = e & 31; const float inv = powf(10000.0f, -(float)(2 * f) / 64.0f); const float ang = (float)t * inv;
            const double ad = (double)ang, kq = rint(ad * 0.15915494309189535); double rr = fma(-kq, 6.283185307179586, ad); rr = fma(-kq, 2.4492935982947064e-16, rr);
            const float rf = (float)rr; tab[2 * e] = __cosf(rf); tab[2 * e + 1] = __sinf(rf); }
        const float* x = a->in[0]; bf16_t* xb = (bf16_t*)(ws + WS_XB); float* ssp = (float*)(ws + WS_SSP);
        for (int m0 = 2 * gw; m0 < MTOK; m0 += 2 * NGW) { f32x4 v[2][4]; float s[2] = {0.f, 0.f};
#pragma unroll
            for (int q = 0; q < 2; ++q) { const f32x4* xr = (const f32x4*)(x + (size_t)(m0 + q) * DM) + lane;
#pragma unroll
                for (int j = 0; j < 4; ++j) v[q][j] = xr[64 * j]; }
#pragma unroll
            for (int q = 0; q < 2; ++q) {
#pragma unroll
                for (int j = 0; j < 4; ++j) s[q] += (v[q][j][0] * v[q][j][0] + v[q][j][1] * v[q][j][1]) + (v[q][j][2] * v[q][j][2] + v[q][j][3] * v[q][j][3]);
#pragma unroll
                for (int o = 1; o < 64; o <<= 1) s[q] += __shfl_xor(s[q], o);
                u32x2* o8 = (u32x2*)(xb + (size_t)(m0 + q) * DM) + lane;
#pragma unroll
                for (int j = 0; j < 4; ++j) o8[64 * j] = (u32x2){cvtpk(v[q][j][0], v[q][j][1]), cvtpk(v[q][j][2], v[q][j][3])};
                if (lane < 16) ssp[(size_t)(m0 + q) * 16 + lane] = lane == 0 ? s[q] : 0.f; } }
        int* order = (int*)(ws + WS_ORDER);
        auto cost = [](int id) { if (id < 512) { const int i = id & 127; return 10 * ((i + 1) + ((i < 8 ? i : 8) + 1) + 10) + 16 * ((4 * i + 3 + 63) >> 6); } const int qb = (id - 512) & 31; return 7 * (4 * qb + 3) + 50; };
        for (int id = gw; id < 768; id += NGW) { const int mc = cost(id); int rk = 0;
            for (int j = lane; j < 768; j += 64) { const int cj = cost(j); rk += (cj > mc || (cj == mc && j < id)) ? 1 : 0; }
#pragma unroll
            for (int o = 1; o < 64; o <<= 1) rk += __shfl_xor(rk, o);
            if (lane == 0) order[rk] = id; }
    }
}
__device__ __forceinline__ float gelu_tanh(float x) { const float u = 0.7978845608028654f * (x + 0.044715f * x * x * x); const float th = 1.f - 2.f * __builtin_amdgcn_rcpf(1.f + __expf(2.f * u)); return 0.5f * x * (1.f + th); }
__device__ __forceinline__ void phase2(ArgsP a, LAS unsigned char* lds, int tid, int lane, int wave, int G) {
    unsigned char* ws = a->ws;
    const bf16_t* KV = (const bf16_t*)(ws + WS_KV); const bf16_t* W1t = (const bf16_t*)(ws + WS_W + OFF_W1); const bf16_t* W2t = (const bf16_t*)(ws + WS_W + OFF_W2);
    const float* cb1 = (const float*)(ws + WS_W + OFF_CB1); const float* cb2 = (const float*)(ws + WS_W + OFF_CB2);
    bf16_t* KC = (bf16_t*)(ws + WS_KC);
    LAS bf16_t* hid = (LAS bf16_t*)lds;
    const int arow = lane & 15, kq = lane >> 4;
    for (int task = blockIdx.x; task < 256; task += G) {
        const int kv = task >> 7, bgi = (task >> 5) & 3, nt = task & 31;
        const bf16_t* src = KV + (size_t)kv * att::KV_STRIDE + (size_t)bgi * SEQ * 64;
        const int nrow = 16 * nt + arow, neff = nrow < 510 ? nrow : 510;
        const bf16_t* ap = src + (size_t)neff * 1024 + kq * 8;
        const bf16_t* bp0 = W1t + (size_t)kv * 256 * 2048 + (size_t)(32 * wave + arow) * 2048 + kq * 8; const bf16_t* bp1 = bp0 + 16 * 2048;
        f32x4 c0 = {0.f, 0.f, 0.f, 0.f}, c1 = {0.f, 0.f, 0.f, 0.f};
        float bb0 = 0.f, bb1 = 0.f;
        { const int col0 = 32 * wave + arow; float t0[32], t1[32];
#pragma unroll
          for (int c = 0; c < 32; ++c) { t0[c] = cb1[c * 512 + kv * 256 + col0]; t1[c] = cb1[c * 512 + kv * 256 + col0 + 16]; }
          __builtin_amdgcn_sched_barrier(0);
#pragma unroll
          for (int c = 0; c < 32; ++c) { bb0 += t0[c]; bb1 += t1[c]; } }
#pragma unroll 1
        for (int ks0 = 0; ks0 < 64; ks0 += 8) { bf16x8 av[8], b0[8], b1[8];
#pragma unroll
            for (int q = 0; q < 8; ++q) { av[q] = *(const bf16x8*)(ap + (ks0 + q) * 32); b0[q] = *(const bf16x8*)(bp0 + (ks0 + q) * 32); b1[q] = *(const bf16x8*)(bp1 + (ks0 + q) * 32); }
            __builtin_amdgcn_sched_barrier(0);
#pragma unroll
            for (int q = 0; q < 8; ++q) { c0 = __builtin_amdgcn_mfma_f32_16x16x32_bf16(av[q], b0[q], c0, 0, 0, 0); c1 = __builtin_amdgcn_mfma_f32_16x16x32_bf16(av[q], b1[q], c1, 0, 0, 0); } }
        { const int col0 = 32 * wave + arow;
#pragma unroll
          for (int j = 0; j < 4; ++j) { const int row = kq * 4 + j; hid[row * 264 + col0] = (bf16_t)(cvtpk(gelu_tanh(c0[j] + bb0), 0.f) & 0xffffu); hid[row * 264 + col0 + 16] = (bf16_t)(cvtpk(gelu_tanh(c1[j] + bb1), 0.f) & 0xffffu); } }
        LBAR();
        if (wave < 4) {
            const bf16_t* bp = W2t + (size_t)kv * 64 * 256 + (size_t)(16 * wave + arow) * 256 + kq * 8; f32x4 c = {0.f, 0.f, 0.f, 0.f};
            bf16x8 bv[8];
#pragma unroll
            for (int ks = 0; ks < 8; ++ks) bv[ks] = *(const bf16x8*)(bp + ks * 32);
            __builtin_amdgcn_sched_barrier(0);
#pragma unroll
            for (int ks = 0; ks < 8; ++ks) { const bf16x8 av = *(const LAS bf16x8*)(hid + arow * 264 + kq * 8 + ks * 32); c = __builtin_amdgcn_mfma_f32_16x16x32_bf16(av, bv[ks], c, 0, 0, 0); }
            const int col = 16 * wave + arow; const float bb = cb2[kv * 64 + col];
#pragma unroll
            for (int j = 0; j < 4; ++j) { const int n = 16 * nt + kq * 4 + j; KC[((size_t)(kv * 4 + bgi) * 512 + n) * 64 + col] = n < 511 ? (bf16_t)(cvtpk(c[j] + bb, 0.f) & 0xffffu) : (bf16_t)0; }
        }
        LBAR();
    }
    const int gt = blockIdx.x * 512 + tid, NGT = G * 512;
    { const bf16_t* MoK = (const bf16_t*)(ws + WS_MO) + att::MO_STRIDE; bf16_t* KM = (bf16_t*)(ws + WS_KM); LAS float* part = (LAS float*)(lds + 16384);
      for (int blk = blockIdx.x; blk < 256; blk += G) { const bf16_t* p = MoK + ((size_t)blk * 256 + 32 * wave) * 64 + lane; float s = 0.f;
#pragma unroll
          for (int r0 = 0; r0 < 32; r0 += 16) { unsigned short tv[16];
#pragma unroll
              for (int r = 0; r < 16; ++r) tv[r] = p[(size_t)(r0 + r) * 64];
              __builtin_amdgcn_sched_barrier(0);
#pragma unroll
              for (int r = 0; r < 16; ++r) s += __uint_as_float((unsigned)tv[r] << 16); }
          part[wave * 64 + lane] = s;
          LBAR();
          if (wave == 0) { float t = 0.f;
#pragma unroll
              for (int w = 0; w < 8; ++w) t += part[w * 64 + lane];
              KM[(size_t)blk * 64 + lane] = (bf16_t)(cvtpk(t * (1.0f / 256.0f), 0.f) & 0xffffu); }
          LBAR(); } }
    { const bf16_t* U = (const bf16_t*)(ws + WS_U); bf16_t* Abr = (bf16_t*)(ws + WS_XB);
      for (int e = gt; e < MTOK * 32; e += NGT) { const int row = e >> 5, c8 = e & 31, s = row & (SEQ - 1), w = 2 << (c8 >> 3), cnt = (s + 1 < w) ? s + 1 : w;
          float acc[8] = {0.f, 0.f, 0.f, 0.f, 0.f, 0.f, 0.f, 0.f}; u32x4 v0 = {0u, 0u, 0u, 0u};
#pragma unroll
          for (int i0 = 0; i0 < 16; i0 += 8) { if (i0 >= cnt) break; u32x4 v[8];
#pragma unroll
              for (int i = 0; i < 8; ++i) v[i] = (i0 + i < cnt) ? *(const u32x4*)(U + (size_t)(row - i0 - i) * 256 + c8 * 8) : (u32x4){0u, 0u, 0u, 0u};
              __builtin_amdgcn_sched_barrier(0);
              if (i0 == 0) v0 = v[0];
#pragma unroll
              for (int i = 0; i < 8; ++i)
#pragma unroll
                  for (int q = 0; q < 4; ++q) { acc[2 * q] += bflo(v[i][q]); acc[2 * q + 1] += bfhi(v[i][q]); } }
          const float ic = 1.0f / (float)cnt; u32x4 o;
#pragma unroll
          for (int q = 0; q < 4; ++q) o[q] = cvtpk(acc[2 * q] * ic - bflo(v0[q]), acc[2 * q + 1] * ic - bfhi(v0[q]));
          *(u32x4*)(Abr + (size_t)row * DM + c8 * 8) = o; } }
}
__global__ void __launch_bounds__(512, 2) fwd_megakernel(Args a) {
    extern __shared__ __attribute__((aligned(16))) unsigned char lds_raw[];
    LAS unsigned char* lds = (LAS unsigned char*)lds_raw;
    cg::grid_group grid = cg::this_grid();
    const int G = gridDim.x;
    volatile LAS unsigned* bst = (volatile LAS unsigned*)(lds + LDS_BYTES - 64);
    if (threadIdx.x < 16) bst[threadIdx.x] = 0u;
    __syncthreads();
    const ArgsP ap0 = (ArgsP)__builtin_amdgcn_kernarg_segment_ptr();
#define PHASE_ARGS ArgsP a_ = ap0; asm volatile("" : "+s"(a_)); unsigned char* ws = a_->ws; unsigned* ctl = (unsigned*)(ws + WS_CTL); float* ssp = (float*)(ws + WS_SSP); const float* tab = (const float*)(ws + WS_TAB); \
    bf16_t* XB = (bf16_t*)(ws + WS_XB); bf16_t* BIG = (bf16_t*)(ws + WS_BIG); bf16_t* MRG = (bf16_t*)(ws + WS_MRG); (void)ctl; (void)ssp; (void)tab; (void)XB; (void)BIG; (void)MRG;
    XcdBarrier xbar = xcd_barrier_post((unsigned*)(ap0->ws + WS_BAR), bst);
#define GRID_SYNC() xcd_barrier(xbar)
    for (int l = 0; l < DEPTH; ++l) {
        int tid_ = threadIdx.x; asm volatile("" : "+v"(tid_));
        const int tid = tid_, lane = tid & 63, wave = __builtin_amdgcn_readfirstlane(tid >> 6), gw = blockIdx.x * 8 + wave, NGW = G * 8;
        { PHASE_ARGS phase0(a_, l, lds, tid, lane, wave, gw, NGW); }
        if (l == 0) {
            if (threadIdx.x < 64) {
                unsigned ln_ = threadIdx.x; asm volatile("" : "+v"(ln_)); unsigned c_ = 0u, sp_ = 0u;
                for (;;) { c_ = ln_ < 16 ? xb_ld(&xbar.bar[XB_XCNT(ln_)]) : 0u; unsigned s_ = c_;
#pragma unroll
                    for (int o_ = 1; o_ < 16; o_ <<= 1) s_ += (unsigned)__shfl_xor((int)s_, o_);
                    if ((unsigned)__builtin_amdgcn_readfirstlane((int)s_) == (unsigned)G) break;
                    __builtin_amdgcn_s_sleep(1);
                    if (++sp_ > XB_SPIN_CAP) { if (ln_ == 0) atomicAdd(&xbar.bar[XB_TMO], 1u); break; } }
                const unsigned nx_ = (unsigned)__popcll(__ballot(c_ > 0u)); const unsigned nl_ = (unsigned)__builtin_amdgcn_readlane((int)c_, (int)xbar.x);
                if (ln_ == 0 && nl_ > 0u) { bst[0] = nl_; bst[1] = nx_ > 0u ? nx_ : 1u; } }
            __syncthreads();
            if (G == 0x7fffffff) grid.sync();
            GRID_SYNC();
        } else GRID_SYNC();
        { PHASE_ARGS pg8::Gemm g{XB, (const bf16_t*)(ws + WS_W + OFF_WIN), MTOK, NIN, DM}; pg8::StaticOrder S; S.init(MTOK, NIN, G, (int)blockIdx.x);
          EpiInProj E{ssp, (const float*)(ws + WS_W + OFF_BIN), tab, (bf16_t*)(ws + WS_U), (bf16_t*)(ws + WS_QN), (bf16_t*)(ws + WS_KV), (bf16_t*)(ws + WS_MO), BIG, (bf16_t*)(ws + WS_GN)};
          pg8::gemm_phase(lds, g, S, E); }
        GRID_SYNC();
        { PHASE_ARGS phase2(a_, lds, tid, lane, wave, G); }
        GRID_SYNC();
        { PHASE_ARGS
          att::Bufs B{(const bf16_t*)(ws + WS_QN), (const bf16_t*)(ws + WS_KV), (const bf16_t*)(ws + WS_MO), (const bf16_t*)(ws + WS_KC), (const bf16_t*)(ws + WS_KM), (const bf16_t*)(ws + WS_GN), XB};
          const int* order = (const int*)(ws + WS_ORDER); LAS int* slot = (LAS int*)(lds + att::L_END);
          if (wave >= 4) __builtin_amdgcn_s_setprio(1);
          for (;;) {
              LBAR();
              if (tid == 0) slot[0] = (int)atomicAdd(ctl + l, 1u);
              LBAR();
              const int item = slot[0];
              if (item >= 768) break;
              const int id = order[item];
              int tl = threadIdx.x; asm volatile("" : "+v"(tl));
              const int tid = tl, lane = tid & 63, wave = __builtin_amdgcn_readfirstlane(tid >> 6);
              att::Ctx C; C.lds = (LAS char*)lds; C.wsf = (LAS float*)(lds + att::L_WSF) + wave * 64; C.otl = (LAS float*)(lds + att::L_OT) + wave * 2048 + lane; C.tid = tid; C.wid = wave; C.lane = lane; C.r32 = lane & 31; C.hi = lane >> 5;
              C.vbl = ((lane >> 4) & 1) * 32 + (lane & 3) * 8 + (4 * (lane >> 5) + ((lane & 15) >> 2)) * 64;
              if (id < 512) att::nsa_item(C, B, id >> 8, (id >> 7) & 1, id & 127);
              else { const int x = id - 512; att::moba_item(C, B, x >> 7, (x >> 5) & 3, x & 31); }
          }
          __builtin_amdgcn_s_setprio(0); }
        GRID_SYNC();
        { PHASE_ARGS pg8::Gemm g{XB, (const bf16_t*)(ws + WS_W + OFF_WBR), MTOK, DM, DM}; pg8::StaticOrder S; S.init(MTOK, DM, G, (int)blockIdx.x);
          EpiBranch E{BIG, MRG}; pg8::gemm_phase(lds, g, S, E); }
        GRID_SYNC();
        { PHASE_ARGS pg8::Gemm g{MRG, (const bf16_t*)(ws + WS_W + OFF_WOUT), MTOK, DM, DM}; pg8::StaticOrder S; S.init(MTOK, DM, G, (int)blockIdx.x);
          bf16_t* RES = (bf16_t*)a_->out; EpiResid E{l == 0 ? a_->in[0] : nullptr, RES, XB, nullptr, ssp};   pg8::gemm_phase(lds, g, S, E); }
        GRID_SYNC();
        { PHASE_ARGS pg8::Gemm g{XB, (const bf16_t*)(ws + WS_W + OFF_WGU), MTOK, NGU, DM}; pg8::StaticOrder S; S.init(MTOK, NGU, G, (int)blockIdx.x);
          EpiSwiGLU E{ssp, BIG}; pg8::gemm_phase(lds, g, S, E); }
        GRID_SYNC();
        { PHASE_ARGS pg8::Gemm g{BIG, (const bf16_t*)(ws + WS_W + OFF_WD), MTOK, DM, DFF}; pg8::StaticOrder S; S.init(MTOK, DM, G, (int)blockIdx.x);
          bf16_t* RES = (bf16_t*)a_->out; EpiResid E{nullptr, XB, XB, l + 1 < DEPTH ? RES : nullptr, ssp};   pg8::gemm_phase(lds, g, S, E); }
        GRID_SYNC();
    }
    { PHASE_ARGS const float* fn = a_->in[19]; float* outp = a_->out; const int lane = threadIdx.x & 63, gw = blockIdx.x * 8 + (threadIdx.x >> 6), NGW = G * 8;
      const f32x4* gr = (const f32x4*)fn + lane; f32x4 gv[4];
#pragma unroll
      for (int j = 0; j < 4; ++j) gv[j] = gr[64 * j];
      for (int m0 = 2 * gw; m0 < MTOK; m0 += 2 * NGW) { u32x2 w[2][4]; float rstd[2];
#pragma unroll
          for (int q = 0; q < 2; ++q) { const u32x2* xr = (const u32x2*)(XB + (size_t)(m0 + q) * DM) + lane; rstd[q] = row_rstd(ssp, m0 + q);
#pragma unroll
              for (int j = 0; j < 4; ++j) w[q][j] = xr[64 * j]; }
#pragma unroll
          for (int q = 0; q < 2; ++q) { f32x4* orow = (f32x4*)(outp + (size_t)(m0 + q) * DM) + lane;
#pragma unroll
              for (int j = 0; j < 4; ++j) { const f32x4 v = {bflo(w[q][j][0]), bfhi(w[q][j][0]), bflo(w[q][j][1]), bfhi(w[q][j][1])}; orow[64 * j] = v * rstd[q] * gv[j]; } } } }
}

extern "C" void kernel_launch(void* const* d_in, const int* in_sizes, int n_in, void* d_out, int out_size, void* d_ws, size_t ws_size, hipStream_t stream) {
    static int grid = 0;
    if (grid == 0) {
        if (n_in != 20 || in_sizes[0] != MTOK * DM || out_size != MTOK * DM || ws_size < WS_END) { fprintf(stderr, "kernel_launch: unexpected shapes / workspace (n_in %d, ws %zu)\n", n_in, ws_size); grid = -1; return; }
        int dev = 0, cus = 0, per_cu = 0;
        if (hipGetDevice(&dev) != hipSuccess || hipDeviceGetAttribute(&cus, hipDeviceAttributeMultiprocessorCount, dev) != hipSuccess) { grid = -1; return; }
        if (hipFuncSetAttribute((const void*)fwd_megakernel, hipFuncAttributeMaxDynamicSharedMemorySize, LDS_BYTES) != hipSuccess) { fprintf(stderr, "kernel_launch: hipFuncSetAttribute failed\n"); grid = -1; return; }
        if (hipOccupancyMaxActiveBlocksPerMultiprocessor(&per_cu, (const void*)fwd_megakernel, 512, LDS_BYTES) != hipSuccess || per_cu < 1) { fprintf(stderr, "kernel_launch: occupancy query failed (%d)\n", per_cu); (void)hipGetLastError(); grid = -1; return; }
        grid = cus * per_cu;
    }
    if (grid < 0) return;
    if (hipMemsetAsync((char*)d_ws + WS_CTL, 0, 32768, stream) != hipSuccess) { fprintf(stderr, "kernel_launch: memset failed\n"); return; }
    Args a{};
    for (int i = 0; i < 20; ++i) a.in[i] = (const float*)d_in[i];
    a.out = (float*)d_out; a.ws = (unsigned char*)d_ws;
    void* args[] = {&a};
    const hipError_t e = hipLaunchCooperativeKernel((const void*)fwd_megakernel, dim3(grid), dim3(512), args, LDS_BYTES, stream);
    if (e != hipSuccess) fprintf(stderr, "kernel_launch: cooperative launch failed: %s (grid %d)\n", hipGetErrorString(e), grid);
}
```

```cpp
#include <hip/hip_runtime.h>
#include <hip/hip_cooperative_groups.h>
#include <cstdio>
#include <cstdint>
#include <cmath>
namespace cg = cooperative_groups;

#define LAS __attribute__((address_space(3)))
typedef unsigned short bf16_t;
typedef short bf16x8 __attribute__((ext_vector_type(8)));
typedef short s16x4 __attribute__((ext_vector_type(4)));
typedef float f32x2 __attribute__((ext_vector_type(2)));
typedef float f32x4 __attribute__((ext_vector_type(4)));
typedef float f32x16 __attribute__((ext_vector_type(16)));
typedef unsigned u32x4 __attribute__((ext_vector_type(4)));
typedef unsigned u32x2 __attribute__((ext_vector_type(2)));
typedef __bf16 bf16x2_t __attribute__((ext_vector_type(2)));

constexpr int SEQ = 8192, BATCH = 2, MTOK = BATCH * SEQ, DM = 1024, DEPTH = 2;
constexpr int IN_COLS = 5400, NIN = 5632, DFF = 2816, NGU = 5632;
constexpr float RMS_EPS = 1e-6f;
constexpr float QSCALE = 0.125f * 1.4426950408889634f;

__device__ __forceinline__ unsigned cvtpk(float lo, float hi) { f32x2 v = {lo, hi}; bf16x2_t b = __builtin_convertvector(v, bf16x2_t); return __builtin_bit_cast(unsigned, b); }
__device__ __forceinline__ float bflo(unsigned w) { return __uint_as_float(w << 16); }
__device__ __forceinline__ float bfhi(unsigned w) { return __uint_as_float(w & 0xffff0000u); }
__device__ __forceinline__ float sigmoidf_(float x) { return __builtin_amdgcn_rcpf(1.f + __expf(-x)); }

namespace pg8 {
constexpr int BM = 256, BK = 64, HALF = 128, HTB = HALF * BK * 2, STAGE_BYTES = 8 * HTB, NXCD = 8, WGM = 8;
__host__ __device__ __forceinline__ int lds_byte(int r, int c) { const int st = (r >> 4) * 2 + (c >> 5), rr = r & 15, cc = c & 31, ob = rr * 64 + cc * 2; return st * 1024 + (ob ^ (((ob >> 9) & 1) << 5)); }
__host__ __device__ __forceinline__ void stage_rc(int b, int& R, int& C) { const int st = b / 1024, sb = b % 1024, swz = sb ^ (((sb >> 9) & 1) << 5); R = (st >> 1) * 16 + swz / 64; C = (st & 1) * 32 + (swz % 64) / 2; }
__host__ __device__ __forceinline__ int perm32(int rho) { const int n = rho >> 4, i = rho & 15; return 8 * (i >> 2) + 4 * n + (i & 3); }
struct Unit { int pm, pn; };
struct Gemm { const bf16_t* A; const bf16_t* Bt; int M, N, K; };
struct StaticOrder {
    int nM, nN, nwg, G, c;
    __host__ __device__ void init(int M, int N, int G_, int c_) { nM = M / BM; nN = N / BM; nwg = nM * nN; G = G_; c = c_; }
    __host__ __device__ bool next(int i, Unit& u) const {
        const long L = (long)i * G + c; if (L >= nwg) return false;
        int wgid = (int)L; { const int q = nwg / NXCD, r = nwg % NXCD, xcd = wgid % NXCD, off = wgid / NXCD; wgid = (xcd < r ? xcd * (q + 1) : r * (q + 1) + (xcd - r) * q) + off; }
        const int nig = WGM * nN, gid = wgid / nig, fm = gid * WGM, gsz = (nM - fm) < WGM ? (nM - fm) : WGM;
        u.pm = fm + ((wgid % nig) % gsz); u.pn = (wgid % nig) / gsz; return true;
    }
};
template <class Epi, class Sched>
__device__ __forceinline__ void gemm_phase(LAS unsigned char* lds, const Gemm g, const Sched& S, const Epi& E) {
    int tid_ = threadIdx.x; asm volatile("" : "+v"(tid_));
    const int tid = tid_, wid = __builtin_amdgcn_readfirstlane(tid >> 6), lane = tid & 63, wr = wid >> 2, wc = wid & 3, fr = lane & 15, fq = lane >> 4;
    const int K = g.K, nt = K / BK;
    unsigned voffA[2], voffB[2];
#pragma unroll
    for (int i = 0; i < 2; ++i) { int R, C; stage_rc(tid * 16 + i * 8192, R, C); const int Rb = ((R & ~31) + perm32(R & 31));
        voffA[i] = (unsigned)(R * K + C) * 2u; voffB[i] = (unsigned)(Rb * K + C) * 2u; }
    const size_t kstep = (size_t)(BK * 2);
    const size_t hstep = (size_t)HALF * K * 2;
    const size_t tstep = 2 * hstep;
    const unsigned ldsw = (unsigned)wid * 1024u;
    const int aoff = lds_byte(wr * 64 + fr, fq * 8), boff = lds_byte(wc * 32 + fr, fq * 8);
#define PG8_SA(b, h) (((b) * 2 + (h)) * HTB)
#define PG8_SB(b, h) ((4 + (b) * 2 + (h)) * HTB)
#define PG8_STAGE(bufoff, gbase, voff) do { _Pragma("unroll") for (int _i = 0; _i < 2; ++_i) \
        __builtin_amdgcn_global_load_lds((const unsigned*)((const char*)(gbase) + (voff)[_i]), (LAS unsigned*)(lds + (bufoff) + ldsw + _i * 8192), 16, 0, 0); } while (0)
#define PG8_LDA(dst, b, h) do { _Pragma("unroll") for (int m = 0; m < 4; ++m) _Pragma("unroll") for (int k = 0; k < 2; ++k) dst[m][k] = *(const LAS bf16x8*)(lds + PG8_SA(b, h) + aoff + m * 2048 + k * 1024); } while (0)
#define PG8_LDB(dst, b, h) do { _Pragma("unroll") for (int n = 0; n < 2; ++n) _Pragma("unroll") for (int k = 0; k < 2; ++k) dst[n][k] = *(const LAS bf16x8*)(lds + PG8_SB(b, h) + boff + n * 2048 + k * 1024); } while (0)
#define PG8_MMA(ai, bj, At, Bt) do { __builtin_amdgcn_s_setprio(1); _Pragma("unroll") for (int m = 0; m < 4; ++m) _Pragma("unroll") for (int n = 0; n < 2; ++n) _Pragma("unroll") for (int k = 0; k < 2; ++k) \
        acc[ai][bj][m][n] = __builtin_amdgcn_mfma_f32_16x16x32_bf16(Bt[n][k], At[m][k], acc[ai][bj][m][n], 0, 0, 0); __builtin_amdgcn_s_setprio(0); } while (0)
#define PG8_WAIT_V(n) asm volatile("s_waitcnt vmcnt(" #n ")" ::: "memory")
#define PG8_WAIT_L(n) asm volatile("s_waitcnt lgkmcnt(" #n ")" ::: "memory")
#define PG8_BAR __builtin_amdgcn_s_barrier()
#define PG8_SCHED __builtin_amdgcn_sched_barrier(0)
    Unit cur, nxt; int ui = 0;
    if (!S.next(0, cur)) return;
    f32x4 acc[2][2][4][2];
#pragma unroll
    for (int a = 0; a < 2; ++a)
#pragma unroll
        for (int b = 0; b < 2; ++b)
#pragma unroll
            for (int m = 0; m < 4; ++m)
#pragma unroll
                for (int n = 0; n < 2; ++n) acc[a][b][m][n] = (f32x4){0.f, 0.f, 0.f, 0.f};
    bf16x8 At[4][2], B0[2][2], B1[2][2];
    const char* cA = (const char*)g.A + (size_t)cur.pm * tstep; const char* cB = (const char*)g.Bt + (size_t)cur.pn * tstep;
    PG8_STAGE(PG8_SB(0, 0), cB, voffB); PG8_STAGE(PG8_SB(0, 1), cB + hstep, voffB); PG8_STAGE(PG8_SA(0, 0), cA, voffA); PG8_STAGE(PG8_SA(0, 1), cA + hstep, voffA);
    if (wr == 1) PG8_BAR;
    PG8_WAIT_V(2); PG8_BAR;
    PG8_STAGE(PG8_SB(1, 0), cB + kstep, voffB); PG8_STAGE(PG8_SA(1, 0), cA + kstep, voffA); PG8_STAGE(PG8_SB(1, 1), cB + hstep + kstep, voffB);
    PG8_WAIT_V(6); PG8_BAR;
    for (;;) {
        const bool has_next = S.next(ui + 1, nxt);
        const char* nA = has_next ? (const char*)g.A + (size_t)nxt.pm * tstep : cA; const char* nB = has_next ? (const char*)g.Bt + (size_t)nxt.pn * tstep : cB;
        for (int t = 0; t < nt; t += 2) {
            const bool last = (t == nt - 2);
            const char* a1 = cA + (size_t)(t + 1) * kstep;
            const char* a2 = last ? nA : cA + (size_t)(t + 2) * kstep; const char* b2 = last ? nB : cB + (size_t)(t + 2) * kstep;
            const char* a3 = a2 + kstep; const char* b3 = b2 + kstep;
            if constexpr (Epi::KHOOK) { if (t == 4 || t == 12) { PG8_SCHED; E.khook(acc, cur, t, wr, wc, fr, fq); PG8_SCHED; } }
            PG8_LDB(B0, 0, 0); PG8_LDB(B1, 0, 1); PG8_SCHED; PG8_LDA(At, 0, 0); PG8_STAGE(PG8_SA(1, 1), a1 + hstep, voffA);
            PG8_WAIT_V(8); PG8_WAIT_L(0); PG8_BAR; PG8_MMA(0, 0, At, B0); PG8_MMA(0, 1, At, B1); PG8_BAR; PG8_SCHED;
            PG8_LDA(At, 0, 1); PG8_STAGE(PG8_SB(0, 0), b2, voffB); PG8_STAGE(PG8_SB(0, 1), b2 + hstep, voffB); PG8_STAGE(PG8_SA(0, 0), a2, voffA);
            PG8_WAIT_V(8); PG8_WAIT_L(0); PG8_BAR; PG8_MMA(1, 0, At, B0); PG8_MMA(1, 1, At, B1); PG8_BAR; PG8_SCHED;
            PG8_LDB(B0, 1, 0); PG8_LDB(B1, 1, 1); PG8_SCHED; PG8_LDA(At, 1, 0); PG8_STAGE(PG8_SA(0, 1), a2 + hstep, voffA);
            PG8_WAIT_V(8); PG8_WAIT_L(0); PG8_BAR; PG8_MMA(0, 0, At, B0); PG8_MMA(0, 1, At, B1); PG8_BAR; PG8_SCHED;
            PG8_LDA(At, 1, 1); PG8_STAGE(PG8_SB(1, 0), b3, voffB); PG8_STAGE(PG8_SB(1, 1), b3 + hstep, voffB); PG8_STAGE(PG8_SA(1, 0), a3, voffA);
            PG8_WAIT_V(8); PG8_WAIT_L(0); PG8_BAR; PG8_MMA(1, 0, At, B0); PG8_MMA(1, 1, At, B1); PG8_BAR; PG8_SCHED;
        }
        if (wr == 0) PG8_BAR;
        E(acc, cur, wr, wc, fr, fq);
        if (!has_next) break;
#pragma unroll
        for (int a = 0; a < 2; ++a)
#pragma unroll
            for (int b = 0; b < 2; ++b)
#pragma unroll
                for (int m = 0; m < 4; ++m)
#pragma unroll
                    for (int n = 0; n < 2; ++n) acc[a][b][m][n] = (f32x4){0.f, 0.f, 0.f, 0.f};
        cur = nxt; cA = nA; cB = nB; ++ui;
        if (wr == 1) PG8_BAR;
    }
    PG8_WAIT_V(0);
    PG8_BAR;
#undef PG8_SA
#undef PG8_SB
#undef PG8_STAGE
#undef PG8_LDA
#undef PG8_LDB
#undef PG8_MMA
#undef PG8_WAIT_V
#undef PG8_WAIT_L
#undef PG8_BAR
#undef PG8_SCHED
}
}
using pg8::Unit;
__device__ __forceinline__ float sum_fq(float v) {
    auto a = __builtin_amdgcn_permlane16_swap(__float_as_uint(v), __float_as_uint(v), false, false); v = __uint_as_float(a[0]) + __uint_as_float(a[1]);
    auto b = __builtin_amdgcn_permlane32_swap(__float_as_uint(v), __float_as_uint(v), false, false); return __uint_as_float(b[0]) + __uint_as_float(b[1]);
}
__device__ __forceinline__ float row_rstd(const float* ssp, int row) {
    const f32x4* p = (const f32x4*)(ssp + (size_t)row * 16);
    const f32x4 a = p[0], b = p[1], c = p[2], d = p[3];
    const float ss = ((a[0] + a[1]) + (a[2] + a[3])) + ((b[0] + b[1]) + (b[2] + b[3])) + ((c[0] + c[1]) + (c[2] + c[3])) + ((d[0] + d[1]) + (d[2] + d[3]));
    return 1.0f / sqrtf(ss * (1.0f / DM) + RMS_EPS);
}
__device__ __forceinline__ float row_rstd4(const float* ssp, int row, int fq) {
    const f32x4 a = *((const f32x4*)(ssp + (size_t)row * 16) + fq);
    float ss = (a[0] + a[1]) + (a[2] + a[3]);
    ss = sum_fq(ss);
    return 1.0f / sqrtf(ss * (1.0f / DM) + RMS_EPS);
}
__device__ __forceinline__ u32x4 pack8(const f32x4 a, const f32x4 b) { u32x4 w; w.x = cvtpk(a[0], a[1]); w.y = cvtpk(a[2], a[3]); w.z = cvtpk(b[0], b[1]); w.w = cvtpk(b[2], b[3]); return w; }
__device__ __forceinline__ void rope8(f32x4& v0, f32x4& v1, const float* tab, int t, int pos, float sc) {
    const f32x4* cs = (const f32x4*)(tab + ((size_t)t * 32 + (pos >> 1)) * 2);
    const f32x4 c0 = cs[0], c1 = cs[1];
    f32x4 o0, o1;
    o0[0] = (v0[0] * c0[0] - v0[1] * c0[1]) * sc; o0[1] = (v0[1] * c0[0] + v0[0] * c0[1]) * sc;
    o0[2] = (v0[2] * c0[2] - v0[3] * c0[3]) * sc; o0[3] = (v0[3] * c0[2] + v0[2] * c0[3]) * sc;
    o1[0] = (v1[0] * c1[0] - v1[1] * c1[1]) * sc; o1[1] = (v1[1] * c1[0] + v1[0] * c1[1]) * sc;
    o1[2] = (v1[2] * c1[2] - v1[3] * c1[3]) * sc; o1[3] = (v1[3] * c1[2] + v1[2] * c1[3]) * sc;
    v0 = o0; v1 = o1;
}
struct EpiInProj {
    static constexpr bool KHOOK = false;
    const float* ssp; const float* bias; const float* tab;
    bf16_t *U, *Qn, *KV, *Mo, *G, *Gn;
    __device__ __forceinline__ void operator()(const f32x4 (&acc)[2][2][4][2], const Unit& u, int wr, int wc, int fr, int fq) const {
        asm volatile("" : "+v"(fr), "+v"(fq));
        const int pn = u.pn;
        f32x4 bia[2][2];
#pragma unroll
        for (int bj = 0; bj < 2; ++bj) { const int gc = pn * 256 + bj * 128 + wc * 32 + 8 * fq; bia[bj][0] = *(const f32x4*)(bias + gc); bia[bj][1] = *(const f32x4*)(bias + gc + 4); }
        float rs[2][4];
#pragma unroll
        for (int ai = 0; ai < 2; ++ai) { f32x4 ra[4];
#pragma unroll
            for (int m = 0; m < 4; ++m) ra[m] = *((const f32x4*)(ssp + (size_t)(u.pm * 256 + ai * 128 + wr * 64 + m * 16 + fr) * 16) + fq);
            __builtin_amdgcn_sched_barrier(0);
#pragma unroll
            for (int m = 0; m < 4; ++m) { float ss = (ra[m][0] + ra[m][1]) + (ra[m][2] + ra[m][3]); ss = sum_fq(ss); rs[ai][m] = 1.0f / sqrtf(ss * (1.0f / DM) + RMS_EPS); } }
#pragma unroll
        for (int ai = 0; ai < 2; ++ai)
#pragma unroll
            for (int m = 0; m < 4; ++m) {
                const int row = u.pm * 256 + ai * 128 + wr * 64 + m * 16 + fr;
                const float rstd = rs[ai][m];
                const int t = row & (SEQ - 1), b = row >> 13;
#pragma unroll
                for (int bj = 0; bj < 2; ++bj) {
                    const int cit = bj * 128 + wc * 32 + 8 * fq;
                    f32x4 v0 = acc[ai][bj][m][0] * rstd + bia[bj][0], v1 = acc[ai][bj][m][1] * rstd + bia[bj][1];
                    bf16_t* dst;
                    if (pn == 0) { dst = U + (size_t)row * 256 + cit; }
                    else if (pn <= 2) { const int c2 = (pn - 1) * 256 + cit, head = c2 >> 6, pos = c2 & 63; rope8(v0, v1, tab, t, pos, QSCALE); dst = Qn + ((size_t)(b * 8 + head) * SEQ + t) * 64 + pos; }
                    else if (pn <= 5) { const int c2 = cit & 127, g = c2 >> 6, pos = c2 & 63, kvi = 2 * (pn - 3) + bj; if (bj == 0) rope8(v0, v1, tab, t, pos, 1.f);
                        dst = KV + (size_t)kvi * ((size_t)MTOK * 128) + ((size_t)(b * 2 + g) * SEQ + t) * 64 + pos; }
                    else if (pn <= 8) { const int h = cit >> 6, pos = cit & 63; if (pn < 8) rope8(v0, v1, tab, t, pos, pn == 6 ? QSCALE : 1.f);
                        dst = Mo + (size_t)(pn - 6) * ((size_t)MTOK * 256) + ((size_t)(b * 4 + h) * SEQ + t) * 64 + pos; }
                    else if (pn <= 20) {
#pragma unroll
                        for (int e = 0; e < 4; ++e) { v0[e] = sigmoidf_(v0[e]); v1[e] = sigmoidf_(v1[e]); }
                        dst = G + (size_t)row * 3072 + (pn - 9) * 256 + cit; }
                    else {
#pragma unroll
                        for (int e = 0; e < 4; ++e) { v0[e] = sigmoidf_(v0[e]); v1[e] = sigmoidf_(v1[e]); }
                        dst = Gn + (size_t)row * 32 + (cit & 31); if (cit >= 32) dst = nullptr; }
                    if (dst) *(u32x4*)dst = pack8(v0, v1);
                }
                asm volatile("" ::: "memory");
            }
    }
};
struct EpiBranch {
    static constexpr bool KHOOK = true;
    const bf16_t* G; bf16_t* out;
    __device__ __forceinline__ void khook(f32x4 (&acc)[2][2][4][2], const Unit& u, int t, int wr, int wc, int fr, int fq) const {
        asm volatile("" : "+v"(fr), "+v"(fq));
        const int gsel = (t == 4) ? 0 : 1024;
#pragma unroll
        for (int ai = 0; ai < 2; ++ai)
#pragma unroll
            for (int m = 0; m < 4; ++m) {
                u32x4 gx[2], gy[2];
#pragma unroll
                for (int bj = 0; bj < 2; ++bj) { const int row = u.pm * 256 + ai * 128 + wr * 64 + m * 16 + fr, col = u.pn * 256 + bj * 128 + wc * 32 + 8 * fq;
                    gx[bj] = *(const u32x4*)(G + (size_t)row * 3072 + gsel + col); gy[bj] = *(const u32x4*)(G + (size_t)row * 3072 + gsel + 1024 + col); }
                __builtin_amdgcn_sched_barrier(0);
#pragma unroll
                for (int bj = 0; bj < 2; ++bj)
#pragma unroll
                    for (int e = 0; e < 4; ++e) {
                        const float x0 = fmaxf(bflo(gx[bj][e]), 1e-20f), x1 = fmaxf(bfhi(gx[bj][e]), 1e-20f), y0 = fmaxf(bflo(gy[bj][e]), 1e-20f), y1 = fmaxf(bfhi(gy[bj][e]), 1e-20f);
                        const float r0 = x0 * __builtin_amdgcn_rcpf(y0), r1 = x1 * __builtin_amdgcn_rcpf(y1);
                        acc[ai][bj][m][e >> 1][(e & 1) * 2] *= r0; acc[ai][bj][m][e >> 1][(e & 1) * 2 + 1] *= r1; }
                asm volatile("" ::: "memory");
            }
    }
    __device__ __forceinline__ void operator()(const f32x4 (&acc)[2][2][4][2], const Unit& u, int wr, int wc, int fr, int fq) const {
        asm volatile("" : "+v"(fr), "+v"(fq));
#pragma unroll
        for (int ai = 0; ai < 2; ++ai) {
            u32x4 gz[4][2];
#pragma unroll
            for (int m = 0; m < 4; ++m)
#pragma unroll
                for (int bj = 0; bj < 2; ++bj) gz[m][bj] = *(const u32x4*)(G + (size_t)(u.pm * 256 + ai * 128 + wr * 64 + m * 16 + fr) * 3072 + 2048 + u.pn * 256 + bj * 128 + wc * 32 + 8 * fq);
            __builtin_amdgcn_sched_barrier(0);
#pragma unroll
            for (int m = 0; m < 4; ++m) {
                const int row = u.pm * 256 + ai * 128 + wr * 64 + m * 16 + fr;
#pragma unroll
                for (int bj = 0; bj < 2; ++bj) {
                    const int col = u.pn * 256 + bj * 128 + wc * 32 + 8 * fq; const u32x4 g = gz[m][bj];
                    f32x4 v0 = acc[ai][bj][m][0], v1 = acc[ai][bj][m][1];
                    v0[0] *= fmaxf(bflo(g[0]), 1e-20f); v0[1] *= fmaxf(bfhi(g[0]), 1e-20f); v0[2] *= fmaxf(bflo(g[1]), 1e-20f); v0[3] *= fmaxf(bfhi(g[1]), 1e-20f);
                    v1[0] *= fmaxf(bflo(g[2]), 1e-20f); v1[1] *= fmaxf(bfhi(g[2]), 1e-20f); v1[2] *= fmaxf(bflo(g[3]), 1e-20f); v1[3] *= fmaxf(bfhi(g[3]), 1e-20f);
                    *(u32x4*)(out + (size_t)row * DM + col) = pack8(v0, v1);
                }
            }
            asm volatile("" ::: "memory");
        }
    }
};
struct EpiResid {
    static constexpr bool KHOOK = false;
    const float* base_f; const bf16_t* base_b; bf16_t* xb; bf16_t* res; float* ssp;
    __device__ __forceinline__ void operator()(const f32x4 (&acc)[2][2][4][2], const Unit& u, int wr, int wc, int fr, int fq) const {
        asm volatile("" : "+v"(fr), "+v"(fq));
#pragma unroll
        for (int ai = 0; ai < 2; ++ai)
#pragma unroll
            for (int mp = 0; mp < 2; ++mp) {
                f32x4 b0[2][2], b1[2][2];
                if (base_f) {
#pragma unroll
                    for (int mm = 0; mm < 2; ++mm)
#pragma unroll
                        for (int bj = 0; bj < 2; ++bj) { const size_t off = (size_t)(u.pm * 256 + ai * 128 + wr * 64 + (2 * mp + mm) * 16 + fr) * DM + u.pn * 256 + bj * 128 + wc * 32 + 8 * fq;
                            b0[mm][bj] = *(const f32x4*)(base_f + off); b1[mm][bj] = *(const f32x4*)(base_f + off + 4); }
                    __builtin_amdgcn_sched_barrier(0);
                } else {
                    u32x4 w[2][2];
#pragma unroll
                    for (int mm = 0; mm < 2; ++mm)
#pragma unroll
                        for (int bj = 0; bj < 2; ++bj) w[mm][bj] = *(const u32x4*)(base_b + (size_t)(u.pm * 256 + ai * 128 + wr * 64 + (2 * mp + mm) * 16 + fr) * DM + u.pn * 256 + bj * 128 + wc * 32 + 8 * fq);
                    __builtin_amdgcn_sched_barrier(0);
#pragma unroll
                    for (int mm = 0; mm < 2; ++mm)
#pragma unroll
                        for (int bj = 0; bj < 2; ++bj) { const u32x4 x = w[mm][bj]; b0[mm][bj] = (f32x4){bflo(x[0]), bfhi(x[0]), bflo(x[1]), bfhi(x[1])}; b1[mm][bj] = (f32x4){bflo(x[2]), bfhi(x[2]), bflo(x[3]), bfhi(x[3])}; }
                }
#pragma unroll
                for (int mm = 0; mm < 2; ++mm) {
                    const int m = 2 * mp + mm, row = u.pm * 256 + ai * 128 + wr * 64 + m * 16 + fr;
                    float ss = 0.f;
#pragma unroll
                    for (int bj = 0; bj < 2; ++bj) {
                        const size_t off = (size_t)row * DM + u.pn * 256 + bj * 128 + wc * 32 + 8 * fq;
                        const f32x4 v0 = acc[ai][bj][m][0] + b0[mm][bj], v1 = acc[ai][bj][m][1] + b1[mm][bj];
                        const u32x4 pk = pack8(v0, v1);
                        *(u32x4*)(xb + off) = pk;
                        if (res) *(u32x4*)(res + off) = pk;
                        ss += (v0[0] * v0[0] + v0[1] * v0[1]) + (v0[2] * v0[2] + v0[3] * v0[3]) + (v1[0] * v1[0] + v1[1] * v1[1]) + (v1[2] * v1[2] + v1[3] * v1[3]);
                    }
                    ss = sum_fq(ss);
                    if (fq == 0) ssp[(size_t)row * 16 + u.pn * 4 + wc] = ss;
                }
                asm volatile("" ::: "memory");
            }
    }
};
struct EpiSwiGLU {
    static constexpr bool KHOOK = false;
    const float* ssp; bf16_t* H;
    __device__ __forceinline__ void operator()(const f32x4 (&acc)[2][2][4][2], const Unit& u, int wr, int wc, int fr, int fq) const {
        asm volatile("" : "+v"(fr), "+v"(fq));
        float rs[2][4];
#pragma unroll
        for (int ai = 0; ai < 2; ++ai) { f32x4 ra[4];
#pragma unroll
            for (int m = 0; m < 4; ++m) ra[m] = *((const f32x4*)(ssp + (size_t)(u.pm * 256 + ai * 128 + wr * 64 + m * 16 + fr) * 16) + fq);
            __builtin_amdgcn_sched_barrier(0);
#pragma unroll
            for (int m = 0; m < 4; ++m) { float ss = (ra[m][0] + ra[m][1]) + (ra[m][2] + ra[m][3]); ss = sum_fq(ss); rs[ai][m] = 1.0f / sqrtf(ss * (1.0f / DM) + RMS_EPS); } }
#pragma unroll
        for (int ai = 0; ai < 2; ++ai)
#pragma unroll
            for (int m = 0; m < 4; ++m) {
                const int row = u.pm * 256 + ai * 128 + wr * 64 + m * 16 + fr;
                const float rstd = rs[ai][m];
                f32x4 o[2];
#pragma unroll
                for (int n = 0; n < 2; ++n)
#pragma unroll
                    for (int e = 0; e < 4; ++e) { const float gt = acc[ai][0][m][n][e] * rstd, up = acc[ai][1][m][n][e] * rstd; o[n][e] = gt * sigmoidf_(gt) * up; }
                *(u32x4*)(H + (size_t)row * DFF + u.pn * 128 + wc * 32 + 8 * fq) = pack8(o[0], o[1]);
                asm volatile("" ::: "memory");
            }
    }
};
namespace att {
constexpr int KCS = 1040, KSLOT = 8 * KCS, VSLOT = 8192;
constexpr int L_K0 = 0, L_V0 = 4 * KSLOT, L_WSF = 4 * KSLOT + 4 * VSLOT, L_MSK = L_WSF + 8 * 256, L_UNI = L_MSK + 1024, L_LIST = L_UNI + 64, L_END = L_LIST + 512,
              L_PS = L_END + 64, L_OT = L_PS, L_TOTAL = L_OT + 8 * 8192;
static_assert(L_TOTAL <= 147456 - 64, "attention LDS map");
#define LBAR() asm volatile("s_waitcnt lgkmcnt(0)\n\ts_barrier" ::: "memory")
#define LWAIT() asm volatile("s_waitcnt lgkmcnt(0)" ::: "memory")
__device__ __forceinline__ int crow(int r, int hi) { return (r & 3) + 8 * (r >> 2) + 4 * hi; }
__device__ __forceinline__ float swap_other(float v, int hi) { auto rr = __builtin_amdgcn_permlane32_swap(__float_as_uint(v), __float_as_uint(v), false, false); return __uint_as_float(hi ? rr[0] : rr[1]); }
__device__ __forceinline__ void qkt(f32x16& p0, f32x16& p1, const LAS char* Ks, const bf16x8* qr, const f32x16& cinit, int r32, int hi) {
    const LAS char* kb = Ks + hi * KCS + r32 * 16;
    bf16x8 kf[8];
#pragma unroll
    for (int d0 = 0; d0 < 4; ++d0) { kf[2 * d0] = *(const LAS bf16x8*)(kb + d0 * 2 * KCS); kf[2 * d0 + 1] = *(const LAS bf16x8*)(kb + d0 * 2 * KCS + 512); }
    __builtin_amdgcn_sched_barrier(0);
    p0 = __builtin_amdgcn_mfma_f32_32x32x16_bf16(kf[0], qr[0], cinit, 0, 0, 0); p1 = __builtin_amdgcn_mfma_f32_32x32x16_bf16(kf[1], qr[0], cinit, 0, 0, 0);
#pragma unroll
    for (int d0 = 1; d0 < 4; ++d0) { p0 = __builtin_amdgcn_mfma_f32_32x32x16_bf16(kf[2 * d0], qr[d0], p0, 0, 0, 0); p1 = __builtin_amdgcn_mfma_f32_32x32x16_bf16(kf[2 * d0 + 1], qr[d0], p1, 0, 0, 0); }
}
struct VFrag { s16x4 lo[8], hi[8]; };
typedef short v4i16_t __attribute__((ext_vector_type(4)));
__device__ __forceinline__ s16x4 vtr(const LAS char* p) { return __builtin_bit_cast(s16x4, __builtin_amdgcn_ds_read_tr16_b64_v4i16((LAS v4i16_t*)p)); }
__device__ __forceinline__ void v_issue(VFrag& F, const LAS char* vp) {
#pragma unroll
    for (int d0 = 0; d0 < 2; ++d0)
#pragma unroll
        for (int ks = 0; ks < 4; ++ks) { F.lo[d0 * 4 + ks] = vtr(vp + d0 * 4096 + ks * 1024); F.hi[d0 * 4 + ks] = vtr(vp + d0 * 4096 + ks * 1024 + 512); }
}
template <bool SUM> __device__ __forceinline__ void pv(f32x16* o, f32x16& osum, VFrag& F, bf16x8 pa0, bf16x8 pa1, bf16x8 pa2, bf16x8 pa3) {
#define PK(k) (bf16x8){F.lo[k][0], F.lo[k][1], F.lo[k][2], F.lo[k][3], F.hi[k][0], F.hi[k][1], F.hi[k][2], F.hi[k][3]}
    const bf16x8 ones = {0x3F80, 0x3F80, 0x3F80, 0x3F80, 0x3F80, 0x3F80, 0x3F80, 0x3F80};
    __builtin_amdgcn_s_setprio(1);
    o[0] = __builtin_amdgcn_mfma_f32_32x32x16_bf16(pa0, PK(0), o[0], 0, 0, 0);
    o[1] = __builtin_amdgcn_mfma_f32_32x32x16_bf16(pa0, PK(4), o[1], 0, 0, 0);
    if (SUM) osum = __builtin_amdgcn_mfma_f32_32x32x16_bf16(pa0, ones, osum, 0, 0, 0);
    o[0] = __builtin_amdgcn_mfma_f32_32x32x16_bf16(pa1, PK(1), o[0], 0, 0, 0);
    o[1] = __builtin_amdgcn_mfma_f32_32x32x16_bf16(pa1, PK(5), o[1], 0, 0, 0);
    if (SUM) osum = __builtin_amdgcn_mfma_f32_32x32x16_bf16(pa1, ones, osum, 0, 0, 0);
    o[0] = __builtin_amdgcn_mfma_f32_32x32x16_bf16(pa2, PK(2), o[0], 0, 0, 0);
    o[1] = __builtin_amdgcn_mfma_f32_32x32x16_bf16(pa2, PK(6), o[1], 0, 0, 0);
    if (SUM) osum = __builtin_amdgcn_mfma_f32_32x32x16_bf16(pa2, ones, osum, 0, 0, 0);
    o[0] = __builtin_amdgcn_mfma_f32_32x32x16_bf16(pa3, PK(3), o[0], 0, 0, 0);
    o[1] = __builtin_amdgcn_mfma_f32_32x32x16_bf16(pa3, PK(7), o[1], 0, 0, 0);
    if (SUM) osum = __builtin_amdgcn_mfma_f32_32x32x16_bf16(pa3, ones, osum, 0, 0, 0);
    __builtin_amdgcn_s_setprio(0);
#undef PK
}
__device__ __forceinline__ float rowmax(const f32x16& p0, const f32x16& p1, int hi) {
    float a = __builtin_fmaxf(p0[0], p1[0]);
#pragma unroll
    for (int r = 1; r < 16; ++r) a = __builtin_fmaxf(__builtin_fmaxf(a, p0[r]), p1[r]);
    return __builtin_fmaxf(a, swap_other(a, hi));
}
struct KVRegs { u32x4 k, v; };
__device__ __forceinline__ void tile_load(KVRegs& R, const bf16_t* K, const bf16_t* V, int tid) { R.k = *(const u32x4*)(K + tid * 8); R.v = *(const u32x4*)(V + tid * 8); }
__device__ __forceinline__ void tile_store(const KVRegs& R, LAS char* Ks, LAS char* Vs, int tid) {
    const int row = tid >> 3, c = tid & 7;
    *(LAS u32x4*)(Ks + c * KCS + row * 16) = R.k;
    *(LAS u32x4*)(Vs + (c >> 2) * 4096 + (row >> 4) * 1024 + (row & 15) * 64 + (c & 3) * 16) = R.v;
}
__device__ __forceinline__ void ps_accum(const f32x16 p, int jb, LAS float* ps_row, bool writer) {
#pragma unroll
    for (int rg = 0; rg < 4; ++rg) {
        float a = 2.f * (p[4 * rg] + p[4 * rg + 1] + p[4 * rg + 2]) + p[4 * rg + 3], bq = p[4 * rg + 3];
        a += __builtin_bit_cast(float, __builtin_amdgcn_update_dpp(0, __builtin_bit_cast(int, a), 0xB1, 0xF, 0xF, true)); a += __builtin_bit_cast(float, __builtin_amdgcn_update_dpp(0, __builtin_bit_cast(int, a), 0x4E, 0xF, 0xF, true));
        bq += __builtin_bit_cast(float, __builtin_amdgcn_update_dpp(0, __builtin_bit_cast(int, bq), 0xB1, 0xF, 0xF, true)); bq += __builtin_bit_cast(float, __builtin_amdgcn_update_dpp(0, __builtin_bit_cast(int, bq), 0x4E, 0xF, 0xF, true));
        const int j = jb + 2 * rg;
        if (writer) { __hip_atomic_fetch_add(ps_row + j, a, __ATOMIC_RELAXED, __HIP_MEMORY_SCOPE_WORKGROUP); if (j + 1 < 128) __hip_atomic_fetch_add(ps_row + j + 1, bq, __ATOMIC_RELAXED, __HIP_MEMORY_SCOPE_WORKGROUP); }
    }
}
struct Ctx { LAS char* lds; LAS float* wsf; LAS float* otl; int tid, wid, lane, r32, hi, vbl; };
struct RowSt { float m, l; bool started; f32x16 negm, osum; };
__device__ __forceinline__ void rowst_init(RowSt& S) { S.m = 0.f; S.l = 0.f; S.started = false; S.negm = f32x16{}; S.osum = f32x16{}; asm volatile("" : "+v"(S.negm)); }
__device__ __forceinline__ void rowst_fixed(RowSt& S, float ref) { S.m = ref; S.l = 0.f; S.started = true; S.osum = f32x16{};
#pragma unroll
    for (int r = 0; r < 16; ++r) S.negm[r] = -ref;
    asm volatile("" : "+v"(S.negm)); }
template <int MODE, class Idx, class Src, class Msk>
__device__ __forceinline__ void run_branch(const Ctx& C, int nt, const Idx& idx, const Src& src, const Msk& msk, const bf16x8* qr, RowSt& S, f32x16* o, LAS float* ps_row, bool ps_writer, KVRegs& R0, bool pre, const bf16_t* nk, const bf16_t* nv) {
    KVRegs R1; const bf16_t *kp, *vp;
    int dA = idx(0), dB = nt > 1 ? idx(1) : 0, dC = 0, dD = 0;
    if (!pre) { src(0, dA, kp, vp); tile_load(R0, kp, vp, C.tid); }
    if (nt > 1) { src(1, dB, kp, vp); tile_load(R1, kp, vp, C.tid); }
    auto compute = [&](int it, const LAS char* Ks, const LAS char* Vs, int klo, int khi, bool nm) {
        const bool kill = khi < klo;
        if (!__any(!kill)) return;
        f32x16 p0, p1; qkt(p0, p1, Ks, qr, S.negm, C.r32, C.hi);
        VFrag VF; if constexpr (MODE != 0) { v_issue(VF, Vs + C.vbl); __builtin_amdgcn_sched_barrier(0); }
        if (__any(nm && !kill)) {
#pragma unroll
            for (int r = 0; r < 16; ++r) { const int kv = crow(r, C.hi); if (kv < klo || kv > khi) p0[r] = -INFINITY; if (kv + 32 < klo || kv + 32 > khi) p1[r] = -INFINITY; }
        }
        if constexpr (MODE != 2) {
            float rm = rowmax(p0, p1, C.hi); if (kill) rm = -INFINITY;
            const bool first = !S.started && rm > -INFINITY, grow = first || rm > 8.0f;
            if (__any(grow)) {
                const float d = grow ? rm : 0.f, alpha = first ? 1.0f : __builtin_amdgcn_exp2f(-d);
                S.m += d; S.started = S.started || first;
#pragma unroll
                for (int r = 0; r < 16; ++r) { S.negm[r] = -S.m; p0[r] -= d; p1[r] -= d; }
                if constexpr (MODE == 0) S.l *= alpha;
                if constexpr (MODE == 1) {
                    if (C.hi == 0) C.wsf[C.r32] = alpha;
                    LWAIT();
#pragma unroll
                    for (int r = 0; r < 16; ++r) { const float f = C.wsf[crow(r, C.hi)]; o[0][r] *= f; o[1][r] *= f; S.osum[r] *= f; }
                    LWAIT();
                }
            }
        }
#pragma unroll
        for (int r = 0; r < 16; ++r) { p0[r] = __builtin_amdgcn_exp2f(p0[r]); p1[r] = __builtin_amdgcn_exp2f(p1[r]); }
        if constexpr (MODE == 0) {
            float s = 0.f;
#pragma unroll
            for (int r = 0; r < 16; ++r) s += p0[r] + p1[r];
            S.l += kill ? 0.f : s;
        }
        if constexpr (MODE == 2) {
            if (__any(kill)) {
#pragma unroll
                for (int r = 0; r < 16; ++r) { p0[r] = kill ? 0.f : p0[r]; p1[r] = kill ? 0.f : p1[r]; }
            }
            ps_accum(p0, 16 * it + C.hi, ps_row, ps_writer); ps_accum(p1, 16 * it + 8 + C.hi, ps_row, ps_writer);
        }
        if constexpr (MODE != 0) {
            u32x4 w0 = {cvtpk(p0[0], p0[1]), cvtpk(p0[2], p0[3]), cvtpk(p0[4], p0[5]), cvtpk(p0[6], p0[7])}, w1 = {cvtpk(p0[8], p0[9]), cvtpk(p0[10], p0[11]), cvtpk(p0[12], p0[13]), cvtpk(p0[14], p0[15])};
            u32x4 w2 = {cvtpk(p1[0], p1[1]), cvtpk(p1[2], p1[3]), cvtpk(p1[4], p1[5]), cvtpk(p1[6], p1[7])}, w3 = {cvtpk(p1[8], p1[9]), cvtpk(p1[10], p1[11]), cvtpk(p1[12], p1[13]), cvtpk(p1[14], p1[15])};
            if constexpr (MODE == 1) {
                if (__any(kill)) {
#pragma unroll
                    for (int e = 0; e < 4; ++e) { w0[e] = kill ? 0u : w0[e]; w1[e] = kill ? 0u : w1[e]; w2[e] = kill ? 0u : w2[e]; w3[e] = kill ? 0u : w3[e]; }
                }
            }
            pv<MODE == 1>(o, S.osum, VF, __builtin_bit_cast(bf16x8, w0), __builtin_bit_cast(bf16x8, w1), __builtin_bit_cast(bf16x8, w2), __builtin_bit_cast(bf16x8, w3));
        }
    };
    LBAR();
    for (int it = 0; it < nt; it += 2) {
        const int p = (it >> 1) & 1; const bool two = it + 1 < nt;
        LAS char* KsA = C.lds + L_K0 + (2 * p) * KSLOT; LAS char* VsA = C.lds + L_V0 + (2 * p) * VSLOT;
        LAS char* KsB = KsA + KSLOT; LAS char* VsB = VsA + VSLOT;
        tile_store(R0, KsA, VsA, C.tid); if (two) tile_store(R1, KsB, VsB, C.tid);
        if (it + 2 < nt) dC = idx(it + 2);
        if (it + 3 < nt) dD = idx(it + 3);
        int kloA, khiA, kloB = 0, khiB = -1; const bool nmA = msk(it, dA, kloA, khiA); bool nmB = false; if (two) nmB = msk(it + 1, dB, kloB, khiB);
        if (it + 2 < nt) { src(it + 2, dC, kp, vp); tile_load(R0, kp, vp, C.tid); } else if (nk) tile_load(R0, nk, nv, C.tid);
        if (it + 3 < nt) { src(it + 3, dD, kp, vp); tile_load(R1, kp, vp, C.tid); }
        LBAR();
        compute(it, KsA, VsA, kloA, khiA, nmA);
        if (two) compute(it + 1, KsB, VsB, kloB, khiB, nmB);
        dA = dC; dB = dD;
    }
}
template <bool FIRST> __device__ __forceinline__ void merge_branch_n(const Ctx& C, const f32x16* o, const f32x16& osum, float gate) {
    if (C.hi == 0) C.wsf[C.r32] = gate;
    LWAIT();
#pragma unroll
    for (int r0 = 0; r0 < 16; r0 += 8) {
        float gf[8], t0[8], t1[8];
#pragma unroll
        for (int r = 0; r < 8; ++r) { gf[r] = C.wsf[crow(r0 + r, C.hi)]; t0[r] = FIRST ? 0.f : C.otl[(r0 + r) * 64]; t1[r] = FIRST ? 0.f : C.otl[(16 + r0 + r) * 64]; }
        __builtin_amdgcn_sched_barrier(0);
#pragma unroll
        for (int r = 0; r < 8; ++r) { const float den = osum[r0 + r], f = den > 0.f ? gf[r] * __builtin_amdgcn_rcpf(den) : 0.f;
            C.otl[(r0 + r) * 64] = t0[r] + o[0][r0 + r] * f; C.otl[(16 + r0 + r) * 64] = t1[r] + o[1][r0 + r] * f; } }
    LWAIT();
}
template <bool FIRST> __device__ __forceinline__ void merge_branch(const Ctx& C, const f32x16* o, float factor) {
    if (C.hi == 0) C.wsf[C.r32] = factor;
    LWAIT();
#pragma unroll
    for (int r0 = 0; r0 < 16; r0 += 8) {
        float gf[8], t0[8], t1[8];
#pragma unroll
        for (int r = 0; r < 8; ++r) { gf[r] = C.wsf[crow(r0 + r, C.hi)]; t0[r] = FIRST ? 0.f : C.otl[(r0 + r) * 64]; t1[r] = FIRST ? 0.f : C.otl[(16 + r0 + r) * 64]; }
        __builtin_amdgcn_sched_barrier(0);
#pragma unroll
        for (int r = 0; r < 8; ++r) { C.otl[(r0 + r) * 64] = t0[r] + o[0][r0 + r] * gf[r]; C.otl[(16 + r0 + r) * 64] = t1[r] + o[1][r0 + r] * gf[r]; } }
    LWAIT();
}
struct Bufs { const bf16_t *Qn, *KV, *Mo, *KC, *KM, *Gn; bf16_t* Abr; };
constexpr size_t KV_STRIDE = (size_t)MTOK * 128, MO_STRIDE = (size_t)MTOK * 256;

__device__ __forceinline__ void nsa_item(const Ctx& C, const Bufs& B, int b, int g, int i) {
    const int r32 = C.r32, hi = C.hi, wid = C.wid;
    const int qi = 8 * wid + (r32 >> 2), hh = r32 & 3, head = g * 4 + hh, t = 64 * i + qi, cur = i;
    const size_t bg = (size_t)(b * 2 + g) * SEQ;
    bf16x8 qr[4];
    { const bf16_t* qp = B.Qn + ((size_t)(b * 8 + head) * SEQ + t) * 64 + hi * 8;
#pragma unroll
      for (int d0 = 0; d0 < 4; ++d0) qr[d0] = *(const bf16x8*)(qp + d0 * 16); }
    const unsigned gw = *(const unsigned*)(B.Gn + ((size_t)b * SEQ + t) * 32 + head * 3 - (head & 1));
    const unsigned gw2 = *(const unsigned*)(B.Gn + ((size_t)b * SEQ + t) * 32 + head * 3 - (head & 1) + 2);
    float g0, g1, g2; if (head & 1) { g0 = bfhi(gw); g1 = bflo(gw2); g2 = bfhi(gw2); } else { g0 = bflo(gw); g1 = bfhi(gw); g2 = bflo(gw2); }
    f32x16 o[2];
    LAS float* Ps = (LAS float*)(C.lds + L_PS); LAS unsigned* Mk = (LAS unsigned*)(C.lds + L_MSK); LAS unsigned* Uni = (LAS unsigned*)(C.lds + L_UNI); LAS int* List = (LAS int*)(C.lds + L_LIST);
    const int nv = t >= 31 ? ((t - 31) >> 4) + 1 : 0;
    const int nvt = (4 * i + 3 < 511) ? 4 * i + 3 : 511, ntc = (nvt + 63) >> 6;
    const bf16_t* kc = B.KC + (size_t)(0 * 4 + b * 2 + g) * 512 * 64; const bf16_t* vc = B.KC + (size_t)(1 * 4 + b * 2 + g) * 512 * 64;
    auto idxI = [&](int it) { return it; };
    auto srcC = [&](int it, int, const bf16_t*& kp, const bf16_t*& vp) { kp = kc + (size_t)it * 4096; vp = vc + (size_t)it * 4096; };
    auto mskC = [&](int it, int, int& klo, int& khi) { klo = 0; khi = nv - 1 - 64 * it; return khi < 63; };
    RowSt S; rowst_init(S);
    KVRegs R;
    run_branch<0>(C, ntc, idxI, srcC, mskC, qr, S, o, nullptr, false, R, false, kc, vc);
    const float lt = S.l + swap_other(S.l, hi);
    rowst_fixed(S, lt > 0.f ? S.m + __builtin_amdgcn_logf(lt) : 0.f);
    for (int e = C.tid; e < 64 * 128; e += 512) Ps[e] = 0.f;
    if (C.tid < 8) Uni[C.tid] = 0u;
    o[0] = f32x16{}; o[1] = f32x16{};
    run_branch<2>(C, ntc, idxI, srcC, mskC, qr, S, o, Ps + qi * 128, hh == 0, R, true, B.KV + 2 * KV_STRIDE + bg * 64, B.KV + 3 * KV_STRIDE + bg * 64);
    LBAR();
    {
        const int nf = cur == 0 ? 1 : (cur == 1 ? 2 : 3), kp_ = 16 - nf, lane = C.lane;
#pragma unroll 1
        for (int qq = 0; qq < 8; ++qq) {
            int q = 8 * wid + qq; asm volatile("" : "+s"(q)); LAS float* ps = Ps + q * 128;
            const int j0 = lane, j1 = lane + 64;
            const bool f0 = (j0 == 0 || j0 == cur || j0 == cur - 1) && j0 <= cur, f1 = (j1 == cur || j1 == cur - 1) && j1 <= cur;
            const bool va0 = j0 <= cur && !f0, va1 = j1 <= cur && !f1;
            const unsigned k0 = va0 ? __float_as_uint(ps[j0]) + 1u : 0u, k1 = va1 ? __float_as_uint(ps[j1]) + 1u : 0u;
            unsigned T = 0u;
            for (int bit = 30; bit >= 0; --bit) { const unsigned cand = T | (1u << bit); const int cnt = __popcll(__ballot(k0 >= cand)) + __popcll(__ballot(k1 >= cand)); if (cnt >= kp_) T = cand; }
            const int need = kp_ - (__popcll(__ballot(k0 > T)) + __popcll(__ballot(k1 > T)));
            const unsigned long long t0 = __ballot(k0 == T), t1 = __ballot(k1 == T), below = (1ull << lane) - 1ull;
            const int pre0 = __popcll(t0 & below), pre1 = __popcll(t0) + __popcll(t1 & below);
            const bool s0 = f0 || (k0 > 0u && (k0 > T || (k0 == T && pre0 < need))), s1 = f1 || (k1 > 0u && (k1 > T || (k1 == T && pre1 < need)));
            const unsigned long long b0 = __ballot(s0), b1 = __ballot(s1);
            if (lane == 0) { Mk[q * 4 + 0] = (unsigned)b0; Mk[q * 4 + 1] = (unsigned)(b0 >> 32); Mk[q * 4 + 2] = (unsigned)b1; Mk[q * 4 + 3] = (unsigned)(b1 >> 32);
                __hip_atomic_fetch_or(&Uni[0], (unsigned)b0, __ATOMIC_RELAXED, __HIP_MEMORY_SCOPE_WORKGROUP); __hip_atomic_fetch_or(&Uni[1], (unsigned)(b0 >> 32), __ATOMIC_RELAXED, __HIP_MEMORY_SCOPE_WORKGROUP); __hip_atomic_fetch_or(&Uni[2], (unsigned)b1, __ATOMIC_RELAXED, __HIP_MEMORY_SCOPE_WORKGROUP); __hip_atomic_fetch_or(&Uni[3], (unsigned)(b1 >> 32), __ATOMIC_RELAXED, __HIP_MEMORY_SCOPE_WORKGROUP); }
        }
    }
    LBAR();
    if (C.tid < 128) {
        const int wi = C.tid >> 5, bi = C.tid & 31; const unsigned u0 = Uni[0], u1 = Uni[1], u2 = Uni[2], u3 = Uni[3];
        const unsigned mine = wi == 0 ? u0 : wi == 1 ? u1 : wi == 2 ? u2 : u3;
        const int before = (wi > 0 ? __popc(u0) : 0) + (wi > 1 ? __popc(u1) : 0) + (wi > 2 ? __popc(u2) : 0) + __popc(mine & ((1u << bi) - 1u));
        if ((mine >> bi) & 1u) List[before] = C.tid;
        if (C.tid == 0) Uni[4] = (unsigned)(__popc(u0) + __popc(u1) + __popc(u2) + __popc(u3));
    }
    LBAR();
    merge_branch<true>(C, o, g0);
    {
        const int nsel = (int)Uni[4];
        const bf16_t* ks = B.KV + 2 * KV_STRIDE + bg * 64; const bf16_t* vs = B.KV + 3 * KV_STRIDE + bg * 64;
        auto idxS = [&](int it) { return List[it]; };
        auto srcS = [&](int, int j, const bf16_t*& kp, const bf16_t*& vp) { kp = ks + (size_t)j * 4096; vp = vs + (size_t)j * 4096; };
        auto mskS = [&](int, int j, int& klo, int& khi) { const unsigned w = Mk[qi * 4 + (j >> 5)]; const bool bit = (w >> (j & 31)) & 1u;
            klo = 0; khi = bit ? (j == cur ? qi : 63) : -1; return j == cur; };
        rowst_init(S); o[0] = f32x16{}; o[1] = f32x16{};
        const int tw0n = i >= 8 ? i - 8 : 0;
        run_branch<1>(C, nsel, idxS, srcS, mskS, qr, S, o, nullptr, false, R, true, B.KV + 4 * KV_STRIDE + bg * 64 + (size_t)tw0n * 4096, B.KV + 5 * KV_STRIDE + bg * 64 + (size_t)tw0n * 4096);
        merge_branch_n<false>(C, o, S.osum, g1);
    }
    {
        const int tw0 = i >= 8 ? i - 8 : 0, ntw = i - tw0 + 1;
        const bf16_t* kw = B.KV + 4 * KV_STRIDE + bg * 64; const bf16_t* vw = B.KV + 5 * KV_STRIDE + bg * 64;
        auto srcW = [&](int it, int, const bf16_t*& kp, const bf16_t*& vp) { kp = kw + (size_t)(tw0 + it) * 4096; vp = vw + (size_t)(tw0 + it) * 4096; };
        auto mskW = [&](int it, int, int& klo, int& khi) { const int tw = tw0 + it; klo = (t - 511) - 64 * tw; khi = (tw == i) ? qi : 63; return tw == i || klo > 0; };
        rowst_init(S); o[0] = f32x16{}; o[1] = f32x16{};
        run_branch<1>(C, ntw, idxI, srcW, mskW, qr, S, o, nullptr, false, R, true, nullptr, nullptr);
        merge_branch_n<false>(C, o, S.osum, g2);
    }
#pragma unroll
    for (int r0 = 0; r0 < 16; r0 += 8) { float t0[8], t1[8];
#pragma unroll
        for (int r = 0; r < 8; ++r) { t0[r] = C.otl[(r0 + r) * 64]; t1[r] = C.otl[(16 + r0 + r) * 64]; }
        __builtin_amdgcn_sched_barrier(0);
#pragma unroll
        for (int r = 0; r < 8; ++r) { const int qrow = crow(r0 + r, hi); bf16_t* dst = B.Abr + ((size_t)b * SEQ + 64 * i + 8 * wid + (qrow >> 2)) * DM + 256 + (g * 4 + (qrow & 3)) * 64 + r32;
            dst[0] = (bf16_t)(cvtpk(t0[r], 0.f) & 0xffffu); dst[32] = (bf16_t)(cvtpk(t1[r], 0.f) & 0xffffu); } }
}
__device__ __forceinline__ void moba_item(const Ctx& C, const Bufs& B, int b, int h, int qb) {
    const int r32 = C.r32, hi = C.hi, wid = C.wid, own = qb, t = 256 * qb + 32 * wid + r32;
    const size_t bh = (size_t)(b * 4 + h) * SEQ;
    bf16x8 qr[4];
    { const bf16_t* qp = B.Mo + (bh + t) * 64 + hi * 8;
#pragma unroll
      for (int d0 = 0; d0 < 4; ++d0) qr[d0] = *(const bf16x8*)(qp + d0 * 16); }
    LAS unsigned* Uni = (LAS unsigned*)(C.lds + L_UNI); LAS int* List = (LAS int*)(C.lds + L_LIST);
    LBAR();
    if (C.tid < 256) { const u32x4 kmv = *(const u32x4*)(B.KM + (size_t)(b * 4 + h) * 2048 + C.tid * 8); *(LAS u32x4*)(C.lds + L_K0 + (C.tid & 7) * KCS + (C.tid >> 3) * 16) = kmv; }
    if (C.tid == 0) Uni[0] = 0u;
    LBAR();
    unsigned sel = 0u;
    {
        f32x16 gs = f32x16{};
        const LAS char* kb = C.lds + L_K0 + hi * KCS + r32 * 16;
#pragma unroll
        for (int d0 = 0; d0 < 4; ++d0) gs = __builtin_amdgcn_mfma_f32_32x32x16_bf16(*(const LAS bf16x8*)(kb + d0 * 2 * KCS), qr[d0], gs, 0, 0, 0);
        float lo[16], hv[16];
#pragma unroll
        for (int r = 0; r < 16; ++r) { const float ownv = gs[r], oth = swap_other(ownv, hi); lo[r] = hi ? oth : ownv; hv[r] = hi ? ownv : oth; }
        unsigned taken = ~((1u << own) - 1u);
#pragma unroll
        for (int round = 0; round < 3; ++round) {
            float best = -INFINITY; int bi = 32;
#pragma unroll
            for (int n = 0; n < 32; ++n) { const int rr = (n & 3) + 4 * (n >> 3); const float v = ((n >> 2) & 1) ? hv[rr] : lo[rr]; if (!((taken >> n) & 1u) && v > best) { best = v; bi = n; } }
            if (bi < 32) { sel |= 1u << bi; taken |= 1u << bi; }
        }
    }
    { unsigned u = sel;
#pragma unroll
      for (int o_ = 1; o_ < 64; o_ <<= 1) u |= (unsigned)__shfl_xor((int)u, o_);
      if (C.lane == 0) __hip_atomic_fetch_or(&Uni[0], u, __ATOMIC_RELAXED, __HIP_MEMORY_SCOPE_WORKGROUP); }
    LBAR();
    if (C.tid == 0) { int n = 0; unsigned u = Uni[0]; while (u) { const int bpos = __builtin_ctz(u); u &= u - 1; List[n++] = bpos; } Uni[4] = (unsigned)n; }
    LBAR();
    const int nl = (int)Uni[4], nt = 4 * nl + 4;
    const bf16_t* kk = B.Mo + MO_STRIDE + bh * 64; const bf16_t* vv = B.Mo + 2 * MO_STRIDE + bh * 64;
    auto idxM = [&](int it) { return (it < 4 * nl) ? List[it >> 2] : own; };
    auto src = [&](int it, int blk, const bf16_t*& kp, const bf16_t*& vp) { const int T = 4 * blk + ((it < 4 * nl) ? (it & 3) : (it - 4 * nl)); kp = kk + (size_t)T * 4096; vp = vv + (size_t)T * 4096; };
    auto msk = [&](int it, int blk, int& klo, int& khi) { klo = 0; if (it < 4 * nl) { const bool bit = (sel >> blk) & 1u; khi = bit ? 63 : -1; return false; } khi = 32 * wid + r32 - 64 * (it - 4 * nl); return true; };
    RowSt S; rowst_init(S); f32x16 o[2] = {f32x16{}, f32x16{}};
    KVRegs R;
    run_branch<1>(C, nt, idxM, src, msk, qr, S, o, nullptr, false, R, false, nullptr, nullptr);
    merge_branch_n<true>(C, o, S.osum, 1.0f);
#pragma unroll
    for (int r0 = 0; r0 < 16; r0 += 8) { float t0[8], t1[8];
#pragma unroll
        for (int r = 0; r < 8; ++r) { t0[r] = C.otl[(r0 + r) * 64]; t1[r] = C.otl[(16 + r0 + r) * 64]; }
        __builtin_amdgcn_sched_barrier(0);
#pragma unroll
        for (int r = 0; r < 8; ++r) { const int qrow = crow(r0 + r, hi); bf16_t* dst = B.Abr + ((size_t)b * SEQ + 256 * qb + 32 * wid + qrow) * DM + 768 + h * 64 + r32;
            dst[0] = (bf16_t)(cvtpk(t0[r], 0.f) & 0xffffu); dst[32] = (bf16_t)(cvtpk(t1[r], 0.f) & 0xffffu); } }
}
}
#define XB_TMO      128
#define XB_XCNT(j)  (256  + 64 * (j))
#define XB_XSUB(j)  (1280 + 64 * (j))
#define XB_XGEN(j)  (2304 + 64 * (j))
#define XB_TOP      3328
#define XB_TOPGEN   3392
#define XCD_BAR_WORDS 3456
#define XB_SPIN_CAP (1u << 18)

__device__ __forceinline__ unsigned xb_ld(unsigned* p)              { return __hip_atomic_load(p, __ATOMIC_RELAXED, __HIP_MEMORY_SCOPE_AGENT); }
__device__ __forceinline__ unsigned xb_add(unsigned* p, unsigned v) { return __hip_atomic_fetch_add(p, v, __ATOMIC_RELAXED, __HIP_MEMORY_SCOPE_AGENT); }
__device__ __forceinline__ unsigned xb_xcc_id() { return (unsigned)__builtin_amdgcn_s_getreg((3 << 11) | 20) & 0xFu; }
#define XB_SPIN(cond, bar) do { unsigned _sp = 0; while (cond) { __builtin_amdgcn_s_sleep(1); \
    if ((++_sp & 255u) == 0u) { if (xb_ld(&(bar)[XB_TMO])) break; if (_sp > XB_SPIN_CAP) { atomicAdd(&(bar)[XB_TMO], 1u); break; } } } } while (0)

struct XcdBarrier {
    unsigned* bar; unsigned x;
    volatile LAS unsigned* st;
};

__device__ __forceinline__ XcdBarrier xcd_barrier_post(unsigned* bar, volatile LAS unsigned* st) {
    XcdBarrier b; b.bar = bar; b.x = xb_xcc_id(); b.st = st;
    if (threadIdx.x == 0) (void)xb_add(&bar[XB_XCNT(b.x)], 1u);
    return b;
}
__device__ __forceinline__ void xcd_barrier_complete(unsigned* bar, unsigned x, unsigned& nloc, unsigned& nx) {
    const unsigned G = gridDim.x * gridDim.y * gridDim.z;
    unsigned sum, cnt, mine, sp = 0u;
    for (;;) {
        sum = 0u; cnt = 0u; mine = 0u;
#pragma unroll
        for (unsigned j = 0; j < 16; ++j) { const unsigned c = xb_ld(&bar[XB_XCNT(j)]); sum += c; cnt += (c > 0u) ? 1u : 0u; mine = (j == x) ? c : mine; }
        if (sum == G) break;
        __builtin_amdgcn_s_sleep(1);
        if ((++sp & 255u) == 0u) { if (xb_ld(&bar[XB_TMO])) break; if (sp > XB_SPIN_CAP) { atomicAdd(&bar[XB_TMO], 1u); break; } }
    }
    nloc = mine > 0u ? mine : 1u; nx = cnt > 0u ? cnt : 1u;
}

__device__ __forceinline__ void xcd_barrier(const XcdBarrier& b) {
    asm volatile("s_waitcnt vmcnt(0)" ::: "memory");
    __syncthreads();
    if (threadIdx.x == 0) {
        unsigned* bar = b.bar;
        __builtin_amdgcn_s_waitcnt(0);
        unsigned nloc = b.st[0], nx = b.st[1];
        if (nloc == 0u) { xcd_barrier_complete(bar, b.x, nloc, nx); b.st[0] = nloc; b.st[1] = nx; }
        const unsigned old = xb_add(&bar[XB_XSUB(b.x)], 1u);
        const unsigned gen = old / nloc;
        if (old + 1u == (gen + 1u) * nloc) {
            __builtin_amdgcn_fence(__ATOMIC_RELEASE, "agent");
            asm volatile("s_waitcnt vmcnt(0)" ::: "memory");
            const unsigned og = xb_add(&bar[XB_TOP], 1u);
            const unsigned tg = og / nx;
            if (og + 1u == (tg + 1u) * nx) xb_add(&bar[XB_TOPGEN], 1u);
            else XB_SPIN(xb_ld(&bar[XB_TOPGEN]) == tg, bar);
            __builtin_amdgcn_fence(__ATOMIC_ACQUIRE, "agent");
            xb_add(&bar[XB_XGEN(b.x)], 1u);
            asm volatile("s_waitcnt vmcnt(0)" ::: "memory");
        } else {
            XB_SPIN(xb_ld(&bar[XB_XGEN(b.x)]) == gen, bar);
            __builtin_amdgcn_fence(__ATOMIC_ACQUIRE, "agent");
            asm volatile("s_waitcnt vmcnt(0)" ::: "memory");
        }
    }
    __syncthreads();
}

constexpr size_t MiB = 1u << 20;
constexpr size_t WS_CTL = 0, WS_ORDER = 4096, WS_BAR = 8192;
constexpr size_t WS_W = 1 * MiB, OFF_WIN = 0, OFF_WGU = 11 * MiB, OFF_WD = 22 * MiB, OFF_WBR = 28 * MiB, OFF_WOUT = 30 * MiB, OFF_W1 = 32 * MiB, OFF_W2 = 34 * MiB,
                 OFF_BIN = 34 * MiB + 65536, OFF_CB1 = OFF_BIN + 32768  , OFF_CB2 = OFF_CB1 + 65536;
constexpr size_t WS_TAB = 36 * MiB, WS_SSP = 38 * MiB, WS_KC = 39 * MiB, WS_KM = 39 * MiB + 512 * 1024, WS_GN = 40 * MiB, WS_XB = 42 * MiB, WS_BIG = 74 * MiB,
                 WS_U = 170 * MiB, WS_QN = 178 * MiB, WS_KV = 194 * MiB, WS_MO = 218 * MiB, WS_MRG = 178 * MiB, WS_END = 242 * MiB;
constexpr int LDS_BYTES = 147456;

__device__ __forceinline__ int dint(int pos) { return (pos >> 1) + 32 * (pos & 1); }
__device__ __forceinline__ int in_orig(int c) {
    if (c < 256) return c;
    if (c < 768) { const int c2 = c - 256; return 256 + (c2 >> 6) * 64 + dint(c2 & 63); }
    if (c < 1536) { const int c2 = c - 768, tt = c2 >> 8, bj = (c2 >> 7) & 1, g = (c2 >> 6) & 1, pos = c2 & 63; return 768 + (2 * tt + bj) * 128 + g * 64 + (bj == 0 ? dint(pos) : pos); }
    if (c < 2304) { const int c2 = c - 1536, part = c2 >> 8, h = (c2 >> 6) & 3, pos = c2 & 63; return 1560 + part * 256 + h * 64 + (part < 2 ? dint(pos) : pos); }
    if (c < 5376) return 2328 + (c - 2304);
    const int c2 = c - 5376; return c2 < 24 ? 1536 + c2 : -1;
}
template <class F> __device__ __forceinline__ void cvt_tile(LAS float* scr, int lane, int k0, int n0, bf16_t* dst, size_t pitch, F f) {
    float vals[32];
#pragma unroll
    for (int i = 0; i < 32; ++i) vals[i] = f(k0 + 2 * i + (lane >> 5), n0 + (lane & 31));
#pragma unroll
    for (int i = 0; i < 32; ++i) scr[(2 * i + (lane >> 5)) * 33 + (lane & 31)] = vals[i];
    asm volatile("s_waitcnt lgkmcnt(0)" ::: "memory");
    const int c = lane & 7;
#pragma unroll
    for (int j = 0; j < 4; ++j) { const int n = (lane >> 3) + 8 * j; const LAS float* s = scr + (8 * c) * 33 + n;
        u32x4 o; o.x = cvtpk(s[0 * 33], s[1 * 33]); o.y = cvtpk(s[2 * 33], s[3 * 33]); o.z = cvtpk(s[4 * 33], s[5 * 33]); o.w = cvtpk(s[6 * 33], s[7 * 33]);
        *(u32x4*)(dst + (size_t)(n0 + n) * pitch + k0 + 8 * c) = o; }
    asm volatile("s_waitcnt lgkmcnt(0)" ::: "memory");
}
template <class F> __device__ __forceinline__ void cvt_tile_scaled(LAS float* scr, int lane, int k0, int n0, bf16_t* dst, size_t pitch, F f, const float* scale, float keep) {
    float vals[32], sc[32];
#pragma unroll
    for (int i = 0; i < 32; ++i) { vals[i] = f(k0 + 2 * i + (lane >> 5), n0 + (lane & 31)); sc[i] = scale[k0 + 2 * i + (lane >> 5)]; }
    __builtin_amdgcn_sched_barrier(0);
#pragma unroll
    for (int i = 0; i < 32; ++i) scr[(2 * i + (lane >> 5)) * 33 + (lane & 31)] = vals[i] * (sc[i] * keep);
    asm volatile("s_waitcnt lgkmcnt(0)" ::: "memory");
    const int c = lane & 7;
#pragma unroll
    for (int j = 0; j < 4; ++j) { const int n = (lane >> 3) + 8 * j; const LAS float* s = scr + (8 * c) * 33 + n;
        u32x4 o; o.x = cvtpk(s[0 * 33], s[1 * 33]); o.y = cvtpk(s[2 * 33], s[3 * 33]); o.z = cvtpk(s[4 * 33], s[5 * 33]); o.w = cvtpk(s[6 * 33], s[7 * 33]);
        *(u32x4*)(dst + (size_t)(n0 + n) * pitch + k0 + 8 * c) = o; }
    asm volatile("s_waitcnt lgkmcnt(0)" ::: "memory");
}
struct Args { const float* in[20]; float* out; unsigned char* ws; };
typedef const __attribute__((address_space(4))) Args* ArgsP;

__device__ __forceinline__ void phase0(ArgsP a, int l, LAS unsigned char* lds, int tid, int lane, int wave, int gw, int NGW) {
    unsigned char* ws = a->ws;
    LAS float* scr = (LAS float*)(lds + wave * 8704);
    const float* attn_norm = a->in[1] + (size_t)l * DM; const float* w_in = a->in[2] + (size_t)l * DM * IN_COLS; const float* b_in = a->in[3] + (size_t)l * IN_COLS;
    const float* pool_w = a->in[4] + (size_t)l * 4 * 64 * 64; const float* pool_scale = a->in[5] + (size_t)l * 256; const float* cmp_pos = a->in[6] + (size_t)l * 2 * 32 * 64;
    const float* cmp_w1 = a->in[7] + (size_t)l * 2 * 2048 * 256; const float* cmp_b1 = a->in[8] + (size_t)l * 2 * 256; const float* cmp_w2 = a->in[9] + (size_t)l * 2 * 256 * 64; const float* cmp_b2 = a->in[10] + (size_t)l * 2 * 64;
    const float* w_br_pool = a->in[11] + (size_t)l * 256 * DM; const float* w_br_nsa = a->in[12] + (size_t)l * 512 * DM; const float* w_br_moba = a->in[13] + (size_t)l * 256 * DM;
    const float* w_out = a->in[14] + (size_t)l * DM * DM; const float* ffn_norm = a->in[15] + (size_t)l * DM; const float* w_gate = a->in[16] + (size_t)l * DM * DFF; const float* w_up = a->in[17] + (size_t)l * DM * DFF;
    const float* w_down = a->in[18] + (size_t)l * DFF * DM;
    bf16_t* Win = (bf16_t*)(ws + WS_W + OFF_WIN); bf16_t* Wgu = (bf16_t*)(ws + WS_W + OFF_WGU); bf16_t* Wd = (bf16_t*)(ws + WS_W + OFF_WD); bf16_t* Wbr = (bf16_t*)(ws + WS_W + OFF_WBR);
    bf16_t* Wout = (bf16_t*)(ws + WS_W + OFF_WOUT); bf16_t* W1t = (bf16_t*)(ws + WS_W + OFF_W1); bf16_t* W2t = (bf16_t*)(ws + WS_W + OFF_W2);
    float* bin = (float*)(ws + WS_W + OFF_BIN); float* cb1 = (float*)(ws + WS_W + OFF_CB1); float* cb2 = (float*)(ws + WS_W + OFF_CB2);
    constexpr int I_A = 16 * 176, I_B = 16 * 176, I_C = 44 * 32, I_D = 16 * 32, I_E = 16 * 32, I_F = 2 * 32 * 8, I_G = 2 * 4 * 2;
    constexpr int NITEMS = I_A + I_B + I_C + I_D + I_E + I_F + I_G;
    for (int it = gw; it < NITEMS; it += NGW) {
        int r = it;
        if (r < I_A) { const int kb = r / 176, nb = r % 176; { const int o = in_orig(32 * nb + (lane & 31)); const float* wc = w_in + (o >= 0 ? o : 0); const float keep = o >= 0 ? 1.f : 0.f;
            cvt_tile_scaled(scr, lane, 64 * kb, 32 * nb, Win, DM, [&](int k, int) { return __builtin_nontemporal_load(wc + (size_t)k * IN_COLS); }, attn_norm, keep); } continue; } r -= I_A;
        if (r < I_B) { const int kb = r / 176, nb = r % 176; { const int n = 32 * nb + (lane & 31), j = (n >> 8) * 128 + (n & 127); const float* wc = (((n >> 7) & 1) ? w_up : w_gate) + j;
            cvt_tile_scaled(scr, lane, 64 * kb, 32 * nb, Wgu, DM, [&](int k, int) { return __builtin_nontemporal_load(wc + (size_t)k * DFF); }, ffn_norm, 1.f); } continue; } r -= I_B;
        if (r < I_C) { const int kb = r / 32, nb = r % 32; cvt_tile(scr, lane, 64 * kb, 32 * nb, Wd, DFF, [&](int k, int n) { return __builtin_nontemporal_load(w_down + (size_t)k * DM + n); }); continue; } r -= I_C;
        if (r < I_D) { const int kb = r / 32, nb = r % 32; cvt_tile(scr, lane, 64 * kb, 32 * nb, Wout, DM, [&](int k, int n) { return __builtin_nontemporal_load(w_out + (size_t)k * DM + n); }); continue; } r -= I_D;
        if (r < I_E) { const int kb = r / 32, nb = r % 32;
            if (kb < 4) { }
            else if (kb < 12) cvt_tile(scr, lane, 64 * kb, 32 * nb, Wbr, DM, [&](int k, int n) { return __builtin_nontemporal_load(w_br_nsa + (size_t)(k - 256) * DM + n); });
            else cvt_tile(scr, lane, 64 * kb, 32 * nb, Wbr, DM, [&](int k, int n) { return __builtin_nontemporal_load(w_br_moba + (size_t)(k - 768) * DM + n); });
            continue; } r -= I_E;
        if (r < I_F) { const int kv = r >> 8, kb = (r >> 3) & 31, nb = r & 7; const float* w1 = cmp_w1 + (size_t)kv * 2048 * 256;
            cvt_tile(scr, lane, 64 * kb, 32 * nb, W1t + (size_t)kv * 256 * 2048, 2048, [&](int k, int n) { const int pos = k & 63, d = kv == 0 ? dint(pos) : pos; return w1[(size_t)((k & ~63) + d) * 256 + n]; }); continue; } r -= I_F;
        { const int kv = r >> 3, kb = (r >> 1) & 3, nb = r & 1; const float* w2 = cmp_w2 + (size_t)kv * 256 * 64;
            cvt_tile(scr, lane, 64 * kb, 32 * nb, W2t + (size_t)kv * 64 * 256, 256, [&](int k, int n) { return w2[(size_t)k * 64 + (kv == 0 ? dint(n) : n)]; }); }
    }
    const int gt = gw * 64 + lane, NGT = NGW * 64;
    for (int c = gt; c < NIN; c += NGT) { const int o = in_orig(c); bin[c] = o >= 0 ? b_in[o] : 0.f; }
    for (int idx = gt; idx < 32 * 512; idx += NGT) { const int c = idx >> 9, e = idx & 511, kv = e >> 8, n = e & 255; const float* w1 = cmp_w1 + (size_t)kv * 2048 * 256 + (size_t)(64 * c) * 256 + n; const float* pe = cmp_pos + (size_t)kv * 2048 + 64 * c;
        float s = c == 0 ? cmp_b1[kv * 256 + n] : 0.f;
#pragma unroll
        for (int k0 = 0; k0 < 64; k0 += 32) { float av[32], bv[32];
#pragma unroll
            for (int k = 0; k < 32; ++k) { av[k] = pe[k0 + k]; bv[k] = w1[(size_t)(k0 + k) * 256]; }
            __builtin_amdgcn_sched_barrier(0);
#pragma unroll
            for (int k = 0; k < 32; ++k) s += av[k] * bv[k]; }
        cb1[idx] = s; }
    for (int idx = gt; idx < 256 * DM; idx += NGT) { const int k = idx >> 10, n = idx & 1023, g64 = k & ~63; float s = 0.f;
        const f32x4* pw4 = (const f32x4*)(pool_w + (size_t)k * 64); const f32x4* ps4 = (const f32x4*)(pool_scale + g64);
#pragma unroll
        for (int j0 = 0; j0 < 64; j0 += 32) { f32x4 pw[8], psc[8]; float wb[32];
#pragma unroll
            for (int q = 0; q < 8; ++q) { pw[q] = pw4[j0 / 4 + q]; psc[q] = ps4[j0 / 4 + q]; }
#pragma unroll
            for (int j = 0; j < 32; ++j) wb[j] = w_br_pool[(size_t)(g64 + j0 + j) * DM + n];
            __builtin_amdgcn_sched_barrier(0);
#pragma unroll
            for (int j = 0; j < 32; ++j) s += pw[j >> 2][j & 3] * psc[j >> 2][j & 3] * wb[j]; }
        Wbr[(size_t)n * DM + k] = (bf16_t)(cvtpk(s, 0.f) & 0xffffu); }
    for (int e = gt; e < 128; e += NGT) { const int kv = e >> 6, n = e & 63; cb2[e] = cmp_b2[kv * 64 + (kv == 0 ? dint(n) : n)]; }
    if (l == 0) {
        float* tab = (float*)(ws + WS_TAB);
        for (int e = gt; e < SEQ * 32; e += NGT) { const int t = e >> 5, f = e & 31; const float inv = powf(10000.0f, -(float)(2 * f) / 64.0f); const float ang = (float)t * inv;
            const double ad = (double)ang, kq = rint(ad * 0.15915494309189535); double rr = fma(-kq, 6.283185307179586, ad); rr = fma(-kq, 2.4492935982947064e-16, rr);
            const float rf = (float)rr; tab[2 * e] = __cosf(rf); tab[2 * e + 1] = __sinf(rf); }
        const float* x = a->in[0]; bf16_t* xb = (bf16_t*)(ws + WS_XB); float* ssp = (float*)(ws + WS_SSP);
        for (int m0 = 2 * gw; m0 < MTOK; m0 += 2 * NGW) { f32x4 v[2][4]; float s[2] = {0.f, 0.f};
#pragma unroll
            for (int q = 0; q < 2; ++q) { const f32x4* xr = (const f32x4*)(x + (size_t)(m0 + q) * DM) + lane;
#pragma unroll
                for (int j = 0; j < 4; ++j) v[q][j] = __builtin_nontemporal_load(xr + 64 * j); }
#pragma unroll
            for (int q = 0; q < 2; ++q) {
#pragma unroll
                for (int j = 0; j < 4; ++j) s[q] += (v[q][j][0] * v[q][j][0] + v[q][j][1] * v[q][j][1]) + (v[q][j][2] * v[q][j][2] + v[q][j][3] * v[q][j][3]);
#pragma unroll
                for (int o = 1; o < 64; o <<= 1) s[q] += __shfl_xor(s[q], o);
                u32x2* o8 = (u32x2*)(xb + (size_t)(m0 + q) * DM) + lane;
#pragma unroll
                for (int j = 0; j < 4; ++j) o8[64 * j] = (u32x2){cvtpk(v[q][j][0], v[q][j][1]), cvtpk(v[q][j][2], v[q][j][3])};
                if (lane < 16) ssp[(size_t)(m0 + q) * 16 + lane] = lane == 0 ? s[q] : 0.f; } }
        int* order = (int*)(ws + WS_ORDER);
        auto cost = [](int id) { if (id < 512) { const int i = id & 127; return 10 * ((i + 1) + ((i < 8 ? i : 8) + 1) + 10) + 16 * ((4 * i + 3 + 63) >> 6); } const int qb = (id - 512) & 31; return 7 * (4 * qb + 3) + 50; };
        for (int id = gw; id < 768; id += NGW) { const int mc = cost(id); int rk = 0;
            for (int j = lane; j < 768; j += 64) { const int cj = cost(j); rk += (cj > mc || (cj == mc && j < id)) ? 1 : 0; }
#pragma unroll
            for (int o = 1; o < 64; o <<= 1) rk += __shfl_xor(rk, o);
            if (lane == 0) order[rk] = id; }
    }
}
__device__ __forceinline__ float gelu_tanh(float x) { const float u = 0.7978845608028654f * (x + 0.044715f * x * x * x); const float th = 1.f - 2.f * __builtin_amdgcn_rcpf(1.f + __expf(2.f * u)); return 0.5f * x * (1.f + th); }
__device__ __forceinline__ void phase2(ArgsP a, LAS unsigned char* lds, int tid, int lane, int wave, int G) {
    unsigned char* ws = a->ws;
    const bf16_t* KV = (const bf16_t*)(ws + WS_KV); const bf16_t* W1t = (const bf16_t*)(ws + WS_W + OFF_W1); const bf16_t* W2t = (const bf16_t*)(ws + WS_W + OFF_W2);
    const float* cb1 = (const float*)(ws + WS_W + OFF_CB1); const float* cb2 = (const float*)(ws + WS_W + OFF_CB2);
    bf16_t* KC = (bf16_t*)(ws + WS_KC);
    LAS bf16_t* hid = (LAS bf16_t*)lds;
    const int arow = lane & 15, kq = lane >> 4;
    for (int task = blockIdx.x; task < 256; task += G) {
        const int kv = task >> 7, bgi = (task >> 5) & 3, nt = task & 31;
        const bf16_t* src = KV + (size_t)kv * att::KV_STRIDE + (size_t)bgi * SEQ * 64;
        const int nrow = 16 * nt + arow, neff = nrow < 510 ? nrow : 510;
        const bf16_t* ap = src + (size_t)neff * 1024 + kq * 8;
        const bf16_t* bp0 = W1t + (size_t)kv * 256 * 2048 + (size_t)(32 * wave + arow) * 2048 + kq * 8; const bf16_t* bp1 = bp0 + 16 * 2048;
        f32x4 c0 = {0.f, 0.f, 0.f, 0.f}, c1 = {0.f, 0.f, 0.f, 0.f};
        float bb0 = 0.f, bb1 = 0.f;
        { const int col0 = 32 * wave + arow; float t0[32], t1[32];
#pragma unroll
          for (int c = 0; c < 32; ++c) { t0[c] = cb1[c * 512 + kv * 256 + col0]; t1[c] = cb1[c * 512 + kv * 256 + col0 + 16]; }
          __builtin_amdgcn_sched_barrier(0);
#pragma unroll
          for (int c = 0; c < 32; ++c) { bb0 += t0[c]; bb1 += t1[c]; } }
#pragma unroll 1
        for (int ks0 = 0; ks0 < 64; ks0 += 8) { bf16x8 av[8], b0[8], b1[8];
#pragma unroll
            for (int q = 0; q < 8; ++q) { av[q] = *(const bf16x8*)(ap + (ks0 + q) * 32); b0[q] = *(const bf16x8*)(bp0 + (ks0 + q) * 32); b1[q] = *(const bf16x8*)(bp1 + (ks0 + q) * 32); }
            __builtin_amdgcn_sched_barrier(0);
#pragma unroll
            for (int q = 0; q < 8; ++q) { c0 = __builtin_amdgcn_mfma_f32_16x16x32_bf16(av[q], b0[q], c0, 0, 0, 0); c1 = __builtin_amdgcn_mfma_f32_16x16x32_bf16(av[q], b1[q], c1, 0, 0, 0); } }
        { const int col0 = 32 * wave + arow;
#pragma unroll
          for (int j = 0; j < 4; ++j) { const int row = kq * 4 + j; hid[row * 264 + col0] = (bf16_t)(cvtpk(gelu_tanh(c0[j] + bb0), 0.f) & 0xffffu); hid[row * 264 + col0 + 16] = (bf16_t)(cvtpk(gelu_tanh(c1[j] + bb1), 0.f) & 0xffffu); } }
        LBAR();
        if (wave < 4) {
            const bf16_t* bp = W2t + (size_t)kv * 64 * 256 + (size_t)(16 * wave + arow) * 256 + kq * 8; f32x4 c = {0.f, 0.f, 0.f, 0.f};
            bf16x8 bv[8];
#pragma unroll
            for (int ks = 0; ks < 8; ++ks) bv[ks] = *(const bf16x8*)(bp + ks * 32);
            __builtin_amdgcn_sched_barrier(0);
#pragma unroll
            for (int ks = 0; ks < 8; ++ks) { const bf16x8 av = *(const LAS bf16x8*)(hid + arow * 264 + kq * 8 + ks * 32); c = __builtin_amdgcn_mfma_f32_16x16x32_bf16(av, bv[ks], c, 0, 0, 0); }
            const int col = 16 * wave + arow; const float bb = cb2[kv * 64 + col];
#pragma unroll
            for (int j = 0; j < 4; ++j) { const int n = 16 * nt + kq * 4 + j; KC[((size_t)(kv * 4 + bgi) * 512 + n) * 64 + col] = n < 511 ? (bf16_t)(cvtpk(c[j] + bb, 0.f) & 0xffffu) : (bf16_t)0; }
        }
        LBAR();
    }
    const int gt = blockIdx.x * 512 + tid, NGT = G * 512;
    { const bf16_t* MoK = (const bf16_t*)(ws + WS_MO) + att::MO_STRIDE; bf16_t* KM = (bf16_t*)(ws + WS_KM); LAS float* part = (LAS float*)(lds + 16384);
      for (int blk = blockIdx.x; blk < 256; blk += G) { const bf16_t* p = MoK + ((size_t)blk * 256 + 32 * wave) * 64 + lane; float s = 0.f;
#pragma unroll
          for (int r0 = 0; r0 < 32; r0 += 16) { unsigned short tv[16];
#pragma unroll
              for (int r = 0; r < 16; ++r) tv[r] = p[(size_t)(r0 + r) * 64];
              __builtin_amdgcn_sched_barrier(0);
#pragma unroll
              for (int r = 0; r < 16; ++r) s += __uint_as_float((unsigned)tv[r] << 16); }
          part[wave * 64 + lane] = s;
          LBAR();
          if (wave == 0) { float t = 0.f;
#pragma unroll
              for (int w = 0; w < 8; ++w) t += part[w * 64 + lane];
              KM[(size_t)blk * 64 + lane] = (bf16_t)(cvtpk(t * (1.0f / 256.0f), 0.f) & 0xffffu); }
          LBAR(); } }
    { const bf16_t* U = (const bf16_t*)(ws + WS_U); bf16_t* Abr = (bf16_t*)(ws + WS_XB);
      for (int e = gt; e < MTOK * 32; e += NGT) { const int row = e >> 5, c8 = e & 31, s = row & (SEQ - 1), w = 2 << (c8 >> 3), cnt = (s + 1 < w) ? s + 1 : w;
          float acc[8] = {0.f, 0.f, 0.f, 0.f, 0.f, 0.f, 0.f, 0.f}; u32x4 v0 = {0u, 0u, 0u, 0u};
#pragma unroll
          for (int i0 = 0; i0 < 16; i0 += 8) { if (i0 >= cnt) break; u32x4 v[8];
#pragma unroll
              for (int i = 0; i < 8; ++i) v[i] = (i0 + i < cnt) ? *(const u32x4*)(U + (size_t)(row - i0 - i) * 256 + c8 * 8) : (u32x4){0u, 0u, 0u, 0u};
              __builtin_amdgcn_sched_barrier(0);
              if (i0 == 0) v0 = v[0];
#pragma unroll
              for (int i = 0; i < 8; ++i)
#pragma unroll
                  for (int q = 0; q < 4; ++q) { acc[2 * q] += bflo(v[i][q]); acc[2 * q + 1] += bfhi(v[i][q]); } }
          const float ic = 1.0f / (float)cnt; u32x4 o;
#pragma unroll
          for (int q = 0; q < 4; ++q) o[q] = cvtpk(acc[2 * q] * ic - bflo(v0[q]), acc[2 * q + 1] * ic - bfhi(v0[q]));
          *(u32x4*)(Abr + (size_t)row * DM + c8 * 8) = o; } }
}
__global__ void __launch_bounds__(512, 2) fwd_megakernel(Args a) {
    extern __shared__ __attribute__((aligned(16))) unsigned char lds_raw[];
    LAS unsigned char* lds = (LAS unsigned char*)lds_raw;
    cg::grid_group grid = cg::this_grid();
    const int G = gridDim.x;
    volatile LAS unsigned* bst = (volatile LAS unsigned*)(lds + LDS_BYTES - 64);
    if (threadIdx.x < 16) bst[threadIdx.x] = 0u;
    __syncthreads();
    const ArgsP ap0 = (ArgsP)__builtin_amdgcn_kernarg_segment_ptr();
#define PHASE_ARGS ArgsP a_ = ap0; asm volatile("" : "+s"(a_)); unsigned char* ws = a_->ws; unsigned* ctl = (unsigned*)(ws + WS_CTL); float* ssp = (float*)(ws + WS_SSP); const float* tab = (const float*)(ws + WS_TAB); \
    bf16_t* XB = (bf16_t*)(ws + WS_XB); bf16_t* BIG = (bf16_t*)(ws + WS_BIG); bf16_t* MRG = (bf16_t*)(ws + WS_MRG); (void)ctl; (void)ssp; (void)tab; (void)XB; (void)BIG; (void)MRG;
    XcdBarrier xbar = xcd_barrier_post((unsigned*)(ap0->ws + WS_BAR), bst);
#define GRID_SYNC() xcd_barrier(xbar)
    for (int l = 0; l < DEPTH; ++l) {
        int tid_ = threadIdx.x; asm volatile("" : "+v"(tid_));
        const int tid = tid_, lane = tid & 63, wave = __builtin_amdgcn_readfirstlane(tid >> 6), gw = blockIdx.x * 8 + wave, NGW = G * 8;
        { PHASE_ARGS phase0(a_, l, lds, tid, lane, wave, gw, NGW); }
        if (l == 0) {
            if (threadIdx.x < 64) {
                unsigned ln_ = threadIdx.x; asm volatile("" : "+v"(ln_)); unsigned c_ = 0u, sp_ = 0u;
                for (;;) { c_ = ln_ < 16 ? xb_ld(&xbar.bar[XB_XCNT(ln_)]) : 0u; unsigned s_ = c_;
#pragma unroll
                    for (int o_ = 1; o_ < 16; o_ <<= 1) s_ += (unsigned)__shfl_xor((int)s_, o_);
                    if ((unsigned)__builtin_amdgcn_readfirstlane((int)s_) == (unsigned)G) break;
                    __builtin_amdgcn_s_sleep(1);
                    if (++sp_ > XB_SPIN_CAP) { if (ln_ == 0) atomicAdd(&xbar.bar[XB_TMO], 1u); break; } }
                const unsigned nx_ = (unsigned)__popcll(__ballot(c_ > 0u)); const unsigned nl_ = (unsigned)__builtin_amdgcn_readlane((int)c_, (int)xbar.x);
                if (ln_ == 0 && nl_ > 0u) { bst[0] = nl_; bst[1] = nx_ > 0u ? nx_ : 1u; } }
            __syncthreads();
            if (G == 0x7fffffff) grid.sync();
            GRID_SYNC();
        } else GRID_SYNC();
        { PHASE_ARGS pg8::Gemm g{XB, (const bf16_t*)(ws + WS_W + OFF_WIN), MTOK, NIN, DM}; pg8::StaticOrder S; S.init(MTOK, NIN, G, (int)blockIdx.x);
          EpiInProj E{ssp, (const float*)(ws + WS_W + OFF_BIN), tab, (bf16_t*)(ws + WS_U), (bf16_t*)(ws + WS_QN), (bf16_t*)(ws + WS_KV), (bf16_t*)(ws + WS_MO), BIG, (bf16_t*)(ws + WS_GN)};
          pg8::gemm_phase(lds, g, S, E); }
        GRID_SYNC();
        { PHASE_ARGS phase2(a_, lds, tid, lane, wave, G); }
        GRID_SYNC();
        { PHASE_ARGS
          att::Bufs B{(const bf16_t*)(ws + WS_QN), (const bf16_t*)(ws + WS_KV), (const bf16_t*)(ws + WS_MO), (const bf16_t*)(ws + WS_KC), (const bf16_t*)(ws + WS_KM), (const bf16_t*)(ws + WS_GN), XB};
          const int* order = (const int*)(ws + WS_ORDER); LAS int* slot = (LAS int*)(lds + att::L_END);
          if (wave >= 4) __builtin_amdgcn_s_setprio(1);
          for (;;) {
              LBAR();
              if (tid == 0) slot[0] = (int)atomicAdd(ctl + l, 1u);
              LBAR();
              const int item = slot[0];
              if (item >= 768) break;
              const int id = order[item];
              int tl = threadIdx.x; asm volatile("" : "+v"(tl));
              const int tid = tl, lane = tid & 63, wave = __builtin_amdgcn_readfirstlane(tid >> 6);
              att::Ctx C; C.lds = (LAS char*)lds; C.wsf = (LAS float*)(lds + att::L_WSF) + wave * 64; C.otl = (LAS float*)(lds + att::L_OT) + wave * 2048 + lane; C.tid = tid; C.wid = wave; C.lane = lane; C.r32 = lane & 31; C.hi = lane >> 5;
              C.vbl = ((lane >> 4) & 1) * 32 + (lane & 3) * 8 + (4 * (lane >> 5) + ((lane & 15) >> 2)) * 64;
              if (id < 512) att::nsa_item(C, B, id >> 8, (id >> 7) & 1, id & 127);
              else { const int x = id - 512; att::moba_item(C, B, x >> 7, (x >> 5) & 3, x & 31); }
          }
          __builtin_amdgcn_s_setprio(0); }
        GRID_SYNC();
        { PHASE_ARGS pg8::Gemm g{XB, (const bf16_t*)(ws + WS_W + OFF_WBR), MTOK, DM, DM}; pg8::StaticOrder S; S.init(MTOK, DM, G, (int)blockIdx.x);
          EpiBranch E{BIG, MRG}; pg8::gemm_phase(lds, g, S, E); }
        GRID_SYNC();
        { PHASE_ARGS pg8::Gemm g{MRG, (const bf16_t*)(ws + WS_W + OFF_WOUT), MTOK, DM, DM}; pg8::StaticOrder S; S.init(MTOK, DM, G, (int)blockIdx.x);
          bf16_t* RES = (bf16_t*)a_->out; EpiResid E{l == 0 ? a_->in[0] : nullptr, RES, XB, nullptr, ssp};   pg8::gemm_phase(lds, g, S, E); }
        GRID_SYNC();
        { PHASE_ARGS pg8::Gemm g{XB, (const bf16_t*)(ws + WS_W + OFF_WGU), MTOK, NGU, DM}; pg8::StaticOrder S; S.init(MTOK, NGU, G, (int)blockIdx.x);
          EpiSwiGLU E{ssp, BIG}; pg8::gemm_phase(lds, g, S, E); }
        GRID_SYNC();
        { PHASE_ARGS pg8::Gemm g{BIG, (const bf16_t*)(ws + WS_W + OFF_WD), MTOK, DM, DFF}; pg8::StaticOrder S; S.init(MTOK, DM, G, (int)blockIdx.x);
          bf16_t* RES = (bf16_t*)a_->out; EpiResid E{nullptr, XB, XB, l + 1 < DEPTH ? RES : nullptr, ssp};   pg8::gemm_phase(lds, g, S, E); }
        GRID_SYNC();
    }
    { PHASE_ARGS const float* fn = a_->in[19]; float* outp = a_->out; const int lane = threadIdx.x & 63, gw = blockIdx.x * 8 + (threadIdx.x >> 6), NGW = G * 8;
      const f32x4* gr = (const f32x4*)fn + lane; f32x4 gv[4];
#pragma unroll
      for (int j = 0; j < 4; ++j) gv[j] = gr[64 * j];
      for (int m0 = 2 * gw; m0 < MTOK; m0 += 2 * NGW) { u32x2 w[2][4]; float rstd[2];
#pragma unroll
          for (int q = 0; q < 2; ++q) { const u32x2* xr = (const u32x2*)(XB + (size_t)(m0 + q) * DM) + lane; rstd[q] = row_rstd(ssp, m0 + q);
#pragma unroll
              for (int j = 0; j < 4; ++j) w[q][j] = xr[64 * j]; }
#pragma unroll
          for (int q = 0; q < 2; ++q) { f32x4* orow = (f32x4*)(outp + (size_t)(m0 + q) * DM) + lane;
#pragma unroll
              for (int j = 0; j < 4; ++j) { const f32x4 v = {bflo(w[q][j][0]), bfhi(w[q][j][0]), bflo(w[q][j][1]), bfhi(w[q][j][1])}; __builtin_nontemporal_store(v * rstd[q] * gv[j], orow + 64 * j); } } } }
}

extern "C" void kernel_launch(void* const* d_in, const int* in_sizes, int n_in, void* d_out, int out_size, void* d_ws, size_t ws_size, hipStream_t stream) {
    static int grid = 0;
    if (grid == 0) {
        if (n_in != 20 || in_sizes[0] != MTOK * DM || out_size != MTOK * DM || ws_size < WS_END) { fprintf(stderr, "kernel_launch: unexpected shapes / workspace (n_in %d, ws %zu)\n", n_in, ws_size); grid = -1; return; }
        int dev = 0, cus = 0, per_cu = 0;
        if (hipGetDevice(&dev) != hipSuccess || hipDeviceGetAttribute(&cus, hipDeviceAttributeMultiprocessorCount, dev) != hipSuccess) { grid = -1; return; }
        if (hipFuncSetAttribute((const void*)fwd_megakernel, hipFuncAttributeMaxDynamicSharedMemorySize, LDS_BYTES) != hipSuccess) { fprintf(stderr, "kernel_launch: hipFuncSetAttribute failed\n"); grid = -1; return; }
        if (hipOccupancyMaxActiveBlocksPerMultiprocessor(&per_cu, (const void*)fwd_megakernel, 512, LDS_BYTES) != hipSuccess || per_cu < 1) { fprintf(stderr, "kernel_launch: occupancy query failed (%d)\n", per_cu); (void)hipGetLastError(); grid = -1; return; }
        grid = cus * per_cu;
    }
    if (grid < 0) return;
    if (hipMemsetAsync((char*)d_ws + WS_CTL, 0, 32768, stream) != hipSuccess) { fprintf(stderr, "kernel_launch: memset failed\n"); return; }
    Args a{};
    for (int i = 0; i < 20; ++i) a.in[i] = (const float*)d_in[i];
    a.out = (float*)d_out; a.ws = (unsigned char*)d_ws;
    void* args[] = {&a};
    const hipError_t e = hipLaunchCooperativeKernel((const void*)fwd_megakernel, dim3(grid), dim3(512), args, LDS_BYTES, stream);
    if (e != hipSuccess) fprintf(stderr, "kernel_launch: cooperative launch failed: %s (grid %d)\n", hipGetErrorString(e), grid);
}
```

```cpp
#include <hip/hip_runtime.h>
#include <hip/hip_cooperative_groups.h>
#include <cstdio>
#include <cstdint>
#include <cmath>
namespace cg = cooperative_groups;

#define LAS __attribute__((address_space(3)))
typedef unsigned short bf16_t;
typedef short bf16x8 __attribute__((ext_vector_type(8)));
typedef short s16x4 __attribute__((ext_vector_type(4)));
typedef float f32x2 __attribute__((ext_vector_type(2)));
typedef float f32x4 __attribute__((ext_vector_type(4)));
typedef float f32x16 __attribute__((ext_vector_type(16)));
typedef unsigned u32x4 __attribute__((ext_vector_type(4)));
typedef unsigned u32x2 __attribute__((ext_vector_type(2)));
typedef __bf16 bf16x2_t __attribute__((ext_vector_type(2)));

constexpr int SEQ = 8192, BATCH = 2, MTOK = BATCH * SEQ, DM = 1024, DEPTH = 2;
constexpr int IN_COLS = 5400, NIN = 5632, DFF = 2816, NGU = 5632;
constexpr float RMS_EPS = 1e-6f;
constexpr float QSCALE = 0.125f * 1.4426950408889634f;

__device__ __forceinline__ unsigned cvtpk(float lo, float hi) { f32x2 v = {lo, hi}; bf16x2_t b = __builtin_convertvector(v, bf16x2_t); return __builtin_bit_cast(unsigned, b); }
__device__ __forceinline__ float bflo(unsigned w) { return __uint_as_float(w << 16); }
__device__ __forceinline__ float bfhi(unsigned w) { return __uint_as_float(w & 0xffff0000u); }
__device__ __forceinline__ float sigmoidf_(float x) { return __builtin_amdgcn_rcpf(1.f + __expf(-x)); }

namespace pg8 {
constexpr int BM = 256, BK = 64, HALF = 128, HTB = HALF * BK * 2, STAGE_BYTES = 8 * HTB, NXCD = 8, WGM = 8;
__host__ __device__ __forceinline__ int lds_byte(int r, int c) { const int st = (r >> 4) * 2 + (c >> 5), rr = r & 15, cc = c & 31, ob = rr * 64 + cc * 2; return st * 1024 + (ob ^ (((ob >> 9) & 1) << 5)); }
__host__ __device__ __forceinline__ void stage_rc(int b, int& R, int& C) { const int st = b / 1024, sb = b % 1024, swz = sb ^ (((sb >> 9) & 1) << 5); R = (st >> 1) * 16 + swz / 64; C = (st & 1) * 32 + (swz % 64) / 2; }
__host__ __device__ __forceinline__ int perm32(int rho) { const int n = rho >> 4, i = rho & 15; return 8 * (i >> 2) + 4 * n + (i & 3); }
struct Unit { int pm, pn; };
struct Gemm { const bf16_t* A; const bf16_t* Bt; int M, N, K; };
struct StaticOrder {
    int nM, nN, nwg, G, c;
    __host__ __device__ void init(int M, int N, int G_, int c_) { nM = M / BM; nN = N / BM; nwg = nM * nN; G = G_; c = c_; }
    __host__ __device__ bool next(int i, Unit& u) const {
        const long L = (long)i * G + c; if (L >= nwg) return false;
        int wgid = (int)L; { const int q = nwg / NXCD, r = nwg % NXCD, xcd = wgid % NXCD, off = wgid / NXCD; wgid = (xcd < r ? xcd * (q + 1) : r * (q + 1) + (xcd - r) * q) + off; }
        const int nig = WGM * nN, gid = wgid / nig, fm = gid * WGM, gsz = (nM - fm) < WGM ? (nM - fm) : WGM;
        u.pm = fm + ((wgid % nig) % gsz); u.pn = (wgid % nig) / gsz; return true;
    }
};
template <class Epi, class Sched>
__device__ __forceinline__ void gemm_phase(LAS unsigned char* lds, const Gemm g, const Sched& S, const Epi& E) {
    int tid_ = threadIdx.x; asm volatile("" : "+v"(tid_));
    const int tid = tid_, wid = __builtin_amdgcn_readfirstlane(tid >> 6), lane = tid & 63, wr = wid >> 2, wc = wid & 3, fr = lane & 15, fq = lane >> 4;
    const int K = g.K, nt = K / BK;
    unsigned voffA[2], voffB[2];
#pragma unroll
    for (int i = 0; i < 2; ++i) { int R, C; stage_rc(tid * 16 + i * 8192, R, C); const int Rb = ((R & ~31) + perm32(R & 31));
        voffA[i] = (unsigned)(R * K + C) * 2u; voffB[i] = (unsigned)(Rb * K + C) * 2u; }
    const size_t kstep = (size_t)(BK * 2);
    const size_t hstep = (size_t)HALF * K * 2;
    const size_t tstep = 2 * hstep;
    const unsigned ldsw = (unsigned)wid * 1024u;
    const int aoff = lds_byte(wr * 64 + fr, fq * 8), boff = lds_byte(wc * 32 + fr, fq * 8);
#define PG8_SA(b, h) (((b) * 2 + (h)) * HTB)
#define PG8_SB(b, h) ((4 + (b) * 2 + (h)) * HTB)
#define PG8_STAGE(bufoff, gbase, voff) do { _Pragma("unroll") for (int _i = 0; _i < 2; ++_i) \
        __builtin_amdgcn_global_load_lds((const unsigned*)((const char*)(gbase) + (voff)[_i]), (LAS unsigned*)(lds + (bufoff) + ldsw + _i * 8192), 16, 0, 0); } while (0)
#define PG8_LDA(dst, b, h) do { _Pragma("unroll") for (int m = 0; m < 4; ++m) _Pragma("unroll") for (int k = 0; k < 2; ++k) dst[m][k] = *(const LAS bf16x8*)(lds + PG8_SA(b, h) + aoff + m * 2048 + k * 1024); } while (0)
#define PG8_LDB(dst, b, h) do { _Pragma("unroll") for (int n = 0; n < 2; ++n) _Pragma("unroll") for (int k = 0; k < 2; ++k) dst[n][k] = *(const LAS bf16x8*)(lds + PG8_SB(b, h) + boff + n * 2048 + k * 1024); } while (0)
#define PG8_MMA(ai, bj, At, Bt) do { __builtin_amdgcn_s_setprio(1); _Pragma("unroll") for (int m = 0; m < 4; ++m) _Pragma("unroll") for (int n = 0; n < 2; ++n) _Pragma("unroll") for (int k = 0; k < 2; ++k) \
        acc[ai][bj][m][n] = __builtin_amdgcn_mfma_f32_16x16x32_bf16(Bt[n][k], At[m][k], acc[ai][bj][m][n], 0, 0, 0); __builtin_amdgcn_s_setprio(0); } while (0)
#define PG8_WAIT_V(n) asm volatile("s_waitcnt vmcnt(" #n ")" ::: "memory")
#define PG8_WAIT_L(n) asm volatile("s_waitcnt lgkmcnt(" #n ")" ::: "memory")
#define PG8_BAR __builtin_amdgcn_s_barrier()
#define PG8_SCHED __builtin_amdgcn_sched_barrier(0)
    Unit cur, nxt; int ui = 0;
    if (!S.next(0, cur)) return;
    f32x4 acc[2][2][4][2];
#pragma unroll
    for (int a = 0; a < 2; ++a)
#pragma unroll
        for (int b = 0; b < 2; ++b)
#pragma unroll
            for (int m = 0; m < 4; ++m)
#pragma unroll
                for (int n = 0; n < 2; ++n) acc[a][b][m][n] = (f32x4){0.f, 0.f, 0.f, 0.f};
    bf16x8 At[4][2], B0[2][2], B1[2][2];
    const char* cA = (const char*)g.A + (size_t)cur.pm * tstep; const char* cB = (const char*)g.Bt + (size_t)cur.pn * tstep;
    PG8_STAGE(PG8_SB(0, 0), cB, voffB); PG8_STAGE(PG8_SB(0, 1), cB + hstep, voffB); PG8_STAGE(PG8_SA(0, 0), cA, voffA); PG8_STAGE(PG8_SA(0, 1), cA + hstep, voffA);
    if (wr == 1) PG8_BAR;
    PG8_WAIT_V(2); PG8_BAR;
    PG8_STAGE(PG8_SB(1, 0), cB + kstep, voffB); PG8_STAGE(PG8_SA(1, 0), cA + kstep, voffA); PG8_STAGE(PG8_SB(1, 1), cB + hstep + kstep, voffB);
    PG8_WAIT_V(6); PG8_BAR;
    for (;;) {
        const bool has_next = S.next(ui + 1, nxt);
        const char* nA = has_next ? (const char*)g.A + (size_t)nxt.pm * tstep : cA; const char* nB = has_next ? (const char*)g.Bt + (size_t)nxt.pn * tstep : cB;
        for (int t = 0; t < nt; t += 2) {
            const bool last = (t == nt - 2);
            const char* a1 = cA + (size_t)(t + 1) * kstep;
            const char* a2 = last ? nA : cA + (size_t)(t + 2) * kstep; const char* b2 = last ? nB : cB + (size_t)(t + 2) * kstep;
            const char* a3 = a2 + kstep; const char* b3 = b2 + kstep;
            if constexpr (Epi::KHOOK) { if (t == 4 || t == 12) { PG8_SCHED; E.khook(acc, cur, t, wr, wc, fr, fq); PG8_SCHED; } }
            PG8_LDB(B0, 0, 0); PG8_LDB(B1, 0, 1); PG8_SCHED; PG8_LDA(At, 0, 0); PG8_STAGE(PG8_SA(1, 1), a1 + hstep, voffA);
            PG8_WAIT_V(8); PG8_WAIT_L(0); PG8_BAR; PG8_MMA(0, 0, At, B0); PG8_MMA(0, 1, At, B1); PG8_BAR; PG8_SCHED;
            PG8_LDA(At, 0, 1); PG8_STAGE(PG8_SB(0, 0), b2, voffB); PG8_STAGE(PG8_SB(0, 1), b2 + hstep, voffB); PG8_STAGE(PG8_SA(0, 0), a2, voffA);
            PG8_WAIT_V(8); PG8_WAIT_L(0); PG8_BAR; PG8_MMA(1, 0, At, B0); PG8_MMA(1, 1, At, B1); PG8_BAR; PG8_SCHED;
            PG8_LDB(B0, 1, 0); PG8_LDB(B1, 1, 1); PG8_SCHED; PG8_LDA(At, 1, 0); PG8_STAGE(PG8_SA(0, 1), a2 + hstep, voffA);
            PG8_WAIT_V(8); PG8_WAIT_L(0); PG8_BAR; PG8_MMA(0, 0, At, B0); PG8_MMA(0, 1, At, B1); PG8_BAR; PG8_SCHED;
            PG8_LDA(At, 1, 1); PG8_STAGE(PG8_SB(1, 0), b3, voffB); PG8_STAGE(PG8_SB(1, 1), b3 + hstep, voffB); PG8_STAGE(PG8_SA(1, 0), a3, voffA);
            PG8_WAIT_V(8); PG8_WAIT_L(0); PG8_BAR; PG8_MMA(1, 0, At, B0); PG8_MMA(1, 1, At, B1); PG8_BAR; PG8_SCHED;
        }
        if (wr == 0) PG8_BAR;
        E(acc, cur, wr, wc, fr, fq);
        if (!has_next) break;
#pragma unroll
        for (int a = 0; a < 2; ++a)
#pragma unroll
            for (int b = 0; b < 2; ++b)
#pragma unroll
                for (int m = 0; m < 4; ++m)
#pragma unroll
                    for (int n = 0; n < 2; ++n) acc[a][b][m][n] = (f32x4){0.f, 0.f, 0.f, 0.f};
        cur = nxt; cA = nA; cB = nB; ++ui;
        if (wr == 1) PG8_BAR;
    }
    PG8_WAIT_V(0);
    PG8_BAR;
#undef PG8_SA
#undef PG8_SB
#undef PG8_STAGE
#undef PG8_LDA
#undef PG8_LDB
#undef PG8_MMA
#undef PG8_WAIT_V
#undef PG8_WAIT_L
#undef PG8_BAR
#undef PG8_SCHED
}
}
using pg8::Unit;
__device__ __forceinline__ float sum_fq(float v) {
    auto a = __builtin_amdgcn_permlane16_swap(__float_as_uint(v), __float_as_uint(v), false, false); v = __uint_as_float(a[0]) + __uint_as_float(a[1]);
    auto b = __builtin_amdgcn_permlane32_swap(__float_as_uint(v), __float_as_uint(v), false, false); return __uint_as_float(b[0]) + __uint_as_float(b[1]);
}
__device__ __forceinline__ float row_rstd(const float* ssp, int row) {
    const f32x4* p = (const f32x4*)(ssp + (size_t)row * 16);
    const f32x4 a = p[0], b = p[1], c = p[2], d = p[3];
    const float ss = ((a[0] + a[1]) + (a[2] + a[3])) + ((b[0] + b[1]) + (b[2] + b[3])) + ((c[0] + c[1]) + (c[2] + c[3])) + ((d[0] + d[1]) + (d[2] + d[3]));
    return 1.0f / sqrtf(ss * (1.0f / DM) + RMS_EPS);
}
__device__ __forceinline__ float row_rstd4(const float* ssp, int row, int fq) {
    const f32x4 a = *((const f32x4*)(ssp + (size_t)row * 16) + fq);
    float ss = (a[0] + a[1]) + (a[2] + a[3]);
    ss = sum_fq(ss);
    return 1.0f / sqrtf(ss * (1.0f / DM) + RMS_EPS);
}
__device__ __forceinline__ u32x4 pack8(const f32x4 a, const f32x4 b) { u32x4 w; w.x = cvtpk(a[0], a[1]); w.y = cvtpk(a[2], a[3]); w.z = cvtpk(b[0], b[1]); w.w = cvtpk(b[2], b[3]); return w; }
__device__ __forceinline__ void rope8(f32x4& v0, f32x4& v1, const float* tab, int t, int pos, float sc) {
    const f32x4* cs = (const f32x4*)(tab + ((size_t)t * 32 + (pos >> 1)) * 2);
    const f32x4 c0 = cs[0], c1 = cs[1];
    f32x4 o0, o1;
    o0[0] = (v0[0] * c0[0] - v0[1] * c0[1]) * sc; o0[1] = (v0[1] * c0[0] + v0[0] * c0[1]) * sc;
    o0[2] = (v0[2] * c0[2] - v0[3] * c0[3]) * sc; o0[3] = (v0[3] * c0[2] + v0[2] * c0[3]) * sc;
    o1[0] = (v1[0] * c1[0] - v1[1] * c1[1]) * sc; o1[1] = (v1[1] * c1[0] + v1[0] * c1[1]) * sc;
    o1[2] = (v1[2] * c1[2] - v1[3] * c1[3]) * sc; o1[3] = (v1[3] * c1[2] + v1[2] * c1[3]) * sc;
    v0 = o0; v1 = o1;
}
struct EpiInProj {
    static constexpr bool KHOOK = false;
    const float* ssp; const float* bias; const float* tab;
    bf16_t *U, *Qn, *KV, *Mo, *G, *Gn;
    __device__ __forceinline__ void operator()(const f32x4 (&acc)[2][2][4][2], const Unit& u, int wr, int wc, int fr, int fq) const {
        asm volatile("" : "+v"(fr), "+v"(fq));
        const int pn = u.pn;
        f32x4 bia[2][2];
#pragma unroll
        for (int bj = 0; bj < 2; ++bj) { const int gc = pn * 256 + bj * 128 + wc * 32 + 8 * fq; bia[bj][0] = *(const f32x4*)(bias + gc); bia[bj][1] = *(const f32x4*)(bias + gc + 4); }
        float rs[2][4];
#pragma unroll
        for (int ai = 0; ai < 2; ++ai) { f32x4 ra[4];
#pragma unroll
            for (int m = 0; m < 4; ++m) ra[m] = *((const f32x4*)(ssp + (size_t)(u.pm * 256 + ai * 128 + wr * 64 + m * 16 + fr) * 16) + fq);
            __builtin_amdgcn_sched_barrier(0);
#pragma unroll
            for (int m = 0; m < 4; ++m) { float ss = (ra[m][0] + ra[m][1]) + (ra[m][2] + ra[m][3]); ss = sum_fq(ss); rs[ai][m] = 1.0f / sqrtf(ss * (1.0f / DM) + RMS_EPS); } }
#pragma unroll
        for (int ai = 0; ai < 2; ++ai)
#pragma unroll
            for (int m = 0; m < 4; ++m) {
                const int row = u.pm * 256 + ai * 128 + wr * 64 + m * 16 + fr;
                const float rstd = rs[ai][m];
                const int t = row & (SEQ - 1), b = row >> 13;
#pragma unroll
                for (int bj = 0; bj < 2; ++bj) {
                    const int cit = bj * 128 + wc * 32 + 8 * fq;
                    f32x4 v0 = acc[ai][bj][m][0] * rstd + bia[bj][0], v1 = acc[ai][bj][m][1] * rstd + bia[bj][1];
                    bf16_t* dst;
                    if (pn == 0) { dst = U + (size_t)row * 256 + cit; }
                    else if (pn <= 2) { const int c2 = (pn - 1) * 256 + cit, head = c2 >> 6, pos = c2 & 63; rope8(v0, v1, tab, t, pos, QSCALE); dst = Qn + ((size_t)(b * 8 + head) * SEQ + t) * 64 + pos; }
                    else if (pn <= 5) { const int c2 = cit & 127, g = c2 >> 6, pos = c2 & 63, kvi = 2 * (pn - 3) + bj; if (bj == 0) rope8(v0, v1, tab, t, pos, 1.f);
                        dst = KV + (size_t)kvi * ((size_t)MTOK * 128) + ((size_t)(b * 2 + g) * SEQ + t) * 64 + pos; }
                    else if (pn <= 8) { const int h = cit >> 6, pos = cit & 63; if (pn < 8) rope8(v0, v1, tab, t, pos, pn == 6 ? QSCALE : 1.f);
                        dst = Mo + (size_t)(pn - 6) * ((size_t)MTOK * 256) + ((size_t)(b * 4 + h) * SEQ + t) * 64 + pos; }
                    else if (pn <= 20) {
#pragma unroll
                        for (int e = 0; e < 4; ++e) { v0[e] = sigmoidf_(v0[e]); v1[e] = sigmoidf_(v1[e]); }
                        dst = G + (size_t)row * 3072 + (pn - 9) * 256 + cit; }
                    else {
#pragma unroll
                        for (int e = 0; e < 4; ++e) { v0[e] = sigmoidf_(v0[e]); v1[e] = sigmoidf_(v1[e]); }
                        dst = Gn + (size_t)row * 32 + (cit & 31); if (cit >= 32) dst = nullptr; }
                    if (dst) { if (pn >= 9 && pn <= 20) __builtin_nontemporal_store(pack8(v0, v1), (u32x4*)dst); else *(u32x4*)dst = pack8(v0, v1); }
                }
                asm volatile("" ::: "memory");
            }
    }
};
struct EpiBranch {
    static constexpr bool KHOOK = true;
    const bf16_t* G; bf16_t* out;
    __device__ __forceinline__ void khook(f32x4 (&acc)[2][2][4][2], const Unit& u, int t, int wr, int wc, int fr, int fq) const {
        asm volatile("" : "+v"(fr), "+v"(fq));
        const int gsel = (t == 4) ? 0 : 1024;
#pragma unroll
        for (int ai = 0; ai < 2; ++ai)
#pragma unroll
            for (int m = 0; m < 4; ++m) {
                u32x4 gx[2], gy[2];
#pragma unroll
                for (int bj = 0; bj < 2; ++bj) { const int row = u.pm * 256 + ai * 128 + wr * 64 + m * 16 + fr, col = u.pn * 256 + bj * 128 + wc * 32 + 8 * fq;
                    gx[bj] = *(const u32x4*)(G + (size_t)row * 3072 + gsel + col); gy[bj] = *(const u32x4*)(G + (size_t)row * 3072 + gsel + 1024 + col); }
                __builtin_amdgcn_sched_barrier(0);
#pragma unroll
                for (int bj = 0; bj < 2; ++bj)
#pragma unroll
                    for (int e = 0; e < 4; ++e) {
                        const float x0 = fmaxf(bflo(gx[bj][e]), 1e-20f), x1 = fmaxf(bfhi(gx[bj][e]), 1e-20f), y0 = fmaxf(bflo(gy[bj][e]), 1e-20f), y1 = fmaxf(bfhi(gy[bj][e]), 1e-20f);
                        const float r0 = x0 * __builtin_amdgcn_rcpf(y0), r1 = x1 * __builtin_amdgcn_rcpf(y1);
                        acc[ai][bj][m][e >> 1][(e & 1) * 2] *= r0; acc[ai][bj][m][e >> 1][(e & 1) * 2 + 1] *= r1; }
                asm volatile("" ::: "memory");
            }
    }
    __device__ __forceinline__ void operator()(const f32x4 (&acc)[2][2][4][2], const Unit& u, int wr, int wc, int fr, int fq) const {
        asm volatile("" : "+v"(fr), "+v"(fq));
#pragma unroll
        for (int ai = 0; ai < 2; ++ai) {
            u32x4 gz[4][2];
#pragma unroll
            for (int m = 0; m < 4; ++m)
#pragma unroll
                for (int bj = 0; bj < 2; ++bj) gz[m][bj] = *(const u32x4*)(G + (size_t)(u.pm * 256 + ai * 128 + wr * 64 + m * 16 + fr) * 3072 + 2048 + u.pn * 256 + bj * 128 + wc * 32 + 8 * fq);
            __builtin_amdgcn_sched_barrier(0);
#pragma unroll
            for (int m = 0; m < 4; ++m) {
                const int row = u.pm * 256 + ai * 128 + wr * 64 + m * 16 + fr;
#pragma unroll
                for (int bj = 0; bj < 2; ++bj) {
                    const int col = u.pn * 256 + bj * 128 + wc * 32 + 8 * fq; const u32x4 g = gz[m][bj];
                    f32x4 v0 = acc[ai][bj][m][0], v1 = acc[ai][bj][m][1];
                    v0[0] *= fmaxf(bflo(g[0]), 1e-20f); v0[1] *= fmaxf(bfhi(g[0]), 1e-20f); v0[2] *= fmaxf(bflo(g[1]), 1e-20f); v0[3] *= fmaxf(bfhi(g[1]), 1e-20f);
                    v1[0] *= fmaxf(bflo(g[2]), 1e-20f); v1[1] *= fmaxf(bfhi(g[2]), 1e-20f); v1[2] *= fmaxf(bflo(g[3]), 1e-20f); v1[3] *= fmaxf(bfhi(g[3]), 1e-20f);
                    *(u32x4*)(out + (size_t)row * DM + col) = pack8(v0, v1);
                }
            }
            asm volatile("" ::: "memory");
        }
    }
};
struct EpiResid {
    static constexpr bool KHOOK = false;
    const float* base_f; const bf16_t* base_b; bf16_t* xb; bf16_t* res; float* ssp;
    __device__ __forceinline__ void operator()(const f32x4 (&acc)[2][2][4][2], const Unit& u, int wr, int wc, int fr, int fq) const {
        asm volatile("" : "+v"(fr), "+v"(fq));
#pragma unroll
        for (int ai = 0; ai < 2; ++ai)
#pragma unroll
            for (int mp = 0; mp < 2; ++mp) {
                f32x4 b0[2][2], b1[2][2];
                if (base_f) {
#pragma unroll
                    for (int mm = 0; mm < 2; ++mm)
#pragma unroll
                        for (int bj = 0; bj < 2; ++bj) { const size_t off = (size_t)(u.pm * 256 + ai * 128 + wr * 64 + (2 * mp + mm) * 16 + fr) * DM + u.pn * 256 + bj * 128 + wc * 32 + 8 * fq;
                            b0[mm][bj] = *(const f32x4*)(base_f + off); b1[mm][bj] = *(const f32x4*)(base_f + off + 4); }
                    __builtin_amdgcn_sched_barrier(0);
                } else {
                    u32x4 w[2][2];
#pragma unroll
                    for (int mm = 0; mm < 2; ++mm)
#pragma unroll
                        for (int bj = 0; bj < 2; ++bj) w[mm][bj] = *(const u32x4*)(base_b + (size_t)(u.pm * 256 + ai * 128 + wr * 64 + (2 * mp + mm) * 16 + fr) * DM + u.pn * 256 + bj * 128 + wc * 32 + 8 * fq);
                    __builtin_amdgcn_sched_barrier(0);
#pragma unroll
                    for (int mm = 0; mm < 2; ++mm)
#pragma unroll
                        for (int bj = 0; bj < 2; ++bj) { const u32x4 x = w[mm][bj]; b0[mm][bj] = (f32x4){bflo(x[0]), bfhi(x[0]), bflo(x[1]), bfhi(x[1])}; b1[mm][bj] = (f32x4){bflo(x[2]), bfhi(x[2]), bflo(x[3]), bfhi(x[3])}; }
                }
#pragma unroll
                for (int mm = 0; mm < 2; ++mm) {
                    const int m = 2 * mp + mm, row = u.pm * 256 + ai * 128 + wr * 64 + m * 16 + fr;
                    float ss = 0.f;
#pragma unroll
                    for (int bj = 0; bj < 2; ++bj) {
                        const size_t off = (size_t)row * DM + u.pn * 256 + bj * 128 + wc * 32 + 8 * fq;
                        const f32x4 v0 = acc[ai][bj][m][0] + b0[mm][bj], v1 = acc[ai][bj][m][1] + b1[mm][bj];
                        const u32x4 pk = pack8(v0, v1);
                        *(u32x4*)(xb + off) = pk;
                        if (res) __builtin_nontemporal_store(pk, (u32x4*)(res + off));
                        ss += (v0[0] * v0[0] + v0[1] * v0[1]) + (v0[2] * v0[2] + v0[3] * v0[3]) + (v1[0] * v1[0] + v1[1] * v1[1]) + (v1[2] * v1[2] + v1[3] * v1[3]);
                    }
                    ss = sum_fq(ss);
                    if (fq == 0) ssp[(size_t)row * 16 + u.pn * 4 + wc] = ss;
                }
                asm volatile("" ::: "memory");
            }
    }
};
struct EpiSwiGLU {
    static constexpr bool KHOOK = false;
    const float* ssp; bf16_t* H;
    __device__ __forceinline__ void operator()(const f32x4 (&acc)[2][2][4][2], const Unit& u, int wr, int wc, int fr, int fq) const {
        asm volatile("" : "+v"(fr), "+v"(fq));
        float rs[2][4];
#pragma unroll
        for (int ai = 0; ai < 2; ++ai) { f32x4 ra[4];
#pragma unroll
            for (int m = 0; m < 4; ++m) ra[m] = *((const f32x4*)(ssp + (size_t)(u.pm * 256 + ai * 128 + wr * 64 + m * 16 + fr) * 16) + fq);
            __builtin_amdgcn_sched_barrier(0);
#pragma unroll
            for (int m = 0; m < 4; ++m) { float ss = (ra[m][0] + ra[m][1]) + (ra[m][2] + ra[m][3]); ss = sum_fq(ss); rs[ai][m] = 1.0f / sqrtf(ss * (1.0f / DM) + RMS_EPS); } }
#pragma unroll
        for (int ai = 0; ai < 2; ++ai)
#pragma unroll
            for (int m = 0; m < 4; ++m) {
                const int row = u.pm * 256 + ai * 128 + wr * 64 + m * 16 + fr;
                const float rstd = rs[ai][m];
                f32x4 o[2];
#pragma unroll
                for (int n = 0; n < 2; ++n)
#pragma unroll
                    for (int e = 0; e < 4; ++e) { const float gt = acc[ai][0][m][n][e] * rstd, up = acc[ai][1][m][n][e] * rstd; o[n][e] = gt * sigmoidf_(gt) * up; }
                *(u32x4*)(H + (size_t)row * DFF + u.pn * 128 + wc * 32 + 8 * fq) = pack8(o[0], o[1]);
                asm volatile("" ::: "memory");
            }
    }
};
namespace att {
constexpr int KCS = 1040, KSLOT = 8 * KCS, VSLOT = 8192;
constexpr int L_K0 = 0, L_V0 = 4 * KSLOT, L_WSF = 4 * KSLOT + 4 * VSLOT, L_MSK = L_WSF + 8 * 256, L_UNI = L_MSK + 1024, L_LIST = L_UNI + 64, L_END = L_LIST + 512,
              L_PS = L_END + 64, L_OT = L_PS, L_TOTAL = L_OT + 8 * 8192;
static_assert(L_TOTAL <= 147456 - 64, "attention LDS map");
#define LBAR() asm volatile("s_waitcnt lgkmcnt(0)\n\ts_barrier" ::: "memory")
#define LWAIT() asm volatile("s_waitcnt lgkmcnt(0)" ::: "memory")
__device__ __forceinline__ int crow(int r, int hi) { return (r & 3) + 8 * (r >> 2) + 4 * hi; }
__device__ __forceinline__ float swap_other(float v, int hi) { auto rr = __builtin_amdgcn_permlane32_swap(__float_as_uint(v), __float_as_uint(v), false, false); return __uint_as_float(hi ? rr[0] : rr[1]); }
__device__ __forceinline__ void qkt(f32x16& p0, f32x16& p1, const LAS char* Ks, const bf16x8* qr, const f32x16& cinit, int r32, int hi) {
    const LAS char* kb = Ks + hi * KCS + r32 * 16;
    bf16x8 kf[8];
#pragma unroll
    for (int d0 = 0; d0 < 4; ++d0) { kf[2 * d0] = *(const LAS bf16x8*)(kb + d0 * 2 * KCS); kf[2 * d0 + 1] = *(const LAS bf16x8*)(kb + d0 * 2 * KCS + 512); }
    __builtin_amdgcn_sched_barrier(0);
    p0 = __builtin_amdgcn_mfma_f32_32x32x16_bf16(kf[0], qr[0], cinit, 0, 0, 0); p1 = __builtin_amdgcn_mfma_f32_32x32x16_bf16(kf[1], qr[0], cinit, 0, 0, 0);
#pragma unroll
    for (int d0 = 1; d0 < 4; ++d0) { p0 = __builtin_amdgcn_mfma_f32_32x32x16_bf16(kf[2 * d0], qr[d0], p0, 0, 0, 0); p1 = __builtin_amdgcn_mfma_f32_32x32x16_bf16(kf[2 * d0 + 1], qr[d0], p1, 0, 0, 0); }
}
struct VFrag { s16x4 lo[8], hi[8]; };
typedef short v4i16_t __attribute__((ext_vector_type(4)));
__device__ __forceinline__ s16x4 vtr(const LAS char* p) { return __builtin_bit_cast(s16x4, __builtin_amdgcn_ds_read_tr16_b64_v4i16((LAS v4i16_t*)p)); }
__device__ __forceinline__ void v_issue(VFrag& F, const LAS char* vp) {
#pragma unroll
    for (int d0 = 0; d0 < 2; ++d0)
#pragma unroll
        for (int ks = 0; ks < 4; ++ks) { F.lo[d0 * 4 + ks] = vtr(vp + d0 * 4096 + ks * 1024); F.hi[d0 * 4 + ks] = vtr(vp + d0 * 4096 + ks * 1024 + 512); }
}
template <bool SUM> __device__ __forceinline__ void pv(f32x16* o, f32x16& osum, VFrag& F, bf16x8 pa0, bf16x8 pa1, bf16x8 pa2, bf16x8 pa3) {
#define PK(k) (bf16x8){F.lo[k][0], F.lo[k][1], F.lo[k][2], F.lo[k][3], F.hi[k][0], F.hi[k][1], F.hi[k][2], F.hi[k][3]}
    const bf16x8 ones = {0x3F80, 0x3F80, 0x3F80, 0x3F80, 0x3F80, 0x3F80, 0x3F80, 0x3F80};
    __builtin_amdgcn_s_setprio(1);
    o[0] = __builtin_amdgcn_mfma_f32_32x32x16_bf16(pa0, PK(0), o[0], 0, 0, 0);
    o[1] = __builtin_amdgcn_mfma_f32_32x32x16_bf16(pa0, PK(4), o[1], 0, 0, 0);
    if (SUM) osum = __builtin_amdgcn_mfma_f32_32x32x16_bf16(pa0, ones, osum, 0, 0, 0);
    o[0] = __builtin_amdgcn_mfma_f32_32x32x16_bf16(pa1, PK(1), o[0], 0, 0, 0);
    o[1] = __builtin_amdgcn_mfma_f32_32x32x16_bf16(pa1, PK(5), o[1], 0, 0, 0);
    if (SUM) osum = __builtin_amdgcn_mfma_f32_32x32x16_bf16(pa1, ones, osum, 0, 0, 0);
    o[0] = __builtin_amdgcn_mfma_f32_32x32x16_bf16(pa2, PK(2), o[0], 0, 0, 0);
    o[1] = __builtin_amdgcn_mfma_f32_32x32x16_bf16(pa2, PK(6), o[1], 0, 0, 0);
    if (SUM) osum = __builtin_amdgcn_mfma_f32_32x32x16_bf16(pa2, ones, osum, 0, 0, 0);
    o[0] = __builtin_amdgcn_mfma_f32_32x32x16_bf16(pa3, PK(3), o[0], 0, 0, 0);
    o[1] = __builtin_amdgcn_mfma_f32_32x32x16_bf16(pa3, PK(7), o[1], 0, 0, 0);
    if (SUM) osum = __builtin_amdgcn_mfma_f32_32x32x16_bf16(pa3, ones, osum, 0, 0, 0);
    __builtin_amdgcn_s_setprio(0);
#undef PK
}
__device__ __forceinline__ float rowmax(const f32x16& p0, const f32x16& p1, int hi) {
    float a = __builtin_fmaxf(p0[0], p1[0]);
#pragma unroll
    for (int r = 1; r < 16; ++r) a = __builtin_fmaxf(__builtin_fmaxf(a, p0[r]), p1[r]);
    return __builtin_fmaxf(a, swap_other(a, hi));
}
struct KVRegs { u32x4 k, v; };
__device__ __forceinline__ void tile_load(KVRegs& R, const bf16_t* K, const bf16_t* V, int tid) { R.k = *(const u32x4*)(K + tid * 8); R.v = *(const u32x4*)(V + tid * 8); }
__device__ __forceinline__ void tile_store(const KVRegs& R, LAS char* Ks, LAS char* Vs, int tid) {
    const int row = tid >> 3, c = tid & 7;
    *(LAS u32x4*)(Ks + c * KCS + row * 16) = R.k;
    *(LAS u32x4*)(Vs + (c >> 2) * 4096 + (row >> 4) * 1024 + (row & 15) * 64 + (c & 3) * 16) = R.v;
}
__device__ __forceinline__ void ps_accum(const f32x16 p, int jb, LAS float* ps_row, bool writer) {
#pragma unroll
    for (int rg = 0; rg < 4; ++rg) {
        float a = 2.f * (p[4 * rg] + p[4 * rg + 1] + p[4 * rg + 2]) + p[4 * rg + 3], bq = p[4 * rg + 3];
        a += __builtin_bit_cast(float, __builtin_amdgcn_update_dpp(0, __builtin_bit_cast(int, a), 0xB1, 0xF, 0xF, true)); a += __builtin_bit_cast(float, __builtin_amdgcn_update_dpp(0, __builtin_bit_cast(int, a), 0x4E, 0xF, 0xF, true));
        bq += __builtin_bit_cast(float, __builtin_amdgcn_update_dpp(0, __builtin_bit_cast(int, bq), 0xB1, 0xF, 0xF, true)); bq += __builtin_bit_cast(float, __builtin_amdgcn_update_dpp(0, __builtin_bit_cast(int, bq), 0x4E, 0xF, 0xF, true));
        const int j = jb + 2 * rg;
        if (writer) { __hip_atomic_fetch_add(ps_row + j, a, __ATOMIC_RELAXED, __HIP_MEMORY_SCOPE_WORKGROUP); if (j + 1 < 128) __hip_atomic_fetch_add(ps_row + j + 1, bq, __ATOMIC_RELAXED, __HIP_MEMORY_SCOPE_WORKGROUP); }
    }
}
struct Ctx { LAS char* lds; LAS float* wsf; LAS float* otl; int tid, wid, lane, r32, hi, vbl; };
struct RowSt { float m, l; bool started; f32x16 negm, osum; };
__device__ __forceinline__ void rowst_init(RowSt& S) { S.m = 0.f; S.l = 0.f; S.started = false; S.negm = f32x16{}; S.osum = f32x16{}; asm volatile("" : "+v"(S.negm)); }
__device__ __forceinline__ void rowst_fixed(RowSt& S, float ref) { S.m = ref; S.l = 0.f; S.started = true; S.osum = f32x16{};
#pragma unroll
    for (int r = 0; r < 16; ++r) S.negm[r] = -ref;
    asm volatile("" : "+v"(S.negm)); }
template <int MODE, class Idx, class Src, class Msk>
__device__ __forceinline__ void run_branch(const Ctx& C, int nt, const Idx& idx, const Src& src, const Msk& msk, const bf16x8* qr, RowSt& S, f32x16* o, LAS float* ps_row, bool ps_writer, KVRegs& R0, bool pre, const bf16_t* nk, const bf16_t* nv) {
    KVRegs R1; const bf16_t *kp, *vp;
    int dA = idx(0), dB = nt > 1 ? idx(1) : 0, dC = 0, dD = 0;
    if (!pre) { src(0, dA, kp, vp); tile_load(R0, kp, vp, C.tid); }
    if (nt > 1) { src(1, dB, kp, vp); tile_load(R1, kp, vp, C.tid); }
    auto compute = [&](int it, const LAS char* Ks, const LAS char* Vs, int klo, int khi, bool nm) {
        const bool kill = khi < klo;
        if (!__any(!kill)) return;
        f32x16 p0, p1; qkt(p0, p1, Ks, qr, S.negm, C.r32, C.hi);
        VFrag VF; if constexpr (MODE != 0) { v_issue(VF, Vs + C.vbl); __builtin_amdgcn_sched_barrier(0); }
        if (__any(nm && !kill)) {
#pragma unroll
            for (int r = 0; r < 16; ++r) { const int kv = crow(r, C.hi); if (kv < klo || kv > khi) p0[r] = -INFINITY; if (kv + 32 < klo || kv + 32 > khi) p1[r] = -INFINITY; }
        }
        if constexpr (MODE != 2) {
            float rm = rowmax(p0, p1, C.hi); if (kill) rm = -INFINITY;
            const bool first = !S.started && rm > -INFINITY, grow = first || rm > 8.0f;
            if (__any(grow)) {
                const float d = grow ? rm : 0.f, alpha = first ? 1.0f : __builtin_amdgcn_exp2f(-d);
                S.m += d; S.started = S.started || first;
#pragma unroll
                for (int r = 0; r < 16; ++r) { S.negm[r] = -S.m; p0[r] -= d; p1[r] -= d; }
                if constexpr (MODE == 0) S.l *= alpha;
                if constexpr (MODE == 1) {
                    if (C.hi == 0) C.wsf[C.r32] = alpha;
                    LWAIT();
#pragma unroll
                    for (int r = 0; r < 16; ++r) { const float f = C.wsf[crow(r, C.hi)]; o[0][r] *= f; o[1][r] *= f; S.osum[r] *= f; }
                    LWAIT();
                }
            }
        }
#pragma unroll
        for (int r = 0; r < 16; ++r) { p0[r] = __builtin_amdgcn_exp2f(p0[r]); p1[r] = __builtin_amdgcn_exp2f(p1[r]); }
        if constexpr (MODE == 0) {
            float s = 0.f;
#pragma unroll
            for (int r = 0; r < 16; ++r) s += p0[r] + p1[r];
            S.l += kill ? 0.f : s;
        }
        if constexpr (MODE == 2) {
            if (__any(kill)) {
#pragma unroll
                for (int r = 0; r < 16; ++r) { p0[r] = kill ? 0.f : p0[r]; p1[r] = kill ? 0.f : p1[r]; }
            }
            ps_accum(p0, 16 * it + C.hi, ps_row, ps_writer); ps_accum(p1, 16 * it + 8 + C.hi, ps_row, ps_writer);
        }
        if constexpr (MODE != 0) {
            u32x4 w0 = {cvtpk(p0[0], p0[1]), cvtpk(p0[2], p0[3]), cvtpk(p0[4], p0[5]), cvtpk(p0[6], p0[7])}, w1 = {cvtpk(p0[8], p0[9]), cvtpk(p0[10], p0[11]), cvtpk(p0[12], p0[13]), cvtpk(p0[14], p0[15])};
            u32x4 w2 = {cvtpk(p1[0], p1[1]), cvtpk(p1[2], p1[3]), cvtpk(p1[4], p1[5]), cvtpk(p1[6], p1[7])}, w3 = {cvtpk(p1[8], p1[9]), cvtpk(p1[10], p1[11]), cvtpk(p1[12], p1[13]), cvtpk(p1[14], p1[15])};
            if constexpr (MODE == 1) {
                if (__any(kill)) {
#pragma unroll
                    for (int e = 0; e < 4; ++e) { w0[e] = kill ? 0u : w0[e]; w1[e] = kill ? 0u : w1[e]; w2[e] = kill ? 0u : w2[e]; w3[e] = kill ? 0u : w3[e]; }
                }
            }
            pv<MODE == 1>(o, S.osum, VF, __builtin_bit_cast(bf16x8, w0), __builtin_bit_cast(bf16x8, w1), __builtin_bit_cast(bf16x8, w2), __builtin_bit_cast(bf16x8, w3));
        }
    };
    LBAR();
    for (int it = 0; it < nt; it += 2) {
        const int p = (it >> 1) & 1; const bool two = it + 1 < nt;
        LAS char* KsA = C.lds + L_K0 + (2 * p) * KSLOT; LAS char* VsA = C.lds + L_V0 + (2 * p) * VSLOT;
        LAS char* KsB = KsA + KSLOT; LAS char* VsB = VsA + VSLOT;
        tile_store(R0, KsA, VsA, C.tid); if (two) tile_store(R1, KsB, VsB, C.tid);
        if (it + 2 < nt) dC = idx(it + 2);
        if (it + 3 < nt) dD = idx(it + 3);
        int kloA, khiA, kloB = 0, khiB = -1; const bool nmA = msk(it, dA, kloA, khiA); bool nmB = false; if (two) nmB = msk(it + 1, dB, kloB, khiB);
        if (it + 2 < nt) { src(it + 2, dC, kp, vp); tile_load(R0, kp, vp, C.tid); } else if (nk) tile_load(R0, nk, nv, C.tid);
        if (it + 3 < nt) { src(it + 3, dD, kp, vp); tile_load(R1, kp, vp, C.tid); }
        LBAR();
        compute(it, KsA, VsA, kloA, khiA, nmA);
        if (two) compute(it + 1, KsB, VsB, kloB, khiB, nmB);
        dA = dC; dB = dD;
    }
}
template <bool FIRST> __device__ __forceinline__ void merge_branch_n(const Ctx& C, const f32x16* o, const f32x16& osum, float gate) {
    if (C.hi == 0) C.wsf[C.r32] = gate;
    LWAIT();
#pragma unroll
    for (int r0 = 0; r0 < 16; r0 += 8) {
        float gf[8], t0[8], t1[8];
#pragma unroll
        for (int r = 0; r < 8; ++r) { gf[r] = C.wsf[crow(r0 + r, C.hi)]; t0[r] = FIRST ? 0.f : C.otl[(r0 + r) * 64]; t1[r] = FIRST ? 0.f : C.otl[(16 + r0 + r) * 64]; }
        __builtin_amdgcn_sched_barrier(0);
#pragma unroll
        for (int r = 0; r < 8; ++r) { const float den = osum[r0 + r], f = den > 0.f ? gf[r] * __builtin_amdgcn_rcpf(den) : 0.f;
            C.otl[(r0 + r) * 64] = t0[r] + o[0][r0 + r] * f; C.otl[(16 + r0 + r) * 64] = t1[r] + o[1][r0 + r] * f; } }
    LWAIT();
}
template <bool FIRST> __device__ __forceinline__ void merge_branch(const Ctx& C, const f32x16* o, float factor) {
    if (C.hi == 0) C.wsf[C.r32] = factor;
    LWAIT();
#pragma unroll
    for (int r0 = 0; r0 < 16; r0 += 8) {
        float gf[8], t0[8], t1[8];
#pragma unroll
        for (int r = 0; r < 8; ++r) { gf[r] = C.wsf[crow(r0 + r, C.hi)]; t0[r] = FIRST ? 0.f : C.otl[(r0 + r) * 64]; t1[r] = FIRST ? 0.f : C.otl[(16 + r0 + r) * 64]; }
        __builtin_amdgcn_sched_barrier(0);
#pragma unroll
        for (int r = 0; r < 8; ++r) { C.otl[(r0 + r) * 64] = t0[r] + o[0][r0 + r] * gf[r]; C.otl[(16 + r0 + r) * 64] = t1[r] + o[1][r0 + r] * gf[r]; } }
    LWAIT();
}
struct Bufs { const bf16_t *Qn, *KV, *Mo, *KC, *KM, *Gn; bf16_t* Abr; };
constexpr size_t KV_STRIDE = (size_t)MTOK * 128, MO_STRIDE = (size_t)MTOK * 256;

__device__ __forceinline__ void nsa_item(const Ctx& C, const Bufs& B, int b, int g, int i) {
    const int r32 = C.r32, hi = C.hi, wid = C.wid;
    const int qi = 8 * wid + (r32 >> 2), hh = r32 & 3, head = g * 4 + hh, t = 64 * i + qi, cur = i;
    const size_t bg = (size_t)(b * 2 + g) * SEQ;
    bf16x8 qr[4];
    { const bf16_t* qp = B.Qn + ((size_t)(b * 8 + head) * SEQ + t) * 64 + hi * 8;
#pragma unroll
      for (int d0 = 0; d0 < 4; ++d0) qr[d0] = *(const bf16x8*)(qp + d0 * 16); }
    const unsigned gw = *(const unsigned*)(B.Gn + ((size_t)b * SEQ + t) * 32 + head * 3 - (head & 1));
    const unsigned gw2 = *(const unsigned*)(B.Gn + ((size_t)b * SEQ + t) * 32 + head * 3 - (head & 1) + 2);
    float g0, g1, g2; if (head & 1) { g0 = bfhi(gw); g1 = bflo(gw2); g2 = bfhi(gw2); } else { g0 = bflo(gw); g1 = bfhi(gw); g2 = bflo(gw2); }
    f32x16 o[2];
    LAS float* Ps = (LAS float*)(C.lds + L_PS); LAS unsigned* Mk = (LAS unsigned*)(C.lds + L_MSK); LAS unsigned* Uni = (LAS unsigned*)(C.lds + L_UNI); LAS int* List = (LAS int*)(C.lds + L_LIST);
    const int nv = t >= 31 ? ((t - 31) >> 4) + 1 : 0;
    const int nvt = (4 * i + 3 < 511) ? 4 * i + 3 : 511, ntc = (nvt + 63) >> 6;
    const bf16_t* kc = B.KC + (size_t)(0 * 4 + b * 2 + g) * 512 * 64; const bf16_t* vc = B.KC + (size_t)(1 * 4 + b * 2 + g) * 512 * 64;
    auto idxI = [&](int it) { return it; };
    auto srcC = [&](int it, int, const bf16_t*& kp, const bf16_t*& vp) { kp = kc + (size_t)it * 4096; vp = vc + (size_t)it * 4096; };
    auto mskC = [&](int it, int, int& klo, int& khi) { klo = 0; khi = nv - 1 - 64 * it; return khi < 63; };
    RowSt S; rowst_init(S);
    KVRegs R;
    run_branch<0>(C, ntc, idxI, srcC, mskC, qr, S, o, nullptr, false, R, false, kc, vc);
    const float lt = S.l + swap_other(S.l, hi);
    rowst_fixed(S, lt > 0.f ? S.m + __builtin_amdgcn_logf(lt) : 0.f);
    for (int e = C.tid; e < 64 * 128; e += 512) Ps[e] = 0.f;
    if (C.tid < 8) Uni[C.tid] = 0u;
    o[0] = f32x16{}; o[1] = f32x16{};
    run_branch<2>(C, ntc, idxI, srcC, mskC, qr, S, o, Ps + qi * 128, hh == 0, R, true, B.KV + 2 * KV_STRIDE + bg * 64, B.KV + 3 * KV_STRIDE + bg * 64);
    LBAR();
    {
        const int nf = cur == 0 ? 1 : (cur == 1 ? 2 : 3), kp_ = 16 - nf, lane = C.lane;
#pragma unroll 1
        for (int qq = 0; qq < 8; ++qq) {
            int q = 8 * wid + qq; asm volatile("" : "+s"(q)); LAS float* ps = Ps + q * 128;
            const int j0 = lane, j1 = lane + 64;
            const bool f0 = (j0 == 0 || j0 == cur || j0 == cur - 1) && j0 <= cur, f1 = (j1 == cur || j1 == cur - 1) && j1 <= cur;
            const bool va0 = j0 <= cur && !f0, va1 = j1 <= cur && !f1;
            const unsigned k0 = va0 ? __float_as_uint(ps[j0]) + 1u : 0u, k1 = va1 ? __float_as_uint(ps[j1]) + 1u : 0u;
            unsigned T = 0u;
            for (int bit = 30; bit >= 0; --bit) { const unsigned cand = T | (1u << bit); const int cnt = __popcll(__ballot(k0 >= cand)) + __popcll(__ballot(k1 >= cand)); if (cnt >= kp_) T = cand; }
            const int need = kp_ - (__popcll(__ballot(k0 > T)) + __popcll(__ballot(k1 > T)));
            const unsigned long long t0 = __ballot(k0 == T), t1 = __ballot(k1 == T), below = (1ull << lane) - 1ull;
            const int pre0 = __popcll(t0 & below), pre1 = __popcll(t0) + __popcll(t1 & below);
            const bool s0 = f0 || (k0 > 0u && (k0 > T || (k0 == T && pre0 < need))), s1 = f1 || (k1 > 0u && (k1 > T || (k1 == T && pre1 < need)));
            const unsigned long long b0 = __ballot(s0), b1 = __ballot(s1);
            if (lane == 0) { Mk[q * 4 + 0] = (unsigned)b0; Mk[q * 4 + 1] = (unsigned)(b0 >> 32); Mk[q * 4 + 2] = (unsigned)b1; Mk[q * 4 + 3] = (unsigned)(b1 >> 32);
                __hip_atomic_fetch_or(&Uni[0], (unsigned)b0, __ATOMIC_RELAXED, __HIP_MEMORY_SCOPE_WORKGROUP); __hip_atomic_fetch_or(&Uni[1], (unsigned)(b0 >> 32), __ATOMIC_RELAXED, __HIP_MEMORY_SCOPE_WORKGROUP); __hip_atomic_fetch_or(&Uni[2], (unsigned)b1, __ATOMIC_RELAXED, __HIP_MEMORY_SCOPE_WORKGROUP); __hip_atomic_fetch_or(&Uni[3], (unsigned)(b1 >> 32), __ATOMIC_RELAXED, __HIP_MEMORY_SCOPE_WORKGROUP); }
        }
    }
    LBAR();
    if (C.tid < 128) {
        const int wi = C.tid >> 5, bi = C.tid & 31; const unsigned u0 = Uni[0], u1 = Uni[1], u2 = Uni[2], u3 = Uni[3];
        const unsigned mine = wi == 0 ? u0 : wi == 1 ? u1 : wi == 2 ? u2 : u3;
        const int before = (wi > 0 ? __popc(u0) : 0) + (wi > 1 ? __popc(u1) : 0) + (wi > 2 ? __popc(u2) : 0) + __popc(mine & ((1u << bi) - 1u));
        if ((mine >> bi) & 1u) List[before] = C.tid;
        if (C.tid == 0) Uni[4] = (unsigned)(__popc(u0) + __popc(u1) + __popc(u2) + __popc(u3));
    }
    LBAR();
    merge_branch<true>(C, o, g0);
    {
        const int nsel = (int)Uni[4];
        const bf16_t* ks = B.KV + 2 * KV_STRIDE + bg * 64; const bf16_t* vs = B.KV + 3 * KV_STRIDE + bg * 64;
        auto idxS = [&](int it) { return List[it]; };
        auto srcS = [&](int, int j, const bf16_t*& kp, const bf16_t*& vp) { kp = ks + (size_t)j * 4096; vp = vs + (size_t)j * 4096; };
        auto mskS = [&](int, int j, int& klo, int& khi) { const unsigned w = Mk[qi * 4 + (j >> 5)]; const bool bit = (w >> (j & 31)) & 1u;
            klo = 0; khi = bit ? (j == cur ? qi : 63) : -1; return j == cur; };
        rowst_init(S); o[0] = f32x16{}; o[1] = f32x16{};
        const int tw0n = i >= 8 ? i - 8 : 0;
        run_branch<1>(C, nsel, idxS, srcS, mskS, qr, S, o, nullptr, false, R, true, B.KV + 4 * KV_STRIDE + bg * 64 + (size_t)tw0n * 4096, B.KV + 5 * KV_STRIDE + bg * 64 + (size_t)tw0n * 4096);
        merge_branch_n<false>(C, o, S.osum, g1);
    }
    {
        const int tw0 = i >= 8 ? i - 8 : 0, ntw = i - tw0 + 1;
        const bf16_t* kw = B.KV + 4 * KV_STRIDE + bg * 64; const bf16_t* vw = B.KV + 5 * KV_STRIDE + bg * 64;
        auto srcW = [&](int it, int, const bf16_t*& kp, const bf16_t*& vp) { kp = kw + (size_t)(tw0 + it) * 4096; vp = vw + (size_t)(tw0 + it) * 4096; };
        auto mskW = [&](int it, int, int& klo, int& khi) { const int tw = tw0 + it; klo = (t - 511) - 64 * tw; khi = (tw == i) ? qi : 63; return tw == i || klo > 0; };
        rowst_init(S); o[0] = f32x16{}; o[1] = f32x16{};
        run_branch<1>(C, ntw, idxI, srcW, mskW, qr, S, o, nullptr, false, R, true, nullptr, nullptr);
        merge_branch_n<false>(C, o, S.osum, g2);
    }
#pragma unroll
    for (int r0 = 0; r0 < 16; r0 += 8) { float t0[8], t1[8];
#pragma unroll
        for (int r = 0; r < 8; ++r) { t0[r] = C.otl[(r0 + r) * 64]; t1[r] = C.otl[(16 + r0 + r) * 64]; }
        __builtin_amdgcn_sched_barrier(0);
#pragma unroll
        for (int r = 0; r < 8; ++r) { const int qrow = crow(r0 + r, hi); bf16_t* dst = B.Abr + ((size_t)b * SEQ + 64 * i + 8 * wid + (qrow >> 2)) * DM + 256 + (g * 4 + (qrow & 3)) * 64 + r32;
            dst[0] = (bf16_t)(cvtpk(t0[r], 0.f) & 0xffffu); dst[32] = (bf16_t)(cvtpk(t1[r], 0.f) & 0xffffu); } }
}
__device__ __forceinline__ void moba_item(const Ctx& C, const Bufs& B, int b, int h, int qb) {
    const int r32 = C.r32, hi = C.hi, wid = C.wid, own = qb, t = 256 * qb + 32 * wid + r32;
    const size_t bh = (size_t)(b * 4 + h) * SEQ;
    bf16x8 qr[4];
    { const bf16_t* qp = B.Mo + (bh + t) * 64 + hi * 8;
#pragma unroll
      for (int d0 = 0; d0 < 4; ++d0) qr[d0] = *(const bf16x8*)(qp + d0 * 16); }
    LAS unsigned* Uni = (LAS unsigned*)(C.lds + L_UNI); LAS int* List = (LAS int*)(C.lds + L_LIST);
    LBAR();
    if (C.tid < 256) { const u32x4 kmv = *(const u32x4*)(B.KM + (size_t)(b * 4 + h) * 2048 + C.tid * 8); *(LAS u32x4*)(C.lds + L_K0 + (C.tid & 7) * KCS + (C.tid >> 3) * 16) = kmv; }
    if (C.tid == 0) Uni[0] = 0u;
    LBAR();
    unsigned sel = 0u;
    {
        f32x16 gs = f32x16{};
        const LAS char* kb = C.lds + L_K0 + hi * KCS + r32 * 16;
#pragma unroll
        for (int d0 = 0; d0 < 4; ++d0) gs = __builtin_amdgcn_mfma_f32_32x32x16_bf16(*(const LAS bf16x8*)(kb + d0 * 2 * KCS), qr[d0], gs, 0, 0, 0);
        float lo[16], hv[16];
#pragma unroll
        for (int r = 0; r < 16; ++r) { const float ownv = gs[r], oth = swap_other(ownv, hi); lo[r] = hi ? oth : ownv; hv[r] = hi ? ownv : oth; }
        unsigned taken = ~((1u << own) - 1u);
#pragma unroll
        for (int round = 0; round < 3; ++round) {
            float best = -INFINITY; int bi = 32;
#pragma unroll
            for (int n = 0; n < 32; ++n) { const int rr = (n & 3) + 4 * (n >> 3); const float v = ((n >> 2) & 1) ? hv[rr] : lo[rr]; if (!((taken >> n) & 1u) && v > best) { best = v; bi = n; } }
            if (bi < 32) { sel |= 1u << bi; taken |= 1u << bi; }
        }
    }
    { unsigned u = sel;
#pragma unroll
      for (int o_ = 1; o_ < 64; o_ <<= 1) u |= (unsigned)__shfl_xor((int)u, o_);
      if (C.lane == 0) __hip_atomic_fetch_or(&Uni[0], u, __ATOMIC_RELAXED, __HIP_MEMORY_SCOPE_WORKGROUP); }
    LBAR();
    if (C.tid == 0) { int n = 0; unsigned u = Uni[0]; while (u) { const int bpos = __builtin_ctz(u); u &= u - 1; List[n++] = bpos; } Uni[4] = (unsigned)n; }
    LBAR();
    const int nl = (int)Uni[4], nt = 4 * nl + 4;
    const bf16_t* kk = B.Mo + MO_STRIDE + bh * 64; const bf16_t* vv = B.Mo + 2 * MO_STRIDE + bh * 64;
    auto idxM = [&](int it) { return (it < 4 * nl) ? List[it >> 2] : own; };
    auto src = [&](int it, int blk, const bf16_t*& kp, const bf16_t*& vp) { const int T = 4 * blk + ((it < 4 * nl) ? (it & 3) : (it - 4 * nl)); kp = kk + (size_t)T * 4096; vp = vv + (size_t)T * 4096; };
    auto msk = [&](int it, int blk, int& klo, int& khi) { klo = 0; if (it < 4 * nl) { const bool bit = (sel >> blk) & 1u; khi = bit ? 63 : -1; return false; } khi = 32 * wid + r32 - 64 * (it - 4 * nl); return true; };
    RowSt S; rowst_init(S); f32x16 o[2] = {f32x16{}, f32x16{}};
    KVRegs R;
    run_branch<1>(C, nt, idxM, src, msk, qr, S, o, nullptr, false, R, false, nullptr, nullptr);
    merge_branch_n<true>(C, o, S.osum, 1.0f);
#pragma unroll
    for (int r0 = 0; r0 < 16; r0 += 8) { float t0[8], t1[8];
#pragma unroll
        for (int r = 0; r < 8; ++r) { t0[r] = C.otl[(r0 + r) * 64]; t1[r] = C.otl[(16 + r0 + r) * 64]; }
        __builtin_amdgcn_sched_barrier(0);
#pragma unroll
        for (int r = 0; r < 8; ++r) { const int qrow = crow(r0 + r, hi); bf16_t* dst = B.Abr + ((size_t)b * SEQ + 256 * qb + 32 * wid + qrow) * DM + 768 + h * 64 + r32;
            dst[0] = (bf16_t)(cvtpk(t0[r], 0.f) & 0xffffu); dst[32] = (bf16_t)(cvtpk(t1[r], 0.f) & 0xffffu); } }
}
}
#define XB_TMO      128
#define XB_XCNT(j)  (256  + 64 * (j))
#define XB_XSUB(j)  (1280 + 64 * (j))
#define XB_XGEN(j)  (2304 + 64 * (j))
#define XB_TOP      3328
#define XB_TOPGEN   3392
#define XCD_BAR_WORDS 3456
#define XB_SPIN_CAP (1u << 18)

__device__ __forceinline__ unsigned xb_ld(unsigned* p)              { return __hip_atomic_load(p, __ATOMIC_RELAXED, __HIP_MEMORY_SCOPE_AGENT); }
__device__ __forceinline__ unsigned xb_add(unsigned* p, unsigned v) { return __hip_atomic_fetch_add(p, v, __ATOMIC_RELAXED, __HIP_MEMORY_SCOPE_AGENT); }
__device__ __forceinline__ unsigned xb_xcc_id() { return (unsigned)__builtin_amdgcn_s_getreg((3 << 11) | 20) & 0xFu; }
#define XB_SPIN(cond, bar) do { unsigned _sp = 0; while (cond) { __builtin_amdgcn_s_sleep(1); \
    if ((++_sp & 255u) == 0u) { if (xb_ld(&(bar)[XB_TMO])) break; if (_sp > XB_SPIN_CAP) { atomicAdd(&(bar)[XB_TMO], 1u); break; } } } } while (0)

struct XcdBarrier {
    unsigned* bar; unsigned x;
    volatile LAS unsigned* st;
};

__device__ __forceinline__ XcdBarrier xcd_barrier_post(unsigned* bar, volatile LAS unsigned* st) {
    XcdBarrier b; b.bar = bar; b.x = xb_xcc_id(); b.st = st;
    if (threadIdx.x == 0) (void)xb_add(&bar[XB_XCNT(b.x)], 1u);
    return b;
}
__device__ __forceinline__ void xcd_barrier_complete(unsigned* bar, unsigned x, unsigned& nloc, unsigned& nx) {
    const unsigned G = gridDim.x * gridDim.y * gridDim.z;
    unsigned sum, cnt, mine, sp = 0u;
    for (;;) {
        sum = 0u; cnt = 0u; mine = 0u;
#pragma unroll
        for (unsigned j = 0; j < 16; ++j) { const unsigned c = xb_ld(&bar[XB_XCNT(j)]); sum += c; cnt += (c > 0u) ? 1u : 0u; mine = (j == x) ? c : mine; }
        if (sum == G) break;
        __builtin_amdgcn_s_sleep(1);
        if ((++sp & 255u) == 0u) { if (xb_ld(&bar[XB_TMO])) break; if (sp > XB_SPIN_CAP) { atomicAdd(&bar[XB_TMO], 1u); break; } }
    }
    nloc = mine > 0u ? mine : 1u; nx = cnt > 0u ? cnt : 1u;
}

__device__ __forceinline__ void xcd_barrier(const XcdBarrier& b) {
    asm volatile("s_waitcnt vmcnt(0)" ::: "memory");
    __syncthreads();
    if (threadIdx.x == 0) {
        unsigned* bar = b.bar;
        __builtin_amdgcn_s_waitcnt(0);
        unsigned nloc = b.st[0], nx = b.st[1];
        if (nloc == 0u) { xcd_barrier_complete(bar, b.x, nloc, nx); b.st[0] = nloc; b.st[1] = nx; }
        const unsigned old = xb_add(&bar[XB_XSUB(b.x)], 1u);
        const unsigned gen = old / nloc;
        if (old + 1u == (gen + 1u) * nloc) {
            __builtin_amdgcn_fence(__ATOMIC_RELEASE, "agent");
            asm volatile("s_waitcnt vmcnt(0)" ::: "memory");
            const unsigned og = xb_add(&bar[XB_TOP], 1u);
            const unsigned tg = og / nx;
            if (og + 1u == (tg + 1u) * nx) xb_add(&bar[XB_TOPGEN], 1u);
            else XB_SPIN(xb_ld(&bar[XB_TOPGEN]) == tg, bar);
            __builtin_amdgcn_fence(__ATOMIC_ACQUIRE, "agent");
            xb_add(&bar[XB_XGEN(b.x)], 1u);
            asm volatile("s_waitcnt vmcnt(0)" ::: "memory");
        } else {
            XB_SPIN(xb_ld(&bar[XB_XGEN(b.x)]) == gen, bar);
            __builtin_amdgcn_fence(__ATOMIC_ACQUIRE, "agent");
            asm volatile("s_waitcnt vmcnt(0)" ::: "memory");
        }
    }
    __syncthreads();
}

constexpr size_t MiB = 1u << 20;
constexpr size_t WS_CTL = 0, WS_ORDER = 4096, WS_BAR = 8192;
constexpr size_t WS_W = 1 * MiB, OFF_WIN = 0, OFF_WGU = 11 * MiB, OFF_WD = 22 * MiB, OFF_WBR = 28 * MiB, OFF_WOUT = 30 * MiB, OFF_W1 = 32 * MiB, OFF_W2 = 34 * MiB,
                 OFF_BIN = 34 * MiB + 65536, OFF_CB1 = OFF_BIN + 32768  , OFF_CB2 = OFF_CB1 + 65536;
constexpr size_t WS_TAB = 36 * MiB, WS_SSP = 38 * MiB, WS_KC = 39 * MiB, WS_KM = 39 * MiB + 512 * 1024, WS_GN = 40 * MiB, WS_XB = 42 * MiB, WS_BIG = 74 * MiB,
                 WS_U = 170 * MiB, WS_QN = 178 * MiB, WS_KV = 194 * MiB, WS_MO = 218 * MiB, WS_MRG = 178 * MiB, WS_END = 242 * MiB;
constexpr int LDS_BYTES = 147456;

__device__ __forceinline__ int dint(int pos) { return (pos >> 1) + 32 * (pos & 1); }
__device__ __forceinline__ int in_orig(int c) {
    if (c < 256) return c;
    if (c < 768) { const int c2 = c - 256; return 256 + (c2 >> 6) * 64 + dint(c2 & 63); }
    if (c < 1536) { const int c2 = c - 768, tt = c2 >> 8, bj = (c2 >> 7) & 1, g = (c2 >> 6) & 1, pos = c2 & 63; return 768 + (2 * tt + bj) * 128 + g * 64 + (bj == 0 ? dint(pos) : pos); }
    if (c < 2304) { const int c2 = c - 1536, part = c2 >> 8, h = (c2 >> 6) & 3, pos = c2 & 63; return 1560 + part * 256 + h * 64 + (part < 2 ? dint(pos) : pos); }
    if (c < 5376) return 2328 + (c - 2304);
    const int c2 = c - 5376; return c2 < 24 ? 1536 + c2 : -1;
}
template <class F> __device__ __forceinline__ void cvt_tile(LAS float* scr, int lane, int k0, int n0, bf16_t* dst, size_t pitch, F f) {
    float vals[32];
#pragma unroll
    for (int i = 0; i < 32; ++i) vals[i] = f(k0 + 2 * i + (lane >> 5), n0 + (lane & 31));
#pragma unroll
    for (int i = 0; i < 32; ++i) scr[(2 * i + (lane >> 5)) * 33 + (lane & 31)] = vals[i];
    asm volatile("s_waitcnt lgkmcnt(0)" ::: "memory");
    const int c = lane & 7;
#pragma unroll
    for (int j = 0; j < 4; ++j) { const int n = (lane >> 3) + 8 * j; const LAS float* s = scr + (8 * c) * 33 + n;
        u32x4 o; o.x = cvtpk(s[0 * 33], s[1 * 33]); o.y = cvtpk(s[2 * 33], s[3 * 33]); o.z = cvtpk(s[4 * 33], s[5 * 33]); o.w = cvtpk(s[6 * 33], s[7 * 33]);
        *(u32x4*)(dst + (size_t)(n0 + n) * pitch + k0 + 8 * c) = o; }
    asm volatile("s_waitcnt lgkmcnt(0)" ::: "memory");
}
template <class F> __device__ __forceinline__ void cvt_tile_scaled(LAS float* scr, int lane, int k0, int n0, bf16_t* dst, size_t pitch, F f, const float* scale, float keep) {
    float vals[32], sc[32];
#pragma unroll
    for (int i = 0; i < 32; ++i) { vals[i] = f(k0 + 2 * i + (lane >> 5), n0 + (lane & 31)); sc[i] = scale[k0 + 2 * i + (lane >> 5)]; }
    __builtin_amdgcn_sched_barrier(0);
#pragma unroll
    for (int i = 0; i < 32; ++i) scr[(2 * i + (lane >> 5)) * 33 + (lane & 31)] = vals[i] * (sc[i] * keep);
    asm volatile("s_waitcnt lgkmcnt(0)" ::: "memory");
    const int c = lane & 7;
#pragma unroll
    for (int j = 0; j < 4; ++j) { const int n = (lane >> 3) + 8 * j; const LAS float* s = scr + (8 * c) * 33 + n;
        u32x4 o; o.x = cvtpk(s[0 * 33], s[1 * 33]); o.y = cvtpk(s[2 * 33], s[3 * 33]); o.z = cvtpk(s[4 * 33], s[5 * 33]); o.w = cvtpk(s[6 * 33], s[7 * 33]);
        *(u32x4*)(dst + (size_t)(n0 + n) * pitch + k0 + 8 * c) = o; }
    asm volatile("s_waitcnt lgkmcnt(0)" ::: "memory");
}
struct Args { const float* in[20]; float* out; unsigned char* ws; };
typedef const __attribute__((address_space(4))) Args* ArgsP;

__device__ __forceinline__ void phase0(ArgsP a, int l, LAS unsigned char* lds, int tid, int lane, int wave, int gw, int NGW) {
    unsigned char* ws = a->ws;
    LAS float* scr = (LAS float*)(lds + wave * 8704);
    const float* attn_norm = a->in[1] + (size_t)l * DM; const float* w_in = a->in[2] + (size_t)l * DM * IN_COLS; const float* b_in = a->in[3] + (size_t)l * IN_COLS;
    const float* pool_w = a->in[4] + (size_t)l * 4 * 64 * 64; const float* pool_scale = a->in[5] + (size_t)l * 256; const float* cmp_pos = a->in[6] + (size_t)l * 2 * 32 * 64;
    const float* cmp_w1 = a->in[7] + (size_t)l * 2 * 2048 * 256; const float* cmp_b1 = a->in[8] + (size_t)l * 2 * 256; const float* cmp_w2 = a->in[9] + (size_t)l * 2 * 256 * 64; const float* cmp_b2 = a->in[10] + (size_t)l * 2 * 64;
    const float* w_br_pool = a->in[11] + (size_t)l * 256 * DM; const float* w_br_nsa = a->in[12] + (size_t)l * 512 * DM; const float* w_br_moba = a->in[13] + (size_t)l * 256 * DM;
    const float* w_out = a->in[14] + (size_t)l * DM * DM; const float* ffn_norm = a->in[15] + (size_t)l * DM; const float* w_gate = a->in[16] + (size_t)l * DM * DFF; const float* w_up = a->in[17] + (size_t)l * DM * DFF;
    const float* w_down = a->in[18] + (size_t)l * DFF * DM;
    bf16_t* Win = (bf16_t*)(ws + WS_W + OFF_WIN); bf16_t* Wgu = (bf16_t*)(ws + WS_W + OFF_WGU); bf16_t* Wd = (bf16_t*)(ws + WS_W + OFF_WD); bf16_t* Wbr = (bf16_t*)(ws + WS_W + OFF_WBR);
    bf16_t* Wout = (bf16_t*)(ws + WS_W + OFF_WOUT); bf16_t* W1t = (bf16_t*)(ws + WS_W + OFF_W1); bf16_t* W2t = (bf16_t*)(ws + WS_W + OFF_W2);
    float* bin = (float*)(ws + WS_W + OFF_BIN); float* cb1 = (float*)(ws + WS_W + OFF_CB1); float* cb2 = (float*)(ws + WS_W + OFF_CB2);
    constexpr int I_A = 16 * 176, I_B = 16 * 176, I_C = 44 * 32, I_D = 16 * 32, I_E = 16 * 32, I_F = 2 * 32 * 8, I_G = 2 * 4 * 2;
    constexpr int NITEMS = I_A + I_B + I_C + I_D + I_E + I_F + I_G;
    for (int it = gw; it < NITEMS; it += NGW) {
        int r = it;
        if (r < I_A) { const int kb = r / 176, nb = r % 176; { const int o = in_orig(32 * nb + (lane & 31)); const float* wc = w_in + (o >= 0 ? o : 0); const float keep = o >= 0 ? 1.f : 0.f;
            cvt_tile_scaled(scr, lane, 64 * kb, 32 * nb, Win, DM, [&](int k, int) { return __builtin_nontemporal_load(wc + (size_t)k * IN_COLS); }, attn_norm, keep); } continue; } r -= I_A;
        if (r < I_B) { const int kb = r / 176, nb = r % 176; { const int n = 32 * nb + (lane & 31), j = (n >> 8) * 128 + (n & 127); const float* wc = (((n >> 7) & 1) ? w_up : w_gate) + j;
            cvt_tile_scaled(scr, lane, 64 * kb, 32 * nb, Wgu, DM, [&](int k, int) { return __builtin_nontemporal_load(wc + (size_t)k * DFF); }, ffn_norm, 1.f); } continue; } r -= I_B;
        if (r < I_C) { const int kb = r / 32, nb = r % 32; cvt_tile(scr, lane, 64 * kb, 32 * nb, Wd, DFF, [&](int k, int n) { return __builtin_nontemporal_load(w_down + (size_t)k * DM + n); }); continue; } r -= I_C;
        if (r < I_D) { const int kb = r / 32, nb = r % 32; cvt_tile(scr, lane, 64 * kb, 32 * nb, Wout, DM, [&](int k, int n) { return __builtin_nontemporal_load(w_out + (size_t)k * DM + n); }); continue; } r -= I_D;
        if (r < I_E) { const int kb = r / 32, nb = r % 32;
            if (kb < 4) { }
            else if (kb < 12) cvt_tile(scr, lane, 64 * kb, 32 * nb, Wbr, DM, [&](int k, int n) { return __builtin_nontemporal_load(w_br_nsa + (size_t)(k - 256) * DM + n); });
            else cvt_tile(scr, lane, 64 * kb, 32 * nb, Wbr, DM, [&](int k, int n) { return __builtin_nontemporal_load(w_br_moba + (size_t)(k - 768) * DM + n); });
            continue; } r -= I_E;
        if (r < I_F) { const int kv = r >> 8, kb = (r >> 3) & 31, nb = r & 7; const float* w1 = cmp_w1 + (size_t)kv * 2048 * 256;
            cvt_tile(scr, lane, 64 * kb, 32 * nb, W1t + (size_t)kv * 256 * 2048, 2048, [&](int k, int n) { const int pos = k & 63, d = kv == 0 ? dint(pos) : pos; return w1[(size_t)((k & ~63) + d) * 256 + n]; }); continue; } r -= I_F;
        { const int kv = r >> 3, kb = (r >> 1) & 3, nb = r & 1; const float* w2 = cmp_w2 + (size_t)kv * 256 * 64;
            cvt_tile(scr, lane, 64 * kb, 32 * nb, W2t + (size_t)kv * 64 * 256, 256, [&](int k, int n) { return w2[(size_t)k * 64 + (kv == 0 ? dint(n) : n)]; }); }
    }
    const int gt = gw * 64 + lane, NGT = NGW * 64;
    for (int c = gt; c < NIN; c += NGT) { const int o = in_orig(c); bin[c] = o >= 0 ? b_in[o] : 0.f; }
    for (int idx = gt; idx < 32 * 512; idx += NGT) { const int c = idx >> 9, e = idx & 511, kv = e >> 8, n = e & 255; const float* w1 = cmp_w1 + (size_t)kv * 2048 * 256 + (size_t)(64 * c) * 256 + n; const float* pe = cmp_pos + (size_t)kv * 2048 + 64 * c;
        float s = c == 0 ? cmp_b1[kv * 256 + n] : 0.f;
#pragma unroll
        for (int k0 = 0; k0 < 64; k0 += 32) { float av[32], bv[32];
#pragma unroll
            for (int k = 0; k < 32; ++k) { av[k] = pe[k0 + k]; bv[k] = w1[(size_t)(k0 + k) * 256]; }
            __builtin_amdgcn_sched_barrier(0);
#pragma unroll
            for (int k = 0; k < 32; ++k) s += av[k] * bv[k]; }
        cb1[idx] = s; }
    for (int idx = gt; idx < 256 * DM; idx += NGT) { const int k = idx >> 10, n = idx & 1023, g64 = k & ~63; float s = 0.f;
        const f32x4* pw4 = (const f32x4*)(pool_w + (size_t)k * 64); const f32x4* ps4 = (const f32x4*)(pool_scale + g64);
#pragma unroll
        for (int j0 = 0; j0 < 64; j0 += 32) { f32x4 pw[8], psc[8]; float wb[32];
#pragma unroll
            for (int q = 0; q < 8; ++q) { pw[q] = pw4[j0 / 4 + q]; psc[q] = ps4[j0 / 4 + q]; }
#pragma unroll
            for (int j = 0; j < 32; ++j) wb[j] = w_br_pool[(size_t)(g64 + j0 + j) * DM + n];
            __builtin_amdgcn_sched_barrier(0);
#pragma unroll
            for (int j = 0; j < 32; ++j) s += pw[j >> 2][j & 3] * psc[j >> 2][j & 3] * wb[j]; }
        Wbr[(size_t)n * DM + k] = (bf16_t)(cvtpk(s, 0.f) & 0xffffu); }
    for (int e = gt; e < 128; e += NGT) { const int kv = e >> 6, n = e & 63; cb2[e] = cmp_b2[kv * 64 + (kv == 0 ? dint(n) : n)]; }
    if (l == 0) {
        float* tab = (float*)(ws + WS_TAB);
        for (int e = gt; e < SEQ * 32; e += NGT) { const int t = e >> 5, f = e & 31; const float inv = powf(10000.0f, -(float)(2 * f) / 64.0f); const float ang = (float)t * inv;
            const double ad = (double)ang, kq = rint(ad * 0.15915494309189535); double rr = fma(-kq, 6.283185307179586, ad); rr = fma(-kq, 2.4492935982947064e-16, rr);
            const float rf = (float)rr; tab[2 * e] = __cosf(rf); tab[2 * e + 1] = __sinf(rf); }
        const float* x = a->in[0]; bf16_t* xb = (bf16_t*)(ws + WS_XB); float* ssp = (float*)(ws + WS_SSP);
        for (int m0 = 2 * gw; m0 < MTOK; m0 += 2 * NGW) { f32x4 v[2][4]; float s[2] = {0.f, 0.f};
#pragma unroll
            for (int q = 0; q < 2; ++q) { const f32x4* xr = (const f32x4*)(x + (size_t)(m0 + q) * DM) + lane;
#pragma unroll
                for (int j = 0; j < 4; ++j) v[q][j] = __builtin_nontemporal_load(xr + 64 * j); }
#pragma unroll
            for (int q = 0; q < 2; ++q) {
#pragma unroll
                for (int j = 0; j < 4; ++j) s[q] += (v[q][j][0] * v[q][j][0] + v[q][j][1] * v[q][j][1]) + (v[q][j][2] * v[q][j][2] + v[q][j][3] * v[q][j][3]);
#pragma unroll
                for (int o = 1; o < 64; o <<= 1) s[q] += __shfl_xor(s[q], o);
                u32x2* o8 = (u32x2*)(xb + (size_t)(m0 + q) * DM) + lane;
#pragma unroll
                for (int j = 0; j < 4; ++j) o8[64 * j] = (u32x2){cvtpk(v[q][j][0], v[q][j][1]), cvtpk(v[q][j][2], v[q][j][3])};
                if (lane < 16) ssp[(size_t)(m0 + q) * 16 + lane] = lane == 0 ? s[q] : 0.f; } }
        int* order = (int*)(ws + WS_ORDER);
        auto cost = [](int id) { if (id < 512) { const int i = id & 127; return 10 * ((i + 1) + ((i < 8 ? i : 8) + 1) + 10) + 16 * ((4 * i + 3 + 63) >> 6); } const int qb = (id - 512) & 31; return 7 * (4 * qb + 3) + 50; };
        for (int id = gw; id < 768; id += NGW) { const int mc = cost(id); int rk = 0;
            for (int j = lane; j < 768; j += 64) { const int cj = cost(j); rk += (cj > mc || (cj == mc && j < id)) ? 1 : 0; }
#pragma unroll
            for (int o = 1; o < 64; o <<= 1) rk += __shfl_xor(rk, o);
            if (lane == 0) order[rk] = id; }
    }
}
__device__ __forceinline__ float gelu_tanh(float x) { const float u = 0.7978845608028654f * (x + 0.044715f * x * x * x); const float th = 1.f - 2.f * __builtin_amdgcn_rcpf(1.f + __expf(2.f * u)); return 0.5f * x * (1.f + th); }
__device__ __forceinline__ void phase2(ArgsP a, LAS unsigned char* lds, int tid, int lane, int wave, int G) {
    unsigned char* ws = a->ws;
    const bf16_t* KV = (const bf16_t*)(ws + WS_KV); const bf16_t* W1t = (const bf16_t*)(ws + WS_W + OFF_W1); const bf16_t* W2t = (const bf16_t*)(ws + WS_W + OFF_W2);
    const float* cb1 = (const float*)(ws + WS_W + OFF_CB1); const float* cb2 = (const float*)(ws + WS_W + OFF_CB2);
    bf16_t* KC = (bf16_t*)(ws + WS_KC);
    LAS bf16_t* hid = (LAS bf16_t*)lds;
    const int arow = lane & 15, kq = lane >> 4;
    for (int task = blockIdx.x; task < 256; task += G) {
        const int kv = task >> 7, bgi = (task >> 5) & 3, nt = task & 31;
        const bf16_t* src = KV + (size_t)kv * att::KV_STRIDE + (size_t)bgi * SEQ * 64;
        const int nrow = 16 * nt + arow, neff = nrow < 510 ? nrow : 510;
        const bf16_t* ap = src + (size_t)neff * 1024 + kq * 8;
        const bf16_t* bp0 = W1t + (size_t)kv * 256 * 2048 + (size_t)(32 * wave + arow) * 2048 + kq * 8; const bf16_t* bp1 = bp0 + 16 * 2048;
        f32x4 c0 = {0.f, 0.f, 0.f, 0.f}, c1 = {0.f, 0.f, 0.f, 0.f};
        float bb0 = 0.f, bb1 = 0.f;
        { const int col0 = 32 * wave + arow; float t0[32], t1[32];
#pragma unroll
          for (int c = 0; c < 32; ++c) { t0[c] = cb1[c * 512 + kv * 256 + col0]; t1[c] = cb1[c * 512 + kv * 256 + col0 + 16]; }
          __builtin_amdgcn_sched_barrier(0);
#pragma unroll
          for (int c = 0; c < 32; ++c) { bb0 += t0[c]; bb1 += t1[c]; } }
#pragma unroll 1
        for (int ks0 = 0; ks0 < 64; ks0 += 8) { bf16x8 av[8], b0[8], b1[8];
#pragma unroll
            for (int q = 0; q < 8; ++q) { av[q] = *(const bf16x8*)(ap + (ks0 + q) * 32); b0[q] = *(const bf16x8*)(bp0 + (ks0 + q) * 32); b1[q] = *(const bf16x8*)(bp1 + (ks0 + q) * 32); }
            __builtin_amdgcn_sched_barrier(0);
#pragma unroll
            for (int q = 0; q < 8; ++q) { c0 = __builtin_amdgcn_mfma_f32_16x16x32_bf16(av[q], b0[q], c0, 0, 0, 0); c1 = __builtin_amdgcn_mfma_f32_16x16x32_bf16(av[q], b1[q], c1, 0, 0, 0); } }
        { const int col0 = 32 * wave + arow;
#pragma unroll
          for (int j = 0; j < 4; ++j) { const int row = kq * 4 + j; hid[row * 264 + col0] = (bf16_t)(cvtpk(gelu_tanh(c0[j] + bb0), 0.f) & 0xffffu); hid[row * 264 + col0 + 16] = (bf16_t)(cvtpk(gelu_tanh(c1[j] + bb1), 0.f) & 0xffffu); } }
        LBAR();
        if (wave < 4) {
            const bf16_t* bp = W2t + (size_t)kv * 64 * 256 + (size_t)(16 * wave + arow) * 256 + kq * 8; f32x4 c = {0.f, 0.f, 0.f, 0.f};
            bf16x8 bv[8];
#pragma unroll
            for (int ks = 0; ks < 8; ++ks) bv[ks] = *(const bf16x8*)(bp + ks * 32);
            __builtin_amdgcn_sched_barrier(0);
#pragma unroll
            for (int ks = 0; ks < 8; ++ks) { const bf16x8 av = *(const LAS bf16x8*)(hid + arow * 264 + kq * 8 + ks * 32); c = __builtin_amdgcn_mfma_f32_16x16x32_bf16(av, bv[ks], c, 0, 0, 0); }
            const int col = 16 * wave + arow; const float bb = cb2[kv * 64 + col];
#pragma unroll
            for (int j = 0; j < 4; ++j) { const int n = 16 * nt + kq * 4 + j; KC[((size_t)(kv * 4 + bgi) * 512 + n) * 64 + col] = n < 511 ? (bf16_t)(cvtpk(c[j] + bb, 0.f) & 0xffffu) : (bf16_t)0; }
        }
        LBAR();
    }
    const int gt = blockIdx.x * 512 + tid, NGT = G * 512;
    { const bf16_t* MoK = (const bf16_t*)(ws + WS_MO) + att::MO_STRIDE; bf16_t* KM = (bf16_t*)(ws + WS_KM); LAS float* part = (LAS float*)(lds + 16384);
      for (int blk = blockIdx.x; blk < 256; blk += G) { const bf16_t* p = MoK + ((size_t)blk * 256 + 32 * wave) * 64 + lane; float s = 0.f;
#pragma unroll
          for (int r0 = 0; r0 < 32; r0 += 16) { unsigned short tv[16];
#pragma unroll
              for (int r = 0; r < 16; ++r) tv[r] = p[(size_t)(r0 + r) * 64];
              __builtin_amdgcn_sched_barrier(0);
#pragma unroll
              for (int r = 0; r < 16; ++r) s += __uint_as_float((unsigned)tv[r] << 16); }
          part[wave * 64 + lane] = s;
          LBAR();
          if (wave == 0) { float t = 0.f;
#pragma unroll
              for (int w = 0; w < 8; ++w) t += part[w * 64 + lane];
              KM[(size_t)blk * 64 + lane] = (bf16_t)(cvtpk(t * (1.0f / 256.0f), 0.f) & 0xffffu); }
          LBAR(); } }
    { const bf16_t* U = (const bf16_t*)(ws + WS_U); bf16_t* Abr = (bf16_t*)(ws + WS_XB);
      for (int e = gt; e < MTOK * 32; e += NGT) { const int row = e >> 5, c8 = e & 31, s = row & (SEQ - 1), w = 2 << (c8 >> 3), cnt = (s + 1 < w) ? s + 1 : w;
          float acc[8] = {0.f, 0.f, 0.f, 0.f, 0.f, 0.f, 0.f, 0.f}; u32x4 v0 = {0u, 0u, 0u, 0u};
#pragma unroll
          for (int i0 = 0; i0 < 16; i0 += 8) { if (i0 >= cnt) break; u32x4 v[8];
#pragma unroll
              for (int i = 0; i < 8; ++i) v[i] = (i0 + i < cnt) ? *(const u32x4*)(U + (size_t)(row - i0 - i) * 256 + c8 * 8) : (u32x4){0u, 0u, 0u, 0u};
              __builtin_amdgcn_sched_barrier(0);
              if (i0 == 0) v0 = v[0];
#pragma unroll
              for (int i = 0; i < 8; ++i)
#pragma unroll
                  for (int q = 0; q < 4; ++q) { acc[2 * q] += bflo(v[i][q]); acc[2 * q + 1] += bfhi(v[i][q]); } }
          const float ic = 1.0f / (float)cnt; u32x4 o;
#pragma unroll
          for (int q = 0; q < 4; ++q) o[q] = cvtpk(acc[2 * q] * ic - bflo(v0[q]), acc[2 * q + 1] * ic - bfhi(v0[q]));
          *(u32x4*)(Abr + (size_t)row * DM + c8 * 8) = o; } }
}
__global__ void __launch_bounds__(512, 2) fwd_megakernel(Args a) {
    extern __shared__ __attribute__((aligned(16))) unsigned char lds_raw[];
    LAS unsigned char* lds = (LAS unsigned char*)lds_raw;
    cg::grid_group grid = cg::this_grid();
    const int G = gridDim.x;
    volatile LAS unsigned* bst = (volatile LAS unsigned*)(lds + LDS_BYTES - 64);
    if (threadIdx.x < 16) bst[threadIdx.x] = 0u;
    __syncthreads();
    const ArgsP ap0 = (ArgsP)__builtin_amdgcn_kernarg_segment_ptr();
#define PHASE_ARGS ArgsP a_ = ap0; asm volatile("" : "+s"(a_)); unsigned char* ws = a_->ws; unsigned* ctl = (unsigned*)(ws + WS_CTL); float* ssp = (float*)(ws + WS_SSP); const float* tab = (const float*)(ws + WS_TAB); \
    bf16_t* XB = (bf16_t*)(ws + WS_XB); bf16_t* BIG = (bf16_t*)(ws + WS_BIG); bf16_t* MRG = (bf16_t*)(ws + WS_MRG); (void)ctl; (void)ssp; (void)tab; (void)XB; (void)BIG; (void)MRG;
    XcdBarrier xbar = xcd_barrier_post((unsigned*)(ap0->ws + WS_BAR), bst);
#define GRID_SYNC() xcd_barrier(xbar)
    for (int l = 0; l < DEPTH; ++l) {
        int tid_ = threadIdx.x; asm volatile("" : "+v"(tid_));
        const int tid = tid_, lane = tid & 63, wave = __builtin_amdgcn_readfirstlane(tid >> 6), gw = blockIdx.x * 8 + wave, NGW = G * 8;
        { PHASE_ARGS phase0(a_, l, lds, tid, lane, wave, gw, NGW); }
        if (l == 0) {
            if (threadIdx.x < 64) {
                unsigned ln_ = threadIdx.x; asm volatile("" : "+v"(ln_)); unsigned c_ = 0u, sp_ = 0u;
                for (;;) { c_ = ln_ < 16 ? xb_ld(&xbar.bar[XB_XCNT(ln_)]) : 0u; unsigned s_ = c_;
#pragma unroll
                    for (int o_ = 1; o_ < 16; o_ <<= 1) s_ += (unsigned)__shfl_xor((int)s_, o_);
                    if ((unsigned)__builtin_amdgcn_readfirstlane((int)s_) == (unsigned)G) break;
                    __builtin_amdgcn_s_sleep(1);
                    if (++sp_ > XB_SPIN_CAP) { if (ln_ == 0) atomicAdd(&xbar.bar[XB_TMO], 1u); break; } }
                const unsigned nx_ = (unsigned)__popcll(__ballot(c_ > 0u)); const unsigned nl_ = (unsigned)__builtin_amdgcn_readlane((int)c_, (int)xbar.x);
                if (ln_ == 0 && nl_ > 0u) { bst[0] = nl_; bst[1] = nx_ > 0u ? nx_ : 1u; } }
            __syncthreads();
            if (G == 0x7fffffff) grid.sync();
            GRID_SYNC();
        } else GRID_SYNC();
        { PHASE_ARGS pg8::Gemm g{XB, (const bf16_t*)(ws + WS_W + OFF_WIN), MTOK, NIN, DM}; pg8::StaticOrder S; S.init(MTOK, NIN, G, (int)blockIdx.x);
          EpiInProj E{ssp, (const float*)(ws + WS_W + OFF_BIN), tab, (bf16_t*)(ws + WS_U), (bf16_t*)(ws + WS_QN), (bf16_t*)(ws + WS_KV), (bf16_t*)(ws + WS_MO), BIG, (bf16_t*)(ws + WS_GN)};
          pg8::gemm_phase(lds, g, S, E); }
        GRID_SYNC();
        { PHASE_ARGS phase2(a_, lds, tid, lane, wave, G); }
        GRID_SYNC();
        { PHASE_ARGS
          att::Bufs B{(const bf16_t*)(ws + WS_QN), (const bf16_t*)(ws + WS_KV), (const bf16_t*)(ws + WS_MO), (const bf16_t*)(ws + WS_KC), (const bf16_t*)(ws + WS_KM), (const bf16_t*)(ws + WS_GN), XB};
          const int* order = (const int*)(ws + WS_ORDER); LAS int* slot = (LAS int*)(lds + att::L_END);
          if (wave >= 4) __builtin_amdgcn_s_setprio(1);
          for (;;) {
              LBAR();
              if (tid == 0) slot[0] = (int)atomicAdd(ctl + l, 1u);
              LBAR();
              const int item = slot[0];
              if (item >= 768) break;
              const int id = order[item];
              int tl = threadIdx.x; asm volatile("" : "+v"(tl));
              const int tid = tl, lane = tid & 63, wave = __builtin_amdgcn_readfirstlane(tid >> 6);
              att::Ctx C; C.lds = (LAS char*)lds; C.wsf = (LAS float*)(lds + att::L_WSF) + wave * 64; C.otl = (LAS float*)(lds + att::L_OT) + wave * 2048 + lane; C.tid = tid; C.wid = wave; C.lane = lane; C.r32 = lane & 31; C.hi = lane >> 5;
              C.vbl = ((lane >> 4) & 1) * 32 + (lane & 3) * 8 + (4 * (lane >> 5) + ((lane & 15) >> 2)) * 64;
              if (id < 512) att::nsa_item(C, B, id >> 8, (id >> 7) & 1, id & 127);
              else { const int x = id - 512; att::moba_item(C, B, x >> 7, (x >> 5) & 3, x & 31); }
          }
          __builtin_amdgcn_s_setprio(0); }
        GRID_SYNC();
        { PHASE_ARGS pg8::Gemm g{XB, (const bf16_t*)(ws + WS_W + OFF_WBR), MTOK, DM, DM}; pg8::StaticOrder S; S.init(MTOK, DM, G, (int)blockIdx.x);
          EpiBranch E{BIG, MRG}; pg8::gemm_phase(lds, g, S, E); }
        GRID_SYNC();
        { PHASE_ARGS pg8::Gemm g{MRG, (const bf16_t*)(ws + WS_W + OFF_WOUT), MTOK, DM, DM}; pg8::StaticOrder S; S.init(MTOK, DM, G, (int)blockIdx.x);
          bf16_t* RES = (bf16_t*)a_->out; EpiResid E{l == 0 ? a_->in[0] : nullptr, RES, XB, nullptr, ssp};   pg8::gemm_phase(lds, g, S, E); }
        GRID_SYNC();
        { PHASE_ARGS pg8::Gemm g{XB, (const bf16_t*)(ws + WS_W + OFF_WGU), MTOK, NGU, DM}; pg8::StaticOrder S; S.init(MTOK, NGU, G, (int)blockIdx.x);
          EpiSwiGLU E{ssp, BIG}; pg8::gemm_phase(lds, g, S, E); }
        GRID_SYNC();
        { PHASE_ARGS pg8::Gemm g{BIG, (const bf16_t*)(ws + WS_W + OFF_WD), MTOK, DM, DFF}; pg8::StaticOrder S; S.init(MTOK, DM, G, (int)blockIdx.x);
          bf16_t* RES = (bf16_t*)a_->out; EpiResid E{nullptr, XB, XB, l + 1 < DEPTH ? RES : nullptr, ssp};   pg8::gemm_phase(lds, g, S, E); }
        GRID_SYNC();
    }
    { PHASE_ARGS const float* fn = a_->in[19]; float* outp = a_->out; const int lane = threadIdx.x & 63, gw = blockIdx.x * 8 + (threadIdx.x >> 6), NGW = G * 8;
      const f32x4* gr = (const f32x4*)fn + lane; f32x4 gv[4];
#pragma unroll
      for (int j = 0; j < 4; ++j) gv[j] = gr[64 * j];
      for (int m0 = 2 * gw; m0 < MTOK; m0 += 2 * NGW) { u32x2 w[2][4]; float rstd[2];
#pragma unroll
          for (int q = 0; q < 2; ++q) { const u32x2* xr = (const u32x2*)(XB + (size_t)(m0 + q) * DM) + lane; rstd[q] = row_rstd(ssp, m0 + q);
#pragma unroll
              for (int j = 0; j < 4; ++j) w[q][j] = xr[64 * j]; }
#pragma unroll
          for (int q = 0; q < 2; ++q) { f32x4* orow = (f32x4*)(outp + (size_t)(m0 + q) * DM) + lane;
#pragma unroll
              for (int j = 0; j < 4; ++j) { const f32x4 v = {bflo(w[q][j][0]), bfhi(w[q][j][0]), bflo(w[q][j][1]), bfhi(w[q][j][1])}; __builtin_nontemporal_store(v * rstd[q] * gv[j], orow + 64 * j); } } } }
}

extern "C" void kernel_launch(void* const* d_in, const int* in_sizes, int n_in, void* d_out, int out_size, void* d_ws, size_t ws_size, hipStream_t stream) {
    static int grid = 0;
    if (grid == 0) {
        if (n_in != 20 || in_sizes[0] != MTOK * DM || out_size != MTOK * DM || ws_size < WS_END) { fprintf(stderr, "kernel_launch: unexpected shapes / workspace (n_in %d, ws %zu)\n", n_in, ws_size); grid = -1; return; }
        int dev = 0, cus = 0, per_cu = 0;
        if (hipGetDevice(&dev) != hipSuccess || hipDeviceGetAttribute(&cus, hipDeviceAttributeMultiprocessorCount, dev) != hipSuccess) { grid = -1; return; }
        if (hipFuncSetAttribute((const void*)fwd_megakernel, hipFuncAttributeMaxDynamicSharedMemorySize, LDS_BYTES) != hipSuccess) { fprintf(stderr, "kernel_launch: hipFuncSetAttribute failed\n"); grid = -1; return; }
        if (hipOccupancyMaxActiveBlocksPerMultiprocessor(&per_cu, (const void*)fwd_megakernel, 512, LDS_BYTES) != hipSuccess || per_cu < 1) { fprintf(stderr, "kernel_launch: occupancy query failed (%d)\n", per_cu); (void)hipGetLastError(); grid = -1; return; }
        grid = cus * per_cu;
    }
    if (grid < 0) return;
    if (hipMemsetAsync((char*)d_ws + WS_CTL, 0, 32768, stream) != hipSuccess) { fprintf(stderr, "kernel_launch: memset failed\n"); return; }
    Args a{};
    for (int i = 0; i < 20; ++i) a.in[i] = (const float*)d_in[i];
    a.out = (float*)d_out; a.ws = (unsigned char*)d_ws;
    void* args[] = {&a};
    const hipError_t e = hipLaunchCooperativeKernel((const void*)fwd_megakernel, dim3(grid), dim3(512), args, LDS_BYTES, stream);
    if (e != hipSuccess) fprintf(stderr, "kernel_launch: cooperative launch failed: %s (grid %d)\n", hipGetErrorString(e), grid);
}
```
